# Optimizing an MI355X kernel written in HIP

```python
import jax
import jax.numpy as jnp
from jax import lax
import numpy as np

D_MODEL = 1024
BATCH = 4
SEQ = 4096
DEPTH = 4

GRID_W = 64
CTX_LEN = 256
HEAD_DIM = 64
MIX_WIDTH = D_MODEL
N_MIX_HEADS = MIX_WIDTH // HEAD_DIM
N_DIR = 2
RET_HEADS = N_MIX_HEADS // 4
RET_WIDTH = RET_HEADS * HEAD_DIM
RET_CHUNK = 128
GDN_HEADS = N_MIX_HEADS // 4
GDN_WIDTH = GDN_HEADS * HEAD_DIM
GDN_CHUNK = 64
GDN_CONV = 5
SWA_HEADS = N_MIX_HEADS - RET_HEADS - GDN_HEADS
SWA_KV_HEADS = SWA_HEADS // 4
SWA_GROUP = SWA_HEADS // SWA_KV_HEADS
SWA_WIDTH = SWA_HEADS * HEAD_DIM
SWA_KV_WIDTH = SWA_KV_HEADS * HEAD_DIM
WINDOW = 128
ATTN_BLOCK = 128
ROPE_BASE = 10000.0
RET_COLS = 4 * RET_WIDTH
GDN_COLS = 4 * GDN_WIDTH + 2 * N_DIR * GDN_HEADS
SWA_COLS = SWA_WIDTH + 2 * SWA_KV_WIDTH
IN_COLS = RET_COLS + GDN_COLS + SWA_COLS
DENSE_FF = 2816
N_EXPERTS = 8
TOP_K = 2
EXPERT_FF = 3584
MOE_BLOCK = 128
N_DENSE_LAYERS = (DEPTH + 1) // 2
N_MOE_LAYERS = DEPTH // 2
EPS = 1e-6

kernel_name = 'hybrid_retention_deltanet_swa_moe_dit'


def split_cols(p, sizes):
    idx = [int(s) for s in np.cumsum(sizes)[:-1]]
    return jnp.split(p, idx, axis=-1)


def rms_norm(x, gain):
    xf = x.astype(jnp.float32)
    y = xf * lax.rsqrt(jnp.mean(xf * xf, axis=-1, keepdims=True) + EPS)
    return (y * gain.astype(jnp.float32)).astype(x.dtype)


def modulate(h, shift, scale):
    return h * (1 + scale) + shift


def l2_normalize(t):
    return t * lax.rsqrt(jnp.sum(t * t, axis=-1, keepdims=True) + EPS)


def flip_dir(t, direction):
    return jnp.flip(t, axis=1) if direction == 1 else t


def axial_rope(n_tokens):
    rows = n_tokens // GRID_W
    row = jnp.repeat(jnp.arange(rows, dtype=jnp.float32), GRID_W)
    col = jnp.tile(jnp.arange(GRID_W, dtype=jnp.float32), rows)
    n_freq = HEAD_DIM // 4
    inv = ROPE_BASE ** (-jnp.arange(n_freq, dtype=jnp.float32) / n_freq)
    ang = jnp.concatenate([row[:, None] * inv, col[:, None] * inv], axis=-1)
    return jnp.cos(ang)[:, None, :], jnp.sin(ang)[:, None, :]


def apply_rope(t, cos, sin):
    half = t.shape[-1] // 2
    t1 = t[..., :half].astype(jnp.float32)
    t2 = t[..., half:].astype(jnp.float32)
    return jnp.concatenate([t1 * cos - t2 * sin, t2 * cos + t1 * sin], axis=-1).astype(t.dtype)


def depthwise_conv_centred(x, w):
    return lax.conv_general_dilated(x, w[:, None, :].astype(x.dtype), window_strides=(1,), padding='SAME',
                                    dimension_numbers=('NWC', 'WIO', 'NWC'), feature_group_count=x.shape[-1])


def retention_chunkwise(q, k, v, log_gamma, s0):
    b, t, h, dk = q.shape
    n = t // RET_CHUNK
    qc = q.reshape(b, n, RET_CHUNK, h, dk)
    kc = k.reshape(b, n, RET_CHUNK, h, dk)
    vc = v.reshape(b, n, RET_CHUNK, h, -1)
    pos = jnp.arange(RET_CHUNK, dtype=jnp.float32)
    diff = pos[:, None] - pos[None, :]
    intra_decay = jnp.exp(jnp.where(diff[None] >= 0, diff[None] * log_gamma[:, None, None], -jnp.inf))
    scores = jnp.einsum('bnihd,bnjhd->bnhij', qc, kc) * intra_decay
    o_intra = jnp.einsum('bnhij,bnjhe->bnihe', scores, vc)
    k_w = jnp.exp((RET_CHUNK - 1 - pos)[:, None] * log_gamma)
    chunk_kv = jnp.einsum('bnjhd,bnjhe->nbhde', kc * k_w[..., None], vc)
    chunk_decay = jnp.exp(RET_CHUNK * log_gamma)[:, None, None]

    def step(s, kv):
        return s * chunk_decay + kv, s

    s_final, s_prev = lax.scan(step, s0, chunk_kv)
    q_w = jnp.exp((pos + 1)[:, None] * log_gamma)
    o_inter = jnp.einsum('bnihd,nbhde->bnihe', qc * q_w[..., None], s_prev)
    return (o_intra + o_inter).reshape(b, t, h, -1), s_final


def gated_delta_chunkwise(q, k, v, g, beta, s0):
    b, t, h, dk = q.shape
    dv = v.shape[-1]
    n = t // GDN_CHUNK

    def blk(z):
        return z.reshape(b, n, GDN_CHUNK, h, -1).transpose(0, 1, 3, 2, 4)

    q, k, v = blk(q), blk(k), blk(v)
    g = g.reshape(b, n, GDN_CHUNK, h).transpose(0, 1, 3, 2)
    beta = beta.reshape(b, n, GDN_CHUNK, h).transpose(0, 1, 3, 2)
    gcs = jnp.cumsum(g, axis=-1)
    idx = jnp.arange(GDN_CHUNK)
    incl = idx[:, None] >= idx[None, :]
    strict = idx[:, None] > idx[None, :]
    decay = jnp.exp(jnp.where(incl, gcs[..., :, None] - gcs[..., None, :], -jnp.inf))
    kb = k * beta[..., None]
    a_mat = jnp.where(strict, jnp.einsum('bnhid,bnhjd->bnhij', kb, k) * decay, 0.0)
    rhs = jnp.concatenate([v * beta[..., None], kb * jnp.exp(gcs)[..., None]], axis=-1)
    sol = lax.linalg.triangular_solve(a_mat + jnp.eye(GDN_CHUNK, dtype=a_mat.dtype), rhs, left_side=True,
                                      lower=True, unit_diagonal=True)
    u, w = sol[..., :dv], sol[..., dv:]
    attn = jnp.einsum('bnhid,bnhjd->bnhij', q, k) * decay
    q_dec = q * jnp.exp(gcs)[..., None]
    k_dec = k * jnp.exp(gcs[..., -1:] - gcs)[..., None]
    blk_decay = jnp.exp(gcs[..., -1])
    xs = tuple(jnp.moveaxis(z, 1, 0) for z in (u, w, q_dec, k_dec, attn, blk_decay))

    def step(s, inp):
        u_n, w_n, qd_n, kd_n, at_n, dec_n = inp
        v_new = u_n - jnp.einsum('bhcd,bhde->bhce', w_n, s)
        o = jnp.einsum('bhcd,bhde->bhce', qd_n, s) + jnp.einsum('bhij,bhje->bhie', at_n, v_new)
        s = s * dec_n[..., None, None] + jnp.einsum('bhcd,bhce->bhde', kd_n, v_new)
        return s, o

    s_final, o = lax.scan(step, s0, xs)
    o = jnp.moveaxis(o, 0, 1).transpose(0, 1, 3, 2, 4).reshape(b, t, h, dv)
    return o, s_final


def retention_mixer(p_ctx, p_lat, log_neg_decay, gn_gain, cos, sin):
    def heads(p):
        b, t = p.shape[:2]
        q, k, v, g = split_cols(p.astype(jnp.float32), [RET_WIDTH] * 4)
        hd = lambda z: z.reshape(b, t, RET_HEADS, HEAD_DIM)
        return hd(q), hd(k) * HEAD_DIM ** -0.5, hd(v), g

    qc, kc, vc, gc = heads(p_ctx)
    ql, kl, vl, gl = heads(p_lat)
    ql, kl = apply_rope(ql, cos, sin), apply_rope(kl, cos, sin)
    log_gamma = -jnp.exp(log_neg_decay.astype(jnp.float32))
    b = p_lat.shape[0]
    s0 = jnp.zeros((b, RET_HEADS, HEAD_DIM, HEAD_DIM), jnp.float32)
    o_c = jnp.zeros_like(vc)
    o_l = jnp.zeros_like(vl)
    for d in range(N_DIR):
        oc, s_ctx = retention_chunkwise(flip_dir(qc, d), flip_dir(kc, d), flip_dir(vc, d), log_gamma[d], s0)
        ol, _ = retention_chunkwise(flip_dir(ql, d), flip_dir(kl, d), flip_dir(vl, d), log_gamma[d], s_ctx)
        o_c = o_c + flip_dir(oc, d)
        o_l = o_l + flip_dir(ol, d)

    def finish(o, g):
        mu = jnp.mean(o, axis=-1, keepdims=True)
        var = jnp.mean(jnp.square(o - mu), axis=-1, keepdims=True)
        y = ((o - mu) * lax.rsqrt(var + EPS)).reshape(o.shape[0], o.shape[1], RET_WIDTH)
        return y * gn_gain.astype(jnp.float32) * jax.nn.silu(g)

    return finish(o_c, gc), finish(o_l, gl)


def gated_deltanet_mixer(p_ctx, p_lat, conv_w, a_log, dt_bias, norm_gain):
    def prep(p):
        b, t = p.shape[:2]
        qkv, z, a, bt = split_cols(p.astype(jnp.float32),
                                   [3 * GDN_WIDTH, GDN_WIDTH, N_DIR * GDN_HEADS, N_DIR * GDN_HEADS])
        qkv = jax.nn.silu(depthwise_conv_centred(qkv, conv_w.astype(jnp.float32)))
        q, k, v = split_cols(qkv, [GDN_WIDTH] * 3)
        hd = lambda y: y.reshape(b, t, GDN_HEADS, HEAD_DIM)
        q = l2_normalize(hd(q)) * HEAD_DIM ** -0.5
        k = l2_normalize(hd(k))
        a = a.reshape(b, t, N_DIR, GDN_HEADS)
        bt = bt.reshape(b, t, N_DIR, GDN_HEADS)
        g = -jnp.exp(a_log.astype(jnp.float32)) * jax.nn.softplus(a + dt_bias.astype(jnp.float32))
        return q, k, hd(v), z, g, jax.nn.sigmoid(bt)

    qc, kc, vc, zc, gc, bc = prep(p_ctx)
    ql, kl, vl, zl, gl, bl = prep(p_lat)
    b = p_lat.shape[0]
    s0 = jnp.zeros((b, GDN_HEADS, HEAD_DIM, HEAD_DIM), jnp.float32)
    o_c = jnp.zeros_like(vc)
    o_l = jnp.zeros_like(vl)
    for d in range(N_DIR):
        oc, s_ctx = gated_delta_chunkwise(flip_dir(qc, d), flip_dir(kc, d), flip_dir(vc, d),
                                          flip_dir(gc[:, :, d], d), flip_dir(bc[:, :, d], d), s0)
        ol, _ = gated_delta_chunkwise(flip_dir(ql, d), flip_dir(kl, d), flip_dir(vl, d),
                                      flip_dir(gl[:, :, d], d), flip_dir(bl[:, :, d], d), s_ctx)
        o_c = o_c + flip_dir(oc, d)
        o_l = o_l + flip_dir(ol, d)

    def finish(o, z):
        o = o * lax.rsqrt(jnp.mean(o * o, axis=-1, keepdims=True) + EPS) * norm_gain.astype(jnp.float32)
        return o.reshape(o.shape[0], o.shape[1], GDN_WIDTH) * jax.nn.silu(z)

    return finish(o_c, zc), finish(o_l, zl)


def window_attention_mixer(p_ctx, p_lat, sink, cos, sin):
    b, n_lat = p_lat.shape[:2]
    n_ctx = p_ctx.shape[1]
    scale = HEAD_DIM ** -0.5

    def heads(p):
        t = p.shape[1]
        q, k, v = split_cols(p, [SWA_WIDTH, SWA_KV_WIDTH, SWA_KV_WIDTH])
        return (q.reshape(b, t, SWA_HEADS, HEAD_DIM), k.reshape(b, t, SWA_KV_HEADS, HEAD_DIM),
                v.reshape(b, t, SWA_KV_HEADS, HEAD_DIM))

    qc, kc, vc = heads(p_ctx)
    ql, kl, vl = heads(p_lat)
    ql = apply_rope(ql, cos, sin)
    kl = apply_rope(kl, cos, sin)
    qc = qc.reshape(b, n_ctx, SWA_KV_HEADS, SWA_GROUP, HEAD_DIM)
    ql = ql.reshape(b, n_lat, SWA_KV_HEADS, SWA_GROUP, HEAD_DIM)
    sink_g = sink.astype(jnp.float32).reshape(SWA_KV_HEADS, SWA_GROUP)
    s_cc = jnp.einsum('bqgrd,bkgd->bgrqk', qc, kc).astype(jnp.float32) * scale
    sink_c = jnp.broadcast_to(sink_g[None, :, :, None, None], s_cc.shape[:-1] + (1,))
    p_c = jax.nn.softmax(jnp.concatenate([s_cc, sink_c], axis=-1), axis=-1)[..., :n_ctx].astype(vc.dtype)
    o_c = jnp.einsum('bgrqk,bkgd->bqgrd', p_c, vc).reshape(b, n_ctx, SWA_WIDTH)
    nb = n_lat // ATTN_BLOCK
    qb = ql.reshape(b, nb, ATTN_BLOCK, SWA_KV_HEADS, SWA_GROUP, HEAD_DIM)

    def band(z):
        zp = jnp.pad(z, ((0, 0), (ATTN_BLOCK, ATTN_BLOCK), (0, 0), (0, 0)))
        zp = zp.reshape(b, nb + 2, ATTN_BLOCK, SWA_KV_HEADS, HEAD_DIM)
        return jnp.concatenate([zp[:, :nb], zp[:, 1:nb + 1], zp[:, 2:]], axis=2)

    kw, vw = band(kl), band(vl)
    s_loc = jnp.einsum('bnqgrd,bnkgd->bngrqk', qb, kw).astype(jnp.float32) * scale
    s_ctx = jnp.einsum('bnqgrd,bkgd->bngrqk', qb, kc).astype(jnp.float32) * scale
    q_pos = jnp.arange(nb)[:, None, None] * ATTN_BLOCK + jnp.arange(ATTN_BLOCK)[None, :, None]
    k_pos = (jnp.arange(nb)[:, None, None] - 1) * ATTN_BLOCK + jnp.arange(3 * ATTN_BLOCK)[None, None, :]
    valid = (jnp.abs(k_pos - q_pos) <= WINDOW) & (k_pos >= 0) & (k_pos < n_lat)
    s_loc = jnp.where(valid[None, :, None, None], s_loc, -jnp.inf)
    sink_l = jnp.broadcast_to(sink_g[None, None, :, :, None, None], s_loc.shape[:-1] + (1,))
    p_l = jax.nn.softmax(jnp.concatenate([s_loc, s_ctx, sink_l], axis=-1), axis=-1).astype(vl.dtype)
    n_band = 3 * ATTN_BLOCK
    o_l = (jnp.einsum('bngrqk,bnkgd->bnqgrd', p_l[..., :n_band], vw)
           + jnp.einsum('bngrqk,bkgd->bnqgrd', p_l[..., n_band:n_band + n_ctx], vc))
    return o_c, o_l.reshape(b, n_lat, SWA_WIDTH)


def token_mixers(p_ctx, p_lat, ret_decay, ret_gn_g, gdn_conv_w, gdn_a_log, gdn_dt_bias, gdn_norm_g, swa_sink,
                 cos, sin):
    pc = split_cols(p_ctx, [RET_COLS, GDN_COLS, SWA_COLS])
    pl = split_cols(p_lat, [RET_COLS, GDN_COLS, SWA_COLS])
    rc, rl = retention_mixer(pc[0], pl[0], ret_decay, ret_gn_g, cos, sin)
    dc, dl = gated_deltanet_mixer(pc[1], pl[1], gdn_conv_w, gdn_a_log, gdn_dt_bias, gdn_norm_g)
    wc, wl = window_attention_mixer(pc[2], pl[2], swa_sink, cos, sin)
    dt = p_lat.dtype
    o_ctx = jnp.concatenate([rc.astype(dt), dc.astype(dt), wc.astype(dt)], axis=-1)
    o_lat = jnp.concatenate([rl.astype(dt), dl.astype(dt), wl.astype(dt)], axis=-1)
    return o_ctx, o_lat


def swiglu(h, w1, w3, w2):
    return (jax.nn.silu(h @ w1) * (h @ w3)) @ w2


def moe_swiglu(h, router_w, w_gate, w_up, w_down):
    n_tok, d = h.shape
    logits = (h @ router_w).astype(jnp.float32)
    top_logit, top_idx = lax.top_k(logits, TOP_K)
    gate = jax.nn.softmax(top_logit, axis=-1)
    n_assign = n_tok * TOP_K
    expert_flat = top_idx.reshape(n_assign)
    order = jnp.argsort(expert_flat)
    expert_sorted = expert_flat[order]
    token_sorted = (order // TOP_K).astype(jnp.int32)
    gate_sorted = gate.reshape(n_assign)[order]
    counts = jnp.bincount(expert_flat, length=N_EXPERTS)
    group_start = jnp.cumsum(counts) - counts
    padded = (counts + MOE_BLOCK - 1) // MOE_BLOCK * MOE_BLOCK
    padded_end = jnp.cumsum(padded)
    padded_start = padded_end - padded
    dest = padded_start[expert_sorted] + jnp.arange(n_assign) - group_start[expert_sorted]
    n_blocks = -(-n_assign // MOE_BLOCK) + N_EXPERTS
    n_rows = n_blocks * MOE_BLOCK
    row_token = jnp.zeros((n_rows,), jnp.int32).at[dest].set(token_sorted)
    row_gate = jnp.zeros((n_rows,), jnp.float32).at[dest].set(gate_sorted)
    block_start = jnp.arange(n_blocks) * MOE_BLOCK
    block_expert = jnp.minimum(jnp.searchsorted(padded_end, block_start, side='right'), N_EXPERTS - 1)

    def expert_block(args):
        tok, e = args
        xb = h[tok]
        hid = jax.nn.silu(xb @ w_gate[e]) * (xb @ w_up[e])
        return hid @ w_down[e]

    y = lax.map(expert_block, (row_token.reshape(n_blocks, MOE_BLOCK), block_expert))
    y = y.reshape(n_rows, d) * row_gate[:, None].astype(h.dtype)
    return jnp.zeros_like(h).at[row_token].add(y)


def setup_inputs(seed: int = 0) -> dict:
    key = jax.random.key(seed)
    ks = jax.random.split(key, 32)
    f32 = jnp.float32
    d = D_MODEL

    def nrm(k, shape, scale):
        return jax.random.normal(k, shape, f32) * scale

    ret_base = np.log(-np.log(1.0 - 2.0 ** (-5.0 - np.arange(RET_HEADS))))
    dt = jnp.exp(jax.random.uniform(ks[12], (DEPTH, N_DIR, GDN_HEADS), f32, np.log(1e-3), np.log(1e-1)))
    return {
        'x': nrm(ks[0], (BATCH, SEQ, d), 1.0),
        'c': nrm(ks[1], (BATCH, d), 1.0),
        'ctx': nrm(ks[2], (BATCH, CTX_LEN, d), 1.0),
        'c_ctx': nrm(ks[3], (d,), 1.0),
        'ada_w': nrm(ks[4], (DEPTH, d, 6 * d), 0.5 * d ** -0.5),
        'ada_b': nrm(ks[5], (DEPTH, 6 * d), 0.02),
        'norm1_g': 1.0 + nrm(ks[6], (DEPTH, d), 0.05),
        'w_in': nrm(ks[7], (DEPTH, d, IN_COLS), d ** -0.5),
        'ret_decay': jnp.asarray(ret_base, f32) + nrm(ks[8], (DEPTH, N_DIR, RET_HEADS), 0.05),
        'ret_gn_g': 1.0 + nrm(ks[9], (DEPTH, RET_WIDTH), 0.05),
        'gdn_conv_w': nrm(ks[10], (DEPTH, GDN_CONV, 3 * GDN_WIDTH), GDN_CONV ** -0.5),
        'gdn_a_log': jnp.log(jax.random.uniform(ks[11], (DEPTH, N_DIR, GDN_HEADS), f32, 1.0, 16.0)),
        'gdn_dt_bias': dt + jnp.log(-jnp.expm1(-dt)),
        'gdn_norm_g': 1.0 + nrm(ks[13], (DEPTH, HEAD_DIM), 0.05),
        'swa_sink': nrm(ks[14], (DEPTH, SWA_HEADS), 0.5),
        'w_out': nrm(ks[15], (DEPTH, MIX_WIDTH, d), MIX_WIDTH ** -0.5),
        'norm2_g': 1.0 + nrm(ks[16], (DEPTH, d), 0.05),
        'ffn_w1': nrm(ks[17], (N_DENSE_LAYERS, d, DENSE_FF), d ** -0.5),
        'ffn_w3': nrm(ks[18], (N_DENSE_LAYERS, d, DENSE_FF), d ** -0.5),
        'ffn_w2': nrm(ks[19], (N_DENSE_LAYERS, DENSE_FF, d), DENSE_FF ** -0.5),
        'router_w': nrm(ks[20], (N_MOE_LAYERS, d, N_EXPERTS), d ** -0.5),
        'moe_w1': nrm(ks[21], (N_MOE_LAYERS, N_EXPERTS, d, EXPERT_FF), d ** -0.5),
        'moe_w3': nrm(ks[22], (N_MOE_LAYERS, N_EXPERTS, d, EXPERT_FF), d ** -0.5),
        'moe_w2': nrm(ks[23], (N_MOE_LAYERS, N_EXPERTS, EXPERT_FF, d), EXPERT_FF ** -0.5),
        'final_g': 1.0 + nrm(ks[24], (d,), 0.05),
    }


def reference(x, c, ctx, c_ctx, ada_w, ada_b, norm1_g, w_in, ret_decay, ret_gn_g, gdn_conv_w, gdn_a_log,
              gdn_dt_bias, gdn_norm_g, swa_sink, w_out, norm2_g, ffn_w1, ffn_w3, ffn_w2, router_w, moe_w1, moe_w3,
              moe_w2, final_g):
    b, n_lat, d = x.shape
    n_ctx = ctx.shape[1]
    cos, sin = axial_rope(n_lat)
    silu_c = jax.nn.silu(c)
    silu_cc = jax.nn.silu(c_ctx)
    for layer in range(DEPTH):
        last = layer == DEPTH - 1
        mx = jnp.split((silu_c @ ada_w[layer] + ada_b[layer])[:, None, :], 6, axis=-1)
        mc = jnp.split(silu_cc @ ada_w[layer] + ada_b[layer], 6, axis=-1)
        hx = modulate(rms_norm(x, norm1_g[layer]), mx[0], mx[1])
        hc = modulate(rms_norm(ctx, norm1_g[layer]), mc[0], mc[1])
        oc, ox = token_mixers(hc @ w_in[layer], hx @ w_in[layer], ret_decay[layer], ret_gn_g[layer],
                              gdn_conv_w[layer], gdn_a_log[layer], gdn_dt_bias[layer], gdn_norm_g[layer],
                              swa_sink[layer], cos, sin)
        x = x + mx[2] * (ox @ w_out[layer])
        tokens = modulate(rms_norm(x, norm2_g[layer]), mx[3], mx[4]).reshape(-1, d)
        if not last:
            ctx = ctx + mc[2] * (oc @ w_out[layer])
            hc2 = modulate(rms_norm(ctx, norm2_g[layer]), mc[3], mc[4])
            tokens = jnp.concatenate([hc2.reshape(-1, d), tokens], axis=0)
        i = layer // 2
        if layer % 2 == 0:
            y = swiglu(tokens, ffn_w1[i], ffn_w3[i], ffn_w2[i])
        else:
            y = moe_swiglu(tokens, router_w[i], moe_w1[i], moe_w3[i], moe_w2[i])
        x = x + mx[5] * y[tokens.shape[0] - b * n_lat:].reshape(b, n_lat, d)
        if not last:
            ctx = ctx + mc[5] * y[:b * n_ctx].reshape(b, n_ctx, d)
    return rms_norm(x, final_g)
```

```cpp
#include <hip/hip_runtime.h>
#include <cstdio>
#include <cstdint>

#ifndef MK_ONE_LAUNCH
#define MK_ONE_LAUNCH 0
#endif

#define GAS __attribute__((address_space(1)))
#define LAS __attribute__((address_space(3)))
typedef unsigned short bf16;
typedef short bf16x8 __attribute__((ext_vector_type(8)));
typedef float f32x4 __attribute__((ext_vector_type(4)));
typedef float f32x2 __attribute__((ext_vector_type(2)));
typedef unsigned u32x4 __attribute__((ext_vector_type(4)));
typedef unsigned u32x2 __attribute__((ext_vector_type(2)));

constexpr int D = 1024, NB = 4, TL = 4096, TC = 256, DEPTH = 4;
constexpr int MC = NB * TC, ML = NB * TL, M = MC + ML;
constexpr int INC = 2832, NP = 2816;
constexpr int FF = 2816, EF = 3584, NE = 8;
constexpr int MAXROWS = 36864;
constexpr float EPS = 1e-6f;
constexpr int PC_RQ = 0, PC_RK = 256, PC_RV = 512, PC_RG = 768, PC_GQKV = 1024, PC_GZ = 1792, PC_SQ = 2048, PC_SK = 2560, PC_SV = 2688;

constexpr size_t MiB = 1u << 20;
constexpr size_t WS_CTL = 0, CTL_ZERO_BYTES = 1 * MiB;
constexpr size_t WS_MOD = 1 * MiB;
constexpr size_t WS_ROPE = 2 * MiB;
constexpr size_t WS_TKE = 3 * MiB, WS_TKG = 3 * MiB + 256 * 1024, WS_TOKROW = 3 * MiB + 512 * 1024, WS_ROWTOK = 3 * MiB + 768 * 1024, WS_TILEE = 4 * MiB;
constexpr size_t WS_AB = 5 * MiB, WS_GB = 7 * MiB;
constexpr size_t WS_WIN = 16 * MiB, WS_WOUT = 38 * MiB, WS_W13 = 46 * MiB, WS_W2 = 68 * MiB, WS_MW13 = 80 * MiB, WS_MW2 = 192 * MiB;
constexpr size_t WS_XS = 248 * MiB, WS_H = 316 * MiB, WS_HP = 350 * MiB, WS_YM = 422 * MiB, WS_R1 = 566 * MiB;
constexpr size_t R1_P = 0, R1_PREP = 94 * MiB, R1_O = 158 * MiB, R1_OR = 192 * MiB, R1_OG = 226 * MiB, R1_HID = 0;
constexpr size_t WS_END = WS_R1 + 260 * MiB;
constexpr size_t PREP_RQ = 0, PREP_RK = (size_t)M * 256 * 2, PREP_SQ = (size_t)M * 512 * 2, PREP_SK = (size_t)M * 1024 * 2, PREP_GD = (size_t)M * 1152 * 2;
static_assert(PREP_GD + (size_t)M * 768 * 2 <= 64 * MiB, "prep");
static_assert((size_t)M * NP * 2 <= 94 * MiB && (size_t)MAXROWS * EF * 2 <= 260 * MiB, "r1");

constexpr int CW_TMO = 0, CW_BAR = 4096;

__device__ __forceinline__ float bf2f(bf16 v) { return __uint_as_float(((unsigned)v) << 16); }
__device__ __forceinline__ unsigned f2bf(float f) { unsigned u = __float_as_uint(f); return (u + 0x7fffu + ((u >> 16) & 1u)) >> 16; }
__device__ __forceinline__ unsigned pk2(float lo, float hi) { return f2bf(lo) | (f2bf(hi) << 16); }
__device__ __forceinline__ float wave_sum(float v) {
#pragma unroll
    for (int o = 1; o < 64; o <<= 1) v += __shfl_xor(v, o);
    return v;
}
__device__ __forceinline__ float siluf(float x) { return x / (1.0f + __expf(-x)); }
#define LDS_WAIT() asm volatile("s_waitcnt lgkmcnt(0)" ::: "memory")

namespace pg8 {
#define PG8_LAS __attribute__((address_space(3)))
constexpr int BM = 256, BK = 64, HALF = 128, HTB = HALF * BK * 2, STAGE_BYTES = 8 * HTB;
__host__ __device__ __forceinline__ int lds_byte(int r, int c) { const int st = (r >> 4) * 2 + (c >> 5), rr = r & 15, cc = c & 31, ob = rr * 64 + cc * 2; return st * 1024 + (ob ^ (((ob >> 9) & 1) << 5)); }
__host__ __device__ __forceinline__ void stage_rc(int b, int& R, int& C) { const int st = b / 1024, sb = b % 1024, swz = sb ^ (((sb >> 9) & 1) << 5); R = (st >> 1) * 16 + swz / 64; C = (st & 1) * 32 + (swz % 64) / 2; }
__host__ __device__ __forceinline__ int perm32(int rho) { const int n = rho >> 4, i = rho & 15; return 8 * (i >> 2) + 4 * n + (i & 3); }
struct Unit { int pm, pn, aux; const char* A; const char* B; };
__device__ __forceinline__ unsigned cvt_pk_bf16(float lo, float hi) { unsigned r; asm volatile("v_cvt_pk_bf16_f32 %0, %1, %2" : "=v"(r) : "v"(lo), "v"(hi)); return r; }

template <class Epi, class Sched, bool ALIGN_EPI = true, bool SP2 = true>
__device__ __forceinline__ void gemm_phase(PG8_LAS unsigned char* lds, const int K, const Sched& S, const Epi& E, const int tid) {
    const int wid = __builtin_amdgcn_readfirstlane(tid >> 6), lane = tid & 63, wr = wid >> 2, wc = wid & 3, fr = lane & 15, fq = lane >> 4;
    const int nt = K / BK;
    unsigned voffA[2], voffB[2];
#pragma unroll
    for (int i = 0; i < 2; ++i) { int R, C; stage_rc(tid * 16 + i * 8192, R, C); const int Rb = Epi::PERM ? ((R & ~31) + perm32(R & 31)) : R;
        voffA[i] = (unsigned)(R * K + C) * 2u; voffB[i] = (unsigned)(Rb * K + C) * 2u; }
    const size_t kstep = (size_t)(BK * 2);
    const size_t hstep = (size_t)HALF * K * 2;
    const unsigned ldsw = (unsigned)wid * 1024u;
    const int aoff = lds_byte(wr * 64 + fr, fq * 8), boff = lds_byte(wc * 32 + fr, fq * 8);
#define PG8_SA(b, h) (((b) * 2 + (h)) * HTB)
#define PG8_SB(b, h) ((4 + (b) * 2 + (h)) * HTB)
#define PG8_STAGE(bufoff, gbase, voff) do { _Pragma("unroll") for (int _i = 0; _i < 2; ++_i) \
        __builtin_amdgcn_global_load_lds((const unsigned*)((const char*)(gbase) + (voff)[_i]), (PG8_LAS unsigned*)(lds + (bufoff) + ldsw + _i * 8192), 16, 0, 0); } while (0)
#define PG8_LDA(dst, b, h) do { _Pragma("unroll") for (int m = 0; m < 4; ++m) _Pragma("unroll") for (int k = 0; k < 2; ++k) dst[m][k] = *(const PG8_LAS bf16x8*)(lds + PG8_SA(b, h) + aoff + m * 2048 + k * 1024); } while (0)
#define PG8_LDB(dst, b, h) do { _Pragma("unroll") for (int n = 0; n < 2; ++n) _Pragma("unroll") for (int k = 0; k < 2; ++k) dst[n][k] = *(const PG8_LAS bf16x8*)(lds + PG8_SB(b, h) + boff + n * 2048 + k * 1024); } while (0)
#define PG8_MMA(ai, bj, At, Bt) do { __builtin_amdgcn_s_setprio(1); _Pragma("unroll") for (int m = 0; m < 4; ++m) _Pragma("unroll") for (int n = 0; n < 2; ++n) _Pragma("unroll") for (int k = 0; k < 2; ++k) \
        acc[ai][bj][m][n] = __builtin_amdgcn_mfma_f32_16x16x32_bf16(Bt[n][k], At[m][k], acc[ai][bj][m][n], 0, 0, 0); __builtin_amdgcn_s_setprio(0); } while (0)
#define PG8_WAIT_V(n) asm volatile("s_waitcnt vmcnt(" #n ")" ::: "memory")
#define PG8_WAIT_L(n) asm volatile("s_waitcnt lgkmcnt(" #n ")" ::: "memory")
#define PG8_BAR __builtin_amdgcn_s_barrier()
#define PG8_SCHED __builtin_amdgcn_sched_barrier(0)
    Unit cur, nxt; int ui = 0;
    if (!S.next(0, cur)) return;
    f32x4 acc[2][2][4][2];
#pragma unroll
    for (int a = 0; a < 2; ++a)
#pragma unroll
        for (int b = 0; b < 2; ++b)
#pragma unroll
            for (int m = 0; m < 4; ++m)
#pragma unroll
                for (int n = 0; n < 2; ++n) acc[a][b][m][n] = (f32x4){0.f, 0.f, 0.f, 0.f};
    bf16x8 At[4][2], B0[2][2], B1[2][2];
    const char* cA = cur.A; const char* cB = cur.B;
    if constexpr (SP2) {
        PG8_STAGE(PG8_SB(0, 0), cB, voffB); PG8_STAGE(PG8_SB(0, 1), cB + hstep, voffB); PG8_STAGE(PG8_SA(0, 0), cA, voffA); PG8_STAGE(PG8_SA(0, 1), cA + hstep, voffA);
        if (wr == 1) PG8_BAR;
        PG8_WAIT_V(2); PG8_BAR;
        PG8_STAGE(PG8_SB(1, 0), cB + kstep, voffB); PG8_STAGE(PG8_SA(1, 0), cA + kstep, voffA); PG8_STAGE(PG8_SB(1, 1), cB + hstep + kstep, voffB);
        PG8_WAIT_V(6); PG8_BAR;
    } else {
        PG8_STAGE(PG8_SB(0, 0), cB, voffB); PG8_STAGE(PG8_SA(0, 0), cA, voffA); PG8_STAGE(PG8_SB(0, 1), cB + hstep, voffB); PG8_STAGE(PG8_SA(0, 1), cA + hstep, voffA);
        if (wr == 1) PG8_BAR;
        PG8_WAIT_V(4); PG8_BAR;
        PG8_STAGE(PG8_SB(1, 0), cB + kstep, voffB); PG8_STAGE(PG8_SA(1, 0), cA + kstep, voffA); PG8_STAGE(PG8_SB(1, 1), cB + hstep + kstep, voffB);
        PG8_WAIT_V(6); PG8_BAR;
    }
    for (;;) {
        const bool has_next = S.next(ui + 1, nxt);
        const char* nA = has_next ? nxt.A : cA; const char* nB = has_next ? nxt.B : cB;
        for (int t = 0; t < nt; t += 2) {
            const bool last = (t == nt - 2);
            const char* a1 = cA + (size_t)(t + 1) * kstep;
            const char* a2 = last ? nA : cA + (size_t)(t + 2) * kstep; const char* b2 = last ? nB : cB + (size_t)(t + 2) * kstep;
            const char* a3 = a2 + kstep; const char* b3 = b2 + kstep;
            if constexpr (SP2) {
            PG8_LDB(B0, 0, 0); PG8_LDB(B1, 0, 1); PG8_SCHED; PG8_LDA(At, 0, 0); PG8_STAGE(PG8_SA(1, 1), a1 + hstep, voffA);
            PG8_WAIT_V(8); PG8_WAIT_L(0); PG8_BAR; PG8_MMA(0, 0, At, B0); PG8_MMA(0, 1, At, B1); PG8_BAR; PG8_SCHED;
            PG8_LDA(At, 0, 1); PG8_STAGE(PG8_SB(0, 0), b2, voffB); PG8_STAGE(PG8_SB(0, 1), b2 + hstep, voffB); PG8_STAGE(PG8_SA(0, 0), a2, voffA);
            PG8_WAIT_V(8); PG8_WAIT_L(0); PG8_BAR; PG8_MMA(1, 0, At, B0); PG8_MMA(1, 1, At, B1); PG8_BAR; PG8_SCHED;
            PG8_LDB(B0, 1, 0); PG8_LDB(B1, 1, 1); PG8_SCHED; PG8_LDA(At, 1, 0); PG8_STAGE(PG8_SA(0, 1), a2 + hstep, voffA);
            PG8_WAIT_V(8); PG8_WAIT_L(0); PG8_BAR; PG8_MMA(0, 0, At, B0); PG8_MMA(0, 1, At, B1); PG8_BAR; PG8_SCHED;
            PG8_LDA(At, 1, 1); PG8_STAGE(PG8_SB(1, 0), b3, voffB); PG8_STAGE(PG8_SB(1, 1), b3 + hstep, voffB); PG8_STAGE(PG8_SA(1, 0), a3, voffA);
            PG8_WAIT_V(8); PG8_WAIT_L(0); PG8_BAR; PG8_MMA(1, 0, At, B0); PG8_MMA(1, 1, At, B1); PG8_BAR; PG8_SCHED;
            } else {
            PG8_LDB(B0, 0, 0); PG8_SCHED; PG8_LDA(At, 0, 0); PG8_STAGE(PG8_SA(1, 1), a1 + hstep, voffA);
            PG8_WAIT_L(8); PG8_BAR; PG8_WAIT_L(0); PG8_MMA(0, 0, At, B0); PG8_BAR; PG8_SCHED;
            PG8_LDB(B1, 0, 1); PG8_STAGE(PG8_SB(0, 0), b2, voffB);
            PG8_BAR; PG8_WAIT_L(0); PG8_MMA(0, 1, At, B1); PG8_BAR;
            PG8_LDA(At, 0, 1); PG8_STAGE(PG8_SA(0, 0), a2, voffA);
            PG8_BAR; PG8_WAIT_L(0); PG8_MMA(1, 0, At, B0); PG8_BAR; PG8_SCHED;
            PG8_STAGE(PG8_SB(0, 1), b2 + hstep, voffB);
            PG8_WAIT_V(6); PG8_BAR; PG8_MMA(1, 1, At, B1); PG8_BAR;
            PG8_LDB(B0, 1, 0); PG8_SCHED; PG8_LDA(At, 1, 0); PG8_STAGE(PG8_SA(0, 1), a2 + hstep, voffA);
            PG8_WAIT_L(8); PG8_BAR; PG8_WAIT_L(0); PG8_MMA(0, 0, At, B0); PG8_BAR; PG8_SCHED;
            PG8_LDB(B1, 1, 1); PG8_STAGE(PG8_SB(1, 0), b3, voffB);
            PG8_BAR; PG8_WAIT_L(0); PG8_MMA(0, 1, At, B1); PG8_BAR;
            PG8_LDA(At, 1, 1); PG8_STAGE(PG8_SA(1, 0), a3, voffA);
            PG8_BAR; PG8_WAIT_L(0); PG8_MMA(1, 0, At, B0); PG8_BAR; PG8_SCHED;
            PG8_STAGE(PG8_SB(1, 1), b3 + hstep, voffB);
            PG8_WAIT_V(6); PG8_BAR; PG8_MMA(1, 1, At, B1); PG8_BAR;
            }
        }
        if constexpr (ALIGN_EPI) { if (wr == 0) PG8_BAR; }
        E(acc, cur, wr, wc, fr, fq);
        if (!has_next) break;
#pragma unroll
        for (int a = 0; a < 2; ++a)
#pragma unroll
            for (int b = 0; b < 2; ++b)
#pragma unroll
                for (int m = 0; m < 4; ++m)
#pragma unroll
                    for (int n = 0; n < 2; ++n) acc[a][b][m][n] = (f32x4){0.f, 0.f, 0.f, 0.f};
        cur = nxt; cA = nA; cB = nB; ++ui;
        if constexpr (ALIGN_EPI) { if (wr == 1) PG8_BAR; }
    }
    PG8_WAIT_V(0);
    if constexpr (!ALIGN_EPI) { if (wr == 0) PG8_BAR; }
    PG8_BAR;
#undef PG8_SA
#undef PG8_SB
#undef PG8_STAGE
#undef PG8_LDA
#undef PG8_LDB
#undef PG8_MMA
#undef PG8_WAIT_V
#undef PG8_WAIT_L
#undef PG8_BAR
#undef PG8_SCHED
}

struct StaticOrder {
    int nM, nN, nwg, G, c; const char* A; const char* Bt; size_t tstep;
    __device__ void init(const void* A_, const void* Bt_, int M_, int N_, int K_, int G_, int c_) { A = (const char*)A_; Bt = (const char*)Bt_; nM = M_ / BM; nN = N_ / BM; nwg = nM * nN; G = G_; c = c_; tstep = (size_t)BM * K_ * 2; }
    __device__ bool next(int i, Unit& u) const {
        const long L = (long)i * G + c; if (L >= nwg) return false;
        int wgid = (int)L; { const int q = nwg / 8, r = nwg % 8, xcd = wgid % 8, off = wgid / 8; wgid = (xcd < r ? xcd * (q + 1) : r * (q + 1) + (xcd - r) * q) + off; }
        const int nig = 8 * nN, gid = wgid / nig, fm = gid * 8, gsz = (nM - fm) < 8 ? (nM - fm) : 8;
        u.pm = fm + ((wgid % nig) % gsz); u.pn = (wgid % nig) / gsz; u.aux = 0;
        u.A = A + (size_t)u.pm * tstep; u.B = Bt + (size_t)u.pn * tstep; return true;
    }
};
struct GroupedOrder {
    int nM, nN, nwg, G, c; const char* A; const char* Bt; size_t tstep, estep; const int* tile_e;
    __device__ void init(const void* A_, const void* Bt_, int ntiles, int N_, int K_, int G_, int c_, const int* te) { A = (const char*)A_; Bt = (const char*)Bt_; nM = ntiles; nN = N_ / BM; nwg = nM * nN; G = G_; c = c_; tstep = (size_t)BM * K_ * 2; estep = (size_t)N_ * K_ * 2; tile_e = te; }
    __device__ bool next(int i, Unit& u) const {
        const long L = (long)i * G + c; if (L >= nwg) return false;
        u.pm = (int)(L / nN); u.pn = (int)(L % nN); u.aux = __builtin_amdgcn_readfirstlane(tile_e[u.pm]);
        u.A = A + (size_t)u.pm * tstep; u.B = Bt + (size_t)u.aux * estep + (size_t)u.pn * tstep; return true;
    }
};

struct EpiBf16 {
    static constexpr bool PERM = true;
    bf16* O; int ldc;
    __device__ __forceinline__ void operator()(const f32x4 (&acc)[2][2][4][2], const Unit& u, int wr, int wc, int fr, int fq) const {
        const int row0 = u.pm * BM + wr * 64 + fr, col0 = u.pn * BM + wc * 32 + 8 * fq;
#pragma unroll
        for (int ai = 0; ai < 2; ++ai)
#pragma unroll
            for (int m = 0; m < 4; ++m) { bf16* rowp = O + (size_t)(row0 + ai * HALF + m * 16) * ldc + col0;
#pragma unroll
                for (int bj = 0; bj < 2; ++bj) { const f32x4 v0 = acc[ai][bj][m][0], v1 = acc[ai][bj][m][1];
                    u32x4 w; w.x = cvt_pk_bf16(v0[0], v0[1]); w.y = cvt_pk_bf16(v0[2], v0[3]); w.z = cvt_pk_bf16(v1[0], v1[1]); w.w = cvt_pk_bf16(v1[2], v1[3]);
                    *(u32x4*)(rowp + bj * HALF) = w; } }
    }
};
struct EpiResid {
    static constexpr bool PERM = false;
    float* X; const float* mod; int gsel;
    __device__ __forceinline__ void operator()(const f32x4 (&acc)[2][2][4][2], const Unit& u, int wr, int wc, int fr, int fq) const {
        const int row0 = u.pm * BM + wr * 64 + fr, col0 = u.pn * BM + wc * 32 + 4 * fq;
        const int r = u.pm < 4 ? 4 : ((u.pm - 4) >> 4);
        const float* g = mod + (size_t)r * 6 * D + gsel * D;
        f32x4 gv[2][2];
#pragma unroll
        for (int bj = 0; bj < 2; ++bj)
#pragma unroll
            for (int n = 0; n < 2; ++n) gv[bj][n] = *(const f32x4*)(g + col0 + bj * HALF + n * 16);
#pragma unroll
        for (int ai = 0; ai < 2; ++ai)
#pragma unroll
            for (int m = 0; m < 4; ++m) { float* rowp = X + (size_t)(row0 + ai * HALF + m * 16) * D + col0;
#pragma unroll
                for (int bj = 0; bj < 2; ++bj)
#pragma unroll
                    for (int n = 0; n < 2; ++n) { f32x4 x = *(f32x4*)(rowp + bj * HALF + n * 16); x += gv[bj][n] * acc[ai][bj][m][n]; *(f32x4*)(rowp + bj * HALF + n * 16) = x; } }
    }
};
struct EpiSwiglu {
    static constexpr bool PERM = false;
    bf16* Hd; int ldh;
    __device__ __forceinline__ void operator()(const f32x4 (&acc)[2][2][4][2], const Unit& u, int wr, int wc, int fr, int fq) const {
        const int row0 = u.pm * BM + wr * 64 + fr, col0 = u.pn * 128 + wc * 16 + 4 * fq;
#pragma unroll
        for (int ai = 0; ai < 2; ++ai)
#pragma unroll
            for (int m = 0; m < 4; ++m) { bf16* rowp = Hd + (size_t)(row0 + ai * HALF + m * 16) * ldh + col0;
#pragma unroll
                for (int bj = 0; bj < 2; ++bj) { const f32x4 a = acc[ai][bj][m][0], b = acc[ai][bj][m][1];
                    float h[4];
#pragma unroll
                    for (int j = 0; j < 4; ++j) h[j] = a[j] / (1.0f + __expf(-a[j])) * b[j];
                    u32x2 w; w.x = cvt_pk_bf16(h[0], h[1]); w.y = cvt_pk_bf16(h[2], h[3]);
                    *(u32x2*)(rowp + bj * 64) = w; } }
    }
};
struct EpiF32 {
    static constexpr bool PERM = false;
    float* C; int ldc;
    __device__ __forceinline__ void operator()(const f32x4 (&acc)[2][2][4][2], const Unit& u, int wr, int wc, int fr, int fq) const {
        const int row0 = u.pm * BM + wr * 64 + fr, col0 = u.pn * BM + wc * 32 + 4 * fq;
#pragma unroll
        for (int ai = 0; ai < 2; ++ai)
#pragma unroll
            for (int m = 0; m < 4; ++m) { float* rowp = C + (size_t)(row0 + ai * HALF + m * 16) * ldc + col0;
#pragma unroll
                for (int bj = 0; bj < 2; ++bj)
#pragma unroll
                    for (int n = 0; n < 2; ++n) *(f32x4*)(rowp + bj * HALF + n * 16) = acc[ai][bj][m][n]; }
    }
};
}

#define XB_TMO      128
#define XB_XCNT(j)  (256  + 64 * (j))
#define XB_XSUB(j)  (1280 + 64 * (j))
#define XB_XGEN(j)  (2304 + 64 * (j))
#define XB_TOP      3328
#define XB_TOPGEN   3392
#define XCD_BAR_WORDS 3456
#define XB_SPIN_CAP (1u << 22)
__device__ __forceinline__ unsigned xb_ld(unsigned* p)              { return __hip_atomic_load(p, __ATOMIC_RELAXED, __HIP_MEMORY_SCOPE_AGENT); }
__device__ __forceinline__ unsigned xb_add(unsigned* p, unsigned v) { return __hip_atomic_fetch_add(p, v, __ATOMIC_RELAXED, __HIP_MEMORY_SCOPE_AGENT); }
__device__ __forceinline__ unsigned xb_xcc_id() { return (unsigned)__builtin_amdgcn_s_getreg((3 << 11) | 20) & 0xFu; }
#define XB_SPIN(cond, bar) do { unsigned _sp = 0; while (cond) { __builtin_amdgcn_s_sleep(1); \
    if ((++_sp & 255u) == 0u) { if (xb_ld(&(bar)[XB_TMO])) break; if (_sp > XB_SPIN_CAP) { atomicAdd(&(bar)[XB_TMO], 1u); break; } } } } while (0)
struct XcdBarrier { unsigned* bar; unsigned x; volatile LAS unsigned* st; };
__device__ __forceinline__ XcdBarrier xcd_barrier_post(unsigned* bar, volatile LAS unsigned* st) {
    XcdBarrier b; b.bar = bar; b.x = xb_xcc_id(); b.st = st;
    if (threadIdx.x == 0) (void)xb_add(&bar[XB_XCNT(b.x)], 1u);
    return b;
}
__device__ __forceinline__ void xcd_barrier_complete(unsigned* bar, unsigned x, unsigned& nloc, unsigned& nx) {
    const unsigned G = gridDim.x * gridDim.y * gridDim.z;
    unsigned sum, cnt, mine, sp = 0u;
    for (;;) {
        sum = 0u; cnt = 0u; mine = 0u;
#pragma unroll
        for (unsigned j = 0; j < 16; ++j) { const unsigned c = xb_ld(&bar[XB_XCNT(j)]); sum += c; cnt += (c > 0u) ? 1u : 0u; mine = (j == x) ? c : mine; }
        if (sum == G) break;
        __builtin_amdgcn_s_sleep(1);
        if ((++sp & 255u) == 0u) { if (xb_ld(&bar[XB_TMO])) break; if (sp > XB_SPIN_CAP) { atomicAdd(&bar[XB_TMO], 1u); break; } }
    }
    nloc = mine > 0u ? mine : 1u; nx = cnt > 0u ? cnt : 1u;
}
__device__ __forceinline__ void xcd_barrier(const XcdBarrier& b) {
    asm volatile("s_waitcnt vmcnt(0)" ::: "memory");
    __syncthreads();
    if (threadIdx.x == 0) {
        unsigned* bar = b.bar;
        __builtin_amdgcn_s_waitcnt(0);
        unsigned nloc = b.st[0], nx = b.st[1];
        if (nloc == 0u) { xcd_barrier_complete(bar, b.x, nloc, nx); b.st[0] = nloc; b.st[1] = nx; }
        const unsigned old = xb_add(&bar[XB_XSUB(b.x)], 1u);
        const unsigned gen = old / nloc;
        if (old + 1u == (gen + 1u) * nloc) {
            __builtin_amdgcn_fence(__ATOMIC_RELEASE, "agent");
            asm volatile("s_waitcnt vmcnt(0)" ::: "memory");
            const unsigned og = xb_add(&bar[XB_TOP], 1u);
            const unsigned tg = og / nx;
            if (og + 1u == (tg + 1u) * nx) xb_add(&bar[XB_TOPGEN], 1u);
            else XB_SPIN(xb_ld(&bar[XB_TOPGEN]) == tg, bar);
            __builtin_amdgcn_fence(__ATOMIC_ACQUIRE, "agent");
            xb_add(&bar[XB_XGEN(b.x)], 1u);
            asm volatile("s_waitcnt vmcnt(0)" ::: "memory");
        } else {
            XB_SPIN(xb_ld(&bar[XB_XGEN(b.x)]) == gen, bar);
            __builtin_amdgcn_fence(__ATOMIC_ACQUIRE, "agent");
            asm volatile("s_waitcnt vmcnt(0)" ::: "memory");
        }
    }
    __syncthreads();
}

constexpr int NWAVES = 8, NTHR = 512;
constexpr int RING_BYTES = 131072, MISC_OFF = RING_BYTES + 320, LDS_BYTES = 147456;

struct Inputs {
    const float *x, *c, *ctx, *c_ctx, *ada_w, *ada_b, *norm1_g, *w_in, *ret_decay, *ret_gn_g, *gdn_conv_w, *gdn_a_log, *gdn_dt_bias, *gdn_norm_g, *swa_sink, *w_out, *norm2_g,
        *ffn_w1, *ffn_w3, *ffn_w2, *router_w, *moe_w1, *moe_w3, *moe_w2, *final_g;
};
struct Args { Inputs in; float* out; unsigned char* ws; int ph_lo, ph_hi; };
static_assert(sizeof(Args) == 25 * 8 + 8 + 8 + 8, "no padding");


__device__ __forceinline__ const float* ld_ptr(const LAS unsigned long long* t, int i) { const unsigned long long v = t[i]; const unsigned lo = __builtin_amdgcn_readfirstlane((unsigned)v), hi = __builtin_amdgcn_readfirstlane((unsigned)(v >> 32)); return (const float*)(((unsigned long long)hi << 32) | lo); }
__device__ __forceinline__ Inputs load_inputs(const LAS unsigned long long* t) {
    Inputs in; const float** ip = (const float**)&in;
#pragma unroll
    for (int i = 0; i < 25; ++i) ip[i] = ld_ptr(t, i);
    return in;
}
struct Frame {
    LAS unsigned char* lds;
    int tid, lane, wave, G, gw, NGW, bid;
    unsigned char* ws;
};

template <class SrcF>
__device__ __forceinline__ void transpose_item(const SrcF& src, int K, bf16* WT, LAS float* scr, int k0, int n0, int lane) {
#pragma unroll 8
    for (int i = 0; i < 32; ++i) { const int kk = 2 * i + (lane >> 5); scr[kk * 33 + (lane & 31)] = src(k0 + kk, n0 + (lane & 31)); }
    LDS_WAIT(); asm volatile("" ::: "memory");
    const int c = lane & 7;
#pragma unroll
    for (int j = 0; j < 4; ++j) { const int n = (lane >> 3) + 8 * j; const LAS float* s = scr + (8 * c) * 33 + n;
        u32x4 o; o.x = pk2(s[0 * 33], s[1 * 33]); o.y = pk2(s[2 * 33], s[3 * 33]); o.z = pk2(s[4 * 33], s[5 * 33]); o.w = pk2(s[6 * 33], s[7 * 33]);
        *(u32x4*)(WT + (size_t)(n0 + n) * K + k0 + 8 * c) = o; }
    LDS_WAIT(); asm volatile("" ::: "memory");
}
struct SrcPlain { const float* W; int ld; __device__ __forceinline__ float operator()(int k, int n) const { return W[(size_t)k * ld + n]; } };
struct SrcWin { const float* W; __device__ __forceinline__ float operator()(int k, int n) const { return W[(size_t)k * INC + (n < 2048 ? n : n + 16)]; } };
struct SrcGU { const float* W1; const float* W3; int ld; __device__ __forceinline__ float operator()(int k, int n) const { const int g = n >> 5, i = n & 31; const ptrdiff_t d = (i < 16) ? (ptrdiff_t)0 : (W3 - W1); return W1[d + (ptrdiff_t)k * ld + 16 * g + (i & 15)]; } };

__device__ __forceinline__ void convert_moe_layer(Frame& F, const Inputs& in, int mi) {
    LAS float* scr = (LAS float*)(F.lds + F.wave * 16384);
    bf16* mw13 = (bf16*)(F.ws + WS_MW13); bf16* mw2 = (bf16*)(F.ws + WS_MW2);
    constexpr int I13 = (D / 64) * (2 * EF / 32), I2 = (EF / 64) * (D / 32);
    for (int it = F.gw; it < NE * (I13 + I2); it += F.NGW) {
        const int e = it / (I13 + I2); int r = it % (I13 + I2);
        const size_t wo = ((size_t)mi * NE + e) * (size_t)D * EF;
        if (r < I13) { const int nblk = 2 * EF / 32; SrcGU s{in.moe_w1 + wo, in.moe_w3 + wo, EF}; transpose_item(s, D, mw13 + (size_t)e * 2 * EF * D, scr, 64 * (r / nblk), 32 * (r % nblk), F.lane); }
        else { r -= I13; const int nblk = D / 32; SrcPlain s{in.moe_w2 + wo, D}; transpose_item(s, EF, mw2 + (size_t)e * D * EF, scr, 64 * (r / nblk), 32 * (r % nblk), F.lane); }
    }
}

__device__ __forceinline__ void phase_prologue(Frame& F, const Inputs& in) {
    LAS float* scr = (LAS float*)(F.lds + F.wave * 16384);
    {
        constexpr int I_IN = (D / 64) * (NP / 32), I_OUT = (D / 64) * (D / 32), I_13 = (D / 64) * (2 * FF / 32), I_2 = (FF / 64) * (D / 32);
        constexpr int PER_L = I_IN + I_OUT, PER_F = I_13 + I_2, TOT = DEPTH * PER_L + 2 * PER_F;
        for (int it = F.gw; it < TOT; it += F.NGW) {
            if (it < DEPTH * PER_L) { const int l = it / PER_L; int r = it % PER_L;
                if (r < I_IN) { const int nblk = NP / 32; SrcWin s{in.w_in + (size_t)l * D * INC}; transpose_item(s, D, (bf16*)(F.ws + WS_WIN) + (size_t)l * NP * D, scr, 64 * (r / nblk), 32 * (r % nblk), F.lane); }
                else { r -= I_IN; const int nblk = D / 32; SrcPlain s{in.w_out + (size_t)l * D * D, D}; transpose_item(s, D, (bf16*)(F.ws + WS_WOUT) + (size_t)l * D * D, scr, 64 * (r / nblk), 32 * (r % nblk), F.lane); }
            } else { const int q = it - DEPTH * PER_L; const int i = q / PER_F; int r = q % PER_F;
                if (r < I_13) { const int nblk = 2 * FF / 32; SrcGU s{in.ffn_w1 + (size_t)i * D * FF, in.ffn_w3 + (size_t)i * D * FF, FF}; transpose_item(s, D, (bf16*)(F.ws + WS_W13) + (size_t)i * 2 * FF * D, scr, 64 * (r / nblk), 32 * (r % nblk), F.lane); }
                else { r -= I_13; const int nblk = D / 32; SrcPlain s{in.ffn_w2 + (size_t)i * FF * D, D}; transpose_item(s, FF, (bf16*)(F.ws + WS_W2) + (size_t)i * D * FF, scr, 64 * (r / nblk), 32 * (r % nblk), F.lane); }
            }
        }
    }
    convert_moe_layer(F, in, 0);
    {
        __syncthreads();
        LAS float* sc = (LAS float*)F.lds;
        LAS float* red = (LAS float*)(F.lds + 32768);
        for (int i = F.tid; i < 5 * D; i += NTHR) { const int r = i / D, k = i % D; const float v = r < 4 ? in.c[r * D + k] : in.c_ctx[k]; sc[i] = siluf(v); }
        __syncthreads();
        float* mod = (float*)(F.ws + WS_MOD);
        for (int u = F.bid; u < DEPTH * 96; u += F.G) {
            const int l = u / 96, n = (u % 96) * 64 + F.lane;
            const float* w = in.ada_w + (size_t)l * D * 6 * D + n;
            float a[5] = {0.f, 0.f, 0.f, 0.f, 0.f};
            for (int k = F.wave * 128; k < F.wave * 128 + 128; ++k) { const float wv = w[(size_t)k * 6 * D];
#pragma unroll
                for (int r = 0; r < 5; ++r) a[r] += sc[r * D + k] * wv; }
#pragma unroll
            for (int r = 0; r < 5; ++r) red[(F.wave * 5 + r) * 64 + F.lane] = a[r];
            __syncthreads();
            if (F.tid < 320) { const int r = F.tid / 64, ln = F.tid % 64; float s = 0.f;
#pragma unroll
                for (int w8 = 0; w8 < 8; ++w8) s += red[(w8 * 5 + r) * 64 + ln];
                const int nn = (u % 96) * 64 + ln;
                mod[((size_t)l * 5 + r) * 6 * D + nn] = s + in.ada_b[(size_t)l * 6 * D + nn]; }
            __syncthreads();
        }
    }
    if (F.bid == 0) { float* rp = (float*)(F.ws + WS_ROPE);
        for (int i = F.tid; i < 64 * 16; i += NTHR) { const int pos = i / 16, fi = i % 16; const double inv = pow(10000.0, -(double)fi / 16.0), ang = (double)pos * inv; rp[2 * i] = (float)cos(ang); rp[2 * i + 1] = (float)sin(ang); } }
}

__device__ __forceinline__ int mod_row(int m) { return m < MC ? 4 : ((m - MC) >> 12); }

template <int MODE>
__device__ __forceinline__ void phase_token(Frame& F, const Inputs& in, int layer, bool first_from_input, bool combine_moe, bool moe_router, float* out) {
    float* XS = (float*)(F.ws + WS_XS);
    bf16* H = (bf16*)(F.ws + WS_H);
    const float* mod = (const float*)(F.ws + WS_MOD) + (size_t)(layer < DEPTH ? layer : DEPTH - 1) * 5 * 6 * D;
    const float* modprev = (const float*)(F.ws + WS_MOD) + (size_t)(layer > 0 ? layer - 1 : 0) * 5 * 6 * D;
    const int* TKE = (const int*)(F.ws + WS_TKE); const float* TKG = (const float*)(F.ws + WS_TKG); const int* TOKROW = (const int*)(F.ws + WS_TOKROW);
    const float* YM = (const float*)(F.ws + WS_YM);
    LAS float* wl = (LAS float*)F.lds;
    if (MODE == 0) { __syncthreads(); const float* w = in.w_in + (size_t)layer * D * INC + 2048; for (int i = F.tid; i < D * 16; i += NTHR) { const int k = i >> 4, c = i & 15, kp = ((k >> 8) * 4 + (k & 3)) * 64 + ((k >> 2) & 63); wl[((c >> 2) * 1024 + kp) * 4 + (c & 3)] = w[(size_t)k * INC + c]; } __syncthreads(); }
    if (MODE == 1 && moe_router) { __syncthreads(); const float* w = in.router_w + (size_t)(layer >> 1) * D * NE; for (int i = F.tid; i < D * NE; i += NTHR) { const int k = i >> 3, c = i & 7, kp = ((k >> 8) * 4 + (k & 3)) * 64 + ((k >> 2) & 63); wl[((c >> 2) * 1024 + kp) * 4 + (c & 3)] = w[i]; } __syncthreads(); }
    const float* gain = MODE == 0 ? in.norm1_g + (size_t)layer * D : (MODE == 1 ? in.norm2_g + (size_t)layer * D : in.final_g);
    const int m_lo = (MODE == 2) ? MC : 0;
    for (int m = m_lo + F.gw; m < M; m += F.NGW) {
        const int r = mod_row(m);
        f32x4 v[4];
        const float* xrow = first_from_input ? (m < MC ? in.ctx + (size_t)m * D : in.x + (size_t)(m - MC) * D) : XS + (size_t)m * D;
#pragma unroll
        for (int j = 0; j < 4; ++j) v[j] = *(const f32x4*)(xrow + 4 * F.lane + 256 * j);
        bool wrote = first_from_input;
        if (combine_moe && !(layer == DEPTH && m < MC)) {
            const int r0 = TOKROW[2 * m], r1 = TOKROW[2 * m + 1]; const float g0 = TKG[2 * m], g1 = TKG[2 * m + 1];
            const float* gt = modprev + (size_t)r * 6 * D + 5 * D;
#pragma unroll
            for (int j = 0; j < 4; ++j) { const f32x4 y0 = *(const f32x4*)(YM + (size_t)r0 * D + 4 * F.lane + 256 * j), y1 = *(const f32x4*)(YM + (size_t)r1 * D + 4 * F.lane + 256 * j);
                const f32x4 gg = *(const f32x4*)(gt + 4 * F.lane + 256 * j); v[j] += gg * (g0 * y0 + g1 * y1); }
            wrote = true;
        }
        if (wrote && MODE != 2) {
#pragma unroll
            for (int j = 0; j < 4; ++j) *(f32x4*)(XS + (size_t)m * D + 4 * F.lane + 256 * j) = v[j];
        }
        float ss = 0.f;
#pragma unroll
        for (int j = 0; j < 4; ++j) ss += (v[j].x * v[j].x + v[j].y * v[j].y) + (v[j].z * v[j].z + v[j].w * v[j].w);
        const float rstd = 1.0f / sqrtf(wave_sum(ss) * (1.0f / D) + EPS);
        if (MODE == 2) {
#pragma unroll
            for (int j = 0; j < 4; ++j) { const f32x4 g = *(const f32x4*)(gain + 4 * F.lane + 256 * j); *(f32x4*)(out + (size_t)(m - MC) * D + 4 * F.lane + 256 * j) = v[j] * rstd * g; }
            continue;
        }
        const float* sh = mod + (size_t)r * 6 * D + (MODE == 0 ? 0 : 3) * D; const float* scl = sh + D;
        f32x4 h[4];
#pragma unroll
        for (int j = 0; j < 4; ++j) { const f32x4 g = *(const f32x4*)(gain + 4 * F.lane + 256 * j), s1 = *(const f32x4*)(scl + 4 * F.lane + 256 * j), s0 = *(const f32x4*)(sh + 4 * F.lane + 256 * j);
            h[j] = v[j] * rstd * g * (1.0f + s1) + s0;
            u32x2 w; w.x = pk2(h[j].x, h[j].y); w.y = pk2(h[j].z, h[j].w); *(u32x2*)(H + (size_t)m * D + 4 * F.lane + 256 * j) = w; }
        if (MODE == 0) {
            float a[16];
#pragma unroll
            for (int c = 0; c < 16; ++c) a[c] = 0.f;
#pragma unroll
            for (int j = 0; j < 4; ++j)
#pragma unroll
                for (int e = 0; e < 4; ++e) { const int kp = (j * 4 + e) * 64 + F.lane; const float hv = h[j][e];
#pragma unroll
                    for (int q = 0; q < 4; ++q) { const f32x4 w = *(const LAS f32x4*)(wl + (q * 1024 + kp) * 4); a[4 * q] += hv * w.x; a[4 * q + 1] += hv * w.y; a[4 * q + 2] += hv * w.z; a[4 * q + 3] += hv * w.w; } }
            float mine = 0.f;
#pragma unroll
            for (int c = 0; c < 16; ++c) { const float s = wave_sum(a[c]); mine = (F.lane == c) ? s : mine; }
            if (F.lane < 16) ((float*)(F.ws + WS_AB))[(size_t)m * 16 + F.lane] = mine;
        }
        if (MODE == 1 && moe_router) {
            float a[8];
#pragma unroll
            for (int c = 0; c < 8; ++c) a[c] = 0.f;
#pragma unroll
            for (int j = 0; j < 4; ++j)
#pragma unroll
                for (int e = 0; e < 4; ++e) { const int kp = (j * 4 + e) * 64 + F.lane; const float hv = h[j][e];
#pragma unroll
                    for (int q = 0; q < 2; ++q) { const f32x4 w = *(const LAS f32x4*)(wl + (q * 1024 + kp) * 4); a[4 * q] += hv * w.x; a[4 * q + 1] += hv * w.y; a[4 * q + 2] += hv * w.z; a[4 * q + 3] += hv * w.w; } }
#pragma unroll
            for (int c = 0; c < 8; ++c) a[c] = wave_sum(a[c]);
            int i0 = 0; float l0 = a[0];
#pragma unroll
            for (int c = 1; c < 8; ++c) if (a[c] > l0) { l0 = a[c]; i0 = c; }
            int i1 = -1; float l1 = -3.0e38f;
#pragma unroll
            for (int c = 0; c < 8; ++c) if (c != i0 && a[c] > l1) { l1 = a[c]; i1 = c; }
            const float e1 = __expf(l1 - l0), g0 = 1.0f / (1.0f + e1), g1 = e1 / (1.0f + e1);
            if (F.lane == 0) { ((int*)(F.ws + WS_TKE))[2 * m] = i0; ((int*)(F.ws + WS_TKE))[2 * m + 1] = i1; ((float*)(F.ws + WS_TKG))[2 * m] = g0; ((float*)(F.ws + WS_TKG))[2 * m + 1] = g1; }
        }
    }
    (void)TKE;
}

__device__ __forceinline__ void phase_prep(Frame& F, const Inputs& in, int layer) {
    const bf16* P = (const bf16*)(F.ws + WS_R1 + R1_P);
    unsigned char* prep = F.ws + WS_R1 + R1_PREP;
    bf16* RQ = (bf16*)(prep + PREP_RQ); bf16* RK = (bf16*)(prep + PREP_RK); bf16* SQ = (bf16*)(prep + PREP_SQ); bf16* SK = (bf16*)(prep + PREP_SK); bf16* GD = (bf16*)(prep + PREP_GD);
    const float* rope = (const float*)(F.ws + WS_ROPE);
    const float* AB = (const float*)(F.ws + WS_AB); float* GB = (float*)(F.ws + WS_GB);
    const float* cw = in.gdn_conv_w + (size_t)layer * 5 * 768;
    const int lane = F.lane;
    for (int m = F.gw; m < M; m += F.NGW) {
        const bool lat = m >= MC; const int t = lat ? ((m - MC) & (TL - 1)) : (m & (TC - 1)); const int Tn = lat ? TL : TC;
        const bf16* prow = P + (size_t)m * NP;
        float cs = 1.f, sn = 0.f;
        if (lat) { const int j = lane & 31; const int pos = j < 16 ? (t >> 6) : (t & 63); const int fi = j & 15; cs = rope[(pos * 16 + fi) * 2]; sn = rope[(pos * 16 + fi) * 2 + 1]; if (lane < 32) sn = -sn; }
#pragma unroll
        for (int hh = 0; hh < 4; ++hh) { const float q = bf2f(prow[PC_RQ + hh * 64 + lane]), k = bf2f(prow[PC_RK + hh * 64 + lane]) * 0.125f;
            const float qp = __shfl_xor(q, 32), kp = __shfl_xor(k, 32);
            RQ[(size_t)m * 256 + hh * 64 + lane] = (bf16)f2bf(q * cs + qp * sn); RK[(size_t)m * 256 + hh * 64 + lane] = (bf16)f2bf(k * cs + kp * sn); }
#pragma unroll
        for (int hq = 0; hq < 8; ++hq) { const float q = bf2f(prow[PC_SQ + hq * 64 + lane]); const float qp = __shfl_xor(q, 32); SQ[(size_t)m * 512 + hq * 64 + lane] = (bf16)f2bf(q * cs + qp * sn); }
#pragma unroll
        for (int g = 0; g < 2; ++g) { const float k = bf2f(prow[PC_SK + g * 64 + lane]); const float kp = __shfl_xor(k, 32); SK[(size_t)m * 128 + g * 64 + lane] = (bf16)f2bf(k * cs + kp * sn); }
#pragma unroll
        for (int s = 0; s < 12; ++s) { const int c = s * 64 + lane; float y = 0.f;
#pragma unroll
            for (int j = 0; j < 5; ++j) { const int tt = t + j - 2; if (tt >= 0 && tt < Tn) y += cw[j * 768 + c] * bf2f(prow[(ptrdiff_t)(j - 2) * NP + PC_GQKV + c]); }
            y = siluf(y);
            if (s < 8) { const float n2 = wave_sum(y * y); y = y * (1.0f / sqrtf(n2 + EPS)); if (s < 4) y *= 0.125f; }
            GD[(size_t)m * 768 + c] = (bf16)f2bf(y); }
        if (lane < 16) { const int dh = lane & 7; const float a = AB[(size_t)m * 16 + lane];
            float o;
            if (lane < 8) { const float xx = a + in.gdn_dt_bias[layer * 8 + dh]; const float sp = fmaxf(xx, 0.f) + log1pf(__expf(-fabsf(xx))); o = -__expf(in.gdn_a_log[layer * 8 + dh]) * sp; }
            else o = 1.0f / (1.0f + __expf(-a));
            GB[(size_t)m * 16 + lane] = o; }
    }
}

__device__ __forceinline__ int scan_row(int b, int dir, int tau) {
    if (tau < TC) { const int c = dir ? TC - 1 - tau : tau; return b * TC + c; }
    const int tt = tau - TC; const int t = dir ? TL - 1 - tt : tt; return MC + b * TL + t;
}
__device__ __forceinline__ void phase_scans(Frame& F, const Inputs& in, int layer) {
    if (F.wave != 0 || F.bid >= 64) return;
    const int id = F.bid; const bool gdn = id >= 32; const int sid = id & 31; const int b = sid >> 3, hh = (sid >> 1) & 3, dir = sid & 1;
    const bf16* P = (const bf16*)(F.ws + WS_R1 + R1_P);
    unsigned char* prep = F.ws + WS_R1 + R1_PREP;
    const bf16* RQ = (const bf16*)(prep + PREP_RQ); const bf16* RK = (const bf16*)(prep + PREP_RK); const bf16* GD = (const bf16*)(prep + PREP_GD);
    const float* GB = (const float*)(F.ws + WS_GB);
    float* OUT = (float*)(F.ws + WS_R1 + (gdn ? R1_OG : R1_OR)) + (size_t)dir * M * 256;
    LAS float* lk = (LAS float*)F.lds; LAS float* lq = lk + 64 * 64; LAS float* lg = lq + 64 * 64;
    const int lane = F.lane;
    float S[64];
#pragma unroll
    for (int i = 0; i < 64; ++i) S[i] = 0.f;
    const float gamma = gdn ? 0.f : __expf(-__expf(in.ret_decay[layer * 8 + dir * 4 + hh]));
    for (int t0 = 0; t0 < TC + TL; t0 += 64) {
        for (int i = 0; i < 64; ++i) { const int m = scan_row(b, dir, t0 + i);
            if (gdn) { lq[i * 64 + lane] = bf2f(GD[(size_t)m * 768 + hh * 64 + lane]); lk[i * 64 + lane] = bf2f(GD[(size_t)m * 768 + 256 + hh * 64 + lane]); if (lane < 2) lg[i * 2 + lane] = GB[(size_t)m * 16 + lane * 8 + dir * 4 + hh]; }
            else { lq[i * 64 + lane] = bf2f(RQ[(size_t)m * 256 + hh * 64 + lane]); lk[i * 64 + lane] = bf2f(RK[(size_t)m * 256 + hh * 64 + lane]); } }
        LDS_WAIT(); asm volatile("" ::: "memory");
        for (int i = 0; i < 64; ++i) { const int m = scan_row(b, dir, t0 + i);
            float o = 0.f;
            if (gdn) {
                const float v = bf2f(GD[(size_t)m * 768 + 512 + hh * 64 + lane]); const float a = __expf(lg[i * 2]), beta = lg[i * 2 + 1];
                float ks = 0.f;
#pragma unroll
                for (int d4 = 0; d4 < 16; ++d4) { const f32x4 kv = *(const LAS f32x4*)(lk + i * 64 + 4 * d4); ks += kv.x * S[4 * d4] + kv.y * S[4 * d4 + 1] + kv.z * S[4 * d4 + 2] + kv.w * S[4 * d4 + 3]; }
                const float vn = beta * (v - a * ks);
#pragma unroll
                for (int d4 = 0; d4 < 16; ++d4) { const f32x4 kv = *(const LAS f32x4*)(lk + i * 64 + 4 * d4), qv = *(const LAS f32x4*)(lq + i * 64 + 4 * d4);
                    S[4 * d4] = a * S[4 * d4] + kv.x * vn; S[4 * d4 + 1] = a * S[4 * d4 + 1] + kv.y * vn; S[4 * d4 + 2] = a * S[4 * d4 + 2] + kv.z * vn; S[4 * d4 + 3] = a * S[4 * d4 + 3] + kv.w * vn;
                    o += qv.x * S[4 * d4] + qv.y * S[4 * d4 + 1] + qv.z * S[4 * d4 + 2] + qv.w * S[4 * d4 + 3]; }
            } else {
                const float v = bf2f(P[(size_t)m * NP + PC_RV + hh * 64 + lane]);
#pragma unroll
                for (int d4 = 0; d4 < 16; ++d4) { const f32x4 kv = *(const LAS f32x4*)(lk + i * 64 + 4 * d4), qv = *(const LAS f32x4*)(lq + i * 64 + 4 * d4);
                    S[4 * d4] = gamma * S[4 * d4] + kv.x * v; S[4 * d4 + 1] = gamma * S[4 * d4 + 1] + kv.y * v; S[4 * d4 + 2] = gamma * S[4 * d4 + 2] + kv.z * v; S[4 * d4 + 3] = gamma * S[4 * d4 + 3] + kv.w * v;
                    o += qv.x * S[4 * d4] + qv.y * S[4 * d4 + 1] + qv.z * S[4 * d4 + 2] + qv.w * S[4 * d4 + 3]; }
            }
            OUT[(size_t)m * 256 + hh * 64 + lane] = o;
        }
        LDS_WAIT(); asm volatile("" ::: "memory");
    }
}

__device__ __forceinline__ void phase_swa(Frame& F, const Inputs& in, int layer) {
    const bf16* P = (const bf16*)(F.ws + WS_R1 + R1_P);
    unsigned char* prep = F.ws + WS_R1 + R1_PREP;
    const bf16* SQ = (const bf16*)(prep + PREP_SQ); const bf16* SK = (const bf16*)(prep + PREP_SK);
    bf16* O = (bf16*)(F.ws + WS_R1 + R1_O);
    const int NT = F.G * NTHR;
    for (int idx = F.bid * NTHR + F.tid; idx < M * 8; idx += NT) {
        const int hq = idx / M, m = idx % M, g = hq >> 2;
        const bool lat = m >= MC; const int b = lat ? ((m - MC) >> 12) : (m >> 8); const int t = lat ? ((m - MC) & (TL - 1)) : (m & (TC - 1));
        float q[64], o[64];
#pragma unroll
        for (int i = 0; i < 8; ++i) { const u32x4 w = *(const u32x4*)(SQ + (size_t)m * 512 + hq * 64 + 8 * i);
#pragma unroll
            for (int e = 0; e < 4; ++e) { q[8 * i + 2 * e] = __uint_as_float(w[e] << 16) * 0.125f; q[8 * i + 2 * e + 1] = __uint_as_float(w[e] & 0xffff0000u) * 0.125f; } }
#pragma unroll
        for (int i = 0; i < 64; ++i) o[i] = 0.f;
        float mx = in.swa_sink[layer * 8 + hq], l = 1.0f;
        const int nloc = lat ? 257 : 0;
        for (int kk = 0; kk < nloc + TC; ++kk) {
            int row;
            if (kk < nloc) { const int s = t - 128 + kk; if (s < 0 || s >= TL) continue; row = MC + b * TL + s; }
            else row = b * TC + (kk - nloc);
            float sc = 0.f;
#pragma unroll
            for (int i = 0; i < 8; ++i) { const u32x4 w = *(const u32x4*)(SK + (size_t)row * 128 + g * 64 + 8 * i);
#pragma unroll
                for (int e = 0; e < 4; ++e) sc += q[8 * i + 2 * e] * __uint_as_float(w[e] << 16) + q[8 * i + 2 * e + 1] * __uint_as_float(w[e] & 0xffff0000u); }
            const float mn = fmaxf(mx, sc), corr = __expf(mx - mn), p = __expf(sc - mn);
            l = l * corr + p; mx = mn;
#pragma unroll
            for (int i = 0; i < 8; ++i) { const u32x4 w = *(const u32x4*)(P + (size_t)row * NP + PC_SV + g * 64 + 8 * i);
#pragma unroll
                for (int e = 0; e < 4; ++e) { o[8 * i + 2 * e] = o[8 * i + 2 * e] * corr + p * __uint_as_float(w[e] << 16); o[8 * i + 2 * e + 1] = o[8 * i + 2 * e + 1] * corr + p * __uint_as_float(w[e] & 0xffff0000u); } }
        }
        const float il = 1.0f / l;
#pragma unroll
        for (int i = 0; i < 8; ++i) { u32x4 w;
#pragma unroll
            for (int e = 0; e < 4; ++e) w[e] = pk2(o[8 * i + 2 * e] * il, o[8 * i + 2 * e + 1] * il);
            *(u32x4*)(O + (size_t)m * D + 512 + hq * 64 + 8 * i) = w; }
    }
}

__device__ __forceinline__ void phase_finish(Frame& F, const Inputs& in, int layer) {
    const bf16* P = (const bf16*)(F.ws + WS_R1 + R1_P);
    const float* OR = (const float*)(F.ws + WS_R1 + R1_OR); const float* OG = (const float*)(F.ws + WS_R1 + R1_OG);
    bf16* O = (bf16*)(F.ws + WS_R1 + R1_O);
    const int lane = F.lane;
    for (int m = F.gw; m < M; m += F.NGW) {
#pragma unroll
        for (int hh = 0; hh < 4; ++hh) {
            const float o = OR[(size_t)m * 256 + hh * 64 + lane] + OR[(size_t)(M + m) * 256 + hh * 64 + lane];
            const float mu = wave_sum(o) * (1.0f / 64.0f); const float dlt = o - mu; const float var = wave_sum(dlt * dlt) * (1.0f / 64.0f);
            const float g = bf2f(P[(size_t)m * NP + PC_RG + hh * 64 + lane]);
            const float y = dlt * (1.0f / sqrtf(var + EPS)) * in.ret_gn_g[layer * 256 + hh * 64 + lane] * siluf(g);
            O[(size_t)m * D + hh * 64 + lane] = (bf16)f2bf(y);
            const float o2 = OG[(size_t)m * 256 + hh * 64 + lane] + OG[(size_t)(M + m) * 256 + hh * 64 + lane];
            const float ms = wave_sum(o2 * o2) * (1.0f / 64.0f);
            const float z = bf2f(P[(size_t)m * NP + PC_GZ + hh * 64 + lane]);
            const float y2 = o2 * (1.0f / sqrtf(ms + EPS)) * in.gdn_norm_g[layer * 64 + lane] * siluf(z);
            O[(size_t)m * D + 256 + hh * 64 + lane] = (bf16)f2bf(y2);
        }
    }
}

__device__ __forceinline__ void phase_route(Frame& F, int m_lo) {
    if (F.bid != 0) return;
    const int* TKE = (const int*)(F.ws + WS_TKE);
    int* TOKROW = (int*)(F.ws + WS_TOKROW); int* ROWTOK = (int*)(F.ws + WS_ROWTOK); int* TILEE = (int*)(F.ws + WS_TILEE);
    LAS int* cnt = (LAS int*)F.lds;
    LAS int* tot = cnt + 512 * 8;
    const int ntok = M - m_lo, per = (ntok + NTHR - 1) / NTHR;
    const int a0 = m_lo + F.tid * per, a1 = (a0 + per < M) ? a0 + per : M;
    int c[8];
#pragma unroll
    for (int e = 0; e < 8; ++e) c[e] = 0;
    for (int m = a0; m < a1; ++m) { const int e0 = TKE[2 * m], e1 = TKE[2 * m + 1];
#pragma unroll
        for (int e = 0; e < 8; ++e) c[e] += (e0 == e) + (e1 == e); }
#pragma unroll
    for (int e = 0; e < 8; ++e) cnt[F.tid * 8 + e] = c[e];
    __syncthreads();
    if (F.tid < 8) { int run = 0; for (int i = 0; i < NTHR; ++i) { const int v = cnt[i * 8 + F.tid]; cnt[i * 8 + F.tid] = run; run += v; } tot[F.tid] = run; }
    __syncthreads();
    if (F.tid == 0) { int st = 0; for (int e = 0; e < 8; ++e) { tot[8 + e] = st; const int pad = (tot[e] + 255) / 256 * 256;
            for (int tl = st / 256; tl < (st + pad) / 256; ++tl) TILEE[tl] = e; st += pad; }
        TILEE[256] = st / 256; }
    __syncthreads();
    int pos[8];
#pragma unroll
    for (int e = 0; e < 8; ++e) pos[e] = tot[8 + e] + cnt[F.tid * 8 + e];
    for (int m = a0; m < a1; ++m) {
#pragma unroll
        for (int k = 0; k < 2; ++k) { const int ee = TKE[2 * m + k]; int row = 0;
#pragma unroll
            for (int e = 0; e < 8; ++e) if (ee == e) { row = pos[e]; pos[e] = row + 1; }
            ROWTOK[row] = m; TOKROW[2 * m + k] = row; } }
    for (int e = 0; e < 8; ++e) { const int st = tot[8 + e] + tot[e], en = tot[8 + e] + (tot[e] + 255) / 256 * 256; for (int r = st + F.tid; r < en; r += NTHR) ROWTOK[r] = -1; }
}
__device__ __forceinline__ void phase_permute(Frame& F) {
    const int* ROWTOK = (const int*)(F.ws + WS_ROWTOK); const int nrows = ((const int*)(F.ws + WS_TILEE))[256] * 256;
    const bf16* H = (const bf16*)(F.ws + WS_H); bf16* HP = (bf16*)(F.ws + WS_HP);
    for (int r = F.gw; r < nrows; r += F.NGW) { const int tok = ROWTOK[r];
#pragma unroll
        for (int j = 0; j < 2; ++j) { u32x4 v = (u32x4){0u, 0u, 0u, 0u}; if (tok >= 0) v = *(const u32x4*)(H + (size_t)tok * D + 8 * F.lane + 512 * j); *(u32x4*)(HP + (size_t)r * D + 8 * F.lane + 512 * j) = v; } }
}

constexpr int NPH = 12;
constexpr int PH_TOTAL = 1 + DEPTH * NPH + 1;
__host__ __device__ inline bool phase_exists(int ph) {
    if (ph == 0 || ph == PH_TOTAL - 1) return true;
    const int layer = (ph - 1) / NPH, j = (ph - 1) % NPH;
    if (!(layer & 1) && j >= 10) return false;
    return true;
}
__global__ void __launch_bounds__(NTHR, 2) fwd_kernel(Args args) {
    extern __shared__ __attribute__((aligned(16))) unsigned char lds_raw[];
    Frame F;
    F.lds = (LAS unsigned char*)lds_raw;
    F.tid = threadIdx.x; F.lane = F.tid & 63; F.wave = __builtin_amdgcn_readfirstlane(F.tid >> 6);
    F.G = gridDim.x; F.bid = blockIdx.x; F.gw = blockIdx.x * NWAVES + F.wave; F.NGW = F.G * NWAVES; F.ws = args.ws;
    volatile LAS unsigned* MISC = (volatile LAS unsigned*)(F.lds + MISC_OFF);
    LAS unsigned long long* ptab = (LAS unsigned long long*)(F.lds + MISC_OFF + 128);
    if (F.tid < 32) MISC[F.tid] = 0u;
    if (F.tid == 64) { const Inputs& ai = args.in;
        ptab[0] = (unsigned long long)ai.x; ptab[1] = (unsigned long long)ai.c; ptab[2] = (unsigned long long)ai.ctx; ptab[3] = (unsigned long long)ai.c_ctx; ptab[4] = (unsigned long long)ai.ada_w; ptab[5] = (unsigned long long)ai.ada_b;
        ptab[6] = (unsigned long long)ai.norm1_g; ptab[7] = (unsigned long long)ai.w_in; ptab[8] = (unsigned long long)ai.ret_decay; ptab[9] = (unsigned long long)ai.ret_gn_g; ptab[10] = (unsigned long long)ai.gdn_conv_w; ptab[11] = (unsigned long long)ai.gdn_a_log;
        ptab[12] = (unsigned long long)ai.gdn_dt_bias; ptab[13] = (unsigned long long)ai.gdn_norm_g; ptab[14] = (unsigned long long)ai.swa_sink; ptab[15] = (unsigned long long)ai.w_out; ptab[16] = (unsigned long long)ai.norm2_g; ptab[17] = (unsigned long long)ai.ffn_w1;
        ptab[18] = (unsigned long long)ai.ffn_w3; ptab[19] = (unsigned long long)ai.ffn_w2; ptab[20] = (unsigned long long)ai.router_w; ptab[21] = (unsigned long long)ai.moe_w1; ptab[22] = (unsigned long long)ai.moe_w3; ptab[23] = (unsigned long long)ai.moe_w2; ptab[24] = (unsigned long long)ai.final_g; }
    __syncthreads();
    XcdBarrier bar; bar.bar = (unsigned*)(F.ws + WS_CTL) + CW_BAR; bar.x = 0; bar.st = nullptr;
    const int lo = args.ph_lo, hi = args.ph_hi;
    const bool multi = (hi - lo) > 1;
    if (multi) bar = xcd_barrier_post((unsigned*)(F.ws + WS_CTL) + CW_BAR, MISC + 8);
#define LAUNDER() unsigned char* _w = args.ws; asm volatile("" : "+s"(_w)); F.ws = _w; asm volatile("" ::: "memory"); { int _t = threadIdx.x; asm volatile("" : "+v"(_t)); int _b = blockIdx.x; asm volatile("" : "+s"(_b)); F.tid = _t; F.lane = _t & 63; F.wave = __builtin_amdgcn_readfirstlane(_t >> 6); F.bid = _b; F.gw = _b * NWAVES + F.wave; } const Inputs in = load_inputs(ptab)
#define IN(k) (lo <= (k) && (k) < hi)
#define SEAM(k) do { if (IN(k) && IN((k) + 1)) xcd_barrier(bar); } while (0)
    LAS unsigned char* ring = F.lds;

    if (IN(0)) { LAUNDER(); phase_prologue(F, in); } SEAM(0);

    for (int layer = 0; layer < DEPTH; ++layer) {
        const int p0 = 1 + layer * NPH;
        const bool moe = layer & 1;
        if (IN(p0 + 0)) { LAUNDER(); phase_token<0>(F, in, layer, layer == 0, layer > 0 && ((layer - 1) & 1), false, nullptr); if (layer == 2) convert_moe_layer(F, in, 1); }
        SEAM(p0 + 0);
        if (IN(p0 + 1)) { LAUNDER(); pg8::StaticOrder S; S.init(F.ws + WS_H, (bf16*)(F.ws + WS_WIN) + (size_t)layer * NP * D, M, NP, D, F.G, F.bid);
            pg8::EpiBf16 E{(bf16*)(F.ws + WS_R1 + R1_P), NP}; pg8::gemm_phase<pg8::EpiBf16, pg8::StaticOrder>(ring, D, S, E, F.tid); }
        SEAM(p0 + 1);
        if (IN(p0 + 2)) { LAUNDER(); phase_prep(F, in, layer); }
        SEAM(p0 + 2);
        if (IN(p0 + 3)) { LAUNDER(); phase_scans(F, in, layer); }
        SEAM(p0 + 3);
        if (IN(p0 + 4)) { LAUNDER(); phase_swa(F, in, layer); }
        SEAM(p0 + 4);
        if (IN(p0 + 5)) { LAUNDER(); phase_finish(F, in, layer); }
        SEAM(p0 + 5);
        if (IN(p0 + 6)) { LAUNDER(); pg8::StaticOrder S; S.init(F.ws + WS_R1 + R1_O, (bf16*)(F.ws + WS_WOUT) + (size_t)layer * D * D, M, D, D, F.G, F.bid);
            pg8::EpiResid E{(float*)(F.ws + WS_XS), (const float*)(F.ws + WS_MOD) + (size_t)layer * 5 * 6 * D, 2}; pg8::gemm_phase<pg8::EpiResid, pg8::StaticOrder>(ring, D, S, E, F.tid); }
        SEAM(p0 + 6);
        if (IN(p0 + 7)) { LAUNDER(); phase_token<1>(F, in, layer, false, false, moe, nullptr); }
        SEAM(p0 + 7);
        if (!moe) {
            if (IN(p0 + 8)) { LAUNDER(); pg8::StaticOrder S; S.init(F.ws + WS_H, (bf16*)(F.ws + WS_W13) + (size_t)(layer >> 1) * 2 * FF * D, M, 2 * FF, D, F.G, F.bid);
                pg8::EpiSwiglu E{(bf16*)(F.ws + WS_R1 + R1_HID), FF}; pg8::gemm_phase<pg8::EpiSwiglu, pg8::StaticOrder>(ring, D, S, E, F.tid); }
            SEAM(p0 + 8);
            if (IN(p0 + 9)) { LAUNDER(); pg8::StaticOrder S; S.init(F.ws + WS_R1 + R1_HID, (bf16*)(F.ws + WS_W2) + (size_t)(layer >> 1) * D * FF, M, D, FF, F.G, F.bid);
                pg8::EpiResid E{(float*)(F.ws + WS_XS), (const float*)(F.ws + WS_MOD) + (size_t)layer * 5 * 6 * D, 5}; pg8::gemm_phase<pg8::EpiResid, pg8::StaticOrder>(ring, FF, S, E, F.tid); }
            if (IN(p0 + 9) && IN(p0 + NPH)) xcd_barrier(bar);
        } else {
            if (IN(p0 + 8)) { LAUNDER(); phase_route(F, layer == DEPTH - 1 ? MC : 0); }
            SEAM(p0 + 8);
            if (IN(p0 + 9)) { LAUNDER(); phase_permute(F); }
            SEAM(p0 + 9);
            if (IN(p0 + 10)) { LAUNDER(); const int* tile_e = (const int*)(F.ws + WS_TILEE); const int ntiles = __builtin_amdgcn_readfirstlane(tile_e[256]);
                pg8::GroupedOrder S; S.init(F.ws + WS_HP, F.ws + WS_MW13, ntiles, 2 * EF, D, F.G, F.bid, tile_e);
                pg8::EpiSwiglu E{(bf16*)(F.ws + WS_R1 + R1_HID), EF}; pg8::gemm_phase<pg8::EpiSwiglu, pg8::GroupedOrder>(ring, D, S, E, F.tid); }
            SEAM(p0 + 10);
            if (IN(p0 + 11)) { LAUNDER(); const int* tile_e = (const int*)(F.ws + WS_TILEE); const int ntiles = __builtin_amdgcn_readfirstlane(tile_e[256]);
                pg8::GroupedOrder S; S.init(F.ws + WS_R1 + R1_HID, F.ws + WS_MW2, ntiles, D, EF, F.G, F.bid, tile_e);
                pg8::EpiF32 E{(float*)(F.ws + WS_YM), D}; pg8::gemm_phase<pg8::EpiF32, pg8::GroupedOrder>(ring, EF, S, E, F.tid); }
            SEAM(p0 + 11);
        }
    }
    if (IN(PH_TOTAL - 1)) { LAUNDER(); phase_token<2>(F, in, DEPTH, false, true, false, args.out); }
#undef IN
#undef SEAM
}

extern "C" void kernel_launch(void* const* d_in, const int* in_sizes, int n_in, void* d_out, int out_size, void* d_ws, size_t ws_size, hipStream_t stream) {
    static int grid = 0;
    if (grid == 0) {
        if (n_in != 25 || out_size != ML * D || ws_size < WS_END) { fprintf(stderr, "kernel_launch: unexpected problem: n_in %d out %d ws %zu (need %zu)\n", n_in, out_size, ws_size, (size_t)WS_END); grid = -1; return; }
        int dev = 0, cus = 0, per_cu = 0;
        if (hipGetDevice(&dev) != hipSuccess || hipDeviceGetAttribute(&cus, hipDeviceAttributeMultiprocessorCount, dev) != hipSuccess) { grid = -1; return; }
        if (hipFuncSetAttribute((const void*)fwd_kernel, hipFuncAttributeMaxDynamicSharedMemorySize, LDS_BYTES) != hipSuccess) { fprintf(stderr, "kernel_launch: hipFuncSetAttribute failed\n"); grid = -1; return; }
        if (hipOccupancyMaxActiveBlocksPerMultiprocessor(&per_cu, (const void*)fwd_kernel, NTHR, LDS_BYTES) != hipSuccess || per_cu < 1) fprintf(stderr, "kernel_launch: occupancy query reports %d\n", per_cu);
        (void)hipGetLastError();
        grid = cus;
    }
    if (grid < 0) return;
    (void)hipMemsetAsync((char*)d_ws + WS_CTL, 0, CTL_ZERO_BYTES, stream);
    Args a{};
    const float** ip = (const float**)&a.in;
    for (int i = 0; i < 25; ++i) ip[i] = (const float*)d_in[i];
    a.out = (float*)d_out; a.ws = (unsigned char*)d_ws;
#if MK_ONE_LAUNCH
    a.ph_lo = 0; a.ph_hi = PH_TOTAL;
    hipLaunchKernelGGL(fwd_kernel, dim3(grid), dim3(NTHR), LDS_BYTES, stream, a);
#else
    for (int ph = 0; ph < PH_TOTAL; ++ph) { if (!phase_exists(ph)) continue; a.ph_lo = ph; a.ph_hi = ph + 1;
        hipLaunchKernelGGL(fwd_kernel, dim3(grid), dim3(NTHR), LDS_BYTES, stream, a); }
#endif
}
```

```cpp
#include <hip/hip_runtime.h>
#include <cstdio>
#include <cstdint>

#ifndef MK_ONE_LAUNCH
#define MK_ONE_LAUNCH 1
#endif

#define GAS __attribute__((address_space(1)))
#define LAS __attribute__((address_space(3)))
typedef unsigned short bf16;
typedef short bf16x8 __attribute__((ext_vector_type(8)));
typedef float f32x4 __attribute__((ext_vector_type(4)));
typedef float f32x2 __attribute__((ext_vector_type(2)));
typedef unsigned u32x4 __attribute__((ext_vector_type(4)));
typedef unsigned u32x2 __attribute__((ext_vector_type(2)));

constexpr int D = 1024, NB = 4, TL = 4096, TC = 256, DEPTH = 4;
constexpr int MC = NB * TC, ML = NB * TL, M = MC + ML;
constexpr int INC = 2832, NP = 2816;
constexpr int FF = 2816, EF = 3584, NE = 8;
constexpr int MAXROWS = 36864;
constexpr float EPS = 1e-6f;
constexpr int PC_RQ = 0, PC_RK = 256, PC_RV = 512, PC_RG = 768, PC_GQKV = 1024, PC_GZ = 1792, PC_SQ = 2048, PC_SK = 2560, PC_SV = 2688;

constexpr size_t MiB = 1u << 20;
constexpr size_t WS_CTL = 0, CTL_ZERO_BYTES = 1 * MiB;
constexpr size_t WS_MOD = 1 * MiB;
constexpr size_t WS_ROPE = 2 * MiB;
constexpr size_t WS_TKE = 3 * MiB, WS_TKG = 3 * MiB + 256 * 1024, WS_TOKROW = 3 * MiB + 512 * 1024, WS_ROWTOK = 3 * MiB + 768 * 1024, WS_TILEE = 4 * MiB;
constexpr size_t WS_AB = 5 * MiB, WS_GB = 7 * MiB;
constexpr size_t WS_WIN = 16 * MiB, WS_WOUT = 38 * MiB, WS_W13 = 46 * MiB, WS_W2 = 68 * MiB, WS_MW13 = 80 * MiB, WS_MW2 = 192 * MiB;
constexpr size_t WS_XS = 248 * MiB, WS_H = 316 * MiB, WS_HP = 350 * MiB, WS_YM = 422 * MiB, WS_R1 = 566 * MiB;
constexpr size_t R1_P = 0, R1_PREP = 94 * MiB, R1_O = 158 * MiB, R1_OR = 192 * MiB, R1_OG = 226 * MiB, R1_HID = 0;
constexpr size_t WS_END = WS_R1 + 260 * MiB;
constexpr size_t PREP_RQ = 0, PREP_RK = (size_t)M * 256 * 2, PREP_SQ = (size_t)M * 512 * 2, PREP_SK = (size_t)M * 1024 * 2, PREP_GD = (size_t)M * 1152 * 2;
static_assert(PREP_GD + (size_t)M * 768 * 2 <= 64 * MiB, "prep");
static_assert((size_t)M * NP * 2 <= 94 * MiB && (size_t)MAXROWS * EF * 2 <= 260 * MiB, "r1");

constexpr int CW_TMO = 0, CW_BAR = 4096;

__device__ __forceinline__ float bf2f(bf16 v) { return __uint_as_float(((unsigned)v) << 16); }
__device__ __forceinline__ unsigned f2bf(float f) { unsigned u = __float_as_uint(f); return (u + 0x7fffu + ((u >> 16) & 1u)) >> 16; }
__device__ __forceinline__ unsigned pk2(float lo, float hi) { return f2bf(lo) | (f2bf(hi) << 16); }
__device__ __forceinline__ float wave_sum(float v) {
#pragma unroll
    for (int o = 1; o < 64; o <<= 1) v += __shfl_xor(v, o);
    return v;
}
__device__ __forceinline__ float siluf(float x) { return x / (1.0f + __expf(-x)); }
#define LDS_WAIT() asm volatile("s_waitcnt lgkmcnt(0)" ::: "memory")

namespace pg8 {
#define PG8_LAS __attribute__((address_space(3)))
constexpr int BM = 256, BK = 64, HALF = 128, HTB = HALF * BK * 2, STAGE_BYTES = 8 * HTB;
__host__ __device__ __forceinline__ int lds_byte(int r, int c) { const int st = (r >> 4) * 2 + (c >> 5), rr = r & 15, cc = c & 31, ob = rr * 64 + cc * 2; return st * 1024 + (ob ^ (((ob >> 9) & 1) << 5)); }
__host__ __device__ __forceinline__ void stage_rc(int b, int& R, int& C) { const int st = b / 1024, sb = b % 1024, swz = sb ^ (((sb >> 9) & 1) << 5); R = (st >> 1) * 16 + swz / 64; C = (st & 1) * 32 + (swz % 64) / 2; }
__host__ __device__ __forceinline__ int perm32(int rho) { const int n = rho >> 4, i = rho & 15; return 8 * (i >> 2) + 4 * n + (i & 3); }
struct Unit { int pm, pn, aux; const char* A; const char* B; };
__device__ __forceinline__ unsigned cvt_pk_bf16(float lo, float hi) { unsigned r; asm volatile("v_cvt_pk_bf16_f32 %0, %1, %2" : "=v"(r) : "v"(lo), "v"(hi)); return r; }

template <class Epi, class Sched, bool ALIGN_EPI = true, bool SP2 = true>
__device__ __forceinline__ void gemm_phase(PG8_LAS unsigned char* lds, const int K, const Sched& S, const Epi& E, const int tid) {
    const int wid = __builtin_amdgcn_readfirstlane(tid >> 6), lane = tid & 63, wr = wid >> 2, wc = wid & 3, fr = lane & 15, fq = lane >> 4;
    const int nt = K / BK;
    unsigned voffA[2], voffB[2];
#pragma unroll
    for (int i = 0; i < 2; ++i) { int R, C; stage_rc(tid * 16 + i * 8192, R, C); const int Rb = Epi::PERM ? ((R & ~31) + perm32(R & 31)) : R;
        voffA[i] = (unsigned)(R * K + C) * 2u; voffB[i] = (unsigned)(Rb * K + C) * 2u; }
    const size_t kstep = (size_t)(BK * 2);
    const size_t hstep = (size_t)HALF * K * 2;
    const unsigned ldsw = (unsigned)wid * 1024u;
    const int aoff = lds_byte(wr * 64 + fr, fq * 8), boff = lds_byte(wc * 32 + fr, fq * 8);
#define PG8_SA(b, h) (((b) * 2 + (h)) * HTB)
#define PG8_SB(b, h) ((4 + (b) * 2 + (h)) * HTB)
#define PG8_STAGE(bufoff, gbase, voff) do { _Pragma("unroll") for (int _i = 0; _i < 2; ++_i) \
        __builtin_amdgcn_global_load_lds((const unsigned*)((const char*)(gbase) + (voff)[_i]), (PG8_LAS unsigned*)(lds + (bufoff) + ldsw + _i * 8192), 16, 0, 0); } while (0)
#define PG8_LDA(dst, b, h) do { _Pragma("unroll") for (int m = 0; m < 4; ++m) _Pragma("unroll") for (int k = 0; k < 2; ++k) dst[m][k] = *(const PG8_LAS bf16x8*)(lds + PG8_SA(b, h) + aoff + m * 2048 + k * 1024); } while (0)
#define PG8_LDB(dst, b, h) do { _Pragma("unroll") for (int n = 0; n < 2; ++n) _Pragma("unroll") for (int k = 0; k < 2; ++k) dst[n][k] = *(const PG8_LAS bf16x8*)(lds + PG8_SB(b, h) + boff + n * 2048 + k * 1024); } while (0)
#define PG8_MMA(ai, bj, At, Bt) do { __builtin_amdgcn_s_setprio(1); _Pragma("unroll") for (int m = 0; m < 4; ++m) _Pragma("unroll") for (int n = 0; n < 2; ++n) _Pragma("unroll") for (int k = 0; k < 2; ++k) \
        acc[ai][bj][m][n] = __builtin_amdgcn_mfma_f32_16x16x32_bf16(Bt[n][k], At[m][k], acc[ai][bj][m][n], 0, 0, 0); __builtin_amdgcn_s_setprio(0); } while (0)
#define PG8_WAIT_V(n) asm volatile("s_waitcnt vmcnt(" #n ")" ::: "memory")
#define PG8_WAIT_L(n) asm volatile("s_waitcnt lgkmcnt(" #n ")" ::: "memory")
#define PG8_BAR __builtin_amdgcn_s_barrier()
#define PG8_SCHED __builtin_amdgcn_sched_barrier(0)
    Unit cur, nxt; int ui = 0;
    if (!S.next(0, cur)) return;
    f32x4 acc[2][2][4][2];
#pragma unroll
    for (int a = 0; a < 2; ++a)
#pragma unroll
        for (int b = 0; b < 2; ++b)
#pragma unroll
            for (int m = 0; m < 4; ++m)
#pragma unroll
                for (int n = 0; n < 2; ++n) acc[a][b][m][n] = (f32x4){0.f, 0.f, 0.f, 0.f};
    bf16x8 At[4][2], B0[2][2], B1[2][2];
    const char* cA = cur.A; const char* cB = cur.B;
    if constexpr (SP2) {
        PG8_STAGE(PG8_SB(0, 0), cB, voffB); PG8_STAGE(PG8_SB(0, 1), cB + hstep, voffB); PG8_STAGE(PG8_SA(0, 0), cA, voffA); PG8_STAGE(PG8_SA(0, 1), cA + hstep, voffA);
        if (wr == 1) PG8_BAR;
        PG8_WAIT_V(2); PG8_BAR;
        PG8_STAGE(PG8_SB(1, 0), cB + kstep, voffB); PG8_STAGE(PG8_SA(1, 0), cA + kstep, voffA); PG8_STAGE(PG8_SB(1, 1), cB + hstep + kstep, voffB);
        PG8_WAIT_V(6); PG8_BAR;
    } else {
        PG8_STAGE(PG8_SB(0, 0), cB, voffB); PG8_STAGE(PG8_SA(0, 0), cA, voffA); PG8_STAGE(PG8_SB(0, 1), cB + hstep, voffB); PG8_STAGE(PG8_SA(0, 1), cA + hstep, voffA);
        if (wr == 1) PG8_BAR;
        PG8_WAIT_V(4); PG8_BAR;
        PG8_STAGE(PG8_SB(1, 0), cB + kstep, voffB); PG8_STAGE(PG8_SA(1, 0), cA + kstep, voffA); PG8_STAGE(PG8_SB(1, 1), cB + hstep + kstep, voffB);
        PG8_WAIT_V(6); PG8_BAR;
    }
    for (;;) {
        const bool has_next = S.next(ui + 1, nxt);
        const char* nA = has_next ? nxt.A : cA; const char* nB = has_next ? nxt.B : cB;
        for (int t = 0; t < nt; t += 2) {
            const bool last = (t == nt - 2);
            const char* a1 = cA + (size_t)(t + 1) * kstep;
            const char* a2 = last ? nA : cA + (size_t)(t + 2) * kstep; const char* b2 = last ? nB : cB + (size_t)(t + 2) * kstep;
            const char* a3 = a2 + kstep; const char* b3 = b2 + kstep;
            if constexpr (SP2) {
            PG8_LDB(B0, 0, 0); PG8_LDB(B1, 0, 1); PG8_SCHED; PG8_LDA(At, 0, 0); PG8_STAGE(PG8_SA(1, 1), a1 + hstep, voffA);
            PG8_WAIT_V(8); PG8_WAIT_L(0); PG8_BAR; PG8_MMA(0, 0, At, B0); PG8_MMA(0, 1, At, B1); PG8_BAR; PG8_SCHED;
            PG8_LDA(At, 0, 1); PG8_STAGE(PG8_SB(0, 0), b2, voffB); PG8_STAGE(PG8_SB(0, 1), b2 + hstep, voffB); PG8_STAGE(PG8_SA(0, 0), a2, voffA);
            PG8_WAIT_V(8); PG8_WAIT_L(0); PG8_BAR; PG8_MMA(1, 0, At, B0); PG8_MMA(1, 1, At, B1); PG8_BAR; PG8_SCHED;
            PG8_LDB(B0, 1, 0); PG8_LDB(B1, 1, 1); PG8_SCHED; PG8_LDA(At, 1, 0); PG8_STAGE(PG8_SA(0, 1), a2 + hstep, voffA);
            PG8_WAIT_V(8); PG8_WAIT_L(0); PG8_BAR; PG8_MMA(0, 0, At, B0); PG8_MMA(0, 1, At, B1); PG8_BAR; PG8_SCHED;
            PG8_LDA(At, 1, 1); PG8_STAGE(PG8_SB(1, 0), b3, voffB); PG8_STAGE(PG8_SB(1, 1), b3 + hstep, voffB); PG8_STAGE(PG8_SA(1, 0), a3, voffA);
            PG8_WAIT_V(8); PG8_WAIT_L(0); PG8_BAR; PG8_MMA(1, 0, At, B0); PG8_MMA(1, 1, At, B1); PG8_BAR; PG8_SCHED;
            } else {
            PG8_LDB(B0, 0, 0); PG8_SCHED; PG8_LDA(At, 0, 0); PG8_STAGE(PG8_SA(1, 1), a1 + hstep, voffA);
            PG8_WAIT_L(8); PG8_BAR; PG8_WAIT_L(0); PG8_MMA(0, 0, At, B0); PG8_BAR; PG8_SCHED;
            PG8_LDB(B1, 0, 1); PG8_STAGE(PG8_SB(0, 0), b2, voffB);
            PG8_BAR; PG8_WAIT_L(0); PG8_MMA(0, 1, At, B1); PG8_BAR;
            PG8_LDA(At, 0, 1); PG8_STAGE(PG8_SA(0, 0), a2, voffA);
            PG8_BAR; PG8_WAIT_L(0); PG8_MMA(1, 0, At, B0); PG8_BAR; PG8_SCHED;
            PG8_STAGE(PG8_SB(0, 1), b2 + hstep, voffB);
            PG8_WAIT_V(6); PG8_BAR; PG8_MMA(1, 1, At, B1); PG8_BAR;
            PG8_LDB(B0, 1, 0); PG8_SCHED; PG8_LDA(At, 1, 0); PG8_STAGE(PG8_SA(0, 1), a2 + hstep, voffA);
            PG8_WAIT_L(8); PG8_BAR; PG8_WAIT_L(0); PG8_MMA(0, 0, At, B0); PG8_BAR; PG8_SCHED;
            PG8_LDB(B1, 1, 1); PG8_STAGE(PG8_SB(1, 0), b3, voffB);
            PG8_BAR; PG8_WAIT_L(0); PG8_MMA(0, 1, At, B1); PG8_BAR;
            PG8_LDA(At, 1, 1); PG8_STAGE(PG8_SA(1, 0), a3, voffA);
            PG8_BAR; PG8_WAIT_L(0); PG8_MMA(1, 0, At, B0); PG8_BAR; PG8_SCHED;
            PG8_STAGE(PG8_SB(1, 1), b3 + hstep, voffB);
            PG8_WAIT_V(6); PG8_BAR; PG8_MMA(1, 1, At, B1); PG8_BAR;
            }
        }
        if constexpr (ALIGN_EPI) { if (wr == 0) PG8_BAR; }
        E(acc, cur, wr, wc, fr, fq);
        if (!has_next) break;
#pragma unroll
        for (int a = 0; a < 2; ++a)
#pragma unroll
            for (int b = 0; b < 2; ++b)
#pragma unroll
                for (int m = 0; m < 4; ++m)
#pragma unroll
                    for (int n = 0; n < 2; ++n) acc[a][b][m][n] = (f32x4){0.f, 0.f, 0.f, 0.f};
        cur = nxt; cA = nA; cB = nB; ++ui;
        if constexpr (ALIGN_EPI) { if (wr == 1) PG8_BAR; }
    }
    PG8_WAIT_V(0);
    if constexpr (!ALIGN_EPI) { if (wr == 0) PG8_BAR; }
    PG8_BAR;
#undef PG8_SA
#undef PG8_SB
#undef PG8_STAGE
#undef PG8_LDA
#undef PG8_LDB
#undef PG8_MMA
#undef PG8_WAIT_V
#undef PG8_WAIT_L
#undef PG8_BAR
#undef PG8_SCHED
}

struct StaticOrder {
    int nM, nN, nwg, G, c; const char* A; const char* Bt; size_t tstep;
    __device__ void init(const void* A_, const void* Bt_, int M_, int N_, int K_, int G_, int c_) { A = (const char*)A_; Bt = (const char*)Bt_; nM = M_ / BM; nN = N_ / BM; nwg = nM * nN; G = G_; c = c_; tstep = (size_t)BM * K_ * 2; }
    __device__ bool next(int i, Unit& u) const {
        const long L = (long)i * G + c; if (L >= nwg) return false;
        int wgid = (int)L; { const int q = nwg / 8, r = nwg % 8, xcd = wgid % 8, off = wgid / 8; wgid = (xcd < r ? xcd * (q + 1) : r * (q + 1) + (xcd - r) * q) + off; }
        const int nig = 8 * nN, gid = wgid / nig, fm = gid * 8, gsz = (nM - fm) < 8 ? (nM - fm) : 8;
        u.pm = fm + ((wgid % nig) % gsz); u.pn = (wgid % nig) / gsz; u.aux = 0;
        u.A = A + (size_t)u.pm * tstep; u.B = Bt + (size_t)u.pn * tstep; return true;
    }
};
struct GroupedOrder {
    int nM, nN, nwg, G, c; const char* A; const char* Bt; size_t tstep, estep; const int* tile_e;
    __device__ void init(const void* A_, const void* Bt_, int ntiles, int N_, int K_, int G_, int c_, const int* te) { A = (const char*)A_; Bt = (const char*)Bt_; nM = ntiles; nN = N_ / BM; nwg = nM * nN; G = G_; c = c_; tstep = (size_t)BM * K_ * 2; estep = (size_t)N_ * K_ * 2; tile_e = te; }
    __device__ bool next(int i, Unit& u) const {
        const long L = (long)i * G + c; if (L >= nwg) return false;
        u.pm = (int)(L / nN); u.pn = (int)(L % nN); u.aux = __builtin_amdgcn_readfirstlane(tile_e[u.pm]);
        u.A = A + (size_t)u.pm * tstep; u.B = Bt + (size_t)u.aux * estep + (size_t)u.pn * tstep; return true;
    }
};

struct EpiBf16 {
    static constexpr bool PERM = true;
    bf16* O; int ldc;
    __device__ __forceinline__ void operator()(const f32x4 (&acc)[2][2][4][2], const Unit& u, int wr, int wc, int fr, int fq) const {
        const int row0 = u.pm * BM + wr * 64 + fr, col0 = u.pn * BM + wc * 32 + 8 * fq;
#pragma unroll
        for (int ai = 0; ai < 2; ++ai)
#pragma unroll
            for (int m = 0; m < 4; ++m) { bf16* rowp = O + (size_t)(row0 + ai * HALF + m * 16) * ldc + col0;
#pragma unroll
                for (int bj = 0; bj < 2; ++bj) { const f32x4 v0 = acc[ai][bj][m][0], v1 = acc[ai][bj][m][1];
                    u32x4 w; w.x = cvt_pk_bf16(v0[0], v0[1]); w.y = cvt_pk_bf16(v0[2], v0[3]); w.z = cvt_pk_bf16(v1[0], v1[1]); w.w = cvt_pk_bf16(v1[2], v1[3]);
                    *(u32x4*)(rowp + bj * HALF) = w; } }
    }
};
struct EpiResid {
    static constexpr bool PERM = false;
    float* X; const float* mod; int gsel;
    __device__ __forceinline__ void operator()(const f32x4 (&acc)[2][2][4][2], const Unit& u, int wr, int wc, int fr, int fq) const {
        const int row0 = u.pm * BM + wr * 64 + fr, col0 = u.pn * BM + wc * 32 + 4 * fq;
        const int r = u.pm < 4 ? 4 : ((u.pm - 4) >> 4);
        const float* g = mod + (size_t)r * 6 * D + gsel * D;
        f32x4 gv[2][2];
#pragma unroll
        for (int bj = 0; bj < 2; ++bj)
#pragma unroll
            for (int n = 0; n < 2; ++n) gv[bj][n] = *(const f32x4*)(g + col0 + bj * HALF + n * 16);
#pragma unroll
        for (int ai = 0; ai < 2; ++ai)
#pragma unroll
            for (int m = 0; m < 4; ++m) { float* rowp = X + (size_t)(row0 + ai * HALF + m * 16) * D + col0;
#pragma unroll
                for (int bj = 0; bj < 2; ++bj)
#pragma unroll
                    for (int n = 0; n < 2; ++n) { f32x4 x = *(f32x4*)(rowp + bj * HALF + n * 16); x += gv[bj][n] * acc[ai][bj][m][n]; *(f32x4*)(rowp + bj * HALF + n * 16) = x; } }
    }
};
struct EpiSwiglu {
    static constexpr bool PERM = false;
    bf16* Hd; int ldh;
    __device__ __forceinline__ void operator()(const f32x4 (&acc)[2][2][4][2], const Unit& u, int wr, int wc, int fr, int fq) const {
        const int row0 = u.pm * BM + wr * 64 + fr, col0 = u.pn * 128 + wc * 16 + 4 * fq;
#pragma unroll
        for (int ai = 0; ai < 2; ++ai)
#pragma unroll
            for (int m = 0; m < 4; ++m) { bf16* rowp = Hd + (size_t)(row0 + ai * HALF + m * 16) * ldh + col0;
#pragma unroll
                for (int bj = 0; bj < 2; ++bj) { const f32x4 a = acc[ai][bj][m][0], b = acc[ai][bj][m][1];
                    float h[4];
#pragma unroll
                    for (int j = 0; j < 4; ++j) h[j] = a[j] / (1.0f + __expf(-a[j])) * b[j];
                    u32x2 w; w.x = cvt_pk_bf16(h[0], h[1]); w.y = cvt_pk_bf16(h[2], h[3]);
                    *(u32x2*)(rowp + bj * 64) = w; } }
    }
};
struct EpiF32 {
    static constexpr bool PERM = false;
    float* C; int ldc;
    __device__ __forceinline__ void operator()(const f32x4 (&acc)[2][2][4][2], const Unit& u, int wr, int wc, int fr, int fq) const {
        const int row0 = u.pm * BM + wr * 64 + fr, col0 = u.pn * BM + wc * 32 + 4 * fq;
#pragma unroll
        for (int ai = 0; ai < 2; ++ai)
#pragma unroll
            for (int m = 0; m < 4; ++m) { float* rowp = C + (size_t)(row0 + ai * HALF + m * 16) * ldc + col0;
#pragma unroll
                for (int bj = 0; bj < 2; ++bj)
#pragma unroll
                    for (int n = 0; n < 2; ++n) *(f32x4*)(rowp + bj * HALF + n * 16) = acc[ai][bj][m][n]; }
    }
};
}

#define XB_TMO      128
#define XB_XCNT(j)  (256  + 64 * (j))
#define XB_XSUB(j)  (1280 + 64 * (j))
#define XB_XGEN(j)  (2304 + 64 * (j))
#define XB_TOP      3328
#define XB_TOPGEN   3392
#define XCD_BAR_WORDS 3456
#define XB_SPIN_CAP (1u << 22)
__device__ __forceinline__ unsigned xb_ld(unsigned* p)              { return __hip_atomic_load(p, __ATOMIC_RELAXED, __HIP_MEMORY_SCOPE_AGENT); }
__device__ __forceinline__ unsigned xb_add(unsigned* p, unsigned v) { return __hip_atomic_fetch_add(p, v, __ATOMIC_RELAXED, __HIP_MEMORY_SCOPE_AGENT); }
__device__ __forceinline__ unsigned xb_xcc_id() { return (unsigned)__builtin_amdgcn_s_getreg((3 << 11) | 20) & 0xFu; }
#define XB_SPIN(cond, bar) do { unsigned _sp = 0; while (cond) { __builtin_amdgcn_s_sleep(1); \
    if ((++_sp & 255u) == 0u) { if (xb_ld(&(bar)[XB_TMO])) break; if (_sp > XB_SPIN_CAP) { atomicAdd(&(bar)[XB_TMO], 1u); break; } } } } while (0)
struct XcdBarrier { unsigned* bar; unsigned x; volatile LAS unsigned* st; };
__device__ __forceinline__ XcdBarrier xcd_barrier_post(unsigned* bar, volatile LAS unsigned* st) {
    XcdBarrier b; b.bar = bar; b.x = xb_xcc_id(); b.st = st;
    if (threadIdx.x == 0) (void)xb_add(&bar[XB_XCNT(b.x)], 1u);
    return b;
}
__device__ __forceinline__ void xcd_barrier_complete(unsigned* bar, unsigned x, unsigned& nloc, unsigned& nx) {
    const unsigned G = gridDim.x * gridDim.y * gridDim.z;
    unsigned sum, cnt, mine, sp = 0u;
    for (;;) {
        sum = 0u; cnt = 0u; mine = 0u;
#pragma unroll
        for (unsigned j = 0; j < 16; ++j) { const unsigned c = xb_ld(&bar[XB_XCNT(j)]); sum += c; cnt += (c > 0u) ? 1u : 0u; mine = (j == x) ? c : mine; }
        if (sum == G) break;
        __builtin_amdgcn_s_sleep(1);
        if ((++sp & 255u) == 0u) { if (xb_ld(&bar[XB_TMO])) break; if (sp > XB_SPIN_CAP) { atomicAdd(&bar[XB_TMO], 1u); break; } }
    }
    nloc = mine > 0u ? mine : 1u; nx = cnt > 0u ? cnt : 1u;
}
__device__ __forceinline__ void xcd_barrier(const XcdBarrier& b) {
    asm volatile("s_waitcnt vmcnt(0)" ::: "memory");
    __syncthreads();
    if (threadIdx.x == 0) {
        unsigned* bar = b.bar;
        __builtin_amdgcn_s_waitcnt(0);
        unsigned nloc = b.st[0], nx = b.st[1];
        if (nloc == 0u) { xcd_barrier_complete(bar, b.x, nloc, nx); b.st[0] = nloc; b.st[1] = nx; }
        const unsigned old = xb_add(&bar[XB_XSUB(b.x)], 1u);
        const unsigned gen = old / nloc;
        if (old + 1u == (gen + 1u) * nloc) {
            __builtin_amdgcn_fence(__ATOMIC_RELEASE, "agent");
            asm volatile("s_waitcnt vmcnt(0)" ::: "memory");
            const unsigned og = xb_add(&bar[XB_TOP], 1u);
            const unsigned tg = og / nx;
            if (og + 1u == (tg + 1u) * nx) xb_add(&bar[XB_TOPGEN], 1u);
            else XB_SPIN(xb_ld(&bar[XB_TOPGEN]) == tg, bar);
            __builtin_amdgcn_fence(__ATOMIC_ACQUIRE, "agent");
            xb_add(&bar[XB_XGEN(b.x)], 1u);
            asm volatile("s_waitcnt vmcnt(0)" ::: "memory");
        } else {
            XB_SPIN(xb_ld(&bar[XB_XGEN(b.x)]) == gen, bar);
            __builtin_amdgcn_fence(__ATOMIC_ACQUIRE, "agent");
            asm volatile("s_waitcnt vmcnt(0)" ::: "memory");
        }
    }
    __syncthreads();
}

constexpr int NWAVES = 8, NTHR = 512;
constexpr int RING_BYTES = 131072, MISC_OFF = RING_BYTES + 320, LDS_BYTES = 147456;

struct Inputs {
    const float *x, *c, *ctx, *c_ctx, *ada_w, *ada_b, *norm1_g, *w_in, *ret_decay, *ret_gn_g, *gdn_conv_w, *gdn_a_log, *gdn_dt_bias, *gdn_norm_g, *swa_sink, *w_out, *norm2_g,
        *ffn_w1, *ffn_w3, *ffn_w2, *router_w, *moe_w1, *moe_w3, *moe_w2, *final_g;
};
struct Args { Inputs in; float* out; unsigned char* ws; int ph_lo, ph_hi; };
static_assert(sizeof(Args) == 25 * 8 + 8 + 8 + 8, "no padding");


__device__ __forceinline__ const float* ld_ptr(const LAS unsigned long long* t, int i) { const unsigned long long v = t[i]; const unsigned lo = __builtin_amdgcn_readfirstlane((unsigned)v), hi = __builtin_amdgcn_readfirstlane((unsigned)(v >> 32)); return (const float*)(((unsigned long long)hi << 32) | lo); }
__device__ __forceinline__ Inputs load_inputs(const LAS unsigned long long* t) {
    Inputs in; const float** ip = (const float**)&in;
#pragma unroll
    for (int i = 0; i < 25; ++i) ip[i] = ld_ptr(t, i);
    return in;
}
struct Frame {
    LAS unsigned char* lds;
    int tid, lane, wave, G, gw, NGW, bid;
    unsigned char* ws;
};

template <class SrcF>
__device__ __forceinline__ void transpose_item(const SrcF& src, int K, bf16* WT, LAS float* scr, int k0, int n0, int lane) {
#pragma unroll 8
    for (int i = 0; i < 32; ++i) { const int kk = 2 * i + (lane >> 5); scr[kk * 33 + (lane & 31)] = src(k0 + kk, n0 + (lane & 31)); }
    LDS_WAIT(); asm volatile("" ::: "memory");
    const int c = lane & 7;
#pragma unroll
    for (int j = 0; j < 4; ++j) { const int n = (lane >> 3) + 8 * j; const LAS float* s = scr + (8 * c) * 33 + n;
        u32x4 o; o.x = pk2(s[0 * 33], s[1 * 33]); o.y = pk2(s[2 * 33], s[3 * 33]); o.z = pk2(s[4 * 33], s[5 * 33]); o.w = pk2(s[6 * 33], s[7 * 33]);
        *(u32x4*)(WT + (size_t)(n0 + n) * K + k0 + 8 * c) = o; }
    LDS_WAIT(); asm volatile("" ::: "memory");
}
struct SrcPlain { const float* W; int ld; __device__ __forceinline__ float operator()(int k, int n) const { return W[(size_t)k * ld + n]; } };
struct SrcWin { const float* W; __device__ __forceinline__ float operator()(int k, int n) const { return W[(size_t)k * INC + (n < 2048 ? n : n + 16)]; } };
struct SrcGU { const float* W1; const float* W3; int ld; __device__ __forceinline__ float operator()(int k, int n) const { const int g = n >> 5, i = n & 31; const ptrdiff_t d = (i < 16) ? (ptrdiff_t)0 : (W3 - W1); return W1[d + (ptrdiff_t)k * ld + 16 * g + (i & 15)]; } };

__device__ __forceinline__ void convert_moe_layer(Frame& F, const Inputs& in, int mi) {
    LAS float* scr = (LAS float*)(F.lds + F.wave * 16384);
    bf16* mw13 = (bf16*)(F.ws + WS_MW13); bf16* mw2 = (bf16*)(F.ws + WS_MW2);
    constexpr int I13 = (D / 64) * (2 * EF / 32), I2 = (EF / 64) * (D / 32);
    for (int it = F.gw; it < NE * (I13 + I2); it += F.NGW) {
        const int e = it / (I13 + I2); int r = it % (I13 + I2);
        const size_t wo = ((size_t)mi * NE + e) * (size_t)D * EF;
        if (r < I13) { const int nblk = 2 * EF / 32; SrcGU s{in.moe_w1 + wo, in.moe_w3 + wo, EF}; transpose_item(s, D, mw13 + (size_t)e * 2 * EF * D, scr, 64 * (r / nblk), 32 * (r % nblk), F.lane); }
        else { r -= I13; const int nblk = D / 32; SrcPlain s{in.moe_w2 + wo, D}; transpose_item(s, EF, mw2 + (size_t)e * D * EF, scr, 64 * (r / nblk), 32 * (r % nblk), F.lane); }
    }
}

__device__ __forceinline__ void phase_prologue(Frame& F, const Inputs& in) {
    LAS float* scr = (LAS float*)(F.lds + F.wave * 16384);
    {
        constexpr int I_IN = (D / 64) * (NP / 32), I_OUT = (D / 64) * (D / 32), I_13 = (D / 64) * (2 * FF / 32), I_2 = (FF / 64) * (D / 32);
        constexpr int PER_L = I_IN + I_OUT, PER_F = I_13 + I_2, TOT = DEPTH * PER_L + 2 * PER_F;
        for (int it = F.gw; it < TOT; it += F.NGW) {
            if (it < DEPTH * PER_L) { const int l = it / PER_L; int r = it % PER_L;
                if (r < I_IN) { const int nblk = NP / 32; SrcWin s{in.w_in + (size_t)l * D * INC}; transpose_item(s, D, (bf16*)(F.ws + WS_WIN) + (size_t)l * NP * D, scr, 64 * (r / nblk), 32 * (r % nblk), F.lane); }
                else { r -= I_IN; const int nblk = D / 32; SrcPlain s{in.w_out + (size_t)l * D * D, D}; transpose_item(s, D, (bf16*)(F.ws + WS_WOUT) + (size_t)l * D * D, scr, 64 * (r / nblk), 32 * (r % nblk), F.lane); }
            } else { const int q = it - DEPTH * PER_L; const int i = q / PER_F; int r = q % PER_F;
                if (r < I_13) { const int nblk = 2 * FF / 32; SrcGU s{in.ffn_w1 + (size_t)i * D * FF, in.ffn_w3 + (size_t)i * D * FF, FF}; transpose_item(s, D, (bf16*)(F.ws + WS_W13) + (size_t)i * 2 * FF * D, scr, 64 * (r / nblk), 32 * (r % nblk), F.lane); }
                else { r -= I_13; const int nblk = D / 32; SrcPlain s{in.ffn_w2 + (size_t)i * FF * D, D}; transpose_item(s, FF, (bf16*)(F.ws + WS_W2) + (size_t)i * D * FF, scr, 64 * (r / nblk), 32 * (r % nblk), F.lane); }
            }
        }
    }
    convert_moe_layer(F, in, 0);
    {
        __syncthreads();
        LAS float* sc = (LAS float*)F.lds;
        LAS float* red = (LAS float*)(F.lds + 32768);
        for (int i = F.tid; i < 5 * D; i += NTHR) { const int r = i / D, k = i % D; const float v = r < 4 ? in.c[r * D + k] : in.c_ctx[k]; sc[i] = siluf(v); }
        __syncthreads();
        float* mod = (float*)(F.ws + WS_MOD);
        for (int u = F.bid; u < DEPTH * 96; u += F.G) {
            const int l = u / 96, n = (u % 96) * 64 + F.lane;
            const float* w = in.ada_w + (size_t)l * D * 6 * D + n;
            float a[5] = {0.f, 0.f, 0.f, 0.f, 0.f};
            for (int k = F.wave * 128; k < F.wave * 128 + 128; ++k) { const float wv = w[(size_t)k * 6 * D];
#pragma unroll
                for (int r = 0; r < 5; ++r) a[r] += sc[r * D + k] * wv; }
#pragma unroll
            for (int r = 0; r < 5; ++r) red[(F.wave * 5 + r) * 64 + F.lane] = a[r];
            __syncthreads();
            if (F.tid < 320) { const int r = F.tid / 64, ln = F.tid % 64; float s = 0.f;
#pragma unroll
                for (int w8 = 0; w8 < 8; ++w8) s += red[(w8 * 5 + r) * 64 + ln];
                const int nn = (u % 96) * 64 + ln;
                mod[((size_t)l * 5 + r) * 6 * D + nn] = s + in.ada_b[(size_t)l * 6 * D + nn]; }
            __syncthreads();
        }
    }
    if (F.bid == 0) { float* rp = (float*)(F.ws + WS_ROPE);
        for (int i = F.tid; i < 64 * 16; i += NTHR) { const int pos = i / 16, fi = i % 16; const double inv = pow(10000.0, -(double)fi / 16.0), ang = (double)pos * inv; rp[2 * i] = (float)cos(ang); rp[2 * i + 1] = (float)sin(ang); } }
}

__device__ __forceinline__ int mod_row(int m) { return m < MC ? 4 : ((m - MC) >> 12); }

template <int MODE>
__device__ __forceinline__ void phase_token(Frame& F, const Inputs& in, int layer, bool first_from_input, bool combine_moe, bool moe_router, float* out) {
    float* XS = (float*)(F.ws + WS_XS);
    bf16* H = (bf16*)(F.ws + WS_H);
    const float* mod = (const float*)(F.ws + WS_MOD) + (size_t)(layer < DEPTH ? layer : DEPTH - 1) * 5 * 6 * D;
    const float* modprev = (const float*)(F.ws + WS_MOD) + (size_t)(layer > 0 ? layer - 1 : 0) * 5 * 6 * D;
    const int* TKE = (const int*)(F.ws + WS_TKE); const float* TKG = (const float*)(F.ws + WS_TKG); const int* TOKROW = (const int*)(F.ws + WS_TOKROW);
    const float* YM = (const float*)(F.ws + WS_YM);
    LAS float* wl = (LAS float*)F.lds;
    if (MODE == 0) { __syncthreads(); const float* w = in.w_in + (size_t)layer * D * INC + 2048; for (int i = F.tid; i < D * 16; i += NTHR) { const int k = i >> 4, c = i & 15, kp = ((k >> 8) * 4 + (k & 3)) * 64 + ((k >> 2) & 63); wl[((c >> 2) * 1024 + kp) * 4 + (c & 3)] = w[(size_t)k * INC + c]; } __syncthreads(); }
    if (MODE == 1 && moe_router) { __syncthreads(); const float* w = in.router_w + (size_t)(layer >> 1) * D * NE; for (int i = F.tid; i < D * NE; i += NTHR) { const int k = i >> 3, c = i & 7, kp = ((k >> 8) * 4 + (k & 3)) * 64 + ((k >> 2) & 63); wl[((c >> 2) * 1024 + kp) * 4 + (c & 3)] = w[i]; } __syncthreads(); }
    const float* gain = MODE == 0 ? in.norm1_g + (size_t)layer * D : (MODE == 1 ? in.norm2_g + (size_t)layer * D : in.final_g);
    const int m_lo = (MODE == 2) ? MC : 0;
    for (int m = m_lo + F.gw; m < M; m += F.NGW) {
        const int r = mod_row(m);
        f32x4 v[4];
        const float* xrow = first_from_input ? (m < MC ? in.ctx + (size_t)m * D : in.x + (size_t)(m - MC) * D) : XS + (size_t)m * D;
#pragma unroll
        for (int j = 0; j < 4; ++j) v[j] = *(const f32x4*)(xrow + 4 * F.lane + 256 * j);
        bool wrote = first_from_input;
        if (combine_moe && !(layer == DEPTH && m < MC)) {
            const int r0 = TOKROW[2 * m], r1 = TOKROW[2 * m + 1]; const float g0 = TKG[2 * m], g1 = TKG[2 * m + 1];
            const float* gt = modprev + (size_t)r * 6 * D + 5 * D;
#pragma unroll
            for (int j = 0; j < 4; ++j) { const f32x4 y0 = *(const f32x4*)(YM + (size_t)r0 * D + 4 * F.lane + 256 * j), y1 = *(const f32x4*)(YM + (size_t)r1 * D + 4 * F.lane + 256 * j);
                const f32x4 gg = *(const f32x4*)(gt + 4 * F.lane + 256 * j); v[j] += gg * (g0 * y0 + g1 * y1); }
            wrote = true;
        }
        if (wrote && MODE != 2) {
#pragma unroll
            for (int j = 0; j < 4; ++j) *(f32x4*)(XS + (size_t)m * D + 4 * F.lane + 256 * j) = v[j];
        }
        float ss = 0.f;
#pragma unroll
        for (int j = 0; j < 4; ++j) ss += (v[j].x * v[j].x + v[j].y * v[j].y) + (v[j].z * v[j].z + v[j].w * v[j].w);
        const float rstd = 1.0f / sqrtf(wave_sum(ss) * (1.0f / D) + EPS);
        if (MODE == 2) {
#pragma unroll
            for (int j = 0; j < 4; ++j) { const f32x4 g = *(const f32x4*)(gain + 4 * F.lane + 256 * j); *(f32x4*)(out + (size_t)(m - MC) * D + 4 * F.lane + 256 * j) = v[j] * rstd * g; }
            continue;
        }
        const float* sh = mod + (size_t)r * 6 * D + (MODE == 0 ? 0 : 3) * D; const float* scl = sh + D;
        f32x4 h[4];
#pragma unroll
        for (int j = 0; j < 4; ++j) { const f32x4 g = *(const f32x4*)(gain + 4 * F.lane + 256 * j), s1 = *(const f32x4*)(scl + 4 * F.lane + 256 * j), s0 = *(const f32x4*)(sh + 4 * F.lane + 256 * j);
            h[j] = v[j] * rstd * g * (1.0f + s1) + s0;
            u32x2 w; w.x = pk2(h[j].x, h[j].y); w.y = pk2(h[j].z, h[j].w); *(u32x2*)(H + (size_t)m * D + 4 * F.lane + 256 * j) = w; }
        if (MODE == 0) {
            float a[16];
#pragma unroll
            for (int c = 0; c < 16; ++c) a[c] = 0.f;
#pragma unroll
            for (int j = 0; j < 4; ++j)
#pragma unroll
                for (int e = 0; e < 4; ++e) { const int kp = (j * 4 + e) * 64 + F.lane; const float hv = h[j][e];
#pragma unroll
                    for (int q = 0; q < 4; ++q) { const f32x4 w = *(const LAS f32x4*)(wl + (q * 1024 + kp) * 4); a[4 * q] += hv * w.x; a[4 * q + 1] += hv * w.y; a[4 * q + 2] += hv * w.z; a[4 * q + 3] += hv * w.w; } }
            float mine = 0.f;
#pragma unroll
            for (int c = 0; c < 16; ++c) { const float s = wave_sum(a[c]); mine = (F.lane == c) ? s : mine; }
            if (F.lane < 16) ((float*)(F.ws + WS_AB))[(size_t)m * 16 + F.lane] = mine;
        }
        if (MODE == 1 && moe_router) {
            float a[8];
#pragma unroll
            for (int c = 0; c < 8; ++c) a[c] = 0.f;
#pragma unroll
            for (int j = 0; j < 4; ++j)
#pragma unroll
                for (int e = 0; e < 4; ++e) { const int kp = (j * 4 + e) * 64 + F.lane; const float hv = h[j][e];
#pragma unroll
                    for (int q = 0; q < 2; ++q) { const f32x4 w = *(const LAS f32x4*)(wl + (q * 1024 + kp) * 4); a[4 * q] += hv * w.x; a[4 * q + 1] += hv * w.y; a[4 * q + 2] += hv * w.z; a[4 * q + 3] += hv * w.w; } }
#pragma unroll
            for (int c = 0; c < 8; ++c) a[c] = wave_sum(a[c]);
            int i0 = 0; float l0 = a[0];
#pragma unroll
            for (int c = 1; c < 8; ++c) if (a[c] > l0) { l0 = a[c]; i0 = c; }
            int i1 = -1; float l1 = -3.0e38f;
#pragma unroll
            for (int c = 0; c < 8; ++c) if (c != i0 && a[c] > l1) { l1 = a[c]; i1 = c; }
            const float e1 = __expf(l1 - l0), g0 = 1.0f / (1.0f + e1), g1 = e1 / (1.0f + e1);
            if (F.lane == 0) { ((int*)(F.ws + WS_TKE))[2 * m] = i0; ((int*)(F.ws + WS_TKE))[2 * m + 1] = i1; ((float*)(F.ws + WS_TKG))[2 * m] = g0; ((float*)(F.ws + WS_TKG))[2 * m + 1] = g1; }
        }
    }
    (void)TKE;
}

__device__ __forceinline__ void phase_prep(Frame& F, const Inputs& in, int layer) {
    const bf16* P = (const bf16*)(F.ws + WS_R1 + R1_P);
    unsigned char* prep = F.ws + WS_R1 + R1_PREP;
    bf16* RQ = (bf16*)(prep + PREP_RQ); bf16* RK = (bf16*)(prep + PREP_RK); bf16* SQ = (bf16*)(prep + PREP_SQ); bf16* SK = (bf16*)(prep + PREP_SK); bf16* GD = (bf16*)(prep + PREP_GD);
    const float* rope = (const float*)(F.ws + WS_ROPE);
    const float* AB = (const float*)(F.ws + WS_AB); float* GB = (float*)(F.ws + WS_GB);
    const float* cw = in.gdn_conv_w + (size_t)layer * 5 * 768;
    const int lane = F.lane;
    for (int m = F.gw; m < M; m += F.NGW) {
        const bool lat = m >= MC; const int t = lat ? ((m - MC) & (TL - 1)) : (m & (TC - 1)); const int Tn = lat ? TL : TC;
        const bf16* prow = P + (size_t)m * NP;
        float cs = 1.f, sn = 0.f;
        if (lat) { const int j = lane & 31; const int pos = j < 16 ? (t >> 6) : (t & 63); const int fi = j & 15; cs = rope[(pos * 16 + fi) * 2]; sn = rope[(pos * 16 + fi) * 2 + 1]; if (lane < 32) sn = -sn; }
#pragma unroll
        for (int hh = 0; hh < 4; ++hh) { const float q = bf2f(prow[PC_RQ + hh * 64 + lane]), k = bf2f(prow[PC_RK + hh * 64 + lane]) * 0.125f;
            const float qp = __shfl_xor(q, 32), kp = __shfl_xor(k, 32);
            RQ[(size_t)m * 256 + hh * 64 + lane] = (bf16)f2bf(q * cs + qp * sn); RK[(size_t)m * 256 + hh * 64 + lane] = (bf16)f2bf(k * cs + kp * sn); }
#pragma unroll
        for (int hq = 0; hq < 8; ++hq) { const float q = bf2f(prow[PC_SQ + hq * 64 + lane]); const float qp = __shfl_xor(q, 32); SQ[(size_t)m * 512 + hq * 64 + lane] = (bf16)f2bf(q * cs + qp * sn); }
#pragma unroll
        for (int g = 0; g < 2; ++g) { const float k = bf2f(prow[PC_SK + g * 64 + lane]); const float kp = __shfl_xor(k, 32); SK[(size_t)m * 128 + g * 64 + lane] = (bf16)f2bf(k * cs + kp * sn); }
#pragma unroll
        for (int s = 0; s < 12; ++s) { const int c = s * 64 + lane; float y = 0.f;
#pragma unroll
            for (int j = 0; j < 5; ++j) { const int tt = t + j - 2; if (tt >= 0 && tt < Tn) y += cw[j * 768 + c] * bf2f(prow[(ptrdiff_t)(j - 2) * NP + PC_GQKV + c]); }
            y = siluf(y);
            if (s < 8) { const float n2 = wave_sum(y * y); y = y * (1.0f / sqrtf(n2 + EPS)); if (s < 4) y *= 0.125f; }
            GD[(size_t)m * 768 + c] = (bf16)f2bf(y); }
        if (lane < 16) { const int dh = lane & 7; const float a = AB[(size_t)m * 16 + lane];
            float o;
            if (lane < 8) { const float xx = a + in.gdn_dt_bias[layer * 8 + dh]; const float sp = fmaxf(xx, 0.f) + log1pf(__expf(-fabsf(xx))); o = -__expf(in.gdn_a_log[layer * 8 + dh]) * sp; }
            else o = 1.0f / (1.0f + __expf(-a));
            GB[(size_t)m * 16 + lane] = o; }
    }
}

__device__ __forceinline__ int scan_row(int b, int dir, int tau) {
    if (tau < TC) { const int c = dir ? TC - 1 - tau : tau; return b * TC + c; }
    const int tt = tau - TC; const int t = dir ? TL - 1 - tt : tt; return MC + b * TL + t;
}
__device__ __forceinline__ void phase_scans(Frame& F, const Inputs& in, int layer) {
    if (F.wave != 0 || F.bid >= 64) return;
    const int id = F.bid; const bool gdn = id >= 32; const int sid = id & 31; const int b = sid >> 3, hh = (sid >> 1) & 3, dir = sid & 1;
    const bf16* P = (const bf16*)(F.ws + WS_R1 + R1_P);
    unsigned char* prep = F.ws + WS_R1 + R1_PREP;
    const bf16* RQ = (const bf16*)(prep + PREP_RQ); const bf16* RK = (const bf16*)(prep + PREP_RK); const bf16* GD = (const bf16*)(prep + PREP_GD);
    const float* GB = (const float*)(F.ws + WS_GB);
    float* OUT = (float*)(F.ws + WS_R1 + (gdn ? R1_OG : R1_OR)) + (size_t)dir * M * 256;
    LAS float* lk = (LAS float*)F.lds; LAS float* lq = lk + 64 * 64; LAS float* lg = lq + 64 * 64;
    const int lane = F.lane;
    float S[64];
#pragma unroll
    for (int i = 0; i < 64; ++i) S[i] = 0.f;
    const float gamma = gdn ? 0.f : __expf(-__expf(in.ret_decay[layer * 8 + dir * 4 + hh]));
    for (int t0 = 0; t0 < TC + TL; t0 += 64) {
        for (int i = 0; i < 64; ++i) { const int m = scan_row(b, dir, t0 + i);
            if (gdn) { lq[i * 64 + lane] = bf2f(GD[(size_t)m * 768 + hh * 64 + lane]); lk[i * 64 + lane] = bf2f(GD[(size_t)m * 768 + 256 + hh * 64 + lane]); if (lane < 2) lg[i * 2 + lane] = GB[(size_t)m * 16 + lane * 8 + dir * 4 + hh]; }
            else { lq[i * 64 + lane] = bf2f(RQ[(size_t)m * 256 + hh * 64 + lane]); lk[i * 64 + lane] = bf2f(RK[(size_t)m * 256 + hh * 64 + lane]); } }
        LDS_WAIT(); asm volatile("" ::: "memory");
        for (int i = 0; i < 64; ++i) { const int m = scan_row(b, dir, t0 + i);
            float o = 0.f;
            if (gdn) {
                const float v = bf2f(GD[(size_t)m * 768 + 512 + hh * 64 + lane]); const float a = __expf(lg[i * 2]), beta = lg[i * 2 + 1];
                float ks = 0.f;
#pragma unroll
                for (int d4 = 0; d4 < 16; ++d4) { const f32x4 kv = *(const LAS f32x4*)(lk + i * 64 + 4 * d4); ks += kv.x * S[4 * d4] + kv.y * S[4 * d4 + 1] + kv.z * S[4 * d4 + 2] + kv.w * S[4 * d4 + 3]; }
                const float vn = beta * (v - a * ks);
#pragma unroll
                for (int d4 = 0; d4 < 16; ++d4) { const f32x4 kv = *(const LAS f32x4*)(lk + i * 64 + 4 * d4), qv = *(const LAS f32x4*)(lq + i * 64 + 4 * d4);
                    S[4 * d4] = a * S[4 * d4] + kv.x * vn; S[4 * d4 + 1] = a * S[4 * d4 + 1] + kv.y * vn; S[4 * d4 + 2] = a * S[4 * d4 + 2] + kv.z * vn; S[4 * d4 + 3] = a * S[4 * d4 + 3] + kv.w * vn;
                    o += qv.x * S[4 * d4] + qv.y * S[4 * d4 + 1] + qv.z * S[4 * d4 + 2] + qv.w * S[4 * d4 + 3]; }
            } else {
                const float v = bf2f(P[(size_t)m * NP + PC_RV + hh * 64 + lane]);
#pragma unroll
                for (int d4 = 0; d4 < 16; ++d4) { const f32x4 kv = *(const LAS f32x4*)(lk + i * 64 + 4 * d4), qv = *(const LAS f32x4*)(lq + i * 64 + 4 * d4);
                    S[4 * d4] = gamma * S[4 * d4] + kv.x * v; S[4 * d4 + 1] = gamma * S[4 * d4 + 1] + kv.y * v; S[4 * d4 + 2] = gamma * S[4 * d4 + 2] + kv.z * v; S[4 * d4 + 3] = gamma * S[4 * d4 + 3] + kv.w * v;
                    o += qv.x * S[4 * d4] + qv.y * S[4 * d4 + 1] + qv.z * S[4 * d4 + 2] + qv.w * S[4 * d4 + 3]; }
            }
            OUT[(size_t)m * 256 + hh * 64 + lane] = o;
        }
        LDS_WAIT(); asm volatile("" ::: "memory");
    }
}

__device__ __forceinline__ void phase_swa(Frame& F, const Inputs& in, int layer) {
    const bf16* P = (const bf16*)(F.ws + WS_R1 + R1_P);
    unsigned char* prep = F.ws + WS_R1 + R1_PREP;
    const bf16* SQ = (const bf16*)(prep + PREP_SQ); const bf16* SK = (const bf16*)(prep + PREP_SK);
    bf16* O = (bf16*)(F.ws + WS_R1 + R1_O);
    const int NT = F.G * NTHR;
    for (int idx = F.bid * NTHR + F.tid; idx < M * 8; idx += NT) {
        const int hq = idx / M, m = idx % M, g = hq >> 2;
        const bool lat = m >= MC; const int b = lat ? ((m - MC) >> 12) : (m >> 8); const int t = lat ? ((m - MC) & (TL - 1)) : (m & (TC - 1));
        float q[64], o[64];
#pragma unroll
        for (int i = 0; i < 8; ++i) { const u32x4 w = *(const u32x4*)(SQ + (size_t)m * 512 + hq * 64 + 8 * i);
#pragma unroll
            for (int e = 0; e < 4; ++e) { q[8 * i + 2 * e] = __uint_as_float(w[e] << 16) * 0.125f; q[8 * i + 2 * e + 1] = __uint_as_float(w[e] & 0xffff0000u) * 0.125f; } }
#pragma unroll
        for (int i = 0; i < 64; ++i) o[i] = 0.f;
        float mx = in.swa_sink[layer * 8 + hq], l = 1.0f;
        const int nloc = lat ? 257 : 0;
        for (int kk = 0; kk < nloc + TC; ++kk) {
            int row;
            if (kk < nloc) { const int s = t - 128 + kk; if (s < 0 || s >= TL) continue; row = MC + b * TL + s; }
            else row = b * TC + (kk - nloc);
            float sc = 0.f;
#pragma unroll
            for (int i = 0; i < 8; ++i) { const u32x4 w = *(const u32x4*)(SK + (size_t)row * 128 + g * 64 + 8 * i);
#pragma unroll
                for (int e = 0; e < 4; ++e) sc += q[8 * i + 2 * e] * __uint_as_float(w[e] << 16) + q[8 * i + 2 * e + 1] * __uint_as_float(w[e] & 0xffff0000u); }
            const float mn = fmaxf(mx, sc), corr = __expf(mx - mn), p = __expf(sc - mn);
            l = l * corr + p; mx = mn;
#pragma unroll
            for (int i = 0; i < 8; ++i) { const u32x4 w = *(const u32x4*)(P + (size_t)row * NP + PC_SV + g * 64 + 8 * i);
#pragma unroll
                for (int e = 0; e < 4; ++e) { o[8 * i + 2 * e] = o[8 * i + 2 * e] * corr + p * __uint_as_float(w[e] << 16); o[8 * i + 2 * e + 1] = o[8 * i + 2 * e + 1] * corr + p * __uint_as_float(w[e] & 0xffff0000u); } }
        }
        const float il = 1.0f / l;
#pragma unroll
        for (int i = 0; i < 8; ++i) { u32x4 w;
#pragma unroll
            for (int e = 0; e < 4; ++e) w[e] = pk2(o[8 * i + 2 * e] * il, o[8 * i + 2 * e + 1] * il);
            *(u32x4*)(O + (size_t)m * D + 512 + hq * 64 + 8 * i) = w; }
    }
}

__device__ __forceinline__ void phase_finish(Frame& F, const Inputs& in, int layer) {
    const bf16* P = (const bf16*)(F.ws + WS_R1 + R1_P);
    const float* OR = (const float*)(F.ws + WS_R1 + R1_OR); const float* OG = (const float*)(F.ws + WS_R1 + R1_OG);
    bf16* O = (bf16*)(F.ws + WS_R1 + R1_O);
    const int lane = F.lane;
    for (int m = F.gw; m < M; m += F.NGW) {
#pragma unroll
        for (int hh = 0; hh < 4; ++hh) {
            const float o = OR[(size_t)m * 256 + hh * 64 + lane] + OR[(size_t)(M + m) * 256 + hh * 64 + lane];
            const float mu = wave_sum(o) * (1.0f / 64.0f); const float dlt = o - mu; const float var = wave_sum(dlt * dlt) * (1.0f / 64.0f);
            const float g = bf2f(P[(size_t)m * NP + PC_RG + hh * 64 + lane]);
            const float y = dlt * (1.0f / sqrtf(var + EPS)) * in.ret_gn_g[layer * 256 + hh * 64 + lane] * siluf(g);
            O[(size_t)m * D + hh * 64 + lane] = (bf16)f2bf(y);
            const float o2 = OG[(size_t)m * 256 + hh * 64 + lane] + OG[(size_t)(M + m) * 256 + hh * 64 + lane];
            const float ms = wave_sum(o2 * o2) * (1.0f / 64.0f);
            const float z = bf2f(P[(size_t)m * NP + PC_GZ + hh * 64 + lane]);
            const float y2 = o2 * (1.0f / sqrtf(ms + EPS)) * in.gdn_norm_g[layer * 64 + lane] * siluf(z);
            O[(size_t)m * D + 256 + hh * 64 + lane] = (bf16)f2bf(y2);
        }
    }
}

__device__ __forceinline__ void phase_route(Frame& F, int m_lo) {
    if (F.bid != 0) return;
    const int* TKE = (const int*)(F.ws + WS_TKE);
    int* TOKROW = (int*)(F.ws + WS_TOKROW); int* ROWTOK = (int*)(F.ws + WS_ROWTOK); int* TILEE = (int*)(F.ws + WS_TILEE);
    LAS int* cnt = (LAS int*)F.lds;
    LAS int* tot = cnt + 512 * 8;
    const int ntok = M - m_lo, per = (ntok + NTHR - 1) / NTHR;
    const int a0 = m_lo + F.tid * per, a1 = (a0 + per < M) ? a0 + per : M;
    int c[8];
#pragma unroll
    for (int e = 0; e < 8; ++e) c[e] = 0;
    for (int m = a0; m < a1; ++m) { const int e0 = TKE[2 * m], e1 = TKE[2 * m + 1];
#pragma unroll
        for (int e = 0; e < 8; ++e) c[e] += (e0 == e) + (e1 == e); }
#pragma unroll
    for (int e = 0; e < 8; ++e) cnt[F.tid * 8 + e] = c[e];
    __syncthreads();
    if (F.tid < 8) { int run = 0; for (int i = 0; i < NTHR; ++i) { const int v = cnt[i * 8 + F.tid]; cnt[i * 8 + F.tid] = run; run += v; } tot[F.tid] = run; }
    __syncthreads();
    if (F.tid == 0) { int st = 0; for (int e = 0; e < 8; ++e) { tot[8 + e] = st; const int pad = (tot[e] + 255) / 256 * 256;
            for (int tl = st / 256; tl < (st + pad) / 256; ++tl) TILEE[tl] = e; st += pad; }
        TILEE[256] = st / 256; }
    __syncthreads();
    int pos[8];
#pragma unroll
    for (int e = 0; e < 8; ++e) pos[e] = tot[8 + e] + cnt[F.tid * 8 + e];
    for (int m = a0; m < a1; ++m) {
#pragma unroll
        for (int k = 0; k < 2; ++k) { const int ee = TKE[2 * m + k]; int row = 0;
#pragma unroll
            for (int e = 0; e < 8; ++e) if (ee == e) { row = pos[e]; pos[e] = row + 1; }
            ROWTOK[row] = m; TOKROW[2 * m + k] = row; } }
    for (int e = 0; e < 8; ++e) { const int st = tot[8 + e] + tot[e], en = tot[8 + e] + (tot[e] + 255) / 256 * 256; for (int r = st + F.tid; r < en; r += NTHR) ROWTOK[r] = -1; }
}
__device__ __forceinline__ void phase_permute(Frame& F) {
    const int* ROWTOK = (const int*)(F.ws + WS_ROWTOK); const int nrows = ((const int*)(F.ws + WS_TILEE))[256] * 256;
    const bf16* H = (const bf16*)(F.ws + WS_H); bf16* HP = (bf16*)(F.ws + WS_HP);
    for (int r = F.gw; r < nrows; r += F.NGW) { const int tok = ROWTOK[r];
#pragma unroll
        for (int j = 0; j < 2; ++j) { u32x4 v = (u32x4){0u, 0u, 0u, 0u}; if (tok >= 0) v = *(const u32x4*)(H + (size_t)tok * D + 8 * F.lane + 512 * j); *(u32x4*)(HP + (size_t)r * D + 8 * F.lane + 512 * j) = v; } }
}

constexpr int NPH = 12;
constexpr int PH_TOTAL = 1 + DEPTH * NPH + 1;
__host__ __device__ inline bool phase_exists(int ph) {
    if (ph == 0 || ph == PH_TOTAL - 1) return true;
    const int layer = (ph - 1) / NPH, j = (ph - 1) % NPH;
    if (!(layer & 1) && j >= 10) return false;
    return true;
}
__global__ void __launch_bounds__(NTHR, 2) fwd_kernel(Args args) {
    extern __shared__ __attribute__((aligned(16))) unsigned char lds_raw[];
    Frame F;
    F.lds = (LAS unsigned char*)lds_raw;
    F.tid = threadIdx.x; F.lane = F.tid & 63; F.wave = __builtin_amdgcn_readfirstlane(F.tid >> 6);
    F.G = gridDim.x; F.bid = blockIdx.x; F.gw = blockIdx.x * NWAVES + F.wave; F.NGW = F.G * NWAVES; F.ws = args.ws;
    volatile LAS unsigned* MISC = (volatile LAS unsigned*)(F.lds + MISC_OFF);
    LAS unsigned long long* ptab = (LAS unsigned long long*)(F.lds + MISC_OFF + 128);
    if (F.tid < 32) MISC[F.tid] = 0u;
    if (F.tid == 64) { const Inputs& ai = args.in;
        ptab[0] = (unsigned long long)ai.x; ptab[1] = (unsigned long long)ai.c; ptab[2] = (unsigned long long)ai.ctx; ptab[3] = (unsigned long long)ai.c_ctx; ptab[4] = (unsigned long long)ai.ada_w; ptab[5] = (unsigned long long)ai.ada_b;
        ptab[6] = (unsigned long long)ai.norm1_g; ptab[7] = (unsigned long long)ai.w_in; ptab[8] = (unsigned long long)ai.ret_decay; ptab[9] = (unsigned long long)ai.ret_gn_g; ptab[10] = (unsigned long long)ai.gdn_conv_w; ptab[11] = (unsigned long long)ai.gdn_a_log;
        ptab[12] = (unsigned long long)ai.gdn_dt_bias; ptab[13] = (unsigned long long)ai.gdn_norm_g; ptab[14] = (unsigned long long)ai.swa_sink; ptab[15] = (unsigned long long)ai.w_out; ptab[16] = (unsigned long long)ai.norm2_g; ptab[17] = (unsigned long long)ai.ffn_w1;
        ptab[18] = (unsigned long long)ai.ffn_w3; ptab[19] = (unsigned long long)ai.ffn_w2; ptab[20] = (unsigned long long)ai.router_w; ptab[21] = (unsigned long long)ai.moe_w1; ptab[22] = (unsigned long long)ai.moe_w3; ptab[23] = (unsigned long long)ai.moe_w2; ptab[24] = (unsigned long long)ai.final_g; }
    __syncthreads();
    XcdBarrier bar; bar.bar = (unsigned*)(F.ws + WS_CTL) + CW_BAR; bar.x = 0; bar.st = nullptr;
    const int lo = args.ph_lo, hi = args.ph_hi;
    const bool multi = (hi - lo) > 1;
    if (multi) bar = xcd_barrier_post((unsigned*)(F.ws + WS_CTL) + CW_BAR, MISC + 8);
#define LAUNDER() unsigned char* _w = args.ws; asm volatile("" : "+s"(_w)); F.ws = _w; asm volatile("" ::: "memory"); { int _t = threadIdx.x; asm volatile("" : "+v"(_t)); int _b = blockIdx.x; asm volatile("" : "+s"(_b)); F.tid = _t; F.lane = _t & 63; F.wave = __builtin_amdgcn_readfirstlane(_t >> 6); F.bid = _b; F.gw = _b * NWAVES + F.wave; } const Inputs in = load_inputs(ptab)
#define IN(k) (lo <= (k) && (k) < hi)
#define SEAM(k) do { if (IN(k) && IN((k) + 1)) xcd_barrier(bar); } while (0)
    LAS unsigned char* ring = F.lds;

    if (IN(0)) { LAUNDER(); phase_prologue(F, in); } SEAM(0);

    for (int layer = 0; layer < DEPTH; ++layer) {
        const int p0 = 1 + layer * NPH;
        const bool moe = layer & 1;
        if (IN(p0 + 0)) { LAUNDER(); phase_token<0>(F, in, layer, layer == 0, layer > 0 && ((layer - 1) & 1), false, nullptr); if (layer == 2) convert_moe_layer(F, in, 1); }
        SEAM(p0 + 0);
        if (IN(p0 + 1)) { LAUNDER(); pg8::StaticOrder S; S.init(F.ws + WS_H, (bf16*)(F.ws + WS_WIN) + (size_t)layer * NP * D, M, NP, D, F.G, F.bid);
            pg8::EpiBf16 E{(bf16*)(F.ws + WS_R1 + R1_P), NP}; pg8::gemm_phase<pg8::EpiBf16, pg8::StaticOrder>(ring, D, S, E, F.tid); }
        SEAM(p0 + 1);
        if (IN(p0 + 2)) { LAUNDER(); phase_prep(F, in, layer); }
        SEAM(p0 + 2);
        if (IN(p0 + 3)) { LAUNDER(); phase_scans(F, in, layer); }
        SEAM(p0 + 3);
        if (IN(p0 + 4)) { LAUNDER(); phase_swa(F, in, layer); }
        SEAM(p0 + 4);
        if (IN(p0 + 5)) { LAUNDER(); phase_finish(F, in, layer); }
        SEAM(p0 + 5);
        if (IN(p0 + 6)) { LAUNDER(); pg8::StaticOrder S; S.init(F.ws + WS_R1 + R1_O, (bf16*)(F.ws + WS_WOUT) + (size_t)layer * D * D, M, D, D, F.G, F.bid);
            pg8::EpiResid E{(float*)(F.ws + WS_XS), (const float*)(F.ws + WS_MOD) + (size_t)layer * 5 * 6 * D, 2}; pg8::gemm_phase<pg8::EpiResid, pg8::StaticOrder>(ring, D, S, E, F.tid); }
        SEAM(p0 + 6);
        if (IN(p0 + 7)) { LAUNDER(); phase_token<1>(F, in, layer, false, false, moe, nullptr); }
        SEAM(p0 + 7);
        if (!moe) {
            if (IN(p0 + 8)) { LAUNDER(); pg8::StaticOrder S; S.init(F.ws + WS_H, (bf16*)(F.ws + WS_W13) + (size_t)(layer >> 1) * 2 * FF * D, M, 2 * FF, D, F.G, F.bid);
                pg8::EpiSwiglu E{(bf16*)(F.ws + WS_R1 + R1_HID), FF}; pg8::gemm_phase<pg8::EpiSwiglu, pg8::StaticOrder>(ring, D, S, E, F.tid); }
            SEAM(p0 + 8);
            if (IN(p0 + 9)) { LAUNDER(); pg8::StaticOrder S; S.init(F.ws + WS_R1 + R1_HID, (bf16*)(F.ws + WS_W2) + (size_t)(layer >> 1) * D * FF, M, D, FF, F.G, F.bid);
                pg8::EpiResid E{(float*)(F.ws + WS_XS), (const float*)(F.ws + WS_MOD) + (size_t)layer * 5 * 6 * D, 5}; pg8::gemm_phase<pg8::EpiResid, pg8::StaticOrder>(ring, FF, S, E, F.tid); }
            if (IN(p0 + 9) && IN(p0 + NPH)) xcd_barrier(bar);
        } else {
            if (IN(p0 + 8)) { LAUNDER(); phase_route(F, layer == DEPTH - 1 ? MC : 0); }
            SEAM(p0 + 8);
            if (IN(p0 + 9)) { LAUNDER(); phase_permute(F); }
            SEAM(p0 + 9);
            if (IN(p0 + 10)) { LAUNDER(); const int* tile_e = (const int*)(F.ws + WS_TILEE); const int ntiles = __builtin_amdgcn_readfirstlane(tile_e[256]);
                pg8::GroupedOrder S; S.init(F.ws + WS_HP, F.ws + WS_MW13, ntiles, 2 * EF, D, F.G, F.bid, tile_e);
                pg8::EpiSwiglu E{(bf16*)(F.ws + WS_R1 + R1_HID), EF}; pg8::gemm_phase<pg8::EpiSwiglu, pg8::GroupedOrder>(ring, D, S, E, F.tid); }
            SEAM(p0 + 10);
            if (IN(p0 + 11)) { LAUNDER(); const int* tile_e = (const int*)(F.ws + WS_TILEE); const int ntiles = __builtin_amdgcn_readfirstlane(tile_e[256]);
                pg8::GroupedOrder S; S.init(F.ws + WS_R1 + R1_HID, F.ws + WS_MW2, ntiles, D, EF, F.G, F.bid, tile_e);
                pg8::EpiF32 E{(float*)(F.ws + WS_YM), D}; pg8::gemm_phase<pg8::EpiF32, pg8::GroupedOrder>(ring, EF, S, E, F.tid); }
            SEAM(p0 + 11);
        }
    }
    if (IN(PH_TOTAL - 1)) { LAUNDER(); phase_token<2>(F, in, DEPTH, false, true, false, args.out); }
#undef IN
#undef SEAM
}

extern "C" void kernel_launch(void* const* d_in, const int* in_sizes, int n_in, void* d_out, int out_size, void* d_ws, size_t ws_size, hipStream_t stream) {
    static int grid = 0;
    if (grid == 0) {
        if (n_in != 25 || out_size != ML * D || ws_size < WS_END) { fprintf(stderr, "kernel_launch: unexpected problem: n_in %d out %d ws %zu (need %zu)\n", n_in, out_size, ws_size, (size_t)WS_END); grid = -1; return; }
        int dev = 0, cus = 0, per_cu = 0;
        if (hipGetDevice(&dev) != hipSuccess || hipDeviceGetAttribute(&cus, hipDeviceAttributeMultiprocessorCount, dev) != hipSuccess) { grid = -1; return; }
        if (hipFuncSetAttribute((const void*)fwd_kernel, hipFuncAttributeMaxDynamicSharedMemorySize, LDS_BYTES) != hipSuccess) { fprintf(stderr, "kernel_launch: hipFuncSetAttribute failed\n"); grid = -1; return; }
        if (hipOccupancyMaxActiveBlocksPerMultiprocessor(&per_cu, (const void*)fwd_kernel, NTHR, LDS_BYTES) != hipSuccess || per_cu < 1) fprintf(stderr, "kernel_launch: occupancy query reports %d\n", per_cu);
        (void)hipGetLastError();
        grid = cus;
    }
    if (grid < 0) return;
    (void)hipMemsetAsync((char*)d_ws + WS_CTL, 0, CTL_ZERO_BYTES, stream);
    Args a{};
    const float** ip = (const float**)&a.in;
    for (int i = 0; i < 25; ++i) ip[i] = (const float*)d_in[i];
    a.out = (float*)d_out; a.ws = (unsigned char*)d_ws;
#if MK_ONE_LAUNCH
    a.ph_lo = 0; a.ph_hi = PH_TOTAL;
    hipLaunchKernelGGL(fwd_kernel, dim3(grid), dim3(NTHR), LDS_BYTES, stream, a);
#else
    for (int ph = 0; ph < PH_TOTAL; ++ph) { if (!phase_exists(ph)) continue; a.ph_lo = ph; a.ph_hi = ph + 1;
        hipLaunchKernelGGL(fwd_kernel, dim3(grid), dim3(NTHR), LDS_BYTES, stream, a); }
#endif
}
```

```cpp
#include <hip/hip_runtime.h>
#include <cstdio>
#include <cstdint>

#ifndef MK_ONE_LAUNCH
#define MK_ONE_LAUNCH 1
#endif

#define GAS __attribute__((address_space(1)))
#define LAS __attribute__((address_space(3)))
typedef unsigned short bf16;
typedef short bf16x8 __attribute__((ext_vector_type(8)));
typedef float f32x4 __attribute__((ext_vector_type(4)));
typedef float f32x2 __attribute__((ext_vector_type(2)));
typedef unsigned u32x4 __attribute__((ext_vector_type(4)));
typedef unsigned u32x2 __attribute__((ext_vector_type(2)));

constexpr int D = 1024, NB = 4, TL = 4096, TC = 256, DEPTH = 4;
constexpr int MC = NB * TC, ML = NB * TL, M = MC + ML;
constexpr int INC = 2832, NP = 2816;
constexpr int FF = 2816, EF = 3584, NE = 8;
constexpr int MAXROWS = 36864;
constexpr float EPS = 1e-6f;
constexpr int PC_RQ = 0, PC_RK = 256, PC_RV = 512, PC_RG = 768, PC_GQKV = 1024, PC_GZ = 1792, PC_SQ = 2048, PC_SK = 2560, PC_SV = 2688;

constexpr size_t MiB = 1u << 20;
constexpr size_t WS_CTL = 0, CTL_ZERO_BYTES = 1 * MiB;
constexpr size_t WS_MOD = 1 * MiB;
constexpr size_t WS_ROPE = 2 * MiB;
constexpr size_t WS_TKE = 3 * MiB, WS_TKG = 3 * MiB + 256 * 1024, WS_TOKROW = 3 * MiB + 512 * 1024, WS_ROWTOK = 3 * MiB + 768 * 1024, WS_TILEE = 4 * MiB;
constexpr size_t WS_AB = 5 * MiB, WS_GB = 7 * MiB;
constexpr size_t WS_WIN = 16 * MiB, WS_WOUT = 38 * MiB, WS_W13 = 46 * MiB, WS_W2 = 68 * MiB, WS_MW13 = 80 * MiB, WS_MW2 = 192 * MiB;
constexpr size_t WS_XS = 248 * MiB, WS_H = 316 * MiB, WS_HP = 350 * MiB, WS_YM = 422 * MiB, WS_R1 = 566 * MiB;
constexpr size_t R1_P = 0, R1_PREP = 94 * MiB, R1_O = 158 * MiB, R1_OR = 192 * MiB, R1_OG = 226 * MiB, R1_HID = 0;
constexpr size_t WS_END = WS_R1 + 260 * MiB;
constexpr size_t PREP_RQ = 0, PREP_RK = (size_t)M * 256 * 2, PREP_SQ = (size_t)M * 512 * 2, PREP_SK = (size_t)M * 1024 * 2, PREP_GD = (size_t)M * 1152 * 2;
static_assert(PREP_GD + (size_t)M * 768 * 2 <= 64 * MiB, "prep");
static_assert((size_t)M * NP * 2 <= 94 * MiB && (size_t)MAXROWS * EF * 2 <= 260 * MiB, "r1");

constexpr int CW_TMO = 0, CW_BAR = 4096;

__device__ __forceinline__ float bf2f(bf16 v) { return __uint_as_float(((unsigned)v) << 16); }
__device__ __forceinline__ unsigned f2bf(float f) { unsigned u = __float_as_uint(f); return (u + 0x7fffu + ((u >> 16) & 1u)) >> 16; }
__device__ __forceinline__ unsigned pk2(float lo, float hi) { return f2bf(lo) | (f2bf(hi) << 16); }
__device__ __forceinline__ float wave_sum(float v) {
#pragma unroll
    for (int o = 1; o < 64; o <<= 1) v += __shfl_xor(v, o);
    return v;
}
__device__ __forceinline__ float siluf(float x) { return x / (1.0f + __expf(-x)); }
#define LDS_WAIT() asm volatile("s_waitcnt lgkmcnt(0)" ::: "memory")

namespace pg8 {
#define PG8_LAS __attribute__((address_space(3)))
constexpr int BM = 256, BK = 64, HALF = 128, HTB = HALF * BK * 2, STAGE_BYTES = 8 * HTB;
__host__ __device__ __forceinline__ int lds_byte(int r, int c) { const int st = (r >> 4) * 2 + (c >> 5), rr = r & 15, cc = c & 31, ob = rr * 64 + cc * 2; return st * 1024 + (ob ^ (((ob >> 9) & 1) << 5)); }
__host__ __device__ __forceinline__ void stage_rc(int b, int& R, int& C) { const int st = b / 1024, sb = b % 1024, swz = sb ^ (((sb >> 9) & 1) << 5); R = (st >> 1) * 16 + swz / 64; C = (st & 1) * 32 + (swz % 64) / 2; }
__host__ __device__ __forceinline__ int perm32(int rho) { const int n = rho >> 4, i = rho & 15; return 8 * (i >> 2) + 4 * n + (i & 3); }
struct Unit { int pm, pn, aux; const char* A; const char* B; };
__device__ __forceinline__ unsigned cvt_pk_bf16(float lo, float hi) { unsigned r; asm volatile("v_cvt_pk_bf16_f32 %0, %1, %2" : "=v"(r) : "v"(lo), "v"(hi)); return r; }

template <class Epi, class Sched, bool ALIGN_EPI = true, bool SP2 = true>
__device__ __forceinline__ void gemm_phase(PG8_LAS unsigned char* lds, const int K, const Sched& S, const Epi& E, const int tid) {
    const int wid = __builtin_amdgcn_readfirstlane(tid >> 6), lane = tid & 63, wr = wid >> 2, wc = wid & 3, fr = lane & 15, fq = lane >> 4;
    const int nt = K / BK;
    unsigned voffA[2], voffB[2];
#pragma unroll
    for (int i = 0; i < 2; ++i) { int R, C; stage_rc(tid * 16 + i * 8192, R, C); const int Rb = Epi::PERM ? ((R & ~31) + perm32(R & 31)) : R;
        voffA[i] = (unsigned)(R * K + C) * 2u; voffB[i] = (unsigned)(Rb * K + C) * 2u; }
    const size_t kstep = (size_t)(BK * 2);
    const size_t hstep = (size_t)HALF * K * 2;
    const unsigned ldsw = (unsigned)wid * 1024u;
    const int aoff = lds_byte(wr * 64 + fr, fq * 8), boff = lds_byte(wc * 32 + fr, fq * 8);
#define PG8_SA(b, h) (((b) * 2 + (h)) * HTB)
#define PG8_SB(b, h) ((4 + (b) * 2 + (h)) * HTB)
#define PG8_STAGE(bufoff, gbase, voff) do { _Pragma("unroll") for (int _i = 0; _i < 2; ++_i) \
        __builtin_amdgcn_global_load_lds((const unsigned*)((const char*)(gbase) + (voff)[_i]), (PG8_LAS unsigned*)(lds + (bufoff) + ldsw + _i * 8192), 16, 0, 0); } while (0)
#define PG8_LDA(dst, b, h) do { _Pragma("unroll") for (int m = 0; m < 4; ++m) _Pragma("unroll") for (int k = 0; k < 2; ++k) dst[m][k] = *(const PG8_LAS bf16x8*)(lds + PG8_SA(b, h) + aoff + m * 2048 + k * 1024); } while (0)
#define PG8_LDB(dst, b, h) do { _Pragma("unroll") for (int n = 0; n < 2; ++n) _Pragma("unroll") for (int k = 0; k < 2; ++k) dst[n][k] = *(const PG8_LAS bf16x8*)(lds + PG8_SB(b, h) + boff + n * 2048 + k * 1024); } while (0)
#define PG8_MMA(ai, bj, At, Bt) do { __builtin_amdgcn_s_setprio(1); _Pragma("unroll") for (int m = 0; m < 4; ++m) _Pragma("unroll") for (int n = 0; n < 2; ++n) _Pragma("unroll") for (int k = 0; k < 2; ++k) \
        acc[ai][bj][m][n] = __builtin_amdgcn_mfma_f32_16x16x32_bf16(Bt[n][k], At[m][k], acc[ai][bj][m][n], 0, 0, 0); __builtin_amdgcn_s_setprio(0); } while (0)
#define PG8_WAIT_V(n) asm volatile("s_waitcnt vmcnt(" #n ")" ::: "memory")
#define PG8_WAIT_L(n) asm volatile("s_waitcnt lgkmcnt(" #n ")" ::: "memory")
#define PG8_BAR __builtin_amdgcn_s_barrier()
#define PG8_SCHED __builtin_amdgcn_sched_barrier(0)
    Unit cur, nxt; int ui = 0;
    if (!S.next(0, cur)) return;
    f32x4 acc[2][2][4][2];
#pragma unroll
    for (int a = 0; a < 2; ++a)
#pragma unroll
        for (int b = 0; b < 2; ++b)
#pragma unroll
            for (int m = 0; m < 4; ++m)
#pragma unroll
                for (int n = 0; n < 2; ++n) acc[a][b][m][n] = (f32x4){0.f, 0.f, 0.f, 0.f};
    bf16x8 At[4][2], B0[2][2], B1[2][2];
    const char* cA = cur.A; const char* cB = cur.B;
    if constexpr (SP2) {
        PG8_STAGE(PG8_SB(0, 0), cB, voffB); PG8_STAGE(PG8_SB(0, 1), cB + hstep, voffB); PG8_STAGE(PG8_SA(0, 0), cA, voffA); PG8_STAGE(PG8_SA(0, 1), cA + hstep, voffA);
        if (wr == 1) PG8_BAR;
        PG8_WAIT_V(2); PG8_BAR;
        PG8_STAGE(PG8_SB(1, 0), cB + kstep, voffB); PG8_STAGE(PG8_SA(1, 0), cA + kstep, voffA); PG8_STAGE(PG8_SB(1, 1), cB + hstep + kstep, voffB);
        PG8_WAIT_V(6); PG8_BAR;
    } else {
        PG8_STAGE(PG8_SB(0, 0), cB, voffB); PG8_STAGE(PG8_SA(0, 0), cA, voffA); PG8_STAGE(PG8_SB(0, 1), cB + hstep, voffB); PG8_STAGE(PG8_SA(0, 1), cA + hstep, voffA);
        if (wr == 1) PG8_BAR;
        PG8_WAIT_V(4); PG8_BAR;
        PG8_STAGE(PG8_SB(1, 0), cB + kstep, voffB); PG8_STAGE(PG8_SA(1, 0), cA + kstep, voffA); PG8_STAGE(PG8_SB(1, 1), cB + hstep + kstep, voffB);
        PG8_WAIT_V(6); PG8_BAR;
    }
    for (;;) {
        const bool has_next = S.next(ui + 1, nxt);
        const char* nA = has_next ? nxt.A : cA; const char* nB = has_next ? nxt.B : cB;
        for (int t = 0; t < nt; t += 2) {
            const bool last = (t == nt - 2);
            const char* a1 = cA + (size_t)(t + 1) * kstep;
            const char* a2 = last ? nA : cA + (size_t)(t + 2) * kstep; const char* b2 = last ? nB : cB + (size_t)(t + 2) * kstep;
            const char* a3 = a2 + kstep; const char* b3 = b2 + kstep;
            if constexpr (SP2) {
            PG8_LDB(B0, 0, 0); PG8_LDB(B1, 0, 1); PG8_SCHED; PG8_LDA(At, 0, 0); PG8_STAGE(PG8_SA(1, 1), a1 + hstep, voffA);
            PG8_WAIT_V(8); PG8_WAIT_L(0); PG8_BAR; PG8_MMA(0, 0, At, B0); PG8_MMA(0, 1, At, B1); PG8_BAR; PG8_SCHED;
            PG8_LDA(At, 0, 1); PG8_STAGE(PG8_SB(0, 0), b2, voffB); PG8_STAGE(PG8_SB(0, 1), b2 + hstep, voffB); PG8_STAGE(PG8_SA(0, 0), a2, voffA);
            PG8_WAIT_V(8); PG8_WAIT_L(0); PG8_BAR; PG8_MMA(1, 0, At, B0); PG8_MMA(1, 1, At, B1); PG8_BAR; PG8_SCHED;
            PG8_LDB(B0, 1, 0); PG8_LDB(B1, 1, 1); PG8_SCHED; PG8_LDA(At, 1, 0); PG8_STAGE(PG8_SA(0, 1), a2 + hstep, voffA);
            PG8_WAIT_V(8); PG8_WAIT_L(0); PG8_BAR; PG8_MMA(0, 0, At, B0); PG8_MMA(0, 1, At, B1); PG8_BAR; PG8_SCHED;
            PG8_LDA(At, 1, 1); PG8_STAGE(PG8_SB(1, 0), b3, voffB); PG8_STAGE(PG8_SB(1, 1), b3 + hstep, voffB); PG8_STAGE(PG8_SA(1, 0), a3, voffA);
            PG8_WAIT_V(8); PG8_WAIT_L(0); PG8_BAR; PG8_MMA(1, 0, At, B0); PG8_MMA(1, 1, At, B1); PG8_BAR; PG8_SCHED;
            } else {
            PG8_LDB(B0, 0, 0); PG8_SCHED; PG8_LDA(At, 0, 0); PG8_STAGE(PG8_SA(1, 1), a1 + hstep, voffA);
            PG8_WAIT_L(8); PG8_BAR; PG8_WAIT_L(0); PG8_MMA(0, 0, At, B0); PG8_BAR; PG8_SCHED;
            PG8_LDB(B1, 0, 1); PG8_STAGE(PG8_SB(0, 0), b2, voffB);
            PG8_BAR; PG8_WAIT_L(0); PG8_MMA(0, 1, At, B1); PG8_BAR;
            PG8_LDA(At, 0, 1); PG8_STAGE(PG8_SA(0, 0), a2, voffA);
            PG8_BAR; PG8_WAIT_L(0); PG8_MMA(1, 0, At, B0); PG8_BAR; PG8_SCHED;
            PG8_STAGE(PG8_SB(0, 1), b2 + hstep, voffB);
            PG8_WAIT_V(6); PG8_BAR; PG8_MMA(1, 1, At, B1); PG8_BAR;
            PG8_LDB(B0, 1, 0); PG8_SCHED; PG8_LDA(At, 1, 0); PG8_STAGE(PG8_SA(0, 1), a2 + hstep, voffA);
            PG8_WAIT_L(8); PG8_BAR; PG8_WAIT_L(0); PG8_MMA(0, 0, At, B0); PG8_BAR; PG8_SCHED;
            PG8_LDB(B1, 1, 1); PG8_STAGE(PG8_SB(1, 0), b3, voffB);
            PG8_BAR; PG8_WAIT_L(0); PG8_MMA(0, 1, At, B1); PG8_BAR;
            PG8_LDA(At, 1, 1); PG8_STAGE(PG8_SA(1, 0), a3, voffA);
            PG8_BAR; PG8_WAIT_L(0); PG8_MMA(1, 0, At, B0); PG8_BAR; PG8_SCHED;
            PG8_STAGE(PG8_SB(1, 1), b3 + hstep, voffB);
            PG8_WAIT_V(6); PG8_BAR; PG8_MMA(1, 1, At, B1); PG8_BAR;
            }
        }
        if constexpr (ALIGN_EPI) { if (wr == 0) PG8_BAR; }
        E(acc, cur, wr, wc, fr, fq);
        if (!has_next) break;
#pragma unroll
        for (int a = 0; a < 2; ++a)
#pragma unroll
            for (int b = 0; b < 2; ++b)
#pragma unroll
                for (int m = 0; m < 4; ++m)
#pragma unroll
                    for (int n = 0; n < 2; ++n) acc[a][b][m][n] = (f32x4){0.f, 0.f, 0.f, 0.f};
        cur = nxt; cA = nA; cB = nB; ++ui;
        if constexpr (ALIGN_EPI) { if (wr == 1) PG8_BAR; }
    }
    PG8_WAIT_V(0);
    if constexpr (!ALIGN_EPI) { if (wr == 0) PG8_BAR; }
    PG8_BAR;
#undef PG8_SA
#undef PG8_SB
#undef PG8_STAGE
#undef PG8_LDA
#undef PG8_LDB
#undef PG8_MMA
#undef PG8_WAIT_V
#undef PG8_WAIT_L
#undef PG8_BAR
#undef PG8_SCHED
}

struct StaticOrder {
    int nM, nN, nwg, G, c; const char* A; const char* Bt; size_t tstep;
    __device__ void init(const void* A_, const void* Bt_, int M_, int N_, int K_, int G_, int c_) { A = (const char*)A_; Bt = (const char*)Bt_; nM = M_ / BM; nN = N_ / BM; nwg = nM * nN; G = G_; c = c_; tstep = (size_t)BM * K_ * 2; }
    __device__ bool next(int i, Unit& u) const {
        const long L = (long)i * G + c; if (L >= nwg) return false;
        int wgid = (int)L; { const int q = nwg / 8, r = nwg % 8, xcd = wgid % 8, off = wgid / 8; wgid = (xcd < r ? xcd * (q + 1) : r * (q + 1) + (xcd - r) * q) + off; }
        const int nig = 8 * nN, gid = wgid / nig, fm = gid * 8, gsz = (nM - fm) < 8 ? (nM - fm) : 8;
        u.pm = fm + ((wgid % nig) % gsz); u.pn = (wgid % nig) / gsz; u.aux = 0;
        u.A = A + (size_t)u.pm * tstep; u.B = Bt + (size_t)u.pn * tstep; return true;
    }
};
struct GroupedOrder {
    int nM, nN, nwg, G, c; const char* A; const char* Bt; size_t tstep, estep; const int* tile_e;
    __device__ void init(const void* A_, const void* Bt_, int ntiles, int N_, int K_, int G_, int c_, const int* te) { A = (const char*)A_; Bt = (const char*)Bt_; nM = ntiles; nN = N_ / BM; nwg = nM * nN; G = G_; c = c_; tstep = (size_t)BM * K_ * 2; estep = (size_t)N_ * K_ * 2; tile_e = te; }
    __device__ bool next(int i, Unit& u) const {
        const long L = (long)i * G + c; if (L >= nwg) return false;
        u.pm = (int)(L / nN); u.pn = (int)(L % nN); u.aux = __builtin_amdgcn_readfirstlane(tile_e[u.pm]);
        u.A = A + (size_t)u.pm * tstep; u.B = Bt + (size_t)u.aux * estep + (size_t)u.pn * tstep; return true;
    }
};

struct EpiBf16 {
    static constexpr bool PERM = true;
    bf16* O; int ldc;
    __device__ __forceinline__ void operator()(const f32x4 (&acc)[2][2][4][2], const Unit& u, int wr, int wc, int fr, int fq) const {
        const int row0 = u.pm * BM + wr * 64 + fr, col0 = u.pn * BM + wc * 32 + 8 * fq;
#pragma unroll
        for (int ai = 0; ai < 2; ++ai)
#pragma unroll
            for (int m = 0; m < 4; ++m) { bf16* rowp = O + (size_t)(row0 + ai * HALF + m * 16) * ldc + col0;
#pragma unroll
                for (int bj = 0; bj < 2; ++bj) { const f32x4 v0 = acc[ai][bj][m][0], v1 = acc[ai][bj][m][1];
                    u32x4 w; w.x = cvt_pk_bf16(v0[0], v0[1]); w.y = cvt_pk_bf16(v0[2], v0[3]); w.z = cvt_pk_bf16(v1[0], v1[1]); w.w = cvt_pk_bf16(v1[2], v1[3]);
                    *(u32x4*)(rowp + bj * HALF) = w; } }
    }
};
struct EpiResid {
    static constexpr bool PERM = false;
    float* X; const float* mod; int gsel;
    __device__ __forceinline__ void operator()(const f32x4 (&acc)[2][2][4][2], const Unit& u, int wr, int wc, int fr, int fq) const {
        const int row0 = u.pm * BM + wr * 64 + fr, col0 = u.pn * BM + wc * 32 + 4 * fq;
        const int r = u.pm < 4 ? 4 : ((u.pm - 4) >> 4);
        const float* g = mod + (size_t)r * 6 * D + gsel * D;
        f32x4 gv[2][2];
#pragma unroll
        for (int bj = 0; bj < 2; ++bj)
#pragma unroll
            for (int n = 0; n < 2; ++n) gv[bj][n] = *(const f32x4*)(g + col0 + bj * HALF + n * 16);
#pragma unroll
        for (int ai = 0; ai < 2; ++ai)
#pragma unroll
            for (int m = 0; m < 4; ++m) { float* rowp = X + (size_t)(row0 + ai * HALF + m * 16) * D + col0;
#pragma unroll
                for (int bj = 0; bj < 2; ++bj)
#pragma unroll
                    for (int n = 0; n < 2; ++n) { f32x4 x = *(f32x4*)(rowp + bj * HALF + n * 16); x += gv[bj][n] * acc[ai][bj][m][n]; *(f32x4*)(rowp + bj * HALF + n * 16) = x; } }
    }
};
struct EpiSwiglu {
    static constexpr bool PERM = false;
    bf16* Hd; int ldh;
    __device__ __forceinline__ void operator()(const f32x4 (&acc)[2][2][4][2], const Unit& u, int wr, int wc, int fr, int fq) const {
        const int row0 = u.pm * BM + wr * 64 + fr, col0 = u.pn * 128 + wc * 16 + 4 * fq;
#pragma unroll
        for (int ai = 0; ai < 2; ++ai)
#pragma unroll
            for (int m = 0; m < 4; ++m) { bf16* rowp = Hd + (size_t)(row0 + ai * HALF + m * 16) * ldh + col0;
#pragma unroll
                for (int bj = 0; bj < 2; ++bj) { const f32x4 a = acc[ai][bj][m][0], b = acc[ai][bj][m][1];
                    float h[4];
#pragma unroll
                    for (int j = 0; j < 4; ++j) h[j] = a[j] / (1.0f + __expf(-a[j])) * b[j];
                    u32x2 w; w.x = cvt_pk_bf16(h[0], h[1]); w.y = cvt_pk_bf16(h[2], h[3]);
                    *(u32x2*)(rowp + bj * 64) = w; } }
    }
};
struct EpiF32 {
    static constexpr bool PERM = false;
    float* C; int ldc;
    __device__ __forceinline__ void operator()(const f32x4 (&acc)[2][2][4][2], const Unit& u, int wr, int wc, int fr, int fq) const {
        const int row0 = u.pm * BM + wr * 64 + fr, col0 = u.pn * BM + wc * 32 + 4 * fq;
#pragma unroll
        for (int ai = 0; ai < 2; ++ai)
#pragma unroll
            for (int m = 0; m < 4; ++m) { float* rowp = C + (size_t)(row0 + ai * HALF + m * 16) * ldc + col0;
#pragma unroll
                for (int bj = 0; bj < 2; ++bj)
#pragma unroll
                    for (int n = 0; n < 2; ++n) *(f32x4*)(rowp + bj * HALF + n * 16) = acc[ai][bj][m][n]; }
    }
};
}

#define XB_TMO      128
#define XB_XCNT(j)  (256  + 64 * (j))
#define XB_XSUB(j)  (1280 + 64 * (j))
#define XB_XGEN(j)  (2304 + 64 * (j))
#define XB_TOP      3328
#define XB_TOPGEN   3392
#define XCD_BAR_WORDS 3456
#define XB_SPIN_CAP (1u << 22)
__device__ __forceinline__ unsigned xb_ld(unsigned* p)              { return __hip_atomic_load(p, __ATOMIC_RELAXED, __HIP_MEMORY_SCOPE_AGENT); }
__device__ __forceinline__ unsigned xb_add(unsigned* p, unsigned v) { return __hip_atomic_fetch_add(p, v, __ATOMIC_RELAXED, __HIP_MEMORY_SCOPE_AGENT); }
__device__ __forceinline__ unsigned xb_xcc_id() { return (unsigned)__builtin_amdgcn_s_getreg((3 << 11) | 20) & 0xFu; }
#define XB_SPIN(cond, bar) do { unsigned _sp = 0; while (cond) { __builtin_amdgcn_s_sleep(1); \
    if ((++_sp & 255u) == 0u) { if (xb_ld(&(bar)[XB_TMO])) break; if (_sp > XB_SPIN_CAP) { atomicAdd(&(bar)[XB_TMO], 1u); break; } } } } while (0)
struct XcdBarrier { unsigned* bar; unsigned x; volatile LAS unsigned* st; };
__device__ __forceinline__ XcdBarrier xcd_barrier_post(unsigned* bar, volatile LAS unsigned* st) {
    XcdBarrier b; b.bar = bar; b.x = xb_xcc_id(); b.st = st;
    if (threadIdx.x == 0) (void)xb_add(&bar[XB_XCNT(b.x)], 1u);
    return b;
}
__device__ __forceinline__ void xcd_barrier_complete(unsigned* bar, unsigned x, unsigned& nloc, unsigned& nx) {
    const unsigned G = gridDim.x * gridDim.y * gridDim.z;
    unsigned sum, cnt, mine, sp = 0u;
    for (;;) {
        sum = 0u; cnt = 0u; mine = 0u;
#pragma unroll
        for (unsigned j = 0; j < 16; ++j) { const unsigned c = xb_ld(&bar[XB_XCNT(j)]); sum += c; cnt += (c > 0u) ? 1u : 0u; mine = (j == x) ? c : mine; }
        if (sum == G) break;
        __builtin_amdgcn_s_sleep(1);
        if ((++sp & 255u) == 0u) { if (xb_ld(&bar[XB_TMO])) break; if (sp > XB_SPIN_CAP) { atomicAdd(&bar[XB_TMO], 1u); break; } }
    }
    nloc = mine > 0u ? mine : 1u; nx = cnt > 0u ? cnt : 1u;
}
__device__ __forceinline__ void xcd_barrier(const XcdBarrier& b) {
    asm volatile("s_waitcnt vmcnt(0)" ::: "memory");
    __syncthreads();
    if (threadIdx.x == 0) {
        unsigned* bar = b.bar;
        __builtin_amdgcn_s_waitcnt(0);
        unsigned nloc = b.st[0], nx = b.st[1];
        if (nloc == 0u) { xcd_barrier_complete(bar, b.x, nloc, nx); b.st[0] = nloc; b.st[1] = nx; }
        const unsigned old = xb_add(&bar[XB_XSUB(b.x)], 1u);
        const unsigned gen = old / nloc;
        if (old + 1u == (gen + 1u) * nloc) {
            __builtin_amdgcn_fence(__ATOMIC_RELEASE, "agent");
            asm volatile("s_waitcnt vmcnt(0)" ::: "memory");
            const unsigned og = xb_add(&bar[XB_TOP], 1u);
            const unsigned tg = og / nx;
            if (og + 1u == (tg + 1u) * nx) xb_add(&bar[XB_TOPGEN], 1u);
            else XB_SPIN(xb_ld(&bar[XB_TOPGEN]) == tg, bar);
            __builtin_amdgcn_fence(__ATOMIC_ACQUIRE, "agent");
            xb_add(&bar[XB_XGEN(b.x)], 1u);
            asm volatile("s_waitcnt vmcnt(0)" ::: "memory");
        } else {
            XB_SPIN(xb_ld(&bar[XB_XGEN(b.x)]) == gen, bar);
            __builtin_amdgcn_fence(__ATOMIC_ACQUIRE, "agent");
            asm volatile("s_waitcnt vmcnt(0)" ::: "memory");
        }
    }
    __syncthreads();
}

constexpr int NWAVES = 8, NTHR = 512;
constexpr int RING_BYTES = 131072, MISC_OFF = RING_BYTES + 320, LDS_BYTES = 147456;

struct Inputs {
    const float *x, *c, *ctx, *c_ctx, *ada_w, *ada_b, *norm1_g, *w_in, *ret_decay, *ret_gn_g, *gdn_conv_w, *gdn_a_log, *gdn_dt_bias, *gdn_norm_g, *swa_sink, *w_out, *norm2_g,
        *ffn_w1, *ffn_w3, *ffn_w2, *router_w, *moe_w1, *moe_w3, *moe_w2, *final_g;
};
struct Args { Inputs in; float* out; unsigned char* ws; int ph_lo, ph_hi; };
static_assert(sizeof(Args) == 25 * 8 + 8 + 8 + 8, "no padding");


__device__ __forceinline__ const float* ld_ptr(const LAS unsigned long long* t, int i) { const unsigned long long v = t[i]; const unsigned lo = __builtin_amdgcn_readfirstlane((unsigned)v), hi = __builtin_amdgcn_readfirstlane((unsigned)(v >> 32)); return (const float*)(((unsigned long long)hi << 32) | lo); }
__device__ __forceinline__ Inputs load_inputs(const LAS unsigned long long* t) {
    Inputs in; const float** ip = (const float**)&in;
#pragma unroll
    for (int i = 0; i < 25; ++i) ip[i] = ld_ptr(t, i);
    return in;
}
struct Frame {
    LAS unsigned char* lds;
    int tid, lane, wave, G, gw, NGW, bid;
    unsigned char* ws;
};

template <class SrcF>
__device__ __forceinline__ void transpose_item(const SrcF& src, int K, bf16* WT, LAS float* scr, int k0, int n0, int lane) {
#pragma unroll 8
    for (int i = 0; i < 32; ++i) { const int kk = 2 * i + (lane >> 5); scr[kk * 33 + (lane & 31)] = src(k0 + kk, n0 + (lane & 31)); }
    LDS_WAIT(); asm volatile("" ::: "memory");
    const int c = lane & 7;
#pragma unroll
    for (int j = 0; j < 4; ++j) { const int n = (lane >> 3) + 8 * j; const LAS float* s = scr + (8 * c) * 33 + n;
        u32x4 o; o.x = pk2(s[0 * 33], s[1 * 33]); o.y = pk2(s[2 * 33], s[3 * 33]); o.z = pk2(s[4 * 33], s[5 * 33]); o.w = pk2(s[6 * 33], s[7 * 33]);
        *(u32x4*)(WT + (size_t)(n0 + n) * K + k0 + 8 * c) = o; }
    LDS_WAIT(); asm volatile("" ::: "memory");
}
struct SrcPlain { const float* W; int ld; __device__ __forceinline__ float operator()(int k, int n) const { return W[(size_t)k * ld + n]; } };
struct SrcWin { const float* W; __device__ __forceinline__ float operator()(int k, int n) const { return W[(size_t)k * INC + (n < 2048 ? n : n + 16)]; } };
struct SrcGU { const float* W1; const float* W3; int ld; __device__ __forceinline__ float operator()(int k, int n) const { const int g = n >> 5, i = n & 31; const ptrdiff_t d = (i < 16) ? (ptrdiff_t)0 : (W3 - W1); return W1[d + (ptrdiff_t)k * ld + 16 * g + (i & 15)]; } };

__device__ __forceinline__ void convert_moe_layer(Frame& F, const Inputs& in, int mi) {
    LAS float* scr = (LAS float*)(F.lds + F.wave * 16384);
    bf16* mw13 = (bf16*)(F.ws + WS_MW13); bf16* mw2 = (bf16*)(F.ws + WS_MW2);
    constexpr int I13 = (D / 64) * (2 * EF / 32), I2 = (EF / 64) * (D / 32);
    for (int it = F.gw; it < NE * (I13 + I2); it += F.NGW) {
        const int e = it / (I13 + I2); int r = it % (I13 + I2);
        const size_t wo = ((size_t)mi * NE + e) * (size_t)D * EF;
        if (r < I13) { const int nblk = 2 * EF / 32; SrcGU s{in.moe_w1 + wo, in.moe_w3 + wo, EF}; transpose_item(s, D, mw13 + (size_t)e * 2 * EF * D, scr, 64 * (r / nblk), 32 * (r % nblk), F.lane); }
        else { r -= I13; const int nblk = D / 32; SrcPlain s{in.moe_w2 + wo, D}; transpose_item(s, EF, mw2 + (size_t)e * D * EF, scr, 64 * (r / nblk), 32 * (r % nblk), F.lane); }
    }
}

__device__ __forceinline__ void phase_prologue(Frame& F, const Inputs& in) {
    LAS float* scr = (LAS float*)(F.lds + F.wave * 16384);
    {
        constexpr int I_IN = (D / 64) * (NP / 32), I_OUT = (D / 64) * (D / 32), I_13 = (D / 64) * (2 * FF / 32), I_2 = (FF / 64) * (D / 32);
        constexpr int PER_L = I_IN + I_OUT, PER_F = I_13 + I_2, TOT = DEPTH * PER_L + 2 * PER_F;
        for (int it = F.gw; it < TOT; it += F.NGW) {
            if (it < DEPTH * PER_L) { const int l = it / PER_L; int r = it % PER_L;
                if (r < I_IN) { const int nblk = NP / 32; SrcWin s{in.w_in + (size_t)l * D * INC}; transpose_item(s, D, (bf16*)(F.ws + WS_WIN) + (size_t)l * NP * D, scr, 64 * (r / nblk), 32 * (r % nblk), F.lane); }
                else { r -= I_IN; const int nblk = D / 32; SrcPlain s{in.w_out + (size_t)l * D * D, D}; transpose_item(s, D, (bf16*)(F.ws + WS_WOUT) + (size_t)l * D * D, scr, 64 * (r / nblk), 32 * (r % nblk), F.lane); }
            } else { const int q = it - DEPTH * PER_L; const int i = q / PER_F; int r = q % PER_F;
                if (r < I_13) { const int nblk = 2 * FF / 32; SrcGU s{in.ffn_w1 + (size_t)i * D * FF, in.ffn_w3 + (size_t)i * D * FF, FF}; transpose_item(s, D, (bf16*)(F.ws + WS_W13) + (size_t)i * 2 * FF * D, scr, 64 * (r / nblk), 32 * (r % nblk), F.lane); }
                else { r -= I_13; const int nblk = D / 32; SrcPlain s{in.ffn_w2 + (size_t)i * FF * D, D}; transpose_item(s, FF, (bf16*)(F.ws + WS_W2) + (size_t)i * D * FF, scr, 64 * (r / nblk), 32 * (r % nblk), F.lane); }
            }
        }
    }
    convert_moe_layer(F, in, 0);
    {
        __syncthreads();
        LAS float* sc = (LAS float*)F.lds;
        LAS float* red = (LAS float*)(F.lds + 32768);
        for (int i = F.tid; i < 5 * D; i += NTHR) { const int r = i / D, k = i % D; const float v = r < 4 ? in.c[r * D + k] : in.c_ctx[k]; sc[i] = siluf(v); }
        __syncthreads();
        float* mod = (float*)(F.ws + WS_MOD);
        for (int u = F.bid; u < DEPTH * 96; u += F.G) {
            const int l = u / 96, n = (u % 96) * 64 + F.lane;
            const float* w = in.ada_w + (size_t)l * D * 6 * D + n;
            float a[5] = {0.f, 0.f, 0.f, 0.f, 0.f};
            for (int k = F.wave * 128; k < F.wave * 128 + 128; ++k) { const float wv = w[(size_t)k * 6 * D];
#pragma unroll
                for (int r = 0; r < 5; ++r) a[r] += sc[r * D + k] * wv; }
#pragma unroll
            for (int r = 0; r < 5; ++r) red[(F.wave * 5 + r) * 64 + F.lane] = a[r];
            __syncthreads();
            if (F.tid < 320) { const int r = F.tid / 64, ln = F.tid % 64; float s = 0.f;
#pragma unroll
                for (int w8 = 0; w8 < 8; ++w8) s += red[(w8 * 5 + r) * 64 + ln];
                const int nn = (u % 96) * 64 + ln;
                mod[((size_t)l * 5 + r) * 6 * D + nn] = s + in.ada_b[(size_t)l * 6 * D + nn]; }
            __syncthreads();
        }
    }
    if (F.bid == 0) { float* rp = (float*)(F.ws + WS_ROPE);
        for (int i = F.tid; i < 64 * 16; i += NTHR) { const int pos = i / 16, fi = i % 16; const double inv = pow(10000.0, -(double)fi / 16.0), ang = (double)pos * inv; rp[2 * i] = (float)cos(ang); rp[2 * i + 1] = (float)sin(ang); } }
}

__device__ __forceinline__ int mod_row(int m) { return m < MC ? 4 : ((m - MC) >> 12); }

template <int MODE>
__device__ __forceinline__ void phase_token(Frame& F, const Inputs& in, int layer, bool first_from_input, bool combine_moe, bool moe_router, float* out) {
    float* XS = (float*)(F.ws + WS_XS);
    bf16* H = (bf16*)(F.ws + WS_H);
    const float* mod = (const float*)(F.ws + WS_MOD) + (size_t)(layer < DEPTH ? layer : DEPTH - 1) * 5 * 6 * D;
    const float* modprev = (const float*)(F.ws + WS_MOD) + (size_t)(layer > 0 ? layer - 1 : 0) * 5 * 6 * D;
    const int* TKE = (const int*)(F.ws + WS_TKE); const float* TKG = (const float*)(F.ws + WS_TKG); const int* TOKROW = (const int*)(F.ws + WS_TOKROW);
    const float* YM = (const float*)(F.ws + WS_YM);
    LAS float* wl = (LAS float*)F.lds;
    if (MODE == 0) { __syncthreads(); const float* w = in.w_in + (size_t)layer * D * INC + 2048; for (int i = F.tid; i < D * 16; i += NTHR) { const int k = i >> 4, c = i & 15, kp = ((k >> 8) * 4 + (k & 3)) * 64 + ((k >> 2) & 63); wl[((c >> 2) * 1024 + kp) * 4 + (c & 3)] = w[(size_t)k * INC + c]; } __syncthreads(); }
    if (MODE == 1 && moe_router) { __syncthreads(); const float* w = in.router_w + (size_t)(layer >> 1) * D * NE; for (int i = F.tid; i < D * NE; i += NTHR) { const int k = i >> 3, c = i & 7, kp = ((k >> 8) * 4 + (k & 3)) * 64 + ((k >> 2) & 63); wl[((c >> 2) * 1024 + kp) * 4 + (c & 3)] = w[i]; } __syncthreads(); }
    const float* gain = MODE == 0 ? in.norm1_g + (size_t)layer * D : (MODE == 1 ? in.norm2_g + (size_t)layer * D : in.final_g);
    const int m_lo = (MODE == 2) ? MC : 0;
    for (int m = m_lo + F.gw; m < M; m += F.NGW) {
        const int r = mod_row(m);
        f32x4 v[4];
        const float* xrow = first_from_input ? (m < MC ? in.ctx + (size_t)m * D : in.x + (size_t)(m - MC) * D) : XS + (size_t)m * D;
#pragma unroll
        for (int j = 0; j < 4; ++j) v[j] = *(const f32x4*)(xrow + 4 * F.lane + 256 * j);
        bool wrote = first_from_input;
        if (combine_moe && !(layer == DEPTH && m < MC)) {
            const int r0 = TOKROW[2 * m], r1 = TOKROW[2 * m + 1]; const float g0 = TKG[2 * m], g1 = TKG[2 * m + 1];
            const float* gt = modprev + (size_t)r * 6 * D + 5 * D;
#pragma unroll
            for (int j = 0; j < 4; ++j) { const f32x4 y0 = *(const f32x4*)(YM + (size_t)r0 * D + 4 * F.lane + 256 * j), y1 = *(const f32x4*)(YM + (size_t)r1 * D + 4 * F.lane + 256 * j);
                const f32x4 gg = *(const f32x4*)(gt + 4 * F.lane + 256 * j); v[j] += gg * (g0 * y0 + g1 * y1); }
            wrote = true;
        }
        if (wrote && MODE != 2) {
#pragma unroll
            for (int j = 0; j < 4; ++j) *(f32x4*)(XS + (size_t)m * D + 4 * F.lane + 256 * j) = v[j];
        }
        float ss = 0.f;
#pragma unroll
        for (int j = 0; j < 4; ++j) ss += (v[j].x * v[j].x + v[j].y * v[j].y) + (v[j].z * v[j].z + v[j].w * v[j].w);
        const float rstd = 1.0f / sqrtf(wave_sum(ss) * (1.0f / D) + EPS);
        if (MODE == 2) {
#pragma unroll
            for (int j = 0; j < 4; ++j) { const f32x4 g = *(const f32x4*)(gain + 4 * F.lane + 256 * j); *(f32x4*)(out + (size_t)(m - MC) * D + 4 * F.lane + 256 * j) = v[j] * rstd * g; }
            continue;
        }
        const float* sh = mod + (size_t)r * 6 * D + (MODE == 0 ? 0 : 3) * D; const float* scl = sh + D;
        f32x4 h[4];
#pragma unroll
        for (int j = 0; j < 4; ++j) { const f32x4 g = *(const f32x4*)(gain + 4 * F.lane + 256 * j), s1 = *(const f32x4*)(scl + 4 * F.lane + 256 * j), s0 = *(const f32x4*)(sh + 4 * F.lane + 256 * j);
            h[j] = v[j] * rstd * g * (1.0f + s1) + s0;
            u32x2 w; w.x = pk2(h[j].x, h[j].y); w.y = pk2(h[j].z, h[j].w); *(u32x2*)(H + (size_t)m * D + 4 * F.lane + 256 * j) = w; }
        if (MODE == 0) {
            float a[16];
#pragma unroll
            for (int c = 0; c < 16; ++c) a[c] = 0.f;
#pragma unroll
            for (int j = 0; j < 4; ++j)
#pragma unroll
                for (int e = 0; e < 4; ++e) { const int kp = (j * 4 + e) * 64 + F.lane; const float hv = h[j][e];
#pragma unroll
                    for (int q = 0; q < 4; ++q) { const f32x4 w = *(const LAS f32x4*)(wl + (q * 1024 + kp) * 4); a[4 * q] += hv * w.x; a[4 * q + 1] += hv * w.y; a[4 * q + 2] += hv * w.z; a[4 * q + 3] += hv * w.w; } }
            float mine = 0.f;
#pragma unroll
            for (int c = 0; c < 16; ++c) { const float s = wave_sum(a[c]); mine = (F.lane == c) ? s : mine; }
            if (F.lane < 16) ((float*)(F.ws + WS_AB))[(size_t)m * 16 + F.lane] = mine;
        }
        if (MODE == 1 && moe_router) {
            float a[8];
#pragma unroll
            for (int c = 0; c < 8; ++c) a[c] = 0.f;
#pragma unroll
            for (int j = 0; j < 4; ++j)
#pragma unroll
                for (int e = 0; e < 4; ++e) { const int kp = (j * 4 + e) * 64 + F.lane; const float hv = h[j][e];
#pragma unroll
                    for (int q = 0; q < 2; ++q) { const f32x4 w = *(const LAS f32x4*)(wl + (q * 1024 + kp) * 4); a[4 * q] += hv * w.x; a[4 * q + 1] += hv * w.y; a[4 * q + 2] += hv * w.z; a[4 * q + 3] += hv * w.w; } }
#pragma unroll
            for (int c = 0; c < 8; ++c) a[c] = wave_sum(a[c]);
            int i0 = 0; float l0 = a[0];
#pragma unroll
            for (int c = 1; c < 8; ++c) if (a[c] > l0) { l0 = a[c]; i0 = c; }
            int i1 = -1; float l1 = -3.0e38f;
#pragma unroll
            for (int c = 0; c < 8; ++c) if (c != i0 && a[c] > l1) { l1 = a[c]; i1 = c; }
            const float e1 = __expf(l1 - l0), g0 = 1.0f / (1.0f + e1), g1 = e1 / (1.0f + e1);
            if (F.lane == 0) { ((int*)(F.ws + WS_TKE))[2 * m] = i0; ((int*)(F.ws + WS_TKE))[2 * m + 1] = i1; ((float*)(F.ws + WS_TKG))[2 * m] = g0; ((float*)(F.ws + WS_TKG))[2 * m + 1] = g1; }
        }
    }
    (void)TKE;
}

__device__ __forceinline__ void phase_prep(Frame& F, const Inputs& in, int layer) {
    const bf16* P = (const bf16*)(F.ws + WS_R1 + R1_P);
    unsigned char* prep = F.ws + WS_R1 + R1_PREP;
    bf16* RQ = (bf16*)(prep + PREP_RQ); bf16* RK = (bf16*)(prep + PREP_RK); bf16* SQ = (bf16*)(prep + PREP_SQ); bf16* SK = (bf16*)(prep + PREP_SK); bf16* GD = (bf16*)(prep + PREP_GD);
    const float* rope = (const float*)(F.ws + WS_ROPE);
    const float* AB = (const float*)(F.ws + WS_AB); float* GB = (float*)(F.ws + WS_GB);
    const float* cw = in.gdn_conv_w + (size_t)layer * 5 * 768;
    const int lane = F.lane;
    for (int m = F.gw; m < M; m += F.NGW) {
        const bool lat = m >= MC; const int t = lat ? ((m - MC) & (TL - 1)) : (m & (TC - 1)); const int Tn = lat ? TL : TC;
        const bf16* prow = P + (size_t)m * NP;
        float cs = 1.f, sn = 0.f;
        if (lat) { const int j = lane & 31; const int pos = j < 16 ? (t >> 6) : (t & 63); const int fi = j & 15; cs = rope[(pos * 16 + fi) * 2]; sn = rope[(pos * 16 + fi) * 2 + 1]; if (lane < 32) sn = -sn; }
#pragma unroll
        for (int hh = 0; hh < 4; ++hh) { const float q = bf2f(prow[PC_RQ + hh * 64 + lane]), k = bf2f(prow[PC_RK + hh * 64 + lane]) * 0.125f;
            const float qp = __shfl_xor(q, 32), kp = __shfl_xor(k, 32);
            RQ[(size_t)m * 256 + hh * 64 + lane] = (bf16)f2bf(q * cs + qp * sn); RK[(size_t)m * 256 + hh * 64 + lane] = (bf16)f2bf(k * cs + kp * sn); }
#pragma unroll
        for (int hq = 0; hq < 8; ++hq) { const float q = bf2f(prow[PC_SQ + hq * 64 + lane]); const float qp = __shfl_xor(q, 32); SQ[(size_t)m * 512 + hq * 64 + lane] = (bf16)f2bf(q * cs + qp * sn); }
#pragma unroll
        for (int g = 0; g < 2; ++g) { const float k = bf2f(prow[PC_SK + g * 64 + lane]); const float kp = __shfl_xor(k, 32); SK[(size_t)m * 128 + g * 64 + lane] = (bf16)f2bf(k * cs + kp * sn); }
#pragma unroll
        for (int s = 0; s < 12; ++s) { const int c = s * 64 + lane; float y = 0.f;
#pragma unroll
            for (int j = 0; j < 5; ++j) { const int tt = t + j - 2; if (tt >= 0 && tt < Tn) y += cw[j * 768 + c] * bf2f(prow[(ptrdiff_t)(j - 2) * NP + PC_GQKV + c]); }
            y = siluf(y);
            if (s < 8) { const float n2 = wave_sum(y * y); y = y * (1.0f / sqrtf(n2 + EPS)); if (s < 4) y *= 0.125f; }
            GD[(size_t)m * 768 + c] = (bf16)f2bf(y); }
        if (lane < 16) { const int dh = lane & 7; const float a = AB[(size_t)m * 16 + lane];
            float o;
            if (lane < 8) { const float xx = a + in.gdn_dt_bias[layer * 8 + dh]; const float sp = fmaxf(xx, 0.f) + log1pf(__expf(-fabsf(xx))); o = -__expf(in.gdn_a_log[layer * 8 + dh]) * sp; }
            else o = 1.0f / (1.0f + __expf(-a));
            GB[(size_t)m * 16 + lane] = o; }
    }
}

__device__ __forceinline__ int scan_row(int b, int dir, int tau) {
    if (tau < TC) { const int c = dir ? TC - 1 - tau : tau; return b * TC + c; }
    const int tt = tau - TC; const int t = dir ? TL - 1 - tt : tt; return MC + b * TL + t;
}
__device__ __forceinline__ void phase_scans(Frame& F, const Inputs& in, int layer) {
    if (F.wave != 0 || F.bid >= 64) return;
    const int id = F.bid; const bool gdn = id >= 32; const int sid = id & 31; const int b = sid >> 3, hh = (sid >> 1) & 3, dir = sid & 1;
    const bf16* P = (const bf16*)(F.ws + WS_R1 + R1_P);
    unsigned char* prep = F.ws + WS_R1 + R1_PREP;
    const bf16* RQ = (const bf16*)(prep + PREP_RQ); const bf16* RK = (const bf16*)(prep + PREP_RK); const bf16* GD = (const bf16*)(prep + PREP_GD);
    const float* GB = (const float*)(F.ws + WS_GB);
    float* OUT = (float*)(F.ws + WS_R1 + (gdn ? R1_OG : R1_OR)) + (size_t)dir * M * 256;
    LAS float* lk = (LAS float*)F.lds; LAS float* lq = lk + 64 * 64; LAS float* lg = lq + 64 * 64;
    const int lane = F.lane;
    float S[64];
#pragma unroll
    for (int i = 0; i < 64; ++i) S[i] = 0.f;
    const float gamma = gdn ? 0.f : __expf(-__expf(in.ret_decay[layer * 8 + dir * 4 + hh]));
    for (int t0 = 0; t0 < TC + TL; t0 += 64) {
        for (int i = 0; i < 64; ++i) { const int m = scan_row(b, dir, t0 + i);
            if (gdn) { lq[i * 64 + lane] = bf2f(GD[(size_t)m * 768 + hh * 64 + lane]); lk[i * 64 + lane] = bf2f(GD[(size_t)m * 768 + 256 + hh * 64 + lane]); if (lane < 2) lg[i * 2 + lane] = GB[(size_t)m * 16 + lane * 8 + dir * 4 + hh]; }
            else { lq[i * 64 + lane] = bf2f(RQ[(size_t)m * 256 + hh * 64 + lane]); lk[i * 64 + lane] = bf2f(RK[(size_t)m * 256 + hh * 64 + lane]); } }
        LDS_WAIT(); asm volatile("" ::: "memory");
        for (int i = 0; i < 64; ++i) { const int m = scan_row(b, dir, t0 + i);
            float o = 0.f;
            if (gdn) {
                const float v = bf2f(GD[(size_t)m * 768 + 512 + hh * 64 + lane]); const float a = __expf(lg[i * 2]), beta = lg[i * 2 + 1];
                float ks = 0.f;
#pragma unroll
                for (int d4 = 0; d4 < 16; ++d4) { const f32x4 kv = *(const LAS f32x4*)(lk + i * 64 + 4 * d4); ks += kv.x * S[4 * d4] + kv.y * S[4 * d4 + 1] + kv.z * S[4 * d4 + 2] + kv.w * S[4 * d4 + 3]; }
                const float vn = beta * (v - a * ks);
#pragma unroll
                for (int d4 = 0; d4 < 16; ++d4) { const f32x4 kv = *(const LAS f32x4*)(lk + i * 64 + 4 * d4), qv = *(const LAS f32x4*)(lq + i * 64 + 4 * d4);
                    S[4 * d4] = a * S[4 * d4] + kv.x * vn; S[4 * d4 + 1] = a * S[4 * d4 + 1] + kv.y * vn; S[4 * d4 + 2] = a * S[4 * d4 + 2] + kv.z * vn; S[4 * d4 + 3] = a * S[4 * d4 + 3] + kv.w * vn;
                    o += qv.x * S[4 * d4] + qv.y * S[4 * d4 + 1] + qv.z * S[4 * d4 + 2] + qv.w * S[4 * d4 + 3]; }
            } else {
                const float v = bf2f(P[(size_t)m * NP + PC_RV + hh * 64 + lane]);
#pragma unroll
                for (int d4 = 0; d4 < 16; ++d4) { const f32x4 kv = *(const LAS f32x4*)(lk + i * 64 + 4 * d4), qv = *(const LAS f32x4*)(lq + i * 64 + 4 * d4);
                    S[4 * d4] = gamma * S[4 * d4] + kv.x * v; S[4 * d4 + 1] = gamma * S[4 * d4 + 1] + kv.y * v; S[4 * d4 + 2] = gamma * S[4 * d4 + 2] + kv.z * v; S[4 * d4 + 3] = gamma * S[4 * d4 + 3] + kv.w * v;
                    o += qv.x * S[4 * d4] + qv.y * S[4 * d4 + 1] + qv.z * S[4 * d4 + 2] + qv.w * S[4 * d4 + 3]; }
            }
            OUT[(size_t)m * 256 + hh * 64 + lane] = o;
        }
        LDS_WAIT(); asm volatile("" ::: "memory");
    }
}

__device__ __forceinline__ void phase_swa(Frame& F, const Inputs& in, int layer) {
    const bf16* P = (const bf16*)(F.ws + WS_R1 + R1_P);
    unsigned char* prep = F.ws + WS_R1 + R1_PREP;
    const bf16* SQ = (const bf16*)(prep + PREP_SQ); const bf16* SK = (const bf16*)(prep + PREP_SK);
    bf16* O = (bf16*)(F.ws + WS_R1 + R1_O);
    const int NT = F.G * NTHR;
    for (int idx = F.bid * NTHR + F.tid; idx < M * 8; idx += NT) {
        const int hq = idx / M, m = idx % M, g = hq >> 2;
        const bool lat = m >= MC; const int b = lat ? ((m - MC) >> 12) : (m >> 8); const int t = lat ? ((m - MC) & (TL - 1)) : (m & (TC - 1));
        float q[64], o[64];
#pragma unroll
        for (int i = 0; i < 8; ++i) { const u32x4 w = *(const u32x4*)(SQ + (size_t)m * 512 + hq * 64 + 8 * i);
#pragma unroll
            for (int e = 0; e < 4; ++e) { q[8 * i + 2 * e] = __uint_as_float(w[e] << 16) * 0.125f; q[8 * i + 2 * e + 1] = __uint_as_float(w[e] & 0xffff0000u) * 0.125f; } }
#pragma unroll
        for (int i = 0; i < 64; ++i) o[i] = 0.f;
        float mx = in.swa_sink[layer * 8 + hq], l = 1.0f;
        const int nloc = lat ? 257 : 0;
        for (int kk = 0; kk < nloc + TC; ++kk) {
            int row;
            if (kk < nloc) { const int s = t - 128 + kk; if (s < 0 || s >= TL) continue; row = MC + b * TL + s; }
            else row = b * TC + (kk - nloc);
            float sc = 0.f;
#pragma unroll
            for (int i = 0; i < 8; ++i) { const u32x4 w = *(const u32x4*)(SK + (size_t)row * 128 + g * 64 + 8 * i);
#pragma unroll
                for (int e = 0; e < 4; ++e) sc += q[8 * i + 2 * e] * __uint_as_float(w[e] << 16) + q[8 * i + 2 * e + 1] * __uint_as_float(w[e] & 0xffff0000u); }
            const float mn = fmaxf(mx, sc), corr = __expf(mx - mn), p = __expf(sc - mn);
            l = l * corr + p; mx = mn;
#pragma unroll
            for (int i = 0; i < 8; ++i) { const u32x4 w = *(const u32x4*)(P + (size_t)row * NP + PC_SV + g * 64 + 8 * i);
#pragma unroll
                for (int e = 0; e < 4; ++e) { o[8 * i + 2 * e] = o[8 * i + 2 * e] * corr + p * __uint_as_float(w[e] << 16); o[8 * i + 2 * e + 1] = o[8 * i + 2 * e + 1] * corr + p * __uint_as_float(w[e] & 0xffff0000u); } }
        }
        const float il = 1.0f / l;
#pragma unroll
        for (int i = 0; i < 8; ++i) { u32x4 w;
#pragma unroll
            for (int e = 0; e < 4; ++e) w[e] = pk2(o[8 * i + 2 * e] * il, o[8 * i + 2 * e + 1] * il);
            *(u32x4*)(O + (size_t)m * D + 512 + hq * 64 + 8 * i) = w; }
    }
}


__device__ __forceinline__ f32x4 mfma16(bf16x8 a, bf16x8 b, f32x4 c) { return __builtin_amdgcn_mfma_f32_16x16x32_bf16(a, b, c, 0, 0, 0); }
__device__ __forceinline__ unsigned cvtpk(float lo, float hi) { unsigned r; asm volatile("v_cvt_pk_bf16_f32 %0, %1, %2" : "=v"(r) : "v"(lo), "v"(hi)); return r; }

__device__ __forceinline__ void phase_swa2(Frame& F, const Inputs& in, int layer) {
    const bf16* P = (const bf16*)(F.ws + WS_R1 + R1_P);
    unsigned char* prep = F.ws + WS_R1 + R1_PREP;
    const bf16* SQ = (const bf16*)(prep + PREP_SQ); const bf16* SK = (const bf16*)(prep + PREP_SK);
    bf16* O = (bf16*)(F.ws + WS_R1 + R1_O);
    LAS bf16* Kl = (LAS bf16*)F.lds; LAS bf16* Vt = Kl + 64 * 72;
    const int lane = F.lane, c = lane & 15, q = lane >> 4, w = F.wave;
    const float LOG2E = 1.4426950408889634f;
    const int srow = F.tid >> 3, scol = (F.tid & 7) * 8;
    for (int u = F.bid; u < 544; u += F.G) {
        const bool lat = u < 512; int b, g, qb;
        if (lat) { b = u >> 7; g = (u >> 6) & 1; qb = u & 63; } else { const int uu = u - 512; b = uu >> 3; g = (uu >> 2) & 1; qb = uu & 3; }
        const int hq = 4 * g + (w >> 1), i0 = 32 * (w & 1);
        const int mrow0 = lat ? MC + b * TL + 64 * qb : b * TC + 64 * qb;
        const int kt0 = lat ? (2 - qb > 0 ? 2 - qb : 0) : 0, kt1 = lat ? (65 - qb < 4 ? 65 - qb : 4) : -1, nb = lat ? kt1 - kt0 + 1 : 0, nt = nb + 4;
        const int band0 = MC + b * TL + 64 * qb - 128 + 64 * kt0, ctx0 = b * TC;
        bf16x8 qf[2][2];
#pragma unroll
        for (int ti = 0; ti < 2; ++ti)
#pragma unroll
            for (int ks = 0; ks < 2; ++ks) qf[ti][ks] = *(const bf16x8*)(SQ + (size_t)(mrow0 + i0 + 16 * ti + c) * 512 + hq * 64 + 32 * ks + 8 * q);
        float mrun[2], lrun[2]; f32x4 oacc[4][2];
        const float sk = in.swa_sink[layer * 8 + hq] * LOG2E;
#pragma unroll
        for (int ti = 0; ti < 2; ++ti) { mrun[ti] = sk; lrun[ti] = 1.0f;
#pragma unroll
            for (int te = 0; te < 4; ++te) oacc[te][ti] = (f32x4){0.f, 0.f, 0.f, 0.f}; }
        u32x4 kreg, vreg;
        { const int r0 = (0 < nb) ? band0 : ctx0; kreg = *(const u32x4*)(SK + (size_t)(r0 + srow) * 128 + g * 64 + scol); vreg = *(const u32x4*)(P + (size_t)(r0 + srow) * NP + PC_SV + g * 64 + scol); }
        for (int tt = 0; tt < nt; ++tt) {
            __syncthreads();
            *(LAS u32x4*)(Kl + srow * 72 + scol) = kreg;
#pragma unroll
            for (int x = 0; x < 8; ++x) Vt[(scol + x) * 72 + srow] = (bf16)(vreg[x >> 1] >> (16 * (x & 1)));
            __syncthreads();
            if (tt + 1 < nt) { const int r0 = (tt + 1 < nb) ? band0 + 64 * (tt + 1) : ctx0 + 64 * (tt + 1 - nb);
                kreg = *(const u32x4*)(SK + (size_t)(r0 + srow) * 128 + g * 64 + scol); vreg = *(const u32x4*)(P + (size_t)(r0 + srow) * NP + PC_SV + g * 64 + scol); }
            f32x4 sacc[4][2];
#pragma unroll
            for (int tj = 0; tj < 4; ++tj)
#pragma unroll
                for (int ti = 0; ti < 2; ++ti) sacc[tj][ti] = (f32x4){0.f, 0.f, 0.f, 0.f};
#pragma unroll
            for (int ks = 0; ks < 2; ++ks)
#pragma unroll
                for (int tj = 0; tj < 4; ++tj) { const bf16x8 a = *(const LAS bf16x8*)(Kl + (16 * tj + c) * 72 + 32 * ks + 8 * q);
#pragma unroll
                    for (int ti = 0; ti < 2; ++ti) sacc[tj][ti] = mfma16(a, qf[ti][ks], sacc[tj][ti]); }
            const bool band = tt < nb;
            const int kp0 = 64 * qb - 128 + 64 * (kt0 + tt) + 4 * q;
#pragma unroll
            for (int ti = 0; ti < 2; ++ti) {
                const int qp = 64 * qb + i0 + 16 * ti + c;
                float mx = -30000.0f;
#pragma unroll
                for (int tj = 0; tj < 4; ++tj)
#pragma unroll
                    for (int r = 0; r < 4; ++r) { float s = sacc[tj][ti][r] * (0.125f * LOG2E);
                        if (band) { const int dlt = kp0 + 16 * tj + r - qp; if (dlt > 128 || dlt < -128) s = -30000.0f; }
                        sacc[tj][ti][r] = s; mx = fmaxf(mx, s); }
                mx = fmaxf(mx, __shfl_xor(mx, 16)); mx = fmaxf(mx, __shfl_xor(mx, 32));
                const float mn = fmaxf(mrun[ti], mx), corr = exp2f(mrun[ti] - mn);
                float ls = 0.f;
#pragma unroll
                for (int tj = 0; tj < 4; ++tj)
#pragma unroll
                    for (int r = 0; r < 4; ++r) { const float p = exp2f(sacc[tj][ti][r] - mn); sacc[tj][ti][r] = p; ls += p; }
                ls += __shfl_xor(ls, 16); ls += __shfl_xor(ls, 32);
                lrun[ti] = lrun[ti] * corr + ls; mrun[ti] = mn;
#pragma unroll
                for (int te = 0; te < 4; ++te) oacc[te][ti] *= corr;
            }
#pragma unroll
            for (int ks2 = 0; ks2 < 2; ++ks2) {
                bf16x8 pb[2];
#pragma unroll
                for (int ti = 0; ti < 2; ++ti) { u32x4 t; t.x = cvtpk(sacc[2 * ks2][ti][0], sacc[2 * ks2][ti][1]); t.y = cvtpk(sacc[2 * ks2][ti][2], sacc[2 * ks2][ti][3]);
                    t.z = cvtpk(sacc[2 * ks2 + 1][ti][0], sacc[2 * ks2 + 1][ti][1]); t.w = cvtpk(sacc[2 * ks2 + 1][ti][2], sacc[2 * ks2 + 1][ti][3]); pb[ti] = __builtin_bit_cast(bf16x8, t); }
#pragma unroll
                for (int te = 0; te < 4; ++te) { const u32x2 lo = *(const LAS u32x2*)(Vt + (16 * te + c) * 72 + 32 * ks2 + 4 * q), hi = *(const LAS u32x2*)(Vt + (16 * te + c) * 72 + 32 * ks2 + 16 + 4 * q);
                    const bf16x8 va = __builtin_bit_cast(bf16x8, ((u32x4){lo.x, lo.y, hi.x, hi.y}));
#pragma unroll
                    for (int ti = 0; ti < 2; ++ti) oacc[te][ti] = mfma16(va, pb[ti], oacc[te][ti]); }
            }
        }
#pragma unroll
        for (int ti = 0; ti < 2; ++ti) { const float il = 1.0f / lrun[ti]; bf16* orow = O + (size_t)(mrow0 + i0 + 16 * ti + c) * D + 512 + hq * 64 + 4 * q;
#pragma unroll
            for (int te = 0; te < 4; ++te) { u32x2 wv; wv.x = cvtpk(oacc[te][ti][0] * il, oacc[te][ti][1] * il); wv.y = cvtpk(oacc[te][ti][2] * il, oacc[te][ti][3] * il); *(u32x2*)(orow + 16 * te) = wv; } }
    }
}

__device__ __forceinline__ void phase_finish(Frame& F, const Inputs& in, int layer) {
    const bf16* P = (const bf16*)(F.ws + WS_R1 + R1_P);
    const float* OR = (const float*)(F.ws + WS_R1 + R1_OR); const float* OG = (const float*)(F.ws + WS_R1 + R1_OG);
    bf16* O = (bf16*)(F.ws + WS_R1 + R1_O);
    const int lane = F.lane;
    for (int m = F.gw; m < M; m += F.NGW) {
#pragma unroll
        for (int hh = 0; hh < 4; ++hh) {
            const float o = OR[(size_t)m * 256 + hh * 64 + lane] + OR[(size_t)(M + m) * 256 + hh * 64 + lane];
            const float mu = wave_sum(o) * (1.0f / 64.0f); const float dlt = o - mu; const float var = wave_sum(dlt * dlt) * (1.0f / 64.0f);
            const float g = bf2f(P[(size_t)m * NP + PC_RG + hh * 64 + lane]);
            const float y = dlt * (1.0f / sqrtf(var + EPS)) * in.ret_gn_g[layer * 256 + hh * 64 + lane] * siluf(g);
            O[(size_t)m * D + hh * 64 + lane] = (bf16)f2bf(y);
            const float o2 = OG[(size_t)m * 256 + hh * 64 + lane] + OG[(size_t)(M + m) * 256 + hh * 64 + lane];
            const float ms = wave_sum(o2 * o2) * (1.0f / 64.0f);
            const float z = bf2f(P[(size_t)m * NP + PC_GZ + hh * 64 + lane]);
            const float y2 = o2 * (1.0f / sqrtf(ms + EPS)) * in.gdn_norm_g[layer * 64 + lane] * siluf(z);
            O[(size_t)m * D + 256 + hh * 64 + lane] = (bf16)f2bf(y2);
        }
    }
}

__device__ __forceinline__ void phase_route(Frame& F, int m_lo) {
    if (F.bid != 0) return;
    const int* TKE = (const int*)(F.ws + WS_TKE);
    int* TOKROW = (int*)(F.ws + WS_TOKROW); int* ROWTOK = (int*)(F.ws + WS_ROWTOK); int* TILEE = (int*)(F.ws + WS_TILEE);
    LAS int* cnt = (LAS int*)F.lds;
    LAS int* tot = cnt + 512 * 8;
    const int ntok = M - m_lo, per = (ntok + NTHR - 1) / NTHR;
    const int a0 = m_lo + F.tid * per, a1 = (a0 + per < M) ? a0 + per : M;
    int c[8];
#pragma unroll
    for (int e = 0; e < 8; ++e) c[e] = 0;
    for (int m = a0; m < a1; ++m) { const int e0 = TKE[2 * m], e1 = TKE[2 * m + 1];
#pragma unroll
        for (int e = 0; e < 8; ++e) c[e] += (e0 == e) + (e1 == e); }
#pragma unroll
    for (int e = 0; e < 8; ++e) cnt[F.tid * 8 + e] = c[e];
    __syncthreads();
    if (F.tid < 8) { int run = 0; for (int i = 0; i < NTHR; ++i) { const int v = cnt[i * 8 + F.tid]; cnt[i * 8 + F.tid] = run; run += v; } tot[F.tid] = run; }
    __syncthreads();
    if (F.tid == 0) { int st = 0; for (int e = 0; e < 8; ++e) { tot[8 + e] = st; const int pad = (tot[e] + 255) / 256 * 256;
            for (int tl = st / 256; tl < (st + pad) / 256; ++tl) TILEE[tl] = e; st += pad; }
        TILEE[256] = st / 256; }
    __syncthreads();
    int pos[8];
#pragma unroll
    for (int e = 0; e < 8; ++e) pos[e] = tot[8 + e] + cnt[F.tid * 8 + e];
    for (int m = a0; m < a1; ++m) {
#pragma unroll
        for (int k = 0; k < 2; ++k) { const int ee = TKE[2 * m + k]; int row = 0;
#pragma unroll
            for (int e = 0; e < 8; ++e) if (ee == e) { row = pos[e]; pos[e] = row + 1; }
            ROWTOK[row] = m; TOKROW[2 * m + k] = row; } }
    for (int e = 0; e < 8; ++e) { const int st = tot[8 + e] + tot[e], en = tot[8 + e] + (tot[e] + 255) / 256 * 256; for (int r = st + F.tid; r < en; r += NTHR) ROWTOK[r] = -1; }
}
__device__ __forceinline__ void phase_permute(Frame& F) {
    const int* ROWTOK = (const int*)(F.ws + WS_ROWTOK); const int nrows = ((const int*)(F.ws + WS_TILEE))[256] * 256;
    const bf16* H = (const bf16*)(F.ws + WS_H); bf16* HP = (bf16*)(F.ws + WS_HP);
    for (int r = F.gw; r < nrows; r += F.NGW) { const int tok = ROWTOK[r];
#pragma unroll
        for (int j = 0; j < 2; ++j) { u32x4 v = (u32x4){0u, 0u, 0u, 0u}; if (tok >= 0) v = *(const u32x4*)(H + (size_t)tok * D + 8 * F.lane + 512 * j); *(u32x4*)(HP + (size_t)r * D + 8 * F.lane + 512 * j) = v; } }
}

constexpr int NPH = 12;
constexpr int PH_TOTAL = 1 + DEPTH * NPH + 1;
__host__ __device__ inline bool phase_exists(int ph) {
    if (ph == 0 || ph == PH_TOTAL - 1) return true;
    const int layer = (ph - 1) / NPH, j = (ph - 1) % NPH;
    if (!(layer & 1) && j >= 10) return false;
    return true;
}
__global__ void __launch_bounds__(NTHR, 2) fwd_kernel(Args args) {
    extern __shared__ __attribute__((aligned(16))) unsigned char lds_raw[];
    Frame F;
    F.lds = (LAS unsigned char*)lds_raw;
    F.tid = threadIdx.x; F.lane = F.tid & 63; F.wave = __builtin_amdgcn_readfirstlane(F.tid >> 6);
    F.G = gridDim.x; F.bid = blockIdx.x; F.gw = blockIdx.x * NWAVES + F.wave; F.NGW = F.G * NWAVES; F.ws = args.ws;
    volatile LAS unsigned* MISC = (volatile LAS unsigned*)(F.lds + MISC_OFF);
    LAS unsigned long long* ptab = (LAS unsigned long long*)(F.lds + MISC_OFF + 128);
    if (F.tid < 32) MISC[F.tid] = 0u;
    if (F.tid == 64) { const Inputs& ai = args.in;
        ptab[0] = (unsigned long long)ai.x; ptab[1] = (unsigned long long)ai.c; ptab[2] = (unsigned long long)ai.ctx; ptab[3] = (unsigned long long)ai.c_ctx; ptab[4] = (unsigned long long)ai.ada_w; ptab[5] = (unsigned long long)ai.ada_b;
        ptab[6] = (unsigned long long)ai.norm1_g; ptab[7] = (unsigned long long)ai.w_in; ptab[8] = (unsigned long long)ai.ret_decay; ptab[9] = (unsigned long long)ai.ret_gn_g; ptab[10] = (unsigned long long)ai.gdn_conv_w; ptab[11] = (unsigned long long)ai.gdn_a_log;
        ptab[12] = (unsigned long long)ai.gdn_dt_bias; ptab[13] = (unsigned long long)ai.gdn_norm_g; ptab[14] = (unsigned long long)ai.swa_sink; ptab[15] = (unsigned long long)ai.w_out; ptab[16] = (unsigned long long)ai.norm2_g; ptab[17] = (unsigned long long)ai.ffn_w1;
        ptab[18] = (unsigned long long)ai.ffn_w3; ptab[19] = (unsigned long long)ai.ffn_w2; ptab[20] = (unsigned long long)ai.router_w; ptab[21] = (unsigned long long)ai.moe_w1; ptab[22] = (unsigned long long)ai.moe_w3; ptab[23] = (unsigned long long)ai.moe_w2; ptab[24] = (unsigned long long)ai.final_g; }
    __syncthreads();
    XcdBarrier bar; bar.bar = (unsigned*)(F.ws + WS_CTL) + CW_BAR; bar.x = 0; bar.st = nullptr;
    const int lo = args.ph_lo, hi = args.ph_hi;
    const bool multi = (hi - lo) > 1;
    if (multi) bar = xcd_barrier_post((unsigned*)(F.ws + WS_CTL) + CW_BAR, MISC + 8);
#define LAUNDER() unsigned char* _w = args.ws; asm volatile("" : "+s"(_w)); F.ws = _w; asm volatile("" ::: "memory"); { int _t = threadIdx.x; asm volatile("" : "+v"(_t)); int _b = blockIdx.x; asm volatile("" : "+s"(_b)); F.tid = _t; F.lane = _t & 63; F.wave = __builtin_amdgcn_readfirstlane(_t >> 6); F.bid = _b; F.gw = _b * NWAVES + F.wave; } const Inputs in = load_inputs(ptab)
#define IN(k) (lo <= (k) && (k) < hi)
#define SEAM(k) do { if (IN(k) && IN((k) + 1)) xcd_barrier(bar); } while (0)
    LAS unsigned char* ring = F.lds;

    if (IN(0)) { LAUNDER(); phase_prologue(F, in); } SEAM(0);

    for (int layer = 0; layer < DEPTH; ++layer) {
        const int p0 = 1 + layer * NPH;
        const bool moe = layer & 1;
        if (IN(p0 + 0)) { LAUNDER(); phase_token<0>(F, in, layer, layer == 0, layer > 0 && ((layer - 1) & 1), false, nullptr); if (layer == 2) convert_moe_layer(F, in, 1); }
        SEAM(p0 + 0);
        if (IN(p0 + 1)) { LAUNDER(); pg8::StaticOrder S; S.init(F.ws + WS_H, (bf16*)(F.ws + WS_WIN) + (size_t)layer * NP * D, M, NP, D, F.G, F.bid);
            pg8::EpiBf16 E{(bf16*)(F.ws + WS_R1 + R1_P), NP}; pg8::gemm_phase<pg8::EpiBf16, pg8::StaticOrder>(ring, D, S, E, F.tid); }
        SEAM(p0 + 1);
        if (IN(p0 + 2)) { LAUNDER(); phase_prep(F, in, layer); }
        SEAM(p0 + 2);
        if (IN(p0 + 3)) { LAUNDER(); phase_scans(F, in, layer); }
        SEAM(p0 + 3);
        if (IN(p0 + 4)) { LAUNDER(); phase_swa2(F, in, layer); }
        SEAM(p0 + 4);
        if (IN(p0 + 5)) { LAUNDER(); phase_finish(F, in, layer); }
        SEAM(p0 + 5);
        if (IN(p0 + 6)) { LAUNDER(); pg8::StaticOrder S; S.init(F.ws + WS_R1 + R1_O, (bf16*)(F.ws + WS_WOUT) + (size_t)layer * D * D, M, D, D, F.G, F.bid);
            pg8::EpiResid E{(float*)(F.ws + WS_XS), (const float*)(F.ws + WS_MOD) + (size_t)layer * 5 * 6 * D, 2}; pg8::gemm_phase<pg8::EpiResid, pg8::StaticOrder>(ring, D, S, E, F.tid); }
        SEAM(p0 + 6);
        if (IN(p0 + 7)) { LAUNDER(); phase_token<1>(F, in, layer, false, false, moe, nullptr); }
        SEAM(p0 + 7);
        if (!moe) {
            if (IN(p0 + 8)) { LAUNDER(); pg8::StaticOrder S; S.init(F.ws + WS_H, (bf16*)(F.ws + WS_W13) + (size_t)(layer >> 1) * 2 * FF * D, M, 2 * FF, D, F.G, F.bid);
                pg8::EpiSwiglu E{(bf16*)(F.ws + WS_R1 + R1_HID), FF}; pg8::gemm_phase<pg8::EpiSwiglu, pg8::StaticOrder>(ring, D, S, E, F.tid); }
            SEAM(p0 + 8);
            if (IN(p0 + 9)) { LAUNDER(); pg8::StaticOrder S; S.init(F.ws + WS_R1 + R1_HID, (bf16*)(F.ws + WS_W2) + (size_t)(layer >> 1) * D * FF, M, D, FF, F.G, F.bid);
                pg8::EpiResid E{(float*)(F.ws + WS_XS), (const float*)(F.ws + WS_MOD) + (size_t)layer * 5 * 6 * D, 5}; pg8::gemm_phase<pg8::EpiResid, pg8::StaticOrder>(ring, FF, S, E, F.tid); }
            if (IN(p0 + 9) && IN(p0 + NPH)) xcd_barrier(bar);
        } else {
            if (IN(p0 + 8)) { LAUNDER(); phase_route(F, layer == DEPTH - 1 ? MC : 0); }
            SEAM(p0 + 8);
            if (IN(p0 + 9)) { LAUNDER(); phase_permute(F); }
            SEAM(p0 + 9);
            if (IN(p0 + 10)) { LAUNDER(); const int* tile_e = (const int*)(F.ws + WS_TILEE); const int ntiles = __builtin_amdgcn_readfirstlane(tile_e[256]);
                pg8::GroupedOrder S; S.init(F.ws + WS_HP, F.ws + WS_MW13, ntiles, 2 * EF, D, F.G, F.bid, tile_e);
                pg8::EpiSwiglu E{(bf16*)(F.ws + WS_R1 + R1_HID), EF}; pg8::gemm_phase<pg8::EpiSwiglu, pg8::GroupedOrder>(ring, D, S, E, F.tid); }
            SEAM(p0 + 10);
            if (IN(p0 + 11)) { LAUNDER(); const int* tile_e = (const int*)(F.ws + WS_TILEE); const int ntiles = __builtin_amdgcn_readfirstlane(tile_e[256]);
                pg8::GroupedOrder S; S.init(F.ws + WS_R1 + R1_HID, F.ws + WS_MW2, ntiles, D, EF, F.G, F.bid, tile_e);
                pg8::EpiF32 E{(float*)(F.ws + WS_YM), D}; pg8::gemm_phase<pg8::EpiF32, pg8::GroupedOrder>(ring, EF, S, E, F.tid); }
            SEAM(p0 + 11);
        }
    }
    if (IN(PH_TOTAL - 1)) { LAUNDER(); phase_token<2>(F, in, DEPTH, false, true, false, args.out); }
#undef IN
#undef SEAM
}

extern "C" void kernel_launch(void* const* d_in, const int* in_sizes, int n_in, void* d_out, int out_size, void* d_ws, size_t ws_size, hipStream_t stream) {
    static int grid = 0;
    if (grid == 0) {
        if (n_in != 25 || out_size != ML * D || ws_size < WS_END) { fprintf(stderr, "kernel_launch: unexpected problem: n_in %d out %d ws %zu (need %zu)\n", n_in, out_size, ws_size, (size_t)WS_END); grid = -1; return; }
        int dev = 0, cus = 0, per_cu = 0;
        if (hipGetDevice(&dev) != hipSuccess || hipDeviceGetAttribute(&cus, hipDeviceAttributeMultiprocessorCount, dev) != hipSuccess) { grid = -1; return; }
        if (hipFuncSetAttribute((const void*)fwd_kernel, hipFuncAttributeMaxDynamicSharedMemorySize, LDS_BYTES) != hipSuccess) { fprintf(stderr, "kernel_launch: hipFuncSetAttribute failed\n"); grid = -1; return; }
        if (hipOccupancyMaxActiveBlocksPerMultiprocessor(&per_cu, (const void*)fwd_kernel, NTHR, LDS_BYTES) != hipSuccess || per_cu < 1) fprintf(stderr, "kernel_launch: occupancy query reports %d\n", per_cu);
        (void)hipGetLastError();
        grid = cus;
    }
    if (grid < 0) return;
    (void)hipMemsetAsync((char*)d_ws + WS_CTL, 0, CTL_ZERO_BYTES, stream);
    Args a{};
    const float** ip = (const float**)&a.in;
    for (int i = 0; i < 25; ++i) ip[i] = (const float*)d_in[i];
    a.out = (float*)d_out; a.ws = (unsigned char*)d_ws;
#if MK_ONE_LAUNCH
    a.ph_lo = 0; a.ph_hi = PH_TOTAL;
    hipLaunchKernelGGL(fwd_kernel, dim3(grid), dim3(NTHR), LDS_BYTES, stream, a);
#else
    for (int ph = 0; ph < PH_TOTAL; ++ph) { if (!phase_exists(ph)) continue; a.ph_lo = ph; a.ph_hi = ph + 1;
        hipLaunchKernelGGL(fwd_kernel, dim3(grid), dim3(NTHR), LDS_BYTES, stream, a); }
#endif
}
```

```cpp
#include <hip/hip_runtime.h>
#include <cstdio>
#include <cstdint>

#ifndef MK_ONE_LAUNCH
#define MK_ONE_LAUNCH 1
#endif

#define GAS __attribute__((address_space(1)))
#define LAS __attribute__((address_space(3)))
typedef unsigned short bf16;
typedef short bf16x8 __attribute__((ext_vector_type(8)));
typedef float f32x4 __attribute__((ext_vector_type(4)));
typedef float f32x2 __attribute__((ext_vector_type(2)));
typedef unsigned u32x4 __attribute__((ext_vector_type(4)));
typedef unsigned u32x2 __attribute__((ext_vector_type(2)));

constexpr int D = 1024, NB = 4, TL = 4096, TC = 256, DEPTH = 4;
constexpr int MC = NB * TC, ML = NB * TL, M = MC + ML;
constexpr int INC = 2832, NP = 2816;
constexpr int FF = 2816, EF = 3584, NE = 8;
constexpr int MAXROWS = 36864;
constexpr float EPS = 1e-6f;
constexpr int PC_RQ = 0, PC_RK = 256, PC_RV = 512, PC_RG = 768, PC_GQKV = 1024, PC_GZ = 1792, PC_SQ = 2048, PC_SK = 2560, PC_SV = 2688;

constexpr size_t MiB = 1u << 20;
constexpr size_t WS_CTL = 0, CTL_ZERO_BYTES = 1 * MiB;
constexpr size_t WS_MOD = 1 * MiB;
constexpr size_t WS_ROPE = 2 * MiB;
constexpr size_t WS_TKE = 3 * MiB, WS_TKG = 3 * MiB + 256 * 1024, WS_TOKROW = 3 * MiB + 512 * 1024, WS_ROWTOK = 3 * MiB + 768 * 1024, WS_TILEE = 4 * MiB;
constexpr size_t WS_AB = 5 * MiB, WS_GB = 7 * MiB;
constexpr size_t WS_WIN = 16 * MiB, WS_WOUT = 38 * MiB, WS_W13 = 46 * MiB, WS_W2 = 68 * MiB, WS_MW13 = 80 * MiB, WS_MW2 = 192 * MiB;
constexpr size_t WS_XS = 248 * MiB, WS_H = 316 * MiB, WS_HP = 350 * MiB, WS_YM = 422 * MiB, WS_R1 = 566 * MiB;
constexpr size_t R1_P = 0, R1_PREP = 94 * MiB, R1_O = 158 * MiB, R1_OR = 192 * MiB, R1_OG = 226 * MiB, R1_HID = 0;
constexpr size_t WS_END = WS_R1 + 260 * MiB;
constexpr size_t WS_GCH = WS_YM, GCH_STEP = 40960, GCH_CHAIN = 68 * GCH_STEP, WS_GDEC = WS_HP;
constexpr size_t WS_RKV = WS_YM + 96 * MiB;
constexpr size_t WS_RST = WS_HP + 1 * MiB;
static_assert(32 * GCH_CHAIN <= 144 * MiB, "gdn chunk data");
constexpr size_t PREP_RQ = 0, PREP_RK = (size_t)M * 256 * 2, PREP_SQ = (size_t)M * 512 * 2, PREP_SK = (size_t)M * 1024 * 2, PREP_GD = (size_t)M * 1152 * 2;
static_assert(PREP_GD + (size_t)M * 768 * 2 <= 64 * MiB, "prep");
static_assert((size_t)M * NP * 2 <= 94 * MiB && (size_t)MAXROWS * EF * 2 <= 260 * MiB, "r1");

constexpr int CW_TMO = 0, CW_BAR = 4096;

__device__ __forceinline__ float bf2f(bf16 v) { return __uint_as_float(((unsigned)v) << 16); }
__device__ __forceinline__ unsigned f2bf(float f) { unsigned u = __float_as_uint(f); return (u + 0x7fffu + ((u >> 16) & 1u)) >> 16; }
__device__ __forceinline__ unsigned pk2(float lo, float hi) { return f2bf(lo) | (f2bf(hi) << 16); }
__device__ __forceinline__ float wave_sum(float v) {
#pragma unroll
    for (int o = 1; o < 64; o <<= 1) v += __shfl_xor(v, o);
    return v;
}
__device__ __forceinline__ float siluf(float x) { return x / (1.0f + __expf(-x)); }
#define LDS_WAIT() asm volatile("s_waitcnt lgkmcnt(0)" ::: "memory")

namespace pg8 {
#define PG8_LAS __attribute__((address_space(3)))
constexpr int BM = 256, BK = 64, HALF = 128, HTB = HALF * BK * 2, STAGE_BYTES = 8 * HTB;
__host__ __device__ __forceinline__ int lds_byte(int r, int c) { const int st = (r >> 4) * 2 + (c >> 5), rr = r & 15, cc = c & 31, ob = rr * 64 + cc * 2; return st * 1024 + (ob ^ (((ob >> 9) & 1) << 5)); }
__host__ __device__ __forceinline__ void stage_rc(int b, int& R, int& C) { const int st = b / 1024, sb = b % 1024, swz = sb ^ (((sb >> 9) & 1) << 5); R = (st >> 1) * 16 + swz / 64; C = (st & 1) * 32 + (swz % 64) / 2; }
__host__ __device__ __forceinline__ int perm32(int rho) { const int n = rho >> 4, i = rho & 15; return 8 * (i >> 2) + 4 * n + (i & 3); }
struct Unit { int pm, pn, aux; const char* A; const char* B; };
__device__ __forceinline__ unsigned cvt_pk_bf16(float lo, float hi) { unsigned r; asm volatile("v_cvt_pk_bf16_f32 %0, %1, %2" : "=v"(r) : "v"(lo), "v"(hi)); return r; }

template <class Epi, class Sched, bool ALIGN_EPI = true, bool SP2 = true>
__device__ __forceinline__ void gemm_phase(PG8_LAS unsigned char* lds, const int K, const Sched& S, const Epi& E, const int tid) {
    const int wid = __builtin_amdgcn_readfirstlane(tid >> 6), lane = tid & 63, wr = wid >> 2, wc = wid & 3, fr = lane & 15, fq = lane >> 4;
    const int nt = K / BK;
    unsigned voffA[2], voffB[2];
#pragma unroll
    for (int i = 0; i < 2; ++i) { int R, C; stage_rc(tid * 16 + i * 8192, R, C); const int Rb = Epi::PERM ? ((R & ~31) + perm32(R & 31)) : R;
        voffA[i] = (unsigned)(R * K + C) * 2u; voffB[i] = (unsigned)(Rb * K + C) * 2u; }
    const size_t kstep = (size_t)(BK * 2);
    const size_t hstep = (size_t)HALF * K * 2;
    const unsigned ldsw = (unsigned)wid * 1024u;
    const int aoff = lds_byte(wr * 64 + fr, fq * 8), boff = lds_byte(wc * 32 + fr, fq * 8);
#define PG8_SA(b, h) (((b) * 2 + (h)) * HTB)
#define PG8_SB(b, h) ((4 + (b) * 2 + (h)) * HTB)
#define PG8_STAGE(bufoff, gbase, voff) do { _Pragma("unroll") for (int _i = 0; _i < 2; ++_i) \
        __builtin_amdgcn_global_load_lds((const unsigned*)((const char*)(gbase) + (voff)[_i]), (PG8_LAS unsigned*)(lds + (bufoff) + ldsw + _i * 8192), 16, 0, 0); } while (0)
#define PG8_LDA(dst, b, h) do { _Pragma("unroll") for (int m = 0; m < 4; ++m) _Pragma("unroll") for (int k = 0; k < 2; ++k) dst[m][k] = *(const PG8_LAS bf16x8*)(lds + PG8_SA(b, h) + aoff + m * 2048 + k * 1024); } while (0)
#define PG8_LDB(dst, b, h) do { _Pragma("unroll") for (int n = 0; n < 2; ++n) _Pragma("unroll") for (int k = 0; k < 2; ++k) dst[n][k] = *(const PG8_LAS bf16x8*)(lds + PG8_SB(b, h) + boff + n * 2048 + k * 1024); } while (0)
#define PG8_MMA(ai, bj, At, Bt) do { __builtin_amdgcn_s_setprio(1); _Pragma("unroll") for (int m = 0; m < 4; ++m) _Pragma("unroll") for (int n = 0; n < 2; ++n) _Pragma("unroll") for (int k = 0; k < 2; ++k) \
        acc[ai][bj][m][n] = __builtin_amdgcn_mfma_f32_16x16x32_bf16(Bt[n][k], At[m][k], acc[ai][bj][m][n], 0, 0, 0); __builtin_amdgcn_s_setprio(0); } while (0)
#define PG8_WAIT_V(n) asm volatile("s_waitcnt vmcnt(" #n ")" ::: "memory")
#define PG8_WAIT_L(n) asm volatile("s_waitcnt lgkmcnt(" #n ")" ::: "memory")
#define PG8_BAR __builtin_amdgcn_s_barrier()
#define PG8_SCHED __builtin_amdgcn_sched_barrier(0)
    Unit cur, nxt; int ui = 0;
    if (!S.next(0, cur)) return;
    f32x4 acc[2][2][4][2];
#pragma unroll
    for (int a = 0; a < 2; ++a)
#pragma unroll
        for (int b = 0; b < 2; ++b)
#pragma unroll
            for (int m = 0; m < 4; ++m)
#pragma unroll
                for (int n = 0; n < 2; ++n) acc[a][b][m][n] = (f32x4){0.f, 0.f, 0.f, 0.f};
    bf16x8 At[4][2], B0[2][2], B1[2][2];
    const char* cA = cur.A; const char* cB = cur.B;
    if constexpr (SP2) {
        PG8_STAGE(PG8_SB(0, 0), cB, voffB); PG8_STAGE(PG8_SB(0, 1), cB + hstep, voffB); PG8_STAGE(PG8_SA(0, 0), cA, voffA); PG8_STAGE(PG8_SA(0, 1), cA + hstep, voffA);
        if (wr == 1) PG8_BAR;
        PG8_WAIT_V(2); PG8_BAR;
        PG8_STAGE(PG8_SB(1, 0), cB + kstep, voffB); PG8_STAGE(PG8_SA(1, 0), cA + kstep, voffA); PG8_STAGE(PG8_SB(1, 1), cB + hstep + kstep, voffB);
        PG8_WAIT_V(6); PG8_BAR;
    } else {
        PG8_STAGE(PG8_SB(0, 0), cB, voffB); PG8_STAGE(PG8_SA(0, 0), cA, voffA); PG8_STAGE(PG8_SB(0, 1), cB + hstep, voffB); PG8_STAGE(PG8_SA(0, 1), cA + hstep, voffA);
        if (wr == 1) PG8_BAR;
        PG8_WAIT_V(4); PG8_BAR;
        PG8_STAGE(PG8_SB(1, 0), cB + kstep, voffB); PG8_STAGE(PG8_SA(1, 0), cA + kstep, voffA); PG8_STAGE(PG8_SB(1, 1), cB + hstep + kstep, voffB);
        PG8_WAIT_V(6); PG8_BAR;
    }
    for (;;) {
        const bool has_next = S.next(ui + 1, nxt);
        const char* nA = has_next ? nxt.A : cA; const char* nB = has_next ? nxt.B : cB;
        for (int t = 0; t < nt; t += 2) {
            const bool last = (t == nt - 2);
            const char* a1 = cA + (size_t)(t + 1) * kstep;
            const char* a2 = last ? nA : cA + (size_t)(t + 2) * kstep; const char* b2 = last ? nB : cB + (size_t)(t + 2) * kstep;
            const char* a3 = a2 + kstep; const char* b3 = b2 + kstep;
            if constexpr (SP2) {
            PG8_LDB(B0, 0, 0); PG8_LDB(B1, 0, 1); PG8_SCHED; PG8_LDA(At, 0, 0); PG8_STAGE(PG8_SA(1, 1), a1 + hstep, voffA);
            PG8_WAIT_V(8); PG8_WAIT_L(0); PG8_BAR; PG8_MMA(0, 0, At, B0); PG8_MMA(0, 1, At, B1); PG8_BAR; PG8_SCHED;
            PG8_LDA(At, 0, 1); PG8_STAGE(PG8_SB(0, 0), b2, voffB); PG8_STAGE(PG8_SB(0, 1), b2 + hstep, voffB); PG8_STAGE(PG8_SA(0, 0), a2, voffA);
            PG8_WAIT_V(8); PG8_WAIT_L(0); PG8_BAR; PG8_MMA(1, 0, At, B0); PG8_MMA(1, 1, At, B1); PG8_BAR; PG8_SCHED;
            PG8_LDB(B0, 1, 0); PG8_LDB(B1, 1, 1); PG8_SCHED; PG8_LDA(At, 1, 0); PG8_STAGE(PG8_SA(0, 1), a2 + hstep, voffA);
            PG8_WAIT_V(8); PG8_WAIT_L(0); PG8_BAR; PG8_MMA(0, 0, At, B0); PG8_MMA(0, 1, At, B1); PG8_BAR; PG8_SCHED;
            PG8_LDA(At, 1, 1); PG8_STAGE(PG8_SB(1, 0), b3, voffB); PG8_STAGE(PG8_SB(1, 1), b3 + hstep, voffB); PG8_STAGE(PG8_SA(1, 0), a3, voffA);
            PG8_WAIT_V(8); PG8_WAIT_L(0); PG8_BAR; PG8_MMA(1, 0, At, B0); PG8_MMA(1, 1, At, B1); PG8_BAR; PG8_SCHED;
            } else {
            PG8_LDB(B0, 0, 0); PG8_SCHED; PG8_LDA(At, 0, 0); PG8_STAGE(PG8_SA(1, 1), a1 + hstep, voffA);
            PG8_WAIT_L(8); PG8_BAR; PG8_WAIT_L(0); PG8_MMA(0, 0, At, B0); PG8_BAR; PG8_SCHED;
            PG8_LDB(B1, 0, 1); PG8_STAGE(PG8_SB(0, 0), b2, voffB);
            PG8_BAR; PG8_WAIT_L(0); PG8_MMA(0, 1, At, B1); PG8_BAR;
            PG8_LDA(At, 0, 1); PG8_STAGE(PG8_SA(0, 0), a2, voffA);
            PG8_BAR; PG8_WAIT_L(0); PG8_MMA(1, 0, At, B0); PG8_BAR; PG8_SCHED;
            PG8_STAGE(PG8_SB(0, 1), b2 + hstep, voffB);
            PG8_WAIT_V(6); PG8_BAR; PG8_MMA(1, 1, At, B1); PG8_BAR;
            PG8_LDB(B0, 1, 0); PG8_SCHED; PG8_LDA(At, 1, 0); PG8_STAGE(PG8_SA(0, 1), a2 + hstep, voffA);
            PG8_WAIT_L(8); PG8_BAR; PG8_WAIT_L(0); PG8_MMA(0, 0, At, B0); PG8_BAR; PG8_SCHED;
            PG8_LDB(B1, 1, 1); PG8_STAGE(PG8_SB(1, 0), b3, voffB);
            PG8_BAR; PG8_WAIT_L(0); PG8_MMA(0, 1, At, B1); PG8_BAR;
            PG8_LDA(At, 1, 1); PG8_STAGE(PG8_SA(1, 0), a3, voffA);
            PG8_BAR; PG8_WAIT_L(0); PG8_MMA(1, 0, At, B0); PG8_BAR; PG8_SCHED;
            PG8_STAGE(PG8_SB(1, 1), b3 + hstep, voffB);
            PG8_WAIT_V(6); PG8_BAR; PG8_MMA(1, 1, At, B1); PG8_BAR;
            }
        }
        if constexpr (ALIGN_EPI) { if (wr == 0) PG8_BAR; }
        E(acc, cur, wr, wc, fr, fq);
        if (!has_next) break;
#pragma unroll
        for (int a = 0; a < 2; ++a)
#pragma unroll
            for (int b = 0; b < 2; ++b)
#pragma unroll
                for (int m = 0; m < 4; ++m)
#pragma unroll
                    for (int n = 0; n < 2; ++n) acc[a][b][m][n] = (f32x4){0.f, 0.f, 0.f, 0.f};
        cur = nxt; cA = nA; cB = nB; ++ui;
        if constexpr (ALIGN_EPI) { if (wr == 1) PG8_BAR; }
    }
    PG8_WAIT_V(0);
    if constexpr (!ALIGN_EPI) { if (wr == 0) PG8_BAR; }
    PG8_BAR;
#undef PG8_SA
#undef PG8_SB
#undef PG8_STAGE
#undef PG8_LDA
#undef PG8_LDB
#undef PG8_MMA
#undef PG8_WAIT_V
#undef PG8_WAIT_L
#undef PG8_BAR
#undef PG8_SCHED
}

struct StaticOrder {
    int nM, nN, nwg, G, c; const char* A; const char* Bt; size_t tstep;
    __device__ void init(const void* A_, const void* Bt_, int M_, int N_, int K_, int G_, int c_) { A = (const char*)A_; Bt = (const char*)Bt_; nM = M_ / BM; nN = N_ / BM; nwg = nM * nN; G = G_; c = c_; tstep = (size_t)BM * K_ * 2; }
    __device__ bool next(int i, Unit& u) const {
        const long L = (long)i * G + c; if (L >= nwg) return false;
        int wgid = (int)L; { const int q = nwg / 8, r = nwg % 8, xcd = wgid % 8, off = wgid / 8; wgid = (xcd < r ? xcd * (q + 1) : r * (q + 1) + (xcd - r) * q) + off; }
        const int nig = 8 * nN, gid = wgid / nig, fm = gid * 8, gsz = (nM - fm) < 8 ? (nM - fm) : 8;
        u.pm = fm + ((wgid % nig) % gsz); u.pn = (wgid % nig) / gsz; u.aux = 0;
        u.A = A + (size_t)u.pm * tstep; u.B = Bt + (size_t)u.pn * tstep; return true;
    }
};
struct GroupedOrder {
    int nM, nN, nwg, G, c; const char* A; const char* Bt; size_t tstep, estep; const int* tile_e;
    __device__ void init(const void* A_, const void* Bt_, int ntiles, int N_, int K_, int G_, int c_, const int* te) { A = (const char*)A_; Bt = (const char*)Bt_; nM = ntiles; nN = N_ / BM; nwg = nM * nN; G = G_; c = c_; tstep = (size_t)BM * K_ * 2; estep = (size_t)N_ * K_ * 2; tile_e = te; }
    __device__ bool next(int i, Unit& u) const {
        const long L = (long)i * G + c; if (L >= nwg) return false;
        u.pm = (int)(L / nN); u.pn = (int)(L % nN); u.aux = __builtin_amdgcn_readfirstlane(tile_e[u.pm]);
        u.A = A + (size_t)u.pm * tstep; u.B = Bt + (size_t)u.aux * estep + (size_t)u.pn * tstep; return true;
    }
};

struct EpiBf16 {
    static constexpr bool PERM = true;
    bf16* O; int ldc;
    __device__ __forceinline__ void operator()(const f32x4 (&acc)[2][2][4][2], const Unit& u, int wr, int wc, int fr, int fq) const {
        const int row0 = u.pm * BM + wr * 64 + fr, col0 = u.pn * BM + wc * 32 + 8 * fq;
#pragma unroll
        for (int ai = 0; ai < 2; ++ai)
#pragma unroll
            for (int m = 0; m < 4; ++m) { bf16* rowp = O + (size_t)(row0 + ai * HALF + m * 16) * ldc + col0;
#pragma unroll
                for (int bj = 0; bj < 2; ++bj) { const f32x4 v0 = acc[ai][bj][m][0], v1 = acc[ai][bj][m][1];
                    u32x4 w; w.x = cvt_pk_bf16(v0[0], v0[1]); w.y = cvt_pk_bf16(v0[2], v0[3]); w.z = cvt_pk_bf16(v1[0], v1[1]); w.w = cvt_pk_bf16(v1[2], v1[3]);
                    *(u32x4*)(rowp + bj * HALF) = w; } }
    }
};
struct EpiResid {
    static constexpr bool PERM = false;
    float* X; const float* mod; int gsel;
    __device__ __forceinline__ void operator()(const f32x4 (&acc)[2][2][4][2], const Unit& u, int wr, int wc, int fr, int fq) const {
        const int row0 = u.pm * BM + wr * 64 + fr, col0 = u.pn * BM + wc * 32 + 4 * fq;
        const int r = u.pm < 4 ? 4 : ((u.pm - 4) >> 4);
        const float* g = mod + (size_t)r * 6 * D + gsel * D;
        f32x4 gv[2][2];
#pragma unroll
        for (int bj = 0; bj < 2; ++bj)
#pragma unroll
            for (int n = 0; n < 2; ++n) gv[bj][n] = *(const f32x4*)(g + col0 + bj * HALF + n * 16);
#pragma unroll
        for (int ai = 0; ai < 2; ++ai)
#pragma unroll
            for (int m = 0; m < 4; ++m) { float* rowp = X + (size_t)(row0 + ai * HALF + m * 16) * D + col0;
#pragma unroll
                for (int bj = 0; bj < 2; ++bj)
#pragma unroll
                    for (int n = 0; n < 2; ++n) { f32x4 x = *(f32x4*)(rowp + bj * HALF + n * 16); x += gv[bj][n] * acc[ai][bj][m][n]; *(f32x4*)(rowp + bj * HALF + n * 16) = x; } }
    }
};
struct EpiSwiglu {
    static constexpr bool PERM = false;
    bf16* Hd; int ldh;
    __device__ __forceinline__ void operator()(const f32x4 (&acc)[2][2][4][2], const Unit& u, int wr, int wc, int fr, int fq) const {
        const int row0 = u.pm * BM + wr * 64 + fr, col0 = u.pn * 128 + wc * 16 + 4 * fq;
#pragma unroll
        for (int ai = 0; ai < 2; ++ai)
#pragma unroll
            for (int m = 0; m < 4; ++m) { bf16* rowp = Hd + (size_t)(row0 + ai * HALF + m * 16) * ldh + col0;
#pragma unroll
                for (int bj = 0; bj < 2; ++bj) { const f32x4 a = acc[ai][bj][m][0], b = acc[ai][bj][m][1];
                    float h[4];
#pragma unroll
                    for (int j = 0; j < 4; ++j) h[j] = a[j] / (1.0f + __expf(-a[j])) * b[j];
                    u32x2 w; w.x = cvt_pk_bf16(h[0], h[1]); w.y = cvt_pk_bf16(h[2], h[3]);
                    *(u32x2*)(rowp + bj * 64) = w; } }
    }
};
struct EpiF32 {
    static constexpr bool PERM = false;
    float* C; int ldc;
    __device__ __forceinline__ void operator()(const f32x4 (&acc)[2][2][4][2], const Unit& u, int wr, int wc, int fr, int fq) const {
        const int row0 = u.pm * BM + wr * 64 + fr, col0 = u.pn * BM + wc * 32 + 4 * fq;
#pragma unroll
        for (int ai = 0; ai < 2; ++ai)
#pragma unroll
            for (int m = 0; m < 4; ++m) { float* rowp = C + (size_t)(row0 + ai * HALF + m * 16) * ldc + col0;
#pragma unroll
                for (int bj = 0; bj < 2; ++bj)
#pragma unroll
                    for (int n = 0; n < 2; ++n) *(f32x4*)(rowp + bj * HALF + n * 16) = acc[ai][bj][m][n]; }
    }
};
}

#define XB_TMO      128
#define XB_XCNT(j)  (256  + 64 * (j))
#define XB_XSUB(j)  (1280 + 64 * (j))
#define XB_XGEN(j)  (2304 + 64 * (j))
#define XB_TOP      3328
#define XB_TOPGEN   3392
#define XCD_BAR_WORDS 3456
#define XB_SPIN_CAP (1u << 22)
__device__ __forceinline__ unsigned xb_ld(unsigned* p)              { return __hip_atomic_load(p, __ATOMIC_RELAXED, __HIP_MEMORY_SCOPE_AGENT); }
__device__ __forceinline__ unsigned xb_add(unsigned* p, unsigned v) { return __hip_atomic_fetch_add(p, v, __ATOMIC_RELAXED, __HIP_MEMORY_SCOPE_AGENT); }
__device__ __forceinline__ unsigned xb_xcc_id() { return (unsigned)__builtin_amdgcn_s_getreg((3 << 11) | 20) & 0xFu; }
#define XB_SPIN(cond, bar) do { unsigned _sp = 0; while (cond) { __builtin_amdgcn_s_sleep(1); \
    if ((++_sp & 255u) == 0u) { if (xb_ld(&(bar)[XB_TMO])) break; if (_sp > XB_SPIN_CAP) { atomicAdd(&(bar)[XB_TMO], 1u); break; } } } } while (0)
struct XcdBarrier { unsigned* bar; unsigned x; volatile LAS unsigned* st; };
__device__ __forceinline__ XcdBarrier xcd_barrier_post(unsigned* bar, volatile LAS unsigned* st) {
    XcdBarrier b; b.bar = bar; b.x = xb_xcc_id(); b.st = st;
    if (threadIdx.x == 0) (void)xb_add(&bar[XB_XCNT(b.x)], 1u);
    return b;
}
__device__ __forceinline__ void xcd_barrier_complete(unsigned* bar, unsigned x, unsigned& nloc, unsigned& nx) {
    const unsigned G = gridDim.x * gridDim.y * gridDim.z;
    unsigned sum, cnt, mine, sp = 0u;
    for (;;) {
        sum = 0u; cnt = 0u; mine = 0u;
#pragma unroll
        for (unsigned j = 0; j < 16; ++j) { const unsigned c = xb_ld(&bar[XB_XCNT(j)]); sum += c; cnt += (c > 0u) ? 1u : 0u; mine = (j == x) ? c : mine; }
        if (sum == G) break;
        __builtin_amdgcn_s_sleep(1);
        if ((++sp & 255u) == 0u) { if (xb_ld(&bar[XB_TMO])) break; if (sp > XB_SPIN_CAP) { atomicAdd(&bar[XB_TMO], 1u); break; } }
    }
    nloc = mine > 0u ? mine : 1u; nx = cnt > 0u ? cnt : 1u;
}
__device__ __forceinline__ void xcd_barrier(const XcdBarrier& b) {
    asm volatile("s_waitcnt vmcnt(0)" ::: "memory");
    __syncthreads();
    if (threadIdx.x == 0) {
        unsigned* bar = b.bar; unsigned bx = b.x;
        asm volatile("" : "+s"(bar), "+s"(bx));
        __builtin_amdgcn_s_waitcnt(0);
        unsigned nloc = b.st[0], nx = b.st[1];
        if (nloc == 0u) { xcd_barrier_complete(bar, bx, nloc, nx); b.st[0] = nloc; b.st[1] = nx; }
        const unsigned old = xb_add(&bar[XB_XSUB(bx)], 1u);
        const unsigned gen = old / nloc;
        if (old + 1u == (gen + 1u) * nloc) {
            __builtin_amdgcn_fence(__ATOMIC_RELEASE, "agent");
            asm volatile("s_waitcnt vmcnt(0)" ::: "memory");
            const unsigned og = xb_add(&bar[XB_TOP], 1u);
            const unsigned tg = og / nx;
            if (og + 1u == (tg + 1u) * nx) xb_add(&bar[XB_TOPGEN], 1u);
            else XB_SPIN(xb_ld(&bar[XB_TOPGEN]) == tg, bar);
            __builtin_amdgcn_fence(__ATOMIC_ACQUIRE, "agent");
            xb_add(&bar[XB_XGEN(bx)], 1u);
            asm volatile("s_waitcnt vmcnt(0)" ::: "memory");
        } else {
            XB_SPIN(xb_ld(&bar[XB_XGEN(bx)]) == gen, bar);
            __builtin_amdgcn_fence(__ATOMIC_ACQUIRE, "agent");
            asm volatile("s_waitcnt vmcnt(0)" ::: "memory");
        }
    }
    __syncthreads();
}

constexpr int NWAVES = 8, NTHR = 512;
constexpr int RING_BYTES = 131072, MISC_OFF = RING_BYTES + 320, LDS_BYTES = 147456;

struct Inputs {
    const float *x, *c, *ctx, *c_ctx, *ada_w, *ada_b, *norm1_g, *w_in, *ret_decay, *ret_gn_g, *gdn_conv_w, *gdn_a_log, *gdn_dt_bias, *gdn_norm_g, *swa_sink, *w_out, *norm2_g,
        *ffn_w1, *ffn_w3, *ffn_w2, *router_w, *moe_w1, *moe_w3, *moe_w2, *final_g;
};
struct Args { Inputs in; float* out; unsigned char* ws; int ph_lo, ph_hi; };
static_assert(sizeof(Args) == 25 * 8 + 8 + 8 + 8, "no padding");


__device__ __forceinline__ const float* ld_ptr(const LAS unsigned long long* t, int i) { const unsigned long long v = t[i]; const unsigned lo = __builtin_amdgcn_readfirstlane((unsigned)v), hi = __builtin_amdgcn_readfirstlane((unsigned)(v >> 32)); return (const float*)(((unsigned long long)hi << 32) | lo); }
__device__ __forceinline__ Inputs load_inputs(const LAS unsigned long long* t) {
    Inputs in; const float** ip = (const float**)&in;
#pragma unroll
    for (int i = 0; i < 25; ++i) ip[i] = ld_ptr(t, i);
    return in;
}
struct Frame {
    LAS unsigned char* lds;
    int tid, lane, wave, G, gw, NGW, bid;
    unsigned char* ws;
};

template <class SrcF>
__device__ __forceinline__ void transpose_item(const SrcF& src, int K, bf16* WT, LAS float* scr, int k0, int n0, int lane) {
#pragma unroll 8
    for (int i = 0; i < 32; ++i) { const int kk = 2 * i + (lane >> 5); scr[kk * 33 + (lane & 31)] = src(k0 + kk, n0 + (lane & 31)); }
    LDS_WAIT(); asm volatile("" ::: "memory");
    const int c = lane & 7;
#pragma unroll
    for (int j = 0; j < 4; ++j) { const int n = (lane >> 3) + 8 * j; const LAS float* s = scr + (8 * c) * 33 + n;
        u32x4 o; o.x = pk2(s[0 * 33], s[1 * 33]); o.y = pk2(s[2 * 33], s[3 * 33]); o.z = pk2(s[4 * 33], s[5 * 33]); o.w = pk2(s[6 * 33], s[7 * 33]);
        *(u32x4*)(WT + (size_t)(n0 + n) * K + k0 + 8 * c) = o; }
    LDS_WAIT(); asm volatile("" ::: "memory");
}
struct SrcPlain { const float* W; int ld; __device__ __forceinline__ float operator()(int k, int n) const { return W[(size_t)k * ld + n]; } };
struct SrcWin { const float* W; __device__ __forceinline__ float operator()(int k, int n) const { return W[(size_t)k * INC + (n < 2048 ? n : n + 16)]; } };
struct SrcGU { const float* W1; const float* W3; int ld; __device__ __forceinline__ float operator()(int k, int n) const { const int g = n >> 5, i = n & 31; const ptrdiff_t d = (i < 16) ? (ptrdiff_t)0 : (W3 - W1); return W1[d + (ptrdiff_t)k * ld + 16 * g + (i & 15)]; } };

__device__ __forceinline__ void convert_moe_layer(Frame& F, const Inputs& in, int mi) {
    LAS float* scr = (LAS float*)(F.lds + F.wave * 16384);
    bf16* mw13 = (bf16*)(F.ws + WS_MW13); bf16* mw2 = (bf16*)(F.ws + WS_MW2);
    constexpr int I13 = (D / 64) * (2 * EF / 32), I2 = (EF / 64) * (D / 32);
    for (int it = F.gw; it < NE * (I13 + I2); it += F.NGW) {
        const int e = it / (I13 + I2); int r = it % (I13 + I2);
        const size_t wo = ((size_t)mi * NE + e) * (size_t)D * EF;
        if (r < I13) { const int nblk = 2 * EF / 32; SrcGU s{in.moe_w1 + wo, in.moe_w3 + wo, EF}; transpose_item(s, D, mw13 + (size_t)e * 2 * EF * D, scr, 64 * (r / nblk), 32 * (r % nblk), F.lane); }
        else { r -= I13; const int nblk = D / 32; SrcPlain s{in.moe_w2 + wo, D}; transpose_item(s, EF, mw2 + (size_t)e * D * EF, scr, 64 * (r / nblk), 32 * (r % nblk), F.lane); }
    }
}

__device__ __forceinline__ void phase_prologue(Frame& F, const Inputs& in) {
    LAS float* scr = (LAS float*)(F.lds + F.wave * 16384);
    {
        constexpr int I_IN = (D / 64) * (NP / 32), I_OUT = (D / 64) * (D / 32), I_13 = (D / 64) * (2 * FF / 32), I_2 = (FF / 64) * (D / 32);
        constexpr int PER_L = I_IN + I_OUT, PER_F = I_13 + I_2, TOT = DEPTH * PER_L + 2 * PER_F;
        for (int it = F.gw; it < TOT; it += F.NGW) {
            if (it < DEPTH * PER_L) { const int l = it / PER_L; int r = it % PER_L;
                if (r < I_IN) { const int nblk = NP / 32; SrcWin s{in.w_in + (size_t)l * D * INC}; transpose_item(s, D, (bf16*)(F.ws + WS_WIN) + (size_t)l * NP * D, scr, 64 * (r / nblk), 32 * (r % nblk), F.lane); }
                else { r -= I_IN; const int nblk = D / 32; SrcPlain s{in.w_out + (size_t)l * D * D, D}; transpose_item(s, D, (bf16*)(F.ws + WS_WOUT) + (size_t)l * D * D, scr, 64 * (r / nblk), 32 * (r % nblk), F.lane); }
            } else { const int q = it - DEPTH * PER_L; const int i = q / PER_F; int r = q % PER_F;
                if (r < I_13) { const int nblk = 2 * FF / 32; SrcGU s{in.ffn_w1 + (size_t)i * D * FF, in.ffn_w3 + (size_t)i * D * FF, FF}; transpose_item(s, D, (bf16*)(F.ws + WS_W13) + (size_t)i * 2 * FF * D, scr, 64 * (r / nblk), 32 * (r % nblk), F.lane); }
                else { r -= I_13; const int nblk = D / 32; SrcPlain s{in.ffn_w2 + (size_t)i * FF * D, D}; transpose_item(s, FF, (bf16*)(F.ws + WS_W2) + (size_t)i * D * FF, scr, 64 * (r / nblk), 32 * (r % nblk), F.lane); }
            }
        }
    }
    convert_moe_layer(F, in, 0);
    {
        __syncthreads();
        LAS float* sc = (LAS float*)F.lds;
        LAS float* red = (LAS float*)(F.lds + 32768);
        for (int i = F.tid; i < 5 * D; i += NTHR) { const int r = i / D, k = i % D; const float v = r < 4 ? in.c[r * D + k] : in.c_ctx[k]; sc[i] = siluf(v); }
        __syncthreads();
        float* mod = (float*)(F.ws + WS_MOD);
        for (int u = F.bid; u < DEPTH * 96; u += F.G) {
            const int l = u / 96, n = (u % 96) * 64 + F.lane;
            const float* w = in.ada_w + (size_t)l * D * 6 * D + n;
            float a[5] = {0.f, 0.f, 0.f, 0.f, 0.f};
            for (int k = F.wave * 128; k < F.wave * 128 + 128; ++k) { const float wv = w[(size_t)k * 6 * D];
#pragma unroll
                for (int r = 0; r < 5; ++r) a[r] += sc[r * D + k] * wv; }
#pragma unroll
            for (int r = 0; r < 5; ++r) red[(F.wave * 5 + r) * 64 + F.lane] = a[r];
            __syncthreads();
            if (F.tid < 320) { const int r = F.tid / 64, ln = F.tid % 64; float s = 0.f;
#pragma unroll
                for (int w8 = 0; w8 < 8; ++w8) s += red[(w8 * 5 + r) * 64 + ln];
                const int nn = (u % 96) * 64 + ln;
                mod[((size_t)l * 5 + r) * 6 * D + nn] = s + in.ada_b[(size_t)l * 6 * D + nn]; }
            __syncthreads();
        }
    }
    if (F.bid == 0) { float* rp = (float*)(F.ws + WS_ROPE);
        for (int i = F.tid; i < 64 * 16; i += NTHR) { const int pos = i / 16, fi = i % 16; const double inv = pow(10000.0, -(double)fi / 16.0), ang = (double)pos * inv; rp[2 * i] = (float)cos(ang); rp[2 * i + 1] = (float)sin(ang); } }
}

__device__ __forceinline__ int mod_row(int m) { return m < MC ? 4 : ((m - MC) >> 12); }

template <int MODE>
__device__ __forceinline__ void phase_token(Frame& F, const Inputs& in, int layer, bool first_from_input, bool combine_moe, bool moe_router, float* out) {
    float* XS = (float*)(F.ws + WS_XS);
    bf16* H = (bf16*)(F.ws + WS_H);
    const float* mod = (const float*)(F.ws + WS_MOD) + (size_t)(layer < DEPTH ? layer : DEPTH - 1) * 5 * 6 * D;
    const float* modprev = (const float*)(F.ws + WS_MOD) + (size_t)(layer > 0 ? layer - 1 : 0) * 5 * 6 * D;
    const int* TKE = (const int*)(F.ws + WS_TKE); const float* TKG = (const float*)(F.ws + WS_TKG); const int* TOKROW = (const int*)(F.ws + WS_TOKROW);
    const float* YM = (const float*)(F.ws + WS_YM);
    LAS float* wl = (LAS float*)F.lds;
    if (MODE == 0) { __syncthreads(); const float* w = in.w_in + (size_t)layer * D * INC + 2048; for (int i = F.tid; i < D * 16; i += NTHR) { const int k = i >> 4, c = i & 15, kp = ((k >> 8) * 4 + (k & 3)) * 64 + ((k >> 2) & 63); wl[((c >> 2) * 1024 + kp) * 4 + (c & 3)] = w[(size_t)k * INC + c]; } __syncthreads(); }
    if (MODE == 1 && moe_router) { __syncthreads(); const float* w = in.router_w + (size_t)(layer >> 1) * D * NE; for (int i = F.tid; i < D * NE; i += NTHR) { const int k = i >> 3, c = i & 7, kp = ((k >> 8) * 4 + (k & 3)) * 64 + ((k >> 2) & 63); wl[((c >> 2) * 1024 + kp) * 4 + (c & 3)] = w[i]; } __syncthreads(); }
    const float* gain = MODE == 0 ? in.norm1_g + (size_t)layer * D : (MODE == 1 ? in.norm2_g + (size_t)layer * D : in.final_g);
    const int m_lo = (MODE == 2) ? MC : 0;
    for (int m = m_lo + F.gw; m < M; m += F.NGW) {
        const int r = mod_row(m);
        f32x4 v[4];
        const float* xrow = first_from_input ? (m < MC ? in.ctx + (size_t)m * D : in.x + (size_t)(m - MC) * D) : XS + (size_t)m * D;
#pragma unroll
        for (int j = 0; j < 4; ++j) v[j] = *(const f32x4*)(xrow + 4 * F.lane + 256 * j);
        bool wrote = first_from_input;
        if (combine_moe && !(layer == DEPTH && m < MC)) {
            const int r0 = TOKROW[2 * m], r1 = TOKROW[2 * m + 1]; const float g0 = TKG[2 * m], g1 = TKG[2 * m + 1];
            const float* gt = modprev + (size_t)r * 6 * D + 5 * D;
#pragma unroll
            for (int j = 0; j < 4; ++j) { const f32x4 y0 = *(const f32x4*)(YM + (size_t)r0 * D + 4 * F.lane + 256 * j), y1 = *(const f32x4*)(YM + (size_t)r1 * D + 4 * F.lane + 256 * j);
                const f32x4 gg = *(const f32x4*)(gt + 4 * F.lane + 256 * j); v[j] += gg * (g0 * y0 + g1 * y1); }
            wrote = true;
        }
        if (wrote && MODE != 2) {
#pragma unroll
            for (int j = 0; j < 4; ++j) *(f32x4*)(XS + (size_t)m * D + 4 * F.lane + 256 * j) = v[j];
        }
        float ss = 0.f;
#pragma unroll
        for (int j = 0; j < 4; ++j) ss += (v[j].x * v[j].x + v[j].y * v[j].y) + (v[j].z * v[j].z + v[j].w * v[j].w);
        const float rstd = 1.0f / sqrtf(wave_sum(ss) * (1.0f / D) + EPS);
        if (MODE == 2) {
#pragma unroll
            for (int j = 0; j < 4; ++j) { const f32x4 g = *(const f32x4*)(gain + 4 * F.lane + 256 * j); *(f32x4*)(out + (size_t)(m - MC) * D + 4 * F.lane + 256 * j) = v[j] * rstd * g; }
            continue;
        }
        const float* sh = mod + (size_t)r * 6 * D + (MODE == 0 ? 0 : 3) * D; const float* scl = sh + D;
        f32x4 h[4];
#pragma unroll
        for (int j = 0; j < 4; ++j) { const f32x4 g = *(const f32x4*)(gain + 4 * F.lane + 256 * j), s1 = *(const f32x4*)(scl + 4 * F.lane + 256 * j), s0 = *(const f32x4*)(sh + 4 * F.lane + 256 * j);
            h[j] = v[j] * rstd * g * (1.0f + s1) + s0;
            u32x2 w; w.x = pk2(h[j].x, h[j].y); w.y = pk2(h[j].z, h[j].w); *(u32x2*)(H + (size_t)m * D + 4 * F.lane + 256 * j) = w; }
        if (MODE == 0) {
            float a[16];
#pragma unroll
            for (int c = 0; c < 16; ++c) a[c] = 0.f;
#pragma unroll
            for (int j = 0; j < 4; ++j)
#pragma unroll
                for (int e = 0; e < 4; ++e) { const int kp = (j * 4 + e) * 64 + F.lane; const float hv = h[j][e];
#pragma unroll
                    for (int q = 0; q < 4; ++q) { const f32x4 w = *(const LAS f32x4*)(wl + (q * 1024 + kp) * 4); a[4 * q] += hv * w.x; a[4 * q + 1] += hv * w.y; a[4 * q + 2] += hv * w.z; a[4 * q + 3] += hv * w.w; } }
            float mine = 0.f;
#pragma unroll
            for (int c = 0; c < 16; ++c) { const float s = wave_sum(a[c]); mine = (F.lane == c) ? s : mine; }
            if (F.lane < 16) ((float*)(F.ws + WS_AB))[(size_t)m * 16 + F.lane] = mine;
        }
        if (MODE == 1 && moe_router) {
            float a[8];
#pragma unroll
            for (int c = 0; c < 8; ++c) a[c] = 0.f;
#pragma unroll
            for (int j = 0; j < 4; ++j)
#pragma unroll
                for (int e = 0; e < 4; ++e) { const int kp = (j * 4 + e) * 64 + F.lane; const float hv = h[j][e];
#pragma unroll
                    for (int q = 0; q < 2; ++q) { const f32x4 w = *(const LAS f32x4*)(wl + (q * 1024 + kp) * 4); a[4 * q] += hv * w.x; a[4 * q + 1] += hv * w.y; a[4 * q + 2] += hv * w.z; a[4 * q + 3] += hv * w.w; } }
#pragma unroll
            for (int c = 0; c < 8; ++c) a[c] = wave_sum(a[c]);
            int i0 = 0; float l0 = a[0];
#pragma unroll
            for (int c = 1; c < 8; ++c) if (a[c] > l0) { l0 = a[c]; i0 = c; }
            int i1 = -1; float l1 = -3.0e38f;
#pragma unroll
            for (int c = 0; c < 8; ++c) if (c != i0 && a[c] > l1) { l1 = a[c]; i1 = c; }
            const float e1 = __expf(l1 - l0), g0 = 1.0f / (1.0f + e1), g1 = e1 / (1.0f + e1);
            if (F.lane == 0) { ((int*)(F.ws + WS_TKE))[2 * m] = i0; ((int*)(F.ws + WS_TKE))[2 * m + 1] = i1; ((float*)(F.ws + WS_TKG))[2 * m] = g0; ((float*)(F.ws + WS_TKG))[2 * m + 1] = g1; }
        }
    }
    (void)TKE;
}

__device__ __forceinline__ void phase_prep(Frame& F, const Inputs& in, int layer) {
    const bf16* P = (const bf16*)(F.ws + WS_R1 + R1_P);
    unsigned char* prep = F.ws + WS_R1 + R1_PREP;
    bf16* RQ = (bf16*)(prep + PREP_RQ); bf16* RK = (bf16*)(prep + PREP_RK); bf16* SQ = (bf16*)(prep + PREP_SQ); bf16* SK = (bf16*)(prep + PREP_SK); bf16* GD = (bf16*)(prep + PREP_GD);
    const float* rope = (const float*)(F.ws + WS_ROPE);
    const float* AB = (const float*)(F.ws + WS_AB); float* GB = (float*)(F.ws + WS_GB);
    const float* cw = in.gdn_conv_w + (size_t)layer * 5 * 768;
    const int lane = F.lane;
    for (int m = F.gw; m < M; m += F.NGW) {
        const bool lat = m >= MC; const int t = lat ? ((m - MC) & (TL - 1)) : (m & (TC - 1)); const int Tn = lat ? TL : TC;
        const bf16* prow = P + (size_t)m * NP;
        float cs = 1.f, sn = 0.f;
        if (lat) { const int j = lane & 31; const int pos = j < 16 ? (t >> 6) : (t & 63); const int fi = j & 15; cs = rope[(pos * 16 + fi) * 2]; sn = rope[(pos * 16 + fi) * 2 + 1]; if (lane < 32) sn = -sn; }
#pragma unroll
        for (int hh = 0; hh < 4; ++hh) { const float q = bf2f(prow[PC_RQ + hh * 64 + lane]), k = bf2f(prow[PC_RK + hh * 64 + lane]) * 0.125f;
            const float qp = __shfl_xor(q, 32), kp = __shfl_xor(k, 32);
            RQ[(size_t)m * 256 + hh * 64 + lane] = (bf16)f2bf(q * cs + qp * sn); RK[(size_t)m * 256 + hh * 64 + lane] = (bf16)f2bf(k * cs + kp * sn); }
#pragma unroll
        for (int hq = 0; hq < 8; ++hq) { const float q = bf2f(prow[PC_SQ + hq * 64 + lane]); const float qp = __shfl_xor(q, 32); SQ[(size_t)m * 512 + hq * 64 + lane] = (bf16)f2bf(q * cs + qp * sn); }
#pragma unroll
        for (int g = 0; g < 2; ++g) { const float k = bf2f(prow[PC_SK + g * 64 + lane]); const float kp = __shfl_xor(k, 32); SK[(size_t)m * 128 + g * 64 + lane] = (bf16)f2bf(k * cs + kp * sn); }
#pragma unroll
        for (int s = 0; s < 12; ++s) { const int c = s * 64 + lane; float y = 0.f;
#pragma unroll
            for (int j = 0; j < 5; ++j) { const int tt = t + j - 2; if (tt >= 0 && tt < Tn) y += cw[j * 768 + c] * bf2f(prow[(ptrdiff_t)(j - 2) * NP + PC_GQKV + c]); }
            y = siluf(y);
            if (s < 8) { const float n2 = wave_sum(y * y); y = y * (1.0f / sqrtf(n2 + EPS)); if (s < 4) y *= 0.125f; }
            GD[(size_t)m * 768 + c] = (bf16)f2bf(y); }
        if (lane < 16) { const int dh = lane & 7; const float a = AB[(size_t)m * 16 + lane];
            float o;
            if (lane < 8) { const float xx = a + in.gdn_dt_bias[layer * 8 + dh]; const float sp = fmaxf(xx, 0.f) + log1pf(__expf(-fabsf(xx))); o = -__expf(in.gdn_a_log[layer * 8 + dh]) * sp; }
            else o = 1.0f / (1.0f + __expf(-a));
            GB[(size_t)m * 16 + lane] = o; }
    }
}

__device__ __forceinline__ int scan_row(int b, int dir, int tau) {
    if (tau < TC) { const int c = dir ? TC - 1 - tau : tau; return b * TC + c; }
    const int tt = tau - TC; const int t = dir ? TL - 1 - tt : tt; return MC + b * TL + t;
}
__device__ __forceinline__ void phase_scans(Frame& F, const Inputs& in, int layer, int nscan) {
    if (F.wave != 0 || F.bid >= nscan) return;
    const int id = F.bid; const bool gdn = id >= 32; const int sid = id & 31; const int b = sid >> 3, hh = (sid >> 1) & 3, dir = sid & 1;
    const bf16* P = (const bf16*)(F.ws + WS_R1 + R1_P);
    unsigned char* prep = F.ws + WS_R1 + R1_PREP;
    const bf16* RQ = (const bf16*)(prep + PREP_RQ); const bf16* RK = (const bf16*)(prep + PREP_RK); const bf16* GD = (const bf16*)(prep + PREP_GD);
    const float* GB = (const float*)(F.ws + WS_GB);
    float* OUT = (float*)(F.ws + WS_R1 + (gdn ? R1_OG : R1_OR)) + (size_t)dir * M * 256;
    LAS float* lk = (LAS float*)F.lds; LAS float* lq = lk + 64 * 64; LAS float* lg = lq + 64 * 64;
    const int lane = F.lane;
    float S[64];
#pragma unroll
    for (int i = 0; i < 64; ++i) S[i] = 0.f;
    const float gamma = gdn ? 0.f : __expf(-__expf(in.ret_decay[layer * 8 + dir * 4 + hh]));
    for (int t0 = 0; t0 < TC + TL; t0 += 64) {
        for (int i = 0; i < 64; ++i) { const int m = scan_row(b, dir, t0 + i);
            if (gdn) { lq[i * 64 + lane] = bf2f(GD[(size_t)m * 768 + hh * 64 + lane]); lk[i * 64 + lane] = bf2f(GD[(size_t)m * 768 + 256 + hh * 64 + lane]); if (lane < 2) lg[i * 2 + lane] = GB[(size_t)m * 16 + lane * 8 + dir * 4 + hh]; }
            else { lq[i * 64 + lane] = bf2f(RQ[(size_t)m * 256 + hh * 64 + lane]); lk[i * 64 + lane] = bf2f(RK[(size_t)m * 256 + hh * 64 + lane]); } }
        LDS_WAIT(); asm volatile("" ::: "memory");
        for (int i = 0; i < 64; ++i) { const int m = scan_row(b, dir, t0 + i);
            float o = 0.f;
            if (gdn) {
                const float v = bf2f(GD[(size_t)m * 768 + 512 + hh * 64 + lane]); const float a = __expf(lg[i * 2]), beta = lg[i * 2 + 1];
                float ks = 0.f;
#pragma unroll
                for (int d4 = 0; d4 < 16; ++d4) { const f32x4 kv = *(const LAS f32x4*)(lk + i * 64 + 4 * d4); ks += kv.x * S[4 * d4] + kv.y * S[4 * d4 + 1] + kv.z * S[4 * d4 + 2] + kv.w * S[4 * d4 + 3]; }
                const float vn = beta * (v - a * ks);
#pragma unroll
                for (int d4 = 0; d4 < 16; ++d4) { const f32x4 kv = *(const LAS f32x4*)(lk + i * 64 + 4 * d4), qv = *(const LAS f32x4*)(lq + i * 64 + 4 * d4);
                    S[4 * d4] = a * S[4 * d4] + kv.x * vn; S[4 * d4 + 1] = a * S[4 * d4 + 1] + kv.y * vn; S[4 * d4 + 2] = a * S[4 * d4 + 2] + kv.z * vn; S[4 * d4 + 3] = a * S[4 * d4 + 3] + kv.w * vn;
                    o += qv.x * S[4 * d4] + qv.y * S[4 * d4 + 1] + qv.z * S[4 * d4 + 2] + qv.w * S[4 * d4 + 3]; }
            } else {
                const float v = bf2f(P[(size_t)m * NP + PC_RV + hh * 64 + lane]);
#pragma unroll
                for (int d4 = 0; d4 < 16; ++d4) { const f32x4 kv = *(const LAS f32x4*)(lk + i * 64 + 4 * d4), qv = *(const LAS f32x4*)(lq + i * 64 + 4 * d4);
                    S[4 * d4] = gamma * S[4 * d4] + kv.x * v; S[4 * d4 + 1] = gamma * S[4 * d4 + 1] + kv.y * v; S[4 * d4 + 2] = gamma * S[4 * d4 + 2] + kv.z * v; S[4 * d4 + 3] = gamma * S[4 * d4 + 3] + kv.w * v;
                    o += qv.x * S[4 * d4] + qv.y * S[4 * d4 + 1] + qv.z * S[4 * d4 + 2] + qv.w * S[4 * d4 + 3]; }
            }
            OUT[(size_t)m * 256 + hh * 64 + lane] = o;
        }
        LDS_WAIT(); asm volatile("" ::: "memory");
    }
}

__device__ __forceinline__ void phase_swa(Frame& F, const Inputs& in, int layer) {
    const bf16* P = (const bf16*)(F.ws + WS_R1 + R1_P);
    unsigned char* prep = F.ws + WS_R1 + R1_PREP;
    const bf16* SQ = (const bf16*)(prep + PREP_SQ); const bf16* SK = (const bf16*)(prep + PREP_SK);
    bf16* O = (bf16*)(F.ws + WS_R1 + R1_O);
    const int NT = F.G * NTHR;
    for (int idx = F.bid * NTHR + F.tid; idx < M * 8; idx += NT) {
        const int hq = idx / M, m = idx % M, g = hq >> 2;
        const bool lat = m >= MC; const int b = lat ? ((m - MC) >> 12) : (m >> 8); const int t = lat ? ((m - MC) & (TL - 1)) : (m & (TC - 1));
        float q[64], o[64];
#pragma unroll
        for (int i = 0; i < 8; ++i) { const u32x4 w = *(const u32x4*)(SQ + (size_t)m * 512 + hq * 64 + 8 * i);
#pragma unroll
            for (int e = 0; e < 4; ++e) { q[8 * i + 2 * e] = __uint_as_float(w[e] << 16) * 0.125f; q[8 * i + 2 * e + 1] = __uint_as_float(w[e] & 0xffff0000u) * 0.125f; } }
#pragma unroll
        for (int i = 0; i < 64; ++i) o[i] = 0.f;
        float mx = in.swa_sink[layer * 8 + hq], l = 1.0f;
        const int nloc = lat ? 257 : 0;
        for (int kk = 0; kk < nloc + TC; ++kk) {
            int row;
            if (kk < nloc) { const int s = t - 128 + kk; if (s < 0 || s >= TL) continue; row = MC + b * TL + s; }
            else row = b * TC + (kk - nloc);
            float sc = 0.f;
#pragma unroll
            for (int i = 0; i < 8; ++i) { const u32x4 w = *(const u32x4*)(SK + (size_t)row * 128 + g * 64 + 8 * i);
#pragma unroll
                for (int e = 0; e < 4; ++e) sc += q[8 * i + 2 * e] * __uint_as_float(w[e] << 16) + q[8 * i + 2 * e + 1] * __uint_as_float(w[e] & 0xffff0000u); }
            const float mn = fmaxf(mx, sc), corr = __expf(mx - mn), p = __expf(sc - mn);
            l = l * corr + p; mx = mn;
#pragma unroll
            for (int i = 0; i < 8; ++i) { const u32x4 w = *(const u32x4*)(P + (size_t)row * NP + PC_SV + g * 64 + 8 * i);
#pragma unroll
                for (int e = 0; e < 4; ++e) { o[8 * i + 2 * e] = o[8 * i + 2 * e] * corr + p * __uint_as_float(w[e] << 16); o[8 * i + 2 * e + 1] = o[8 * i + 2 * e + 1] * corr + p * __uint_as_float(w[e] & 0xffff0000u); } }
        }
        const float il = 1.0f / l;
#pragma unroll
        for (int i = 0; i < 8; ++i) { u32x4 w;
#pragma unroll
            for (int e = 0; e < 4; ++e) w[e] = pk2(o[8 * i + 2 * e] * il, o[8 * i + 2 * e + 1] * il);
            *(u32x4*)(O + (size_t)m * D + 512 + hq * 64 + 8 * i) = w; }
    }
}


__device__ __forceinline__ f32x4 mfma16(bf16x8 a, bf16x8 b, f32x4 c) { return __builtin_amdgcn_mfma_f32_16x16x32_bf16(a, b, c, 0, 0, 0); }
__device__ __forceinline__ unsigned cvtpk(float lo, float hi) { unsigned r; asm volatile("v_cvt_pk_bf16_f32 %0, %1, %2" : "=v"(r) : "v"(lo), "v"(hi)); return r; }

__device__ __forceinline__ void phase_swa2(Frame& F, const Inputs& in, int layer) {
    const bf16* P = (const bf16*)(F.ws + WS_R1 + R1_P);
    unsigned char* prep = F.ws + WS_R1 + R1_PREP;
    const bf16* SQ = (const bf16*)(prep + PREP_SQ); const bf16* SK = (const bf16*)(prep + PREP_SK);
    bf16* O = (bf16*)(F.ws + WS_R1 + R1_O);
    LAS bf16* Kl = (LAS bf16*)F.lds; LAS bf16* Vt = Kl + 64 * 72;
    const int lane = F.lane, c = lane & 15, q = lane >> 4, w = F.wave;
    const float LOG2E = 1.4426950408889634f;
    const int srow = F.tid >> 3, scol = (F.tid & 7) * 8;
    for (int u = F.bid; u < 544; u += F.G) {
        const bool lat = u < 512; int b, g, qb;
        if (lat) { b = u >> 7; g = (u >> 6) & 1; qb = u & 63; } else { const int uu = u - 512; b = uu >> 3; g = (uu >> 2) & 1; qb = uu & 3; }
        const int hq = 4 * g + (w >> 1), i0 = 32 * (w & 1);
        const int mrow0 = lat ? MC + b * TL + 64 * qb : b * TC + 64 * qb;
        const int kt0 = lat ? (2 - qb > 0 ? 2 - qb : 0) : 0, kt1 = lat ? (65 - qb < 4 ? 65 - qb : 4) : -1, nb = lat ? kt1 - kt0 + 1 : 0, nt = nb + 4;
        const int band0 = MC + b * TL + 64 * qb - 128 + 64 * kt0, ctx0 = b * TC;
        bf16x8 qf[2][2];
#pragma unroll
        for (int ti = 0; ti < 2; ++ti)
#pragma unroll
            for (int ks = 0; ks < 2; ++ks) qf[ti][ks] = *(const bf16x8*)(SQ + (size_t)(mrow0 + i0 + 16 * ti + c) * 512 + hq * 64 + 32 * ks + 8 * q);
        float mrun[2], lrun[2]; f32x4 oacc[4][2];
        const float sk = in.swa_sink[layer * 8 + hq] * LOG2E;
#pragma unroll
        for (int ti = 0; ti < 2; ++ti) { mrun[ti] = sk; lrun[ti] = 1.0f;
#pragma unroll
            for (int te = 0; te < 4; ++te) oacc[te][ti] = (f32x4){0.f, 0.f, 0.f, 0.f}; }
        u32x4 kreg, vreg;
        { const int r0 = (0 < nb) ? band0 : ctx0; kreg = *(const u32x4*)(SK + (size_t)(r0 + srow) * 128 + g * 64 + scol); vreg = *(const u32x4*)(P + (size_t)(r0 + srow) * NP + PC_SV + g * 64 + scol); }
        for (int tt = 0; tt < nt; ++tt) {
            __syncthreads();
            *(LAS u32x4*)(Kl + srow * 72 + scol) = kreg;
#pragma unroll
            for (int x = 0; x < 8; ++x) Vt[(scol + x) * 72 + srow] = (bf16)(vreg[x >> 1] >> (16 * (x & 1)));
            __syncthreads();
            if (tt + 1 < nt) { const int r0 = (tt + 1 < nb) ? band0 + 64 * (tt + 1) : ctx0 + 64 * (tt + 1 - nb);
                kreg = *(const u32x4*)(SK + (size_t)(r0 + srow) * 128 + g * 64 + scol); vreg = *(const u32x4*)(P + (size_t)(r0 + srow) * NP + PC_SV + g * 64 + scol); }
            f32x4 sacc[4][2];
#pragma unroll
            for (int tj = 0; tj < 4; ++tj)
#pragma unroll
                for (int ti = 0; ti < 2; ++ti) sacc[tj][ti] = (f32x4){0.f, 0.f, 0.f, 0.f};
#pragma unroll
            for (int ks = 0; ks < 2; ++ks)
#pragma unroll
                for (int tj = 0; tj < 4; ++tj) { const bf16x8 a = *(const LAS bf16x8*)(Kl + (16 * tj + c) * 72 + 32 * ks + 8 * q);
#pragma unroll
                    for (int ti = 0; ti < 2; ++ti) sacc[tj][ti] = mfma16(a, qf[ti][ks], sacc[tj][ti]); }
            const bool band = tt < nb;
            const int kp0 = 64 * qb - 128 + 64 * (kt0 + tt) + 4 * q;
#pragma unroll
            for (int ti = 0; ti < 2; ++ti) {
                const int qp = 64 * qb + i0 + 16 * ti + c;
                float mx = -30000.0f;
#pragma unroll
                for (int tj = 0; tj < 4; ++tj)
#pragma unroll
                    for (int r = 0; r < 4; ++r) { float s = sacc[tj][ti][r] * (0.125f * LOG2E);
                        if (band) { const int dlt = kp0 + 16 * tj + r - qp; if (dlt > 128 || dlt < -128) s = -30000.0f; }
                        sacc[tj][ti][r] = s; mx = fmaxf(mx, s); }
                mx = fmaxf(mx, __shfl_xor(mx, 16)); mx = fmaxf(mx, __shfl_xor(mx, 32));
                const float mn = fmaxf(mrun[ti], mx), corr = exp2f(mrun[ti] - mn);
                float ls = 0.f;
#pragma unroll
                for (int tj = 0; tj < 4; ++tj)
#pragma unroll
                    for (int r = 0; r < 4; ++r) { const float p = exp2f(sacc[tj][ti][r] - mn); sacc[tj][ti][r] = p; ls += p; }
                ls += __shfl_xor(ls, 16); ls += __shfl_xor(ls, 32);
                lrun[ti] = lrun[ti] * corr + ls; mrun[ti] = mn;
#pragma unroll
                for (int te = 0; te < 4; ++te) oacc[te][ti] *= corr;
            }
#pragma unroll
            for (int ks2 = 0; ks2 < 2; ++ks2) {
                bf16x8 pb[2];
#pragma unroll
                for (int ti = 0; ti < 2; ++ti) { u32x4 t; t.x = cvtpk(sacc[2 * ks2][ti][0], sacc[2 * ks2][ti][1]); t.y = cvtpk(sacc[2 * ks2][ti][2], sacc[2 * ks2][ti][3]);
                    t.z = cvtpk(sacc[2 * ks2 + 1][ti][0], sacc[2 * ks2 + 1][ti][1]); t.w = cvtpk(sacc[2 * ks2 + 1][ti][2], sacc[2 * ks2 + 1][ti][3]); pb[ti] = __builtin_bit_cast(bf16x8, t); }
#pragma unroll
                for (int te = 0; te < 4; ++te) { const u32x2 lo = *(const LAS u32x2*)(Vt + (16 * te + c) * 72 + 32 * ks2 + 4 * q), hi = *(const LAS u32x2*)(Vt + (16 * te + c) * 72 + 32 * ks2 + 16 + 4 * q);
                    const bf16x8 va = __builtin_bit_cast(bf16x8, ((u32x4){lo.x, lo.y, hi.x, hi.y}));
#pragma unroll
                    for (int ti = 0; ti < 2; ++ti) oacc[te][ti] = mfma16(va, pb[ti], oacc[te][ti]); }
            }
        }
#pragma unroll
        for (int ti = 0; ti < 2; ++ti) { const float il = 1.0f / lrun[ti]; bf16* orow = O + (size_t)(mrow0 + i0 + 16 * ti + c) * D + 512 + hq * 64 + 4 * q;
#pragma unroll
            for (int te = 0; te < 4; ++te) { u32x2 wv; wv.x = cvtpk(oacc[te][ti][0] * il, oacc[te][ti][1] * il); wv.y = cvtpk(oacc[te][ti][2] * il, oacc[te][ti][3] * il); *(u32x2*)(orow + 16 * te) = wv; } }
    }
}


__device__ __forceinline__ void phase_gdn_local(Frame& F) {
    unsigned char* prep = F.ws + WS_R1 + R1_PREP;
    const bf16* GD = (const bf16*)(prep + PREP_GD); const float* GB = (const float*)(F.ws + WS_GB);
    LAS bf16* Qs = (LAS bf16*)F.lds; LAS bf16* Ks = Qs + 64 * 72; LAS bf16* Vs = Ks + 64 * 72;
    LAS float* At = (LAS float*)(F.lds + 27648);
    LAS bf16* ATs = (LAS bf16*)(F.lds + 60416);
    LAS bf16* XS_ = (LAS bf16*)(F.lds + 78848);
    LAS float* sm = (LAS float*)(F.lds + 115712);
    LAS float* gl = sm; LAS float* bl = sm + 128; LAS float* gcs = sm + 256; LAS float* eg = sm + 384; LAS float* ekd = sm + 512;
    const int lane = F.lane, c = lane & 15, q = lane >> 4, w = F.wave, tid = F.tid;
    for (int uu = F.bid; uu < 16 * 68; uu += F.G) {
        const int bh = uu / 68, ch = uu % 68, b = bh >> 2, hh = bh & 3;
        const int m0 = ch < 4 ? b * TC + 64 * ch : MC + b * TL + 64 * (ch - 4);
        __syncthreads();
        { const int row = tid >> 3, col8 = (tid & 7) * 8; const bf16* src = GD + (size_t)(m0 + row) * 768 + hh * 64 + col8;
          *(LAS u32x4*)(Qs + row * 72 + col8) = *(const u32x4*)(src); *(LAS u32x4*)(Ks + row * 72 + col8) = *(const u32x4*)(src + 256); *(LAS u32x4*)(Vs + row * 72 + col8) = *(const u32x4*)(src + 512);
          if (tid < 256) { const int tok = tid & 63, which = tid >> 6; sm[which * 64 + tok] = GB[(size_t)(m0 + tok) * 16 + (which >> 1) * 8 + (which & 1) * 4 + hh]; } }
        __syncthreads();
        if (w < 2) { const int d = w; const int tok = d ? 63 - lane : lane; float v = gl[d * 64 + tok];
#pragma unroll
            for (int o = 1; o < 64; o <<= 1) { const float t = __shfl_up(v, o); if (lane >= o) v += t; }
            const float last = __shfl(v, 63);
            gcs[d * 64 + lane] = v; eg[d * 64 + lane] = __expf(v); ekd[d * 64 + lane] = __expf(last - v); }
        __syncthreads();
        {
            const int type = w >> 2, ti = w & 3; const LAS bf16* X = type ? Qs : Ks;
            bf16x8 a[2];
#pragma unroll
            for (int ks = 0; ks < 2; ++ks) a[ks] = *(const LAS bf16x8*)(X + (16 * ti + c) * 72 + 32 * ks + 8 * q);
#pragma unroll
            for (int tj = 0; tj < 4; ++tj) { f32x4 acc = (f32x4){0.f, 0.f, 0.f, 0.f};
#pragma unroll
                for (int ks = 0; ks < 2; ++ks) acc = mfma16(a[ks], *(const LAS bf16x8*)(Ks + (16 * tj + c) * 72 + 32 * ks + 8 * q), acc);
#pragma unroll
                for (int r = 0; r < 4; ++r) { const int it = 16 * ti + 4 * q + r, jt = 16 * tj + c;
#pragma unroll
                    for (int d = 0; d < 2; ++d) { const int i = d ? 63 - it : it, j = d ? 63 - jt : jt;
                        const float e = __expf(fminf(gcs[d * 64 + i] - gcs[d * 64 + j], 0.f));
                        if (type == 0) At[d * 4096 + j * 64 + i] = (j < i) ? bl[d * 64 + it] * acc[r] * e : 0.f;
                        else ATs[d * 4608 + i * 72 + j] = (bf16)f2bf((j <= i) ? acc[r] * e : 0.f); } } }
        }
        __syncthreads();
        if (w < 4) {
            const int d = w >> 1, kind = w & 1; const LAS bf16* R = kind ? Ks : Vs; const LAS float* A = At + d * 4096;
            float x[64];
#pragma unroll
            for (int i = 0; i < 64; ++i) { const int tok = d ? 63 - i : i; float v = bl[d * 64 + tok] * bf2f(R[tok * 72 + lane]); if (kind) v *= eg[d * 64 + i]; x[i] = v; }
#pragma unroll
            for (int j = 0; j < 63; ++j) { const float xj = x[j];
#pragma unroll
                for (int i4 = ((j + 1) & ~3); i4 < 64; i4 += 4) { const f32x4 av = *(const LAS f32x4*)(A + j * 64 + i4);
                    x[i4] -= av.x * xj; x[i4 + 1] -= av.y * xj; x[i4 + 2] -= av.z * xj; x[i4 + 3] -= av.w * xj; } }
            LAS bf16* XO = XS_ + (d * 2 + kind) * 4608;
#pragma unroll
            for (int i = 0; i < 64; ++i) XO[i * 72 + lane] = (bf16)f2bf(x[i]);
        } else {
            const int t2 = tid - 256;
            for (int it = t2; it < 6 * 512; it += 256) { const int mat = it >> 9, chk = it & 511, d = mat & 1, kindm = mat >> 1;
                const int rt = chk >> 7, ks = (chk >> 6) & 1, ln = chk & 63, r = ln & 15, qq = ln >> 4, row = 16 * rt + r, c0 = 32 * ks + 4 * qq;
                float v[8];
                if (kindm == 0) { const u32x2 lo = *(const LAS u32x2*)(ATs + d * 4608 + row * 72 + c0), hi = *(const LAS u32x2*)(ATs + d * 4608 + row * 72 + c0 + 16);
                    v[0] = __uint_as_float(lo.x << 16); v[1] = __uint_as_float(lo.x & 0xffff0000u); v[2] = __uint_as_float(lo.y << 16); v[3] = __uint_as_float(lo.y & 0xffff0000u);
                    v[4] = __uint_as_float(hi.x << 16); v[5] = __uint_as_float(hi.x & 0xffff0000u); v[6] = __uint_as_float(hi.y << 16); v[7] = __uint_as_float(hi.y & 0xffff0000u); }
                else if (kindm == 1) { const int tok = d ? 63 - row : row; const float sc = eg[d * 64 + row];
#pragma unroll
                    for (int x8 = 0; x8 < 8; ++x8) v[x8] = bf2f(Qs[tok * 72 + c0 + (x8 & 3) + 16 * (x8 >> 2)]) * sc; }
                else {
#pragma unroll
                    for (int x8 = 0; x8 < 8; ++x8) { const int i = c0 + (x8 & 3) + 16 * (x8 >> 2); const int tok = d ? 63 - i : i; v[x8] = bf2f(Ks[tok * 72 + row]) * ekd[d * 64 + i]; } }
                const int chain = bh * 2 + d, sg = ch < 4 ? (d ? 3 - ch : ch) : 4 + (d ? 63 - (ch - 4) : ch - 4);
                unsigned char* dst = F.ws + WS_GCH + (size_t)chain * GCH_CHAIN + (size_t)sg * GCH_STEP + (kindm == 0 ? 16384 : (kindm == 1 ? 8192 : 24576));
                u32x4 o; o.x = pk2(v[0], v[1]); o.y = pk2(v[2], v[3]); o.z = pk2(v[4], v[5]); o.w = pk2(v[6], v[7]);
                *(u32x4*)(dst + chk * 16) = o; }
        }
        __syncthreads();
        {
            for (int it = tid; it < 2 * 512; it += NTHR) { const int d = it >> 9, chk = it & 511;
                const int rt = chk >> 7, ks = (chk >> 6) & 1, ln = chk & 63, r = ln & 15, qq = ln >> 4, row = 16 * rt + r, c0 = 32 * ks + 4 * qq;
                const LAS bf16* XW = XS_ + (d * 2 + 1) * 4608;
                const u32x2 lo = *(const LAS u32x2*)(XW + row * 72 + c0), hi = *(const LAS u32x2*)(XW + row * 72 + c0 + 16);
                const int chain = bh * 2 + d, sg = ch < 4 ? (d ? 3 - ch : ch) : 4 + (d ? 63 - (ch - 4) : ch - 4);
                unsigned char* dst = F.ws + WS_GCH + (size_t)chain * GCH_CHAIN + (size_t)sg * GCH_STEP;
                *(u32x4*)(dst + chk * 16) = (u32x4){lo.x, lo.y, hi.x, hi.y}; }
            for (int it = tid; it < 2 * 1024; it += NTHR) { const int d = it >> 10, cu = it & 1023;
                const int sl = cu >> 8, rt = (cu >> 6) & 3, ln = cu & 63, qq = ln >> 4, cc = ln & 15;
                const LAS bf16* XU = XS_ + (d * 2) * 4608;
                bf16 e0 = XU[(16 * rt + 4 * qq + 0) * 72 + 16 * sl + cc], e1 = XU[(16 * rt + 4 * qq + 1) * 72 + 16 * sl + cc], e2 = XU[(16 * rt + 4 * qq + 2) * 72 + 16 * sl + cc], e3 = XU[(16 * rt + 4 * qq + 3) * 72 + 16 * sl + cc];
                const int chain = bh * 2 + d, sg = ch < 4 ? (d ? 3 - ch : ch) : 4 + (d ? 63 - (ch - 4) : ch - 4);
                unsigned char* dst = F.ws + WS_GCH + (size_t)chain * GCH_CHAIN + (size_t)sg * GCH_STEP + 32768;
                *(u32x2*)(dst + cu * 8) = (u32x2){(unsigned)e0 | ((unsigned)e1 << 16), (unsigned)e2 | ((unsigned)e3 << 16)}; }
            if (tid < 2) { const int d = tid; const int chain = bh * 2 + d, sg = ch < 4 ? (d ? 3 - ch : ch) : 4 + (d ? 63 - (ch - 4) : ch - 4);
                ((float*)(F.ws + WS_GDEC))[chain * 68 + sg] = eg[d * 64 + 63]; }
        }
    }
}

__device__ __forceinline__ void phase_gdn_scan(Frame& F, int first_wg) {
    const int chain = F.bid - first_wg; if (chain < 0 || chain >= 32) return;
    const int b = chain >> 3, hh = (chain >> 1) & 3, d = chain & 1;
    const unsigned char* src = F.ws + WS_GCH + (size_t)chain * GCH_CHAIN;
    const float* decs = (const float*)(F.ws + WS_GDEC) + chain * 68;
    float* OUT = (float*)(F.ws + WS_R1 + R1_OG) + (size_t)d * M * 256;
    LAS unsigned char* ring = F.lds;
    const int lane = F.lane, w = F.wave;
    if (w >= 4) {
        const int dw = w - 4;
#define GS_ISSUE(step) do { _Pragma("unroll") for (int k = 0; k < 10; ++k) { const int p = dw * 10 + k; \
            __builtin_amdgcn_global_load_lds((const unsigned*)(src + (size_t)(step) * GCH_STEP + p * 1024 + lane * 16), (LAS unsigned*)(ring + ((step) % 3) * 40960 + p * 1024), 16, 0, 0); } } while (0)
        GS_ISSUE(0); GS_ISSUE(1);
        asm volatile("s_waitcnt vmcnt(10)" ::: "memory"); __builtin_amdgcn_s_barrier();
        for (int n = 0; n < 68; ++n) {
            if (n + 2 < 68) { GS_ISSUE(n + 2); asm volatile("s_waitcnt vmcnt(10)" ::: "memory"); }
            else asm volatile("s_waitcnt vmcnt(0)" ::: "memory");
            __builtin_amdgcn_s_barrier();
        }
#undef GS_ISSUE
    } else {
        const int sl = w, qq = lane >> 4, cc = lane & 15;
        f32x4 S[4];
#pragma unroll
        for (int rt = 0; rt < 4; ++rt) S[rt] = (f32x4){0.f, 0.f, 0.f, 0.f};
        const float dv0 = decs[lane], dv1 = decs[64 + (lane & 3)];
        asm volatile("s_waitcnt vmcnt(0)" ::: "memory"); __builtin_amdgcn_s_barrier(); asm volatile("" ::: "memory");
        for (int n = 0; n < 68; ++n) {
            const LAS unsigned char* base = ring + (n % 3) * 40960;
            const float dec = n < 64 ? __shfl(dv0, n) : __shfl(dv1, n - 64);
#define GS_FRAG(mat, rt, ks) (*(const LAS bf16x8*)(base + (mat) * 8192 + (((rt) * 2 + (ks)) * 64 + lane) * 16))
            bf16x8 BS[2], BV[2];
#pragma unroll
            for (int ks = 0; ks < 2; ++ks) { u32x4 t; t.x = cvtpk(S[2 * ks][0], S[2 * ks][1]); t.y = cvtpk(S[2 * ks][2], S[2 * ks][3]); t.z = cvtpk(S[2 * ks + 1][0], S[2 * ks + 1][1]); t.w = cvtpk(S[2 * ks + 1][2], S[2 * ks + 1][3]); BS[ks] = __builtin_bit_cast(bf16x8, t); }
            f32x4 vn[4], o[4];
#pragma unroll
            for (int rt = 0; rt < 4; ++rt) { f32x4 acc = (f32x4){0.f, 0.f, 0.f, 0.f};
#pragma unroll
                for (int ks = 0; ks < 2; ++ks) acc = mfma16(GS_FRAG(0, rt, ks), BS[ks], acc);
                const u32x2 uu = *(const LAS u32x2*)(base + 32768 + ((sl * 4 + rt) * 64 + lane) * 8);
                vn[rt] = (f32x4){__uint_as_float(uu.x << 16), __uint_as_float(uu.x & 0xffff0000u), __uint_as_float(uu.y << 16), __uint_as_float(uu.y & 0xffff0000u)} - acc;
                f32x4 oo = (f32x4){0.f, 0.f, 0.f, 0.f};
#pragma unroll
                for (int ks = 0; ks < 2; ++ks) oo = mfma16(GS_FRAG(1, rt, ks), BS[ks], oo);
                o[rt] = oo; }
#pragma unroll
            for (int ks = 0; ks < 2; ++ks) { u32x4 t; t.x = cvtpk(vn[2 * ks][0], vn[2 * ks][1]); t.y = cvtpk(vn[2 * ks][2], vn[2 * ks][3]); t.z = cvtpk(vn[2 * ks + 1][0], vn[2 * ks + 1][1]); t.w = cvtpk(vn[2 * ks + 1][2], vn[2 * ks + 1][3]); BV[ks] = __builtin_bit_cast(bf16x8, t); }
#pragma unroll
            for (int rt = 0; rt < 4; ++rt) { f32x4 oo = o[rt], sn = S[rt] * dec;
#pragma unroll
                for (int ks = 0; ks < 2; ++ks) { oo = mfma16(GS_FRAG(2, rt, ks), BV[ks], oo); sn = mfma16(GS_FRAG(3, rt, ks), BV[ks], sn); }
                o[rt] = oo; S[rt] = sn; }
#undef GS_FRAG
            const int m0 = n < 4 ? b * TC + 64 * (d ? 3 - n : n) : MC + b * TL + 64 * (d ? 63 - (n - 4) : n - 4);
#pragma unroll
            for (int rt = 0; rt < 4; ++rt)
#pragma unroll
                for (int r = 0; r < 4; ++r) { const int i = 16 * rt + 4 * qq + r, tok = d ? 63 - i : i; OUT[(size_t)(m0 + tok) * 256 + hh * 64 + 16 * sl + cc] = o[rt][r]; }
            asm volatile("s_waitcnt lgkmcnt(0)" ::: "memory"); __builtin_amdgcn_s_barrier(); asm volatile("" ::: "memory");
        }
    }
}


__device__ __forceinline__ void phase_ret_kv(Frame& F, const Inputs& in, int layer) {
    const bf16* P = (const bf16*)(F.ws + WS_R1 + R1_P);
    const bf16* RK = (const bf16*)(F.ws + WS_R1 + R1_PREP + PREP_RK);
    LAS bf16* Kt = (LAS bf16*)F.lds; LAS bf16* Vw = Kt + 64 * 72;
    const int lane = F.lane, c = lane & 15, q = lane >> 4, w = F.wave, tid = F.tid;
    const float LOG2E = 1.4426950408889634f;
    for (int uu = F.bid; uu < 16 * 68; uu += F.G) {
        const int bh = uu / 68, ch = uu % 68, b = bh >> 2, hh = bh & 3;
        const int m0 = ch < 4 ? b * TC + 64 * ch : MC + b * TL + 64 * (ch - 4);
        const float l0 = -__expf(in.ret_decay[layer * 8 + hh]) * LOG2E, l1 = -__expf(in.ret_decay[layer * 8 + 4 + hh]) * LOG2E;
        __syncthreads();
        { const int j = tid >> 3, col8 = (tid & 7) * 8;
          const u32x4 k8 = *(const u32x4*)(RK + (size_t)(m0 + j) * 256 + hh * 64 + col8), v8 = *(const u32x4*)(P + (size_t)(m0 + j) * NP + PC_RV + hh * 64 + col8);
          const float w0 = exp2f((float)(63 - j) * l0), w1 = exp2f((float)j * l1);
#pragma unroll
          for (int x = 0; x < 8; ++x) { const unsigned kk = (k8[x >> 1] >> (16 * (x & 1))) & 0xffffu; const float vv = __uint_as_float(((v8[x >> 1] >> (16 * (x & 1))) & 0xffffu) << 16);
              Kt[(col8 + x) * 72 + j] = (bf16)kk; Vw[(col8 + x) * 72 + j] = (bf16)f2bf(vv * w0); Vw[4608 + (col8 + x) * 72 + j] = (bf16)f2bf(vv * w1); } }
        __syncthreads();
        { const int d = w >> 2, td = w & 3;
          bf16x8 a[2];
#pragma unroll
          for (int ks = 0; ks < 2; ++ks) a[ks] = *(const LAS bf16x8*)(Kt + (16 * td + c) * 72 + 32 * ks + 8 * q);
          const int chain = bh * 2 + d, sg = d ? (ch < 4 ? 3 - ch : 71 - ch) : ch;
          float* dst = (float*)(F.ws + WS_RKV) + ((size_t)chain * 68 + sg) * 4096;
#pragma unroll
          for (int te = 0; te < 4; ++te) { f32x4 acc = (f32x4){0.f, 0.f, 0.f, 0.f};
#pragma unroll
              for (int ks = 0; ks < 2; ++ks) acc = mfma16(a[ks], *(const LAS bf16x8*)(Vw + d * 4608 + (16 * te + c) * 72 + 32 * ks + 8 * q), acc);
              *(f32x4*)(dst + (16 * te + c) * 64 + 16 * td + 4 * q) = acc; } }
    }
}
__device__ __forceinline__ void phase_ret_state(Frame& F, const Inputs& in, int layer, int nwg) {
    if (F.bid >= nwg) return;
    const float* RKV = (const float*)(F.ws + WS_RKV); bf16* RST = (bf16*)(F.ws + WS_RST);
    for (int el = F.bid * NTHR + F.tid; el < 32 * 4096; el += nwg * NTHR) {
        const int chain = el >> 12, idx = el & 4095, hh = (chain >> 1) & 3, d = chain & 1;
        const float G64 = __expf(-64.0f * __expf(in.ret_decay[layer * 8 + d * 4 + hh]));
        const float* kv = RKV + (size_t)chain * 68 * 4096 + idx; bf16* st = RST + (size_t)chain * 68 * 4096 + idx;
        float S = 0.f;
#pragma unroll 4
        for (int sg = 0; sg < 68; ++sg) { st[(size_t)sg * 4096] = (bf16)f2bf(S); S = G64 * S + kv[(size_t)sg * 4096]; }
    }
}
__device__ __forceinline__ void phase_ret_out(Frame& F, const Inputs& in, int layer) {
    const bf16* P = (const bf16*)(F.ws + WS_R1 + R1_P);
    const bf16* RQ = (const bf16*)(F.ws + WS_R1 + R1_PREP + PREP_RQ); const bf16* RK = (const bf16*)(F.ws + WS_R1 + R1_PREP + PREP_RK);
    const bf16* RST = (const bf16*)(F.ws + WS_RST);
    bf16* O = (bf16*)(F.ws + WS_R1 + R1_O);
    const int lane = F.lane, c = lane & 15, q = lane >> 4, w = F.wave, half = w >> 2, ti = w & 3, t2 = F.tid & 255;
    LAS bf16* Qs = (LAS bf16*)(F.lds + half * 46080); LAS bf16* Ks = Qs + 4608; LAS bf16* Vt = Ks + 4608; LAS bf16* St = Vt + 4608;
    const float LOG2E = 1.4426950408889634f;
    for (int pp = F.bid; pp < 8 * 68; pp += F.G) {
        const int uu = 2 * pp + half, bh = uu / 68, ch = uu % 68, b = bh >> 2, hh = bh & 3;
        const int m0 = ch < 4 ? b * TC + 64 * ch : MC + b * TL + 64 * (ch - 4);
        const float l0 = -__expf(in.ret_decay[layer * 8 + hh]) * LOG2E, l1 = -__expf(in.ret_decay[layer * 8 + 4 + hh]) * LOG2E;
        __syncthreads();
#pragma unroll
        for (int rep = 0; rep < 2; ++rep) { const int idx = t2 + 256 * rep, row = idx >> 3, col8 = (idx & 7) * 8;
            *(LAS u32x4*)(Qs + row * 72 + col8) = *(const u32x4*)(RQ + (size_t)(m0 + row) * 256 + hh * 64 + col8);
            *(LAS u32x4*)(Ks + row * 72 + col8) = *(const u32x4*)(RK + (size_t)(m0 + row) * 256 + hh * 64 + col8);
            const u32x4 v8 = *(const u32x4*)(P + (size_t)(m0 + row) * NP + PC_RV + hh * 64 + col8);
#pragma unroll
            for (int x = 0; x < 8; ++x) Vt[(col8 + x) * 72 + row] = (bf16)(v8[x >> 1] >> (16 * (x & 1)));
#pragma unroll
            for (int d = 0; d < 2; ++d) { const int sg = d ? (ch < 4 ? 3 - ch : 71 - ch) : ch;
                *(LAS u32x4*)(St + d * 4608 + row * 72 + col8) = *(const u32x4*)(RST + ((size_t)(bh * 2 + d) * 68 + sg) * 4096 + row * 64 + col8); } }
        __syncthreads();
        bf16x8 qf[2];
#pragma unroll
        for (int ks = 0; ks < 2; ++ks) qf[ks] = *(const LAS bf16x8*)(Qs + (16 * ti + c) * 72 + 32 * ks + 8 * q);
        const int i = 16 * ti + c;
        f32x4 p[4];
#pragma unroll
        for (int tj = 0; tj < 4; ++tj) { f32x4 acc = (f32x4){0.f, 0.f, 0.f, 0.f};
#pragma unroll
            for (int ks = 0; ks < 2; ++ks) acc = mfma16(*(const LAS bf16x8*)(Ks + (16 * tj + c) * 72 + 32 * ks + 8 * q), qf[ks], acc);
#pragma unroll
            for (int r = 0; r < 4; ++r) { const int dlt = i - (16 * tj + 4 * q + r);
                const float wgt = (dlt >= 0 ? exp2f((float)dlt * l0) : 0.f) + (dlt <= 0 ? exp2f((float)(-dlt) * l1) : 0.f);
                acc[r] *= wgt; }
            p[tj] = acc; }
        bf16x8 pb[2];
#pragma unroll
        for (int ks2 = 0; ks2 < 2; ++ks2) { u32x4 t; t.x = cvtpk(p[2 * ks2][0], p[2 * ks2][1]); t.y = cvtpk(p[2 * ks2][2], p[2 * ks2][3]); t.z = cvtpk(p[2 * ks2 + 1][0], p[2 * ks2 + 1][1]); t.w = cvtpk(p[2 * ks2 + 1][2], p[2 * ks2 + 1][3]); pb[ks2] = __builtin_bit_cast(bf16x8, t); }
        const float sc0 = exp2f((float)(i + 1) * l0), sc1 = exp2f((float)(64 - i) * l1);
        f32x4 o[4]; float sum = 0.f;
#pragma unroll
        for (int te = 0; te < 4; ++te) { f32x4 acc = (f32x4){0.f, 0.f, 0.f, 0.f}, t0 = acc, t1 = acc;
#pragma unroll
            for (int ks2 = 0; ks2 < 2; ++ks2) { const u32x2 lo = *(const LAS u32x2*)(Vt + (16 * te + c) * 72 + 32 * ks2 + 4 * q), hi = *(const LAS u32x2*)(Vt + (16 * te + c) * 72 + 32 * ks2 + 16 + 4 * q);
                acc = mfma16(__builtin_bit_cast(bf16x8, ((u32x4){lo.x, lo.y, hi.x, hi.y})), pb[ks2], acc); }
#pragma unroll
            for (int ks = 0; ks < 2; ++ks) { t0 = mfma16(*(const LAS bf16x8*)(St + (16 * te + c) * 72 + 32 * ks + 8 * q), qf[ks], t0);
                t1 = mfma16(*(const LAS bf16x8*)(St + 4608 + (16 * te + c) * 72 + 32 * ks + 8 * q), qf[ks], t1); }
            o[te] = acc + sc0 * t0 + sc1 * t1; sum += (o[te][0] + o[te][1]) + (o[te][2] + o[te][3]); }
        sum += __shfl_xor(sum, 16); sum += __shfl_xor(sum, 32);
        const float mu = sum * (1.0f / 64.0f); float vs = 0.f;
#pragma unroll
        for (int te = 0; te < 4; ++te) { o[te] = o[te] - mu; vs += (o[te][0] * o[te][0] + o[te][1] * o[te][1]) + (o[te][2] * o[te][2] + o[te][3] * o[te][3]); }
        vs += __shfl_xor(vs, 16); vs += __shfl_xor(vs, 32);
        const float rs = 1.0f / sqrtf(vs * (1.0f / 64.0f) + EPS);
#pragma unroll
        for (int te = 0; te < 4; ++te) { const int e0 = hh * 64 + 16 * te + 4 * q;
            const u32x2 g2 = *(const u32x2*)(P + (size_t)(m0 + i) * NP + PC_RG + e0); const f32x4 gn = *(const f32x4*)(in.ret_gn_g + layer * 256 + e0);
            const float g0 = __uint_as_float(g2.x << 16), g1 = __uint_as_float(g2.x & 0xffff0000u), g2f = __uint_as_float(g2.y << 16), g3 = __uint_as_float(g2.y & 0xffff0000u);
            u32x2 wv; wv.x = cvtpk(o[te][0] * rs * gn[0] * siluf(g0), o[te][1] * rs * gn[1] * siluf(g1)); wv.y = cvtpk(o[te][2] * rs * gn[2] * siluf(g2f), o[te][3] * rs * gn[3] * siluf(g3));
            *(u32x2*)(O + (size_t)(m0 + i) * D + e0) = wv; }
    }
}

__device__ __forceinline__ void phase_finish(Frame& F, const Inputs& in, int layer) {
    const bf16* P = (const bf16*)(F.ws + WS_R1 + R1_P);
    const float* OG = (const float*)(F.ws + WS_R1 + R1_OG);
    bf16* O = (bf16*)(F.ws + WS_R1 + R1_O);
    const int lane = F.lane;
    for (int m = F.gw; m < M; m += F.NGW) {
#pragma unroll
        for (int hh = 0; hh < 4; ++hh) {
            const float o2 = OG[(size_t)m * 256 + hh * 64 + lane] + OG[(size_t)(M + m) * 256 + hh * 64 + lane];
            const float ms = wave_sum(o2 * o2) * (1.0f / 64.0f);
            const float z = bf2f(P[(size_t)m * NP + PC_GZ + hh * 64 + lane]);
            const float y2 = o2 * (1.0f / sqrtf(ms + EPS)) * in.gdn_norm_g[layer * 64 + lane] * siluf(z);
            O[(size_t)m * D + 256 + hh * 64 + lane] = (bf16)f2bf(y2);
        }
    }
}

__device__ __forceinline__ void phase_route(Frame& F, int m_lo) {
    if (F.bid != 0) return;
    const int* TKE = (const int*)(F.ws + WS_TKE);
    int* TOKROW = (int*)(F.ws + WS_TOKROW); int* ROWTOK = (int*)(F.ws + WS_ROWTOK); int* TILEE = (int*)(F.ws + WS_TILEE);
    LAS int* cnt = (LAS int*)F.lds;
    LAS int* tot = cnt + 512 * 8;
    const int ntok = M - m_lo, per = (ntok + NTHR - 1) / NTHR;
    const int a0 = m_lo + F.tid * per, a1 = (a0 + per < M) ? a0 + per : M;
    int c[8];
#pragma unroll
    for (int e = 0; e < 8; ++e) c[e] = 0;
    for (int m = a0; m < a1; ++m) { const int e0 = TKE[2 * m], e1 = TKE[2 * m + 1];
#pragma unroll
        for (int e = 0; e < 8; ++e) c[e] += (e0 == e) + (e1 == e); }
#pragma unroll
    for (int e = 0; e < 8; ++e) cnt[F.tid * 8 + e] = c[e];
    __syncthreads();
    if (F.tid < 8) { int run = 0; for (int i = 0; i < NTHR; ++i) { const int v = cnt[i * 8 + F.tid]; cnt[i * 8 + F.tid] = run; run += v; } tot[F.tid] = run; }
    __syncthreads();
    if (F.tid == 0) { int st = 0; for (int e = 0; e < 8; ++e) { tot[8 + e] = st; const int pad = (tot[e] + 255) / 256 * 256;
            for (int tl = st / 256; tl < (st + pad) / 256; ++tl) TILEE[tl] = e; st += pad; }
        TILEE[256] = st / 256; }
    __syncthreads();
    int pos[8];
#pragma unroll
    for (int e = 0; e < 8; ++e) pos[e] = tot[8 + e] + cnt[F.tid * 8 + e];
    for (int m = a0; m < a1; ++m) {
#pragma unroll
        for (int k = 0; k < 2; ++k) { const int ee = TKE[2 * m + k]; int row = 0;
#pragma unroll
            for (int e = 0; e < 8; ++e) if (ee == e) { row = pos[e]; pos[e] = row + 1; }
            ROWTOK[row] = m; TOKROW[2 * m + k] = row; } }
    for (int e = 0; e < 8; ++e) { const int st = tot[8 + e] + tot[e], en = tot[8 + e] + (tot[e] + 255) / 256 * 256; for (int r = st + F.tid; r < en; r += NTHR) ROWTOK[r] = -1; }
}
__device__ __forceinline__ void phase_permute(Frame& F) {
    const int* ROWTOK = (const int*)(F.ws + WS_ROWTOK); const int nrows = ((const int*)(F.ws + WS_TILEE))[256] * 256;
    const bf16* H = (const bf16*)(F.ws + WS_H); bf16* HP = (bf16*)(F.ws + WS_HP);
    for (int r = F.gw; r < nrows; r += F.NGW) { const int tok = ROWTOK[r];
#pragma unroll
        for (int j = 0; j < 2; ++j) { u32x4 v = (u32x4){0u, 0u, 0u, 0u}; if (tok >= 0) v = *(const u32x4*)(H + (size_t)tok * D + 8 * F.lane + 512 * j); *(u32x4*)(HP + (size_t)r * D + 8 * F.lane + 512 * j) = v; } }
}

constexpr int NPH = 12;
constexpr int PH_TOTAL = 1 + DEPTH * NPH + 1;
__host__ __device__ inline bool phase_exists(int ph) {
    if (ph == 0 || ph == PH_TOTAL - 1) return true;
    const int layer = (ph - 1) / NPH, j = (ph - 1) % NPH;
    if (!(layer & 1) && j >= 10) return false;
    return true;
}
__global__ void __launch_bounds__(NTHR, 2) fwd_kernel(Args args) {
    extern __shared__ __attribute__((aligned(16))) unsigned char lds_raw[];
    Frame F;
    F.lds = (LAS unsigned char*)lds_raw;
    F.tid = threadIdx.x; F.lane = F.tid & 63; F.wave = __builtin_amdgcn_readfirstlane(F.tid >> 6);
    F.G = gridDim.x; F.bid = blockIdx.x; F.gw = blockIdx.x * NWAVES + F.wave; F.NGW = F.G * NWAVES; F.ws = args.ws;
    volatile LAS unsigned* MISC = (volatile LAS unsigned*)(F.lds + MISC_OFF);
    LAS unsigned long long* ptab = (LAS unsigned long long*)(F.lds + MISC_OFF + 128);
    if (F.tid < 32) MISC[F.tid] = 0u;
    if (F.tid == 64) { const Inputs& ai = args.in;
        ptab[0] = (unsigned long long)ai.x; ptab[1] = (unsigned long long)ai.c; ptab[2] = (unsigned long long)ai.ctx; ptab[3] = (unsigned long long)ai.c_ctx; ptab[4] = (unsigned long long)ai.ada_w; ptab[5] = (unsigned long long)ai.ada_b;
        ptab[6] = (unsigned long long)ai.norm1_g; ptab[7] = (unsigned long long)ai.w_in; ptab[8] = (unsigned long long)ai.ret_decay; ptab[9] = (unsigned long long)ai.ret_gn_g; ptab[10] = (unsigned long long)ai.gdn_conv_w; ptab[11] = (unsigned long long)ai.gdn_a_log;
        ptab[12] = (unsigned long long)ai.gdn_dt_bias; ptab[13] = (unsigned long long)ai.gdn_norm_g; ptab[14] = (unsigned long long)ai.swa_sink; ptab[15] = (unsigned long long)ai.w_out; ptab[16] = (unsigned long long)ai.norm2_g; ptab[17] = (unsigned long long)ai.ffn_w1;
        ptab[18] = (unsigned long long)ai.ffn_w3; ptab[19] = (unsigned long long)ai.ffn_w2; ptab[20] = (unsigned long long)ai.router_w; ptab[21] = (unsigned long long)ai.moe_w1; ptab[22] = (unsigned long long)ai.moe_w3; ptab[23] = (unsigned long long)ai.moe_w2; ptab[24] = (unsigned long long)ai.final_g; }
    __syncthreads();
    XcdBarrier bar; bar.bar = (unsigned*)(F.ws + WS_CTL) + CW_BAR; bar.x = 0; bar.st = nullptr;
    const int lo = args.ph_lo, hi = args.ph_hi;
    const bool multi = (hi - lo) > 1;
    if (multi) bar = xcd_barrier_post((unsigned*)(F.ws + WS_CTL) + CW_BAR, MISC + 8);
#define LAUNDER() unsigned char* _w = args.ws; asm volatile("" : "+s"(_w)); F.ws = _w; asm volatile("" ::: "memory"); { int _t = threadIdx.x; asm volatile("" : "+v"(_t)); int _b = blockIdx.x; asm volatile("" : "+s"(_b)); F.tid = _t; F.lane = _t & 63; F.wave = __builtin_amdgcn_readfirstlane(_t >> 6); F.bid = _b; F.gw = _b * NWAVES + F.wave; } const Inputs in = load_inputs(ptab)
#define RELAUNDER() do { unsigned char* _w2 = args.ws; asm volatile("" : "+s"(_w2)); F.ws = _w2; int _t = threadIdx.x; asm volatile("" : "+v"(_t)); int _b = blockIdx.x; asm volatile("" : "+s"(_b)); F.tid = _t; F.lane = _t & 63; F.wave = __builtin_amdgcn_readfirstlane(_t >> 6); F.bid = _b; F.gw = _b * NWAVES + F.wave; asm volatile("" ::: "memory"); } while (0)
#define IN(k) (lo <= (k) && (k) < hi)
#define SEAM(k) do { if (IN(k) && IN((k) + 1)) xcd_barrier(bar); } while (0)
    LAS unsigned char* ring = F.lds;

    if (IN(0)) { LAUNDER(); phase_prologue(F, in); } SEAM(0);

    for (int layer = 0; layer < DEPTH; ++layer) {
        const int p0 = 1 + layer * NPH;
        const bool moe = layer & 1;
        if (IN(p0 + 0)) { LAUNDER(); phase_token<0>(F, in, layer, layer == 0, layer > 0 && ((layer - 1) & 1), false, nullptr); if (layer == 2) convert_moe_layer(F, in, 1); }
        SEAM(p0 + 0);
        if (IN(p0 + 1)) { LAUNDER(); pg8::StaticOrder S; S.init(F.ws + WS_H, (bf16*)(F.ws + WS_WIN) + (size_t)layer * NP * D, M, NP, D, F.G, F.bid);
            pg8::EpiBf16 E{(bf16*)(F.ws + WS_R1 + R1_P), NP}; pg8::gemm_phase<pg8::EpiBf16, pg8::StaticOrder>(ring, D, S, E, F.tid); }
        SEAM(p0 + 1);
        if (IN(p0 + 2)) { LAUNDER(); phase_prep(F, in, layer); }
        SEAM(p0 + 2);
        if (IN(p0 + 3)) { LAUNDER(); phase_gdn_local(F); RELAUNDER(); phase_ret_kv(F, in, layer); }
        SEAM(p0 + 3);
        if (IN(p0 + 4)) { LAUNDER(); phase_gdn_scan(F, F.G - 32); RELAUNDER(); phase_ret_state(F, in, layer, F.G - 32); RELAUNDER(); phase_swa2(F, in, layer); }
        SEAM(p0 + 4);
        if (IN(p0 + 5)) { LAUNDER(); phase_ret_out(F, in, layer); RELAUNDER(); phase_finish(F, in, layer); }
        SEAM(p0 + 5);
        if (IN(p0 + 6)) { LAUNDER(); pg8::StaticOrder S; S.init(F.ws + WS_R1 + R1_O, (bf16*)(F.ws + WS_WOUT) + (size_t)layer * D * D, M, D, D, F.G, F.bid);
            pg8::EpiResid E{(float*)(F.ws + WS_XS), (const float*)(F.ws + WS_MOD) + (size_t)layer * 5 * 6 * D, 2}; pg8::gemm_phase<pg8::EpiResid, pg8::StaticOrder>(ring, D, S, E, F.tid); }
        SEAM(p0 + 6);
        if (IN(p0 + 7)) { LAUNDER(); phase_token<1>(F, in, layer, false, false, moe, nullptr); }
        SEAM(p0 + 7);
        if (!moe) {
            if (IN(p0 + 8)) { LAUNDER(); pg8::StaticOrder S; S.init(F.ws + WS_H, (bf16*)(F.ws + WS_W13) + (size_t)(layer >> 1) * 2 * FF * D, M, 2 * FF, D, F.G, F.bid);
                pg8::EpiSwiglu E{(bf16*)(F.ws + WS_R1 + R1_HID), FF}; pg8::gemm_phase<pg8::EpiSwiglu, pg8::StaticOrder>(ring, D, S, E, F.tid); }
            SEAM(p0 + 8);
            if (IN(p0 + 9)) { LAUNDER(); pg8::StaticOrder S; S.init(F.ws + WS_R1 + R1_HID, (bf16*)(F.ws + WS_W2) + (size_t)(layer >> 1) * D * FF, M, D, FF, F.G, F.bid);
                pg8::EpiResid E{(float*)(F.ws + WS_XS), (const float*)(F.ws + WS_MOD) + (size_t)layer * 5 * 6 * D, 5}; pg8::gemm_phase<pg8::EpiResid, pg8::StaticOrder>(ring, FF, S, E, F.tid); }
            if (IN(p0 + 9) && IN(p0 + NPH)) xcd_barrier(bar);
        } else {
            if (IN(p0 + 8)) { LAUNDER(); phase_route(F, layer == DEPTH - 1 ? MC : 0); }
            SEAM(p0 + 8);
            if (IN(p0 + 9)) { LAUNDER(); phase_permute(F); }
            SEAM(p0 + 9);
            if (IN(p0 + 10)) { LAUNDER(); const int* tile_e = (const int*)(F.ws + WS_TILEE); const int ntiles = __builtin_amdgcn_readfirstlane(tile_e[256]);
                pg8::GroupedOrder S; S.init(F.ws + WS_HP, F.ws + WS_MW13, ntiles, 2 * EF, D, F.G, F.bid, tile_e);
                pg8::EpiSwiglu E{(bf16*)(F.ws + WS_R1 + R1_HID), EF}; pg8::gemm_phase<pg8::EpiSwiglu, pg8::GroupedOrder>(ring, D, S, E, F.tid); }
            SEAM(p0 + 10);
            if (IN(p0 + 11)) { LAUNDER(); const int* tile_e = (const int*)(F.ws + WS_TILEE); const int ntiles = __builtin_amdgcn_readfirstlane(tile_e[256]);
                pg8::GroupedOrder S; S.init(F.ws + WS_R1 + R1_HID, F.ws + WS_MW2, ntiles, D, EF, F.G, F.bid, tile_e);
                pg8::EpiF32 E{(float*)(F.ws + WS_YM), D}; pg8::gemm_phase<pg8::EpiF32, pg8::GroupedOrder>(ring, EF, S, E, F.tid); }
            SEAM(p0 + 11);
        }
    }
    if (IN(PH_TOTAL - 1)) { LAUNDER(); phase_token<2>(F, in, DEPTH, false, true, false, args.out); }
#undef IN
#undef SEAM
}

extern "C" void kernel_launch(void* const* d_in, const int* in_sizes, int n_in, void* d_out, int out_size, void* d_ws, size_t ws_size, hipStream_t stream) {
    static int grid = 0;
    if (grid == 0) {
        if (n_in != 25 || out_size != ML * D || ws_size < WS_END) { fprintf(stderr, "kernel_launch: unexpected problem: n_in %d out %d ws %zu (need %zu)\n", n_in, out_size, ws_size, (size_t)WS_END); grid = -1; return; }
        int dev = 0, cus = 0, per_cu = 0;
        if (hipGetDevice(&dev) != hipSuccess || hipDeviceGetAttribute(&cus, hipDeviceAttributeMultiprocessorCount, dev) != hipSuccess) { grid = -1; return; }
        if (hipFuncSetAttribute((const void*)fwd_kernel, hipFuncAttributeMaxDynamicSharedMemorySize, LDS_BYTES) != hipSuccess) { fprintf(stderr, "kernel_launch: hipFuncSetAttribute failed\n"); grid = -1; return; }
        if (hipOccupancyMaxActiveBlocksPerMultiprocessor(&per_cu, (const void*)fwd_kernel, NTHR, LDS_BYTES) != hipSuccess || per_cu < 1) fprintf(stderr, "kernel_launch: occupancy query reports %d\n", per_cu);
        (void)hipGetLastError();
        grid = cus;
    }
    if (grid < 0) return;
    (void)hipMemsetAsync((char*)d_ws + WS_CTL, 0, CTL_ZERO_BYTES, stream);
    Args a{};
    const float** ip = (const float**)&a.in;
    for (int i = 0; i < 25; ++i) ip[i] = (const float*)d_in[i];
    a.out = (float*)d_out; a.ws = (unsigned char*)d_ws;
#if MK_ONE_LAUNCH
    a.ph_lo = 0; a.ph_hi = PH_TOTAL;
    hipLaunchKernelGGL(fwd_kernel, dim3(grid), dim3(NTHR), LDS_BYTES, stream, a);
#else
    for (int ph = 0; ph < PH_TOTAL; ++ph) { if (!phase_exists(ph)) continue; a.ph_lo = ph; a.ph_hi = ph + 1;
        hipLaunchKernelGGL(fwd_kernel, dim3(grid), dim3(NTHR), LDS_BYTES, stream, a); }
#endif
}
```

```cpp
#include <hip/hip_runtime.h>
#include <cstdio>
#include <cstdint>

#ifndef PROBE_JMASK
#define PROBE_JMASK 0u
#endif
#ifndef PROBE_LMASK
#define PROBE_LMASK 15u
#endif
#ifndef PROBE_PRO
#define PROBE_PRO 0
#endif
#ifndef PROBE_CUSTOM
#define PROBE_CUSTOM 0
#endif
#ifndef PROBE_BLOCK
#define PROBE_BLOCK 0
#endif
#define PROBE_ON ((PROBE_JMASK) != 0u || (PROBE_PRO) != 0 || (PROBE_CUSTOM) != 0)
#define PB(id) do { if ((PROBE_CUSTOM) == (id) && (int)blockIdx.x == (PROBE_BLOCK < 0 ? (int)gridDim.x + (PROBE_BLOCK) : (PROBE_BLOCK)) && threadIdx.x == 0) ((volatile LAS unsigned long long*)(F.lds + 132096))[2] = __builtin_amdgcn_s_memrealtime(); } while (0)
#define PE(id) do { if ((PROBE_CUSTOM) == (id) && (int)blockIdx.x == (PROBE_BLOCK < 0 ? (int)gridDim.x + (PROBE_BLOCK) : (PROBE_BLOCK)) && threadIdx.x == 0) { volatile LAS unsigned long long* _s = (volatile LAS unsigned long long*)(F.lds + 132096); _s[1] = _s[1] + (__builtin_amdgcn_s_memrealtime() - _s[2]); } } while (0)
#ifndef MK_ONE_LAUNCH
#define MK_ONE_LAUNCH 1
#endif

#define GAS __attribute__((address_space(1)))
#define LAS __attribute__((address_space(3)))
typedef unsigned short bf16;
typedef short bf16x8 __attribute__((ext_vector_type(8)));
typedef float f32x4 __attribute__((ext_vector_type(4)));
typedef float f32x2 __attribute__((ext_vector_type(2)));
typedef unsigned u32x4 __attribute__((ext_vector_type(4)));
typedef unsigned u32x2 __attribute__((ext_vector_type(2)));

constexpr int D = 1024, NB = 4, TL = 4096, TC = 256, DEPTH = 4;
constexpr int MC = NB * TC, ML = NB * TL, M = MC + ML;
constexpr int INC = 2832, NP = 2816;
constexpr int FF = 2816, EF = 3584, NE = 8;
constexpr int MAXROWS = 36864;
constexpr float EPS = 1e-6f;
constexpr int PC_RQ = 0, PC_RK = 256, PC_RV = 512, PC_RG = 768, PC_GQKV = 1024, PC_GZ = 1792, PC_SQ = 2048, PC_SK = 2560, PC_SV = 2688;

constexpr size_t MiB = 1u << 20;
constexpr size_t WS_CTL = 0, CTL_ZERO_BYTES = 1 * MiB;
constexpr size_t WS_MOD = 1 * MiB;
constexpr size_t WS_ROPE = 2 * MiB;
constexpr size_t WS_TKE = 3 * MiB, WS_TKG = 3 * MiB + 256 * 1024, WS_TOKROW = 3 * MiB + 512 * 1024, WS_ROWTOK = 3 * MiB + 768 * 1024, WS_TILEE = 4 * MiB;
constexpr size_t WS_AB = 5 * MiB, WS_GB = 7 * MiB;
constexpr size_t WS_WIN = 16 * MiB, WS_WOUT = 38 * MiB, WS_W13 = 46 * MiB, WS_W2 = 68 * MiB, WS_MW13 = 80 * MiB, WS_MW2 = 192 * MiB;
constexpr size_t WS_XS = 248 * MiB, WS_H = 316 * MiB, WS_HP = 350 * MiB, WS_YM = 422 * MiB, WS_R1 = 566 * MiB;
constexpr size_t R1_P = 0, R1_PREP = 94 * MiB, R1_O = 158 * MiB, R1_OR = 192 * MiB, R1_OG = 226 * MiB, R1_HID = 0;
constexpr size_t WS_END = WS_R1 + 260 * MiB;
constexpr size_t WS_GCH = WS_YM, GCH_STEP = 40960, GCH_CHAIN = 68 * GCH_STEP, WS_GDEC = WS_HP;
constexpr size_t WS_RKV = WS_YM + 96 * MiB;
constexpr size_t WS_RST = WS_HP + 1 * MiB;
static_assert(32 * GCH_CHAIN <= 144 * MiB, "gdn chunk data");
constexpr size_t PREP_RQ = 0, PREP_RK = (size_t)M * 256 * 2, PREP_SQ = (size_t)M * 512 * 2, PREP_SK = (size_t)M * 1024 * 2, PREP_GD = (size_t)M * 1152 * 2;
static_assert(PREP_GD + (size_t)M * 768 * 2 <= 64 * MiB, "prep");
static_assert((size_t)M * NP * 2 <= 94 * MiB && (size_t)MAXROWS * EF * 2 <= 260 * MiB, "r1");

constexpr int CW_TMO = 0, CW_BAR = 4096;

__device__ __forceinline__ float bf2f(bf16 v) { return __uint_as_float(((unsigned)v) << 16); }
__device__ __forceinline__ unsigned f2bf(float f) { unsigned u = __float_as_uint(f); return (u + 0x7fffu + ((u >> 16) & 1u)) >> 16; }
__device__ __forceinline__ unsigned pk2(float lo, float hi) { return f2bf(lo) | (f2bf(hi) << 16); }
template <int CTRL> __device__ __forceinline__ float dppf(float v) { return __int_as_float(__builtin_amdgcn_update_dpp(0, __float_as_int(v), CTRL, 0xF, 0xF, true)); }
__device__ __forceinline__ float row_sum16(float v) {
    v += dppf<0xB1>(v); v += dppf<0x4E>(v); v += dppf<0x141>(v); v += dppf<0x140>(v); return v; }
__device__ __forceinline__ float wave_sum(float v) {
    v = row_sum16(v);
    return __int_as_float(__builtin_amdgcn_readlane(__float_as_int(v), 0)) + __int_as_float(__builtin_amdgcn_readlane(__float_as_int(v), 16))
         + __int_as_float(__builtin_amdgcn_readlane(__float_as_int(v), 32)) + __int_as_float(__builtin_amdgcn_readlane(__float_as_int(v), 48)); }
__device__ __forceinline__ float quad_rows_sum(float v) {
    u32x2 r = __builtin_amdgcn_permlane16_swap(__float_as_uint(v), __float_as_uint(v), false, false); v = __uint_as_float(r.x) + __uint_as_float(r.y);
    r = __builtin_amdgcn_permlane32_swap(__float_as_uint(v), __float_as_uint(v), false, false); return __uint_as_float(r.x) + __uint_as_float(r.y); }
__device__ __forceinline__ float quad_rows_max(float v) {
    u32x2 r = __builtin_amdgcn_permlane16_swap(__float_as_uint(v), __float_as_uint(v), false, false); v = fmaxf(__uint_as_float(r.x), __uint_as_float(r.y));
    r = __builtin_amdgcn_permlane32_swap(__float_as_uint(v), __float_as_uint(v), false, false); return fmaxf(__uint_as_float(r.x), __uint_as_float(r.y)); }
__device__ __forceinline__ float siluf(float x) { return x / (1.0f + __expf(-x)); }
#define LDS_WAIT() asm volatile("s_waitcnt lgkmcnt(0)" ::: "memory")
__device__ __forceinline__ f32x4 mfma16(bf16x8 a, bf16x8 b, f32x4 c) { return __builtin_amdgcn_mfma_f32_16x16x32_bf16(a, b, c, 0, 0, 0); }
__device__ __forceinline__ unsigned cvtpk(float lo, float hi) { unsigned r; asm volatile("v_cvt_pk_bf16_f32 %0, %1, %2" : "=v"(r) : "v"(lo), "v"(hi)); return r; }


namespace pg8 {
#define PG8_LAS __attribute__((address_space(3)))
constexpr int BM = 256, BK = 64, HALF = 128, HTB = HALF * BK * 2, STAGE_BYTES = 8 * HTB;
__host__ __device__ __forceinline__ int lds_byte(int r, int c) { const int st = (r >> 4) * 2 + (c >> 5), rr = r & 15, cc = c & 31, ob = rr * 64 + cc * 2; return st * 1024 + (ob ^ (((ob >> 9) & 1) << 5)); }
__host__ __device__ __forceinline__ void stage_rc(int b, int& R, int& C) { const int st = b / 1024, sb = b % 1024, swz = sb ^ (((sb >> 9) & 1) << 5); R = (st >> 1) * 16 + swz / 64; C = (st & 1) * 32 + (swz % 64) / 2; }
__host__ __device__ __forceinline__ int perm32(int rho) { const int n = rho >> 4, i = rho & 15; return 8 * (i >> 2) + 4 * n + (i & 3); }
struct Unit { int pm, pn, aux; const char* A; const char* B; };
__device__ __forceinline__ unsigned cvt_pk_bf16(float lo, float hi) { unsigned r; asm volatile("v_cvt_pk_bf16_f32 %0, %1, %2" : "=v"(r) : "v"(lo), "v"(hi)); return r; }

template <int K, class Epi, class Sched, bool ALIGN_EPI = true, bool SP2 = true>
__device__ __forceinline__ void gemm_phase(PG8_LAS unsigned char* lds, const Sched& S, const Epi& E, const int tid) {
    const int wid = __builtin_amdgcn_readfirstlane(tid >> 6), lane = tid & 63, wr = wid >> 2, wc = wid & 3, fr = lane & 15, fq = lane >> 4;
    constexpr int nt = K / BK;
    unsigned voffA[2], voffB[2];
#pragma unroll
    for (int i = 0; i < 2; ++i) { int R, C; stage_rc(tid * 16 + i * 8192, R, C); const int Rb = Epi::PERM ? ((R & ~31) + perm32(R & 31)) : R;
        voffA[i] = (unsigned)(R * K + C) * 2u; voffB[i] = (unsigned)(Rb * K + C) * 2u; }
    constexpr size_t kstep = (size_t)(BK * 2);
    constexpr size_t hstep = (size_t)HALF * K * 2;
    const unsigned ldsw = (unsigned)wid * 1024u;
    const int aoff = lds_byte(wr * 64 + fr, fq * 8), boff = lds_byte(wc * 32 + fr, fq * 8);
#define PG8_SA(b, h) (((b) * 2 + (h)) * HTB)
#define PG8_SB(b, h) ((4 + (b) * 2 + (h)) * HTB)
#define PG8_STAGE(bufoff, gbase, voff) do { _Pragma("unroll") for (int _i = 0; _i < 2; ++_i) \
        __builtin_amdgcn_global_load_lds((const unsigned*)((const char*)(gbase) + (voff)[_i]), (PG8_LAS unsigned*)(lds + (bufoff) + ldsw + _i * 8192), 16, 0, 0); } while (0)
#define PG8_LDA(dst, b, h) do { _Pragma("unroll") for (int m = 0; m < 4; ++m) _Pragma("unroll") for (int k = 0; k < 2; ++k) dst[m][k] = *(const PG8_LAS bf16x8*)(lds + PG8_SA(b, h) + aoff + m * 2048 + k * 1024); } while (0)
#define PG8_LDB(dst, b, h) do { _Pragma("unroll") for (int n = 0; n < 2; ++n) _Pragma("unroll") for (int k = 0; k < 2; ++k) dst[n][k] = *(const PG8_LAS bf16x8*)(lds + PG8_SB(b, h) + boff + n * 2048 + k * 1024); } while (0)
#define PG8_MMA(ai, bj, At, Bt) do { __builtin_amdgcn_s_setprio(1); _Pragma("unroll") for (int m = 0; m < 4; ++m) _Pragma("unroll") for (int n = 0; n < 2; ++n) _Pragma("unroll") for (int k = 0; k < 2; ++k) \
        acc[ai][bj][m][n] = __builtin_amdgcn_mfma_f32_16x16x32_bf16(Bt[n][k], At[m][k], acc[ai][bj][m][n], 0, 0, 0); __builtin_amdgcn_s_setprio(0); } while (0)
#define PG8_WAIT_V(n) asm volatile("s_waitcnt vmcnt(" #n ")" ::: "memory")
#define PG8_WAIT_L(n) asm volatile("s_waitcnt lgkmcnt(" #n ")" ::: "memory")
#define PG8_BAR __builtin_amdgcn_s_barrier()
#define PG8_SCHED __builtin_amdgcn_sched_barrier(0)
    Unit cur, nxt; int ui = 0;
    if (!S.next(0, cur)) return;
    f32x4 acc[2][2][4][2];
#pragma unroll
    for (int a = 0; a < 2; ++a)
#pragma unroll
        for (int b = 0; b < 2; ++b)
#pragma unroll
            for (int m = 0; m < 4; ++m)
#pragma unroll
                for (int n = 0; n < 2; ++n) acc[a][b][m][n] = (f32x4){0.f, 0.f, 0.f, 0.f};
    bf16x8 At[4][2], B0[2][2], B1[2][2];
    const char* cA = cur.A; const char* cB = cur.B;
    if constexpr (SP2) {
        PG8_STAGE(PG8_SB(0, 0), cB, voffB); PG8_STAGE(PG8_SB(0, 1), cB + hstep, voffB); PG8_STAGE(PG8_SA(0, 0), cA, voffA); PG8_STAGE(PG8_SA(0, 1), cA + hstep, voffA);
        if (wr == 1) PG8_BAR;
        PG8_WAIT_V(2); PG8_BAR;
        PG8_STAGE(PG8_SB(1, 0), cB + kstep, voffB); PG8_STAGE(PG8_SA(1, 0), cA + kstep, voffA); PG8_STAGE(PG8_SB(1, 1), cB + hstep + kstep, voffB);
        PG8_WAIT_V(6); PG8_BAR;
    } else {
        PG8_STAGE(PG8_SB(0, 0), cB, voffB); PG8_STAGE(PG8_SA(0, 0), cA, voffA); PG8_STAGE(PG8_SB(0, 1), cB + hstep, voffB); PG8_STAGE(PG8_SA(0, 1), cA + hstep, voffA);
        if (wr == 1) PG8_BAR;
        PG8_WAIT_V(4); PG8_BAR;
        PG8_STAGE(PG8_SB(1, 0), cB + kstep, voffB); PG8_STAGE(PG8_SA(1, 0), cA + kstep, voffA); PG8_STAGE(PG8_SB(1, 1), cB + hstep + kstep, voffB);
        PG8_WAIT_V(6); PG8_BAR;
    }
    for (;;) {
        const bool has_next = S.next(ui + 1, nxt);
        const char* nA = has_next ? nxt.A : cA; const char* nB = has_next ? nxt.B : cB;
        for (int t = 0; t < nt; t += 2) {
            const bool last = (t == nt - 2);
            const char* a1 = cA + (size_t)(t + 1) * kstep;
            const char* a2 = last ? nA : cA + (size_t)(t + 2) * kstep; const char* b2 = last ? nB : cB + (size_t)(t + 2) * kstep;
            const char* a3 = a2 + kstep; const char* b3 = b2 + kstep;
            if constexpr (SP2) {
            PG8_LDB(B0, 0, 0); PG8_LDB(B1, 0, 1); PG8_SCHED; PG8_LDA(At, 0, 0); PG8_STAGE(PG8_SA(1, 1), a1 + hstep, voffA);
            PG8_WAIT_V(8); PG8_WAIT_L(0); PG8_BAR; PG8_MMA(0, 0, At, B0); PG8_MMA(0, 1, At, B1); PG8_BAR; PG8_SCHED;
            PG8_LDA(At, 0, 1); PG8_STAGE(PG8_SB(0, 0), b2, voffB); PG8_STAGE(PG8_SB(0, 1), b2 + hstep, voffB); PG8_STAGE(PG8_SA(0, 0), a2, voffA);
            PG8_WAIT_V(8); PG8_WAIT_L(0); PG8_BAR; PG8_MMA(1, 0, At, B0); PG8_MMA(1, 1, At, B1); PG8_BAR; PG8_SCHED;
            PG8_LDB(B0, 1, 0); PG8_LDB(B1, 1, 1); PG8_SCHED; PG8_LDA(At, 1, 0); PG8_STAGE(PG8_SA(0, 1), a2 + hstep, voffA);
            PG8_WAIT_V(8); PG8_WAIT_L(0); PG8_BAR; PG8_MMA(0, 0, At, B0); PG8_MMA(0, 1, At, B1); PG8_BAR; PG8_SCHED;
            PG8_LDA(At, 1, 1); PG8_STAGE(PG8_SB(1, 0), b3, voffB); PG8_STAGE(PG8_SB(1, 1), b3 + hstep, voffB); PG8_STAGE(PG8_SA(1, 0), a3, voffA);
            PG8_WAIT_V(8); PG8_WAIT_L(0); PG8_BAR; PG8_MMA(1, 0, At, B0); PG8_MMA(1, 1, At, B1); PG8_BAR; PG8_SCHED;
            } else {
            PG8_LDB(B0, 0, 0); PG8_SCHED; PG8_LDA(At, 0, 0); PG8_STAGE(PG8_SA(1, 1), a1 + hstep, voffA);
            PG8_WAIT_L(8); PG8_BAR; PG8_WAIT_L(0); PG8_MMA(0, 0, At, B0); PG8_BAR; PG8_SCHED;
            PG8_LDB(B1, 0, 1); PG8_STAGE(PG8_SB(0, 0), b2, voffB);
            PG8_BAR; PG8_WAIT_L(0); PG8_MMA(0, 1, At, B1); PG8_BAR;
            PG8_LDA(At, 0, 1); PG8_STAGE(PG8_SA(0, 0), a2, voffA);
            PG8_BAR; PG8_WAIT_L(0); PG8_MMA(1, 0, At, B0); PG8_BAR; PG8_SCHED;
            PG8_STAGE(PG8_SB(0, 1), b2 + hstep, voffB);
            PG8_WAIT_V(6); PG8_BAR; PG8_MMA(1, 1, At, B1); PG8_BAR;
            PG8_LDB(B0, 1, 0); PG8_SCHED; PG8_LDA(At, 1, 0); PG8_STAGE(PG8_SA(0, 1), a2 + hstep, voffA);
            PG8_WAIT_L(8); PG8_BAR; PG8_WAIT_L(0); PG8_MMA(0, 0, At, B0); PG8_BAR; PG8_SCHED;
            PG8_LDB(B1, 1, 1); PG8_STAGE(PG8_SB(1, 0), b3, voffB);
            PG8_BAR; PG8_WAIT_L(0); PG8_MMA(0, 1, At, B1); PG8_BAR;
            PG8_LDA(At, 1, 1); PG8_STAGE(PG8_SA(1, 0), a3, voffA);
            PG8_BAR; PG8_WAIT_L(0); PG8_MMA(1, 0, At, B0); PG8_BAR; PG8_SCHED;
            PG8_STAGE(PG8_SB(1, 1), b3 + hstep, voffB);
            PG8_WAIT_V(6); PG8_BAR; PG8_MMA(1, 1, At, B1); PG8_BAR;
            }
        }
        if constexpr (ALIGN_EPI) { if (wr == 0) PG8_BAR; }
        E(acc, cur, wr, wc, fr, fq);
        if (!has_next) break;
#pragma unroll
        for (int a = 0; a < 2; ++a)
#pragma unroll
            for (int b = 0; b < 2; ++b)
#pragma unroll
                for (int m = 0; m < 4; ++m)
#pragma unroll
                    for (int n = 0; n < 2; ++n) acc[a][b][m][n] = (f32x4){0.f, 0.f, 0.f, 0.f};
        cur = nxt; cA = nA; cB = nB; ++ui;
        if constexpr (ALIGN_EPI) { if (wr == 1) PG8_BAR; }
    }
    PG8_WAIT_V(0);
    if constexpr (!ALIGN_EPI) { if (wr == 0) PG8_BAR; }
    PG8_BAR;
#undef PG8_SA
#undef PG8_SB
#undef PG8_STAGE
#undef PG8_LDA
#undef PG8_LDB
#undef PG8_MMA
#undef PG8_WAIT_V
#undef PG8_WAIT_L
#undef PG8_BAR
#undef PG8_SCHED
}

struct StaticOrder {
    int nM, nN, nwg, G, c; const char* A; const char* Bt; size_t tstep;
    __device__ void init(const void* A_, const void* Bt_, int M_, int N_, int K_, int G_, int c_) { A = (const char*)A_; Bt = (const char*)Bt_; nM = M_ / BM; nN = N_ / BM; nwg = nM * nN; G = G_; c = c_; tstep = (size_t)BM * K_ * 2; }
    __device__ bool next(int i, Unit& u) const {
        const long L = (long)i * G + c; if (L >= nwg) return false;
        int wgid = (int)L; { const int q = nwg / 8, r = nwg % 8, xcd = wgid % 8, off = wgid / 8; wgid = (xcd < r ? xcd * (q + 1) : r * (q + 1) + (xcd - r) * q) + off; }
        const int nig = 8 * nN, gid = wgid / nig, fm = gid * 8, gsz = (nM - fm) < 8 ? (nM - fm) : 8;
        u.pm = fm + ((wgid % nig) % gsz); u.pn = (wgid % nig) / gsz; u.aux = 0;
        u.A = A + (size_t)u.pm * tstep; u.B = Bt + (size_t)u.pn * tstep; return true;
    }
};
struct GroupedOrder {
    int nM, nN, nwg, G, c; const char* A; const char* Bt; size_t tstep, estep; const int* tile_e;
    __device__ void init(const void* A_, const void* Bt_, int ntiles, int N_, int K_, int G_, int c_, const int* te) { A = (const char*)A_; Bt = (const char*)Bt_; nM = ntiles; nN = N_ / BM; nwg = nM * nN; G = G_; c = c_; tstep = (size_t)BM * K_ * 2; estep = (size_t)N_ * K_ * 2; tile_e = te; }
    __device__ bool next(int i, Unit& u) const {
        const long L = (long)i * G + c; if (L >= nwg) return false;
        u.pm = (int)(L / nN); u.pn = (int)(L % nN); u.aux = __builtin_amdgcn_readfirstlane(tile_e[u.pm]);
        u.A = A + (size_t)u.pm * tstep; u.B = Bt + (size_t)u.aux * estep + (size_t)u.pn * tstep; return true;
    }
};

struct EpiBf16 {
    static constexpr bool PERM = true;
    bf16* O; int ldc;
    __device__ __forceinline__ void operator()(const f32x4 (&acc)[2][2][4][2], const Unit& u, int wr, int wc, int fr, int fq) const {
        const int row0 = u.pm * BM + wr * 64 + fr, col0 = u.pn * BM + wc * 32 + 8 * fq;
#pragma unroll
        for (int ai = 0; ai < 2; ++ai)
#pragma unroll
            for (int m = 0; m < 4; ++m) { bf16* rowp = O + (size_t)(row0 + ai * HALF + m * 16) * ldc + col0;
#pragma unroll
                for (int bj = 0; bj < 2; ++bj) { const f32x4 v0 = acc[ai][bj][m][0], v1 = acc[ai][bj][m][1];
                    u32x4 w; w.x = cvt_pk_bf16(v0[0], v0[1]); w.y = cvt_pk_bf16(v0[2], v0[3]); w.z = cvt_pk_bf16(v1[0], v1[1]); w.w = cvt_pk_bf16(v1[2], v1[3]);
                    *(u32x4*)(rowp + bj * HALF) = w; } }
    }
};
struct EpiResid {
    static constexpr bool PERM = false;
    float* X; const float* mod; int gsel;
    __device__ __forceinline__ void operator()(const f32x4 (&acc)[2][2][4][2], const Unit& u, int wr, int wc, int fr, int fq) const {
        const int row0 = u.pm * BM + wr * 64 + fr, col0 = u.pn * BM + wc * 32 + 4 * fq;
        const int r = u.pm < 4 ? 4 : ((u.pm - 4) >> 4);
        const float* g = mod + (size_t)r * 6 * D + gsel * D;
        f32x4 gv[2][2];
#pragma unroll
        for (int bj = 0; bj < 2; ++bj)
#pragma unroll
            for (int n = 0; n < 2; ++n) gv[bj][n] = *(const f32x4*)(g + col0 + bj * HALF + n * 16);
#pragma unroll
        for (int ai = 0; ai < 2; ++ai)
#pragma unroll
            for (int m = 0; m < 4; ++m) { float* rowp = X + (size_t)(row0 + ai * HALF + m * 16) * D + col0;
#pragma unroll
                for (int bj = 0; bj < 2; ++bj)
#pragma unroll
                    for (int n = 0; n < 2; ++n) { f32x4 x = *(f32x4*)(rowp + bj * HALF + n * 16); x += gv[bj][n] * acc[ai][bj][m][n]; *(f32x4*)(rowp + bj * HALF + n * 16) = x; } }
    }
};
struct EpiSwiglu {
    static constexpr bool PERM = false;
    bf16* Hd; int ldh;
    __device__ __forceinline__ void operator()(const f32x4 (&acc)[2][2][4][2], const Unit& u, int wr, int wc, int fr, int fq) const {
        const int row0 = u.pm * BM + wr * 64 + fr, col0 = u.pn * 128 + wc * 16 + 4 * fq;
#pragma unroll
        for (int ai = 0; ai < 2; ++ai)
#pragma unroll
            for (int m = 0; m < 4; ++m) { bf16* rowp = Hd + (size_t)(row0 + ai * HALF + m * 16) * ldh + col0;
#pragma unroll
                for (int bj = 0; bj < 2; ++bj) { const f32x4 a = acc[ai][bj][m][0], b = acc[ai][bj][m][1];
                    float h[4];
#pragma unroll
                    for (int j = 0; j < 4; ++j) h[j] = a[j] / (1.0f + __expf(-a[j])) * b[j];
                    u32x2 w; w.x = cvt_pk_bf16(h[0], h[1]); w.y = cvt_pk_bf16(h[2], h[3]);
                    *(u32x2*)(rowp + bj * 64) = w; } }
    }
};
struct EpiF32 {
    static constexpr bool PERM = false;
    float* C; int ldc;
    __device__ __forceinline__ void operator()(const f32x4 (&acc)[2][2][4][2], const Unit& u, int wr, int wc, int fr, int fq) const {
        const int row0 = u.pm * BM + wr * 64 + fr, col0 = u.pn * BM + wc * 32 + 4 * fq;
#pragma unroll
        for (int ai = 0; ai < 2; ++ai)
#pragma unroll
            for (int m = 0; m < 4; ++m) { float* rowp = C + (size_t)(row0 + ai * HALF + m * 16) * ldc + col0;
#pragma unroll
                for (int bj = 0; bj < 2; ++bj)
#pragma unroll
                    for (int n = 0; n < 2; ++n) *(f32x4*)(rowp + bj * HALF + n * 16) = acc[ai][bj][m][n]; }
    }
};
}

#define XB_TMO      128
#define XB_XCNT(j)  (256  + 64 * (j))
#define XB_XSUB(j)  (1280 + 64 * (j))
#define XB_XGEN(j)  (2304 + 64 * (j))
#define XB_TOP      3328
#define XB_TOPGEN   3392
#define XCD_BAR_WORDS 3456
#define XB_SPIN_CAP (1u << 22)
__device__ __forceinline__ unsigned xb_ld(unsigned* p)              { return __hip_atomic_load(p, __ATOMIC_RELAXED, __HIP_MEMORY_SCOPE_AGENT); }
__device__ __forceinline__ unsigned xb_add(unsigned* p, unsigned v) { return __hip_atomic_fetch_add(p, v, __ATOMIC_RELAXED, __HIP_MEMORY_SCOPE_AGENT); }
__device__ __forceinline__ unsigned xb_xcc_id() { return (unsigned)__builtin_amdgcn_s_getreg((3 << 11) | 20) & 0xFu; }
#define XB_SPIN(cond, bar) do { unsigned _sp = 0; while (cond) { __builtin_amdgcn_s_sleep(1); \
    if ((++_sp & 255u) == 0u) { if (xb_ld(&(bar)[XB_TMO])) break; if (_sp > XB_SPIN_CAP) { atomicAdd(&(bar)[XB_TMO], 1u); break; } } } } while (0)
struct XcdBarrier { unsigned* bar; unsigned x; volatile LAS unsigned* st; };
__device__ __forceinline__ XcdBarrier xcd_barrier_post(unsigned* bar, volatile LAS unsigned* st) {
    XcdBarrier b; b.bar = bar; b.x = xb_xcc_id(); b.st = st;
    if (threadIdx.x == 0) (void)xb_add(&bar[XB_XCNT(b.x)], 1u);
    return b;
}
__device__ __forceinline__ void xcd_barrier_complete(unsigned* bar, unsigned x, unsigned& nloc, unsigned& nx) {
    const unsigned G = gridDim.x * gridDim.y * gridDim.z;
    unsigned sum, cnt, mine, sp = 0u;
    for (;;) {
        sum = 0u; cnt = 0u; mine = 0u;
#pragma unroll
        for (unsigned j = 0; j < 16; ++j) { const unsigned c = xb_ld(&bar[XB_XCNT(j)]); sum += c; cnt += (c > 0u) ? 1u : 0u; mine = (j == x) ? c : mine; }
        if (sum == G) break;
        __builtin_amdgcn_s_sleep(1);
        if ((++sp & 255u) == 0u) { if (xb_ld(&bar[XB_TMO])) break; if (sp > XB_SPIN_CAP) { atomicAdd(&bar[XB_TMO], 1u); break; } }
    }
    nloc = mine > 0u ? mine : 1u; nx = cnt > 0u ? cnt : 1u;
}
__device__ __forceinline__ void xcd_barrier(const XcdBarrier& b) {
    asm volatile("s_waitcnt vmcnt(0)" ::: "memory");
    __syncthreads();
    if (threadIdx.x == 0) {
        unsigned* bar = b.bar; unsigned bx = b.x;
        asm volatile("" : "+s"(bar), "+s"(bx));
        __builtin_amdgcn_s_waitcnt(0);
        unsigned nloc = b.st[0], nx = b.st[1];
        if (nloc == 0u) { xcd_barrier_complete(bar, bx, nloc, nx); b.st[0] = nloc; b.st[1] = nx; }
        const unsigned old = xb_add(&bar[XB_XSUB(bx)], 1u);
        const unsigned gen = old / nloc;
        if (old + 1u == (gen + 1u) * nloc) {
            __builtin_amdgcn_fence(__ATOMIC_RELEASE, "agent");
            asm volatile("s_waitcnt vmcnt(0)" ::: "memory");
            const unsigned og = xb_add(&bar[XB_TOP], 1u);
            const unsigned tg = og / nx;
            if (og + 1u == (tg + 1u) * nx) xb_add(&bar[XB_TOPGEN], 1u);
            else XB_SPIN(xb_ld(&bar[XB_TOPGEN]) == tg, bar);
            __builtin_amdgcn_fence(__ATOMIC_ACQUIRE, "agent");
            xb_add(&bar[XB_XGEN(bx)], 1u);
            asm volatile("s_waitcnt vmcnt(0)" ::: "memory");
        } else {
            XB_SPIN(xb_ld(&bar[XB_XGEN(bx)]) == gen, bar);
            __builtin_amdgcn_fence(__ATOMIC_ACQUIRE, "agent");
            asm volatile("s_waitcnt vmcnt(0)" ::: "memory");
        }
    }
    __syncthreads();
}

constexpr int NWAVES = 8, NTHR = 512;
constexpr int RING_BYTES = 131072, MISC_OFF = RING_BYTES + 320, LDS_BYTES = 147456;

struct Inputs {
    const float *x, *c, *ctx, *c_ctx, *ada_w, *ada_b, *norm1_g, *w_in, *ret_decay, *ret_gn_g, *gdn_conv_w, *gdn_a_log, *gdn_dt_bias, *gdn_norm_g, *swa_sink, *w_out, *norm2_g,
        *ffn_w1, *ffn_w3, *ffn_w2, *router_w, *moe_w1, *moe_w3, *moe_w2, *final_g;
};
struct Args { Inputs in; float* out; unsigned char* ws; int ph_lo, ph_hi; };
static_assert(sizeof(Args) == 25 * 8 + 8 + 8 + 8, "no padding");


__device__ __forceinline__ const float* ld_ptr(const LAS unsigned long long* t, int i) { const unsigned long long v = t[i]; const unsigned lo = __builtin_amdgcn_readfirstlane((unsigned)v), hi = __builtin_amdgcn_readfirstlane((unsigned)(v >> 32)); return (const float*)(((unsigned long long)hi << 32) | lo); }
__device__ __forceinline__ Inputs load_inputs(const LAS unsigned long long* t) {
    Inputs in; const float** ip = (const float**)&in;
#pragma unroll
    for (int i = 0; i < 25; ++i) ip[i] = ld_ptr(t, i);
    return in;
}
struct Frame {
    LAS unsigned char* lds;
    int tid, lane, wave, G, gw, NGW, bid;
    unsigned char* ws;
};

template <class SrcF>
__device__ __forceinline__ void transpose_item(const SrcF& src, int K, bf16* WT, LAS float* scr, int k0, int n0, int lane) {
#pragma unroll
    for (int i = 0; i < 8; ++i) { const int row = 4 * i + (lane >> 4), col = 4 * (lane & 15); *(LAS f32x4*)(scr + row * 68 + col) = src(k0 + row, n0 + col); }
    LDS_WAIT(); asm volatile("" ::: "memory");
#pragma unroll
    for (int j = 0; j < 4; ++j) { const int ch = j * 64 + lane, n = ch >> 2, c8 = ch & 3; const LAS float* sp = scr + (8 * c8) * 68 + n;
        u32x4 o; o.x = cvtpk(sp[0 * 68], sp[1 * 68]); o.y = cvtpk(sp[2 * 68], sp[3 * 68]); o.z = cvtpk(sp[4 * 68], sp[5 * 68]); o.w = cvtpk(sp[6 * 68], sp[7 * 68]);
        *(u32x4*)(WT + (size_t)(n0 + n) * K + k0 + 8 * c8) = o; }
    LDS_WAIT(); asm volatile("" ::: "memory");
}
struct SrcPlain { const float* W; int ld; __device__ __forceinline__ f32x4 operator()(int k, int n) const { return *(const f32x4*)(W + (size_t)k * ld + n); } };
struct SrcWin { const float* W; __device__ __forceinline__ f32x4 operator()(int k, int n) const { return *(const f32x4*)(W + (size_t)k * INC + (n < 2048 ? n : n + 16)); } };
struct SrcGU { const float* W1; const float* W3; int ld; __device__ __forceinline__ f32x4 operator()(int k, int n) const { const int g = n >> 5, i = n & 31; const ptrdiff_t d = (i < 16) ? (ptrdiff_t)0 : (W3 - W1); return *(const f32x4*)(W1 + d + (ptrdiff_t)k * ld + 16 * g + (i & 15)); } };

__device__ __forceinline__ void convert_moe_layer(Frame& F, const Inputs& in, int mi) {
    LAS float* scr = (LAS float*)(F.lds + F.wave * 16384);
    bf16* mw13 = (bf16*)(F.ws + WS_MW13); bf16* mw2 = (bf16*)(F.ws + WS_MW2);
    constexpr int I13 = (D / 32) * (2 * EF / 64), I2 = (EF / 32) * (D / 64);
    for (int it = F.gw; it < NE * (I13 + I2); it += F.NGW) {
        const int e = it / (I13 + I2); int r = it % (I13 + I2);
        const size_t wo = ((size_t)mi * NE + e) * (size_t)D * EF;
        if (r < I13) { const int nblk = 2 * EF / 64; SrcGU s{in.moe_w1 + wo, in.moe_w3 + wo, EF}; transpose_item(s, D, mw13 + (size_t)e * 2 * EF * D, scr, 32 * (r / nblk), 64 * (r % nblk), F.lane); }
        else { r -= I13; const int nblk = D / 64; SrcPlain s{in.moe_w2 + wo, D}; transpose_item(s, EF, mw2 + (size_t)e * D * EF, scr, 32 * (r / nblk), 64 * (r % nblk), F.lane); }
    }
}

__device__ __forceinline__ void phase_prologue(Frame& F, const Inputs& in) {
    LAS float* scr = (LAS float*)(F.lds + F.wave * 16384);
    {
        constexpr int I_IN = (D / 32) * (NP / 64), I_OUT = (D / 32) * (D / 64), I_13 = (D / 32) * (2 * FF / 64), I_2 = (FF / 32) * (D / 64);
        constexpr int PER_L = I_IN + I_OUT, PER_F = I_13 + I_2, TOT = DEPTH * PER_L + 2 * PER_F;
        for (int it = F.gw; it < TOT; it += F.NGW) {
            if (it < DEPTH * PER_L) { const int l = it / PER_L; int r = it % PER_L;
                if (r < I_IN) { const int nblk = NP / 64; SrcWin s{in.w_in + (size_t)l * D * INC}; transpose_item(s, D, (bf16*)(F.ws + WS_WIN) + (size_t)l * NP * D, scr, 32 * (r / nblk), 64 * (r % nblk), F.lane); }
                else { r -= I_IN; const int nblk = D / 64; SrcPlain s{in.w_out + (size_t)l * D * D, D}; transpose_item(s, D, (bf16*)(F.ws + WS_WOUT) + (size_t)l * D * D, scr, 32 * (r / nblk), 64 * (r % nblk), F.lane); }
            } else { const int q = it - DEPTH * PER_L; const int i = q / PER_F; int r = q % PER_F;
                if (r < I_13) { const int nblk = 2 * FF / 64; SrcGU s{in.ffn_w1 + (size_t)i * D * FF, in.ffn_w3 + (size_t)i * D * FF, FF}; transpose_item(s, D, (bf16*)(F.ws + WS_W13) + (size_t)i * 2 * FF * D, scr, 32 * (r / nblk), 64 * (r % nblk), F.lane); }
                else { r -= I_13; const int nblk = D / 64; SrcPlain s{in.ffn_w2 + (size_t)i * FF * D, D}; transpose_item(s, FF, (bf16*)(F.ws + WS_W2) + (size_t)i * D * FF, scr, 32 * (r / nblk), 64 * (r % nblk), F.lane); }
            }
        }
    }
    convert_moe_layer(F, in, 0);
    {
        __syncthreads();
        LAS float* sc = (LAS float*)F.lds;
        LAS float* red = (LAS float*)(F.lds + 32768);
        for (int i = F.tid; i < 5 * D; i += NTHR) { const int r = i / D, k = i % D; const float v = r < 4 ? in.c[r * D + k] : in.c_ctx[k]; sc[i] = siluf(v); }
        __syncthreads();
        float* mod = (float*)(F.ws + WS_MOD);
        for (int u = F.bid; u < DEPTH * 96; u += F.G) {
            const int l = u / 96, n = (u % 96) * 64 + F.lane;
            const float* w = in.ada_w + (size_t)l * D * 6 * D + n;
            float a[5] = {0.f, 0.f, 0.f, 0.f, 0.f};
            for (int k = F.wave * 128; k < F.wave * 128 + 128; ++k) { const float wv = w[(size_t)k * 6 * D];
#pragma unroll
                for (int r = 0; r < 5; ++r) a[r] += sc[r * D + k] * wv; }
#pragma unroll
            for (int r = 0; r < 5; ++r) red[(F.wave * 5 + r) * 64 + F.lane] = a[r];
            __syncthreads();
            if (F.tid < 320) { const int r = F.tid / 64, ln = F.tid % 64; float s = 0.f;
#pragma unroll
                for (int w8 = 0; w8 < 8; ++w8) s += red[(w8 * 5 + r) * 64 + ln];
                const int nn = (u % 96) * 64 + ln;
                mod[((size_t)l * 5 + r) * 6 * D + nn] = s + in.ada_b[(size_t)l * 6 * D + nn]; }
            __syncthreads();
        }
    }
    if (F.bid == 0) { float* rp = (float*)(F.ws + WS_ROPE);
        for (int i = F.tid; i < 64 * 16; i += NTHR) { const int pos = i / 16, fi = i % 16; const double inv = pow(10000.0, -(double)fi / 16.0), ang = (double)pos * inv; rp[2 * i] = (float)cos(ang); rp[2 * i + 1] = (float)sin(ang); } }
}

__device__ __forceinline__ int mod_row(int m) { return m < MC ? 4 : ((m - MC) >> 12); }

template <int MODE>
__device__ __forceinline__ void phase_token(Frame& F, const Inputs& in, int layer, bool first_from_input, bool combine_moe, bool moe_router, float* out) {
    float* XS = (float*)(F.ws + WS_XS);
    bf16* H = (bf16*)(F.ws + WS_H);
    const float* mod = (const float*)(F.ws + WS_MOD) + (size_t)(layer < DEPTH ? layer : DEPTH - 1) * 5 * 6 * D;
    const float* modprev = (const float*)(F.ws + WS_MOD) + (size_t)(layer > 0 ? layer - 1 : 0) * 5 * 6 * D;
    const int* TKE = (const int*)(F.ws + WS_TKE); const float* TKG = (const float*)(F.ws + WS_TKG); const int* TOKROW = (const int*)(F.ws + WS_TOKROW);
    const float* YM = (const float*)(F.ws + WS_YM);
    LAS float* wl = (LAS float*)F.lds;
    if (MODE == 0) { __syncthreads(); const float* w = in.w_in + (size_t)layer * D * INC + 2048; for (int i = F.tid; i < D * 16; i += NTHR) { const int k = i >> 4, c = i & 15, kp = ((k >> 8) * 4 + (k & 3)) * 64 + ((k >> 2) & 63); wl[((c >> 2) * 1024 + kp) * 4 + (c & 3)] = w[(size_t)k * INC + c]; } __syncthreads(); }
    LAS int* lcnt = (LAS int*)(F.lds + 61440);
    if (MODE == 1 && moe_router) { __syncthreads(); if (F.tid < 8) lcnt[F.tid] = 0; const float* w = in.router_w + (size_t)(layer >> 1) * D * NE; for (int i = F.tid; i < D * NE; i += NTHR) { const int k = i >> 3, c = i & 7, kp = ((k >> 8) * 4 + (k & 3)) * 64 + ((k >> 2) & 63); wl[((c >> 2) * 1024 + kp) * 4 + (c & 3)] = w[i]; } __syncthreads(); }
    const float* gain = MODE == 0 ? in.norm1_g + (size_t)layer * D : (MODE == 1 ? in.norm2_g + (size_t)layer * D : in.final_g);
    const int m_lo = (MODE == 2) ? MC : 0;
    for (int m = m_lo + F.gw; m < M; m += F.NGW) {
        const int r = mod_row(m);
        f32x4 v[4];
        const float* xrow = first_from_input ? (m < MC ? in.ctx + (size_t)m * D : in.x + (size_t)(m - MC) * D) : XS + (size_t)m * D;
#pragma unroll
        for (int j = 0; j < 4; ++j) v[j] = *(const f32x4*)(xrow + 4 * F.lane + 256 * j);
        bool wrote = first_from_input;
        if (combine_moe && !(layer == DEPTH && m < MC)) {
            const int r0 = TOKROW[2 * m], r1 = TOKROW[2 * m + 1]; const float g0 = TKG[2 * m], g1 = TKG[2 * m + 1];
            const float* gt = modprev + (size_t)r * 6 * D + 5 * D;
#pragma unroll
            for (int j = 0; j < 4; ++j) { const f32x4 y0 = *(const f32x4*)(YM + (size_t)r0 * D + 4 * F.lane + 256 * j), y1 = *(const f32x4*)(YM + (size_t)r1 * D + 4 * F.lane + 256 * j);
                const f32x4 gg = *(const f32x4*)(gt + 4 * F.lane + 256 * j); v[j] += gg * (g0 * y0 + g1 * y1); }
            wrote = true;
        }
        if (wrote && MODE != 2) {
#pragma unroll
            for (int j = 0; j < 4; ++j) *(f32x4*)(XS + (size_t)m * D + 4 * F.lane + 256 * j) = v[j];
        }
        float ss = 0.f;
#pragma unroll
        for (int j = 0; j < 4; ++j) ss += (v[j].x * v[j].x + v[j].y * v[j].y) + (v[j].z * v[j].z + v[j].w * v[j].w);
        const float rstd = 1.0f / sqrtf(wave_sum(ss) * (1.0f / D) + EPS);
        if (MODE == 2) {
#pragma unroll
            for (int j = 0; j < 4; ++j) { const f32x4 g = *(const f32x4*)(gain + 4 * F.lane + 256 * j); *(f32x4*)(out + (size_t)(m - MC) * D + 4 * F.lane + 256 * j) = v[j] * rstd * g; }
            continue;
        }
        const float* sh = mod + (size_t)r * 6 * D + (MODE == 0 ? 0 : 3) * D; const float* scl = sh + D;
        f32x4 h[4];
#pragma unroll
        for (int j = 0; j < 4; ++j) { const f32x4 g = *(const f32x4*)(gain + 4 * F.lane + 256 * j), s1 = *(const f32x4*)(scl + 4 * F.lane + 256 * j), s0 = *(const f32x4*)(sh + 4 * F.lane + 256 * j);
            h[j] = v[j] * rstd * g * (1.0f + s1) + s0;
            u32x2 w; w.x = pk2(h[j].x, h[j].y); w.y = pk2(h[j].z, h[j].w); *(u32x2*)(H + (size_t)m * D + 4 * F.lane + 256 * j) = w; }
        if (MODE == 0) {
            float a[16];
#pragma unroll
            for (int c = 0; c < 16; ++c) a[c] = 0.f;
#pragma unroll
            for (int j = 0; j < 4; ++j)
#pragma unroll
                for (int e = 0; e < 4; ++e) { const int kp = (j * 4 + e) * 64 + F.lane; const float hv = h[j][e];
#pragma unroll
                    for (int q = 0; q < 4; ++q) { const f32x4 w = *(const LAS f32x4*)(wl + (q * 1024 + kp) * 4); a[4 * q] += hv * w.x; a[4 * q + 1] += hv * w.y; a[4 * q + 2] += hv * w.z; a[4 * q + 3] += hv * w.w; } }
            float mine = 0.f;
#pragma unroll
            for (int c = 0; c < 16; ++c) { const float s = wave_sum(a[c]); mine = (F.lane == c) ? s : mine; }
            if (F.lane < 16) ((float*)(F.ws + WS_AB))[(size_t)m * 16 + F.lane] = mine;
        }
        if (MODE == 1 && moe_router) {
            float a[8];
#pragma unroll
            for (int c = 0; c < 8; ++c) a[c] = 0.f;
#pragma unroll
            for (int j = 0; j < 4; ++j)
#pragma unroll
                for (int e = 0; e < 4; ++e) { const int kp = (j * 4 + e) * 64 + F.lane; const float hv = h[j][e];
#pragma unroll
                    for (int q = 0; q < 2; ++q) { const f32x4 w = *(const LAS f32x4*)(wl + (q * 1024 + kp) * 4); a[4 * q] += hv * w.x; a[4 * q + 1] += hv * w.y; a[4 * q + 2] += hv * w.z; a[4 * q + 3] += hv * w.w; } }
#pragma unroll
            for (int c = 0; c < 8; ++c) a[c] = wave_sum(a[c]);
            int i0 = 0; float l0 = a[0];
#pragma unroll
            for (int c = 1; c < 8; ++c) if (a[c] > l0) { l0 = a[c]; i0 = c; }
            int i1 = -1; float l1 = -3.0e38f;
#pragma unroll
            for (int c = 0; c < 8; ++c) if (c != i0 && a[c] > l1) { l1 = a[c]; i1 = c; }
            const float e1 = __expf(l1 - l0), g0 = 1.0f / (1.0f + e1), g1 = e1 / (1.0f + e1);
            if (F.lane == 0) { ((int*)(F.ws + WS_TKE))[2 * m] = i0; ((int*)(F.ws + WS_TKE))[2 * m + 1] = i1; ((float*)(F.ws + WS_TKG))[2 * m] = g0; ((float*)(F.ws + WS_TKG))[2 * m + 1] = g1; }
        }
    }
    (void)TKE;
}


template <int MODE>
__device__ __forceinline__ void phase_token2(Frame& F, const Inputs& in, int layer, bool first_from_input, bool combine_moe, bool moe_router, float* out, int route_lo = 0) {
    float* XS = (float*)(F.ws + WS_XS);
    bf16* H = (bf16*)(F.ws + WS_H);
    const float* mod = (const float*)(F.ws + WS_MOD) + (size_t)(layer < DEPTH ? layer : DEPTH - 1) * 5 * 6 * D;
    const float* modprev = (const float*)(F.ws + WS_MOD) + (size_t)(layer > 0 ? layer - 1 : 0) * 5 * 6 * D;
    const float* TKG = (const float*)(F.ws + WS_TKG); const int* TOKROW = (const int*)(F.ws + WS_TOKROW);
    const float* YM = (const float*)(F.ws + WS_YM);
    LAS float* wl = (LAS float*)F.lds;
    const int lane = F.lane;
    if (MODE == 0) PB(8);
    if (MODE == 0) { __syncthreads(); const float* w = in.w_in + (size_t)layer * D * INC + 2048;
#pragma unroll
        for (int n = 0; n < 8; ++n) { const int k = (F.tid >> 2) + 128 * n, q4 = F.tid & 3, kp = ((k >> 8) * 4 + (k & 3)) * 64 + ((k >> 2) & 63);
            *(LAS f32x4*)(wl + (q4 * 1024 + kp) * 4) = *(const f32x4*)(w + (size_t)k * INC + 4 * q4); }
        __syncthreads(); }
    LAS int* lcnt = (LAS int*)(F.lds + 61440);
    if (MODE == 1 && moe_router) { __syncthreads(); if (F.tid < 8) lcnt[F.tid] = 0; const float* w = in.router_w + (size_t)(layer >> 1) * D * NE;
#pragma unroll
        for (int n = 0; n < 4; ++n) { const int k = (F.tid >> 1) + 256 * n, q4 = F.tid & 1, kp = ((k >> 8) * 4 + (k & 3)) * 64 + ((k >> 2) & 63);
            *(LAS f32x4*)(wl + (q4 * 1024 + kp) * 4) = *(const f32x4*)(w + (size_t)k * NE + 4 * q4); }
        __syncthreads(); }
    if (MODE == 0) PE(8);
    if (MODE == 0) PB(9);
    if (MODE == 1) PB(10);
    const float* gain = MODE == 0 ? in.norm1_g + (size_t)layer * D : (MODE == 1 ? in.norm2_g + (size_t)layer * D : in.final_g);
    const int m_lo = (MODE == 2) ? MC : 0, R = M - m_lo;
    const int r_beg = m_lo + (int)(((long)F.gw * R) / F.NGW), r_end = m_lo + (int)(((long)(F.gw + 1) * R) / F.NGW);
    f32x4 gv[4], av[4], bv[4], gt[4];
#pragma unroll
    for (int j = 0; j < 4; ++j) gv[j] = *(const f32x4*)(gain + 4 * lane + 256 * j);
    int rcur = -1;
    for (int m0 = r_beg; m0 < r_end; m0 += 2) {
        const int ma = m0; const bool two = ma + 1 < r_end; const int m1 = two ? ma + 1 : ma;
        const int r = mod_row(ma);
        const bool same = mod_row(m1) == r;
        const int mm1 = same ? m1 : ma; const bool do1 = two && same;
        if (!same) m0 -= 1;
        if (r != rcur) { rcur = r;
            if (MODE != 2) { const float* sh = mod + (size_t)r * 6 * D + (MODE == 0 ? 0 : 3) * D;
#pragma unroll
                for (int j = 0; j < 4; ++j) { const f32x4 s1 = *(const f32x4*)(sh + D + 4 * lane + 256 * j); av[j] = gv[j] * (1.0f + s1); bv[j] = *(const f32x4*)(sh + 4 * lane + 256 * j); } }
            if (combine_moe) {
#pragma unroll
                for (int j = 0; j < 4; ++j) gt[j] = *(const f32x4*)(modprev + (size_t)r * 6 * D + 5 * D + 4 * lane + 256 * j); } }
        const int mr[2] = {ma, mm1};
        f32x4 v[2][4];
        int t0[2], t1[2]; float g0[2], g1[2];
        if (combine_moe) {
#pragma unroll
            for (int p = 0; p < 2; ++p) { t0[p] = TOKROW[2 * mr[p]]; t1[p] = TOKROW[2 * mr[p] + 1]; g0[p] = TKG[2 * mr[p]]; g1[p] = TKG[2 * mr[p] + 1]; } }
#pragma unroll
        for (int p = 0; p < 2; ++p) { const int m = mr[p];
            const float* xrow = first_from_input ? (m < MC ? in.ctx + (size_t)m * D : in.x + (size_t)(m - MC) * D) : XS + (size_t)m * D;
#pragma unroll
            for (int j = 0; j < 4; ++j) v[p][j] = *(const f32x4*)(xrow + 4 * lane + 256 * j); }
        if (combine_moe) {
#pragma unroll
            for (int p = 0; p < 2; ++p)
#pragma unroll
                for (int j = 0; j < 4; ++j) { const f32x4 y0 = *(const f32x4*)(YM + (size_t)t0[p] * D + 4 * lane + 256 * j), y1 = *(const f32x4*)(YM + (size_t)t1[p] * D + 4 * lane + 256 * j);
                    v[p][j] += gt[j] * (g0[p] * y0 + g1[p] * y1); } }
        if ((first_from_input || combine_moe) && MODE != 2) {
#pragma unroll
            for (int p = 0; p < 2; ++p) if (p == 0 || do1) {
#pragma unroll
                for (int j = 0; j < 4; ++j) *(f32x4*)(XS + (size_t)mr[p] * D + 4 * lane + 256 * j) = v[p][j]; } }
        float rstd[2];
#pragma unroll
        for (int p = 0; p < 2; ++p) { float ss = 0.f;
#pragma unroll
            for (int j = 0; j < 4; ++j) ss += (v[p][j].x * v[p][j].x + v[p][j].y * v[p][j].y) + (v[p][j].z * v[p][j].z + v[p][j].w * v[p][j].w);
            rstd[p] = 1.0f / sqrtf(wave_sum(ss) * (1.0f / D) + EPS); }
        if (MODE == 2) {
#pragma unroll
            for (int p = 0; p < 2; ++p) if (p == 0 || do1) {
#pragma unroll
                for (int j = 0; j < 4; ++j) *(f32x4*)(out + (size_t)(mr[p] - MC) * D + 4 * lane + 256 * j) = v[p][j] * rstd[p] * gv[j]; }
            continue; }
        f32x4 h[2][4];
#pragma unroll
        for (int p = 0; p < 2; ++p)
#pragma unroll
            for (int j = 0; j < 4; ++j) { h[p][j] = v[p][j] * rstd[p] * av[j] + bv[j];
                if (p == 0 || do1) { u32x2 w; w.x = cvtpk(h[p][j].x, h[p][j].y); w.y = cvtpk(h[p][j].z, h[p][j].w); *(u32x2*)(H + (size_t)mr[p] * D + 4 * lane + 256 * j) = w; } }
        if (MODE == 0 || (MODE == 1 && moe_router)) {
            constexpr int NC = (MODE == 0) ? 16 : 8;
            float a[2][NC];
#pragma unroll
            for (int p = 0; p < 2; ++p)
#pragma unroll
                for (int c = 0; c < NC; ++c) a[p][c] = 0.f;
#pragma unroll
            for (int j = 0; j < 4; ++j)
#pragma unroll
                for (int e = 0; e < 4; ++e) { const int kp = (j * 4 + e) * 64 + lane;
#pragma unroll
                    for (int q = 0; q < NC / 4; ++q) { const f32x4 w = *(const LAS f32x4*)(wl + (q * 1024 + kp) * 4);
#pragma unroll
                        for (int p = 0; p < 2; ++p) { const float hv = h[p][j][e]; a[p][4 * q] += hv * w.x; a[p][4 * q + 1] += hv * w.y; a[p][4 * q + 2] += hv * w.z; a[p][4 * q + 3] += hv * w.w; } } }
#pragma unroll
            for (int p = 0; p < 2; ++p) {
#pragma unroll
                for (int c = 0; c < NC; ++c) a[p][c] = wave_sum(a[p][c]); }
#pragma unroll
            for (int p = 0; p < 2; ++p) if (p == 0 || do1) { const int m = mr[p];
                if (MODE == 0) { float mine = 0.f;
#pragma unroll
                    for (int c = 0; c < NC; ++c) mine = (lane == c) ? a[p][c] : mine;
                    if (lane < 16) ((float*)(F.ws + WS_AB))[(size_t)m * 16 + lane] = mine; }
                else { int i0 = 0; float l0 = a[p][0];
#pragma unroll
                    for (int c = 1; c < NC; ++c) if (a[p][c] > l0) { l0 = a[p][c]; i0 = c; }
                    int i1 = -1; float l1 = -3.0e38f;
#pragma unroll
                    for (int c = 0; c < NC; ++c) if (c != i0 && a[p][c] > l1) { l1 = a[p][c]; i1 = c; }
                    const float e1 = __expf(l1 - l0), gg0 = 1.0f / (1.0f + e1), gg1 = e1 / (1.0f + e1);
                    if (lane == 0 && m >= route_lo) { ((int*)(F.ws + WS_TKE))[2 * m] = i0; ((int*)(F.ws + WS_TKE))[2 * m + 1] = i1; ((float*)(F.ws + WS_TKG))[2 * m] = gg0; ((float*)(F.ws + WS_TKG))[2 * m + 1] = gg1;
                        ((int*)(F.ws + WS_TOKROW))[2 * m] = __hip_atomic_fetch_add(lcnt + i0, 1, __ATOMIC_RELAXED, __HIP_MEMORY_SCOPE_WORKGROUP); ((int*)(F.ws + WS_TOKROW))[2 * m + 1] = __hip_atomic_fetch_add(lcnt + i1, 1, __ATOMIC_RELAXED, __HIP_MEMORY_SCOPE_WORKGROUP); } } }
        }
    }
    if (MODE == 0) PE(9);
    if (MODE == 1) PE(10);
    if (MODE == 1 && moe_router) { __syncthreads(); if (F.tid < 8) ((int*)(F.ws + WS_TILEE + 4096))[F.bid * 8 + F.tid] = lcnt[F.tid]; }
}

__device__ __forceinline__ void phase_prep(Frame& F, const Inputs& in, int layer) {
    const bf16* P = (const bf16*)(F.ws + WS_R1 + R1_P);
    unsigned char* prep = F.ws + WS_R1 + R1_PREP;
    bf16* RQ = (bf16*)(prep + PREP_RQ); bf16* RK = (bf16*)(prep + PREP_RK); bf16* SQ = (bf16*)(prep + PREP_SQ); bf16* SK = (bf16*)(prep + PREP_SK); bf16* GD = (bf16*)(prep + PREP_GD);
    const float* rope = (const float*)(F.ws + WS_ROPE);
    const float* AB = (const float*)(F.ws + WS_AB); float* GB = (float*)(F.ws + WS_GB);
    const float* cw = in.gdn_conv_w + (size_t)layer * 5 * 768;
    const int lane = F.lane;
    for (int m = F.gw; m < M; m += F.NGW) {
        const bool lat = m >= MC; const int t = lat ? ((m - MC) & (TL - 1)) : (m & (TC - 1)); const int Tn = lat ? TL : TC;
        const bf16* prow = P + (size_t)m * NP;
        float cs = 1.f, sn = 0.f;
        if (lat) { const int j = lane & 31; const int pos = j < 16 ? (t >> 6) : (t & 63); const int fi = j & 15; cs = rope[(pos * 16 + fi) * 2]; sn = rope[(pos * 16 + fi) * 2 + 1]; if (lane < 32) sn = -sn; }
#pragma unroll
        for (int hh = 0; hh < 4; ++hh) { const float q = bf2f(prow[PC_RQ + hh * 64 + lane]), k = bf2f(prow[PC_RK + hh * 64 + lane]) * 0.125f;
            const float qp = __shfl_xor(q, 32), kp = __shfl_xor(k, 32);
            RQ[(size_t)m * 256 + hh * 64 + lane] = (bf16)f2bf(q * cs + qp * sn); RK[(size_t)m * 256 + hh * 64 + lane] = (bf16)f2bf(k * cs + kp * sn); }
#pragma unroll
        for (int hq = 0; hq < 8; ++hq) { const float q = bf2f(prow[PC_SQ + hq * 64 + lane]); const float qp = __shfl_xor(q, 32); SQ[(size_t)m * 512 + hq * 64 + lane] = (bf16)f2bf(q * cs + qp * sn); }
#pragma unroll
        for (int g = 0; g < 2; ++g) { const float k = bf2f(prow[PC_SK + g * 64 + lane]); const float kp = __shfl_xor(k, 32); SK[(size_t)m * 128 + g * 64 + lane] = (bf16)f2bf(k * cs + kp * sn); }
#pragma unroll 1
        for (int s = 0; s < 12; ++s) { const int c = s * 64 + lane; float y = 0.f;
#pragma unroll
            for (int j = 0; j < 5; ++j) { const int tt = t + j - 2; if (tt >= 0 && tt < Tn) y += cw[j * 768 + c] * bf2f(prow[(ptrdiff_t)(j - 2) * NP + PC_GQKV + c]); }
            y = siluf(y);
            if (s < 8) { const float n2 = wave_sum(y * y); y = y * (1.0f / sqrtf(n2 + EPS)); if (s < 4) y *= 0.125f; }
            GD[(size_t)m * 768 + c] = (bf16)f2bf(y); }
        if (lane < 16) { const int dh = lane & 7; const float a = AB[(size_t)m * 16 + lane];
            float o;
            if (lane < 8) { const float xx = a + in.gdn_dt_bias[layer * 8 + dh]; const float sp = fmaxf(xx, 0.f) + log1pf(__expf(-fabsf(xx))); o = -__expf(in.gdn_a_log[layer * 8 + dh]) * sp; }
            else o = 1.0f / (1.0f + __expf(-a));
            GB[(size_t)m * 16 + lane] = o; }
    }
}


__device__ __forceinline__ void unpack8(const u32x4 w, float (&v)[8]) {
#pragma unroll
    for (int e = 0; e < 4; ++e) { v[2 * e] = __uint_as_float(w[e] << 16); v[2 * e + 1] = __uint_as_float(w[e] & 0xffff0000u); } }
__device__ __forceinline__ u32x4 pack8(const float (&v)[8]) { u32x4 w; w.x = cvtpk(v[0], v[1]); w.y = cvtpk(v[2], v[3]); w.z = cvtpk(v[4], v[5]); w.w = cvtpk(v[6], v[7]); return w; }
__device__ __forceinline__ void phase_prep2(Frame& F, const Inputs& in, int layer) {
    const bf16* P = (const bf16*)(F.ws + WS_R1 + R1_P);
    unsigned char* prep = F.ws + WS_R1 + R1_PREP;
    bf16* RQ = (bf16*)(prep + PREP_RQ); bf16* RK = (bf16*)(prep + PREP_RK); bf16* SQ = (bf16*)(prep + PREP_SQ); bf16* SK = (bf16*)(prep + PREP_SK); bf16* GD = (bf16*)(prep + PREP_GD);
    const float* rope = (const float*)(F.ws + WS_ROPE);
    const float* AB = (const float*)(F.ws + WS_AB); float* GB = (float*)(F.ws + WS_GB);
    const float* cw = in.gdn_conv_w + (size_t)layer * 5 * 768;
    const int lane = F.lane, l3 = lane & 3, l31 = lane & 31;
    float wA[5][8], wB[5][8];
#pragma unroll
    for (int j = 0; j < 5; ++j) { const f32x4 a0 = *(const f32x4*)(cw + j * 768 + 8 * lane), a1 = *(const f32x4*)(cw + j * 768 + 8 * lane + 4), b0 = *(const f32x4*)(cw + j * 768 + 512 + 8 * l31), b1 = *(const f32x4*)(cw + j * 768 + 512 + 8 * l31 + 4);
#pragma unroll
        for (int x = 0; x < 4; ++x) { wA[j][x] = a0[x]; wA[j][4 + x] = a1[x]; wB[j][x] = b0[x]; wB[j][4 + x] = b1[x]; } }
    const float sgn = ((lane & 7) < 4) ? -1.0f : 1.0f;
    for (int m = F.gw; m < M; m += F.NGW) {
        const bool lat = m >= MC; const int t = lat ? ((m - MC) & (TL - 1)) : (m & (TC - 1)); const int Tn = lat ? TL : TC;
        const bf16* prow = P + (size_t)m * NP;
        float cs[8], sn[8];
        { const int pos = (l3 < 2) ? (t >> 6) : (t & 63); const float* rp = rope + (pos * 16 + 8 * (l3 & 1)) * 2;
          const f32x4 r0 = *(const f32x4*)(rp), r1 = *(const f32x4*)(rp + 4), r2 = *(const f32x4*)(rp + 8), r3 = *(const f32x4*)(rp + 12);
          cs[0] = r0[0]; sn[0] = r0[1]; cs[1] = r0[2]; sn[1] = r0[3]; cs[2] = r1[0]; sn[2] = r1[1]; cs[3] = r1[2]; sn[3] = r1[3];
          cs[4] = r2[0]; sn[4] = r2[1]; cs[5] = r2[2]; sn[5] = r2[3]; cs[6] = r3[0]; sn[6] = r3[1]; cs[7] = r3[2]; sn[7] = r3[3];
#pragma unroll
          for (int x = 0; x < 8; ++x) { if (!lat) { cs[x] = 1.0f; sn[x] = 0.0f; } sn[x] *= sgn; } }
        { const bool isk = lane >= 32; float v[8], o[8]; unpack8(*(const u32x4*)(prow + (isk ? PC_RK : PC_RQ) + 8 * l31), v);
#pragma unroll
          for (int x = 0; x < 8; ++x) { if (isk) v[x] *= 0.125f; const float pv = __shfl_xor(v[x], 4); o[x] = v[x] * cs[x] + pv * sn[x]; }
          *(u32x4*)((isk ? RK : RQ) + (size_t)m * 256 + 8 * l31) = pack8(o); }
        { float v[8], o[8]; unpack8(*(const u32x4*)(prow + PC_SQ + 8 * lane), v);
#pragma unroll
          for (int x = 0; x < 8; ++x) { const float pv = __shfl_xor(v[x], 4); o[x] = v[x] * cs[x] + pv * sn[x]; }
          *(u32x4*)(SQ + (size_t)m * 512 + 8 * lane) = pack8(o); }
        { float v[8], o[8]; unpack8(*(const u32x4*)(prow + PC_SK + 8 * (lane & 15)), v);
#pragma unroll
          for (int x = 0; x < 8; ++x) { const float pv = __shfl_xor(v[x], 4); o[x] = v[x] * cs[x] + pv * sn[x]; }
          if (lane < 16) *(u32x4*)(SK + (size_t)m * 128 + 8 * lane) = pack8(o); }
        { float a[8], bq[8];
#pragma unroll
          for (int x = 0; x < 8; ++x) { a[x] = 0.f; bq[x] = 0.f; }
#pragma unroll
          for (int j = 0; j < 5; ++j) { const int tt = t + j - 2; const bool ok = tt >= 0 && tt < Tn; const bf16* pr = prow + (ok ? (ptrdiff_t)(j - 2) * NP : (ptrdiff_t)0) + PC_GQKV;
              float va[8], vb[8]; unpack8(*(const u32x4*)(pr + 8 * lane), va); unpack8(*(const u32x4*)(pr + 512 + 8 * l31), vb);
              const float z = ok ? 1.0f : 0.0f;
#pragma unroll
              for (int x = 0; x < 8; ++x) { a[x] += z * wA[j][x] * va[x]; bq[x] += z * wB[j][x] * vb[x]; } }
          float n2 = 0.f;
#pragma unroll
          for (int x = 0; x < 8; ++x) { a[x] = siluf(a[x]); bq[x] = siluf(bq[x]); n2 += a[x] * a[x]; }
          n2 += dppf<0xB1>(n2); n2 += dppf<0x4E>(n2); n2 += dppf<0x141>(n2);
          const float sc = (1.0f / sqrtf(n2 + EPS)) * (lane < 32 ? 0.125f : 1.0f);
#pragma unroll
          for (int x = 0; x < 8; ++x) a[x] *= sc;
          *(u32x4*)(GD + (size_t)m * 768 + 8 * lane) = pack8(a);
          if (lane < 32) *(u32x4*)(GD + (size_t)m * 768 + 512 + 8 * lane) = pack8(bq); }
        if (lane < 16) { const int dh = lane & 7; const float a = AB[(size_t)m * 16 + lane];
            float o;
            if (lane < 8) { const float xx = a + in.gdn_dt_bias[layer * 8 + dh]; const float sp = fmaxf(xx, 0.f) + log1pf(__expf(-fabsf(xx))); o = -__expf(in.gdn_a_log[layer * 8 + dh]) * sp; }
            else o = 1.0f / (1.0f + __expf(-a));
            GB[(size_t)m * 16 + lane] = o; }
    }
}

__device__ __forceinline__ int scan_row(int b, int dir, int tau) {
    if (tau < TC) { const int c = dir ? TC - 1 - tau : tau; return b * TC + c; }
    const int tt = tau - TC; const int t = dir ? TL - 1 - tt : tt; return MC + b * TL + t;
}
__device__ __forceinline__ void phase_scans(Frame& F, const Inputs& in, int layer, int nscan) {
    if (F.wave != 0 || F.bid >= nscan) return;
    const int id = F.bid; const bool gdn = id >= 32; const int sid = id & 31; const int b = sid >> 3, hh = (sid >> 1) & 3, dir = sid & 1;
    const bf16* P = (const bf16*)(F.ws + WS_R1 + R1_P);
    unsigned char* prep = F.ws + WS_R1 + R1_PREP;
    const bf16* RQ = (const bf16*)(prep + PREP_RQ); const bf16* RK = (const bf16*)(prep + PREP_RK); const bf16* GD = (const bf16*)(prep + PREP_GD);
    const float* GB = (const float*)(F.ws + WS_GB);
    float* OUT = (float*)(F.ws + WS_R1 + (gdn ? R1_OG : R1_OR)) + (size_t)dir * M * 256;
    LAS float* lk = (LAS float*)F.lds; LAS float* lq = lk + 64 * 64; LAS float* lg = lq + 64 * 64;
    const int lane = F.lane;
    float S[64];
#pragma unroll
    for (int i = 0; i < 64; ++i) S[i] = 0.f;
    const float gamma = gdn ? 0.f : __expf(-__expf(in.ret_decay[layer * 8 + dir * 4 + hh]));
    for (int t0 = 0; t0 < TC + TL; t0 += 64) {
        for (int i = 0; i < 64; ++i) { const int m = scan_row(b, dir, t0 + i);
            if (gdn) { lq[i * 64 + lane] = bf2f(GD[(size_t)m * 768 + hh * 64 + lane]); lk[i * 64 + lane] = bf2f(GD[(size_t)m * 768 + 256 + hh * 64 + lane]); if (lane < 2) lg[i * 2 + lane] = GB[(size_t)m * 16 + lane * 8 + dir * 4 + hh]; }
            else { lq[i * 64 + lane] = bf2f(RQ[(size_t)m * 256 + hh * 64 + lane]); lk[i * 64 + lane] = bf2f(RK[(size_t)m * 256 + hh * 64 + lane]); } }
        LDS_WAIT(); asm volatile("" ::: "memory");
        for (int i = 0; i < 64; ++i) { const int m = scan_row(b, dir, t0 + i);
            float o = 0.f;
            if (gdn) {
                const float v = bf2f(GD[(size_t)m * 768 + 512 + hh * 64 + lane]); const float a = __expf(lg[i * 2]), beta = lg[i * 2 + 1];
                float ks = 0.f;
#pragma unroll
                for (int d4 = 0; d4 < 16; ++d4) { const f32x4 kv = *(const LAS f32x4*)(lk + i * 64 + 4 * d4); ks += kv.x * S[4 * d4] + kv.y * S[4 * d4 + 1] + kv.z * S[4 * d4 + 2] + kv.w * S[4 * d4 + 3]; }
                const float vn = beta * (v - a * ks);
#pragma unroll
                for (int d4 = 0; d4 < 16; ++d4) { const f32x4 kv = *(const LAS f32x4*)(lk + i * 64 + 4 * d4), qv = *(const LAS f32x4*)(lq + i * 64 + 4 * d4);
                    S[4 * d4] = a * S[4 * d4] + kv.x * vn; S[4 * d4 + 1] = a * S[4 * d4 + 1] + kv.y * vn; S[4 * d4 + 2] = a * S[4 * d4 + 2] + kv.z * vn; S[4 * d4 + 3] = a * S[4 * d4 + 3] + kv.w * vn;
                    o += qv.x * S[4 * d4] + qv.y * S[4 * d4 + 1] + qv.z * S[4 * d4 + 2] + qv.w * S[4 * d4 + 3]; }
            } else {
                const float v = bf2f(P[(size_t)m * NP + PC_RV + hh * 64 + lane]);
#pragma unroll
                for (int d4 = 0; d4 < 16; ++d4) { const f32x4 kv = *(const LAS f32x4*)(lk + i * 64 + 4 * d4), qv = *(const LAS f32x4*)(lq + i * 64 + 4 * d4);
                    S[4 * d4] = gamma * S[4 * d4] + kv.x * v; S[4 * d4 + 1] = gamma * S[4 * d4 + 1] + kv.y * v; S[4 * d4 + 2] = gamma * S[4 * d4 + 2] + kv.z * v; S[4 * d4 + 3] = gamma * S[4 * d4 + 3] + kv.w * v;
                    o += qv.x * S[4 * d4] + qv.y * S[4 * d4 + 1] + qv.z * S[4 * d4 + 2] + qv.w * S[4 * d4 + 3]; }
            }
            OUT[(size_t)m * 256 + hh * 64 + lane] = o;
        }
        LDS_WAIT(); asm volatile("" ::: "memory");
    }
}

__device__ __forceinline__ void phase_swa(Frame& F, const Inputs& in, int layer) {
    const bf16* P = (const bf16*)(F.ws + WS_R1 + R1_P);
    unsigned char* prep = F.ws + WS_R1 + R1_PREP;
    const bf16* SQ = (const bf16*)(prep + PREP_SQ); const bf16* SK = (const bf16*)(prep + PREP_SK);
    bf16* O = (bf16*)(F.ws + WS_R1 + R1_O);
    const int NT = F.G * NTHR;
    for (int idx = F.bid * NTHR + F.tid; idx < M * 8; idx += NT) {
        const int hq = idx / M, m = idx % M, g = hq >> 2;
        const bool lat = m >= MC; const int b = lat ? ((m - MC) >> 12) : (m >> 8); const int t = lat ? ((m - MC) & (TL - 1)) : (m & (TC - 1));
        float q[64], o[64];
#pragma unroll
        for (int i = 0; i < 8; ++i) { const u32x4 w = *(const u32x4*)(SQ + (size_t)m * 512 + hq * 64 + 8 * i);
#pragma unroll
            for (int e = 0; e < 4; ++e) { q[8 * i + 2 * e] = __uint_as_float(w[e] << 16) * 0.125f; q[8 * i + 2 * e + 1] = __uint_as_float(w[e] & 0xffff0000u) * 0.125f; } }
#pragma unroll
        for (int i = 0; i < 64; ++i) o[i] = 0.f;
        float mx = in.swa_sink[layer * 8 + hq], l = 1.0f;
        const int nloc = lat ? 257 : 0;
        for (int kk = 0; kk < nloc + TC; ++kk) {
            int row;
            if (kk < nloc) { const int s = t - 128 + kk; if (s < 0 || s >= TL) continue; row = MC + b * TL + s; }
            else row = b * TC + (kk - nloc);
            float sc = 0.f;
#pragma unroll
            for (int i = 0; i < 8; ++i) { const u32x4 w = *(const u32x4*)(SK + (size_t)row * 128 + g * 64 + 8 * i);
#pragma unroll
                for (int e = 0; e < 4; ++e) sc += q[8 * i + 2 * e] * __uint_as_float(w[e] << 16) + q[8 * i + 2 * e + 1] * __uint_as_float(w[e] & 0xffff0000u); }
            const float mn = fmaxf(mx, sc), corr = __expf(mx - mn), p = __expf(sc - mn);
            l = l * corr + p; mx = mn;
#pragma unroll
            for (int i = 0; i < 8; ++i) { const u32x4 w = *(const u32x4*)(P + (size_t)row * NP + PC_SV + g * 64 + 8 * i);
#pragma unroll
                for (int e = 0; e < 4; ++e) { o[8 * i + 2 * e] = o[8 * i + 2 * e] * corr + p * __uint_as_float(w[e] << 16); o[8 * i + 2 * e + 1] = o[8 * i + 2 * e + 1] * corr + p * __uint_as_float(w[e] & 0xffff0000u); } }
        }
        const float il = 1.0f / l;
#pragma unroll
        for (int i = 0; i < 8; ++i) { u32x4 w;
#pragma unroll
            for (int e = 0; e < 4; ++e) w[e] = pk2(o[8 * i + 2 * e] * il, o[8 * i + 2 * e + 1] * il);
            *(u32x4*)(O + (size_t)m * D + 512 + hq * 64 + 8 * i) = w; }
    }
}


__device__ __forceinline__ void phase_swa2(Frame& F, const Inputs& in, int layer, int nwg) {
    if (F.bid >= nwg) return;
    const bf16* P = (const bf16*)(F.ws + WS_R1 + R1_P);
    unsigned char* prep = F.ws + WS_R1 + R1_PREP;
    const bf16* SQ = (const bf16*)(prep + PREP_SQ); const bf16* SK = (const bf16*)(prep + PREP_SK);
    bf16* O = (bf16*)(F.ws + WS_R1 + R1_O);
    LAS bf16* Kl = (LAS bf16*)F.lds; LAS bf16* Vt = Kl + 64 * 72;
    const int lane = F.lane, c = lane & 15, q = lane >> 4, w = F.wave;
    const float LOG2E = 1.4426950408889634f;
    const int srow = F.tid >> 3, scol = (F.tid & 7) * 8;
    for (int u = F.bid; u < 544; u += nwg) {
        const bool lat = u < 512; int b, g, qb;
        if (lat) { b = u >> 7; g = (u >> 6) & 1; qb = u & 63; } else { const int uu = u - 512; b = uu >> 3; g = (uu >> 2) & 1; qb = uu & 3; }
        const int hq = 4 * g + (w >> 1), i0 = 32 * (w & 1);
        const int mrow0 = lat ? MC + b * TL + 64 * qb : b * TC + 64 * qb;
        const int kt0 = lat ? (2 - qb > 0 ? 2 - qb : 0) : 0, kt1 = lat ? (65 - qb < 4 ? 65 - qb : 4) : -1, nb = lat ? kt1 - kt0 + 1 : 0, nt = nb + 4;
        const int band0 = MC + b * TL + 64 * qb - 128 + 64 * kt0, ctx0 = b * TC;
        bf16x8 qf[2][2];
#pragma unroll
        for (int ti = 0; ti < 2; ++ti)
#pragma unroll
            for (int ks = 0; ks < 2; ++ks) qf[ti][ks] = *(const bf16x8*)(SQ + (size_t)(mrow0 + i0 + 16 * ti + c) * 512 + hq * 64 + 32 * ks + 8 * q);
        float mrun[2], lrun[2]; f32x4 oacc[4][2];
        const float sk = in.swa_sink[layer * 8 + hq] * LOG2E;
#pragma unroll
        for (int ti = 0; ti < 2; ++ti) { mrun[ti] = sk; lrun[ti] = 1.0f;
#pragma unroll
            for (int te = 0; te < 4; ++te) oacc[te][ti] = (f32x4){0.f, 0.f, 0.f, 0.f}; }
        u32x4 kreg, vreg;
        { const int r0 = (0 < nb) ? band0 : ctx0; kreg = *(const u32x4*)(SK + (size_t)(r0 + srow) * 128 + g * 64 + scol); vreg = *(const u32x4*)(P + (size_t)(r0 + srow) * NP + PC_SV + g * 64 + scol); }
        for (int tt = 0; tt < nt; ++tt) {
            __syncthreads();
            *(LAS u32x4*)(Kl + srow * 72 + scol) = kreg;
#pragma unroll
            for (int x = 0; x < 8; ++x) Vt[(scol + x) * 72 + srow] = (bf16)(vreg[x >> 1] >> (16 * (x & 1)));
            __syncthreads();
            if (tt + 1 < nt) { const int r0 = (tt + 1 < nb) ? band0 + 64 * (tt + 1) : ctx0 + 64 * (tt + 1 - nb);
                kreg = *(const u32x4*)(SK + (size_t)(r0 + srow) * 128 + g * 64 + scol); vreg = *(const u32x4*)(P + (size_t)(r0 + srow) * NP + PC_SV + g * 64 + scol); }
            f32x4 sacc[4][2];
#pragma unroll
            for (int tj = 0; tj < 4; ++tj)
#pragma unroll
                for (int ti = 0; ti < 2; ++ti) sacc[tj][ti] = (f32x4){0.f, 0.f, 0.f, 0.f};
#pragma unroll
            for (int ks = 0; ks < 2; ++ks)
#pragma unroll
                for (int tj = 0; tj < 4; ++tj) { const bf16x8 a = *(const LAS bf16x8*)(Kl + (16 * tj + c) * 72 + 32 * ks + 8 * q);
#pragma unroll
                    for (int ti = 0; ti < 2; ++ti) sacc[tj][ti] = mfma16(a, qf[ti][ks], sacc[tj][ti]); }
            const bool band = tt < nb;
            const int kp0 = 64 * qb - 128 + 64 * (kt0 + tt) + 4 * q;
#pragma unroll
            for (int ti = 0; ti < 2; ++ti) {
                const int qp = 64 * qb + i0 + 16 * ti + c;
                float mx = -30000.0f;
#pragma unroll
                for (int tj = 0; tj < 4; ++tj)
#pragma unroll
                    for (int r = 0; r < 4; ++r) { float s = sacc[tj][ti][r] * (0.125f * LOG2E);
                        if (band) { const int dlt = kp0 + 16 * tj + r - qp; if (dlt > 128 || dlt < -128) s = -30000.0f; }
                        sacc[tj][ti][r] = s; mx = fmaxf(mx, s); }
                mx = quad_rows_max(mx);
                const float mn = fmaxf(mrun[ti], mx), corr = exp2f(mrun[ti] - mn);
                float ls = 0.f;
#pragma unroll
                for (int tj = 0; tj < 4; ++tj)
#pragma unroll
                    for (int r = 0; r < 4; ++r) { const float p = exp2f(sacc[tj][ti][r] - mn); sacc[tj][ti][r] = p; ls += p; }
                ls = quad_rows_sum(ls);
                lrun[ti] = lrun[ti] * corr + ls; mrun[ti] = mn;
#pragma unroll
                for (int te = 0; te < 4; ++te) oacc[te][ti] *= corr;
            }
#pragma unroll
            for (int ks2 = 0; ks2 < 2; ++ks2) {
                bf16x8 pb[2];
#pragma unroll
                for (int ti = 0; ti < 2; ++ti) { u32x4 t; t.x = cvtpk(sacc[2 * ks2][ti][0], sacc[2 * ks2][ti][1]); t.y = cvtpk(sacc[2 * ks2][ti][2], sacc[2 * ks2][ti][3]);
                    t.z = cvtpk(sacc[2 * ks2 + 1][ti][0], sacc[2 * ks2 + 1][ti][1]); t.w = cvtpk(sacc[2 * ks2 + 1][ti][2], sacc[2 * ks2 + 1][ti][3]); pb[ti] = __builtin_bit_cast(bf16x8, t); }
#pragma unroll
                for (int te = 0; te < 4; ++te) { const u32x2 lo = *(const LAS u32x2*)(Vt + (16 * te + c) * 72 + 32 * ks2 + 4 * q), hi = *(const LAS u32x2*)(Vt + (16 * te + c) * 72 + 32 * ks2 + 16 + 4 * q);
                    const bf16x8 va = __builtin_bit_cast(bf16x8, ((u32x4){lo.x, lo.y, hi.x, hi.y}));
#pragma unroll
                    for (int ti = 0; ti < 2; ++ti) oacc[te][ti] = mfma16(va, pb[ti], oacc[te][ti]); }
            }
        }
#pragma unroll
        for (int ti = 0; ti < 2; ++ti) { const float il = 1.0f / lrun[ti]; bf16* orow = O + (size_t)(mrow0 + i0 + 16 * ti + c) * D + 512 + hq * 64 + 4 * q;
#pragma unroll
            for (int te = 0; te < 4; ++te) { u32x2 wv; wv.x = cvtpk(oacc[te][ti][0] * il, oacc[te][ti][1] * il); wv.y = cvtpk(oacc[te][ti][2] * il, oacc[te][ti][3] * il); *(u32x2*)(orow + 16 * te) = wv; } }
    }
}


__device__ __forceinline__ void phase_gdn_local(Frame& F) {
    unsigned char* prep = F.ws + WS_R1 + R1_PREP;
    const bf16* GD = (const bf16*)(prep + PREP_GD); const float* GB = (const float*)(F.ws + WS_GB);
    LAS bf16* Qs = (LAS bf16*)F.lds; LAS bf16* Ks = Qs + 64 * 72; LAS bf16* Vs = Ks + 64 * 72;
    LAS float* At = (LAS float*)(F.lds + 27648);
    LAS bf16* ATs = (LAS bf16*)(F.lds + 60416);
    LAS bf16* XS_ = (LAS bf16*)(F.lds + 78848);
    LAS float* sm = (LAS float*)(F.lds + 115712);
    LAS float* gl = sm; LAS float* bl = sm + 128; LAS float* gcs = sm + 256; LAS float* eg = sm + 384; LAS float* ekd = sm + 512;
    const int lane = F.lane, c = lane & 15, q = lane >> 4, w = F.wave, tid = F.tid;
    for (int uu = F.bid; uu < 16 * 68; uu += F.G) {
        const int bh = uu / 68, ch = uu % 68, b = bh >> 2, hh = bh & 3;
        const int m0 = ch < 4 ? b * TC + 64 * ch : MC + b * TL + 64 * (ch - 4);
        __syncthreads();
        { const int row = tid >> 3, col8 = (tid & 7) * 8; const bf16* src = GD + (size_t)(m0 + row) * 768 + hh * 64 + col8;
          *(LAS u32x4*)(Qs + row * 72 + col8) = *(const u32x4*)(src); *(LAS u32x4*)(Ks + row * 72 + col8) = *(const u32x4*)(src + 256); *(LAS u32x4*)(Vs + row * 72 + col8) = *(const u32x4*)(src + 512);
          if (tid < 256) { const int tok = tid & 63, which = tid >> 6; sm[which * 64 + tok] = GB[(size_t)(m0 + tok) * 16 + (which >> 1) * 8 + (which & 1) * 4 + hh]; } }
        __syncthreads();
        if (w < 2) { const int d = w; const int tok = d ? 63 - lane : lane; float v = gl[d * 64 + tok];
#pragma unroll
            for (int o = 1; o < 64; o <<= 1) { const float t = __shfl_up(v, o); if (lane >= o) v += t; }
            const float last = __shfl(v, 63);
            gcs[d * 64 + lane] = v; eg[d * 64 + lane] = __expf(v); ekd[d * 64 + lane] = __expf(last - v); }
        __syncthreads();
        {
            const int type = w >> 2, ti = w & 3; const LAS bf16* X = type ? Qs : Ks;
            bf16x8 a[2];
#pragma unroll
            for (int ks = 0; ks < 2; ++ks) a[ks] = *(const LAS bf16x8*)(X + (16 * ti + c) * 72 + 32 * ks + 8 * q);
#pragma unroll
            for (int tj = 0; tj < 4; ++tj) { f32x4 acc = (f32x4){0.f, 0.f, 0.f, 0.f};
#pragma unroll
                for (int ks = 0; ks < 2; ++ks) acc = mfma16(a[ks], *(const LAS bf16x8*)(Ks + (16 * tj + c) * 72 + 32 * ks + 8 * q), acc);
#pragma unroll
                for (int r = 0; r < 4; ++r) { const int it = 16 * ti + 4 * q + r, jt = 16 * tj + c;
#pragma unroll
                    for (int d = 0; d < 2; ++d) { const int i = d ? 63 - it : it, j = d ? 63 - jt : jt;
                        const float e = __expf(fminf(gcs[d * 64 + i] - gcs[d * 64 + j], 0.f));
                        if (type == 0) At[d * 4096 + j * 64 + i] = (j < i) ? bl[d * 64 + it] * acc[r] * e : 0.f;
                        else ATs[d * 4608 + i * 72 + j] = (bf16)f2bf((j <= i) ? acc[r] * e : 0.f); } } }
        }
        __syncthreads();
        if (w < 4) {
            const int d = w >> 1, kind = w & 1; const LAS bf16* R = kind ? Ks : Vs; const LAS float* A = At + d * 4096;
            float x[64];
#pragma unroll
            for (int i = 0; i < 64; ++i) { const int tok = d ? 63 - i : i; float v = bl[d * 64 + tok] * bf2f(R[tok * 72 + lane]); if (kind) v *= eg[d * 64 + i]; x[i] = v; }
#pragma unroll
            for (int j = 0; j < 63; ++j) { const float xj = x[j];
                f32x4 ca[16];
#pragma unroll
                for (int g = ((j + 1) >> 2); g < 16; ++g) ca[g] = *(const LAS f32x4*)(A + j * 64 + 4 * g);
                __builtin_amdgcn_sched_barrier(0);
#pragma unroll
                for (int g = ((j + 1) >> 2); g < 16; ++g) { x[4 * g] -= ca[g].x * xj; x[4 * g + 1] -= ca[g].y * xj; x[4 * g + 2] -= ca[g].z * xj; x[4 * g + 3] -= ca[g].w * xj; }
                __builtin_amdgcn_sched_barrier(0); }
            LAS bf16* XO = XS_ + (d * 2 + kind) * 4608;
#pragma unroll
            for (int i = 0; i < 64; ++i) XO[i * 72 + lane] = (bf16)f2bf(x[i]);
        } else {
            const int t2 = tid - 256;
            for (int it = t2; it < 6 * 512; it += 256) { const int mat = it >> 9, chk = it & 511, d = mat & 1, kindm = mat >> 1;
                const int rt = chk >> 7, ks = (chk >> 6) & 1, ln = chk & 63, r = ln & 15, qq = ln >> 4, row = 16 * rt + r, c0 = 32 * ks + 4 * qq;
                float v[8];
                if (kindm == 0) { const u32x2 lo = *(const LAS u32x2*)(ATs + d * 4608 + row * 72 + c0), hi = *(const LAS u32x2*)(ATs + d * 4608 + row * 72 + c0 + 16);
                    v[0] = __uint_as_float(lo.x << 16); v[1] = __uint_as_float(lo.x & 0xffff0000u); v[2] = __uint_as_float(lo.y << 16); v[3] = __uint_as_float(lo.y & 0xffff0000u);
                    v[4] = __uint_as_float(hi.x << 16); v[5] = __uint_as_float(hi.x & 0xffff0000u); v[6] = __uint_as_float(hi.y << 16); v[7] = __uint_as_float(hi.y & 0xffff0000u); }
                else if (kindm == 1) { const int tok = d ? 63 - row : row; const float sc = eg[d * 64 + row];
#pragma unroll
                    for (int x8 = 0; x8 < 8; ++x8) v[x8] = bf2f(Qs[tok * 72 + c0 + (x8 & 3) + 16 * (x8 >> 2)]) * sc; }
                else {
#pragma unroll
                    for (int x8 = 0; x8 < 8; ++x8) { const int i = c0 + (x8 & 3) + 16 * (x8 >> 2); const int tok = d ? 63 - i : i; v[x8] = bf2f(Ks[tok * 72 + row]) * ekd[d * 64 + i]; } }
                const int chain = bh * 2 + d, sg = ch < 4 ? (d ? 3 - ch : ch) : 4 + (d ? 63 - (ch - 4) : ch - 4);
                unsigned char* dst = F.ws + WS_GCH + (size_t)chain * GCH_CHAIN + (size_t)sg * GCH_STEP + (kindm == 0 ? 16384 : (kindm == 1 ? 8192 : 24576));
                u32x4 o; o.x = pk2(v[0], v[1]); o.y = pk2(v[2], v[3]); o.z = pk2(v[4], v[5]); o.w = pk2(v[6], v[7]);
                *(u32x4*)(dst + chk * 16) = o; }
        }
        __syncthreads();
        {
            for (int it = tid; it < 2 * 512; it += NTHR) { const int d = it >> 9, chk = it & 511;
                const int rt = chk >> 7, ks = (chk >> 6) & 1, ln = chk & 63, r = ln & 15, qq = ln >> 4, row = 16 * rt + r, c0 = 32 * ks + 4 * qq;
                const LAS bf16* XW = XS_ + (d * 2 + 1) * 4608;
                const u32x2 lo = *(const LAS u32x2*)(XW + row * 72 + c0), hi = *(const LAS u32x2*)(XW + row * 72 + c0 + 16);
                const int chain = bh * 2 + d, sg = ch < 4 ? (d ? 3 - ch : ch) : 4 + (d ? 63 - (ch - 4) : ch - 4);
                unsigned char* dst = F.ws + WS_GCH + (size_t)chain * GCH_CHAIN + (size_t)sg * GCH_STEP;
                *(u32x4*)(dst + chk * 16) = (u32x4){lo.x, lo.y, hi.x, hi.y}; }
            for (int it = tid; it < 2 * 1024; it += NTHR) { const int d = it >> 10, cu = it & 1023;
                const int sl = cu >> 8, rt = (cu >> 6) & 3, ln = cu & 63, qq = ln >> 4, cc = ln & 15;
                const LAS bf16* XU = XS_ + (d * 2) * 4608;
                bf16 e0 = XU[(16 * rt + 4 * qq + 0) * 72 + 16 * sl + cc], e1 = XU[(16 * rt + 4 * qq + 1) * 72 + 16 * sl + cc], e2 = XU[(16 * rt + 4 * qq + 2) * 72 + 16 * sl + cc], e3 = XU[(16 * rt + 4 * qq + 3) * 72 + 16 * sl + cc];
                const int chain = bh * 2 + d, sg = ch < 4 ? (d ? 3 - ch : ch) : 4 + (d ? 63 - (ch - 4) : ch - 4);
                unsigned char* dst = F.ws + WS_GCH + (size_t)chain * GCH_CHAIN + (size_t)sg * GCH_STEP + 32768;
                *(u32x2*)(dst + cu * 8) = (u32x2){(unsigned)e0 | ((unsigned)e1 << 16), (unsigned)e2 | ((unsigned)e3 << 16)}; }
            if (tid < 2) { const int d = tid; const int chain = bh * 2 + d, sg = ch < 4 ? (d ? 3 - ch : ch) : 4 + (d ? 63 - (ch - 4) : ch - 4);
                ((float*)(F.ws + WS_GDEC))[chain * 68 + sg] = eg[d * 64 + 63]; }
        }
    }
}

__device__ __forceinline__ void phase_gdn_scan(Frame& F, int first_wg) {
    const int chain = F.bid - first_wg; if (chain < 0 || chain >= 32) return;
    const int b = chain >> 3, hh = (chain >> 1) & 3, d = chain & 1;
    const unsigned char* src = F.ws + WS_GCH + (size_t)chain * GCH_CHAIN;
    const float* decs = (const float*)(F.ws + WS_GDEC) + chain * 68;
    float* OUT = (float*)(F.ws + WS_R1 + R1_OG) + (size_t)d * M * 256;
    LAS unsigned char* ring = F.lds;
    const int lane = F.lane, w = F.wave;
    if (w >= 4) {
        const int dw = w - 4;
#define GS_ISSUE(step) do { _Pragma("unroll") for (int k = 0; k < 10; ++k) { const int p = dw * 10 + k; \
            __builtin_amdgcn_global_load_lds((const unsigned*)(src + (size_t)(step) * GCH_STEP + p * 1024 + lane * 16), (LAS unsigned*)(ring + ((step) % 3) * 40960 + p * 1024), 16, 0, 0); } } while (0)
        GS_ISSUE(0); GS_ISSUE(1);
        asm volatile("s_waitcnt vmcnt(10)" ::: "memory"); __builtin_amdgcn_s_barrier();
        for (int n = 0; n < 68; ++n) {
            if (n + 2 < 68) { GS_ISSUE(n + 2); asm volatile("s_waitcnt vmcnt(10)" ::: "memory"); }
            else asm volatile("s_waitcnt vmcnt(0)" ::: "memory");
            __builtin_amdgcn_s_barrier();
        }
#undef GS_ISSUE
    } else {
        const int sl = w, qq = lane >> 4, cc = lane & 15;
        f32x4 S[4];
#pragma unroll
        for (int rt = 0; rt < 4; ++rt) S[rt] = (f32x4){0.f, 0.f, 0.f, 0.f};
        const float dv0 = decs[lane], dv1 = decs[64 + (lane & 3)];
        asm volatile("s_waitcnt vmcnt(0)" ::: "memory"); __builtin_amdgcn_s_barrier(); asm volatile("" ::: "memory");
        for (int n = 0; n < 68; ++n) {
            const LAS unsigned char* base = ring + (n % 3) * 40960;
            const float dec = n < 64 ? __shfl(dv0, n) : __shfl(dv1, n - 64);
#define GS_FRAG(mat, rt, ks) (*(const LAS bf16x8*)(base + (mat) * 8192 + (((rt) * 2 + (ks)) * 64 + lane) * 16))
            bf16x8 BS[2], BV[2];
#pragma unroll
            for (int ks = 0; ks < 2; ++ks) { u32x4 t; t.x = cvtpk(S[2 * ks][0], S[2 * ks][1]); t.y = cvtpk(S[2 * ks][2], S[2 * ks][3]); t.z = cvtpk(S[2 * ks + 1][0], S[2 * ks + 1][1]); t.w = cvtpk(S[2 * ks + 1][2], S[2 * ks + 1][3]); BS[ks] = __builtin_bit_cast(bf16x8, t); }
            f32x4 vn[4], o[4];
#pragma unroll
            for (int rt = 0; rt < 4; ++rt) { f32x4 acc = (f32x4){0.f, 0.f, 0.f, 0.f};
#pragma unroll
                for (int ks = 0; ks < 2; ++ks) acc = mfma16(GS_FRAG(0, rt, ks), BS[ks], acc);
                const u32x2 uu = *(const LAS u32x2*)(base + 32768 + ((sl * 4 + rt) * 64 + lane) * 8);
                vn[rt] = (f32x4){__uint_as_float(uu.x << 16), __uint_as_float(uu.x & 0xffff0000u), __uint_as_float(uu.y << 16), __uint_as_float(uu.y & 0xffff0000u)} - acc;
                f32x4 oo = (f32x4){0.f, 0.f, 0.f, 0.f};
#pragma unroll
                for (int ks = 0; ks < 2; ++ks) oo = mfma16(GS_FRAG(1, rt, ks), BS[ks], oo);
                o[rt] = oo; }
#pragma unroll
            for (int ks = 0; ks < 2; ++ks) { u32x4 t; t.x = cvtpk(vn[2 * ks][0], vn[2 * ks][1]); t.y = cvtpk(vn[2 * ks][2], vn[2 * ks][3]); t.z = cvtpk(vn[2 * ks + 1][0], vn[2 * ks + 1][1]); t.w = cvtpk(vn[2 * ks + 1][2], vn[2 * ks + 1][3]); BV[ks] = __builtin_bit_cast(bf16x8, t); }
#pragma unroll
            for (int rt = 0; rt < 4; ++rt) { f32x4 oo = o[rt], sn = S[rt] * dec;
#pragma unroll
                for (int ks = 0; ks < 2; ++ks) { oo = mfma16(GS_FRAG(2, rt, ks), BV[ks], oo); sn = mfma16(GS_FRAG(3, rt, ks), BV[ks], sn); }
                o[rt] = oo; S[rt] = sn; }
#undef GS_FRAG
            const int m0 = n < 4 ? b * TC + 64 * (d ? 3 - n : n) : MC + b * TL + 64 * (d ? 63 - (n - 4) : n - 4);
#pragma unroll
            for (int rt = 0; rt < 4; ++rt)
#pragma unroll
                for (int r = 0; r < 4; ++r) { const int i = 16 * rt + 4 * qq + r, tok = d ? 63 - i : i; OUT[(size_t)(m0 + tok) * 256 + hh * 64 + 16 * sl + cc] = o[rt][r]; }
            asm volatile("s_waitcnt lgkmcnt(0)" ::: "memory"); __builtin_amdgcn_s_barrier(); asm volatile("" ::: "memory");
        }
    }
}


__device__ __forceinline__ void phase_ret_kv(Frame& F, const Inputs& in, int layer) {
    const bf16* P = (const bf16*)(F.ws + WS_R1 + R1_P);
    const bf16* RK = (const bf16*)(F.ws + WS_R1 + R1_PREP + PREP_RK);
    LAS bf16* Kt = (LAS bf16*)F.lds; LAS bf16* Vw = Kt + 64 * 72;
    const int lane = F.lane, c = lane & 15, q = lane >> 4, w = F.wave, tid = F.tid;
    const float LOG2E = 1.4426950408889634f;
    for (int uu = F.bid; uu < 16 * 68; uu += F.G) {
        const int bh = uu / 68, ch = uu % 68, b = bh >> 2, hh = bh & 3;
        const int m0 = ch < 4 ? b * TC + 64 * ch : MC + b * TL + 64 * (ch - 4);
        const float l0 = -__expf(in.ret_decay[layer * 8 + hh]) * LOG2E, l1 = -__expf(in.ret_decay[layer * 8 + 4 + hh]) * LOG2E;
        __syncthreads();
        { const int j = tid >> 3, col8 = (tid & 7) * 8;
          const u32x4 k8 = *(const u32x4*)(RK + (size_t)(m0 + j) * 256 + hh * 64 + col8), v8 = *(const u32x4*)(P + (size_t)(m0 + j) * NP + PC_RV + hh * 64 + col8);
          const float w0 = exp2f((float)(63 - j) * l0), w1 = exp2f((float)j * l1);
#pragma unroll
          for (int x = 0; x < 8; ++x) { const unsigned kk = (k8[x >> 1] >> (16 * (x & 1))) & 0xffffu; const float vv = __uint_as_float(((v8[x >> 1] >> (16 * (x & 1))) & 0xffffu) << 16);
              Kt[(col8 + x) * 72 + j] = (bf16)kk; Vw[(col8 + x) * 72 + j] = (bf16)f2bf(vv * w0); Vw[4608 + (col8 + x) * 72 + j] = (bf16)f2bf(vv * w1); } }
        __syncthreads();
        { const int d = w >> 2, td = w & 3;
          bf16x8 a[2];
#pragma unroll
          for (int ks = 0; ks < 2; ++ks) a[ks] = *(const LAS bf16x8*)(Kt + (16 * td + c) * 72 + 32 * ks + 8 * q);
          const int chain = bh * 2 + d, sg = d ? (ch < 4 ? 3 - ch : 71 - ch) : ch;
          float* dst = (float*)(F.ws + WS_RKV) + ((size_t)chain * 68 + sg) * 4096;
#pragma unroll
          for (int te = 0; te < 4; ++te) { f32x4 acc = (f32x4){0.f, 0.f, 0.f, 0.f};
#pragma unroll
              for (int ks = 0; ks < 2; ++ks) acc = mfma16(a[ks], *(const LAS bf16x8*)(Vw + d * 4608 + (16 * te + c) * 72 + 32 * ks + 8 * q), acc);
              *(f32x4*)(dst + (16 * te + c) * 64 + 16 * td + 4 * q) = acc; } }
    }
}
__device__ __forceinline__ void phase_ret_state(Frame& F, const Inputs& in, int layer, int nwg) {
    if (F.bid >= nwg) return;
    const float* RKV = (const float*)(F.ws + WS_RKV); bf16* RST = (bf16*)(F.ws + WS_RST);
    for (int el = F.bid * NTHR + F.tid; el < 32 * 4096; el += nwg * NTHR) {
        const int chain = el >> 12, idx = el & 4095, hh = (chain >> 1) & 3, d = chain & 1;
        const float G64 = __expf(-64.0f * __expf(in.ret_decay[layer * 8 + d * 4 + hh]));
        const float* kv = RKV + (size_t)chain * 68 * 4096 + idx; bf16* st = RST + (size_t)chain * 68 * 4096 + idx;
        float S = 0.f;
#pragma unroll 4
        for (int sg = 0; sg < 68; ++sg) { st[(size_t)sg * 4096] = (bf16)f2bf(S); S = G64 * S + kv[(size_t)sg * 4096]; }
    }
}
__device__ __forceinline__ void phase_ret_out(Frame& F, const Inputs& in, int layer) {
    const bf16* P = (const bf16*)(F.ws + WS_R1 + R1_P);
    const bf16* RQ = (const bf16*)(F.ws + WS_R1 + R1_PREP + PREP_RQ); const bf16* RK = (const bf16*)(F.ws + WS_R1 + R1_PREP + PREP_RK);
    const bf16* RST = (const bf16*)(F.ws + WS_RST);
    bf16* O = (bf16*)(F.ws + WS_R1 + R1_O);
    const int lane = F.lane, c = lane & 15, q = lane >> 4, w = F.wave, half = w >> 2, ti = w & 3, t2 = F.tid & 255;
    LAS bf16* Qs = (LAS bf16*)(F.lds + half * 46080); LAS bf16* Ks = Qs + 4608; LAS bf16* Vt = Ks + 4608; LAS bf16* St = Vt + 4608;
    const float LOG2E = 1.4426950408889634f;
    for (int pp = F.bid; pp < 8 * 68; pp += F.G) {
        const int uu = 2 * pp + half, bh = uu / 68, ch = uu % 68, b = bh >> 2, hh = bh & 3;
        const int m0 = ch < 4 ? b * TC + 64 * ch : MC + b * TL + 64 * (ch - 4);
        const float l0 = -__expf(in.ret_decay[layer * 8 + hh]) * LOG2E, l1 = -__expf(in.ret_decay[layer * 8 + 4 + hh]) * LOG2E;
        __syncthreads();
#pragma unroll
        for (int rep = 0; rep < 2; ++rep) { const int idx = t2 + 256 * rep, row = idx >> 3, col8 = (idx & 7) * 8;
            *(LAS u32x4*)(Qs + row * 72 + col8) = *(const u32x4*)(RQ + (size_t)(m0 + row) * 256 + hh * 64 + col8);
            *(LAS u32x4*)(Ks + row * 72 + col8) = *(const u32x4*)(RK + (size_t)(m0 + row) * 256 + hh * 64 + col8);
            const u32x4 v8 = *(const u32x4*)(P + (size_t)(m0 + row) * NP + PC_RV + hh * 64 + col8);
#pragma unroll
            for (int x = 0; x < 8; ++x) Vt[(col8 + x) * 72 + row] = (bf16)(v8[x >> 1] >> (16 * (x & 1)));
#pragma unroll
            for (int d = 0; d < 2; ++d) { const int sg = d ? (ch < 4 ? 3 - ch : 71 - ch) : ch;
                *(LAS u32x4*)(St + d * 4608 + row * 72 + col8) = *(const u32x4*)(RST + ((size_t)(bh * 2 + d) * 68 + sg) * 4096 + row * 64 + col8); } }
        __syncthreads();
        bf16x8 qf[2];
#pragma unroll
        for (int ks = 0; ks < 2; ++ks) qf[ks] = *(const LAS bf16x8*)(Qs + (16 * ti + c) * 72 + 32 * ks + 8 * q);
        const int i = 16 * ti + c;
        f32x4 p[4];
#pragma unroll
        for (int tj = 0; tj < 4; ++tj) { f32x4 acc = (f32x4){0.f, 0.f, 0.f, 0.f};
#pragma unroll
            for (int ks = 0; ks < 2; ++ks) acc = mfma16(*(const LAS bf16x8*)(Ks + (16 * tj + c) * 72 + 32 * ks + 8 * q), qf[ks], acc);
#pragma unroll
            for (int r = 0; r < 4; ++r) { const int dlt = i - (16 * tj + 4 * q + r);
                const float wgt = (dlt >= 0 ? exp2f((float)dlt * l0) : 0.f) + (dlt <= 0 ? exp2f((float)(-dlt) * l1) : 0.f);
                acc[r] *= wgt; }
            p[tj] = acc; }
        bf16x8 pb[2];
#pragma unroll
        for (int ks2 = 0; ks2 < 2; ++ks2) { u32x4 t; t.x = cvtpk(p[2 * ks2][0], p[2 * ks2][1]); t.y = cvtpk(p[2 * ks2][2], p[2 * ks2][3]); t.z = cvtpk(p[2 * ks2 + 1][0], p[2 * ks2 + 1][1]); t.w = cvtpk(p[2 * ks2 + 1][2], p[2 * ks2 + 1][3]); pb[ks2] = __builtin_bit_cast(bf16x8, t); }
        const float sc0 = exp2f((float)(i + 1) * l0), sc1 = exp2f((float)(64 - i) * l1);
        f32x4 o[4]; float sum = 0.f;
#pragma unroll
        for (int te = 0; te < 4; ++te) { f32x4 acc = (f32x4){0.f, 0.f, 0.f, 0.f}, t0 = acc, t1 = acc;
#pragma unroll
            for (int ks2 = 0; ks2 < 2; ++ks2) { const u32x2 lo = *(const LAS u32x2*)(Vt + (16 * te + c) * 72 + 32 * ks2 + 4 * q), hi = *(const LAS u32x2*)(Vt + (16 * te + c) * 72 + 32 * ks2 + 16 + 4 * q);
                acc = mfma16(__builtin_bit_cast(bf16x8, ((u32x4){lo.x, lo.y, hi.x, hi.y})), pb[ks2], acc); }
#pragma unroll
            for (int ks = 0; ks < 2; ++ks) { t0 = mfma16(*(const LAS bf16x8*)(St + (16 * te + c) * 72 + 32 * ks + 8 * q), qf[ks], t0);
                t1 = mfma16(*(const LAS bf16x8*)(St + 4608 + (16 * te + c) * 72 + 32 * ks + 8 * q), qf[ks], t1); }
            o[te] = acc + sc0 * t0 + sc1 * t1; sum += (o[te][0] + o[te][1]) + (o[te][2] + o[te][3]); }
        sum = quad_rows_sum(sum);
        const float mu = sum * (1.0f / 64.0f); float vs = 0.f;
#pragma unroll
        for (int te = 0; te < 4; ++te) { o[te] = o[te] - mu; vs += (o[te][0] * o[te][0] + o[te][1] * o[te][1]) + (o[te][2] * o[te][2] + o[te][3] * o[te][3]); }
        vs = quad_rows_sum(vs);
        const float rs = 1.0f / sqrtf(vs * (1.0f / 64.0f) + EPS);
#pragma unroll
        for (int te = 0; te < 4; ++te) { const int e0 = hh * 64 + 16 * te + 4 * q;
            const u32x2 g2 = *(const u32x2*)(P + (size_t)(m0 + i) * NP + PC_RG + e0); const f32x4 gn = *(const f32x4*)(in.ret_gn_g + layer * 256 + e0);
            const float g0 = __uint_as_float(g2.x << 16), g1 = __uint_as_float(g2.x & 0xffff0000u), g2f = __uint_as_float(g2.y << 16), g3 = __uint_as_float(g2.y & 0xffff0000u);
            u32x2 wv; wv.x = cvtpk(o[te][0] * rs * gn[0] * siluf(g0), o[te][1] * rs * gn[1] * siluf(g1)); wv.y = cvtpk(o[te][2] * rs * gn[2] * siluf(g2f), o[te][3] * rs * gn[3] * siluf(g3));
            *(u32x2*)(O + (size_t)(m0 + i) * D + e0) = wv; }
    }
}

__device__ __forceinline__ void phase_finish(Frame& F, const Inputs& in, int layer) {
    const bf16* P = (const bf16*)(F.ws + WS_R1 + R1_P);
    const float* OG = (const float*)(F.ws + WS_R1 + R1_OG);
    bf16* O = (bf16*)(F.ws + WS_R1 + R1_O);
    const int lane = F.lane;
    for (int m = F.gw; m < M; m += F.NGW) {
#pragma unroll
        for (int hh = 0; hh < 4; ++hh) {
            const float o2 = OG[(size_t)m * 256 + hh * 64 + lane] + OG[(size_t)(M + m) * 256 + hh * 64 + lane];
            const float ms = wave_sum(o2 * o2) * (1.0f / 64.0f);
            const float z = bf2f(P[(size_t)m * NP + PC_GZ + hh * 64 + lane]);
            const float y2 = o2 * (1.0f / sqrtf(ms + EPS)) * in.gdn_norm_g[layer * 64 + lane] * siluf(z);
            O[(size_t)m * D + 256 + hh * 64 + lane] = (bf16)f2bf(y2);
        }
    }
}

__device__ __forceinline__ void phase_route(Frame& F, int m_lo) {
    if (F.bid != 0) return;
    const int* TKE = (const int*)(F.ws + WS_TKE);
    int* TOKROW = (int*)(F.ws + WS_TOKROW); int* ROWTOK = (int*)(F.ws + WS_ROWTOK); int* TILEE = (int*)(F.ws + WS_TILEE);
    LAS int* cnt = (LAS int*)F.lds;
    LAS int* tot = cnt + 512 * 8;
    const int ntok = M - m_lo, per = (ntok + NTHR - 1) / NTHR;
    const int a0 = m_lo + F.tid * per, a1 = (a0 + per < M) ? a0 + per : M;
    int c[8];
#pragma unroll
    for (int e = 0; e < 8; ++e) c[e] = 0;
    for (int m = a0; m < a1; ++m) { const int e0 = TKE[2 * m], e1 = TKE[2 * m + 1];
#pragma unroll
        for (int e = 0; e < 8; ++e) c[e] += (e0 == e) + (e1 == e); }
#pragma unroll
    for (int e = 0; e < 8; ++e) cnt[F.tid * 8 + e] = c[e];
    __syncthreads();
    if (F.tid < 8) { int run = 0; for (int i = 0; i < NTHR; ++i) { const int v = cnt[i * 8 + F.tid]; cnt[i * 8 + F.tid] = run; run += v; } tot[F.tid] = run; }
    __syncthreads();
    if (F.tid == 0) { int st = 0; for (int e = 0; e < 8; ++e) { tot[8 + e] = st; const int pad = (tot[e] + 255) / 256 * 256;
            for (int tl = st / 256; tl < (st + pad) / 256; ++tl) TILEE[tl] = e; st += pad; }
        TILEE[256] = st / 256; }
    __syncthreads();
    int pos[8];
#pragma unroll
    for (int e = 0; e < 8; ++e) pos[e] = tot[8 + e] + cnt[F.tid * 8 + e];
    for (int m = a0; m < a1; ++m) {
#pragma unroll
        for (int k = 0; k < 2; ++k) { const int ee = TKE[2 * m + k]; int row = 0;
#pragma unroll
            for (int e = 0; e < 8; ++e) if (ee == e) { row = pos[e]; pos[e] = row + 1; }
            ROWTOK[row] = m; TOKROW[2 * m + k] = row; } }
    for (int e = 0; e < 8; ++e) { const int st = tot[8 + e] + tot[e], en = tot[8 + e] + (tot[e] + 255) / 256 * 256; for (int r = st + F.tid; r < en; r += NTHR) ROWTOK[r] = -1; }
}
__device__ __forceinline__ void phase_permute(Frame& F) {
    const int* ROWTOK = (const int*)(F.ws + WS_ROWTOK); const int nrows = ((const int*)(F.ws + WS_TILEE))[256] * 256;
    const bf16* H = (const bf16*)(F.ws + WS_H); bf16* HP = (bf16*)(F.ws + WS_HP);
    for (int r = F.gw; r < nrows; r += F.NGW) { const int tok = ROWTOK[r];
#pragma unroll
        for (int j = 0; j < 2; ++j) { u32x4 v = (u32x4){0u, 0u, 0u, 0u}; if (tok >= 0) v = *(const u32x4*)(H + (size_t)tok * D + 8 * F.lane + 512 * j); *(u32x4*)(HP + (size_t)r * D + 8 * F.lane + 512 * j) = v; } }
}


__device__ __forceinline__ void phase_permute2(Frame& F, int route_lo) {
    const int* TKE = (const int*)(F.ws + WS_TKE); int* TOKROW = (int*)(F.ws + WS_TOKROW); int* TILEE = (int*)(F.ws + WS_TILEE);
    const int* WGCNT = (const int*)(F.ws + WS_TILEE + 4096);
    const bf16* H = (const bf16*)(F.ws + WS_H); bf16* HP = (bf16*)(F.ws + WS_HP);
    LAS int* base = (LAS int*)F.lds;
    LAS int* tot = base + 256 * 8;
    __syncthreads();
    if (F.tid < 8) { int run = 0; for (int g = 0; g < F.G; ++g) { base[g * 8 + F.tid] = run; run += WGCNT[g * 8 + F.tid]; } tot[F.tid] = run; }
    __syncthreads();
    if (F.tid == 0) { int st = 0; for (int e = 0; e < 8; ++e) { tot[8 + e] = st; const int pad = (tot[e] + 255) / 256 * 256;
            if (F.bid == 0) for (int tl = st / 256; tl < (st + pad) / 256; ++tl) TILEE[tl] = e;
            st += pad; }
        if (F.bid == 0) TILEE[256] = st / 256; }
    __syncthreads();
    const int lane = F.lane;
    for (int m = route_lo + F.gw; m < M; m += F.NGW) {
        const int gwm = (int)((((long)(m + 1)) * F.NGW - 1) / M), wg = gwm >> 3;
        const int e0 = TKE[2 * m], e1 = TKE[2 * m + 1];
        const int r0 = tot[8 + e0] + base[wg * 8 + e0] + TOKROW[2 * m], r1 = tot[8 + e1] + base[wg * 8 + e1] + TOKROW[2 * m + 1];
        const u32x4 a = *(const u32x4*)(H + (size_t)m * D + 8 * lane), b = *(const u32x4*)(H + (size_t)m * D + 512 + 8 * lane);
        *(u32x4*)(HP + (size_t)r0 * D + 8 * lane) = a; *(u32x4*)(HP + (size_t)r0 * D + 512 + 8 * lane) = b;
        *(u32x4*)(HP + (size_t)r1 * D + 8 * lane) = a; *(u32x4*)(HP + (size_t)r1 * D + 512 + 8 * lane) = b;
        asm volatile("" ::: "memory");
        if (lane == 0) { TOKROW[2 * m] = r0; TOKROW[2 * m + 1] = r1; }
    }
    for (int e = 0; e < 8; ++e) { const int st = tot[8 + e] + tot[e], en = tot[8 + e] + (tot[e] + 255) / 256 * 256;
        for (int r = st + F.gw; r < en; r += F.NGW) { *(u32x4*)(HP + (size_t)r * D + 8 * lane) = (u32x4){0u, 0u, 0u, 0u}; *(u32x4*)(HP + (size_t)r * D + 512 + 8 * lane) = (u32x4){0u, 0u, 0u, 0u}; } }
}

constexpr int NPH = 12;
constexpr int PH_TOTAL = 1 + DEPTH * NPH + 1;
__host__ __device__ inline bool phase_exists(int ph) {
    if (ph == 0 || ph == PH_TOTAL - 1) return true;
    const int layer = (ph - 1) / NPH, j = (ph - 1) % NPH;
    if (!(layer & 1) && j >= 10) return false;
    if ((layer & 1) && j >= 11) return false;
    return true;
}
__global__ void __launch_bounds__(NTHR, 2) fwd_kernel(Args args) {
    extern __shared__ __attribute__((aligned(16))) unsigned char lds_raw[];
    Frame F;
    F.lds = (LAS unsigned char*)lds_raw;
    F.tid = threadIdx.x; F.lane = F.tid & 63; F.wave = __builtin_amdgcn_readfirstlane(F.tid >> 6);
    F.G = gridDim.x; F.bid = blockIdx.x; F.gw = blockIdx.x * NWAVES + F.wave; F.NGW = F.G * NWAVES; F.ws = args.ws;
    volatile LAS unsigned* MISC = (volatile LAS unsigned*)(F.lds + MISC_OFF);
    LAS unsigned long long* ptab = (LAS unsigned long long*)(F.lds + MISC_OFF + 128);
    if (F.tid < 32) MISC[F.tid] = 0u;
    if (PROBE_ON && F.tid == 65) { ((volatile LAS unsigned long long*)(F.lds + 132096))[0] = 0ull; ((volatile LAS unsigned long long*)(F.lds + 132096))[1] = 0ull; }
    if (F.tid == 64) { const Inputs& ai = args.in;
        ptab[0] = (unsigned long long)ai.x; ptab[1] = (unsigned long long)ai.c; ptab[2] = (unsigned long long)ai.ctx; ptab[3] = (unsigned long long)ai.c_ctx; ptab[4] = (unsigned long long)ai.ada_w; ptab[5] = (unsigned long long)ai.ada_b;
        ptab[6] = (unsigned long long)ai.norm1_g; ptab[7] = (unsigned long long)ai.w_in; ptab[8] = (unsigned long long)ai.ret_decay; ptab[9] = (unsigned long long)ai.ret_gn_g; ptab[10] = (unsigned long long)ai.gdn_conv_w; ptab[11] = (unsigned long long)ai.gdn_a_log;
        ptab[12] = (unsigned long long)ai.gdn_dt_bias; ptab[13] = (unsigned long long)ai.gdn_norm_g; ptab[14] = (unsigned long long)ai.swa_sink; ptab[15] = (unsigned long long)ai.w_out; ptab[16] = (unsigned long long)ai.norm2_g; ptab[17] = (unsigned long long)ai.ffn_w1;
        ptab[18] = (unsigned long long)ai.ffn_w3; ptab[19] = (unsigned long long)ai.ffn_w2; ptab[20] = (unsigned long long)ai.router_w; ptab[21] = (unsigned long long)ai.moe_w1; ptab[22] = (unsigned long long)ai.moe_w3; ptab[23] = (unsigned long long)ai.moe_w2; ptab[24] = (unsigned long long)ai.final_g; }
    __syncthreads();
    XcdBarrier bar; bar.bar = (unsigned*)(F.ws + WS_CTL) + CW_BAR; bar.x = 0; bar.st = nullptr;
    const int lo = args.ph_lo, hi = args.ph_hi;
    const bool multi = (hi - lo) > 1;
    if (multi) bar = xcd_barrier_post((unsigned*)(F.ws + WS_CTL) + CW_BAR, MISC + 8);
#define LAUNDER() unsigned char* _w = args.ws; asm volatile("" : "+s"(_w)); F.ws = _w; asm volatile("" ::: "memory"); { int _t = threadIdx.x; asm volatile("" : "+v"(_t)); int _b = blockIdx.x; asm volatile("" : "+s"(_b)); F.tid = _t; F.lane = _t & 63; F.wave = __builtin_amdgcn_readfirstlane(_t >> 6); F.bid = _b; F.gw = _b * NWAVES + F.wave; } const Inputs in = load_inputs(ptab)
#define RELAUNDER() do { unsigned char* _w2 = args.ws; asm volatile("" : "+s"(_w2)); F.ws = _w2; int _t = threadIdx.x; asm volatile("" : "+v"(_t)); int _b = blockIdx.x; asm volatile("" : "+s"(_b)); F.tid = _t; F.lane = _t & 63; F.wave = __builtin_amdgcn_readfirstlane(_t >> 6); F.bid = _b; F.gw = _b * NWAVES + F.wave; asm volatile("" ::: "memory"); } while (0)
#define IN(k) (lo <= (k) && (k) < hi)
#define STAMP(k) do { if (PROBE_ON && !(PROBE_CUSTOM) && blockIdx.x == 0 && threadIdx.x == 0) { volatile LAS unsigned long long* _st = (volatile LAS unsigned long long*)(F.lds + 132096); const unsigned long long _now = __builtin_amdgcn_s_memrealtime(), _prev = _st[0]; _st[0] = _now; \
    const int _ph = (k) - 1; bool _sel = false; if (_ph == 0) _sel = (PROBE_PRO) != 0; else if (_ph > 0) { const int _l = (_ph - 1) / NPH, _j = (_ph - 1) % NPH; _sel = (((PROBE_LMASK) >> _l) & 1u) && (((PROBE_JMASK) >> _j) & 1u); } if (_sel) _st[1] = _st[1] + (_now - _prev); } } while (0)
#define SEAM(k) do { if (IN(k) && IN((k) + 1)) { xcd_barrier(bar); STAMP((k) + 1); } } while (0)
    LAS unsigned char* ring = F.lds;

    STAMP(0);
    if (IN(0)) { LAUNDER(); phase_prologue(F, in); } SEAM(0);

    for (int layer = 0; layer < DEPTH; ++layer) {
        const int p0 = 1 + layer * NPH;
        const bool moe = layer & 1;
        if (IN(p0 + 0)) { LAUNDER(); phase_token2<0>(F, in, layer, layer == 0, layer > 0 && ((layer - 1) & 1), false, nullptr); if (layer == 2) { __syncthreads(); convert_moe_layer(F, in, 1); } }
        SEAM(p0 + 0);
        if (IN(p0 + 1)) { LAUNDER(); pg8::StaticOrder S; S.init(F.ws + WS_H, (bf16*)(F.ws + WS_WIN) + (size_t)layer * NP * D, M, NP, D, F.G, F.bid);
            pg8::EpiBf16 E{(bf16*)(F.ws + WS_R1 + R1_P), NP}; pg8::gemm_phase<D, pg8::EpiBf16, pg8::StaticOrder>(ring, S, E, F.tid); }
        SEAM(p0 + 1);
        if (IN(p0 + 2)) { LAUNDER(); phase_prep2(F, in, layer); }
        SEAM(p0 + 2);
        if (IN(p0 + 3)) { LAUNDER(); PB(4); phase_gdn_local(F); PE(4); RELAUNDER(); PB(5); phase_ret_kv(F, in, layer); PE(5); }
        SEAM(p0 + 3);
        if (IN(p0 + 4)) { LAUNDER(); PB(1); phase_gdn_scan(F, F.G - 32); PE(1); RELAUNDER(); PB(2); phase_ret_state(F, in, layer, F.G - 32); PE(2); RELAUNDER(); PB(3); phase_swa2(F, in, layer, F.G - 32); PE(3); }
        SEAM(p0 + 4);
        if (IN(p0 + 5)) { LAUNDER(); PB(6); phase_ret_out(F, in, layer); PE(6); RELAUNDER(); PB(7); phase_finish(F, in, layer); PE(7); }
        SEAM(p0 + 5);
        if (IN(p0 + 6)) { LAUNDER(); pg8::StaticOrder S; S.init(F.ws + WS_R1 + R1_O, (bf16*)(F.ws + WS_WOUT) + (size_t)layer * D * D, M, D, D, F.G, F.bid);
            pg8::EpiResid E{(float*)(F.ws + WS_XS), (const float*)(F.ws + WS_MOD) + (size_t)layer * 5 * 6 * D, 2}; pg8::gemm_phase<D, pg8::EpiResid, pg8::StaticOrder>(ring, S, E, F.tid); }
        SEAM(p0 + 6);
        if (IN(p0 + 7)) { LAUNDER(); phase_token2<1>(F, in, layer, false, false, moe, nullptr, layer == DEPTH - 1 ? MC : 0); }
        SEAM(p0 + 7);
        if (!moe) {
            if (IN(p0 + 8)) { LAUNDER(); pg8::StaticOrder S; S.init(F.ws + WS_H, (bf16*)(F.ws + WS_W13) + (size_t)(layer >> 1) * 2 * FF * D, M, 2 * FF, D, F.G, F.bid);
                pg8::EpiSwiglu E{(bf16*)(F.ws + WS_R1 + R1_HID), FF}; pg8::gemm_phase<D, pg8::EpiSwiglu, pg8::StaticOrder>(ring, S, E, F.tid); }
            SEAM(p0 + 8);
            if (IN(p0 + 9)) { LAUNDER(); pg8::StaticOrder S; S.init(F.ws + WS_R1 + R1_HID, (bf16*)(F.ws + WS_W2) + (size_t)(layer >> 1) * D * FF, M, D, FF, F.G, F.bid);
                pg8::EpiResid E{(float*)(F.ws + WS_XS), (const float*)(F.ws + WS_MOD) + (size_t)layer * 5 * 6 * D, 5}; pg8::gemm_phase<FF, pg8::EpiResid, pg8::StaticOrder>(ring, S, E, F.tid); }
            if (IN(p0 + 9) && IN(p0 + NPH)) { xcd_barrier(bar); STAMP(p0 + 10); }
        } else {
            if (IN(p0 + 8)) { LAUNDER(); phase_permute2(F, layer == DEPTH - 1 ? MC : 0); }
            SEAM(p0 + 8);
            if (IN(p0 + 9)) { LAUNDER(); const int* tile_e = (const int*)(F.ws + WS_TILEE); const int ntiles = __builtin_amdgcn_readfirstlane(tile_e[256]);
                pg8::GroupedOrder S; S.init(F.ws + WS_HP, F.ws + WS_MW13, ntiles, 2 * EF, D, F.G, F.bid, tile_e);
                pg8::EpiSwiglu E{(bf16*)(F.ws + WS_R1 + R1_HID), EF}; pg8::gemm_phase<D, pg8::EpiSwiglu, pg8::GroupedOrder>(ring, S, E, F.tid); }
            SEAM(p0 + 9);
            if (IN(p0 + 10)) { LAUNDER(); const int* tile_e = (const int*)(F.ws + WS_TILEE); const int ntiles = __builtin_amdgcn_readfirstlane(tile_e[256]);
                pg8::GroupedOrder S; S.init(F.ws + WS_R1 + R1_HID, F.ws + WS_MW2, ntiles, D, EF, F.G, F.bid, tile_e);
                pg8::EpiF32 E{(float*)(F.ws + WS_YM), D}; pg8::gemm_phase<EF, pg8::EpiF32, pg8::GroupedOrder>(ring, S, E, F.tid); }
            if (IN(p0 + 10) && IN(p0 + NPH)) { xcd_barrier(bar); STAMP(p0 + 11); }
        }
    }
    if (IN(PH_TOTAL - 1)) { LAUNDER(); phase_token2<2>(F, in, DEPTH, false, true, false, args.out); }
    if (PROBE_ON && (int)blockIdx.x == ((PROBE_CUSTOM) ? (PROBE_BLOCK < 0 ? (int)gridDim.x + (PROBE_BLOCK) : (PROBE_BLOCK)) : 0) && threadIdx.x == 0) {
        STAMP(PH_TOTAL);
        const unsigned long long T = ((volatile LAS unsigned long long*)(F.lds + 132096))[1];
        const unsigned long long t0 = __builtin_amdgcn_s_memrealtime();
        while (__builtin_amdgcn_s_memrealtime() - t0 < 8ull * T) __builtin_amdgcn_s_sleep(8);
    }
#undef IN
#undef SEAM
}

extern "C" void kernel_launch(void* const* d_in, const int* in_sizes, int n_in, void* d_out, int out_size, void* d_ws, size_t ws_size, hipStream_t stream) {
    static int grid = 0;
    if (grid == 0) {
        if (n_in != 25 || out_size != ML * D || ws_size < WS_END) { fprintf(stderr, "kernel_launch: unexpected problem: n_in %d out %d ws %zu (need %zu)\n", n_in, out_size, ws_size, (size_t)WS_END); grid = -1; return; }
        int dev = 0, cus = 0, per_cu = 0;
        if (hipGetDevice(&dev) != hipSuccess || hipDeviceGetAttribute(&cus, hipDeviceAttributeMultiprocessorCount, dev) != hipSuccess) { grid = -1; return; }
        if (hipFuncSetAttribute((const void*)fwd_kernel, hipFuncAttributeMaxDynamicSharedMemorySize, LDS_BYTES) != hipSuccess) { fprintf(stderr, "kernel_launch: hipFuncSetAttribute failed\n"); grid = -1; return; }
        if (hipOccupancyMaxActiveBlocksPerMultiprocessor(&per_cu, (const void*)fwd_kernel, NTHR, LDS_BYTES) != hipSuccess || per_cu < 1) fprintf(stderr, "kernel_launch: occupancy query reports %d\n", per_cu);
        (void)hipGetLastError();
        grid = cus;
    }
    if (grid < 0) return;
    (void)hipMemsetAsync((char*)d_ws + WS_CTL, 0, CTL_ZERO_BYTES, stream);
    Args a{};
    const float** ip = (const float**)&a.in;
    for (int i = 0; i < 25; ++i) ip[i] = (const float*)d_in[i];
    a.out = (float*)d_out; a.ws = (unsigned char*)d_ws;
#if MK_ONE_LAUNCH
    a.ph_lo = 0; a.ph_hi = PH_TOTAL;
    hipLaunchKernelGGL(fwd_kernel, dim3(grid), dim3(NTHR), LDS_BYTES, stream, a);
#else
    for (int ph = 0; ph < PH_TOTAL; ++ph) { if (!phase_exists(ph)) continue; a.ph_lo = ph; a.ph_hi = ph + 1;
        hipLaunchKernelGGL(fwd_kernel, dim3(grid), dim3(NTHR), LDS_BYTES, stream, a); }
#endif
}
```

```cpp
#include <hip/hip_runtime.h>
#include <cstdio>
#include <cstdint>

#ifndef PROBE_JMASK
#define PROBE_JMASK 0u
#endif
#ifndef PROBE_LMASK
#define PROBE_LMASK 15u
#endif
#ifndef PROBE_PRO
#define PROBE_PRO 0
#endif
#ifndef PROBE_CUSTOM
#define PROBE_CUSTOM 0
#endif
#ifndef PROBE_BLOCK
#define PROBE_BLOCK 0
#endif
#define PROBE_ON ((PROBE_JMASK) != 0u || (PROBE_PRO) != 0 || (PROBE_CUSTOM) != 0)
#define PB(id) do { if ((PROBE_CUSTOM) == (id) && (int)blockIdx.x == (PROBE_BLOCK < 0 ? (int)gridDim.x + (PROBE_BLOCK) : (PROBE_BLOCK)) && threadIdx.x == 0) ((volatile LAS unsigned long long*)(F.lds + 132096))[2] = __builtin_amdgcn_s_memrealtime(); } while (0)
#define PE(id) do { if ((PROBE_CUSTOM) == (id) && (int)blockIdx.x == (PROBE_BLOCK < 0 ? (int)gridDim.x + (PROBE_BLOCK) : (PROBE_BLOCK)) && threadIdx.x == 0) { volatile LAS unsigned long long* _s = (volatile LAS unsigned long long*)(F.lds + 132096); _s[1] = _s[1] + (__builtin_amdgcn_s_memrealtime() - _s[2]); } } while (0)
#ifndef MK_ONE_LAUNCH
#define MK_ONE_LAUNCH 1
#endif

#define GAS __attribute__((address_space(1)))
#define LAS __attribute__((address_space(3)))
typedef unsigned short bf16;
typedef short bf16x8 __attribute__((ext_vector_type(8)));
typedef float f32x4 __attribute__((ext_vector_type(4)));
typedef float f32x2 __attribute__((ext_vector_type(2)));
typedef unsigned u32x4 __attribute__((ext_vector_type(4)));
typedef unsigned u32x2 __attribute__((ext_vector_type(2)));

constexpr int D = 1024, NB = 4, TL = 4096, TC = 256, DEPTH = 4;
constexpr int MC = NB * TC, ML = NB * TL, M = MC + ML;
constexpr int INC = 2832, NP = 2816;
constexpr int FF = 2816, EF = 3584, NE = 8;
constexpr int MAXROWS = 36864;
constexpr float EPS = 1e-6f;
constexpr int PC_RQ = 0, PC_RK = 256, PC_RV = 512, PC_RG = 768, PC_GQKV = 1024, PC_GZ = 1792, PC_SQ = 2048, PC_SK = 2560, PC_SV = 2688;

constexpr size_t MiB = 1u << 20;
constexpr size_t WS_CTL = 0, CTL_ZERO_BYTES = 1 * MiB;
constexpr size_t WS_MOD = 1 * MiB;
constexpr size_t WS_ROPE = 2 * MiB;
constexpr size_t WS_TKE = 3 * MiB, WS_TKG = 3 * MiB + 256 * 1024, WS_TOKROW = 3 * MiB + 512 * 1024, WS_ROWTOK = 3 * MiB + 768 * 1024, WS_TILEE = 4 * MiB;
constexpr size_t WS_AB = 5 * MiB, WS_GB = 7 * MiB;
constexpr size_t WS_WIN = 16 * MiB, WS_WOUT = 38 * MiB, WS_W13 = 46 * MiB, WS_W2 = 68 * MiB, WS_MW13 = 80 * MiB, WS_MW2 = 192 * MiB;
constexpr size_t WS_XS = 248 * MiB, WS_H = 316 * MiB, WS_HP = 350 * MiB, WS_YM = 422 * MiB, WS_R1 = 566 * MiB;
constexpr size_t R1_P = 0, R1_PREP = 94 * MiB, R1_O = 158 * MiB, R1_OR = 192 * MiB, R1_OG = 226 * MiB, R1_HID = 0;
constexpr size_t WS_END = WS_R1 + 260 * MiB;
constexpr size_t WS_GCH = WS_YM, GCH_STEP = 40960, GCH_CHAIN = 68 * GCH_STEP, WS_GDEC = WS_HP;
constexpr size_t G2_STEP = 24576, G2_CHAIN = 68 * G2_STEP;
constexpr size_t WS_GST = WS_YM + 56 * MiB;
constexpr size_t WS_GCS = WS_HP + 64 * 1024;
static_assert(32 * G2_CHAIN <= 56 * MiB && 32 * 68 * 16384 <= 40 * MiB, "gdn v2 buffers");
constexpr size_t WS_RKV = WS_YM + 96 * MiB;
constexpr size_t WS_RST = WS_HP + 1 * MiB;
static_assert(32 * GCH_CHAIN <= 144 * MiB, "gdn chunk data");
constexpr size_t PREP_RQ = 0, PREP_RK = (size_t)M * 256 * 2, PREP_SQ = (size_t)M * 512 * 2, PREP_SK = (size_t)M * 1024 * 2, PREP_GD = (size_t)M * 1152 * 2;
static_assert(PREP_GD + (size_t)M * 768 * 2 <= 64 * MiB, "prep");
static_assert((size_t)M * NP * 2 <= 94 * MiB && (size_t)MAXROWS * EF * 2 <= 260 * MiB, "r1");

constexpr int CW_TMO = 0, CW_BAR = 4096;

__device__ __forceinline__ float bf2f(bf16 v) { return __uint_as_float(((unsigned)v) << 16); }
__device__ __forceinline__ unsigned f2bf(float f) { unsigned u = __float_as_uint(f); return (u + 0x7fffu + ((u >> 16) & 1u)) >> 16; }
__device__ __forceinline__ unsigned pk2(float lo, float hi) { return f2bf(lo) | (f2bf(hi) << 16); }
template <int CTRL> __device__ __forceinline__ float dppf(float v) { return __int_as_float(__builtin_amdgcn_update_dpp(0, __float_as_int(v), CTRL, 0xF, 0xF, true)); }
__device__ __forceinline__ float row_sum16(float v) {
    v += dppf<0xB1>(v); v += dppf<0x4E>(v); v += dppf<0x141>(v); v += dppf<0x140>(v); return v; }
__device__ __forceinline__ float wave_sum(float v) {
    v = row_sum16(v);
    return __int_as_float(__builtin_amdgcn_readlane(__float_as_int(v), 0)) + __int_as_float(__builtin_amdgcn_readlane(__float_as_int(v), 16))
         + __int_as_float(__builtin_amdgcn_readlane(__float_as_int(v), 32)) + __int_as_float(__builtin_amdgcn_readlane(__float_as_int(v), 48)); }
__device__ __forceinline__ float quad_rows_sum(float v) {
    u32x2 r = __builtin_amdgcn_permlane16_swap(__float_as_uint(v), __float_as_uint(v), false, false); v = __uint_as_float(r.x) + __uint_as_float(r.y);
    r = __builtin_amdgcn_permlane32_swap(__float_as_uint(v), __float_as_uint(v), false, false); return __uint_as_float(r.x) + __uint_as_float(r.y); }
__device__ __forceinline__ float quad_rows_max(float v) {
    u32x2 r = __builtin_amdgcn_permlane16_swap(__float_as_uint(v), __float_as_uint(v), false, false); v = fmaxf(__uint_as_float(r.x), __uint_as_float(r.y));
    r = __builtin_amdgcn_permlane32_swap(__float_as_uint(v), __float_as_uint(v), false, false); return fmaxf(__uint_as_float(r.x), __uint_as_float(r.y)); }
__device__ __forceinline__ float fexp2(float x) { return __builtin_amdgcn_exp2f(x); }
__device__ __forceinline__ float fexp(float x) { return __builtin_amdgcn_exp2f(x * 1.4426950408889634f); }
__device__ __forceinline__ float siluf(float x) { return x * __builtin_amdgcn_rcpf(1.0f + fexp(-x)); }
#define LDS_WAIT() asm volatile("s_waitcnt lgkmcnt(0)" ::: "memory")
__device__ __forceinline__ f32x4 mfma16(bf16x8 a, bf16x8 b, f32x4 c) { return __builtin_amdgcn_mfma_f32_16x16x32_bf16(a, b, c, 0, 0, 0); }
__device__ __forceinline__ unsigned cvtpk(float lo, float hi) { unsigned r; asm volatile("v_cvt_pk_bf16_f32 %0, %1, %2" : "=v"(r) : "v"(lo), "v"(hi)); return r; }


namespace pg8 {
#define PG8_LAS __attribute__((address_space(3)))
constexpr int BM = 256, BK = 64, HALF = 128, HTB = HALF * BK * 2, STAGE_BYTES = 8 * HTB;
__host__ __device__ __forceinline__ int lds_byte(int r, int c) { const int st = (r >> 4) * 2 + (c >> 5), rr = r & 15, cc = c & 31, ob = rr * 64 + cc * 2; return st * 1024 + (ob ^ (((ob >> 9) & 1) << 5)); }
__host__ __device__ __forceinline__ void stage_rc(int b, int& R, int& C) { const int st = b / 1024, sb = b % 1024, swz = sb ^ (((sb >> 9) & 1) << 5); R = (st >> 1) * 16 + swz / 64; C = (st & 1) * 32 + (swz % 64) / 2; }
__host__ __device__ __forceinline__ int perm32(int rho) { const int n = rho >> 4, i = rho & 15; return 8 * (i >> 2) + 4 * n + (i & 3); }
struct Unit { int pm, pn, aux; const char* A; const char* B; };
__device__ __forceinline__ unsigned cvt_pk_bf16(float lo, float hi) { unsigned r; asm volatile("v_cvt_pk_bf16_f32 %0, %1, %2" : "=v"(r) : "v"(lo), "v"(hi)); return r; }

template <int K, class Epi, class Sched, bool ALIGN_EPI = true, bool SP2 = true>
__device__ __forceinline__ void gemm_phase(PG8_LAS unsigned char* lds, const Sched& S, const Epi& E, const int tid) {
    const int wid = __builtin_amdgcn_readfirstlane(tid >> 6), lane = tid & 63, wr = wid >> 2, wc = wid & 3, fr = lane & 15, fq = lane >> 4;
    constexpr int nt = K / BK;
    unsigned voffA[2], voffB[2];
#pragma unroll
    for (int i = 0; i < 2; ++i) { int R, C; stage_rc(tid * 16 + i * 8192, R, C); const int Rb = Epi::PERM ? ((R & ~31) + perm32(R & 31)) : R;
        voffA[i] = (unsigned)(R * K + C) * 2u; voffB[i] = (unsigned)(Rb * K + C) * 2u; }
    constexpr size_t kstep = (size_t)(BK * 2);
    constexpr size_t hstep = (size_t)HALF * K * 2;
    const unsigned ldsw = (unsigned)wid * 1024u;
    const int aoff = lds_byte(wr * 64 + fr, fq * 8), boff = lds_byte(wc * 32 + fr, fq * 8);
#define PG8_SA(b, h) (((b) * 2 + (h)) * HTB)
#define PG8_SB(b, h) ((4 + (b) * 2 + (h)) * HTB)
#define PG8_STAGE(bufoff, gbase, voff) do { _Pragma("unroll") for (int _i = 0; _i < 2; ++_i) \
        __builtin_amdgcn_global_load_lds((const unsigned*)((const char*)(gbase) + (voff)[_i]), (PG8_LAS unsigned*)(lds + (bufoff) + ldsw + _i * 8192), 16, 0, 0); } while (0)
#define PG8_LDA(dst, b, h) do { _Pragma("unroll") for (int m = 0; m < 4; ++m) _Pragma("unroll") for (int k = 0; k < 2; ++k) dst[m][k] = *(const PG8_LAS bf16x8*)(lds + PG8_SA(b, h) + aoff + m * 2048 + k * 1024); } while (0)
#define PG8_LDB(dst, b, h) do { _Pragma("unroll") for (int n = 0; n < 2; ++n) _Pragma("unroll") for (int k = 0; k < 2; ++k) dst[n][k] = *(const PG8_LAS bf16x8*)(lds + PG8_SB(b, h) + boff + n * 2048 + k * 1024); } while (0)
#define PG8_MMA(ai, bj, At, Bt) do { __builtin_amdgcn_s_setprio(1); _Pragma("unroll") for (int m = 0; m < 4; ++m) _Pragma("unroll") for (int n = 0; n < 2; ++n) _Pragma("unroll") for (int k = 0; k < 2; ++k) \
        acc[ai][bj][m][n] = __builtin_amdgcn_mfma_f32_16x16x32_bf16(Bt[n][k], At[m][k], acc[ai][bj][m][n], 0, 0, 0); __builtin_amdgcn_s_setprio(0); } while (0)
#define PG8_WAIT_V(n) asm volatile("s_waitcnt vmcnt(" #n ")" ::: "memory")
#define PG8_WAIT_L(n) asm volatile("s_waitcnt lgkmcnt(" #n ")" ::: "memory")
#define PG8_BAR __builtin_amdgcn_s_barrier()
#define PG8_SCHED __builtin_amdgcn_sched_barrier(0)
    Unit cur, nxt; int ui = 0;
    if (!S.next(0, cur)) return;
    f32x4 acc[2][2][4][2];
#pragma unroll
    for (int a = 0; a < 2; ++a)
#pragma unroll
        for (int b = 0; b < 2; ++b)
#pragma unroll
            for (int m = 0; m < 4; ++m)
#pragma unroll
                for (int n = 0; n < 2; ++n) acc[a][b][m][n] = (f32x4){0.f, 0.f, 0.f, 0.f};
    bf16x8 At[4][2], B0[2][2], B1[2][2];
    const char* cA = cur.A; const char* cB = cur.B;
    if constexpr (SP2) {
        PG8_STAGE(PG8_SB(0, 0), cB, voffB); PG8_STAGE(PG8_SB(0, 1), cB + hstep, voffB); PG8_STAGE(PG8_SA(0, 0), cA, voffA); PG8_STAGE(PG8_SA(0, 1), cA + hstep, voffA);
        if (wr == 1) PG8_BAR;
        PG8_WAIT_V(2); PG8_BAR;
        PG8_STAGE(PG8_SB(1, 0), cB + kstep, voffB); PG8_STAGE(PG8_SA(1, 0), cA + kstep, voffA); PG8_STAGE(PG8_SB(1, 1), cB + hstep + kstep, voffB);
        PG8_WAIT_V(6); PG8_BAR;
    } else {
        PG8_STAGE(PG8_SB(0, 0), cB, voffB); PG8_STAGE(PG8_SA(0, 0), cA, voffA); PG8_STAGE(PG8_SB(0, 1), cB + hstep, voffB); PG8_STAGE(PG8_SA(0, 1), cA + hstep, voffA);
        if (wr == 1) PG8_BAR;
        PG8_WAIT_V(4); PG8_BAR;
        PG8_STAGE(PG8_SB(1, 0), cB + kstep, voffB); PG8_STAGE(PG8_SA(1, 0), cA + kstep, voffA); PG8_STAGE(PG8_SB(1, 1), cB + hstep + kstep, voffB);
        PG8_WAIT_V(6); PG8_BAR;
    }
    for (;;) {
        const bool has_next = S.next(ui + 1, nxt);
        const char* nA = has_next ? nxt.A : cA; const char* nB = has_next ? nxt.B : cB;
        for (int t = 0; t < nt; t += 2) {
            const bool last = (t == nt - 2);
            const char* a1 = cA + (size_t)(t + 1) * kstep;
            const char* a2 = last ? nA : cA + (size_t)(t + 2) * kstep; const char* b2 = last ? nB : cB + (size_t)(t + 2) * kstep;
            const char* a3 = a2 + kstep; const char* b3 = b2 + kstep;
            if constexpr (SP2) {
            PG8_LDB(B0, 0, 0); PG8_LDB(B1, 0, 1); PG8_SCHED; PG8_LDA(At, 0, 0); PG8_STAGE(PG8_SA(1, 1), a1 + hstep, voffA);
            PG8_WAIT_V(8); PG8_WAIT_L(0); PG8_BAR; PG8_MMA(0, 0, At, B0); PG8_MMA(0, 1, At, B1); PG8_BAR; PG8_SCHED;
            PG8_LDA(At, 0, 1); PG8_STAGE(PG8_SB(0, 0), b2, voffB); PG8_STAGE(PG8_SB(0, 1), b2 + hstep, voffB); PG8_STAGE(PG8_SA(0, 0), a2, voffA);
            PG8_WAIT_V(8); PG8_WAIT_L(0); PG8_BAR; PG8_MMA(1, 0, At, B0); PG8_MMA(1, 1, At, B1); PG8_BAR; PG8_SCHED;
            PG8_LDB(B0, 1, 0); PG8_LDB(B1, 1, 1); PG8_SCHED; PG8_LDA(At, 1, 0); PG8_STAGE(PG8_SA(0, 1), a2 + hstep, voffA);
            PG8_WAIT_V(8); PG8_WAIT_L(0); PG8_BAR; PG8_MMA(0, 0, At, B0); PG8_MMA(0, 1, At, B1); PG8_BAR; PG8_SCHED;
            PG8_LDA(At, 1, 1); PG8_STAGE(PG8_SB(1, 0), b3, voffB); PG8_STAGE(PG8_SB(1, 1), b3 + hstep, voffB); PG8_STAGE(PG8_SA(1, 0), a3, voffA);
            PG8_WAIT_V(8); PG8_WAIT_L(0); PG8_BAR; PG8_MMA(1, 0, At, B0); PG8_MMA(1, 1, At, B1); PG8_BAR; PG8_SCHED;
            } else {
            PG8_LDB(B0, 0, 0); PG8_SCHED; PG8_LDA(At, 0, 0); PG8_STAGE(PG8_SA(1, 1), a1 + hstep, voffA);
            PG8_WAIT_L(8); PG8_BAR; PG8_WAIT_L(0); PG8_MMA(0, 0, At, B0); PG8_BAR; PG8_SCHED;
            PG8_LDB(B1, 0, 1); PG8_STAGE(PG8_SB(0, 0), b2, voffB);
            PG8_BAR; PG8_WAIT_L(0); PG8_MMA(0, 1, At, B1); PG8_BAR;
            PG8_LDA(At, 0, 1); PG8_STAGE(PG8_SA(0, 0), a2, voffA);
            PG8_BAR; PG8_WAIT_L(0); PG8_MMA(1, 0, At, B0); PG8_BAR; PG8_SCHED;
            PG8_STAGE(PG8_SB(0, 1), b2 + hstep, voffB);
            PG8_WAIT_V(6); PG8_BAR; PG8_MMA(1, 1, At, B1); PG8_BAR;
            PG8_LDB(B0, 1, 0); PG8_SCHED; PG8_LDA(At, 1, 0); PG8_STAGE(PG8_SA(0, 1), a2 + hstep, voffA);
            PG8_WAIT_L(8); PG8_BAR; PG8_WAIT_L(0); PG8_MMA(0, 0, At, B0); PG8_BAR; PG8_SCHED;
            PG8_LDB(B1, 1, 1); PG8_STAGE(PG8_SB(1, 0), b3, voffB);
            PG8_BAR; PG8_WAIT_L(0); PG8_MMA(0, 1, At, B1); PG8_BAR;
            PG8_LDA(At, 1, 1); PG8_STAGE(PG8_SA(1, 0), a3, voffA);
            PG8_BAR; PG8_WAIT_L(0); PG8_MMA(1, 0, At, B0); PG8_BAR; PG8_SCHED;
            PG8_STAGE(PG8_SB(1, 1), b3 + hstep, voffB);
            PG8_WAIT_V(6); PG8_BAR; PG8_MMA(1, 1, At, B1); PG8_BAR;
            }
        }
        if constexpr (ALIGN_EPI) { if (wr == 0) PG8_BAR; }
        E(acc, cur, wr, wc, fr, fq);
        if (!has_next) break;
#pragma unroll
        for (int a = 0; a < 2; ++a)
#pragma unroll
            for (int b = 0; b < 2; ++b)
#pragma unroll
                for (int m = 0; m < 4; ++m)
#pragma unroll
                    for (int n = 0; n < 2; ++n) acc[a][b][m][n] = (f32x4){0.f, 0.f, 0.f, 0.f};
        cur = nxt; cA = nA; cB = nB; ++ui;
        if constexpr (ALIGN_EPI) { if (wr == 1) PG8_BAR; }
    }
    PG8_WAIT_V(0);
    if constexpr (!ALIGN_EPI) { if (wr == 0) PG8_BAR; }
    PG8_BAR;
#undef PG8_SA
#undef PG8_SB
#undef PG8_STAGE
#undef PG8_LDA
#undef PG8_LDB
#undef PG8_MMA
#undef PG8_WAIT_V
#undef PG8_WAIT_L
#undef PG8_BAR
#undef PG8_SCHED
}

struct StaticOrder {
    int nM, nN, nwg, G, c; const char* A; const char* Bt; size_t tstep;
    __device__ void init(const void* A_, const void* Bt_, int M_, int N_, int K_, int G_, int c_) { A = (const char*)A_; Bt = (const char*)Bt_; nM = M_ / BM; nN = N_ / BM; nwg = nM * nN; G = G_; c = c_; tstep = (size_t)BM * K_ * 2; }
    __device__ bool next(int i, Unit& u) const {
        const long L = (long)i * G + c; if (L >= nwg) return false;
        int wgid = (int)L; { const int q = nwg / 8, r = nwg % 8, xcd = wgid % 8, off = wgid / 8; wgid = (xcd < r ? xcd * (q + 1) : r * (q + 1) + (xcd - r) * q) + off; }
        const int nig = 8 * nN, gid = wgid / nig, fm = gid * 8, gsz = (nM - fm) < 8 ? (nM - fm) : 8;
        u.pm = fm + ((wgid % nig) % gsz); u.pn = (wgid % nig) / gsz; u.aux = 0;
        u.A = A + (size_t)u.pm * tstep; u.B = Bt + (size_t)u.pn * tstep; return true;
    }
};
struct GroupedOrder {
    int nM, nN, nwg, G, c; const char* A; const char* Bt; size_t tstep, estep; const int* tile_e;
    __device__ void init(const void* A_, const void* Bt_, int ntiles, int N_, int K_, int G_, int c_, const int* te) { A = (const char*)A_; Bt = (const char*)Bt_; nM = ntiles; nN = N_ / BM; nwg = nM * nN; G = G_; c = c_; tstep = (size_t)BM * K_ * 2; estep = (size_t)N_ * K_ * 2; tile_e = te; }
    __device__ bool next(int i, Unit& u) const {
        const long L = (long)i * G + c; if (L >= nwg) return false;
        u.pm = (int)(L / nN); u.pn = (int)(L % nN); u.aux = __builtin_amdgcn_readfirstlane(tile_e[u.pm]);
        u.A = A + (size_t)u.pm * tstep; u.B = Bt + (size_t)u.aux * estep + (size_t)u.pn * tstep; return true;
    }
};

struct EpiBf16 {
    static constexpr bool PERM = true;
    bf16* O; int ldc;
    __device__ __forceinline__ void operator()(const f32x4 (&acc)[2][2][4][2], const Unit& u, int wr, int wc, int fr, int fq) const {
        const int row0 = u.pm * BM + wr * 64 + fr, col0 = u.pn * BM + wc * 32 + 8 * fq;
#pragma unroll
        for (int ai = 0; ai < 2; ++ai)
#pragma unroll
            for (int m = 0; m < 4; ++m) { bf16* rowp = O + (size_t)(row0 + ai * HALF + m * 16) * ldc + col0;
#pragma unroll
                for (int bj = 0; bj < 2; ++bj) { const f32x4 v0 = acc[ai][bj][m][0], v1 = acc[ai][bj][m][1];
                    u32x4 w; w.x = cvt_pk_bf16(v0[0], v0[1]); w.y = cvt_pk_bf16(v0[2], v0[3]); w.z = cvt_pk_bf16(v1[0], v1[1]); w.w = cvt_pk_bf16(v1[2], v1[3]);
                    *(u32x4*)(rowp + bj * HALF) = w; } }
    }
};
struct EpiResid {
    static constexpr bool PERM = false;
    float* X; const float* mod; int gsel;
    __device__ __forceinline__ void operator()(const f32x4 (&acc)[2][2][4][2], const Unit& u, int wr, int wc, int fr, int fq) const {
        const int row0 = u.pm * BM + wr * 64 + fr, col0 = u.pn * BM + wc * 32 + 4 * fq;
        const int r = u.pm < 4 ? 4 : ((u.pm - 4) >> 4);
        const float* g = mod + (size_t)r * 6 * D + gsel * D;
        f32x4 gv[2][2];
#pragma unroll
        for (int bj = 0; bj < 2; ++bj)
#pragma unroll
            for (int n = 0; n < 2; ++n) gv[bj][n] = *(const f32x4*)(g + col0 + bj * HALF + n * 16);
#pragma unroll
        for (int ai = 0; ai < 2; ++ai)
#pragma unroll
            for (int m = 0; m < 4; ++m) { float* rowp = X + (size_t)(row0 + ai * HALF + m * 16) * D + col0;
#pragma unroll
                for (int bj = 0; bj < 2; ++bj)
#pragma unroll
                    for (int n = 0; n < 2; ++n) { f32x4 x = *(f32x4*)(rowp + bj * HALF + n * 16); x += gv[bj][n] * acc[ai][bj][m][n]; *(f32x4*)(rowp + bj * HALF + n * 16) = x; } }
    }
};
struct EpiSwiglu {
    static constexpr bool PERM = false;
    bf16* Hd; int ldh;
    __device__ __forceinline__ void operator()(const f32x4 (&acc)[2][2][4][2], const Unit& u, int wr, int wc, int fr, int fq) const {
        const int row0 = u.pm * BM + wr * 64 + fr, col0 = u.pn * 128 + wc * 16 + 4 * fq;
#pragma unroll
        for (int ai = 0; ai < 2; ++ai)
#pragma unroll
            for (int m = 0; m < 4; ++m) { bf16* rowp = Hd + (size_t)(row0 + ai * HALF + m * 16) * ldh + col0;
#pragma unroll
                for (int bj = 0; bj < 2; ++bj) { const f32x4 a = acc[ai][bj][m][0], b = acc[ai][bj][m][1];
                    float h[4];
#pragma unroll
                    for (int j = 0; j < 4; ++j) h[j] = a[j] * __builtin_amdgcn_rcpf(1.0f + __builtin_amdgcn_exp2f(-1.4426950408889634f * a[j])) * b[j];
                    u32x2 w; w.x = cvt_pk_bf16(h[0], h[1]); w.y = cvt_pk_bf16(h[2], h[3]);
                    *(u32x2*)(rowp + bj * 64) = w; } }
    }
};
struct EpiF32 {
    static constexpr bool PERM = false;
    float* C; int ldc;
    __device__ __forceinline__ void operator()(const f32x4 (&acc)[2][2][4][2], const Unit& u, int wr, int wc, int fr, int fq) const {
        const int row0 = u.pm * BM + wr * 64 + fr, col0 = u.pn * BM + wc * 32 + 4 * fq;
#pragma unroll
        for (int ai = 0; ai < 2; ++ai)
#pragma unroll
            for (int m = 0; m < 4; ++m) { float* rowp = C + (size_t)(row0 + ai * HALF + m * 16) * ldc + col0;
#pragma unroll
                for (int bj = 0; bj < 2; ++bj)
#pragma unroll
                    for (int n = 0; n < 2; ++n) *(f32x4*)(rowp + bj * HALF + n * 16) = acc[ai][bj][m][n]; }
    }
};
}

#define XB_TMO      128
#define XB_XCNT(j)  (256  + 64 * (j))
#define XB_XSUB(j)  (1280 + 64 * (j))
#define XB_XGEN(j)  (2304 + 64 * (j))
#define XB_TOP      3328
#define XB_TOPGEN   3392
#define XCD_BAR_WORDS 3456
#define XB_SPIN_CAP (1u << 22)
__device__ __forceinline__ unsigned xb_ld(unsigned* p)              { return __hip_atomic_load(p, __ATOMIC_RELAXED, __HIP_MEMORY_SCOPE_AGENT); }
__device__ __forceinline__ unsigned xb_add(unsigned* p, unsigned v) { return __hip_atomic_fetch_add(p, v, __ATOMIC_RELAXED, __HIP_MEMORY_SCOPE_AGENT); }
__device__ __forceinline__ unsigned xb_xcc_id() { return (unsigned)__builtin_amdgcn_s_getreg((3 << 11) | 20) & 0xFu; }
#define XB_SPIN(cond, bar) do { unsigned _sp = 0; while (cond) { __builtin_amdgcn_s_sleep(1); \
    if ((++_sp & 255u) == 0u) { if (xb_ld(&(bar)[XB_TMO])) break; if (_sp > XB_SPIN_CAP) { atomicAdd(&(bar)[XB_TMO], 1u); break; } } } } while (0)
struct XcdBarrier { unsigned* bar; unsigned x; volatile LAS unsigned* st; };
__device__ __forceinline__ XcdBarrier xcd_barrier_post(unsigned* bar, volatile LAS unsigned* st) {
    XcdBarrier b; b.bar = bar; b.x = xb_xcc_id(); b.st = st;
    if (threadIdx.x == 0) (void)xb_add(&bar[XB_XCNT(b.x)], 1u);
    return b;
}
__device__ __forceinline__ void xcd_barrier_complete(unsigned* bar, unsigned x, unsigned& nloc, unsigned& nx) {
    const unsigned G = gridDim.x * gridDim.y * gridDim.z;
    unsigned sum, cnt, mine, sp = 0u;
    for (;;) {
        sum = 0u; cnt = 0u; mine = 0u;
#pragma unroll
        for (unsigned j = 0; j < 16; ++j) { const unsigned c = xb_ld(&bar[XB_XCNT(j)]); sum += c; cnt += (c > 0u) ? 1u : 0u; mine = (j == x) ? c : mine; }
        if (sum == G) break;
        __builtin_amdgcn_s_sleep(1);
        if ((++sp & 255u) == 0u) { if (xb_ld(&bar[XB_TMO])) break; if (sp > XB_SPIN_CAP) { atomicAdd(&bar[XB_TMO], 1u); break; } }
    }
    nloc = mine > 0u ? mine : 1u; nx = cnt > 0u ? cnt : 1u;
}
__device__ __forceinline__ void xcd_barrier(const XcdBarrier& b) {
    asm volatile("s_waitcnt vmcnt(0)" ::: "memory");
    __syncthreads();
    if (threadIdx.x == 0) {
        unsigned* bar = b.bar; unsigned bx = b.x;
        asm volatile("" : "+s"(bar), "+s"(bx));
        __builtin_amdgcn_s_waitcnt(0);
        unsigned nloc = b.st[0], nx = b.st[1];
        if (nloc == 0u) { xcd_barrier_complete(bar, bx, nloc, nx); b.st[0] = nloc; b.st[1] = nx; }
        const unsigned old = xb_add(&bar[XB_XSUB(bx)], 1u);
        const unsigned gen = old / nloc;
        if (old + 1u == (gen + 1u) * nloc) {
            __builtin_amdgcn_fence(__ATOMIC_RELEASE, "agent");
            asm volatile("s_waitcnt vmcnt(0)" ::: "memory");
            const unsigned og = xb_add(&bar[XB_TOP], 1u);
            const unsigned tg = og / nx;
            if (og + 1u == (tg + 1u) * nx) xb_add(&bar[XB_TOPGEN], 1u);
            else XB_SPIN(xb_ld(&bar[XB_TOPGEN]) == tg, bar);
            __builtin_amdgcn_fence(__ATOMIC_ACQUIRE, "agent");
            xb_add(&bar[XB_XGEN(bx)], 1u);
            asm volatile("s_waitcnt vmcnt(0)" ::: "memory");
        } else {
            XB_SPIN(xb_ld(&bar[XB_XGEN(bx)]) == gen, bar);
            __builtin_amdgcn_fence(__ATOMIC_ACQUIRE, "agent");
            asm volatile("s_waitcnt vmcnt(0)" ::: "memory");
        }
    }
    __syncthreads();
}

constexpr int NWAVES = 8, NTHR = 512;
constexpr int RING_BYTES = 131072, MISC_OFF = RING_BYTES + 320, LDS_BYTES = 147456;

struct Inputs {
    const float *x, *c, *ctx, *c_ctx, *ada_w, *ada_b, *norm1_g, *w_in, *ret_decay, *ret_gn_g, *gdn_conv_w, *gdn_a_log, *gdn_dt_bias, *gdn_norm_g, *swa_sink, *w_out, *norm2_g,
        *ffn_w1, *ffn_w3, *ffn_w2, *router_w, *moe_w1, *moe_w3, *moe_w2, *final_g;
};
struct Args { Inputs in; float* out; unsigned char* ws; int ph_lo, ph_hi; };
static_assert(sizeof(Args) == 25 * 8 + 8 + 8 + 8, "no padding");


__device__ __forceinline__ const float* ld_ptr(const LAS unsigned long long* t, int i) { const unsigned long long v = t[i]; const unsigned lo = __builtin_amdgcn_readfirstlane((unsigned)v), hi = __builtin_amdgcn_readfirstlane((unsigned)(v >> 32)); return (const float*)(GAS const float*)(((unsigned long long)hi << 32) | lo); }
__device__ __forceinline__ Inputs load_inputs(const LAS unsigned long long* t) {
    Inputs in; const float** ip = (const float**)&in;
#pragma unroll
    for (int i = 0; i < 25; ++i) ip[i] = ld_ptr(t, i);
    return in;
}
struct Frame {
    LAS unsigned char* lds;
    int tid, lane, wave, G, gw, NGW, bid;
    unsigned char* ws;
};

template <class SrcF>
__device__ __forceinline__ void transpose_item(const SrcF& src, int K, bf16* WT, LAS float* scr, int k0, int n0, int lane) {
#pragma unroll
    for (int i = 0; i < 8; ++i) { const int row = 4 * i + (lane >> 4), col = 4 * (lane & 15); *(LAS f32x4*)(scr + row * 68 + col) = src(k0 + row, n0 + col); }
    LDS_WAIT(); asm volatile("" ::: "memory");
#pragma unroll
    for (int j = 0; j < 4; ++j) { const int ch = j * 64 + lane, n = ch >> 2, c8 = ch & 3; const LAS float* sp = scr + (8 * c8) * 68 + n;
        u32x4 o; o.x = cvtpk(sp[0 * 68], sp[1 * 68]); o.y = cvtpk(sp[2 * 68], sp[3 * 68]); o.z = cvtpk(sp[4 * 68], sp[5 * 68]); o.w = cvtpk(sp[6 * 68], sp[7 * 68]);
        *(u32x4*)(WT + (size_t)(n0 + n) * K + k0 + 8 * c8) = o; }
    LDS_WAIT(); asm volatile("" ::: "memory");
}
struct SrcPlain { const float* W; int ld; __device__ __forceinline__ f32x4 operator()(int k, int n) const { return *(const f32x4*)(W + (size_t)k * ld + n); } };
struct SrcWin { const float* W; __device__ __forceinline__ f32x4 operator()(int k, int n) const { return *(const f32x4*)(W + (size_t)k * INC + (n < 2048 ? n : n + 16)); } };
struct SrcGU { const float* W1; const float* W3; int ld; __device__ __forceinline__ f32x4 operator()(int k, int n) const { const int g = n >> 5, i = n & 31; const ptrdiff_t d = (i < 16) ? (ptrdiff_t)0 : (W3 - W1); return *(const f32x4*)(W1 + d + (ptrdiff_t)k * ld + 16 * g + (i & 15)); } };

__device__ __forceinline__ void convert_moe_layer(Frame& F, const Inputs& in, int mi) {
    LAS float* scr = (LAS float*)(F.lds + F.wave * 16384);
    bf16* mw13 = (bf16*)(F.ws + WS_MW13); bf16* mw2 = (bf16*)(F.ws + WS_MW2);
    constexpr int I13 = (D / 32) * (2 * EF / 64), I2 = (EF / 32) * (D / 64);
    for (int it = F.gw; it < NE * (I13 + I2); it += F.NGW) {
        const int e = it / (I13 + I2); int r = it % (I13 + I2);
        const size_t wo = ((size_t)mi * NE + e) * (size_t)D * EF;
        if (r < I13) { const int nblk = 2 * EF / 64; SrcGU s{in.moe_w1 + wo, in.moe_w3 + wo, EF}; transpose_item(s, D, mw13 + (size_t)e * 2 * EF * D, scr, 32 * (r / nblk), 64 * (r % nblk), F.lane); }
        else { r -= I13; const int nblk = D / 64; SrcPlain s{in.moe_w2 + wo, D}; transpose_item(s, EF, mw2 + (size_t)e * D * EF, scr, 32 * (r / nblk), 64 * (r % nblk), F.lane); }
    }
}

__device__ __forceinline__ void phase_prologue(Frame& F, const Inputs& in) {
    LAS float* scr = (LAS float*)(F.lds + F.wave * 16384);
    {
        constexpr int I_IN = (D / 32) * (NP / 64), I_OUT = (D / 32) * (D / 64), I_13 = (D / 32) * (2 * FF / 64), I_2 = (FF / 32) * (D / 64);
        constexpr int PER_L = I_IN + I_OUT, PER_F = I_13 + I_2, TOT = DEPTH * PER_L + 2 * PER_F;
        for (int it = F.gw; it < TOT; it += F.NGW) {
            if (it < DEPTH * PER_L) { const int l = it / PER_L; int r = it % PER_L;
                if (r < I_IN) { const int nblk = NP / 64; SrcWin s{in.w_in + (size_t)l * D * INC}; transpose_item(s, D, (bf16*)(F.ws + WS_WIN) + (size_t)l * NP * D, scr, 32 * (r / nblk), 64 * (r % nblk), F.lane); }
                else { r -= I_IN; const int nblk = D / 64; SrcPlain s{in.w_out + (size_t)l * D * D, D}; transpose_item(s, D, (bf16*)(F.ws + WS_WOUT) + (size_t)l * D * D, scr, 32 * (r / nblk), 64 * (r % nblk), F.lane); }
            } else { const int q = it - DEPTH * PER_L; const int i = q / PER_F; int r = q % PER_F;
                if (r < I_13) { const int nblk = 2 * FF / 64; SrcGU s{in.ffn_w1 + (size_t)i * D * FF, in.ffn_w3 + (size_t)i * D * FF, FF}; transpose_item(s, D, (bf16*)(F.ws + WS_W13) + (size_t)i * 2 * FF * D, scr, 32 * (r / nblk), 64 * (r % nblk), F.lane); }
                else { r -= I_13; const int nblk = D / 64; SrcPlain s{in.ffn_w2 + (size_t)i * FF * D, D}; transpose_item(s, FF, (bf16*)(F.ws + WS_W2) + (size_t)i * D * FF, scr, 32 * (r / nblk), 64 * (r % nblk), F.lane); }
            }
        }
    }
    convert_moe_layer(F, in, 0);
    {
        __syncthreads();
        LAS float* sc = (LAS float*)F.lds;
        LAS float* red = (LAS float*)(F.lds + 32768);
        for (int i = F.tid; i < 5 * D; i += NTHR) { const int r = i / D, k = i % D; const float v = r < 4 ? in.c[r * D + k] : in.c_ctx[k]; sc[i] = siluf(v); }
        __syncthreads();
        float* mod = (float*)(F.ws + WS_MOD);
        for (int u = F.bid; u < DEPTH * 96; u += F.G) {
            const int l = u / 96, n = (u % 96) * 64 + F.lane;
            const float* w = in.ada_w + (size_t)l * D * 6 * D + n;
            float a[5] = {0.f, 0.f, 0.f, 0.f, 0.f};
            for (int k = F.wave * 128; k < F.wave * 128 + 128; ++k) { const float wv = w[(size_t)k * 6 * D];
#pragma unroll
                for (int r = 0; r < 5; ++r) a[r] += sc[r * D + k] * wv; }
#pragma unroll
            for (int r = 0; r < 5; ++r) red[(F.wave * 5 + r) * 64 + F.lane] = a[r];
            __syncthreads();
            if (F.tid < 320) { const int r = F.tid / 64, ln = F.tid % 64; float s = 0.f;
#pragma unroll
                for (int w8 = 0; w8 < 8; ++w8) s += red[(w8 * 5 + r) * 64 + ln];
                const int nn = (u % 96) * 64 + ln;
                mod[((size_t)l * 5 + r) * 6 * D + nn] = s + in.ada_b[(size_t)l * 6 * D + nn]; }
            __syncthreads();
        }
    }
    if (F.bid == 0) { float* rp = (float*)(F.ws + WS_ROPE);
        for (int i = F.tid; i < 64 * 16; i += NTHR) { const int pos = i / 16, fi = i % 16; const double inv = pow(10000.0, -(double)fi / 16.0), ang = (double)pos * inv; rp[2 * i] = (float)cos(ang); rp[2 * i + 1] = (float)sin(ang); } }
}

__device__ __forceinline__ int mod_row(int m) { return m < MC ? 4 : ((m - MC) >> 12); }

template <int MODE>
__device__ __forceinline__ void phase_token(Frame& F, const Inputs& in, int layer, bool first_from_input, bool combine_moe, bool moe_router, float* out) {
    float* XS = (float*)(F.ws + WS_XS);
    bf16* H = (bf16*)(F.ws + WS_H);
    const float* mod = (const float*)(F.ws + WS_MOD) + (size_t)(layer < DEPTH ? layer : DEPTH - 1) * 5 * 6 * D;
    const float* modprev = (const float*)(F.ws + WS_MOD) + (size_t)(layer > 0 ? layer - 1 : 0) * 5 * 6 * D;
    const int* TKE = (const int*)(F.ws + WS_TKE); const float* TKG = (const float*)(F.ws + WS_TKG); const int* TOKROW = (const int*)(F.ws + WS_TOKROW);
    const float* YM = (const float*)(F.ws + WS_YM);
    LAS float* wl = (LAS float*)F.lds;
    if (MODE == 0) { __syncthreads(); const float* w = in.w_in + (size_t)layer * D * INC + 2048; for (int i = F.tid; i < D * 16; i += NTHR) { const int k = i >> 4, c = i & 15, kp = ((k >> 8) * 4 + (k & 3)) * 64 + ((k >> 2) & 63); wl[((c >> 2) * 1024 + kp) * 4 + (c & 3)] = w[(size_t)k * INC + c]; } __syncthreads(); }
    LAS int* lcnt = (LAS int*)(F.lds + 61440);
    if (MODE == 1 && moe_router) { __syncthreads(); if (F.tid < 8) lcnt[F.tid] = 0; const float* w = in.router_w + (size_t)(layer >> 1) * D * NE; for (int i = F.tid; i < D * NE; i += NTHR) { const int k = i >> 3, c = i & 7, kp = ((k >> 8) * 4 + (k & 3)) * 64 + ((k >> 2) & 63); wl[((c >> 2) * 1024 + kp) * 4 + (c & 3)] = w[i]; } __syncthreads(); }
    const float* gain = MODE == 0 ? in.norm1_g + (size_t)layer * D : (MODE == 1 ? in.norm2_g + (size_t)layer * D : in.final_g);
    const int m_lo = (MODE == 2) ? MC : 0;
    for (int m = m_lo + F.gw; m < M; m += F.NGW) {
        const int r = mod_row(m);
        f32x4 v[4];
        const float* xrow = first_from_input ? (m < MC ? in.ctx + (size_t)m * D : in.x + (size_t)(m - MC) * D) : XS + (size_t)m * D;
#pragma unroll
        for (int j = 0; j < 4; ++j) v[j] = *(const f32x4*)(xrow + 4 * F.lane + 256 * j);
        bool wrote = first_from_input;
        if (combine_moe && !(layer == DEPTH && m < MC)) {
            const int r0 = TOKROW[2 * m], r1 = TOKROW[2 * m + 1]; const float g0 = TKG[2 * m], g1 = TKG[2 * m + 1];
            const float* gt = modprev + (size_t)r * 6 * D + 5 * D;
#pragma unroll
            for (int j = 0; j < 4; ++j) { const f32x4 y0 = *(const f32x4*)(YM + (size_t)r0 * D + 4 * F.lane + 256 * j), y1 = *(const f32x4*)(YM + (size_t)r1 * D + 4 * F.lane + 256 * j);
                const f32x4 gg = *(const f32x4*)(gt + 4 * F.lane + 256 * j); v[j] += gg * (g0 * y0 + g1 * y1); }
            wrote = true;
        }
        if (wrote && MODE != 2) {
#pragma unroll
            for (int j = 0; j < 4; ++j) *(f32x4*)(XS + (size_t)m * D + 4 * F.lane + 256 * j) = v[j];
        }
        float ss = 0.f;
#pragma unroll
        for (int j = 0; j < 4; ++j) ss += (v[j].x * v[j].x + v[j].y * v[j].y) + (v[j].z * v[j].z + v[j].w * v[j].w);
        const float rstd = 1.0f / sqrtf(wave_sum(ss) * (1.0f / D) + EPS);
        if (MODE == 2) {
#pragma unroll
            for (int j = 0; j < 4; ++j) { const f32x4 g = *(const f32x4*)(gain + 4 * F.lane + 256 * j); *(f32x4*)(out + (size_t)(m - MC) * D + 4 * F.lane + 256 * j) = v[j] * rstd * g; }
            continue;
        }
        const float* sh = mod + (size_t)r * 6 * D + (MODE == 0 ? 0 : 3) * D; const float* scl = sh + D;
        f32x4 h[4];
#pragma unroll
        for (int j = 0; j < 4; ++j) { const f32x4 g = *(const f32x4*)(gain + 4 * F.lane + 256 * j), s1 = *(const f32x4*)(scl + 4 * F.lane + 256 * j), s0 = *(const f32x4*)(sh + 4 * F.lane + 256 * j);
            h[j] = v[j] * rstd * g * (1.0f + s1) + s0;
            u32x2 w; w.x = pk2(h[j].x, h[j].y); w.y = pk2(h[j].z, h[j].w); *(u32x2*)(H + (size_t)m * D + 4 * F.lane + 256 * j) = w; }
        if (MODE == 0) {
            float a[16];
#pragma unroll
            for (int c = 0; c < 16; ++c) a[c] = 0.f;
#pragma unroll
            for (int j = 0; j < 4; ++j)
#pragma unroll
                for (int e = 0; e < 4; ++e) { const int kp = (j * 4 + e) * 64 + F.lane; const float hv = h[j][e];
#pragma unroll
                    for (int q = 0; q < 4; ++q) { const f32x4 w = *(const LAS f32x4*)(wl + (q * 1024 + kp) * 4); a[4 * q] += hv * w.x; a[4 * q + 1] += hv * w.y; a[4 * q + 2] += hv * w.z; a[4 * q + 3] += hv * w.w; } }
            float mine = 0.f;
#pragma unroll
            for (int c = 0; c < 16; ++c) { const float s = wave_sum(a[c]); mine = (F.lane == c) ? s : mine; }
            if (F.lane < 16) ((float*)(F.ws + WS_AB))[(size_t)m * 16 + F.lane] = mine;
        }
        if (MODE == 1 && moe_router) {
            float a[8];
#pragma unroll
            for (int c = 0; c < 8; ++c) a[c] = 0.f;
#pragma unroll
            for (int j = 0; j < 4; ++j)
#pragma unroll
                for (int e = 0; e < 4; ++e) { const int kp = (j * 4 + e) * 64 + F.lane; const float hv = h[j][e];
#pragma unroll
                    for (int q = 0; q < 2; ++q) { const f32x4 w = *(const LAS f32x4*)(wl + (q * 1024 + kp) * 4); a[4 * q] += hv * w.x; a[4 * q + 1] += hv * w.y; a[4 * q + 2] += hv * w.z; a[4 * q + 3] += hv * w.w; } }
#pragma unroll
            for (int c = 0; c < 8; ++c) a[c] = wave_sum(a[c]);
            int i0 = 0; float l0 = a[0];
#pragma unroll
            for (int c = 1; c < 8; ++c) if (a[c] > l0) { l0 = a[c]; i0 = c; }
            int i1 = -1; float l1 = -3.0e38f;
#pragma unroll
            for (int c = 0; c < 8; ++c) if (c != i0 && a[c] > l1) { l1 = a[c]; i1 = c; }
            const float e1 = fexp(l1 - l0), g0 = 1.0f / (1.0f + e1), g1 = e1 / (1.0f + e1);
            if (F.lane == 0) { ((int*)(F.ws + WS_TKE))[2 * m] = i0; ((int*)(F.ws + WS_TKE))[2 * m + 1] = i1; ((float*)(F.ws + WS_TKG))[2 * m] = g0; ((float*)(F.ws + WS_TKG))[2 * m + 1] = g1; }
        }
    }
    (void)TKE;
}


template <int MODE>
__device__ __forceinline__ void phase_token2(Frame& F, const Inputs& in, int layer, bool first_from_input, bool combine_moe, bool moe_router, float* out, int route_lo = 0) {
    float* XS = (float*)(F.ws + WS_XS);
    bf16* H = (bf16*)(F.ws + WS_H);
    const float* mod = (const float*)(F.ws + WS_MOD) + (size_t)(layer < DEPTH ? layer : DEPTH - 1) * 5 * 6 * D;
    const float* modprev = (const float*)(F.ws + WS_MOD) + (size_t)(layer > 0 ? layer - 1 : 0) * 5 * 6 * D;
    const float* TKG = (const float*)(F.ws + WS_TKG); const int* TOKROW = (const int*)(F.ws + WS_TOKROW);
    const float* YM = (const float*)(F.ws + WS_YM);
    LAS float* wl = (LAS float*)F.lds;
    const int lane = F.lane;
    if (MODE == 0) PB(8);
    if (MODE == 0) { __syncthreads(); const float* w = in.w_in + (size_t)layer * D * INC + 2048;
#pragma unroll
        for (int n = 0; n < 8; ++n) { const int k = (F.tid >> 2) + 128 * n, q4 = F.tid & 3, kp = ((k >> 8) * 4 + (k & 3)) * 64 + ((k >> 2) & 63);
            *(LAS f32x4*)(wl + (q4 * 1024 + kp) * 4) = *(const f32x4*)(w + (size_t)k * INC + 4 * q4); }
        __syncthreads(); }
    LAS int* lcnt = (LAS int*)(F.lds + 61440);
    if (MODE == 1 && moe_router) { __syncthreads(); if (F.tid < 8) lcnt[F.tid] = 0; const float* w = in.router_w + (size_t)(layer >> 1) * D * NE;
#pragma unroll
        for (int n = 0; n < 4; ++n) { const int k = (F.tid >> 1) + 256 * n, q4 = F.tid & 1, kp = ((k >> 8) * 4 + (k & 3)) * 64 + ((k >> 2) & 63);
            *(LAS f32x4*)(wl + (q4 * 1024 + kp) * 4) = *(const f32x4*)(w + (size_t)k * NE + 4 * q4); }
        __syncthreads(); }
    if (MODE == 0) PE(8);
    if (MODE == 0) PB(9);
    if (MODE == 1) PB(10);
    const float* gain = MODE == 0 ? in.norm1_g + (size_t)layer * D : (MODE == 1 ? in.norm2_g + (size_t)layer * D : in.final_g);
    const int m_lo = (MODE == 2) ? MC : 0, R = M - m_lo;
    const int r_beg = m_lo + (int)(((long)F.gw * R) / F.NGW), r_end = m_lo + (int)(((long)(F.gw + 1) * R) / F.NGW);
    f32x4 gv[4], av[4], bv[4], gt[4];
#pragma unroll
    for (int j = 0; j < 4; ++j) gv[j] = *(const f32x4*)(gain + 4 * lane + 256 * j);
    int rcur = -1;
    for (int m0 = r_beg; m0 < r_end; m0 += 2) {
        const int ma = m0; const bool two = ma + 1 < r_end; const int m1 = two ? ma + 1 : ma;
        const int r = mod_row(ma);
        const bool same = mod_row(m1) == r;
        const int mm1 = same ? m1 : ma; const bool do1 = two && same;
        if (!same) m0 -= 1;
        if (r != rcur) { rcur = r;
            if (MODE != 2) { const float* sh = mod + (size_t)r * 6 * D + (MODE == 0 ? 0 : 3) * D;
#pragma unroll
                for (int j = 0; j < 4; ++j) { const f32x4 s1 = *(const f32x4*)(sh + D + 4 * lane + 256 * j); av[j] = gv[j] * (1.0f + s1); bv[j] = *(const f32x4*)(sh + 4 * lane + 256 * j); } }
            if (combine_moe) {
#pragma unroll
                for (int j = 0; j < 4; ++j) gt[j] = *(const f32x4*)(modprev + (size_t)r * 6 * D + 5 * D + 4 * lane + 256 * j); } }
        const int mr[2] = {ma, mm1};
        f32x4 v[2][4];
        int t0[2], t1[2]; float g0[2], g1[2];
        if (combine_moe) {
#pragma unroll
            for (int p = 0; p < 2; ++p) { t0[p] = TOKROW[2 * mr[p]]; t1[p] = TOKROW[2 * mr[p] + 1]; g0[p] = TKG[2 * mr[p]]; g1[p] = TKG[2 * mr[p] + 1]; } }
#pragma unroll
        for (int p = 0; p < 2; ++p) { const int m = mr[p];
            const float* xrow = first_from_input ? (m < MC ? in.ctx + (size_t)m * D : in.x + (size_t)(m - MC) * D) : XS + (size_t)m * D;
#pragma unroll
            for (int j = 0; j < 4; ++j) v[p][j] = *(const f32x4*)(xrow + 4 * lane + 256 * j); }
        if (combine_moe) {
#pragma unroll
            for (int p = 0; p < 2; ++p)
#pragma unroll
                for (int j = 0; j < 4; ++j) { const f32x4 y0 = *(const f32x4*)(YM + (size_t)t0[p] * D + 4 * lane + 256 * j), y1 = *(const f32x4*)(YM + (size_t)t1[p] * D + 4 * lane + 256 * j);
                    v[p][j] += gt[j] * (g0[p] * y0 + g1[p] * y1); } }
        if ((first_from_input || combine_moe) && MODE != 2) {
#pragma unroll
            for (int p = 0; p < 2; ++p) if (p == 0 || do1) {
#pragma unroll
                for (int j = 0; j < 4; ++j) *(f32x4*)(XS + (size_t)mr[p] * D + 4 * lane + 256 * j) = v[p][j]; } }
        float rstd[2];
#pragma unroll
        for (int p = 0; p < 2; ++p) { float ss = 0.f;
#pragma unroll
            for (int j = 0; j < 4; ++j) ss += (v[p][j].x * v[p][j].x + v[p][j].y * v[p][j].y) + (v[p][j].z * v[p][j].z + v[p][j].w * v[p][j].w);
            rstd[p] = 1.0f / sqrtf(wave_sum(ss) * (1.0f / D) + EPS); }
        if (MODE == 2) {
#pragma unroll
            for (int p = 0; p < 2; ++p) if (p == 0 || do1) {
#pragma unroll
                for (int j = 0; j < 4; ++j) *(f32x4*)(out + (size_t)(mr[p] - MC) * D + 4 * lane + 256 * j) = v[p][j] * rstd[p] * gv[j]; }
            continue; }
        f32x4 h[2][4];
#pragma unroll
        for (int p = 0; p < 2; ++p)
#pragma unroll
            for (int j = 0; j < 4; ++j) { h[p][j] = v[p][j] * rstd[p] * av[j] + bv[j];
                if (p == 0 || do1) { u32x2 w; w.x = cvtpk(h[p][j].x, h[p][j].y); w.y = cvtpk(h[p][j].z, h[p][j].w); *(u32x2*)(H + (size_t)mr[p] * D + 4 * lane + 256 * j) = w; } }
        if (MODE == 0 || (MODE == 1 && moe_router)) {
            constexpr int NC = (MODE == 0) ? 16 : 8;
            float a[2][NC];
#pragma unroll
            for (int p = 0; p < 2; ++p)
#pragma unroll
                for (int c = 0; c < NC; ++c) a[p][c] = 0.f;
#pragma unroll
            for (int j = 0; j < 4; ++j)
#pragma unroll
                for (int e = 0; e < 4; ++e) { const int kp = (j * 4 + e) * 64 + lane;
#pragma unroll
                    for (int q = 0; q < NC / 4; ++q) { const f32x4 w = *(const LAS f32x4*)(wl + (q * 1024 + kp) * 4);
#pragma unroll
                        for (int p = 0; p < 2; ++p) { const float hv = h[p][j][e]; a[p][4 * q] += hv * w.x; a[p][4 * q + 1] += hv * w.y; a[p][4 * q + 2] += hv * w.z; a[p][4 * q + 3] += hv * w.w; } } }
#pragma unroll
            for (int p = 0; p < 2; ++p) {
#pragma unroll
                for (int c = 0; c < NC; ++c) a[p][c] = wave_sum(a[p][c]); }
#pragma unroll
            for (int p = 0; p < 2; ++p) if (p == 0 || do1) { const int m = mr[p];
                if (MODE == 0) { float mine = 0.f;
#pragma unroll
                    for (int c = 0; c < NC; ++c) mine = (lane == c) ? a[p][c] : mine;
                    if (lane < 16) ((float*)(F.ws + WS_AB))[(size_t)m * 16 + lane] = mine; }
                else { int i0 = 0; float l0 = a[p][0];
#pragma unroll
                    for (int c = 1; c < NC; ++c) if (a[p][c] > l0) { l0 = a[p][c]; i0 = c; }
                    int i1 = -1; float l1 = -3.0e38f;
#pragma unroll
                    for (int c = 0; c < NC; ++c) if (c != i0 && a[p][c] > l1) { l1 = a[p][c]; i1 = c; }
                    const float e1 = fexp(l1 - l0), gg0 = 1.0f / (1.0f + e1), gg1 = e1 / (1.0f + e1);
                    if (lane == 0 && m >= route_lo) { ((int*)(F.ws + WS_TKE))[2 * m] = i0; ((int*)(F.ws + WS_TKE))[2 * m + 1] = i1; ((float*)(F.ws + WS_TKG))[2 * m] = gg0; ((float*)(F.ws + WS_TKG))[2 * m + 1] = gg1;
                        ((int*)(F.ws + WS_TOKROW))[2 * m] = __hip_atomic_fetch_add(lcnt + i0, 1, __ATOMIC_RELAXED, __HIP_MEMORY_SCOPE_WORKGROUP); ((int*)(F.ws + WS_TOKROW))[2 * m + 1] = __hip_atomic_fetch_add(lcnt + i1, 1, __ATOMIC_RELAXED, __HIP_MEMORY_SCOPE_WORKGROUP); } } }
        }
    }
    if (MODE == 0) PE(9);
    if (MODE == 1) PE(10);
    if (MODE == 1 && moe_router) { __syncthreads(); if (F.tid < 8) ((int*)(F.ws + WS_TILEE + 4096))[F.bid * 8 + F.tid] = lcnt[F.tid]; }
}

__device__ __forceinline__ void phase_prep(Frame& F, const Inputs& in, int layer) {
    const bf16* P = (const bf16*)(F.ws + WS_R1 + R1_P);
    unsigned char* prep = F.ws + WS_R1 + R1_PREP;
    bf16* RQ = (bf16*)(prep + PREP_RQ); bf16* RK = (bf16*)(prep + PREP_RK); bf16* SQ = (bf16*)(prep + PREP_SQ); bf16* SK = (bf16*)(prep + PREP_SK); bf16* GD = (bf16*)(prep + PREP_GD);
    const float* rope = (const float*)(F.ws + WS_ROPE);
    const float* AB = (const float*)(F.ws + WS_AB); float* GB = (float*)(F.ws + WS_GB);
    const float* cw = in.gdn_conv_w + (size_t)layer * 5 * 768;
    const int lane = F.lane;
    for (int m = F.gw; m < M; m += F.NGW) {
        const bool lat = m >= MC; const int t = lat ? ((m - MC) & (TL - 1)) : (m & (TC - 1)); const int Tn = lat ? TL : TC;
        const bf16* prow = P + (size_t)m * NP;
        float cs = 1.f, sn = 0.f;
        if (lat) { const int j = lane & 31; const int pos = j < 16 ? (t >> 6) : (t & 63); const int fi = j & 15; cs = rope[(pos * 16 + fi) * 2]; sn = rope[(pos * 16 + fi) * 2 + 1]; if (lane < 32) sn = -sn; }
#pragma unroll
        for (int hh = 0; hh < 4; ++hh) { const float q = bf2f(prow[PC_RQ + hh * 64 + lane]), k = bf2f(prow[PC_RK + hh * 64 + lane]) * 0.125f;
            const float qp = __shfl_xor(q, 32), kp = __shfl_xor(k, 32);
            RQ[(size_t)m * 256 + hh * 64 + lane] = (bf16)f2bf(q * cs + qp * sn); RK[(size_t)m * 256 + hh * 64 + lane] = (bf16)f2bf(k * cs + kp * sn); }
#pragma unroll
        for (int hq = 0; hq < 8; ++hq) { const float q = bf2f(prow[PC_SQ + hq * 64 + lane]); const float qp = __shfl_xor(q, 32); SQ[(size_t)m * 512 + hq * 64 + lane] = (bf16)f2bf(q * cs + qp * sn); }
#pragma unroll
        for (int g = 0; g < 2; ++g) { const float k = bf2f(prow[PC_SK + g * 64 + lane]); const float kp = __shfl_xor(k, 32); SK[(size_t)m * 128 + g * 64 + lane] = (bf16)f2bf(k * cs + kp * sn); }
#pragma unroll 1
        for (int s = 0; s < 12; ++s) { const int c = s * 64 + lane; float y = 0.f;
#pragma unroll
            for (int j = 0; j < 5; ++j) { const int tt = t + j - 2; if (tt >= 0 && tt < Tn) y += cw[j * 768 + c] * bf2f(prow[(ptrdiff_t)(j - 2) * NP + PC_GQKV + c]); }
            y = siluf(y);
            if (s < 8) { const float n2 = wave_sum(y * y); y = y * (1.0f / sqrtf(n2 + EPS)); if (s < 4) y *= 0.125f; }
            GD[(size_t)m * 768 + c] = (bf16)f2bf(y); }
        if (lane < 16) { const int dh = lane & 7; const float a = AB[(size_t)m * 16 + lane];
            float o;
            if (lane < 8) { const float xx = a + in.gdn_dt_bias[layer * 8 + dh]; const float sp = fmaxf(xx, 0.f) + log1pf(fexp(-fabsf(xx))); o = -fexp(in.gdn_a_log[layer * 8 + dh]) * sp; }
            else o = 1.0f / (1.0f + fexp(-a));
            GB[(size_t)m * 16 + lane] = o; }
    }
}


__device__ __forceinline__ void unpack8(const u32x4 w, float (&v)[8]) {
#pragma unroll
    for (int e = 0; e < 4; ++e) { v[2 * e] = __uint_as_float(w[e] << 16); v[2 * e + 1] = __uint_as_float(w[e] & 0xffff0000u); } }
__device__ __forceinline__ u32x4 pack8(const float (&v)[8]) { u32x4 w; w.x = cvtpk(v[0], v[1]); w.y = cvtpk(v[2], v[3]); w.z = cvtpk(v[4], v[5]); w.w = cvtpk(v[6], v[7]); return w; }
__device__ __forceinline__ void phase_prep2(Frame& F, const Inputs& in, int layer) {
    const bf16* P = (const bf16*)(F.ws + WS_R1 + R1_P);
    unsigned char* prep = F.ws + WS_R1 + R1_PREP;
    bf16* RQ = (bf16*)(prep + PREP_RQ); bf16* RK = (bf16*)(prep + PREP_RK); bf16* SQ = (bf16*)(prep + PREP_SQ); bf16* SK = (bf16*)(prep + PREP_SK); bf16* GD = (bf16*)(prep + PREP_GD);
    const float* rope = (const float*)(F.ws + WS_ROPE);
    const float* AB = (const float*)(F.ws + WS_AB); float* GB = (float*)(F.ws + WS_GB);
    const float* cw = in.gdn_conv_w + (size_t)layer * 5 * 768;
    const int lane = F.lane, l3 = lane & 3, l31 = lane & 31;
    float wA[5][8], wB[5][8];
#pragma unroll
    for (int j = 0; j < 5; ++j) { const f32x4 a0 = *(const f32x4*)(cw + j * 768 + 8 * lane), a1 = *(const f32x4*)(cw + j * 768 + 8 * lane + 4), b0 = *(const f32x4*)(cw + j * 768 + 512 + 8 * l31), b1 = *(const f32x4*)(cw + j * 768 + 512 + 8 * l31 + 4);
#pragma unroll
        for (int x = 0; x < 4; ++x) { wA[j][x] = a0[x]; wA[j][4 + x] = a1[x]; wB[j][x] = b0[x]; wB[j][4 + x] = b1[x]; } }
    const float sgn = ((lane & 7) < 4) ? -1.0f : 1.0f;
    for (int m = F.gw; m < M; m += F.NGW) {
        const bool lat = m >= MC; const int t = lat ? ((m - MC) & (TL - 1)) : (m & (TC - 1)); const int Tn = lat ? TL : TC;
        const bf16* prow = P + (size_t)m * NP;
        float cs[8], sn[8];
        { const int pos = (l3 < 2) ? (t >> 6) : (t & 63); const float* rp = rope + (pos * 16 + 8 * (l3 & 1)) * 2;
          const f32x4 r0 = *(const f32x4*)(rp), r1 = *(const f32x4*)(rp + 4), r2 = *(const f32x4*)(rp + 8), r3 = *(const f32x4*)(rp + 12);
          cs[0] = r0[0]; sn[0] = r0[1]; cs[1] = r0[2]; sn[1] = r0[3]; cs[2] = r1[0]; sn[2] = r1[1]; cs[3] = r1[2]; sn[3] = r1[3];
          cs[4] = r2[0]; sn[4] = r2[1]; cs[5] = r2[2]; sn[5] = r2[3]; cs[6] = r3[0]; sn[6] = r3[1]; cs[7] = r3[2]; sn[7] = r3[3];
#pragma unroll
          for (int x = 0; x < 8; ++x) { if (!lat) { cs[x] = 1.0f; sn[x] = 0.0f; } sn[x] *= sgn; } }
        { const bool isk = lane >= 32; float v[8], o[8]; unpack8(*(const u32x4*)(prow + (isk ? PC_RK : PC_RQ) + 8 * l31), v);
#pragma unroll
          for (int x = 0; x < 8; ++x) { if (isk) v[x] *= 0.125f; const float pv = __shfl_xor(v[x], 4); o[x] = v[x] * cs[x] + pv * sn[x]; }
          *(u32x4*)((isk ? RK : RQ) + (size_t)m * 256 + 8 * l31) = pack8(o); }
        { float v[8], o[8]; unpack8(*(const u32x4*)(prow + PC_SQ + 8 * lane), v);
#pragma unroll
          for (int x = 0; x < 8; ++x) { const float pv = __shfl_xor(v[x], 4); o[x] = v[x] * cs[x] + pv * sn[x]; }
          *(u32x4*)(SQ + (size_t)m * 512 + 8 * lane) = pack8(o); }
        { float v[8], o[8]; unpack8(*(const u32x4*)(prow + PC_SK + 8 * (lane & 15)), v);
#pragma unroll
          for (int x = 0; x < 8; ++x) { const float pv = __shfl_xor(v[x], 4); o[x] = v[x] * cs[x] + pv * sn[x]; }
          if (lane < 16) *(u32x4*)(SK + (size_t)m * 128 + 8 * lane) = pack8(o); }
        { float a[8], bq[8];
#pragma unroll
          for (int x = 0; x < 8; ++x) { a[x] = 0.f; bq[x] = 0.f; }
#pragma unroll
          for (int j = 0; j < 5; ++j) { const int tt = t + j - 2; const bool ok = tt >= 0 && tt < Tn; const bf16* pr = prow + (ok ? (ptrdiff_t)(j - 2) * NP : (ptrdiff_t)0) + PC_GQKV;
              float va[8], vb[8]; unpack8(*(const u32x4*)(pr + 8 * lane), va); unpack8(*(const u32x4*)(pr + 512 + 8 * l31), vb);
              const float z = ok ? 1.0f : 0.0f;
#pragma unroll
              for (int x = 0; x < 8; ++x) { a[x] += z * wA[j][x] * va[x]; bq[x] += z * wB[j][x] * vb[x]; } }
          float n2 = 0.f;
#pragma unroll
          for (int x = 0; x < 8; ++x) { a[x] = siluf(a[x]); bq[x] = siluf(bq[x]); n2 += a[x] * a[x]; }
          n2 += dppf<0xB1>(n2); n2 += dppf<0x4E>(n2); n2 += dppf<0x141>(n2);
          const float sc = (1.0f / sqrtf(n2 + EPS)) * (lane < 32 ? 0.125f : 1.0f);
#pragma unroll
          for (int x = 0; x < 8; ++x) a[x] *= sc;
          *(u32x4*)(GD + (size_t)m * 768 + 8 * lane) = pack8(a);
          if (lane < 32) *(u32x4*)(GD + (size_t)m * 768 + 512 + 8 * lane) = pack8(bq); }
        if (lane < 16) { const int dh = lane & 7; const float a = AB[(size_t)m * 16 + lane];
            float o;
            if (lane < 8) { const float xx = a + in.gdn_dt_bias[layer * 8 + dh]; const float sp = fmaxf(xx, 0.f) + log1pf(fexp(-fabsf(xx))); o = -fexp(in.gdn_a_log[layer * 8 + dh]) * sp; }
            else o = 1.0f / (1.0f + fexp(-a));
            GB[(size_t)m * 16 + lane] = o; }
    }
}

__device__ __forceinline__ int scan_row(int b, int dir, int tau) {
    if (tau < TC) { const int c = dir ? TC - 1 - tau : tau; return b * TC + c; }
    const int tt = tau - TC; const int t = dir ? TL - 1 - tt : tt; return MC + b * TL + t;
}
__device__ __forceinline__ void phase_scans(Frame& F, const Inputs& in, int layer, int nscan) {
    if (F.wave != 0 || F.bid >= nscan) return;
    const int id = F.bid; const bool gdn = id >= 32; const int sid = id & 31; const int b = sid >> 3, hh = (sid >> 1) & 3, dir = sid & 1;
    const bf16* P = (const bf16*)(F.ws + WS_R1 + R1_P);
    unsigned char* prep = F.ws + WS_R1 + R1_PREP;
    const bf16* RQ = (const bf16*)(prep + PREP_RQ); const bf16* RK = (const bf16*)(prep + PREP_RK); const bf16* GD = (const bf16*)(prep + PREP_GD);
    const float* GB = (const float*)(F.ws + WS_GB);
    float* OUT = (float*)(F.ws + WS_R1 + (gdn ? R1_OG : R1_OR)) + (size_t)dir * M * 256;
    LAS float* lk = (LAS float*)F.lds; LAS float* lq = lk + 64 * 64; LAS float* lg = lq + 64 * 64;
    const int lane = F.lane;
    float S[64];
#pragma unroll
    for (int i = 0; i < 64; ++i) S[i] = 0.f;
    const float gamma = gdn ? 0.f : fexp(-fexp(in.ret_decay[layer * 8 + dir * 4 + hh]));
    for (int t0 = 0; t0 < TC + TL; t0 += 64) {
        for (int i = 0; i < 64; ++i) { const int m = scan_row(b, dir, t0 + i);
            if (gdn) { lq[i * 64 + lane] = bf2f(GD[(size_t)m * 768 + hh * 64 + lane]); lk[i * 64 + lane] = bf2f(GD[(size_t)m * 768 + 256 + hh * 64 + lane]); if (lane < 2) lg[i * 2 + lane] = GB[(size_t)m * 16 + lane * 8 + dir * 4 + hh]; }
            else { lq[i * 64 + lane] = bf2f(RQ[(size_t)m * 256 + hh * 64 + lane]); lk[i * 64 + lane] = bf2f(RK[(size_t)m * 256 + hh * 64 + lane]); } }
        LDS_WAIT(); asm volatile("" ::: "memory");
        for (int i = 0; i < 64; ++i) { const int m = scan_row(b, dir, t0 + i);
            float o = 0.f;
            if (gdn) {
                const float v = bf2f(GD[(size_t)m * 768 + 512 + hh * 64 + lane]); const float a = fexp(lg[i * 2]), beta = lg[i * 2 + 1];
                float ks = 0.f;
#pragma unroll
                for (int d4 = 0; d4 < 16; ++d4) { const f32x4 kv = *(const LAS f32x4*)(lk + i * 64 + 4 * d4); ks += kv.x * S[4 * d4] + kv.y * S[4 * d4 + 1] + kv.z * S[4 * d4 + 2] + kv.w * S[4 * d4 + 3]; }
                const float vn = beta * (v - a * ks);
#pragma unroll
                for (int d4 = 0; d4 < 16; ++d4) { const f32x4 kv = *(const LAS f32x4*)(lk + i * 64 + 4 * d4), qv = *(const LAS f32x4*)(lq + i * 64 + 4 * d4);
                    S[4 * d4] = a * S[4 * d4] + kv.x * vn; S[4 * d4 + 1] = a * S[4 * d4 + 1] + kv.y * vn; S[4 * d4 + 2] = a * S[4 * d4 + 2] + kv.z * vn; S[4 * d4 + 3] = a * S[4 * d4 + 3] + kv.w * vn;
                    o += qv.x * S[4 * d4] + qv.y * S[4 * d4 + 1] + qv.z * S[4 * d4 + 2] + qv.w * S[4 * d4 + 3]; }
            } else {
                const float v = bf2f(P[(size_t)m * NP + PC_RV + hh * 64 + lane]);
#pragma unroll
                for (int d4 = 0; d4 < 16; ++d4) { const f32x4 kv = *(const LAS f32x4*)(lk + i * 64 + 4 * d4), qv = *(const LAS f32x4*)(lq + i * 64 + 4 * d4);
                    S[4 * d4] = gamma * S[4 * d4] + kv.x * v; S[4 * d4 + 1] = gamma * S[4 * d4 + 1] + kv.y * v; S[4 * d4 + 2] = gamma * S[4 * d4 + 2] + kv.z * v; S[4 * d4 + 3] = gamma * S[4 * d4 + 3] + kv.w * v;
                    o += qv.x * S[4 * d4] + qv.y * S[4 * d4 + 1] + qv.z * S[4 * d4 + 2] + qv.w * S[4 * d4 + 3]; }
            }
            OUT[(size_t)m * 256 + hh * 64 + lane] = o;
        }
        LDS_WAIT(); asm volatile("" ::: "memory");
    }
}

__device__ __forceinline__ void phase_swa(Frame& F, const Inputs& in, int layer) {
    const bf16* P = (const bf16*)(F.ws + WS_R1 + R1_P);
    unsigned char* prep = F.ws + WS_R1 + R1_PREP;
    const bf16* SQ = (const bf16*)(prep + PREP_SQ); const bf16* SK = (const bf16*)(prep + PREP_SK);
    bf16* O = (bf16*)(F.ws + WS_R1 + R1_O);
    const int NT = F.G * NTHR;
    for (int idx = F.bid * NTHR + F.tid; idx < M * 8; idx += NT) {
        const int hq = idx / M, m = idx % M, g = hq >> 2;
        const bool lat = m >= MC; const int b = lat ? ((m - MC) >> 12) : (m >> 8); const int t = lat ? ((m - MC) & (TL - 1)) : (m & (TC - 1));
        float q[64], o[64];
#pragma unroll
        for (int i = 0; i < 8; ++i) { const u32x4 w = *(const u32x4*)(SQ + (size_t)m * 512 + hq * 64 + 8 * i);
#pragma unroll
            for (int e = 0; e < 4; ++e) { q[8 * i + 2 * e] = __uint_as_float(w[e] << 16) * 0.125f; q[8 * i + 2 * e + 1] = __uint_as_float(w[e] & 0xffff0000u) * 0.125f; } }
#pragma unroll
        for (int i = 0; i < 64; ++i) o[i] = 0.f;
        float mx = in.swa_sink[layer * 8 + hq], l = 1.0f;
        const int nloc = lat ? 257 : 0;
        for (int kk = 0; kk < nloc + TC; ++kk) {
            int row;
            if (kk < nloc) { const int s = t - 128 + kk; if (s < 0 || s >= TL) continue; row = MC + b * TL + s; }
            else row = b * TC + (kk - nloc);
            float sc = 0.f;
#pragma unroll
            for (int i = 0; i < 8; ++i) { const u32x4 w = *(const u32x4*)(SK + (size_t)row * 128 + g * 64 + 8 * i);
#pragma unroll
                for (int e = 0; e < 4; ++e) sc += q[8 * i + 2 * e] * __uint_as_float(w[e] << 16) + q[8 * i + 2 * e + 1] * __uint_as_float(w[e] & 0xffff0000u); }
            const float mn = fmaxf(mx, sc), corr = fexp(mx - mn), p = fexp(sc - mn);
            l = l * corr + p; mx = mn;
#pragma unroll
            for (int i = 0; i < 8; ++i) { const u32x4 w = *(const u32x4*)(P + (size_t)row * NP + PC_SV + g * 64 + 8 * i);
#pragma unroll
                for (int e = 0; e < 4; ++e) { o[8 * i + 2 * e] = o[8 * i + 2 * e] * corr + p * __uint_as_float(w[e] << 16); o[8 * i + 2 * e + 1] = o[8 * i + 2 * e + 1] * corr + p * __uint_as_float(w[e] & 0xffff0000u); } }
        }
        const float il = 1.0f / l;
#pragma unroll
        for (int i = 0; i < 8; ++i) { u32x4 w;
#pragma unroll
            for (int e = 0; e < 4; ++e) w[e] = pk2(o[8 * i + 2 * e] * il, o[8 * i + 2 * e + 1] * il);
            *(u32x4*)(O + (size_t)m * D + 512 + hq * 64 + 8 * i) = w; }
    }
}


__device__ __forceinline__ void phase_swa2(Frame& F, const Inputs& in, int layer, int nwg) {
    if (F.bid >= nwg) return;
    const bf16* P = (const bf16*)(F.ws + WS_R1 + R1_P);
    unsigned char* prep = F.ws + WS_R1 + R1_PREP;
    const bf16* SQ = (const bf16*)(prep + PREP_SQ); const bf16* SK = (const bf16*)(prep + PREP_SK);
    bf16* O = (bf16*)(F.ws + WS_R1 + R1_O);
    LAS bf16* Kl = (LAS bf16*)F.lds; LAS bf16* Vt = Kl + 64 * 72;
    const int lane = F.lane, c = lane & 15, q = lane >> 4, w = F.wave;
    const float LOG2E = 1.4426950408889634f;
    const int srow = F.tid >> 3, scol = (F.tid & 7) * 8;
    for (int u = F.bid; u < 544; u += nwg) {
        const bool lat = u < 512; int b, g, qb;
        if (lat) { b = u >> 7; g = (u >> 6) & 1; qb = u & 63; } else { const int uu = u - 512; b = uu >> 3; g = (uu >> 2) & 1; qb = uu & 3; }
        const int hq = 4 * g + (w >> 1), i0 = 32 * (w & 1);
        const int mrow0 = lat ? MC + b * TL + 64 * qb : b * TC + 64 * qb;
        const int kt0 = lat ? (2 - qb > 0 ? 2 - qb : 0) : 0, kt1 = lat ? (65 - qb < 4 ? 65 - qb : 4) : -1, nb = lat ? kt1 - kt0 + 1 : 0, nt = nb + 4;
        const int band0 = MC + b * TL + 64 * qb - 128 + 64 * kt0, ctx0 = b * TC;
        bf16x8 qf[2][2];
#pragma unroll
        for (int ti = 0; ti < 2; ++ti)
#pragma unroll
            for (int ks = 0; ks < 2; ++ks) qf[ti][ks] = *(const bf16x8*)(SQ + (size_t)(mrow0 + i0 + 16 * ti + c) * 512 + hq * 64 + 32 * ks + 8 * q);
        float mrun[2], lrun[2]; f32x4 oacc[4][2];
        const float sk = in.swa_sink[layer * 8 + hq] * LOG2E;
#pragma unroll
        for (int ti = 0; ti < 2; ++ti) { mrun[ti] = sk; lrun[ti] = 1.0f;
#pragma unroll
            for (int te = 0; te < 4; ++te) oacc[te][ti] = (f32x4){0.f, 0.f, 0.f, 0.f}; }
        u32x4 kreg, vreg;
        { const int r0 = (0 < nb) ? band0 : ctx0; kreg = *(const u32x4*)(SK + (size_t)(r0 + srow) * 128 + g * 64 + scol); vreg = *(const u32x4*)(P + (size_t)(r0 + srow) * NP + PC_SV + g * 64 + scol); }
        for (int tt = 0; tt < nt; ++tt) {
            __syncthreads();
            *(LAS u32x4*)(Kl + srow * 72 + scol) = kreg;
#pragma unroll
            for (int x = 0; x < 8; ++x) Vt[(scol + x) * 72 + srow] = (bf16)(vreg[x >> 1] >> (16 * (x & 1)));
            __syncthreads();
            if (tt + 1 < nt) { const int r0 = (tt + 1 < nb) ? band0 + 64 * (tt + 1) : ctx0 + 64 * (tt + 1 - nb);
                kreg = *(const u32x4*)(SK + (size_t)(r0 + srow) * 128 + g * 64 + scol); vreg = *(const u32x4*)(P + (size_t)(r0 + srow) * NP + PC_SV + g * 64 + scol); }
            bf16x8 kfr[2][4]; u32x2 vlo[2][4], vhi[2][4];
#pragma unroll
            for (int ks = 0; ks < 2; ++ks)
#pragma unroll
                for (int tj = 0; tj < 4; ++tj) kfr[ks][tj] = *(const LAS bf16x8*)(Kl + (16 * tj + c) * 72 + 32 * ks + 8 * q);
#pragma unroll
            for (int ks2 = 0; ks2 < 2; ++ks2)
#pragma unroll
                for (int te = 0; te < 4; ++te) { vlo[ks2][te] = *(const LAS u32x2*)(Vt + (16 * te + c) * 72 + 32 * ks2 + 4 * q); vhi[ks2][te] = *(const LAS u32x2*)(Vt + (16 * te + c) * 72 + 32 * ks2 + 16 + 4 * q); }
            __builtin_amdgcn_sched_barrier(0);
            f32x4 sacc[4][2];
#pragma unroll
            for (int tj = 0; tj < 4; ++tj)
#pragma unroll
                for (int ti = 0; ti < 2; ++ti) sacc[tj][ti] = (f32x4){0.f, 0.f, 0.f, 0.f};
#pragma unroll
            for (int ks = 0; ks < 2; ++ks)
#pragma unroll
                for (int tj = 0; tj < 4; ++tj)
#pragma unroll
                    for (int ti = 0; ti < 2; ++ti) sacc[tj][ti] = mfma16(kfr[ks][tj], qf[ti][ks], sacc[tj][ti]);
            const bool band = tt < nb;
            const int kp0 = 64 * qb - 128 + 64 * (kt0 + tt) + 4 * q;
#pragma unroll
            for (int ti = 0; ti < 2; ++ti) {
                const int qp = 64 * qb + i0 + 16 * ti + c;
                float mx = -30000.0f;
                if (band) {
#pragma unroll
                    for (int tj = 0; tj < 4; ++tj)
#pragma unroll
                        for (int r = 0; r < 4; ++r) { float sv = sacc[tj][ti][r] * (0.125f * LOG2E); const int dlt = kp0 + 16 * tj + r - qp; if (dlt > 128 || dlt < -128) sv = -30000.0f; sacc[tj][ti][r] = sv; mx = fmaxf(mx, sv); }
                } else {
#pragma unroll
                    for (int tj = 0; tj < 4; ++tj)
#pragma unroll
                        for (int r = 0; r < 4; ++r) { const float sv = sacc[tj][ti][r] * (0.125f * LOG2E); sacc[tj][ti][r] = sv; mx = fmaxf(mx, sv); }
                }
                mx = quad_rows_max(mx);
                const float mn = fmaxf(mrun[ti], mx), corr = __builtin_amdgcn_exp2f(mrun[ti] - mn);
                float ls = 0.f;
#pragma unroll
                for (int tj = 0; tj < 4; ++tj)
#pragma unroll
                    for (int r = 0; r < 4; ++r) { const float p = __builtin_amdgcn_exp2f(sacc[tj][ti][r] - mn); sacc[tj][ti][r] = p; ls += p; }
                ls = quad_rows_sum(ls);
                lrun[ti] = lrun[ti] * corr + ls; mrun[ti] = mn;
#pragma unroll
                for (int te = 0; te < 4; ++te) oacc[te][ti] *= corr;
            }
#pragma unroll
            for (int ks2 = 0; ks2 < 2; ++ks2) {
                bf16x8 pb[2];
#pragma unroll
                for (int ti = 0; ti < 2; ++ti) { u32x4 t; t.x = cvtpk(sacc[2 * ks2][ti][0], sacc[2 * ks2][ti][1]); t.y = cvtpk(sacc[2 * ks2][ti][2], sacc[2 * ks2][ti][3]);
                    t.z = cvtpk(sacc[2 * ks2 + 1][ti][0], sacc[2 * ks2 + 1][ti][1]); t.w = cvtpk(sacc[2 * ks2 + 1][ti][2], sacc[2 * ks2 + 1][ti][3]); pb[ti] = __builtin_bit_cast(bf16x8, t); }
#pragma unroll
                for (int te = 0; te < 4; ++te) { const bf16x8 va = __builtin_bit_cast(bf16x8, ((u32x4){vlo[ks2][te].x, vlo[ks2][te].y, vhi[ks2][te].x, vhi[ks2][te].y}));
#pragma unroll
                    for (int ti = 0; ti < 2; ++ti) oacc[te][ti] = mfma16(va, pb[ti], oacc[te][ti]); }
            }
        }
#pragma unroll
        for (int ti = 0; ti < 2; ++ti) { const float il = 1.0f / lrun[ti]; bf16* orow = O + (size_t)(mrow0 + i0 + 16 * ti + c) * D + 512 + hq * 64 + 4 * q;
#pragma unroll
            for (int te = 0; te < 4; ++te) { u32x2 wv; wv.x = cvtpk(oacc[te][ti][0] * il, oacc[te][ti][1] * il); wv.y = cvtpk(oacc[te][ti][2] * il, oacc[te][ti][3] * il); *(u32x2*)(orow + 16 * te) = wv; } }
    }
}


__device__ __forceinline__ void phase_gdn_local(Frame& F) {
    unsigned char* prep = F.ws + WS_R1 + R1_PREP;
    const bf16* GD = (const bf16*)(prep + PREP_GD); const float* GB = (const float*)(F.ws + WS_GB);
    LAS bf16* Qs = (LAS bf16*)F.lds; LAS bf16* Ks = Qs + 64 * 72; LAS bf16* Vs = Ks + 64 * 72;
    LAS float* At = (LAS float*)(F.lds + 27648);
    LAS bf16* ATs = (LAS bf16*)(F.lds + 60416);
    LAS bf16* XS_ = (LAS bf16*)(F.lds + 78848);
    LAS float* sm = (LAS float*)(F.lds + 115712);
    LAS float* gl = sm; LAS float* bl = sm + 128; LAS float* gcs = sm + 256; LAS float* eg = sm + 384; LAS float* ekd = sm + 512;
    const int lane = F.lane, c = lane & 15, q = lane >> 4, w = F.wave, tid = F.tid;
    for (int uu = F.bid; uu < 16 * 68; uu += F.G) {
        const int bh = uu / 68, ch = uu % 68, b = bh >> 2, hh = bh & 3;
        const int m0 = ch < 4 ? b * TC + 64 * ch : MC + b * TL + 64 * (ch - 4);
        __syncthreads();
        { const int row = tid >> 3, col8 = (tid & 7) * 8; const bf16* src = GD + (size_t)(m0 + row) * 768 + hh * 64 + col8;
          *(LAS u32x4*)(Qs + row * 72 + col8) = *(const u32x4*)(src); *(LAS u32x4*)(Ks + row * 72 + col8) = *(const u32x4*)(src + 256); *(LAS u32x4*)(Vs + row * 72 + col8) = *(const u32x4*)(src + 512);
          if (tid < 256) { const int tok = tid & 63, which = tid >> 6; sm[which * 64 + tok] = GB[(size_t)(m0 + tok) * 16 + (which >> 1) * 8 + (which & 1) * 4 + hh]; } }
        __syncthreads();
        if (w < 2) { const int d = w; const int tok = d ? 63 - lane : lane; float v = gl[d * 64 + tok];
#pragma unroll
            for (int o = 1; o < 64; o <<= 1) { const float t = __shfl_up(v, o); if (lane >= o) v += t; }
            const float last = __shfl(v, 63);
            gcs[d * 64 + lane] = v; eg[d * 64 + lane] = fexp(v); ekd[d * 64 + lane] = fexp(last - v); }
        __syncthreads();
        {
            const int type = w >> 2, ti = w & 3; const LAS bf16* X = type ? Qs : Ks;
            bf16x8 a[2];
#pragma unroll
            for (int ks = 0; ks < 2; ++ks) a[ks] = *(const LAS bf16x8*)(X + (16 * ti + c) * 72 + 32 * ks + 8 * q);
#pragma unroll
            for (int tj = 0; tj < 4; ++tj) { f32x4 acc = (f32x4){0.f, 0.f, 0.f, 0.f};
#pragma unroll
                for (int ks = 0; ks < 2; ++ks) acc = mfma16(a[ks], *(const LAS bf16x8*)(Ks + (16 * tj + c) * 72 + 32 * ks + 8 * q), acc);
#pragma unroll
                for (int r = 0; r < 4; ++r) { const int it = 16 * ti + 4 * q + r, jt = 16 * tj + c;
#pragma unroll
                    for (int d = 0; d < 2; ++d) { const int i = d ? 63 - it : it, j = d ? 63 - jt : jt;
                        const float e = fexp(fminf(gcs[d * 64 + i] - gcs[d * 64 + j], 0.f));
                        if (type == 0) At[d * 4096 + j * 64 + i] = (j < i) ? bl[d * 64 + it] * acc[r] * e : 0.f;
                        else ATs[d * 4608 + i * 72 + j] = (bf16)f2bf((j <= i) ? acc[r] * e : 0.f); } } }
        }
        __syncthreads();
        if (w < 4) {
            const int d = w >> 1, kind = w & 1; const LAS bf16* R = kind ? Ks : Vs; const LAS float* A = At + d * 4096;
            float x[64];
#pragma unroll
            for (int i = 0; i < 64; ++i) { const int tok = d ? 63 - i : i; float v = bl[d * 64 + tok] * bf2f(R[tok * 72 + lane]); if (kind) v *= eg[d * 64 + i]; x[i] = v; }
#pragma unroll
            for (int j = 0; j < 63; ++j) { const float xj = x[j];
                f32x4 ca[16];
#pragma unroll
                for (int g = ((j + 1) >> 2); g < 16; ++g) ca[g] = *(const LAS f32x4*)(A + j * 64 + 4 * g);
                __builtin_amdgcn_sched_barrier(0);
#pragma unroll
                for (int g = ((j + 1) >> 2); g < 16; ++g) { x[4 * g] -= ca[g].x * xj; x[4 * g + 1] -= ca[g].y * xj; x[4 * g + 2] -= ca[g].z * xj; x[4 * g + 3] -= ca[g].w * xj; }
                __builtin_amdgcn_sched_barrier(0); }
            LAS bf16* XO = XS_ + (d * 2 + kind) * 4608;
#pragma unroll
            for (int i = 0; i < 64; ++i) XO[i * 72 + lane] = (bf16)f2bf(x[i]);
        } else {
            const int t2 = tid - 256;
            for (int it = t2; it < 6 * 512; it += 256) { const int mat = it >> 9, chk = it & 511, d = mat & 1, kindm = mat >> 1;
                const int rt = chk >> 7, ks = (chk >> 6) & 1, ln = chk & 63, r = ln & 15, qq = ln >> 4, row = 16 * rt + r, c0 = 32 * ks + 4 * qq;
                float v[8];
                if (kindm == 0) { const u32x2 lo = *(const LAS u32x2*)(ATs + d * 4608 + row * 72 + c0), hi = *(const LAS u32x2*)(ATs + d * 4608 + row * 72 + c0 + 16);
                    v[0] = __uint_as_float(lo.x << 16); v[1] = __uint_as_float(lo.x & 0xffff0000u); v[2] = __uint_as_float(lo.y << 16); v[3] = __uint_as_float(lo.y & 0xffff0000u);
                    v[4] = __uint_as_float(hi.x << 16); v[5] = __uint_as_float(hi.x & 0xffff0000u); v[6] = __uint_as_float(hi.y << 16); v[7] = __uint_as_float(hi.y & 0xffff0000u); }
                else if (kindm == 1) { const int tok = d ? 63 - row : row; const float sc = eg[d * 64 + row];
#pragma unroll
                    for (int x8 = 0; x8 < 8; ++x8) v[x8] = bf2f(Qs[tok * 72 + c0 + (x8 & 3) + 16 * (x8 >> 2)]) * sc; }
                else {
#pragma unroll
                    for (int x8 = 0; x8 < 8; ++x8) { const int i = c0 + (x8 & 3) + 16 * (x8 >> 2); const int tok = d ? 63 - i : i; v[x8] = bf2f(Ks[tok * 72 + row]) * ekd[d * 64 + i]; } }
                const int chain = bh * 2 + d, sg = ch < 4 ? (d ? 3 - ch : ch) : 4 + (d ? 63 - (ch - 4) : ch - 4);
                unsigned char* dst = F.ws + WS_GCH + (size_t)chain * GCH_CHAIN + (size_t)sg * GCH_STEP + (kindm == 0 ? 16384 : (kindm == 1 ? 8192 : 24576));
                u32x4 o; o.x = pk2(v[0], v[1]); o.y = pk2(v[2], v[3]); o.z = pk2(v[4], v[5]); o.w = pk2(v[6], v[7]);
                *(u32x4*)(dst + chk * 16) = o; }
        }
        __syncthreads();
        {
            for (int it = tid; it < 2 * 512; it += NTHR) { const int d = it >> 9, chk = it & 511;
                const int rt = chk >> 7, ks = (chk >> 6) & 1, ln = chk & 63, r = ln & 15, qq = ln >> 4, row = 16 * rt + r, c0 = 32 * ks + 4 * qq;
                const LAS bf16* XW = XS_ + (d * 2 + 1) * 4608;
                const u32x2 lo = *(const LAS u32x2*)(XW + row * 72 + c0), hi = *(const LAS u32x2*)(XW + row * 72 + c0 + 16);
                const int chain = bh * 2 + d, sg = ch < 4 ? (d ? 3 - ch : ch) : 4 + (d ? 63 - (ch - 4) : ch - 4);
                unsigned char* dst = F.ws + WS_GCH + (size_t)chain * GCH_CHAIN + (size_t)sg * GCH_STEP;
                *(u32x4*)(dst + chk * 16) = (u32x4){lo.x, lo.y, hi.x, hi.y}; }
            for (int it = tid; it < 2 * 1024; it += NTHR) { const int d = it >> 10, cu = it & 1023;
                const int sl = cu >> 8, rt = (cu >> 6) & 3, ln = cu & 63, qq = ln >> 4, cc = ln & 15;
                const LAS bf16* XU = XS_ + (d * 2) * 4608;
                bf16 e0 = XU[(16 * rt + 4 * qq + 0) * 72 + 16 * sl + cc], e1 = XU[(16 * rt + 4 * qq + 1) * 72 + 16 * sl + cc], e2 = XU[(16 * rt + 4 * qq + 2) * 72 + 16 * sl + cc], e3 = XU[(16 * rt + 4 * qq + 3) * 72 + 16 * sl + cc];
                const int chain = bh * 2 + d, sg = ch < 4 ? (d ? 3 - ch : ch) : 4 + (d ? 63 - (ch - 4) : ch - 4);
                unsigned char* dst = F.ws + WS_GCH + (size_t)chain * GCH_CHAIN + (size_t)sg * GCH_STEP + 32768;
                *(u32x2*)(dst + cu * 8) = (u32x2){(unsigned)e0 | ((unsigned)e1 << 16), (unsigned)e2 | ((unsigned)e3 << 16)}; }
            if (tid < 2) { const int d = tid; const int chain = bh * 2 + d, sg = ch < 4 ? (d ? 3 - ch : ch) : 4 + (d ? 63 - (ch - 4) : ch - 4);
                ((float*)(F.ws + WS_GDEC))[chain * 68 + sg] = eg[d * 64 + 63]; }
        }
    }
}

__device__ __forceinline__ void phase_gdn_scan(Frame& F, int first_wg) {
    const int chain = F.bid - first_wg; if (chain < 0 || chain >= 32) return;
    const int b = chain >> 3, hh = (chain >> 1) & 3, d = chain & 1;
    const unsigned char* src = F.ws + WS_GCH + (size_t)chain * GCH_CHAIN;
    const float* decs = (const float*)(F.ws + WS_GDEC) + chain * 68;
    float* OUT = (float*)(F.ws + WS_R1 + R1_OG) + (size_t)d * M * 256;
    LAS unsigned char* ring = F.lds;
    const int lane = F.lane, w = F.wave;
    if (w >= 4) {
        const int dw = w - 4;
#define GS_ISSUE(step) do { _Pragma("unroll") for (int k = 0; k < 10; ++k) { const int p = dw * 10 + k; \
            __builtin_amdgcn_global_load_lds((const unsigned*)(src + (size_t)(step) * GCH_STEP + p * 1024 + lane * 16), (LAS unsigned*)(ring + ((step) % 3) * 40960 + p * 1024), 16, 0, 0); } } while (0)
        GS_ISSUE(0); GS_ISSUE(1);
        asm volatile("s_waitcnt vmcnt(10)" ::: "memory"); __builtin_amdgcn_s_barrier();
        for (int n = 0; n < 68; ++n) {
            if (n + 2 < 68) { GS_ISSUE(n + 2); asm volatile("s_waitcnt vmcnt(10)" ::: "memory"); }
            else asm volatile("s_waitcnt vmcnt(0)" ::: "memory");
            __builtin_amdgcn_s_barrier();
        }
#undef GS_ISSUE
    } else {
        const int sl = w, qq = lane >> 4, cc = lane & 15;
        f32x4 S[4];
#pragma unroll
        for (int rt = 0; rt < 4; ++rt) S[rt] = (f32x4){0.f, 0.f, 0.f, 0.f};
        const float dv0 = decs[lane], dv1 = decs[64 + (lane & 3)];
        asm volatile("s_waitcnt vmcnt(0)" ::: "memory"); __builtin_amdgcn_s_barrier(); asm volatile("" ::: "memory");
        for (int n = 0; n < 68; ++n) {
            const LAS unsigned char* base = ring + (n % 3) * 40960;
            const float dec = n < 64 ? __shfl(dv0, n) : __shfl(dv1, n - 64);
#define GS_FRAG(mat, rt, ks) (*(const LAS bf16x8*)(base + (mat) * 8192 + (((rt) * 2 + (ks)) * 64 + lane) * 16))
            bf16x8 BS[2], BV[2];
#pragma unroll
            for (int ks = 0; ks < 2; ++ks) { u32x4 t; t.x = cvtpk(S[2 * ks][0], S[2 * ks][1]); t.y = cvtpk(S[2 * ks][2], S[2 * ks][3]); t.z = cvtpk(S[2 * ks + 1][0], S[2 * ks + 1][1]); t.w = cvtpk(S[2 * ks + 1][2], S[2 * ks + 1][3]); BS[ks] = __builtin_bit_cast(bf16x8, t); }
            f32x4 vn[4], o[4];
#pragma unroll
            for (int rt = 0; rt < 4; ++rt) { f32x4 acc = (f32x4){0.f, 0.f, 0.f, 0.f};
#pragma unroll
                for (int ks = 0; ks < 2; ++ks) acc = mfma16(GS_FRAG(0, rt, ks), BS[ks], acc);
                const u32x2 uu = *(const LAS u32x2*)(base + 32768 + ((sl * 4 + rt) * 64 + lane) * 8);
                vn[rt] = (f32x4){__uint_as_float(uu.x << 16), __uint_as_float(uu.x & 0xffff0000u), __uint_as_float(uu.y << 16), __uint_as_float(uu.y & 0xffff0000u)} - acc;
                f32x4 oo = (f32x4){0.f, 0.f, 0.f, 0.f};
#pragma unroll
                for (int ks = 0; ks < 2; ++ks) oo = mfma16(GS_FRAG(1, rt, ks), BS[ks], oo);
                o[rt] = oo; }
#pragma unroll
            for (int ks = 0; ks < 2; ++ks) { u32x4 t; t.x = cvtpk(vn[2 * ks][0], vn[2 * ks][1]); t.y = cvtpk(vn[2 * ks][2], vn[2 * ks][3]); t.z = cvtpk(vn[2 * ks + 1][0], vn[2 * ks + 1][1]); t.w = cvtpk(vn[2 * ks + 1][2], vn[2 * ks + 1][3]); BV[ks] = __builtin_bit_cast(bf16x8, t); }
#pragma unroll
            for (int rt = 0; rt < 4; ++rt) { f32x4 oo = o[rt], sn = S[rt] * dec;
#pragma unroll
                for (int ks = 0; ks < 2; ++ks) { oo = mfma16(GS_FRAG(2, rt, ks), BV[ks], oo); sn = mfma16(GS_FRAG(3, rt, ks), BV[ks], sn); }
                o[rt] = oo; S[rt] = sn; }
#undef GS_FRAG
            const int m0 = n < 4 ? b * TC + 64 * (d ? 3 - n : n) : MC + b * TL + 64 * (d ? 63 - (n - 4) : n - 4);
#pragma unroll
            for (int rt = 0; rt < 4; ++rt)
#pragma unroll
                for (int r = 0; r < 4; ++r) { const int i = 16 * rt + 4 * qq + r, tok = d ? 63 - i : i; OUT[(size_t)(m0 + tok) * 256 + hh * 64 + 16 * sl + cc] = o[rt][r]; }
            asm volatile("s_waitcnt lgkmcnt(0)" ::: "memory"); PB(11); __builtin_amdgcn_s_barrier(); PE(11); asm volatile("" ::: "memory");
        }
    }
}


__device__ __forceinline__ void phase_gdn_local2(Frame& F) {
    unsigned char* prep = F.ws + WS_R1 + R1_PREP;
    const bf16* GD = (const bf16*)(prep + PREP_GD); const float* GB = (const float*)(F.ws + WS_GB);
    LAS bf16* Ks = (LAS bf16*)F.lds; LAS bf16* Vs = Ks + 64 * 72;
    LAS float* At = (LAS float*)(F.lds + 18432);
    LAS bf16* XS_ = (LAS bf16*)(F.lds + 51200);
    LAS float* sm = (LAS float*)(F.lds + 88064);
    LAS float* gl = sm; LAS float* bl = sm + 128; LAS float* gcs = sm + 256; LAS float* eg = sm + 384; LAS float* ekd = sm + 512;
    const int lane = F.lane, c = lane & 15, q = lane >> 4, w = F.wave, tid = F.tid;
    for (int uu = F.bid; uu < 16 * 68; uu += F.G) {
        const int bh = uu / 68, ch = uu % 68, b = bh >> 2, hh = bh & 3;
        const int m0 = ch < 4 ? b * TC + 64 * ch : MC + b * TL + 64 * (ch - 4);
        __syncthreads();
        { const int row = tid >> 3, col8 = (tid & 7) * 8; const bf16* src = GD + (size_t)(m0 + row) * 768 + hh * 64 + col8;
          *(LAS u32x4*)(Ks + row * 72 + col8) = *(const u32x4*)(src + 256); *(LAS u32x4*)(Vs + row * 72 + col8) = *(const u32x4*)(src + 512);
          if (tid < 256) { const int tok = tid & 63, which = tid >> 6; sm[which * 64 + tok] = GB[(size_t)(m0 + tok) * 16 + (which >> 1) * 8 + (which & 1) * 4 + hh]; } }
        __syncthreads();
        if (w < 2) { const int d = w; const int tok = d ? 63 - lane : lane; float v = gl[d * 64 + tok];
#pragma unroll
            for (int o = 1; o < 64; o <<= 1) { const float t = __shfl_up(v, o); if (lane >= o) v += t; }
            const float last = __shfl(v, 63);
            gcs[d * 64 + lane] = v; eg[d * 64 + lane] = fexp(v); ekd[d * 64 + lane] = fexp(last - v);
            ((float*)(F.ws + WS_GCS))[((size_t)uu * 2 + d) * 64 + tok] = v; }
        __syncthreads();
        {
            const int ti = w & 3, th = w >> 2;
            bf16x8 a[2];
#pragma unroll
            for (int ks = 0; ks < 2; ++ks) a[ks] = *(const LAS bf16x8*)(Ks + (16 * ti + c) * 72 + 32 * ks + 8 * q);
#pragma unroll
            for (int t2 = 0; t2 < 2; ++t2) { const int tj = 2 * th + t2; f32x4 acc = (f32x4){0.f, 0.f, 0.f, 0.f};
#pragma unroll
                for (int ks = 0; ks < 2; ++ks) acc = mfma16(a[ks], *(const LAS bf16x8*)(Ks + (16 * tj + c) * 72 + 32 * ks + 8 * q), acc);
#pragma unroll
                for (int r = 0; r < 4; ++r) { const int it = 16 * ti + 4 * q + r, jt = 16 * tj + c;
#pragma unroll
                    for (int d = 0; d < 2; ++d) { const int i = d ? 63 - it : it, j = d ? 63 - jt : jt;
                        const float e = fexp(fminf(gcs[d * 64 + i] - gcs[d * 64 + j], 0.f));
                        At[d * 4096 + j * 64 + i] = (j < i) ? bl[d * 64 + it] * acc[r] * e : 0.f; } } }
        }
        __syncthreads();
        if (w < 4) {
            const int d = w >> 1, kind = w & 1; const LAS bf16* R = kind ? Ks : Vs; const LAS float* A = At + d * 4096;
            float x[64];
#pragma unroll
            for (int i = 0; i < 64; ++i) { const int tok = d ? 63 - i : i; float v = bl[d * 64 + tok] * bf2f(R[tok * 72 + lane]); if (kind) v *= eg[d * 64 + i]; x[i] = v; }
#pragma unroll
            for (int j = 0; j < 63; ++j) { const float xj = x[j];
                f32x4 ca[16];
#pragma unroll
                for (int g = ((j + 1) >> 2); g < 16; ++g) ca[g] = *(const LAS f32x4*)(A + j * 64 + 4 * g);
                __builtin_amdgcn_sched_barrier(0);
#pragma unroll
                for (int g = ((j + 1) >> 2); g < 16; ++g) { x[4 * g] -= ca[g].x * xj; x[4 * g + 1] -= ca[g].y * xj; x[4 * g + 2] -= ca[g].z * xj; x[4 * g + 3] -= ca[g].w * xj; }
                __builtin_amdgcn_sched_barrier(0); }
            LAS bf16* XO = XS_ + (d * 2 + kind) * 4608;
#pragma unroll
            for (int i = 0; i < 64; ++i) XO[i * 72 + lane] = (bf16)f2bf(x[i]);
        } else {
            const int t2 = tid - 256;
            for (int it = t2; it < 2 * 512; it += 256) { const int d = it >> 9, chk = it & 511;
                const int rt = chk >> 7, ks = (chk >> 6) & 1, ln = chk & 63, r = ln & 15, qq = ln >> 4, row = 16 * rt + r, c0 = 32 * ks + 4 * qq;
                float v[8];
#pragma unroll
                for (int x8 = 0; x8 < 8; ++x8) { const int tok = c0 + (x8 & 3) + 16 * (x8 >> 2); const int i = d ? 63 - tok : tok; v[x8] = bf2f(Ks[tok * 72 + row]) * ekd[d * 64 + i]; }
                const int chain = bh * 2 + d, sg = ch < 4 ? (d ? 3 - ch : ch) : 4 + (d ? 63 - (ch - 4) : ch - 4);
                unsigned char* dst = F.ws + WS_GCH + (size_t)chain * G2_CHAIN + (size_t)sg * G2_STEP + 8192;
                u32x4 o; o.x = cvtpk(v[0], v[1]); o.y = cvtpk(v[2], v[3]); o.z = cvtpk(v[4], v[5]); o.w = cvtpk(v[6], v[7]);
                *(u32x4*)(dst + chk * 16) = o; }
        }
        __syncthreads();
        {
            for (int it = tid; it < 2 * 512; it += NTHR) { const int d = it >> 9, chk = it & 511;
                const int rt = chk >> 7, ks = (chk >> 6) & 1, ln = chk & 63, r = ln & 15, qq = ln >> 4, row = 16 * rt + r, c0 = 32 * ks + 4 * qq;
                const LAS bf16* XW = XS_ + (d * 2 + 1) * 4608;
                const int prow = d ? 63 - row : row;
                const u32x2 lo = *(const LAS u32x2*)(XW + prow * 72 + c0), hi = *(const LAS u32x2*)(XW + prow * 72 + c0 + 16);
                const int chain = bh * 2 + d, sg = ch < 4 ? (d ? 3 - ch : ch) : 4 + (d ? 63 - (ch - 4) : ch - 4);
                unsigned char* dst = F.ws + WS_GCH + (size_t)chain * G2_CHAIN + (size_t)sg * G2_STEP;
                *(u32x4*)(dst + chk * 16) = (u32x4){lo.x, lo.y, hi.x, hi.y}; }
            for (int it = tid; it < 2 * 1024; it += NTHR) { const int d = it >> 10, cu = it & 1023;
                const int sl = cu >> 8, rt = (cu >> 6) & 3, ln = cu & 63, qq = ln >> 4, cc = ln & 15;
                const LAS bf16* XU = XS_ + (d * 2) * 4608;
                const int tr = 16 * rt + 4 * qq, p0 = d ? 63 - tr : tr, ps = d ? -1 : 1;
                bf16 e0 = XU[(p0) * 72 + 16 * sl + cc], e1 = XU[(p0 + ps) * 72 + 16 * sl + cc], e2 = XU[(p0 + 2 * ps) * 72 + 16 * sl + cc], e3 = XU[(p0 + 3 * ps) * 72 + 16 * sl + cc];
                const int chain = bh * 2 + d, sg = ch < 4 ? (d ? 3 - ch : ch) : 4 + (d ? 63 - (ch - 4) : ch - 4);
                unsigned char* dst = F.ws + WS_GCH + (size_t)chain * G2_CHAIN + (size_t)sg * G2_STEP + 16384;
                *(u32x2*)(dst + cu * 8) = (u32x2){(unsigned)e0 | ((unsigned)e1 << 16), (unsigned)e2 | ((unsigned)e3 << 16)}; }
            if (tid < 2) { const int d = tid; const int chain = bh * 2 + d, sg = ch < 4 ? (d ? 3 - ch : ch) : 4 + (d ? 63 - (ch - 4) : ch - 4);
                ((float*)(F.ws + WS_GDEC))[chain * 68 + sg] = eg[d * 64 + 63]; }
        }
    }
}

__device__ __forceinline__ void phase_gdn_scan2(Frame& F, int first_wg) {
    const int chain = F.bid - first_wg; if (chain < 0 || chain >= 32) return;
    const int d = chain & 1;
    const unsigned char* src = F.ws + WS_GCH + (size_t)chain * G2_CHAIN;
    const float* decs = (const float*)(F.ws + WS_GDEC) + chain * 68;
    bf16* GST = (bf16*)(F.ws + WS_GST) + (size_t)chain * 68 * 8192;
    LAS unsigned char* ring = F.lds;
    const int lane = F.lane, w = F.wave;
    if (w >= 2) {
        const int dw = w - 2;
#define GS2_ISSUE(step) do { _Pragma("unroll") for (int k = 0; k < 4; ++k) { const int p = dw * 4 + k; \
            __builtin_amdgcn_global_load_lds((const unsigned*)(src + (size_t)(step) * G2_STEP + p * 1024 + lane * 16), (LAS unsigned*)(ring + ((step) & 3) * 24576 + p * 1024), 16, 0, 0); } } while (0)
        GS2_ISSUE(0); GS2_ISSUE(1); GS2_ISSUE(2);
        asm volatile("s_waitcnt vmcnt(8)" ::: "memory"); __builtin_amdgcn_s_barrier();
        for (int n = 0; n < 68; ++n) {
            if (n + 3 < 68) { GS2_ISSUE(n + 3); asm volatile("s_waitcnt vmcnt(8)" ::: "memory"); }
            else if (n + 2 < 68) asm volatile("s_waitcnt vmcnt(4)" ::: "memory");
            else asm volatile("s_waitcnt vmcnt(0)" ::: "memory");
            __builtin_amdgcn_s_barrier();
        }
#undef GS2_ISSUE
    } else {
        const int qq = lane >> 4, cc = lane & 15;
        f32x4 S[2][4];
#pragma unroll
        for (int ct = 0; ct < 2; ++ct)
#pragma unroll
            for (int rt = 0; rt < 4; ++rt) S[ct][rt] = (f32x4){0.f, 0.f, 0.f, 0.f};
        const float dv0 = decs[lane], dv1 = decs[64 + (lane & 3)];
        asm volatile("s_waitcnt vmcnt(0)" ::: "memory"); __builtin_amdgcn_s_barrier(); asm volatile("" ::: "memory");
        for (int n = 0; n < 68; ++n) {
            const LAS unsigned char* base = ring + (n & 3) * 24576;
            const float dec = n < 64 ? __shfl(dv0, n) : __shfl(dv1, n - 64);
            bf16* st = GST + (size_t)n * 8192;
            bf16* vt = st + 4096;
#define GS2_FRAG(mat, rt, ks) (*(const LAS bf16x8*)(base + (mat) * 8192 + (((rt) * 2 + (ks)) * 64 + lane) * 16))
            bf16x8 wf[4][2], kf[4][2]; u32x2 uf[2][4];
#pragma unroll
            for (int rt = 0; rt < 4; ++rt) { wf[rt][0] = GS2_FRAG(0, rt, 0); wf[rt][1] = GS2_FRAG(0, rt, 1); }
#pragma unroll
            for (int ct = 0; ct < 2; ++ct)
#pragma unroll
                for (int rt = 0; rt < 4; ++rt) uf[ct][rt] = *(const LAS u32x2*)(base + 16384 + (((2 * w + ct) * 4 + rt) * 64 + lane) * 8);
#pragma unroll
            for (int rt = 0; rt < 4; ++rt) { kf[rt][0] = GS2_FRAG(1, rt, 0); kf[rt][1] = GS2_FRAG(1, rt, 1); }
            __builtin_amdgcn_sched_barrier(0);
            bf16x8 BS[2][2], BV[2][2];
#pragma unroll
            for (int ct = 0; ct < 2; ++ct) { const int e = 32 * w + 16 * ct + cc;
#pragma unroll
                for (int ks = 0; ks < 2; ++ks) { u32x4 t; t.x = cvtpk(S[ct][2 * ks][0], S[ct][2 * ks][1]); t.y = cvtpk(S[ct][2 * ks][2], S[ct][2 * ks][3]); t.z = cvtpk(S[ct][2 * ks + 1][0], S[ct][2 * ks + 1][1]); t.w = cvtpk(S[ct][2 * ks + 1][2], S[ct][2 * ks + 1][3]);
                    BS[ct][ks] = __builtin_bit_cast(bf16x8, t);
                    *(u32x2*)(st + e * 64 + 32 * ks + 4 * qq) = (u32x2){t.x, t.y}; *(u32x2*)(st + e * 64 + 32 * ks + 16 + 4 * qq) = (u32x2){t.z, t.w}; } }
            f32x4 vn[2][4];
#pragma unroll
            for (int ks = 0; ks < 2; ++ks)
#pragma unroll
                for (int rt = 0; rt < 4; ++rt)
#pragma unroll
                    for (int ct = 0; ct < 2; ++ct) vn[ct][rt] = mfma16(wf[rt][ks], BS[ct][ks], ks ? vn[ct][rt] : (f32x4){0.f, 0.f, 0.f, 0.f});
#pragma unroll
            for (int ct = 0; ct < 2; ++ct)
#pragma unroll
                for (int rt = 0; rt < 4; ++rt) { const u32x2 uu = uf[ct][rt];
                    vn[ct][rt] = (f32x4){__uint_as_float(uu.x << 16), __uint_as_float(uu.x & 0xffff0000u), __uint_as_float(uu.y << 16), __uint_as_float(uu.y & 0xffff0000u)} - vn[ct][rt]; }
#pragma unroll
            for (int ct = 0; ct < 2; ++ct) { const int e = 32 * w + 16 * ct + cc;
#pragma unroll
                for (int ks = 0; ks < 2; ++ks) { u32x4 t; t.x = cvtpk(vn[ct][2 * ks][0], vn[ct][2 * ks][1]); t.y = cvtpk(vn[ct][2 * ks][2], vn[ct][2 * ks][3]); t.z = cvtpk(vn[ct][2 * ks + 1][0], vn[ct][2 * ks + 1][1]); t.w = cvtpk(vn[ct][2 * ks + 1][2], vn[ct][2 * ks + 1][3]);
                    BV[ct][ks] = __builtin_bit_cast(bf16x8, t);
                    if (d == 0) { *(u32x2*)(vt + e * 64 + 32 * ks + 4 * qq) = (u32x2){t.x, t.y}; *(u32x2*)(vt + e * 64 + 32 * ks + 16 + 4 * qq) = (u32x2){t.z, t.w}; }
                    else { const u32x2 r0 = (u32x2){(t.y >> 16) | (t.y << 16), (t.x >> 16) | (t.x << 16)}, r1 = (u32x2){(t.w >> 16) | (t.w << 16), (t.z >> 16) | (t.z << 16)};
                        *(u32x2*)(vt + e * 64 + 60 - 32 * ks - 4 * qq) = r0; *(u32x2*)(vt + e * 64 + 44 - 32 * ks - 4 * qq) = r1; } } }
#pragma unroll
            for (int ct = 0; ct < 2; ++ct)
#pragma unroll
                for (int rt = 0; rt < 4; ++rt) S[ct][rt] = S[ct][rt] * dec;
#pragma unroll
            for (int ks = 0; ks < 2; ++ks)
#pragma unroll
                for (int rt = 0; rt < 4; ++rt)
#pragma unroll
                    for (int ct = 0; ct < 2; ++ct) S[ct][rt] = mfma16(kf[rt][ks], BV[ct][ks], S[ct][rt]);
#undef GS2_FRAG
            asm volatile("s_waitcnt lgkmcnt(0)" ::: "memory"); __builtin_amdgcn_s_barrier(); asm volatile("" ::: "memory");
        }
    }
}

__device__ __forceinline__ void phase_gdn_out(Frame& F, const Inputs& in, int layer) {
    const bf16* P = (const bf16*)(F.ws + WS_R1 + R1_P);
    const bf16* GD = (const bf16*)(F.ws + WS_R1 + R1_PREP + PREP_GD);
    const bf16* GST = (const bf16*)(F.ws + WS_GST); const float* GCS = (const float*)(F.ws + WS_GCS);
    bf16* O = (bf16*)(F.ws + WS_R1 + R1_O);
    const int lane = F.lane, c = lane & 15, q = lane >> 4, w = F.wave, half = w >> 2, ti = w & 3, t2 = F.tid & 255;
    LAS bf16* Qs = (LAS bf16*)(F.lds + half * 56320); LAS bf16* Ks = Qs + 4608; LAS bf16* St = Ks + 4608; LAS bf16* Vn = St + 2 * 4608;
    LAS float* gT = (LAS float*)(F.lds + half * 56320 + 55296);
    for (int pp = F.bid; pp < 8 * 68; pp += F.G) {
        const int uu = 2 * pp + half, bh = uu / 68, ch = uu % 68, b = bh >> 2, hh = bh & 3;
        const int m0 = ch < 4 ? b * TC + 64 * ch : MC + b * TL + 64 * (ch - 4);
        __syncthreads();
#pragma unroll
        for (int rep = 0; rep < 2; ++rep) { const int idx = t2 + 256 * rep, row = idx >> 3, col8 = (idx & 7) * 8;
            const bf16* src = GD + (size_t)(m0 + row) * 768 + hh * 64 + col8;
            *(LAS u32x4*)(Qs + row * 72 + col8) = *(const u32x4*)(src); *(LAS u32x4*)(Ks + row * 72 + col8) = *(const u32x4*)(src + 256);
#pragma unroll
            for (int d = 0; d < 2; ++d) { const int sg = ch < 4 ? (d ? 3 - ch : ch) : 4 + (d ? 63 - (ch - 4) : ch - 4);
                const bf16* g = GST + ((size_t)(bh * 2 + d) * 68 + sg) * 8192 + row * 64 + col8;
                *(LAS u32x4*)(St + d * 4608 + row * 72 + col8) = *(const u32x4*)(g); *(LAS u32x4*)(Vn + d * 4608 + row * 72 + col8) = *(const u32x4*)(g + 4096); } }
        if (t2 < 128) gT[t2] = GCS[(size_t)uu * 128 + t2];
        __syncthreads();
        bf16x8 qf[2];
#pragma unroll
        for (int ks = 0; ks < 2; ++ks) qf[ks] = *(const LAS bf16x8*)(Qs + (16 * ti + c) * 72 + 32 * ks + 8 * q);
        const int i = 16 * ti + c;
        const float gi0 = gT[i], gi1 = gT[64 + i];
        f32x4 sacc[4];
#pragma unroll
        for (int tj = 0; tj < 4; ++tj) { f32x4 acc = (f32x4){0.f, 0.f, 0.f, 0.f};
#pragma unroll
            for (int ks = 0; ks < 2; ++ks) acc = mfma16(*(const LAS bf16x8*)(Ks + (16 * tj + c) * 72 + 32 * ks + 8 * q), qf[ks], acc);
            sacc[tj] = acc; }
        bf16x8 pb[2][2];
#pragma unroll
        for (int d = 0; d < 2; ++d) { f32x4 p[4];
#pragma unroll
            for (int tj = 0; tj < 4; ++tj) { const f32x4 gj = *(const LAS f32x4*)(gT + d * 64 + 16 * tj + 4 * q);
#pragma unroll
                for (int r = 0; r < 4; ++r) { const int j = 16 * tj + 4 * q + r; const bool ok = d ? (j >= i) : (j <= i);
                    p[tj][r] = ok ? sacc[tj][r] * fexp(fminf((d ? gi1 : gi0) - gj[r], 0.f)) : 0.f; } }
#pragma unroll
            for (int ks2 = 0; ks2 < 2; ++ks2) { u32x4 t; t.x = cvtpk(p[2 * ks2][0], p[2 * ks2][1]); t.y = cvtpk(p[2 * ks2][2], p[2 * ks2][3]); t.z = cvtpk(p[2 * ks2 + 1][0], p[2 * ks2 + 1][1]); t.w = cvtpk(p[2 * ks2 + 1][2], p[2 * ks2 + 1][3]); pb[d][ks2] = __builtin_bit_cast(bf16x8, t); } }
        const float sc0 = fexp(gi0), sc1 = fexp(gi1);
        f32x4 o[4]; float ssq = 0.f;
#pragma unroll
        for (int te = 0; te < 4; ++te) { f32x4 acc = (f32x4){0.f, 0.f, 0.f, 0.f}, t0 = acc, t1 = acc;
#pragma unroll
            for (int d = 0; d < 2; ++d)
#pragma unroll
                for (int ks2 = 0; ks2 < 2; ++ks2) { const u32x2 lo = *(const LAS u32x2*)(Vn + d * 4608 + (16 * te + c) * 72 + 32 * ks2 + 4 * q), hi = *(const LAS u32x2*)(Vn + d * 4608 + (16 * te + c) * 72 + 32 * ks2 + 16 + 4 * q);
                    acc = mfma16(__builtin_bit_cast(bf16x8, ((u32x4){lo.x, lo.y, hi.x, hi.y})), pb[d][ks2], acc); }
#pragma unroll
            for (int ks = 0; ks < 2; ++ks) { t0 = mfma16(*(const LAS bf16x8*)(St + (16 * te + c) * 72 + 32 * ks + 8 * q), qf[ks], t0);
                t1 = mfma16(*(const LAS bf16x8*)(St + 4608 + (16 * te + c) * 72 + 32 * ks + 8 * q), qf[ks], t1); }
            o[te] = acc + sc0 * t0 + sc1 * t1; ssq += (o[te][0] * o[te][0] + o[te][1] * o[te][1]) + (o[te][2] * o[te][2] + o[te][3] * o[te][3]); }
        ssq = quad_rows_sum(ssq);
        const float rs = 1.0f / sqrtf(ssq * (1.0f / 64.0f) + EPS);
#pragma unroll
        for (int te = 0; te < 4; ++te) { const int e0 = 16 * te + 4 * q;
            const u32x2 z2 = *(const u32x2*)(P + (size_t)(m0 + i) * NP + PC_GZ + hh * 64 + e0); const f32x4 gn = *(const f32x4*)(in.gdn_norm_g + layer * 64 + e0);
            const float z0 = __uint_as_float(z2.x << 16), z1 = __uint_as_float(z2.x & 0xffff0000u), z2f = __uint_as_float(z2.y << 16), z3 = __uint_as_float(z2.y & 0xffff0000u);
            u32x2 wv; wv.x = cvtpk(o[te][0] * rs * gn[0] * siluf(z0), o[te][1] * rs * gn[1] * siluf(z1)); wv.y = cvtpk(o[te][2] * rs * gn[2] * siluf(z2f), o[te][3] * rs * gn[3] * siluf(z3));
            *(u32x2*)(O + (size_t)(m0 + i) * D + 256 + hh * 64 + e0) = wv; }
    }
}


__device__ __forceinline__ void phase_gdn_scan3(Frame& F, int first_wg) {
    const int chain = F.bid - first_wg; if (chain < 0 || chain >= 32) return;
    const unsigned char* src = F.ws + WS_GCH + (size_t)chain * G2_CHAIN;
    const float* decs = (const float*)(F.ws + WS_GDEC) + chain * 68;
    unsigned char* GSTb = F.ws + WS_GST + (size_t)chain * 68 * 16384;
    LAS unsigned char* ring = F.lds;
    const int lane = F.lane, w = F.wave;
    if (w >= 4) {
        const int dw = w - 4;
#define GS3_ISSUE(step) do { _Pragma("unroll") for (int k = 0; k < 6; ++k) { const int p = dw * 6 + k; \
            __builtin_amdgcn_global_load_lds((const unsigned*)(src + (size_t)(step) * G2_STEP + p * 1024 + lane * 16), (LAS unsigned*)(ring + ((step) & 3) * 24576 + p * 1024), 16, 0, 0); } } while (0)
        GS3_ISSUE(0); GS3_ISSUE(1); GS3_ISSUE(2);
        asm volatile("s_waitcnt vmcnt(12)" ::: "memory"); __builtin_amdgcn_s_barrier();
        for (int n = 0; n < 68; ++n) {
            if (n + 3 < 68) { GS3_ISSUE(n + 3); asm volatile("s_waitcnt vmcnt(12)" ::: "memory"); }
            else if (n + 2 < 68) asm volatile("s_waitcnt vmcnt(6)" ::: "memory");
            else asm volatile("s_waitcnt vmcnt(0)" ::: "memory");
            __builtin_amdgcn_s_barrier();
        }
#undef GS3_ISSUE
    } else {
        const int sl = w;
        f32x4 S[4];
#pragma unroll
        for (int rt = 0; rt < 4; ++rt) S[rt] = (f32x4){0.f, 0.f, 0.f, 0.f};
        const float dv0 = decs[lane], dv1 = decs[64 + (lane & 3)];
        asm volatile("s_waitcnt vmcnt(0)" ::: "memory"); __builtin_amdgcn_s_barrier(); asm volatile("" ::: "memory");
        for (int n = 0; n < 68; ++n) {
            const LAS unsigned char* base = ring + (n & 3) * 24576;
            const float dec = n < 64 ? __shfl(dv0, n) : __shfl(dv1, n - 64);
            unsigned char* go = GSTb + (size_t)n * 16384 + (size_t)(sl * 2 * 64 + lane) * 16;
#define GS3_FRAG(mat, rt, ks) (*(const LAS bf16x8*)(base + (mat) * 8192 + (((rt) * 2 + (ks)) * 64 + lane) * 16))
            bf16x8 wf[4][2], kf[4][2]; u32x2 uf[4];
#pragma unroll
            for (int rt = 0; rt < 4; ++rt) { wf[rt][0] = GS3_FRAG(0, rt, 0); wf[rt][1] = GS3_FRAG(0, rt, 1); }
#pragma unroll
            for (int rt = 0; rt < 4; ++rt) uf[rt] = *(const LAS u32x2*)(base + 16384 + ((sl * 4 + rt) * 64 + lane) * 8);
#pragma unroll
            for (int rt = 0; rt < 4; ++rt) { kf[rt][0] = GS3_FRAG(1, rt, 0); kf[rt][1] = GS3_FRAG(1, rt, 1); }
#undef GS3_FRAG
            __builtin_amdgcn_sched_barrier(0);
            bf16x8 BS[2], BV[2];
#pragma unroll
            for (int ks = 0; ks < 2; ++ks) { u32x4 t; t.x = cvtpk(S[2 * ks][0], S[2 * ks][1]); t.y = cvtpk(S[2 * ks][2], S[2 * ks][3]); t.z = cvtpk(S[2 * ks + 1][0], S[2 * ks + 1][1]); t.w = cvtpk(S[2 * ks + 1][2], S[2 * ks + 1][3]);
                BS[ks] = __builtin_bit_cast(bf16x8, t); *(u32x4*)(go + ks * 1024) = t; }
            f32x4 vn[4];
#pragma unroll
            for (int ks = 0; ks < 2; ++ks)
#pragma unroll
                for (int rt = 0; rt < 4; ++rt) vn[rt] = mfma16(wf[rt][ks], BS[ks], ks ? vn[rt] : (f32x4){0.f, 0.f, 0.f, 0.f});
#pragma unroll
            for (int rt = 0; rt < 4; ++rt) { const u32x2 uu = uf[rt];
                vn[rt] = (f32x4){__uint_as_float(uu.x << 16), __uint_as_float(uu.x & 0xffff0000u), __uint_as_float(uu.y << 16), __uint_as_float(uu.y & 0xffff0000u)} - vn[rt]; }
#pragma unroll
            for (int ks = 0; ks < 2; ++ks) { u32x4 t; t.x = cvtpk(vn[2 * ks][0], vn[2 * ks][1]); t.y = cvtpk(vn[2 * ks][2], vn[2 * ks][3]); t.z = cvtpk(vn[2 * ks + 1][0], vn[2 * ks + 1][1]); t.w = cvtpk(vn[2 * ks + 1][2], vn[2 * ks + 1][3]);
                BV[ks] = __builtin_bit_cast(bf16x8, t); *(u32x4*)(go + 8192 + ks * 1024) = t; }
#pragma unroll
            for (int rt = 0; rt < 4; ++rt) S[rt] = S[rt] * dec;
#pragma unroll
            for (int ks = 0; ks < 2; ++ks)
#pragma unroll
                for (int rt = 0; rt < 4; ++rt) S[rt] = mfma16(kf[rt][ks], BV[ks], S[rt]);
            asm volatile("s_waitcnt lgkmcnt(0)" ::: "memory"); __builtin_amdgcn_s_barrier(); asm volatile("" ::: "memory");
        }
    }
}

__device__ __forceinline__ void phase_gdn_out2(Frame& F, const Inputs& in, int layer) {
    const bf16* P = (const bf16*)(F.ws + WS_R1 + R1_P);
    const bf16* GD = (const bf16*)(F.ws + WS_R1 + R1_PREP + PREP_GD);
    const unsigned char* GSTb = F.ws + WS_GST; const float* GCS = (const float*)(F.ws + WS_GCS);
    bf16* O = (bf16*)(F.ws + WS_R1 + R1_O);
    const int lane = F.lane, c = lane & 15, q = lane >> 4, w = F.wave, half = w >> 2, ti = w & 3, t2 = F.tid & 255;
    LAS bf16* Qs = (LAS bf16*)(F.lds + half * 56320); LAS bf16* Ks = Qs + 4608;
    LAS unsigned char* Fr = F.lds + half * 56320 + 18432;
    LAS float* gT = (LAS float*)(F.lds + half * 56320 + 55296);
    for (int pp = F.bid; pp < 8 * 68; pp += F.G) {
        const int uu = 2 * pp + half, bh = uu / 68, ch = uu % 68, b = bh >> 2, hh = bh & 3;
        const int m0 = ch < 4 ? b * TC + 64 * ch : MC + b * TL + 64 * (ch - 4);
        __syncthreads();
#pragma unroll
        for (int rep = 0; rep < 2; ++rep) { const int idx = t2 + 256 * rep, row = idx >> 3, col8 = (idx & 7) * 8;
            const bf16* src = GD + (size_t)(m0 + row) * 768 + hh * 64 + col8;
            *(LAS u32x4*)(Qs + row * 72 + col8) = *(const u32x4*)(src); *(LAS u32x4*)(Ks + row * 72 + col8) = *(const u32x4*)(src + 256); }
#pragma unroll
        for (int d = 0; d < 2; ++d) { const int sg = ch < 4 ? (d ? 3 - ch : ch) : 4 + (d ? 63 - (ch - 4) : ch - 4);
            const unsigned char* g = GSTb + ((size_t)(bh * 2 + d) * 68 + sg) * 16384;
#pragma unroll
            for (int rep = 0; rep < 4; ++rep) { const int idx = t2 + 256 * rep; *(LAS u32x4*)(Fr + d * 16384 + idx * 16) = *(const u32x4*)(g + (size_t)idx * 16); } }
        if (t2 < 128) gT[t2] = GCS[(size_t)uu * 128 + t2];
        __syncthreads();
        bf16x8 qf[2], qr[2];
#pragma unroll
        for (int ks = 0; ks < 2; ++ks) { qf[ks] = *(const LAS bf16x8*)(Qs + (16 * ti + c) * 72 + 32 * ks + 8 * q);
            const u32x2 lo = *(const LAS u32x2*)(Qs + (16 * ti + c) * 72 + 32 * ks + 4 * q), hi = *(const LAS u32x2*)(Qs + (16 * ti + c) * 72 + 32 * ks + 16 + 4 * q);
            qr[ks] = __builtin_bit_cast(bf16x8, ((u32x4){lo.x, lo.y, hi.x, hi.y})); }
        const int i = 16 * ti + c;
        const float gi0 = gT[i], gi1 = gT[64 + i];
        f32x4 sacc[4];
#pragma unroll
        for (int tj = 0; tj < 4; ++tj) { f32x4 acc = (f32x4){0.f, 0.f, 0.f, 0.f};
#pragma unroll
            for (int ks = 0; ks < 2; ++ks) acc = mfma16(*(const LAS bf16x8*)(Ks + (16 * tj + c) * 72 + 32 * ks + 8 * q), qf[ks], acc);
            sacc[tj] = acc; }
        bf16x8 pb[2][2];
#pragma unroll
        for (int d = 0; d < 2; ++d) { f32x4 p[4];
#pragma unroll
            for (int tj = 0; tj < 4; ++tj) { const f32x4 gj = *(const LAS f32x4*)(gT + d * 64 + 16 * tj + 4 * q);
#pragma unroll
                for (int r = 0; r < 4; ++r) { const int j = 16 * tj + 4 * q + r; const bool ok = d ? (j >= i) : (j <= i);
                    p[tj][r] = ok ? sacc[tj][r] * fexp(fminf((d ? gi1 : gi0) - gj[r], 0.f)) : 0.f; } }
#pragma unroll
            for (int ks2 = 0; ks2 < 2; ++ks2) { u32x4 t; t.x = cvtpk(p[2 * ks2][0], p[2 * ks2][1]); t.y = cvtpk(p[2 * ks2][2], p[2 * ks2][3]); t.z = cvtpk(p[2 * ks2 + 1][0], p[2 * ks2 + 1][1]); t.w = cvtpk(p[2 * ks2 + 1][2], p[2 * ks2 + 1][3]); pb[d][ks2] = __builtin_bit_cast(bf16x8, t); } }
        const float sc0 = fexp(gi0), sc1 = fexp(gi1);
        f32x4 o[4]; float ssq = 0.f;
#pragma unroll
        for (int te = 0; te < 4; ++te) { f32x4 acc = (f32x4){0.f, 0.f, 0.f, 0.f}, t0 = acc, t1 = acc;
#pragma unroll
            for (int ks = 0; ks < 2; ++ks) {
                acc = mfma16(*(const LAS bf16x8*)(Fr + 8192 + ((te * 2 + ks) * 64 + lane) * 16), pb[0][ks], acc);
                acc = mfma16(*(const LAS bf16x8*)(Fr + 16384 + 8192 + ((te * 2 + ks) * 64 + lane) * 16), pb[1][ks], acc);
                t0 = mfma16(*(const LAS bf16x8*)(Fr + ((te * 2 + ks) * 64 + lane) * 16), qr[ks], t0);
                t1 = mfma16(*(const LAS bf16x8*)(Fr + 16384 + ((te * 2 + ks) * 64 + lane) * 16), qr[ks], t1); }
            o[te] = acc + sc0 * t0 + sc1 * t1; ssq += (o[te][0] * o[te][0] + o[te][1] * o[te][1]) + (o[te][2] * o[te][2] + o[te][3] * o[te][3]); }
        ssq = quad_rows_sum(ssq);
        const float rs = 1.0f / sqrtf(ssq * (1.0f / 64.0f) + EPS);
#pragma unroll
        for (int te = 0; te < 4; ++te) { const int e0 = 16 * te + 4 * q;
            const u32x2 z2 = *(const u32x2*)(P + (size_t)(m0 + i) * NP + PC_GZ + hh * 64 + e0); const f32x4 gn = *(const f32x4*)(in.gdn_norm_g + layer * 64 + e0);
            const float z0 = __uint_as_float(z2.x << 16), z1 = __uint_as_float(z2.x & 0xffff0000u), z2f = __uint_as_float(z2.y << 16), z3 = __uint_as_float(z2.y & 0xffff0000u);
            u32x2 wv; wv.x = cvtpk(o[te][0] * rs * gn[0] * siluf(z0), o[te][1] * rs * gn[1] * siluf(z1)); wv.y = cvtpk(o[te][2] * rs * gn[2] * siluf(z2f), o[te][3] * rs * gn[3] * siluf(z3));
            *(u32x2*)(O + (size_t)(m0 + i) * D + 256 + hh * 64 + e0) = wv; }
    }
}

__device__ __forceinline__ void phase_ret_kv(Frame& F, const Inputs& in, int layer) {
    const bf16* P = (const bf16*)(F.ws + WS_R1 + R1_P);
    const bf16* RK = (const bf16*)(F.ws + WS_R1 + R1_PREP + PREP_RK);
    LAS bf16* Kt = (LAS bf16*)F.lds; LAS bf16* Vw = Kt + 64 * 72;
    const int lane = F.lane, c = lane & 15, q = lane >> 4, w = F.wave, tid = F.tid;
    const float LOG2E = 1.4426950408889634f;
    for (int uu = F.bid; uu < 16 * 68; uu += F.G) {
        const int bh = uu / 68, ch = uu % 68, b = bh >> 2, hh = bh & 3;
        const int m0 = ch < 4 ? b * TC + 64 * ch : MC + b * TL + 64 * (ch - 4);
        const float l0 = -fexp(in.ret_decay[layer * 8 + hh]) * LOG2E, l1 = -fexp(in.ret_decay[layer * 8 + 4 + hh]) * LOG2E;
        __syncthreads();
        { const int j = tid >> 3, col8 = (tid & 7) * 8;
          const u32x4 k8 = *(const u32x4*)(RK + (size_t)(m0 + j) * 256 + hh * 64 + col8), v8 = *(const u32x4*)(P + (size_t)(m0 + j) * NP + PC_RV + hh * 64 + col8);
          const float w0 = fexp2((float)(63 - j) * l0), w1 = fexp2((float)j * l1);
#pragma unroll
          for (int x = 0; x < 8; ++x) { const unsigned kk = (k8[x >> 1] >> (16 * (x & 1))) & 0xffffu; const float vv = __uint_as_float(((v8[x >> 1] >> (16 * (x & 1))) & 0xffffu) << 16);
              Kt[(col8 + x) * 72 + j] = (bf16)kk; Vw[(col8 + x) * 72 + j] = (bf16)f2bf(vv * w0); Vw[4608 + (col8 + x) * 72 + j] = (bf16)f2bf(vv * w1); } }
        __syncthreads();
        { const int d = w >> 2, td = w & 3;
          bf16x8 a[2];
#pragma unroll
          for (int ks = 0; ks < 2; ++ks) a[ks] = *(const LAS bf16x8*)(Kt + (16 * td + c) * 72 + 32 * ks + 8 * q);
          const int chain = bh * 2 + d, sg = d ? (ch < 4 ? 3 - ch : 71 - ch) : ch;
          float* dst = (float*)(F.ws + WS_RKV) + ((size_t)chain * 68 + sg) * 4096;
#pragma unroll
          for (int te = 0; te < 4; ++te) { f32x4 acc = (f32x4){0.f, 0.f, 0.f, 0.f};
#pragma unroll
              for (int ks = 0; ks < 2; ++ks) acc = mfma16(a[ks], *(const LAS bf16x8*)(Vw + d * 4608 + (16 * te + c) * 72 + 32 * ks + 8 * q), acc);
              *(f32x4*)(dst + (16 * te + c) * 64 + 16 * td + 4 * q) = acc; } }
    }
}
__device__ __forceinline__ void phase_ret_state(Frame& F, const Inputs& in, int layer, int nwg) {
    if (F.bid >= nwg) return;
    const float* RKV = (const float*)(F.ws + WS_RKV); bf16* RST = (bf16*)(F.ws + WS_RST);
    for (int el = F.bid * NTHR + F.tid; el < 32 * 4096; el += nwg * NTHR) {
        const int chain = el >> 12, idx = el & 4095, hh = (chain >> 1) & 3, d = chain & 1;
        const float G64 = fexp(-64.0f * fexp(in.ret_decay[layer * 8 + d * 4 + hh]));
        const float* kv = RKV + (size_t)chain * 68 * 4096 + idx; bf16* st = RST + (size_t)chain * 68 * 4096 + idx;
        float S = 0.f;
#pragma unroll
        for (int h2 = 0; h2 < 2; ++h2) { float kvv[34];
#pragma unroll
            for (int sg = 0; sg < 34; ++sg) kvv[sg] = kv[(size_t)(34 * h2 + sg) * 4096];
#pragma unroll
            for (int sg = 0; sg < 34; ++sg) { st[(size_t)(34 * h2 + sg) * 4096] = (bf16)f2bf(S); S = G64 * S + kvv[sg]; } }
    }
}
__device__ __forceinline__ void phase_ret_out(Frame& F, const Inputs& in, int layer) {
    const bf16* P = (const bf16*)(F.ws + WS_R1 + R1_P);
    const bf16* RQ = (const bf16*)(F.ws + WS_R1 + R1_PREP + PREP_RQ); const bf16* RK = (const bf16*)(F.ws + WS_R1 + R1_PREP + PREP_RK);
    const bf16* RST = (const bf16*)(F.ws + WS_RST);
    bf16* O = (bf16*)(F.ws + WS_R1 + R1_O);
    const int lane = F.lane, c = lane & 15, q = lane >> 4, w = F.wave, half = w >> 2, ti = w & 3, t2 = F.tid & 255;
    LAS bf16* Qs = (LAS bf16*)(F.lds + half * 46080); LAS bf16* Ks = Qs + 4608; LAS bf16* Vt = Ks + 4608; LAS bf16* St = Vt + 4608;
    const float LOG2E = 1.4426950408889634f;
    for (int pp = F.bid; pp < 8 * 68; pp += F.G) {
        const int uu = 2 * pp + half, bh = uu / 68, ch = uu % 68, b = bh >> 2, hh = bh & 3;
        const int m0 = ch < 4 ? b * TC + 64 * ch : MC + b * TL + 64 * (ch - 4);
        const float l0 = -fexp(in.ret_decay[layer * 8 + hh]) * LOG2E, l1 = -fexp(in.ret_decay[layer * 8 + 4 + hh]) * LOG2E;
        __syncthreads();
#pragma unroll
        for (int rep = 0; rep < 2; ++rep) { const int idx = t2 + 256 * rep, row = idx >> 3, col8 = (idx & 7) * 8;
            *(LAS u32x4*)(Qs + row * 72 + col8) = *(const u32x4*)(RQ + (size_t)(m0 + row) * 256 + hh * 64 + col8);
            *(LAS u32x4*)(Ks + row * 72 + col8) = *(const u32x4*)(RK + (size_t)(m0 + row) * 256 + hh * 64 + col8);
            const u32x4 v8 = *(const u32x4*)(P + (size_t)(m0 + row) * NP + PC_RV + hh * 64 + col8);
#pragma unroll
            for (int x = 0; x < 8; ++x) Vt[(col8 + x) * 72 + row] = (bf16)(v8[x >> 1] >> (16 * (x & 1)));
#pragma unroll
            for (int d = 0; d < 2; ++d) { const int sg = d ? (ch < 4 ? 3 - ch : 71 - ch) : ch;
                *(LAS u32x4*)(St + d * 4608 + row * 72 + col8) = *(const u32x4*)(RST + ((size_t)(bh * 2 + d) * 68 + sg) * 4096 + row * 64 + col8); } }
        __syncthreads();
        bf16x8 qf[2];
#pragma unroll
        for (int ks = 0; ks < 2; ++ks) qf[ks] = *(const LAS bf16x8*)(Qs + (16 * ti + c) * 72 + 32 * ks + 8 * q);
        const int i = 16 * ti + c;
        f32x4 p[4];
#pragma unroll
        for (int tj = 0; tj < 4; ++tj) { f32x4 acc = (f32x4){0.f, 0.f, 0.f, 0.f};
#pragma unroll
            for (int ks = 0; ks < 2; ++ks) acc = mfma16(*(const LAS bf16x8*)(Ks + (16 * tj + c) * 72 + 32 * ks + 8 * q), qf[ks], acc);
#pragma unroll
            for (int r = 0; r < 4; ++r) { const int dlt = i - (16 * tj + 4 * q + r);
                const float wgt = (dlt >= 0 ? fexp2((float)dlt * l0) : 0.f) + (dlt <= 0 ? fexp2((float)(-dlt) * l1) : 0.f);
                acc[r] *= wgt; }
            p[tj] = acc; }
        bf16x8 pb[2];
#pragma unroll
        for (int ks2 = 0; ks2 < 2; ++ks2) { u32x4 t; t.x = cvtpk(p[2 * ks2][0], p[2 * ks2][1]); t.y = cvtpk(p[2 * ks2][2], p[2 * ks2][3]); t.z = cvtpk(p[2 * ks2 + 1][0], p[2 * ks2 + 1][1]); t.w = cvtpk(p[2 * ks2 + 1][2], p[2 * ks2 + 1][3]); pb[ks2] = __builtin_bit_cast(bf16x8, t); }
        const float sc0 = fexp2((float)(i + 1) * l0), sc1 = fexp2((float)(64 - i) * l1);
        f32x4 o[4]; float sum = 0.f;
#pragma unroll
        for (int te = 0; te < 4; ++te) { f32x4 acc = (f32x4){0.f, 0.f, 0.f, 0.f}, t0 = acc, t1 = acc;
#pragma unroll
            for (int ks2 = 0; ks2 < 2; ++ks2) { const u32x2 lo = *(const LAS u32x2*)(Vt + (16 * te + c) * 72 + 32 * ks2 + 4 * q), hi = *(const LAS u32x2*)(Vt + (16 * te + c) * 72 + 32 * ks2 + 16 + 4 * q);
                acc = mfma16(__builtin_bit_cast(bf16x8, ((u32x4){lo.x, lo.y, hi.x, hi.y})), pb[ks2], acc); }
#pragma unroll
            for (int ks = 0; ks < 2; ++ks) { t0 = mfma16(*(const LAS bf16x8*)(St + (16 * te + c) * 72 + 32 * ks + 8 * q), qf[ks], t0);
                t1 = mfma16(*(const LAS bf16x8*)(St + 4608 + (16 * te + c) * 72 + 32 * ks + 8 * q), qf[ks], t1); }
            o[te] = acc + sc0 * t0 + sc1 * t1; sum += (o[te][0] + o[te][1]) + (o[te][2] + o[te][3]); }
        sum = quad_rows_sum(sum);
        const float mu = sum * (1.0f / 64.0f); float vs = 0.f;
#pragma unroll
        for (int te = 0; te < 4; ++te) { o[te] = o[te] - mu; vs += (o[te][0] * o[te][0] + o[te][1] * o[te][1]) + (o[te][2] * o[te][2] + o[te][3] * o[te][3]); }
        vs = quad_rows_sum(vs);
        const float rs = 1.0f / sqrtf(vs * (1.0f / 64.0f) + EPS);
#pragma unroll
        for (int te = 0; te < 4; ++te) { const int e0 = hh * 64 + 16 * te + 4 * q;
            const u32x2 g2 = *(const u32x2*)(P + (size_t)(m0 + i) * NP + PC_RG + e0); const f32x4 gn = *(const f32x4*)(in.ret_gn_g + layer * 256 + e0);
            const float g0 = __uint_as_float(g2.x << 16), g1 = __uint_as_float(g2.x & 0xffff0000u), g2f = __uint_as_float(g2.y << 16), g3 = __uint_as_float(g2.y & 0xffff0000u);
            u32x2 wv; wv.x = cvtpk(o[te][0] * rs * gn[0] * siluf(g0), o[te][1] * rs * gn[1] * siluf(g1)); wv.y = cvtpk(o[te][2] * rs * gn[2] * siluf(g2f), o[te][3] * rs * gn[3] * siluf(g3));
            *(u32x2*)(O + (size_t)(m0 + i) * D + e0) = wv; }
    }
}

__device__ __forceinline__ void phase_finish(Frame& F, const Inputs& in, int layer) {
    const bf16* P = (const bf16*)(F.ws + WS_R1 + R1_P);
    const float* OG = (const float*)(F.ws + WS_R1 + R1_OG);
    bf16* O = (bf16*)(F.ws + WS_R1 + R1_O);
    const int lane = F.lane;
    for (int m = F.gw; m < M; m += F.NGW) {
#pragma unroll
        for (int hh = 0; hh < 4; ++hh) {
            const float o2 = OG[(size_t)m * 256 + hh * 64 + lane] + OG[(size_t)(M + m) * 256 + hh * 64 + lane];
            const float ms = wave_sum(o2 * o2) * (1.0f / 64.0f);
            const float z = bf2f(P[(size_t)m * NP + PC_GZ + hh * 64 + lane]);
            const float y2 = o2 * (1.0f / sqrtf(ms + EPS)) * in.gdn_norm_g[layer * 64 + lane] * siluf(z);
            O[(size_t)m * D + 256 + hh * 64 + lane] = (bf16)f2bf(y2);
        }
    }
}

__device__ __forceinline__ void phase_route(Frame& F, int m_lo) {
    if (F.bid != 0) return;
    const int* TKE = (const int*)(F.ws + WS_TKE);
    int* TOKROW = (int*)(F.ws + WS_TOKROW); int* ROWTOK = (int*)(F.ws + WS_ROWTOK); int* TILEE = (int*)(F.ws + WS_TILEE);
    LAS int* cnt = (LAS int*)F.lds;
    LAS int* tot = cnt + 512 * 8;
    const int ntok = M - m_lo, per = (ntok + NTHR - 1) / NTHR;
    const int a0 = m_lo + F.tid * per, a1 = (a0 + per < M) ? a0 + per : M;
    int c[8];
#pragma unroll
    for (int e = 0; e < 8; ++e) c[e] = 0;
    for (int m = a0; m < a1; ++m) { const int e0 = TKE[2 * m], e1 = TKE[2 * m + 1];
#pragma unroll
        for (int e = 0; e < 8; ++e) c[e] += (e0 == e) + (e1 == e); }
#pragma unroll
    for (int e = 0; e < 8; ++e) cnt[F.tid * 8 + e] = c[e];
    __syncthreads();
    if (F.tid < 8) { int run = 0; for (int i = 0; i < NTHR; ++i) { const int v = cnt[i * 8 + F.tid]; cnt[i * 8 + F.tid] = run; run += v; } tot[F.tid] = run; }
    __syncthreads();
    if (F.tid == 0) { int st = 0; for (int e = 0; e < 8; ++e) { tot[8 + e] = st; const int pad = (tot[e] + 255) / 256 * 256;
            for (int tl = st / 256; tl < (st + pad) / 256; ++tl) TILEE[tl] = e; st += pad; }
        TILEE[256] = st / 256; }
    __syncthreads();
    int pos[8];
#pragma unroll
    for (int e = 0; e < 8; ++e) pos[e] = tot[8 + e] + cnt[F.tid * 8 + e];
    for (int m = a0; m < a1; ++m) {
#pragma unroll
        for (int k = 0; k < 2; ++k) { const int ee = TKE[2 * m + k]; int row = 0;
#pragma unroll
            for (int e = 0; e < 8; ++e) if (ee == e) { row = pos[e]; pos[e] = row + 1; }
            ROWTOK[row] = m; TOKROW[2 * m + k] = row; } }
    for (int e = 0; e < 8; ++e) { const int st = tot[8 + e] + tot[e], en = tot[8 + e] + (tot[e] + 255) / 256 * 256; for (int r = st + F.tid; r < en; r += NTHR) ROWTOK[r] = -1; }
}
__device__ __forceinline__ void phase_permute(Frame& F) {
    const int* ROWTOK = (const int*)(F.ws + WS_ROWTOK); const int nrows = ((const int*)(F.ws + WS_TILEE))[256] * 256;
    const bf16* H = (const bf16*)(F.ws + WS_H); bf16* HP = (bf16*)(F.ws + WS_HP);
    for (int r = F.gw; r < nrows; r += F.NGW) { const int tok = ROWTOK[r];
#pragma unroll
        for (int j = 0; j < 2; ++j) { u32x4 v = (u32x4){0u, 0u, 0u, 0u}; if (tok >= 0) v = *(const u32x4*)(H + (size_t)tok * D + 8 * F.lane + 512 * j); *(u32x4*)(HP + (size_t)r * D + 8 * F.lane + 512 * j) = v; } }
}


__device__ __forceinline__ void phase_permute2(Frame& F, int route_lo) {
    const int* TKE = (const int*)(F.ws + WS_TKE); int* TOKROW = (int*)(F.ws + WS_TOKROW); int* TILEE = (int*)(F.ws + WS_TILEE);
    const int* WGCNT = (const int*)(F.ws + WS_TILEE + 4096);
    const bf16* H = (const bf16*)(F.ws + WS_H); bf16* HP = (bf16*)(F.ws + WS_HP);
    LAS int* base = (LAS int*)F.lds;
    LAS int* tot = base + 256 * 8;
    __syncthreads();
    if (F.tid < 8) { int run = 0; for (int g = 0; g < F.G; ++g) { base[g * 8 + F.tid] = run; run += WGCNT[g * 8 + F.tid]; } tot[F.tid] = run; }
    __syncthreads();
    if (F.tid == 0) { int st = 0; for (int e = 0; e < 8; ++e) { tot[8 + e] = st; const int pad = (tot[e] + 255) / 256 * 256;
            if (F.bid == 0) for (int tl = st / 256; tl < (st + pad) / 256; ++tl) TILEE[tl] = e;
            st += pad; }
        if (F.bid == 0) TILEE[256] = st / 256; }
    __syncthreads();
    const int lane = F.lane;
    for (int m = route_lo + F.gw; m < M; m += F.NGW) {
        const int gwm = (int)((((long)(m + 1)) * F.NGW - 1) / M), wg = gwm >> 3;
        const int e0 = TKE[2 * m], e1 = TKE[2 * m + 1];
        const int r0 = tot[8 + e0] + base[wg * 8 + e0] + TOKROW[2 * m], r1 = tot[8 + e1] + base[wg * 8 + e1] + TOKROW[2 * m + 1];
        const u32x4 a = *(const u32x4*)(H + (size_t)m * D + 8 * lane), b = *(const u32x4*)(H + (size_t)m * D + 512 + 8 * lane);
        *(u32x4*)(HP + (size_t)r0 * D + 8 * lane) = a; *(u32x4*)(HP + (size_t)r0 * D + 512 + 8 * lane) = b;
        *(u32x4*)(HP + (size_t)r1 * D + 8 * lane) = a; *(u32x4*)(HP + (size_t)r1 * D + 512 + 8 * lane) = b;
        asm volatile("" ::: "memory");
        if (lane == 0) { TOKROW[2 * m] = r0; TOKROW[2 * m + 1] = r1; }
    }
    for (int e = 0; e < 8; ++e) { const int st = tot[8 + e] + tot[e], en = tot[8 + e] + (tot[e] + 255) / 256 * 256;
        for (int r = st + F.gw; r < en; r += F.NGW) { *(u32x4*)(HP + (size_t)r * D + 8 * lane) = (u32x4){0u, 0u, 0u, 0u}; *(u32x4*)(HP + (size_t)r * D + 512 + 8 * lane) = (u32x4){0u, 0u, 0u, 0u}; } }
}

constexpr int NPH = 12;
constexpr int PH_TOTAL = 1 + DEPTH * NPH + 1;
__host__ __device__ inline bool phase_exists(int ph) {
    if (ph == 0 || ph == PH_TOTAL - 1) return true;
    const int layer = (ph - 1) / NPH, j = (ph - 1) % NPH;
    if (!(layer & 1) && j >= 10) return false;
    if ((layer & 1) && j >= 11) return false;
    return true;
}
__global__ void __launch_bounds__(NTHR, 2) fwd_kernel(Args args) {
    extern __shared__ __attribute__((aligned(16))) unsigned char lds_raw[];
    Frame F;
    F.lds = (LAS unsigned char*)lds_raw;
    F.tid = threadIdx.x; F.lane = F.tid & 63; F.wave = __builtin_amdgcn_readfirstlane(F.tid >> 6);
    F.G = gridDim.x; F.bid = blockIdx.x; F.gw = blockIdx.x * NWAVES + F.wave; F.NGW = F.G * NWAVES; F.ws = args.ws;
    volatile LAS unsigned* MISC = (volatile LAS unsigned*)(F.lds + MISC_OFF);
    LAS unsigned long long* ptab = (LAS unsigned long long*)(F.lds + MISC_OFF + 128);
    if (F.tid < 32) MISC[F.tid] = 0u;
    if (PROBE_ON && F.tid == 65) { ((volatile LAS unsigned long long*)(F.lds + 132096))[0] = 0ull; ((volatile LAS unsigned long long*)(F.lds + 132096))[1] = 0ull; }
    if (F.tid == 64) { const Inputs& ai = args.in;
        ptab[0] = (unsigned long long)ai.x; ptab[1] = (unsigned long long)ai.c; ptab[2] = (unsigned long long)ai.ctx; ptab[3] = (unsigned long long)ai.c_ctx; ptab[4] = (unsigned long long)ai.ada_w; ptab[5] = (unsigned long long)ai.ada_b;
        ptab[6] = (unsigned long long)ai.norm1_g; ptab[7] = (unsigned long long)ai.w_in; ptab[8] = (unsigned long long)ai.ret_decay; ptab[9] = (unsigned long long)ai.ret_gn_g; ptab[10] = (unsigned long long)ai.gdn_conv_w; ptab[11] = (unsigned long long)ai.gdn_a_log;
        ptab[12] = (unsigned long long)ai.gdn_dt_bias; ptab[13] = (unsigned long long)ai.gdn_norm_g; ptab[14] = (unsigned long long)ai.swa_sink; ptab[15] = (unsigned long long)ai.w_out; ptab[16] = (unsigned long long)ai.norm2_g; ptab[17] = (unsigned long long)ai.ffn_w1;
        ptab[18] = (unsigned long long)ai.ffn_w3; ptab[19] = (unsigned long long)ai.ffn_w2; ptab[20] = (unsigned long long)ai.router_w; ptab[21] = (unsigned long long)ai.moe_w1; ptab[22] = (unsigned long long)ai.moe_w3; ptab[23] = (unsigned long long)ai.moe_w2; ptab[24] = (unsigned long long)ai.final_g; }
    __syncthreads();
    XcdBarrier bar; bar.bar = (unsigned*)(F.ws + WS_CTL) + CW_BAR; bar.x = 0; bar.st = nullptr;
    const int lo = args.ph_lo, hi = args.ph_hi;
    const bool multi = (hi - lo) > 1;
    if (multi) bar = xcd_barrier_post((unsigned*)(F.ws + WS_CTL) + CW_BAR, MISC + 8);
#define LAUNDER() GAS unsigned char* _w = (GAS unsigned char*)args.ws; asm volatile("" : "+s"(_w)); F.ws = (unsigned char*)_w; asm volatile("" ::: "memory"); { int _t = threadIdx.x; asm volatile("" : "+v"(_t)); int _b = blockIdx.x; asm volatile("" : "+s"(_b)); F.tid = _t; F.lane = _t & 63; F.wave = __builtin_amdgcn_readfirstlane(_t >> 6); F.bid = _b; F.gw = _b * NWAVES + F.wave; } const Inputs in = load_inputs(ptab)
#define RELAUNDER() do { GAS unsigned char* _w2 = (GAS unsigned char*)args.ws; asm volatile("" : "+s"(_w2)); F.ws = (unsigned char*)_w2; int _t = threadIdx.x; asm volatile("" : "+v"(_t)); int _b = blockIdx.x; asm volatile("" : "+s"(_b)); F.tid = _t; F.lane = _t & 63; F.wave = __builtin_amdgcn_readfirstlane(_t >> 6); F.bid = _b; F.gw = _b * NWAVES + F.wave; asm volatile("" ::: "memory"); } while (0)
#define IN(k) (lo <= (k) && (k) < hi)
#define STAMP(k) do { if (PROBE_ON && !(PROBE_CUSTOM) && blockIdx.x == 0 && threadIdx.x == 0) { volatile LAS unsigned long long* _st = (volatile LAS unsigned long long*)(F.lds + 132096); const unsigned long long _now = __builtin_amdgcn_s_memrealtime(), _prev = _st[0]; _st[0] = _now; \
    const int _ph = (k) - 1; bool _sel = false; if (_ph == 0) _sel = (PROBE_PRO) != 0; else if (_ph > 0) { const int _l = (_ph - 1) / NPH, _j = (_ph - 1) % NPH; _sel = (((PROBE_LMASK) >> _l) & 1u) && (((PROBE_JMASK) >> _j) & 1u); } if (_sel) _st[1] = _st[1] + (_now - _prev); } } while (0)
#define SEAM(k) do { if (IN(k) && IN((k) + 1)) { xcd_barrier(bar); STAMP((k) + 1); } } while (0)
    LAS unsigned char* ring = F.lds;

    STAMP(0);
    if (IN(0)) { LAUNDER(); phase_prologue(F, in); } SEAM(0);

    for (int layer = 0; layer < DEPTH; ++layer) {
        const int p0 = 1 + layer * NPH;
        const bool moe = layer & 1;
        if (IN(p0 + 0)) { LAUNDER(); phase_token2<0>(F, in, layer, layer == 0, layer > 0 && ((layer - 1) & 1), false, nullptr); if (layer == 2) { __syncthreads(); convert_moe_layer(F, in, 1); } }
        SEAM(p0 + 0);
        if (IN(p0 + 1)) { LAUNDER(); pg8::StaticOrder S; S.init(F.ws + WS_H, (bf16*)(F.ws + WS_WIN) + (size_t)layer * NP * D, M, NP, D, F.G, F.bid);
            pg8::EpiBf16 E{(bf16*)(F.ws + WS_R1 + R1_P), NP}; pg8::gemm_phase<D, pg8::EpiBf16, pg8::StaticOrder>(ring, S, E, F.tid); }
        SEAM(p0 + 1);
        if (IN(p0 + 2)) { LAUNDER(); phase_prep2(F, in, layer); }
        SEAM(p0 + 2);
        if (IN(p0 + 3)) { LAUNDER(); PB(4); phase_gdn_local2(F); PE(4); RELAUNDER(); PB(5); phase_ret_kv(F, in, layer); PE(5); }
        SEAM(p0 + 3);
        if (IN(p0 + 4)) { LAUNDER(); PB(1); phase_gdn_scan3(F, F.G - 32); PE(1); RELAUNDER(); PB(2); phase_ret_state(F, in, layer, F.G - 32); PE(2); RELAUNDER(); PB(3); phase_swa2(F, in, layer, F.G - 32); PE(3); }
        SEAM(p0 + 4);
        if (IN(p0 + 5)) { LAUNDER(); PB(6); phase_ret_out(F, in, layer); PE(6); RELAUNDER(); PB(7); phase_gdn_out2(F, in, layer); PE(7); }
        SEAM(p0 + 5);
        if (IN(p0 + 6)) { LAUNDER(); pg8::StaticOrder S; S.init(F.ws + WS_R1 + R1_O, (bf16*)(F.ws + WS_WOUT) + (size_t)layer * D * D, M, D, D, F.G, F.bid);
            pg8::EpiResid E{(float*)(F.ws + WS_XS), (const float*)(F.ws + WS_MOD) + (size_t)layer * 5 * 6 * D, 2}; pg8::gemm_phase<D, pg8::EpiResid, pg8::StaticOrder>(ring, S, E, F.tid); }
        SEAM(p0 + 6);
        if (IN(p0 + 7)) { LAUNDER(); phase_token2<1>(F, in, layer, false, false, moe, nullptr, layer == DEPTH - 1 ? MC : 0); }
        SEAM(p0 + 7);
        if (!moe) {
            if (IN(p0 + 8)) { LAUNDER(); pg8::StaticOrder S; S.init(F.ws + WS_H, (bf16*)(F.ws + WS_W13) + (size_t)(layer >> 1) * 2 * FF * D, M, 2 * FF, D, F.G, F.bid);
                pg8::EpiSwiglu E{(bf16*)(F.ws + WS_R1 + R1_HID), FF}; pg8::gemm_phase<D, pg8::EpiSwiglu, pg8::StaticOrder>(ring, S, E, F.tid); }
            SEAM(p0 + 8);
            if (IN(p0 + 9)) { LAUNDER(); pg8::StaticOrder S; S.init(F.ws + WS_R1 + R1_HID, (bf16*)(F.ws + WS_W2) + (size_t)(layer >> 1) * D * FF, M, D, FF, F.G, F.bid);
                pg8::EpiResid E{(float*)(F.ws + WS_XS), (const float*)(F.ws + WS_MOD) + (size_t)layer * 5 * 6 * D, 5}; pg8::gemm_phase<FF, pg8::EpiResid, pg8::StaticOrder>(ring, S, E, F.tid); }
            if (IN(p0 + 9) && IN(p0 + NPH)) { xcd_barrier(bar); STAMP(p0 + 10); }
        } else {
            if (IN(p0 + 8)) { LAUNDER(); phase_permute2(F, layer == DEPTH - 1 ? MC : 0); }
            SEAM(p0 + 8);
            if (IN(p0 + 9)) { LAUNDER(); const int* tile_e = (const int*)(F.ws + WS_TILEE); const int ntiles = __builtin_amdgcn_readfirstlane(tile_e[256]);
                pg8::GroupedOrder S; S.init(F.ws + WS_HP, F.ws + WS_MW13, ntiles, 2 * EF, D, F.G, F.bid, tile_e);
                pg8::EpiSwiglu E{(bf16*)(F.ws + WS_R1 + R1_HID), EF}; pg8::gemm_phase<D, pg8::EpiSwiglu, pg8::GroupedOrder>(ring, S, E, F.tid); }
            SEAM(p0 + 9);
            if (IN(p0 + 10)) { LAUNDER(); const int* tile_e = (const int*)(F.ws + WS_TILEE); const int ntiles = __builtin_amdgcn_readfirstlane(tile_e[256]);
                pg8::GroupedOrder S; S.init(F.ws + WS_R1 + R1_HID, F.ws + WS_MW2, ntiles, D, EF, F.G, F.bid, tile_e);
                pg8::EpiF32 E{(float*)(F.ws + WS_YM), D}; pg8::gemm_phase<EF, pg8::EpiF32, pg8::GroupedOrder>(ring, S, E, F.tid); }
            if (IN(p0 + 10) && IN(p0 + NPH)) { xcd_barrier(bar); STAMP(p0 + 11); }
        }
    }
    if (IN(PH_TOTAL - 1)) { LAUNDER(); phase_token2<2>(F, in, DEPTH, false, true, false, args.out); }
    if (PROBE_ON && (int)blockIdx.x == ((PROBE_CUSTOM) ? (PROBE_BLOCK < 0 ? (int)gridDim.x + (PROBE_BLOCK) : (PROBE_BLOCK)) : 0) && threadIdx.x == 0) {
        STAMP(PH_TOTAL);
        const unsigned long long T = ((volatile LAS unsigned long long*)(F.lds + 132096))[1];
        const unsigned long long t0 = __builtin_amdgcn_s_memrealtime();
        while (__builtin_amdgcn_s_memrealtime() - t0 < 8ull * T) __builtin_amdgcn_s_sleep(8);
    }
#undef IN
#undef SEAM
}

extern "C" void kernel_launch(void* const* d_in, const int* in_sizes, int n_in, void* d_out, int out_size, void* d_ws, size_t ws_size, hipStream_t stream) {
    static int grid = 0;
    if (grid == 0) {
        if (n_in != 25 || out_size != ML * D || ws_size < WS_END) { fprintf(stderr, "kernel_launch: unexpected problem: n_in %d out %d ws %zu (need %zu)\n", n_in, out_size, ws_size, (size_t)WS_END); grid = -1; return; }
        int dev = 0, cus = 0, per_cu = 0;
        if (hipGetDevice(&dev) != hipSuccess || hipDeviceGetAttribute(&cus, hipDeviceAttributeMultiprocessorCount, dev) != hipSuccess) { grid = -1; return; }
        if (hipFuncSetAttribute((const void*)fwd_kernel, hipFuncAttributeMaxDynamicSharedMemorySize, LDS_BYTES) != hipSuccess) { fprintf(stderr, "kernel_launch: hipFuncSetAttribute failed\n"); grid = -1; return; }
        if (hipOccupancyMaxActiveBlocksPerMultiprocessor(&per_cu, (const void*)fwd_kernel, NTHR, LDS_BYTES) != hipSuccess || per_cu < 1) fprintf(stderr, "kernel_launch: occupancy query reports %d\n", per_cu);
        (void)hipGetLastError();
        grid = cus;
    }
    if (grid < 0) return;
    (void)hipMemsetAsync((char*)d_ws + WS_CTL, 0, CTL_ZERO_BYTES, stream);
    Args a{};
    const float** ip = (const float**)&a.in;
    for (int i = 0; i < 25; ++i) ip[i] = (const float*)d_in[i];
    a.out = (float*)d_out; a.ws = (unsigned char*)d_ws;
#if MK_ONE_LAUNCH
    a.ph_lo = 0; a.ph_hi = PH_TOTAL;
    hipLaunchKernelGGL(fwd_kernel, dim3(grid), dim3(NTHR), LDS_BYTES, stream, a);
#else
    for (int ph = 0; ph < PH_TOTAL; ++ph) { if (!phase_exists(ph)) continue; a.ph_lo = ph; a.ph_hi = ph + 1;
        hipLaunchKernelGGL(fwd_kernel, dim3(grid), dim3(NTHR), LDS_BYTES, stream, a); }
#endif
}
```

```cpp
#include <hip/hip_runtime.h>
#include <cstdio>
#include <cstdint>

#ifndef PROBE_JMASK
#define PROBE_JMASK 0u
#endif
#ifndef PROBE_LMASK
#define PROBE_LMASK 15u
#endif
#ifndef PROBE_PRO
#define PROBE_PRO 0
#endif
#ifndef PROBE_CUSTOM
#define PROBE_CUSTOM 0
#endif
#ifndef PROBE_BLOCK
#define PROBE_BLOCK 0
#endif
#define PROBE_ON ((PROBE_JMASK) != 0u || (PROBE_PRO) != 0 || (PROBE_CUSTOM) != 0)
#define PB(id) do { if ((PROBE_CUSTOM) == (id) && (int)blockIdx.x == (PROBE_BLOCK < 0 ? (int)gridDim.x + (PROBE_BLOCK) : (PROBE_BLOCK)) && threadIdx.x == 0) ((volatile LAS unsigned long long*)(F.lds + 132096))[2] = __builtin_amdgcn_s_memrealtime(); } while (0)
#define PE(id) do { if ((PROBE_CUSTOM) == (id) && (int)blockIdx.x == (PROBE_BLOCK < 0 ? (int)gridDim.x + (PROBE_BLOCK) : (PROBE_BLOCK)) && threadIdx.x == 0) { volatile LAS unsigned long long* _s = (volatile LAS unsigned long long*)(F.lds + 132096); _s[1] = _s[1] + (__builtin_amdgcn_s_memrealtime() - _s[2]); } } while (0)
#ifndef MK_ONE_LAUNCH
#define MK_ONE_LAUNCH 1
#endif

#define GAS __attribute__((address_space(1)))
#define LAS __attribute__((address_space(3)))
typedef unsigned short bf16;
typedef short bf16x8 __attribute__((ext_vector_type(8)));
typedef float f32x4 __attribute__((ext_vector_type(4)));
typedef float f32x2 __attribute__((ext_vector_type(2)));
typedef unsigned u32x4 __attribute__((ext_vector_type(4)));
typedef unsigned u32x2 __attribute__((ext_vector_type(2)));

constexpr int D = 1024, NB = 4, TL = 4096, TC = 256, DEPTH = 4;
constexpr int MC = NB * TC, ML = NB * TL, M = MC + ML;
constexpr int INC = 2832, NP = 2816;
constexpr int FF = 2816, EF = 3584, NE = 8;
constexpr int MAXROWS = 36864;
constexpr float EPS = 1e-6f;
constexpr int PC_RQ = 0, PC_RK = 256, PC_RV = 512, PC_RG = 768, PC_GQKV = 1024, PC_GZ = 1792, PC_SQ = 2048, PC_SK = 2560, PC_SV = 2688;

constexpr size_t MiB = 1u << 20;
constexpr size_t WS_CTL = 0, CTL_ZERO_BYTES = 1 * MiB;
constexpr size_t WS_MOD = 1 * MiB;
constexpr size_t WS_ROPE = 2 * MiB;
constexpr size_t WS_TKE = 3 * MiB, WS_TKG = 3 * MiB + 256 * 1024, WS_TOKROW = 3 * MiB + 512 * 1024, WS_ROWTOK = 3 * MiB + 768 * 1024, WS_TILEE = 4 * MiB;
constexpr size_t WS_AB = 5 * MiB, WS_GB = 7 * MiB;
constexpr size_t WS_WIN = 16 * MiB, WS_WOUT = 38 * MiB, WS_W13 = 46 * MiB, WS_W2 = 68 * MiB, WS_MW13 = 80 * MiB, WS_MW2 = 192 * MiB;
constexpr size_t WS_XS = 248 * MiB, WS_H = 316 * MiB, WS_HP = 350 * MiB, WS_YM = 422 * MiB, WS_R1 = 566 * MiB;
constexpr size_t R1_P = 0, R1_PREP = 94 * MiB, R1_O = 158 * MiB, R1_OR = 192 * MiB, R1_OG = 226 * MiB, R1_HID = 0;
constexpr size_t WS_END = WS_R1 + 260 * MiB;
constexpr size_t WS_GCH = WS_YM, GCH_STEP = 40960, GCH_CHAIN = 68 * GCH_STEP, WS_GDEC = WS_HP;
constexpr size_t G2_STEP = 24576, G2_CHAIN = 68 * G2_STEP;
constexpr size_t WS_GST = WS_YM + 56 * MiB;
constexpr size_t WS_GCS = WS_HP + 64 * 1024;
static_assert(32 * G2_CHAIN <= 56 * MiB && 32 * 68 * 16384 <= 40 * MiB, "gdn v2 buffers");
constexpr size_t WS_RKV = WS_YM + 96 * MiB;
constexpr size_t WS_RST = WS_HP + 1 * MiB;
static_assert(32 * GCH_CHAIN <= 144 * MiB, "gdn chunk data");
constexpr size_t PREP_RQ = 0, PREP_RK = (size_t)M * 256 * 2, PREP_SQ = (size_t)M * 512 * 2, PREP_SK = (size_t)M * 1024 * 2, PREP_GD = (size_t)M * 1152 * 2;
static_assert(PREP_GD + (size_t)M * 768 * 2 <= 64 * MiB, "prep");
static_assert((size_t)M * NP * 2 <= 94 * MiB && (size_t)MAXROWS * EF * 2 <= 260 * MiB, "r1");

constexpr int CW_TMO = 0, CW_BAR = 4096;

__device__ __forceinline__ float bf2f(bf16 v) { return __uint_as_float(((unsigned)v) << 16); }
__device__ __forceinline__ unsigned f2bf(float f) { unsigned u = __float_as_uint(f); return (u + 0x7fffu + ((u >> 16) & 1u)) >> 16; }
__device__ __forceinline__ unsigned pk2(float lo, float hi) { return f2bf(lo) | (f2bf(hi) << 16); }
template <int CTRL> __device__ __forceinline__ float dppf(float v) { return __int_as_float(__builtin_amdgcn_update_dpp(0, __float_as_int(v), CTRL, 0xF, 0xF, true)); }
__device__ __forceinline__ float row_sum16(float v) {
    v += dppf<0xB1>(v); v += dppf<0x4E>(v); v += dppf<0x141>(v); v += dppf<0x140>(v); return v; }
__device__ __forceinline__ float wave_sum(float v) {
    v = row_sum16(v);
    return __int_as_float(__builtin_amdgcn_readlane(__float_as_int(v), 0)) + __int_as_float(__builtin_amdgcn_readlane(__float_as_int(v), 16))
         + __int_as_float(__builtin_amdgcn_readlane(__float_as_int(v), 32)) + __int_as_float(__builtin_amdgcn_readlane(__float_as_int(v), 48)); }
__device__ __forceinline__ float quad_rows_sum(float v) {
    u32x2 r = __builtin_amdgcn_permlane16_swap(__float_as_uint(v), __float_as_uint(v), false, false); v = __uint_as_float(r.x) + __uint_as_float(r.y);
    r = __builtin_amdgcn_permlane32_swap(__float_as_uint(v), __float_as_uint(v), false, false); return __uint_as_float(r.x) + __uint_as_float(r.y); }
__device__ __forceinline__ float quad_rows_max(float v) {
    u32x2 r = __builtin_amdgcn_permlane16_swap(__float_as_uint(v), __float_as_uint(v), false, false); v = fmaxf(__uint_as_float(r.x), __uint_as_float(r.y));
    r = __builtin_amdgcn_permlane32_swap(__float_as_uint(v), __float_as_uint(v), false, false); return fmaxf(__uint_as_float(r.x), __uint_as_float(r.y)); }
__device__ __forceinline__ float fexp2(float x) { return __builtin_amdgcn_exp2f(x); }
__device__ __forceinline__ float fexp(float x) { return __builtin_amdgcn_exp2f(x * 1.4426950408889634f); }
__device__ __forceinline__ float siluf(float x) { return x * __builtin_amdgcn_rcpf(1.0f + fexp(-x)); }
#define LDS_WAIT() asm volatile("s_waitcnt lgkmcnt(0)" ::: "memory")
__device__ __forceinline__ f32x4 mfma16(bf16x8 a, bf16x8 b, f32x4 c) { return __builtin_amdgcn_mfma_f32_16x16x32_bf16(a, b, c, 0, 0, 0); }
__device__ __forceinline__ unsigned cvtpk(float lo, float hi) { unsigned r; asm volatile("v_cvt_pk_bf16_f32 %0, %1, %2" : "=v"(r) : "v"(lo), "v"(hi)); return r; }


namespace pg8 {
#define PG8_LAS __attribute__((address_space(3)))
constexpr int BM = 256, BK = 64, HALF = 128, HTB = HALF * BK * 2, STAGE_BYTES = 8 * HTB;
__host__ __device__ __forceinline__ int lds_byte(int r, int c) { const int st = (r >> 4) * 2 + (c >> 5), rr = r & 15, cc = c & 31, ob = rr * 64 + cc * 2; return st * 1024 + (ob ^ (((ob >> 9) & 1) << 5)); }
__host__ __device__ __forceinline__ void stage_rc(int b, int& R, int& C) { const int st = b / 1024, sb = b % 1024, swz = sb ^ (((sb >> 9) & 1) << 5); R = (st >> 1) * 16 + swz / 64; C = (st & 1) * 32 + (swz % 64) / 2; }
__host__ __device__ __forceinline__ int perm32(int rho) { const int n = rho >> 4, i = rho & 15; return 8 * (i >> 2) + 4 * n + (i & 3); }
struct Unit { int pm, pn, aux; const char* A; const char* B; };
__device__ __forceinline__ unsigned cvt_pk_bf16(float lo, float hi) { unsigned r; asm volatile("v_cvt_pk_bf16_f32 %0, %1, %2" : "=v"(r) : "v"(lo), "v"(hi)); return r; }

template <int K, int LD, class Epi, class Sched, bool ALIGN_EPI = true, bool SP2 = true>
__device__ __forceinline__ void gemm_phase(PG8_LAS unsigned char* lds, const Sched& S, const Epi& E, const int tid) {
    const int wid = __builtin_amdgcn_readfirstlane(tid >> 6), lane = tid & 63, wr = wid >> 2, wc = wid & 3, fr = lane & 15, fq = lane >> 4;
    constexpr int nt = K / BK;
    unsigned voffA[2], voffB[2];
#pragma unroll
    for (int i = 0; i < 2; ++i) { int R, C; stage_rc(tid * 16 + i * 8192, R, C); const int Rb = Epi::PERM ? ((R & ~31) + perm32(R & 31)) : R;
        voffA[i] = (unsigned)(R * LD + C) * 2u; voffB[i] = (unsigned)(Rb * LD + C) * 2u; }
    constexpr size_t kstep = (size_t)(BK * 2);
    constexpr size_t hstep = (size_t)HALF * LD * 2;
    const unsigned ldsw = (unsigned)wid * 1024u;
    const int aoff = lds_byte(wr * 64 + fr, fq * 8), boff = lds_byte(wc * 32 + fr, fq * 8);
#define PG8_SA(b, h) (((b) * 2 + (h)) * HTB)
#define PG8_SB(b, h) ((4 + (b) * 2 + (h)) * HTB)
#define PG8_STAGE(bufoff, gbase, voff) do { _Pragma("unroll") for (int _i = 0; _i < 2; ++_i) \
        __builtin_amdgcn_global_load_lds((const unsigned*)((const char*)(gbase) + (voff)[_i]), (PG8_LAS unsigned*)(lds + (bufoff) + ldsw + _i * 8192), 16, 0, 0); } while (0)
#define PG8_LDA(dst, b, h) do { _Pragma("unroll") for (int m = 0; m < 4; ++m) _Pragma("unroll") for (int k = 0; k < 2; ++k) dst[m][k] = *(const PG8_LAS bf16x8*)(lds + PG8_SA(b, h) + aoff + m * 2048 + k * 1024); } while (0)
#define PG8_LDB(dst, b, h) do { _Pragma("unroll") for (int n = 0; n < 2; ++n) _Pragma("unroll") for (int k = 0; k < 2; ++k) dst[n][k] = *(const PG8_LAS bf16x8*)(lds + PG8_SB(b, h) + boff + n * 2048 + k * 1024); } while (0)
#define PG8_MMA(ai, bj, At, Bt) do { __builtin_amdgcn_s_setprio(1); _Pragma("unroll") for (int m = 0; m < 4; ++m) _Pragma("unroll") for (int n = 0; n < 2; ++n) _Pragma("unroll") for (int k = 0; k < 2; ++k) \
        acc[ai][bj][m][n] = __builtin_amdgcn_mfma_f32_16x16x32_bf16(Bt[n][k], At[m][k], acc[ai][bj][m][n], 0, 0, 0); __builtin_amdgcn_s_setprio(0); } while (0)
#define PG8_WAIT_V(n) asm volatile("s_waitcnt vmcnt(" #n ")" ::: "memory")
#define PG8_WAIT_L(n) asm volatile("s_waitcnt lgkmcnt(" #n ")" ::: "memory")
#define PG8_BAR __builtin_amdgcn_s_barrier()
#define PG8_SCHED __builtin_amdgcn_sched_barrier(0)
    Unit cur, nxt; int ui = 0;
    if (!S.next(0, cur)) return;
    f32x4 acc[2][2][4][2];
#pragma unroll
    for (int a = 0; a < 2; ++a)
#pragma unroll
        for (int b = 0; b < 2; ++b)
#pragma unroll
            for (int m = 0; m < 4; ++m)
#pragma unroll
                for (int n = 0; n < 2; ++n) acc[a][b][m][n] = (f32x4){0.f, 0.f, 0.f, 0.f};
    bf16x8 At[4][2], B0[2][2], B1[2][2];
    const char* cA = cur.A; const char* cB = cur.B;
    if constexpr (SP2) {
        PG8_STAGE(PG8_SB(0, 0), cB, voffB); PG8_STAGE(PG8_SB(0, 1), cB + hstep, voffB); PG8_STAGE(PG8_SA(0, 0), cA, voffA); PG8_STAGE(PG8_SA(0, 1), cA + hstep, voffA);
        if (wr == 1) PG8_BAR;
        PG8_WAIT_V(2); PG8_BAR;
        PG8_STAGE(PG8_SB(1, 0), cB + kstep, voffB); PG8_STAGE(PG8_SA(1, 0), cA + kstep, voffA); PG8_STAGE(PG8_SB(1, 1), cB + hstep + kstep, voffB);
        PG8_WAIT_V(6); PG8_BAR;
    } else {
        PG8_STAGE(PG8_SB(0, 0), cB, voffB); PG8_STAGE(PG8_SA(0, 0), cA, voffA); PG8_STAGE(PG8_SB(0, 1), cB + hstep, voffB); PG8_STAGE(PG8_SA(0, 1), cA + hstep, voffA);
        if (wr == 1) PG8_BAR;
        PG8_WAIT_V(4); PG8_BAR;
        PG8_STAGE(PG8_SB(1, 0), cB + kstep, voffB); PG8_STAGE(PG8_SA(1, 0), cA + kstep, voffA); PG8_STAGE(PG8_SB(1, 1), cB + hstep + kstep, voffB);
        PG8_WAIT_V(6); PG8_BAR;
    }
    for (;;) {
        const bool has_next = S.next(ui + 1, nxt);
        const char* nA = has_next ? nxt.A : cA; const char* nB = has_next ? nxt.B : cB;
        for (int t = 0; t < nt; t += 2) {
            const bool last = (t == nt - 2);
            const char* a1 = cA + (size_t)(t + 1) * kstep;
            const char* a2 = last ? nA : cA + (size_t)(t + 2) * kstep; const char* b2 = last ? nB : cB + (size_t)(t + 2) * kstep;
            const char* a3 = a2 + kstep; const char* b3 = b2 + kstep;
            if constexpr (SP2) {
            PG8_LDB(B0, 0, 0); PG8_LDB(B1, 0, 1); PG8_SCHED; PG8_LDA(At, 0, 0); PG8_STAGE(PG8_SA(1, 1), a1 + hstep, voffA);
            PG8_WAIT_V(8); PG8_WAIT_L(0); PG8_BAR; PG8_MMA(0, 0, At, B0); PG8_MMA(0, 1, At, B1); PG8_BAR; PG8_SCHED;
            PG8_LDA(At, 0, 1); PG8_STAGE(PG8_SB(0, 0), b2, voffB); PG8_STAGE(PG8_SB(0, 1), b2 + hstep, voffB); PG8_STAGE(PG8_SA(0, 0), a2, voffA);
            PG8_WAIT_V(8); PG8_WAIT_L(0); PG8_BAR; PG8_MMA(1, 0, At, B0); PG8_MMA(1, 1, At, B1); PG8_BAR; PG8_SCHED;
            PG8_LDB(B0, 1, 0); PG8_LDB(B1, 1, 1); PG8_SCHED; PG8_LDA(At, 1, 0); PG8_STAGE(PG8_SA(0, 1), a2 + hstep, voffA);
            PG8_WAIT_V(8); PG8_WAIT_L(0); PG8_BAR; PG8_MMA(0, 0, At, B0); PG8_MMA(0, 1, At, B1); PG8_BAR; PG8_SCHED;
            PG8_LDA(At, 1, 1); PG8_STAGE(PG8_SB(1, 0), b3, voffB); PG8_STAGE(PG8_SB(1, 1), b3 + hstep, voffB); PG8_STAGE(PG8_SA(1, 0), a3, voffA);
            PG8_WAIT_V(8); PG8_WAIT_L(0); PG8_BAR; PG8_MMA(1, 0, At, B0); PG8_MMA(1, 1, At, B1); PG8_BAR; PG8_SCHED;
            } else {
            PG8_LDB(B0, 0, 0); PG8_SCHED; PG8_LDA(At, 0, 0); PG8_STAGE(PG8_SA(1, 1), a1 + hstep, voffA);
            PG8_WAIT_L(8); PG8_BAR; PG8_WAIT_L(0); PG8_MMA(0, 0, At, B0); PG8_BAR; PG8_SCHED;
            PG8_LDB(B1, 0, 1); PG8_STAGE(PG8_SB(0, 0), b2, voffB);
            PG8_BAR; PG8_WAIT_L(0); PG8_MMA(0, 1, At, B1); PG8_BAR;
            PG8_LDA(At, 0, 1); PG8_STAGE(PG8_SA(0, 0), a2, voffA);
            PG8_BAR; PG8_WAIT_L(0); PG8_MMA(1, 0, At, B0); PG8_BAR; PG8_SCHED;
            PG8_STAGE(PG8_SB(0, 1), b2 + hstep, voffB);
            PG8_WAIT_V(6); PG8_BAR; PG8_MMA(1, 1, At, B1); PG8_BAR;
            PG8_LDB(B0, 1, 0); PG8_SCHED; PG8_LDA(At, 1, 0); PG8_STAGE(PG8_SA(0, 1), a2 + hstep, voffA);
            PG8_WAIT_L(8); PG8_BAR; PG8_WAIT_L(0); PG8_MMA(0, 0, At, B0); PG8_BAR; PG8_SCHED;
            PG8_LDB(B1, 1, 1); PG8_STAGE(PG8_SB(1, 0), b3, voffB);
            PG8_BAR; PG8_WAIT_L(0); PG8_MMA(0, 1, At, B1); PG8_BAR;
            PG8_LDA(At, 1, 1); PG8_STAGE(PG8_SA(1, 0), a3, voffA);
            PG8_BAR; PG8_WAIT_L(0); PG8_MMA(1, 0, At, B0); PG8_BAR; PG8_SCHED;
            PG8_STAGE(PG8_SB(1, 1), b3 + hstep, voffB);
            PG8_WAIT_V(6); PG8_BAR; PG8_MMA(1, 1, At, B1); PG8_BAR;
            }
        }
        if constexpr (ALIGN_EPI) { if (wr == 0) PG8_BAR; }
        E(acc, cur, wr, wc, fr, fq);
        if (!has_next) break;
#pragma unroll
        for (int a = 0; a < 2; ++a)
#pragma unroll
            for (int b = 0; b < 2; ++b)
#pragma unroll
                for (int m = 0; m < 4; ++m)
#pragma unroll
                    for (int n = 0; n < 2; ++n) acc[a][b][m][n] = (f32x4){0.f, 0.f, 0.f, 0.f};
        cur = nxt; cA = nA; cB = nB; ++ui;
        if constexpr (ALIGN_EPI) { if (wr == 1) PG8_BAR; }
    }
    PG8_WAIT_V(0);
    if constexpr (!ALIGN_EPI) { if (wr == 0) PG8_BAR; }
    PG8_BAR;
#undef PG8_SA
#undef PG8_SB
#undef PG8_STAGE
#undef PG8_LDA
#undef PG8_LDB
#undef PG8_MMA
#undef PG8_WAIT_V
#undef PG8_WAIT_L
#undef PG8_BAR
#undef PG8_SCHED
}

struct StaticOrder {
    int nM, nN, nwg, G, c, pm_off; const char* A; const char* Bt; size_t tstep;
    __device__ void init(const void* A_, const void* Bt_, int M_, int N_, int K_, int G_, int c_, int pm_off_ = 0) { A = (const char*)A_; Bt = (const char*)Bt_; nM = M_ / BM; nN = N_ / BM; nwg = nM * nN; G = G_; c = c_; pm_off = pm_off_; tstep = (size_t)BM * K_ * 2; }
    __device__ bool next(int i, Unit& u) const {
        const long L = (long)i * G + c; if (L >= nwg) return false;
        int wgid = (int)L; { const int q = nwg / 8, r = nwg % 8, xcd = wgid % 8, off = wgid / 8; wgid = (xcd < r ? xcd * (q + 1) : r * (q + 1) + (xcd - r) * q) + off; }
        const int nig = 8 * nN, gid = wgid / nig, fm = gid * 8, gsz = (nM - fm) < 8 ? (nM - fm) : 8;
        u.pm = fm + ((wgid % nig) % gsz) + pm_off; u.pn = (wgid % nig) / gsz; u.aux = 0;
        u.A = A + (size_t)u.pm * tstep; u.B = Bt + (size_t)u.pn * tstep; return true;
    }
};
struct SplitOrder {
    int nks, nsub, G, c; const char* A; const char* Bt; size_t tstep;
    __device__ void init(const void* A_, const void* Bt_, int LD_, int nks_, int G_, int c_) { A = (const char*)A_; Bt = (const char*)Bt_; nks = nks_; nsub = 16 * nks_; G = G_; c = c_; tstep = (size_t)BM * LD_ * 2; }
    __device__ bool next(int i, Unit& u) const {
        const int L = i * G + c; if (L >= nsub) return false;
        const int ksl = L % nks, t = L / nks; u.pm = t >> 2; u.pn = t & 3; u.aux = ksl;
        u.A = A + (size_t)u.pm * tstep + (size_t)ksl * 512; u.B = Bt + (size_t)u.pn * tstep + (size_t)ksl * 512; return true;
    }
};
struct GroupedOrder {
    int nM, nN, nwg, G, c; const char* A; const char* Bt; size_t tstep, estep; const int* tile_e;
    __device__ void init(const void* A_, const void* Bt_, int ntiles, int N_, int K_, int G_, int c_, const int* te) { A = (const char*)A_; Bt = (const char*)Bt_; nM = ntiles; nN = N_ / BM; nwg = nM * nN; G = G_; c = c_; tstep = (size_t)BM * K_ * 2; estep = (size_t)N_ * K_ * 2; tile_e = te; }
    __device__ bool next(int i, Unit& u) const {
        const long L = (long)i * G + c; if (L >= nwg) return false;
        u.pm = (int)(L / nN); u.pn = (int)(L % nN); u.aux = __builtin_amdgcn_readfirstlane(tile_e[u.pm]);
        u.A = A + (size_t)u.pm * tstep; u.B = Bt + (size_t)u.aux * estep + (size_t)u.pn * tstep; return true;
    }
};

struct EpiBf16 {
    static constexpr bool PERM = true;
    bf16* O; int ldc;
    __device__ __forceinline__ void operator()(const f32x4 (&acc)[2][2][4][2], const Unit& u, int wr, int wc, int fr, int fq) const {
        const int row0 = u.pm * BM + wr * 64 + fr, col0 = u.pn * BM + wc * 32 + 8 * fq;
#pragma unroll
        for (int ai = 0; ai < 2; ++ai)
#pragma unroll
            for (int m = 0; m < 4; ++m) { bf16* rowp = O + (size_t)(row0 + ai * HALF + m * 16) * ldc + col0;
#pragma unroll
                for (int bj = 0; bj < 2; ++bj) { const f32x4 v0 = acc[ai][bj][m][0], v1 = acc[ai][bj][m][1];
                    u32x4 w; w.x = cvt_pk_bf16(v0[0], v0[1]); w.y = cvt_pk_bf16(v0[2], v0[3]); w.z = cvt_pk_bf16(v1[0], v1[1]); w.w = cvt_pk_bf16(v1[2], v1[3]);
                    *(u32x4*)(rowp + bj * HALF) = w; } }
    }
};
struct EpiResid {
    static constexpr bool PERM = false;
    float* X; const float* mod; int gsel;
    __device__ __forceinline__ void operator()(const f32x4 (&acc)[2][2][4][2], const Unit& u, int wr, int wc, int fr, int fq) const {
        const int row0 = u.pm * BM + wr * 64 + fr, col0 = u.pn * BM + wc * 32 + 4 * fq;
        const int r = u.pm < 4 ? 4 : ((u.pm - 4) >> 4);
        const float* g = mod + (size_t)r * 6 * D + gsel * D;
        f32x4 gv[2][2];
#pragma unroll
        for (int bj = 0; bj < 2; ++bj)
#pragma unroll
            for (int n = 0; n < 2; ++n) gv[bj][n] = *(const f32x4*)(g + col0 + bj * HALF + n * 16);
#pragma unroll
        for (int ai = 0; ai < 2; ++ai)
#pragma unroll
            for (int m = 0; m < 4; ++m) { float* rowp = X + (size_t)(row0 + ai * HALF + m * 16) * D + col0;
#pragma unroll
                for (int bj = 0; bj < 2; ++bj)
#pragma unroll
                    for (int n = 0; n < 2; ++n) { f32x4 x = *(f32x4*)(rowp + bj * HALF + n * 16); x += gv[bj][n] * acc[ai][bj][m][n]; *(f32x4*)(rowp + bj * HALF + n * 16) = x; } }
    }
};
struct EpiSwiglu {
    static constexpr bool PERM = false;
    bf16* Hd; int ldh;
    __device__ __forceinline__ void operator()(const f32x4 (&acc)[2][2][4][2], const Unit& u, int wr, int wc, int fr, int fq) const {
        const int row0 = u.pm * BM + wr * 64 + fr, col0 = u.pn * 128 + wc * 16 + 4 * fq;
#pragma unroll
        for (int ai = 0; ai < 2; ++ai)
#pragma unroll
            for (int m = 0; m < 4; ++m) { bf16* rowp = Hd + (size_t)(row0 + ai * HALF + m * 16) * ldh + col0;
#pragma unroll
                for (int bj = 0; bj < 2; ++bj) { const f32x4 a = acc[ai][bj][m][0], b = acc[ai][bj][m][1];
                    float h[4];
#pragma unroll
                    for (int j = 0; j < 4; ++j) h[j] = a[j] * __builtin_amdgcn_rcpf(1.0f + __builtin_amdgcn_exp2f(-1.4426950408889634f * a[j])) * b[j];
                    u32x2 w; w.x = cvt_pk_bf16(h[0], h[1]); w.y = cvt_pk_bf16(h[2], h[3]);
                    *(u32x2*)(rowp + bj * 64) = w; } }
    }
};
struct EpiF32 {
    static constexpr bool PERM = false;
    float* C; int ldc;
    __device__ __forceinline__ void operator()(const f32x4 (&acc)[2][2][4][2], const Unit& u, int wr, int wc, int fr, int fq) const {
        const int row0 = u.pm * BM + wr * 64 + fr, col0 = u.pn * BM + wc * 32 + 4 * fq;
#pragma unroll
        for (int ai = 0; ai < 2; ++ai)
#pragma unroll
            for (int m = 0; m < 4; ++m) { float* rowp = C + (size_t)(row0 + ai * HALF + m * 16) * ldc + col0;
#pragma unroll
                for (int bj = 0; bj < 2; ++bj)
#pragma unroll
                    for (int n = 0; n < 2; ++n) *(f32x4*)(rowp + bj * HALF + n * 16) = acc[ai][bj][m][n]; }
    }
};
struct EpiSlab {
    static constexpr bool PERM = false;
    float* C;
    __device__ __forceinline__ void operator()(const f32x4 (&acc)[2][2][4][2], const Unit& u, int wr, int wc, int fr, int fq) const {
        const int row0 = u.pm * BM + wr * 64 + fr, col0 = u.pn * BM + wc * 32 + 4 * fq;
        float* base = C + (size_t)u.aux * MC * D;
#pragma unroll
        for (int ai = 0; ai < 2; ++ai)
#pragma unroll
            for (int m = 0; m < 4; ++m) { float* rowp = base + (size_t)(row0 + ai * HALF + m * 16) * D + col0;
#pragma unroll
                for (int bj = 0; bj < 2; ++bj)
#pragma unroll
                    for (int n = 0; n < 2; ++n) *(f32x4*)(rowp + bj * HALF + n * 16) = acc[ai][bj][m][n]; }
    }
};
}

#define XB_TMO      128
#define XB_XCNT(j)  (256  + 64 * (j))
#define XB_XSUB(j)  (1280 + 64 * (j))
#define XB_XGEN(j)  (2304 + 64 * (j))
#define XB_TOP      3328
#define XB_TOPGEN   3392
#define XCD_BAR_WORDS 3456
#define XB_SPIN_CAP (1u << 22)
__device__ __forceinline__ unsigned xb_ld(unsigned* p)              { return __hip_atomic_load(p, __ATOMIC_RELAXED, __HIP_MEMORY_SCOPE_AGENT); }
__device__ __forceinline__ unsigned xb_add(unsigned* p, unsigned v) { return __hip_atomic_fetch_add(p, v, __ATOMIC_RELAXED, __HIP_MEMORY_SCOPE_AGENT); }
__device__ __forceinline__ unsigned xb_xcc_id() { return (unsigned)__builtin_amdgcn_s_getreg((3 << 11) | 20) & 0xFu; }
#define XB_SPIN(cond, bar) do { unsigned _sp = 0; while (cond) { __builtin_amdgcn_s_sleep(1); \
    if ((++_sp & 255u) == 0u) { if (xb_ld(&(bar)[XB_TMO])) break; if (_sp > XB_SPIN_CAP) { atomicAdd(&(bar)[XB_TMO], 1u); break; } } } } while (0)
struct XcdBarrier { unsigned* bar; unsigned x; volatile LAS unsigned* st; };
__device__ __forceinline__ XcdBarrier xcd_barrier_post(unsigned* bar, volatile LAS unsigned* st) {
    XcdBarrier b; b.bar = bar; b.x = xb_xcc_id(); b.st = st;
    if (threadIdx.x == 0) (void)xb_add(&bar[XB_XCNT(b.x)], 1u);
    return b;
}
__device__ __forceinline__ void xcd_barrier_complete(unsigned* bar, unsigned x, unsigned& nloc, unsigned& nx) {
    const unsigned G = gridDim.x * gridDim.y * gridDim.z;
    unsigned sum, cnt, mine, sp = 0u;
    for (;;) {
        sum = 0u; cnt = 0u; mine = 0u;
#pragma unroll
        for (unsigned j = 0; j < 16; ++j) { const unsigned c = xb_ld(&bar[XB_XCNT(j)]); sum += c; cnt += (c > 0u) ? 1u : 0u; mine = (j == x) ? c : mine; }
        if (sum == G) break;
        __builtin_amdgcn_s_sleep(1);
        if ((++sp & 255u) == 0u) { if (xb_ld(&bar[XB_TMO])) break; if (sp > XB_SPIN_CAP) { atomicAdd(&bar[XB_TMO], 1u); break; } }
    }
    nloc = mine > 0u ? mine : 1u; nx = cnt > 0u ? cnt : 1u;
}
__device__ __forceinline__ void xcd_barrier(const XcdBarrier& b) {
    asm volatile("s_waitcnt vmcnt(0)" ::: "memory");
    __syncthreads();
    if (threadIdx.x == 0) {
        unsigned* bar = b.bar; unsigned bx = b.x;
        asm volatile("" : "+s"(bar), "+s"(bx));
        __builtin_amdgcn_s_waitcnt(0);
        unsigned nloc = b.st[0], nx = b.st[1];
        if (nloc == 0u) { xcd_barrier_complete(bar, bx, nloc, nx); b.st[0] = nloc; b.st[1] = nx; }
        const unsigned old = xb_add(&bar[XB_XSUB(bx)], 1u);
        const unsigned gen = old / nloc;
        if (old + 1u == (gen + 1u) * nloc) {
            __builtin_amdgcn_fence(__ATOMIC_RELEASE, "agent");
            asm volatile("s_waitcnt vmcnt(0)" ::: "memory");
            const unsigned og = xb_add(&bar[XB_TOP], 1u);
            const unsigned tg = og / nx;
            if (og + 1u == (tg + 1u) * nx) xb_add(&bar[XB_TOPGEN], 1u);
            else XB_SPIN(xb_ld(&bar[XB_TOPGEN]) == tg, bar);
            __builtin_amdgcn_fence(__ATOMIC_ACQUIRE, "agent");
            xb_add(&bar[XB_XGEN(bx)], 1u);
            asm volatile("s_waitcnt vmcnt(0)" ::: "memory");
        } else {
            XB_SPIN(xb_ld(&bar[XB_XGEN(bx)]) == gen, bar);
            __builtin_amdgcn_fence(__ATOMIC_ACQUIRE, "agent");
            asm volatile("s_waitcnt vmcnt(0)" ::: "memory");
        }
    }
    __syncthreads();
}

constexpr int NWAVES = 8, NTHR = 512;
constexpr int RING_BYTES = 131072, MISC_OFF = RING_BYTES + 320, LDS_BYTES = 147456;

struct Inputs {
    const float *x, *c, *ctx, *c_ctx, *ada_w, *ada_b, *norm1_g, *w_in, *ret_decay, *ret_gn_g, *gdn_conv_w, *gdn_a_log, *gdn_dt_bias, *gdn_norm_g, *swa_sink, *w_out, *norm2_g,
        *ffn_w1, *ffn_w3, *ffn_w2, *router_w, *moe_w1, *moe_w3, *moe_w2, *final_g;
};
struct Args { Inputs in; float* out; unsigned char* ws; int ph_lo, ph_hi; };
static_assert(sizeof(Args) == 25 * 8 + 8 + 8 + 8, "no padding");


__device__ __forceinline__ const float* ld_ptr(const LAS unsigned long long* t, int i) { const unsigned long long v = t[i]; const unsigned lo = __builtin_amdgcn_readfirstlane((unsigned)v), hi = __builtin_amdgcn_readfirstlane((unsigned)(v >> 32)); return (const float*)(GAS const float*)(((unsigned long long)hi << 32) | lo); }
__device__ __forceinline__ Inputs load_inputs(const LAS unsigned long long* t) {
    Inputs in; const float** ip = (const float**)&in;
#pragma unroll
    for (int i = 0; i < 25; ++i) ip[i] = ld_ptr(t, i);
    return in;
}
struct Frame {
    LAS unsigned char* lds;
    int tid, lane, wave, G, gw, NGW, bid;
    unsigned char* ws;
};

template <class SrcF>
__device__ __forceinline__ void transpose_item(const SrcF& src, int K, bf16* WT, LAS float* scr, int k0, int n0, int lane) {
#pragma unroll
    for (int i = 0; i < 8; ++i) { const int row = 4 * i + (lane >> 4), col = 4 * (lane & 15); *(LAS f32x4*)(scr + row * 68 + col) = src(k0 + row, n0 + col); }
    LDS_WAIT(); asm volatile("" ::: "memory");
#pragma unroll
    for (int j = 0; j < 4; ++j) { const int ch = j * 64 + lane, n = ch >> 2, c8 = ch & 3; const LAS float* sp = scr + (8 * c8) * 68 + n;
        u32x4 o; o.x = cvtpk(sp[0 * 68], sp[1 * 68]); o.y = cvtpk(sp[2 * 68], sp[3 * 68]); o.z = cvtpk(sp[4 * 68], sp[5 * 68]); o.w = cvtpk(sp[6 * 68], sp[7 * 68]);
        *(u32x4*)(WT + (size_t)(n0 + n) * K + k0 + 8 * c8) = o; }
    LDS_WAIT(); asm volatile("" ::: "memory");
}
struct SrcPlain { const float* W; int ld; __device__ __forceinline__ f32x4 operator()(int k, int n) const { return *(const f32x4*)(W + (size_t)k * ld + n); } };
struct SrcWin { const float* W; __device__ __forceinline__ f32x4 operator()(int k, int n) const { return *(const f32x4*)(W + (size_t)k * INC + (n < 2048 ? n : n + 16)); } };
struct SrcGU { const float* W1; const float* W3; int ld; __device__ __forceinline__ f32x4 operator()(int k, int n) const { const int g = n >> 5, i = n & 31; const ptrdiff_t d = (i < 16) ? (ptrdiff_t)0 : (W3 - W1); return *(const f32x4*)(W1 + d + (ptrdiff_t)k * ld + 16 * g + (i & 15)); } };

__device__ __forceinline__ void convert_moe_layer(Frame& F, const Inputs& in, int mi) {
    LAS float* scr = (LAS float*)(F.lds + F.wave * 16384);
    bf16* mw13 = (bf16*)(F.ws + WS_MW13); bf16* mw2 = (bf16*)(F.ws + WS_MW2);
    constexpr int I13 = (D / 32) * (2 * EF / 64), I2 = (EF / 32) * (D / 64);
    for (int it = F.gw; it < NE * (I13 + I2); it += F.NGW) {
        const int e = it / (I13 + I2); int r = it % (I13 + I2);
        const size_t wo = ((size_t)mi * NE + e) * (size_t)D * EF;
        if (r < I13) { const int nblk = 2 * EF / 64; SrcGU s{in.moe_w1 + wo, in.moe_w3 + wo, EF}; transpose_item(s, D, mw13 + (size_t)e * 2 * EF * D, scr, 32 * (r / nblk), 64 * (r % nblk), F.lane); }
        else { r -= I13; const int nblk = D / 64; SrcPlain s{in.moe_w2 + wo, D}; transpose_item(s, EF, mw2 + (size_t)e * D * EF, scr, 32 * (r / nblk), 64 * (r % nblk), F.lane); }
    }
}

__device__ __forceinline__ void phase_prologue(Frame& F, const Inputs& in) {
    LAS float* scr = (LAS float*)(F.lds + F.wave * 16384);
    {
        constexpr int I_IN = (D / 32) * (NP / 64), I_OUT = (D / 32) * (D / 64), I_13 = (D / 32) * (2 * FF / 64), I_2 = (FF / 32) * (D / 64);
        constexpr int PER_L = I_IN + I_OUT, PER_F = I_13 + I_2, TOT = DEPTH * PER_L + 2 * PER_F;
        for (int it = F.gw; it < TOT; it += F.NGW) {
            if (it < DEPTH * PER_L) { const int l = it / PER_L; int r = it % PER_L;
                if (r < I_IN) { const int nblk = NP / 64; SrcWin s{in.w_in + (size_t)l * D * INC}; transpose_item(s, D, (bf16*)(F.ws + WS_WIN) + (size_t)l * NP * D, scr, 32 * (r / nblk), 64 * (r % nblk), F.lane); }
                else { r -= I_IN; const int nblk = D / 64; SrcPlain s{in.w_out + (size_t)l * D * D, D}; transpose_item(s, D, (bf16*)(F.ws + WS_WOUT) + (size_t)l * D * D, scr, 32 * (r / nblk), 64 * (r % nblk), F.lane); }
            } else { const int q = it - DEPTH * PER_L; const int i = q / PER_F; int r = q % PER_F;
                if (r < I_13) { const int nblk = 2 * FF / 64; SrcGU s{in.ffn_w1 + (size_t)i * D * FF, in.ffn_w3 + (size_t)i * D * FF, FF}; transpose_item(s, D, (bf16*)(F.ws + WS_W13) + (size_t)i * 2 * FF * D, scr, 32 * (r / nblk), 64 * (r % nblk), F.lane); }
                else { r -= I_13; const int nblk = D / 64; SrcPlain s{in.ffn_w2 + (size_t)i * FF * D, D}; transpose_item(s, FF, (bf16*)(F.ws + WS_W2) + (size_t)i * D * FF, scr, 32 * (r / nblk), 64 * (r % nblk), F.lane); }
            }
        }
    }
    convert_moe_layer(F, in, 0);
    {
        __syncthreads();
        LAS float* sc = (LAS float*)F.lds;
        LAS float* red = (LAS float*)(F.lds + 32768);
        for (int i = F.tid; i < 5 * D; i += NTHR) { const int r = i / D, k = i % D; const float v = r < 4 ? in.c[r * D + k] : in.c_ctx[k]; sc[i] = siluf(v); }
        __syncthreads();
        float* mod = (float*)(F.ws + WS_MOD);
        for (int u = F.bid; u < DEPTH * 96; u += F.G) {
            const int l = u / 96, n = (u % 96) * 64 + F.lane;
            const float* w = in.ada_w + (size_t)l * D * 6 * D + n;
            float a[5] = {0.f, 0.f, 0.f, 0.f, 0.f};
            for (int k = F.wave * 128; k < F.wave * 128 + 128; ++k) { const float wv = w[(size_t)k * 6 * D];
#pragma unroll
                for (int r = 0; r < 5; ++r) a[r] += sc[r * D + k] * wv; }
#pragma unroll
            for (int r = 0; r < 5; ++r) red[(F.wave * 5 + r) * 64 + F.lane] = a[r];
            __syncthreads();
            if (F.tid < 320) { const int r = F.tid / 64, ln = F.tid % 64; float s = 0.f;
#pragma unroll
                for (int w8 = 0; w8 < 8; ++w8) s += red[(w8 * 5 + r) * 64 + ln];
                const int nn = (u % 96) * 64 + ln;
                mod[((size_t)l * 5 + r) * 6 * D + nn] = s + in.ada_b[(size_t)l * 6 * D + nn]; }
            __syncthreads();
        }
    }
    if (F.bid == 0) { float* rp = (float*)(F.ws + WS_ROPE);
        for (int i = F.tid; i < 64 * 16; i += NTHR) { const int pos = i / 16, fi = i % 16; const double inv = pow(10000.0, -(double)fi / 16.0), ang = (double)pos * inv; rp[2 * i] = (float)cos(ang); rp[2 * i + 1] = (float)sin(ang); } }
}

__device__ __forceinline__ int mod_row(int m) { return m < MC ? 4 : ((m - MC) >> 12); }

template <int MODE>
__device__ __forceinline__ void phase_token(Frame& F, const Inputs& in, int layer, bool first_from_input, bool combine_moe, bool moe_router, float* out) {
    float* XS = (float*)(F.ws + WS_XS);
    bf16* H = (bf16*)(F.ws + WS_H);
    const float* mod = (const float*)(F.ws + WS_MOD) + (size_t)(layer < DEPTH ? layer : DEPTH - 1) * 5 * 6 * D;
    const float* modprev = (const float*)(F.ws + WS_MOD) + (size_t)(layer > 0 ? layer - 1 : 0) * 5 * 6 * D;
    const int* TKE = (const int*)(F.ws + WS_TKE); const float* TKG = (const float*)(F.ws + WS_TKG); const int* TOKROW = (const int*)(F.ws + WS_TOKROW);
    const float* YM = (const float*)(F.ws + WS_YM);
    LAS float* wl = (LAS float*)F.lds;
    if (MODE == 0) { __syncthreads(); const float* w = in.w_in + (size_t)layer * D * INC + 2048; for (int i = F.tid; i < D * 16; i += NTHR) { const int k = i >> 4, c = i & 15, kp = ((k >> 8) * 4 + (k & 3)) * 64 + ((k >> 2) & 63); wl[((c >> 2) * 1024 + kp) * 4 + (c & 3)] = w[(size_t)k * INC + c]; } __syncthreads(); }
    LAS int* lcnt = (LAS int*)(F.lds + 61440);
    if (MODE == 1 && moe_router) { __syncthreads(); if (F.tid < 8) lcnt[F.tid] = 0; const float* w = in.router_w + (size_t)(layer >> 1) * D * NE; for (int i = F.tid; i < D * NE; i += NTHR) { const int k = i >> 3, c = i & 7, kp = ((k >> 8) * 4 + (k & 3)) * 64 + ((k >> 2) & 63); wl[((c >> 2) * 1024 + kp) * 4 + (c & 3)] = w[i]; } __syncthreads(); }
    const float* gain = MODE == 0 ? in.norm1_g + (size_t)layer * D : (MODE == 1 ? in.norm2_g + (size_t)layer * D : in.final_g);
    const int m_lo = (MODE == 2) ? MC : 0;
    for (int m = m_lo + F.gw; m < M; m += F.NGW) {
        const int r = mod_row(m);
        f32x4 v[4];
        const float* xrow = first_from_input ? (m < MC ? in.ctx + (size_t)m * D : in.x + (size_t)(m - MC) * D) : XS + (size_t)m * D;
#pragma unroll
        for (int j = 0; j < 4; ++j) v[j] = *(const f32x4*)(xrow + 4 * F.lane + 256 * j);
        bool wrote = first_from_input;
        if (combine_moe && !(layer == DEPTH && m < MC)) {
            const int r0 = TOKROW[2 * m], r1 = TOKROW[2 * m + 1]; const float g0 = TKG[2 * m], g1 = TKG[2 * m + 1];
            const float* gt = modprev + (size_t)r * 6 * D + 5 * D;
#pragma unroll
            for (int j = 0; j < 4; ++j) { const f32x4 y0 = *(const f32x4*)(YM + (size_t)r0 * D + 4 * F.lane + 256 * j), y1 = *(const f32x4*)(YM + (size_t)r1 * D + 4 * F.lane + 256 * j);
                const f32x4 gg = *(const f32x4*)(gt + 4 * F.lane + 256 * j); v[j] += gg * (g0 * y0 + g1 * y1); }
            wrote = true;
        }
        if (wrote && MODE != 2) {
#pragma unroll
            for (int j = 0; j < 4; ++j) *(f32x4*)(XS + (size_t)m * D + 4 * F.lane + 256 * j) = v[j];
        }
        float ss = 0.f;
#pragma unroll
        for (int j = 0; j < 4; ++j) ss += (v[j].x * v[j].x + v[j].y * v[j].y) + (v[j].z * v[j].z + v[j].w * v[j].w);
        const float rstd = 1.0f / sqrtf(wave_sum(ss) * (1.0f / D) + EPS);
        if (MODE == 2) {
#pragma unroll
            for (int j = 0; j < 4; ++j) { const f32x4 g = *(const f32x4*)(gain + 4 * F.lane + 256 * j); *(f32x4*)(out + (size_t)(m - MC) * D + 4 * F.lane + 256 * j) = v[j] * rstd * g; }
            continue;
        }
        const float* sh = mod + (size_t)r * 6 * D + (MODE == 0 ? 0 : 3) * D; const float* scl = sh + D;
        f32x4 h[4];
#pragma unroll
        for (int j = 0; j < 4; ++j) { const f32x4 g = *(const f32x4*)(gain + 4 * F.lane + 256 * j), s1 = *(const f32x4*)(scl + 4 * F.lane + 256 * j), s0 = *(const f32x4*)(sh + 4 * F.lane + 256 * j);
            h[j] = v[j] * rstd * g * (1.0f + s1) + s0;
            u32x2 w; w.x = pk2(h[j].x, h[j].y); w.y = pk2(h[j].z, h[j].w); *(u32x2*)(H + (size_t)m * D + 4 * F.lane + 256 * j) = w; }
        if (MODE == 0) {
            float a[16];
#pragma unroll
            for (int c = 0; c < 16; ++c) a[c] = 0.f;
#pragma unroll
            for (int j = 0; j < 4; ++j)
#pragma unroll
                for (int e = 0; e < 4; ++e) { const int kp = (j * 4 + e) * 64 + F.lane; const float hv = h[j][e];
#pragma unroll
                    for (int q = 0; q < 4; ++q) { const f32x4 w = *(const LAS f32x4*)(wl + (q * 1024 + kp) * 4); a[4 * q] += hv * w.x; a[4 * q + 1] += hv * w.y; a[4 * q + 2] += hv * w.z; a[4 * q + 3] += hv * w.w; } }
            float mine = 0.f;
#pragma unroll
            for (int c = 0; c < 16; ++c) { const float s = wave_sum(a[c]); mine = (F.lane == c) ? s : mine; }
            if (F.lane < 16) ((float*)(F.ws + WS_AB))[(size_t)m * 16 + F.lane] = mine;
        }
        if (MODE == 1 && moe_router) {
            float a[8];
#pragma unroll
            for (int c = 0; c < 8; ++c) a[c] = 0.f;
#pragma unroll
            for (int j = 0; j < 4; ++j)
#pragma unroll
                for (int e = 0; e < 4; ++e) { const int kp = (j * 4 + e) * 64 + F.lane; const float hv = h[j][e];
#pragma unroll
                    for (int q = 0; q < 2; ++q) { const f32x4 w = *(const LAS f32x4*)(wl + (q * 1024 + kp) * 4); a[4 * q] += hv * w.x; a[4 * q + 1] += hv * w.y; a[4 * q + 2] += hv * w.z; a[4 * q + 3] += hv * w.w; } }
#pragma unroll
            for (int c = 0; c < 8; ++c) a[c] = wave_sum(a[c]);
            int i0 = 0; float l0 = a[0];
#pragma unroll
            for (int c = 1; c < 8; ++c) if (a[c] > l0) { l0 = a[c]; i0 = c; }
            int i1 = -1; float l1 = -3.0e38f;
#pragma unroll
            for (int c = 0; c < 8; ++c) if (c != i0 && a[c] > l1) { l1 = a[c]; i1 = c; }
            const float e1 = fexp(l1 - l0), g0 = 1.0f / (1.0f + e1), g1 = e1 / (1.0f + e1);
            if (F.lane == 0) { ((int*)(F.ws + WS_TKE))[2 * m] = i0; ((int*)(F.ws + WS_TKE))[2 * m + 1] = i1; ((float*)(F.ws + WS_TKG))[2 * m] = g0; ((float*)(F.ws + WS_TKG))[2 * m + 1] = g1; }
        }
    }
    (void)TKE;
}


template <int MODE>
__device__ __forceinline__ void phase_token2(Frame& F, const Inputs& in, int layer, bool first_from_input, bool combine_moe, bool moe_router, float* out, int route_lo = 0, int nslab = 0) {
    float* XS = (float*)(F.ws + WS_XS);
    bf16* H = (bf16*)(F.ws + WS_H);
    const float* mod = (const float*)(F.ws + WS_MOD) + (size_t)(layer < DEPTH ? layer : DEPTH - 1) * 5 * 6 * D;
    const float* modprev = (const float*)(F.ws + WS_MOD) + (size_t)(layer > 0 ? layer - 1 : 0) * 5 * 6 * D;
    const float* TKG = (const float*)(F.ws + WS_TKG); const int* TOKROW = (const int*)(F.ws + WS_TOKROW);
    const float* YM = (const float*)(F.ws + WS_YM);
    LAS float* wl = (LAS float*)F.lds;
    const int lane = F.lane;
    if (MODE == 0) PB(8);
    if (MODE == 0) { __syncthreads(); const float* w = in.w_in + (size_t)layer * D * INC + 2048;
#pragma unroll
        for (int n = 0; n < 8; ++n) { const int k = (F.tid >> 2) + 128 * n, q4 = F.tid & 3, kp = ((k >> 8) * 4 + (k & 3)) * 64 + ((k >> 2) & 63);
            *(LAS f32x4*)(wl + (q4 * 1024 + kp) * 4) = *(const f32x4*)(w + (size_t)k * INC + 4 * q4); }
        __syncthreads(); }
    LAS int* lcnt = (LAS int*)(F.lds + 61440);
    if (MODE == 1 && moe_router) { __syncthreads(); if (F.tid < 8) lcnt[F.tid] = 0; const float* w = in.router_w + (size_t)(layer >> 1) * D * NE;
#pragma unroll
        for (int n = 0; n < 4; ++n) { const int k = (F.tid >> 1) + 256 * n, q4 = F.tid & 1, kp = ((k >> 8) * 4 + (k & 3)) * 64 + ((k >> 2) & 63);
            *(LAS f32x4*)(wl + (q4 * 1024 + kp) * 4) = *(const f32x4*)(w + (size_t)k * NE + 4 * q4); }
        __syncthreads(); }
    if (MODE == 0) PE(8);
    if (MODE == 0) PB(9);
    if (MODE == 1) PB(10);
    const float* gain = MODE == 0 ? in.norm1_g + (size_t)layer * D : (MODE == 1 ? in.norm2_g + (size_t)layer * D : in.final_g);
    const bool has_ctx = (MODE != 2) && F.gw < MC;
    const int r_beg = MC + (int)(((long)F.gw * ML) / F.NGW), r_end = MC + (int)(((long)(F.gw + 1) * ML) / F.NGW);
    if (nslab > 0 && has_ctx) {
        const float* sb = (const float*)(F.ws + WS_R1 + 100 * MiB); const float* gsrc = (MODE == 1 ? mod + (size_t)4 * 6 * D + 2 * D : modprev + (size_t)4 * 6 * D + 5 * D);
        { const int m = F.gw;
#pragma unroll
            for (int j = 0; j < 4; ++j) { f32x4 a0 = (f32x4){0.f, 0.f, 0.f, 0.f};
                for (int sidx = 0; sidx < nslab; ++sidx) a0 += *(const f32x4*)(sb + ((size_t)sidx * MC + m) * D + 4 * lane + 256 * j);
                float* xp = XS + (size_t)m * D + 4 * lane + 256 * j; *(f32x4*)xp = *(const f32x4*)xp + *(const f32x4*)(gsrc + 4 * lane + 256 * j) * a0; } }
        asm volatile("s_waitcnt vmcnt(0)" ::: "memory");
    }
    f32x4 gv[4], av[4], bv[4], gt[4];
#pragma unroll
    for (int j = 0; j < 4; ++j) gv[j] = *(const f32x4*)(gain + 4 * lane + 256 * j);
    int rcur = -1;
    for (int m0 = has_ctx ? r_beg - 1 : r_beg; m0 < r_end; m0 += 2) {
        const bool isc = m0 < r_beg;
        const int ma = isc ? F.gw : m0; const bool two = !isc && ma + 1 < r_end; const int m1 = two ? ma + 1 : ma;
        if (isc) m0 -= 1;
        const int r = mod_row(ma);
        const bool same = mod_row(m1) == r;
        const int mm1 = same ? m1 : ma; const bool do1 = two && same;
        if (!same) m0 -= 1;
        if (r != rcur) { rcur = r;
            if (MODE != 2) { const float* sh = mod + (size_t)r * 6 * D + (MODE == 0 ? 0 : 3) * D;
#pragma unroll
                for (int j = 0; j < 4; ++j) { const f32x4 s1 = *(const f32x4*)(sh + D + 4 * lane + 256 * j); av[j] = gv[j] * (1.0f + s1); bv[j] = *(const f32x4*)(sh + 4 * lane + 256 * j); } }
            if (combine_moe) {
#pragma unroll
                for (int j = 0; j < 4; ++j) gt[j] = *(const f32x4*)(modprev + (size_t)r * 6 * D + 5 * D + 4 * lane + 256 * j); } }
        const int mr[2] = {ma, mm1};
        f32x4 v[2][4];
        int t0[2], t1[2]; float g0[2], g1[2];
        if (combine_moe) {
#pragma unroll
            for (int p = 0; p < 2; ++p) { t0[p] = TOKROW[2 * mr[p]]; t1[p] = TOKROW[2 * mr[p] + 1]; g0[p] = TKG[2 * mr[p]]; g1[p] = TKG[2 * mr[p] + 1]; } }
#pragma unroll
        for (int p = 0; p < 2; ++p) { const int m = mr[p];
            const float* xrow = first_from_input ? (m < MC ? in.ctx + (size_t)m * D : in.x + (size_t)(m - MC) * D) : XS + (size_t)m * D;
#pragma unroll
            for (int j = 0; j < 4; ++j) v[p][j] = *(const f32x4*)(xrow + 4 * lane + 256 * j); }
        if (combine_moe) {
#pragma unroll
            for (int p = 0; p < 2; ++p)
#pragma unroll
                for (int j = 0; j < 4; ++j) { const f32x4 y0 = *(const f32x4*)(YM + (size_t)t0[p] * D + 4 * lane + 256 * j), y1 = *(const f32x4*)(YM + (size_t)t1[p] * D + 4 * lane + 256 * j);
                    v[p][j] += gt[j] * (g0[p] * y0 + g1[p] * y1); } }
        if ((first_from_input || combine_moe) && MODE != 2) {
#pragma unroll
            for (int p = 0; p < 2; ++p) if (p == 0 || do1) {
#pragma unroll
                for (int j = 0; j < 4; ++j) *(f32x4*)(XS + (size_t)mr[p] * D + 4 * lane + 256 * j) = v[p][j]; } }
        float rstd[2];
#pragma unroll
        for (int p = 0; p < 2; ++p) { float ss = 0.f;
#pragma unroll
            for (int j = 0; j < 4; ++j) ss += (v[p][j].x * v[p][j].x + v[p][j].y * v[p][j].y) + (v[p][j].z * v[p][j].z + v[p][j].w * v[p][j].w);
            rstd[p] = 1.0f / sqrtf(wave_sum(ss) * (1.0f / D) + EPS); }
        if (MODE == 2) {
#pragma unroll
            for (int p = 0; p < 2; ++p) if (p == 0 || do1) {
#pragma unroll
                for (int j = 0; j < 4; ++j) *(f32x4*)(out + (size_t)(mr[p] - MC) * D + 4 * lane + 256 * j) = v[p][j] * rstd[p] * gv[j]; }
            continue; }
        f32x4 h[2][4];
#pragma unroll
        for (int p = 0; p < 2; ++p)
#pragma unroll
            for (int j = 0; j < 4; ++j) { h[p][j] = v[p][j] * rstd[p] * av[j] + bv[j];
                if (p == 0 || do1) { u32x2 w; w.x = cvtpk(h[p][j].x, h[p][j].y); w.y = cvtpk(h[p][j].z, h[p][j].w); *(u32x2*)(H + (size_t)mr[p] * D + 4 * lane + 256 * j) = w; } }
        if (MODE == 0 || (MODE == 1 && moe_router)) {
            constexpr int NC = (MODE == 0) ? 16 : 8;
            float a[2][NC];
#pragma unroll
            for (int p = 0; p < 2; ++p)
#pragma unroll
                for (int c = 0; c < NC; ++c) a[p][c] = 0.f;
#pragma unroll
            for (int j = 0; j < 4; ++j)
#pragma unroll
                for (int e = 0; e < 4; ++e) { const int kp = (j * 4 + e) * 64 + lane;
#pragma unroll
                    for (int q = 0; q < NC / 4; ++q) { const f32x4 w = *(const LAS f32x4*)(wl + (q * 1024 + kp) * 4);
#pragma unroll
                        for (int p = 0; p < 2; ++p) { const float hv = h[p][j][e]; a[p][4 * q] += hv * w.x; a[p][4 * q + 1] += hv * w.y; a[p][4 * q + 2] += hv * w.z; a[p][4 * q + 3] += hv * w.w; } } }
#pragma unroll
            for (int p = 0; p < 2; ++p) {
#pragma unroll
                for (int c = 0; c < NC; ++c) a[p][c] = wave_sum(a[p][c]); }
#pragma unroll
            for (int p = 0; p < 2; ++p) if (p == 0 || do1) { const int m = mr[p];
                if (MODE == 0) { float mine = 0.f;
#pragma unroll
                    for (int c = 0; c < NC; ++c) mine = (lane == c) ? a[p][c] : mine;
                    if (lane < 16) ((float*)(F.ws + WS_AB))[(size_t)m * 16 + lane] = mine; }
                else { int i0 = 0; float l0 = a[p][0];
#pragma unroll
                    for (int c = 1; c < NC; ++c) if (a[p][c] > l0) { l0 = a[p][c]; i0 = c; }
                    int i1 = -1; float l1 = -3.0e38f;
#pragma unroll
                    for (int c = 0; c < NC; ++c) if (c != i0 && a[p][c] > l1) { l1 = a[p][c]; i1 = c; }
                    const float e1 = fexp(l1 - l0), gg0 = 1.0f / (1.0f + e1), gg1 = e1 / (1.0f + e1);
                    if (lane == 0 && m >= route_lo) { ((int*)(F.ws + WS_TKE))[2 * m] = i0; ((int*)(F.ws + WS_TKE))[2 * m + 1] = i1; ((float*)(F.ws + WS_TKG))[2 * m] = gg0; ((float*)(F.ws + WS_TKG))[2 * m + 1] = gg1;
                        ((int*)(F.ws + WS_TOKROW))[2 * m] = __hip_atomic_fetch_add(lcnt + i0, 1, __ATOMIC_RELAXED, __HIP_MEMORY_SCOPE_WORKGROUP); ((int*)(F.ws + WS_TOKROW))[2 * m + 1] = __hip_atomic_fetch_add(lcnt + i1, 1, __ATOMIC_RELAXED, __HIP_MEMORY_SCOPE_WORKGROUP); } } }
        }
    }
    if (MODE == 0) PE(9);
    if (MODE == 1) PE(10);
    if (MODE == 1 && moe_router) { __syncthreads(); if (F.tid < 8) ((int*)(F.ws + WS_TILEE + 4096))[F.bid * 8 + F.tid] = lcnt[F.tid]; }
}

__device__ __forceinline__ void phase_prep(Frame& F, const Inputs& in, int layer) {
    const bf16* P = (const bf16*)(F.ws + WS_R1 + R1_P);
    unsigned char* prep = F.ws + WS_R1 + R1_PREP;
    bf16* RQ = (bf16*)(prep + PREP_RQ); bf16* RK = (bf16*)(prep + PREP_RK); bf16* SQ = (bf16*)(prep + PREP_SQ); bf16* SK = (bf16*)(prep + PREP_SK); bf16* GD = (bf16*)(prep + PREP_GD);
    const float* rope = (const float*)(F.ws + WS_ROPE);
    const float* AB = (const float*)(F.ws + WS_AB); float* GB = (float*)(F.ws + WS_GB);
    const float* cw = in.gdn_conv_w + (size_t)layer * 5 * 768;
    const int lane = F.lane;
    for (int m = F.gw; m < M; m += F.NGW) {
        const bool lat = m >= MC; const int t = lat ? ((m - MC) & (TL - 1)) : (m & (TC - 1)); const int Tn = lat ? TL : TC;
        const bf16* prow = P + (size_t)m * NP;
        float cs = 1.f, sn = 0.f;
        if (lat) { const int j = lane & 31; const int pos = j < 16 ? (t >> 6) : (t & 63); const int fi = j & 15; cs = rope[(pos * 16 + fi) * 2]; sn = rope[(pos * 16 + fi) * 2 + 1]; if (lane < 32) sn = -sn; }
#pragma unroll
        for (int hh = 0; hh < 4; ++hh) { const float q = bf2f(prow[PC_RQ + hh * 64 + lane]), k = bf2f(prow[PC_RK + hh * 64 + lane]) * 0.125f;
            const float qp = __shfl_xor(q, 32), kp = __shfl_xor(k, 32);
            RQ[(size_t)m * 256 + hh * 64 + lane] = (bf16)f2bf(q * cs + qp * sn); RK[(size_t)m * 256 + hh * 64 + lane] = (bf16)f2bf(k * cs + kp * sn); }
#pragma unroll
        for (int hq = 0; hq < 8; ++hq) { const float q = bf2f(prow[PC_SQ + hq * 64 + lane]); const float qp = __shfl_xor(q, 32); SQ[(size_t)m * 512 + hq * 64 + lane] = (bf16)f2bf(q * cs + qp * sn); }
#pragma unroll
        for (int g = 0; g < 2; ++g) { const float k = bf2f(prow[PC_SK + g * 64 + lane]); const float kp = __shfl_xor(k, 32); SK[(size_t)m * 128 + g * 64 + lane] = (bf16)f2bf(k * cs + kp * sn); }
#pragma unroll 1
        for (int s = 0; s < 12; ++s) { const int c = s * 64 + lane; float y = 0.f;
#pragma unroll
            for (int j = 0; j < 5; ++j) { const int tt = t + j - 2; if (tt >= 0 && tt < Tn) y += cw[j * 768 + c] * bf2f(prow[(ptrdiff_t)(j - 2) * NP + PC_GQKV + c]); }
            y = siluf(y);
            if (s < 8) { const float n2 = wave_sum(y * y); y = y * (1.0f / sqrtf(n2 + EPS)); if (s < 4) y *= 0.125f; }
            GD[(size_t)m * 768 + c] = (bf16)f2bf(y); }
        if (lane < 16) { const int dh = lane & 7; const float a = AB[(size_t)m * 16 + lane];
            float o;
            if (lane < 8) { const float xx = a + in.gdn_dt_bias[layer * 8 + dh]; const float sp = fmaxf(xx, 0.f) + log1pf(fexp(-fabsf(xx))); o = -fexp(in.gdn_a_log[layer * 8 + dh]) * sp; }
            else o = 1.0f / (1.0f + fexp(-a));
            GB[(size_t)m * 16 + lane] = o; }
    }
}


__device__ __forceinline__ void unpack8(const u32x4 w, float (&v)[8]) {
#pragma unroll
    for (int e = 0; e < 4; ++e) { v[2 * e] = __uint_as_float(w[e] << 16); v[2 * e + 1] = __uint_as_float(w[e] & 0xffff0000u); } }
__device__ __forceinline__ u32x4 pack8(const float (&v)[8]) { u32x4 w; w.x = cvtpk(v[0], v[1]); w.y = cvtpk(v[2], v[3]); w.z = cvtpk(v[4], v[5]); w.w = cvtpk(v[6], v[7]); return w; }
__device__ __forceinline__ void phase_prep2(Frame& F, const Inputs& in, int layer) {
    const bf16* P = (const bf16*)(F.ws + WS_R1 + R1_P);
    unsigned char* prep = F.ws + WS_R1 + R1_PREP;
    bf16* RQ = (bf16*)(prep + PREP_RQ); bf16* RK = (bf16*)(prep + PREP_RK); bf16* SQ = (bf16*)(prep + PREP_SQ); bf16* SK = (bf16*)(prep + PREP_SK); bf16* GD = (bf16*)(prep + PREP_GD);
    const float* rope = (const float*)(F.ws + WS_ROPE);
    const float* AB = (const float*)(F.ws + WS_AB); float* GB = (float*)(F.ws + WS_GB);
    const float* cw = in.gdn_conv_w + (size_t)layer * 5 * 768;
    const int lane = F.lane, l3 = lane & 3, l31 = lane & 31;
    float wA[5][8], wB[5][8];
#pragma unroll
    for (int j = 0; j < 5; ++j) { const f32x4 a0 = *(const f32x4*)(cw + j * 768 + 8 * lane), a1 = *(const f32x4*)(cw + j * 768 + 8 * lane + 4), b0 = *(const f32x4*)(cw + j * 768 + 512 + 8 * l31), b1 = *(const f32x4*)(cw + j * 768 + 512 + 8 * l31 + 4);
#pragma unroll
        for (int x = 0; x < 4; ++x) { wA[j][x] = a0[x]; wA[j][4 + x] = a1[x]; wB[j][x] = b0[x]; wB[j][4 + x] = b1[x]; } }
    const float sgn = ((lane & 7) < 4) ? -1.0f : 1.0f;
    for (int m = F.gw; m < M; m += F.NGW) {
        const bool lat = m >= MC; const int t = lat ? ((m - MC) & (TL - 1)) : (m & (TC - 1)); const int Tn = lat ? TL : TC;
        const bf16* prow = P + (size_t)m * NP;
        float cs[8], sn[8];
        { const int pos = (l3 < 2) ? (t >> 6) : (t & 63); const float* rp = rope + (pos * 16 + 8 * (l3 & 1)) * 2;
          const f32x4 r0 = *(const f32x4*)(rp), r1 = *(const f32x4*)(rp + 4), r2 = *(const f32x4*)(rp + 8), r3 = *(const f32x4*)(rp + 12);
          cs[0] = r0[0]; sn[0] = r0[1]; cs[1] = r0[2]; sn[1] = r0[3]; cs[2] = r1[0]; sn[2] = r1[1]; cs[3] = r1[2]; sn[3] = r1[3];
          cs[4] = r2[0]; sn[4] = r2[1]; cs[5] = r2[2]; sn[5] = r2[3]; cs[6] = r3[0]; sn[6] = r3[1]; cs[7] = r3[2]; sn[7] = r3[3];
#pragma unroll
          for (int x = 0; x < 8; ++x) { if (!lat) { cs[x] = 1.0f; sn[x] = 0.0f; } sn[x] *= sgn; } }
        { const bool isk = lane >= 32; float v[8], o[8]; unpack8(*(const u32x4*)(prow + (isk ? PC_RK : PC_RQ) + 8 * l31), v);
#pragma unroll
          for (int x = 0; x < 8; ++x) { if (isk) v[x] *= 0.125f; const float pv = __shfl_xor(v[x], 4); o[x] = v[x] * cs[x] + pv * sn[x]; }
          *(u32x4*)((isk ? RK : RQ) + (size_t)m * 256 + 8 * l31) = pack8(o); }
        { float v[8], o[8]; unpack8(*(const u32x4*)(prow + PC_SQ + 8 * lane), v);
#pragma unroll
          for (int x = 0; x < 8; ++x) { const float pv = __shfl_xor(v[x], 4); o[x] = v[x] * cs[x] + pv * sn[x]; }
          *(u32x4*)(SQ + (size_t)m * 512 + 8 * lane) = pack8(o); }
        { float v[8], o[8]; unpack8(*(const u32x4*)(prow + PC_SK + 8 * (lane & 15)), v);
#pragma unroll
          for (int x = 0; x < 8; ++x) { const float pv = __shfl_xor(v[x], 4); o[x] = v[x] * cs[x] + pv * sn[x]; }
          if (lane < 16) *(u32x4*)(SK + (size_t)m * 128 + 8 * lane) = pack8(o); }
        { float a[8], bq[8];
#pragma unroll
          for (int x = 0; x < 8; ++x) { a[x] = 0.f; bq[x] = 0.f; }
#pragma unroll
          for (int j = 0; j < 5; ++j) { const int tt = t + j - 2; const bool ok = tt >= 0 && tt < Tn; const bf16* pr = prow + (ok ? (ptrdiff_t)(j - 2) * NP : (ptrdiff_t)0) + PC_GQKV;
              float va[8], vb[8]; unpack8(*(const u32x4*)(pr + 8 * lane), va); unpack8(*(const u32x4*)(pr + 512 + 8 * l31), vb);
              const float z = ok ? 1.0f : 0.0f;
#pragma unroll
              for (int x = 0; x < 8; ++x) { a[x] += z * wA[j][x] * va[x]; bq[x] += z * wB[j][x] * vb[x]; } }
          float n2 = 0.f;
#pragma unroll
          for (int x = 0; x < 8; ++x) { a[x] = siluf(a[x]); bq[x] = siluf(bq[x]); n2 += a[x] * a[x]; }
          n2 += dppf<0xB1>(n2); n2 += dppf<0x4E>(n2); n2 += dppf<0x141>(n2);
          const float sc = (1.0f / sqrtf(n2 + EPS)) * (lane < 32 ? 0.125f : 1.0f);
#pragma unroll
          for (int x = 0; x < 8; ++x) a[x] *= sc;
          *(u32x4*)(GD + (size_t)m * 768 + 8 * lane) = pack8(a);
          if (lane < 32) *(u32x4*)(GD + (size_t)m * 768 + 512 + 8 * lane) = pack8(bq); }
        if (lane < 16) { const int dh = lane & 7; const float a = AB[(size_t)m * 16 + lane];
            float o;
            if (lane < 8) { const float xx = a + in.gdn_dt_bias[layer * 8 + dh]; const float sp = fmaxf(xx, 0.f) + log1pf(fexp(-fabsf(xx))); o = -fexp(in.gdn_a_log[layer * 8 + dh]) * sp; }
            else o = 1.0f / (1.0f + fexp(-a));
            GB[(size_t)m * 16 + lane] = o; }
    }
}

__device__ __forceinline__ int scan_row(int b, int dir, int tau) {
    if (tau < TC) { const int c = dir ? TC - 1 - tau : tau; return b * TC + c; }
    const int tt = tau - TC; const int t = dir ? TL - 1 - tt : tt; return MC + b * TL + t;
}
__device__ __forceinline__ void phase_scans(Frame& F, const Inputs& in, int layer, int nscan) {
    if (F.wave != 0 || F.bid >= nscan) return;
    const int id = F.bid; const bool gdn = id >= 32; const int sid = id & 31; const int b = sid >> 3, hh = (sid >> 1) & 3, dir = sid & 1;
    const bf16* P = (const bf16*)(F.ws + WS_R1 + R1_P);
    unsigned char* prep = F.ws + WS_R1 + R1_PREP;
    const bf16* RQ = (const bf16*)(prep + PREP_RQ); const bf16* RK = (const bf16*)(prep + PREP_RK); const bf16* GD = (const bf16*)(prep + PREP_GD);
    const float* GB = (const float*)(F.ws + WS_GB);
    float* OUT = (float*)(F.ws + WS_R1 + (gdn ? R1_OG : R1_OR)) + (size_t)dir * M * 256;
    LAS float* lk = (LAS float*)F.lds; LAS float* lq = lk + 64 * 64; LAS float* lg = lq + 64 * 64;
    const int lane = F.lane;
    float S[64];
#pragma unroll
    for (int i = 0; i < 64; ++i) S[i] = 0.f;
    const float gamma = gdn ? 0.f : fexp(-fexp(in.ret_decay[layer * 8 + dir * 4 + hh]));
    for (int t0 = 0; t0 < TC + TL; t0 += 64) {
        for (int i = 0; i < 64; ++i) { const int m = scan_row(b, dir, t0 + i);
            if (gdn) { lq[i * 64 + lane] = bf2f(GD[(size_t)m * 768 + hh * 64 + lane]); lk[i * 64 + lane] = bf2f(GD[(size_t)m * 768 + 256 + hh * 64 + lane]); if (lane < 2) lg[i * 2 + lane] = GB[(size_t)m * 16 + lane * 8 + dir * 4 + hh]; }
            else { lq[i * 64 + lane] = bf2f(RQ[(size_t)m * 256 + hh * 64 + lane]); lk[i * 64 + lane] = bf2f(RK[(size_t)m * 256 + hh * 64 + lane]); } }
        LDS_WAIT(); asm volatile("" ::: "memory");
        for (int i = 0; i < 64; ++i) { const int m = scan_row(b, dir, t0 + i);
            float o = 0.f;
            if (gdn) {
                const float v = bf2f(GD[(size_t)m * 768 + 512 + hh * 64 + lane]); const float a = fexp(lg[i * 2]), beta = lg[i * 2 + 1];
                float ks = 0.f;
#pragma unroll
                for (int d4 = 0; d4 < 16; ++d4) { const f32x4 kv = *(const LAS f32x4*)(lk + i * 64 + 4 * d4); ks += kv.x * S[4 * d4] + kv.y * S[4 * d4 + 1] + kv.z * S[4 * d4 + 2] + kv.w * S[4 * d4 + 3]; }
                const float vn = beta * (v - a * ks);
#pragma unroll
                for (int d4 = 0; d4 < 16; ++d4) { const f32x4 kv = *(const LAS f32x4*)(lk + i * 64 + 4 * d4), qv = *(const LAS f32x4*)(lq + i * 64 + 4 * d4);
                    S[4 * d4] = a * S[4 * d4] + kv.x * vn; S[4 * d4 + 1] = a * S[4 * d4 + 1] + kv.y * vn; S[4 * d4 + 2] = a * S[4 * d4 + 2] + kv.z * vn; S[4 * d4 + 3] = a * S[4 * d4 + 3] + kv.w * vn;
                    o += qv.x * S[4 * d4] + qv.y * S[4 * d4 + 1] + qv.z * S[4 * d4 + 2] + qv.w * S[4 * d4 + 3]; }
            } else {
                const float v = bf2f(P[(size_t)m * NP + PC_RV + hh * 64 + lane]);
#pragma unroll
                for (int d4 = 0; d4 < 16; ++d4) { const f32x4 kv = *(const LAS f32x4*)(lk + i * 64 + 4 * d4), qv = *(const LAS f32x4*)(lq + i * 64 + 4 * d4);
                    S[4 * d4] = gamma * S[4 * d4] + kv.x * v; S[4 * d4 + 1] = gamma * S[4 * d4 + 1] + kv.y * v; S[4 * d4 + 2] = gamma * S[4 * d4 + 2] + kv.z * v; S[4 * d4 + 3] = gamma * S[4 * d4 + 3] + kv.w * v;
                    o += qv.x * S[4 * d4] + qv.y * S[4 * d4 + 1] + qv.z * S[4 * d4 + 2] + qv.w * S[4 * d4 + 3]; }
            }
            OUT[(size_t)m * 256 + hh * 64 + lane] = o;
        }
        LDS_WAIT(); asm volatile("" ::: "memory");
    }
}

__device__ __forceinline__ void phase_swa(Frame& F, const Inputs& in, int layer) {
    const bf16* P = (const bf16*)(F.ws + WS_R1 + R1_P);
    unsigned char* prep = F.ws + WS_R1 + R1_PREP;
    const bf16* SQ = (const bf16*)(prep + PREP_SQ); const bf16* SK = (const bf16*)(prep + PREP_SK);
    bf16* O = (bf16*)(F.ws + WS_R1 + R1_O);
    const int NT = F.G * NTHR;
    for (int idx = F.bid * NTHR + F.tid; idx < M * 8; idx += NT) {
        const int hq = idx / M, m = idx % M, g = hq >> 2;
        const bool lat = m >= MC; const int b = lat ? ((m - MC) >> 12) : (m >> 8); const int t = lat ? ((m - MC) & (TL - 1)) : (m & (TC - 1));
        float q[64], o[64];
#pragma unroll
        for (int i = 0; i < 8; ++i) { const u32x4 w = *(const u32x4*)(SQ + (size_t)m * 512 + hq * 64 + 8 * i);
#pragma unroll
            for (int e = 0; e < 4; ++e) { q[8 * i + 2 * e] = __uint_as_float(w[e] << 16) * 0.125f; q[8 * i + 2 * e + 1] = __uint_as_float(w[e] & 0xffff0000u) * 0.125f; } }
#pragma unroll
        for (int i = 0; i < 64; ++i) o[i] = 0.f;
        float mx = in.swa_sink[layer * 8 + hq], l = 1.0f;
        const int nloc = lat ? 257 : 0;
        for (int kk = 0; kk < nloc + TC; ++kk) {
            int row;
            if (kk < nloc) { const int s = t - 128 + kk; if (s < 0 || s >= TL) continue; row = MC + b * TL + s; }
            else row = b * TC + (kk - nloc);
            float sc = 0.f;
#pragma unroll
            for (int i = 0; i < 8; ++i) { const u32x4 w = *(const u32x4*)(SK + (size_t)row * 128 + g * 64 + 8 * i);
#pragma unroll
                for (int e = 0; e < 4; ++e) sc += q[8 * i + 2 * e] * __uint_as_float(w[e] << 16) + q[8 * i + 2 * e + 1] * __uint_as_float(w[e] & 0xffff0000u); }
            const float mn = fmaxf(mx, sc), corr = fexp(mx - mn), p = fexp(sc - mn);
            l = l * corr + p; mx = mn;
#pragma unroll
            for (int i = 0; i < 8; ++i) { const u32x4 w = *(const u32x4*)(P + (size_t)row * NP + PC_SV + g * 64 + 8 * i);
#pragma unroll
                for (int e = 0; e < 4; ++e) { o[8 * i + 2 * e] = o[8 * i + 2 * e] * corr + p * __uint_as_float(w[e] << 16); o[8 * i + 2 * e + 1] = o[8 * i + 2 * e + 1] * corr + p * __uint_as_float(w[e] & 0xffff0000u); } }
        }
        const float il = 1.0f / l;
#pragma unroll
        for (int i = 0; i < 8; ++i) { u32x4 w;
#pragma unroll
            for (int e = 0; e < 4; ++e) w[e] = pk2(o[8 * i + 2 * e] * il, o[8 * i + 2 * e + 1] * il);
            *(u32x4*)(O + (size_t)m * D + 512 + hq * 64 + 8 * i) = w; }
    }
}


__device__ __forceinline__ void phase_swa2(Frame& F, const Inputs& in, int layer, int nwg) {
    if (F.bid >= nwg) return;
    const bf16* P = (const bf16*)(F.ws + WS_R1 + R1_P);
    unsigned char* prep = F.ws + WS_R1 + R1_PREP;
    const bf16* SQ = (const bf16*)(prep + PREP_SQ); const bf16* SK = (const bf16*)(prep + PREP_SK);
    bf16* O = (bf16*)(F.ws + WS_R1 + R1_O);
    LAS bf16* Kl = (LAS bf16*)F.lds; LAS bf16* Vt = Kl + 64 * 72;
    const int lane = F.lane, c = lane & 15, q = lane >> 4, w = F.wave;
    const float LOG2E = 1.4426950408889634f;
    const int srow = F.tid >> 3, scol = (F.tid & 7) * 8;
    for (int u = F.bid; u < 544; u += nwg) {
        const bool lat = u < 512; int b, g, qb;
        if (lat) { b = u >> 7; g = (u >> 6) & 1; qb = u & 63; } else { const int uu = u - 512; b = uu >> 3; g = (uu >> 2) & 1; qb = uu & 3; }
        const int hq = 4 * g + (w >> 1), i0 = 32 * (w & 1);
        const int mrow0 = lat ? MC + b * TL + 64 * qb : b * TC + 64 * qb;
        const int kt0 = lat ? (2 - qb > 0 ? 2 - qb : 0) : 0, kt1 = lat ? (65 - qb < 4 ? 65 - qb : 4) : -1, nb = lat ? kt1 - kt0 + 1 : 0, nt = nb + 4;
        const int band0 = MC + b * TL + 64 * qb - 128 + 64 * kt0, ctx0 = b * TC;
        bf16x8 qf[2][2];
#pragma unroll
        for (int ti = 0; ti < 2; ++ti)
#pragma unroll
            for (int ks = 0; ks < 2; ++ks) qf[ti][ks] = *(const bf16x8*)(SQ + (size_t)(mrow0 + i0 + 16 * ti + c) * 512 + hq * 64 + 32 * ks + 8 * q);
        float mrun[2], lrun[2]; f32x4 oacc[4][2];
        const float sk = in.swa_sink[layer * 8 + hq] * LOG2E;
#pragma unroll
        for (int ti = 0; ti < 2; ++ti) { mrun[ti] = sk; lrun[ti] = 1.0f;
#pragma unroll
            for (int te = 0; te < 4; ++te) oacc[te][ti] = (f32x4){0.f, 0.f, 0.f, 0.f}; }
        u32x4 kreg, vreg;
        { const int r0 = (0 < nb) ? band0 : ctx0; kreg = *(const u32x4*)(SK + (size_t)(r0 + srow) * 128 + g * 64 + scol); vreg = *(const u32x4*)(P + (size_t)(r0 + srow) * NP + PC_SV + g * 64 + scol); }
        for (int tt = 0; tt < nt; ++tt) {
            __syncthreads();
            *(LAS u32x4*)(Kl + srow * 72 + scol) = kreg;
#pragma unroll
            for (int x = 0; x < 8; ++x) Vt[(scol + x) * 72 + srow] = (bf16)(vreg[x >> 1] >> (16 * (x & 1)));
            __syncthreads();
            if (tt + 1 < nt) { const int r0 = (tt + 1 < nb) ? band0 + 64 * (tt + 1) : ctx0 + 64 * (tt + 1 - nb);
                kreg = *(const u32x4*)(SK + (size_t)(r0 + srow) * 128 + g * 64 + scol); vreg = *(const u32x4*)(P + (size_t)(r0 + srow) * NP + PC_SV + g * 64 + scol); }
            bf16x8 kfr[2][4]; u32x2 vlo[2][4], vhi[2][4];
#pragma unroll
            for (int ks = 0; ks < 2; ++ks)
#pragma unroll
                for (int tj = 0; tj < 4; ++tj) kfr[ks][tj] = *(const LAS bf16x8*)(Kl + (16 * tj + c) * 72 + 32 * ks + 8 * q);
#pragma unroll
            for (int ks2 = 0; ks2 < 2; ++ks2)
#pragma unroll
                for (int te = 0; te < 4; ++te) { vlo[ks2][te] = *(const LAS u32x2*)(Vt + (16 * te + c) * 72 + 32 * ks2 + 4 * q); vhi[ks2][te] = *(const LAS u32x2*)(Vt + (16 * te + c) * 72 + 32 * ks2 + 16 + 4 * q); }
            __builtin_amdgcn_sched_barrier(0);
            f32x4 sacc[4][2];
#pragma unroll
            for (int tj = 0; tj < 4; ++tj)
#pragma unroll
                for (int ti = 0; ti < 2; ++ti) sacc[tj][ti] = (f32x4){0.f, 0.f, 0.f, 0.f};
#pragma unroll
            for (int ks = 0; ks < 2; ++ks)
#pragma unroll
                for (int tj = 0; tj < 4; ++tj)
#pragma unroll
                    for (int ti = 0; ti < 2; ++ti) sacc[tj][ti] = mfma16(kfr[ks][tj], qf[ti][ks], sacc[tj][ti]);
            const bool band = tt < nb;
            const int kp0 = 64 * qb - 128 + 64 * (kt0 + tt) + 4 * q;
#pragma unroll
            for (int ti = 0; ti < 2; ++ti) {
                const int qp = 64 * qb + i0 + 16 * ti + c;
                float mx = -30000.0f;
                if (band) {
#pragma unroll
                    for (int tj = 0; tj < 4; ++tj)
#pragma unroll
                        for (int r = 0; r < 4; ++r) { float sv = sacc[tj][ti][r] * (0.125f * LOG2E); const int dlt = kp0 + 16 * tj + r - qp; if (dlt > 128 || dlt < -128) sv = -30000.0f; sacc[tj][ti][r] = sv; mx = fmaxf(mx, sv); }
                } else {
#pragma unroll
                    for (int tj = 0; tj < 4; ++tj)
#pragma unroll
                        for (int r = 0; r < 4; ++r) { const float sv = sacc[tj][ti][r] * (0.125f * LOG2E); sacc[tj][ti][r] = sv; mx = fmaxf(mx, sv); }
                }
                mx = quad_rows_max(mx);
                const float mn = fmaxf(mrun[ti], mx), corr = __builtin_amdgcn_exp2f(mrun[ti] - mn);
                float ls = 0.f;
#pragma unroll
                for (int tj = 0; tj < 4; ++tj)
#pragma unroll
                    for (int r = 0; r < 4; ++r) { const float p = __builtin_amdgcn_exp2f(sacc[tj][ti][r] - mn); sacc[tj][ti][r] = p; ls += p; }
                ls = quad_rows_sum(ls);
                lrun[ti] = lrun[ti] * corr + ls; mrun[ti] = mn;
#pragma unroll
                for (int te = 0; te < 4; ++te) oacc[te][ti] *= corr;
            }
#pragma unroll
            for (int ks2 = 0; ks2 < 2; ++ks2) {
                bf16x8 pb[2];
#pragma unroll
                for (int ti = 0; ti < 2; ++ti) { u32x4 t; t.x = cvtpk(sacc[2 * ks2][ti][0], sacc[2 * ks2][ti][1]); t.y = cvtpk(sacc[2 * ks2][ti][2], sacc[2 * ks2][ti][3]);
                    t.z = cvtpk(sacc[2 * ks2 + 1][ti][0], sacc[2 * ks2 + 1][ti][1]); t.w = cvtpk(sacc[2 * ks2 + 1][ti][2], sacc[2 * ks2 + 1][ti][3]); pb[ti] = __builtin_bit_cast(bf16x8, t); }
#pragma unroll
                for (int te = 0; te < 4; ++te) { const bf16x8 va = __builtin_bit_cast(bf16x8, ((u32x4){vlo[ks2][te].x, vlo[ks2][te].y, vhi[ks2][te].x, vhi[ks2][te].y}));
#pragma unroll
                    for (int ti = 0; ti < 2; ++ti) oacc[te][ti] = mfma16(va, pb[ti], oacc[te][ti]); }
            }
        }
#pragma unroll
        for (int ti = 0; ti < 2; ++ti) { const float il = 1.0f / lrun[ti]; bf16* orow = O + (size_t)(mrow0 + i0 + 16 * ti + c) * D + 512 + hq * 64 + 4 * q;
#pragma unroll
            for (int te = 0; te < 4; ++te) { u32x2 wv; wv.x = cvtpk(oacc[te][ti][0] * il, oacc[te][ti][1] * il); wv.y = cvtpk(oacc[te][ti][2] * il, oacc[te][ti][3] * il); *(u32x2*)(orow + 16 * te) = wv; } }
    }
}


__device__ __forceinline__ void phase_gdn_local(Frame& F) {
    unsigned char* prep = F.ws + WS_R1 + R1_PREP;
    const bf16* GD = (const bf16*)(prep + PREP_GD); const float* GB = (const float*)(F.ws + WS_GB);
    LAS bf16* Qs = (LAS bf16*)F.lds; LAS bf16* Ks = Qs + 64 * 72; LAS bf16* Vs = Ks + 64 * 72;
    LAS float* At = (LAS float*)(F.lds + 27648);
    LAS bf16* ATs = (LAS bf16*)(F.lds + 60416);
    LAS bf16* XS_ = (LAS bf16*)(F.lds + 78848);
    LAS float* sm = (LAS float*)(F.lds + 115712);
    LAS float* gl = sm; LAS float* bl = sm + 128; LAS float* gcs = sm + 256; LAS float* eg = sm + 384; LAS float* ekd = sm + 512;
    const int lane = F.lane, c = lane & 15, q = lane >> 4, w = F.wave, tid = F.tid;
    for (int uu = F.bid; uu < 16 * 68; uu += F.G) {
        const int bh = uu / 68, ch = uu % 68, b = bh >> 2, hh = bh & 3;
        const int m0 = ch < 4 ? b * TC + 64 * ch : MC + b * TL + 64 * (ch - 4);
        __syncthreads();
        { const int row = tid >> 3, col8 = (tid & 7) * 8; const bf16* src = GD + (size_t)(m0 + row) * 768 + hh * 64 + col8;
          *(LAS u32x4*)(Qs + row * 72 + col8) = *(const u32x4*)(src); *(LAS u32x4*)(Ks + row * 72 + col8) = *(const u32x4*)(src + 256); *(LAS u32x4*)(Vs + row * 72 + col8) = *(const u32x4*)(src + 512);
          if (tid < 256) { const int tok = tid & 63, which = tid >> 6; sm[which * 64 + tok] = GB[(size_t)(m0 + tok) * 16 + (which >> 1) * 8 + (which & 1) * 4 + hh]; } }
        __syncthreads();
        if (w < 2) { const int d = w; const int tok = d ? 63 - lane : lane; float v = gl[d * 64 + tok];
#pragma unroll
            for (int o = 1; o < 64; o <<= 1) { const float t = __shfl_up(v, o); if (lane >= o) v += t; }
            const float last = __shfl(v, 63);
            gcs[d * 64 + lane] = v; eg[d * 64 + lane] = fexp(v); ekd[d * 64 + lane] = fexp(last - v); }
        __syncthreads();
        {
            const int type = w >> 2, ti = w & 3; const LAS bf16* X = type ? Qs : Ks;
            bf16x8 a[2];
#pragma unroll
            for (int ks = 0; ks < 2; ++ks) a[ks] = *(const LAS bf16x8*)(X + (16 * ti + c) * 72 + 32 * ks + 8 * q);
#pragma unroll
            for (int tj = 0; tj < 4; ++tj) { f32x4 acc = (f32x4){0.f, 0.f, 0.f, 0.f};
#pragma unroll
                for (int ks = 0; ks < 2; ++ks) acc = mfma16(a[ks], *(const LAS bf16x8*)(Ks + (16 * tj + c) * 72 + 32 * ks + 8 * q), acc);
#pragma unroll
                for (int r = 0; r < 4; ++r) { const int it = 16 * ti + 4 * q + r, jt = 16 * tj + c;
#pragma unroll
                    for (int d = 0; d < 2; ++d) { const int i = d ? 63 - it : it, j = d ? 63 - jt : jt;
                        const float e = fexp(fminf(gcs[d * 64 + i] - gcs[d * 64 + j], 0.f));
                        if (type == 0) At[d * 4096 + j * 64 + i] = (j < i) ? bl[d * 64 + it] * acc[r] * e : 0.f;
                        else ATs[d * 4608 + i * 72 + j] = (bf16)f2bf((j <= i) ? acc[r] * e : 0.f); } } }
        }
        __syncthreads();
        if (w < 4) {
            const int d = w >> 1, kind = w & 1; const LAS bf16* R = kind ? Ks : Vs; const LAS float* A = At + d * 4096;
            float x[64];
#pragma unroll
            for (int i = 0; i < 64; ++i) { const int tok = d ? 63 - i : i; float v = bl[d * 64 + tok] * bf2f(R[tok * 72 + lane]); if (kind) v *= eg[d * 64 + i]; x[i] = v; }
#pragma unroll
            for (int j = 0; j < 63; ++j) { const float xj = x[j];
                f32x4 ca[16];
#pragma unroll
                for (int g = ((j + 1) >> 2); g < 16; ++g) ca[g] = *(const LAS f32x4*)(A + j * 64 + 4 * g);
                __builtin_amdgcn_sched_barrier(0);
#pragma unroll
                for (int g = ((j + 1) >> 2); g < 16; ++g) { x[4 * g] -= ca[g].x * xj; x[4 * g + 1] -= ca[g].y * xj; x[4 * g + 2] -= ca[g].z * xj; x[4 * g + 3] -= ca[g].w * xj; }
                __builtin_amdgcn_sched_barrier(0); }
            LAS bf16* XO = XS_ + (d * 2 + kind) * 4608;
#pragma unroll
            for (int i = 0; i < 64; ++i) XO[i * 72 + lane] = (bf16)f2bf(x[i]);
        } else {
            const int t2 = tid - 256;
            for (int it = t2; it < 6 * 512; it += 256) { const int mat = it >> 9, chk = it & 511, d = mat & 1, kindm = mat >> 1;
                const int rt = chk >> 7, ks = (chk >> 6) & 1, ln = chk & 63, r = ln & 15, qq = ln >> 4, row = 16 * rt + r, c0 = 32 * ks + 4 * qq;
                float v[8];
                if (kindm == 0) { const u32x2 lo = *(const LAS u32x2*)(ATs + d * 4608 + row * 72 + c0), hi = *(const LAS u32x2*)(ATs + d * 4608 + row * 72 + c0 + 16);
                    v[0] = __uint_as_float(lo.x << 16); v[1] = __uint_as_float(lo.x & 0xffff0000u); v[2] = __uint_as_float(lo.y << 16); v[3] = __uint_as_float(lo.y & 0xffff0000u);
                    v[4] = __uint_as_float(hi.x << 16); v[5] = __uint_as_float(hi.x & 0xffff0000u); v[6] = __uint_as_float(hi.y << 16); v[7] = __uint_as_float(hi.y & 0xffff0000u); }
                else if (kindm == 1) { const int tok = d ? 63 - row : row; const float sc = eg[d * 64 + row];
#pragma unroll
                    for (int x8 = 0; x8 < 8; ++x8) v[x8] = bf2f(Qs[tok * 72 + c0 + (x8 & 3) + 16 * (x8 >> 2)]) * sc; }
                else {
#pragma unroll
                    for (int x8 = 0; x8 < 8; ++x8) { const int i = c0 + (x8 & 3) + 16 * (x8 >> 2); const int tok = d ? 63 - i : i; v[x8] = bf2f(Ks[tok * 72 + row]) * ekd[d * 64 + i]; } }
                const int chain = bh * 2 + d, sg = ch < 4 ? (d ? 3 - ch : ch) : 4 + (d ? 63 - (ch - 4) : ch - 4);
                unsigned char* dst = F.ws + WS_GCH + (size_t)chain * GCH_CHAIN + (size_t)sg * GCH_STEP + (kindm == 0 ? 16384 : (kindm == 1 ? 8192 : 24576));
                u32x4 o; o.x = pk2(v[0], v[1]); o.y = pk2(v[2], v[3]); o.z = pk2(v[4], v[5]); o.w = pk2(v[6], v[7]);
                *(u32x4*)(dst + chk * 16) = o; }
        }
        __syncthreads();
        {
            for (int it = tid; it < 2 * 512; it += NTHR) { const int d = it >> 9, chk = it & 511;
                const int rt = chk >> 7, ks = (chk >> 6) & 1, ln = chk & 63, r = ln & 15, qq = ln >> 4, row = 16 * rt + r, c0 = 32 * ks + 4 * qq;
                const LAS bf16* XW = XS_ + (d * 2 + 1) * 4608;
                const u32x2 lo = *(const LAS u32x2*)(XW + row * 72 + c0), hi = *(const LAS u32x2*)(XW + row * 72 + c0 + 16);
                const int chain = bh * 2 + d, sg = ch < 4 ? (d ? 3 - ch : ch) : 4 + (d ? 63 - (ch - 4) : ch - 4);
                unsigned char* dst = F.ws + WS_GCH + (size_t)chain * GCH_CHAIN + (size_t)sg * GCH_STEP;
                *(u32x4*)(dst + chk * 16) = (u32x4){lo.x, lo.y, hi.x, hi.y}; }
            for (int it = tid; it < 2 * 1024; it += NTHR) { const int d = it >> 10, cu = it & 1023;
                const int sl = cu >> 8, rt = (cu >> 6) & 3, ln = cu & 63, qq = ln >> 4, cc = ln & 15;
                const LAS bf16* XU = XS_ + (d * 2) * 4608;
                bf16 e0 = XU[(16 * rt + 4 * qq + 0) * 72 + 16 * sl + cc], e1 = XU[(16 * rt + 4 * qq + 1) * 72 + 16 * sl + cc], e2 = XU[(16 * rt + 4 * qq + 2) * 72 + 16 * sl + cc], e3 = XU[(16 * rt + 4 * qq + 3) * 72 + 16 * sl + cc];
                const int chain = bh * 2 + d, sg = ch < 4 ? (d ? 3 - ch : ch) : 4 + (d ? 63 - (ch - 4) : ch - 4);
                unsigned char* dst = F.ws + WS_GCH + (size_t)chain * GCH_CHAIN + (size_t)sg * GCH_STEP + 32768;
                *(u32x2*)(dst + cu * 8) = (u32x2){(unsigned)e0 | ((unsigned)e1 << 16), (unsigned)e2 | ((unsigned)e3 << 16)}; }
            if (tid < 2) { const int d = tid; const int chain = bh * 2 + d, sg = ch < 4 ? (d ? 3 - ch : ch) : 4 + (d ? 63 - (ch - 4) : ch - 4);
                ((float*)(F.ws + WS_GDEC))[chain * 68 + sg] = eg[d * 64 + 63]; }
        }
    }
}

__device__ __forceinline__ void phase_gdn_scan(Frame& F, int first_wg) {
    const int chain = F.bid - first_wg; if (chain < 0 || chain >= 32) return;
    const int b = chain >> 3, hh = (chain >> 1) & 3, d = chain & 1;
    const unsigned char* src = F.ws + WS_GCH + (size_t)chain * GCH_CHAIN;
    const float* decs = (const float*)(F.ws + WS_GDEC) + chain * 68;
    float* OUT = (float*)(F.ws + WS_R1 + R1_OG) + (size_t)d * M * 256;
    LAS unsigned char* ring = F.lds;
    const int lane = F.lane, w = F.wave;
    if (w >= 4) {
        const int dw = w - 4;
#define GS_ISSUE(step) do { _Pragma("unroll") for (int k = 0; k < 10; ++k) { const int p = dw * 10 + k; \
            __builtin_amdgcn_global_load_lds((const unsigned*)(src + (size_t)(step) * GCH_STEP + p * 1024 + lane * 16), (LAS unsigned*)(ring + ((step) % 3) * 40960 + p * 1024), 16, 0, 0); } } while (0)
        GS_ISSUE(0); GS_ISSUE(1);
        asm volatile("s_waitcnt vmcnt(10)" ::: "memory"); __builtin_amdgcn_s_barrier();
        for (int n = 0; n < 68; ++n) {
            if (n + 2 < 68) { GS_ISSUE(n + 2); asm volatile("s_waitcnt vmcnt(10)" ::: "memory"); }
            else asm volatile("s_waitcnt vmcnt(0)" ::: "memory");
            __builtin_amdgcn_s_barrier();
        }
#undef GS_ISSUE
    } else {
        const int sl = w, qq = lane >> 4, cc = lane & 15;
        f32x4 S[4];
#pragma unroll
        for (int rt = 0; rt < 4; ++rt) S[rt] = (f32x4){0.f, 0.f, 0.f, 0.f};
        const float dv0 = decs[lane], dv1 = decs[64 + (lane & 3)];
        asm volatile("s_waitcnt vmcnt(0)" ::: "memory"); __builtin_amdgcn_s_barrier(); asm volatile("" ::: "memory");
        for (int n = 0; n < 68; ++n) {
            const LAS unsigned char* base = ring + (n % 3) * 40960;
            const float dec = n < 64 ? __shfl(dv0, n) : __shfl(dv1, n - 64);
#define GS_FRAG(mat, rt, ks) (*(const LAS bf16x8*)(base + (mat) * 8192 + (((rt) * 2 + (ks)) * 64 + lane) * 16))
            bf16x8 BS[2], BV[2];
#pragma unroll
            for (int ks = 0; ks < 2; ++ks) { u32x4 t; t.x = cvtpk(S[2 * ks][0], S[2 * ks][1]); t.y = cvtpk(S[2 * ks][2], S[2 * ks][3]); t.z = cvtpk(S[2 * ks + 1][0], S[2 * ks + 1][1]); t.w = cvtpk(S[2 * ks + 1][2], S[2 * ks + 1][3]); BS[ks] = __builtin_bit_cast(bf16x8, t); }
            f32x4 vn[4], o[4];
#pragma unroll
            for (int rt = 0; rt < 4; ++rt) { f32x4 acc = (f32x4){0.f, 0.f, 0.f, 0.f};
#pragma unroll
                for (int ks = 0; ks < 2; ++ks) acc = mfma16(GS_FRAG(0, rt, ks), BS[ks], acc);
                const u32x2 uu = *(const LAS u32x2*)(base + 32768 + ((sl * 4 + rt) * 64 + lane) * 8);
                vn[rt] = (f32x4){__uint_as_float(uu.x << 16), __uint_as_float(uu.x & 0xffff0000u), __uint_as_float(uu.y << 16), __uint_as_float(uu.y & 0xffff0000u)} - acc;
                f32x4 oo = (f32x4){0.f, 0.f, 0.f, 0.f};
#pragma unroll
                for (int ks = 0; ks < 2; ++ks) oo = mfma16(GS_FRAG(1, rt, ks), BS[ks], oo);
                o[rt] = oo; }
#pragma unroll
            for (int ks = 0; ks < 2; ++ks) { u32x4 t; t.x = cvtpk(vn[2 * ks][0], vn[2 * ks][1]); t.y = cvtpk(vn[2 * ks][2], vn[2 * ks][3]); t.z = cvtpk(vn[2 * ks + 1][0], vn[2 * ks + 1][1]); t.w = cvtpk(vn[2 * ks + 1][2], vn[2 * ks + 1][3]); BV[ks] = __builtin_bit_cast(bf16x8, t); }
#pragma unroll
            for (int rt = 0; rt < 4; ++rt) { f32x4 oo = o[rt], sn = S[rt] * dec;
#pragma unroll
                for (int ks = 0; ks < 2; ++ks) { oo = mfma16(GS_FRAG(2, rt, ks), BV[ks], oo); sn = mfma16(GS_FRAG(3, rt, ks), BV[ks], sn); }
                o[rt] = oo; S[rt] = sn; }
#undef GS_FRAG
            const int m0 = n < 4 ? b * TC + 64 * (d ? 3 - n : n) : MC + b * TL + 64 * (d ? 63 - (n - 4) : n - 4);
#pragma unroll
            for (int rt = 0; rt < 4; ++rt)
#pragma unroll
                for (int r = 0; r < 4; ++r) { const int i = 16 * rt + 4 * qq + r, tok = d ? 63 - i : i; OUT[(size_t)(m0 + tok) * 256 + hh * 64 + 16 * sl + cc] = o[rt][r]; }
            asm volatile("s_waitcnt lgkmcnt(0)" ::: "memory"); PB(11); __builtin_amdgcn_s_barrier(); PE(11); asm volatile("" ::: "memory");
        }
    }
}


__device__ __forceinline__ void phase_gdn_local2(Frame& F) {
    unsigned char* prep = F.ws + WS_R1 + R1_PREP;
    const bf16* GD = (const bf16*)(prep + PREP_GD); const float* GB = (const float*)(F.ws + WS_GB);
    LAS bf16* Ks = (LAS bf16*)F.lds; LAS bf16* Vs = Ks + 64 * 72;
    LAS float* At = (LAS float*)(F.lds + 18432);
    LAS bf16* XS_ = (LAS bf16*)(F.lds + 51200);
    LAS float* sm = (LAS float*)(F.lds + 88064);
    LAS float* gl = sm; LAS float* bl = sm + 128; LAS float* gcs = sm + 256; LAS float* eg = sm + 384; LAS float* ekd = sm + 512;
    const int lane = F.lane, c = lane & 15, q = lane >> 4, w = F.wave, tid = F.tid;
    for (int uu = F.bid; uu < 16 * 68; uu += F.G) {
        const int bh = uu / 68, ch = uu % 68, b = bh >> 2, hh = bh & 3;
        const int m0 = ch < 4 ? b * TC + 64 * ch : MC + b * TL + 64 * (ch - 4);
        __syncthreads();
        { const int row = tid >> 3, col8 = (tid & 7) * 8; const bf16* src = GD + (size_t)(m0 + row) * 768 + hh * 64 + col8;
          *(LAS u32x4*)(Ks + row * 72 + col8) = *(const u32x4*)(src + 256); *(LAS u32x4*)(Vs + row * 72 + col8) = *(const u32x4*)(src + 512);
          if (tid < 256) { const int tok = tid & 63, which = tid >> 6; sm[which * 64 + tok] = GB[(size_t)(m0 + tok) * 16 + (which >> 1) * 8 + (which & 1) * 4 + hh]; } }
        __syncthreads();
        if (w < 2) { const int d = w; const int tok = d ? 63 - lane : lane; float v = gl[d * 64 + tok];
#pragma unroll
            for (int o = 1; o < 64; o <<= 1) { const float t = __shfl_up(v, o); if (lane >= o) v += t; }
            const float last = __shfl(v, 63);
            gcs[d * 64 + lane] = v; eg[d * 64 + lane] = fexp(v); ekd[d * 64 + lane] = fexp(last - v);
            ((float*)(F.ws + WS_GCS))[((size_t)uu * 2 + d) * 64 + tok] = v; }
        __syncthreads();
        {
            const int ti = w & 3, th = w >> 2;
            bf16x8 a[2];
#pragma unroll
            for (int ks = 0; ks < 2; ++ks) a[ks] = *(const LAS bf16x8*)(Ks + (16 * ti + c) * 72 + 32 * ks + 8 * q);
#pragma unroll
            for (int t2 = 0; t2 < 2; ++t2) { const int tj = 2 * th + t2; f32x4 acc = (f32x4){0.f, 0.f, 0.f, 0.f};
#pragma unroll
                for (int ks = 0; ks < 2; ++ks) acc = mfma16(a[ks], *(const LAS bf16x8*)(Ks + (16 * tj + c) * 72 + 32 * ks + 8 * q), acc);
#pragma unroll
                for (int r = 0; r < 4; ++r) { const int it = 16 * ti + 4 * q + r, jt = 16 * tj + c;
#pragma unroll
                    for (int d = 0; d < 2; ++d) { const int i = d ? 63 - it : it, j = d ? 63 - jt : jt;
                        const float e = fexp(fminf(gcs[d * 64 + i] - gcs[d * 64 + j], 0.f));
                        At[d * 4096 + j * 64 + i] = (j < i) ? bl[d * 64 + it] * acc[r] * e : 0.f; } } }
        }
        __syncthreads();
        if (w < 4) {
            const int d = w >> 1, kind = w & 1; const LAS bf16* R = kind ? Ks : Vs; const LAS float* A = At + d * 4096;
            float x[64];
#pragma unroll
            for (int i = 0; i < 64; ++i) { const int tok = d ? 63 - i : i; float v = bl[d * 64 + tok] * bf2f(R[tok * 72 + lane]); if (kind) v *= eg[d * 64 + i]; x[i] = v; }
#pragma unroll
            for (int j = 0; j < 63; ++j) { const float xj = x[j];
                f32x4 ca[16];
#pragma unroll
                for (int g = ((j + 1) >> 2); g < 16; ++g) ca[g] = *(const LAS f32x4*)(A + j * 64 + 4 * g);
                __builtin_amdgcn_sched_barrier(0);
#pragma unroll
                for (int g = ((j + 1) >> 2); g < 16; ++g) { x[4 * g] -= ca[g].x * xj; x[4 * g + 1] -= ca[g].y * xj; x[4 * g + 2] -= ca[g].z * xj; x[4 * g + 3] -= ca[g].w * xj; }
                __builtin_amdgcn_sched_barrier(0); }
            LAS bf16* XO = XS_ + (d * 2 + kind) * 4608;
#pragma unroll
            for (int i = 0; i < 64; ++i) XO[i * 72 + lane] = (bf16)f2bf(x[i]);
        } else {
            const int t2 = tid - 256;
            for (int it = t2; it < 2 * 512; it += 256) { const int d = it >> 9, chk = it & 511;
                const int rt = chk >> 7, ks = (chk >> 6) & 1, ln = chk & 63, r = ln & 15, qq = ln >> 4, row = 16 * rt + r, c0 = 32 * ks + 4 * qq;
                float v[8];
#pragma unroll
                for (int x8 = 0; x8 < 8; ++x8) { const int tok = c0 + (x8 & 3) + 16 * (x8 >> 2); const int i = d ? 63 - tok : tok; v[x8] = bf2f(Ks[tok * 72 + row]) * ekd[d * 64 + i]; }
                const int chain = bh * 2 + d, sg = ch < 4 ? (d ? 3 - ch : ch) : 4 + (d ? 63 - (ch - 4) : ch - 4);
                unsigned char* dst = F.ws + WS_GCH + (size_t)chain * G2_CHAIN + (size_t)sg * G2_STEP + 8192;
                u32x4 o; o.x = cvtpk(v[0], v[1]); o.y = cvtpk(v[2], v[3]); o.z = cvtpk(v[4], v[5]); o.w = cvtpk(v[6], v[7]);
                *(u32x4*)(dst + chk * 16) = o; }
        }
        __syncthreads();
        {
            for (int it = tid; it < 2 * 512; it += NTHR) { const int d = it >> 9, chk = it & 511;
                const int rt = chk >> 7, ks = (chk >> 6) & 1, ln = chk & 63, r = ln & 15, qq = ln >> 4, row = 16 * rt + r, c0 = 32 * ks + 4 * qq;
                const LAS bf16* XW = XS_ + (d * 2 + 1) * 4608;
                const int prow = d ? 63 - row : row;
                const u32x2 lo = *(const LAS u32x2*)(XW + prow * 72 + c0), hi = *(const LAS u32x2*)(XW + prow * 72 + c0 + 16);
                const int chain = bh * 2 + d, sg = ch < 4 ? (d ? 3 - ch : ch) : 4 + (d ? 63 - (ch - 4) : ch - 4);
                unsigned char* dst = F.ws + WS_GCH + (size_t)chain * G2_CHAIN + (size_t)sg * G2_STEP;
                *(u32x4*)(dst + chk * 16) = (u32x4){lo.x, lo.y, hi.x, hi.y}; }
            for (int it = tid; it < 2 * 1024; it += NTHR) { const int d = it >> 10, cu = it & 1023;
                const int sl = cu >> 8, rt = (cu >> 6) & 3, ln = cu & 63, qq = ln >> 4, cc = ln & 15;
                const LAS bf16* XU = XS_ + (d * 2) * 4608;
                const int tr = 16 * rt + 4 * qq, p0 = d ? 63 - tr : tr, ps = d ? -1 : 1;
                bf16 e0 = XU[(p0) * 72 + 16 * sl + cc], e1 = XU[(p0 + ps) * 72 + 16 * sl + cc], e2 = XU[(p0 + 2 * ps) * 72 + 16 * sl + cc], e3 = XU[(p0 + 3 * ps) * 72 + 16 * sl + cc];
                const int chain = bh * 2 + d, sg = ch < 4 ? (d ? 3 - ch : ch) : 4 + (d ? 63 - (ch - 4) : ch - 4);
                unsigned char* dst = F.ws + WS_GCH + (size_t)chain * G2_CHAIN + (size_t)sg * G2_STEP + 16384;
                *(u32x2*)(dst + cu * 8) = (u32x2){(unsigned)e0 | ((unsigned)e1 << 16), (unsigned)e2 | ((unsigned)e3 << 16)}; }
            if (tid < 2) { const int d = tid; const int chain = bh * 2 + d, sg = ch < 4 ? (d ? 3 - ch : ch) : 4 + (d ? 63 - (ch - 4) : ch - 4);
                ((float*)(F.ws + WS_GDEC))[chain * 68 + sg] = eg[d * 64 + 63]; }
        }
    }
}

__device__ __forceinline__ void phase_gdn_scan2(Frame& F, int first_wg) {
    const int chain = F.bid - first_wg; if (chain < 0 || chain >= 32) return;
    const int d = chain & 1;
    const unsigned char* src = F.ws + WS_GCH + (size_t)chain * G2_CHAIN;
    const float* decs = (const float*)(F.ws + WS_GDEC) + chain * 68;
    bf16* GST = (bf16*)(F.ws + WS_GST) + (size_t)chain * 68 * 8192;
    LAS unsigned char* ring = F.lds;
    const int lane = F.lane, w = F.wave;
    if (w >= 2) {
        const int dw = w - 2;
#define GS2_ISSUE(step) do { _Pragma("unroll") for (int k = 0; k < 4; ++k) { const int p = dw * 4 + k; \
            __builtin_amdgcn_global_load_lds((const unsigned*)(src + (size_t)(step) * G2_STEP + p * 1024 + lane * 16), (LAS unsigned*)(ring + ((step) & 3) * 24576 + p * 1024), 16, 0, 0); } } while (0)
        GS2_ISSUE(0); GS2_ISSUE(1); GS2_ISSUE(2);
        asm volatile("s_waitcnt vmcnt(8)" ::: "memory"); __builtin_amdgcn_s_barrier();
        for (int n = 0; n < 68; ++n) {
            if (n + 3 < 68) { GS2_ISSUE(n + 3); asm volatile("s_waitcnt vmcnt(8)" ::: "memory"); }
            else if (n + 2 < 68) asm volatile("s_waitcnt vmcnt(4)" ::: "memory");
            else asm volatile("s_waitcnt vmcnt(0)" ::: "memory");
            __builtin_amdgcn_s_barrier();
        }
#undef GS2_ISSUE
    } else {
        const int qq = lane >> 4, cc = lane & 15;
        f32x4 S[2][4];
#pragma unroll
        for (int ct = 0; ct < 2; ++ct)
#pragma unroll
            for (int rt = 0; rt < 4; ++rt) S[ct][rt] = (f32x4){0.f, 0.f, 0.f, 0.f};
        const float dv0 = decs[lane], dv1 = decs[64 + (lane & 3)];
        asm volatile("s_waitcnt vmcnt(0)" ::: "memory"); __builtin_amdgcn_s_barrier(); asm volatile("" ::: "memory");
        for (int n = 0; n < 68; ++n) {
            const LAS unsigned char* base = ring + (n & 3) * 24576;
            const float dec = n < 64 ? __shfl(dv0, n) : __shfl(dv1, n - 64);
            bf16* st = GST + (size_t)n * 8192;
            bf16* vt = st + 4096;
#define GS2_FRAG(mat, rt, ks) (*(const LAS bf16x8*)(base + (mat) * 8192 + (((rt) * 2 + (ks)) * 64 + lane) * 16))
            bf16x8 wf[4][2], kf[4][2]; u32x2 uf[2][4];
#pragma unroll
            for (int rt = 0; rt < 4; ++rt) { wf[rt][0] = GS2_FRAG(0, rt, 0); wf[rt][1] = GS2_FRAG(0, rt, 1); }
#pragma unroll
            for (int ct = 0; ct < 2; ++ct)
#pragma unroll
                for (int rt = 0; rt < 4; ++rt) uf[ct][rt] = *(const LAS u32x2*)(base + 16384 + (((2 * w + ct) * 4 + rt) * 64 + lane) * 8);
#pragma unroll
            for (int rt = 0; rt < 4; ++rt) { kf[rt][0] = GS2_FRAG(1, rt, 0); kf[rt][1] = GS2_FRAG(1, rt, 1); }
            __builtin_amdgcn_sched_barrier(0);
            bf16x8 BS[2][2], BV[2][2];
#pragma unroll
            for (int ct = 0; ct < 2; ++ct) { const int e = 32 * w + 16 * ct + cc;
#pragma unroll
                for (int ks = 0; ks < 2; ++ks) { u32x4 t; t.x = cvtpk(S[ct][2 * ks][0], S[ct][2 * ks][1]); t.y = cvtpk(S[ct][2 * ks][2], S[ct][2 * ks][3]); t.z = cvtpk(S[ct][2 * ks + 1][0], S[ct][2 * ks + 1][1]); t.w = cvtpk(S[ct][2 * ks + 1][2], S[ct][2 * ks + 1][3]);
                    BS[ct][ks] = __builtin_bit_cast(bf16x8, t);
                    *(u32x2*)(st + e * 64 + 32 * ks + 4 * qq) = (u32x2){t.x, t.y}; *(u32x2*)(st + e * 64 + 32 * ks + 16 + 4 * qq) = (u32x2){t.z, t.w}; } }
            f32x4 vn[2][4];
#pragma unroll
            for (int ks = 0; ks < 2; ++ks)
#pragma unroll
                for (int rt = 0; rt < 4; ++rt)
#pragma unroll
                    for (int ct = 0; ct < 2; ++ct) vn[ct][rt] = mfma16(wf[rt][ks], BS[ct][ks], ks ? vn[ct][rt] : (f32x4){0.f, 0.f, 0.f, 0.f});
#pragma unroll
            for (int ct = 0; ct < 2; ++ct)
#pragma unroll
                for (int rt = 0; rt < 4; ++rt) { const u32x2 uu = uf[ct][rt];
                    vn[ct][rt] = (f32x4){__uint_as_float(uu.x << 16), __uint_as_float(uu.x & 0xffff0000u), __uint_as_float(uu.y << 16), __uint_as_float(uu.y & 0xffff0000u)} - vn[ct][rt]; }
#pragma unroll
            for (int ct = 0; ct < 2; ++ct) { const int e = 32 * w + 16 * ct + cc;
#pragma unroll
                for (int ks = 0; ks < 2; ++ks) { u32x4 t; t.x = cvtpk(vn[ct][2 * ks][0], vn[ct][2 * ks][1]); t.y = cvtpk(vn[ct][2 * ks][2], vn[ct][2 * ks][3]); t.z = cvtpk(vn[ct][2 * ks + 1][0], vn[ct][2 * ks + 1][1]); t.w = cvtpk(vn[ct][2 * ks + 1][2], vn[ct][2 * ks + 1][3]);
                    BV[ct][ks] = __builtin_bit_cast(bf16x8, t);
                    if (d == 0) { *(u32x2*)(vt + e * 64 + 32 * ks + 4 * qq) = (u32x2){t.x, t.y}; *(u32x2*)(vt + e * 64 + 32 * ks + 16 + 4 * qq) = (u32x2){t.z, t.w}; }
                    else { const u32x2 r0 = (u32x2){(t.y >> 16) | (t.y << 16), (t.x >> 16) | (t.x << 16)}, r1 = (u32x2){(t.w >> 16) | (t.w << 16), (t.z >> 16) | (t.z << 16)};
                        *(u32x2*)(vt + e * 64 + 60 - 32 * ks - 4 * qq) = r0; *(u32x2*)(vt + e * 64 + 44 - 32 * ks - 4 * qq) = r1; } } }
#pragma unroll
            for (int ct = 0; ct < 2; ++ct)
#pragma unroll
                for (int rt = 0; rt < 4; ++rt) S[ct][rt] = S[ct][rt] * dec;
#pragma unroll
            for (int ks = 0; ks < 2; ++ks)
#pragma unroll
                for (int rt = 0; rt < 4; ++rt)
#pragma unroll
                    for (int ct = 0; ct < 2; ++ct) S[ct][rt] = mfma16(kf[rt][ks], BV[ct][ks], S[ct][rt]);
#undef GS2_FRAG
            asm volatile("s_waitcnt lgkmcnt(0)" ::: "memory"); __builtin_amdgcn_s_barrier(); asm volatile("" ::: "memory");
        }
    }
}

__device__ __forceinline__ void phase_gdn_out(Frame& F, const Inputs& in, int layer) {
    const bf16* P = (const bf16*)(F.ws + WS_R1 + R1_P);
    const bf16* GD = (const bf16*)(F.ws + WS_R1 + R1_PREP + PREP_GD);
    const bf16* GST = (const bf16*)(F.ws + WS_GST); const float* GCS = (const float*)(F.ws + WS_GCS);
    bf16* O = (bf16*)(F.ws + WS_R1 + R1_O);
    const int lane = F.lane, c = lane & 15, q = lane >> 4, w = F.wave, half = w >> 2, ti = w & 3, t2 = F.tid & 255;
    LAS bf16* Qs = (LAS bf16*)(F.lds + half * 56320); LAS bf16* Ks = Qs + 4608; LAS bf16* St = Ks + 4608; LAS bf16* Vn = St + 2 * 4608;
    LAS float* gT = (LAS float*)(F.lds + half * 56320 + 55296);
    for (int pp = F.bid; pp < 8 * 68; pp += F.G) {
        const int uu = 2 * pp + half, bh = uu / 68, ch = uu % 68, b = bh >> 2, hh = bh & 3;
        const int m0 = ch < 4 ? b * TC + 64 * ch : MC + b * TL + 64 * (ch - 4);
        __syncthreads();
#pragma unroll
        for (int rep = 0; rep < 2; ++rep) { const int idx = t2 + 256 * rep, row = idx >> 3, col8 = (idx & 7) * 8;
            const bf16* src = GD + (size_t)(m0 + row) * 768 + hh * 64 + col8;
            *(LAS u32x4*)(Qs + row * 72 + col8) = *(const u32x4*)(src); *(LAS u32x4*)(Ks + row * 72 + col8) = *(const u32x4*)(src + 256);
#pragma unroll
            for (int d = 0; d < 2; ++d) { const int sg = ch < 4 ? (d ? 3 - ch : ch) : 4 + (d ? 63 - (ch - 4) : ch - 4);
                const bf16* g = GST + ((size_t)(bh * 2 + d) * 68 + sg) * 8192 + row * 64 + col8;
                *(LAS u32x4*)(St + d * 4608 + row * 72 + col8) = *(const u32x4*)(g); *(LAS u32x4*)(Vn + d * 4608 + row * 72 + col8) = *(const u32x4*)(g + 4096); } }
        if (t2 < 128) gT[t2] = GCS[(size_t)uu * 128 + t2];
        __syncthreads();
        bf16x8 qf[2];
#pragma unroll
        for (int ks = 0; ks < 2; ++ks) qf[ks] = *(const LAS bf16x8*)(Qs + (16 * ti + c) * 72 + 32 * ks + 8 * q);
        const int i = 16 * ti + c;
        const float gi0 = gT[i], gi1 = gT[64 + i];
        f32x4 sacc[4];
#pragma unroll
        for (int tj = 0; tj < 4; ++tj) { f32x4 acc = (f32x4){0.f, 0.f, 0.f, 0.f};
#pragma unroll
            for (int ks = 0; ks < 2; ++ks) acc = mfma16(*(const LAS bf16x8*)(Ks + (16 * tj + c) * 72 + 32 * ks + 8 * q), qf[ks], acc);
            sacc[tj] = acc; }
        bf16x8 pb[2][2];
#pragma unroll
        for (int d = 0; d < 2; ++d) { f32x4 p[4];
#pragma unroll
            for (int tj = 0; tj < 4; ++tj) { const f32x4 gj = *(const LAS f32x4*)(gT + d * 64 + 16 * tj + 4 * q);
#pragma unroll
                for (int r = 0; r < 4; ++r) { const int j = 16 * tj + 4 * q + r; const bool ok = d ? (j >= i) : (j <= i);
                    p[tj][r] = ok ? sacc[tj][r] * fexp(fminf((d ? gi1 : gi0) - gj[r], 0.f)) : 0.f; } }
#pragma unroll
            for (int ks2 = 0; ks2 < 2; ++ks2) { u32x4 t; t.x = cvtpk(p[2 * ks2][0], p[2 * ks2][1]); t.y = cvtpk(p[2 * ks2][2], p[2 * ks2][3]); t.z = cvtpk(p[2 * ks2 + 1][0], p[2 * ks2 + 1][1]); t.w = cvtpk(p[2 * ks2 + 1][2], p[2 * ks2 + 1][3]); pb[d][ks2] = __builtin_bit_cast(bf16x8, t); } }
        const float sc0 = fexp(gi0), sc1 = fexp(gi1);
        f32x4 o[4]; float ssq = 0.f;
#pragma unroll
        for (int te = 0; te < 4; ++te) { f32x4 acc = (f32x4){0.f, 0.f, 0.f, 0.f}, t0 = acc, t1 = acc;
#pragma unroll
            for (int d = 0; d < 2; ++d)
#pragma unroll
                for (int ks2 = 0; ks2 < 2; ++ks2) { const u32x2 lo = *(const LAS u32x2*)(Vn + d * 4608 + (16 * te + c) * 72 + 32 * ks2 + 4 * q), hi = *(const LAS u32x2*)(Vn + d * 4608 + (16 * te + c) * 72 + 32 * ks2 + 16 + 4 * q);
                    acc = mfma16(__builtin_bit_cast(bf16x8, ((u32x4){lo.x, lo.y, hi.x, hi.y})), pb[d][ks2], acc); }
#pragma unroll
            for (int ks = 0; ks < 2; ++ks) { t0 = mfma16(*(const LAS bf16x8*)(St + (16 * te + c) * 72 + 32 * ks + 8 * q), qf[ks], t0);
                t1 = mfma16(*(const LAS bf16x8*)(St + 4608 + (16 * te + c) * 72 + 32 * ks + 8 * q), qf[ks], t1); }
            o[te] = acc + sc0 * t0 + sc1 * t1; ssq += (o[te][0] * o[te][0] + o[te][1] * o[te][1]) + (o[te][2] * o[te][2] + o[te][3] * o[te][3]); }
        ssq = quad_rows_sum(ssq);
        const float rs = 1.0f / sqrtf(ssq * (1.0f / 64.0f) + EPS);
#pragma unroll
        for (int te = 0; te < 4; ++te) { const int e0 = 16 * te + 4 * q;
            const u32x2 z2 = *(const u32x2*)(P + (size_t)(m0 + i) * NP + PC_GZ + hh * 64 + e0); const f32x4 gn = *(const f32x4*)(in.gdn_norm_g + layer * 64 + e0);
            const float z0 = __uint_as_float(z2.x << 16), z1 = __uint_as_float(z2.x & 0xffff0000u), z2f = __uint_as_float(z2.y << 16), z3 = __uint_as_float(z2.y & 0xffff0000u);
            u32x2 wv; wv.x = cvtpk(o[te][0] * rs * gn[0] * siluf(z0), o[te][1] * rs * gn[1] * siluf(z1)); wv.y = cvtpk(o[te][2] * rs * gn[2] * siluf(z2f), o[te][3] * rs * gn[3] * siluf(z3));
            *(u32x2*)(O + (size_t)(m0 + i) * D + 256 + hh * 64 + e0) = wv; }
    }
}


__device__ __forceinline__ void phase_gdn_scan3(Frame& F, int first_wg) {
    const int chain = F.bid - first_wg; if (chain < 0 || chain >= 32) return;
    const unsigned char* src = F.ws + WS_GCH + (size_t)chain * G2_CHAIN;
    const float* decs = (const float*)(F.ws + WS_GDEC) + chain * 68;
    unsigned char* GSTb = F.ws + WS_GST + (size_t)chain * 68 * 16384;
    LAS unsigned char* ring = F.lds;
    const int lane = F.lane, w = F.wave;
    if (w >= 4) {
        const int dw = w - 4;
#define GS3_ISSUE(step) do { _Pragma("unroll") for (int k = 0; k < 6; ++k) { const int p = dw * 6 + k; \
            __builtin_amdgcn_global_load_lds((const unsigned*)(src + (size_t)(step) * G2_STEP + p * 1024 + lane * 16), (LAS unsigned*)(ring + ((step) & 3) * 24576 + p * 1024), 16, 0, 0); } } while (0)
        GS3_ISSUE(0); GS3_ISSUE(1); GS3_ISSUE(2);
        asm volatile("s_waitcnt vmcnt(12)" ::: "memory"); __builtin_amdgcn_s_barrier();
        for (int n = 0; n < 68; ++n) {
            if (n + 3 < 68) { GS3_ISSUE(n + 3); asm volatile("s_waitcnt vmcnt(12)" ::: "memory"); }
            else if (n + 2 < 68) asm volatile("s_waitcnt vmcnt(6)" ::: "memory");
            else asm volatile("s_waitcnt vmcnt(0)" ::: "memory");
            __builtin_amdgcn_s_barrier();
        }
#undef GS3_ISSUE
    } else {
        const int sl = w;
        f32x4 S[4];
#pragma unroll
        for (int rt = 0; rt < 4; ++rt) S[rt] = (f32x4){0.f, 0.f, 0.f, 0.f};
        const float dv0 = decs[lane], dv1 = decs[64 + (lane & 3)];
        asm volatile("s_waitcnt vmcnt(0)" ::: "memory"); __builtin_amdgcn_s_barrier(); asm volatile("" ::: "memory");
        for (int n = 0; n < 68; ++n) {
            const LAS unsigned char* base = ring + (n & 3) * 24576;
            const float dec = n < 64 ? __shfl(dv0, n) : __shfl(dv1, n - 64);
            unsigned char* go = GSTb + (size_t)n * 16384 + (size_t)(sl * 2 * 64 + lane) * 16;
#define GS3_FRAG(mat, rt, ks) (*(const LAS bf16x8*)(base + (mat) * 8192 + (((rt) * 2 + (ks)) * 64 + lane) * 16))
            bf16x8 wf[4][2], kf[4][2]; u32x2 uf[4];
#pragma unroll
            for (int rt = 0; rt < 4; ++rt) { wf[rt][0] = GS3_FRAG(0, rt, 0); wf[rt][1] = GS3_FRAG(0, rt, 1); }
#pragma unroll
            for (int rt = 0; rt < 4; ++rt) uf[rt] = *(const LAS u32x2*)(base + 16384 + ((sl * 4 + rt) * 64 + lane) * 8);
#pragma unroll
            for (int rt = 0; rt < 4; ++rt) { kf[rt][0] = GS3_FRAG(1, rt, 0); kf[rt][1] = GS3_FRAG(1, rt, 1); }
#undef GS3_FRAG
            __builtin_amdgcn_sched_barrier(0);
            bf16x8 BS[2], BV[2];
#pragma unroll
            for (int ks = 0; ks < 2; ++ks) { u32x4 t; t.x = cvtpk(S[2 * ks][0], S[2 * ks][1]); t.y = cvtpk(S[2 * ks][2], S[2 * ks][3]); t.z = cvtpk(S[2 * ks + 1][0], S[2 * ks + 1][1]); t.w = cvtpk(S[2 * ks + 1][2], S[2 * ks + 1][3]);
                BS[ks] = __builtin_bit_cast(bf16x8, t); *(u32x4*)(go + ks * 1024) = t; }
            f32x4 vn[4];
#pragma unroll
            for (int ks = 0; ks < 2; ++ks)
#pragma unroll
                for (int rt = 0; rt < 4; ++rt) vn[rt] = mfma16(wf[rt][ks], BS[ks], ks ? vn[rt] : (f32x4){0.f, 0.f, 0.f, 0.f});
#pragma unroll
            for (int rt = 0; rt < 4; ++rt) { const u32x2 uu = uf[rt];
                vn[rt] = (f32x4){__uint_as_float(uu.x << 16), __uint_as_float(uu.x & 0xffff0000u), __uint_as_float(uu.y << 16), __uint_as_float(uu.y & 0xffff0000u)} - vn[rt]; }
#pragma unroll
            for (int ks = 0; ks < 2; ++ks) { u32x4 t; t.x = cvtpk(vn[2 * ks][0], vn[2 * ks][1]); t.y = cvtpk(vn[2 * ks][2], vn[2 * ks][3]); t.z = cvtpk(vn[2 * ks + 1][0], vn[2 * ks + 1][1]); t.w = cvtpk(vn[2 * ks + 1][2], vn[2 * ks + 1][3]);
                BV[ks] = __builtin_bit_cast(bf16x8, t); *(u32x4*)(go + 8192 + ks * 1024) = t; }
#pragma unroll
            for (int rt = 0; rt < 4; ++rt) S[rt] = S[rt] * dec;
#pragma unroll
            for (int ks = 0; ks < 2; ++ks)
#pragma unroll
                for (int rt = 0; rt < 4; ++rt) S[rt] = mfma16(kf[rt][ks], BV[ks], S[rt]);
            asm volatile("s_waitcnt lgkmcnt(0)" ::: "memory"); __builtin_amdgcn_s_barrier(); asm volatile("" ::: "memory");
        }
    }
}

__device__ __forceinline__ void phase_gdn_out2(Frame& F, const Inputs& in, int layer) {
    const bf16* P = (const bf16*)(F.ws + WS_R1 + R1_P);
    const bf16* GD = (const bf16*)(F.ws + WS_R1 + R1_PREP + PREP_GD);
    const unsigned char* GSTb = F.ws + WS_GST; const float* GCS = (const float*)(F.ws + WS_GCS);
    bf16* O = (bf16*)(F.ws + WS_R1 + R1_O);
    const int lane = F.lane, c = lane & 15, q = lane >> 4, w = F.wave, half = w >> 2, ti = w & 3, t2 = F.tid & 255;
    LAS bf16* Qs = (LAS bf16*)(F.lds + half * 56320); LAS bf16* Ks = Qs + 4608;
    LAS unsigned char* Fr = F.lds + half * 56320 + 18432;
    LAS float* gT = (LAS float*)(F.lds + half * 56320 + 55296);
    for (int pp = F.bid; pp < 8 * 68; pp += F.G) {
        const int uu = 2 * pp + half, bh = uu / 68, ch = uu % 68, b = bh >> 2, hh = bh & 3;
        const int m0 = ch < 4 ? b * TC + 64 * ch : MC + b * TL + 64 * (ch - 4);
        __syncthreads();
#pragma unroll
        for (int rep = 0; rep < 2; ++rep) { const int idx = t2 + 256 * rep, row = idx >> 3, col8 = (idx & 7) * 8;
            const bf16* src = GD + (size_t)(m0 + row) * 768 + hh * 64 + col8;
            *(LAS u32x4*)(Qs + row * 72 + col8) = *(const u32x4*)(src); *(LAS u32x4*)(Ks + row * 72 + col8) = *(const u32x4*)(src + 256); }
#pragma unroll
        for (int d = 0; d < 2; ++d) { const int sg = ch < 4 ? (d ? 3 - ch : ch) : 4 + (d ? 63 - (ch - 4) : ch - 4);
            const unsigned char* g = GSTb + ((size_t)(bh * 2 + d) * 68 + sg) * 16384;
#pragma unroll
            for (int rep = 0; rep < 4; ++rep) { const int idx = t2 + 256 * rep; *(LAS u32x4*)(Fr + d * 16384 + idx * 16) = *(const u32x4*)(g + (size_t)idx * 16); } }
        if (t2 < 128) gT[t2] = GCS[(size_t)uu * 128 + t2];
        __syncthreads();
        bf16x8 qf[2], qr[2];
#pragma unroll
        for (int ks = 0; ks < 2; ++ks) { qf[ks] = *(const LAS bf16x8*)(Qs + (16 * ti + c) * 72 + 32 * ks + 8 * q);
            const u32x2 lo = *(const LAS u32x2*)(Qs + (16 * ti + c) * 72 + 32 * ks + 4 * q), hi = *(const LAS u32x2*)(Qs + (16 * ti + c) * 72 + 32 * ks + 16 + 4 * q);
            qr[ks] = __builtin_bit_cast(bf16x8, ((u32x4){lo.x, lo.y, hi.x, hi.y})); }
        const int i = 16 * ti + c;
        const float gi0 = gT[i], gi1 = gT[64 + i];
        f32x4 sacc[4];
#pragma unroll
        for (int tj = 0; tj < 4; ++tj) { f32x4 acc = (f32x4){0.f, 0.f, 0.f, 0.f};
#pragma unroll
            for (int ks = 0; ks < 2; ++ks) acc = mfma16(*(const LAS bf16x8*)(Ks + (16 * tj + c) * 72 + 32 * ks + 8 * q), qf[ks], acc);
            sacc[tj] = acc; }
        bf16x8 pb[2][2];
#pragma unroll
        for (int d = 0; d < 2; ++d) { f32x4 p[4];
#pragma unroll
            for (int tj = 0; tj < 4; ++tj) { const f32x4 gj = *(const LAS f32x4*)(gT + d * 64 + 16 * tj + 4 * q);
#pragma unroll
                for (int r = 0; r < 4; ++r) { const int j = 16 * tj + 4 * q + r; const bool ok = d ? (j >= i) : (j <= i);
                    p[tj][r] = ok ? sacc[tj][r] * fexp(fminf((d ? gi1 : gi0) - gj[r], 0.f)) : 0.f; } }
#pragma unroll
            for (int ks2 = 0; ks2 < 2; ++ks2) { u32x4 t; t.x = cvtpk(p[2 * ks2][0], p[2 * ks2][1]); t.y = cvtpk(p[2 * ks2][2], p[2 * ks2][3]); t.z = cvtpk(p[2 * ks2 + 1][0], p[2 * ks2 + 1][1]); t.w = cvtpk(p[2 * ks2 + 1][2], p[2 * ks2 + 1][3]); pb[d][ks2] = __builtin_bit_cast(bf16x8, t); } }
        const float sc0 = fexp(gi0), sc1 = fexp(gi1);
        f32x4 o[4]; float ssq = 0.f;
#pragma unroll
        for (int te = 0; te < 4; ++te) { f32x4 acc = (f32x4){0.f, 0.f, 0.f, 0.f}, t0 = acc, t1 = acc;
#pragma unroll
            for (int ks = 0; ks < 2; ++ks) {
                acc = mfma16(*(const LAS bf16x8*)(Fr + 8192 + ((te * 2 + ks) * 64 + lane) * 16), pb[0][ks], acc);
                acc = mfma16(*(const LAS bf16x8*)(Fr + 16384 + 8192 + ((te * 2 + ks) * 64 + lane) * 16), pb[1][ks], acc);
                t0 = mfma16(*(const LAS bf16x8*)(Fr + ((te * 2 + ks) * 64 + lane) * 16), qr[ks], t0);
                t1 = mfma16(*(const LAS bf16x8*)(Fr + 16384 + ((te * 2 + ks) * 64 + lane) * 16), qr[ks], t1); }
            o[te] = acc + sc0 * t0 + sc1 * t1; ssq += (o[te][0] * o[te][0] + o[te][1] * o[te][1]) + (o[te][2] * o[te][2] + o[te][3] * o[te][3]); }
        ssq = quad_rows_sum(ssq);
        const float rs = 1.0f / sqrtf(ssq * (1.0f / 64.0f) + EPS);
#pragma unroll
        for (int te = 0; te < 4; ++te) { const int e0 = 16 * te + 4 * q;
            const u32x2 z2 = *(const u32x2*)(P + (size_t)(m0 + i) * NP + PC_GZ + hh * 64 + e0); const f32x4 gn = *(const f32x4*)(in.gdn_norm_g + layer * 64 + e0);
            const float z0 = __uint_as_float(z2.x << 16), z1 = __uint_as_float(z2.x & 0xffff0000u), z2f = __uint_as_float(z2.y << 16), z3 = __uint_as_float(z2.y & 0xffff0000u);
            u32x2 wv; wv.x = cvtpk(o[te][0] * rs * gn[0] * siluf(z0), o[te][1] * rs * gn[1] * siluf(z1)); wv.y = cvtpk(o[te][2] * rs * gn[2] * siluf(z2f), o[te][3] * rs * gn[3] * siluf(z3));
            *(u32x2*)(O + (size_t)(m0 + i) * D + 256 + hh * 64 + e0) = wv; }
    }
}

__device__ __forceinline__ void phase_ret_kv(Frame& F, const Inputs& in, int layer) {
    const bf16* P = (const bf16*)(F.ws + WS_R1 + R1_P);
    const bf16* RK = (const bf16*)(F.ws + WS_R1 + R1_PREP + PREP_RK);
    LAS bf16* Kt = (LAS bf16*)F.lds; LAS bf16* Vw = Kt + 64 * 72;
    const int lane = F.lane, c = lane & 15, q = lane >> 4, w = F.wave, tid = F.tid;
    const float LOG2E = 1.4426950408889634f;
    for (int uu = F.bid; uu < 16 * 68; uu += F.G) {
        const int bh = uu / 68, ch = uu % 68, b = bh >> 2, hh = bh & 3;
        const int m0 = ch < 4 ? b * TC + 64 * ch : MC + b * TL + 64 * (ch - 4);
        const float l0 = -fexp(in.ret_decay[layer * 8 + hh]) * LOG2E, l1 = -fexp(in.ret_decay[layer * 8 + 4 + hh]) * LOG2E;
        __syncthreads();
        { const int j = tid >> 3, col8 = (tid & 7) * 8;
          const u32x4 k8 = *(const u32x4*)(RK + (size_t)(m0 + j) * 256 + hh * 64 + col8), v8 = *(const u32x4*)(P + (size_t)(m0 + j) * NP + PC_RV + hh * 64 + col8);
          const float w0 = fexp2((float)(63 - j) * l0), w1 = fexp2((float)j * l1);
#pragma unroll
          for (int x = 0; x < 8; ++x) { const unsigned kk = (k8[x >> 1] >> (16 * (x & 1))) & 0xffffu; const float vv = __uint_as_float(((v8[x >> 1] >> (16 * (x & 1))) & 0xffffu) << 16);
              Kt[(col8 + x) * 72 + j] = (bf16)kk; Vw[(col8 + x) * 72 + j] = (bf16)f2bf(vv * w0); Vw[4608 + (col8 + x) * 72 + j] = (bf16)f2bf(vv * w1); } }
        __syncthreads();
        { const int d = w >> 2, td = w & 3;
          bf16x8 a[2];
#pragma unroll
          for (int ks = 0; ks < 2; ++ks) a[ks] = *(const LAS bf16x8*)(Kt + (16 * td + c) * 72 + 32 * ks + 8 * q);
          const int chain = bh * 2 + d, sg = d ? (ch < 4 ? 3 - ch : 71 - ch) : ch;
          float* dst = (float*)(F.ws + WS_RKV) + ((size_t)chain * 68 + sg) * 4096;
#pragma unroll
          for (int te = 0; te < 4; ++te) { f32x4 acc = (f32x4){0.f, 0.f, 0.f, 0.f};
#pragma unroll
              for (int ks = 0; ks < 2; ++ks) acc = mfma16(a[ks], *(const LAS bf16x8*)(Vw + d * 4608 + (16 * te + c) * 72 + 32 * ks + 8 * q), acc);
              *(f32x4*)(dst + (16 * te + c) * 64 + 16 * td + 4 * q) = acc; } }
    }
}
__device__ __forceinline__ void phase_ret_state(Frame& F, const Inputs& in, int layer, int nwg) {
    if (F.bid >= nwg) return;
    const float* RKV = (const float*)(F.ws + WS_RKV); bf16* RST = (bf16*)(F.ws + WS_RST);
    for (int el = F.bid * NTHR + F.tid; el < 32 * 4096; el += nwg * NTHR) {
        const int chain = el >> 12, idx = el & 4095, hh = (chain >> 1) & 3, d = chain & 1;
        const float G64 = fexp(-64.0f * fexp(in.ret_decay[layer * 8 + d * 4 + hh]));
        const float* kv = RKV + (size_t)chain * 68 * 4096 + idx; bf16* st = RST + (size_t)chain * 68 * 4096 + idx;
        float S = 0.f;
#pragma unroll
        for (int h2 = 0; h2 < 2; ++h2) { float kvv[34];
#pragma unroll
            for (int sg = 0; sg < 34; ++sg) kvv[sg] = kv[(size_t)(34 * h2 + sg) * 4096];
#pragma unroll
            for (int sg = 0; sg < 34; ++sg) { st[(size_t)(34 * h2 + sg) * 4096] = (bf16)f2bf(S); S = G64 * S + kvv[sg]; } }
    }
}
__device__ __forceinline__ void phase_ret_out(Frame& F, const Inputs& in, int layer) {
    const bf16* P = (const bf16*)(F.ws + WS_R1 + R1_P);
    const bf16* RQ = (const bf16*)(F.ws + WS_R1 + R1_PREP + PREP_RQ); const bf16* RK = (const bf16*)(F.ws + WS_R1 + R1_PREP + PREP_RK);
    const bf16* RST = (const bf16*)(F.ws + WS_RST);
    bf16* O = (bf16*)(F.ws + WS_R1 + R1_O);
    const int lane = F.lane, c = lane & 15, q = lane >> 4, w = F.wave, half = w >> 2, ti = w & 3, t2 = F.tid & 255;
    LAS bf16* Qs = (LAS bf16*)(F.lds + half * 46080); LAS bf16* Ks = Qs + 4608; LAS bf16* Vt = Ks + 4608; LAS bf16* St = Vt + 4608;
    const float LOG2E = 1.4426950408889634f;
    for (int pp = F.bid; pp < 8 * 68; pp += F.G) {
        const int uu = 2 * pp + half, bh = uu / 68, ch = uu % 68, b = bh >> 2, hh = bh & 3;
        const int m0 = ch < 4 ? b * TC + 64 * ch : MC + b * TL + 64 * (ch - 4);
        const float l0 = -fexp(in.ret_decay[layer * 8 + hh]) * LOG2E, l1 = -fexp(in.ret_decay[layer * 8 + 4 + hh]) * LOG2E;
        __syncthreads();
#pragma unroll
        for (int rep = 0; rep < 2; ++rep) { const int idx = t2 + 256 * rep, row = idx >> 3, col8 = (idx & 7) * 8;
            *(LAS u32x4*)(Qs + row * 72 + col8) = *(const u32x4*)(RQ + (size_t)(m0 + row) * 256 + hh * 64 + col8);
            *(LAS u32x4*)(Ks + row * 72 + col8) = *(const u32x4*)(RK + (size_t)(m0 + row) * 256 + hh * 64 + col8);
            const u32x4 v8 = *(const u32x4*)(P + (size_t)(m0 + row) * NP + PC_RV + hh * 64 + col8);
#pragma unroll
            for (int x = 0; x < 8; ++x) Vt[(col8 + x) * 72 + row] = (bf16)(v8[x >> 1] >> (16 * (x & 1)));
#pragma unroll
            for (int d = 0; d < 2; ++d) { const int sg = d ? (ch < 4 ? 3 - ch : 71 - ch) : ch;
                *(LAS u32x4*)(St + d * 4608 + row * 72 + col8) = *(const u32x4*)(RST + ((size_t)(bh * 2 + d) * 68 + sg) * 4096 + row * 64 + col8); } }
        __syncthreads();
        bf16x8 qf[2];
#pragma unroll
        for (int ks = 0; ks < 2; ++ks) qf[ks] = *(const LAS bf16x8*)(Qs + (16 * ti + c) * 72 + 32 * ks + 8 * q);
        const int i = 16 * ti + c;
        f32x4 p[4];
#pragma unroll
        for (int tj = 0; tj < 4; ++tj) { f32x4 acc = (f32x4){0.f, 0.f, 0.f, 0.f};
#pragma unroll
            for (int ks = 0; ks < 2; ++ks) acc = mfma16(*(const LAS bf16x8*)(Ks + (16 * tj + c) * 72 + 32 * ks + 8 * q), qf[ks], acc);
#pragma unroll
            for (int r = 0; r < 4; ++r) { const int dlt = i - (16 * tj + 4 * q + r);
                const float wgt = (dlt >= 0 ? fexp2((float)dlt * l0) : 0.f) + (dlt <= 0 ? fexp2((float)(-dlt) * l1) : 0.f);
                acc[r] *= wgt; }
            p[tj] = acc; }
        bf16x8 pb[2];
#pragma unroll
        for (int ks2 = 0; ks2 < 2; ++ks2) { u32x4 t; t.x = cvtpk(p[2 * ks2][0], p[2 * ks2][1]); t.y = cvtpk(p[2 * ks2][2], p[2 * ks2][3]); t.z = cvtpk(p[2 * ks2 + 1][0], p[2 * ks2 + 1][1]); t.w = cvtpk(p[2 * ks2 + 1][2], p[2 * ks2 + 1][3]); pb[ks2] = __builtin_bit_cast(bf16x8, t); }
        const float sc0 = fexp2((float)(i + 1) * l0), sc1 = fexp2((float)(64 - i) * l1);
        f32x4 o[4]; float sum = 0.f;
#pragma unroll
        for (int te = 0; te < 4; ++te) { f32x4 acc = (f32x4){0.f, 0.f, 0.f, 0.f}, t0 = acc, t1 = acc;
#pragma unroll
            for (int ks2 = 0; ks2 < 2; ++ks2) { const u32x2 lo = *(const LAS u32x2*)(Vt + (16 * te + c) * 72 + 32 * ks2 + 4 * q), hi = *(const LAS u32x2*)(Vt + (16 * te + c) * 72 + 32 * ks2 + 16 + 4 * q);
                acc = mfma16(__builtin_bit_cast(bf16x8, ((u32x4){lo.x, lo.y, hi.x, hi.y})), pb[ks2], acc); }
#pragma unroll
            for (int ks = 0; ks < 2; ++ks) { t0 = mfma16(*(const LAS bf16x8*)(St + (16 * te + c) * 72 + 32 * ks + 8 * q), qf[ks], t0);
                t1 = mfma16(*(const LAS bf16x8*)(St + 4608 + (16 * te + c) * 72 + 32 * ks + 8 * q), qf[ks], t1); }
            o[te] = acc + sc0 * t0 + sc1 * t1; sum += (o[te][0] + o[te][1]) + (o[te][2] + o[te][3]); }
        sum = quad_rows_sum(sum);
        const float mu = sum * (1.0f / 64.0f); float vs = 0.f;
#pragma unroll
        for (int te = 0; te < 4; ++te) { o[te] = o[te] - mu; vs += (o[te][0] * o[te][0] + o[te][1] * o[te][1]) + (o[te][2] * o[te][2] + o[te][3] * o[te][3]); }
        vs = quad_rows_sum(vs);
        const float rs = 1.0f / sqrtf(vs * (1.0f / 64.0f) + EPS);
#pragma unroll
        for (int te = 0; te < 4; ++te) { const int e0 = hh * 64 + 16 * te + 4 * q;
            const u32x2 g2 = *(const u32x2*)(P + (size_t)(m0 + i) * NP + PC_RG + e0); const f32x4 gn = *(const f32x4*)(in.ret_gn_g + layer * 256 + e0);
            const float g0 = __uint_as_float(g2.x << 16), g1 = __uint_as_float(g2.x & 0xffff0000u), g2f = __uint_as_float(g2.y << 16), g3 = __uint_as_float(g2.y & 0xffff0000u);
            u32x2 wv; wv.x = cvtpk(o[te][0] * rs * gn[0] * siluf(g0), o[te][1] * rs * gn[1] * siluf(g1)); wv.y = cvtpk(o[te][2] * rs * gn[2] * siluf(g2f), o[te][3] * rs * gn[3] * siluf(g3));
            *(u32x2*)(O + (size_t)(m0 + i) * D + e0) = wv; }
    }
}

__device__ __forceinline__ void phase_finish(Frame& F, const Inputs& in, int layer) {
    const bf16* P = (const bf16*)(F.ws + WS_R1 + R1_P);
    const float* OG = (const float*)(F.ws + WS_R1 + R1_OG);
    bf16* O = (bf16*)(F.ws + WS_R1 + R1_O);
    const int lane = F.lane;
    for (int m = F.gw; m < M; m += F.NGW) {
#pragma unroll
        for (int hh = 0; hh < 4; ++hh) {
            const float o2 = OG[(size_t)m * 256 + hh * 64 + lane] + OG[(size_t)(M + m) * 256 + hh * 64 + lane];
            const float ms = wave_sum(o2 * o2) * (1.0f / 64.0f);
            const float z = bf2f(P[(size_t)m * NP + PC_GZ + hh * 64 + lane]);
            const float y2 = o2 * (1.0f / sqrtf(ms + EPS)) * in.gdn_norm_g[layer * 64 + lane] * siluf(z);
            O[(size_t)m * D + 256 + hh * 64 + lane] = (bf16)f2bf(y2);
        }
    }
}

__device__ __forceinline__ void phase_route(Frame& F, int m_lo) {
    if (F.bid != 0) return;
    const int* TKE = (const int*)(F.ws + WS_TKE);
    int* TOKROW = (int*)(F.ws + WS_TOKROW); int* ROWTOK = (int*)(F.ws + WS_ROWTOK); int* TILEE = (int*)(F.ws + WS_TILEE);
    LAS int* cnt = (LAS int*)F.lds;
    LAS int* tot = cnt + 512 * 8;
    const int ntok = M - m_lo, per = (ntok + NTHR - 1) / NTHR;
    const int a0 = m_lo + F.tid * per, a1 = (a0 + per < M) ? a0 + per : M;
    int c[8];
#pragma unroll
    for (int e = 0; e < 8; ++e) c[e] = 0;
    for (int m = a0; m < a1; ++m) { const int e0 = TKE[2 * m], e1 = TKE[2 * m + 1];
#pragma unroll
        for (int e = 0; e < 8; ++e) c[e] += (e0 == e) + (e1 == e); }
#pragma unroll
    for (int e = 0; e < 8; ++e) cnt[F.tid * 8 + e] = c[e];
    __syncthreads();
    if (F.tid < 8) { int run = 0; for (int i = 0; i < NTHR; ++i) { const int v = cnt[i * 8 + F.tid]; cnt[i * 8 + F.tid] = run; run += v; } tot[F.tid] = run; }
    __syncthreads();
    if (F.tid == 0) { int st = 0; for (int e = 0; e < 8; ++e) { tot[8 + e] = st; const int pad = (tot[e] + 255) / 256 * 256;
            for (int tl = st / 256; tl < (st + pad) / 256; ++tl) TILEE[tl] = e; st += pad; }
        TILEE[256] = st / 256; }
    __syncthreads();
    int pos[8];
#pragma unroll
    for (int e = 0; e < 8; ++e) pos[e] = tot[8 + e] + cnt[F.tid * 8 + e];
    for (int m = a0; m < a1; ++m) {
#pragma unroll
        for (int k = 0; k < 2; ++k) { const int ee = TKE[2 * m + k]; int row = 0;
#pragma unroll
            for (int e = 0; e < 8; ++e) if (ee == e) { row = pos[e]; pos[e] = row + 1; }
            ROWTOK[row] = m; TOKROW[2 * m + k] = row; } }
    for (int e = 0; e < 8; ++e) { const int st = tot[8 + e] + tot[e], en = tot[8 + e] + (tot[e] + 255) / 256 * 256; for (int r = st + F.tid; r < en; r += NTHR) ROWTOK[r] = -1; }
}
__device__ __forceinline__ void phase_permute(Frame& F) {
    const int* ROWTOK = (const int*)(F.ws + WS_ROWTOK); const int nrows = ((const int*)(F.ws + WS_TILEE))[256] * 256;
    const bf16* H = (const bf16*)(F.ws + WS_H); bf16* HP = (bf16*)(F.ws + WS_HP);
    for (int r = F.gw; r < nrows; r += F.NGW) { const int tok = ROWTOK[r];
#pragma unroll
        for (int j = 0; j < 2; ++j) { u32x4 v = (u32x4){0u, 0u, 0u, 0u}; if (tok >= 0) v = *(const u32x4*)(H + (size_t)tok * D + 8 * F.lane + 512 * j); *(u32x4*)(HP + (size_t)r * D + 8 * F.lane + 512 * j) = v; } }
}


__device__ __forceinline__ void phase_permute2(Frame& F, int route_lo) {
    const int* TKE = (const int*)(F.ws + WS_TKE); int* TOKROW = (int*)(F.ws + WS_TOKROW); int* TILEE = (int*)(F.ws + WS_TILEE);
    const int* WGCNT = (const int*)(F.ws + WS_TILEE + 4096);
    const bf16* H = (const bf16*)(F.ws + WS_H); bf16* HP = (bf16*)(F.ws + WS_HP);
    LAS int* base = (LAS int*)F.lds;
    LAS int* tot = base + 256 * 8;
    __syncthreads();
    if (F.tid < 8) { int run = 0; for (int g = 0; g < F.G; ++g) { base[g * 8 + F.tid] = run; run += WGCNT[g * 8 + F.tid]; } tot[F.tid] = run; }
    __syncthreads();
    if (F.tid == 0) { int st = 0; for (int e = 0; e < 8; ++e) { tot[8 + e] = st; const int pad = (tot[e] + 255) / 256 * 256;
            if (F.bid == 0) for (int tl = st / 256; tl < (st + pad) / 256; ++tl) TILEE[tl] = e;
            st += pad; }
        if (F.bid == 0) TILEE[256] = st / 256; }
    __syncthreads();
    const int lane = F.lane;
    for (int m = route_lo + F.gw; m < M; m += F.NGW) {
        const int gwm = m < MC ? m : (int)((((long)(m - MC + 1)) * F.NGW - 1) / ML), wg = gwm >> 3;
        const int e0 = TKE[2 * m], e1 = TKE[2 * m + 1];
        const int r0 = tot[8 + e0] + base[wg * 8 + e0] + TOKROW[2 * m], r1 = tot[8 + e1] + base[wg * 8 + e1] + TOKROW[2 * m + 1];
        const u32x4 a = *(const u32x4*)(H + (size_t)m * D + 8 * lane), b = *(const u32x4*)(H + (size_t)m * D + 512 + 8 * lane);
        *(u32x4*)(HP + (size_t)r0 * D + 8 * lane) = a; *(u32x4*)(HP + (size_t)r0 * D + 512 + 8 * lane) = b;
        *(u32x4*)(HP + (size_t)r1 * D + 8 * lane) = a; *(u32x4*)(HP + (size_t)r1 * D + 512 + 8 * lane) = b;
        asm volatile("" ::: "memory");
        if (lane == 0) { TOKROW[2 * m] = r0; TOKROW[2 * m + 1] = r1; }
    }
    for (int e = 0; e < 8; ++e) { const int st = tot[8 + e] + tot[e], en = tot[8 + e] + (tot[e] + 255) / 256 * 256;
        for (int r = st + F.gw; r < en; r += F.NGW) { *(u32x4*)(HP + (size_t)r * D + 8 * lane) = (u32x4){0u, 0u, 0u, 0u}; *(u32x4*)(HP + (size_t)r * D + 512 + 8 * lane) = (u32x4){0u, 0u, 0u, 0u}; } }
}

constexpr int NPH = 12;
constexpr int PH_TOTAL = 1 + DEPTH * NPH + 1;
__host__ __device__ inline bool phase_exists(int ph) {
    if (ph == 0 || ph == PH_TOTAL - 1) return true;
    const int layer = (ph - 1) / NPH, j = (ph - 1) % NPH;
    if (!(layer & 1) && j >= 10) return false;
    if ((layer & 1) && j >= 11) return false;
    return true;
}
__global__ void __launch_bounds__(NTHR, 2) fwd_kernel(Args args) {
    extern __shared__ __attribute__((aligned(16))) unsigned char lds_raw[];
    Frame F;
    F.lds = (LAS unsigned char*)lds_raw;
    F.tid = threadIdx.x; F.lane = F.tid & 63; F.wave = __builtin_amdgcn_readfirstlane(F.tid >> 6);
    F.G = gridDim.x; F.bid = blockIdx.x; F.gw = blockIdx.x * NWAVES + F.wave; F.NGW = F.G * NWAVES; F.ws = args.ws;
    volatile LAS unsigned* MISC = (volatile LAS unsigned*)(F.lds + MISC_OFF);
    LAS unsigned long long* ptab = (LAS unsigned long long*)(F.lds + MISC_OFF + 128);
    if (F.tid < 32) MISC[F.tid] = 0u;
    if (PROBE_ON && F.tid == 65) { ((volatile LAS unsigned long long*)(F.lds + 132096))[0] = 0ull; ((volatile LAS unsigned long long*)(F.lds + 132096))[1] = 0ull; }
    if (F.tid == 64) { const Inputs& ai = args.in;
        ptab[0] = (unsigned long long)ai.x; ptab[1] = (unsigned long long)ai.c; ptab[2] = (unsigned long long)ai.ctx; ptab[3] = (unsigned long long)ai.c_ctx; ptab[4] = (unsigned long long)ai.ada_w; ptab[5] = (unsigned long long)ai.ada_b;
        ptab[6] = (unsigned long long)ai.norm1_g; ptab[7] = (unsigned long long)ai.w_in; ptab[8] = (unsigned long long)ai.ret_decay; ptab[9] = (unsigned long long)ai.ret_gn_g; ptab[10] = (unsigned long long)ai.gdn_conv_w; ptab[11] = (unsigned long long)ai.gdn_a_log;
        ptab[12] = (unsigned long long)ai.gdn_dt_bias; ptab[13] = (unsigned long long)ai.gdn_norm_g; ptab[14] = (unsigned long long)ai.swa_sink; ptab[15] = (unsigned long long)ai.w_out; ptab[16] = (unsigned long long)ai.norm2_g; ptab[17] = (unsigned long long)ai.ffn_w1;
        ptab[18] = (unsigned long long)ai.ffn_w3; ptab[19] = (unsigned long long)ai.ffn_w2; ptab[20] = (unsigned long long)ai.router_w; ptab[21] = (unsigned long long)ai.moe_w1; ptab[22] = (unsigned long long)ai.moe_w3; ptab[23] = (unsigned long long)ai.moe_w2; ptab[24] = (unsigned long long)ai.final_g; }
    __syncthreads();
    XcdBarrier bar; bar.bar = (unsigned*)(F.ws + WS_CTL) + CW_BAR; bar.x = 0; bar.st = nullptr;
    const int lo = args.ph_lo, hi = args.ph_hi;
    const bool multi = (hi - lo) > 1;
    if (multi) bar = xcd_barrier_post((unsigned*)(F.ws + WS_CTL) + CW_BAR, MISC + 8);
#define LAUNDER() GAS unsigned char* _w = (GAS unsigned char*)args.ws; asm volatile("" : "+s"(_w)); F.ws = (unsigned char*)_w; asm volatile("" ::: "memory"); { int _t = threadIdx.x; asm volatile("" : "+v"(_t)); int _b = blockIdx.x; asm volatile("" : "+s"(_b)); F.tid = _t; F.lane = _t & 63; F.wave = __builtin_amdgcn_readfirstlane(_t >> 6); F.bid = _b; F.gw = _b * NWAVES + F.wave; } const Inputs in = load_inputs(ptab)
#define RELAUNDER() do { GAS unsigned char* _w2 = (GAS unsigned char*)args.ws; asm volatile("" : "+s"(_w2)); F.ws = (unsigned char*)_w2; int _t = threadIdx.x; asm volatile("" : "+v"(_t)); int _b = blockIdx.x; asm volatile("" : "+s"(_b)); F.tid = _t; F.lane = _t & 63; F.wave = __builtin_amdgcn_readfirstlane(_t >> 6); F.bid = _b; F.gw = _b * NWAVES + F.wave; asm volatile("" ::: "memory"); } while (0)
#define IN(k) (lo <= (k) && (k) < hi)
#define STAMP(k) do { if (PROBE_ON && !(PROBE_CUSTOM) && blockIdx.x == 0 && threadIdx.x == 0) { volatile LAS unsigned long long* _st = (volatile LAS unsigned long long*)(F.lds + 132096); const unsigned long long _now = __builtin_amdgcn_s_memrealtime(), _prev = _st[0]; _st[0] = _now; \
    const int _ph = (k) - 1; bool _sel = false; if (_ph == 0) _sel = (PROBE_PRO) != 0; else if (_ph > 0) { const int _l = (_ph - 1) / NPH, _j = (_ph - 1) % NPH; _sel = (((PROBE_LMASK) >> _l) & 1u) && (((PROBE_JMASK) >> _j) & 1u); } if (_sel) _st[1] = _st[1] + (_now - _prev); } } while (0)
#define SEAM(k) do { if (IN(k) && IN((k) + 1)) { xcd_barrier(bar); STAMP((k) + 1); } } while (0)
    LAS unsigned char* ring = F.lds;

    STAMP(0);
    if (IN(0)) { LAUNDER(); phase_prologue(F, in); } SEAM(0);

#define LAYER_BODY(layer) { \
        const int p0 = 1 + layer * NPH; \
        const bool moe = layer & 1; \
        if (IN(p0 + 0)) { LAUNDER(); phase_token2<0>(F, in, layer, layer == 0, layer > 0 && ((layer - 1) & 1), false, nullptr, 0, (layer > 0 && !((layer - 1) & 1)) ? 11 : 0); if (layer == 2) { __syncthreads(); convert_moe_layer(F, in, 1); } } \
        SEAM(p0 + 0); \
        if (IN(p0 + 1)) { LAUNDER(); pg8::StaticOrder S; S.init(F.ws + WS_H, (bf16*)(F.ws + WS_WIN) + (size_t)layer * NP * D, M, NP, D, F.G, F.bid); \
            pg8::EpiBf16 E{(bf16*)(F.ws + WS_R1 + R1_P), NP}; pg8::gemm_phase<D, D, pg8::EpiBf16, pg8::StaticOrder>(ring, S, E, F.tid); } \
        SEAM(p0 + 1); \
        if (IN(p0 + 2)) { LAUNDER(); phase_prep2(F, in, layer); } \
        SEAM(p0 + 2); \
        if (IN(p0 + 3)) { LAUNDER(); PB(4); phase_gdn_local2(F); PE(4); RELAUNDER(); PB(5); phase_ret_kv(F, in, layer); PE(5); } \
        SEAM(p0 + 3); \
        if (IN(p0 + 4)) { LAUNDER(); PB(1); phase_gdn_scan3(F, F.G - 32); PE(1); RELAUNDER(); PB(2); phase_ret_state(F, in, layer, F.G - 32); PE(2); RELAUNDER(); PB(3); phase_swa2(F, in, layer, F.G - 32); PE(3); } \
        SEAM(p0 + 4); \
        if (IN(p0 + 5)) { LAUNDER(); PB(6); phase_ret_out(F, in, layer); PE(6); RELAUNDER(); PB(7); phase_gdn_out2(F, in, layer); PE(7); } \
        SEAM(p0 + 5); \
        if (IN(p0 + 6)) { LAUNDER(); \
            { pg8::StaticOrder S; S.init(F.ws + WS_R1 + R1_O, (bf16*)(F.ws + WS_WOUT) + (size_t)layer * D * D, ML, D, D, F.G, F.bid, 4); \
              pg8::EpiResid E{(float*)(F.ws + WS_XS), (const float*)(F.ws + WS_MOD) + (size_t)layer * 5 * 6 * D, 2}; pg8::gemm_phase<D, D, pg8::EpiResid, pg8::StaticOrder>(ring, S, E, F.tid); } \
            if (layer < DEPTH - 1) { RELAUNDER(); \
              pg8::SplitOrder S; S.init(F.ws + WS_R1 + R1_O, (bf16*)(F.ws + WS_WOUT) + (size_t)layer * D * D, D, 4, F.G, F.bid); \
              pg8::EpiSlab E{(float*)(F.ws + WS_R1 + 100 * MiB)}; pg8::gemm_phase<256, D, pg8::EpiSlab, pg8::SplitOrder>(ring, S, E, F.tid); } } \
        SEAM(p0 + 6); \
        if (IN(p0 + 7)) { LAUNDER(); phase_token2<1>(F, in, layer, false, false, moe, nullptr, layer == DEPTH - 1 ? MC : 0, layer < DEPTH - 1 ? 4 : 0); } \
        SEAM(p0 + 7); \
        if (!moe) { \
            if (IN(p0 + 8)) { LAUNDER(); pg8::StaticOrder S; S.init(F.ws + WS_H, (bf16*)(F.ws + WS_W13) + (size_t)(layer >> 1) * 2 * FF * D, M, 2 * FF, D, F.G, F.bid); \
                pg8::EpiSwiglu E{(bf16*)(F.ws + WS_R1 + R1_HID), FF}; pg8::gemm_phase<D, D, pg8::EpiSwiglu, pg8::StaticOrder>(ring, S, E, F.tid); } \
            SEAM(p0 + 8); \
            if (IN(p0 + 9)) { LAUNDER(); \
                { pg8::StaticOrder S; S.init(F.ws + WS_R1 + R1_HID, (bf16*)(F.ws + WS_W2) + (size_t)(layer >> 1) * D * FF, ML, D, FF, F.G, F.bid, 4); \
                  pg8::EpiResid E{(float*)(F.ws + WS_XS), (const float*)(F.ws + WS_MOD) + (size_t)layer * 5 * 6 * D, 5}; pg8::gemm_phase<FF, FF, pg8::EpiResid, pg8::StaticOrder>(ring, S, E, F.tid); } \
                { RELAUNDER(); \
                  pg8::SplitOrder S; S.init(F.ws + WS_R1 + R1_HID, (bf16*)(F.ws + WS_W2) + (size_t)(layer >> 1) * D * FF, FF, 11, F.G, F.bid); \
                  pg8::EpiSlab E{(float*)(F.ws + WS_R1 + 100 * MiB)}; pg8::gemm_phase<256, FF, pg8::EpiSlab, pg8::SplitOrder>(ring, S, E, F.tid); } } \
            if (IN(p0 + 9) && IN(p0 + NPH)) { xcd_barrier(bar); STAMP(p0 + 10); } \
        } else { \
            if (IN(p0 + 8)) { LAUNDER(); phase_permute2(F, layer == DEPTH - 1 ? MC : 0); } \
            SEAM(p0 + 8); \
            if (IN(p0 + 9)) { LAUNDER(); const int* tile_e = (const int*)(F.ws + WS_TILEE); const int ntiles = __builtin_amdgcn_readfirstlane(tile_e[256]); \
                pg8::GroupedOrder S; S.init(F.ws + WS_HP, F.ws + WS_MW13, ntiles, 2 * EF, D, F.G, F.bid, tile_e); \
                pg8::EpiSwiglu E{(bf16*)(F.ws + WS_R1 + R1_HID), EF}; pg8::gemm_phase<D, D, pg8::EpiSwiglu, pg8::GroupedOrder>(ring, S, E, F.tid); } \
            SEAM(p0 + 9); \
            if (IN(p0 + 10)) { LAUNDER(); const int* tile_e = (const int*)(F.ws + WS_TILEE); const int ntiles = __builtin_amdgcn_readfirstlane(tile_e[256]); \
                pg8::GroupedOrder S; S.init(F.ws + WS_R1 + R1_HID, F.ws + WS_MW2, ntiles, D, EF, F.G, F.bid, tile_e); \
                pg8::EpiF32 E{(float*)(F.ws + WS_YM), D}; pg8::gemm_phase<EF, EF, pg8::EpiF32, pg8::GroupedOrder>(ring, S, E, F.tid); } \
            if (IN(p0 + 10) && IN(p0 + NPH)) { xcd_barrier(bar); STAMP(p0 + 11); } \
        } \
    }
    LAYER_BODY(0) LAYER_BODY(1) LAYER_BODY(2) LAYER_BODY(3)
#undef LAYER_BODY
    if (IN(PH_TOTAL - 1)) { LAUNDER(); phase_token2<2>(F, in, DEPTH, false, true, false, args.out); }
    if (PROBE_ON && (int)blockIdx.x == ((PROBE_CUSTOM) ? (PROBE_BLOCK < 0 ? (int)gridDim.x + (PROBE_BLOCK) : (PROBE_BLOCK)) : 0) && threadIdx.x == 0) {
        STAMP(PH_TOTAL);
        const unsigned long long T = ((volatile LAS unsigned long long*)(F.lds + 132096))[1];
        const unsigned long long t0 = __builtin_amdgcn_s_memrealtime();
        while (__builtin_amdgcn_s_memrealtime() - t0 < 8ull * T) __builtin_amdgcn_s_sleep(8);
    }
#undef IN
#undef SEAM
}

extern "C" void kernel_launch(void* const* d_in, const int* in_sizes, int n_in, void* d_out, int out_size, void* d_ws, size_t ws_size, hipStream_t stream) {
    static int grid = 0;
    if (grid == 0) {
        if (n_in != 25 || out_size != ML * D || ws_size < WS_END) { fprintf(stderr, "kernel_launch: unexpected problem: n_in %d out %d ws %zu (need %zu)\n", n_in, out_size, ws_size, (size_t)WS_END); grid = -1; return; }
        int dev = 0, cus = 0, per_cu = 0;
        if (hipGetDevice(&dev) != hipSuccess || hipDeviceGetAttribute(&cus, hipDeviceAttributeMultiprocessorCount, dev) != hipSuccess) { grid = -1; return; }
        if (hipFuncSetAttribute((const void*)fwd_kernel, hipFuncAttributeMaxDynamicSharedMemorySize, LDS_BYTES) != hipSuccess) { fprintf(stderr, "kernel_launch: hipFuncSetAttribute failed\n"); grid = -1; return; }
        if (hipOccupancyMaxActiveBlocksPerMultiprocessor(&per_cu, (const void*)fwd_kernel, NTHR, LDS_BYTES) != hipSuccess || per_cu < 1) fprintf(stderr, "kernel_launch: occupancy query reports %d\n", per_cu);
        (void)hipGetLastError();
        grid = cus;
    }
    if (grid < 0) return;
    (void)hipMemsetAsync((char*)d_ws + WS_CTL, 0, CTL_ZERO_BYTES, stream);
    Args a{};
    const float** ip = (const float**)&a.in;
    for (int i = 0; i < 25; ++i) ip[i] = (const float*)d_in[i];
    a.out = (float*)d_out; a.ws = (unsigned char*)d_ws;
#if MK_ONE_LAUNCH
    a.ph_lo = 0; a.ph_hi = PH_TOTAL;
    hipLaunchKernelGGL(fwd_kernel, dim3(grid), dim3(NTHR), LDS_BYTES, stream, a);
#else
    for (int ph = 0; ph < PH_TOTAL; ++ph) { if (!phase_exists(ph)) continue; a.ph_lo = ph; a.ph_hi = ph + 1;
        hipLaunchKernelGGL(fwd_kernel, dim3(grid), dim3(NTHR), LDS_BYTES, stream, a); }
#endif
}
```

```cpp
#include <hip/hip_runtime.h>
#include <cstdio>
#include <cstdint>

#ifndef PROBE_JMASK
#define PROBE_JMASK 0u
#endif
#ifndef PROBE_LMASK
#define PROBE_LMASK 15u
#endif
#ifndef PROBE_PRO
#define PROBE_PRO 0
#endif
#ifndef PROBE_CUSTOM
#define PROBE_CUSTOM 0
#endif
#ifndef PROBE_BLOCK
#define PROBE_BLOCK 0
#endif
#define PROBE_ON ((PROBE_JMASK) != 0u || (PROBE_PRO) != 0 || (PROBE_CUSTOM) != 0)
#define PB(id) do { if ((PROBE_CUSTOM) == (id) && (int)blockIdx.x == (PROBE_BLOCK < 0 ? (int)gridDim.x + (PROBE_BLOCK) : (PROBE_BLOCK)) && threadIdx.x == 0) ((volatile LAS unsigned long long*)(F.lds + 132096))[2] = __builtin_amdgcn_s_memrealtime(); } while (0)
#define PE(id) do { if ((PROBE_CUSTOM) == (id) && (int)blockIdx.x == (PROBE_BLOCK < 0 ? (int)gridDim.x + (PROBE_BLOCK) : (PROBE_BLOCK)) && threadIdx.x == 0) { volatile LAS unsigned long long* _s = (volatile LAS unsigned long long*)(F.lds + 132096); _s[1] = _s[1] + (__builtin_amdgcn_s_memrealtime() - _s[2]); } } while (0)
#ifndef MK_ONE_LAUNCH
#define MK_ONE_LAUNCH 1
#endif

#define GAS __attribute__((address_space(1)))
#define LAS __attribute__((address_space(3)))
typedef unsigned short bf16;
typedef short bf16x8 __attribute__((ext_vector_type(8)));
typedef float f32x4 __attribute__((ext_vector_type(4)));
typedef float f32x2 __attribute__((ext_vector_type(2)));
typedef unsigned u32x4 __attribute__((ext_vector_type(4)));
typedef unsigned u32x2 __attribute__((ext_vector_type(2)));

constexpr int D = 1024, NB = 4, TL = 4096, TC = 256, DEPTH = 4;
constexpr int MC = NB * TC, ML = NB * TL, M = MC + ML;
constexpr int INC = 2832, NP = 2816;
constexpr int FF = 2816, EF = 3584, NE = 8;
constexpr int MAXROWS = 36864;
constexpr float EPS = 1e-6f;
constexpr int PC_RQ = 0, PC_RK = 256, PC_RV = 512, PC_RG = 768, PC_GQKV = 1024, PC_GZ = 1792, PC_SQ = 2048, PC_SK = 2560, PC_SV = 2688;

constexpr size_t MiB = 1u << 20;
constexpr size_t WS_CTL = 0, CTL_ZERO_BYTES = 1 * MiB;
constexpr size_t WS_MOD = 1 * MiB;
constexpr size_t WS_ROPE = 2 * MiB;
constexpr size_t WS_TKE = 3 * MiB, WS_TKG = 3 * MiB + 256 * 1024, WS_TOKROW = 3 * MiB + 512 * 1024, WS_ROWTOK = 3 * MiB + 768 * 1024, WS_TILEE = 4 * MiB;
constexpr size_t WS_AB = 5 * MiB, WS_GB = 7 * MiB;
constexpr size_t WS_WIN = 16 * MiB, WS_WOUT = 38 * MiB, WS_W13 = 46 * MiB, WS_W2 = 68 * MiB, WS_MW13 = 80 * MiB, WS_MW2 = 192 * MiB;
constexpr size_t WS_XS = 248 * MiB, WS_H = 316 * MiB, WS_HP = 350 * MiB, WS_YM = 422 * MiB, WS_R1 = 566 * MiB;
constexpr size_t R1_P = 0, R1_PREP = 94 * MiB, R1_O = 158 * MiB, R1_OR = 192 * MiB, R1_OG = 226 * MiB, R1_HID = 0;
constexpr size_t WS_END = WS_R1 + 260 * MiB;
constexpr size_t WS_GCH = WS_YM, GCH_STEP = 40960, GCH_CHAIN = 68 * GCH_STEP, WS_GDEC = WS_HP;
constexpr size_t G2_STEP = 24576, G2_CHAIN = 68 * G2_STEP;
constexpr size_t WS_GST = WS_YM + 56 * MiB;
constexpr size_t WS_GCS = WS_HP + 64 * 1024;
static_assert(32 * G2_CHAIN <= 56 * MiB && 32 * 68 * 16384 <= 40 * MiB, "gdn v2 buffers");
constexpr size_t WS_RKV = WS_YM + 96 * MiB;
constexpr size_t WS_RST = WS_HP + 1 * MiB;
static_assert(32 * GCH_CHAIN <= 144 * MiB, "gdn chunk data");
constexpr size_t PREP_RQ = 0, PREP_RK = (size_t)M * 256 * 2, PREP_SQ = (size_t)M * 512 * 2, PREP_SK = (size_t)M * 1024 * 2, PREP_GD = (size_t)M * 1152 * 2;
static_assert(PREP_GD + (size_t)M * 768 * 2 <= 64 * MiB, "prep");
static_assert((size_t)M * NP * 2 <= 94 * MiB && (size_t)MAXROWS * EF * 2 <= 260 * MiB, "r1");

constexpr int CW_TMO = 0, CW_BAR = 4096;

__device__ __forceinline__ float bf2f(bf16 v) { return __uint_as_float(((unsigned)v) << 16); }
__device__ __forceinline__ unsigned f2bf(float f) { unsigned u = __float_as_uint(f); return (u + 0x7fffu + ((u >> 16) & 1u)) >> 16; }
__device__ __forceinline__ unsigned pk2(float lo, float hi) { return f2bf(lo) | (f2bf(hi) << 16); }
template <int CTRL> __device__ __forceinline__ float dppf(float v) { return __int_as_float(__builtin_amdgcn_update_dpp(0, __float_as_int(v), CTRL, 0xF, 0xF, true)); }
__device__ __forceinline__ float row_sum16(float v) {
    v += dppf<0xB1>(v); v += dppf<0x4E>(v); v += dppf<0x141>(v); v += dppf<0x140>(v); return v; }
__device__ __forceinline__ float wave_sum(float v) {
    v = row_sum16(v);
    return __int_as_float(__builtin_amdgcn_readlane(__float_as_int(v), 0)) + __int_as_float(__builtin_amdgcn_readlane(__float_as_int(v), 16))
         + __int_as_float(__builtin_amdgcn_readlane(__float_as_int(v), 32)) + __int_as_float(__builtin_amdgcn_readlane(__float_as_int(v), 48)); }
__device__ __forceinline__ float quad_rows_sum(float v) {
    u32x2 r = __builtin_amdgcn_permlane16_swap(__float_as_uint(v), __float_as_uint(v), false, false); v = __uint_as_float(r.x) + __uint_as_float(r.y);
    r = __builtin_amdgcn_permlane32_swap(__float_as_uint(v), __float_as_uint(v), false, false); return __uint_as_float(r.x) + __uint_as_float(r.y); }
__device__ __forceinline__ float quad_rows_max(float v) {
    u32x2 r = __builtin_amdgcn_permlane16_swap(__float_as_uint(v), __float_as_uint(v), false, false); v = fmaxf(__uint_as_float(r.x), __uint_as_float(r.y));
    r = __builtin_amdgcn_permlane32_swap(__float_as_uint(v), __float_as_uint(v), false, false); return fmaxf(__uint_as_float(r.x), __uint_as_float(r.y)); }
__device__ __forceinline__ float fexp2(float x) { return __builtin_amdgcn_exp2f(x); }
__device__ __forceinline__ float fexp(float x) { return __builtin_amdgcn_exp2f(x * 1.4426950408889634f); }
__device__ __forceinline__ float siluf(float x) { return x * __builtin_amdgcn_rcpf(1.0f + fexp(-x)); }
#define LDS_WAIT() asm volatile("s_waitcnt lgkmcnt(0)" ::: "memory")
__device__ __forceinline__ f32x4 mfma16(bf16x8 a, bf16x8 b, f32x4 c) { return __builtin_amdgcn_mfma_f32_16x16x32_bf16(a, b, c, 0, 0, 0); }
__device__ __forceinline__ unsigned cvtpk(float lo, float hi) { unsigned r; asm volatile("v_cvt_pk_bf16_f32 %0, %1, %2" : "=v"(r) : "v"(lo), "v"(hi)); return r; }


namespace pg8 {
#define PG8_LAS __attribute__((address_space(3)))
constexpr int BM = 256, BK = 64, HALF = 128, HTB = HALF * BK * 2, STAGE_BYTES = 8 * HTB;
__host__ __device__ __forceinline__ int lds_byte(int r, int c) { const int st = (r >> 4) * 2 + (c >> 5), rr = r & 15, cc = c & 31, ob = rr * 64 + cc * 2; return st * 1024 + (ob ^ (((ob >> 9) & 1) << 5)); }
__host__ __device__ __forceinline__ void stage_rc(int b, int& R, int& C) { const int st = b / 1024, sb = b % 1024, swz = sb ^ (((sb >> 9) & 1) << 5); R = (st >> 1) * 16 + swz / 64; C = (st & 1) * 32 + (swz % 64) / 2; }
__host__ __device__ __forceinline__ int perm32(int rho) { const int n = rho >> 4, i = rho & 15; return 8 * (i >> 2) + 4 * n + (i & 3); }
struct Unit { int pm, pn, aux; const char* A; const char* B; };
__device__ __forceinline__ unsigned cvt_pk_bf16(float lo, float hi) { unsigned r; asm volatile("v_cvt_pk_bf16_f32 %0, %1, %2" : "=v"(r) : "v"(lo), "v"(hi)); return r; }

template <int K, int LD, class Epi, class Sched, bool ALIGN_EPI = true, bool SP2 = true>
__device__ __forceinline__ void gemm_phase(PG8_LAS unsigned char* lds, const Sched& S, const Epi& E, const int tid) {
    const int wid = __builtin_amdgcn_readfirstlane(tid >> 6), lane = tid & 63, wr = wid >> 2, wc = wid & 3, fr = lane & 15, fq = lane >> 4;
    constexpr int nt = K / BK;
    unsigned voffA[2], voffB[2];
#pragma unroll
    for (int i = 0; i < 2; ++i) { int R, C; stage_rc(tid * 16 + i * 8192, R, C); const int Rb = Epi::PERM ? ((R & ~31) + perm32(R & 31)) : R;
        voffA[i] = (unsigned)(R * LD + C) * 2u; voffB[i] = (unsigned)(Rb * LD + C) * 2u; }
    constexpr size_t kstep = (size_t)(BK * 2);
    constexpr size_t hstep = (size_t)HALF * LD * 2;
    const unsigned ldsw = (unsigned)wid * 1024u;
    const int aoff = lds_byte(wr * 64 + fr, fq * 8), boff = lds_byte(wc * 32 + fr, fq * 8);
#define PG8_SA(b, h) (((b) * 2 + (h)) * HTB)
#define PG8_SB(b, h) ((4 + (b) * 2 + (h)) * HTB)
#define PG8_STAGE(bufoff, gbase, voff) do { _Pragma("unroll") for (int _i = 0; _i < 2; ++_i) \
        __builtin_amdgcn_global_load_lds((const unsigned*)((const char*)(gbase) + (voff)[_i]), (PG8_LAS unsigned*)(lds + (bufoff) + ldsw + _i * 8192), 16, 0, 0); } while (0)
#define PG8_LDA(dst, b, h) do { _Pragma("unroll") for (int m = 0; m < 4; ++m) _Pragma("unroll") for (int k = 0; k < 2; ++k) dst[m][k] = *(const PG8_LAS bf16x8*)(lds + PG8_SA(b, h) + aoff + m * 2048 + k * 1024); } while (0)
#define PG8_LDB(dst, b, h) do { _Pragma("unroll") for (int n = 0; n < 2; ++n) _Pragma("unroll") for (int k = 0; k < 2; ++k) dst[n][k] = *(const PG8_LAS bf16x8*)(lds + PG8_SB(b, h) + boff + n * 2048 + k * 1024); } while (0)
#define PG8_MMA(ai, bj, At, Bt) do { __builtin_amdgcn_s_setprio(1); _Pragma("unroll") for (int m = 0; m < 4; ++m) _Pragma("unroll") for (int n = 0; n < 2; ++n) _Pragma("unroll") for (int k = 0; k < 2; ++k) \
        acc[ai][bj][m][n] = __builtin_amdgcn_mfma_f32_16x16x32_bf16(Bt[n][k], At[m][k], acc[ai][bj][m][n], 0, 0, 0); __builtin_amdgcn_s_setprio(0); } while (0)
#define PG8_WAIT_V(n) asm volatile("s_waitcnt vmcnt(" #n ")" ::: "memory")
#define PG8_WAIT_L(n) asm volatile("s_waitcnt lgkmcnt(" #n ")" ::: "memory")
#define PG8_BAR __builtin_amdgcn_s_barrier()
#define PG8_SCHED __builtin_amdgcn_sched_barrier(0)
    Unit cur, nxt; int ui = 0;
    if (!S.next(0, cur)) return;
    f32x4 acc[2][2][4][2];
#pragma unroll
    for (int a = 0; a < 2; ++a)
#pragma unroll
        for (int b = 0; b < 2; ++b)
#pragma unroll
            for (int m = 0; m < 4; ++m)
#pragma unroll
                for (int n = 0; n < 2; ++n) acc[a][b][m][n] = (f32x4){0.f, 0.f, 0.f, 0.f};
    bf16x8 At[4][2], B0[2][2], B1[2][2];
    const char* cA = cur.A; const char* cB = cur.B;
    if constexpr (SP2) {
        PG8_STAGE(PG8_SB(0, 0), cB, voffB); PG8_STAGE(PG8_SB(0, 1), cB + hstep, voffB); PG8_STAGE(PG8_SA(0, 0), cA, voffA); PG8_STAGE(PG8_SA(0, 1), cA + hstep, voffA);
        if (wr == 1) PG8_BAR;
        PG8_WAIT_V(2); PG8_BAR;
        PG8_STAGE(PG8_SB(1, 0), cB + kstep, voffB); PG8_STAGE(PG8_SA(1, 0), cA + kstep, voffA); PG8_STAGE(PG8_SB(1, 1), cB + hstep + kstep, voffB);
        PG8_WAIT_V(6); PG8_BAR;
    } else {
        PG8_STAGE(PG8_SB(0, 0), cB, voffB); PG8_STAGE(PG8_SA(0, 0), cA, voffA); PG8_STAGE(PG8_SB(0, 1), cB + hstep, voffB); PG8_STAGE(PG8_SA(0, 1), cA + hstep, voffA);
        if (wr == 1) PG8_BAR;
        PG8_WAIT_V(4); PG8_BAR;
        PG8_STAGE(PG8_SB(1, 0), cB + kstep, voffB); PG8_STAGE(PG8_SA(1, 0), cA + kstep, voffA); PG8_STAGE(PG8_SB(1, 1), cB + hstep + kstep, voffB);
        PG8_WAIT_V(6); PG8_BAR;
    }
    for (;;) {
        const bool has_next = S.next(ui + 1, nxt);
        const char* nA = has_next ? nxt.A : cA; const char* nB = has_next ? nxt.B : cB;
        for (int t = 0; t < nt; t += 2) {
            const bool last = (t == nt - 2);
            const char* a1 = cA + (size_t)(t + 1) * kstep;
            const char* a2 = last ? nA : cA + (size_t)(t + 2) * kstep; const char* b2 = last ? nB : cB + (size_t)(t + 2) * kstep;
            const char* a3 = a2 + kstep; const char* b3 = b2 + kstep;
            if constexpr (SP2) {
            PG8_LDB(B0, 0, 0); PG8_LDB(B1, 0, 1); PG8_SCHED; PG8_LDA(At, 0, 0); PG8_STAGE(PG8_SA(1, 1), a1 + hstep, voffA);
            PG8_WAIT_V(8); PG8_WAIT_L(0); PG8_BAR; PG8_MMA(0, 0, At, B0); PG8_MMA(0, 1, At, B1); PG8_BAR; PG8_SCHED;
            PG8_LDA(At, 0, 1); PG8_STAGE(PG8_SB(0, 0), b2, voffB); PG8_STAGE(PG8_SB(0, 1), b2 + hstep, voffB); PG8_STAGE(PG8_SA(0, 0), a2, voffA);
            PG8_WAIT_V(8); PG8_WAIT_L(0); PG8_BAR; PG8_MMA(1, 0, At, B0); PG8_MMA(1, 1, At, B1); PG8_BAR; PG8_SCHED;
            PG8_LDB(B0, 1, 0); PG8_LDB(B1, 1, 1); PG8_SCHED; PG8_LDA(At, 1, 0); PG8_STAGE(PG8_SA(0, 1), a2 + hstep, voffA);
            PG8_WAIT_V(8); PG8_WAIT_L(0); PG8_BAR; PG8_MMA(0, 0, At, B0); PG8_MMA(0, 1, At, B1); PG8_BAR; PG8_SCHED;
            PG8_LDA(At, 1, 1); PG8_STAGE(PG8_SB(1, 0), b3, voffB); PG8_STAGE(PG8_SB(1, 1), b3 + hstep, voffB); PG8_STAGE(PG8_SA(1, 0), a3, voffA);
            PG8_WAIT_V(8); PG8_WAIT_L(0); PG8_BAR; PG8_MMA(1, 0, At, B0); PG8_MMA(1, 1, At, B1); PG8_BAR; PG8_SCHED;
            } else {
            PG8_LDB(B0, 0, 0); PG8_SCHED; PG8_LDA(At, 0, 0); PG8_STAGE(PG8_SA(1, 1), a1 + hstep, voffA);
            PG8_WAIT_L(8); PG8_BAR; PG8_WAIT_L(0); PG8_MMA(0, 0, At, B0); PG8_BAR; PG8_SCHED;
            PG8_LDB(B1, 0, 1); PG8_STAGE(PG8_SB(0, 0), b2, voffB);
            PG8_BAR; PG8_WAIT_L(0); PG8_MMA(0, 1, At, B1); PG8_BAR;
            PG8_LDA(At, 0, 1); PG8_STAGE(PG8_SA(0, 0), a2, voffA);
            PG8_BAR; PG8_WAIT_L(0); PG8_MMA(1, 0, At, B0); PG8_BAR; PG8_SCHED;
            PG8_STAGE(PG8_SB(0, 1), b2 + hstep, voffB);
            PG8_WAIT_V(6); PG8_BAR; PG8_MMA(1, 1, At, B1); PG8_BAR;
            PG8_LDB(B0, 1, 0); PG8_SCHED; PG8_LDA(At, 1, 0); PG8_STAGE(PG8_SA(0, 1), a2 + hstep, voffA);
            PG8_WAIT_L(8); PG8_BAR; PG8_WAIT_L(0); PG8_MMA(0, 0, At, B0); PG8_BAR; PG8_SCHED;
            PG8_LDB(B1, 1, 1); PG8_STAGE(PG8_SB(1, 0), b3, voffB);
            PG8_BAR; PG8_WAIT_L(0); PG8_MMA(0, 1, At, B1); PG8_BAR;
            PG8_LDA(At, 1, 1); PG8_STAGE(PG8_SA(1, 0), a3, voffA);
            PG8_BAR; PG8_WAIT_L(0); PG8_MMA(1, 0, At, B0); PG8_BAR; PG8_SCHED;
            PG8_STAGE(PG8_SB(1, 1), b3 + hstep, voffB);
            PG8_WAIT_V(6); PG8_BAR; PG8_MMA(1, 1, At, B1); PG8_BAR;
            }
        }
        if constexpr (ALIGN_EPI) { if (wr == 0) PG8_BAR; }
        E(acc, cur, wr, wc, fr, fq);
        if (!has_next) break;
#pragma unroll
        for (int a = 0; a < 2; ++a)
#pragma unroll
            for (int b = 0; b < 2; ++b)
#pragma unroll
                for (int m = 0; m < 4; ++m)
#pragma unroll
                    for (int n = 0; n < 2; ++n) acc[a][b][m][n] = (f32x4){0.f, 0.f, 0.f, 0.f};
        cur = nxt; cA = nA; cB = nB; ++ui;
        if constexpr (ALIGN_EPI) { if (wr == 1) PG8_BAR; }
    }
    PG8_WAIT_V(0);
    if constexpr (!ALIGN_EPI) { if (wr == 0) PG8_BAR; }
    PG8_BAR;
#undef PG8_SA
#undef PG8_SB
#undef PG8_STAGE
#undef PG8_LDA
#undef PG8_LDB
#undef PG8_MMA
#undef PG8_WAIT_V
#undef PG8_WAIT_L
#undef PG8_BAR
#undef PG8_SCHED
}

struct StaticOrder {
    int nM, nN, nwg, G, c, pm_off; const char* A; const char* Bt; size_t tstep;
    __device__ void init(const void* A_, const void* Bt_, int M_, int N_, int K_, int G_, int c_, int pm_off_ = 0) { A = (const char*)A_; Bt = (const char*)Bt_; nM = M_ / BM; nN = N_ / BM; nwg = nM * nN; G = G_; c = c_; pm_off = pm_off_; tstep = (size_t)BM * K_ * 2; }
    __device__ bool next(int i, Unit& u) const {
        const long L = (long)i * G + c; if (L >= nwg) return false;
        int wgid = (int)L; { const int q = nwg / 8, r = nwg % 8, xcd = wgid % 8, off = wgid / 8; wgid = (xcd < r ? xcd * (q + 1) : r * (q + 1) + (xcd - r) * q) + off; }
        const int nig = 8 * nN, gid = wgid / nig, fm = gid * 8, gsz = (nM - fm) < 8 ? (nM - fm) : 8;
        u.pm = fm + ((wgid % nig) % gsz) + pm_off; u.pn = (wgid % nig) / gsz; u.aux = 0;
        u.A = A + (size_t)u.pm * tstep; u.B = Bt + (size_t)u.pn * tstep; return true;
    }
};
struct SplitOrder {
    int nks, nsub, G, c; const char* A; const char* Bt; size_t tstep;
    __device__ void init(const void* A_, const void* Bt_, int LD_, int nks_, int G_, int c_) { A = (const char*)A_; Bt = (const char*)Bt_; nks = nks_; nsub = 16 * nks_; G = G_; c = c_; tstep = (size_t)BM * LD_ * 2; }
    __device__ bool next(int i, Unit& u) const {
        const int L = i * G + c; if (L >= nsub) return false;
        const int ksl = L % nks, t = L / nks; u.pm = t >> 2; u.pn = t & 3; u.aux = ksl;
        u.A = A + (size_t)u.pm * tstep + (size_t)ksl * 512; u.B = Bt + (size_t)u.pn * tstep + (size_t)ksl * 512; return true;
    }
};
struct GroupedOrder {
    int nM, nN, nwg, G, c; const char* A; const char* Bt; size_t tstep, estep; const int* tile_e;
    __device__ void init(const void* A_, const void* Bt_, int ntiles, int N_, int K_, int G_, int c_, const int* te) { A = (const char*)A_; Bt = (const char*)Bt_; nM = ntiles; nN = N_ / BM; nwg = nM * nN; G = G_; c = c_; tstep = (size_t)BM * K_ * 2; estep = (size_t)N_ * K_ * 2; tile_e = te; }
    __device__ bool next(int i, Unit& u) const {
        const long L = (long)i * G + c; if (L >= nwg) return false;
        int wgid = (int)L; { const int q = nwg / 8, r = nwg % 8, xcd = wgid % 8, off = wgid / 8; wgid = (xcd < r ? xcd * (q + 1) : r * (q + 1) + (xcd - r) * q) + off; }
        const int nig = 8 * nN, gid = wgid / nig, fm = gid * 8, gsz = (nM - fm) < 8 ? (nM - fm) : 8;
        u.pm = fm + ((wgid % nig) % gsz); u.pn = (wgid % nig) / gsz; u.aux = __builtin_amdgcn_readfirstlane(tile_e[u.pm]);
        u.A = A + (size_t)u.pm * tstep; u.B = Bt + (size_t)u.aux * estep + (size_t)u.pn * tstep; return true;
    }
};

struct SplitGroupedOrder {
    int t0, nsub, G, c; const char* A; const char* Bt; size_t tstep, estep; const int* tile_e;
    __device__ void init(const void* A_, const void* Bt_, int t0_, int nt_, int G_, int c_, const int* te) { A = (const char*)A_; Bt = (const char*)Bt_; t0 = t0_; nsub = nt_ * 16; G = G_; c = c_; tstep = (size_t)BM * EF * 2; estep = (size_t)D * EF * 2; tile_e = te; }
    __device__ bool next(int i, Unit& u) const {
        const int L = i * G + c; if (L >= nsub) return false;
        const int ksl = L & 3, t = L >> 2; u.pm = t0 + (t >> 2); u.pn = t & 3; u.aux = ksl;
        const int e = __builtin_amdgcn_readfirstlane(tile_e[u.pm]);
        u.A = A + (size_t)u.pm * tstep + (size_t)ksl * 896 * 2; u.B = Bt + (size_t)e * estep + (size_t)u.pn * tstep + (size_t)ksl * 896 * 2; return true;
    }
};
struct EpiBf16 {
    static constexpr bool PERM = true;
    bf16* O; int ldc;
    __device__ __forceinline__ void operator()(const f32x4 (&acc)[2][2][4][2], const Unit& u, int wr, int wc, int fr, int fq) const {
        const int row0 = u.pm * BM + wr * 64 + fr, col0 = u.pn * BM + wc * 32 + 8 * fq;
#pragma unroll
        for (int ai = 0; ai < 2; ++ai)
#pragma unroll
            for (int m = 0; m < 4; ++m) { bf16* rowp = O + (size_t)(row0 + ai * HALF + m * 16) * ldc + col0;
#pragma unroll
                for (int bj = 0; bj < 2; ++bj) { const f32x4 v0 = acc[ai][bj][m][0], v1 = acc[ai][bj][m][1];
                    u32x4 w; w.x = cvt_pk_bf16(v0[0], v0[1]); w.y = cvt_pk_bf16(v0[2], v0[3]); w.z = cvt_pk_bf16(v1[0], v1[1]); w.w = cvt_pk_bf16(v1[2], v1[3]);
                    *(u32x4*)(rowp + bj * HALF) = w; } }
    }
};
struct EpiResid {
    static constexpr bool PERM = false;
    float* X; const float* mod; int gsel;
    __device__ __forceinline__ void operator()(const f32x4 (&acc)[2][2][4][2], const Unit& u, int wr, int wc, int fr, int fq) const {
        const int row0 = u.pm * BM + wr * 64 + fr, col0 = u.pn * BM + wc * 32 + 4 * fq;
        const int r = u.pm < 4 ? 4 : ((u.pm - 4) >> 4);
        const float* g = mod + (size_t)r * 6 * D + gsel * D;
        f32x4 gv[2][2];
#pragma unroll
        for (int bj = 0; bj < 2; ++bj)
#pragma unroll
            for (int n = 0; n < 2; ++n) gv[bj][n] = *(const f32x4*)(g + col0 + bj * HALF + n * 16);
#pragma unroll
        for (int ai = 0; ai < 2; ++ai)
#pragma unroll
            for (int m = 0; m < 4; ++m) { float* rowp = X + (size_t)(row0 + ai * HALF + m * 16) * D + col0;
#pragma unroll
                for (int bj = 0; bj < 2; ++bj)
#pragma unroll
                    for (int n = 0; n < 2; ++n) { f32x4 x = *(f32x4*)(rowp + bj * HALF + n * 16); x += gv[bj][n] * acc[ai][bj][m][n]; *(f32x4*)(rowp + bj * HALF + n * 16) = x; } }
    }
};
struct EpiSwiglu {
    static constexpr bool PERM = false;
    bf16* Hd; int ldh;
    __device__ __forceinline__ void operator()(const f32x4 (&acc)[2][2][4][2], const Unit& u, int wr, int wc, int fr, int fq) const {
        const int row0 = u.pm * BM + wr * 64 + fr, col0 = u.pn * 128 + wc * 16 + 4 * fq;
#pragma unroll
        for (int ai = 0; ai < 2; ++ai)
#pragma unroll
            for (int m = 0; m < 4; ++m) { bf16* rowp = Hd + (size_t)(row0 + ai * HALF + m * 16) * ldh + col0;
#pragma unroll
                for (int bj = 0; bj < 2; ++bj) { const f32x4 a = acc[ai][bj][m][0], b = acc[ai][bj][m][1];
                    float h[4];
#pragma unroll
                    for (int j = 0; j < 4; ++j) h[j] = a[j] * __builtin_amdgcn_rcpf(1.0f + __builtin_amdgcn_exp2f(-1.4426950408889634f * a[j])) * b[j];
                    u32x2 w; w.x = cvt_pk_bf16(h[0], h[1]); w.y = cvt_pk_bf16(h[2], h[3]);
                    *(u32x2*)(rowp + bj * 64) = w; } }
    }
};
struct EpiF32 {
    static constexpr bool PERM = false;
    float* C; int ldc;
    __device__ __forceinline__ void operator()(const f32x4 (&acc)[2][2][4][2], const Unit& u, int wr, int wc, int fr, int fq) const {
        const int row0 = u.pm * BM + wr * 64 + fr, col0 = u.pn * BM + wc * 32 + 4 * fq;
#pragma unroll
        for (int ai = 0; ai < 2; ++ai)
#pragma unroll
            for (int m = 0; m < 4; ++m) { float* rowp = C + (size_t)(row0 + ai * HALF + m * 16) * ldc + col0;
#pragma unroll
                for (int bj = 0; bj < 2; ++bj)
#pragma unroll
                    for (int n = 0; n < 2; ++n) *(f32x4*)(rowp + bj * HALF + n * 16) = acc[ai][bj][m][n]; }
    }
};
struct EpiSlab {
    static constexpr bool PERM = false;
    float* C;
    __device__ __forceinline__ void operator()(const f32x4 (&acc)[2][2][4][2], const Unit& u, int wr, int wc, int fr, int fq) const {
        const int row0 = u.pm * BM + wr * 64 + fr, col0 = u.pn * BM + wc * 32 + 4 * fq;
        float* base = C + (size_t)u.aux * MC * D;
#pragma unroll
        for (int ai = 0; ai < 2; ++ai)
#pragma unroll
            for (int m = 0; m < 4; ++m) { float* rowp = base + (size_t)(row0 + ai * HALF + m * 16) * D + col0;
#pragma unroll
                for (int bj = 0; bj < 2; ++bj)
#pragma unroll
                    for (int n = 0; n < 2; ++n) *(f32x4*)(rowp + bj * HALF + n * 16) = acc[ai][bj][m][n]; }
    }
};
struct EpiYMSlab {
    static constexpr bool PERM = false;
    float* YMp; float* slab; int row0s;
    __device__ __forceinline__ void operator()(const f32x4 (&acc)[2][2][4][2], const Unit& u, int wr, int wc, int fr, int fq) const {
        const int row0 = u.pm * BM + wr * 64 + fr, col0 = u.pn * BM + wc * 32 + 4 * fq;
        float* base = u.aux == 0 ? YMp + (size_t)row0 * D : slab + ((size_t)(u.aux - 1) * 4096 + (row0 - row0s)) * D;
#pragma unroll
        for (int ai = 0; ai < 2; ++ai)
#pragma unroll
            for (int m = 0; m < 4; ++m) { float* rowp = base + (size_t)(ai * HALF + m * 16) * D + col0;
#pragma unroll
                for (int bj = 0; bj < 2; ++bj)
#pragma unroll
                    for (int n = 0; n < 2; ++n) *(f32x4*)(rowp + bj * HALF + n * 16) = acc[ai][bj][m][n]; }
    }
};
}

#define XB_TMO      128
#define XB_XCNT(j)  (256  + 64 * (j))
#define XB_XSUB(j)  (1280 + 64 * (j))
#define XB_XGEN(j)  (2304 + 64 * (j))
#define XB_TOP      3328
#define XB_TOPGEN   3392
#define XCD_BAR_WORDS 3456
#define XB_SPIN_CAP (1u << 22)
__device__ __forceinline__ unsigned xb_ld(unsigned* p)              { return __hip_atomic_load(p, __ATOMIC_RELAXED, __HIP_MEMORY_SCOPE_AGENT); }
__device__ __forceinline__ unsigned xb_add(unsigned* p, unsigned v) { return __hip_atomic_fetch_add(p, v, __ATOMIC_RELAXED, __HIP_MEMORY_SCOPE_AGENT); }
__device__ __forceinline__ unsigned xb_xcc_id() { return (unsigned)__builtin_amdgcn_s_getreg((3 << 11) | 20) & 0xFu; }
#define XB_SPIN(cond, bar) do { unsigned _sp = 0; while (cond) { __builtin_amdgcn_s_sleep(1); \
    if ((++_sp & 255u) == 0u) { if (xb_ld(&(bar)[XB_TMO])) break; if (_sp > XB_SPIN_CAP) { atomicAdd(&(bar)[XB_TMO], 1u); break; } } } } while (0)
struct XcdBarrier { unsigned* bar; unsigned x; volatile LAS unsigned* st; };
__device__ __forceinline__ XcdBarrier xcd_barrier_post(unsigned* bar, volatile LAS unsigned* st) {
    XcdBarrier b; b.bar = bar; b.x = xb_xcc_id(); b.st = st;
    if (threadIdx.x == 0) (void)xb_add(&bar[XB_XCNT(b.x)], 1u);
    return b;
}
__device__ __forceinline__ void xcd_barrier_complete(unsigned* bar, unsigned x, unsigned& nloc, unsigned& nx) {
    const unsigned G = gridDim.x * gridDim.y * gridDim.z;
    unsigned sum, cnt, mine, sp = 0u;
    for (;;) {
        sum = 0u; cnt = 0u; mine = 0u;
#pragma unroll
        for (unsigned j = 0; j < 16; ++j) { const unsigned c = xb_ld(&bar[XB_XCNT(j)]); sum += c; cnt += (c > 0u) ? 1u : 0u; mine = (j == x) ? c : mine; }
        if (sum == G) break;
        __builtin_amdgcn_s_sleep(1);
        if ((++sp & 255u) == 0u) { if (xb_ld(&bar[XB_TMO])) break; if (sp > XB_SPIN_CAP) { atomicAdd(&bar[XB_TMO], 1u); break; } }
    }
    nloc = mine > 0u ? mine : 1u; nx = cnt > 0u ? cnt : 1u;
}
__device__ __forceinline__ void xcd_barrier(const XcdBarrier& b) {
    asm volatile("s_waitcnt vmcnt(0)" ::: "memory");
    __syncthreads();
    if (threadIdx.x == 0) {
        unsigned* bar = b.bar; unsigned bx = b.x;
        asm volatile("" : "+s"(bar), "+s"(bx));
        __builtin_amdgcn_s_waitcnt(0);
        unsigned nloc = b.st[0], nx = b.st[1];
        if (nloc == 0u) { xcd_barrier_complete(bar, bx, nloc, nx); b.st[0] = nloc; b.st[1] = nx; }
        const unsigned old = xb_add(&bar[XB_XSUB(bx)], 1u);
        const unsigned gen = old / nloc;
        if (old + 1u == (gen + 1u) * nloc) {
            __builtin_amdgcn_fence(__ATOMIC_RELEASE, "agent");
            asm volatile("s_waitcnt vmcnt(0)" ::: "memory");
            const unsigned og = xb_add(&bar[XB_TOP], 1u);
            const unsigned tg = og / nx;
            if (og + 1u == (tg + 1u) * nx) xb_add(&bar[XB_TOPGEN], 1u);
            else XB_SPIN(xb_ld(&bar[XB_TOPGEN]) == tg, bar);
            __builtin_amdgcn_fence(__ATOMIC_ACQUIRE, "agent");
            xb_add(&bar[XB_XGEN(bx)], 1u);
            asm volatile("s_waitcnt vmcnt(0)" ::: "memory");
        } else {
            XB_SPIN(xb_ld(&bar[XB_XGEN(bx)]) == gen, bar);
            __builtin_amdgcn_fence(__ATOMIC_ACQUIRE, "agent");
            asm volatile("s_waitcnt vmcnt(0)" ::: "memory");
        }
    }
    __syncthreads();
}

constexpr int NWAVES = 8, NTHR = 512;
constexpr int RING_BYTES = 131072, MISC_OFF = RING_BYTES + 320, LDS_BYTES = 147456;

struct Inputs {
    const float *x, *c, *ctx, *c_ctx, *ada_w, *ada_b, *norm1_g, *w_in, *ret_decay, *ret_gn_g, *gdn_conv_w, *gdn_a_log, *gdn_dt_bias, *gdn_norm_g, *swa_sink, *w_out, *norm2_g,
        *ffn_w1, *ffn_w3, *ffn_w2, *router_w, *moe_w1, *moe_w3, *moe_w2, *final_g;
};
struct Args { Inputs in; float* out; unsigned char* ws; int ph_lo, ph_hi; };
static_assert(sizeof(Args) == 25 * 8 + 8 + 8 + 8, "no padding");


__device__ __forceinline__ const float* ld_ptr(const LAS unsigned long long* t, int i) { const unsigned long long v = t[i]; const unsigned lo = __builtin_amdgcn_readfirstlane((unsigned)v), hi = __builtin_amdgcn_readfirstlane((unsigned)(v >> 32)); return (const float*)(GAS const float*)(((unsigned long long)hi << 32) | lo); }
__device__ __forceinline__ Inputs load_inputs(const LAS unsigned long long* t) {
    Inputs in; const float** ip = (const float**)&in;
#pragma unroll
    for (int i = 0; i < 25; ++i) ip[i] = ld_ptr(t, i);
    return in;
}
struct Frame {
    LAS unsigned char* lds;
    int tid, lane, wave, G, gw, NGW, bid;
    unsigned char* ws;
};

template <class SrcF>
__device__ __forceinline__ void transpose_item(const SrcF& src, int K, bf16* WT, LAS float* scr, int k0, int n0, int lane) {
#pragma unroll
    for (int i = 0; i < 8; ++i) { const int row = 4 * i + (lane >> 4), col = 4 * (lane & 15); *(LAS f32x4*)(scr + row * 68 + col) = src(k0 + row, n0 + col); }
    LDS_WAIT(); asm volatile("" ::: "memory");
#pragma unroll
    for (int j = 0; j < 4; ++j) { const int ch = j * 64 + lane, n = ch >> 2, c8 = ch & 3; const LAS float* sp = scr + (8 * c8) * 68 + n;
        u32x4 o; o.x = cvtpk(sp[0 * 68], sp[1 * 68]); o.y = cvtpk(sp[2 * 68], sp[3 * 68]); o.z = cvtpk(sp[4 * 68], sp[5 * 68]); o.w = cvtpk(sp[6 * 68], sp[7 * 68]);
        *(u32x4*)(WT + (size_t)(n0 + n) * K + k0 + 8 * c8) = o; }
    LDS_WAIT(); asm volatile("" ::: "memory");
}
struct SrcPlain { const float* W; int ld; __device__ __forceinline__ f32x4 operator()(int k, int n) const { return *(const f32x4*)(W + (size_t)k * ld + n); } };
struct SrcWin { const float* W; __device__ __forceinline__ f32x4 operator()(int k, int n) const { return *(const f32x4*)(W + (size_t)k * INC + (n < 2048 ? n : n + 16)); } };
struct SrcGU { const float* W1; const float* W3; int ld; __device__ __forceinline__ f32x4 operator()(int k, int n) const { const int g = n >> 5, i = n & 31; const ptrdiff_t d = (i < 16) ? (ptrdiff_t)0 : (W3 - W1); return *(const f32x4*)(W1 + d + (ptrdiff_t)k * ld + 16 * g + (i & 15)); } };

__device__ __forceinline__ void convert_moe_layer(Frame& F, const Inputs& in, int mi) {
    LAS float* scr = (LAS float*)(F.lds + F.wave * 16384);
    bf16* mw13 = (bf16*)(F.ws + WS_MW13); bf16* mw2 = (bf16*)(F.ws + WS_MW2);
    constexpr int I13 = (D / 32) * (2 * EF / 64), I2 = (EF / 32) * (D / 64);
    for (int it = F.gw; it < NE * (I13 + I2); it += F.NGW) {
        const int e = it / (I13 + I2); int r = it % (I13 + I2);
        const size_t wo = ((size_t)mi * NE + e) * (size_t)D * EF;
        if (r < I13) { const int nblk = 2 * EF / 64; SrcGU s{in.moe_w1 + wo, in.moe_w3 + wo, EF}; transpose_item(s, D, mw13 + (size_t)e * 2 * EF * D, scr, 32 * (r / nblk), 64 * (r % nblk), F.lane); }
        else { r -= I13; const int nblk = D / 64; SrcPlain s{in.moe_w2 + wo, D}; transpose_item(s, EF, mw2 + (size_t)e * D * EF, scr, 32 * (r / nblk), 64 * (r % nblk), F.lane); }
    }
}

__device__ __forceinline__ void phase_prologue(Frame& F, const Inputs& in) {
    LAS float* scr = (LAS float*)(F.lds + F.wave * 16384);
    {
        constexpr int I_IN = (D / 32) * (NP / 64), I_OUT = (D / 32) * (D / 64), I_13 = (D / 32) * (2 * FF / 64), I_2 = (FF / 32) * (D / 64);
        constexpr int PER_L = I_IN + I_OUT, PER_F = I_13 + I_2, TOT = DEPTH * PER_L + 2 * PER_F;
        for (int it = F.gw; it < TOT; it += F.NGW) {
            if (it < DEPTH * PER_L) { const int l = it / PER_L; int r = it % PER_L;
                if (r < I_IN) { const int nblk = NP / 64; SrcWin s{in.w_in + (size_t)l * D * INC}; transpose_item(s, D, (bf16*)(F.ws + WS_WIN) + (size_t)l * NP * D, scr, 32 * (r / nblk), 64 * (r % nblk), F.lane); }
                else { r -= I_IN; const int nblk = D / 64; SrcPlain s{in.w_out + (size_t)l * D * D, D}; transpose_item(s, D, (bf16*)(F.ws + WS_WOUT) + (size_t)l * D * D, scr, 32 * (r / nblk), 64 * (r % nblk), F.lane); }
            } else { const int q = it - DEPTH * PER_L; const int i = q / PER_F; int r = q % PER_F;
                if (r < I_13) { const int nblk = 2 * FF / 64; SrcGU s{in.ffn_w1 + (size_t)i * D * FF, in.ffn_w3 + (size_t)i * D * FF, FF}; transpose_item(s, D, (bf16*)(F.ws + WS_W13) + (size_t)i * 2 * FF * D, scr, 32 * (r / nblk), 64 * (r % nblk), F.lane); }
                else { r -= I_13; const int nblk = D / 64; SrcPlain s{in.ffn_w2 + (size_t)i * FF * D, D}; transpose_item(s, FF, (bf16*)(F.ws + WS_W2) + (size_t)i * D * FF, scr, 32 * (r / nblk), 64 * (r % nblk), F.lane); }
            }
        }
    }
    convert_moe_layer(F, in, 0);
    {
        __syncthreads();
        LAS float* sc = (LAS float*)F.lds;
        LAS float* red = (LAS float*)(F.lds + 32768);
        for (int i = F.tid; i < 5 * D; i += NTHR) { const int r = i / D, k = i % D; const float v = r < 4 ? in.c[r * D + k] : in.c_ctx[k]; sc[i] = siluf(v); }
        __syncthreads();
        float* mod = (float*)(F.ws + WS_MOD);
        for (int u = F.bid; u < DEPTH * 96; u += F.G) {
            const int l = u / 96, n = (u % 96) * 64 + F.lane;
            const float* w = in.ada_w + (size_t)l * D * 6 * D + n;
            float a[5] = {0.f, 0.f, 0.f, 0.f, 0.f};
            for (int k = F.wave * 128; k < F.wave * 128 + 128; ++k) { const float wv = w[(size_t)k * 6 * D];
#pragma unroll
                for (int r = 0; r < 5; ++r) a[r] += sc[r * D + k] * wv; }
#pragma unroll
            for (int r = 0; r < 5; ++r) red[(F.wave * 5 + r) * 64 + F.lane] = a[r];
            __syncthreads();
            if (F.tid < 320) { const int r = F.tid / 64, ln = F.tid % 64; float s = 0.f;
#pragma unroll
                for (int w8 = 0; w8 < 8; ++w8) s += red[(w8 * 5 + r) * 64 + ln];
                const int nn = (u % 96) * 64 + ln;
                mod[((size_t)l * 5 + r) * 6 * D + nn] = s + in.ada_b[(size_t)l * 6 * D + nn]; }
            __syncthreads();
        }
    }
    if (F.bid == 0) { float* rp = (float*)(F.ws + WS_ROPE);
        for (int i = F.tid; i < 64 * 16; i += NTHR) { const int pos = i / 16, fi = i % 16; const double inv = pow(10000.0, -(double)fi / 16.0), ang = (double)pos * inv; rp[2 * i] = (float)cos(ang); rp[2 * i + 1] = (float)sin(ang); } }
}

__device__ __forceinline__ int mod_row(int m) { return m < MC ? 4 : ((m - MC) >> 12); }

template <int MODE>
__device__ __forceinline__ void phase_token(Frame& F, const Inputs& in, int layer, bool first_from_input, bool combine_moe, bool moe_router, float* out) {
    float* XS = (float*)(F.ws + WS_XS);
    bf16* H = (bf16*)(F.ws + WS_H);
    const float* mod = (const float*)(F.ws + WS_MOD) + (size_t)(layer < DEPTH ? layer : DEPTH - 1) * 5 * 6 * D;
    const float* modprev = (const float*)(F.ws + WS_MOD) + (size_t)(layer > 0 ? layer - 1 : 0) * 5 * 6 * D;
    const int* TKE = (const int*)(F.ws + WS_TKE); const float* TKG = (const float*)(F.ws + WS_TKG); const int* TOKROW = (const int*)(F.ws + WS_TOKROW);
    const float* YM = (const float*)(F.ws + WS_YM);
    LAS float* wl = (LAS float*)F.lds;
    if (MODE == 0) { __syncthreads(); const float* w = in.w_in + (size_t)layer * D * INC + 2048; for (int i = F.tid; i < D * 16; i += NTHR) { const int k = i >> 4, c = i & 15, kp = ((k >> 8) * 4 + (k & 3)) * 64 + ((k >> 2) & 63); wl[((c >> 2) * 1024 + kp) * 4 + (c & 3)] = w[(size_t)k * INC + c]; } __syncthreads(); }
    LAS int* lcnt = (LAS int*)(F.lds + 61440);
    if (MODE == 1 && moe_router) { __syncthreads(); if (F.tid < 8) lcnt[F.tid] = 0; const float* w = in.router_w + (size_t)(layer >> 1) * D * NE; for (int i = F.tid; i < D * NE; i += NTHR) { const int k = i >> 3, c = i & 7, kp = ((k >> 8) * 4 + (k & 3)) * 64 + ((k >> 2) & 63); wl[((c >> 2) * 1024 + kp) * 4 + (c & 3)] = w[i]; } __syncthreads(); }
    const float* gain = MODE == 0 ? in.norm1_g + (size_t)layer * D : (MODE == 1 ? in.norm2_g + (size_t)layer * D : in.final_g);
    const int m_lo = (MODE == 2) ? MC : 0;
    for (int m = m_lo + F.gw; m < M; m += F.NGW) {
        const int r = mod_row(m);
        f32x4 v[4];
        const float* xrow = first_from_input ? (m < MC ? in.ctx + (size_t)m * D : in.x + (size_t)(m - MC) * D) : XS + (size_t)m * D;
#pragma unroll
        for (int j = 0; j < 4; ++j) v[j] = *(const f32x4*)(xrow + 4 * F.lane + 256 * j);
        bool wrote = first_from_input;
        if (combine_moe && !(layer == DEPTH && m < MC)) {
            const int r0 = TOKROW[2 * m], r1 = TOKROW[2 * m + 1]; const float g0 = TKG[2 * m], g1 = TKG[2 * m + 1];
            const float* gt = modprev + (size_t)r * 6 * D + 5 * D;
#pragma unroll
            for (int j = 0; j < 4; ++j) { const f32x4 y0 = *(const f32x4*)(YM + (size_t)r0 * D + 4 * F.lane + 256 * j), y1 = *(const f32x4*)(YM + (size_t)r1 * D + 4 * F.lane + 256 * j);
                const f32x4 gg = *(const f32x4*)(gt + 4 * F.lane + 256 * j); v[j] += gg * (g0 * y0 + g1 * y1); }
            wrote = true;
        }
        if (wrote && MODE != 2) {
#pragma unroll
            for (int j = 0; j < 4; ++j) *(f32x4*)(XS + (size_t)m * D + 4 * F.lane + 256 * j) = v[j];
        }
        float ss = 0.f;
#pragma unroll
        for (int j = 0; j < 4; ++j) ss += (v[j].x * v[j].x + v[j].y * v[j].y) + (v[j].z * v[j].z + v[j].w * v[j].w);
        const float rstd = 1.0f / sqrtf(wave_sum(ss) * (1.0f / D) + EPS);
        if (MODE == 2) {
#pragma unroll
            for (int j = 0; j < 4; ++j) { const f32x4 g = *(const f32x4*)(gain + 4 * F.lane + 256 * j); *(f32x4*)(out + (size_t)(m - MC) * D + 4 * F.lane + 256 * j) = v[j] * rstd * g; }
            continue;
        }
        const float* sh = mod + (size_t)r * 6 * D + (MODE == 0 ? 0 : 3) * D; const float* scl = sh + D;
        f32x4 h[4];
#pragma unroll
        for (int j = 0; j < 4; ++j) { const f32x4 g = *(const f32x4*)(gain + 4 * F.lane + 256 * j), s1 = *(const f32x4*)(scl + 4 * F.lane + 256 * j), s0 = *(const f32x4*)(sh + 4 * F.lane + 256 * j);
            h[j] = v[j] * rstd * g * (1.0f + s1) + s0;
            u32x2 w; w.x = pk2(h[j].x, h[j].y); w.y = pk2(h[j].z, h[j].w); *(u32x2*)(H + (size_t)m * D + 4 * F.lane + 256 * j) = w; }
        if (MODE == 0) {
            float a[16];
#pragma unroll
            for (int c = 0; c < 16; ++c) a[c] = 0.f;
#pragma unroll
            for (int j = 0; j < 4; ++j)
#pragma unroll
                for (int e = 0; e < 4; ++e) { const int kp = (j * 4 + e) * 64 + F.lane; const float hv = h[j][e];
#pragma unroll
                    for (int q = 0; q < 4; ++q) { const f32x4 w = *(const LAS f32x4*)(wl + (q * 1024 + kp) * 4); a[4 * q] += hv * w.x; a[4 * q + 1] += hv * w.y; a[4 * q + 2] += hv * w.z; a[4 * q + 3] += hv * w.w; } }
            float mine = 0.f;
#pragma unroll
            for (int c = 0; c < 16; ++c) { const float s = wave_sum(a[c]); mine = (F.lane == c) ? s : mine; }
            if (F.lane < 16) ((float*)(F.ws + WS_AB))[(size_t)m * 16 + F.lane] = mine;
        }
        if (MODE == 1 && moe_router) {
            float a[8];
#pragma unroll
            for (int c = 0; c < 8; ++c) a[c] = 0.f;
#pragma unroll
            for (int j = 0; j < 4; ++j)
#pragma unroll
                for (int e = 0; e < 4; ++e) { const int kp = (j * 4 + e) * 64 + F.lane; const float hv = h[j][e];
#pragma unroll
                    for (int q = 0; q < 2; ++q) { const f32x4 w = *(const LAS f32x4*)(wl + (q * 1024 + kp) * 4); a[4 * q] += hv * w.x; a[4 * q + 1] += hv * w.y; a[4 * q + 2] += hv * w.z; a[4 * q + 3] += hv * w.w; } }
#pragma unroll
            for (int c = 0; c < 8; ++c) a[c] = wave_sum(a[c]);
            int i0 = 0; float l0 = a[0];
#pragma unroll
            for (int c = 1; c < 8; ++c) if (a[c] > l0) { l0 = a[c]; i0 = c; }
            int i1 = -1; float l1 = -3.0e38f;
#pragma unroll
            for (int c = 0; c < 8; ++c) if (c != i0 && a[c] > l1) { l1 = a[c]; i1 = c; }
            const float e1 = fexp(l1 - l0), g0 = 1.0f / (1.0f + e1), g1 = e1 / (1.0f + e1);
            if (F.lane == 0) { ((int*)(F.ws + WS_TKE))[2 * m] = i0; ((int*)(F.ws + WS_TKE))[2 * m + 1] = i1; ((float*)(F.ws + WS_TKG))[2 * m] = g0; ((float*)(F.ws + WS_TKG))[2 * m + 1] = g1; }
        }
    }
    (void)TKE;
}


template <int MODE>
__device__ __forceinline__ void phase_token2(Frame& F, const Inputs& in, int layer, bool first_from_input, bool combine_moe, bool moe_router, float* out, int route_lo = 0, int nslab = 0) {
    float* XS = (float*)(F.ws + WS_XS);
    bf16* H = (bf16*)(F.ws + WS_H);
    const float* mod = (const float*)(F.ws + WS_MOD) + (size_t)(layer < DEPTH ? layer : DEPTH - 1) * 5 * 6 * D;
    const float* modprev = (const float*)(F.ws + WS_MOD) + (size_t)(layer > 0 ? layer - 1 : 0) * 5 * 6 * D;
    const float* TKG = (const float*)(F.ws + WS_TKG); const int* TOKROW = (const int*)(F.ws + WS_TOKROW);
    const float* YM = (const float*)(F.ws + WS_YM);
    LAS float* wl = (LAS float*)F.lds;
    const int lane = F.lane;
    if (MODE == 0) PB(8);
    if (MODE == 0) { __syncthreads(); const float* w = in.w_in + (size_t)layer * D * INC + 2048;
#pragma unroll
        for (int n = 0; n < 8; ++n) { const int k = (F.tid >> 2) + 128 * n, q4 = F.tid & 3, kp = ((k >> 8) * 4 + (k & 3)) * 64 + ((k >> 2) & 63);
            *(LAS f32x4*)(wl + (q4 * 1024 + kp) * 4) = *(const f32x4*)(w + (size_t)k * INC + 4 * q4); }
        __syncthreads(); }
    LAS int* lcnt = (LAS int*)(F.lds + 61440);
    if (MODE == 1 && moe_router) { __syncthreads(); if (F.tid < 8) lcnt[F.tid] = 0; const float* w = in.router_w + (size_t)(layer >> 1) * D * NE;
#pragma unroll
        for (int n = 0; n < 4; ++n) { const int k = (F.tid >> 1) + 256 * n, q4 = F.tid & 1, kp = ((k >> 8) * 4 + (k & 3)) * 64 + ((k >> 2) & 63);
            *(LAS f32x4*)(wl + (q4 * 1024 + kp) * 4) = *(const f32x4*)(w + (size_t)k * NE + 4 * q4); }
        __syncthreads(); }
    if (MODE == 0) PE(8);
    if (MODE == 0) PB(9);
    if (MODE == 1) PB(10);
    const float* gain = MODE == 0 ? in.norm1_g + (size_t)layer * D : (MODE == 1 ? in.norm2_g + (size_t)layer * D : in.final_g);
    const bool has_ctx = (MODE != 2) && F.gw < MC;
    const int r_beg = MC + (int)(((long)F.gw * ML) / F.NGW), r_end = MC + (int)(((long)(F.gw + 1) * ML) / F.NGW);
    if (nslab > 0 && has_ctx) {
        const float* sb = (const float*)(F.ws + WS_R1 + 100 * MiB); const float* gsrc = (MODE == 1 ? mod + (size_t)4 * 6 * D + 2 * D : modprev + (size_t)4 * 6 * D + 5 * D);
        { const int m = F.gw;
#pragma unroll
            for (int j = 0; j < 4; ++j) { f32x4 a0 = (f32x4){0.f, 0.f, 0.f, 0.f};
                for (int sidx = 0; sidx < nslab; ++sidx) a0 += *(const f32x4*)(sb + ((size_t)sidx * MC + m) * D + 4 * lane + 256 * j);
                float* xp = XS + (size_t)m * D + 4 * lane + 256 * j; *(f32x4*)xp = *(const f32x4*)xp + *(const f32x4*)(gsrc + 4 * lane + 256 * j) * a0; } }
        asm volatile("s_waitcnt vmcnt(0)" ::: "memory");
    }
    if (combine_moe) {
        const int ntl = ((const int*)(F.ws + WS_TILEE))[256]; const int srow = ((ntl - (ntl / 64) * 64 <= 16) ? (ntl / 64) * 64 : ntl) * 256; const float* sl = (const float*)(F.ws + WS_HP);
        float* YMw = (float*)(F.ws + WS_YM);
        for (int m0 = has_ctx ? r_beg - 1 : r_beg; m0 < r_end; ++m0) { const int m = m0 < r_beg ? F.gw : m0;
            if (MODE == 0 && layer == DEPTH && m < MC) continue;
#pragma unroll
            for (int k = 0; k < 2; ++k) { const int r = TOKROW[2 * m + k];
                if (r >= srow) { const size_t o = (size_t)(r - srow) * D;
#pragma unroll
                    for (int j = 0; j < 4; ++j) { float* yp = YMw + (size_t)r * D + 4 * lane + 256 * j;
                        *(f32x4*)yp = ((*(const f32x4*)yp + *(const f32x4*)(sl + o + 4 * lane + 256 * j)) + *(const f32x4*)(sl + (size_t)4096 * D + o + 4 * lane + 256 * j)) + *(const f32x4*)(sl + (size_t)8192 * D + o + 4 * lane + 256 * j); } } } }
        asm volatile("s_waitcnt vmcnt(0)" ::: "memory");
    }
    f32x4 gv[4], av[4], bv[4], gt[4];
#pragma unroll
    for (int j = 0; j < 4; ++j) gv[j] = *(const f32x4*)(gain + 4 * lane + 256 * j);
    int rcur = -1;
    for (int m0 = has_ctx ? r_beg - 1 : r_beg; m0 < r_end; m0 += 2) {
        const bool isc = m0 < r_beg;
        const int ma = isc ? F.gw : m0; const bool two = !isc && ma + 1 < r_end; const int m1 = two ? ma + 1 : ma;
        if (isc) m0 -= 1;
        const int r = mod_row(ma);
        const bool same = mod_row(m1) == r;
        const int mm1 = same ? m1 : ma; const bool do1 = two && same;
        if (!same) m0 -= 1;
        if (r != rcur) { rcur = r;
            if (MODE != 2) { const float* sh = mod + (size_t)r * 6 * D + (MODE == 0 ? 0 : 3) * D;
#pragma unroll
                for (int j = 0; j < 4; ++j) { const f32x4 s1 = *(const f32x4*)(sh + D + 4 * lane + 256 * j); av[j] = gv[j] * (1.0f + s1); bv[j] = *(const f32x4*)(sh + 4 * lane + 256 * j); } }
            if (combine_moe) {
#pragma unroll
                for (int j = 0; j < 4; ++j) gt[j] = *(const f32x4*)(modprev + (size_t)r * 6 * D + 5 * D + 4 * lane + 256 * j); } }
        const int mr[2] = {ma, mm1};
        f32x4 v[2][4];
        int t0[2], t1[2]; float g0[2], g1[2];
        if (combine_moe) {
#pragma unroll
            for (int p = 0; p < 2; ++p) { t0[p] = TOKROW[2 * mr[p]]; t1[p] = TOKROW[2 * mr[p] + 1]; g0[p] = TKG[2 * mr[p]]; g1[p] = TKG[2 * mr[p] + 1]; } }
#pragma unroll
        for (int p = 0; p < 2; ++p) { const int m = mr[p];
            const float* xrow = first_from_input ? (m < MC ? in.ctx + (size_t)m * D : in.x + (size_t)(m - MC) * D) : XS + (size_t)m * D;
#pragma unroll
            for (int j = 0; j < 4; ++j) v[p][j] = *(const f32x4*)(xrow + 4 * lane + 256 * j); }
        if (combine_moe) {
#pragma unroll
            for (int p = 0; p < 2; ++p)
#pragma unroll
                for (int j = 0; j < 4; ++j) { const f32x4 y0 = *(const f32x4*)(YM + (size_t)t0[p] * D + 4 * lane + 256 * j), y1 = *(const f32x4*)(YM + (size_t)t1[p] * D + 4 * lane + 256 * j);
                    v[p][j] += gt[j] * (g0[p] * y0 + g1[p] * y1); } }
        if ((first_from_input || combine_moe) && MODE != 2) {
#pragma unroll
            for (int p = 0; p < 2; ++p) if (p == 0 || do1) {
#pragma unroll
                for (int j = 0; j < 4; ++j) *(f32x4*)(XS + (size_t)mr[p] * D + 4 * lane + 256 * j) = v[p][j]; } }
        float rstd[2];
#pragma unroll
        for (int p = 0; p < 2; ++p) { float ss = 0.f;
#pragma unroll
            for (int j = 0; j < 4; ++j) ss += (v[p][j].x * v[p][j].x + v[p][j].y * v[p][j].y) + (v[p][j].z * v[p][j].z + v[p][j].w * v[p][j].w);
            rstd[p] = 1.0f / sqrtf(wave_sum(ss) * (1.0f / D) + EPS); }
        if (MODE == 2) {
#pragma unroll
            for (int p = 0; p < 2; ++p) if (p == 0 || do1) {
#pragma unroll
                for (int j = 0; j < 4; ++j) *(f32x4*)(out + (size_t)(mr[p] - MC) * D + 4 * lane + 256 * j) = v[p][j] * rstd[p] * gv[j]; }
            continue; }
        f32x4 h[2][4];
#pragma unroll
        for (int p = 0; p < 2; ++p)
#pragma unroll
            for (int j = 0; j < 4; ++j) { h[p][j] = v[p][j] * rstd[p] * av[j] + bv[j];
                if (p == 0 || do1) { u32x2 w; w.x = cvtpk(h[p][j].x, h[p][j].y); w.y = cvtpk(h[p][j].z, h[p][j].w); *(u32x2*)(H + (size_t)mr[p] * D + 4 * lane + 256 * j) = w; } }
        if (MODE == 0 || (MODE == 1 && moe_router)) {
            constexpr int NC = (MODE == 0) ? 16 : 8;
            float a[2][NC];
#pragma unroll
            for (int p = 0; p < 2; ++p)
#pragma unroll
                for (int c = 0; c < NC; ++c) a[p][c] = 0.f;
#pragma unroll
            for (int j = 0; j < 4; ++j)
#pragma unroll
                for (int e = 0; e < 4; ++e) { const int kp = (j * 4 + e) * 64 + lane;
#pragma unroll
                    for (int q = 0; q < NC / 4; ++q) { const f32x4 w = *(const LAS f32x4*)(wl + (q * 1024 + kp) * 4);
#pragma unroll
                        for (int p = 0; p < 2; ++p) { const float hv = h[p][j][e]; a[p][4 * q] += hv * w.x; a[p][4 * q + 1] += hv * w.y; a[p][4 * q + 2] += hv * w.z; a[p][4 * q + 3] += hv * w.w; } } }
#pragma unroll
            for (int p = 0; p < 2; ++p) {
#pragma unroll
                for (int c = 0; c < NC; ++c) a[p][c] = wave_sum(a[p][c]); }
#pragma unroll
            for (int p = 0; p < 2; ++p) if (p == 0 || do1) { const int m = mr[p];
                if (MODE == 0) { float mine = 0.f;
#pragma unroll
                    for (int c = 0; c < NC; ++c) mine = (lane == c) ? a[p][c] : mine;
                    if (lane < 16) ((float*)(F.ws + WS_AB))[(size_t)m * 16 + lane] = mine; }
                else { int i0 = 0; float l0 = a[p][0];
#pragma unroll
                    for (int c = 1; c < NC; ++c) if (a[p][c] > l0) { l0 = a[p][c]; i0 = c; }
                    int i1 = -1; float l1 = -3.0e38f;
#pragma unroll
                    for (int c = 0; c < NC; ++c) if (c != i0 && a[p][c] > l1) { l1 = a[p][c]; i1 = c; }
                    const float e1 = fexp(l1 - l0), gg0 = 1.0f / (1.0f + e1), gg1 = e1 / (1.0f + e1);
                    if (lane == 0 && m >= route_lo) { ((int*)(F.ws + WS_TKE))[2 * m] = i0; ((int*)(F.ws + WS_TKE))[2 * m + 1] = i1; ((float*)(F.ws + WS_TKG))[2 * m] = gg0; ((float*)(F.ws + WS_TKG))[2 * m + 1] = gg1;
                        ((int*)(F.ws + WS_TOKROW))[2 * m] = __hip_atomic_fetch_add(lcnt + i0, 1, __ATOMIC_RELAXED, __HIP_MEMORY_SCOPE_WORKGROUP); ((int*)(F.ws + WS_TOKROW))[2 * m + 1] = __hip_atomic_fetch_add(lcnt + i1, 1, __ATOMIC_RELAXED, __HIP_MEMORY_SCOPE_WORKGROUP); } } }
        }
    }
    if (MODE == 0) PE(9);
    if (MODE == 1) PE(10);
    if (MODE == 1 && moe_router) { __syncthreads(); if (F.tid < 8) ((int*)(F.ws + WS_TILEE + 4096))[F.bid * 8 + F.tid] = lcnt[F.tid]; }
}

__device__ __forceinline__ void phase_prep(Frame& F, const Inputs& in, int layer) {
    const bf16* P = (const bf16*)(F.ws + WS_R1 + R1_P);
    unsigned char* prep = F.ws + WS_R1 + R1_PREP;
    bf16* RQ = (bf16*)(prep + PREP_RQ); bf16* RK = (bf16*)(prep + PREP_RK); bf16* SQ = (bf16*)(prep + PREP_SQ); bf16* SK = (bf16*)(prep + PREP_SK); bf16* GD = (bf16*)(prep + PREP_GD);
    const float* rope = (const float*)(F.ws + WS_ROPE);
    const float* AB = (const float*)(F.ws + WS_AB); float* GB = (float*)(F.ws + WS_GB);
    const float* cw = in.gdn_conv_w + (size_t)layer * 5 * 768;
    const int lane = F.lane;
    for (int m = F.gw; m < M; m += F.NGW) {
        const bool lat = m >= MC; const int t = lat ? ((m - MC) & (TL - 1)) : (m & (TC - 1)); const int Tn = lat ? TL : TC;
        const bf16* prow = P + (size_t)m * NP;
        float cs = 1.f, sn = 0.f;
        if (lat) { const int j = lane & 31; const int pos = j < 16 ? (t >> 6) : (t & 63); const int fi = j & 15; cs = rope[(pos * 16 + fi) * 2]; sn = rope[(pos * 16 + fi) * 2 + 1]; if (lane < 32) sn = -sn; }
#pragma unroll
        for (int hh = 0; hh < 4; ++hh) { const float q = bf2f(prow[PC_RQ + hh * 64 + lane]), k = bf2f(prow[PC_RK + hh * 64 + lane]) * 0.125f;
            const float qp = __shfl_xor(q, 32), kp = __shfl_xor(k, 32);
            RQ[(size_t)m * 256 + hh * 64 + lane] = (bf16)f2bf(q * cs + qp * sn); RK[(size_t)m * 256 + hh * 64 + lane] = (bf16)f2bf(k * cs + kp * sn); }
#pragma unroll
        for (int hq = 0; hq < 8; ++hq) { const float q = bf2f(prow[PC_SQ + hq * 64 + lane]); const float qp = __shfl_xor(q, 32); SQ[(size_t)m * 512 + hq * 64 + lane] = (bf16)f2bf(q * cs + qp * sn); }
#pragma unroll
        for (int g = 0; g < 2; ++g) { const float k = bf2f(prow[PC_SK + g * 64 + lane]); const float kp = __shfl_xor(k, 32); SK[(size_t)m * 128 + g * 64 + lane] = (bf16)f2bf(k * cs + kp * sn); }
#pragma unroll 1
        for (int s = 0; s < 12; ++s) { const int c = s * 64 + lane; float y = 0.f;
#pragma unroll
            for (int j = 0; j < 5; ++j) { const int tt = t + j - 2; if (tt >= 0 && tt < Tn) y += cw[j * 768 + c] * bf2f(prow[(ptrdiff_t)(j - 2) * NP + PC_GQKV + c]); }
            y = siluf(y);
            if (s < 8) { const float n2 = wave_sum(y * y); y = y * (1.0f / sqrtf(n2 + EPS)); if (s < 4) y *= 0.125f; }
            GD[(size_t)m * 768 + c] = (bf16)f2bf(y); }
        if (lane < 16) { const int dh = lane & 7; const float a = AB[(size_t)m * 16 + lane];
            float o;
            if (lane < 8) { const float xx = a + in.gdn_dt_bias[layer * 8 + dh]; const float sp = fmaxf(xx, 0.f) + log1pf(fexp(-fabsf(xx))); o = -fexp(in.gdn_a_log[layer * 8 + dh]) * sp; }
            else o = 1.0f / (1.0f + fexp(-a));
            GB[(size_t)m * 16 + lane] = o; }
    }
}


__device__ __forceinline__ void unpack8(const u32x4 w, float (&v)[8]) {
#pragma unroll
    for (int e = 0; e < 4; ++e) { v[2 * e] = __uint_as_float(w[e] << 16); v[2 * e + 1] = __uint_as_float(w[e] & 0xffff0000u); } }
__device__ __forceinline__ u32x4 pack8(const float (&v)[8]) { u32x4 w; w.x = cvtpk(v[0], v[1]); w.y = cvtpk(v[2], v[3]); w.z = cvtpk(v[4], v[5]); w.w = cvtpk(v[6], v[7]); return w; }
__device__ __forceinline__ void phase_prep2(Frame& F, const Inputs& in, int layer) {
    const bf16* P = (const bf16*)(F.ws + WS_R1 + R1_P);
    unsigned char* prep = F.ws + WS_R1 + R1_PREP;
    bf16* RQ = (bf16*)(prep + PREP_RQ); bf16* RK = (bf16*)(prep + PREP_RK); bf16* SQ = (bf16*)(prep + PREP_SQ); bf16* SK = (bf16*)(prep + PREP_SK); bf16* GD = (bf16*)(prep + PREP_GD);
    const float* rope = (const float*)(F.ws + WS_ROPE);
    const float* AB = (const float*)(F.ws + WS_AB); float* GB = (float*)(F.ws + WS_GB);
    const float* cw = in.gdn_conv_w + (size_t)layer * 5 * 768;
    const int lane = F.lane, l3 = lane & 3, l31 = lane & 31;
    float wA[5][8], wB[5][8];
#pragma unroll
    for (int j = 0; j < 5; ++j) { const f32x4 a0 = *(const f32x4*)(cw + j * 768 + 8 * lane), a1 = *(const f32x4*)(cw + j * 768 + 8 * lane + 4), b0 = *(const f32x4*)(cw + j * 768 + 512 + 8 * l31), b1 = *(const f32x4*)(cw + j * 768 + 512 + 8 * l31 + 4);
#pragma unroll
        for (int x = 0; x < 4; ++x) { wA[j][x] = a0[x]; wA[j][4 + x] = a1[x]; wB[j][x] = b0[x]; wB[j][4 + x] = b1[x]; } }
    const float sgn = ((lane & 7) < 4) ? -1.0f : 1.0f;
    for (int m = F.gw; m < M; m += F.NGW) {
        const bool lat = m >= MC; const int t = lat ? ((m - MC) & (TL - 1)) : (m & (TC - 1)); const int Tn = lat ? TL : TC;
        const bf16* prow = P + (size_t)m * NP;
        float cs[8], sn[8];
        { const int pos = (l3 < 2) ? (t >> 6) : (t & 63); const float* rp = rope + (pos * 16 + 8 * (l3 & 1)) * 2;
          const f32x4 r0 = *(const f32x4*)(rp), r1 = *(const f32x4*)(rp + 4), r2 = *(const f32x4*)(rp + 8), r3 = *(const f32x4*)(rp + 12);
          cs[0] = r0[0]; sn[0] = r0[1]; cs[1] = r0[2]; sn[1] = r0[3]; cs[2] = r1[0]; sn[2] = r1[1]; cs[3] = r1[2]; sn[3] = r1[3];
          cs[4] = r2[0]; sn[4] = r2[1]; cs[5] = r2[2]; sn[5] = r2[3]; cs[6] = r3[0]; sn[6] = r3[1]; cs[7] = r3[2]; sn[7] = r3[3];
#pragma unroll
          for (int x = 0; x < 8; ++x) { if (!lat) { cs[x] = 1.0f; sn[x] = 0.0f; } sn[x] *= sgn; } }
        { const bool isk = lane >= 32; float v[8], o[8]; unpack8(*(const u32x4*)(prow + (isk ? PC_RK : PC_RQ) + 8 * l31), v);
#pragma unroll
          for (int x = 0; x < 8; ++x) { if (isk) v[x] *= 0.125f; const float pv = __shfl_xor(v[x], 4); o[x] = v[x] * cs[x] + pv * sn[x]; }
          *(u32x4*)((isk ? RK : RQ) + (size_t)m * 256 + 8 * l31) = pack8(o); }
        { float v[8], o[8]; unpack8(*(const u32x4*)(prow + PC_SQ + 8 * lane), v);
#pragma unroll
          for (int x = 0; x < 8; ++x) { const float pv = __shfl_xor(v[x], 4); o[x] = v[x] * cs[x] + pv * sn[x]; }
          *(u32x4*)(SQ + (size_t)m * 512 + 8 * lane) = pack8(o); }
        { float v[8], o[8]; unpack8(*(const u32x4*)(prow + PC_SK + 8 * (lane & 15)), v);
#pragma unroll
          for (int x = 0; x < 8; ++x) { const float pv = __shfl_xor(v[x], 4); o[x] = v[x] * cs[x] + pv * sn[x]; }
          if (lane < 16) *(u32x4*)(SK + (size_t)m * 128 + 8 * lane) = pack8(o); }
        { float a[8], bq[8];
#pragma unroll
          for (int x = 0; x < 8; ++x) { a[x] = 0.f; bq[x] = 0.f; }
#pragma unroll
          for (int j = 0; j < 5; ++j) { const int tt = t + j - 2; const bool ok = tt >= 0 && tt < Tn; const bf16* pr = prow + (ok ? (ptrdiff_t)(j - 2) * NP : (ptrdiff_t)0) + PC_GQKV;
              float va[8], vb[8]; unpack8(*(const u32x4*)(pr + 8 * lane), va); unpack8(*(const u32x4*)(pr + 512 + 8 * l31), vb);
              const float z = ok ? 1.0f : 0.0f;
#pragma unroll
              for (int x = 0; x < 8; ++x) { a[x] += z * wA[j][x] * va[x]; bq[x] += z * wB[j][x] * vb[x]; } }
          float n2 = 0.f;
#pragma unroll
          for (int x = 0; x < 8; ++x) { a[x] = siluf(a[x]); bq[x] = siluf(bq[x]); n2 += a[x] * a[x]; }
          n2 += dppf<0xB1>(n2); n2 += dppf<0x4E>(n2); n2 += dppf<0x141>(n2);
          const float sc = (1.0f / sqrtf(n2 + EPS)) * (lane < 32 ? 0.125f : 1.0f);
#pragma unroll
          for (int x = 0; x < 8; ++x) a[x] *= sc;
          *(u32x4*)(GD + (size_t)m * 768 + 8 * lane) = pack8(a);
          if (lane < 32) *(u32x4*)(GD + (size_t)m * 768 + 512 + 8 * lane) = pack8(bq); }
        if (lane < 16) { const int dh = lane & 7; const float a = AB[(size_t)m * 16 + lane];
            float o;
            if (lane < 8) { const float xx = a + in.gdn_dt_bias[layer * 8 + dh]; const float sp = fmaxf(xx, 0.f) + log1pf(fexp(-fabsf(xx))); o = -fexp(in.gdn_a_log[layer * 8 + dh]) * sp; }
            else o = 1.0f / (1.0f + fexp(-a));
            GB[(size_t)m * 16 + lane] = o; }
    }
}

__device__ __forceinline__ int scan_row(int b, int dir, int tau) {
    if (tau < TC) { const int c = dir ? TC - 1 - tau : tau; return b * TC + c; }
    const int tt = tau - TC; const int t = dir ? TL - 1 - tt : tt; return MC + b * TL + t;
}
__device__ __forceinline__ void phase_scans(Frame& F, const Inputs& in, int layer, int nscan) {
    if (F.wave != 0 || F.bid >= nscan) return;
    const int id = F.bid; const bool gdn = id >= 32; const int sid = id & 31; const int b = sid >> 3, hh = (sid >> 1) & 3, dir = sid & 1;
    const bf16* P = (const bf16*)(F.ws + WS_R1 + R1_P);
    unsigned char* prep = F.ws + WS_R1 + R1_PREP;
    const bf16* RQ = (const bf16*)(prep + PREP_RQ); const bf16* RK = (const bf16*)(prep + PREP_RK); const bf16* GD = (const bf16*)(prep + PREP_GD);
    const float* GB = (const float*)(F.ws + WS_GB);
    float* OUT = (float*)(F.ws + WS_R1 + (gdn ? R1_OG : R1_OR)) + (size_t)dir * M * 256;
    LAS float* lk = (LAS float*)F.lds; LAS float* lq = lk + 64 * 64; LAS float* lg = lq + 64 * 64;
    const int lane = F.lane;
    float S[64];
#pragma unroll
    for (int i = 0; i < 64; ++i) S[i] = 0.f;
    const float gamma = gdn ? 0.f : fexp(-fexp(in.ret_decay[layer * 8 + dir * 4 + hh]));
    for (int t0 = 0; t0 < TC + TL; t0 += 64) {
        for (int i = 0; i < 64; ++i) { const int m = scan_row(b, dir, t0 + i);
            if (gdn) { lq[i * 64 + lane] = bf2f(GD[(size_t)m * 768 + hh * 64 + lane]); lk[i * 64 + lane] = bf2f(GD[(size_t)m * 768 + 256 + hh * 64 + lane]); if (lane < 2) lg[i * 2 + lane] = GB[(size_t)m * 16 + lane * 8 + dir * 4 + hh]; }
            else { lq[i * 64 + lane] = bf2f(RQ[(size_t)m * 256 + hh * 64 + lane]); lk[i * 64 + lane] = bf2f(RK[(size_t)m * 256 + hh * 64 + lane]); } }
        LDS_WAIT(); asm volatile("" ::: "memory");
        for (int i = 0; i < 64; ++i) { const int m = scan_row(b, dir, t0 + i);
            float o = 0.f;
            if (gdn) {
                const float v = bf2f(GD[(size_t)m * 768 + 512 + hh * 64 + lane]); const float a = fexp(lg[i * 2]), beta = lg[i * 2 + 1];
                float ks = 0.f;
#pragma unroll
                for (int d4 = 0; d4 < 16; ++d4) { const f32x4 kv = *(const LAS f32x4*)(lk + i * 64 + 4 * d4); ks += kv.x * S[4 * d4] + kv.y * S[4 * d4 + 1] + kv.z * S[4 * d4 + 2] + kv.w * S[4 * d4 + 3]; }
                const float vn = beta * (v - a * ks);
#pragma unroll
                for (int d4 = 0; d4 < 16; ++d4) { const f32x4 kv = *(const LAS f32x4*)(lk + i * 64 + 4 * d4), qv = *(const LAS f32x4*)(lq + i * 64 + 4 * d4);
                    S[4 * d4] = a * S[4 * d4] + kv.x * vn; S[4 * d4 + 1] = a * S[4 * d4 + 1] + kv.y * vn; S[4 * d4 + 2] = a * S[4 * d4 + 2] + kv.z * vn; S[4 * d4 + 3] = a * S[4 * d4 + 3] + kv.w * vn;
                    o += qv.x * S[4 * d4] + qv.y * S[4 * d4 + 1] + qv.z * S[4 * d4 + 2] + qv.w * S[4 * d4 + 3]; }
            } else {
                const float v = bf2f(P[(size_t)m * NP + PC_RV + hh * 64 + lane]);
#pragma unroll
                for (int d4 = 0; d4 < 16; ++d4) { const f32x4 kv = *(const LAS f32x4*)(lk + i * 64 + 4 * d4), qv = *(const LAS f32x4*)(lq + i * 64 + 4 * d4);
                    S[4 * d4] = gamma * S[4 * d4] + kv.x * v; S[4 * d4 + 1] = gamma * S[4 * d4 + 1] + kv.y * v; S[4 * d4 + 2] = gamma * S[4 * d4 + 2] + kv.z * v; S[4 * d4 + 3] = gamma * S[4 * d4 + 3] + kv.w * v;
                    o += qv.x * S[4 * d4] + qv.y * S[4 * d4 + 1] + qv.z * S[4 * d4 + 2] + qv.w * S[4 * d4 + 3]; }
            }
            OUT[(size_t)m * 256 + hh * 64 + lane] = o;
        }
        LDS_WAIT(); asm volatile("" ::: "memory");
    }
}

__device__ __forceinline__ void phase_swa(Frame& F, const Inputs& in, int layer) {
    const bf16* P = (const bf16*)(F.ws + WS_R1 + R1_P);
    unsigned char* prep = F.ws + WS_R1 + R1_PREP;
    const bf16* SQ = (const bf16*)(prep + PREP_SQ); const bf16* SK = (const bf16*)(prep + PREP_SK);
    bf16* O = (bf16*)(F.ws + WS_R1 + R1_O);
    const int NT = F.G * NTHR;
    for (int idx = F.bid * NTHR + F.tid; idx < M * 8; idx += NT) {
        const int hq = idx / M, m = idx % M, g = hq >> 2;
        const bool lat = m >= MC; const int b = lat ? ((m - MC) >> 12) : (m >> 8); const int t = lat ? ((m - MC) & (TL - 1)) : (m & (TC - 1));
        float q[64], o[64];
#pragma unroll
        for (int i = 0; i < 8; ++i) { const u32x4 w = *(const u32x4*)(SQ + (size_t)m * 512 + hq * 64 + 8 * i);
#pragma unroll
            for (int e = 0; e < 4; ++e) { q[8 * i + 2 * e] = __uint_as_float(w[e] << 16) * 0.125f; q[8 * i + 2 * e + 1] = __uint_as_float(w[e] & 0xffff0000u) * 0.125f; } }
#pragma unroll
        for (int i = 0; i < 64; ++i) o[i] = 0.f;
        float mx = in.swa_sink[layer * 8 + hq], l = 1.0f;
        const int nloc = lat ? 257 : 0;
        for (int kk = 0; kk < nloc + TC; ++kk) {
            int row;
            if (kk < nloc) { const int s = t - 128 + kk; if (s < 0 || s >= TL) continue; row = MC + b * TL + s; }
            else row = b * TC + (kk - nloc);
            float sc = 0.f;
#pragma unroll
            for (int i = 0; i < 8; ++i) { const u32x4 w = *(const u32x4*)(SK + (size_t)row * 128 + g * 64 + 8 * i);
#pragma unroll
                for (int e = 0; e < 4; ++e) sc += q[8 * i + 2 * e] * __uint_as_float(w[e] << 16) + q[8 * i + 2 * e + 1] * __uint_as_float(w[e] & 0xffff0000u); }
            const float mn = fmaxf(mx, sc), corr = fexp(mx - mn), p = fexp(sc - mn);
            l = l * corr + p; mx = mn;
#pragma unroll
            for (int i = 0; i < 8; ++i) { const u32x4 w = *(const u32x4*)(P + (size_t)row * NP + PC_SV + g * 64 + 8 * i);
#pragma unroll
                for (int e = 0; e < 4; ++e) { o[8 * i + 2 * e] = o[8 * i + 2 * e] * corr + p * __uint_as_float(w[e] << 16); o[8 * i + 2 * e + 1] = o[8 * i + 2 * e + 1] * corr + p * __uint_as_float(w[e] & 0xffff0000u); } }
        }
        const float il = 1.0f / l;
#pragma unroll
        for (int i = 0; i < 8; ++i) { u32x4 w;
#pragma unroll
            for (int e = 0; e < 4; ++e) w[e] = pk2(o[8 * i + 2 * e] * il, o[8 * i + 2 * e + 1] * il);
            *(u32x4*)(O + (size_t)m * D + 512 + hq * 64 + 8 * i) = w; }
    }
}


__device__ __forceinline__ void phase_swa2(Frame& F, const Inputs& in, int layer, int nwg) {
    if (F.bid >= nwg) return;
    const bf16* P = (const bf16*)(F.ws + WS_R1 + R1_P);
    unsigned char* prep = F.ws + WS_R1 + R1_PREP;
    const bf16* SQ = (const bf16*)(prep + PREP_SQ); const bf16* SK = (const bf16*)(prep + PREP_SK);
    bf16* O = (bf16*)(F.ws + WS_R1 + R1_O);
    LAS bf16* Kl = (LAS bf16*)F.lds; LAS bf16* Vt = Kl + 64 * 72;
    const int lane = F.lane, c = lane & 15, q = lane >> 4, w = F.wave;
    const float LOG2E = 1.4426950408889634f;
    const int srow = F.tid >> 3, scol = (F.tid & 7) * 8;
    for (int u = F.bid; u < 544; u += nwg) {
        const bool lat = u < 512; int b, g, qb;
        if (lat) { b = u >> 7; g = (u >> 6) & 1; qb = u & 63; } else { const int uu = u - 512; b = uu >> 3; g = (uu >> 2) & 1; qb = uu & 3; }
        const int hq = 4 * g + (w >> 1), i0 = 32 * (w & 1);
        const int mrow0 = lat ? MC + b * TL + 64 * qb : b * TC + 64 * qb;
        const int kt0 = lat ? (2 - qb > 0 ? 2 - qb : 0) : 0, kt1 = lat ? (65 - qb < 4 ? 65 - qb : 4) : -1, nb = lat ? kt1 - kt0 + 1 : 0, nt = nb + 4;
        const int band0 = MC + b * TL + 64 * qb - 128 + 64 * kt0, ctx0 = b * TC;
        bf16x8 qf[2][2];
#pragma unroll
        for (int ti = 0; ti < 2; ++ti)
#pragma unroll
            for (int ks = 0; ks < 2; ++ks) qf[ti][ks] = *(const bf16x8*)(SQ + (size_t)(mrow0 + i0 + 16 * ti + c) * 512 + hq * 64 + 32 * ks + 8 * q);
        float mrun[2], lrun[2]; f32x4 oacc[4][2];
        const float sk = in.swa_sink[layer * 8 + hq] * LOG2E;
#pragma unroll
        for (int ti = 0; ti < 2; ++ti) { mrun[ti] = sk; lrun[ti] = 1.0f;
#pragma unroll
            for (int te = 0; te < 4; ++te) oacc[te][ti] = (f32x4){0.f, 0.f, 0.f, 0.f}; }
        u32x4 kreg, vreg;
        { const int r0 = (0 < nb) ? band0 : ctx0; kreg = *(const u32x4*)(SK + (size_t)(r0 + srow) * 128 + g * 64 + scol); vreg = *(const u32x4*)(P + (size_t)(r0 + srow) * NP + PC_SV + g * 64 + scol); }
        for (int tt = 0; tt < nt; ++tt) {
            __syncthreads();
            *(LAS u32x4*)(Kl + srow * 72 + scol) = kreg;
#pragma unroll
            for (int x = 0; x < 8; ++x) Vt[(scol + x) * 72 + srow] = (bf16)(vreg[x >> 1] >> (16 * (x & 1)));
            __syncthreads();
            if (tt + 1 < nt) { const int r0 = (tt + 1 < nb) ? band0 + 64 * (tt + 1) : ctx0 + 64 * (tt + 1 - nb);
                kreg = *(const u32x4*)(SK + (size_t)(r0 + srow) * 128 + g * 64 + scol); vreg = *(const u32x4*)(P + (size_t)(r0 + srow) * NP + PC_SV + g * 64 + scol); }
            bf16x8 kfr[2][4]; u32x2 vlo[2][4], vhi[2][4];
#pragma unroll
            for (int ks = 0; ks < 2; ++ks)
#pragma unroll
                for (int tj = 0; tj < 4; ++tj) kfr[ks][tj] = *(const LAS bf16x8*)(Kl + (16 * tj + c) * 72 + 32 * ks + 8 * q);
#pragma unroll
            for (int ks2 = 0; ks2 < 2; ++ks2)
#pragma unroll
                for (int te = 0; te < 4; ++te) { vlo[ks2][te] = *(const LAS u32x2*)(Vt + (16 * te + c) * 72 + 32 * ks2 + 4 * q); vhi[ks2][te] = *(const LAS u32x2*)(Vt + (16 * te + c) * 72 + 32 * ks2 + 16 + 4 * q); }
            __builtin_amdgcn_sched_barrier(0);
            f32x4 sacc[4][2];
#pragma unroll
            for (int tj = 0; tj < 4; ++tj)
#pragma unroll
                for (int ti = 0; ti < 2; ++ti) sacc[tj][ti] = (f32x4){0.f, 0.f, 0.f, 0.f};
#pragma unroll
            for (int ks = 0; ks < 2; ++ks)
#pragma unroll
                for (int tj = 0; tj < 4; ++tj)
#pragma unroll
                    for (int ti = 0; ti < 2; ++ti) sacc[tj][ti] = mfma16(kfr[ks][tj], qf[ti][ks], sacc[tj][ti]);
            const bool band = tt < nb;
            const int kp0 = 64 * qb - 128 + 64 * (kt0 + tt) + 4 * q;
#pragma unroll
            for (int ti = 0; ti < 2; ++ti) {
                const int qp = 64 * qb + i0 + 16 * ti + c;
                float mx = -30000.0f;
                if (band) {
#pragma unroll
                    for (int tj = 0; tj < 4; ++tj)
#pragma unroll
                        for (int r = 0; r < 4; ++r) { float sv = sacc[tj][ti][r] * (0.125f * LOG2E); const int dlt = kp0 + 16 * tj + r - qp; if (dlt > 128 || dlt < -128) sv = -30000.0f; sacc[tj][ti][r] = sv; mx = fmaxf(mx, sv); }
                } else {
#pragma unroll
                    for (int tj = 0; tj < 4; ++tj)
#pragma unroll
                        for (int r = 0; r < 4; ++r) { const float sv = sacc[tj][ti][r] * (0.125f * LOG2E); sacc[tj][ti][r] = sv; mx = fmaxf(mx, sv); }
                }
                mx = quad_rows_max(mx);
                const float mn = fmaxf(mrun[ti], mx), corr = __builtin_amdgcn_exp2f(mrun[ti] - mn);
                float ls = 0.f;
#pragma unroll
                for (int tj = 0; tj < 4; ++tj)
#pragma unroll
                    for (int r = 0; r < 4; ++r) { const float p = __builtin_amdgcn_exp2f(sacc[tj][ti][r] - mn); sacc[tj][ti][r] = p; ls += p; }
                ls = quad_rows_sum(ls);
                lrun[ti] = lrun[ti] * corr + ls; mrun[ti] = mn;
#pragma unroll
                for (int te = 0; te < 4; ++te) oacc[te][ti] *= corr;
            }
#pragma unroll
            for (int ks2 = 0; ks2 < 2; ++ks2) {
                bf16x8 pb[2];
#pragma unroll
                for (int ti = 0; ti < 2; ++ti) { u32x4 t; t.x = cvtpk(sacc[2 * ks2][ti][0], sacc[2 * ks2][ti][1]); t.y = cvtpk(sacc[2 * ks2][ti][2], sacc[2 * ks2][ti][3]);
                    t.z = cvtpk(sacc[2 * ks2 + 1][ti][0], sacc[2 * ks2 + 1][ti][1]); t.w = cvtpk(sacc[2 * ks2 + 1][ti][2], sacc[2 * ks2 + 1][ti][3]); pb[ti] = __builtin_bit_cast(bf16x8, t); }
#pragma unroll
                for (int te = 0; te < 4; ++te) { const bf16x8 va = __builtin_bit_cast(bf16x8, ((u32x4){vlo[ks2][te].x, vlo[ks2][te].y, vhi[ks2][te].x, vhi[ks2][te].y}));
#pragma unroll
                    for (int ti = 0; ti < 2; ++ti) oacc[te][ti] = mfma16(va, pb[ti], oacc[te][ti]); }
            }
        }
#pragma unroll
        for (int ti = 0; ti < 2; ++ti) { const float il = 1.0f / lrun[ti]; bf16* orow = O + (size_t)(mrow0 + i0 + 16 * ti + c) * D + 512 + hq * 64 + 4 * q;
#pragma unroll
            for (int te = 0; te < 4; ++te) { u32x2 wv; wv.x = cvtpk(oacc[te][ti][0] * il, oacc[te][ti][1] * il); wv.y = cvtpk(oacc[te][ti][2] * il, oacc[te][ti][3] * il); *(u32x2*)(orow + 16 * te) = wv; } }
    }
}


__device__ __forceinline__ void phase_gdn_local(Frame& F) {
    unsigned char* prep = F.ws + WS_R1 + R1_PREP;
    const bf16* GD = (const bf16*)(prep + PREP_GD); const float* GB = (const float*)(F.ws + WS_GB);
    LAS bf16* Qs = (LAS bf16*)F.lds; LAS bf16* Ks = Qs + 64 * 72; LAS bf16* Vs = Ks + 64 * 72;
    LAS float* At = (LAS float*)(F.lds + 27648);
    LAS bf16* ATs = (LAS bf16*)(F.lds + 60416);
    LAS bf16* XS_ = (LAS bf16*)(F.lds + 78848);
    LAS float* sm = (LAS float*)(F.lds + 115712);
    LAS float* gl = sm; LAS float* bl = sm + 128; LAS float* gcs = sm + 256; LAS float* eg = sm + 384; LAS float* ekd = sm + 512;
    const int lane = F.lane, c = lane & 15, q = lane >> 4, w = F.wave, tid = F.tid;
    for (int uu = F.bid; uu < 16 * 68; uu += F.G) {
        const int bh = uu / 68, ch = uu % 68, b = bh >> 2, hh = bh & 3;
        const int m0 = ch < 4 ? b * TC + 64 * ch : MC + b * TL + 64 * (ch - 4);
        __syncthreads();
        { const int row = tid >> 3, col8 = (tid & 7) * 8; const bf16* src = GD + (size_t)(m0 + row) * 768 + hh * 64 + col8;
          *(LAS u32x4*)(Qs + row * 72 + col8) = *(const u32x4*)(src); *(LAS u32x4*)(Ks + row * 72 + col8) = *(const u32x4*)(src + 256); *(LAS u32x4*)(Vs + row * 72 + col8) = *(const u32x4*)(src + 512);
          if (tid < 256) { const int tok = tid & 63, which = tid >> 6; sm[which * 64 + tok] = GB[(size_t)(m0 + tok) * 16 + (which >> 1) * 8 + (which & 1) * 4 + hh]; } }
        __syncthreads();
        if (w < 2) { const int d = w; const int tok = d ? 63 - lane : lane; float v = gl[d * 64 + tok];
#pragma unroll
            for (int o = 1; o < 64; o <<= 1) { const float t = __shfl_up(v, o); if (lane >= o) v += t; }
            const float last = __shfl(v, 63);
            gcs[d * 64 + lane] = v; eg[d * 64 + lane] = fexp(v); ekd[d * 64 + lane] = fexp(last - v); }
        __syncthreads();
        {
            const int type = w >> 2, ti = w & 3; const LAS bf16* X = type ? Qs : Ks;
            bf16x8 a[2];
#pragma unroll
            for (int ks = 0; ks < 2; ++ks) a[ks] = *(const LAS bf16x8*)(X + (16 * ti + c) * 72 + 32 * ks + 8 * q);
#pragma unroll
            for (int tj = 0; tj < 4; ++tj) { f32x4 acc = (f32x4){0.f, 0.f, 0.f, 0.f};
#pragma unroll
                for (int ks = 0; ks < 2; ++ks) acc = mfma16(a[ks], *(const LAS bf16x8*)(Ks + (16 * tj + c) * 72 + 32 * ks + 8 * q), acc);
#pragma unroll
                for (int r = 0; r < 4; ++r) { const int it = 16 * ti + 4 * q + r, jt = 16 * tj + c;
#pragma unroll
                    for (int d = 0; d < 2; ++d) { const int i = d ? 63 - it : it, j = d ? 63 - jt : jt;
                        const float e = fexp(fminf(gcs[d * 64 + i] - gcs[d * 64 + j], 0.f));
                        if (type == 0) At[d * 4096 + j * 64 + i] = (j < i) ? bl[d * 64 + it] * acc[r] * e : 0.f;
                        else ATs[d * 4608 + i * 72 + j] = (bf16)f2bf((j <= i) ? acc[r] * e : 0.f); } } }
        }
        __syncthreads();
        if (w < 4) {
            const int d = w >> 1, kind = w & 1; const LAS bf16* R = kind ? Ks : Vs; const LAS float* A = At + d * 4096;
            float x[64];
#pragma unroll
            for (int i = 0; i < 64; ++i) { const int tok = d ? 63 - i : i; float v = bl[d * 64 + tok] * bf2f(R[tok * 72 + lane]); if (kind) v *= eg[d * 64 + i]; x[i] = v; }
#pragma unroll
            for (int j = 0; j < 63; ++j) { const float xj = x[j];
                f32x4 ca[16];
#pragma unroll
                for (int g = ((j + 1) >> 2); g < 16; ++g) ca[g] = *(const LAS f32x4*)(A + j * 64 + 4 * g);
                __builtin_amdgcn_sched_barrier(0);
#pragma unroll
                for (int g = ((j + 1) >> 2); g < 16; ++g) { x[4 * g] -= ca[g].x * xj; x[4 * g + 1] -= ca[g].y * xj; x[4 * g + 2] -= ca[g].z * xj; x[4 * g + 3] -= ca[g].w * xj; }
                __builtin_amdgcn_sched_barrier(0); }
            LAS bf16* XO = XS_ + (d * 2 + kind) * 4608;
#pragma unroll
            for (int i = 0; i < 64; ++i) XO[i * 72 + lane] = (bf16)f2bf(x[i]);
        } else {
            const int t2 = tid - 256;
            for (int it = t2; it < 6 * 512; it += 256) { const int mat = it >> 9, chk = it & 511, d = mat & 1, kindm = mat >> 1;
                const int rt = chk >> 7, ks = (chk >> 6) & 1, ln = chk & 63, r = ln & 15, qq = ln >> 4, row = 16 * rt + r, c0 = 32 * ks + 4 * qq;
                float v[8];
                if (kindm == 0) { const u32x2 lo = *(const LAS u32x2*)(ATs + d * 4608 + row * 72 + c0), hi = *(const LAS u32x2*)(ATs + d * 4608 + row * 72 + c0 + 16);
                    v[0] = __uint_as_float(lo.x << 16); v[1] = __uint_as_float(lo.x & 0xffff0000u); v[2] = __uint_as_float(lo.y << 16); v[3] = __uint_as_float(lo.y & 0xffff0000u);
                    v[4] = __uint_as_float(hi.x << 16); v[5] = __uint_as_float(hi.x & 0xffff0000u); v[6] = __uint_as_float(hi.y << 16); v[7] = __uint_as_float(hi.y & 0xffff0000u); }
                else if (kindm == 1) { const int tok = d ? 63 - row : row; const float sc = eg[d * 64 + row];
#pragma unroll
                    for (int x8 = 0; x8 < 8; ++x8) v[x8] = bf2f(Qs[tok * 72 + c0 + (x8 & 3) + 16 * (x8 >> 2)]) * sc; }
                else {
#pragma unroll
                    for (int x8 = 0; x8 < 8; ++x8) { const int i = c0 + (x8 & 3) + 16 * (x8 >> 2); const int tok = d ? 63 - i : i; v[x8] = bf2f(Ks[tok * 72 + row]) * ekd[d * 64 + i]; } }
                const int chain = bh * 2 + d, sg = ch < 4 ? (d ? 3 - ch : ch) : 4 + (d ? 63 - (ch - 4) : ch - 4);
                unsigned char* dst = F.ws + WS_GCH + (size_t)chain * GCH_CHAIN + (size_t)sg * GCH_STEP + (kindm == 0 ? 16384 : (kindm == 1 ? 8192 : 24576));
                u32x4 o; o.x = pk2(v[0], v[1]); o.y = pk2(v[2], v[3]); o.z = pk2(v[4], v[5]); o.w = pk2(v[6], v[7]);
                *(u32x4*)(dst + chk * 16) = o; }
        }
        __syncthreads();
        {
            for (int it = tid; it < 2 * 512; it += NTHR) { const int d = it >> 9, chk = it & 511;
                const int rt = chk >> 7, ks = (chk >> 6) & 1, ln = chk & 63, r = ln & 15, qq = ln >> 4, row = 16 * rt + r, c0 = 32 * ks + 4 * qq;
                const LAS bf16* XW = XS_ + (d * 2 + 1) * 4608;
                const u32x2 lo = *(const LAS u32x2*)(XW + row * 72 + c0), hi = *(const LAS u32x2*)(XW + row * 72 + c0 + 16);
                const int chain = bh * 2 + d, sg = ch < 4 ? (d ? 3 - ch : ch) : 4 + (d ? 63 - (ch - 4) : ch - 4);
                unsigned char* dst = F.ws + WS_GCH + (size_t)chain * GCH_CHAIN + (size_t)sg * GCH_STEP;
                *(u32x4*)(dst + chk * 16) = (u32x4){lo.x, lo.y, hi.x, hi.y}; }
            for (int it = tid; it < 2 * 1024; it += NTHR) { const int d = it >> 10, cu = it & 1023;
                const int sl = cu >> 8, rt = (cu >> 6) & 3, ln = cu & 63, qq = ln >> 4, cc = ln & 15;
                const LAS bf16* XU = XS_ + (d * 2) * 4608;
                bf16 e0 = XU[(16 * rt + 4 * qq + 0) * 72 + 16 * sl + cc], e1 = XU[(16 * rt + 4 * qq + 1) * 72 + 16 * sl + cc], e2 = XU[(16 * rt + 4 * qq + 2) * 72 + 16 * sl + cc], e3 = XU[(16 * rt + 4 * qq + 3) * 72 + 16 * sl + cc];
                const int chain = bh * 2 + d, sg = ch < 4 ? (d ? 3 - ch : ch) : 4 + (d ? 63 - (ch - 4) : ch - 4);
                unsigned char* dst = F.ws + WS_GCH + (size_t)chain * GCH_CHAIN + (size_t)sg * GCH_STEP + 32768;
                *(u32x2*)(dst + cu * 8) = (u32x2){(unsigned)e0 | ((unsigned)e1 << 16), (unsigned)e2 | ((unsigned)e3 << 16)}; }
            if (tid < 2) { const int d = tid; const int chain = bh * 2 + d, sg = ch < 4 ? (d ? 3 - ch : ch) : 4 + (d ? 63 - (ch - 4) : ch - 4);
                ((float*)(F.ws + WS_GDEC))[chain * 68 + sg] = eg[d * 64 + 63]; }
        }
    }
}

__device__ __forceinline__ void phase_gdn_scan(Frame& F, int first_wg) {
    const int chain = F.bid - first_wg; if (chain < 0 || chain >= 32) return;
    const int b = chain >> 3, hh = (chain >> 1) & 3, d = chain & 1;
    const unsigned char* src = F.ws + WS_GCH + (size_t)chain * GCH_CHAIN;
    const float* decs = (const float*)(F.ws + WS_GDEC) + chain * 68;
    float* OUT = (float*)(F.ws + WS_R1 + R1_OG) + (size_t)d * M * 256;
    LAS unsigned char* ring = F.lds;
    const int lane = F.lane, w = F.wave;
    if (w >= 4) {
        const int dw = w - 4;
#define GS_ISSUE(step) do { _Pragma("unroll") for (int k = 0; k < 10; ++k) { const int p = dw * 10 + k; \
            __builtin_amdgcn_global_load_lds((const unsigned*)(src + (size_t)(step) * GCH_STEP + p * 1024 + lane * 16), (LAS unsigned*)(ring + ((step) % 3) * 40960 + p * 1024), 16, 0, 0); } } while (0)
        GS_ISSUE(0); GS_ISSUE(1);
        asm volatile("s_waitcnt vmcnt(10)" ::: "memory"); __builtin_amdgcn_s_barrier();
        for (int n = 0; n < 68; ++n) {
            if (n + 2 < 68) { GS_ISSUE(n + 2); asm volatile("s_waitcnt vmcnt(10)" ::: "memory"); }
            else asm volatile("s_waitcnt vmcnt(0)" ::: "memory");
            __builtin_amdgcn_s_barrier();
        }
#undef GS_ISSUE
    } else {
        const int sl = w, qq = lane >> 4, cc = lane & 15;
        f32x4 S[4];
#pragma unroll
        for (int rt = 0; rt < 4; ++rt) S[rt] = (f32x4){0.f, 0.f, 0.f, 0.f};
        const float dv0 = decs[lane], dv1 = decs[64 + (lane & 3)];
        asm volatile("s_waitcnt vmcnt(0)" ::: "memory"); __builtin_amdgcn_s_barrier(); asm volatile("" ::: "memory");
        for (int n = 0; n < 68; ++n) {
            const LAS unsigned char* base = ring + (n % 3) * 40960;
            const float dec = n < 64 ? __shfl(dv0, n) : __shfl(dv1, n - 64);
#define GS_FRAG(mat, rt, ks) (*(const LAS bf16x8*)(base + (mat) * 8192 + (((rt) * 2 + (ks)) * 64 + lane) * 16))
            bf16x8 BS[2], BV[2];
#pragma unroll
            for (int ks = 0; ks < 2; ++ks) { u32x4 t; t.x = cvtpk(S[2 * ks][0], S[2 * ks][1]); t.y = cvtpk(S[2 * ks][2], S[2 * ks][3]); t.z = cvtpk(S[2 * ks + 1][0], S[2 * ks + 1][1]); t.w = cvtpk(S[2 * ks + 1][2], S[2 * ks + 1][3]); BS[ks] = __builtin_bit_cast(bf16x8, t); }
            f32x4 vn[4], o[4];
#pragma unroll
            for (int rt = 0; rt < 4; ++rt) { f32x4 acc = (f32x4){0.f, 0.f, 0.f, 0.f};
#pragma unroll
                for (int ks = 0; ks < 2; ++ks) acc = mfma16(GS_FRAG(0, rt, ks), BS[ks], acc);
                const u32x2 uu = *(const LAS u32x2*)(base + 32768 + ((sl * 4 + rt) * 64 + lane) * 8);
                vn[rt] = (f32x4){__uint_as_float(uu.x << 16), __uint_as_float(uu.x & 0xffff0000u), __uint_as_float(uu.y << 16), __uint_as_float(uu.y & 0xffff0000u)} - acc;
                f32x4 oo = (f32x4){0.f, 0.f, 0.f, 0.f};
#pragma unroll
                for (int ks = 0; ks < 2; ++ks) oo = mfma16(GS_FRAG(1, rt, ks), BS[ks], oo);
                o[rt] = oo; }
#pragma unroll
            for (int ks = 0; ks < 2; ++ks) { u32x4 t; t.x = cvtpk(vn[2 * ks][0], vn[2 * ks][1]); t.y = cvtpk(vn[2 * ks][2], vn[2 * ks][3]); t.z = cvtpk(vn[2 * ks + 1][0], vn[2 * ks + 1][1]); t.w = cvtpk(vn[2 * ks + 1][2], vn[2 * ks + 1][3]); BV[ks] = __builtin_bit_cast(bf16x8, t); }
#pragma unroll
            for (int rt = 0; rt < 4; ++rt) { f32x4 oo = o[rt], sn = S[rt] * dec;
#pragma unroll
                for (int ks = 0; ks < 2; ++ks) { oo = mfma16(GS_FRAG(2, rt, ks), BV[ks], oo); sn = mfma16(GS_FRAG(3, rt, ks), BV[ks], sn); }
                o[rt] = oo; S[rt] = sn; }
#undef GS_FRAG
            const int m0 = n < 4 ? b * TC + 64 * (d ? 3 - n : n) : MC + b * TL + 64 * (d ? 63 - (n - 4) : n - 4);
#pragma unroll
            for (int rt = 0; rt < 4; ++rt)
#pragma unroll
                for (int r = 0; r < 4; ++r) { const int i = 16 * rt + 4 * qq + r, tok = d ? 63 - i : i; OUT[(size_t)(m0 + tok) * 256 + hh * 64 + 16 * sl + cc] = o[rt][r]; }
            asm volatile("s_waitcnt lgkmcnt(0)" ::: "memory"); PB(11); __builtin_amdgcn_s_barrier(); PE(11); asm volatile("" ::: "memory");
        }
    }
}


__device__ __forceinline__ void phase_gdn_local2(Frame& F) {
    unsigned char* prep = F.ws + WS_R1 + R1_PREP;
    const bf16* GD = (const bf16*)(prep + PREP_GD); const float* GB = (const float*)(F.ws + WS_GB);
    LAS bf16* Ks = (LAS bf16*)F.lds; LAS bf16* Vs = Ks + 64 * 72;
    LAS float* At = (LAS float*)(F.lds + 18432);
    LAS bf16* XS_ = (LAS bf16*)(F.lds + 51200);
    LAS float* sm = (LAS float*)(F.lds + 88064);
    LAS float* gl = sm; LAS float* bl = sm + 128; LAS float* gcs = sm + 256; LAS float* eg = sm + 384; LAS float* ekd = sm + 512;
    const int lane = F.lane, c = lane & 15, q = lane >> 4, w = F.wave, tid = F.tid;
    for (int uu = F.bid; uu < 16 * 68; uu += F.G) {
        const int bh = uu / 68, ch = uu % 68, b = bh >> 2, hh = bh & 3;
        const int m0 = ch < 4 ? b * TC + 64 * ch : MC + b * TL + 64 * (ch - 4);
        __syncthreads();
        { const int row = tid >> 3, col8 = (tid & 7) * 8; const bf16* src = GD + (size_t)(m0 + row) * 768 + hh * 64 + col8;
          *(LAS u32x4*)(Ks + row * 72 + col8) = *(const u32x4*)(src + 256); *(LAS u32x4*)(Vs + row * 72 + col8) = *(const u32x4*)(src + 512);
          if (tid < 256) { const int tok = tid & 63, which = tid >> 6; sm[which * 64 + tok] = GB[(size_t)(m0 + tok) * 16 + (which >> 1) * 8 + (which & 1) * 4 + hh]; } }
        __syncthreads();
        if (w < 2) { const int d = w; const int tok = d ? 63 - lane : lane; float v = gl[d * 64 + tok];
#pragma unroll
            for (int o = 1; o < 64; o <<= 1) { const float t = __shfl_up(v, o); if (lane >= o) v += t; }
            const float last = __shfl(v, 63);
            gcs[d * 64 + lane] = v; eg[d * 64 + lane] = fexp(v); ekd[d * 64 + lane] = fexp(last - v);
            ((float*)(F.ws + WS_GCS))[((size_t)uu * 2 + d) * 64 + tok] = v; }
        __syncthreads();
        {
            const int ti = w & 3, th = w >> 2;
            bf16x8 a[2];
#pragma unroll
            for (int ks = 0; ks < 2; ++ks) a[ks] = *(const LAS bf16x8*)(Ks + (16 * ti + c) * 72 + 32 * ks + 8 * q);
#pragma unroll
            for (int t2 = 0; t2 < 2; ++t2) { const int tj = 2 * th + t2; f32x4 acc = (f32x4){0.f, 0.f, 0.f, 0.f};
#pragma unroll
                for (int ks = 0; ks < 2; ++ks) acc = mfma16(a[ks], *(const LAS bf16x8*)(Ks + (16 * tj + c) * 72 + 32 * ks + 8 * q), acc);
#pragma unroll
                for (int r = 0; r < 4; ++r) { const int it = 16 * ti + 4 * q + r, jt = 16 * tj + c;
#pragma unroll
                    for (int d = 0; d < 2; ++d) { const int i = d ? 63 - it : it, j = d ? 63 - jt : jt;
                        const float e = fexp(fminf(gcs[d * 64 + i] - gcs[d * 64 + j], 0.f));
                        At[d * 4096 + j * 64 + i] = (j < i) ? bl[d * 64 + it] * acc[r] * e : 0.f; } } }
        }
        __syncthreads();
        if (w < 4) {
            const int d = w >> 1, kind = w & 1; const LAS bf16* R = kind ? Ks : Vs; const LAS float* A = At + d * 4096;
            float x[64];
#pragma unroll
            for (int i = 0; i < 64; ++i) { const int tok = d ? 63 - i : i; float v = bl[d * 64 + tok] * bf2f(R[tok * 72 + lane]); if (kind) v *= eg[d * 64 + i]; x[i] = v; }
#pragma unroll
            for (int j = 0; j < 63; ++j) { const float xj = x[j];
                f32x4 ca[16];
#pragma unroll
                for (int g = ((j + 1) >> 2); g < 16; ++g) ca[g] = *(const LAS f32x4*)(A + j * 64 + 4 * g);
                __builtin_amdgcn_sched_barrier(0);
#pragma unroll
                for (int g = ((j + 1) >> 2); g < 16; ++g) { x[4 * g] -= ca[g].x * xj; x[4 * g + 1] -= ca[g].y * xj; x[4 * g + 2] -= ca[g].z * xj; x[4 * g + 3] -= ca[g].w * xj; }
                __builtin_amdgcn_sched_barrier(0); }
            LAS bf16* XO = XS_ + (d * 2 + kind) * 4608;
#pragma unroll
            for (int i = 0; i < 64; ++i) XO[i * 72 + lane] = (bf16)f2bf(x[i]);
        } else {
            const int t2 = tid - 256;
            for (int it = t2; it < 2 * 512; it += 256) { const int d = it >> 9, chk = it & 511;
                const int rt = chk >> 7, ks = (chk >> 6) & 1, ln = chk & 63, r = ln & 15, qq = ln >> 4, row = 16 * rt + r, c0 = 32 * ks + 4 * qq;
                float v[8];
#pragma unroll
                for (int x8 = 0; x8 < 8; ++x8) { const int tok = c0 + (x8 & 3) + 16 * (x8 >> 2); const int i = d ? 63 - tok : tok; v[x8] = bf2f(Ks[tok * 72 + row]) * ekd[d * 64 + i]; }
                const int chain = bh * 2 + d, sg = ch < 4 ? (d ? 3 - ch : ch) : 4 + (d ? 63 - (ch - 4) : ch - 4);
                unsigned char* dst = F.ws + WS_GCH + (size_t)chain * G2_CHAIN + (size_t)sg * G2_STEP + 8192;
                u32x4 o; o.x = cvtpk(v[0], v[1]); o.y = cvtpk(v[2], v[3]); o.z = cvtpk(v[4], v[5]); o.w = cvtpk(v[6], v[7]);
                *(u32x4*)(dst + chk * 16) = o; }
        }
        __syncthreads();
        {
            for (int it = tid; it < 2 * 512; it += NTHR) { const int d = it >> 9, chk = it & 511;
                const int rt = chk >> 7, ks = (chk >> 6) & 1, ln = chk & 63, r = ln & 15, qq = ln >> 4, row = 16 * rt + r, c0 = 32 * ks + 4 * qq;
                const LAS bf16* XW = XS_ + (d * 2 + 1) * 4608;
                const int prow = d ? 63 - row : row;
                const u32x2 lo = *(const LAS u32x2*)(XW + prow * 72 + c0), hi = *(const LAS u32x2*)(XW + prow * 72 + c0 + 16);
                const int chain = bh * 2 + d, sg = ch < 4 ? (d ? 3 - ch : ch) : 4 + (d ? 63 - (ch - 4) : ch - 4);
                unsigned char* dst = F.ws + WS_GCH + (size_t)chain * G2_CHAIN + (size_t)sg * G2_STEP;
                *(u32x4*)(dst + chk * 16) = (u32x4){lo.x, lo.y, hi.x, hi.y}; }
            for (int it = tid; it < 2 * 1024; it += NTHR) { const int d = it >> 10, cu = it & 1023;
                const int sl = cu >> 8, rt = (cu >> 6) & 3, ln = cu & 63, qq = ln >> 4, cc = ln & 15;
                const LAS bf16* XU = XS_ + (d * 2) * 4608;
                const int tr = 16 * rt + 4 * qq, p0 = d ? 63 - tr : tr, ps = d ? -1 : 1;
                bf16 e0 = XU[(p0) * 72 + 16 * sl + cc], e1 = XU[(p0 + ps) * 72 + 16 * sl + cc], e2 = XU[(p0 + 2 * ps) * 72 + 16 * sl + cc], e3 = XU[(p0 + 3 * ps) * 72 + 16 * sl + cc];
                const int chain = bh * 2 + d, sg = ch < 4 ? (d ? 3 - ch : ch) : 4 + (d ? 63 - (ch - 4) : ch - 4);
                unsigned char* dst = F.ws + WS_GCH + (size_t)chain * G2_CHAIN + (size_t)sg * G2_STEP + 16384;
                *(u32x2*)(dst + cu * 8) = (u32x2){(unsigned)e0 | ((unsigned)e1 << 16), (unsigned)e2 | ((unsigned)e3 << 16)}; }
            if (tid < 2) { const int d = tid; const int chain = bh * 2 + d, sg = ch < 4 ? (d ? 3 - ch : ch) : 4 + (d ? 63 - (ch - 4) : ch - 4);
                ((float*)(F.ws + WS_GDEC))[chain * 68 + sg] = eg[d * 64 + 63]; }
        }
    }
}

__device__ __forceinline__ void phase_gdn_scan2(Frame& F, int first_wg) {
    const int chain = F.bid - first_wg; if (chain < 0 || chain >= 32) return;
    const int d = chain & 1;
    const unsigned char* src = F.ws + WS_GCH + (size_t)chain * G2_CHAIN;
    const float* decs = (const float*)(F.ws + WS_GDEC) + chain * 68;
    bf16* GST = (bf16*)(F.ws + WS_GST) + (size_t)chain * 68 * 8192;
    LAS unsigned char* ring = F.lds;
    const int lane = F.lane, w = F.wave;
    if (w >= 2) {
        const int dw = w - 2;
#define GS2_ISSUE(step) do { _Pragma("unroll") for (int k = 0; k < 4; ++k) { const int p = dw * 4 + k; \
            __builtin_amdgcn_global_load_lds((const unsigned*)(src + (size_t)(step) * G2_STEP + p * 1024 + lane * 16), (LAS unsigned*)(ring + ((step) & 3) * 24576 + p * 1024), 16, 0, 0); } } while (0)
        GS2_ISSUE(0); GS2_ISSUE(1); GS2_ISSUE(2);
        asm volatile("s_waitcnt vmcnt(8)" ::: "memory"); __builtin_amdgcn_s_barrier();
        for (int n = 0; n < 68; ++n) {
            if (n + 3 < 68) { GS2_ISSUE(n + 3); asm volatile("s_waitcnt vmcnt(8)" ::: "memory"); }
            else if (n + 2 < 68) asm volatile("s_waitcnt vmcnt(4)" ::: "memory");
            else asm volatile("s_waitcnt vmcnt(0)" ::: "memory");
            __builtin_amdgcn_s_barrier();
        }
#undef GS2_ISSUE
    } else {
        const int qq = lane >> 4, cc = lane & 15;
        f32x4 S[2][4];
#pragma unroll
        for (int ct = 0; ct < 2; ++ct)
#pragma unroll
            for (int rt = 0; rt < 4; ++rt) S[ct][rt] = (f32x4){0.f, 0.f, 0.f, 0.f};
        const float dv0 = decs[lane], dv1 = decs[64 + (lane & 3)];
        asm volatile("s_waitcnt vmcnt(0)" ::: "memory"); __builtin_amdgcn_s_barrier(); asm volatile("" ::: "memory");
        for (int n = 0; n < 68; ++n) {
            const LAS unsigned char* base = ring + (n & 3) * 24576;
            const float dec = n < 64 ? __shfl(dv0, n) : __shfl(dv1, n - 64);
            bf16* st = GST + (size_t)n * 8192;
            bf16* vt = st + 4096;
#define GS2_FRAG(mat, rt, ks) (*(const LAS bf16x8*)(base + (mat) * 8192 + (((rt) * 2 + (ks)) * 64 + lane) * 16))
            bf16x8 wf[4][2], kf[4][2]; u32x2 uf[2][4];
#pragma unroll
            for (int rt = 0; rt < 4; ++rt) { wf[rt][0] = GS2_FRAG(0, rt, 0); wf[rt][1] = GS2_FRAG(0, rt, 1); }
#pragma unroll
            for (int ct = 0; ct < 2; ++ct)
#pragma unroll
                for (int rt = 0; rt < 4; ++rt) uf[ct][rt] = *(const LAS u32x2*)(base + 16384 + (((2 * w + ct) * 4 + rt) * 64 + lane) * 8);
#pragma unroll
            for (int rt = 0; rt < 4; ++rt) { kf[rt][0] = GS2_FRAG(1, rt, 0); kf[rt][1] = GS2_FRAG(1, rt, 1); }
            __builtin_amdgcn_sched_barrier(0);
            bf16x8 BS[2][2], BV[2][2];
#pragma unroll
            for (int ct = 0; ct < 2; ++ct) { const int e = 32 * w + 16 * ct + cc;
#pragma unroll
                for (int ks = 0; ks < 2; ++ks) { u32x4 t; t.x = cvtpk(S[ct][2 * ks][0], S[ct][2 * ks][1]); t.y = cvtpk(S[ct][2 * ks][2], S[ct][2 * ks][3]); t.z = cvtpk(S[ct][2 * ks + 1][0], S[ct][2 * ks + 1][1]); t.w = cvtpk(S[ct][2 * ks + 1][2], S[ct][2 * ks + 1][3]);
                    BS[ct][ks] = __builtin_bit_cast(bf16x8, t);
                    *(u32x2*)(st + e * 64 + 32 * ks + 4 * qq) = (u32x2){t.x, t.y}; *(u32x2*)(st + e * 64 + 32 * ks + 16 + 4 * qq) = (u32x2){t.z, t.w}; } }
            f32x4 vn[2][4];
#pragma unroll
            for (int ks = 0; ks < 2; ++ks)
#pragma unroll
                for (int rt = 0; rt < 4; ++rt)
#pragma unroll
                    for (int ct = 0; ct < 2; ++ct) vn[ct][rt] = mfma16(wf[rt][ks], BS[ct][ks], ks ? vn[ct][rt] : (f32x4){0.f, 0.f, 0.f, 0.f});
#pragma unroll
            for (int ct = 0; ct < 2; ++ct)
#pragma unroll
                for (int rt = 0; rt < 4; ++rt) { const u32x2 uu = uf[ct][rt];
                    vn[ct][rt] = (f32x4){__uint_as_float(uu.x << 16), __uint_as_float(uu.x & 0xffff0000u), __uint_as_float(uu.y << 16), __uint_as_float(uu.y & 0xffff0000u)} - vn[ct][rt]; }
#pragma unroll
            for (int ct = 0; ct < 2; ++ct) { const int e = 32 * w + 16 * ct + cc;
#pragma unroll
                for (int ks = 0; ks < 2; ++ks) { u32x4 t; t.x = cvtpk(vn[ct][2 * ks][0], vn[ct][2 * ks][1]); t.y = cvtpk(vn[ct][2 * ks][2], vn[ct][2 * ks][3]); t.z = cvtpk(vn[ct][2 * ks + 1][0], vn[ct][2 * ks + 1][1]); t.w = cvtpk(vn[ct][2 * ks + 1][2], vn[ct][2 * ks + 1][3]);
                    BV[ct][ks] = __builtin_bit_cast(bf16x8, t);
                    if (d == 0) { *(u32x2*)(vt + e * 64 + 32 * ks + 4 * qq) = (u32x2){t.x, t.y}; *(u32x2*)(vt + e * 64 + 32 * ks + 16 + 4 * qq) = (u32x2){t.z, t.w}; }
                    else { const u32x2 r0 = (u32x2){(t.y >> 16) | (t.y << 16), (t.x >> 16) | (t.x << 16)}, r1 = (u32x2){(t.w >> 16) | (t.w << 16), (t.z >> 16) | (t.z << 16)};
                        *(u32x2*)(vt + e * 64 + 60 - 32 * ks - 4 * qq) = r0; *(u32x2*)(vt + e * 64 + 44 - 32 * ks - 4 * qq) = r1; } } }
#pragma unroll
            for (int ct = 0; ct < 2; ++ct)
#pragma unroll
                for (int rt = 0; rt < 4; ++rt) S[ct][rt] = S[ct][rt] * dec;
#pragma unroll
            for (int ks = 0; ks < 2; ++ks)
#pragma unroll
                for (int rt = 0; rt < 4; ++rt)
#pragma unroll
                    for (int ct = 0; ct < 2; ++ct) S[ct][rt] = mfma16(kf[rt][ks], BV[ct][ks], S[ct][rt]);
#undef GS2_FRAG
            asm volatile("s_waitcnt lgkmcnt(0)" ::: "memory"); __builtin_amdgcn_s_barrier(); asm volatile("" ::: "memory");
        }
    }
}

__device__ __forceinline__ void phase_gdn_out(Frame& F, const Inputs& in, int layer) {
    const bf16* P = (const bf16*)(F.ws + WS_R1 + R1_P);
    const bf16* GD = (const bf16*)(F.ws + WS_R1 + R1_PREP + PREP_GD);
    const bf16* GST = (const bf16*)(F.ws + WS_GST); const float* GCS = (const float*)(F.ws + WS_GCS);
    bf16* O = (bf16*)(F.ws + WS_R1 + R1_O);
    const int lane = F.lane, c = lane & 15, q = lane >> 4, w = F.wave, half = w >> 2, ti = w & 3, t2 = F.tid & 255;
    LAS bf16* Qs = (LAS bf16*)(F.lds + half * 56320); LAS bf16* Ks = Qs + 4608; LAS bf16* St = Ks + 4608; LAS bf16* Vn = St + 2 * 4608;
    LAS float* gT = (LAS float*)(F.lds + half * 56320 + 55296);
    for (int pp = F.bid; pp < 8 * 68; pp += F.G) {
        const int uu = 2 * pp + half, bh = uu / 68, ch = uu % 68, b = bh >> 2, hh = bh & 3;
        const int m0 = ch < 4 ? b * TC + 64 * ch : MC + b * TL + 64 * (ch - 4);
        __syncthreads();
#pragma unroll
        for (int rep = 0; rep < 2; ++rep) { const int idx = t2 + 256 * rep, row = idx >> 3, col8 = (idx & 7) * 8;
            const bf16* src = GD + (size_t)(m0 + row) * 768 + hh * 64 + col8;
            *(LAS u32x4*)(Qs + row * 72 + col8) = *(const u32x4*)(src); *(LAS u32x4*)(Ks + row * 72 + col8) = *(const u32x4*)(src + 256);
#pragma unroll
            for (int d = 0; d < 2; ++d) { const int sg = ch < 4 ? (d ? 3 - ch : ch) : 4 + (d ? 63 - (ch - 4) : ch - 4);
                const bf16* g = GST + ((size_t)(bh * 2 + d) * 68 + sg) * 8192 + row * 64 + col8;
                *(LAS u32x4*)(St + d * 4608 + row * 72 + col8) = *(const u32x4*)(g); *(LAS u32x4*)(Vn + d * 4608 + row * 72 + col8) = *(const u32x4*)(g + 4096); } }
        if (t2 < 128) gT[t2] = GCS[(size_t)uu * 128 + t2];
        __syncthreads();
        bf16x8 qf[2];
#pragma unroll
        for (int ks = 0; ks < 2; ++ks) qf[ks] = *(const LAS bf16x8*)(Qs + (16 * ti + c) * 72 + 32 * ks + 8 * q);
        const int i = 16 * ti + c;
        const float gi0 = gT[i], gi1 = gT[64 + i];
        f32x4 sacc[4];
#pragma unroll
        for (int tj = 0; tj < 4; ++tj) { f32x4 acc = (f32x4){0.f, 0.f, 0.f, 0.f};
#pragma unroll
            for (int ks = 0; ks < 2; ++ks) acc = mfma16(*(const LAS bf16x8*)(Ks + (16 * tj + c) * 72 + 32 * ks + 8 * q), qf[ks], acc);
            sacc[tj] = acc; }
        bf16x8 pb[2][2];
#pragma unroll
        for (int d = 0; d < 2; ++d) { f32x4 p[4];
#pragma unroll
            for (int tj = 0; tj < 4; ++tj) { const f32x4 gj = *(const LAS f32x4*)(gT + d * 64 + 16 * tj + 4 * q);
#pragma unroll
                for (int r = 0; r < 4; ++r) { const int j = 16 * tj + 4 * q + r; const bool ok = d ? (j >= i) : (j <= i);
                    p[tj][r] = ok ? sacc[tj][r] * fexp(fminf((d ? gi1 : gi0) - gj[r], 0.f)) : 0.f; } }
#pragma unroll
            for (int ks2 = 0; ks2 < 2; ++ks2) { u32x4 t; t.x = cvtpk(p[2 * ks2][0], p[2 * ks2][1]); t.y = cvtpk(p[2 * ks2][2], p[2 * ks2][3]); t.z = cvtpk(p[2 * ks2 + 1][0], p[2 * ks2 + 1][1]); t.w = cvtpk(p[2 * ks2 + 1][2], p[2 * ks2 + 1][3]); pb[d][ks2] = __builtin_bit_cast(bf16x8, t); } }
        const float sc0 = fexp(gi0), sc1 = fexp(gi1);
        f32x4 o[4]; float ssq = 0.f;
#pragma unroll
        for (int te = 0; te < 4; ++te) { f32x4 acc = (f32x4){0.f, 0.f, 0.f, 0.f}, t0 = acc, t1 = acc;
#pragma unroll
            for (int d = 0; d < 2; ++d)
#pragma unroll
                for (int ks2 = 0; ks2 < 2; ++ks2) { const u32x2 lo = *(const LAS u32x2*)(Vn + d * 4608 + (16 * te + c) * 72 + 32 * ks2 + 4 * q), hi = *(const LAS u32x2*)(Vn + d * 4608 + (16 * te + c) * 72 + 32 * ks2 + 16 + 4 * q);
                    acc = mfma16(__builtin_bit_cast(bf16x8, ((u32x4){lo.x, lo.y, hi.x, hi.y})), pb[d][ks2], acc); }
#pragma unroll
            for (int ks = 0; ks < 2; ++ks) { t0 = mfma16(*(const LAS bf16x8*)(St + (16 * te + c) * 72 + 32 * ks + 8 * q), qf[ks], t0);
                t1 = mfma16(*(const LAS bf16x8*)(St + 4608 + (16 * te + c) * 72 + 32 * ks + 8 * q), qf[ks], t1); }
            o[te] = acc + sc0 * t0 + sc1 * t1; ssq += (o[te][0] * o[te][0] + o[te][1] * o[te][1]) + (o[te][2] * o[te][2] + o[te][3] * o[te][3]); }
        ssq = quad_rows_sum(ssq);
        const float rs = 1.0f / sqrtf(ssq * (1.0f / 64.0f) + EPS);
#pragma unroll
        for (int te = 0; te < 4; ++te) { const int e0 = 16 * te + 4 * q;
            const u32x2 z2 = *(const u32x2*)(P + (size_t)(m0 + i) * NP + PC_GZ + hh * 64 + e0); const f32x4 gn = *(const f32x4*)(in.gdn_norm_g + layer * 64 + e0);
            const float z0 = __uint_as_float(z2.x << 16), z1 = __uint_as_float(z2.x & 0xffff0000u), z2f = __uint_as_float(z2.y << 16), z3 = __uint_as_float(z2.y & 0xffff0000u);
            u32x2 wv; wv.x = cvtpk(o[te][0] * rs * gn[0] * siluf(z0), o[te][1] * rs * gn[1] * siluf(z1)); wv.y = cvtpk(o[te][2] * rs * gn[2] * siluf(z2f), o[te][3] * rs * gn[3] * siluf(z3));
            *(u32x2*)(O + (size_t)(m0 + i) * D + 256 + hh * 64 + e0) = wv; }
    }
}


__device__ __forceinline__ void phase_gdn_scan3(Frame& F, int first_wg) {
    const int chain = F.bid - first_wg; if (chain < 0 || chain >= 32) return;
    const unsigned char* src = F.ws + WS_GCH + (size_t)chain * G2_CHAIN;
    const float* decs = (const float*)(F.ws + WS_GDEC) + chain * 68;
    unsigned char* GSTb = F.ws + WS_GST + (size_t)chain * 68 * 16384;
    LAS unsigned char* ring = F.lds;
    const int lane = F.lane, w = F.wave;
    if (w >= 4) {
        const int dw = w - 4;
#define GS3_ISSUE(step) do { _Pragma("unroll") for (int k = 0; k < 6; ++k) { const int p = dw * 6 + k; \
            __builtin_amdgcn_global_load_lds((const unsigned*)(src + (size_t)(step) * G2_STEP + p * 1024 + lane * 16), (LAS unsigned*)(ring + ((step) & 3) * 24576 + p * 1024), 16, 0, 0); } } while (0)
        GS3_ISSUE(0); GS3_ISSUE(1); GS3_ISSUE(2);
        asm volatile("s_waitcnt vmcnt(12)" ::: "memory"); __builtin_amdgcn_s_barrier();
        for (int n = 0; n < 68; ++n) {
            if (n + 3 < 68) { GS3_ISSUE(n + 3); asm volatile("s_waitcnt vmcnt(12)" ::: "memory"); }
            else if (n + 2 < 68) asm volatile("s_waitcnt vmcnt(6)" ::: "memory");
            else asm volatile("s_waitcnt vmcnt(0)" ::: "memory");
            __builtin_amdgcn_s_barrier();
        }
#undef GS3_ISSUE
    } else {
        const int sl = w;
        f32x4 S[4];
#pragma unroll
        for (int rt = 0; rt < 4; ++rt) S[rt] = (f32x4){0.f, 0.f, 0.f, 0.f};
        const float dv0 = decs[lane], dv1 = decs[64 + (lane & 3)];
        asm volatile("s_waitcnt vmcnt(0)" ::: "memory"); __builtin_amdgcn_s_barrier(); asm volatile("" ::: "memory");
        for (int n = 0; n < 68; ++n) {
            const LAS unsigned char* base = ring + (n & 3) * 24576;
            const float dec = n < 64 ? __shfl(dv0, n) : __shfl(dv1, n - 64);
            unsigned char* go = GSTb + (size_t)n * 16384 + (size_t)(sl * 2 * 64 + lane) * 16;
#define GS3_FRAG(mat, rt, ks) (*(const LAS bf16x8*)(base + (mat) * 8192 + (((rt) * 2 + (ks)) * 64 + lane) * 16))
            bf16x8 wf[4][2], kf[4][2]; u32x2 uf[4];
#pragma unroll
            for (int rt = 0; rt < 4; ++rt) { wf[rt][0] = GS3_FRAG(0, rt, 0); wf[rt][1] = GS3_FRAG(0, rt, 1); }
#pragma unroll
            for (int rt = 0; rt < 4; ++rt) uf[rt] = *(const LAS u32x2*)(base + 16384 + ((sl * 4 + rt) * 64 + lane) * 8);
#pragma unroll
            for (int rt = 0; rt < 4; ++rt) { kf[rt][0] = GS3_FRAG(1, rt, 0); kf[rt][1] = GS3_FRAG(1, rt, 1); }
#undef GS3_FRAG
            __builtin_amdgcn_sched_barrier(0);
            bf16x8 BS[2], BV[2];
#pragma unroll
            for (int ks = 0; ks < 2; ++ks) { u32x4 t; t.x = cvtpk(S[2 * ks][0], S[2 * ks][1]); t.y = cvtpk(S[2 * ks][2], S[2 * ks][3]); t.z = cvtpk(S[2 * ks + 1][0], S[2 * ks + 1][1]); t.w = cvtpk(S[2 * ks + 1][2], S[2 * ks + 1][3]);
                BS[ks] = __builtin_bit_cast(bf16x8, t); *(u32x4*)(go + ks * 1024) = t; }
            f32x4 vn[4];
#pragma unroll
            for (int ks = 0; ks < 2; ++ks)
#pragma unroll
                for (int rt = 0; rt < 4; ++rt) vn[rt] = mfma16(wf[rt][ks], BS[ks], ks ? vn[rt] : (f32x4){0.f, 0.f, 0.f, 0.f});
#pragma unroll
            for (int rt = 0; rt < 4; ++rt) { const u32x2 uu = uf[rt];
                vn[rt] = (f32x4){__uint_as_float(uu.x << 16), __uint_as_float(uu.x & 0xffff0000u), __uint_as_float(uu.y << 16), __uint_as_float(uu.y & 0xffff0000u)} - vn[rt]; }
#pragma unroll
            for (int ks = 0; ks < 2; ++ks) { u32x4 t; t.x = cvtpk(vn[2 * ks][0], vn[2 * ks][1]); t.y = cvtpk(vn[2 * ks][2], vn[2 * ks][3]); t.z = cvtpk(vn[2 * ks + 1][0], vn[2 * ks + 1][1]); t.w = cvtpk(vn[2 * ks + 1][2], vn[2 * ks + 1][3]);
                BV[ks] = __builtin_bit_cast(bf16x8, t); *(u32x4*)(go + 8192 + ks * 1024) = t; }
#pragma unroll
            for (int rt = 0; rt < 4; ++rt) S[rt] = S[rt] * dec;
#pragma unroll
            for (int ks = 0; ks < 2; ++ks)
#pragma unroll
                for (int rt = 0; rt < 4; ++rt) S[rt] = mfma16(kf[rt][ks], BV[ks], S[rt]);
            asm volatile("s_waitcnt lgkmcnt(0)" ::: "memory"); __builtin_amdgcn_s_barrier(); asm volatile("" ::: "memory");
        }
    }
}

__device__ __forceinline__ void phase_gdn_out2(Frame& F, const Inputs& in, int layer) {
    const bf16* P = (const bf16*)(F.ws + WS_R1 + R1_P);
    const bf16* GD = (const bf16*)(F.ws + WS_R1 + R1_PREP + PREP_GD);
    const unsigned char* GSTb = F.ws + WS_GST; const float* GCS = (const float*)(F.ws + WS_GCS);
    bf16* O = (bf16*)(F.ws + WS_R1 + R1_O);
    const int lane = F.lane, c = lane & 15, q = lane >> 4, w = F.wave, half = w >> 2, ti = w & 3, t2 = F.tid & 255;
    LAS bf16* Qs = (LAS bf16*)(F.lds + half * 56320); LAS bf16* Ks = Qs + 4608;
    LAS unsigned char* Fr = F.lds + half * 56320 + 18432;
    LAS float* gT = (LAS float*)(F.lds + half * 56320 + 55296);
    for (int pp = F.bid; pp < 8 * 68; pp += F.G) {
        const int uu = 2 * pp + half, bh = uu / 68, ch = uu % 68, b = bh >> 2, hh = bh & 3;
        const int m0 = ch < 4 ? b * TC + 64 * ch : MC + b * TL + 64 * (ch - 4);
        __syncthreads();
#pragma unroll
        for (int rep = 0; rep < 2; ++rep) { const int idx = t2 + 256 * rep, row = idx >> 3, col8 = (idx & 7) * 8;
            const bf16* src = GD + (size_t)(m0 + row) * 768 + hh * 64 + col8;
            *(LAS u32x4*)(Qs + row * 72 + col8) = *(const u32x4*)(src); *(LAS u32x4*)(Ks + row * 72 + col8) = *(const u32x4*)(src + 256); }
#pragma unroll
        for (int d = 0; d < 2; ++d) { const int sg = ch < 4 ? (d ? 3 - ch : ch) : 4 + (d ? 63 - (ch - 4) : ch - 4);
            const unsigned char* g = GSTb + ((size_t)(bh * 2 + d) * 68 + sg) * 16384;
#pragma unroll
            for (int rep = 0; rep < 4; ++rep) { const int idx = t2 + 256 * rep; *(LAS u32x4*)(Fr + d * 16384 + idx * 16) = *(const u32x4*)(g + (size_t)idx * 16); } }
        if (t2 < 128) gT[t2] = GCS[(size_t)uu * 128 + t2];
        __syncthreads();
        bf16x8 qf[2], qr[2];
#pragma unroll
        for (int ks = 0; ks < 2; ++ks) { qf[ks] = *(const LAS bf16x8*)(Qs + (16 * ti + c) * 72 + 32 * ks + 8 * q);
            const u32x2 lo = *(const LAS u32x2*)(Qs + (16 * ti + c) * 72 + 32 * ks + 4 * q), hi = *(const LAS u32x2*)(Qs + (16 * ti + c) * 72 + 32 * ks + 16 + 4 * q);
            qr[ks] = __builtin_bit_cast(bf16x8, ((u32x4){lo.x, lo.y, hi.x, hi.y})); }
        const int i = 16 * ti + c;
        const float gi0 = gT[i], gi1 = gT[64 + i];
        f32x4 sacc[4];
#pragma unroll
        for (int tj = 0; tj < 4; ++tj) { f32x4 acc = (f32x4){0.f, 0.f, 0.f, 0.f};
#pragma unroll
            for (int ks = 0; ks < 2; ++ks) acc = mfma16(*(const LAS bf16x8*)(Ks + (16 * tj + c) * 72 + 32 * ks + 8 * q), qf[ks], acc);
            sacc[tj] = acc; }
        bf16x8 pb[2][2];
#pragma unroll
        for (int d = 0; d < 2; ++d) { f32x4 p[4];
#pragma unroll
            for (int tj = 0; tj < 4; ++tj) { const f32x4 gj = *(const LAS f32x4*)(gT + d * 64 + 16 * tj + 4 * q);
#pragma unroll
                for (int r = 0; r < 4; ++r) { const int j = 16 * tj + 4 * q + r; const bool ok = d ? (j >= i) : (j <= i);
                    p[tj][r] = ok ? sacc[tj][r] * fexp(fminf((d ? gi1 : gi0) - gj[r], 0.f)) : 0.f; } }
#pragma unroll
            for (int ks2 = 0; ks2 < 2; ++ks2) { u32x4 t; t.x = cvtpk(p[2 * ks2][0], p[2 * ks2][1]); t.y = cvtpk(p[2 * ks2][2], p[2 * ks2][3]); t.z = cvtpk(p[2 * ks2 + 1][0], p[2 * ks2 + 1][1]); t.w = cvtpk(p[2 * ks2 + 1][2], p[2 * ks2 + 1][3]); pb[d][ks2] = __builtin_bit_cast(bf16x8, t); } }
        const float sc0 = fexp(gi0), sc1 = fexp(gi1);
        f32x4 o[4]; float ssq = 0.f;
#pragma unroll
        for (int te = 0; te < 4; ++te) { f32x4 acc = (f32x4){0.f, 0.f, 0.f, 0.f}, t0 = acc, t1 = acc;
#pragma unroll
            for (int ks = 0; ks < 2; ++ks) {
                acc = mfma16(*(const LAS bf16x8*)(Fr + 8192 + ((te * 2 + ks) * 64 + lane) * 16), pb[0][ks], acc);
                acc = mfma16(*(const LAS bf16x8*)(Fr + 16384 + 8192 + ((te * 2 + ks) * 64 + lane) * 16), pb[1][ks], acc);
                t0 = mfma16(*(const LAS bf16x8*)(Fr + ((te * 2 + ks) * 64 + lane) * 16), qr[ks], t0);
                t1 = mfma16(*(const LAS bf16x8*)(Fr + 16384 + ((te * 2 + ks) * 64 + lane) * 16), qr[ks], t1); }
            o[te] = acc + sc0 * t0 + sc1 * t1; ssq += (o[te][0] * o[te][0] + o[te][1] * o[te][1]) + (o[te][2] * o[te][2] + o[te][3] * o[te][3]); }
        ssq = quad_rows_sum(ssq);
        const float rs = 1.0f / sqrtf(ssq * (1.0f / 64.0f) + EPS);
#pragma unroll
        for (int te = 0; te < 4; ++te) { const int e0 = 16 * te + 4 * q;
            const u32x2 z2 = *(const u32x2*)(P + (size_t)(m0 + i) * NP + PC_GZ + hh * 64 + e0); const f32x4 gn = *(const f32x4*)(in.gdn_norm_g + layer * 64 + e0);
            const float z0 = __uint_as_float(z2.x << 16), z1 = __uint_as_float(z2.x & 0xffff0000u), z2f = __uint_as_float(z2.y << 16), z3 = __uint_as_float(z2.y & 0xffff0000u);
            u32x2 wv; wv.x = cvtpk(o[te][0] * rs * gn[0] * siluf(z0), o[te][1] * rs * gn[1] * siluf(z1)); wv.y = cvtpk(o[te][2] * rs * gn[2] * siluf(z2f), o[te][3] * rs * gn[3] * siluf(z3));
            *(u32x2*)(O + (size_t)(m0 + i) * D + 256 + hh * 64 + e0) = wv; }
    }
}

__device__ __forceinline__ void phase_ret_kv(Frame& F, const Inputs& in, int layer) {
    const bf16* P = (const bf16*)(F.ws + WS_R1 + R1_P);
    const bf16* RK = (const bf16*)(F.ws + WS_R1 + R1_PREP + PREP_RK);
    LAS bf16* Kt = (LAS bf16*)F.lds; LAS bf16* Vw = Kt + 64 * 72;
    const int lane = F.lane, c = lane & 15, q = lane >> 4, w = F.wave, tid = F.tid;
    const float LOG2E = 1.4426950408889634f;
    for (int uu = F.bid; uu < 16 * 68; uu += F.G) {
        const int bh = uu / 68, ch = uu % 68, b = bh >> 2, hh = bh & 3;
        const int m0 = ch < 4 ? b * TC + 64 * ch : MC + b * TL + 64 * (ch - 4);
        const float l0 = -fexp(in.ret_decay[layer * 8 + hh]) * LOG2E, l1 = -fexp(in.ret_decay[layer * 8 + 4 + hh]) * LOG2E;
        __syncthreads();
        { const int j = tid >> 3, col8 = (tid & 7) * 8;
          const u32x4 k8 = *(const u32x4*)(RK + (size_t)(m0 + j) * 256 + hh * 64 + col8), v8 = *(const u32x4*)(P + (size_t)(m0 + j) * NP + PC_RV + hh * 64 + col8);
          const float w0 = fexp2((float)(63 - j) * l0), w1 = fexp2((float)j * l1);
#pragma unroll
          for (int x = 0; x < 8; ++x) { const unsigned kk = (k8[x >> 1] >> (16 * (x & 1))) & 0xffffu; const float vv = __uint_as_float(((v8[x >> 1] >> (16 * (x & 1))) & 0xffffu) << 16);
              Kt[(col8 + x) * 72 + j] = (bf16)kk; Vw[(col8 + x) * 72 + j] = (bf16)f2bf(vv * w0); Vw[4608 + (col8 + x) * 72 + j] = (bf16)f2bf(vv * w1); } }
        __syncthreads();
        { const int d = w >> 2, td = w & 3;
          bf16x8 a[2];
#pragma unroll
          for (int ks = 0; ks < 2; ++ks) a[ks] = *(const LAS bf16x8*)(Kt + (16 * td + c) * 72 + 32 * ks + 8 * q);
          const int chain = bh * 2 + d, sg = d ? (ch < 4 ? 3 - ch : 71 - ch) : ch;
          float* dst = (float*)(F.ws + WS_RKV) + ((size_t)chain * 68 + sg) * 4096;
#pragma unroll
          for (int te = 0; te < 4; ++te) { f32x4 acc = (f32x4){0.f, 0.f, 0.f, 0.f};
#pragma unroll
              for (int ks = 0; ks < 2; ++ks) acc = mfma16(a[ks], *(const LAS bf16x8*)(Vw + d * 4608 + (16 * te + c) * 72 + 32 * ks + 8 * q), acc);
              *(f32x4*)(dst + (16 * te + c) * 64 + 16 * td + 4 * q) = acc; } }
    }
}
__device__ __forceinline__ void phase_ret_state(Frame& F, const Inputs& in, int layer, int nwg) {
    if (F.bid >= nwg) return;
    const float* RKV = (const float*)(F.ws + WS_RKV); bf16* RST = (bf16*)(F.ws + WS_RST);
    for (int el = F.bid * NTHR + F.tid; el < 32 * 4096; el += nwg * NTHR) {
        const int chain = el >> 12, idx = el & 4095, hh = (chain >> 1) & 3, d = chain & 1;
        const float G64 = fexp(-64.0f * fexp(in.ret_decay[layer * 8 + d * 4 + hh]));
        const float* kv = RKV + (size_t)chain * 68 * 4096 + idx; bf16* st = RST + (size_t)chain * 68 * 4096 + idx;
        float S = 0.f;
#pragma unroll
        for (int h2 = 0; h2 < 2; ++h2) { float kvv[34];
#pragma unroll
            for (int sg = 0; sg < 34; ++sg) kvv[sg] = kv[(size_t)(34 * h2 + sg) * 4096];
#pragma unroll
            for (int sg = 0; sg < 34; ++sg) { st[(size_t)(34 * h2 + sg) * 4096] = (bf16)f2bf(S); S = G64 * S + kvv[sg]; } }
    }
}
__device__ __forceinline__ void phase_ret_out(Frame& F, const Inputs& in, int layer) {
    const bf16* P = (const bf16*)(F.ws + WS_R1 + R1_P);
    const bf16* RQ = (const bf16*)(F.ws + WS_R1 + R1_PREP + PREP_RQ); const bf16* RK = (const bf16*)(F.ws + WS_R1 + R1_PREP + PREP_RK);
    const bf16* RST = (const bf16*)(F.ws + WS_RST);
    bf16* O = (bf16*)(F.ws + WS_R1 + R1_O);
    const int lane = F.lane, c = lane & 15, q = lane >> 4, w = F.wave, half = w >> 2, ti = w & 3, t2 = F.tid & 255;
    LAS bf16* Qs = (LAS bf16*)(F.lds + half * 46080); LAS bf16* Ks = Qs + 4608; LAS bf16* Vt = Ks + 4608; LAS bf16* St = Vt + 4608;
    const float LOG2E = 1.4426950408889634f;
    for (int pp = F.bid; pp < 8 * 68; pp += F.G) {
        const int uu = 2 * pp + half, bh = uu / 68, ch = uu % 68, b = bh >> 2, hh = bh & 3;
        const int m0 = ch < 4 ? b * TC + 64 * ch : MC + b * TL + 64 * (ch - 4);
        const float l0 = -fexp(in.ret_decay[layer * 8 + hh]) * LOG2E, l1 = -fexp(in.ret_decay[layer * 8 + 4 + hh]) * LOG2E;
        __syncthreads();
#pragma unroll
        for (int rep = 0; rep < 2; ++rep) { const int idx = t2 + 256 * rep, row = idx >> 3, col8 = (idx & 7) * 8;
            *(LAS u32x4*)(Qs + row * 72 + col8) = *(const u32x4*)(RQ + (size_t)(m0 + row) * 256 + hh * 64 + col8);
            *(LAS u32x4*)(Ks + row * 72 + col8) = *(const u32x4*)(RK + (size_t)(m0 + row) * 256 + hh * 64 + col8);
            const u32x4 v8 = *(const u32x4*)(P + (size_t)(m0 + row) * NP + PC_RV + hh * 64 + col8);
#pragma unroll
            for (int x = 0; x < 8; ++x) Vt[(col8 + x) * 72 + row] = (bf16)(v8[x >> 1] >> (16 * (x & 1)));
#pragma unroll
            for (int d = 0; d < 2; ++d) { const int sg = d ? (ch < 4 ? 3 - ch : 71 - ch) : ch;
                *(LAS u32x4*)(St + d * 4608 + row * 72 + col8) = *(const u32x4*)(RST + ((size_t)(bh * 2 + d) * 68 + sg) * 4096 + row * 64 + col8); } }
        __syncthreads();
        bf16x8 qf[2];
#pragma unroll
        for (int ks = 0; ks < 2; ++ks) qf[ks] = *(const LAS bf16x8*)(Qs + (16 * ti + c) * 72 + 32 * ks + 8 * q);
        const int i = 16 * ti + c;
        f32x4 p[4];
#pragma unroll
        for (int tj = 0; tj < 4; ++tj) { f32x4 acc = (f32x4){0.f, 0.f, 0.f, 0.f};
#pragma unroll
            for (int ks = 0; ks < 2; ++ks) acc = mfma16(*(const LAS bf16x8*)(Ks + (16 * tj + c) * 72 + 32 * ks + 8 * q), qf[ks], acc);
#pragma unroll
            for (int r = 0; r < 4; ++r) { const int dlt = i - (16 * tj + 4 * q + r);
                const float wgt = (dlt >= 0 ? fexp2((float)dlt * l0) : 0.f) + (dlt <= 0 ? fexp2((float)(-dlt) * l1) : 0.f);
                acc[r] *= wgt; }
            p[tj] = acc; }
        bf16x8 pb[2];
#pragma unroll
        for (int ks2 = 0; ks2 < 2; ++ks2) { u32x4 t; t.x = cvtpk(p[2 * ks2][0], p[2 * ks2][1]); t.y = cvtpk(p[2 * ks2][2], p[2 * ks2][3]); t.z = cvtpk(p[2 * ks2 + 1][0], p[2 * ks2 + 1][1]); t.w = cvtpk(p[2 * ks2 + 1][2], p[2 * ks2 + 1][3]); pb[ks2] = __builtin_bit_cast(bf16x8, t); }
        const float sc0 = fexp2((float)(i + 1) * l0), sc1 = fexp2((float)(64 - i) * l1);
        f32x4 o[4]; float sum = 0.f;
#pragma unroll
        for (int te = 0; te < 4; ++te) { f32x4 acc = (f32x4){0.f, 0.f, 0.f, 0.f}, t0 = acc, t1 = acc;
#pragma unroll
            for (int ks2 = 0; ks2 < 2; ++ks2) { const u32x2 lo = *(const LAS u32x2*)(Vt + (16 * te + c) * 72 + 32 * ks2 + 4 * q), hi = *(const LAS u32x2*)(Vt + (16 * te + c) * 72 + 32 * ks2 + 16 + 4 * q);
                acc = mfma16(__builtin_bit_cast(bf16x8, ((u32x4){lo.x, lo.y, hi.x, hi.y})), pb[ks2], acc); }
#pragma unroll
            for (int ks = 0; ks < 2; ++ks) { t0 = mfma16(*(const LAS bf16x8*)(St + (16 * te + c) * 72 + 32 * ks + 8 * q), qf[ks], t0);
                t1 = mfma16(*(const LAS bf16x8*)(St + 4608 + (16 * te + c) * 72 + 32 * ks + 8 * q), qf[ks], t1); }
            o[te] = acc + sc0 * t0 + sc1 * t1; sum += (o[te][0] + o[te][1]) + (o[te][2] + o[te][3]); }
        sum = quad_rows_sum(sum);
        const float mu = sum * (1.0f / 64.0f); float vs = 0.f;
#pragma unroll
        for (int te = 0; te < 4; ++te) { o[te] = o[te] - mu; vs += (o[te][0] * o[te][0] + o[te][1] * o[te][1]) + (o[te][2] * o[te][2] + o[te][3] * o[te][3]); }
        vs = quad_rows_sum(vs);
        const float rs = 1.0f / sqrtf(vs * (1.0f / 64.0f) + EPS);
#pragma unroll
        for (int te = 0; te < 4; ++te) { const int e0 = hh * 64 + 16 * te + 4 * q;
            const u32x2 g2 = *(const u32x2*)(P + (size_t)(m0 + i) * NP + PC_RG + e0); const f32x4 gn = *(const f32x4*)(in.ret_gn_g + layer * 256 + e0);
            const float g0 = __uint_as_float(g2.x << 16), g1 = __uint_as_float(g2.x & 0xffff0000u), g2f = __uint_as_float(g2.y << 16), g3 = __uint_as_float(g2.y & 0xffff0000u);
            u32x2 wv; wv.x = cvtpk(o[te][0] * rs * gn[0] * siluf(g0), o[te][1] * rs * gn[1] * siluf(g1)); wv.y = cvtpk(o[te][2] * rs * gn[2] * siluf(g2f), o[te][3] * rs * gn[3] * siluf(g3));
            *(u32x2*)(O + (size_t)(m0 + i) * D + e0) = wv; }
    }
}

__device__ __forceinline__ void phase_finish(Frame& F, const Inputs& in, int layer) {
    const bf16* P = (const bf16*)(F.ws + WS_R1 + R1_P);
    const float* OG = (const float*)(F.ws + WS_R1 + R1_OG);
    bf16* O = (bf16*)(F.ws + WS_R1 + R1_O);
    const int lane = F.lane;
    for (int m = F.gw; m < M; m += F.NGW) {
#pragma unroll
        for (int hh = 0; hh < 4; ++hh) {
            const float o2 = OG[(size_t)m * 256 + hh * 64 + lane] + OG[(size_t)(M + m) * 256 + hh * 64 + lane];
            const float ms = wave_sum(o2 * o2) * (1.0f / 64.0f);
            const float z = bf2f(P[(size_t)m * NP + PC_GZ + hh * 64 + lane]);
            const float y2 = o2 * (1.0f / sqrtf(ms + EPS)) * in.gdn_norm_g[layer * 64 + lane] * siluf(z);
            O[(size_t)m * D + 256 + hh * 64 + lane] = (bf16)f2bf(y2);
        }
    }
}

__device__ __forceinline__ void phase_route(Frame& F, int m_lo) {
    if (F.bid != 0) return;
    const int* TKE = (const int*)(F.ws + WS_TKE);
    int* TOKROW = (int*)(F.ws + WS_TOKROW); int* ROWTOK = (int*)(F.ws + WS_ROWTOK); int* TILEE = (int*)(F.ws + WS_TILEE);
    LAS int* cnt = (LAS int*)F.lds;
    LAS int* tot = cnt + 512 * 8;
    const int ntok = M - m_lo, per = (ntok + NTHR - 1) / NTHR;
    const int a0 = m_lo + F.tid * per, a1 = (a0 + per < M) ? a0 + per : M;
    int c[8];
#pragma unroll
    for (int e = 0; e < 8; ++e) c[e] = 0;
    for (int m = a0; m < a1; ++m) { const int e0 = TKE[2 * m], e1 = TKE[2 * m + 1];
#pragma unroll
        for (int e = 0; e < 8; ++e) c[e] += (e0 == e) + (e1 == e); }
#pragma unroll
    for (int e = 0; e < 8; ++e) cnt[F.tid * 8 + e] = c[e];
    __syncthreads();
    if (F.tid < 8) { int run = 0; for (int i = 0; i < NTHR; ++i) { const int v = cnt[i * 8 + F.tid]; cnt[i * 8 + F.tid] = run; run += v; } tot[F.tid] = run; }
    __syncthreads();
    if (F.tid == 0) { int st = 0; for (int e = 0; e < 8; ++e) { tot[8 + e] = st; const int pad = (tot[e] + 255) / 256 * 256;
            for (int tl = st / 256; tl < (st + pad) / 256; ++tl) TILEE[tl] = e; st += pad; }
        TILEE[256] = st / 256; }
    __syncthreads();
    int pos[8];
#pragma unroll
    for (int e = 0; e < 8; ++e) pos[e] = tot[8 + e] + cnt[F.tid * 8 + e];
    for (int m = a0; m < a1; ++m) {
#pragma unroll
        for (int k = 0; k < 2; ++k) { const int ee = TKE[2 * m + k]; int row = 0;
#pragma unroll
            for (int e = 0; e < 8; ++e) if (ee == e) { row = pos[e]; pos[e] = row + 1; }
            ROWTOK[row] = m; TOKROW[2 * m + k] = row; } }
    for (int e = 0; e < 8; ++e) { const int st = tot[8 + e] + tot[e], en = tot[8 + e] + (tot[e] + 255) / 256 * 256; for (int r = st + F.tid; r < en; r += NTHR) ROWTOK[r] = -1; }
}
__device__ __forceinline__ void phase_permute(Frame& F) {
    const int* ROWTOK = (const int*)(F.ws + WS_ROWTOK); const int nrows = ((const int*)(F.ws + WS_TILEE))[256] * 256;
    const bf16* H = (const bf16*)(F.ws + WS_H); bf16* HP = (bf16*)(F.ws + WS_HP);
    for (int r = F.gw; r < nrows; r += F.NGW) { const int tok = ROWTOK[r];
#pragma unroll
        for (int j = 0; j < 2; ++j) { u32x4 v = (u32x4){0u, 0u, 0u, 0u}; if (tok >= 0) v = *(const u32x4*)(H + (size_t)tok * D + 8 * F.lane + 512 * j); *(u32x4*)(HP + (size_t)r * D + 8 * F.lane + 512 * j) = v; } }
}


__device__ __forceinline__ void phase_permute2(Frame& F, int route_lo) {
    const int* TKE = (const int*)(F.ws + WS_TKE); int* TOKROW = (int*)(F.ws + WS_TOKROW); int* TILEE = (int*)(F.ws + WS_TILEE);
    const int* WGCNT = (const int*)(F.ws + WS_TILEE + 4096);
    const bf16* H = (const bf16*)(F.ws + WS_H); bf16* HP = (bf16*)(F.ws + WS_HP);
    LAS int* base = (LAS int*)F.lds;
    LAS int* tot = base + 256 * 8;
    __syncthreads();
    if (F.tid < 8) { int run = 0; for (int g = 0; g < F.G; ++g) { base[g * 8 + F.tid] = run; run += WGCNT[g * 8 + F.tid]; } tot[F.tid] = run; }
    __syncthreads();
    if (F.tid == 0) { int st = 0; for (int e = 0; e < 8; ++e) { tot[8 + e] = st; const int pad = (tot[e] + 255) / 256 * 256;
            if (F.bid == 0) for (int tl = st / 256; tl < (st + pad) / 256; ++tl) TILEE[tl] = e;
            st += pad; }
        if (F.bid == 0) TILEE[256] = st / 256; }
    __syncthreads();
    const int lane = F.lane;
    for (int m = route_lo + F.gw; m < M; m += F.NGW) {
        const int gwm = m < MC ? m : (int)((((long)(m - MC + 1)) * F.NGW - 1) / ML), wg = gwm >> 3;
        const int e0 = TKE[2 * m], e1 = TKE[2 * m + 1];
        const int r0 = tot[8 + e0] + base[wg * 8 + e0] + TOKROW[2 * m], r1 = tot[8 + e1] + base[wg * 8 + e1] + TOKROW[2 * m + 1];
        const u32x4 a = *(const u32x4*)(H + (size_t)m * D + 8 * lane), b = *(const u32x4*)(H + (size_t)m * D + 512 + 8 * lane);
        *(u32x4*)(HP + (size_t)r0 * D + 8 * lane) = a; *(u32x4*)(HP + (size_t)r0 * D + 512 + 8 * lane) = b;
        *(u32x4*)(HP + (size_t)r1 * D + 8 * lane) = a; *(u32x4*)(HP + (size_t)r1 * D + 512 + 8 * lane) = b;
        asm volatile("" ::: "memory");
        if (lane == 0) { TOKROW[2 * m] = r0; TOKROW[2 * m + 1] = r1; }
    }
    for (int e = 0; e < 8; ++e) { const int st = tot[8 + e] + tot[e], en = tot[8 + e] + (tot[e] + 255) / 256 * 256;
        for (int r = st + F.gw; r < en; r += F.NGW) { *(u32x4*)(HP + (size_t)r * D + 8 * lane) = (u32x4){0u, 0u, 0u, 0u}; *(u32x4*)(HP + (size_t)r * D + 512 + 8 * lane) = (u32x4){0u, 0u, 0u, 0u}; } }
}

constexpr int NPH = 12;
constexpr int PH_TOTAL = 1 + DEPTH * NPH + 1;
__host__ __device__ inline bool phase_exists(int ph) {
    if (ph == 0 || ph == PH_TOTAL - 1) return true;
    const int layer = (ph - 1) / NPH, j = (ph - 1) % NPH;
    if (!(layer & 1) && j >= 10) return false;
    if ((layer & 1) && j >= 11) return false;
    return true;
}
__global__ void __launch_bounds__(NTHR, 2) fwd_kernel(Args args) {
    extern __shared__ __attribute__((aligned(16))) unsigned char lds_raw[];
    Frame F;
    F.lds = (LAS unsigned char*)lds_raw;
    F.tid = threadIdx.x; F.lane = F.tid & 63; F.wave = __builtin_amdgcn_readfirstlane(F.tid >> 6);
    F.G = gridDim.x; F.bid = blockIdx.x; F.gw = blockIdx.x * NWAVES + F.wave; F.NGW = F.G * NWAVES; F.ws = args.ws;
    volatile LAS unsigned* MISC = (volatile LAS unsigned*)(F.lds + MISC_OFF);
    LAS unsigned long long* ptab = (LAS unsigned long long*)(F.lds + MISC_OFF + 128);
    if (F.tid < 32) MISC[F.tid] = 0u;
    if (PROBE_ON && F.tid == 65) { ((volatile LAS unsigned long long*)(F.lds + 132096))[0] = 0ull; ((volatile LAS unsigned long long*)(F.lds + 132096))[1] = 0ull; }
    if (F.tid == 64) { const Inputs& ai = args.in;
        ptab[0] = (unsigned long long)ai.x; ptab[1] = (unsigned long long)ai.c; ptab[2] = (unsigned long long)ai.ctx; ptab[3] = (unsigned long long)ai.c_ctx; ptab[4] = (unsigned long long)ai.ada_w; ptab[5] = (unsigned long long)ai.ada_b;
        ptab[6] = (unsigned long long)ai.norm1_g; ptab[7] = (unsigned long long)ai.w_in; ptab[8] = (unsigned long long)ai.ret_decay; ptab[9] = (unsigned long long)ai.ret_gn_g; ptab[10] = (unsigned long long)ai.gdn_conv_w; ptab[11] = (unsigned long long)ai.gdn_a_log;
        ptab[12] = (unsigned long long)ai.gdn_dt_bias; ptab[13] = (unsigned long long)ai.gdn_norm_g; ptab[14] = (unsigned long long)ai.swa_sink; ptab[15] = (unsigned long long)ai.w_out; ptab[16] = (unsigned long long)ai.norm2_g; ptab[17] = (unsigned long long)ai.ffn_w1;
        ptab[18] = (unsigned long long)ai.ffn_w3; ptab[19] = (unsigned long long)ai.ffn_w2; ptab[20] = (unsigned long long)ai.router_w; ptab[21] = (unsigned long long)ai.moe_w1; ptab[22] = (unsigned long long)ai.moe_w3; ptab[23] = (unsigned long long)ai.moe_w2; ptab[24] = (unsigned long long)ai.final_g; }
    __syncthreads();
    XcdBarrier bar; bar.bar = (unsigned*)(F.ws + WS_CTL) + CW_BAR; bar.x = 0; bar.st = nullptr;
    const int lo = args.ph_lo, hi = args.ph_hi;
    const bool multi = (hi - lo) > 1;
    if (multi) bar = xcd_barrier_post((unsigned*)(F.ws + WS_CTL) + CW_BAR, MISC + 8);
#define LAUNDER() GAS unsigned char* _w = (GAS unsigned char*)args.ws; asm volatile("" : "+s"(_w)); F.ws = (unsigned char*)_w; asm volatile("" ::: "memory"); { int _t = threadIdx.x; asm volatile("" : "+v"(_t)); int _b = blockIdx.x; asm volatile("" : "+s"(_b)); F.tid = _t; F.lane = _t & 63; F.wave = __builtin_amdgcn_readfirstlane(_t >> 6); F.bid = _b; F.gw = _b * NWAVES + F.wave; } const Inputs in = load_inputs(ptab)
#define RELAUNDER() do { GAS unsigned char* _w2 = (GAS unsigned char*)args.ws; asm volatile("" : "+s"(_w2)); F.ws = (unsigned char*)_w2; int _t = threadIdx.x; asm volatile("" : "+v"(_t)); int _b = blockIdx.x; asm volatile("" : "+s"(_b)); F.tid = _t; F.lane = _t & 63; F.wave = __builtin_amdgcn_readfirstlane(_t >> 6); F.bid = _b; F.gw = _b * NWAVES + F.wave; asm volatile("" ::: "memory"); } while (0)
#define IN(k) (lo <= (k) && (k) < hi)
#define STAMP(k) do { if (PROBE_ON && !(PROBE_CUSTOM) && blockIdx.x == 0 && threadIdx.x == 0) { volatile LAS unsigned long long* _st = (volatile LAS unsigned long long*)(F.lds + 132096); const unsigned long long _now = __builtin_amdgcn_s_memrealtime(), _prev = _st[0]; _st[0] = _now; \
    const int _ph = (k) - 1; bool _sel = false; if (_ph == 0) _sel = (PROBE_PRO) != 0; else if (_ph > 0) { const int _l = (_ph - 1) / NPH, _j = (_ph - 1) % NPH; _sel = (((PROBE_LMASK) >> _l) & 1u) && (((PROBE_JMASK) >> _j) & 1u); } if (_sel) _st[1] = _st[1] + (_now - _prev); } } while (0)
#define SEAM(k) do { if (IN(k) && IN((k) + 1)) { xcd_barrier(bar); STAMP((k) + 1); } } while (0)
    LAS unsigned char* ring = F.lds;

    STAMP(0);
    if (IN(0)) { LAUNDER(); phase_prologue(F, in); } SEAM(0);

#define LAYER_BODY(layer) { \
        const int p0 = 1 + layer * NPH; \
        const bool moe = layer & 1; \
        if (IN(p0 + 0)) { LAUNDER(); phase_token2<0>(F, in, layer, layer == 0, layer > 0 && ((layer - 1) & 1), false, nullptr, 0, (layer > 0 && !((layer - 1) & 1)) ? 11 : 0); if (layer == 2) { __syncthreads(); convert_moe_layer(F, in, 1); } } \
        SEAM(p0 + 0); \
        if (IN(p0 + 1)) { LAUNDER(); pg8::StaticOrder S; S.init(F.ws + WS_H, (bf16*)(F.ws + WS_WIN) + (size_t)layer * NP * D, M, NP, D, F.G, F.bid); \
            pg8::EpiBf16 E{(bf16*)(F.ws + WS_R1 + R1_P), NP}; pg8::gemm_phase<D, D, pg8::EpiBf16, pg8::StaticOrder>(ring, S, E, F.tid); } \
        SEAM(p0 + 1); \
        if (IN(p0 + 2)) { LAUNDER(); phase_prep2(F, in, layer); } \
        SEAM(p0 + 2); \
        if (IN(p0 + 3)) { LAUNDER(); PB(4); phase_gdn_local2(F); PE(4); RELAUNDER(); PB(5); phase_ret_kv(F, in, layer); PE(5); } \
        SEAM(p0 + 3); \
        if (IN(p0 + 4)) { LAUNDER(); PB(1); phase_gdn_scan3(F, F.G - 32); PE(1); RELAUNDER(); PB(2); phase_ret_state(F, in, layer, F.G - 32); PE(2); RELAUNDER(); PB(3); phase_swa2(F, in, layer, F.G - 32); PE(3); } \
        SEAM(p0 + 4); \
        if (IN(p0 + 5)) { LAUNDER(); PB(6); phase_ret_out(F, in, layer); PE(6); RELAUNDER(); PB(7); phase_gdn_out2(F, in, layer); PE(7); } \
        SEAM(p0 + 5); \
        if (IN(p0 + 6)) { LAUNDER(); \
            { pg8::StaticOrder S; S.init(F.ws + WS_R1 + R1_O, (bf16*)(F.ws + WS_WOUT) + (size_t)layer * D * D, ML, D, D, F.G, F.bid, 4); \
              pg8::EpiResid E{(float*)(F.ws + WS_XS), (const float*)(F.ws + WS_MOD) + (size_t)layer * 5 * 6 * D, 2}; pg8::gemm_phase<D, D, pg8::EpiResid, pg8::StaticOrder>(ring, S, E, F.tid); } \
            if (layer < DEPTH - 1) { RELAUNDER(); \
              pg8::SplitOrder S; S.init(F.ws + WS_R1 + R1_O, (bf16*)(F.ws + WS_WOUT) + (size_t)layer * D * D, D, 4, F.G, F.bid); \
              pg8::EpiSlab E{(float*)(F.ws + WS_R1 + 100 * MiB)}; pg8::gemm_phase<256, D, pg8::EpiSlab, pg8::SplitOrder>(ring, S, E, F.tid); } } \
        SEAM(p0 + 6); \
        if (IN(p0 + 7)) { LAUNDER(); phase_token2<1>(F, in, layer, false, false, moe, nullptr, layer == DEPTH - 1 ? MC : 0, layer < DEPTH - 1 ? 4 : 0); } \
        SEAM(p0 + 7); \
        if (!moe) { \
            if (IN(p0 + 8)) { LAUNDER(); pg8::StaticOrder S; S.init(F.ws + WS_H, (bf16*)(F.ws + WS_W13) + (size_t)(layer >> 1) * 2 * FF * D, M, 2 * FF, D, F.G, F.bid); \
                pg8::EpiSwiglu E{(bf16*)(F.ws + WS_R1 + R1_HID), FF}; pg8::gemm_phase<D, D, pg8::EpiSwiglu, pg8::StaticOrder>(ring, S, E, F.tid); } \
            SEAM(p0 + 8); \
            if (IN(p0 + 9)) { LAUNDER(); \
                { pg8::StaticOrder S; S.init(F.ws + WS_R1 + R1_HID, (bf16*)(F.ws + WS_W2) + (size_t)(layer >> 1) * D * FF, ML, D, FF, F.G, F.bid, 4); \
                  pg8::EpiResid E{(float*)(F.ws + WS_XS), (const float*)(F.ws + WS_MOD) + (size_t)layer * 5 * 6 * D, 5}; pg8::gemm_phase<FF, FF, pg8::EpiResid, pg8::StaticOrder>(ring, S, E, F.tid); } \
                { RELAUNDER(); \
                  pg8::SplitOrder S; S.init(F.ws + WS_R1 + R1_HID, (bf16*)(F.ws + WS_W2) + (size_t)(layer >> 1) * D * FF, FF, 11, F.G, F.bid); \
                  pg8::EpiSlab E{(float*)(F.ws + WS_R1 + 100 * MiB)}; pg8::gemm_phase<256, FF, pg8::EpiSlab, pg8::SplitOrder>(ring, S, E, F.tid); } } \
            if (IN(p0 + 9) && IN(p0 + NPH)) { xcd_barrier(bar); STAMP(p0 + 10); } \
        } else { \
            if (IN(p0 + 8)) { LAUNDER(); phase_permute2(F, layer == DEPTH - 1 ? MC : 0); } \
            SEAM(p0 + 8); \
            if (IN(p0 + 9)) { LAUNDER(); const int* tile_e = (const int*)(F.ws + WS_TILEE); const int ntiles = __builtin_amdgcn_readfirstlane(tile_e[256]); \
                pg8::GroupedOrder S; S.init(F.ws + WS_HP, F.ws + WS_MW13, ntiles, 2 * EF, D, F.G, F.bid, tile_e); \
                pg8::EpiSwiglu E{(bf16*)(F.ws + WS_R1 + R1_HID), EF}; pg8::gemm_phase<D, D, pg8::EpiSwiglu, pg8::GroupedOrder>(ring, S, E, F.tid); } \
            SEAM(p0 + 9); \
            if (IN(p0 + 10)) { LAUNDER(); const int* tile_e = (const int*)(F.ws + WS_TILEE); const int ntiles = __builtin_amdgcn_readfirstlane(tile_e[256]); \
                const int tmain = (ntiles - (ntiles / 64) * 64 <= 16) ? (ntiles / 64) * 64 : ntiles; \
                { pg8::GroupedOrder S; S.init(F.ws + WS_R1 + R1_HID, F.ws + WS_MW2, tmain, D, EF, F.G, F.bid, tile_e); \
                  pg8::EpiF32 E{(float*)(F.ws + WS_YM), D}; pg8::gemm_phase<EF, EF, pg8::EpiF32, pg8::GroupedOrder>(ring, S, E, F.tid); } \
                if (ntiles > tmain) { RELAUNDER(); const int* tile_e2 = (const int*)(F.ws + WS_TILEE); \
                  pg8::SplitGroupedOrder S; S.init(F.ws + WS_R1 + R1_HID, F.ws + WS_MW2, tmain, ntiles - tmain, F.G, F.bid, tile_e2); \
                  pg8::EpiYMSlab E{(float*)(F.ws + WS_YM), (float*)(F.ws + WS_HP), tmain * 256}; pg8::gemm_phase<896, EF, pg8::EpiYMSlab, pg8::SplitGroupedOrder>(ring, S, E, F.tid); } } \
            if (IN(p0 + 10) && IN(p0 + NPH)) { xcd_barrier(bar); STAMP(p0 + 11); } \
        } \
    }
    LAYER_BODY(0) LAYER_BODY(1) LAYER_BODY(2) LAYER_BODY(3)
#undef LAYER_BODY
    if (IN(PH_TOTAL - 1)) { LAUNDER(); phase_token2<2>(F, in, DEPTH, false, true, false, args.out); }
    if (PROBE_ON && (int)blockIdx.x == ((PROBE_CUSTOM) ? (PROBE_BLOCK < 0 ? (int)gridDim.x + (PROBE_BLOCK) : (PROBE_BLOCK)) : 0) && threadIdx.x == 0) {
        STAMP(PH_TOTAL);
        const unsigned long long T = ((volatile LAS unsigned long long*)(F.lds + 132096))[1];
        const unsigned long long t0 = __builtin_amdgcn_s_memrealtime();
        while (__builtin_amdgcn_s_memrealtime() - t0 < 8ull * T) __builtin_amdgcn_s_sleep(8);
    }
#undef IN
#undef SEAM
}

extern "C" void kernel_launch(void* const* d_in, const int* in_sizes, int n_in, void* d_out, int out_size, void* d_ws, size_t ws_size, hipStream_t stream) {
    static int grid = 0;
    if (grid == 0) {
        if (n_in != 25 || out_size != ML * D || ws_size < WS_END) { fprintf(stderr, "kernel_launch: unexpected problem: n_in %d out %d ws %zu (need %zu)\n", n_in, out_size, ws_size, (size_t)WS_END); grid = -1; return; }
        int dev = 0, cus = 0, per_cu = 0;
        if (hipGetDevice(&dev) != hipSuccess || hipDeviceGetAttribute(&cus, hipDeviceAttributeMultiprocessorCount, dev) != hipSuccess) { grid = -1; return; }
        if (hipFuncSetAttribute((const void*)fwd_kernel, hipFuncAttributeMaxDynamicSharedMemorySize, LDS_BYTES) != hipSuccess) { fprintf(stderr, "kernel_launch: hipFuncSetAttribute failed\n"); grid = -1; return; }
        if (hipOccupancyMaxActiveBlocksPerMultiprocessor(&per_cu, (const void*)fwd_kernel, NTHR, LDS_BYTES) != hipSuccess || per_cu < 1) fprintf(stderr, "kernel_launch: occupancy query reports %d\n", per_cu);
        (void)hipGetLastError();
        grid = cus;
    }
    if (grid < 0) return;
    (void)hipMemsetAsync((char*)d_ws + WS_CTL, 0, CTL_ZERO_BYTES, stream);
    Args a{};
    const float** ip = (const float**)&a.in;
    for (int i = 0; i < 25; ++i) ip[i] = (const float*)d_in[i];
    a.out = (float*)d_out; a.ws = (unsigned char*)d_ws;
#if MK_ONE_LAUNCH
    a.ph_lo = 0; a.ph_hi = PH_TOTAL;
    hipLaunchKernelGGL(fwd_kernel, dim3(grid), dim3(NTHR), LDS_BYTES, stream, a);
#else
    for (int ph = 0; ph < PH_TOTAL; ++ph) { if (!phase_exists(ph)) continue; a.ph_lo = ph; a.ph_hi = ph + 1;
        hipLaunchKernelGGL(fwd_kernel, dim3(grid), dim3(NTHR), LDS_BYTES, stream, a); }
#endif
}
```

```cpp
#include <hip/hip_runtime.h>
#include <cstdio>
#include <cstdint>

#ifndef PROBE_JMASK
#define PROBE_JMASK 0u
#endif
#ifndef PROBE_LMASK
#define PROBE_LMASK 15u
#endif
#ifndef PROBE_PRO
#define PROBE_PRO 0
#endif
#ifndef PROBE_CUSTOM
#define PROBE_CUSTOM 0
#endif
#ifndef PROBE_BLOCK
#define PROBE_BLOCK 0
#endif
#define PROBE_ON ((PROBE_JMASK) != 0u || (PROBE_PRO) != 0 || (PROBE_CUSTOM) != 0)
#define PB(id) do { if ((PROBE_CUSTOM) == (id) && (int)blockIdx.x == (PROBE_BLOCK < 0 ? (int)gridDim.x + (PROBE_BLOCK) : (PROBE_BLOCK)) && xb_leader(F.wave)) ((volatile LAS unsigned long long*)(F.lds + 132096))[2] = __builtin_amdgcn_s_memrealtime(); } while (0)
#define PE(id) do { if ((PROBE_CUSTOM) == (id) && (int)blockIdx.x == (PROBE_BLOCK < 0 ? (int)gridDim.x + (PROBE_BLOCK) : (PROBE_BLOCK)) && xb_leader(F.wave)) { volatile LAS unsigned long long* _s = (volatile LAS unsigned long long*)(F.lds + 132096); _s[1] = _s[1] + (__builtin_amdgcn_s_memrealtime() - _s[2]); } } while (0)
#define PG8_PB() do { if ((PROBE_CUSTOM) == 20 && (int)blockIdx.x == 0 && wid == 0 && lane == 0) ((volatile __attribute__((address_space(3))) unsigned long long*)(lds + 132096))[2] = __builtin_amdgcn_s_memrealtime(); } while (0)
#define PG8_PE() do { if ((PROBE_CUSTOM) == 20 && (int)blockIdx.x == 0 && wid == 0 && lane == 0) { volatile __attribute__((address_space(3))) unsigned long long* _s = (volatile __attribute__((address_space(3))) unsigned long long*)(lds + 132096); _s[1] = _s[1] + (__builtin_amdgcn_s_memrealtime() - _s[2]); } } while (0)
#ifndef MK_ONE_LAUNCH
#define MK_ONE_LAUNCH 1
#endif

#define GAS __attribute__((address_space(1)))
#define LAS __attribute__((address_space(3)))
typedef unsigned short bf16;
typedef short bf16x8 __attribute__((ext_vector_type(8)));
typedef float f32x4 __attribute__((ext_vector_type(4)));
typedef float f32x2 __attribute__((ext_vector_type(2)));
typedef unsigned u32x4 __attribute__((ext_vector_type(4)));
typedef unsigned u32x2 __attribute__((ext_vector_type(2)));

constexpr int D = 1024, NB = 4, TL = 4096, TC = 256, DEPTH = 4;
constexpr int MC = NB * TC, ML = NB * TL, M = MC + ML;
constexpr int INC = 2832, NP = 2816;
constexpr int FF = 2816, EF = 3584, NE = 8;
constexpr int MAXROWS = 36864;
constexpr float EPS = 1e-6f;
constexpr int PC_RQ = 0, PC_RK = 256, PC_RV = 512, PC_RG = 768, PC_GQKV = 1024, PC_GZ = 1792, PC_SQ = 2048, PC_SK = 2560, PC_SV = 2688;

constexpr size_t MiB = 1u << 20;
constexpr size_t WS_CTL = 0, CTL_ZERO_BYTES = 1 * MiB;
constexpr size_t WS_MOD = 1 * MiB;
constexpr size_t WS_ROPE = 2 * MiB;
constexpr size_t WS_TKE = 3 * MiB, WS_TKG = 3 * MiB + 256 * 1024, WS_TOKROW = 3 * MiB + 512 * 1024, WS_ROWTOK = 3 * MiB + 768 * 1024, WS_TILEE = 4 * MiB;
constexpr size_t WS_AB = 5 * MiB, WS_GB = 7 * MiB;
constexpr size_t WS_WIN = 16 * MiB, WS_WOUT = 38 * MiB, WS_W13 = 46 * MiB, WS_W2 = 68 * MiB, WS_MW13 = 80 * MiB, WS_MW2 = 192 * MiB;
constexpr size_t WS_XS = 248 * MiB, WS_H = 316 * MiB, WS_HP = 350 * MiB, WS_YM = 422 * MiB, WS_R1 = 566 * MiB;
constexpr size_t R1_P = 0, R1_PREP = 94 * MiB, R1_O = 158 * MiB, R1_OR = 192 * MiB, R1_OG = 226 * MiB, R1_HID = 0;
constexpr size_t WS_END = WS_R1 + 260 * MiB;
constexpr size_t WS_GCH = WS_YM, GCH_STEP = 40960, GCH_CHAIN = 68 * GCH_STEP, WS_GDEC = WS_HP;
constexpr size_t G2_STEP = 24576, G2_CHAIN = 68 * G2_STEP;
constexpr size_t WS_GST = WS_YM + 56 * MiB;
constexpr size_t WS_GCS = WS_HP + 64 * 1024;
static_assert(32 * G2_CHAIN <= 56 * MiB && 32 * 68 * 16384 <= 40 * MiB, "gdn v2 buffers");
constexpr size_t WS_RKV = WS_YM + 96 * MiB;
constexpr size_t WS_RST = WS_HP + 1 * MiB;
static_assert(32 * GCH_CHAIN <= 144 * MiB, "gdn chunk data");
constexpr size_t PREP_RQ = 0, PREP_RK = (size_t)M * 256 * 2, PREP_SQ = (size_t)M * 512 * 2, PREP_SK = (size_t)M * 1024 * 2, PREP_GD = (size_t)M * 1152 * 2;
static_assert(PREP_GD + (size_t)M * 768 * 2 <= 64 * MiB, "prep");
static_assert((size_t)M * NP * 2 <= 94 * MiB && (size_t)MAXROWS * EF * 2 <= 260 * MiB, "r1");

constexpr int CW_TMO = 0, CW_BAR = 4096;

__device__ __forceinline__ float bf2f(bf16 v) { return __uint_as_float(((unsigned)v) << 16); }
__device__ __forceinline__ unsigned f2bf(float f) { unsigned u = __float_as_uint(f); return (u + 0x7fffu + ((u >> 16) & 1u)) >> 16; }
__device__ __forceinline__ unsigned pk2(float lo, float hi) { return f2bf(lo) | (f2bf(hi) << 16); }
template <int CTRL> __device__ __forceinline__ float dppf(float v) { return __int_as_float(__builtin_amdgcn_update_dpp(0, __float_as_int(v), CTRL, 0xF, 0xF, true)); }
__device__ __forceinline__ float row_sum16(float v) {
    v += dppf<0xB1>(v); v += dppf<0x4E>(v); v += dppf<0x141>(v); v += dppf<0x140>(v); return v; }
__device__ __forceinline__ float wave_sum(float v) {
    v = row_sum16(v);
    return __int_as_float(__builtin_amdgcn_readlane(__float_as_int(v), 0)) + __int_as_float(__builtin_amdgcn_readlane(__float_as_int(v), 16))
         + __int_as_float(__builtin_amdgcn_readlane(__float_as_int(v), 32)) + __int_as_float(__builtin_amdgcn_readlane(__float_as_int(v), 48)); }
__device__ __forceinline__ float quad_rows_sum(float v) {
    u32x2 r = __builtin_amdgcn_permlane16_swap(__float_as_uint(v), __float_as_uint(v), false, false); v = __uint_as_float(r.x) + __uint_as_float(r.y);
    r = __builtin_amdgcn_permlane32_swap(__float_as_uint(v), __float_as_uint(v), false, false); return __uint_as_float(r.x) + __uint_as_float(r.y); }
__device__ __forceinline__ float quad_rows_max(float v) {
    u32x2 r = __builtin_amdgcn_permlane16_swap(__float_as_uint(v), __float_as_uint(v), false, false); v = fmaxf(__uint_as_float(r.x), __uint_as_float(r.y));
    r = __builtin_amdgcn_permlane32_swap(__float_as_uint(v), __float_as_uint(v), false, false); return fmaxf(__uint_as_float(r.x), __uint_as_float(r.y)); }
__device__ __forceinline__ float fexp2(float x) { return __builtin_amdgcn_exp2f(x); }
__device__ __forceinline__ float fexp(float x) { return __builtin_amdgcn_exp2f(x * 1.4426950408889634f); }
__device__ __forceinline__ float siluf(float x) { return x * __builtin_amdgcn_rcpf(1.0f + fexp(-x)); }
#define LDS_WAIT() asm volatile("s_waitcnt lgkmcnt(0)" ::: "memory")
__device__ __forceinline__ f32x4 mfma16(bf16x8 a, bf16x8 b, f32x4 c) { return __builtin_amdgcn_mfma_f32_16x16x32_bf16(a, b, c, 0, 0, 0); }
__device__ __forceinline__ unsigned cvtpk(float lo, float hi) { unsigned r; asm volatile("v_cvt_pk_bf16_f32 %0, %1, %2" : "=v"(r) : "v"(lo), "v"(hi)); return r; }


namespace pg8 {
#define PG8_LAS __attribute__((address_space(3)))
constexpr int BM = 256, BK = 64, HALF = 128, HTB = HALF * BK * 2, STAGE_BYTES = 8 * HTB;
__host__ __device__ __forceinline__ int lds_byte(int r, int c) { const int st = (r >> 4) * 2 + (c >> 5), rr = r & 15, cc = c & 31, ob = rr * 64 + cc * 2; return st * 1024 + (ob ^ (((ob >> 9) & 1) << 5)); }
__host__ __device__ __forceinline__ void stage_rc(int b, int& R, int& C) { const int st = b / 1024, sb = b % 1024, swz = sb ^ (((sb >> 9) & 1) << 5); R = (st >> 1) * 16 + swz / 64; C = (st & 1) * 32 + (swz % 64) / 2; }
__host__ __device__ __forceinline__ int perm32(int rho) { const int n = rho >> 4, i = rho & 15; return 8 * (i >> 2) + 4 * n + (i & 3); }
struct Unit { int pm, pn, aux; const char* A; const char* B; };
__device__ __forceinline__ unsigned cvt_pk_bf16(float lo, float hi) { unsigned r; asm volatile("v_cvt_pk_bf16_f32 %0, %1, %2" : "=v"(r) : "v"(lo), "v"(hi)); return r; }

template <int K, int LD, class Epi, class Sched, bool ALIGN_EPI = true, bool SP2 = true>
__device__ __forceinline__ void gemm_phase(PG8_LAS unsigned char* lds, const Sched& S, const Epi& E, const int tid) {
    const int wid = __builtin_amdgcn_readfirstlane(tid >> 6), lane = tid & 63, wr = wid >> 2, wc = wid & 3, fr = lane & 15, fq = lane >> 4;
    constexpr int nt = K / BK;
    unsigned voffA[2], voffB[2];
#pragma unroll
    for (int i = 0; i < 2; ++i) { int R, C; stage_rc(tid * 16 + i * 8192, R, C); const int Rb = Epi::PERM ? ((R & ~31) + perm32(R & 31)) : R;
        voffA[i] = (unsigned)(R * LD + C) * 2u; voffB[i] = (unsigned)(Rb * LD + C) * 2u; }
    constexpr size_t kstep = (size_t)(BK * 2);
    constexpr size_t hstep = (size_t)HALF * LD * 2;
    const unsigned ldsw = (unsigned)wid * 1024u;
    const int aoff = lds_byte(wr * 64 + fr, fq * 8), boff = lds_byte(wc * 32 + fr, fq * 8);
#define PG8_SA(b, h) (((b) * 2 + (h)) * HTB)
#define PG8_SB(b, h) ((4 + (b) * 2 + (h)) * HTB)
#define PG8_STAGE(bufoff, gbase, voff) do { _Pragma("unroll") for (int _i = 0; _i < 2; ++_i) \
        __builtin_amdgcn_global_load_lds((const unsigned*)((const char*)(gbase) + (voff)[_i]), (PG8_LAS unsigned*)(lds + (bufoff) + ldsw + _i * 8192), 16, 0, 0); } while (0)
#define PG8_LDA(dst, b, h) do { _Pragma("unroll") for (int m = 0; m < 4; ++m) _Pragma("unroll") for (int k = 0; k < 2; ++k) dst[m][k] = *(const PG8_LAS bf16x8*)(lds + PG8_SA(b, h) + aoff + m * 2048 + k * 1024); } while (0)
#define PG8_LDB(dst, b, h) do { _Pragma("unroll") for (int n = 0; n < 2; ++n) _Pragma("unroll") for (int k = 0; k < 2; ++k) dst[n][k] = *(const PG8_LAS bf16x8*)(lds + PG8_SB(b, h) + boff + n * 2048 + k * 1024); } while (0)
#define PG8_MMA(ai, bj, At, Bt) do { __builtin_amdgcn_s_setprio(1); _Pragma("unroll") for (int m = 0; m < 4; ++m) _Pragma("unroll") for (int n = 0; n < 2; ++n) _Pragma("unroll") for (int k = 0; k < 2; ++k) \
        acc[ai][bj][m][n] = __builtin_amdgcn_mfma_f32_16x16x32_bf16(Bt[n][k], At[m][k], acc[ai][bj][m][n], 0, 0, 0); __builtin_amdgcn_s_setprio(0); } while (0)
#define PG8_WAIT_V(n) asm volatile("s_waitcnt vmcnt(" #n ")" ::: "memory")
#define PG8_WAIT_L(n) asm volatile("s_waitcnt lgkmcnt(" #n ")" ::: "memory")
#define PG8_BAR __builtin_amdgcn_s_barrier()
#define PG8_SCHED __builtin_amdgcn_sched_barrier(0)
    Unit cur, nxt; int ui = 0;
    if (!S.next(0, cur)) return;
    f32x4 acc[2][2][4][2];
#pragma unroll
    for (int a = 0; a < 2; ++a)
#pragma unroll
        for (int b = 0; b < 2; ++b)
#pragma unroll
            for (int m = 0; m < 4; ++m)
#pragma unroll
                for (int n = 0; n < 2; ++n) acc[a][b][m][n] = (f32x4){0.f, 0.f, 0.f, 0.f};
    bf16x8 At[4][2], B0[2][2], B1[2][2];
    const char* cA = cur.A; const char* cB = cur.B;
    if constexpr (SP2) {
        PG8_STAGE(PG8_SB(0, 0), cB, voffB); PG8_STAGE(PG8_SB(0, 1), cB + hstep, voffB); PG8_STAGE(PG8_SA(0, 0), cA, voffA); PG8_STAGE(PG8_SA(0, 1), cA + hstep, voffA);
        if (wr == 1) PG8_BAR;
        PG8_WAIT_V(2); PG8_BAR;
        PG8_STAGE(PG8_SB(1, 0), cB + kstep, voffB); PG8_STAGE(PG8_SA(1, 0), cA + kstep, voffA); PG8_STAGE(PG8_SB(1, 1), cB + hstep + kstep, voffB);
        PG8_WAIT_V(6); PG8_BAR;
    } else {
        PG8_STAGE(PG8_SB(0, 0), cB, voffB); PG8_STAGE(PG8_SA(0, 0), cA, voffA); PG8_STAGE(PG8_SB(0, 1), cB + hstep, voffB); PG8_STAGE(PG8_SA(0, 1), cA + hstep, voffA);
        if (wr == 1) PG8_BAR;
        PG8_WAIT_V(4); PG8_BAR;
        PG8_STAGE(PG8_SB(1, 0), cB + kstep, voffB); PG8_STAGE(PG8_SA(1, 0), cA + kstep, voffA); PG8_STAGE(PG8_SB(1, 1), cB + hstep + kstep, voffB);
        PG8_WAIT_V(6); PG8_BAR;
    }
    for (;;) {
        const bool has_next = S.next(ui + 1, nxt);
        const char* nA = has_next ? nxt.A : cA; const char* nB = has_next ? nxt.B : cB;
        for (int t = 0; t < nt; t += 2) {
            const bool last = (t == nt - 2);
            const char* a1 = cA + (size_t)(t + 1) * kstep;
            const char* a2 = last ? nA : cA + (size_t)(t + 2) * kstep; const char* b2 = last ? nB : cB + (size_t)(t + 2) * kstep;
            const char* a3 = a2 + kstep; const char* b3 = b2 + kstep;
            if constexpr (SP2) {
            PG8_LDB(B0, 0, 0); PG8_LDB(B1, 0, 1); PG8_SCHED; PG8_LDA(At, 0, 0); PG8_STAGE(PG8_SA(1, 1), a1 + hstep, voffA);
            PG8_WAIT_V(8); PG8_WAIT_L(0); PG8_BAR; PG8_MMA(0, 0, At, B0); PG8_MMA(0, 1, At, B1); PG8_BAR; PG8_SCHED;
            PG8_LDA(At, 0, 1); PG8_STAGE(PG8_SB(0, 0), b2, voffB); PG8_STAGE(PG8_SB(0, 1), b2 + hstep, voffB); PG8_STAGE(PG8_SA(0, 0), a2, voffA);
            PG8_WAIT_V(8); PG8_WAIT_L(0); PG8_BAR; PG8_MMA(1, 0, At, B0); PG8_MMA(1, 1, At, B1); PG8_BAR; PG8_SCHED;
            PG8_LDB(B0, 1, 0); PG8_LDB(B1, 1, 1); PG8_SCHED; PG8_LDA(At, 1, 0); PG8_STAGE(PG8_SA(0, 1), a2 + hstep, voffA);
            PG8_WAIT_V(8); PG8_WAIT_L(0); PG8_BAR; PG8_MMA(0, 0, At, B0); PG8_MMA(0, 1, At, B1); PG8_BAR; PG8_SCHED;
            PG8_LDA(At, 1, 1); PG8_STAGE(PG8_SB(1, 0), b3, voffB); PG8_STAGE(PG8_SB(1, 1), b3 + hstep, voffB); PG8_STAGE(PG8_SA(1, 0), a3, voffA);
            PG8_WAIT_V(8); PG8_WAIT_L(0); PG8_BAR; PG8_MMA(1, 0, At, B0); PG8_MMA(1, 1, At, B1); PG8_BAR; PG8_SCHED;
            } else {
            PG8_LDB(B0, 0, 0); PG8_SCHED; PG8_LDA(At, 0, 0); PG8_STAGE(PG8_SA(1, 1), a1 + hstep, voffA);
            PG8_WAIT_L(8); PG8_BAR; PG8_WAIT_L(0); PG8_MMA(0, 0, At, B0); PG8_BAR; PG8_SCHED;
            PG8_LDB(B1, 0, 1); PG8_STAGE(PG8_SB(0, 0), b2, voffB);
            PG8_BAR; PG8_WAIT_L(0); PG8_MMA(0, 1, At, B1); PG8_BAR;
            PG8_LDA(At, 0, 1); PG8_STAGE(PG8_SA(0, 0), a2, voffA);
            PG8_BAR; PG8_WAIT_L(0); PG8_MMA(1, 0, At, B0); PG8_BAR; PG8_SCHED;
            PG8_STAGE(PG8_SB(0, 1), b2 + hstep, voffB);
            PG8_WAIT_V(6); PG8_BAR; PG8_MMA(1, 1, At, B1); PG8_BAR;
            PG8_LDB(B0, 1, 0); PG8_SCHED; PG8_LDA(At, 1, 0); PG8_STAGE(PG8_SA(0, 1), a2 + hstep, voffA);
            PG8_WAIT_L(8); PG8_BAR; PG8_WAIT_L(0); PG8_MMA(0, 0, At, B0); PG8_BAR; PG8_SCHED;
            PG8_LDB(B1, 1, 1); PG8_STAGE(PG8_SB(1, 0), b3, voffB);
            PG8_BAR; PG8_WAIT_L(0); PG8_MMA(0, 1, At, B1); PG8_BAR;
            PG8_LDA(At, 1, 1); PG8_STAGE(PG8_SA(1, 0), a3, voffA);
            PG8_BAR; PG8_WAIT_L(0); PG8_MMA(1, 0, At, B0); PG8_BAR; PG8_SCHED;
            PG8_STAGE(PG8_SB(1, 1), b3 + hstep, voffB);
            PG8_WAIT_V(6); PG8_BAR; PG8_MMA(1, 1, At, B1); PG8_BAR;
            }
        }
        if constexpr (ALIGN_EPI) { if (wr == 0) PG8_BAR; }
        PG8_PB();
        E(acc, cur, wr, wc, fr, fq);
        PG8_PE();
        if (!has_next) break;
#pragma unroll
        for (int a = 0; a < 2; ++a)
#pragma unroll
            for (int b = 0; b < 2; ++b)
#pragma unroll
                for (int m = 0; m < 4; ++m)
#pragma unroll
                    for (int n = 0; n < 2; ++n) acc[a][b][m][n] = (f32x4){0.f, 0.f, 0.f, 0.f};
        cur = nxt; cA = nA; cB = nB; ++ui;
        if constexpr (ALIGN_EPI) { if (wr == 1) PG8_BAR; }
    }
    PG8_WAIT_V(0);
    if constexpr (!ALIGN_EPI) { if (wr == 0) PG8_BAR; }
    PG8_BAR;
#undef PG8_SA
#undef PG8_SB
#undef PG8_STAGE
#undef PG8_LDA
#undef PG8_LDB
#undef PG8_MMA
#undef PG8_WAIT_V
#undef PG8_WAIT_L
#undef PG8_BAR
#undef PG8_SCHED
}

struct StaticOrder {
    int nM, nN, nwg, G, c, pm_off; const char* A; const char* Bt; size_t tstep;
    __device__ void init(const void* A_, const void* Bt_, int M_, int N_, int K_, int G_, int c_, int pm_off_ = 0) { A = (const char*)A_; Bt = (const char*)Bt_; nM = M_ / BM; nN = N_ / BM; nwg = nM * nN; G = G_; c = c_; pm_off = pm_off_; tstep = (size_t)BM * K_ * 2; }
    __device__ bool next(int i, Unit& u) const {
        const long L = (long)i * G + c; if (L >= nwg) return false;
        int wgid = (int)L; { const int q = nwg / 8, r = nwg % 8, xcd = wgid % 8, off = wgid / 8; wgid = (xcd < r ? xcd * (q + 1) : r * (q + 1) + (xcd - r) * q) + off; }
        const int nig = 8 * nN, gid = wgid / nig, fm = gid * 8, gsz = (nM - fm) < 8 ? (nM - fm) : 8;
        u.pm = fm + ((wgid % nig) % gsz) + pm_off; u.pn = (wgid % nig) / gsz; u.aux = 0;
        u.A = A + (size_t)u.pm * tstep; u.B = Bt + (size_t)u.pn * tstep; return true;
    }
};
struct SplitOrder {
    int nks, nsub, G, c; const char* A; const char* Bt; size_t tstep;
    __device__ void init(const void* A_, const void* Bt_, int LD_, int nks_, int G_, int c_) { A = (const char*)A_; Bt = (const char*)Bt_; nks = nks_; nsub = 16 * nks_; G = G_; c = c_; tstep = (size_t)BM * LD_ * 2; }
    __device__ bool next(int i, Unit& u) const {
        const int L = i * G + c; if (L >= nsub) return false;
        const int ksl = L % nks, t = L / nks; u.pm = t >> 2; u.pn = t & 3; u.aux = ksl;
        u.A = A + (size_t)u.pm * tstep + (size_t)ksl * 512; u.B = Bt + (size_t)u.pn * tstep + (size_t)ksl * 512; return true;
    }
};
struct GroupedOrder {
    int nM, nN, nwg, G, c; const char* A; const char* Bt; size_t tstep, estep; const int* tile_e;
    __device__ void init(const void* A_, const void* Bt_, int ntiles, int N_, int K_, int G_, int c_, const int* te) { A = (const char*)A_; Bt = (const char*)Bt_; nM = ntiles; nN = N_ / BM; nwg = nM * nN; G = G_; c = c_; tstep = (size_t)BM * K_ * 2; estep = (size_t)N_ * K_ * 2; tile_e = te; }
    __device__ bool next(int i, Unit& u) const {
        const long L = (long)i * G + c; if (L >= nwg) return false;
        int wgid = (int)L; { const int q = nwg / 8, r = nwg % 8, xcd = wgid % 8, off = wgid / 8; wgid = (xcd < r ? xcd * (q + 1) : r * (q + 1) + (xcd - r) * q) + off; }
        const int nig = 8 * nN, gid = wgid / nig, fm = gid * 8, gsz = (nM - fm) < 8 ? (nM - fm) : 8;
        u.pm = fm + ((wgid % nig) % gsz); u.pn = (wgid % nig) / gsz; u.aux = __builtin_amdgcn_readfirstlane(tile_e[u.pm]);
        u.A = A + (size_t)u.pm * tstep; u.B = Bt + (size_t)u.aux * estep + (size_t)u.pn * tstep; return true;
    }
};

struct SplitGroupedOrder {
    int t0, nsub, G, c; const char* A; const char* Bt; size_t tstep, estep; const int* tile_e;
    __device__ void init(const void* A_, const void* Bt_, int t0_, int nt_, int G_, int c_, const int* te) { A = (const char*)A_; Bt = (const char*)Bt_; t0 = t0_; nsub = nt_ * 16; G = G_; c = c_; tstep = (size_t)BM * EF * 2; estep = (size_t)D * EF * 2; tile_e = te; }
    __device__ bool next(int i, Unit& u) const {
        const int L = i * G + c; if (L >= nsub) return false;
        const int ksl = L & 3, t = L >> 2; u.pm = t0 + (t >> 2); u.pn = t & 3; u.aux = ksl;
        const int e = __builtin_amdgcn_readfirstlane(tile_e[u.pm]);
        u.A = A + (size_t)u.pm * tstep + (size_t)ksl * 896 * 2; u.B = Bt + (size_t)e * estep + (size_t)u.pn * tstep + (size_t)ksl * 896 * 2; return true;
    }
};
struct EpiBf16 {
    static constexpr bool PERM = true;
    bf16* O; int ldc;
    __device__ __forceinline__ void operator()(const f32x4 (&acc)[2][2][4][2], const Unit& u, int wr, int wc, int fr, int fq) const {
        const int row0 = u.pm * BM + wr * 64 + fr, col0 = u.pn * BM + wc * 32 + 8 * fq;
#pragma unroll
        for (int ai = 0; ai < 2; ++ai)
#pragma unroll
            for (int m = 0; m < 4; ++m) { bf16* rowp = O + (size_t)(row0 + ai * HALF + m * 16) * ldc + col0;
#pragma unroll
                for (int bj = 0; bj < 2; ++bj) { const f32x4 v0 = acc[ai][bj][m][0], v1 = acc[ai][bj][m][1];
                    u32x4 w; w.x = cvt_pk_bf16(v0[0], v0[1]); w.y = cvt_pk_bf16(v0[2], v0[3]); w.z = cvt_pk_bf16(v1[0], v1[1]); w.w = cvt_pk_bf16(v1[2], v1[3]);
                    *(u32x4*)(rowp + bj * HALF) = w; } }
    }
};
struct EpiResid {
    static constexpr bool PERM = false;
    float* X; const float* mod; int gsel;
    __device__ __forceinline__ void operator()(const f32x4 (&acc)[2][2][4][2], const Unit& u, int wr, int wc, int fr, int fq) const {
        const int row0 = u.pm * BM + wr * 64 + fr, col0 = u.pn * BM + wc * 32 + 4 * fq;
        const int r = u.pm < 4 ? 4 : ((u.pm - 4) >> 4);
        const float* g = mod + (size_t)r * 6 * D + gsel * D;
        f32x4 gv[2][2];
#pragma unroll
        for (int bj = 0; bj < 2; ++bj)
#pragma unroll
            for (int n = 0; n < 2; ++n) gv[bj][n] = *(const f32x4*)(g + col0 + bj * HALF + n * 16);
#pragma unroll
        for (int ai = 0; ai < 2; ++ai)
#pragma unroll
            for (int m = 0; m < 4; ++m) { float* rowp = X + (size_t)(row0 + ai * HALF + m * 16) * D + col0;
#pragma unroll
                for (int bj = 0; bj < 2; ++bj)
#pragma unroll
                    for (int n = 0; n < 2; ++n) { f32x4 x = *(f32x4*)(rowp + bj * HALF + n * 16); x += gv[bj][n] * acc[ai][bj][m][n]; *(f32x4*)(rowp + bj * HALF + n * 16) = x; } }
    }
};
struct EpiSwiglu {
    static constexpr bool PERM = false;
    bf16* Hd; int ldh;
    __device__ __forceinline__ void operator()(const f32x4 (&acc)[2][2][4][2], const Unit& u, int wr, int wc, int fr, int fq) const {
        const int row0 = u.pm * BM + wr * 64 + fr, col0 = u.pn * 128 + wc * 16 + 4 * fq;
#pragma unroll
        for (int ai = 0; ai < 2; ++ai)
#pragma unroll
            for (int m = 0; m < 4; ++m) { bf16* rowp = Hd + (size_t)(row0 + ai * HALF + m * 16) * ldh + col0;
#pragma unroll
                for (int bj = 0; bj < 2; ++bj) { const f32x4 a = acc[ai][bj][m][0], b = acc[ai][bj][m][1];
                    float h[4];
#pragma unroll
                    for (int j = 0; j < 4; ++j) h[j] = a[j] * __builtin_amdgcn_rcpf(1.0f + __builtin_amdgcn_exp2f(-1.4426950408889634f * a[j])) * b[j];
                    u32x2 w; w.x = cvt_pk_bf16(h[0], h[1]); w.y = cvt_pk_bf16(h[2], h[3]);
                    *(u32x2*)(rowp + bj * 64) = w; } }
    }
};
struct EpiF32 {
    static constexpr bool PERM = false;
    float* C; int ldc;
    __device__ __forceinline__ void operator()(const f32x4 (&acc)[2][2][4][2], const Unit& u, int wr, int wc, int fr, int fq) const {
        const int row0 = u.pm * BM + wr * 64 + fr, col0 = u.pn * BM + wc * 32 + 4 * fq;
#pragma unroll
        for (int ai = 0; ai < 2; ++ai)
#pragma unroll
            for (int m = 0; m < 4; ++m) { float* rowp = C + (size_t)(row0 + ai * HALF + m * 16) * ldc + col0;
#pragma unroll
                for (int bj = 0; bj < 2; ++bj)
#pragma unroll
                    for (int n = 0; n < 2; ++n) *(f32x4*)(rowp + bj * HALF + n * 16) = acc[ai][bj][m][n]; }
    }
};
struct EpiSlab {
    static constexpr bool PERM = false;
    float* C;
    __device__ __forceinline__ void operator()(const f32x4 (&acc)[2][2][4][2], const Unit& u, int wr, int wc, int fr, int fq) const {
        const int row0 = u.pm * BM + wr * 64 + fr, col0 = u.pn * BM + wc * 32 + 4 * fq;
        float* base = C + (size_t)u.aux * MC * D;
#pragma unroll
        for (int ai = 0; ai < 2; ++ai)
#pragma unroll
            for (int m = 0; m < 4; ++m) { float* rowp = base + (size_t)(row0 + ai * HALF + m * 16) * D + col0;
#pragma unroll
                for (int bj = 0; bj < 2; ++bj)
#pragma unroll
                    for (int n = 0; n < 2; ++n) *(f32x4*)(rowp + bj * HALF + n * 16) = acc[ai][bj][m][n]; }
    }
};
struct EpiYMSlab {
    static constexpr bool PERM = false;
    float* YMp; float* slab; int row0s;
    __device__ __forceinline__ void operator()(const f32x4 (&acc)[2][2][4][2], const Unit& u, int wr, int wc, int fr, int fq) const {
        const int row0 = u.pm * BM + wr * 64 + fr, col0 = u.pn * BM + wc * 32 + 4 * fq;
        float* base = u.aux == 0 ? YMp + (size_t)row0 * D : slab + ((size_t)(u.aux - 1) * 4096 + (row0 - row0s)) * D;
#pragma unroll
        for (int ai = 0; ai < 2; ++ai)
#pragma unroll
            for (int m = 0; m < 4; ++m) { float* rowp = base + (size_t)(ai * HALF + m * 16) * D + col0;
#pragma unroll
                for (int bj = 0; bj < 2; ++bj)
#pragma unroll
                    for (int n = 0; n < 2; ++n) *(f32x4*)(rowp + bj * HALF + n * 16) = acc[ai][bj][m][n]; }
    }
};
}

#define XB_TMO      128
#define XB_XCNT(j)  (256  + 64 * (j))
#define XB_XSUB(j)  (1280 + 64 * (j))
#define XB_XGEN(j)  (2304 + 64 * (j))
#define XB_TOP      3328
#define XB_TOPGEN   3392
#define XCD_BAR_WORDS 3456
#define XB_SPIN_CAP (1u << 22)
__device__ __forceinline__ unsigned xb_ld(unsigned* p)              { return __hip_atomic_load(p, __ATOMIC_RELAXED, __HIP_MEMORY_SCOPE_AGENT); }
__device__ __forceinline__ unsigned xb_add(unsigned* p, unsigned v) { return __hip_atomic_fetch_add(p, v, __ATOMIC_RELAXED, __HIP_MEMORY_SCOPE_AGENT); }
__device__ __forceinline__ unsigned xb_xcc_id() { return (unsigned)__builtin_amdgcn_s_getreg((3 << 11) | 20) & 0xFu; }
#define XB_SPIN(cond, bar) do { unsigned _sp = 0; while (cond) { __builtin_amdgcn_s_sleep(1); \
    if ((++_sp & 255u) == 0u) { if (xb_ld(&(bar)[XB_TMO])) break; if (_sp > XB_SPIN_CAP) { atomicAdd(&(bar)[XB_TMO], 1u); break; } } } } while (0)
struct XcdBarrier { unsigned* bar; unsigned x; volatile LAS unsigned* st; int w0; };
__device__ __forceinline__ bool xb_leader(int w0) { return w0 == 0 && __builtin_amdgcn_mbcnt_hi(~0u, __builtin_amdgcn_mbcnt_lo(~0u, 0u)) == 0u; }
__device__ __forceinline__ XcdBarrier xcd_barrier_post(unsigned* bar, volatile LAS unsigned* st) {
    XcdBarrier b; b.bar = bar; b.x = xb_xcc_id(); b.st = st; b.w0 = __builtin_amdgcn_readfirstlane(threadIdx.x >> 6);
    if (xb_leader(b.w0)) (void)xb_add(&bar[XB_XCNT(b.x)], 1u);
    return b;
}
__device__ __forceinline__ void xcd_barrier_complete(unsigned* bar, unsigned x, unsigned& nloc, unsigned& nx) {
    const unsigned G = gridDim.x * gridDim.y * gridDim.z;
    unsigned sum, cnt, mine, sp = 0u;
    for (;;) {
        sum = 0u; cnt = 0u; mine = 0u;
#pragma unroll
        for (unsigned j = 0; j < 16; ++j) { const unsigned c = xb_ld(&bar[XB_XCNT(j)]); sum += c; cnt += (c > 0u) ? 1u : 0u; mine = (j == x) ? c : mine; }
        if (sum == G) break;
        __builtin_amdgcn_s_sleep(1);
        if ((++sp & 255u) == 0u) { if (xb_ld(&bar[XB_TMO])) break; if (sp > XB_SPIN_CAP) { atomicAdd(&bar[XB_TMO], 1u); break; } }
    }
    nloc = mine > 0u ? mine : 1u; nx = cnt > 0u ? cnt : 1u;
}
__device__ __forceinline__ void xcd_barrier(const XcdBarrier& b) {
    asm volatile("s_waitcnt vmcnt(0)" ::: "memory");
    __syncthreads();
    if (xb_leader(b.w0)) {
        unsigned* bar = b.bar; unsigned bx = b.x;
        asm volatile("" : "+s"(bar), "+s"(bx));
        __builtin_amdgcn_s_waitcnt(0);
        unsigned nloc = b.st[0], nx = b.st[1];
        if (nloc == 0u) { xcd_barrier_complete(bar, bx, nloc, nx); b.st[0] = nloc; b.st[1] = nx; }
        const unsigned old = xb_add(&bar[XB_XSUB(bx)], 1u);
        const unsigned gen = old / nloc;
        if (old + 1u == (gen + 1u) * nloc) {
            __builtin_amdgcn_fence(__ATOMIC_RELEASE, "agent");
            asm volatile("s_waitcnt vmcnt(0)" ::: "memory");
            const unsigned og = xb_add(&bar[XB_TOP], 1u);
            const unsigned tg = og / nx;
            if (og + 1u == (tg + 1u) * nx) xb_add(&bar[XB_TOPGEN], 1u);
            else XB_SPIN(xb_ld(&bar[XB_TOPGEN]) == tg, bar);
            __builtin_amdgcn_fence(__ATOMIC_ACQUIRE, "agent");
            xb_add(&bar[XB_XGEN(bx)], 1u);
            asm volatile("s_waitcnt vmcnt(0)" ::: "memory");
        } else {
            XB_SPIN(xb_ld(&bar[XB_XGEN(bx)]) == gen, bar);
            __builtin_amdgcn_fence(__ATOMIC_ACQUIRE, "agent");
            asm volatile("s_waitcnt vmcnt(0)" ::: "memory");
        }
    }
    __syncthreads();
}

constexpr int NWAVES = 8, NTHR = 512;
constexpr int RING_BYTES = 131072, MISC_OFF = RING_BYTES + 320, LDS_BYTES = 147456;

struct Inputs {
    const float *x, *c, *ctx, *c_ctx, *ada_w, *ada_b, *norm1_g, *w_in, *ret_decay, *ret_gn_g, *gdn_conv_w, *gdn_a_log, *gdn_dt_bias, *gdn_norm_g, *swa_sink, *w_out, *norm2_g,
        *ffn_w1, *ffn_w3, *ffn_w2, *router_w, *moe_w1, *moe_w3, *moe_w2, *final_g;
};
struct Args { Inputs in; float* out; unsigned char* ws; int ph_lo, ph_hi; };
static_assert(sizeof(Args) == 25 * 8 + 8 + 8 + 8, "no padding");


__device__ __forceinline__ const float* ld_ptr(const LAS unsigned long long* t, int i) { const unsigned long long v = t[i]; const unsigned lo = __builtin_amdgcn_readfirstlane((unsigned)v), hi = __builtin_amdgcn_readfirstlane((unsigned)(v >> 32)); return (const float*)(GAS const float*)(((unsigned long long)hi << 32) | lo); }
__device__ __forceinline__ Inputs load_inputs(const LAS unsigned long long* t) {
    Inputs in; const float** ip = (const float**)&in;
#pragma unroll
    for (int i = 0; i < 25; ++i) ip[i] = ld_ptr(t, i);
    return in;
}
struct Frame {
    LAS unsigned char* lds;
    int tid, lane, wave, G, gw, NGW, bid;
    unsigned char* ws;
};


constexpr int CW_DYN = 8192;
struct DynQ { unsigned* ctr; volatile LAS int* slot; bool lead; };
__device__ __forceinline__ DynQ dyn_make(Frame& F, int layer, int k) { DynQ q; q.ctr = (unsigned*)(F.ws + WS_CTL) + CW_DYN + (layer * 8 + k) * 64; q.slot = (volatile LAS int*)(F.lds + MISC_OFF + 64); q.lead = F.wave == 0 && F.lane == 0; return q; }
__device__ __forceinline__ int dyn_grab(const DynQ& q) { return q.lead ? (int)__hip_atomic_fetch_add(q.ctr, 1u, __ATOMIC_RELAXED, __HIP_MEMORY_SCOPE_AGENT) : 0; }
__device__ __forceinline__ int dyn_bcast(const DynQ& q, int v) { __syncthreads(); if (q.lead) q.slot[0] = v; __syncthreads(); return __builtin_amdgcn_readfirstlane(q.slot[0]); }

template <class SrcF>
__device__ __forceinline__ void transpose_item(const SrcF& src, int K, bf16* WT, LAS float* scr, int k0, int n0, int lane) {
#pragma unroll
    for (int i = 0; i < 8; ++i) { const int row = 4 * i + (lane >> 4), col = 4 * (lane & 15); *(LAS f32x4*)(scr + row * 68 + col) = src(k0 + row, n0 + col); }
    LDS_WAIT(); asm volatile("" ::: "memory");
#pragma unroll
    for (int j = 0; j < 4; ++j) { const int ch = j * 64 + lane, n = ch >> 2, c8 = ch & 3; const LAS float* sp = scr + (8 * c8) * 68 + n;
        u32x4 o; o.x = cvtpk(sp[0 * 68], sp[1 * 68]); o.y = cvtpk(sp[2 * 68], sp[3 * 68]); o.z = cvtpk(sp[4 * 68], sp[5 * 68]); o.w = cvtpk(sp[6 * 68], sp[7 * 68]);
        *(u32x4*)(WT + (size_t)(n0 + n) * K + k0 + 8 * c8) = o; }
    LDS_WAIT(); asm volatile("" ::: "memory");
}
struct SrcPlain { const float* W; int ld; __device__ __forceinline__ f32x4 operator()(int k, int n) const { return *(const f32x4*)(W + (size_t)k * ld + n); } };
struct SrcWin { const float* W; __device__ __forceinline__ f32x4 operator()(int k, int n) const { return *(const f32x4*)(W + (size_t)k * INC + (n < 2048 ? n : n + 16)); } };
struct SrcGU { const float* W1; const float* W3; int ld; __device__ __forceinline__ f32x4 operator()(int k, int n) const { const int g = n >> 5, i = n & 31; const ptrdiff_t d = (i < 16) ? (ptrdiff_t)0 : (W3 - W1); return *(const f32x4*)(W1 + d + (ptrdiff_t)k * ld + 16 * g + (i & 15)); } };

__device__ __forceinline__ void convert_moe_layer(Frame& F, const Inputs& in, int mi, int part, int nwg) {
    LAS float* scr = (LAS float*)(F.lds + F.wave * 16384);
    bf16* mw13 = (bf16*)(F.ws + WS_MW13); bf16* mw2 = (bf16*)(F.ws + WS_MW2);
    constexpr int I13 = (D / 32) * (2 * EF / 64), I2 = (EF / 32) * (D / 64);
    if (F.bid >= nwg) return;
    constexpr int NIT = NE * (I13 + I2);
    for (int it = part * (NIT / 2) + F.gw; it < (part + 1) * (NIT / 2); it += nwg * NWAVES) {
        const int e = it / (I13 + I2); int r = it % (I13 + I2);
        const size_t wo = ((size_t)mi * NE + e) * (size_t)D * EF;
        if (r < I13) { const int nblk = 2 * EF / 64; SrcGU s{in.moe_w1 + wo, in.moe_w3 + wo, EF}; transpose_item(s, D, mw13 + (size_t)e * 2 * EF * D, scr, 32 * (r / nblk), 64 * (r % nblk), F.lane); }
        else { r -= I13; const int nblk = D / 64; SrcPlain s{in.moe_w2 + wo, D}; transpose_item(s, EF, mw2 + (size_t)e * D * EF, scr, 32 * (r / nblk), 64 * (r % nblk), F.lane); }
    }
}

__device__ __forceinline__ void phase_prologue(Frame& F, const Inputs& in) {
    LAS float* scr = (LAS float*)(F.lds + F.wave * 16384);
    {
        constexpr int I_IN = (D / 32) * (NP / 64), I_OUT = (D / 32) * (D / 64), I_13 = (D / 32) * (2 * FF / 64), I_2 = (FF / 32) * (D / 64);
        constexpr int PER_L = I_IN + I_OUT, PER_F = I_13 + I_2, TOT = DEPTH * PER_L + 2 * PER_F;
        for (int it = F.gw; it < TOT; it += F.NGW) {
            if (it < DEPTH * PER_L) { const int l = it / PER_L; int r = it % PER_L;
                if (r < I_IN) { const int nblk = NP / 64; SrcWin s{in.w_in + (size_t)l * D * INC}; transpose_item(s, D, (bf16*)(F.ws + WS_WIN) + (size_t)l * NP * D, scr, 32 * (r / nblk), 64 * (r % nblk), F.lane); }
                else { r -= I_IN; const int nblk = D / 64; SrcPlain s{in.w_out + (size_t)l * D * D, D}; transpose_item(s, D, (bf16*)(F.ws + WS_WOUT) + (size_t)l * D * D, scr, 32 * (r / nblk), 64 * (r % nblk), F.lane); }
            } else { const int q = it - DEPTH * PER_L; const int i = q / PER_F; int r = q % PER_F;
                if (r < I_13) { const int nblk = 2 * FF / 64; SrcGU s{in.ffn_w1 + (size_t)i * D * FF, in.ffn_w3 + (size_t)i * D * FF, FF}; transpose_item(s, D, (bf16*)(F.ws + WS_W13) + (size_t)i * 2 * FF * D, scr, 32 * (r / nblk), 64 * (r % nblk), F.lane); }
                else { r -= I_13; const int nblk = D / 64; SrcPlain s{in.ffn_w2 + (size_t)i * FF * D, D}; transpose_item(s, FF, (bf16*)(F.ws + WS_W2) + (size_t)i * D * FF, scr, 32 * (r / nblk), 64 * (r % nblk), F.lane); }
            }
        }
    }
    {
        __syncthreads();
        LAS float* sc = (LAS float*)F.lds;
        LAS float* red = (LAS float*)(F.lds + 32768);
        for (int i = F.tid; i < 5 * D; i += NTHR) { const int r = i / D, k = i % D; const float v = r < 4 ? in.c[r * D + k] : in.c_ctx[k]; sc[i] = siluf(v); }
        __syncthreads();
        float* mod = (float*)(F.ws + WS_MOD);
        for (int u = F.bid; u < DEPTH * 96; u += F.G) {
            const int l = u / 96, n = (u % 96) * 64 + F.lane;
            const float* w = in.ada_w + (size_t)l * D * 6 * D + n;
            float a[5] = {0.f, 0.f, 0.f, 0.f, 0.f};
            for (int k = F.wave * 128; k < F.wave * 128 + 128; ++k) { const float wv = w[(size_t)k * 6 * D];
#pragma unroll
                for (int r = 0; r < 5; ++r) a[r] += sc[r * D + k] * wv; }
#pragma unroll
            for (int r = 0; r < 5; ++r) red[(F.wave * 5 + r) * 64 + F.lane] = a[r];
            __syncthreads();
            if (F.tid < 320) { const int r = F.tid / 64, ln = F.tid % 64; float s = 0.f;
#pragma unroll
                for (int w8 = 0; w8 < 8; ++w8) s += red[(w8 * 5 + r) * 64 + ln];
                const int nn = (u % 96) * 64 + ln;
                mod[((size_t)l * 5 + r) * 6 * D + nn] = s + in.ada_b[(size_t)l * 6 * D + nn]; }
            __syncthreads();
        }
    }
    if (F.bid == 0) { float* rp = (float*)(F.ws + WS_ROPE);
        for (int i = F.tid; i < 64 * 16; i += NTHR) { const int pos = i / 16, fi = i % 16; const double inv = pow(10000.0, -(double)fi / 16.0), ang = (double)pos * inv; rp[2 * i] = (float)cos(ang); rp[2 * i + 1] = (float)sin(ang); } }
}

__device__ __forceinline__ int mod_row(int m) { return m < MC ? 4 : ((m - MC) >> 12); }

template <int MODE>
__device__ __forceinline__ void phase_token(Frame& F, const Inputs& in, int layer, bool first_from_input, bool combine_moe, bool moe_router, float* out) {
    float* XS = (float*)(F.ws + WS_XS);
    bf16* H = (bf16*)(F.ws + WS_H);
    const float* mod = (const float*)(F.ws + WS_MOD) + (size_t)(layer < DEPTH ? layer : DEPTH - 1) * 5 * 6 * D;
    const float* modprev = (const float*)(F.ws + WS_MOD) + (size_t)(layer > 0 ? layer - 1 : 0) * 5 * 6 * D;
    const int* TKE = (const int*)(F.ws + WS_TKE); const float* TKG = (const float*)(F.ws + WS_TKG); const int* TOKROW = (const int*)(F.ws + WS_TOKROW);
    const float* YM = (const float*)(F.ws + WS_YM);
    LAS float* wl = (LAS float*)F.lds;
    if (MODE == 0) { __syncthreads(); const float* w = in.w_in + (size_t)layer * D * INC + 2048; for (int i = F.tid; i < D * 16; i += NTHR) { const int k = i >> 4, c = i & 15, kp = ((k >> 8) * 4 + (k & 3)) * 64 + ((k >> 2) & 63); wl[((c >> 2) * 1024 + kp) * 4 + (c & 3)] = w[(size_t)k * INC + c]; } __syncthreads(); }
    LAS int* lcnt = (LAS int*)(F.lds + 61440);
    if (MODE == 1 && moe_router) { __syncthreads(); if (F.tid < 8) lcnt[F.tid] = 0; const float* w = in.router_w + (size_t)(layer >> 1) * D * NE; for (int i = F.tid; i < D * NE; i += NTHR) { const int k = i >> 3, c = i & 7, kp = ((k >> 8) * 4 + (k & 3)) * 64 + ((k >> 2) & 63); wl[((c >> 2) * 1024 + kp) * 4 + (c & 3)] = w[i]; } __syncthreads(); }
    const float* gain = MODE == 0 ? in.norm1_g + (size_t)layer * D : (MODE == 1 ? in.norm2_g + (size_t)layer * D : in.final_g);
    const int m_lo = (MODE == 2) ? MC : 0;
    for (int m = m_lo + F.gw; m < M; m += F.NGW) {
        const int r = mod_row(m);
        f32x4 v[4];
        const float* xrow = first_from_input ? (m < MC ? in.ctx + (size_t)m * D : in.x + (size_t)(m - MC) * D) : XS + (size_t)m * D;
#pragma unroll
        for (int j = 0; j < 4; ++j) v[j] = *(const f32x4*)(xrow + 4 * F.lane + 256 * j);
        bool wrote = first_from_input;
        if (combine_moe && !(layer == DEPTH && m < MC)) {
            const int r0 = TOKROW[2 * m], r1 = TOKROW[2 * m + 1]; const float g0 = TKG[2 * m], g1 = TKG[2 * m + 1];
            const float* gt = modprev + (size_t)r * 6 * D + 5 * D;
#pragma unroll
            for (int j = 0; j < 4; ++j) { const f32x4 y0 = *(const f32x4*)(YM + (size_t)r0 * D + 4 * F.lane + 256 * j), y1 = *(const f32x4*)(YM + (size_t)r1 * D + 4 * F.lane + 256 * j);
                const f32x4 gg = *(const f32x4*)(gt + 4 * F.lane + 256 * j); v[j] += gg * (g0 * y0 + g1 * y1); }
            wrote = true;
        }
        if (wrote && MODE != 2) {
#pragma unroll
            for (int j = 0; j < 4; ++j) *(f32x4*)(XS + (size_t)m * D + 4 * F.lane + 256 * j) = v[j];
        }
        float ss = 0.f;
#pragma unroll
        for (int j = 0; j < 4; ++j) ss += (v[j].x * v[j].x + v[j].y * v[j].y) + (v[j].z * v[j].z + v[j].w * v[j].w);
        const float rstd = 1.0f / sqrtf(wave_sum(ss) * (1.0f / D) + EPS);
        if (MODE == 2) {
#pragma unroll
            for (int j = 0; j < 4; ++j) { const f32x4 g = *(const f32x4*)(gain + 4 * F.lane + 256 * j); *(f32x4*)(out + (size_t)(m - MC) * D + 4 * F.lane + 256 * j) = v[j] * rstd * g; }
            continue;
        }
        const float* sh = mod + (size_t)r * 6 * D + (MODE == 0 ? 0 : 3) * D; const float* scl = sh + D;
        f32x4 h[4];
#pragma unroll
        for (int j = 0; j < 4; ++j) { const f32x4 g = *(const f32x4*)(gain + 4 * F.lane + 256 * j), s1 = *(const f32x4*)(scl + 4 * F.lane + 256 * j), s0 = *(const f32x4*)(sh + 4 * F.lane + 256 * j);
            h[j] = v[j] * rstd * g * (1.0f + s1) + s0;
            u32x2 w; w.x = pk2(h[j].x, h[j].y); w.y = pk2(h[j].z, h[j].w); *(u32x2*)(H + (size_t)m * D + 4 * F.lane + 256 * j) = w; }
        if (MODE == 0) {
            float a[16];
#pragma unroll
            for (int c = 0; c < 16; ++c) a[c] = 0.f;
#pragma unroll
            for (int j = 0; j < 4; ++j)
#pragma unroll
                for (int e = 0; e < 4; ++e) { const int kp = (j * 4 + e) * 64 + F.lane; const float hv = h[j][e];
#pragma unroll
                    for (int q = 0; q < 4; ++q) { const f32x4 w = *(const LAS f32x4*)(wl + (q * 1024 + kp) * 4); a[4 * q] += hv * w.x; a[4 * q + 1] += hv * w.y; a[4 * q + 2] += hv * w.z; a[4 * q + 3] += hv * w.w; } }
            float mine = 0.f;
#pragma unroll
            for (int c = 0; c < 16; ++c) { const float s = wave_sum(a[c]); mine = (F.lane == c) ? s : mine; }
            if (F.lane < 16) ((float*)(F.ws + WS_AB))[(size_t)m * 16 + F.lane] = mine;
        }
        if (MODE == 1 && moe_router) {
            float a[8];
#pragma unroll
            for (int c = 0; c < 8; ++c) a[c] = 0.f;
#pragma unroll
            for (int j = 0; j < 4; ++j)
#pragma unroll
                for (int e = 0; e < 4; ++e) { const int kp = (j * 4 + e) * 64 + F.lane; const float hv = h[j][e];
#pragma unroll
                    for (int q = 0; q < 2; ++q) { const f32x4 w = *(const LAS f32x4*)(wl + (q * 1024 + kp) * 4); a[4 * q] += hv * w.x; a[4 * q + 1] += hv * w.y; a[4 * q + 2] += hv * w.z; a[4 * q + 3] += hv * w.w; } }
#pragma unroll
            for (int c = 0; c < 8; ++c) a[c] = wave_sum(a[c]);
            int i0 = 0; float l0 = a[0];
#pragma unroll
            for (int c = 1; c < 8; ++c) if (a[c] > l0) { l0 = a[c]; i0 = c; }
            int i1 = -1; float l1 = -3.0e38f;
#pragma unroll
            for (int c = 0; c < 8; ++c) if (c != i0 && a[c] > l1) { l1 = a[c]; i1 = c; }
            const float e1 = fexp(l1 - l0), g0 = 1.0f / (1.0f + e1), g1 = e1 / (1.0f + e1);
            if (F.lane == 0) { ((int*)(F.ws + WS_TKE))[2 * m] = i0; ((int*)(F.ws + WS_TKE))[2 * m + 1] = i1; ((float*)(F.ws + WS_TKG))[2 * m] = g0; ((float*)(F.ws + WS_TKG))[2 * m + 1] = g1; }
        }
    }
    (void)TKE;
}


template <int MODE>
__device__ __forceinline__ void phase_token2(Frame& F, const Inputs& in, int layer, bool first_from_input, bool combine_moe, bool moe_router, float* out, int route_lo = 0, int nslab = 0) {
    float* XS = (float*)(F.ws + WS_XS);
    bf16* H = (bf16*)(F.ws + WS_H);
    const float* mod = (const float*)(F.ws + WS_MOD) + (size_t)(layer < DEPTH ? layer : DEPTH - 1) * 5 * 6 * D;
    const float* modprev = (const float*)(F.ws + WS_MOD) + (size_t)(layer > 0 ? layer - 1 : 0) * 5 * 6 * D;
    const float* TKG = (const float*)(F.ws + WS_TKG); const int* TOKROW = (const int*)(F.ws + WS_TOKROW);
    const float* YM = (const float*)(F.ws + WS_YM);
    LAS float* wl = (LAS float*)F.lds;
    const int lane = F.lane;
    if (MODE == 0) PB(8);
    if (MODE == 0) { __syncthreads(); const float* w = in.w_in + (size_t)layer * D * INC + 2048;
#pragma unroll
        for (int n = 0; n < 8; ++n) { const int k = (F.tid >> 2) + 128 * n, q4 = F.tid & 3, kp = ((k >> 8) * 4 + (k & 3)) * 64 + ((k >> 2) & 63);
            *(LAS f32x4*)(wl + (q4 * 1024 + kp) * 4) = *(const f32x4*)(w + (size_t)k * INC + 4 * q4); }
        __syncthreads(); }
    LAS int* lcnt = (LAS int*)(F.lds + 61440);
    if (MODE == 1 && moe_router) { __syncthreads(); if (F.tid < 8) lcnt[F.tid] = 0; const float* w = in.router_w + (size_t)(layer >> 1) * D * NE;
#pragma unroll
        for (int n = 0; n < 4; ++n) { const int k = (F.tid >> 1) + 256 * n, q4 = F.tid & 1, kp = ((k >> 8) * 4 + (k & 3)) * 64 + ((k >> 2) & 63);
            *(LAS f32x4*)(wl + (q4 * 1024 + kp) * 4) = *(const f32x4*)(w + (size_t)k * NE + 4 * q4); }
        __syncthreads(); }
    if (MODE == 0) PE(8);
    if (MODE == 0) PB(9);
    if (MODE == 1) PB(10);
    const float* gain = MODE == 0 ? in.norm1_g + (size_t)layer * D : (MODE == 1 ? in.norm2_g + (size_t)layer * D : in.final_g);
    const bool has_ctx = (MODE != 2) && F.gw < MC;
    const int r_beg = MC + (int)(((long)F.gw * ML) / F.NGW), r_end = MC + (int)(((long)(F.gw + 1) * ML) / F.NGW);
    if (nslab > 0 && has_ctx) {
        const float* sb = (const float*)(F.ws + WS_R1 + 100 * MiB); const float* gsrc = (MODE == 1 ? mod + (size_t)4 * 6 * D + 2 * D : modprev + (size_t)4 * 6 * D + 5 * D);
        { const int m = F.gw;
#pragma unroll
            for (int j = 0; j < 4; ++j) { f32x4 a0 = (f32x4){0.f, 0.f, 0.f, 0.f};
                for (int sidx = 0; sidx < nslab; ++sidx) a0 += *(const f32x4*)(sb + ((size_t)sidx * MC + m) * D + 4 * lane + 256 * j);
                float* xp = XS + (size_t)m * D + 4 * lane + 256 * j; *(f32x4*)xp = *(const f32x4*)xp + *(const f32x4*)(gsrc + 4 * lane + 256 * j) * a0; } }
        asm volatile("s_waitcnt vmcnt(0)" ::: "memory");
    }
    if (combine_moe) {
        const int ntl = ((const int*)(F.ws + WS_TILEE))[256]; const int srow = ((ntl - (ntl / 64) * 64 <= 16) ? (ntl / 64) * 64 : ntl) * 256; const float* sl = (const float*)(F.ws + WS_HP);
        float* YMw = (float*)(F.ws + WS_YM);
        for (int m0 = has_ctx ? r_beg - 1 : r_beg; m0 < r_end; ++m0) { const int m = m0 < r_beg ? F.gw : m0;
            if (MODE == 0 && layer == DEPTH && m < MC) continue;
#pragma unroll
            for (int k = 0; k < 2; ++k) { const int r = TOKROW[2 * m + k];
                if (r >= srow) { const size_t o = (size_t)(r - srow) * D;
#pragma unroll
                    for (int j = 0; j < 4; ++j) { float* yp = YMw + (size_t)r * D + 4 * lane + 256 * j;
                        *(f32x4*)yp = ((*(const f32x4*)yp + *(const f32x4*)(sl + o + 4 * lane + 256 * j)) + *(const f32x4*)(sl + (size_t)4096 * D + o + 4 * lane + 256 * j)) + *(const f32x4*)(sl + (size_t)8192 * D + o + 4 * lane + 256 * j); } } } }
        asm volatile("s_waitcnt vmcnt(0)" ::: "memory");
    }
    f32x4 gv[4], av[4], bv[4], gt[4];
#pragma unroll
    for (int j = 0; j < 4; ++j) gv[j] = *(const f32x4*)(gain + 4 * lane + 256 * j);
    int rcur = -1;
    for (int m0 = has_ctx ? r_beg - 1 : r_beg; m0 < r_end; m0 += 2) {
        const bool isc = m0 < r_beg;
        const int ma = isc ? F.gw : m0; const bool two = !isc && ma + 1 < r_end; const int m1 = two ? ma + 1 : ma;
        if (isc) m0 -= 1;
        const int r = mod_row(ma);
        const bool same = mod_row(m1) == r;
        const int mm1 = same ? m1 : ma; const bool do1 = two && same;
        if (!same) m0 -= 1;
        if (r != rcur) { rcur = r;
            if (MODE != 2) { const float* sh = mod + (size_t)r * 6 * D + (MODE == 0 ? 0 : 3) * D;
#pragma unroll
                for (int j = 0; j < 4; ++j) { const f32x4 s1 = *(const f32x4*)(sh + D + 4 * lane + 256 * j); av[j] = gv[j] * (1.0f + s1); bv[j] = *(const f32x4*)(sh + 4 * lane + 256 * j); } }
            if (combine_moe) {
#pragma unroll
                for (int j = 0; j < 4; ++j) gt[j] = *(const f32x4*)(modprev + (size_t)r * 6 * D + 5 * D + 4 * lane + 256 * j); } }
        const int mr[2] = {ma, mm1};
        f32x4 v[2][4];
        int t0[2], t1[2]; float g0[2], g1[2];
        if (combine_moe) {
#pragma unroll
            for (int p = 0; p < 2; ++p) { t0[p] = TOKROW[2 * mr[p]]; t1[p] = TOKROW[2 * mr[p] + 1]; g0[p] = TKG[2 * mr[p]]; g1[p] = TKG[2 * mr[p] + 1]; } }
#pragma unroll
        for (int p = 0; p < 2; ++p) { const int m = mr[p];
            const float* xrow = first_from_input ? (m < MC ? in.ctx + (size_t)m * D : in.x + (size_t)(m - MC) * D) : XS + (size_t)m * D;
#pragma unroll
            for (int j = 0; j < 4; ++j) v[p][j] = *(const f32x4*)(xrow + 4 * lane + 256 * j); }
        if (combine_moe) {
#pragma unroll
            for (int p = 0; p < 2; ++p)
#pragma unroll
                for (int j = 0; j < 4; ++j) { const f32x4 y0 = *(const f32x4*)(YM + (size_t)t0[p] * D + 4 * lane + 256 * j), y1 = *(const f32x4*)(YM + (size_t)t1[p] * D + 4 * lane + 256 * j);
                    v[p][j] += gt[j] * (g0[p] * y0 + g1[p] * y1); } }
        if ((first_from_input || combine_moe) && MODE != 2) {
#pragma unroll
            for (int p = 0; p < 2; ++p) if (p == 0 || do1) {
#pragma unroll
                for (int j = 0; j < 4; ++j) *(f32x4*)(XS + (size_t)mr[p] * D + 4 * lane + 256 * j) = v[p][j]; } }
        float rstd[2];
#pragma unroll
        for (int p = 0; p < 2; ++p) { float ss = 0.f;
#pragma unroll
            for (int j = 0; j < 4; ++j) ss += (v[p][j].x * v[p][j].x + v[p][j].y * v[p][j].y) + (v[p][j].z * v[p][j].z + v[p][j].w * v[p][j].w);
            rstd[p] = 1.0f / sqrtf(wave_sum(ss) * (1.0f / D) + EPS); }
        if (MODE == 2) {
#pragma unroll
            for (int p = 0; p < 2; ++p) if (p == 0 || do1) {
#pragma unroll
                for (int j = 0; j < 4; ++j) *(f32x4*)(out + (size_t)(mr[p] - MC) * D + 4 * lane + 256 * j) = v[p][j] * rstd[p] * gv[j]; }
            continue; }
        f32x4 h[2][4];
#pragma unroll
        for (int p = 0; p < 2; ++p)
#pragma unroll
            for (int j = 0; j < 4; ++j) { h[p][j] = v[p][j] * rstd[p] * av[j] + bv[j];
                if (p == 0 || do1) { u32x2 w; w.x = cvtpk(h[p][j].x, h[p][j].y); w.y = cvtpk(h[p][j].z, h[p][j].w); *(u32x2*)(H + (size_t)mr[p] * D + 4 * lane + 256 * j) = w; } }
        if (MODE == 0 || (MODE == 1 && moe_router)) {
            constexpr int NC = (MODE == 0) ? 16 : 8;
            float a[2][NC];
#pragma unroll
            for (int p = 0; p < 2; ++p)
#pragma unroll
                for (int c = 0; c < NC; ++c) a[p][c] = 0.f;
#pragma unroll
            for (int j = 0; j < 4; ++j)
#pragma unroll
                for (int e = 0; e < 4; ++e) { const int kp = (j * 4 + e) * 64 + lane;
#pragma unroll
                    for (int q = 0; q < NC / 4; ++q) { const f32x4 w = *(const LAS f32x4*)(wl + (q * 1024 + kp) * 4);
#pragma unroll
                        for (int p = 0; p < 2; ++p) { const float hv = h[p][j][e]; a[p][4 * q] += hv * w.x; a[p][4 * q + 1] += hv * w.y; a[p][4 * q + 2] += hv * w.z; a[p][4 * q + 3] += hv * w.w; } } }
#pragma unroll
            for (int p = 0; p < 2; ++p) {
#pragma unroll
                for (int c = 0; c < NC; ++c) a[p][c] = wave_sum(a[p][c]); }
#pragma unroll
            for (int p = 0; p < 2; ++p) if (p == 0 || do1) { const int m = mr[p];
                if (MODE == 0) { float mine = 0.f;
#pragma unroll
                    for (int c = 0; c < NC; ++c) mine = (lane == c) ? a[p][c] : mine;
                    if (lane < 16) ((float*)(F.ws + WS_AB))[(size_t)m * 16 + lane] = mine; }
                else { int i0 = 0; float l0 = a[p][0];
#pragma unroll
                    for (int c = 1; c < NC; ++c) if (a[p][c] > l0) { l0 = a[p][c]; i0 = c; }
                    int i1 = -1; float l1 = -3.0e38f;
#pragma unroll
                    for (int c = 0; c < NC; ++c) if (c != i0 && a[p][c] > l1) { l1 = a[p][c]; i1 = c; }
                    const float e1 = fexp(l1 - l0), gg0 = 1.0f / (1.0f + e1), gg1 = e1 / (1.0f + e1);
                    if (lane == 0 && m >= route_lo) { ((int*)(F.ws + WS_TKE))[2 * m] = i0; ((int*)(F.ws + WS_TKE))[2 * m + 1] = i1; ((float*)(F.ws + WS_TKG))[2 * m] = gg0; ((float*)(F.ws + WS_TKG))[2 * m + 1] = gg1;
                        ((int*)(F.ws + WS_TOKROW))[2 * m] = __hip_atomic_fetch_add(lcnt + i0, 1, __ATOMIC_RELAXED, __HIP_MEMORY_SCOPE_WORKGROUP); ((int*)(F.ws + WS_TOKROW))[2 * m + 1] = __hip_atomic_fetch_add(lcnt + i1, 1, __ATOMIC_RELAXED, __HIP_MEMORY_SCOPE_WORKGROUP); } } }
        }
    }
    if (MODE == 0) PE(9);
    if (MODE == 1) PE(10);
    if (MODE == 1 && moe_router) { __syncthreads(); if (F.tid < 8) ((int*)(F.ws + WS_TILEE + 4096))[F.bid * 8 + F.tid] = lcnt[F.tid]; }
}

__device__ __forceinline__ void phase_prep(Frame& F, const Inputs& in, int layer) {
    const bf16* P = (const bf16*)(F.ws + WS_R1 + R1_P);
    unsigned char* prep = F.ws + WS_R1 + R1_PREP;
    bf16* RQ = (bf16*)(prep + PREP_RQ); bf16* RK = (bf16*)(prep + PREP_RK); bf16* SQ = (bf16*)(prep + PREP_SQ); bf16* SK = (bf16*)(prep + PREP_SK); bf16* GD = (bf16*)(prep + PREP_GD);
    const float* rope = (const float*)(F.ws + WS_ROPE);
    const float* AB = (const float*)(F.ws + WS_AB); float* GB = (float*)(F.ws + WS_GB);
    const float* cw = in.gdn_conv_w + (size_t)layer * 5 * 768;
    const int lane = F.lane;
    for (int m = F.gw; m < M; m += F.NGW) {
        const bool lat = m >= MC; const int t = lat ? ((m - MC) & (TL - 1)) : (m & (TC - 1)); const int Tn = lat ? TL : TC;
        const bf16* prow = P + (size_t)m * NP;
        float cs = 1.f, sn = 0.f;
        if (lat) { const int j = lane & 31; const int pos = j < 16 ? (t >> 6) : (t & 63); const int fi = j & 15; cs = rope[(pos * 16 + fi) * 2]; sn = rope[(pos * 16 + fi) * 2 + 1]; if (lane < 32) sn = -sn; }
#pragma unroll
        for (int hh = 0; hh < 4; ++hh) { const float q = bf2f(prow[PC_RQ + hh * 64 + lane]), k = bf2f(prow[PC_RK + hh * 64 + lane]) * 0.125f;
            const float qp = __shfl_xor(q, 32), kp = __shfl_xor(k, 32);
            RQ[(size_t)m * 256 + hh * 64 + lane] = (bf16)f2bf(q * cs + qp * sn); RK[(size_t)m * 256 + hh * 64 + lane] = (bf16)f2bf(k * cs + kp * sn); }
#pragma unroll
        for (int hq = 0; hq < 8; ++hq) { const float q = bf2f(prow[PC_SQ + hq * 64 + lane]); const float qp = __shfl_xor(q, 32); SQ[(size_t)m * 512 + hq * 64 + lane] = (bf16)f2bf(q * cs + qp * sn); }
#pragma unroll
        for (int g = 0; g < 2; ++g) { const float k = bf2f(prow[PC_SK + g * 64 + lane]); const float kp = __shfl_xor(k, 32); SK[(size_t)m * 128 + g * 64 + lane] = (bf16)f2bf(k * cs + kp * sn); }
#pragma unroll 1
        for (int s = 0; s < 12; ++s) { const int c = s * 64 + lane; float y = 0.f;
#pragma unroll
            for (int j = 0; j < 5; ++j) { const int tt = t + j - 2; if (tt >= 0 && tt < Tn) y += cw[j * 768 + c] * bf2f(prow[(ptrdiff_t)(j - 2) * NP + PC_GQKV + c]); }
            y = siluf(y);
            if (s < 8) { const float n2 = wave_sum(y * y); y = y * (1.0f / sqrtf(n2 + EPS)); if (s < 4) y *= 0.125f; }
            GD[(size_t)m * 768 + c] = (bf16)f2bf(y); }
        if (lane < 16) { const int dh = lane & 7; const float a = AB[(size_t)m * 16 + lane];
            float o;
            if (lane < 8) { const float xx = a + in.gdn_dt_bias[layer * 8 + dh]; const float sp = fmaxf(xx, 0.f) + log1pf(fexp(-fabsf(xx))); o = -fexp(in.gdn_a_log[layer * 8 + dh]) * sp; }
            else o = 1.0f / (1.0f + fexp(-a));
            GB[(size_t)m * 16 + lane] = o; }
    }
}


__device__ __forceinline__ void unpack8(const u32x4 w, float (&v)[8]) {
#pragma unroll
    for (int e = 0; e < 4; ++e) { v[2 * e] = __uint_as_float(w[e] << 16); v[2 * e + 1] = __uint_as_float(w[e] & 0xffff0000u); } }
__device__ __forceinline__ u32x4 pack8(const float (&v)[8]) { u32x4 w; w.x = cvtpk(v[0], v[1]); w.y = cvtpk(v[2], v[3]); w.z = cvtpk(v[4], v[5]); w.w = cvtpk(v[6], v[7]); return w; }
__device__ __forceinline__ void phase_prep2(Frame& F, const Inputs& in, int layer) {
    const bf16* P = (const bf16*)(F.ws + WS_R1 + R1_P);
    unsigned char* prep = F.ws + WS_R1 + R1_PREP;
    bf16* RQ = (bf16*)(prep + PREP_RQ); bf16* RK = (bf16*)(prep + PREP_RK); bf16* SQ = (bf16*)(prep + PREP_SQ); bf16* SK = (bf16*)(prep + PREP_SK); bf16* GD = (bf16*)(prep + PREP_GD);
    const float* rope = (const float*)(F.ws + WS_ROPE);
    const float* AB = (const float*)(F.ws + WS_AB); float* GB = (float*)(F.ws + WS_GB);
    const float* cw = in.gdn_conv_w + (size_t)layer * 5 * 768;
    const int lane = F.lane, l3 = lane & 3, l31 = lane & 31;
    float wA[5][8], wB[5][8];
#pragma unroll
    for (int j = 0; j < 5; ++j) { const f32x4 a0 = *(const f32x4*)(cw + j * 768 + 8 * lane), a1 = *(const f32x4*)(cw + j * 768 + 8 * lane + 4), b0 = *(const f32x4*)(cw + j * 768 + 512 + 8 * l31), b1 = *(const f32x4*)(cw + j * 768 + 512 + 8 * l31 + 4);
#pragma unroll
        for (int x = 0; x < 4; ++x) { wA[j][x] = a0[x]; wA[j][4 + x] = a1[x]; wB[j][x] = b0[x]; wB[j][4 + x] = b1[x]; } }
    const float sgn = ((lane & 7) < 4) ? -1.0f : 1.0f;
    for (int m = F.gw; m < M; m += F.NGW) {
        const bool lat = m >= MC; const int t = lat ? ((m - MC) & (TL - 1)) : (m & (TC - 1)); const int Tn = lat ? TL : TC;
        const bf16* prow = P + (size_t)m * NP;
        float cs[8], sn[8];
        { const int pos = (l3 < 2) ? (t >> 6) : (t & 63); const float* rp = rope + (pos * 16 + 8 * (l3 & 1)) * 2;
          const f32x4 r0 = *(const f32x4*)(rp), r1 = *(const f32x4*)(rp + 4), r2 = *(const f32x4*)(rp + 8), r3 = *(const f32x4*)(rp + 12);
          cs[0] = r0[0]; sn[0] = r0[1]; cs[1] = r0[2]; sn[1] = r0[3]; cs[2] = r1[0]; sn[2] = r1[1]; cs[3] = r1[2]; sn[3] = r1[3];
          cs[4] = r2[0]; sn[4] = r2[1]; cs[5] = r2[2]; sn[5] = r2[3]; cs[6] = r3[0]; sn[6] = r3[1]; cs[7] = r3[2]; sn[7] = r3[3];
#pragma unroll
          for (int x = 0; x < 8; ++x) { if (!lat) { cs[x] = 1.0f; sn[x] = 0.0f; } sn[x] *= sgn; } }
        { const bool isk = lane >= 32; float v[8], o[8]; unpack8(*(const u32x4*)(prow + (isk ? PC_RK : PC_RQ) + 8 * l31), v);
#pragma unroll
          for (int x = 0; x < 8; ++x) { if (isk) v[x] *= 0.125f; const float pv = __shfl_xor(v[x], 4); o[x] = v[x] * cs[x] + pv * sn[x]; }
          *(u32x4*)((isk ? RK : RQ) + (size_t)m * 256 + 8 * l31) = pack8(o); }
        { float v[8], o[8]; unpack8(*(const u32x4*)(prow + PC_SQ + 8 * lane), v);
#pragma unroll
          for (int x = 0; x < 8; ++x) { const float pv = __shfl_xor(v[x], 4); o[x] = v[x] * cs[x] + pv * sn[x]; }
          *(u32x4*)(SQ + (size_t)m * 512 + 8 * lane) = pack8(o); }
        { float v[8], o[8]; unpack8(*(const u32x4*)(prow + PC_SK + 8 * (lane & 15)), v);
#pragma unroll
          for (int x = 0; x < 8; ++x) { const float pv = __shfl_xor(v[x], 4); o[x] = v[x] * cs[x] + pv * sn[x]; }
          if (lane < 16) *(u32x4*)(SK + (size_t)m * 128 + 8 * lane) = pack8(o); }
        { float a[8], bq[8];
#pragma unroll
          for (int x = 0; x < 8; ++x) { a[x] = 0.f; bq[x] = 0.f; }
#pragma unroll
          for (int j = 0; j < 5; ++j) { const int tt = t + j - 2; const bool ok = tt >= 0 && tt < Tn; const bf16* pr = prow + (ok ? (ptrdiff_t)(j - 2) * NP : (ptrdiff_t)0) + PC_GQKV;
              float va[8], vb[8]; unpack8(*(const u32x4*)(pr + 8 * lane), va); unpack8(*(const u32x4*)(pr + 512 + 8 * l31), vb);
              const float z = ok ? 1.0f : 0.0f;
#pragma unroll
              for (int x = 0; x < 8; ++x) { a[x] += z * wA[j][x] * va[x]; bq[x] += z * wB[j][x] * vb[x]; } }
          float n2 = 0.f;
#pragma unroll
          for (int x = 0; x < 8; ++x) { a[x] = siluf(a[x]); bq[x] = siluf(bq[x]); n2 += a[x] * a[x]; }
          n2 += dppf<0xB1>(n2); n2 += dppf<0x4E>(n2); n2 += dppf<0x141>(n2);
          const float sc = (1.0f / sqrtf(n2 + EPS)) * (lane < 32 ? 0.125f : 1.0f);
#pragma unroll
          for (int x = 0; x < 8; ++x) a[x] *= sc;
          *(u32x4*)(GD + (size_t)m * 768 + 8 * lane) = pack8(a);
          if (lane < 32) *(u32x4*)(GD + (size_t)m * 768 + 512 + 8 * lane) = pack8(bq); }
        if (lane < 16) { const int dh = lane & 7; const float a = AB[(size_t)m * 16 + lane];
            float o;
            if (lane < 8) { const float xx = a + in.gdn_dt_bias[layer * 8 + dh]; const float sp = fmaxf(xx, 0.f) + log1pf(fexp(-fabsf(xx))); o = -fexp(in.gdn_a_log[layer * 8 + dh]) * sp; }
            else o = 1.0f / (1.0f + fexp(-a));
            GB[(size_t)m * 16 + lane] = o; }
    }
}


__device__ __forceinline__ void phase_prep3(Frame& F, const Inputs& in, int layer) {
    const bf16* P = (const bf16*)(F.ws + WS_R1 + R1_P);
    unsigned char* prep = F.ws + WS_R1 + R1_PREP;
    bf16* RQ = (bf16*)(prep + PREP_RQ); bf16* RK = (bf16*)(prep + PREP_RK); bf16* SQ = (bf16*)(prep + PREP_SQ); bf16* SK = (bf16*)(prep + PREP_SK); bf16* GD = (bf16*)(prep + PREP_GD);
    const float* rope = (const float*)(F.ws + WS_ROPE);
    const float* AB = (const float*)(F.ws + WS_AB); float* GB = (float*)(F.ws + WS_GB);
    const float* cw = in.gdn_conv_w + (size_t)layer * 5 * 768;
    const int lane = F.lane, l3 = lane & 3, l31 = lane & 31;
    float wA[5][8], wB[5][8];
#pragma unroll
    for (int j = 0; j < 5; ++j) { const f32x4 a0 = *(const f32x4*)(cw + j * 768 + 8 * lane), a1 = *(const f32x4*)(cw + j * 768 + 8 * lane + 4), b0 = *(const f32x4*)(cw + j * 768 + 512 + 8 * l31), b1 = *(const f32x4*)(cw + j * 768 + 512 + 8 * l31 + 4);
#pragma unroll
        for (int x = 0; x < 4; ++x) { wA[j][x] = a0[x]; wA[j][4 + x] = a1[x]; wB[j][x] = b0[x]; wB[j][4 + x] = b1[x]; } }
    const float sgn = ((lane & 7) < 4) ? -1.0f : 1.0f;
    const bool isk = lane >= 32;
    const float dtb = in.gdn_dt_bias[layer * 8 + (lane & 7)], alg = -fexp(in.gdn_a_log[layer * 8 + (lane & 7)]);
    for (int mbase = F.gw; mbase < M; mbase += 2 * F.NGW) {
        const bool ok1 = mbase + F.NGW < M;
        const int mm[2] = {mbase, ok1 ? mbase + F.NGW : mbase};
        bool lat[2]; int tt0[2], Tn[2]; const bf16* prow[2];
#pragma unroll
        for (int p = 0; p < 2; ++p) { const int m = mm[p]; lat[p] = m >= MC; tt0[p] = lat[p] ? ((m - MC) & (TL - 1)) : (m & (TC - 1)); Tn[p] = lat[p] ? TL : TC; prow[p] = P + (size_t)m * NP; }
        f32x4 rt[2][4]; u32x4 u1[2], u2[2], u3[2];
#pragma unroll
        for (int p = 0; p < 2; ++p) { const int t = tt0[p]; const int pos = (l3 < 2) ? (t >> 6) : (t & 63); const float* rp = rope + (pos * 16 + 8 * (l3 & 1)) * 2;
            rt[p][0] = *(const f32x4*)(rp); rt[p][1] = *(const f32x4*)(rp + 4); rt[p][2] = *(const f32x4*)(rp + 8); rt[p][3] = *(const f32x4*)(rp + 12);
            u1[p] = *(const u32x4*)(prow[p] + (isk ? PC_RK : PC_RQ) + 8 * l31); u2[p] = *(const u32x4*)(prow[p] + PC_SQ + 8 * lane); u3[p] = *(const u32x4*)(prow[p] + PC_SK + 8 * (lane & 15)); }
        __builtin_amdgcn_sched_barrier(0);
#pragma unroll
        for (int p = 0; p < 2; ++p) { const int m = mm[p]; const bool st = (p == 0) || ok1;
            float cs[8], sn[8];
#pragma unroll
            for (int x = 0; x < 8; ++x) { cs[x] = rt[p][x >> 1][(x & 1) * 2]; sn[x] = rt[p][x >> 1][(x & 1) * 2 + 1]; if (!lat[p]) { cs[x] = 1.0f; sn[x] = 0.0f; } sn[x] *= sgn; }
            { float v[8], o[8]; unpack8(u1[p], v);
#pragma unroll
              for (int x = 0; x < 8; ++x) { if (isk) v[x] *= 0.125f; const float pv = __shfl_xor(v[x], 4); o[x] = v[x] * cs[x] + pv * sn[x]; }
              if (st) *(u32x4*)((isk ? RK : RQ) + (size_t)m * 256 + 8 * l31) = pack8(o); }
            { float v[8], o[8]; unpack8(u2[p], v);
#pragma unroll
              for (int x = 0; x < 8; ++x) { const float pv = __shfl_xor(v[x], 4); o[x] = v[x] * cs[x] + pv * sn[x]; }
              if (st) *(u32x4*)(SQ + (size_t)m * 512 + 8 * lane) = pack8(o); }
            { float v[8], o[8]; unpack8(u3[p], v);
#pragma unroll
              for (int x = 0; x < 8; ++x) { const float pv = __shfl_xor(v[x], 4); o[x] = v[x] * cs[x] + pv * sn[x]; }
              if (st && lane < 16) *(u32x4*)(SK + (size_t)m * 128 + 8 * lane) = pack8(o); } }
        { u32x4 ca[2][5];
#pragma unroll
          for (int p = 0; p < 2; ++p)
#pragma unroll
              for (int j = 0; j < 5; ++j) { const int tt = tt0[p] + j - 2; const bool ok = tt >= 0 && tt < Tn[p]; ca[p][j] = *(const u32x4*)(prow[p] + (ok ? (ptrdiff_t)(j - 2) * NP : (ptrdiff_t)0) + PC_GQKV + 8 * lane); }
          __builtin_amdgcn_sched_barrier(0);
#pragma unroll
          for (int p = 0; p < 2; ++p) { float a[8];
#pragma unroll
              for (int x = 0; x < 8; ++x) a[x] = 0.f;
#pragma unroll
              for (int j = 0; j < 5; ++j) { const int tt = tt0[p] + j - 2; const float z = (tt >= 0 && tt < Tn[p]) ? 1.0f : 0.0f; float va[8]; unpack8(ca[p][j], va);
#pragma unroll
                  for (int x = 0; x < 8; ++x) a[x] += z * wA[j][x] * va[x]; }
              float n2 = 0.f;
#pragma unroll
              for (int x = 0; x < 8; ++x) { a[x] = siluf(a[x]); n2 += a[x] * a[x]; }
              n2 += dppf<0xB1>(n2); n2 += dppf<0x4E>(n2); n2 += dppf<0x141>(n2);
              const float sc = __builtin_amdgcn_rsqf(n2 + EPS) * (lane < 32 ? 0.125f : 1.0f);
#pragma unroll
              for (int x = 0; x < 8; ++x) a[x] *= sc;
              if (p == 0 || ok1) *(u32x4*)(GD + (size_t)mm[p] * 768 + 8 * lane) = pack8(a); } }
        { u32x4 cb[2][5]; float abv[2];
#pragma unroll
          for (int p = 0; p < 2; ++p) {
#pragma unroll
              for (int j = 0; j < 5; ++j) { const int tt = tt0[p] + j - 2; const bool ok = tt >= 0 && tt < Tn[p]; cb[p][j] = *(const u32x4*)(prow[p] + (ok ? (ptrdiff_t)(j - 2) * NP : (ptrdiff_t)0) + PC_GQKV + 512 + 8 * l31); }
              abv[p] = AB[(size_t)mm[p] * 16 + (lane & 15)]; }
          __builtin_amdgcn_sched_barrier(0);
#pragma unroll
          for (int p = 0; p < 2; ++p) { const int m = mm[p]; float bq[8];
#pragma unroll
              for (int x = 0; x < 8; ++x) bq[x] = 0.f;
#pragma unroll
              for (int j = 0; j < 5; ++j) { const int tt = tt0[p] + j - 2; const float z = (tt >= 0 && tt < Tn[p]) ? 1.0f : 0.0f; float vb[8]; unpack8(cb[p][j], vb);
#pragma unroll
                  for (int x = 0; x < 8; ++x) bq[x] += z * wB[j][x] * vb[x]; }
#pragma unroll
              for (int x = 0; x < 8; ++x) bq[x] = siluf(bq[x]);
              if (p == 0 || ok1) { if (lane < 32) *(u32x4*)(GD + (size_t)m * 768 + 512 + 8 * lane) = pack8(bq);
                  if (lane < 16) { const float av = abv[p]; float o;
                      if (lane < 8) { const float xx = av + dtb; const float sp = fmaxf(xx, 0.f) + log1pf(fexp(-fabsf(xx))); o = alg * sp; }
                      else o = __builtin_amdgcn_rcpf(1.0f + fexp(-av));
                      GB[(size_t)m * 16 + lane] = o; } } } }
    }
}

__device__ __forceinline__ int scan_row(int b, int dir, int tau) {
    if (tau < TC) { const int c = dir ? TC - 1 - tau : tau; return b * TC + c; }
    const int tt = tau - TC; const int t = dir ? TL - 1 - tt : tt; return MC + b * TL + t;
}
__device__ __forceinline__ void phase_scans(Frame& F, const Inputs& in, int layer, int nscan) {
    if (F.wave != 0 || F.bid >= nscan) return;
    const int id = F.bid; const bool gdn = id >= 32; const int sid = id & 31; const int b = sid >> 3, hh = (sid >> 1) & 3, dir = sid & 1;
    const bf16* P = (const bf16*)(F.ws + WS_R1 + R1_P);
    unsigned char* prep = F.ws + WS_R1 + R1_PREP;
    const bf16* RQ = (const bf16*)(prep + PREP_RQ); const bf16* RK = (const bf16*)(prep + PREP_RK); const bf16* GD = (const bf16*)(prep + PREP_GD);
    const float* GB = (const float*)(F.ws + WS_GB);
    float* OUT = (float*)(F.ws + WS_R1 + (gdn ? R1_OG : R1_OR)) + (size_t)dir * M * 256;
    LAS float* lk = (LAS float*)F.lds; LAS float* lq = lk + 64 * 64; LAS float* lg = lq + 64 * 64;
    const int lane = F.lane;
    float S[64];
#pragma unroll
    for (int i = 0; i < 64; ++i) S[i] = 0.f;
    const float gamma = gdn ? 0.f : fexp(-fexp(in.ret_decay[layer * 8 + dir * 4 + hh]));
    for (int t0 = 0; t0 < TC + TL; t0 += 64) {
        for (int i = 0; i < 64; ++i) { const int m = scan_row(b, dir, t0 + i);
            if (gdn) { lq[i * 64 + lane] = bf2f(GD[(size_t)m * 768 + hh * 64 + lane]); lk[i * 64 + lane] = bf2f(GD[(size_t)m * 768 + 256 + hh * 64 + lane]); if (lane < 2) lg[i * 2 + lane] = GB[(size_t)m * 16 + lane * 8 + dir * 4 + hh]; }
            else { lq[i * 64 + lane] = bf2f(RQ[(size_t)m * 256 + hh * 64 + lane]); lk[i * 64 + lane] = bf2f(RK[(size_t)m * 256 + hh * 64 + lane]); } }
        LDS_WAIT(); asm volatile("" ::: "memory");
        for (int i = 0; i < 64; ++i) { const int m = scan_row(b, dir, t0 + i);
            float o = 0.f;
            if (gdn) {
                const float v = bf2f(GD[(size_t)m * 768 + 512 + hh * 64 + lane]); const float a = fexp(lg[i * 2]), beta = lg[i * 2 + 1];
                float ks = 0.f;
#pragma unroll
                for (int d4 = 0; d4 < 16; ++d4) { const f32x4 kv = *(const LAS f32x4*)(lk + i * 64 + 4 * d4); ks += kv.x * S[4 * d4] + kv.y * S[4 * d4 + 1] + kv.z * S[4 * d4 + 2] + kv.w * S[4 * d4 + 3]; }
                const float vn = beta * (v - a * ks);
#pragma unroll
                for (int d4 = 0; d4 < 16; ++d4) { const f32x4 kv = *(const LAS f32x4*)(lk + i * 64 + 4 * d4), qv = *(const LAS f32x4*)(lq + i * 64 + 4 * d4);
                    S[4 * d4] = a * S[4 * d4] + kv.x * vn; S[4 * d4 + 1] = a * S[4 * d4 + 1] + kv.y * vn; S[4 * d4 + 2] = a * S[4 * d4 + 2] + kv.z * vn; S[4 * d4 + 3] = a * S[4 * d4 + 3] + kv.w * vn;
                    o += qv.x * S[4 * d4] + qv.y * S[4 * d4 + 1] + qv.z * S[4 * d4 + 2] + qv.w * S[4 * d4 + 3]; }
            } else {
                const float v = bf2f(P[(size_t)m * NP + PC_RV + hh * 64 + lane]);
#pragma unroll
                for (int d4 = 0; d4 < 16; ++d4) { const f32x4 kv = *(const LAS f32x4*)(lk + i * 64 + 4 * d4), qv = *(const LAS f32x4*)(lq + i * 64 + 4 * d4);
                    S[4 * d4] = gamma * S[4 * d4] + kv.x * v; S[4 * d4 + 1] = gamma * S[4 * d4 + 1] + kv.y * v; S[4 * d4 + 2] = gamma * S[4 * d4 + 2] + kv.z * v; S[4 * d4 + 3] = gamma * S[4 * d4 + 3] + kv.w * v;
                    o += qv.x * S[4 * d4] + qv.y * S[4 * d4 + 1] + qv.z * S[4 * d4 + 2] + qv.w * S[4 * d4 + 3]; }
            }
            OUT[(size_t)m * 256 + hh * 64 + lane] = o;
        }
        LDS_WAIT(); asm volatile("" ::: "memory");
    }
}

__device__ __forceinline__ void phase_swa(Frame& F, const Inputs& in, int layer) {
    const bf16* P = (const bf16*)(F.ws + WS_R1 + R1_P);
    unsigned char* prep = F.ws + WS_R1 + R1_PREP;
    const bf16* SQ = (const bf16*)(prep + PREP_SQ); const bf16* SK = (const bf16*)(prep + PREP_SK);
    bf16* O = (bf16*)(F.ws + WS_R1 + R1_O);
    const int NT = F.G * NTHR;
    for (int idx = F.bid * NTHR + F.tid; idx < M * 8; idx += NT) {
        const int hq = idx / M, m = idx % M, g = hq >> 2;
        const bool lat = m >= MC; const int b = lat ? ((m - MC) >> 12) : (m >> 8); const int t = lat ? ((m - MC) & (TL - 1)) : (m & (TC - 1));
        float q[64], o[64];
#pragma unroll
        for (int i = 0; i < 8; ++i) { const u32x4 w = *(const u32x4*)(SQ + (size_t)m * 512 + hq * 64 + 8 * i);
#pragma unroll
            for (int e = 0; e < 4; ++e) { q[8 * i + 2 * e] = __uint_as_float(w[e] << 16) * 0.125f; q[8 * i + 2 * e + 1] = __uint_as_float(w[e] & 0xffff0000u) * 0.125f; } }
#pragma unroll
        for (int i = 0; i < 64; ++i) o[i] = 0.f;
        float mx = in.swa_sink[layer * 8 + hq], l = 1.0f;
        const int nloc = lat ? 257 : 0;
        for (int kk = 0; kk < nloc + TC; ++kk) {
            int row;
            if (kk < nloc) { const int s = t - 128 + kk; if (s < 0 || s >= TL) continue; row = MC + b * TL + s; }
            else row = b * TC + (kk - nloc);
            float sc = 0.f;
#pragma unroll
            for (int i = 0; i < 8; ++i) { const u32x4 w = *(const u32x4*)(SK + (size_t)row * 128 + g * 64 + 8 * i);
#pragma unroll
                for (int e = 0; e < 4; ++e) sc += q[8 * i + 2 * e] * __uint_as_float(w[e] << 16) + q[8 * i + 2 * e + 1] * __uint_as_float(w[e] & 0xffff0000u); }
            const float mn = fmaxf(mx, sc), corr = fexp(mx - mn), p = fexp(sc - mn);
            l = l * corr + p; mx = mn;
#pragma unroll
            for (int i = 0; i < 8; ++i) { const u32x4 w = *(const u32x4*)(P + (size_t)row * NP + PC_SV + g * 64 + 8 * i);
#pragma unroll
                for (int e = 0; e < 4; ++e) { o[8 * i + 2 * e] = o[8 * i + 2 * e] * corr + p * __uint_as_float(w[e] << 16); o[8 * i + 2 * e + 1] = o[8 * i + 2 * e + 1] * corr + p * __uint_as_float(w[e] & 0xffff0000u); } }
        }
        const float il = 1.0f / l;
#pragma unroll
        for (int i = 0; i < 8; ++i) { u32x4 w;
#pragma unroll
            for (int e = 0; e < 4; ++e) w[e] = pk2(o[8 * i + 2 * e] * il, o[8 * i + 2 * e + 1] * il);
            *(u32x4*)(O + (size_t)m * D + 512 + hq * 64 + 8 * i) = w; }
    }
}


__device__ __forceinline__ void phase_swa2(Frame& F, const Inputs& in, int layer, int nwg) {
    if (F.bid >= nwg) return;
    const bf16* P = (const bf16*)(F.ws + WS_R1 + R1_P);
    unsigned char* prep = F.ws + WS_R1 + R1_PREP;
    const bf16* SQ = (const bf16*)(prep + PREP_SQ); const bf16* SK = (const bf16*)(prep + PREP_SK);
    bf16* O = (bf16*)(F.ws + WS_R1 + R1_O);
    LAS bf16* Kl = (LAS bf16*)F.lds; LAS bf16* Vt = Kl + 64 * 72;
    const int lane = F.lane, c = lane & 15, q = lane >> 4, w = F.wave;
    const float LOG2E = 1.4426950408889634f;
    const int srow = F.tid >> 3, scol = (F.tid & 7) * 8;
    DynQ dq = dyn_make(F, layer, 1);
    for (int u = dyn_bcast(dq, dyn_grab(dq)); u < 544; ) {
        const int u_next = dyn_grab(dq);
        const bool lat = u < 512; int b, g, qb;
        if (lat) { b = u >> 7; g = (u >> 6) & 1; qb = u & 63; } else { const int uu = u - 512; b = uu >> 3; g = (uu >> 2) & 1; qb = uu & 3; }
        const int hq = 4 * g + (w >> 1), i0 = 32 * (w & 1);
        const int mrow0 = lat ? MC + b * TL + 64 * qb : b * TC + 64 * qb;
        const int kt0 = lat ? (2 - qb > 0 ? 2 - qb : 0) : 0, kt1 = lat ? (65 - qb < 4 ? 65 - qb : 4) : -1, nb = lat ? kt1 - kt0 + 1 : 0, nt = nb + 4;
        const int band0 = MC + b * TL + 64 * qb - 128 + 64 * kt0, ctx0 = b * TC;
        bf16x8 qf[2][2];
#pragma unroll
        for (int ti = 0; ti < 2; ++ti)
#pragma unroll
            for (int ks = 0; ks < 2; ++ks) qf[ti][ks] = *(const bf16x8*)(SQ + (size_t)(mrow0 + i0 + 16 * ti + c) * 512 + hq * 64 + 32 * ks + 8 * q);
        float mrun[2], lrun[2]; f32x4 oacc[4][2];
        const float sk = in.swa_sink[layer * 8 + hq] * LOG2E;
#pragma unroll
        for (int ti = 0; ti < 2; ++ti) { mrun[ti] = sk; lrun[ti] = 1.0f;
#pragma unroll
            for (int te = 0; te < 4; ++te) oacc[te][ti] = (f32x4){0.f, 0.f, 0.f, 0.f}; }
        u32x4 kreg, vreg;
        { const int r0 = (0 < nb) ? band0 : ctx0; kreg = *(const u32x4*)(SK + (size_t)(r0 + srow) * 128 + g * 64 + scol); vreg = *(const u32x4*)(P + (size_t)(r0 + srow) * NP + PC_SV + g * 64 + scol); }
        for (int tt = 0; tt < nt; ++tt) {
            __syncthreads();
            *(LAS u32x4*)(Kl + srow * 72 + scol) = kreg;
#pragma unroll
            for (int x = 0; x < 8; ++x) Vt[(scol + x) * 72 + srow] = (bf16)(vreg[x >> 1] >> (16 * (x & 1)));
            __syncthreads();
            if (tt + 1 < nt) { const int r0 = (tt + 1 < nb) ? band0 + 64 * (tt + 1) : ctx0 + 64 * (tt + 1 - nb);
                kreg = *(const u32x4*)(SK + (size_t)(r0 + srow) * 128 + g * 64 + scol); vreg = *(const u32x4*)(P + (size_t)(r0 + srow) * NP + PC_SV + g * 64 + scol); }
            bf16x8 kfr[2][4]; u32x2 vlo[2][4], vhi[2][4];
#pragma unroll
            for (int ks = 0; ks < 2; ++ks)
#pragma unroll
                for (int tj = 0; tj < 4; ++tj) kfr[ks][tj] = *(const LAS bf16x8*)(Kl + (16 * tj + c) * 72 + 32 * ks + 8 * q);
#pragma unroll
            for (int ks2 = 0; ks2 < 2; ++ks2)
#pragma unroll
                for (int te = 0; te < 4; ++te) { vlo[ks2][te] = *(const LAS u32x2*)(Vt + (16 * te + c) * 72 + 32 * ks2 + 4 * q); vhi[ks2][te] = *(const LAS u32x2*)(Vt + (16 * te + c) * 72 + 32 * ks2 + 16 + 4 * q); }
            __builtin_amdgcn_sched_barrier(0);
            f32x4 sacc[4][2];
#pragma unroll
            for (int tj = 0; tj < 4; ++tj)
#pragma unroll
                for (int ti = 0; ti < 2; ++ti) sacc[tj][ti] = (f32x4){0.f, 0.f, 0.f, 0.f};
#pragma unroll
            for (int ks = 0; ks < 2; ++ks)
#pragma unroll
                for (int tj = 0; tj < 4; ++tj)
#pragma unroll
                    for (int ti = 0; ti < 2; ++ti) sacc[tj][ti] = mfma16(kfr[ks][tj], qf[ti][ks], sacc[tj][ti]);
            const bool band = tt < nb;
            const int kp0 = 64 * qb - 128 + 64 * (kt0 + tt) + 4 * q;
#pragma unroll
            for (int ti = 0; ti < 2; ++ti) {
                const int qp = 64 * qb + i0 + 16 * ti + c;
                float mx = -30000.0f;
                if (band) {
#pragma unroll
                    for (int tj = 0; tj < 4; ++tj)
#pragma unroll
                        for (int r = 0; r < 4; ++r) { float sv = sacc[tj][ti][r] * (0.125f * LOG2E); const int dlt = kp0 + 16 * tj + r - qp; if (dlt > 128 || dlt < -128) sv = -30000.0f; sacc[tj][ti][r] = sv; mx = fmaxf(mx, sv); }
                } else {
#pragma unroll
                    for (int tj = 0; tj < 4; ++tj)
#pragma unroll
                        for (int r = 0; r < 4; ++r) { const float sv = sacc[tj][ti][r] * (0.125f * LOG2E); sacc[tj][ti][r] = sv; mx = fmaxf(mx, sv); }
                }
                mx = quad_rows_max(mx);
                const float mn = fmaxf(mrun[ti], mx), corr = __builtin_amdgcn_exp2f(mrun[ti] - mn);
                float ls = 0.f;
#pragma unroll
                for (int tj = 0; tj < 4; ++tj)
#pragma unroll
                    for (int r = 0; r < 4; ++r) { const float p = __builtin_amdgcn_exp2f(sacc[tj][ti][r] - mn); sacc[tj][ti][r] = p; ls += p; }
                ls = quad_rows_sum(ls);
                lrun[ti] = lrun[ti] * corr + ls; mrun[ti] = mn;
#pragma unroll
                for (int te = 0; te < 4; ++te) oacc[te][ti] *= corr;
            }
#pragma unroll
            for (int ks2 = 0; ks2 < 2; ++ks2) {
                bf16x8 pb[2];
#pragma unroll
                for (int ti = 0; ti < 2; ++ti) { u32x4 t; t.x = cvtpk(sacc[2 * ks2][ti][0], sacc[2 * ks2][ti][1]); t.y = cvtpk(sacc[2 * ks2][ti][2], sacc[2 * ks2][ti][3]);
                    t.z = cvtpk(sacc[2 * ks2 + 1][ti][0], sacc[2 * ks2 + 1][ti][1]); t.w = cvtpk(sacc[2 * ks2 + 1][ti][2], sacc[2 * ks2 + 1][ti][3]); pb[ti] = __builtin_bit_cast(bf16x8, t); }
#pragma unroll
                for (int te = 0; te < 4; ++te) { const bf16x8 va = __builtin_bit_cast(bf16x8, ((u32x4){vlo[ks2][te].x, vlo[ks2][te].y, vhi[ks2][te].x, vhi[ks2][te].y}));
#pragma unroll
                    for (int ti = 0; ti < 2; ++ti) oacc[te][ti] = mfma16(va, pb[ti], oacc[te][ti]); }
            }
        }
#pragma unroll
        for (int ti = 0; ti < 2; ++ti) { const float il = 1.0f / lrun[ti]; bf16* orow = O + (size_t)(mrow0 + i0 + 16 * ti + c) * D + 512 + hq * 64 + 4 * q;
#pragma unroll
            for (int te = 0; te < 4; ++te) { u32x2 wv; wv.x = cvtpk(oacc[te][ti][0] * il, oacc[te][ti][1] * il); wv.y = cvtpk(oacc[te][ti][2] * il, oacc[te][ti][3] * il); *(u32x2*)(orow + 16 * te) = wv; } }
        u = dyn_bcast(dq, u_next);
    }
}


__device__ __forceinline__ void phase_gdn_local(Frame& F) {
    unsigned char* prep = F.ws + WS_R1 + R1_PREP;
    const bf16* GD = (const bf16*)(prep + PREP_GD); const float* GB = (const float*)(F.ws + WS_GB);
    LAS bf16* Qs = (LAS bf16*)F.lds; LAS bf16* Ks = Qs + 64 * 72; LAS bf16* Vs = Ks + 64 * 72;
    LAS float* At = (LAS float*)(F.lds + 27648);
    LAS bf16* ATs = (LAS bf16*)(F.lds + 60416);
    LAS bf16* XS_ = (LAS bf16*)(F.lds + 78848);
    LAS float* sm = (LAS float*)(F.lds + 115712);
    LAS float* gl = sm; LAS float* bl = sm + 128; LAS float* gcs = sm + 256; LAS float* eg = sm + 384; LAS float* ekd = sm + 512;
    const int lane = F.lane, c = lane & 15, q = lane >> 4, w = F.wave, tid = F.tid;
    for (int uu = F.bid; uu < 16 * 68; uu += F.G) {
        const int bh = uu / 68, ch = uu % 68, b = bh >> 2, hh = bh & 3;
        const int m0 = ch < 4 ? b * TC + 64 * ch : MC + b * TL + 64 * (ch - 4);
        __syncthreads();
        { const int row = tid >> 3, col8 = (tid & 7) * 8; const bf16* src = GD + (size_t)(m0 + row) * 768 + hh * 64 + col8;
          *(LAS u32x4*)(Qs + row * 72 + col8) = *(const u32x4*)(src); *(LAS u32x4*)(Ks + row * 72 + col8) = *(const u32x4*)(src + 256); *(LAS u32x4*)(Vs + row * 72 + col8) = *(const u32x4*)(src + 512);
          if (tid < 256) { const int tok = tid & 63, which = tid >> 6; sm[which * 64 + tok] = GB[(size_t)(m0 + tok) * 16 + (which >> 1) * 8 + (which & 1) * 4 + hh]; } }
        __syncthreads();
        if (w < 2) { const int d = w; const int tok = d ? 63 - lane : lane; float v = gl[d * 64 + tok];
#pragma unroll
            for (int o = 1; o < 64; o <<= 1) { const float t = __shfl_up(v, o); if (lane >= o) v += t; }
            const float last = __shfl(v, 63);
            gcs[d * 64 + lane] = v; eg[d * 64 + lane] = fexp(v); ekd[d * 64 + lane] = fexp(last - v); }
        __syncthreads();
        {
            const int type = w >> 2, ti = w & 3; const LAS bf16* X = type ? Qs : Ks;
            bf16x8 a[2];
#pragma unroll
            for (int ks = 0; ks < 2; ++ks) a[ks] = *(const LAS bf16x8*)(X + (16 * ti + c) * 72 + 32 * ks + 8 * q);
#pragma unroll
            for (int tj = 0; tj < 4; ++tj) { f32x4 acc = (f32x4){0.f, 0.f, 0.f, 0.f};
#pragma unroll
                for (int ks = 0; ks < 2; ++ks) acc = mfma16(a[ks], *(const LAS bf16x8*)(Ks + (16 * tj + c) * 72 + 32 * ks + 8 * q), acc);
#pragma unroll
                for (int r = 0; r < 4; ++r) { const int it = 16 * ti + 4 * q + r, jt = 16 * tj + c;
#pragma unroll
                    for (int d = 0; d < 2; ++d) { const int i = d ? 63 - it : it, j = d ? 63 - jt : jt;
                        const float e = fexp(fminf(gcs[d * 64 + i] - gcs[d * 64 + j], 0.f));
                        if (type == 0) At[d * 4096 + j * 64 + i] = (j < i) ? bl[d * 64 + it] * acc[r] * e : 0.f;
                        else ATs[d * 4608 + i * 72 + j] = (bf16)f2bf((j <= i) ? acc[r] * e : 0.f); } } }
        }
        __syncthreads();
        if (w < 4) {
            const int d = w >> 1, kind = w & 1; const LAS bf16* R = kind ? Ks : Vs; const LAS float* A = At + d * 4096;
            float x[64];
#pragma unroll
            for (int i = 0; i < 64; ++i) { const int tok = d ? 63 - i : i; float v = bl[d * 64 + tok] * bf2f(R[tok * 72 + lane]); if (kind) v *= eg[d * 64 + i]; x[i] = v; }
#pragma unroll
            for (int j = 0; j < 63; ++j) { const float xj = x[j];
                f32x4 ca[16];
#pragma unroll
                for (int g = ((j + 1) >> 2); g < 16; ++g) ca[g] = *(const LAS f32x4*)(A + j * 64 + 4 * g);
                __builtin_amdgcn_sched_barrier(0);
#pragma unroll
                for (int g = ((j + 1) >> 2); g < 16; ++g) { x[4 * g] -= ca[g].x * xj; x[4 * g + 1] -= ca[g].y * xj; x[4 * g + 2] -= ca[g].z * xj; x[4 * g + 3] -= ca[g].w * xj; }
                __builtin_amdgcn_sched_barrier(0); }
            LAS bf16* XO = XS_ + (d * 2 + kind) * 4608;
#pragma unroll
            for (int i = 0; i < 64; ++i) XO[i * 72 + lane] = (bf16)f2bf(x[i]);
        } else {
            const int t2 = tid - 256;
            for (int it = t2; it < 6 * 512; it += 256) { const int mat = it >> 9, chk = it & 511, d = mat & 1, kindm = mat >> 1;
                const int rt = chk >> 7, ks = (chk >> 6) & 1, ln = chk & 63, r = ln & 15, qq = ln >> 4, row = 16 * rt + r, c0 = 32 * ks + 4 * qq;
                float v[8];
                if (kindm == 0) { const u32x2 lo = *(const LAS u32x2*)(ATs + d * 4608 + row * 72 + c0), hi = *(const LAS u32x2*)(ATs + d * 4608 + row * 72 + c0 + 16);
                    v[0] = __uint_as_float(lo.x << 16); v[1] = __uint_as_float(lo.x & 0xffff0000u); v[2] = __uint_as_float(lo.y << 16); v[3] = __uint_as_float(lo.y & 0xffff0000u);
                    v[4] = __uint_as_float(hi.x << 16); v[5] = __uint_as_float(hi.x & 0xffff0000u); v[6] = __uint_as_float(hi.y << 16); v[7] = __uint_as_float(hi.y & 0xffff0000u); }
                else if (kindm == 1) { const int tok = d ? 63 - row : row; const float sc = eg[d * 64 + row];
#pragma unroll
                    for (int x8 = 0; x8 < 8; ++x8) v[x8] = bf2f(Qs[tok * 72 + c0 + (x8 & 3) + 16 * (x8 >> 2)]) * sc; }
                else {
#pragma unroll
                    for (int x8 = 0; x8 < 8; ++x8) { const int i = c0 + (x8 & 3) + 16 * (x8 >> 2); const int tok = d ? 63 - i : i; v[x8] = bf2f(Ks[tok * 72 + row]) * ekd[d * 64 + i]; } }
                const int chain = bh * 2 + d, sg = ch < 4 ? (d ? 3 - ch : ch) : 4 + (d ? 63 - (ch - 4) : ch - 4);
                unsigned char* dst = F.ws + WS_GCH + (size_t)chain * GCH_CHAIN + (size_t)sg * GCH_STEP + (kindm == 0 ? 16384 : (kindm == 1 ? 8192 : 24576));
                u32x4 o; o.x = pk2(v[0], v[1]); o.y = pk2(v[2], v[3]); o.z = pk2(v[4], v[5]); o.w = pk2(v[6], v[7]);
                *(u32x4*)(dst + chk * 16) = o; }
        }
        __syncthreads();
        {
            for (int it = tid; it < 2 * 512; it += NTHR) { const int d = it >> 9, chk = it & 511;
                const int rt = chk >> 7, ks = (chk >> 6) & 1, ln = chk & 63, r = ln & 15, qq = ln >> 4, row = 16 * rt + r, c0 = 32 * ks + 4 * qq;
                const LAS bf16* XW = XS_ + (d * 2 + 1) * 4608;
                const u32x2 lo = *(const LAS u32x2*)(XW + row * 72 + c0), hi = *(const LAS u32x2*)(XW + row * 72 + c0 + 16);
                const int chain = bh * 2 + d, sg = ch < 4 ? (d ? 3 - ch : ch) : 4 + (d ? 63 - (ch - 4) : ch - 4);
                unsigned char* dst = F.ws + WS_GCH + (size_t)chain * GCH_CHAIN + (size_t)sg * GCH_STEP;
                *(u32x4*)(dst + chk * 16) = (u32x4){lo.x, lo.y, hi.x, hi.y}; }
            for (int it = tid; it < 2 * 1024; it += NTHR) { const int d = it >> 10, cu = it & 1023;
                const int sl = cu >> 8, rt = (cu >> 6) & 3, ln = cu & 63, qq = ln >> 4, cc = ln & 15;
                const LAS bf16* XU = XS_ + (d * 2) * 4608;
                bf16 e0 = XU[(16 * rt + 4 * qq + 0) * 72 + 16 * sl + cc], e1 = XU[(16 * rt + 4 * qq + 1) * 72 + 16 * sl + cc], e2 = XU[(16 * rt + 4 * qq + 2) * 72 + 16 * sl + cc], e3 = XU[(16 * rt + 4 * qq + 3) * 72 + 16 * sl + cc];
                const int chain = bh * 2 + d, sg = ch < 4 ? (d ? 3 - ch : ch) : 4 + (d ? 63 - (ch - 4) : ch - 4);
                unsigned char* dst = F.ws + WS_GCH + (size_t)chain * GCH_CHAIN + (size_t)sg * GCH_STEP + 32768;
                *(u32x2*)(dst + cu * 8) = (u32x2){(unsigned)e0 | ((unsigned)e1 << 16), (unsigned)e2 | ((unsigned)e3 << 16)}; }
            if (tid < 2) { const int d = tid; const int chain = bh * 2 + d, sg = ch < 4 ? (d ? 3 - ch : ch) : 4 + (d ? 63 - (ch - 4) : ch - 4);
                ((float*)(F.ws + WS_GDEC))[chain * 68 + sg] = eg[d * 64 + 63]; }
        }
    }
}

__device__ __forceinline__ void phase_gdn_scan(Frame& F, int first_wg) {
    const int chain = F.bid - first_wg; if (chain < 0 || chain >= 32) return;
    const int b = chain >> 3, hh = (chain >> 1) & 3, d = chain & 1;
    const unsigned char* src = F.ws + WS_GCH + (size_t)chain * GCH_CHAIN;
    const float* decs = (const float*)(F.ws + WS_GDEC) + chain * 68;
    float* OUT = (float*)(F.ws + WS_R1 + R1_OG) + (size_t)d * M * 256;
    LAS unsigned char* ring = F.lds;
    const int lane = F.lane, w = F.wave;
    if (w >= 4) {
        const int dw = w - 4;
#define GS_ISSUE(step) do { _Pragma("unroll") for (int k = 0; k < 10; ++k) { const int p = dw * 10 + k; \
            __builtin_amdgcn_global_load_lds((const unsigned*)(src + (size_t)(step) * GCH_STEP + p * 1024 + lane * 16), (LAS unsigned*)(ring + ((step) % 3) * 40960 + p * 1024), 16, 0, 0); } } while (0)
        GS_ISSUE(0); GS_ISSUE(1);
        asm volatile("s_waitcnt vmcnt(10)" ::: "memory"); __builtin_amdgcn_s_barrier();
        for (int n = 0; n < 68; ++n) {
            if (n + 2 < 68) { GS_ISSUE(n + 2); asm volatile("s_waitcnt vmcnt(10)" ::: "memory"); }
            else asm volatile("s_waitcnt vmcnt(0)" ::: "memory");
            __builtin_amdgcn_s_barrier();
        }
#undef GS_ISSUE
    } else {
        const int sl = w, qq = lane >> 4, cc = lane & 15;
        f32x4 S[4];
#pragma unroll
        for (int rt = 0; rt < 4; ++rt) S[rt] = (f32x4){0.f, 0.f, 0.f, 0.f};
        const float dv0 = decs[lane], dv1 = decs[64 + (lane & 3)];
        asm volatile("s_waitcnt vmcnt(0)" ::: "memory"); __builtin_amdgcn_s_barrier(); asm volatile("" ::: "memory");
        for (int n = 0; n < 68; ++n) {
            const LAS unsigned char* base = ring + (n % 3) * 40960;
            const float dec = n < 64 ? __shfl(dv0, n) : __shfl(dv1, n - 64);
#define GS_FRAG(mat, rt, ks) (*(const LAS bf16x8*)(base + (mat) * 8192 + (((rt) * 2 + (ks)) * 64 + lane) * 16))
            bf16x8 BS[2], BV[2];
#pragma unroll
            for (int ks = 0; ks < 2; ++ks) { u32x4 t; t.x = cvtpk(S[2 * ks][0], S[2 * ks][1]); t.y = cvtpk(S[2 * ks][2], S[2 * ks][3]); t.z = cvtpk(S[2 * ks + 1][0], S[2 * ks + 1][1]); t.w = cvtpk(S[2 * ks + 1][2], S[2 * ks + 1][3]); BS[ks] = __builtin_bit_cast(bf16x8, t); }
            f32x4 vn[4], o[4];
#pragma unroll
            for (int rt = 0; rt < 4; ++rt) { f32x4 acc = (f32x4){0.f, 0.f, 0.f, 0.f};
#pragma unroll
                for (int ks = 0; ks < 2; ++ks) acc = mfma16(GS_FRAG(0, rt, ks), BS[ks], acc);
                const u32x2 uu = *(const LAS u32x2*)(base + 32768 + ((sl * 4 + rt) * 64 + lane) * 8);
                vn[rt] = (f32x4){__uint_as_float(uu.x << 16), __uint_as_float(uu.x & 0xffff0000u), __uint_as_float(uu.y << 16), __uint_as_float(uu.y & 0xffff0000u)} - acc;
                f32x4 oo = (f32x4){0.f, 0.f, 0.f, 0.f};
#pragma unroll
                for (int ks = 0; ks < 2; ++ks) oo = mfma16(GS_FRAG(1, rt, ks), BS[ks], oo);
                o[rt] = oo; }
#pragma unroll
            for (int ks = 0; ks < 2; ++ks) { u32x4 t; t.x = cvtpk(vn[2 * ks][0], vn[2 * ks][1]); t.y = cvtpk(vn[2 * ks][2], vn[2 * ks][3]); t.z = cvtpk(vn[2 * ks + 1][0], vn[2 * ks + 1][1]); t.w = cvtpk(vn[2 * ks + 1][2], vn[2 * ks + 1][3]); BV[ks] = __builtin_bit_cast(bf16x8, t); }
#pragma unroll
            for (int rt = 0; rt < 4; ++rt) { f32x4 oo = o[rt], sn = S[rt] * dec;
#pragma unroll
                for (int ks = 0; ks < 2; ++ks) { oo = mfma16(GS_FRAG(2, rt, ks), BV[ks], oo); sn = mfma16(GS_FRAG(3, rt, ks), BV[ks], sn); }
                o[rt] = oo; S[rt] = sn; }
#undef GS_FRAG
            const int m0 = n < 4 ? b * TC + 64 * (d ? 3 - n : n) : MC + b * TL + 64 * (d ? 63 - (n - 4) : n - 4);
#pragma unroll
            for (int rt = 0; rt < 4; ++rt)
#pragma unroll
                for (int r = 0; r < 4; ++r) { const int i = 16 * rt + 4 * qq + r, tok = d ? 63 - i : i; OUT[(size_t)(m0 + tok) * 256 + hh * 64 + 16 * sl + cc] = o[rt][r]; }
            asm volatile("s_waitcnt lgkmcnt(0)" ::: "memory"); PB(11); __builtin_amdgcn_s_barrier(); PE(11); asm volatile("" ::: "memory");
        }
    }
}


__device__ __forceinline__ void phase_gdn_local2(Frame& F) {
    unsigned char* prep = F.ws + WS_R1 + R1_PREP;
    const bf16* GD = (const bf16*)(prep + PREP_GD); const float* GB = (const float*)(F.ws + WS_GB);
    LAS bf16* Ks = (LAS bf16*)F.lds; LAS bf16* Vs = Ks + 64 * 72;
    LAS float* At = (LAS float*)(F.lds + 18432);
    LAS bf16* XS_ = (LAS bf16*)(F.lds + 51200);
    LAS float* sm = (LAS float*)(F.lds + 88064);
    LAS float* gl = sm; LAS float* bl = sm + 128; LAS float* gcs = sm + 256; LAS float* eg = sm + 384; LAS float* ekd = sm + 512;
    const int lane = F.lane, c = lane & 15, q = lane >> 4, w = F.wave, tid = F.tid;
    for (int uu = F.bid; uu < 16 * 68; uu += F.G) {
        const int bh = uu / 68, ch = uu % 68, b = bh >> 2, hh = bh & 3;
        const int m0 = ch < 4 ? b * TC + 64 * ch : MC + b * TL + 64 * (ch - 4);
        __syncthreads();
        { const int row = tid >> 3, col8 = (tid & 7) * 8; const bf16* src = GD + (size_t)(m0 + row) * 768 + hh * 64 + col8;
          *(LAS u32x4*)(Ks + row * 72 + col8) = *(const u32x4*)(src + 256); *(LAS u32x4*)(Vs + row * 72 + col8) = *(const u32x4*)(src + 512);
          if (tid < 256) { const int tok = tid & 63, which = tid >> 6; sm[which * 64 + tok] = GB[(size_t)(m0 + tok) * 16 + (which >> 1) * 8 + (which & 1) * 4 + hh]; } }
        __syncthreads();
        if (w < 2) { const int d = w; const int tok = d ? 63 - lane : lane; float v = gl[d * 64 + tok];
#pragma unroll
            for (int o = 1; o < 64; o <<= 1) { const float t = __shfl_up(v, o); if (lane >= o) v += t; }
            const float last = __shfl(v, 63);
            gcs[d * 64 + lane] = v; eg[d * 64 + lane] = fexp(v); ekd[d * 64 + lane] = fexp(last - v);
            ((float*)(F.ws + WS_GCS))[((size_t)uu * 2 + d) * 64 + tok] = v; }
        __syncthreads();
        {
            const int ti = w & 3, th = w >> 2;
            bf16x8 a[2];
#pragma unroll
            for (int ks = 0; ks < 2; ++ks) a[ks] = *(const LAS bf16x8*)(Ks + (16 * ti + c) * 72 + 32 * ks + 8 * q);
#pragma unroll
            for (int t2 = 0; t2 < 2; ++t2) { const int tj = 2 * th + t2; f32x4 acc = (f32x4){0.f, 0.f, 0.f, 0.f};
#pragma unroll
                for (int ks = 0; ks < 2; ++ks) acc = mfma16(a[ks], *(const LAS bf16x8*)(Ks + (16 * tj + c) * 72 + 32 * ks + 8 * q), acc);
#pragma unroll
                for (int r = 0; r < 4; ++r) { const int it = 16 * ti + 4 * q + r, jt = 16 * tj + c;
#pragma unroll
                    for (int d = 0; d < 2; ++d) { const int i = d ? 63 - it : it, j = d ? 63 - jt : jt;
                        const float e = fexp(fminf(gcs[d * 64 + i] - gcs[d * 64 + j], 0.f));
                        At[d * 4096 + j * 64 + i] = (j < i) ? bl[d * 64 + it] * acc[r] * e : 0.f; } } }
        }
        __syncthreads();
        if (w < 4) {
            const int d = w >> 1, kind = w & 1; const LAS bf16* R = kind ? Ks : Vs; const LAS float* A = At + d * 4096;
            float x[64];
#pragma unroll
            for (int i = 0; i < 64; ++i) { const int tok = d ? 63 - i : i; float v = bl[d * 64 + tok] * bf2f(R[tok * 72 + lane]); if (kind) v *= eg[d * 64 + i]; x[i] = v; }
#pragma unroll
            for (int j = 0; j < 63; ++j) { const float xj = x[j];
                f32x4 ca[16];
#pragma unroll
                for (int g = ((j + 1) >> 2); g < 16; ++g) ca[g] = *(const LAS f32x4*)(A + j * 64 + 4 * g);
                __builtin_amdgcn_sched_barrier(0);
#pragma unroll
                for (int g = ((j + 1) >> 2); g < 16; ++g) { x[4 * g] -= ca[g].x * xj; x[4 * g + 1] -= ca[g].y * xj; x[4 * g + 2] -= ca[g].z * xj; x[4 * g + 3] -= ca[g].w * xj; }
                __builtin_amdgcn_sched_barrier(0); }
            LAS bf16* XO = XS_ + (d * 2 + kind) * 4608;
#pragma unroll
            for (int i = 0; i < 64; ++i) XO[i * 72 + lane] = (bf16)f2bf(x[i]);
        } else {
            const int t2 = tid - 256;
            for (int it = t2; it < 2 * 512; it += 256) { const int d = it >> 9, chk = it & 511;
                const int rt = chk >> 7, ks = (chk >> 6) & 1, ln = chk & 63, r = ln & 15, qq = ln >> 4, row = 16 * rt + r, c0 = 32 * ks + 4 * qq;
                float v[8];
#pragma unroll
                for (int x8 = 0; x8 < 8; ++x8) { const int tok = c0 + (x8 & 3) + 16 * (x8 >> 2); const int i = d ? 63 - tok : tok; v[x8] = bf2f(Ks[tok * 72 + row]) * ekd[d * 64 + i]; }
                const int chain = bh * 2 + d, sg = ch < 4 ? (d ? 3 - ch : ch) : 4 + (d ? 63 - (ch - 4) : ch - 4);
                unsigned char* dst = F.ws + WS_GCH + (size_t)chain * G2_CHAIN + (size_t)sg * G2_STEP + 8192;
                u32x4 o; o.x = cvtpk(v[0], v[1]); o.y = cvtpk(v[2], v[3]); o.z = cvtpk(v[4], v[5]); o.w = cvtpk(v[6], v[7]);
                *(u32x4*)(dst + chk * 16) = o; }
        }
        __syncthreads();
        {
            for (int it = tid; it < 2 * 512; it += NTHR) { const int d = it >> 9, chk = it & 511;
                const int rt = chk >> 7, ks = (chk >> 6) & 1, ln = chk & 63, r = ln & 15, qq = ln >> 4, row = 16 * rt + r, c0 = 32 * ks + 4 * qq;
                const LAS bf16* XW = XS_ + (d * 2 + 1) * 4608;
                const int prow = d ? 63 - row : row;
                const u32x2 lo = *(const LAS u32x2*)(XW + prow * 72 + c0), hi = *(const LAS u32x2*)(XW + prow * 72 + c0 + 16);
                const int chain = bh * 2 + d, sg = ch < 4 ? (d ? 3 - ch : ch) : 4 + (d ? 63 - (ch - 4) : ch - 4);
                unsigned char* dst = F.ws + WS_GCH + (size_t)chain * G2_CHAIN + (size_t)sg * G2_STEP;
                *(u32x4*)(dst + chk * 16) = (u32x4){lo.x, lo.y, hi.x, hi.y}; }
            for (int it = tid; it < 2 * 1024; it += NTHR) { const int d = it >> 10, cu = it & 1023;
                const int sl = cu >> 8, rt = (cu >> 6) & 3, ln = cu & 63, qq = ln >> 4, cc = ln & 15;
                const LAS bf16* XU = XS_ + (d * 2) * 4608;
                const int tr = 16 * rt + 4 * qq, p0 = d ? 63 - tr : tr, ps = d ? -1 : 1;
                bf16 e0 = XU[(p0) * 72 + 16 * sl + cc], e1 = XU[(p0 + ps) * 72 + 16 * sl + cc], e2 = XU[(p0 + 2 * ps) * 72 + 16 * sl + cc], e3 = XU[(p0 + 3 * ps) * 72 + 16 * sl + cc];
                const int chain = bh * 2 + d, sg = ch < 4 ? (d ? 3 - ch : ch) : 4 + (d ? 63 - (ch - 4) : ch - 4);
                unsigned char* dst = F.ws + WS_GCH + (size_t)chain * G2_CHAIN + (size_t)sg * G2_STEP + 16384;
                *(u32x2*)(dst + cu * 8) = (u32x2){(unsigned)e0 | ((unsigned)e1 << 16), (unsigned)e2 | ((unsigned)e3 << 16)}; }
            if (tid < 2) { const int d = tid; const int chain = bh * 2 + d, sg = ch < 4 ? (d ? 3 - ch : ch) : 4 + (d ? 63 - (ch - 4) : ch - 4);
                ((float*)(F.ws + WS_GDEC))[chain * 68 + sg] = eg[d * 64 + 63]; }
        }
    }
}


__device__ __forceinline__ void phase_gdn_local3(Frame& F, int layer) {
    unsigned char* prep = F.ws + WS_R1 + R1_PREP;
    const bf16* GD = (const bf16*)(prep + PREP_GD); const float* GB = (const float*)(F.ws + WS_GB);
    const int lane = F.lane, c = lane & 15, q = lane >> 4, w = F.wave, half = w >> 2, wq = w & 3, t2 = F.tid & 255;
    LAS unsigned char* L0 = F.lds + half * 54272;
    LAS bf16* Ks = (LAS bf16*)L0; LAS bf16* Vs = Ks + 64 * 72;
    LAS float* At = (LAS float*)(L0 + 18432);
    LAS bf16* XS_ = (LAS bf16*)(L0 + 18432);
    LAS float* sm = (LAS float*)(L0 + 51200);
    LAS float* gl = sm; LAS float* bl = sm + 128; LAS float* gcs = sm + 256; LAS float* eg = sm + 384; LAS float* ekd = sm + 512;
    DynQ dq = dyn_make(F, layer, 0);
    for (int pp = dyn_bcast(dq, dyn_grab(dq)); pp < 8 * 68; ) {
        const int pp_next = dyn_grab(dq);
        const int uu = 2 * pp + half, bh = uu / 68, ch = uu % 68, b = bh >> 2, hh = bh & 3;
        const int m0 = ch < 4 ? b * TC + 64 * ch : MC + b * TL + 64 * (ch - 4);
        __syncthreads();
#pragma unroll
        for (int rep = 0; rep < 2; ++rep) { const int idx = t2 + 256 * rep, row = idx >> 3, col8 = (idx & 7) * 8; const bf16* src = GD + (size_t)(m0 + row) * 768 + hh * 64 + col8;
            *(LAS u32x4*)(Ks + row * 72 + col8) = *(const u32x4*)(src + 256); *(LAS u32x4*)(Vs + row * 72 + col8) = *(const u32x4*)(src + 512); }
        { const int tok = t2 & 63, which = t2 >> 6; sm[which * 64 + tok] = GB[(size_t)(m0 + tok) * 16 + (which >> 1) * 8 + (which & 1) * 4 + hh]; }
        __syncthreads();
        if (wq < 2) { const int d = wq; const int tok = d ? 63 - lane : lane; float v = gl[d * 64 + tok];
#pragma unroll
            for (int o = 1; o < 64; o <<= 1) { const float t = __shfl_up(v, o); if (lane >= o) v += t; }
            const float last = __shfl(v, 63);
            gcs[d * 64 + lane] = v; eg[d * 64 + lane] = fexp(v); ekd[d * 64 + lane] = fexp(last - v);
            ((float*)(F.ws + WS_GCS))[((size_t)uu * 2 + d) * 64 + tok] = v; }
        __syncthreads();
        {
            const int ti = wq;
            bf16x8 a[2];
#pragma unroll
            for (int ks = 0; ks < 2; ++ks) a[ks] = *(const LAS bf16x8*)(Ks + (16 * ti + c) * 72 + 32 * ks + 8 * q);
#pragma unroll
            for (int tj = 0; tj < 4; ++tj) { f32x4 acc = (f32x4){0.f, 0.f, 0.f, 0.f};
#pragma unroll
                for (int ks = 0; ks < 2; ++ks) acc = mfma16(a[ks], *(const LAS bf16x8*)(Ks + (16 * tj + c) * 72 + 32 * ks + 8 * q), acc);
#pragma unroll
                for (int r = 0; r < 4; ++r) { const int it = 16 * ti + 4 * q + r, jt = 16 * tj + c;
#pragma unroll
                    for (int d = 0; d < 2; ++d) { const int i = d ? 63 - it : it, j = d ? 63 - jt : jt;
                        const float e = fexp(fminf(gcs[d * 64 + i] - gcs[d * 64 + j], 0.f));
                        At[d * 4096 + j * 64 + i] = (j < i) ? bl[d * 64 + it] * acc[r] * e : 0.f; } } }
        }
        __syncthreads();
        float x[64];
        const int sd = wq >> 1, kind = wq & 1;
        {
            const LAS bf16* R = kind ? Ks : Vs; const LAS float* A = At + sd * 4096;
#pragma unroll
            for (int i = 0; i < 64; ++i) { const int tok = sd ? 63 - i : i; float v = bl[sd * 64 + tok] * bf2f(R[tok * 72 + lane]); if (kind) v *= eg[sd * 64 + i]; x[i] = v; }
#pragma unroll
            for (int j = 0; j < 63; ++j) { const float xj = x[j];
                f32x4 ca[16];
#pragma unroll
                for (int g = ((j + 1) >> 2); g < 16; ++g) ca[g] = *(const LAS f32x4*)(A + j * 64 + 4 * g);
                __builtin_amdgcn_sched_barrier(0);
#pragma unroll
                for (int g = ((j + 1) >> 2); g < 16; ++g) { x[4 * g] -= ca[g].x * xj; x[4 * g + 1] -= ca[g].y * xj; x[4 * g + 2] -= ca[g].z * xj; x[4 * g + 3] -= ca[g].w * xj; }
                __builtin_amdgcn_sched_barrier(0); }
        }
        __syncthreads();
        { LAS bf16* XO = XS_ + (sd * 2 + kind) * 4096;
#pragma unroll
          for (int i = 0; i < 64; ++i) XO[(sd ? 63 - i : i) * 64 + lane] = (bf16)f2bf(x[i]); }
        __syncthreads();
        {
            for (int it = t2; it < 2 * 512; it += 256) { const int d = it >> 9, chk = it & 511;
                const int rt = chk >> 7, ks = (chk >> 6) & 1, ln = chk & 63, r = ln & 15, qq = ln >> 4, row = 16 * rt + r, c0 = 32 * ks + 4 * qq;
                const int chain = bh * 2 + d, sg = ch < 4 ? (d ? 3 - ch : ch) : 4 + (d ? 63 - (ch - 4) : ch - 4);
                unsigned char* dst = F.ws + WS_GCH + (size_t)chain * G2_CHAIN + (size_t)sg * G2_STEP;
                const LAS bf16* XW = XS_ + (d * 2 + 1) * 4096;
                const u32x2 lo = *(const LAS u32x2*)(XW + row * 64 + c0), hi = *(const LAS u32x2*)(XW + row * 64 + c0 + 16);
                *(u32x4*)(dst + chk * 16) = (u32x4){lo.x, lo.y, hi.x, hi.y};
                float v[8];
#pragma unroll
                for (int x8 = 0; x8 < 8; ++x8) { const int tok = c0 + (x8 & 3) + 16 * (x8 >> 2); const int i = d ? 63 - tok : tok; v[x8] = bf2f(Ks[tok * 72 + row]) * ekd[d * 64 + i]; }
                u32x4 o; o.x = cvtpk(v[0], v[1]); o.y = cvtpk(v[2], v[3]); o.z = cvtpk(v[4], v[5]); o.w = cvtpk(v[6], v[7]);
                *(u32x4*)(dst + 8192 + chk * 16) = o; }
            for (int it = t2; it < 2 * 1024; it += 256) { const int d = it >> 10, cu = it & 1023;
                const int sl = cu >> 8, rt = (cu >> 6) & 3, ln = cu & 63, qq = ln >> 4, cc = ln & 15;
                const LAS bf16* XU = XS_ + (d * 2) * 4096; const int tr = 16 * rt + 4 * qq;
                const bf16 e0 = XU[(tr) * 64 + 16 * sl + cc], e1 = XU[(tr + 1) * 64 + 16 * sl + cc], e2 = XU[(tr + 2) * 64 + 16 * sl + cc], e3 = XU[(tr + 3) * 64 + 16 * sl + cc];
                const int chain = bh * 2 + d, sg = ch < 4 ? (d ? 3 - ch : ch) : 4 + (d ? 63 - (ch - 4) : ch - 4);
                unsigned char* dst = F.ws + WS_GCH + (size_t)chain * G2_CHAIN + (size_t)sg * G2_STEP + 16384;
                *(u32x2*)(dst + cu * 8) = (u32x2){(unsigned)e0 | ((unsigned)e1 << 16), (unsigned)e2 | ((unsigned)e3 << 16)}; }
            if (t2 < 2) { const int d = t2; const int chain = bh * 2 + d, sg = ch < 4 ? (d ? 3 - ch : ch) : 4 + (d ? 63 - (ch - 4) : ch - 4);
                ((float*)(F.ws + WS_GDEC))[chain * 68 + sg] = eg[d * 64 + 63]; }
        }
        pp = dyn_bcast(dq, pp_next);
    }
}

__device__ __forceinline__ void phase_gdn_scan2(Frame& F, int first_wg) {
    const int chain = F.bid - first_wg; if (chain < 0 || chain >= 32) return;
    const int d = chain & 1;
    const unsigned char* src = F.ws + WS_GCH + (size_t)chain * G2_CHAIN;
    const float* decs = (const float*)(F.ws + WS_GDEC) + chain * 68;
    bf16* GST = (bf16*)(F.ws + WS_GST) + (size_t)chain * 68 * 8192;
    LAS unsigned char* ring = F.lds;
    const int lane = F.lane, w = F.wave;
    if (w >= 2) {
        const int dw = w - 2;
#define GS2_ISSUE(step) do { _Pragma("unroll") for (int k = 0; k < 4; ++k) { const int p = dw * 4 + k; \
            __builtin_amdgcn_global_load_lds((const unsigned*)(src + (size_t)(step) * G2_STEP + p * 1024 + lane * 16), (LAS unsigned*)(ring + ((step) & 3) * 24576 + p * 1024), 16, 0, 0); } } while (0)
        GS2_ISSUE(0); GS2_ISSUE(1); GS2_ISSUE(2);
        asm volatile("s_waitcnt vmcnt(8)" ::: "memory"); __builtin_amdgcn_s_barrier();
        for (int n = 0; n < 68; ++n) {
            if (n + 3 < 68) { GS2_ISSUE(n + 3); asm volatile("s_waitcnt vmcnt(8)" ::: "memory"); }
            else if (n + 2 < 68) asm volatile("s_waitcnt vmcnt(4)" ::: "memory");
            else asm volatile("s_waitcnt vmcnt(0)" ::: "memory");
            __builtin_amdgcn_s_barrier();
        }
#undef GS2_ISSUE
    } else {
        const int qq = lane >> 4, cc = lane & 15;
        f32x4 S[2][4];
#pragma unroll
        for (int ct = 0; ct < 2; ++ct)
#pragma unroll
            for (int rt = 0; rt < 4; ++rt) S[ct][rt] = (f32x4){0.f, 0.f, 0.f, 0.f};
        const float dv0 = decs[lane], dv1 = decs[64 + (lane & 3)];
        asm volatile("s_waitcnt vmcnt(0)" ::: "memory"); __builtin_amdgcn_s_barrier(); asm volatile("" ::: "memory");
        for (int n = 0; n < 68; ++n) {
            const LAS unsigned char* base = ring + (n & 3) * 24576;
            const float dec = n < 64 ? __shfl(dv0, n) : __shfl(dv1, n - 64);
            bf16* st = GST + (size_t)n * 8192;
            bf16* vt = st + 4096;
#define GS2_FRAG(mat, rt, ks) (*(const LAS bf16x8*)(base + (mat) * 8192 + (((rt) * 2 + (ks)) * 64 + lane) * 16))
            bf16x8 wf[4][2], kf[4][2]; u32x2 uf[2][4];
#pragma unroll
            for (int rt = 0; rt < 4; ++rt) { wf[rt][0] = GS2_FRAG(0, rt, 0); wf[rt][1] = GS2_FRAG(0, rt, 1); }
#pragma unroll
            for (int ct = 0; ct < 2; ++ct)
#pragma unroll
                for (int rt = 0; rt < 4; ++rt) uf[ct][rt] = *(const LAS u32x2*)(base + 16384 + (((2 * w + ct) * 4 + rt) * 64 + lane) * 8);
#pragma unroll
            for (int rt = 0; rt < 4; ++rt) { kf[rt][0] = GS2_FRAG(1, rt, 0); kf[rt][1] = GS2_FRAG(1, rt, 1); }
            __builtin_amdgcn_sched_barrier(0);
            bf16x8 BS[2][2], BV[2][2];
#pragma unroll
            for (int ct = 0; ct < 2; ++ct) { const int e = 32 * w + 16 * ct + cc;
#pragma unroll
                for (int ks = 0; ks < 2; ++ks) { u32x4 t; t.x = cvtpk(S[ct][2 * ks][0], S[ct][2 * ks][1]); t.y = cvtpk(S[ct][2 * ks][2], S[ct][2 * ks][3]); t.z = cvtpk(S[ct][2 * ks + 1][0], S[ct][2 * ks + 1][1]); t.w = cvtpk(S[ct][2 * ks + 1][2], S[ct][2 * ks + 1][3]);
                    BS[ct][ks] = __builtin_bit_cast(bf16x8, t);
                    *(u32x2*)(st + e * 64 + 32 * ks + 4 * qq) = (u32x2){t.x, t.y}; *(u32x2*)(st + e * 64 + 32 * ks + 16 + 4 * qq) = (u32x2){t.z, t.w}; } }
            f32x4 vn[2][4];
#pragma unroll
            for (int ks = 0; ks < 2; ++ks)
#pragma unroll
                for (int rt = 0; rt < 4; ++rt)
#pragma unroll
                    for (int ct = 0; ct < 2; ++ct) vn[ct][rt] = mfma16(wf[rt][ks], BS[ct][ks], ks ? vn[ct][rt] : (f32x4){0.f, 0.f, 0.f, 0.f});
#pragma unroll
            for (int ct = 0; ct < 2; ++ct)
#pragma unroll
                for (int rt = 0; rt < 4; ++rt) { const u32x2 uu = uf[ct][rt];
                    vn[ct][rt] = (f32x4){__uint_as_float(uu.x << 16), __uint_as_float(uu.x & 0xffff0000u), __uint_as_float(uu.y << 16), __uint_as_float(uu.y & 0xffff0000u)} - vn[ct][rt]; }
#pragma unroll
            for (int ct = 0; ct < 2; ++ct) { const int e = 32 * w + 16 * ct + cc;
#pragma unroll
                for (int ks = 0; ks < 2; ++ks) { u32x4 t; t.x = cvtpk(vn[ct][2 * ks][0], vn[ct][2 * ks][1]); t.y = cvtpk(vn[ct][2 * ks][2], vn[ct][2 * ks][3]); t.z = cvtpk(vn[ct][2 * ks + 1][0], vn[ct][2 * ks + 1][1]); t.w = cvtpk(vn[ct][2 * ks + 1][2], vn[ct][2 * ks + 1][3]);
                    BV[ct][ks] = __builtin_bit_cast(bf16x8, t);
                    if (d == 0) { *(u32x2*)(vt + e * 64 + 32 * ks + 4 * qq) = (u32x2){t.x, t.y}; *(u32x2*)(vt + e * 64 + 32 * ks + 16 + 4 * qq) = (u32x2){t.z, t.w}; }
                    else { const u32x2 r0 = (u32x2){(t.y >> 16) | (t.y << 16), (t.x >> 16) | (t.x << 16)}, r1 = (u32x2){(t.w >> 16) | (t.w << 16), (t.z >> 16) | (t.z << 16)};
                        *(u32x2*)(vt + e * 64 + 60 - 32 * ks - 4 * qq) = r0; *(u32x2*)(vt + e * 64 + 44 - 32 * ks - 4 * qq) = r1; } } }
#pragma unroll
            for (int ct = 0; ct < 2; ++ct)
#pragma unroll
                for (int rt = 0; rt < 4; ++rt) S[ct][rt] = S[ct][rt] * dec;
#pragma unroll
            for (int ks = 0; ks < 2; ++ks)
#pragma unroll
                for (int rt = 0; rt < 4; ++rt)
#pragma unroll
                    for (int ct = 0; ct < 2; ++ct) S[ct][rt] = mfma16(kf[rt][ks], BV[ct][ks], S[ct][rt]);
#undef GS2_FRAG
            asm volatile("s_waitcnt lgkmcnt(0)" ::: "memory"); __builtin_amdgcn_s_barrier(); asm volatile("" ::: "memory");
        }
    }
}

__device__ __forceinline__ void phase_gdn_out(Frame& F, const Inputs& in, int layer) {
    const bf16* P = (const bf16*)(F.ws + WS_R1 + R1_P);
    const bf16* GD = (const bf16*)(F.ws + WS_R1 + R1_PREP + PREP_GD);
    const bf16* GST = (const bf16*)(F.ws + WS_GST); const float* GCS = (const float*)(F.ws + WS_GCS);
    bf16* O = (bf16*)(F.ws + WS_R1 + R1_O);
    const int lane = F.lane, c = lane & 15, q = lane >> 4, w = F.wave, half = w >> 2, ti = w & 3, t2 = F.tid & 255;
    LAS bf16* Qs = (LAS bf16*)(F.lds + half * 56320); LAS bf16* Ks = Qs + 4608; LAS bf16* St = Ks + 4608; LAS bf16* Vn = St + 2 * 4608;
    LAS float* gT = (LAS float*)(F.lds + half * 56320 + 55296);
    for (int pp = F.bid; pp < 8 * 68; pp += F.G) {
        const int uu = 2 * pp + half, bh = uu / 68, ch = uu % 68, b = bh >> 2, hh = bh & 3;
        const int m0 = ch < 4 ? b * TC + 64 * ch : MC + b * TL + 64 * (ch - 4);
        __syncthreads();
#pragma unroll
        for (int rep = 0; rep < 2; ++rep) { const int idx = t2 + 256 * rep, row = idx >> 3, col8 = (idx & 7) * 8;
            const bf16* src = GD + (size_t)(m0 + row) * 768 + hh * 64 + col8;
            *(LAS u32x4*)(Qs + row * 72 + col8) = *(const u32x4*)(src); *(LAS u32x4*)(Ks + row * 72 + col8) = *(const u32x4*)(src + 256);
#pragma unroll
            for (int d = 0; d < 2; ++d) { const int sg = ch < 4 ? (d ? 3 - ch : ch) : 4 + (d ? 63 - (ch - 4) : ch - 4);
                const bf16* g = GST + ((size_t)(bh * 2 + d) * 68 + sg) * 8192 + row * 64 + col8;
                *(LAS u32x4*)(St + d * 4608 + row * 72 + col8) = *(const u32x4*)(g); *(LAS u32x4*)(Vn + d * 4608 + row * 72 + col8) = *(const u32x4*)(g + 4096); } }
        if (t2 < 128) gT[t2] = GCS[(size_t)uu * 128 + t2];
        __syncthreads();
        bf16x8 qf[2];
#pragma unroll
        for (int ks = 0; ks < 2; ++ks) qf[ks] = *(const LAS bf16x8*)(Qs + (16 * ti + c) * 72 + 32 * ks + 8 * q);
        const int i = 16 * ti + c;
        const float gi0 = gT[i], gi1 = gT[64 + i];
        f32x4 sacc[4];
#pragma unroll
        for (int tj = 0; tj < 4; ++tj) { f32x4 acc = (f32x4){0.f, 0.f, 0.f, 0.f};
#pragma unroll
            for (int ks = 0; ks < 2; ++ks) acc = mfma16(*(const LAS bf16x8*)(Ks + (16 * tj + c) * 72 + 32 * ks + 8 * q), qf[ks], acc);
            sacc[tj] = acc; }
        bf16x8 pb[2][2];
#pragma unroll
        for (int d = 0; d < 2; ++d) { f32x4 p[4];
#pragma unroll
            for (int tj = 0; tj < 4; ++tj) { const f32x4 gj = *(const LAS f32x4*)(gT + d * 64 + 16 * tj + 4 * q);
#pragma unroll
                for (int r = 0; r < 4; ++r) { const int j = 16 * tj + 4 * q + r; const bool ok = d ? (j >= i) : (j <= i);
                    p[tj][r] = ok ? sacc[tj][r] * fexp(fminf((d ? gi1 : gi0) - gj[r], 0.f)) : 0.f; } }
#pragma unroll
            for (int ks2 = 0; ks2 < 2; ++ks2) { u32x4 t; t.x = cvtpk(p[2 * ks2][0], p[2 * ks2][1]); t.y = cvtpk(p[2 * ks2][2], p[2 * ks2][3]); t.z = cvtpk(p[2 * ks2 + 1][0], p[2 * ks2 + 1][1]); t.w = cvtpk(p[2 * ks2 + 1][2], p[2 * ks2 + 1][3]); pb[d][ks2] = __builtin_bit_cast(bf16x8, t); } }
        const float sc0 = fexp(gi0), sc1 = fexp(gi1);
        f32x4 o[4]; float ssq = 0.f;
#pragma unroll
        for (int te = 0; te < 4; ++te) { f32x4 acc = (f32x4){0.f, 0.f, 0.f, 0.f}, t0 = acc, t1 = acc;
#pragma unroll
            for (int d = 0; d < 2; ++d)
#pragma unroll
                for (int ks2 = 0; ks2 < 2; ++ks2) { const u32x2 lo = *(const LAS u32x2*)(Vn + d * 4608 + (16 * te + c) * 72 + 32 * ks2 + 4 * q), hi = *(const LAS u32x2*)(Vn + d * 4608 + (16 * te + c) * 72 + 32 * ks2 + 16 + 4 * q);
                    acc = mfma16(__builtin_bit_cast(bf16x8, ((u32x4){lo.x, lo.y, hi.x, hi.y})), pb[d][ks2], acc); }
#pragma unroll
            for (int ks = 0; ks < 2; ++ks) { t0 = mfma16(*(const LAS bf16x8*)(St + (16 * te + c) * 72 + 32 * ks + 8 * q), qf[ks], t0);
                t1 = mfma16(*(const LAS bf16x8*)(St + 4608 + (16 * te + c) * 72 + 32 * ks + 8 * q), qf[ks], t1); }
            o[te] = acc + sc0 * t0 + sc1 * t1; ssq += (o[te][0] * o[te][0] + o[te][1] * o[te][1]) + (o[te][2] * o[te][2] + o[te][3] * o[te][3]); }
        ssq = quad_rows_sum(ssq);
        const float rs = 1.0f / sqrtf(ssq * (1.0f / 64.0f) + EPS);
#pragma unroll
        for (int te = 0; te < 4; ++te) { const int e0 = 16 * te + 4 * q;
            const u32x2 z2 = *(const u32x2*)(P + (size_t)(m0 + i) * NP + PC_GZ + hh * 64 + e0); const f32x4 gn = *(const f32x4*)(in.gdn_norm_g + layer * 64 + e0);
            const float z0 = __uint_as_float(z2.x << 16), z1 = __uint_as_float(z2.x & 0xffff0000u), z2f = __uint_as_float(z2.y << 16), z3 = __uint_as_float(z2.y & 0xffff0000u);
            u32x2 wv; wv.x = cvtpk(o[te][0] * rs * gn[0] * siluf(z0), o[te][1] * rs * gn[1] * siluf(z1)); wv.y = cvtpk(o[te][2] * rs * gn[2] * siluf(z2f), o[te][3] * rs * gn[3] * siluf(z3));
            *(u32x2*)(O + (size_t)(m0 + i) * D + 256 + hh * 64 + e0) = wv; }
    }
}


__device__ __forceinline__ void phase_gdn_scan3(Frame& F, int first_wg) {
    const int chain = F.bid - first_wg; if (chain < 0 || chain >= 32) return;
    const unsigned char* src = F.ws + WS_GCH + (size_t)chain * G2_CHAIN;
    const float* decs = (const float*)(F.ws + WS_GDEC) + chain * 68;
    unsigned char* GSTb = F.ws + WS_GST + (size_t)chain * 68 * 16384;
    LAS unsigned char* ring = F.lds;
    const int lane = F.lane, w = F.wave;
    if (w >= 4) {
        const int dw = w - 4;
#define GS3_ISSUE(step) do { _Pragma("unroll") for (int k = 0; k < 6; ++k) { const int p = dw * 6 + k; \
            __builtin_amdgcn_global_load_lds((const unsigned*)(src + (size_t)(step) * G2_STEP + p * 1024 + lane * 16), (LAS unsigned*)(ring + ((step) & 3) * 24576 + p * 1024), 16, 0, 0); } } while (0)
        GS3_ISSUE(0); GS3_ISSUE(1); GS3_ISSUE(2);
        asm volatile("s_waitcnt vmcnt(12)" ::: "memory"); __builtin_amdgcn_s_barrier();
        for (int n = 0; n < 68; ++n) {
            if (n + 3 < 68) { GS3_ISSUE(n + 3); asm volatile("s_waitcnt vmcnt(12)" ::: "memory"); }
            else if (n + 2 < 68) asm volatile("s_waitcnt vmcnt(6)" ::: "memory");
            else asm volatile("s_waitcnt vmcnt(0)" ::: "memory");
            __builtin_amdgcn_s_barrier();
        }
#undef GS3_ISSUE
    } else {
        const int sl = w;
        f32x4 S[4];
#pragma unroll
        for (int rt = 0; rt < 4; ++rt) S[rt] = (f32x4){0.f, 0.f, 0.f, 0.f};
        const float dv0 = decs[lane], dv1 = decs[64 + (lane & 3)];
        asm volatile("s_waitcnt vmcnt(0)" ::: "memory"); __builtin_amdgcn_s_barrier(); asm volatile("" ::: "memory");
        for (int n = 0; n < 68; ++n) {
            const LAS unsigned char* base = ring + (n & 3) * 24576;
            const float dec = n < 64 ? __shfl(dv0, n) : __shfl(dv1, n - 64);
            unsigned char* go = GSTb + (size_t)n * 16384 + (size_t)(sl * 2 * 64 + lane) * 16;
#define GS3_FRAG(mat, rt, ks) (*(const LAS bf16x8*)(base + (mat) * 8192 + (((rt) * 2 + (ks)) * 64 + lane) * 16))
            bf16x8 wf[4][2], kf[4][2]; u32x2 uf[4];
#pragma unroll
            for (int rt = 0; rt < 4; ++rt) { wf[rt][0] = GS3_FRAG(0, rt, 0); wf[rt][1] = GS3_FRAG(0, rt, 1); }
#pragma unroll
            for (int rt = 0; rt < 4; ++rt) uf[rt] = *(const LAS u32x2*)(base + 16384 + ((sl * 4 + rt) * 64 + lane) * 8);
#pragma unroll
            for (int rt = 0; rt < 4; ++rt) { kf[rt][0] = GS3_FRAG(1, rt, 0); kf[rt][1] = GS3_FRAG(1, rt, 1); }
#undef GS3_FRAG
            __builtin_amdgcn_sched_barrier(0);
            bf16x8 BS[2], BV[2];
#pragma unroll
            for (int ks = 0; ks < 2; ++ks) { u32x4 t; t.x = cvtpk(S[2 * ks][0], S[2 * ks][1]); t.y = cvtpk(S[2 * ks][2], S[2 * ks][3]); t.z = cvtpk(S[2 * ks + 1][0], S[2 * ks + 1][1]); t.w = cvtpk(S[2 * ks + 1][2], S[2 * ks + 1][3]);
                BS[ks] = __builtin_bit_cast(bf16x8, t); *(u32x4*)(go + ks * 1024) = t; }
            f32x4 vn[4];
#pragma unroll
            for (int ks = 0; ks < 2; ++ks)
#pragma unroll
                for (int rt = 0; rt < 4; ++rt) vn[rt] = mfma16(wf[rt][ks], BS[ks], ks ? vn[rt] : (f32x4){0.f, 0.f, 0.f, 0.f});
#pragma unroll
            for (int rt = 0; rt < 4; ++rt) { const u32x2 uu = uf[rt];
                vn[rt] = (f32x4){__uint_as_float(uu.x << 16), __uint_as_float(uu.x & 0xffff0000u), __uint_as_float(uu.y << 16), __uint_as_float(uu.y & 0xffff0000u)} - vn[rt]; }
#pragma unroll
            for (int ks = 0; ks < 2; ++ks) { u32x4 t; t.x = cvtpk(vn[2 * ks][0], vn[2 * ks][1]); t.y = cvtpk(vn[2 * ks][2], vn[2 * ks][3]); t.z = cvtpk(vn[2 * ks + 1][0], vn[2 * ks + 1][1]); t.w = cvtpk(vn[2 * ks + 1][2], vn[2 * ks + 1][3]);
                BV[ks] = __builtin_bit_cast(bf16x8, t); *(u32x4*)(go + 8192 + ks * 1024) = t; }
#pragma unroll
            for (int rt = 0; rt < 4; ++rt) S[rt] = S[rt] * dec;
#pragma unroll
            for (int ks = 0; ks < 2; ++ks)
#pragma unroll
                for (int rt = 0; rt < 4; ++rt) S[rt] = mfma16(kf[rt][ks], BV[ks], S[rt]);
            asm volatile("s_waitcnt lgkmcnt(0)" ::: "memory"); __builtin_amdgcn_s_barrier(); asm volatile("" ::: "memory");
        }
    }
}

__device__ __forceinline__ void phase_gdn_out2(Frame& F, const Inputs& in, int layer) {
    const bf16* P = (const bf16*)(F.ws + WS_R1 + R1_P);
    const bf16* GD = (const bf16*)(F.ws + WS_R1 + R1_PREP + PREP_GD);
    const unsigned char* GSTb = F.ws + WS_GST; const float* GCS = (const float*)(F.ws + WS_GCS);
    bf16* O = (bf16*)(F.ws + WS_R1 + R1_O);
    const int lane = F.lane, c = lane & 15, q = lane >> 4, w = F.wave, half = w >> 2, ti = w & 3, t2 = F.tid & 255;
    LAS bf16* Qs = (LAS bf16*)(F.lds + half * 56320); LAS bf16* Ks = Qs + 4608;
    LAS unsigned char* Fr = F.lds + half * 56320 + 18432;
    LAS float* gT = (LAS float*)(F.lds + half * 56320 + 55296);
    DynQ dq = dyn_make(F, layer, 4);
    for (int pp = dyn_bcast(dq, dyn_grab(dq)); pp < 8 * 68; ) {
        const int pp_next = dyn_grab(dq);
        const int uu = 2 * pp + half, bh = uu / 68, ch = uu % 68, b = bh >> 2, hh = bh & 3;
        const int m0 = ch < 4 ? b * TC + 64 * ch : MC + b * TL + 64 * (ch - 4);
        __syncthreads();
#pragma unroll
        for (int rep = 0; rep < 2; ++rep) { const int idx = t2 + 256 * rep, row = idx >> 3, col8 = (idx & 7) * 8;
            const bf16* src = GD + (size_t)(m0 + row) * 768 + hh * 64 + col8;
            *(LAS u32x4*)(Qs + row * 72 + col8) = *(const u32x4*)(src); *(LAS u32x4*)(Ks + row * 72 + col8) = *(const u32x4*)(src + 256); }
#pragma unroll
        for (int d = 0; d < 2; ++d) { const int sg = ch < 4 ? (d ? 3 - ch : ch) : 4 + (d ? 63 - (ch - 4) : ch - 4);
            const unsigned char* g = GSTb + ((size_t)(bh * 2 + d) * 68 + sg) * 16384;
#pragma unroll
            for (int rep = 0; rep < 4; ++rep) { const int idx = t2 + 256 * rep; *(LAS u32x4*)(Fr + d * 16384 + idx * 16) = *(const u32x4*)(g + (size_t)idx * 16); } }
        if (t2 < 128) gT[t2] = GCS[(size_t)uu * 128 + t2];
        __syncthreads();
        bf16x8 qf[2], qr[2];
#pragma unroll
        for (int ks = 0; ks < 2; ++ks) { qf[ks] = *(const LAS bf16x8*)(Qs + (16 * ti + c) * 72 + 32 * ks + 8 * q);
            const u32x2 lo = *(const LAS u32x2*)(Qs + (16 * ti + c) * 72 + 32 * ks + 4 * q), hi = *(const LAS u32x2*)(Qs + (16 * ti + c) * 72 + 32 * ks + 16 + 4 * q);
            qr[ks] = __builtin_bit_cast(bf16x8, ((u32x4){lo.x, lo.y, hi.x, hi.y})); }
        const int i = 16 * ti + c;
        const float gi0 = gT[i], gi1 = gT[64 + i];
        f32x4 sacc[4];
#pragma unroll
        for (int tj = 0; tj < 4; ++tj) { f32x4 acc = (f32x4){0.f, 0.f, 0.f, 0.f};
#pragma unroll
            for (int ks = 0; ks < 2; ++ks) acc = mfma16(*(const LAS bf16x8*)(Ks + (16 * tj + c) * 72 + 32 * ks + 8 * q), qf[ks], acc);
            sacc[tj] = acc; }
        bf16x8 pb[2][2];
#pragma unroll
        for (int d = 0; d < 2; ++d) { f32x4 p[4];
#pragma unroll
            for (int tj = 0; tj < 4; ++tj) { const f32x4 gj = *(const LAS f32x4*)(gT + d * 64 + 16 * tj + 4 * q);
#pragma unroll
                for (int r = 0; r < 4; ++r) { const int j = 16 * tj + 4 * q + r; const bool ok = d ? (j >= i) : (j <= i);
                    p[tj][r] = ok ? sacc[tj][r] * fexp(fminf((d ? gi1 : gi0) - gj[r], 0.f)) : 0.f; } }
#pragma unroll
            for (int ks2 = 0; ks2 < 2; ++ks2) { u32x4 t; t.x = cvtpk(p[2 * ks2][0], p[2 * ks2][1]); t.y = cvtpk(p[2 * ks2][2], p[2 * ks2][3]); t.z = cvtpk(p[2 * ks2 + 1][0], p[2 * ks2 + 1][1]); t.w = cvtpk(p[2 * ks2 + 1][2], p[2 * ks2 + 1][3]); pb[d][ks2] = __builtin_bit_cast(bf16x8, t); } }
        const float sc0 = fexp(gi0), sc1 = fexp(gi1);
        f32x4 o[4]; float ssq = 0.f;
#pragma unroll
        for (int te = 0; te < 4; ++te) { f32x4 acc = (f32x4){0.f, 0.f, 0.f, 0.f}, t0 = acc, t1 = acc;
#pragma unroll
            for (int ks = 0; ks < 2; ++ks) {
                acc = mfma16(*(const LAS bf16x8*)(Fr + 8192 + ((te * 2 + ks) * 64 + lane) * 16), pb[0][ks], acc);
                acc = mfma16(*(const LAS bf16x8*)(Fr + 16384 + 8192 + ((te * 2 + ks) * 64 + lane) * 16), pb[1][ks], acc);
                t0 = mfma16(*(const LAS bf16x8*)(Fr + ((te * 2 + ks) * 64 + lane) * 16), qr[ks], t0);
                t1 = mfma16(*(const LAS bf16x8*)(Fr + 16384 + ((te * 2 + ks) * 64 + lane) * 16), qr[ks], t1); }
            o[te] = acc + sc0 * t0 + sc1 * t1; ssq += (o[te][0] * o[te][0] + o[te][1] * o[te][1]) + (o[te][2] * o[te][2] + o[te][3] * o[te][3]); }
        ssq = quad_rows_sum(ssq);
        const float rs = 1.0f / sqrtf(ssq * (1.0f / 64.0f) + EPS);
#pragma unroll
        for (int te = 0; te < 4; ++te) { const int e0 = 16 * te + 4 * q;
            const u32x2 z2 = *(const u32x2*)(P + (size_t)(m0 + i) * NP + PC_GZ + hh * 64 + e0); const f32x4 gn = *(const f32x4*)(in.gdn_norm_g + layer * 64 + e0);
            const float z0 = __uint_as_float(z2.x << 16), z1 = __uint_as_float(z2.x & 0xffff0000u), z2f = __uint_as_float(z2.y << 16), z3 = __uint_as_float(z2.y & 0xffff0000u);
            u32x2 wv; wv.x = cvtpk(o[te][0] * rs * gn[0] * siluf(z0), o[te][1] * rs * gn[1] * siluf(z1)); wv.y = cvtpk(o[te][2] * rs * gn[2] * siluf(z2f), o[te][3] * rs * gn[3] * siluf(z3));
            *(u32x2*)(O + (size_t)(m0 + i) * D + 256 + hh * 64 + e0) = wv; }
        pp = dyn_bcast(dq, pp_next);
    }
}

__device__ __forceinline__ void phase_ret_kv(Frame& F, const Inputs& in, int layer) {
    const bf16* P = (const bf16*)(F.ws + WS_R1 + R1_P);
    const bf16* RK = (const bf16*)(F.ws + WS_R1 + R1_PREP + PREP_RK);
    LAS bf16* Kt = (LAS bf16*)F.lds; LAS bf16* Vw = Kt + 64 * 72;
    const int lane = F.lane, c = lane & 15, q = lane >> 4, w = F.wave, tid = F.tid;
    const float LOG2E = 1.4426950408889634f;
    DynQ dq = dyn_make(F, layer, 2);
    for (int uu = dyn_bcast(dq, dyn_grab(dq)); uu < 16 * 68; ) {
        const int uu_next = dyn_grab(dq);
        const int bh = uu / 68, ch = uu % 68, b = bh >> 2, hh = bh & 3;
        const int m0 = ch < 4 ? b * TC + 64 * ch : MC + b * TL + 64 * (ch - 4);
        const float l0 = -fexp(in.ret_decay[layer * 8 + hh]) * LOG2E, l1 = -fexp(in.ret_decay[layer * 8 + 4 + hh]) * LOG2E;
        __syncthreads();
        { const int j = tid >> 3, col8 = (tid & 7) * 8;
          const u32x4 k8 = *(const u32x4*)(RK + (size_t)(m0 + j) * 256 + hh * 64 + col8), v8 = *(const u32x4*)(P + (size_t)(m0 + j) * NP + PC_RV + hh * 64 + col8);
          const float w0 = fexp2((float)(63 - j) * l0), w1 = fexp2((float)j * l1);
#pragma unroll
          for (int x = 0; x < 8; ++x) { const unsigned kk = (k8[x >> 1] >> (16 * (x & 1))) & 0xffffu; const float vv = __uint_as_float(((v8[x >> 1] >> (16 * (x & 1))) & 0xffffu) << 16);
              Kt[(col8 + x) * 72 + j] = (bf16)kk; Vw[(col8 + x) * 72 + j] = (bf16)f2bf(vv * w0); Vw[4608 + (col8 + x) * 72 + j] = (bf16)f2bf(vv * w1); } }
        __syncthreads();
        { const int d = w >> 2, td = w & 3;
          bf16x8 a[2];
#pragma unroll
          for (int ks = 0; ks < 2; ++ks) a[ks] = *(const LAS bf16x8*)(Kt + (16 * td + c) * 72 + 32 * ks + 8 * q);
          const int chain = bh * 2 + d, sg = d ? (ch < 4 ? 3 - ch : 71 - ch) : ch;
          float* dst = (float*)(F.ws + WS_RKV) + ((size_t)chain * 68 + sg) * 4096;
#pragma unroll
          for (int te = 0; te < 4; ++te) { f32x4 acc = (f32x4){0.f, 0.f, 0.f, 0.f};
#pragma unroll
              for (int ks = 0; ks < 2; ++ks) acc = mfma16(a[ks], *(const LAS bf16x8*)(Vw + d * 4608 + (16 * te + c) * 72 + 32 * ks + 8 * q), acc);
              *(f32x4*)(dst + (16 * te + c) * 64 + 16 * td + 4 * q) = acc; } }
        uu = dyn_bcast(dq, uu_next);
    }
}
__device__ __forceinline__ void phase_ret_state(Frame& F, const Inputs& in, int layer, int nwg) {
    if (F.bid >= nwg) return;
    const float* RKV = (const float*)(F.ws + WS_RKV); bf16* RST = (bf16*)(F.ws + WS_RST);
    for (int el = F.bid * NTHR + F.tid; el < 32 * 4096; el += nwg * NTHR) {
        const int chain = el >> 12, idx = el & 4095, hh = (chain >> 1) & 3, d = chain & 1;
        const float G64 = fexp(-64.0f * fexp(in.ret_decay[layer * 8 + d * 4 + hh]));
        const float* kv = RKV + (size_t)chain * 68 * 4096 + idx; bf16* st = RST + (size_t)chain * 68 * 4096 + idx;
        float S = 0.f;
#pragma unroll
        for (int h2 = 0; h2 < 2; ++h2) { float kvv[34];
#pragma unroll
            for (int sg = 0; sg < 34; ++sg) kvv[sg] = kv[(size_t)(34 * h2 + sg) * 4096];
#pragma unroll
            for (int sg = 0; sg < 34; ++sg) { st[(size_t)(34 * h2 + sg) * 4096] = (bf16)f2bf(S); S = G64 * S + kvv[sg]; } }
    }
}
__device__ __forceinline__ void phase_ret_out(Frame& F, const Inputs& in, int layer) {
    const bf16* P = (const bf16*)(F.ws + WS_R1 + R1_P);
    const bf16* RQ = (const bf16*)(F.ws + WS_R1 + R1_PREP + PREP_RQ); const bf16* RK = (const bf16*)(F.ws + WS_R1 + R1_PREP + PREP_RK);
    const bf16* RST = (const bf16*)(F.ws + WS_RST);
    bf16* O = (bf16*)(F.ws + WS_R1 + R1_O);
    const int lane = F.lane, c = lane & 15, q = lane >> 4, w = F.wave, half = w >> 2, ti = w & 3, t2 = F.tid & 255;
    LAS bf16* Qs = (LAS bf16*)(F.lds + half * 46080); LAS bf16* Ks = Qs + 4608; LAS bf16* Vt = Ks + 4608; LAS bf16* St = Vt + 4608;
    const float LOG2E = 1.4426950408889634f;
    DynQ dq = dyn_make(F, layer, 3);
    for (int pp = dyn_bcast(dq, dyn_grab(dq)); pp < 8 * 68; ) {
        const int pp_next = dyn_grab(dq);
        const int uu = 2 * pp + half, bh = uu / 68, ch = uu % 68, b = bh >> 2, hh = bh & 3;
        const int m0 = ch < 4 ? b * TC + 64 * ch : MC + b * TL + 64 * (ch - 4);
        const float l0 = -fexp(in.ret_decay[layer * 8 + hh]) * LOG2E, l1 = -fexp(in.ret_decay[layer * 8 + 4 + hh]) * LOG2E;
        __syncthreads();
#pragma unroll
        for (int rep = 0; rep < 2; ++rep) { const int idx = t2 + 256 * rep, row = idx >> 3, col8 = (idx & 7) * 8;
            *(LAS u32x4*)(Qs + row * 72 + col8) = *(const u32x4*)(RQ + (size_t)(m0 + row) * 256 + hh * 64 + col8);
            *(LAS u32x4*)(Ks + row * 72 + col8) = *(const u32x4*)(RK + (size_t)(m0 + row) * 256 + hh * 64 + col8);
            const u32x4 v8 = *(const u32x4*)(P + (size_t)(m0 + row) * NP + PC_RV + hh * 64 + col8);
#pragma unroll
            for (int x = 0; x < 8; ++x) Vt[(col8 + x) * 72 + row] = (bf16)(v8[x >> 1] >> (16 * (x & 1)));
#pragma unroll
            for (int d = 0; d < 2; ++d) { const int sg = d ? (ch < 4 ? 3 - ch : 71 - ch) : ch;
                *(LAS u32x4*)(St + d * 4608 + row * 72 + col8) = *(const u32x4*)(RST + ((size_t)(bh * 2 + d) * 68 + sg) * 4096 + row * 64 + col8); } }
        __syncthreads();
        bf16x8 qf[2];
#pragma unroll
        for (int ks = 0; ks < 2; ++ks) qf[ks] = *(const LAS bf16x8*)(Qs + (16 * ti + c) * 72 + 32 * ks + 8 * q);
        const int i = 16 * ti + c;
        f32x4 p[4];
#pragma unroll
        for (int tj = 0; tj < 4; ++tj) { f32x4 acc = (f32x4){0.f, 0.f, 0.f, 0.f};
#pragma unroll
            for (int ks = 0; ks < 2; ++ks) acc = mfma16(*(const LAS bf16x8*)(Ks + (16 * tj + c) * 72 + 32 * ks + 8 * q), qf[ks], acc);
#pragma unroll
            for (int r = 0; r < 4; ++r) { const int dlt = i - (16 * tj + 4 * q + r);
                const float wgt = (dlt >= 0 ? fexp2((float)dlt * l0) : 0.f) + (dlt <= 0 ? fexp2((float)(-dlt) * l1) : 0.f);
                acc[r] *= wgt; }
            p[tj] = acc; }
        bf16x8 pb[2];
#pragma unroll
        for (int ks2 = 0; ks2 < 2; ++ks2) { u32x4 t; t.x = cvtpk(p[2 * ks2][0], p[2 * ks2][1]); t.y = cvtpk(p[2 * ks2][2], p[2 * ks2][3]); t.z = cvtpk(p[2 * ks2 + 1][0], p[2 * ks2 + 1][1]); t.w = cvtpk(p[2 * ks2 + 1][2], p[2 * ks2 + 1][3]); pb[ks2] = __builtin_bit_cast(bf16x8, t); }
        const float sc0 = fexp2((float)(i + 1) * l0), sc1 = fexp2((float)(64 - i) * l1);
        f32x4 o[4]; float sum = 0.f;
#pragma unroll
        for (int te = 0; te < 4; ++te) { f32x4 acc = (f32x4){0.f, 0.f, 0.f, 0.f}, t0 = acc, t1 = acc;
#pragma unroll
            for (int ks2 = 0; ks2 < 2; ++ks2) { const u32x2 lo = *(const LAS u32x2*)(Vt + (16 * te + c) * 72 + 32 * ks2 + 4 * q), hi = *(const LAS u32x2*)(Vt + (16 * te + c) * 72 + 32 * ks2 + 16 + 4 * q);
                acc = mfma16(__builtin_bit_cast(bf16x8, ((u32x4){lo.x, lo.y, hi.x, hi.y})), pb[ks2], acc); }
#pragma unroll
            for (int ks = 0; ks < 2; ++ks) { t0 = mfma16(*(const LAS bf16x8*)(St + (16 * te + c) * 72 + 32 * ks + 8 * q), qf[ks], t0);
                t1 = mfma16(*(const LAS bf16x8*)(St + 4608 + (16 * te + c) * 72 + 32 * ks + 8 * q), qf[ks], t1); }
            o[te] = acc + sc0 * t0 + sc1 * t1; sum += (o[te][0] + o[te][1]) + (o[te][2] + o[te][3]); }
        sum = quad_rows_sum(sum);
        const float mu = sum * (1.0f / 64.0f); float vs = 0.f;
#pragma unroll
        for (int te = 0; te < 4; ++te) { o[te] = o[te] - mu; vs += (o[te][0] * o[te][0] + o[te][1] * o[te][1]) + (o[te][2] * o[te][2] + o[te][3] * o[te][3]); }
        vs = quad_rows_sum(vs);
        const float rs = 1.0f / sqrtf(vs * (1.0f / 64.0f) + EPS);
#pragma unroll
        for (int te = 0; te < 4; ++te) { const int e0 = hh * 64 + 16 * te + 4 * q;
            const u32x2 g2 = *(const u32x2*)(P + (size_t)(m0 + i) * NP + PC_RG + e0); const f32x4 gn = *(const f32x4*)(in.ret_gn_g + layer * 256 + e0);
            const float g0 = __uint_as_float(g2.x << 16), g1 = __uint_as_float(g2.x & 0xffff0000u), g2f = __uint_as_float(g2.y << 16), g3 = __uint_as_float(g2.y & 0xffff0000u);
            u32x2 wv; wv.x = cvtpk(o[te][0] * rs * gn[0] * siluf(g0), o[te][1] * rs * gn[1] * siluf(g1)); wv.y = cvtpk(o[te][2] * rs * gn[2] * siluf(g2f), o[te][3] * rs * gn[3] * siluf(g3));
            *(u32x2*)(O + (size_t)(m0 + i) * D + e0) = wv; }
        pp = dyn_bcast(dq, pp_next);
    }
}

__device__ __forceinline__ void phase_finish(Frame& F, const Inputs& in, int layer) {
    const bf16* P = (const bf16*)(F.ws + WS_R1 + R1_P);
    const float* OG = (const float*)(F.ws + WS_R1 + R1_OG);
    bf16* O = (bf16*)(F.ws + WS_R1 + R1_O);
    const int lane = F.lane;
    for (int m = F.gw; m < M; m += F.NGW) {
#pragma unroll
        for (int hh = 0; hh < 4; ++hh) {
            const float o2 = OG[(size_t)m * 256 + hh * 64 + lane] + OG[(size_t)(M + m) * 256 + hh * 64 + lane];
            const float ms = wave_sum(o2 * o2) * (1.0f / 64.0f);
            const float z = bf2f(P[(size_t)m * NP + PC_GZ + hh * 64 + lane]);
            const float y2 = o2 * (1.0f / sqrtf(ms + EPS)) * in.gdn_norm_g[layer * 64 + lane] * siluf(z);
            O[(size_t)m * D + 256 + hh * 64 + lane] = (bf16)f2bf(y2);
        }
    }
}

__device__ __forceinline__ void phase_route(Frame& F, int m_lo) {
    if (F.bid != 0) return;
    const int* TKE = (const int*)(F.ws + WS_TKE);
    int* TOKROW = (int*)(F.ws + WS_TOKROW); int* ROWTOK = (int*)(F.ws + WS_ROWTOK); int* TILEE = (int*)(F.ws + WS_TILEE);
    LAS int* cnt = (LAS int*)F.lds;
    LAS int* tot = cnt + 512 * 8;
    const int ntok = M - m_lo, per = (ntok + NTHR - 1) / NTHR;
    const int a0 = m_lo + F.tid * per, a1 = (a0 + per < M) ? a0 + per : M;
    int c[8];
#pragma unroll
    for (int e = 0; e < 8; ++e) c[e] = 0;
    for (int m = a0; m < a1; ++m) { const int e0 = TKE[2 * m], e1 = TKE[2 * m + 1];
#pragma unroll
        for (int e = 0; e < 8; ++e) c[e] += (e0 == e) + (e1 == e); }
#pragma unroll
    for (int e = 0; e < 8; ++e) cnt[F.tid * 8 + e] = c[e];
    __syncthreads();
    if (F.tid < 8) { int run = 0; for (int i = 0; i < NTHR; ++i) { const int v = cnt[i * 8 + F.tid]; cnt[i * 8 + F.tid] = run; run += v; } tot[F.tid] = run; }
    __syncthreads();
    if (F.tid == 0) { int st = 0; for (int e = 0; e < 8; ++e) { tot[8 + e] = st; const int pad = (tot[e] + 255) / 256 * 256;
            for (int tl = st / 256; tl < (st + pad) / 256; ++tl) TILEE[tl] = e; st += pad; }
        TILEE[256] = st / 256; }
    __syncthreads();
    int pos[8];
#pragma unroll
    for (int e = 0; e < 8; ++e) pos[e] = tot[8 + e] + cnt[F.tid * 8 + e];
    for (int m = a0; m < a1; ++m) {
#pragma unroll
        for (int k = 0; k < 2; ++k) { const int ee = TKE[2 * m + k]; int row = 0;
#pragma unroll
            for (int e = 0; e < 8; ++e) if (ee == e) { row = pos[e]; pos[e] = row + 1; }
            ROWTOK[row] = m; TOKROW[2 * m + k] = row; } }
    for (int e = 0; e < 8; ++e) { const int st = tot[8 + e] + tot[e], en = tot[8 + e] + (tot[e] + 255) / 256 * 256; for (int r = st + F.tid; r < en; r += NTHR) ROWTOK[r] = -1; }
}
__device__ __forceinline__ void phase_permute(Frame& F) {
    const int* ROWTOK = (const int*)(F.ws + WS_ROWTOK); const int nrows = ((const int*)(F.ws + WS_TILEE))[256] * 256;
    const bf16* H = (const bf16*)(F.ws + WS_H); bf16* HP = (bf16*)(F.ws + WS_HP);
    for (int r = F.gw; r < nrows; r += F.NGW) { const int tok = ROWTOK[r];
#pragma unroll
        for (int j = 0; j < 2; ++j) { u32x4 v = (u32x4){0u, 0u, 0u, 0u}; if (tok >= 0) v = *(const u32x4*)(H + (size_t)tok * D + 8 * F.lane + 512 * j); *(u32x4*)(HP + (size_t)r * D + 8 * F.lane + 512 * j) = v; } }
}


__device__ __forceinline__ void phase_permute2(Frame& F, int route_lo) {
    const int* TKE = (const int*)(F.ws + WS_TKE); int* TOKROW = (int*)(F.ws + WS_TOKROW); int* TILEE = (int*)(F.ws + WS_TILEE);
    const int* WGCNT = (const int*)(F.ws + WS_TILEE + 4096);
    const bf16* H = (const bf16*)(F.ws + WS_H); bf16* HP = (bf16*)(F.ws + WS_HP);
    LAS int* base = (LAS int*)F.lds;
    LAS int* tot = base + 256 * 8;
    __syncthreads();
    {
        LAS int* scn = base + 256 * 8 + 64;
        int cnt8[8];
#pragma unroll
        for (int e = 0; e < 8; ++e) cnt8[e] = (F.tid < F.G) ? WGCNT[F.tid * 8 + e] : 0;
#pragma unroll
        for (int e = 0; e < 8; ++e) scn[F.tid * 8 + e] = cnt8[e];
        __syncthreads();
        int cur = 0;
        for (int off = 1; off < NTHR; off <<= 1) { int v[8];
#pragma unroll
            for (int e = 0; e < 8; ++e) v[e] = scn[cur * 4096 + F.tid * 8 + e] + (F.tid >= off ? scn[cur * 4096 + (F.tid - off) * 8 + e] : 0);
#pragma unroll
            for (int e = 0; e < 8; ++e) scn[(cur ^ 1) * 4096 + F.tid * 8 + e] = v[e];
            __syncthreads(); cur ^= 1; }
        if (F.tid < F.G) {
#pragma unroll
            for (int e = 0; e < 8; ++e) base[F.tid * 8 + e] = scn[cur * 4096 + F.tid * 8 + e] - cnt8[e]; }
        if (F.tid < 8) tot[F.tid] = scn[cur * 4096 + (F.G - 1) * 8 + F.tid];
    }
    __syncthreads();
    if (F.tid == 0) { int st = 0; for (int e = 0; e < 8; ++e) { tot[8 + e] = st; const int pad = (tot[e] + 255) / 256 * 256;
            if (F.bid == 0) for (int tl = st / 256; tl < (st + pad) / 256; ++tl) TILEE[tl] = e;
            st += pad; }
        if (F.bid == 0) TILEE[256] = st / 256; }
    __syncthreads();
    const int lane = F.lane;
    for (int m = route_lo + F.gw; m < M; m += F.NGW) {
        const int gwm = m < MC ? m : (int)((((long)(m - MC + 1)) * F.NGW - 1) / ML), wg = gwm >> 3;
        const int e0 = TKE[2 * m], e1 = TKE[2 * m + 1];
        const int r0 = tot[8 + e0] + base[wg * 8 + e0] + TOKROW[2 * m], r1 = tot[8 + e1] + base[wg * 8 + e1] + TOKROW[2 * m + 1];
        const u32x4 a = *(const u32x4*)(H + (size_t)m * D + 8 * lane), b = *(const u32x4*)(H + (size_t)m * D + 512 + 8 * lane);
        *(u32x4*)(HP + (size_t)r0 * D + 8 * lane) = a; *(u32x4*)(HP + (size_t)r0 * D + 512 + 8 * lane) = b;
        *(u32x4*)(HP + (size_t)r1 * D + 8 * lane) = a; *(u32x4*)(HP + (size_t)r1 * D + 512 + 8 * lane) = b;
        asm volatile("" ::: "memory");
        if (lane == 0) { TOKROW[2 * m] = r0; TOKROW[2 * m + 1] = r1; }
    }
    for (int e = 0; e < 8; ++e) { const int st = tot[8 + e] + tot[e], en = tot[8 + e] + (tot[e] + 255) / 256 * 256;
        for (int r = st + F.gw; r < en; r += F.NGW) { *(u32x4*)(HP + (size_t)r * D + 8 * lane) = (u32x4){0u, 0u, 0u, 0u}; *(u32x4*)(HP + (size_t)r * D + 512 + 8 * lane) = (u32x4){0u, 0u, 0u, 0u}; } }
}

constexpr int NPH = 12;
constexpr int PH_TOTAL = 1 + DEPTH * NPH + 1;
__host__ __device__ inline bool phase_exists(int ph) {
    if (ph == 0 || ph == PH_TOTAL - 1) return true;
    const int layer = (ph - 1) / NPH, j = (ph - 1) % NPH;
    if (!(layer & 1) && j >= 10) return false;
    if ((layer & 1) && j >= 11) return false;
    return true;
}
__global__ void __launch_bounds__(NTHR, 2) fwd_kernel(Args args) {
    extern __shared__ __attribute__((aligned(16))) unsigned char lds_raw[];
    Frame F;
    F.lds = (LAS unsigned char*)lds_raw;
    F.tid = threadIdx.x; F.lane = F.tid & 63; F.wave = __builtin_amdgcn_readfirstlane(F.tid >> 6);
    const int wave0 = F.wave;
    F.G = gridDim.x; F.bid = blockIdx.x; F.gw = blockIdx.x * NWAVES + F.wave; F.NGW = F.G * NWAVES; F.ws = args.ws;
    volatile LAS unsigned* MISC = (volatile LAS unsigned*)(F.lds + MISC_OFF);
    LAS unsigned long long* ptab = (LAS unsigned long long*)(F.lds + MISC_OFF + 128);
    if (F.tid < 32) MISC[F.tid] = 0u;
    if (PROBE_ON && F.tid == 65) { ((volatile LAS unsigned long long*)(F.lds + 132096))[0] = 0ull; ((volatile LAS unsigned long long*)(F.lds + 132096))[1] = 0ull; }
    if (F.tid == 64) { const Inputs& ai = args.in;
        ptab[0] = (unsigned long long)ai.x; ptab[1] = (unsigned long long)ai.c; ptab[2] = (unsigned long long)ai.ctx; ptab[3] = (unsigned long long)ai.c_ctx; ptab[4] = (unsigned long long)ai.ada_w; ptab[5] = (unsigned long long)ai.ada_b;
        ptab[6] = (unsigned long long)ai.norm1_g; ptab[7] = (unsigned long long)ai.w_in; ptab[8] = (unsigned long long)ai.ret_decay; ptab[9] = (unsigned long long)ai.ret_gn_g; ptab[10] = (unsigned long long)ai.gdn_conv_w; ptab[11] = (unsigned long long)ai.gdn_a_log;
        ptab[12] = (unsigned long long)ai.gdn_dt_bias; ptab[13] = (unsigned long long)ai.gdn_norm_g; ptab[14] = (unsigned long long)ai.swa_sink; ptab[15] = (unsigned long long)ai.w_out; ptab[16] = (unsigned long long)ai.norm2_g; ptab[17] = (unsigned long long)ai.ffn_w1;
        ptab[18] = (unsigned long long)ai.ffn_w3; ptab[19] = (unsigned long long)ai.ffn_w2; ptab[20] = (unsigned long long)ai.router_w; ptab[21] = (unsigned long long)ai.moe_w1; ptab[22] = (unsigned long long)ai.moe_w3; ptab[23] = (unsigned long long)ai.moe_w2; ptab[24] = (unsigned long long)ai.final_g; }
    __syncthreads();
    XcdBarrier bar; bar.bar = (unsigned*)(F.ws + WS_CTL) + CW_BAR; bar.x = 0; bar.st = nullptr; bar.w0 = F.wave;
    const int lo = args.ph_lo, hi = args.ph_hi;
    const bool multi = (hi - lo) > 1;
    if (multi) bar = xcd_barrier_post((unsigned*)(F.ws + WS_CTL) + CW_BAR, MISC + 8);
#define LAUNDER() GAS unsigned char* _w = (GAS unsigned char*)args.ws; asm volatile("" : "+s"(_w)); F.ws = (unsigned char*)_w; asm volatile("" ::: "memory"); { int _t = (wave0 << 6) | (int)__builtin_amdgcn_mbcnt_hi(~0u, __builtin_amdgcn_mbcnt_lo(~0u, 0u)); asm volatile("" : "+v"(_t)); int _b = blockIdx.x; asm volatile("" : "+s"(_b)); F.tid = _t; F.lane = _t & 63; F.wave = __builtin_amdgcn_readfirstlane(_t >> 6); F.bid = _b; F.gw = _b * NWAVES + F.wave; } const Inputs in = load_inputs(ptab)
#define RELAUNDER() do { GAS unsigned char* _w2 = (GAS unsigned char*)args.ws; asm volatile("" : "+s"(_w2)); F.ws = (unsigned char*)_w2; int _t = (wave0 << 6) | (int)__builtin_amdgcn_mbcnt_hi(~0u, __builtin_amdgcn_mbcnt_lo(~0u, 0u)); asm volatile("" : "+v"(_t)); int _b = blockIdx.x; asm volatile("" : "+s"(_b)); F.tid = _t; F.lane = _t & 63; F.wave = __builtin_amdgcn_readfirstlane(_t >> 6); F.bid = _b; F.gw = _b * NWAVES + F.wave; asm volatile("" ::: "memory"); } while (0)
#define IN(k) (lo <= (k) && (k) < hi)
#define STAMP(k) do { if (PROBE_ON && !(PROBE_CUSTOM) && blockIdx.x == 0 && xb_leader(F.wave)) { volatile LAS unsigned long long* _st = (volatile LAS unsigned long long*)(F.lds + 132096); const unsigned long long _now = __builtin_amdgcn_s_memrealtime(), _prev = _st[0]; _st[0] = _now; \
    const int _ph = (k) - 1; bool _sel = false; if (_ph == 0) _sel = (PROBE_PRO) != 0; else if (_ph > 0) { const int _l = (_ph - 1) / NPH, _j = (_ph - 1) % NPH; _sel = (((PROBE_LMASK) >> _l) & 1u) && (((PROBE_JMASK) >> _j) & 1u); } if (_sel) _st[1] = _st[1] + (_now - _prev); } } while (0)
#define SEAM(k) do { if (IN(k) && IN((k) + 1)) { xcd_barrier(bar); STAMP((k) + 1); } } while (0)
    LAS unsigned char* ring = F.lds;

    STAMP(0);
    if (IN(0)) { LAUNDER(); phase_prologue(F, in); } SEAM(0);

#define LAYER_BODY(layer) { \
        const int p0 = 1 + layer * NPH; \
        const bool moe = layer & 1; \
        if (IN(p0 + 0)) { LAUNDER(); phase_token2<0>(F, in, layer, layer == 0, layer > 0 && ((layer - 1) & 1), false, nullptr, 0, (layer > 0 && !((layer - 1) & 1)) ? 11 : 0); } \
        SEAM(p0 + 0); \
        if (IN(p0 + 1)) { LAUNDER(); pg8::StaticOrder S; S.init(F.ws + WS_H, (bf16*)(F.ws + WS_WIN) + (size_t)layer * NP * D, M, NP, D, F.G, F.bid); \
            pg8::EpiBf16 E{(bf16*)(F.ws + WS_R1 + R1_P), NP}; pg8::gemm_phase<D, D, pg8::EpiBf16, pg8::StaticOrder>(ring, S, E, F.tid); } \
        SEAM(p0 + 1); \
        if (IN(p0 + 2)) { LAUNDER(); phase_prep3(F, in, layer); } \
        SEAM(p0 + 2); \
        if (IN(p0 + 3)) { LAUNDER(); PB(4); phase_gdn_local3(F, layer); PE(4); RELAUNDER(); PB(5); phase_ret_kv(F, in, layer); PE(5); RELAUNDER(); PB(3); phase_swa2(F, in, layer, F.G); PE(3); } \
        SEAM(p0 + 3); \
        if (IN(p0 + 4)) { LAUNDER(); PB(1); phase_gdn_scan3(F, F.G - 32); PE(1); RELAUNDER(); PB(2); phase_ret_state(F, in, layer, F.G - 32); PE(2); RELAUNDER(); convert_moe_layer(F, in, (layer) >> 1, (layer) & 1, F.G - 32); } \
        SEAM(p0 + 4); \
        if (IN(p0 + 5)) { LAUNDER(); PB(6); phase_ret_out(F, in, layer); PE(6); RELAUNDER(); PB(7); phase_gdn_out2(F, in, layer); PE(7); } \
        SEAM(p0 + 5); \
        if (IN(p0 + 6)) { LAUNDER(); \
            { pg8::StaticOrder S; S.init(F.ws + WS_R1 + R1_O, (bf16*)(F.ws + WS_WOUT) + (size_t)layer * D * D, ML, D, D, F.G, F.bid, 4); \
              pg8::EpiResid E{(float*)(F.ws + WS_XS), (const float*)(F.ws + WS_MOD) + (size_t)layer * 5 * 6 * D, 2}; pg8::gemm_phase<D, D, pg8::EpiResid, pg8::StaticOrder>(ring, S, E, F.tid); } \
            if (layer < DEPTH - 1) { RELAUNDER(); \
              pg8::SplitOrder S; S.init(F.ws + WS_R1 + R1_O, (bf16*)(F.ws + WS_WOUT) + (size_t)layer * D * D, D, 4, F.G, F.bid); \
              pg8::EpiSlab E{(float*)(F.ws + WS_R1 + 100 * MiB)}; pg8::gemm_phase<256, D, pg8::EpiSlab, pg8::SplitOrder>(ring, S, E, F.tid); } } \
        SEAM(p0 + 6); \
        if (IN(p0 + 7)) { LAUNDER(); phase_token2<1>(F, in, layer, false, false, moe, nullptr, layer == DEPTH - 1 ? MC : 0, layer < DEPTH - 1 ? 4 : 0); } \
        SEAM(p0 + 7); \
        if (!moe) { \
            if (IN(p0 + 8)) { LAUNDER(); pg8::StaticOrder S; S.init(F.ws + WS_H, (bf16*)(F.ws + WS_W13) + (size_t)(layer >> 1) * 2 * FF * D, M, 2 * FF, D, F.G, F.bid); \
                pg8::EpiSwiglu E{(bf16*)(F.ws + WS_R1 + R1_HID), FF}; pg8::gemm_phase<D, D, pg8::EpiSwiglu, pg8::StaticOrder>(ring, S, E, F.tid); } \
            SEAM(p0 + 8); \
            if (IN(p0 + 9)) { LAUNDER(); \
                { pg8::StaticOrder S; S.init(F.ws + WS_R1 + R1_HID, (bf16*)(F.ws + WS_W2) + (size_t)(layer >> 1) * D * FF, ML, D, FF, F.G, F.bid, 4); \
                  pg8::EpiResid E{(float*)(F.ws + WS_XS), (const float*)(F.ws + WS_MOD) + (size_t)layer * 5 * 6 * D, 5}; pg8::gemm_phase<FF, FF, pg8::EpiResid, pg8::StaticOrder>(ring, S, E, F.tid); } \
                { RELAUNDER(); \
                  pg8::SplitOrder S; S.init(F.ws + WS_R1 + R1_HID, (bf16*)(F.ws + WS_W2) + (size_t)(layer >> 1) * D * FF, FF, 11, F.G, F.bid); \
                  pg8::EpiSlab E{(float*)(F.ws + WS_R1 + 100 * MiB)}; pg8::gemm_phase<256, FF, pg8::EpiSlab, pg8::SplitOrder>(ring, S, E, F.tid); } } \
            if (IN(p0 + 9) && IN(p0 + NPH)) { xcd_barrier(bar); STAMP(p0 + 10); } \
        } else { \
            if (IN(p0 + 8)) { LAUNDER(); phase_permute2(F, layer == DEPTH - 1 ? MC : 0); } \
            SEAM(p0 + 8); \
            if (IN(p0 + 9)) { LAUNDER(); const int* tile_e = (const int*)(F.ws + WS_TILEE); const int ntiles = __builtin_amdgcn_readfirstlane(tile_e[256]); \
                pg8::GroupedOrder S; S.init(F.ws + WS_HP, F.ws + WS_MW13, ntiles, 2 * EF, D, F.G, F.bid, tile_e); \
                pg8::EpiSwiglu E{(bf16*)(F.ws + WS_R1 + R1_HID), EF}; pg8::gemm_phase<D, D, pg8::EpiSwiglu, pg8::GroupedOrder>(ring, S, E, F.tid); } \
            SEAM(p0 + 9); \
            if (IN(p0 + 10)) { LAUNDER(); const int* tile_e = (const int*)(F.ws + WS_TILEE); const int ntiles = __builtin_amdgcn_readfirstlane(tile_e[256]); \
                const int tmain = (ntiles - (ntiles / 64) * 64 <= 16) ? (ntiles / 64) * 64 : ntiles; \
                { pg8::GroupedOrder S; S.init(F.ws + WS_R1 + R1_HID, F.ws + WS_MW2, tmain, D, EF, F.G, F.bid, tile_e); \
                  pg8::EpiF32 E{(float*)(F.ws + WS_YM), D}; pg8::gemm_phase<EF, EF, pg8::EpiF32, pg8::GroupedOrder>(ring, S, E, F.tid); } \
                if (ntiles > tmain) { RELAUNDER(); const int* tile_e2 = (const int*)(F.ws + WS_TILEE); \
                  pg8::SplitGroupedOrder S; S.init(F.ws + WS_R1 + R1_HID, F.ws + WS_MW2, tmain, ntiles - tmain, F.G, F.bid, tile_e2); \
                  pg8::EpiYMSlab E{(float*)(F.ws + WS_YM), (float*)(F.ws + WS_HP), tmain * 256}; pg8::gemm_phase<896, EF, pg8::EpiYMSlab, pg8::SplitGroupedOrder>(ring, S, E, F.tid); } } \
            if (IN(p0 + 10) && IN(p0 + NPH)) { xcd_barrier(bar); STAMP(p0 + 11); } \
        } \
    }
    LAYER_BODY(0) LAYER_BODY(1) LAYER_BODY(2) LAYER_BODY(3)
#undef LAYER_BODY
    if (IN(PH_TOTAL - 1)) { LAUNDER(); phase_token2<2>(F, in, DEPTH, false, true, false, args.out); }
    if (PROBE_ON && (int)blockIdx.x == ((PROBE_CUSTOM) ? (PROBE_BLOCK < 0 ? (int)gridDim.x + (PROBE_BLOCK) : (PROBE_BLOCK)) : 0) && xb_leader(F.wave)) {
        STAMP(PH_TOTAL);
        const unsigned long long T = ((volatile LAS unsigned long long*)(F.lds + 132096))[1];
        const unsigned long long t0 = __builtin_amdgcn_s_memrealtime();
        while (__builtin_amdgcn_s_memrealtime() - t0 < 8ull * T) __builtin_amdgcn_s_sleep(8);
    }
#undef IN
#undef SEAM
}

extern "C" void kernel_launch(void* const* d_in, const int* in_sizes, int n_in, void* d_out, int out_size, void* d_ws, size_t ws_size, hipStream_t stream) {
    static int grid = 0;
    if (grid == 0) {
        if (n_in != 25 || out_size != ML * D || ws_size < WS_END) { fprintf(stderr, "kernel_launch: unexpected problem: n_in %d out %d ws %zu (need %zu)\n", n_in, out_size, ws_size, (size_t)WS_END); grid = -1; return; }
        int dev = 0, cus = 0, per_cu = 0;
        if (hipGetDevice(&dev) != hipSuccess || hipDeviceGetAttribute(&cus, hipDeviceAttributeMultiprocessorCount, dev) != hipSuccess) { grid = -1; return; }
        if (hipFuncSetAttribute((const void*)fwd_kernel, hipFuncAttributeMaxDynamicSharedMemorySize, LDS_BYTES) != hipSuccess) { fprintf(stderr, "kernel_launch: hipFuncSetAttribute failed\n"); grid = -1; return; }
        if (hipOccupancyMaxActiveBlocksPerMultiprocessor(&per_cu, (const void*)fwd_kernel, NTHR, LDS_BYTES) != hipSuccess || per_cu < 1) fprintf(stderr, "kernel_launch: occupancy query reports %d\n", per_cu);
        (void)hipGetLastError();
        grid = cus;
    }
    if (grid < 0) return;
    (void)hipMemsetAsync((char*)d_ws + WS_CTL, 0, CTL_ZERO_BYTES, stream);
    Args a{};
    const float** ip = (const float**)&a.in;
    for (int i = 0; i < 25; ++i) ip[i] = (const float*)d_in[i];
    a.out = (float*)d_out; a.ws = (unsigned char*)d_ws;
#if MK_ONE_LAUNCH
    a.ph_lo = 0; a.ph_hi = PH_TOTAL;
    hipLaunchKernelGGL(fwd_kernel, dim3(grid), dim3(NTHR), LDS_BYTES, stream, a);
#else
    for (int ph = 0; ph < PH_TOTAL; ++ph) { if (!phase_exists(ph)) continue; a.ph_lo = ph; a.ph_hi = ph + 1;
        hipLaunchKernelGGL(fwd_kernel, dim3(grid), dim3(NTHR), LDS_BYTES, stream, a); }
#endif
}
```

```cpp
#include <hip/hip_runtime.h>
#include <cstdio>
#include <cstdint>

#ifndef PROBE_JMASK
#define PROBE_JMASK 0u
#endif
#ifndef PROBE_LMASK
#define PROBE_LMASK 15u
#endif
#ifndef PROBE_PRO
#define PROBE_PRO 0
#endif
#ifndef PROBE_CUSTOM
#define PROBE_CUSTOM 0
#endif
#ifndef PROBE_BLOCK
#define PROBE_BLOCK 0
#endif
#define PROBE_ON ((PROBE_JMASK) != 0u || (PROBE_PRO) != 0 || (PROBE_CUSTOM) != 0)
#define PB(id) do { if ((PROBE_CUSTOM) == (id) && (int)blockIdx.x == (PROBE_BLOCK < 0 ? (int)gridDim.x + (PROBE_BLOCK) : (PROBE_BLOCK)) && xb_leader(F.wave)) ((volatile LAS unsigned long long*)(F.lds + 132096))[2] = __builtin_amdgcn_s_memrealtime(); } while (0)
#define PE(id) do { if ((PROBE_CUSTOM) == (id) && (int)blockIdx.x == (PROBE_BLOCK < 0 ? (int)gridDim.x + (PROBE_BLOCK) : (PROBE_BLOCK)) && xb_leader(F.wave)) { volatile LAS unsigned long long* _s = (volatile LAS unsigned long long*)(F.lds + 132096); _s[1] = _s[1] + (__builtin_amdgcn_s_memrealtime() - _s[2]); } } while (0)
#define PG8_PB() do { if ((PROBE_CUSTOM) == 20 && (int)blockIdx.x == 0 && wid == 0 && lane == 0) ((volatile __attribute__((address_space(3))) unsigned long long*)(lds + 132096))[2] = __builtin_amdgcn_s_memrealtime(); } while (0)
#define PG8_PE() do { if ((PROBE_CUSTOM) == 20 && (int)blockIdx.x == 0 && wid == 0 && lane == 0) { volatile __attribute__((address_space(3))) unsigned long long* _s = (volatile __attribute__((address_space(3))) unsigned long long*)(lds + 132096); _s[1] = _s[1] + (__builtin_amdgcn_s_memrealtime() - _s[2]); } } while (0)
#ifndef MK_ONE_LAUNCH
#define MK_ONE_LAUNCH 1
#endif

#define GAS __attribute__((address_space(1)))
#define LAS __attribute__((address_space(3)))
typedef unsigned short bf16;
typedef short bf16x8 __attribute__((ext_vector_type(8)));
typedef float f32x4 __attribute__((ext_vector_type(4)));
typedef float f32x2 __attribute__((ext_vector_type(2)));
typedef unsigned u32x4 __attribute__((ext_vector_type(4)));
typedef unsigned u32x2 __attribute__((ext_vector_type(2)));

constexpr int D = 1024, NB = 4, TL = 4096, TC = 256, DEPTH = 4;
constexpr int MC = NB * TC, ML = NB * TL, M = MC + ML;
constexpr int INC = 2832, NP = 2816;
constexpr int FF = 2816, EF = 3584, NE = 8;
constexpr int MAXROWS = 36864;
constexpr float EPS = 1e-6f;
constexpr int PC_RQ = 0, PC_RK = 256, PC_RV = 512, PC_RG = 768, PC_GQKV = 1024, PC_GZ = 1792, PC_SQ = 2048, PC_SK = 2560, PC_SV = 2688;

constexpr size_t MiB = 1u << 20;
constexpr size_t WS_CTL = 0, CTL_ZERO_BYTES = 1 * MiB;
constexpr size_t WS_MOD = 1 * MiB;
constexpr size_t WS_ROPE = 2 * MiB;
constexpr size_t WS_TKE = 3 * MiB, WS_TKG = 3 * MiB + 256 * 1024, WS_TOKROW = 3 * MiB + 512 * 1024, WS_ROWTOK = 3 * MiB + 768 * 1024, WS_TILEE = 4 * MiB;
constexpr size_t WS_AB = 5 * MiB, WS_GB = 7 * MiB;
constexpr size_t WS_WIN = 16 * MiB, WS_WOUT = 38 * MiB, WS_W13 = 46 * MiB, WS_W2 = 68 * MiB, WS_MW13 = 80 * MiB, WS_MW2 = 192 * MiB;
constexpr size_t WS_XS = 248 * MiB, WS_H = 316 * MiB, WS_HP = 350 * MiB, WS_YM = 422 * MiB, WS_R1 = 566 * MiB;
constexpr size_t R1_P = 0, R1_PREP = 94 * MiB, R1_O = 158 * MiB, R1_OR = 192 * MiB, R1_OG = 226 * MiB, R1_HID = 0;
constexpr size_t WS_END = WS_R1 + 260 * MiB;
constexpr size_t WS_GCH = WS_YM, GCH_STEP = 40960, GCH_CHAIN = 68 * GCH_STEP, WS_GDEC = WS_HP;
constexpr size_t G2_STEP = 24576, G2_CHAIN = 68 * G2_STEP;
constexpr size_t WS_GST = WS_YM + 56 * MiB;
constexpr size_t WS_GCS = WS_HP + 64 * 1024;
static_assert(32 * G2_CHAIN <= 56 * MiB && 32 * 68 * 16384 <= 40 * MiB, "gdn v2 buffers");
constexpr size_t WS_RKV = WS_YM + 96 * MiB;
constexpr size_t WS_RST = WS_HP + 1 * MiB;
static_assert(32 * GCH_CHAIN <= 144 * MiB, "gdn chunk data");
constexpr size_t PREP_RQ = 0, PREP_RK = (size_t)M * 256 * 2, PREP_SQ = (size_t)M * 512 * 2, PREP_SK = (size_t)M * 1024 * 2, PREP_GD = (size_t)M * 1152 * 2;
static_assert(PREP_GD + (size_t)M * 768 * 2 <= 64 * MiB, "prep");
static_assert((size_t)M * NP * 2 <= 94 * MiB && (size_t)MAXROWS * EF * 2 <= 260 * MiB, "r1");

constexpr int CW_TMO = 0, CW_BAR = 4096;

__device__ __forceinline__ float bf2f(bf16 v) { return __uint_as_float(((unsigned)v) << 16); }
__device__ __forceinline__ unsigned f2bf(float f) { unsigned u = __float_as_uint(f); return (u + 0x7fffu + ((u >> 16) & 1u)) >> 16; }
__device__ __forceinline__ unsigned pk2(float lo, float hi) { return f2bf(lo) | (f2bf(hi) << 16); }
template <int CTRL> __device__ __forceinline__ float dppf(float v) { return __int_as_float(__builtin_amdgcn_update_dpp(0, __float_as_int(v), CTRL, 0xF, 0xF, true)); }
__device__ __forceinline__ float row_sum16(float v) {
    v += dppf<0xB1>(v); v += dppf<0x4E>(v); v += dppf<0x141>(v); v += dppf<0x140>(v); return v; }
__device__ __forceinline__ float wave_sum(float v) {
    v = row_sum16(v);
    return __int_as_float(__builtin_amdgcn_readlane(__float_as_int(v), 0)) + __int_as_float(__builtin_amdgcn_readlane(__float_as_int(v), 16))
         + __int_as_float(__builtin_amdgcn_readlane(__float_as_int(v), 32)) + __int_as_float(__builtin_amdgcn_readlane(__float_as_int(v), 48)); }
__device__ __forceinline__ float quad_rows_sum(float v) {
    u32x2 r = __builtin_amdgcn_permlane16_swap(__float_as_uint(v), __float_as_uint(v), false, false); v = __uint_as_float(r.x) + __uint_as_float(r.y);
    r = __builtin_amdgcn_permlane32_swap(__float_as_uint(v), __float_as_uint(v), false, false); return __uint_as_float(r.x) + __uint_as_float(r.y); }
__device__ __forceinline__ float quad_rows_max(float v) {
    u32x2 r = __builtin_amdgcn_permlane16_swap(__float_as_uint(v), __float_as_uint(v), false, false); v = fmaxf(__uint_as_float(r.x), __uint_as_float(r.y));
    r = __builtin_amdgcn_permlane32_swap(__float_as_uint(v), __float_as_uint(v), false, false); return fmaxf(__uint_as_float(r.x), __uint_as_float(r.y)); }
__device__ __forceinline__ float fexp2(float x) { return __builtin_amdgcn_exp2f(x); }
__device__ __forceinline__ float fexp(float x) { return __builtin_amdgcn_exp2f(x * 1.4426950408889634f); }
__device__ __forceinline__ float siluf(float x) { return x * __builtin_amdgcn_rcpf(1.0f + fexp(-x)); }
#define LDS_WAIT() asm volatile("s_waitcnt lgkmcnt(0)" ::: "memory")
__device__ __forceinline__ f32x4 mfma16(bf16x8 a, bf16x8 b, f32x4 c) { return __builtin_amdgcn_mfma_f32_16x16x32_bf16(a, b, c, 0, 0, 0); }
__device__ __forceinline__ unsigned cvtpk(float lo, float hi) { unsigned r; asm volatile("v_cvt_pk_bf16_f32 %0, %1, %2" : "=v"(r) : "v"(lo), "v"(hi)); return r; }


namespace pg8 {
#define PG8_LAS __attribute__((address_space(3)))
constexpr int BM = 256, BK = 64, HALF = 128, HTB = HALF * BK * 2, STAGE_BYTES = 8 * HTB;
__host__ __device__ __forceinline__ int lds_byte(int r, int c) { const int st = (r >> 4) * 2 + (c >> 5), rr = r & 15, cc = c & 31, ob = rr * 64 + cc * 2; return st * 1024 + (ob ^ (((ob >> 9) & 1) << 5)); }
__host__ __device__ __forceinline__ void stage_rc(int b, int& R, int& C) { const int st = b / 1024, sb = b % 1024, swz = sb ^ (((sb >> 9) & 1) << 5); R = (st >> 1) * 16 + swz / 64; C = (st & 1) * 32 + (swz % 64) / 2; }
__host__ __device__ __forceinline__ int perm32(int rho) { const int n = rho >> 4, i = rho & 15; return 8 * (i >> 2) + 4 * n + (i & 3); }
struct Unit { int pm, pn, aux; const char* A; const char* B; };
__device__ __forceinline__ unsigned cvt_pk_bf16(float lo, float hi) { unsigned r; asm volatile("v_cvt_pk_bf16_f32 %0, %1, %2" : "=v"(r) : "v"(lo), "v"(hi)); return r; }

template <int K, int LD, class Epi, class Sched, bool ALIGN_EPI = true, bool SP2 = true>
__device__ __forceinline__ void gemm_phase(PG8_LAS unsigned char* lds, const Sched& S, const Epi& E, const int tid) {
    const int wid = __builtin_amdgcn_readfirstlane(tid >> 6), lane = tid & 63, wr = wid >> 2, wc = wid & 3, fr = lane & 15, fq = lane >> 4;
    constexpr int nt = K / BK;
    unsigned voffA[2], voffB[2];
#pragma unroll
    for (int i = 0; i < 2; ++i) { int R, C; stage_rc(tid * 16 + i * 8192, R, C); const int Rb = Epi::PERM ? ((R & ~31) + perm32(R & 31)) : R;
        voffA[i] = (unsigned)(R * LD + C) * 2u; voffB[i] = (unsigned)(Rb * LD + C) * 2u; }
    constexpr size_t kstep = (size_t)(BK * 2);
    constexpr size_t hstep = (size_t)HALF * LD * 2;
    const unsigned ldsw = (unsigned)wid * 1024u;
    const int aoff = lds_byte(wr * 64 + fr, fq * 8), boff = lds_byte(wc * 32 + fr, fq * 8);
#define PG8_SA(b, h) (((b) * 2 + (h)) * HTB)
#define PG8_SB(b, h) ((4 + (b) * 2 + (h)) * HTB)
#define PG8_STAGE(bufoff, gbase, voff) do { _Pragma("unroll") for (int _i = 0; _i < 2; ++_i) \
        __builtin_amdgcn_global_load_lds((const unsigned*)((const char*)(gbase) + (voff)[_i]), (PG8_LAS unsigned*)(lds + (bufoff) + ldsw + _i * 8192), 16, 0, 0); } while (0)
#define PG8_LDA(dst, b, h) do { _Pragma("unroll") for (int m = 0; m < 4; ++m) _Pragma("unroll") for (int k = 0; k < 2; ++k) dst[m][k] = *(const PG8_LAS bf16x8*)(lds + PG8_SA(b, h) + aoff + m * 2048 + k * 1024); } while (0)
#define PG8_LDB(dst, b, h) do { _Pragma("unroll") for (int n = 0; n < 2; ++n) _Pragma("unroll") for (int k = 0; k < 2; ++k) dst[n][k] = *(const PG8_LAS bf16x8*)(lds + PG8_SB(b, h) + boff + n * 2048 + k * 1024); } while (0)
#define PG8_MMA(ai, bj, At, Bt) do { __builtin_amdgcn_s_setprio(1); _Pragma("unroll") for (int m = 0; m < 4; ++m) _Pragma("unroll") for (int n = 0; n < 2; ++n) _Pragma("unroll") for (int k = 0; k < 2; ++k) \
        acc[ai][bj][m][n] = __builtin_amdgcn_mfma_f32_16x16x32_bf16(Bt[n][k], At[m][k], acc[ai][bj][m][n], 0, 0, 0); __builtin_amdgcn_s_setprio(0); } while (0)
#define PG8_WAIT_V(n) asm volatile("s_waitcnt vmcnt(" #n ")" ::: "memory")
#define PG8_WAIT_L(n) asm volatile("s_waitcnt lgkmcnt(" #n ")" ::: "memory")
#define PG8_BAR __builtin_amdgcn_s_barrier()
#define PG8_SCHED __builtin_amdgcn_sched_barrier(0)
    Unit cur, nxt; int ui = 0;
    if (!S.next(0, cur)) return;
    f32x4 acc[2][2][4][2];
#pragma unroll
    for (int a = 0; a < 2; ++a)
#pragma unroll
        for (int b = 0; b < 2; ++b)
#pragma unroll
            for (int m = 0; m < 4; ++m)
#pragma unroll
                for (int n = 0; n < 2; ++n) acc[a][b][m][n] = (f32x4){0.f, 0.f, 0.f, 0.f};
    bf16x8 At[4][2], B0[2][2], B1[2][2];
    const char* cA = cur.A; const char* cB = cur.B;
    if constexpr (SP2) {
        PG8_STAGE(PG8_SB(0, 0), cB, voffB); PG8_STAGE(PG8_SB(0, 1), cB + hstep, voffB); PG8_STAGE(PG8_SA(0, 0), cA, voffA); PG8_STAGE(PG8_SA(0, 1), cA + hstep, voffA);
        if (wr == 1) PG8_BAR;
        PG8_WAIT_V(2); PG8_BAR;
        PG8_STAGE(PG8_SB(1, 0), cB + kstep, voffB); PG8_STAGE(PG8_SA(1, 0), cA + kstep, voffA); PG8_STAGE(PG8_SB(1, 1), cB + hstep + kstep, voffB);
        PG8_WAIT_V(6); PG8_BAR;
    } else {
        PG8_STAGE(PG8_SB(0, 0), cB, voffB); PG8_STAGE(PG8_SA(0, 0), cA, voffA); PG8_STAGE(PG8_SB(0, 1), cB + hstep, voffB); PG8_STAGE(PG8_SA(0, 1), cA + hstep, voffA);
        if (wr == 1) PG8_BAR;
        PG8_WAIT_V(4); PG8_BAR;
        PG8_STAGE(PG8_SB(1, 0), cB + kstep, voffB); PG8_STAGE(PG8_SA(1, 0), cA + kstep, voffA); PG8_STAGE(PG8_SB(1, 1), cB + hstep + kstep, voffB);
        PG8_WAIT_V(6); PG8_BAR;
    }
    for (;;) {
        const bool has_next = S.next(ui + 1, nxt);
        const char* nA = has_next ? nxt.A : cA; const char* nB = has_next ? nxt.B : cB;
        for (int t = 0; t < nt; t += 2) {
            const bool last = (t == nt - 2);
            const char* a1 = cA + (size_t)(t + 1) * kstep;
            const char* a2 = last ? nA : cA + (size_t)(t + 2) * kstep; const char* b2 = last ? nB : cB + (size_t)(t + 2) * kstep;
            const char* a3 = a2 + kstep; const char* b3 = b2 + kstep;
            if constexpr (SP2) {
            PG8_LDB(B0, 0, 0); PG8_LDB(B1, 0, 1); PG8_SCHED; PG8_LDA(At, 0, 0); PG8_STAGE(PG8_SA(1, 1), a1 + hstep, voffA);
            PG8_WAIT_V(8); PG8_WAIT_L(0); PG8_BAR; PG8_MMA(0, 0, At, B0); PG8_MMA(0, 1, At, B1); PG8_BAR; PG8_SCHED;
            PG8_LDA(At, 0, 1); PG8_STAGE(PG8_SB(0, 0), b2, voffB); PG8_STAGE(PG8_SB(0, 1), b2 + hstep, voffB); PG8_STAGE(PG8_SA(0, 0), a2, voffA);
            PG8_WAIT_V(8); PG8_WAIT_L(0); PG8_BAR; PG8_MMA(1, 0, At, B0); PG8_MMA(1, 1, At, B1); PG8_BAR; PG8_SCHED;
            PG8_LDB(B0, 1, 0); PG8_LDB(B1, 1, 1); PG8_SCHED; PG8_LDA(At, 1, 0); PG8_STAGE(PG8_SA(0, 1), a2 + hstep, voffA);
            PG8_WAIT_V(8); PG8_WAIT_L(0); PG8_BAR; PG8_MMA(0, 0, At, B0); PG8_MMA(0, 1, At, B1); PG8_BAR; PG8_SCHED;
            PG8_LDA(At, 1, 1); PG8_STAGE(PG8_SB(1, 0), b3, voffB); PG8_STAGE(PG8_SB(1, 1), b3 + hstep, voffB); PG8_STAGE(PG8_SA(1, 0), a3, voffA);
            PG8_WAIT_V(8); PG8_WAIT_L(0); PG8_BAR; PG8_MMA(1, 0, At, B0); PG8_MMA(1, 1, At, B1); PG8_BAR; PG8_SCHED;
            } else {
            PG8_LDB(B0, 0, 0); PG8_SCHED; PG8_LDA(At, 0, 0); PG8_STAGE(PG8_SA(1, 1), a1 + hstep, voffA);
            PG8_WAIT_L(8); PG8_BAR; PG8_WAIT_L(0); PG8_MMA(0, 0, At, B0); PG8_BAR; PG8_SCHED;
            PG8_LDB(B1, 0, 1); PG8_STAGE(PG8_SB(0, 0), b2, voffB);
            PG8_BAR; PG8_WAIT_L(0); PG8_MMA(0, 1, At, B1); PG8_BAR;
            PG8_LDA(At, 0, 1); PG8_STAGE(PG8_SA(0, 0), a2, voffA);
            PG8_BAR; PG8_WAIT_L(0); PG8_MMA(1, 0, At, B0); PG8_BAR; PG8_SCHED;
            PG8_STAGE(PG8_SB(0, 1), b2 + hstep, voffB);
            PG8_WAIT_V(6); PG8_BAR; PG8_MMA(1, 1, At, B1); PG8_BAR;
            PG8_LDB(B0, 1, 0); PG8_SCHED; PG8_LDA(At, 1, 0); PG8_STAGE(PG8_SA(0, 1), a2 + hstep, voffA);
            PG8_WAIT_L(8); PG8_BAR; PG8_WAIT_L(0); PG8_MMA(0, 0, At, B0); PG8_BAR; PG8_SCHED;
            PG8_LDB(B1, 1, 1); PG8_STAGE(PG8_SB(1, 0), b3, voffB);
            PG8_BAR; PG8_WAIT_L(0); PG8_MMA(0, 1, At, B1); PG8_BAR;
            PG8_LDA(At, 1, 1); PG8_STAGE(PG8_SA(1, 0), a3, voffA);
            PG8_BAR; PG8_WAIT_L(0); PG8_MMA(1, 0, At, B0); PG8_BAR; PG8_SCHED;
            PG8_STAGE(PG8_SB(1, 1), b3 + hstep, voffB);
            PG8_WAIT_V(6); PG8_BAR; PG8_MMA(1, 1, At, B1); PG8_BAR;
            }
        }
        if constexpr (ALIGN_EPI) { if (wr == 0) PG8_BAR; }
        PG8_PB();
        E(acc, cur, wr, wc, fr, fq);
        PG8_PE();
        if (!has_next) break;
#pragma unroll
        for (int a = 0; a < 2; ++a)
#pragma unroll
            for (int b = 0; b < 2; ++b)
#pragma unroll
                for (int m = 0; m < 4; ++m)
#pragma unroll
                    for (int n = 0; n < 2; ++n) acc[a][b][m][n] = (f32x4){0.f, 0.f, 0.f, 0.f};
        cur = nxt; cA = nA; cB = nB; ++ui;
        if constexpr (ALIGN_EPI) { if (wr == 1) PG8_BAR; }
    }
    PG8_WAIT_V(0);
    if constexpr (!ALIGN_EPI) { if (wr == 0) PG8_BAR; }
    PG8_BAR;
#undef PG8_SA
#undef PG8_SB
#undef PG8_STAGE
#undef PG8_LDA
#undef PG8_LDB
#undef PG8_MMA
#undef PG8_WAIT_V
#undef PG8_WAIT_L
#undef PG8_BAR
#undef PG8_SCHED
}

struct StaticOrder {
    int nM, nN, nwg, G, c, pm_off; const char* A; const char* Bt; size_t tstep;
    __device__ void init(const void* A_, const void* Bt_, int M_, int N_, int K_, int G_, int c_, int pm_off_ = 0) { A = (const char*)A_; Bt = (const char*)Bt_; nM = M_ / BM; nN = N_ / BM; nwg = nM * nN; G = G_; c = c_; pm_off = pm_off_; tstep = (size_t)BM * K_ * 2; }
    __device__ bool next(int i, Unit& u) const {
        const long L = (long)i * G + c; if (L >= nwg) return false;
        int wgid = (int)L; { const int q = nwg / 8, r = nwg % 8, xcd = wgid % 8, off = wgid / 8; wgid = (xcd < r ? xcd * (q + 1) : r * (q + 1) + (xcd - r) * q) + off; }
        const int nig = 8 * nN, gid = wgid / nig, fm = gid * 8, gsz = (nM - fm) < 8 ? (nM - fm) : 8;
        u.pm = fm + ((wgid % nig) % gsz) + pm_off; u.pn = (wgid % nig) / gsz; u.aux = 0;
        u.A = A + (size_t)u.pm * tstep; u.B = Bt + (size_t)u.pn * tstep; return true;
    }
};
struct SplitOrder {
    int nks, nsub, G, c; const char* A; const char* Bt; size_t tstep;
    __device__ void init(const void* A_, const void* Bt_, int LD_, int nks_, int G_, int c_) { A = (const char*)A_; Bt = (const char*)Bt_; nks = nks_; nsub = 16 * nks_; G = G_; c = c_; tstep = (size_t)BM * LD_ * 2; }
    __device__ bool next(int i, Unit& u) const {
        const int L = i * G + c; if (L >= nsub) return false;
        const int ksl = L % nks, t = L / nks; u.pm = t >> 2; u.pn = t & 3; u.aux = ksl;
        u.A = A + (size_t)u.pm * tstep + (size_t)ksl * 512; u.B = Bt + (size_t)u.pn * tstep + (size_t)ksl * 512; return true;
    }
};
struct GroupedOrder {
    int nM, nN, nwg, G, c; const char* A; const char* Bt; size_t tstep, estep; const int* tile_e;
    __device__ void init(const void* A_, const void* Bt_, int ntiles, int N_, int K_, int G_, int c_, const int* te) { A = (const char*)A_; Bt = (const char*)Bt_; nM = ntiles; nN = N_ / BM; nwg = nM * nN; G = G_; c = c_; tstep = (size_t)BM * K_ * 2; estep = (size_t)N_ * K_ * 2; tile_e = te; }
    __device__ bool next(int i, Unit& u) const {
        const long L = (long)i * G + c; if (L >= nwg) return false;
        int wgid = (int)L; { const int q = nwg / 8, r = nwg % 8, xcd = wgid % 8, off = wgid / 8; wgid = (xcd < r ? xcd * (q + 1) : r * (q + 1) + (xcd - r) * q) + off; }
        const int nig = 8 * nN, gid = wgid / nig, fm = gid * 8, gsz = (nM - fm) < 8 ? (nM - fm) : 8;
        u.pm = fm + ((wgid % nig) % gsz); u.pn = (wgid % nig) / gsz; u.aux = __builtin_amdgcn_readfirstlane(tile_e[u.pm]);
        u.A = A + (size_t)u.pm * tstep; u.B = Bt + (size_t)u.aux * estep + (size_t)u.pn * tstep; return true;
    }
};

struct SplitGroupedOrder {
    int t0, nsub, G, c; const char* A; const char* Bt; size_t tstep, estep; const int* tile_e;
    __device__ void init(const void* A_, const void* Bt_, int t0_, int nt_, int G_, int c_, const int* te) { A = (const char*)A_; Bt = (const char*)Bt_; t0 = t0_; nsub = nt_ * 16; G = G_; c = c_; tstep = (size_t)BM * EF * 2; estep = (size_t)D * EF * 2; tile_e = te; }
    __device__ bool next(int i, Unit& u) const {
        const int L = i * G + c; if (L >= nsub) return false;
        const int ksl = L & 3, t = L >> 2; u.pm = t0 + (t >> 2); u.pn = t & 3; u.aux = ksl;
        const int e = __builtin_amdgcn_readfirstlane(tile_e[u.pm]);
        u.A = A + (size_t)u.pm * tstep + (size_t)ksl * 896 * 2; u.B = Bt + (size_t)e * estep + (size_t)u.pn * tstep + (size_t)ksl * 896 * 2; return true;
    }
};
struct EpiBf16 {
    static constexpr bool PERM = true;
    bf16* O; int ldc;
    __device__ __forceinline__ void operator()(const f32x4 (&acc)[2][2][4][2], const Unit& u, int wr, int wc, int fr, int fq) const {
        const int row0 = u.pm * BM + wr * 64 + fr, col0 = u.pn * BM + wc * 32 + 8 * fq;
#pragma unroll
        for (int ai = 0; ai < 2; ++ai)
#pragma unroll
            for (int m = 0; m < 4; ++m) { bf16* rowp = O + (size_t)(row0 + ai * HALF + m * 16) * ldc + col0;
#pragma unroll
                for (int bj = 0; bj < 2; ++bj) { const f32x4 v0 = acc[ai][bj][m][0], v1 = acc[ai][bj][m][1];
                    u32x4 w; w.x = cvt_pk_bf16(v0[0], v0[1]); w.y = cvt_pk_bf16(v0[2], v0[3]); w.z = cvt_pk_bf16(v1[0], v1[1]); w.w = cvt_pk_bf16(v1[2], v1[3]);
                    *(u32x4*)(rowp + bj * HALF) = w; } }
    }
};
struct EpiResid {
    static constexpr bool PERM = false;
    float* X; const float* mod; int gsel; const float* Xsrc;
    __device__ __forceinline__ void operator()(const f32x4 (&acc)[2][2][4][2], const Unit& u, int wr, int wc, int fr, int fq) const {
        const int row0 = u.pm * BM + wr * 64 + fr, col0 = u.pn * BM + wc * 32 + 4 * fq;
        const int r = u.pm < 4 ? 4 : ((u.pm - 4) >> 4);
        const float* g = mod + (size_t)r * 6 * D + gsel * D;
        f32x4 gv[2][2];
#pragma unroll
        for (int bj = 0; bj < 2; ++bj)
#pragma unroll
            for (int n = 0; n < 2; ++n) gv[bj][n] = *(const f32x4*)(g + col0 + bj * HALF + n * 16);
#pragma unroll
        for (int ai = 0; ai < 2; ++ai)
#pragma unroll
            for (int m = 0; m < 4; ++m) { float* rowp = X + (size_t)(row0 + ai * HALF + m * 16) * D + col0; const float* srcp = Xsrc ? Xsrc + (size_t)(row0 + ai * HALF + m * 16 - MC) * D + col0 : rowp;
#pragma unroll
                for (int bj = 0; bj < 2; ++bj)
#pragma unroll
                    for (int n = 0; n < 2; ++n) { f32x4 x = *(const f32x4*)(srcp + bj * HALF + n * 16); x += gv[bj][n] * acc[ai][bj][m][n]; *(f32x4*)(rowp + bj * HALF + n * 16) = x; } }
    }
};
struct EpiSwiglu {
    static constexpr bool PERM = false;
    bf16* Hd; int ldh;
    __device__ __forceinline__ void operator()(const f32x4 (&acc)[2][2][4][2], const Unit& u, int wr, int wc, int fr, int fq) const {
        const int row0 = u.pm * BM + wr * 64 + fr, col0 = u.pn * 128 + wc * 16 + 4 * fq;
#pragma unroll
        for (int ai = 0; ai < 2; ++ai)
#pragma unroll
            for (int m = 0; m < 4; ++m) { bf16* rowp = Hd + (size_t)(row0 + ai * HALF + m * 16) * ldh + col0;
#pragma unroll
                for (int bj = 0; bj < 2; ++bj) { const f32x4 a = acc[ai][bj][m][0], b = acc[ai][bj][m][1];
                    float h[4];
#pragma unroll
                    for (int j = 0; j < 4; ++j) h[j] = a[j] * __builtin_amdgcn_rcpf(1.0f + __builtin_amdgcn_exp2f(-1.4426950408889634f * a[j])) * b[j];
                    u32x2 w; w.x = cvt_pk_bf16(h[0], h[1]); w.y = cvt_pk_bf16(h[2], h[3]);
                    *(u32x2*)(rowp + bj * 64) = w; } }
    }
};
struct EpiF32 {
    static constexpr bool PERM = false;
    float* C; int ldc;
    __device__ __forceinline__ void operator()(const f32x4 (&acc)[2][2][4][2], const Unit& u, int wr, int wc, int fr, int fq) const {
        const int row0 = u.pm * BM + wr * 64 + fr, col0 = u.pn * BM + wc * 32 + 4 * fq;
#pragma unroll
        for (int ai = 0; ai < 2; ++ai)
#pragma unroll
            for (int m = 0; m < 4; ++m) { float* rowp = C + (size_t)(row0 + ai * HALF + m * 16) * ldc + col0;
#pragma unroll
                for (int bj = 0; bj < 2; ++bj)
#pragma unroll
                    for (int n = 0; n < 2; ++n) *(f32x4*)(rowp + bj * HALF + n * 16) = acc[ai][bj][m][n]; }
    }
};
struct EpiSlab {
    static constexpr bool PERM = false;
    float* C;
    __device__ __forceinline__ void operator()(const f32x4 (&acc)[2][2][4][2], const Unit& u, int wr, int wc, int fr, int fq) const {
        const int row0 = u.pm * BM + wr * 64 + fr, col0 = u.pn * BM + wc * 32 + 4 * fq;
        float* base = C + (size_t)u.aux * MC * D;
#pragma unroll
        for (int ai = 0; ai < 2; ++ai)
#pragma unroll
            for (int m = 0; m < 4; ++m) { float* rowp = base + (size_t)(row0 + ai * HALF + m * 16) * D + col0;
#pragma unroll
                for (int bj = 0; bj < 2; ++bj)
#pragma unroll
                    for (int n = 0; n < 2; ++n) *(f32x4*)(rowp + bj * HALF + n * 16) = acc[ai][bj][m][n]; }
    }
};
struct EpiYMSlab {
    static constexpr bool PERM = false;
    float* YMp; float* slab; int row0s;
    __device__ __forceinline__ void operator()(const f32x4 (&acc)[2][2][4][2], const Unit& u, int wr, int wc, int fr, int fq) const {
        const int row0 = u.pm * BM + wr * 64 + fr, col0 = u.pn * BM + wc * 32 + 4 * fq;
        float* base = slab + ((size_t)u.aux * 4096 + (row0 - row0s)) * D;
#pragma unroll
        for (int ai = 0; ai < 2; ++ai)
#pragma unroll
            for (int m = 0; m < 4; ++m) { float* rowp = base + (size_t)(ai * HALF + m * 16) * D + col0;
#pragma unroll
                for (int bj = 0; bj < 2; ++bj)
#pragma unroll
                    for (int n = 0; n < 2; ++n) *(f32x4*)(rowp + bj * HALF + n * 16) = acc[ai][bj][m][n]; }
    }
};
}

#define XB_TMO      128
#define XB_XCNT(j)  (256  + 64 * (j))
#define XB_XSUB(j)  (1280 + 64 * (j))
#define XB_XGEN(j)  (2304 + 64 * (j))
#define XB_TOP      3328
#define XB_TOPGEN   3392
#define XCD_BAR_WORDS 3456
#define XB_SPIN_CAP (1u << 22)
__device__ __forceinline__ unsigned xb_ld(unsigned* p)              { return __hip_atomic_load(p, __ATOMIC_RELAXED, __HIP_MEMORY_SCOPE_AGENT); }
__device__ __forceinline__ unsigned xb_add(unsigned* p, unsigned v) { return __hip_atomic_fetch_add(p, v, __ATOMIC_RELAXED, __HIP_MEMORY_SCOPE_AGENT); }
__device__ __forceinline__ unsigned xb_xcc_id() { return (unsigned)__builtin_amdgcn_s_getreg((3 << 11) | 20) & 0xFu; }
#define XB_SPIN(cond, bar) do { unsigned _sp = 0; while (cond) { __builtin_amdgcn_s_sleep(1); \
    if ((++_sp & 255u) == 0u) { if (xb_ld(&(bar)[XB_TMO])) break; if (_sp > XB_SPIN_CAP) { atomicAdd(&(bar)[XB_TMO], 1u); break; } } } } while (0)
struct XcdBarrier { unsigned* bar; unsigned x; volatile LAS unsigned* st; int w0; };
__device__ __forceinline__ bool xb_leader(int w0) { return w0 == 0 && __builtin_amdgcn_mbcnt_hi(~0u, __builtin_amdgcn_mbcnt_lo(~0u, 0u)) == 0u; }
__device__ __forceinline__ XcdBarrier xcd_barrier_post(unsigned* bar, volatile LAS unsigned* st) {
    XcdBarrier b; b.bar = bar; b.x = xb_xcc_id(); b.st = st; b.w0 = __builtin_amdgcn_readfirstlane(threadIdx.x >> 6);
    if (xb_leader(b.w0)) (void)xb_add(&bar[XB_XCNT(b.x)], 1u);
    return b;
}
__device__ __forceinline__ void xcd_barrier_complete(unsigned* bar, unsigned x, unsigned& nloc, unsigned& nx) {
    const unsigned G = gridDim.x * gridDim.y * gridDim.z;
    unsigned sum, cnt, mine, sp = 0u;
    for (;;) {
        sum = 0u; cnt = 0u; mine = 0u;
#pragma unroll
        for (unsigned j = 0; j < 16; ++j) { const unsigned c = xb_ld(&bar[XB_XCNT(j)]); sum += c; cnt += (c > 0u) ? 1u : 0u; mine = (j == x) ? c : mine; }
        if (sum == G) break;
        __builtin_amdgcn_s_sleep(1);
        if ((++sp & 255u) == 0u) { if (xb_ld(&bar[XB_TMO])) break; if (sp > XB_SPIN_CAP) { atomicAdd(&bar[XB_TMO], 1u); break; } }
    }
    nloc = mine > 0u ? mine : 1u; nx = cnt > 0u ? cnt : 1u;
}
__device__ __forceinline__ void xcd_barrier(const XcdBarrier& b) {
    asm volatile("s_waitcnt vmcnt(0)" ::: "memory");
    __syncthreads();
    if (xb_leader(b.w0)) {
        unsigned* bar = b.bar; unsigned bx = b.x;
        asm volatile("" : "+s"(bar), "+s"(bx));
        __builtin_amdgcn_s_waitcnt(0);
        unsigned nloc = b.st[0], nx = b.st[1];
        if (nloc == 0u) { xcd_barrier_complete(bar, bx, nloc, nx); b.st[0] = nloc; b.st[1] = nx; }
        const unsigned old = xb_add(&bar[XB_XSUB(bx)], 1u);
        const unsigned gen = old / nloc;
        if (old + 1u == (gen + 1u) * nloc) {
            __builtin_amdgcn_fence(__ATOMIC_RELEASE, "agent");
            asm volatile("s_waitcnt vmcnt(0)" ::: "memory");
            const unsigned og = xb_add(&bar[XB_TOP], 1u);
            const unsigned tg = og / nx;
            if (og + 1u == (tg + 1u) * nx) xb_add(&bar[XB_TOPGEN], 1u);
            else XB_SPIN(xb_ld(&bar[XB_TOPGEN]) == tg, bar);
            __builtin_amdgcn_fence(__ATOMIC_ACQUIRE, "agent");
            xb_add(&bar[XB_XGEN(bx)], 1u);
            asm volatile("s_waitcnt vmcnt(0)" ::: "memory");
        } else {
            XB_SPIN(xb_ld(&bar[XB_XGEN(bx)]) == gen, bar);
            __builtin_amdgcn_fence(__ATOMIC_ACQUIRE, "agent");
            asm volatile("s_waitcnt vmcnt(0)" ::: "memory");
        }
    }
    __syncthreads();
}

constexpr int NWAVES = 8, NTHR = 512;
constexpr int RING_BYTES = 131072, MISC_OFF = RING_BYTES + 320, LDS_BYTES = 147456;

struct Inputs {
    const float *x, *c, *ctx, *c_ctx, *ada_w, *ada_b, *norm1_g, *w_in, *ret_decay, *ret_gn_g, *gdn_conv_w, *gdn_a_log, *gdn_dt_bias, *gdn_norm_g, *swa_sink, *w_out, *norm2_g,
        *ffn_w1, *ffn_w3, *ffn_w2, *router_w, *moe_w1, *moe_w3, *moe_w2, *final_g;
};
struct Args { Inputs in; float* out; unsigned char* ws; int ph_lo, ph_hi; };
static_assert(sizeof(Args) == 25 * 8 + 8 + 8 + 8, "no padding");


__device__ __forceinline__ const float* ld_ptr(const LAS unsigned long long* t, int i) { const unsigned long long v = t[i]; const unsigned lo = __builtin_amdgcn_readfirstlane((unsigned)v), hi = __builtin_amdgcn_readfirstlane((unsigned)(v >> 32)); return (const float*)(GAS const float*)(((unsigned long long)hi << 32) | lo); }
__device__ __forceinline__ Inputs load_inputs(const LAS unsigned long long* t) {
    Inputs in; const float** ip = (const float**)&in;
#pragma unroll
    for (int i = 0; i < 25; ++i) ip[i] = ld_ptr(t, i);
    return in;
}
struct Frame {
    LAS unsigned char* lds;
    int tid, lane, wave, G, gw, NGW, bid;
    unsigned char* ws;
};


constexpr int CW_DYN = 8192;
struct DynQ { unsigned* ctr; volatile LAS int* slot; bool lead; };
__device__ __forceinline__ DynQ dyn_make(Frame& F, int layer, int k) { DynQ q; q.ctr = (unsigned*)(F.ws + WS_CTL) + CW_DYN + (layer * 8 + k) * 64; q.slot = (volatile LAS int*)(F.lds + MISC_OFF + 64); q.lead = F.wave == 0 && F.lane == 0; return q; }
__device__ __forceinline__ int dyn_grab(const DynQ& q) { return q.lead ? (int)__hip_atomic_fetch_add(q.ctr, 1u, __ATOMIC_RELAXED, __HIP_MEMORY_SCOPE_AGENT) : 0; }
__device__ __forceinline__ int dyn_bcast(const DynQ& q, int v) { __syncthreads(); if (q.lead) q.slot[0] = v; __syncthreads(); return __builtin_amdgcn_readfirstlane(q.slot[0]); }

template <class SrcF>
__device__ __forceinline__ void transpose_item(const SrcF& src, int K, bf16* WT, LAS float* scr, int k0, int n0, int lane) {
#pragma unroll
    for (int i = 0; i < 8; ++i) { const int row = 4 * i + (lane >> 4), col = 4 * (lane & 15); *(LAS f32x4*)(scr + row * 68 + col) = src(k0 + row, n0 + col); }
    LDS_WAIT(); asm volatile("" ::: "memory");
#pragma unroll
    for (int j = 0; j < 4; ++j) { const int ch = j * 64 + lane, n = ch >> 2, c8 = ch & 3; const LAS float* sp = scr + (8 * c8) * 68 + n;
        u32x4 o; o.x = cvtpk(sp[0 * 68], sp[1 * 68]); o.y = cvtpk(sp[2 * 68], sp[3 * 68]); o.z = cvtpk(sp[4 * 68], sp[5 * 68]); o.w = cvtpk(sp[6 * 68], sp[7 * 68]);
        *(u32x4*)(WT + (size_t)(n0 + n) * K + k0 + 8 * c8) = o; }
    LDS_WAIT(); asm volatile("" ::: "memory");
}
struct SrcPlain { const float* W; int ld; __device__ __forceinline__ f32x4 operator()(int k, int n) const { return *(const f32x4*)(W + (size_t)k * ld + n); } };
struct SrcWin { const float* W; __device__ __forceinline__ f32x4 operator()(int k, int n) const { return *(const f32x4*)(W + (size_t)k * INC + (n < 2048 ? n : n + 16)); } };
struct SrcGU { const float* W1; const float* W3; int ld; __device__ __forceinline__ f32x4 operator()(int k, int n) const { const int g = n >> 5, i = n & 31; const ptrdiff_t d = (i < 16) ? (ptrdiff_t)0 : (W3 - W1); return *(const f32x4*)(W1 + d + (ptrdiff_t)k * ld + 16 * g + (i & 15)); } };

__device__ __forceinline__ void convert_moe_layer(Frame& F, const Inputs& in, int mi, int part, int nwg) {
    LAS float* scr = (LAS float*)(F.lds + F.wave * 16384);
    bf16* mw13 = (bf16*)(F.ws + WS_MW13); bf16* mw2 = (bf16*)(F.ws + WS_MW2);
    constexpr int I13 = (D / 32) * (2 * EF / 64), I2 = (EF / 32) * (D / 64);
    if (F.bid >= nwg) return;
    constexpr int NIT = NE * (I13 + I2);
    const int lane = F.lane, lr = lane >> 4, lc = 4 * (lane & 15);
    const int it_end = (part + 1) * (NIT / 2), step = nwg * NWAVES;
    int it = part * (NIT / 2) + F.gw;
    const float* sp = nullptr; int ld = 0; bf16* dp = nullptr; int dK = 0;
#define CV_DESC(itv, SP, LDv, DP, DK) do { const int e_ = (itv) / (I13 + I2); int r_ = (itv) % (I13 + I2); const size_t wo_ = ((size_t)mi * NE + e_) * (size_t)D * EF; \
        if (r_ < I13) { const int nb_ = 2 * EF / 64, k0_ = 32 * (r_ / nb_), n0_ = 64 * (r_ % nb_), n_ = n0_ + lc, g_ = n_ >> 5, i_ = n_ & 31; \
            SP = (i_ < 16 ? in.moe_w1 : in.moe_w3) + wo_ + (size_t)(k0_ + lr) * EF + 16 * g_ + (i_ & 15); LDv = EF; DP = mw13 + (size_t)e_ * 2 * EF * D + (size_t)n0_ * D + k0_; DK = D; } \
        else { r_ -= I13; const int nb_ = D / 64, k0_ = 32 * (r_ / nb_), n0_ = 64 * (r_ % nb_); \
            SP = in.moe_w2 + wo_ + (size_t)(k0_ + lr) * D + n0_ + lc; LDv = D; DP = mw2 + (size_t)e_ * D * EF + (size_t)n0_ * EF + k0_; DK = EF; } } while (0)
    f32x4 rc[8];
    if (it < it_end) { CV_DESC(it, sp, ld, dp, dK);
#pragma unroll
        for (int i = 0; i < 8; ++i) rc[i] = *(const f32x4*)(sp + (size_t)(4 * i) * ld); }
    while (it < it_end) {
        const int itn = it + step; const bool hasn = itn < it_end;
        const float* spn = sp; int ldn = ld; bf16* dpn = dp; int dKn = dK;
        if (hasn) CV_DESC(itn, spn, ldn, dpn, dKn);
#pragma unroll
        for (int i = 0; i < 8; ++i) *(LAS f32x4*)(scr + (4 * i + lr) * 68 + lc) = rc[i];
        f32x4 rn[8];
#pragma unroll
        for (int i = 0; i < 8; ++i) rn[i] = *(const f32x4*)(spn + (size_t)(4 * i) * ldn);
        LDS_WAIT(); asm volatile("" ::: "memory");
#pragma unroll
        for (int j = 0; j < 4; ++j) { const int ch = j * 64 + lane, n = ch >> 2, c8 = ch & 3; const LAS float* q = scr + (8 * c8) * 68 + n;
            u32x4 o; o.x = cvtpk(q[0 * 68], q[1 * 68]); o.y = cvtpk(q[2 * 68], q[3 * 68]); o.z = cvtpk(q[4 * 68], q[5 * 68]); o.w = cvtpk(q[6 * 68], q[7 * 68]);
            *(u32x4*)(dp + (size_t)n * dK + 8 * c8) = o; }
        LDS_WAIT(); asm volatile("" ::: "memory");
        it = itn; sp = spn; ld = ldn; dp = dpn; dK = dKn;
#pragma unroll
        for (int i = 0; i < 8; ++i) rc[i] = rn[i];
    }
#undef CV_DESC
}
__device__ __forceinline__ void phase_prologue(Frame& F, const Inputs& in) {
    LAS float* scr = (LAS float*)(F.lds + F.wave * 16384);
    {
        constexpr int I_IN = (D / 32) * (NP / 64), I_OUT = (D / 32) * (D / 64), I_13 = (D / 32) * (2 * FF / 64), I_2 = (FF / 32) * (D / 64);
        constexpr int PER_L = I_IN + I_OUT, PER_F = I_13 + I_2, TOT = DEPTH * PER_L + 2 * PER_F;
        for (int it = F.gw; it < TOT; it += F.NGW) {
            if (it < DEPTH * PER_L) { const int l = it / PER_L; int r = it % PER_L;
                if (r < I_IN) { const int nblk = NP / 64; SrcWin s{in.w_in + (size_t)l * D * INC}; transpose_item(s, D, (bf16*)(F.ws + WS_WIN) + (size_t)l * NP * D, scr, 32 * (r / nblk), 64 * (r % nblk), F.lane); }
                else { r -= I_IN; const int nblk = D / 64; SrcPlain s{in.w_out + (size_t)l * D * D, D}; transpose_item(s, D, (bf16*)(F.ws + WS_WOUT) + (size_t)l * D * D, scr, 32 * (r / nblk), 64 * (r % nblk), F.lane); }
            } else { const int q = it - DEPTH * PER_L; const int i = q / PER_F; int r = q % PER_F;
                if (r < I_13) { const int nblk = 2 * FF / 64; SrcGU s{in.ffn_w1 + (size_t)i * D * FF, in.ffn_w3 + (size_t)i * D * FF, FF}; transpose_item(s, D, (bf16*)(F.ws + WS_W13) + (size_t)i * 2 * FF * D, scr, 32 * (r / nblk), 64 * (r % nblk), F.lane); }
                else { r -= I_13; const int nblk = D / 64; SrcPlain s{in.ffn_w2 + (size_t)i * FF * D, D}; transpose_item(s, FF, (bf16*)(F.ws + WS_W2) + (size_t)i * D * FF, scr, 32 * (r / nblk), 64 * (r % nblk), F.lane); }
            }
        }
    }
    {
        __syncthreads();
        LAS float* sc = (LAS float*)F.lds;
        LAS float* red = (LAS float*)(F.lds + 32768);
        for (int i = F.tid; i < 5 * D; i += NTHR) { const int r = i / D, k = i % D; const float v = r < 4 ? in.c[r * D + k] : in.c_ctx[k]; sc[i] = siluf(v); }
        __syncthreads();
        float* mod = (float*)(F.ws + WS_MOD);
        for (int u = F.bid; u < DEPTH * 96; u += F.G) {
            const int l = u / 96, n = (u % 96) * 64 + F.lane;
            const float* w = in.ada_w + (size_t)l * D * 6 * D + n;
            float a[5] = {0.f, 0.f, 0.f, 0.f, 0.f};
            for (int k = F.wave * 128; k < F.wave * 128 + 128; ++k) { const float wv = w[(size_t)k * 6 * D];
#pragma unroll
                for (int r = 0; r < 5; ++r) a[r] += sc[r * D + k] * wv; }
#pragma unroll
            for (int r = 0; r < 5; ++r) red[(F.wave * 5 + r) * 64 + F.lane] = a[r];
            __syncthreads();
            if (F.tid < 320) { const int r = F.tid / 64, ln = F.tid % 64; float s = 0.f;
#pragma unroll
                for (int w8 = 0; w8 < 8; ++w8) s += red[(w8 * 5 + r) * 64 + ln];
                const int nn = (u % 96) * 64 + ln;
                mod[((size_t)l * 5 + r) * 6 * D + nn] = s + in.ada_b[(size_t)l * 6 * D + nn]; }
            __syncthreads();
        }
    }
    if (F.bid == 0) { float* rp = (float*)(F.ws + WS_ROPE);
        for (int i = F.tid; i < 64 * 16; i += NTHR) { const int pos = i / 16, fi = i % 16; const double inv = pow(10000.0, -(double)fi / 16.0), ang = (double)pos * inv; rp[2 * i] = (float)cos(ang); rp[2 * i + 1] = (float)sin(ang); } }
}

__device__ __forceinline__ int mod_row(int m) { return m < MC ? 4 : ((m - MC) >> 12); }

template <int MODE>
__device__ __forceinline__ void phase_token(Frame& F, const Inputs& in, int layer, bool first_from_input, bool combine_moe, bool moe_router, float* out) {
    float* XS = (float*)(F.ws + WS_XS);
    bf16* H = (bf16*)(F.ws + WS_H);
    const float* mod = (const float*)(F.ws + WS_MOD) + (size_t)(layer < DEPTH ? layer : DEPTH - 1) * 5 * 6 * D;
    const float* modprev = (const float*)(F.ws + WS_MOD) + (size_t)(layer > 0 ? layer - 1 : 0) * 5 * 6 * D;
    const int* TKE = (const int*)(F.ws + WS_TKE); const float* TKG = (const float*)(F.ws + WS_TKG); const int* TOKROW = (const int*)(F.ws + WS_TOKROW);
    const float* YM = (const float*)(F.ws + WS_YM);
    LAS float* wl = (LAS float*)F.lds;
    if (MODE == 0) { __syncthreads(); const float* w = in.w_in + (size_t)layer * D * INC + 2048; for (int i = F.tid; i < D * 16; i += NTHR) { const int k = i >> 4, c = i & 15, kp = ((k >> 8) * 4 + (k & 3)) * 64 + ((k >> 2) & 63); wl[((c >> 2) * 1024 + kp) * 4 + (c & 3)] = w[(size_t)k * INC + c]; } __syncthreads(); }
    LAS int* lcnt = (LAS int*)(F.lds + 61440);
    if (MODE == 1 && moe_router) { __syncthreads(); if (F.tid < 8) lcnt[F.tid] = 0; const float* w = in.router_w + (size_t)(layer >> 1) * D * NE; for (int i = F.tid; i < D * NE; i += NTHR) { const int k = i >> 3, c = i & 7, kp = ((k >> 8) * 4 + (k & 3)) * 64 + ((k >> 2) & 63); wl[((c >> 2) * 1024 + kp) * 4 + (c & 3)] = w[i]; } __syncthreads(); }
    const float* gain = MODE == 0 ? in.norm1_g + (size_t)layer * D : (MODE == 1 ? in.norm2_g + (size_t)layer * D : in.final_g);
    const int m_lo = (MODE == 2) ? MC : 0;
    for (int m = m_lo + F.gw; m < M; m += F.NGW) {
        const int r = mod_row(m);
        f32x4 v[4];
        const float* xrow = first_from_input ? (m < MC ? in.ctx + (size_t)m * D : in.x + (size_t)(m - MC) * D) : XS + (size_t)m * D;
#pragma unroll
        for (int j = 0; j < 4; ++j) v[j] = *(const f32x4*)(xrow + 4 * F.lane + 256 * j);
        bool wrote = first_from_input;
        if (combine_moe && !(layer == DEPTH && m < MC)) {
            const int r0 = TOKROW[2 * m], r1 = TOKROW[2 * m + 1]; const float g0 = TKG[2 * m], g1 = TKG[2 * m + 1];
            const float* gt = modprev + (size_t)r * 6 * D + 5 * D;
#pragma unroll
            for (int j = 0; j < 4; ++j) { const f32x4 y0 = *(const f32x4*)(YM + (size_t)r0 * D + 4 * F.lane + 256 * j), y1 = *(const f32x4*)(YM + (size_t)r1 * D + 4 * F.lane + 256 * j);
                const f32x4 gg = *(const f32x4*)(gt + 4 * F.lane + 256 * j); v[j] += gg * (g0 * y0 + g1 * y1); }
            wrote = true;
        }
        if (wrote && MODE != 2) {
#pragma unroll
            for (int j = 0; j < 4; ++j) *(f32x4*)(XS + (size_t)m * D + 4 * F.lane + 256 * j) = v[j];
        }
        float ss = 0.f;
#pragma unroll
        for (int j = 0; j < 4; ++j) ss += (v[j].x * v[j].x + v[j].y * v[j].y) + (v[j].z * v[j].z + v[j].w * v[j].w);
        const float rstd = 1.0f / sqrtf(wave_sum(ss) * (1.0f / D) + EPS);
        if (MODE == 2) {
#pragma unroll
            for (int j = 0; j < 4; ++j) { const f32x4 g = *(const f32x4*)(gain + 4 * F.lane + 256 * j); *(f32x4*)(out + (size_t)(m - MC) * D + 4 * F.lane + 256 * j) = v[j] * rstd * g; }
            continue;
        }
        const float* sh = mod + (size_t)r * 6 * D + (MODE == 0 ? 0 : 3) * D; const float* scl = sh + D;
        f32x4 h[4];
#pragma unroll
        for (int j = 0; j < 4; ++j) { const f32x4 g = *(const f32x4*)(gain + 4 * F.lane + 256 * j), s1 = *(const f32x4*)(scl + 4 * F.lane + 256 * j), s0 = *(const f32x4*)(sh + 4 * F.lane + 256 * j);
            h[j] = v[j] * rstd * g * (1.0f + s1) + s0;
            u32x2 w; w.x = pk2(h[j].x, h[j].y); w.y = pk2(h[j].z, h[j].w); *(u32x2*)(H + (size_t)m * D + 4 * F.lane + 256 * j) = w; }
        if (MODE == 0) {
            float a[16];
#pragma unroll
            for (int c = 0; c < 16; ++c) a[c] = 0.f;
#pragma unroll
            for (int j = 0; j < 4; ++j)
#pragma unroll
                for (int e = 0; e < 4; ++e) { const int kp = (j * 4 + e) * 64 + F.lane; const float hv = h[j][e];
#pragma unroll
                    for (int q = 0; q < 4; ++q) { const f32x4 w = *(const LAS f32x4*)(wl + (q * 1024 + kp) * 4); a[4 * q] += hv * w.x; a[4 * q + 1] += hv * w.y; a[4 * q + 2] += hv * w.z; a[4 * q + 3] += hv * w.w; } }
            float mine = 0.f;
#pragma unroll
            for (int c = 0; c < 16; ++c) { const float s = wave_sum(a[c]); mine = (F.lane == c) ? s : mine; }
            if (F.lane < 16) ((float*)(F.ws + WS_AB))[(size_t)m * 16 + F.lane] = mine;
        }
        if (MODE == 1 && moe_router) {
            float a[8];
#pragma unroll
            for (int c = 0; c < 8; ++c) a[c] = 0.f;
#pragma unroll
            for (int j = 0; j < 4; ++j)
#pragma unroll
                for (int e = 0; e < 4; ++e) { const int kp = (j * 4 + e) * 64 + F.lane; const float hv = h[j][e];
#pragma unroll
                    for (int q = 0; q < 2; ++q) { const f32x4 w = *(const LAS f32x4*)(wl + (q * 1024 + kp) * 4); a[4 * q] += hv * w.x; a[4 * q + 1] += hv * w.y; a[4 * q + 2] += hv * w.z; a[4 * q + 3] += hv * w.w; } }
#pragma unroll
            for (int c = 0; c < 8; ++c) a[c] = wave_sum(a[c]);
            int i0 = 0; float l0 = a[0];
#pragma unroll
            for (int c = 1; c < 8; ++c) if (a[c] > l0) { l0 = a[c]; i0 = c; }
            int i1 = -1; float l1 = -3.0e38f;
#pragma unroll
            for (int c = 0; c < 8; ++c) if (c != i0 && a[c] > l1) { l1 = a[c]; i1 = c; }
            const float e1 = fexp(l1 - l0), g0 = 1.0f / (1.0f + e1), g1 = e1 / (1.0f + e1);
            if (F.lane == 0) { ((int*)(F.ws + WS_TKE))[2 * m] = i0; ((int*)(F.ws + WS_TKE))[2 * m + 1] = i1; ((float*)(F.ws + WS_TKG))[2 * m] = g0; ((float*)(F.ws + WS_TKG))[2 * m + 1] = g1; }
        }
    }
    (void)TKE;
}


template <int MODE>
__device__ __forceinline__ void phase_token2(Frame& F, const Inputs& in, int layer, bool first_from_input, bool combine_moe, bool moe_router, float* out, int route_lo = 0, int nslab = 0) {
    float* XS = (float*)(F.ws + WS_XS);
    bf16* H = (bf16*)(F.ws + WS_H);
    const float* mod = (const float*)(F.ws + WS_MOD) + (size_t)(layer < DEPTH ? layer : DEPTH - 1) * 5 * 6 * D;
    const float* modprev = (const float*)(F.ws + WS_MOD) + (size_t)(layer > 0 ? layer - 1 : 0) * 5 * 6 * D;
    const float* TKG = (const float*)(F.ws + WS_TKG); const int* TOKROW = (const int*)(F.ws + WS_TOKROW);
    const bf16* YM = (const bf16*)(F.ws + WS_YM);
    LAS float* wl = (LAS float*)F.lds;
    const int lane = F.lane;
    if (MODE == 0) PB(8);
    if (MODE == 0) { __syncthreads(); const float* w = in.w_in + (size_t)layer * D * INC + 2048;
#pragma unroll
        for (int n = 0; n < 8; ++n) { const int k = (F.tid >> 2) + 128 * n, q4 = F.tid & 3, kp = ((k >> 8) * 4 + (k & 3)) * 64 + ((k >> 2) & 63);
            *(LAS f32x4*)(wl + (q4 * 1024 + kp) * 4) = *(const f32x4*)(w + (size_t)k * INC + 4 * q4); }
        __syncthreads(); }
    LAS int* lcnt = (LAS int*)(F.lds + 61440);
    if (MODE == 1 && moe_router) { __syncthreads(); if (F.tid < 8) lcnt[F.tid] = 0; const float* w = in.router_w + (size_t)(layer >> 1) * D * NE;
#pragma unroll
        for (int n = 0; n < 4; ++n) { const int k = (F.tid >> 1) + 256 * n, q4 = F.tid & 1, kp = ((k >> 8) * 4 + (k & 3)) * 64 + ((k >> 2) & 63);
            *(LAS f32x4*)(wl + (q4 * 1024 + kp) * 4) = *(const f32x4*)(w + (size_t)k * NE + 4 * q4); }
        __syncthreads(); }
    if (MODE == 0) PE(8);
    if (MODE == 0) PB(9);
    if (MODE == 1) PB(10);
    const float* gain = MODE == 0 ? in.norm1_g + (size_t)layer * D : (MODE == 1 ? in.norm2_g + (size_t)layer * D : in.final_g);
    const bool has_ctx = (MODE != 2) && F.gw < MC;
    const int r_beg = MC + (int)(((long)F.gw * ML) / F.NGW), r_end = MC + (int)(((long)(F.gw + 1) * ML) / F.NGW);
    if (nslab > 0 && has_ctx) {
        const float* sb = (const float*)(F.ws + WS_R1 + 100 * MiB); const float* gsrc = (MODE == 1 ? mod + (size_t)4 * 6 * D + 2 * D : modprev + (size_t)4 * 6 * D + 5 * D);
        { const int m = F.gw;
#pragma unroll
            for (int j = 0; j < 4; ++j) { f32x4 a0 = (f32x4){0.f, 0.f, 0.f, 0.f};
                for (int sidx = 0; sidx < nslab; ++sidx) a0 += *(const f32x4*)(sb + ((size_t)sidx * MC + m) * D + 4 * lane + 256 * j);
                float* xp = XS + (size_t)m * D + 4 * lane + 256 * j; *(f32x4*)xp = *(const f32x4*)xp + *(const f32x4*)(gsrc + 4 * lane + 256 * j) * a0; } }
        asm volatile("s_waitcnt vmcnt(0)" ::: "memory");
    }
    if (combine_moe) {
        const int ntl = ((const int*)(F.ws + WS_TILEE))[256]; const int srow = ((ntl - (ntl / 64) * 64 <= 16) ? (ntl / 64) * 64 : ntl) * 256; const float* sl = (const float*)(F.ws + WS_HP);
        bf16* YMw = (bf16*)(F.ws + WS_YM);
        for (int m0 = has_ctx ? r_beg - 1 : r_beg; m0 < r_end; ++m0) { const int m = m0 < r_beg ? F.gw : m0;
            if (MODE == 0 && layer == DEPTH && m < MC) continue;
#pragma unroll
            for (int k = 0; k < 2; ++k) { const int r = TOKROW[2 * m + k];
                if (r >= srow) { const size_t o = (size_t)(r - srow) * D;
#pragma unroll
                    for (int j = 0; j < 4; ++j) { const f32x4 y = ((*(const f32x4*)(sl + o + 4 * lane + 256 * j) + *(const f32x4*)(sl + (size_t)4096 * D + o + 4 * lane + 256 * j)) + *(const f32x4*)(sl + (size_t)8192 * D + o + 4 * lane + 256 * j)) + *(const f32x4*)(sl + (size_t)12288 * D + o + 4 * lane + 256 * j);
                        u32x2 wv; wv.x = cvtpk(y.x, y.y); wv.y = cvtpk(y.z, y.w); *(u32x2*)(YMw + (size_t)r * D + 4 * lane + 256 * j) = wv; } } } }
        asm volatile("s_waitcnt vmcnt(0)" ::: "memory");
    }
    f32x4 gv[4], av[4], bv[4], gt[4];
#pragma unroll
    for (int j = 0; j < 4; ++j) gv[j] = *(const f32x4*)(gain + 4 * lane + 256 * j);
    int rcur = -1;
    for (int m0 = has_ctx ? r_beg - 1 : r_beg; m0 < r_end; m0 += 2) {
        const bool isc = m0 < r_beg;
        const int ma = isc ? F.gw : m0; const bool two = !isc && ma + 1 < r_end; const int m1 = two ? ma + 1 : ma;
        if (isc) m0 -= 1;
        const int r = mod_row(ma);
        const bool same = mod_row(m1) == r;
        const int mm1 = same ? m1 : ma; const bool do1 = two && same;
        if (!same) m0 -= 1;
        if (r != rcur) { rcur = r;
            if (MODE != 2) { const float* sh = mod + (size_t)r * 6 * D + (MODE == 0 ? 0 : 3) * D;
#pragma unroll
                for (int j = 0; j < 4; ++j) { const f32x4 s1 = *(const f32x4*)(sh + D + 4 * lane + 256 * j); av[j] = gv[j] * (1.0f + s1); bv[j] = *(const f32x4*)(sh + 4 * lane + 256 * j); } }
            if (combine_moe) {
#pragma unroll
                for (int j = 0; j < 4; ++j) gt[j] = *(const f32x4*)(modprev + (size_t)r * 6 * D + 5 * D + 4 * lane + 256 * j); } }
        const int mr[2] = {ma, mm1};
        f32x4 v[2][4];
        int t0[2], t1[2]; float g0[2], g1[2];
        if (combine_moe) {
#pragma unroll
            for (int p = 0; p < 2; ++p) { t0[p] = TOKROW[2 * mr[p]]; t1[p] = TOKROW[2 * mr[p] + 1]; g0[p] = TKG[2 * mr[p]]; g1[p] = TKG[2 * mr[p] + 1]; } }
#pragma unroll
        for (int p = 0; p < 2; ++p) { const int m = mr[p];
            const float* xrow = first_from_input ? (m < MC ? in.ctx + (size_t)m * D : in.x + (size_t)(m - MC) * D) : XS + (size_t)m * D;
#pragma unroll
            for (int j = 0; j < 4; ++j) v[p][j] = *(const f32x4*)(xrow + 4 * lane + 256 * j); }
        if (combine_moe) {
#pragma unroll
            for (int p = 0; p < 2; ++p)
#pragma unroll
                for (int j = 0; j < 4; ++j) { const u32x2 a = *(const u32x2*)(YM + (size_t)t0[p] * D + 4 * lane + 256 * j), b = *(const u32x2*)(YM + (size_t)t1[p] * D + 4 * lane + 256 * j);
                    const f32x4 y0 = (f32x4){__uint_as_float(a.x << 16), __uint_as_float(a.x & 0xffff0000u), __uint_as_float(a.y << 16), __uint_as_float(a.y & 0xffff0000u)};
                    const f32x4 y1 = (f32x4){__uint_as_float(b.x << 16), __uint_as_float(b.x & 0xffff0000u), __uint_as_float(b.y << 16), __uint_as_float(b.y & 0xffff0000u)};
                    v[p][j] += gt[j] * (g0[p] * y0 + g1[p] * y1); } }
        if (((first_from_input && ma < MC) || combine_moe) && MODE != 2) {
#pragma unroll
            for (int p = 0; p < 2; ++p) if (p == 0 || do1) {
#pragma unroll
                for (int j = 0; j < 4; ++j) *(f32x4*)(XS + (size_t)mr[p] * D + 4 * lane + 256 * j) = v[p][j]; } }
        float rstd[2];
#pragma unroll
        for (int p = 0; p < 2; ++p) { float ss = 0.f;
#pragma unroll
            for (int j = 0; j < 4; ++j) ss += (v[p][j].x * v[p][j].x + v[p][j].y * v[p][j].y) + (v[p][j].z * v[p][j].z + v[p][j].w * v[p][j].w);
            rstd[p] = 1.0f / sqrtf(wave_sum(ss) * (1.0f / D) + EPS); }
        if (MODE == 2) {
#pragma unroll
            for (int p = 0; p < 2; ++p) if (p == 0 || do1) {
#pragma unroll
                for (int j = 0; j < 4; ++j) *(f32x4*)(out + (size_t)(mr[p] - MC) * D + 4 * lane + 256 * j) = v[p][j] * rstd[p] * gv[j]; }
            continue; }
        f32x4 h[2][4];
#pragma unroll
        for (int p = 0; p < 2; ++p)
#pragma unroll
            for (int j = 0; j < 4; ++j) { h[p][j] = v[p][j] * rstd[p] * av[j] + bv[j];
                if (p == 0 || do1) { u32x2 w; w.x = cvtpk(h[p][j].x, h[p][j].y); w.y = cvtpk(h[p][j].z, h[p][j].w); *(u32x2*)(H + (size_t)mr[p] * D + 4 * lane + 256 * j) = w; } }
        if (MODE == 0 || (MODE == 1 && moe_router)) {
            constexpr int NC = (MODE == 0) ? 16 : 8;
            float a[2][NC];
#pragma unroll
            for (int p = 0; p < 2; ++p)
#pragma unroll
                for (int c = 0; c < NC; ++c) a[p][c] = 0.f;
#pragma unroll
            for (int j = 0; j < 4; ++j)
#pragma unroll
                for (int e = 0; e < 4; ++e) { const int kp = (j * 4 + e) * 64 + lane;
#pragma unroll
                    for (int q = 0; q < NC / 4; ++q) { const f32x4 w = *(const LAS f32x4*)(wl + (q * 1024 + kp) * 4);
#pragma unroll
                        for (int p = 0; p < 2; ++p) { const float hv = h[p][j][e]; a[p][4 * q] += hv * w.x; a[p][4 * q + 1] += hv * w.y; a[p][4 * q + 2] += hv * w.z; a[p][4 * q + 3] += hv * w.w; } } }
#pragma unroll
            for (int p = 0; p < 2; ++p) {
#pragma unroll
                for (int c = 0; c < NC; ++c) a[p][c] = wave_sum(a[p][c]); }
#pragma unroll
            for (int p = 0; p < 2; ++p) if (p == 0 || do1) { const int m = mr[p];
                if (MODE == 0) { float mine = 0.f;
#pragma unroll
                    for (int c = 0; c < NC; ++c) mine = (lane == c) ? a[p][c] : mine;
                    if (lane < 16) ((float*)(F.ws + WS_AB))[(size_t)m * 16 + lane] = mine; }
                else { int i0 = 0; float l0 = a[p][0];
#pragma unroll
                    for (int c = 1; c < NC; ++c) if (a[p][c] > l0) { l0 = a[p][c]; i0 = c; }
                    int i1 = -1; float l1 = -3.0e38f;
#pragma unroll
                    for (int c = 0; c < NC; ++c) if (c != i0 && a[p][c] > l1) { l1 = a[p][c]; i1 = c; }
                    const float e1 = fexp(l1 - l0), gg0 = 1.0f / (1.0f + e1), gg1 = e1 / (1.0f + e1);
                    if (lane == 0 && m >= route_lo) { ((int*)(F.ws + WS_TKE))[2 * m] = i0; ((int*)(F.ws + WS_TKE))[2 * m + 1] = i1; ((float*)(F.ws + WS_TKG))[2 * m] = gg0; ((float*)(F.ws + WS_TKG))[2 * m + 1] = gg1;
                        ((int*)(F.ws + WS_TOKROW))[2 * m] = __hip_atomic_fetch_add(lcnt + i0, 1, __ATOMIC_RELAXED, __HIP_MEMORY_SCOPE_WORKGROUP); ((int*)(F.ws + WS_TOKROW))[2 * m + 1] = __hip_atomic_fetch_add(lcnt + i1, 1, __ATOMIC_RELAXED, __HIP_MEMORY_SCOPE_WORKGROUP); } } }
        }
    }
    if (MODE == 0) PE(9);
    if (MODE == 1) PE(10);
    if (MODE == 1 && moe_router) { __syncthreads(); if (F.tid < 8) ((int*)(F.ws + WS_TILEE + 4096))[F.bid * 8 + F.tid] = lcnt[F.tid]; }
}

__device__ __forceinline__ void phase_prep(Frame& F, const Inputs& in, int layer) {
    const bf16* P = (const bf16*)(F.ws + WS_R1 + R1_P);
    unsigned char* prep = F.ws + WS_R1 + R1_PREP;
    bf16* RQ = (bf16*)(prep + PREP_RQ); bf16* RK = (bf16*)(prep + PREP_RK); bf16* SQ = (bf16*)(prep + PREP_SQ); bf16* SK = (bf16*)(prep + PREP_SK); bf16* GD = (bf16*)(prep + PREP_GD);
    const float* rope = (const float*)(F.ws + WS_ROPE);
    const float* AB = (const float*)(F.ws + WS_AB); float* GB = (float*)(F.ws + WS_GB);
    const float* cw = in.gdn_conv_w + (size_t)layer * 5 * 768;
    const int lane = F.lane;
    for (int m = F.gw; m < M; m += F.NGW) {
        const bool lat = m >= MC; const int t = lat ? ((m - MC) & (TL - 1)) : (m & (TC - 1)); const int Tn = lat ? TL : TC;
        const bf16* prow = P + (size_t)m * NP;
        float cs = 1.f, sn = 0.f;
        if (lat) { const int j = lane & 31; const int pos = j < 16 ? (t >> 6) : (t & 63); const int fi = j & 15; cs = rope[(pos * 16 + fi) * 2]; sn = rope[(pos * 16 + fi) * 2 + 1]; if (lane < 32) sn = -sn; }
#pragma unroll
        for (int hh = 0; hh < 4; ++hh) { const float q = bf2f(prow[PC_RQ + hh * 64 + lane]), k = bf2f(prow[PC_RK + hh * 64 + lane]) * 0.125f;
            const float qp = __shfl_xor(q, 32), kp = __shfl_xor(k, 32);
            RQ[(size_t)m * 256 + hh * 64 + lane] = (bf16)f2bf(q * cs + qp * sn); RK[(size_t)m * 256 + hh * 64 + lane] = (bf16)f2bf(k * cs + kp * sn); }
#pragma unroll
        for (int hq = 0; hq < 8; ++hq) { const float q = bf2f(prow[PC_SQ + hq * 64 + lane]); const float qp = __shfl_xor(q, 32); SQ[(size_t)m * 512 + hq * 64 + lane] = (bf16)f2bf(q * cs + qp * sn); }
#pragma unroll
        for (int g = 0; g < 2; ++g) { const float k = bf2f(prow[PC_SK + g * 64 + lane]); const float kp = __shfl_xor(k, 32); SK[(size_t)m * 128 + g * 64 + lane] = (bf16)f2bf(k * cs + kp * sn); }
#pragma unroll 1
        for (int s = 0; s < 12; ++s) { const int c = s * 64 + lane; float y = 0.f;
#pragma unroll
            for (int j = 0; j < 5; ++j) { const int tt = t + j - 2; if (tt >= 0 && tt < Tn) y += cw[j * 768 + c] * bf2f(prow[(ptrdiff_t)(j - 2) * NP + PC_GQKV + c]); }
            y = siluf(y);
            if (s < 8) { const float n2 = wave_sum(y * y); y = y * (1.0f / sqrtf(n2 + EPS)); if (s < 4) y *= 0.125f; }
            GD[(size_t)m * 768 + c] = (bf16)f2bf(y); }
        if (lane < 16) { const int dh = lane & 7; const float a = AB[(size_t)m * 16 + lane];
            float o;
            if (lane < 8) { const float xx = a + in.gdn_dt_bias[layer * 8 + dh]; const float sp = fmaxf(xx, 0.f) + log1pf(fexp(-fabsf(xx))); o = -fexp(in.gdn_a_log[layer * 8 + dh]) * sp; }
            else o = 1.0f / (1.0f + fexp(-a));
            GB[(size_t)m * 16 + lane] = o; }
    }
}


__device__ __forceinline__ void unpack8(const u32x4 w, float (&v)[8]) {
#pragma unroll
    for (int e = 0; e < 4; ++e) { v[2 * e] = __uint_as_float(w[e] << 16); v[2 * e + 1] = __uint_as_float(w[e] & 0xffff0000u); } }
__device__ __forceinline__ u32x4 pack8(const float (&v)[8]) { u32x4 w; w.x = cvtpk(v[0], v[1]); w.y = cvtpk(v[2], v[3]); w.z = cvtpk(v[4], v[5]); w.w = cvtpk(v[6], v[7]); return w; }
__device__ __forceinline__ void phase_prep2(Frame& F, const Inputs& in, int layer) {
    const bf16* P = (const bf16*)(F.ws + WS_R1 + R1_P);
    unsigned char* prep = F.ws + WS_R1 + R1_PREP;
    bf16* RQ = (bf16*)(prep + PREP_RQ); bf16* RK = (bf16*)(prep + PREP_RK); bf16* SQ = (bf16*)(prep + PREP_SQ); bf16* SK = (bf16*)(prep + PREP_SK); bf16* GD = (bf16*)(prep + PREP_GD);
    const float* rope = (const float*)(F.ws + WS_ROPE);
    const float* AB = (const float*)(F.ws + WS_AB); float* GB = (float*)(F.ws + WS_GB);
    const float* cw = in.gdn_conv_w + (size_t)layer * 5 * 768;
    const int lane = F.lane, l3 = lane & 3, l31 = lane & 31;
    float wA[5][8], wB[5][8];
#pragma unroll
    for (int j = 0; j < 5; ++j) { const f32x4 a0 = *(const f32x4*)(cw + j * 768 + 8 * lane), a1 = *(const f32x4*)(cw + j * 768 + 8 * lane + 4), b0 = *(const f32x4*)(cw + j * 768 + 512 + 8 * l31), b1 = *(const f32x4*)(cw + j * 768 + 512 + 8 * l31 + 4);
#pragma unroll
        for (int x = 0; x < 4; ++x) { wA[j][x] = a0[x]; wA[j][4 + x] = a1[x]; wB[j][x] = b0[x]; wB[j][4 + x] = b1[x]; } }
    const float sgn = ((lane & 7) < 4) ? -1.0f : 1.0f;
    for (int m = F.gw; m < M; m += F.NGW) {
        const bool lat = m >= MC; const int t = lat ? ((m - MC) & (TL - 1)) : (m & (TC - 1)); const int Tn = lat ? TL : TC;
        const bf16* prow = P + (size_t)m * NP;
        float cs[8], sn[8];
        { const int pos = (l3 < 2) ? (t >> 6) : (t & 63); const float* rp = rope + (pos * 16 + 8 * (l3 & 1)) * 2;
          const f32x4 r0 = *(const f32x4*)(rp), r1 = *(const f32x4*)(rp + 4), r2 = *(const f32x4*)(rp + 8), r3 = *(const f32x4*)(rp + 12);
          cs[0] = r0[0]; sn[0] = r0[1]; cs[1] = r0[2]; sn[1] = r0[3]; cs[2] = r1[0]; sn[2] = r1[1]; cs[3] = r1[2]; sn[3] = r1[3];
          cs[4] = r2[0]; sn[4] = r2[1]; cs[5] = r2[2]; sn[5] = r2[3]; cs[6] = r3[0]; sn[6] = r3[1]; cs[7] = r3[2]; sn[7] = r3[3];
#pragma unroll
          for (int x = 0; x < 8; ++x) { if (!lat) { cs[x] = 1.0f; sn[x] = 0.0f; } sn[x] *= sgn; } }
        { const bool isk = lane >= 32; float v[8], o[8]; unpack8(*(const u32x4*)(prow + (isk ? PC_RK : PC_RQ) + 8 * l31), v);
#pragma unroll
          for (int x = 0; x < 8; ++x) { if (isk) v[x] *= 0.125f; const float pv = __shfl_xor(v[x], 4); o[x] = v[x] * cs[x] + pv * sn[x]; }
          *(u32x4*)((isk ? RK : RQ) + (size_t)m * 256 + 8 * l31) = pack8(o); }
        { float v[8], o[8]; unpack8(*(const u32x4*)(prow + PC_SQ + 8 * lane), v);
#pragma unroll
          for (int x = 0; x < 8; ++x) { const float pv = __shfl_xor(v[x], 4); o[x] = v[x] * cs[x] + pv * sn[x]; }
          *(u32x4*)(SQ + (size_t)m * 512 + 8 * lane) = pack8(o); }
        { float v[8], o[8]; unpack8(*(const u32x4*)(prow + PC_SK + 8 * (lane & 15)), v);
#pragma unroll
          for (int x = 0; x < 8; ++x) { const float pv = __shfl_xor(v[x], 4); o[x] = v[x] * cs[x] + pv * sn[x]; }
          if (lane < 16) *(u32x4*)(SK + (size_t)m * 128 + 8 * lane) = pack8(o); }
        { float a[8], bq[8];
#pragma unroll
          for (int x = 0; x < 8; ++x) { a[x] = 0.f; bq[x] = 0.f; }
#pragma unroll
          for (int j = 0; j < 5; ++j) { const int tt = t + j - 2; const bool ok = tt >= 0 && tt < Tn; const bf16* pr = prow + (ok ? (ptrdiff_t)(j - 2) * NP : (ptrdiff_t)0) + PC_GQKV;
              float va[8], vb[8]; unpack8(*(const u32x4*)(pr + 8 * lane), va); unpack8(*(const u32x4*)(pr + 512 + 8 * l31), vb);
              const float z = ok ? 1.0f : 0.0f;
#pragma unroll
              for (int x = 0; x < 8; ++x) { a[x] += z * wA[j][x] * va[x]; bq[x] += z * wB[j][x] * vb[x]; } }
          float n2 = 0.f;
#pragma unroll
          for (int x = 0; x < 8; ++x) { a[x] = siluf(a[x]); bq[x] = siluf(bq[x]); n2 += a[x] * a[x]; }
          n2 += dppf<0xB1>(n2); n2 += dppf<0x4E>(n2); n2 += dppf<0x141>(n2);
          const float sc = (1.0f / sqrtf(n2 + EPS)) * (lane < 32 ? 0.125f : 1.0f);
#pragma unroll
          for (int x = 0; x < 8; ++x) a[x] *= sc;
          *(u32x4*)(GD + (size_t)m * 768 + 8 * lane) = pack8(a);
          if (lane < 32) *(u32x4*)(GD + (size_t)m * 768 + 512 + 8 * lane) = pack8(bq); }
        if (lane < 16) { const int dh = lane & 7; const float a = AB[(size_t)m * 16 + lane];
            float o;
            if (lane < 8) { const float xx = a + in.gdn_dt_bias[layer * 8 + dh]; const float sp = fmaxf(xx, 0.f) + log1pf(fexp(-fabsf(xx))); o = -fexp(in.gdn_a_log[layer * 8 + dh]) * sp; }
            else o = 1.0f / (1.0f + fexp(-a));
            GB[(size_t)m * 16 + lane] = o; }
    }
}


__device__ __forceinline__ void phase_prep3(Frame& F, const Inputs& in, int layer) {
    const bf16* P = (const bf16*)(F.ws + WS_R1 + R1_P);
    unsigned char* prep = F.ws + WS_R1 + R1_PREP;
    bf16* RQ = (bf16*)(prep + PREP_RQ); bf16* RK = (bf16*)(prep + PREP_RK); bf16* SQ = (bf16*)(prep + PREP_SQ); bf16* SK = (bf16*)(prep + PREP_SK); bf16* GD = (bf16*)(prep + PREP_GD);
    const float* rope = (const float*)(F.ws + WS_ROPE);
    const float* AB = (const float*)(F.ws + WS_AB); float* GB = (float*)(F.ws + WS_GB);
    const float* cw = in.gdn_conv_w + (size_t)layer * 5 * 768;
    const int lane = F.lane, l3 = lane & 3, l31 = lane & 31;
    float wA[5][8], wB[5][8];
#pragma unroll
    for (int j = 0; j < 5; ++j) { const f32x4 a0 = *(const f32x4*)(cw + j * 768 + 8 * lane), a1 = *(const f32x4*)(cw + j * 768 + 8 * lane + 4), b0 = *(const f32x4*)(cw + j * 768 + 512 + 8 * l31), b1 = *(const f32x4*)(cw + j * 768 + 512 + 8 * l31 + 4);
#pragma unroll
        for (int x = 0; x < 4; ++x) { wA[j][x] = a0[x]; wA[j][4 + x] = a1[x]; wB[j][x] = b0[x]; wB[j][4 + x] = b1[x]; } }
    const float sgn = ((lane & 7) < 4) ? -1.0f : 1.0f;
    const bool isk = lane >= 32;
    const float dtb = in.gdn_dt_bias[layer * 8 + (lane & 7)], alg = -fexp(in.gdn_a_log[layer * 8 + (lane & 7)]);
    for (int mbase = F.gw; mbase < M; mbase += 2 * F.NGW) {
        const bool ok1 = mbase + F.NGW < M;
        const int mm[2] = {mbase, ok1 ? mbase + F.NGW : mbase};
        bool lat[2]; int tt0[2], Tn[2]; const bf16* prow[2];
#pragma unroll
        for (int p = 0; p < 2; ++p) { const int m = mm[p]; lat[p] = m >= MC; tt0[p] = lat[p] ? ((m - MC) & (TL - 1)) : (m & (TC - 1)); Tn[p] = lat[p] ? TL : TC; prow[p] = P + (size_t)m * NP; }
        f32x4 rt[2][4]; u32x4 u1[2], u2[2], u3[2];
#pragma unroll
        for (int p = 0; p < 2; ++p) { const int t = tt0[p]; const int pos = (l3 < 2) ? (t >> 6) : (t & 63); const float* rp = rope + (pos * 16 + 8 * (l3 & 1)) * 2;
            rt[p][0] = *(const f32x4*)(rp); rt[p][1] = *(const f32x4*)(rp + 4); rt[p][2] = *(const f32x4*)(rp + 8); rt[p][3] = *(const f32x4*)(rp + 12);
            u1[p] = *(const u32x4*)(prow[p] + (isk ? PC_RK : PC_RQ) + 8 * l31); u2[p] = *(const u32x4*)(prow[p] + PC_SQ + 8 * lane); u3[p] = *(const u32x4*)(prow[p] + PC_SK + 8 * (lane & 15)); }
        __builtin_amdgcn_sched_barrier(0);
#pragma unroll
        for (int p = 0; p < 2; ++p) { const int m = mm[p]; const bool st = (p == 0) || ok1;
            float cs[8], sn[8];
#pragma unroll
            for (int x = 0; x < 8; ++x) { cs[x] = rt[p][x >> 1][(x & 1) * 2]; sn[x] = rt[p][x >> 1][(x & 1) * 2 + 1]; if (!lat[p]) { cs[x] = 1.0f; sn[x] = 0.0f; } sn[x] *= sgn; }
            { float v[8], o[8]; unpack8(u1[p], v);
#pragma unroll
              for (int x = 0; x < 8; ++x) { if (isk) v[x] *= 0.125f; const float pv = __shfl_xor(v[x], 4); o[x] = v[x] * cs[x] + pv * sn[x]; }
              if (st) *(u32x4*)((isk ? RK : RQ) + (size_t)m * 256 + 8 * l31) = pack8(o); }
            { float v[8], o[8]; unpack8(u2[p], v);
#pragma unroll
              for (int x = 0; x < 8; ++x) { const float pv = __shfl_xor(v[x], 4); o[x] = v[x] * cs[x] + pv * sn[x]; }
              if (st) *(u32x4*)(SQ + (size_t)m * 512 + 8 * lane) = pack8(o); }
            { float v[8], o[8]; unpack8(u3[p], v);
#pragma unroll
              for (int x = 0; x < 8; ++x) { const float pv = __shfl_xor(v[x], 4); o[x] = v[x] * cs[x] + pv * sn[x]; }
              if (st && lane < 16) *(u32x4*)(SK + (size_t)m * 128 + 8 * lane) = pack8(o); } }
        { u32x4 ca[2][5];
#pragma unroll
          for (int p = 0; p < 2; ++p)
#pragma unroll
              for (int j = 0; j < 5; ++j) { const int tt = tt0[p] + j - 2; const bool ok = tt >= 0 && tt < Tn[p]; ca[p][j] = *(const u32x4*)(prow[p] + (ok ? (ptrdiff_t)(j - 2) * NP : (ptrdiff_t)0) + PC_GQKV + 8 * lane); }
          __builtin_amdgcn_sched_barrier(0);
#pragma unroll
          for (int p = 0; p < 2; ++p) { float a[8];
#pragma unroll
              for (int x = 0; x < 8; ++x) a[x] = 0.f;
#pragma unroll
              for (int j = 0; j < 5; ++j) { const int tt = tt0[p] + j - 2; const float z = (tt >= 0 && tt < Tn[p]) ? 1.0f : 0.0f; float va[8]; unpack8(ca[p][j], va);
#pragma unroll
                  for (int x = 0; x < 8; ++x) a[x] += z * wA[j][x] * va[x]; }
              float n2 = 0.f;
#pragma unroll
              for (int x = 0; x < 8; ++x) { a[x] = siluf(a[x]); n2 += a[x] * a[x]; }
              n2 += dppf<0xB1>(n2); n2 += dppf<0x4E>(n2); n2 += dppf<0x141>(n2);
              const float sc = __builtin_amdgcn_rsqf(n2 + EPS) * (lane < 32 ? 0.125f : 1.0f);
#pragma unroll
              for (int x = 0; x < 8; ++x) a[x] *= sc;
              if (p == 0 || ok1) *(u32x4*)(GD + (size_t)mm[p] * 768 + 8 * lane) = pack8(a); } }
        { u32x4 cb[2][5]; float abv[2];
#pragma unroll
          for (int p = 0; p < 2; ++p) {
#pragma unroll
              for (int j = 0; j < 5; ++j) { const int tt = tt0[p] + j - 2; const bool ok = tt >= 0 && tt < Tn[p]; cb[p][j] = *(const u32x4*)(prow[p] + (ok ? (ptrdiff_t)(j - 2) * NP : (ptrdiff_t)0) + PC_GQKV + 512 + 8 * l31); }
              abv[p] = AB[(size_t)mm[p] * 16 + (lane & 15)]; }
          __builtin_amdgcn_sched_barrier(0);
#pragma unroll
          for (int p = 0; p < 2; ++p) { const int m = mm[p]; float bq[8];
#pragma unroll
              for (int x = 0; x < 8; ++x) bq[x] = 0.f;
#pragma unroll
              for (int j = 0; j < 5; ++j) { const int tt = tt0[p] + j - 2; const float z = (tt >= 0 && tt < Tn[p]) ? 1.0f : 0.0f; float vb[8]; unpack8(cb[p][j], vb);
#pragma unroll
                  for (int x = 0; x < 8; ++x) bq[x] += z * wB[j][x] * vb[x]; }
#pragma unroll
              for (int x = 0; x < 8; ++x) bq[x] = siluf(bq[x]);
              if (p == 0 || ok1) { if (lane < 32) *(u32x4*)(GD + (size_t)m * 768 + 512 + 8 * lane) = pack8(bq);
                  if (lane < 16) { const float av = abv[p]; float o;
                      if (lane < 8) { const float xx = av + dtb; const float sp = fmaxf(xx, 0.f) + log1pf(fexp(-fabsf(xx))); o = alg * sp; }
                      else o = __builtin_amdgcn_rcpf(1.0f + fexp(-av));
                      GB[(size_t)m * 16 + lane] = o; } } } }
    }
}

__device__ __forceinline__ int scan_row(int b, int dir, int tau) {
    if (tau < TC) { const int c = dir ? TC - 1 - tau : tau; return b * TC + c; }
    const int tt = tau - TC; const int t = dir ? TL - 1 - tt : tt; return MC + b * TL + t;
}
__device__ __forceinline__ void phase_scans(Frame& F, const Inputs& in, int layer, int nscan) {
    if (F.wave != 0 || F.bid >= nscan) return;
    const int id = F.bid; const bool gdn = id >= 32; const int sid = id & 31; const int b = sid >> 3, hh = (sid >> 1) & 3, dir = sid & 1;
    const bf16* P = (const bf16*)(F.ws + WS_R1 + R1_P);
    unsigned char* prep = F.ws + WS_R1 + R1_PREP;
    const bf16* RQ = (const bf16*)(prep + PREP_RQ); const bf16* RK = (const bf16*)(prep + PREP_RK); const bf16* GD = (const bf16*)(prep + PREP_GD);
    const float* GB = (const float*)(F.ws + WS_GB);
    float* OUT = (float*)(F.ws + WS_R1 + (gdn ? R1_OG : R1_OR)) + (size_t)dir * M * 256;
    LAS float* lk = (LAS float*)F.lds; LAS float* lq = lk + 64 * 64; LAS float* lg = lq + 64 * 64;
    const int lane = F.lane;
    float S[64];
#pragma unroll
    for (int i = 0; i < 64; ++i) S[i] = 0.f;
    const float gamma = gdn ? 0.f : fexp(-fexp(in.ret_decay[layer * 8 + dir * 4 + hh]));
    for (int t0 = 0; t0 < TC + TL; t0 += 64) {
        for (int i = 0; i < 64; ++i) { const int m = scan_row(b, dir, t0 + i);
            if (gdn) { lq[i * 64 + lane] = bf2f(GD[(size_t)m * 768 + hh * 64 + lane]); lk[i * 64 + lane] = bf2f(GD[(size_t)m * 768 + 256 + hh * 64 + lane]); if (lane < 2) lg[i * 2 + lane] = GB[(size_t)m * 16 + lane * 8 + dir * 4 + hh]; }
            else { lq[i * 64 + lane] = bf2f(RQ[(size_t)m * 256 + hh * 64 + lane]); lk[i * 64 + lane] = bf2f(RK[(size_t)m * 256 + hh * 64 + lane]); } }
        LDS_WAIT(); asm volatile("" ::: "memory");
        for (int i = 0; i < 64; ++i) { const int m = scan_row(b, dir, t0 + i);
            float o = 0.f;
            if (gdn) {
                const float v = bf2f(GD[(size_t)m * 768 + 512 + hh * 64 + lane]); const float a = fexp(lg[i * 2]), beta = lg[i * 2 + 1];
                float ks = 0.f;
#pragma unroll
                for (int d4 = 0; d4 < 16; ++d4) { const f32x4 kv = *(const LAS f32x4*)(lk + i * 64 + 4 * d4); ks += kv.x * S[4 * d4] + kv.y * S[4 * d4 + 1] + kv.z * S[4 * d4 + 2] + kv.w * S[4 * d4 + 3]; }
                const float vn = beta * (v - a * ks);
#pragma unroll
                for (int d4 = 0; d4 < 16; ++d4) { const f32x4 kv = *(const LAS f32x4*)(lk + i * 64 + 4 * d4), qv = *(const LAS f32x4*)(lq + i * 64 + 4 * d4);
                    S[4 * d4] = a * S[4 * d4] + kv.x * vn; S[4 * d4 + 1] = a * S[4 * d4 + 1] + kv.y * vn; S[4 * d4 + 2] = a * S[4 * d4 + 2] + kv.z * vn; S[4 * d4 + 3] = a * S[4 * d4 + 3] + kv.w * vn;
                    o += qv.x * S[4 * d4] + qv.y * S[4 * d4 + 1] + qv.z * S[4 * d4 + 2] + qv.w * S[4 * d4 + 3]; }
            } else {
                const float v = bf2f(P[(size_t)m * NP + PC_RV + hh * 64 + lane]);
#pragma unroll
                for (int d4 = 0; d4 < 16; ++d4) { const f32x4 kv = *(const LAS f32x4*)(lk + i * 64 + 4 * d4), qv = *(const LAS f32x4*)(lq + i * 64 + 4 * d4);
                    S[4 * d4] = gamma * S[4 * d4] + kv.x * v; S[4 * d4 + 1] = gamma * S[4 * d4 + 1] + kv.y * v; S[4 * d4 + 2] = gamma * S[4 * d4 + 2] + kv.z * v; S[4 * d4 + 3] = gamma * S[4 * d4 + 3] + kv.w * v;
                    o += qv.x * S[4 * d4] + qv.y * S[4 * d4 + 1] + qv.z * S[4 * d4 + 2] + qv.w * S[4 * d4 + 3]; }
            }
            OUT[(size_t)m * 256 + hh * 64 + lane] = o;
        }
        LDS_WAIT(); asm volatile("" ::: "memory");
    }
}

__device__ __forceinline__ void phase_swa(Frame& F, const Inputs& in, int layer) {
    const bf16* P = (const bf16*)(F.ws + WS_R1 + R1_P);
    unsigned char* prep = F.ws + WS_R1 + R1_PREP;
    const bf16* SQ = (const bf16*)(prep + PREP_SQ); const bf16* SK = (const bf16*)(prep + PREP_SK);
    bf16* O = (bf16*)(F.ws + WS_R1 + R1_O);
    const int NT = F.G * NTHR;
    for (int idx = F.bid * NTHR + F.tid; idx < M * 8; idx += NT) {
        const int hq = idx / M, m = idx % M, g = hq >> 2;
        const bool lat = m >= MC; const int b = lat ? ((m - MC) >> 12) : (m >> 8); const int t = lat ? ((m - MC) & (TL - 1)) : (m & (TC - 1));
        float q[64], o[64];
#pragma unroll
        for (int i = 0; i < 8; ++i) { const u32x4 w = *(const u32x4*)(SQ + (size_t)m * 512 + hq * 64 + 8 * i);
#pragma unroll
            for (int e = 0; e < 4; ++e) { q[8 * i + 2 * e] = __uint_as_float(w[e] << 16) * 0.125f; q[8 * i + 2 * e + 1] = __uint_as_float(w[e] & 0xffff0000u) * 0.125f; } }
#pragma unroll
        for (int i = 0; i < 64; ++i) o[i] = 0.f;
        float mx = in.swa_sink[layer * 8 + hq], l = 1.0f;
        const int nloc = lat ? 257 : 0;
        for (int kk = 0; kk < nloc + TC; ++kk) {
            int row;
            if (kk < nloc) { const int s = t - 128 + kk; if (s < 0 || s >= TL) continue; row = MC + b * TL + s; }
            else row = b * TC + (kk - nloc);
            float sc = 0.f;
#pragma unroll
            for (int i = 0; i < 8; ++i) { const u32x4 w = *(const u32x4*)(SK + (size_t)row * 128 + g * 64 + 8 * i);
#pragma unroll
                for (int e = 0; e < 4; ++e) sc += q[8 * i + 2 * e] * __uint_as_float(w[e] << 16) + q[8 * i + 2 * e + 1] * __uint_as_float(w[e] & 0xffff0000u); }
            const float mn = fmaxf(mx, sc), corr = fexp(mx - mn), p = fexp(sc - mn);
            l = l * corr + p; mx = mn;
#pragma unroll
            for (int i = 0; i < 8; ++i) { const u32x4 w = *(const u32x4*)(P + (size_t)row * NP + PC_SV + g * 64 + 8 * i);
#pragma unroll
                for (int e = 0; e < 4; ++e) { o[8 * i + 2 * e] = o[8 * i + 2 * e] * corr + p * __uint_as_float(w[e] << 16); o[8 * i + 2 * e + 1] = o[8 * i + 2 * e + 1] * corr + p * __uint_as_float(w[e] & 0xffff0000u); } }
        }
        const float il = 1.0f / l;
#pragma unroll
        for (int i = 0; i < 8; ++i) { u32x4 w;
#pragma unroll
            for (int e = 0; e < 4; ++e) w[e] = pk2(o[8 * i + 2 * e] * il, o[8 * i + 2 * e + 1] * il);
            *(u32x4*)(O + (size_t)m * D + 512 + hq * 64 + 8 * i) = w; }
    }
}


__device__ __forceinline__ void phase_swa2(Frame& F, const Inputs& in, int layer, int nwg) {
    if (F.bid >= nwg) return;
    const bf16* P = (const bf16*)(F.ws + WS_R1 + R1_P);
    unsigned char* prep = F.ws + WS_R1 + R1_PREP;
    const bf16* SQ = (const bf16*)(prep + PREP_SQ); const bf16* SK = (const bf16*)(prep + PREP_SK);
    bf16* O = (bf16*)(F.ws + WS_R1 + R1_O);
    LAS bf16* Kl = (LAS bf16*)F.lds; LAS bf16* Vt = Kl + 64 * 72;
    const int lane = F.lane, c = lane & 15, q = lane >> 4, w = F.wave;
    const float LOG2E = 1.4426950408889634f;
    const int srow = F.tid >> 3, scol = (F.tid & 7) * 8;
    DynQ dq = dyn_make(F, layer, 1);
    for (int u = dyn_bcast(dq, dyn_grab(dq)); u < 544; ) {
        const int u_next = dyn_grab(dq);
        const bool lat = u < 512; int b, g, qb;
        if (lat) { b = u >> 7; g = (u >> 6) & 1; qb = u & 63; } else { const int uu = u - 512; b = uu >> 3; g = (uu >> 2) & 1; qb = uu & 3; }
        const int hq = 4 * g + (w >> 1), i0 = 32 * (w & 1);
        const int mrow0 = lat ? MC + b * TL + 64 * qb : b * TC + 64 * qb;
        const int kt0 = lat ? (2 - qb > 0 ? 2 - qb : 0) : 0, kt1 = lat ? (65 - qb < 4 ? 65 - qb : 4) : -1, nb = lat ? kt1 - kt0 + 1 : 0, nt = nb + 4;
        const int band0 = MC + b * TL + 64 * qb - 128 + 64 * kt0, ctx0 = b * TC;
        bf16x8 qf[2][2];
#pragma unroll
        for (int ti = 0; ti < 2; ++ti)
#pragma unroll
            for (int ks = 0; ks < 2; ++ks) qf[ti][ks] = *(const bf16x8*)(SQ + (size_t)(mrow0 + i0 + 16 * ti + c) * 512 + hq * 64 + 32 * ks + 8 * q);
        float mrun[2], lrun[2]; f32x4 oacc[4][2];
        const float sk = in.swa_sink[layer * 8 + hq] * LOG2E;
#pragma unroll
        for (int ti = 0; ti < 2; ++ti) { mrun[ti] = sk; lrun[ti] = 1.0f;
#pragma unroll
            for (int te = 0; te < 4; ++te) oacc[te][ti] = (f32x4){0.f, 0.f, 0.f, 0.f}; }
        u32x4 kreg, vreg;
        { const int r0 = (0 < nb) ? band0 : ctx0; kreg = *(const u32x4*)(SK + (size_t)(r0 + srow) * 128 + g * 64 + scol); vreg = *(const u32x4*)(P + (size_t)(r0 + srow) * NP + PC_SV + g * 64 + scol); }
        for (int tt = 0; tt < nt; ++tt) {
            __syncthreads();
            *(LAS u32x4*)(Kl + srow * 72 + scol) = kreg;
#pragma unroll
            for (int x = 0; x < 8; ++x) Vt[(scol + x) * 72 + srow] = (bf16)(vreg[x >> 1] >> (16 * (x & 1)));
            __syncthreads();
            if (tt + 1 < nt) { const int r0 = (tt + 1 < nb) ? band0 + 64 * (tt + 1) : ctx0 + 64 * (tt + 1 - nb);
                kreg = *(const u32x4*)(SK + (size_t)(r0 + srow) * 128 + g * 64 + scol); vreg = *(const u32x4*)(P + (size_t)(r0 + srow) * NP + PC_SV + g * 64 + scol); }
            bf16x8 kfr[2][4]; u32x2 vlo[2][4], vhi[2][4];
#pragma unroll
            for (int ks = 0; ks < 2; ++ks)
#pragma unroll
                for (int tj = 0; tj < 4; ++tj) kfr[ks][tj] = *(const LAS bf16x8*)(Kl + (16 * tj + c) * 72 + 32 * ks + 8 * q);
#pragma unroll
            for (int ks2 = 0; ks2 < 2; ++ks2)
#pragma unroll
                for (int te = 0; te < 4; ++te) { vlo[ks2][te] = *(const LAS u32x2*)(Vt + (16 * te + c) * 72 + 32 * ks2 + 4 * q); vhi[ks2][te] = *(const LAS u32x2*)(Vt + (16 * te + c) * 72 + 32 * ks2 + 16 + 4 * q); }
            __builtin_amdgcn_sched_barrier(0);
            f32x4 sacc[4][2];
#pragma unroll
            for (int tj = 0; tj < 4; ++tj)
#pragma unroll
                for (int ti = 0; ti < 2; ++ti) sacc[tj][ti] = (f32x4){0.f, 0.f, 0.f, 0.f};
#pragma unroll
            for (int ks = 0; ks < 2; ++ks)
#pragma unroll
                for (int tj = 0; tj < 4; ++tj)
#pragma unroll
                    for (int ti = 0; ti < 2; ++ti) sacc[tj][ti] = mfma16(kfr[ks][tj], qf[ti][ks], sacc[tj][ti]);
            const bool band = tt < nb;
            const int kp0 = 64 * qb - 128 + 64 * (kt0 + tt) + 4 * q;
#pragma unroll
            for (int ti = 0; ti < 2; ++ti) {
                const int qp = 64 * qb + i0 + 16 * ti + c;
                float mx = -30000.0f;
                if (band) {
#pragma unroll
                    for (int tj = 0; tj < 4; ++tj)
#pragma unroll
                        for (int r = 0; r < 4; ++r) { float sv = sacc[tj][ti][r] * (0.125f * LOG2E); const int dlt = kp0 + 16 * tj + r - qp; if (dlt > 128 || dlt < -128) sv = -30000.0f; sacc[tj][ti][r] = sv; mx = fmaxf(mx, sv); }
                } else {
#pragma unroll
                    for (int tj = 0; tj < 4; ++tj)
#pragma unroll
                        for (int r = 0; r < 4; ++r) { const float sv = sacc[tj][ti][r] * (0.125f * LOG2E); sacc[tj][ti][r] = sv; mx = fmaxf(mx, sv); }
                }
                mx = quad_rows_max(mx);
                const float mn = fmaxf(mrun[ti], mx), corr = __builtin_amdgcn_exp2f(mrun[ti] - mn);
                float ls = 0.f;
#pragma unroll
                for (int tj = 0; tj < 4; ++tj)
#pragma unroll
                    for (int r = 0; r < 4; ++r) { const float p = __builtin_amdgcn_exp2f(sacc[tj][ti][r] - mn); sacc[tj][ti][r] = p; ls += p; }
                ls = quad_rows_sum(ls);
                lrun[ti] = lrun[ti] * corr + ls; mrun[ti] = mn;
#pragma unroll
                for (int te = 0; te < 4; ++te) oacc[te][ti] *= corr;
            }
#pragma unroll
            for (int ks2 = 0; ks2 < 2; ++ks2) {
                bf16x8 pb[2];
#pragma unroll
                for (int ti = 0; ti < 2; ++ti) { u32x4 t; t.x = cvtpk(sacc[2 * ks2][ti][0], sacc[2 * ks2][ti][1]); t.y = cvtpk(sacc[2 * ks2][ti][2], sacc[2 * ks2][ti][3]);
                    t.z = cvtpk(sacc[2 * ks2 + 1][ti][0], sacc[2 * ks2 + 1][ti][1]); t.w = cvtpk(sacc[2 * ks2 + 1][ti][2], sacc[2 * ks2 + 1][ti][3]); pb[ti] = __builtin_bit_cast(bf16x8, t); }
#pragma unroll
                for (int te = 0; te < 4; ++te) { const bf16x8 va = __builtin_bit_cast(bf16x8, ((u32x4){vlo[ks2][te].x, vlo[ks2][te].y, vhi[ks2][te].x, vhi[ks2][te].y}));
#pragma unroll
                    for (int ti = 0; ti < 2; ++ti) oacc[te][ti] = mfma16(va, pb[ti], oacc[te][ti]); }
            }
        }
#pragma unroll
        for (int ti = 0; ti < 2; ++ti) { const float il = 1.0f / lrun[ti]; bf16* orow = O + (size_t)(mrow0 + i0 + 16 * ti + c) * D + 512 + hq * 64 + 4 * q;
#pragma unroll
            for (int te = 0; te < 4; ++te) { u32x2 wv; wv.x = cvtpk(oacc[te][ti][0] * il, oacc[te][ti][1] * il); wv.y = cvtpk(oacc[te][ti][2] * il, oacc[te][ti][3] * il); *(u32x2*)(orow + 16 * te) = wv; } }
        u = dyn_bcast(dq, u_next);
    }
}


__device__ __forceinline__ void phase_gdn_local(Frame& F) {
    unsigned char* prep = F.ws + WS_R1 + R1_PREP;
    const bf16* GD = (const bf16*)(prep + PREP_GD); const float* GB = (const float*)(F.ws + WS_GB);
    LAS bf16* Qs = (LAS bf16*)F.lds; LAS bf16* Ks = Qs + 64 * 72; LAS bf16* Vs = Ks + 64 * 72;
    LAS float* At = (LAS float*)(F.lds + 27648);
    LAS bf16* ATs = (LAS bf16*)(F.lds + 60416);
    LAS bf16* XS_ = (LAS bf16*)(F.lds + 78848);
    LAS float* sm = (LAS float*)(F.lds + 115712);
    LAS float* gl = sm; LAS float* bl = sm + 128; LAS float* gcs = sm + 256; LAS float* eg = sm + 384; LAS float* ekd = sm + 512;
    const int lane = F.lane, c = lane & 15, q = lane >> 4, w = F.wave, tid = F.tid;
    for (int uu = F.bid; uu < 16 * 68; uu += F.G) {
        const int bh = uu / 68, ch = uu % 68, b = bh >> 2, hh = bh & 3;
        const int m0 = ch < 4 ? b * TC + 64 * ch : MC + b * TL + 64 * (ch - 4);
        __syncthreads();
        { const int row = tid >> 3, col8 = (tid & 7) * 8; const bf16* src = GD + (size_t)(m0 + row) * 768 + hh * 64 + col8;
          *(LAS u32x4*)(Qs + row * 72 + col8) = *(const u32x4*)(src); *(LAS u32x4*)(Ks + row * 72 + col8) = *(const u32x4*)(src + 256); *(LAS u32x4*)(Vs + row * 72 + col8) = *(const u32x4*)(src + 512);
          if (tid < 256) { const int tok = tid & 63, which = tid >> 6; sm[which * 64 + tok] = GB[(size_t)(m0 + tok) * 16 + (which >> 1) * 8 + (which & 1) * 4 + hh]; } }
        __syncthreads();
        if (w < 2) { const int d = w; const int tok = d ? 63 - lane : lane; float v = gl[d * 64 + tok];
#pragma unroll
            for (int o = 1; o < 64; o <<= 1) { const float t = __shfl_up(v, o); if (lane >= o) v += t; }
            const float last = __shfl(v, 63);
            gcs[d * 64 + lane] = v; eg[d * 64 + lane] = fexp(v); ekd[d * 64 + lane] = fexp(last - v); }
        __syncthreads();
        {
            const int type = w >> 2, ti = w & 3; const LAS bf16* X = type ? Qs : Ks;
            bf16x8 a[2];
#pragma unroll
            for (int ks = 0; ks < 2; ++ks) a[ks] = *(const LAS bf16x8*)(X + (16 * ti + c) * 72 + 32 * ks + 8 * q);
#pragma unroll
            for (int tj = 0; tj < 4; ++tj) { f32x4 acc = (f32x4){0.f, 0.f, 0.f, 0.f};
#pragma unroll
                for (int ks = 0; ks < 2; ++ks) acc = mfma16(a[ks], *(const LAS bf16x8*)(Ks + (16 * tj + c) * 72 + 32 * ks + 8 * q), acc);
#pragma unroll
                for (int r = 0; r < 4; ++r) { const int it = 16 * ti + 4 * q + r, jt = 16 * tj + c;
#pragma unroll
                    for (int d = 0; d < 2; ++d) { const int i = d ? 63 - it : it, j = d ? 63 - jt : jt;
                        const float e = fexp(fminf(gcs[d * 64 + i] - gcs[d * 64 + j], 0.f));
                        if (type == 0) At[d * 4096 + j * 64 + i] = (j < i) ? bl[d * 64 + it] * acc[r] * e : 0.f;
                        else ATs[d * 4608 + i * 72 + j] = (bf16)f2bf((j <= i) ? acc[r] * e : 0.f); } } }
        }
        __syncthreads();
        if (w < 4) {
            const int d = w >> 1, kind = w & 1; const LAS bf16* R = kind ? Ks : Vs; const LAS float* A = At + d * 4096;
            float x[64];
#pragma unroll
            for (int i = 0; i < 64; ++i) { const int tok = d ? 63 - i : i; float v = bl[d * 64 + tok] * bf2f(R[tok * 72 + lane]); if (kind) v *= eg[d * 64 + i]; x[i] = v; }
#pragma unroll
            for (int j = 0; j < 63; ++j) { const float xj = x[j];
                f32x4 ca[16];
#pragma unroll
                for (int g = ((j + 1) >> 2); g < 16; ++g) ca[g] = *(const LAS f32x4*)(A + j * 64 + 4 * g);
                __builtin_amdgcn_sched_barrier(0);
#pragma unroll
                for (int g = ((j + 1) >> 2); g < 16; ++g) { x[4 * g] -= ca[g].x * xj; x[4 * g + 1] -= ca[g].y * xj; x[4 * g + 2] -= ca[g].z * xj; x[4 * g + 3] -= ca[g].w * xj; }
                __builtin_amdgcn_sched_barrier(0); }
            LAS bf16* XO = XS_ + (d * 2 + kind) * 4608;
#pragma unroll
            for (int i = 0; i < 64; ++i) XO[i * 72 + lane] = (bf16)f2bf(x[i]);
        } else {
            const int t2 = tid - 256;
            for (int it = t2; it < 6 * 512; it += 256) { const int mat = it >> 9, chk = it & 511, d = mat & 1, kindm = mat >> 1;
                const int rt = chk >> 7, ks = (chk >> 6) & 1, ln = chk & 63, r = ln & 15, qq = ln >> 4, row = 16 * rt + r, c0 = 32 * ks + 4 * qq;
                float v[8];
                if (kindm == 0) { const u32x2 lo = *(const LAS u32x2*)(ATs + d * 4608 + row * 72 + c0), hi = *(const LAS u32x2*)(ATs + d * 4608 + row * 72 + c0 + 16);
                    v[0] = __uint_as_float(lo.x << 16); v[1] = __uint_as_float(lo.x & 0xffff0000u); v[2] = __uint_as_float(lo.y << 16); v[3] = __uint_as_float(lo.y & 0xffff0000u);
                    v[4] = __uint_as_float(hi.x << 16); v[5] = __uint_as_float(hi.x & 0xffff0000u); v[6] = __uint_as_float(hi.y << 16); v[7] = __uint_as_float(hi.y & 0xffff0000u); }
                else if (kindm == 1) { const int tok = d ? 63 - row : row; const float sc = eg[d * 64 + row];
#pragma unroll
                    for (int x8 = 0; x8 < 8; ++x8) v[x8] = bf2f(Qs[tok * 72 + c0 + (x8 & 3) + 16 * (x8 >> 2)]) * sc; }
                else {
#pragma unroll
                    for (int x8 = 0; x8 < 8; ++x8) { const int i = c0 + (x8 & 3) + 16 * (x8 >> 2); const int tok = d ? 63 - i : i; v[x8] = bf2f(Ks[tok * 72 + row]) * ekd[d * 64 + i]; } }
                const int chain = bh * 2 + d, sg = ch < 4 ? (d ? 3 - ch : ch) : 4 + (d ? 63 - (ch - 4) : ch - 4);
                unsigned char* dst = F.ws + WS_GCH + (size_t)chain * GCH_CHAIN + (size_t)sg * GCH_STEP + (kindm == 0 ? 16384 : (kindm == 1 ? 8192 : 24576));
                u32x4 o; o.x = pk2(v[0], v[1]); o.y = pk2(v[2], v[3]); o.z = pk2(v[4], v[5]); o.w = pk2(v[6], v[7]);
                *(u32x4*)(dst + chk * 16) = o; }
        }
        __syncthreads();
        {
            for (int it = tid; it < 2 * 512; it += NTHR) { const int d = it >> 9, chk = it & 511;
                const int rt = chk >> 7, ks = (chk >> 6) & 1, ln = chk & 63, r = ln & 15, qq = ln >> 4, row = 16 * rt + r, c0 = 32 * ks + 4 * qq;
                const LAS bf16* XW = XS_ + (d * 2 + 1) * 4608;
                const u32x2 lo = *(const LAS u32x2*)(XW + row * 72 + c0), hi = *(const LAS u32x2*)(XW + row * 72 + c0 + 16);
                const int chain = bh * 2 + d, sg = ch < 4 ? (d ? 3 - ch : ch) : 4 + (d ? 63 - (ch - 4) : ch - 4);
                unsigned char* dst = F.ws + WS_GCH + (size_t)chain * GCH_CHAIN + (size_t)sg * GCH_STEP;
                *(u32x4*)(dst + chk * 16) = (u32x4){lo.x, lo.y, hi.x, hi.y}; }
            for (int it = tid; it < 2 * 1024; it += NTHR) { const int d = it >> 10, cu = it & 1023;
                const int sl = cu >> 8, rt = (cu >> 6) & 3, ln = cu & 63, qq = ln >> 4, cc = ln & 15;
                const LAS bf16* XU = XS_ + (d * 2) * 4608;
                bf16 e0 = XU[(16 * rt + 4 * qq + 0) * 72 + 16 * sl + cc], e1 = XU[(16 * rt + 4 * qq + 1) * 72 + 16 * sl + cc], e2 = XU[(16 * rt + 4 * qq + 2) * 72 + 16 * sl + cc], e3 = XU[(16 * rt + 4 * qq + 3) * 72 + 16 * sl + cc];
                const int chain = bh * 2 + d, sg = ch < 4 ? (d ? 3 - ch : ch) : 4 + (d ? 63 - (ch - 4) : ch - 4);
                unsigned char* dst = F.ws + WS_GCH + (size_t)chain * GCH_CHAIN + (size_t)sg * GCH_STEP + 32768;
                *(u32x2*)(dst + cu * 8) = (u32x2){(unsigned)e0 | ((unsigned)e1 << 16), (unsigned)e2 | ((unsigned)e3 << 16)}; }
            if (tid < 2) { const int d = tid; const int chain = bh * 2 + d, sg = ch < 4 ? (d ? 3 - ch : ch) : 4 + (d ? 63 - (ch - 4) : ch - 4);
                ((float*)(F.ws + WS_GDEC))[chain * 68 + sg] = eg[d * 64 + 63]; }
        }
    }
}

__device__ __forceinline__ void phase_gdn_scan(Frame& F, int first_wg) {
    const int chain = F.bid - first_wg; if (chain < 0 || chain >= 32) return;
    const int b = chain >> 3, hh = (chain >> 1) & 3, d = chain & 1;
    const unsigned char* src = F.ws + WS_GCH + (size_t)chain * GCH_CHAIN;
    const float* decs = (const float*)(F.ws + WS_GDEC) + chain * 68;
    float* OUT = (float*)(F.ws + WS_R1 + R1_OG) + (size_t)d * M * 256;
    LAS unsigned char* ring = F.lds;
    const int lane = F.lane, w = F.wave;
    if (w >= 4) {
        const int dw = w - 4;
#define GS_ISSUE(step) do { _Pragma("unroll") for (int k = 0; k < 10; ++k) { const int p = dw * 10 + k; \
            __builtin_amdgcn_global_load_lds((const unsigned*)(src + (size_t)(step) * GCH_STEP + p * 1024 + lane * 16), (LAS unsigned*)(ring + ((step) % 3) * 40960 + p * 1024), 16, 0, 0); } } while (0)
        GS_ISSUE(0); GS_ISSUE(1);
        asm volatile("s_waitcnt vmcnt(10)" ::: "memory"); __builtin_amdgcn_s_barrier();
        for (int n = 0; n < 68; ++n) {
            if (n + 2 < 68) { GS_ISSUE(n + 2); asm volatile("s_waitcnt vmcnt(10)" ::: "memory"); }
            else asm volatile("s_waitcnt vmcnt(0)" ::: "memory");
            __builtin_amdgcn_s_barrier();
        }
#undef GS_ISSUE
    } else {
        const int sl = w, qq = lane >> 4, cc = lane & 15;
        f32x4 S[4];
#pragma unroll
        for (int rt = 0; rt < 4; ++rt) S[rt] = (f32x4){0.f, 0.f, 0.f, 0.f};
        const float dv0 = decs[lane], dv1 = decs[64 + (lane & 3)];
        asm volatile("s_waitcnt vmcnt(0)" ::: "memory"); __builtin_amdgcn_s_barrier(); asm volatile("" ::: "memory");
        for (int n = 0; n < 68; ++n) {
            const LAS unsigned char* base = ring + (n % 3) * 40960;
            const float dec = n < 64 ? __shfl(dv0, n) : __shfl(dv1, n - 64);
#define GS_FRAG(mat, rt, ks) (*(const LAS bf16x8*)(base + (mat) * 8192 + (((rt) * 2 + (ks)) * 64 + lane) * 16))
            bf16x8 BS[2], BV[2];
#pragma unroll
            for (int ks = 0; ks < 2; ++ks) { u32x4 t; t.x = cvtpk(S[2 * ks][0], S[2 * ks][1]); t.y = cvtpk(S[2 * ks][2], S[2 * ks][3]); t.z = cvtpk(S[2 * ks + 1][0], S[2 * ks + 1][1]); t.w = cvtpk(S[2 * ks + 1][2], S[2 * ks + 1][3]); BS[ks] = __builtin_bit_cast(bf16x8, t); }
            f32x4 vn[4], o[4];
#pragma unroll
            for (int rt = 0; rt < 4; ++rt) { f32x4 acc = (f32x4){0.f, 0.f, 0.f, 0.f};
#pragma unroll
                for (int ks = 0; ks < 2; ++ks) acc = mfma16(GS_FRAG(0, rt, ks), BS[ks], acc);
                const u32x2 uu = *(const LAS u32x2*)(base + 32768 + ((sl * 4 + rt) * 64 + lane) * 8);
                vn[rt] = (f32x4){__uint_as_float(uu.x << 16), __uint_as_float(uu.x & 0xffff0000u), __uint_as_float(uu.y << 16), __uint_as_float(uu.y & 0xffff0000u)} - acc;
                f32x4 oo = (f32x4){0.f, 0.f, 0.f, 0.f};
#pragma unroll
                for (int ks = 0; ks < 2; ++ks) oo = mfma16(GS_FRAG(1, rt, ks), BS[ks], oo);
                o[rt] = oo; }
#pragma unroll
            for (int ks = 0; ks < 2; ++ks) { u32x4 t; t.x = cvtpk(vn[2 * ks][0], vn[2 * ks][1]); t.y = cvtpk(vn[2 * ks][2], vn[2 * ks][3]); t.z = cvtpk(vn[2 * ks + 1][0], vn[2 * ks + 1][1]); t.w = cvtpk(vn[2 * ks + 1][2], vn[2 * ks + 1][3]); BV[ks] = __builtin_bit_cast(bf16x8, t); }
#pragma unroll
            for (int rt = 0; rt < 4; ++rt) { f32x4 oo = o[rt], sn = S[rt] * dec;
#pragma unroll
                for (int ks = 0; ks < 2; ++ks) { oo = mfma16(GS_FRAG(2, rt, ks), BV[ks], oo); sn = mfma16(GS_FRAG(3, rt, ks), BV[ks], sn); }
                o[rt] = oo; S[rt] = sn; }
#undef GS_FRAG
            const int m0 = n < 4 ? b * TC + 64 * (d ? 3 - n : n) : MC + b * TL + 64 * (d ? 63 - (n - 4) : n - 4);
#pragma unroll
            for (int rt = 0; rt < 4; ++rt)
#pragma unroll
                for (int r = 0; r < 4; ++r) { const int i = 16 * rt + 4 * qq + r, tok = d ? 63 - i : i; OUT[(size_t)(m0 + tok) * 256 + hh * 64 + 16 * sl + cc] = o[rt][r]; }
            asm volatile("s_waitcnt lgkmcnt(0)" ::: "memory"); PB(11); __builtin_amdgcn_s_barrier(); PE(11); asm volatile("" ::: "memory");
        }
    }
}


__device__ __forceinline__ void phase_gdn_local2(Frame& F) {
    unsigned char* prep = F.ws + WS_R1 + R1_PREP;
    const bf16* GD = (const bf16*)(prep + PREP_GD); const float* GB = (const float*)(F.ws + WS_GB);
    LAS bf16* Ks = (LAS bf16*)F.lds; LAS bf16* Vs = Ks + 64 * 72;
    LAS float* At = (LAS float*)(F.lds + 18432);
    LAS bf16* XS_ = (LAS bf16*)(F.lds + 51200);
    LAS float* sm = (LAS float*)(F.lds + 88064);
    LAS float* gl = sm; LAS float* bl = sm + 128; LAS float* gcs = sm + 256; LAS float* eg = sm + 384; LAS float* ekd = sm + 512;
    const int lane = F.lane, c = lane & 15, q = lane >> 4, w = F.wave, tid = F.tid;
    for (int uu = F.bid; uu < 16 * 68; uu += F.G) {
        const int bh = uu / 68, ch = uu % 68, b = bh >> 2, hh = bh & 3;
        const int m0 = ch < 4 ? b * TC + 64 * ch : MC + b * TL + 64 * (ch - 4);
        __syncthreads();
        { const int row = tid >> 3, col8 = (tid & 7) * 8; const bf16* src = GD + (size_t)(m0 + row) * 768 + hh * 64 + col8;
          *(LAS u32x4*)(Ks + row * 72 + col8) = *(const u32x4*)(src + 256); *(LAS u32x4*)(Vs + row * 72 + col8) = *(const u32x4*)(src + 512);
          if (tid < 256) { const int tok = tid & 63, which = tid >> 6; sm[which * 64 + tok] = GB[(size_t)(m0 + tok) * 16 + (which >> 1) * 8 + (which & 1) * 4 + hh]; } }
        __syncthreads();
        if (w < 2) { const int d = w; const int tok = d ? 63 - lane : lane; float v = gl[d * 64 + tok];
#pragma unroll
            for (int o = 1; o < 64; o <<= 1) { const float t = __shfl_up(v, o); if (lane >= o) v += t; }
            const float last = __shfl(v, 63);
            gcs[d * 64 + lane] = v; eg[d * 64 + lane] = fexp(v); ekd[d * 64 + lane] = fexp(last - v);
            ((float*)(F.ws + WS_GCS))[((size_t)uu * 2 + d) * 64 + tok] = v; }
        __syncthreads();
        {
            const int ti = w & 3, th = w >> 2;
            bf16x8 a[2];
#pragma unroll
            for (int ks = 0; ks < 2; ++ks) a[ks] = *(const LAS bf16x8*)(Ks + (16 * ti + c) * 72 + 32 * ks + 8 * q);
#pragma unroll
            for (int t2 = 0; t2 < 2; ++t2) { const int tj = 2 * th + t2; f32x4 acc = (f32x4){0.f, 0.f, 0.f, 0.f};
#pragma unroll
                for (int ks = 0; ks < 2; ++ks) acc = mfma16(a[ks], *(const LAS bf16x8*)(Ks + (16 * tj + c) * 72 + 32 * ks + 8 * q), acc);
#pragma unroll
                for (int r = 0; r < 4; ++r) { const int it = 16 * ti + 4 * q + r, jt = 16 * tj + c;
#pragma unroll
                    for (int d = 0; d < 2; ++d) { const int i = d ? 63 - it : it, j = d ? 63 - jt : jt;
                        const float e = fexp(fminf(gcs[d * 64 + i] - gcs[d * 64 + j], 0.f));
                        At[d * 4096 + j * 64 + i] = (j < i) ? bl[d * 64 + it] * acc[r] * e : 0.f; } } }
        }
        __syncthreads();
        if (w < 4) {
            const int d = w >> 1, kind = w & 1; const LAS bf16* R = kind ? Ks : Vs; const LAS float* A = At + d * 4096;
            float x[64];
#pragma unroll
            for (int i = 0; i < 64; ++i) { const int tok = d ? 63 - i : i; float v = bl[d * 64 + tok] * bf2f(R[tok * 72 + lane]); if (kind) v *= eg[d * 64 + i]; x[i] = v; }
#pragma unroll
            for (int j = 0; j < 63; ++j) { const float xj = x[j];
                f32x4 ca[16];
#pragma unroll
                for (int g = ((j + 1) >> 2); g < 16; ++g) ca[g] = *(const LAS f32x4*)(A + j * 64 + 4 * g);
                __builtin_amdgcn_sched_barrier(0);
#pragma unroll
                for (int g = ((j + 1) >> 2); g < 16; ++g) { x[4 * g] -= ca[g].x * xj; x[4 * g + 1] -= ca[g].y * xj; x[4 * g + 2] -= ca[g].z * xj; x[4 * g + 3] -= ca[g].w * xj; }
                __builtin_amdgcn_sched_barrier(0); }
            LAS bf16* XO = XS_ + (d * 2 + kind) * 4608;
#pragma unroll
            for (int i = 0; i < 64; ++i) XO[i * 72 + lane] = (bf16)f2bf(x[i]);
        } else {
            const int t2 = tid - 256;
            for (int it = t2; it < 2 * 512; it += 256) { const int d = it >> 9, chk = it & 511;
                const int rt = chk >> 7, ks = (chk >> 6) & 1, ln = chk & 63, r = ln & 15, qq = ln >> 4, row = 16 * rt + r, c0 = 32 * ks + 4 * qq;
                float v[8];
#pragma unroll
                for (int x8 = 0; x8 < 8; ++x8) { const int tok = c0 + (x8 & 3) + 16 * (x8 >> 2); const int i = d ? 63 - tok : tok; v[x8] = bf2f(Ks[tok * 72 + row]) * ekd[d * 64 + i]; }
                const int chain = bh * 2 + d, sg = ch < 4 ? (d ? 3 - ch : ch) : 4 + (d ? 63 - (ch - 4) : ch - 4);
                unsigned char* dst = F.ws + WS_GCH + (size_t)chain * G2_CHAIN + (size_t)sg * G2_STEP + 8192;
                u32x4 o; o.x = cvtpk(v[0], v[1]); o.y = cvtpk(v[2], v[3]); o.z = cvtpk(v[4], v[5]); o.w = cvtpk(v[6], v[7]);
                *(u32x4*)(dst + chk * 16) = o; }
        }
        __syncthreads();
        {
            for (int it = tid; it < 2 * 512; it += NTHR) { const int d = it >> 9, chk = it & 511;
                const int rt = chk >> 7, ks = (chk >> 6) & 1, ln = chk & 63, r = ln & 15, qq = ln >> 4, row = 16 * rt + r, c0 = 32 * ks + 4 * qq;
                const LAS bf16* XW = XS_ + (d * 2 + 1) * 4608;
                const int prow = d ? 63 - row : row;
                const u32x2 lo = *(const LAS u32x2*)(XW + prow * 72 + c0), hi = *(const LAS u32x2*)(XW + prow * 72 + c0 + 16);
                const int chain = bh * 2 + d, sg = ch < 4 ? (d ? 3 - ch : ch) : 4 + (d ? 63 - (ch - 4) : ch - 4);
                unsigned char* dst = F.ws + WS_GCH + (size_t)chain * G2_CHAIN + (size_t)sg * G2_STEP;
                *(u32x4*)(dst + chk * 16) = (u32x4){lo.x, lo.y, hi.x, hi.y}; }
            for (int it = tid; it < 2 * 1024; it += NTHR) { const int d = it >> 10, cu = it & 1023;
                const int sl = cu >> 8, rt = (cu >> 6) & 3, ln = cu & 63, qq = ln >> 4, cc = ln & 15;
                const LAS bf16* XU = XS_ + (d * 2) * 4608;
                const int tr = 16 * rt + 4 * qq, p0 = d ? 63 - tr : tr, ps = d ? -1 : 1;
                bf16 e0 = XU[(p0) * 72 + 16 * sl + cc], e1 = XU[(p0 + ps) * 72 + 16 * sl + cc], e2 = XU[(p0 + 2 * ps) * 72 + 16 * sl + cc], e3 = XU[(p0 + 3 * ps) * 72 + 16 * sl + cc];
                const int chain = bh * 2 + d, sg = ch < 4 ? (d ? 3 - ch : ch) : 4 + (d ? 63 - (ch - 4) : ch - 4);
                unsigned char* dst = F.ws + WS_GCH + (size_t)chain * G2_CHAIN + (size_t)sg * G2_STEP + 16384;
                *(u32x2*)(dst + cu * 8) = (u32x2){(unsigned)e0 | ((unsigned)e1 << 16), (unsigned)e2 | ((unsigned)e3 << 16)}; }
            if (tid < 2) { const int d = tid; const int chain = bh * 2 + d, sg = ch < 4 ? (d ? 3 - ch : ch) : 4 + (d ? 63 - (ch - 4) : ch - 4);
                ((float*)(F.ws + WS_GDEC))[chain * 68 + sg] = eg[d * 64 + 63]; }
        }
    }
}


__device__ __forceinline__ void phase_gdn_local3(Frame& F, int layer) {
    unsigned char* prep = F.ws + WS_R1 + R1_PREP;
    const bf16* GD = (const bf16*)(prep + PREP_GD); const float* GB = (const float*)(F.ws + WS_GB);
    const int lane = F.lane, c = lane & 15, q = lane >> 4, w = F.wave, half = w >> 2, wq = w & 3, t2 = F.tid & 255;
    LAS unsigned char* L0 = F.lds + half * 54272;
    LAS bf16* Ks = (LAS bf16*)L0; LAS bf16* Vs = Ks + 64 * 72;
    LAS float* At = (LAS float*)(L0 + 18432);
    LAS bf16* XS_ = (LAS bf16*)(L0 + 18432);
    LAS float* sm = (LAS float*)(L0 + 51200);
    LAS float* gl = sm; LAS float* bl = sm + 128; LAS float* gcs = sm + 256; LAS float* eg = sm + 384; LAS float* ekd = sm + 512;
    DynQ dq = dyn_make(F, layer, 0);
    for (int pp = dyn_bcast(dq, dyn_grab(dq)); pp < 8 * 68; ) {
        const int pp_next = dyn_grab(dq);
        const int uu = 2 * pp + half, bh = uu / 68, ch = uu % 68, b = bh >> 2, hh = bh & 3;
        const int m0 = ch < 4 ? b * TC + 64 * ch : MC + b * TL + 64 * (ch - 4);
        __syncthreads();
#pragma unroll
        for (int rep = 0; rep < 2; ++rep) { const int idx = t2 + 256 * rep, row = idx >> 3, col8 = (idx & 7) * 8; const bf16* src = GD + (size_t)(m0 + row) * 768 + hh * 64 + col8;
            *(LAS u32x4*)(Ks + row * 72 + col8) = *(const u32x4*)(src + 256); *(LAS u32x4*)(Vs + row * 72 + col8) = *(const u32x4*)(src + 512); }
        { const int tok = t2 & 63, which = t2 >> 6; sm[which * 64 + tok] = GB[(size_t)(m0 + tok) * 16 + (which >> 1) * 8 + (which & 1) * 4 + hh]; }
        __syncthreads();
        if (wq < 2) { const int d = wq; const int tok = d ? 63 - lane : lane; float v = gl[d * 64 + tok];
#pragma unroll
            for (int o = 1; o < 64; o <<= 1) { const float t = __shfl_up(v, o); if (lane >= o) v += t; }
            const float last = __shfl(v, 63);
            gcs[d * 64 + lane] = v; eg[d * 64 + lane] = fexp(v); ekd[d * 64 + lane] = fexp(last - v);
            ((float*)(F.ws + WS_GCS))[((size_t)uu * 2 + d) * 64 + tok] = v; }
        __syncthreads();
        {
            const int ti = wq;
            bf16x8 a[2];
#pragma unroll
            for (int ks = 0; ks < 2; ++ks) a[ks] = *(const LAS bf16x8*)(Ks + (16 * ti + c) * 72 + 32 * ks + 8 * q);
#pragma unroll
            for (int tj = 0; tj < 4; ++tj) { f32x4 acc = (f32x4){0.f, 0.f, 0.f, 0.f};
#pragma unroll
                for (int ks = 0; ks < 2; ++ks) acc = mfma16(a[ks], *(const LAS bf16x8*)(Ks + (16 * tj + c) * 72 + 32 * ks + 8 * q), acc);
#pragma unroll
                for (int r = 0; r < 4; ++r) { const int it = 16 * ti + 4 * q + r, jt = 16 * tj + c;
#pragma unroll
                    for (int d = 0; d < 2; ++d) { const int i = d ? 63 - it : it, j = d ? 63 - jt : jt;
                        const float e = fexp(fminf(gcs[d * 64 + i] - gcs[d * 64 + j], 0.f));
                        At[d * 4096 + j * 64 + i] = (j < i) ? bl[d * 64 + it] * acc[r] * e : 0.f; } } }
        }
        __syncthreads();
        float x[64];
        const int sd = wq >> 1, kind = wq & 1;
        {
            const LAS bf16* R = kind ? Ks : Vs; const LAS float* A = At + sd * 4096;
#pragma unroll
            for (int i = 0; i < 64; ++i) { const int tok = sd ? 63 - i : i; float v = bl[sd * 64 + tok] * bf2f(R[tok * 72 + lane]); if (kind) v *= eg[sd * 64 + i]; x[i] = v; }
#pragma unroll
            for (int j = 0; j < 63; ++j) { const float xj = x[j];
                f32x4 ca[16];
#pragma unroll
                for (int g = ((j + 1) >> 2); g < 16; ++g) ca[g] = *(const LAS f32x4*)(A + j * 64 + 4 * g);
                __builtin_amdgcn_sched_barrier(0);
#pragma unroll
                for (int g = ((j + 1) >> 2); g < 16; ++g) { x[4 * g] -= ca[g].x * xj; x[4 * g + 1] -= ca[g].y * xj; x[4 * g + 2] -= ca[g].z * xj; x[4 * g + 3] -= ca[g].w * xj; }
                __builtin_amdgcn_sched_barrier(0); }
        }
        __syncthreads();
        { LAS bf16* XO = XS_ + (sd * 2 + kind) * 4096;
#pragma unroll
          for (int i = 0; i < 64; ++i) XO[(sd ? 63 - i : i) * 64 + lane] = (bf16)f2bf(x[i]); }
        __syncthreads();
        {
            for (int it = t2; it < 2 * 512; it += 256) { const int d = it >> 9, chk = it & 511;
                const int rt = chk >> 7, ks = (chk >> 6) & 1, ln = chk & 63, r = ln & 15, qq = ln >> 4, row = 16 * rt + r, c0 = 32 * ks + 4 * qq;
                const int chain = bh * 2 + d, sg = ch < 4 ? (d ? 3 - ch : ch) : 4 + (d ? 63 - (ch - 4) : ch - 4);
                unsigned char* dst = F.ws + WS_GCH + (size_t)chain * G2_CHAIN + (size_t)sg * G2_STEP;
                const LAS bf16* XW = XS_ + (d * 2 + 1) * 4096;
                const u32x2 lo = *(const LAS u32x2*)(XW + row * 64 + c0), hi = *(const LAS u32x2*)(XW + row * 64 + c0 + 16);
                *(u32x4*)(dst + chk * 16) = (u32x4){lo.x, lo.y, hi.x, hi.y};
                float v[8];
#pragma unroll
                for (int x8 = 0; x8 < 8; ++x8) { const int tok = c0 + (x8 & 3) + 16 * (x8 >> 2); const int i = d ? 63 - tok : tok; v[x8] = bf2f(Ks[tok * 72 + row]) * ekd[d * 64 + i]; }
                u32x4 o; o.x = cvtpk(v[0], v[1]); o.y = cvtpk(v[2], v[3]); o.z = cvtpk(v[4], v[5]); o.w = cvtpk(v[6], v[7]);
                *(u32x4*)(dst + 8192 + chk * 16) = o; }
            for (int it = t2; it < 2 * 1024; it += 256) { const int d = it >> 10, cu = it & 1023;
                const int sl = cu >> 8, rt = (cu >> 6) & 3, ln = cu & 63, qq = ln >> 4, cc = ln & 15;
                const LAS bf16* XU = XS_ + (d * 2) * 4096; const int tr = 16 * rt + 4 * qq;
                const bf16 e0 = XU[(tr) * 64 + 16 * sl + cc], e1 = XU[(tr + 1) * 64 + 16 * sl + cc], e2 = XU[(tr + 2) * 64 + 16 * sl + cc], e3 = XU[(tr + 3) * 64 + 16 * sl + cc];
                const int chain = bh * 2 + d, sg = ch < 4 ? (d ? 3 - ch : ch) : 4 + (d ? 63 - (ch - 4) : ch - 4);
                unsigned char* dst = F.ws + WS_GCH + (size_t)chain * G2_CHAIN + (size_t)sg * G2_STEP + 16384;
                *(u32x2*)(dst + cu * 8) = (u32x2){(unsigned)e0 | ((unsigned)e1 << 16), (unsigned)e2 | ((unsigned)e3 << 16)}; }
            if (t2 < 2) { const int d = t2; const int chain = bh * 2 + d, sg = ch < 4 ? (d ? 3 - ch : ch) : 4 + (d ? 63 - (ch - 4) : ch - 4);
                ((float*)(F.ws + WS_GDEC))[chain * 68 + sg] = eg[d * 64 + 63]; }
        }
        pp = dyn_bcast(dq, pp_next);
    }
}

__device__ __forceinline__ void phase_gdn_scan2(Frame& F, int first_wg) {
    const int chain = F.bid - first_wg; if (chain < 0 || chain >= 32) return;
    const int d = chain & 1;
    const unsigned char* src = F.ws + WS_GCH + (size_t)chain * G2_CHAIN;
    const float* decs = (const float*)(F.ws + WS_GDEC) + chain * 68;
    bf16* GST = (bf16*)(F.ws + WS_GST) + (size_t)chain * 68 * 8192;
    LAS unsigned char* ring = F.lds;
    const int lane = F.lane, w = F.wave;
    if (w >= 2) {
        const int dw = w - 2;
#define GS2_ISSUE(step) do { _Pragma("unroll") for (int k = 0; k < 4; ++k) { const int p = dw * 4 + k; \
            __builtin_amdgcn_global_load_lds((const unsigned*)(src + (size_t)(step) * G2_STEP + p * 1024 + lane * 16), (LAS unsigned*)(ring + ((step) & 3) * 24576 + p * 1024), 16, 0, 0); } } while (0)
        GS2_ISSUE(0); GS2_ISSUE(1); GS2_ISSUE(2);
        asm volatile("s_waitcnt vmcnt(8)" ::: "memory"); __builtin_amdgcn_s_barrier();
        for (int n = 0; n < 68; ++n) {
            if (n + 3 < 68) { GS2_ISSUE(n + 3); asm volatile("s_waitcnt vmcnt(8)" ::: "memory"); }
            else if (n + 2 < 68) asm volatile("s_waitcnt vmcnt(4)" ::: "memory");
            else asm volatile("s_waitcnt vmcnt(0)" ::: "memory");
            __builtin_amdgcn_s_barrier();
        }
#undef GS2_ISSUE
    } else {
        const int qq = lane >> 4, cc = lane & 15;
        f32x4 S[2][4];
#pragma unroll
        for (int ct = 0; ct < 2; ++ct)
#pragma unroll
            for (int rt = 0; rt < 4; ++rt) S[ct][rt] = (f32x4){0.f, 0.f, 0.f, 0.f};
        const float dv0 = decs[lane], dv1 = decs[64 + (lane & 3)];
        asm volatile("s_waitcnt vmcnt(0)" ::: "memory"); __builtin_amdgcn_s_barrier(); asm volatile("" ::: "memory");
        for (int n = 0; n < 68; ++n) {
            const LAS unsigned char* base = ring + (n & 3) * 24576;
            const float dec = n < 64 ? __shfl(dv0, n) : __shfl(dv1, n - 64);
            bf16* st = GST + (size_t)n * 8192;
            bf16* vt = st + 4096;
#define GS2_FRAG(mat, rt, ks) (*(const LAS bf16x8*)(base + (mat) * 8192 + (((rt) * 2 + (ks)) * 64 + lane) * 16))
            bf16x8 wf[4][2], kf[4][2]; u32x2 uf[2][4];
#pragma unroll
            for (int rt = 0; rt < 4; ++rt) { wf[rt][0] = GS2_FRAG(0, rt, 0); wf[rt][1] = GS2_FRAG(0, rt, 1); }
#pragma unroll
            for (int ct = 0; ct < 2; ++ct)
#pragma unroll
                for (int rt = 0; rt < 4; ++rt) uf[ct][rt] = *(const LAS u32x2*)(base + 16384 + (((2 * w + ct) * 4 + rt) * 64 + lane) * 8);
#pragma unroll
            for (int rt = 0; rt < 4; ++rt) { kf[rt][0] = GS2_FRAG(1, rt, 0); kf[rt][1] = GS2_FRAG(1, rt, 1); }
            __builtin_amdgcn_sched_barrier(0);
            bf16x8 BS[2][2], BV[2][2];
#pragma unroll
            for (int ct = 0; ct < 2; ++ct) { const int e = 32 * w + 16 * ct + cc;
#pragma unroll
                for (int ks = 0; ks < 2; ++ks) { u32x4 t; t.x = cvtpk(S[ct][2 * ks][0], S[ct][2 * ks][1]); t.y = cvtpk(S[ct][2 * ks][2], S[ct][2 * ks][3]); t.z = cvtpk(S[ct][2 * ks + 1][0], S[ct][2 * ks + 1][1]); t.w = cvtpk(S[ct][2 * ks + 1][2], S[ct][2 * ks + 1][3]);
                    BS[ct][ks] = __builtin_bit_cast(bf16x8, t);
                    *(u32x2*)(st + e * 64 + 32 * ks + 4 * qq) = (u32x2){t.x, t.y}; *(u32x2*)(st + e * 64 + 32 * ks + 16 + 4 * qq) = (u32x2){t.z, t.w}; } }
            f32x4 vn[2][4];
#pragma unroll
            for (int ks = 0; ks < 2; ++ks)
#pragma unroll
                for (int rt = 0; rt < 4; ++rt)
#pragma unroll
                    for (int ct = 0; ct < 2; ++ct) vn[ct][rt] = mfma16(wf[rt][ks], BS[ct][ks], ks ? vn[ct][rt] : (f32x4){0.f, 0.f, 0.f, 0.f});
#pragma unroll
            for (int ct = 0; ct < 2; ++ct)
#pragma unroll
                for (int rt = 0; rt < 4; ++rt) { const u32x2 uu = uf[ct][rt];
                    vn[ct][rt] = (f32x4){__uint_as_float(uu.x << 16), __uint_as_float(uu.x & 0xffff0000u), __uint_as_float(uu.y << 16), __uint_as_float(uu.y & 0xffff0000u)} - vn[ct][rt]; }
#pragma unroll
            for (int ct = 0; ct < 2; ++ct) { const int e = 32 * w + 16 * ct + cc;
#pragma unroll
                for (int ks = 0; ks < 2; ++ks) { u32x4 t; t.x = cvtpk(vn[ct][2 * ks][0], vn[ct][2 * ks][1]); t.y = cvtpk(vn[ct][2 * ks][2], vn[ct][2 * ks][3]); t.z = cvtpk(vn[ct][2 * ks + 1][0], vn[ct][2 * ks + 1][1]); t.w = cvtpk(vn[ct][2 * ks + 1][2], vn[ct][2 * ks + 1][3]);
                    BV[ct][ks] = __builtin_bit_cast(bf16x8, t);
                    if (d == 0) { *(u32x2*)(vt + e * 64 + 32 * ks + 4 * qq) = (u32x2){t.x, t.y}; *(u32x2*)(vt + e * 64 + 32 * ks + 16 + 4 * qq) = (u32x2){t.z, t.w}; }
                    else { const u32x2 r0 = (u32x2){(t.y >> 16) | (t.y << 16), (t.x >> 16) | (t.x << 16)}, r1 = (u32x2){(t.w >> 16) | (t.w << 16), (t.z >> 16) | (t.z << 16)};
                        *(u32x2*)(vt + e * 64 + 60 - 32 * ks - 4 * qq) = r0; *(u32x2*)(vt + e * 64 + 44 - 32 * ks - 4 * qq) = r1; } } }
#pragma unroll
            for (int ct = 0; ct < 2; ++ct)
#pragma unroll
                for (int rt = 0; rt < 4; ++rt) S[ct][rt] = S[ct][rt] * dec;
#pragma unroll
            for (int ks = 0; ks < 2; ++ks)
#pragma unroll
                for (int rt = 0; rt < 4; ++rt)
#pragma unroll
                    for (int ct = 0; ct < 2; ++ct) S[ct][rt] = mfma16(kf[rt][ks], BV[ct][ks], S[ct][rt]);
#undef GS2_FRAG
            asm volatile("s_waitcnt lgkmcnt(0)" ::: "memory"); __builtin_amdgcn_s_barrier(); asm volatile("" ::: "memory");
        }
    }
}

__device__ __forceinline__ void phase_gdn_out(Frame& F, const Inputs& in, int layer) {
    const bf16* P = (const bf16*)(F.ws + WS_R1 + R1_P);
    const bf16* GD = (const bf16*)(F.ws + WS_R1 + R1_PREP + PREP_GD);
    const bf16* GST = (const bf16*)(F.ws + WS_GST); const float* GCS = (const float*)(F.ws + WS_GCS);
    bf16* O = (bf16*)(F.ws + WS_R1 + R1_O);
    const int lane = F.lane, c = lane & 15, q = lane >> 4, w = F.wave, half = w >> 2, ti = w & 3, t2 = F.tid & 255;
    LAS bf16* Qs = (LAS bf16*)(F.lds + half * 56320); LAS bf16* Ks = Qs + 4608; LAS bf16* St = Ks + 4608; LAS bf16* Vn = St + 2 * 4608;
    LAS float* gT = (LAS float*)(F.lds + half * 56320 + 55296);
    for (int pp = F.bid; pp < 8 * 68; pp += F.G) {
        const int uu = 2 * pp + half, bh = uu / 68, ch = uu % 68, b = bh >> 2, hh = bh & 3;
        const int m0 = ch < 4 ? b * TC + 64 * ch : MC + b * TL + 64 * (ch - 4);
        __syncthreads();
#pragma unroll
        for (int rep = 0; rep < 2; ++rep) { const int idx = t2 + 256 * rep, row = idx >> 3, col8 = (idx & 7) * 8;
            const bf16* src = GD + (size_t)(m0 + row) * 768 + hh * 64 + col8;
            *(LAS u32x4*)(Qs + row * 72 + col8) = *(const u32x4*)(src); *(LAS u32x4*)(Ks + row * 72 + col8) = *(const u32x4*)(src + 256);
#pragma unroll
            for (int d = 0; d < 2; ++d) { const int sg = ch < 4 ? (d ? 3 - ch : ch) : 4 + (d ? 63 - (ch - 4) : ch - 4);
                const bf16* g = GST + ((size_t)(bh * 2 + d) * 68 + sg) * 8192 + row * 64 + col8;
                *(LAS u32x4*)(St + d * 4608 + row * 72 + col8) = *(const u32x4*)(g); *(LAS u32x4*)(Vn + d * 4608 + row * 72 + col8) = *(const u32x4*)(g + 4096); } }
        if (t2 < 128) gT[t2] = GCS[(size_t)uu * 128 + t2];
        __syncthreads();
        bf16x8 qf[2];
#pragma unroll
        for (int ks = 0; ks < 2; ++ks) qf[ks] = *(const LAS bf16x8*)(Qs + (16 * ti + c) * 72 + 32 * ks + 8 * q);
        const int i = 16 * ti + c;
        const float gi0 = gT[i], gi1 = gT[64 + i];
        f32x4 sacc[4];
#pragma unroll
        for (int tj = 0; tj < 4; ++tj) { f32x4 acc = (f32x4){0.f, 0.f, 0.f, 0.f};
#pragma unroll
            for (int ks = 0; ks < 2; ++ks) acc = mfma16(*(const LAS bf16x8*)(Ks + (16 * tj + c) * 72 + 32 * ks + 8 * q), qf[ks], acc);
            sacc[tj] = acc; }
        bf16x8 pb[2][2];
#pragma unroll
        for (int d = 0; d < 2; ++d) { f32x4 p[4];
#pragma unroll
            for (int tj = 0; tj < 4; ++tj) { const f32x4 gj = *(const LAS f32x4*)(gT + d * 64 + 16 * tj + 4 * q);
#pragma unroll
                for (int r = 0; r < 4; ++r) { const int j = 16 * tj + 4 * q + r; const bool ok = d ? (j >= i) : (j <= i);
                    p[tj][r] = ok ? sacc[tj][r] * fexp(fminf((d ? gi1 : gi0) - gj[r], 0.f)) : 0.f; } }
#pragma unroll
            for (int ks2 = 0; ks2 < 2; ++ks2) { u32x4 t; t.x = cvtpk(p[2 * ks2][0], p[2 * ks2][1]); t.y = cvtpk(p[2 * ks2][2], p[2 * ks2][3]); t.z = cvtpk(p[2 * ks2 + 1][0], p[2 * ks2 + 1][1]); t.w = cvtpk(p[2 * ks2 + 1][2], p[2 * ks2 + 1][3]); pb[d][ks2] = __builtin_bit_cast(bf16x8, t); } }
        const float sc0 = fexp(gi0), sc1 = fexp(gi1);
        f32x4 o[4]; float ssq = 0.f;
#pragma unroll
        for (int te = 0; te < 4; ++te) { f32x4 acc = (f32x4){0.f, 0.f, 0.f, 0.f}, t0 = acc, t1 = acc;
#pragma unroll
            for (int d = 0; d < 2; ++d)
#pragma unroll
                for (int ks2 = 0; ks2 < 2; ++ks2) { const u32x2 lo = *(const LAS u32x2*)(Vn + d * 4608 + (16 * te + c) * 72 + 32 * ks2 + 4 * q), hi = *(const LAS u32x2*)(Vn + d * 4608 + (16 * te + c) * 72 + 32 * ks2 + 16 + 4 * q);
                    acc = mfma16(__builtin_bit_cast(bf16x8, ((u32x4){lo.x, lo.y, hi.x, hi.y})), pb[d][ks2], acc); }
#pragma unroll
            for (int ks = 0; ks < 2; ++ks) { t0 = mfma16(*(const LAS bf16x8*)(St + (16 * te + c) * 72 + 32 * ks + 8 * q), qf[ks], t0);
                t1 = mfma16(*(const LAS bf16x8*)(St + 4608 + (16 * te + c) * 72 + 32 * ks + 8 * q), qf[ks], t1); }
            o[te] = acc + sc0 * t0 + sc1 * t1; ssq += (o[te][0] * o[te][0] + o[te][1] * o[te][1]) + (o[te][2] * o[te][2] + o[te][3] * o[te][3]); }
        ssq = quad_rows_sum(ssq);
        const float rs = 1.0f / sqrtf(ssq * (1.0f / 64.0f) + EPS);
#pragma unroll
        for (int te = 0; te < 4; ++te) { const int e0 = 16 * te + 4 * q;
            const u32x2 z2 = *(const u32x2*)(P + (size_t)(m0 + i) * NP + PC_GZ + hh * 64 + e0); const f32x4 gn = *(const f32x4*)(in.gdn_norm_g + layer * 64 + e0);
            const float z0 = __uint_as_float(z2.x << 16), z1 = __uint_as_float(z2.x & 0xffff0000u), z2f = __uint_as_float(z2.y << 16), z3 = __uint_as_float(z2.y & 0xffff0000u);
            u32x2 wv; wv.x = cvtpk(o[te][0] * rs * gn[0] * siluf(z0), o[te][1] * rs * gn[1] * siluf(z1)); wv.y = cvtpk(o[te][2] * rs * gn[2] * siluf(z2f), o[te][3] * rs * gn[3] * siluf(z3));
            *(u32x2*)(O + (size_t)(m0 + i) * D + 256 + hh * 64 + e0) = wv; }
    }
}


__device__ __forceinline__ void phase_gdn_scan3(Frame& F, int first_wg) {
    const int chain = F.bid - first_wg; if (chain < 0 || chain >= 32) return;
    const unsigned char* src = F.ws + WS_GCH + (size_t)chain * G2_CHAIN;
    const float* decs = (const float*)(F.ws + WS_GDEC) + chain * 68;
    unsigned char* GSTb = F.ws + WS_GST + (size_t)chain * 68 * 16384;
    LAS unsigned char* ring = F.lds;
    const int lane = F.lane, w = F.wave;
    if (w >= 4) {
        const int dw = w - 4;
#define GS3_ISSUE(step) do { _Pragma("unroll") for (int k = 0; k < 6; ++k) { const int p = dw * 6 + k; \
            __builtin_amdgcn_global_load_lds((const unsigned*)(src + (size_t)(step) * G2_STEP + p * 1024 + lane * 16), (LAS unsigned*)(ring + ((step) & 3) * 24576 + p * 1024), 16, 0, 0); } } while (0)
        GS3_ISSUE(0); GS3_ISSUE(1); GS3_ISSUE(2);
        asm volatile("s_waitcnt vmcnt(12)" ::: "memory"); __builtin_amdgcn_s_barrier();
        for (int n = 0; n < 68; ++n) {
            if (n + 3 < 68) { GS3_ISSUE(n + 3); asm volatile("s_waitcnt vmcnt(12)" ::: "memory"); }
            else if (n + 2 < 68) asm volatile("s_waitcnt vmcnt(6)" ::: "memory");
            else asm volatile("s_waitcnt vmcnt(0)" ::: "memory");
            __builtin_amdgcn_s_barrier();
        }
#undef GS3_ISSUE
    } else {
        const int sl = w;
        f32x4 S[4];
#pragma unroll
        for (int rt = 0; rt < 4; ++rt) S[rt] = (f32x4){0.f, 0.f, 0.f, 0.f};
        const float dv0 = decs[lane], dv1 = decs[64 + (lane & 3)];
        asm volatile("s_waitcnt vmcnt(0)" ::: "memory"); __builtin_amdgcn_s_barrier(); asm volatile("" ::: "memory");
        for (int n = 0; n < 68; ++n) {
            const LAS unsigned char* base = ring + (n & 3) * 24576;
            const float dec = n < 64 ? __shfl(dv0, n) : __shfl(dv1, n - 64);
            unsigned char* go = GSTb + (size_t)n * 16384 + (size_t)(sl * 2 * 64 + lane) * 16;
#define GS3_FRAG(mat, rt, ks) (*(const LAS bf16x8*)(base + (mat) * 8192 + (((rt) * 2 + (ks)) * 64 + lane) * 16))
            bf16x8 wf[4][2], kf[4][2]; u32x2 uf[4];
#pragma unroll
            for (int rt = 0; rt < 4; ++rt) { wf[rt][0] = GS3_FRAG(0, rt, 0); wf[rt][1] = GS3_FRAG(0, rt, 1); }
#pragma unroll
            for (int rt = 0; rt < 4; ++rt) uf[rt] = *(const LAS u32x2*)(base + 16384 + ((sl * 4 + rt) * 64 + lane) * 8);
#pragma unroll
            for (int rt = 0; rt < 4; ++rt) { kf[rt][0] = GS3_FRAG(1, rt, 0); kf[rt][1] = GS3_FRAG(1, rt, 1); }
#undef GS3_FRAG
            __builtin_amdgcn_sched_barrier(0);
            bf16x8 BS[2], BV[2];
#pragma unroll
            for (int ks = 0; ks < 2; ++ks) { u32x4 t; t.x = cvtpk(S[2 * ks][0], S[2 * ks][1]); t.y = cvtpk(S[2 * ks][2], S[2 * ks][3]); t.z = cvtpk(S[2 * ks + 1][0], S[2 * ks + 1][1]); t.w = cvtpk(S[2 * ks + 1][2], S[2 * ks + 1][3]);
                BS[ks] = __builtin_bit_cast(bf16x8, t); *(u32x4*)(go + ks * 1024) = t; }
            f32x4 vn[4];
#pragma unroll
            for (int ks = 0; ks < 2; ++ks)
#pragma unroll
                for (int rt = 0; rt < 4; ++rt) vn[rt] = mfma16(wf[rt][ks], BS[ks], ks ? vn[rt] : (f32x4){0.f, 0.f, 0.f, 0.f});
#pragma unroll
            for (int rt = 0; rt < 4; ++rt) { const u32x2 uu = uf[rt];
                vn[rt] = (f32x4){__uint_as_float(uu.x << 16), __uint_as_float(uu.x & 0xffff0000u), __uint_as_float(uu.y << 16), __uint_as_float(uu.y & 0xffff0000u)} - vn[rt]; }
#pragma unroll
            for (int ks = 0; ks < 2; ++ks) { u32x4 t; t.x = cvtpk(vn[2 * ks][0], vn[2 * ks][1]); t.y = cvtpk(vn[2 * ks][2], vn[2 * ks][3]); t.z = cvtpk(vn[2 * ks + 1][0], vn[2 * ks + 1][1]); t.w = cvtpk(vn[2 * ks + 1][2], vn[2 * ks + 1][3]);
                BV[ks] = __builtin_bit_cast(bf16x8, t); *(u32x4*)(go + 8192 + ks * 1024) = t; }
#pragma unroll
            for (int rt = 0; rt < 4; ++rt) S[rt] = S[rt] * dec;
#pragma unroll
            for (int ks = 0; ks < 2; ++ks)
#pragma unroll
                for (int rt = 0; rt < 4; ++rt) S[rt] = mfma16(kf[rt][ks], BV[ks], S[rt]);
            asm volatile("s_waitcnt lgkmcnt(0)" ::: "memory"); __builtin_amdgcn_s_barrier(); asm volatile("" ::: "memory");
        }
    }
}

__device__ __forceinline__ void phase_gdn_out2(Frame& F, const Inputs& in, int layer) {
    const bf16* P = (const bf16*)(F.ws + WS_R1 + R1_P);
    const bf16* GD = (const bf16*)(F.ws + WS_R1 + R1_PREP + PREP_GD);
    const unsigned char* GSTb = F.ws + WS_GST; const float* GCS = (const float*)(F.ws + WS_GCS);
    bf16* O = (bf16*)(F.ws + WS_R1 + R1_O);
    const int lane = F.lane, c = lane & 15, q = lane >> 4, w = F.wave, half = w >> 2, ti = w & 3, t2 = F.tid & 255;
    LAS bf16* Qs = (LAS bf16*)(F.lds + half * 56320); LAS bf16* Ks = Qs + 4608;
    LAS unsigned char* Fr = F.lds + half * 56320 + 18432;
    LAS float* gT = (LAS float*)(F.lds + half * 56320 + 55296);
    DynQ dq = dyn_make(F, layer, 4);
    for (int pp = dyn_bcast(dq, dyn_grab(dq)); pp < 8 * 68; ) {
        const int pp_next = dyn_grab(dq);
        const int uu = 2 * pp + half, bh = uu / 68, ch = uu % 68, b = bh >> 2, hh = bh & 3;
        const int m0 = ch < 4 ? b * TC + 64 * ch : MC + b * TL + 64 * (ch - 4);
        __syncthreads();
#pragma unroll
        for (int rep = 0; rep < 2; ++rep) { const int idx = t2 + 256 * rep, row = idx >> 3, col8 = (idx & 7) * 8;
            const bf16* src = GD + (size_t)(m0 + row) * 768 + hh * 64 + col8;
            *(LAS u32x4*)(Qs + row * 72 + col8) = *(const u32x4*)(src); *(LAS u32x4*)(Ks + row * 72 + col8) = *(const u32x4*)(src + 256); }
#pragma unroll
        for (int d = 0; d < 2; ++d) { const int sg = ch < 4 ? (d ? 3 - ch : ch) : 4 + (d ? 63 - (ch - 4) : ch - 4);
            const unsigned char* g = GSTb + ((size_t)(bh * 2 + d) * 68 + sg) * 16384;
#pragma unroll
            for (int rep = 0; rep < 4; ++rep) { const int idx = t2 + 256 * rep; *(LAS u32x4*)(Fr + d * 16384 + idx * 16) = *(const u32x4*)(g + (size_t)idx * 16); } }
        if (t2 < 128) gT[t2] = GCS[(size_t)uu * 128 + t2];
        __syncthreads();
        bf16x8 qf[2], qr[2];
#pragma unroll
        for (int ks = 0; ks < 2; ++ks) { qf[ks] = *(const LAS bf16x8*)(Qs + (16 * ti + c) * 72 + 32 * ks + 8 * q);
            const u32x2 lo = *(const LAS u32x2*)(Qs + (16 * ti + c) * 72 + 32 * ks + 4 * q), hi = *(const LAS u32x2*)(Qs + (16 * ti + c) * 72 + 32 * ks + 16 + 4 * q);
            qr[ks] = __builtin_bit_cast(bf16x8, ((u32x4){lo.x, lo.y, hi.x, hi.y})); }
        const int i = 16 * ti + c;
        const float gi0 = gT[i], gi1 = gT[64 + i];
        f32x4 sacc[4];
#pragma unroll
        for (int tj = 0; tj < 4; ++tj) { f32x4 acc = (f32x4){0.f, 0.f, 0.f, 0.f};
#pragma unroll
            for (int ks = 0; ks < 2; ++ks) acc = mfma16(*(const LAS bf16x8*)(Ks + (16 * tj + c) * 72 + 32 * ks + 8 * q), qf[ks], acc);
            sacc[tj] = acc; }
        bf16x8 pb[2][2];
#pragma unroll
        for (int d = 0; d < 2; ++d) { f32x4 p[4];
#pragma unroll
            for (int tj = 0; tj < 4; ++tj) { const f32x4 gj = *(const LAS f32x4*)(gT + d * 64 + 16 * tj + 4 * q);
#pragma unroll
                for (int r = 0; r < 4; ++r) { const int j = 16 * tj + 4 * q + r; const bool ok = d ? (j >= i) : (j <= i);
                    p[tj][r] = ok ? sacc[tj][r] * fexp(fminf((d ? gi1 : gi0) - gj[r], 0.f)) : 0.f; } }
#pragma unroll
            for (int ks2 = 0; ks2 < 2; ++ks2) { u32x4 t; t.x = cvtpk(p[2 * ks2][0], p[2 * ks2][1]); t.y = cvtpk(p[2 * ks2][2], p[2 * ks2][3]); t.z = cvtpk(p[2 * ks2 + 1][0], p[2 * ks2 + 1][1]); t.w = cvtpk(p[2 * ks2 + 1][2], p[2 * ks2 + 1][3]); pb[d][ks2] = __builtin_bit_cast(bf16x8, t); } }
        const float sc0 = fexp(gi0), sc1 = fexp(gi1);
        f32x4 o[4]; float ssq = 0.f;
#pragma unroll
        for (int te = 0; te < 4; ++te) { f32x4 acc = (f32x4){0.f, 0.f, 0.f, 0.f}, t0 = acc, t1 = acc;
#pragma unroll
            for (int ks = 0; ks < 2; ++ks) {
                acc = mfma16(*(const LAS bf16x8*)(Fr + 8192 + ((te * 2 + ks) * 64 + lane) * 16), pb[0][ks], acc);
                acc = mfma16(*(const LAS bf16x8*)(Fr + 16384 + 8192 + ((te * 2 + ks) * 64 + lane) * 16), pb[1][ks], acc);
                t0 = mfma16(*(const LAS bf16x8*)(Fr + ((te * 2 + ks) * 64 + lane) * 16), qr[ks], t0);
                t1 = mfma16(*(const LAS bf16x8*)(Fr + 16384 + ((te * 2 + ks) * 64 + lane) * 16), qr[ks], t1); }
            o[te] = acc + sc0 * t0 + sc1 * t1; ssq += (o[te][0] * o[te][0] + o[te][1] * o[te][1]) + (o[te][2] * o[te][2] + o[te][3] * o[te][3]); }
        ssq = quad_rows_sum(ssq);
        const float rs = 1.0f / sqrtf(ssq * (1.0f / 64.0f) + EPS);
#pragma unroll
        for (int te = 0; te < 4; ++te) { const int e0 = 16 * te + 4 * q;
            const u32x2 z2 = *(const u32x2*)(P + (size_t)(m0 + i) * NP + PC_GZ + hh * 64 + e0); const f32x4 gn = *(const f32x4*)(in.gdn_norm_g + layer * 64 + e0);
            const float z0 = __uint_as_float(z2.x << 16), z1 = __uint_as_float(z2.x & 0xffff0000u), z2f = __uint_as_float(z2.y << 16), z3 = __uint_as_float(z2.y & 0xffff0000u);
            u32x2 wv; wv.x = cvtpk(o[te][0] * rs * gn[0] * siluf(z0), o[te][1] * rs * gn[1] * siluf(z1)); wv.y = cvtpk(o[te][2] * rs * gn[2] * siluf(z2f), o[te][3] * rs * gn[3] * siluf(z3));
            *(u32x2*)(O + (size_t)(m0 + i) * D + 256 + hh * 64 + e0) = wv; }
        pp = dyn_bcast(dq, pp_next);
    }
}

__device__ __forceinline__ void phase_ret_kv(Frame& F, const Inputs& in, int layer) {
    const bf16* P = (const bf16*)(F.ws + WS_R1 + R1_P);
    const bf16* RK = (const bf16*)(F.ws + WS_R1 + R1_PREP + PREP_RK);
    LAS bf16* Kt = (LAS bf16*)F.lds; LAS bf16* Vw = Kt + 64 * 72;
    const int lane = F.lane, c = lane & 15, q = lane >> 4, w = F.wave, tid = F.tid;
    const float LOG2E = 1.4426950408889634f;
    DynQ dq = dyn_make(F, layer, 2);
    for (int uu = dyn_bcast(dq, dyn_grab(dq)); uu < 16 * 68; ) {
        const int uu_next = dyn_grab(dq);
        const int bh = uu / 68, ch = uu % 68, b = bh >> 2, hh = bh & 3;
        const int m0 = ch < 4 ? b * TC + 64 * ch : MC + b * TL + 64 * (ch - 4);
        const float l0 = -fexp(in.ret_decay[layer * 8 + hh]) * LOG2E, l1 = -fexp(in.ret_decay[layer * 8 + 4 + hh]) * LOG2E;
        __syncthreads();
        { const int j = tid >> 3, col8 = (tid & 7) * 8;
          const u32x4 k8 = *(const u32x4*)(RK + (size_t)(m0 + j) * 256 + hh * 64 + col8), v8 = *(const u32x4*)(P + (size_t)(m0 + j) * NP + PC_RV + hh * 64 + col8);
          const float w0 = fexp2((float)(63 - j) * l0), w1 = fexp2((float)j * l1);
#pragma unroll
          for (int x = 0; x < 8; ++x) { const unsigned kk = (k8[x >> 1] >> (16 * (x & 1))) & 0xffffu; const float vv = __uint_as_float(((v8[x >> 1] >> (16 * (x & 1))) & 0xffffu) << 16);
              Kt[(col8 + x) * 72 + j] = (bf16)kk; Vw[(col8 + x) * 72 + j] = (bf16)f2bf(vv * w0); Vw[4608 + (col8 + x) * 72 + j] = (bf16)f2bf(vv * w1); } }
        __syncthreads();
        { const int d = w >> 2, td = w & 3;
          bf16x8 a[2];
#pragma unroll
          for (int ks = 0; ks < 2; ++ks) a[ks] = *(const LAS bf16x8*)(Kt + (16 * td + c) * 72 + 32 * ks + 8 * q);
          const int chain = bh * 2 + d, sg = d ? (ch < 4 ? 3 - ch : 71 - ch) : ch;
          float* dst = (float*)(F.ws + WS_RKV) + ((size_t)chain * 68 + sg) * 4096;
#pragma unroll
          for (int te = 0; te < 4; ++te) { f32x4 acc = (f32x4){0.f, 0.f, 0.f, 0.f};
#pragma unroll
              for (int ks = 0; ks < 2; ++ks) acc = mfma16(a[ks], *(const LAS bf16x8*)(Vw + d * 4608 + (16 * te + c) * 72 + 32 * ks + 8 * q), acc);
              *(f32x4*)(dst + (16 * te + c) * 64 + 16 * td + 4 * q) = acc; } }
        uu = dyn_bcast(dq, uu_next);
    }
}
__device__ __forceinline__ void phase_ret_state(Frame& F, const Inputs& in, int layer, int nwg) {
    if (F.bid >= nwg) return;
    const float* RKV = (const float*)(F.ws + WS_RKV); bf16* RST = (bf16*)(F.ws + WS_RST);
    for (int el = F.bid * NTHR + F.tid; el < 32 * 4096; el += nwg * NTHR) {
        const int chain = el >> 12, idx = el & 4095, hh = (chain >> 1) & 3, d = chain & 1;
        const float G64 = fexp(-64.0f * fexp(in.ret_decay[layer * 8 + d * 4 + hh]));
        const float* kv = RKV + (size_t)chain * 68 * 4096 + idx; bf16* st = RST + (size_t)chain * 68 * 4096 + idx;
        float S = 0.f;
#pragma unroll
        for (int h2 = 0; h2 < 2; ++h2) { float kvv[34];
#pragma unroll
            for (int sg = 0; sg < 34; ++sg) kvv[sg] = kv[(size_t)(34 * h2 + sg) * 4096];
#pragma unroll
            for (int sg = 0; sg < 34; ++sg) { st[(size_t)(34 * h2 + sg) * 4096] = (bf16)f2bf(S); S = G64 * S + kvv[sg]; } }
    }
}
__device__ __forceinline__ void phase_ret_out(Frame& F, const Inputs& in, int layer) {
    const bf16* P = (const bf16*)(F.ws + WS_R1 + R1_P);
    const bf16* RQ = (const bf16*)(F.ws + WS_R1 + R1_PREP + PREP_RQ); const bf16* RK = (const bf16*)(F.ws + WS_R1 + R1_PREP + PREP_RK);
    const bf16* RST = (const bf16*)(F.ws + WS_RST);
    bf16* O = (bf16*)(F.ws + WS_R1 + R1_O);
    const int lane = F.lane, c = lane & 15, q = lane >> 4, w = F.wave, half = w >> 2, ti = w & 3, t2 = F.tid & 255;
    LAS bf16* Qs = (LAS bf16*)(F.lds + half * 46080); LAS bf16* Ks = Qs + 4608; LAS bf16* Vt = Ks + 4608; LAS bf16* St = Vt + 4608;
    const float LOG2E = 1.4426950408889634f;
    DynQ dq = dyn_make(F, layer, 3);
    for (int pp = dyn_bcast(dq, dyn_grab(dq)); pp < 8 * 68; ) {
        const int pp_next = dyn_grab(dq);
        const int uu = 2 * pp + half, bh = uu / 68, ch = uu % 68, b = bh >> 2, hh = bh & 3;
        const int m0 = ch < 4 ? b * TC + 64 * ch : MC + b * TL + 64 * (ch - 4);
        const float l0 = -fexp(in.ret_decay[layer * 8 + hh]) * LOG2E, l1 = -fexp(in.ret_decay[layer * 8 + 4 + hh]) * LOG2E;
        __syncthreads();
#pragma unroll
        for (int rep = 0; rep < 2; ++rep) { const int idx = t2 + 256 * rep, row = idx >> 3, col8 = (idx & 7) * 8;
            *(LAS u32x4*)(Qs + row * 72 + col8) = *(const u32x4*)(RQ + (size_t)(m0 + row) * 256 + hh * 64 + col8);
            *(LAS u32x4*)(Ks + row * 72 + col8) = *(const u32x4*)(RK + (size_t)(m0 + row) * 256 + hh * 64 + col8);
            const u32x4 v8 = *(const u32x4*)(P + (size_t)(m0 + row) * NP + PC_RV + hh * 64 + col8);
#pragma unroll
            for (int x = 0; x < 8; ++x) Vt[(col8 + x) * 72 + row] = (bf16)(v8[x >> 1] >> (16 * (x & 1)));
#pragma unroll
            for (int d = 0; d < 2; ++d) { const int sg = d ? (ch < 4 ? 3 - ch : 71 - ch) : ch;
                *(LAS u32x4*)(St + d * 4608 + row * 72 + col8) = *(const u32x4*)(RST + ((size_t)(bh * 2 + d) * 68 + sg) * 4096 + row * 64 + col8); } }
        __syncthreads();
        bf16x8 qf[2];
#pragma unroll
        for (int ks = 0; ks < 2; ++ks) qf[ks] = *(const LAS bf16x8*)(Qs + (16 * ti + c) * 72 + 32 * ks + 8 * q);
        const int i = 16 * ti + c;
        f32x4 p[4];
#pragma unroll
        for (int tj = 0; tj < 4; ++tj) { f32x4 acc = (f32x4){0.f, 0.f, 0.f, 0.f};
#pragma unroll
            for (int ks = 0; ks < 2; ++ks) acc = mfma16(*(const LAS bf16x8*)(Ks + (16 * tj + c) * 72 + 32 * ks + 8 * q), qf[ks], acc);
#pragma unroll
            for (int r = 0; r < 4; ++r) { const int dlt = i - (16 * tj + 4 * q + r);
                const float wgt = (dlt >= 0 ? fexp2((float)dlt * l0) : 0.f) + (dlt <= 0 ? fexp2((float)(-dlt) * l1) : 0.f);
                acc[r] *= wgt; }
            p[tj] = acc; }
        bf16x8 pb[2];
#pragma unroll
        for (int ks2 = 0; ks2 < 2; ++ks2) { u32x4 t; t.x = cvtpk(p[2 * ks2][0], p[2 * ks2][1]); t.y = cvtpk(p[2 * ks2][2], p[2 * ks2][3]); t.z = cvtpk(p[2 * ks2 + 1][0], p[2 * ks2 + 1][1]); t.w = cvtpk(p[2 * ks2 + 1][2], p[2 * ks2 + 1][3]); pb[ks2] = __builtin_bit_cast(bf16x8, t); }
        const float sc0 = fexp2((float)(i + 1) * l0), sc1 = fexp2((float)(64 - i) * l1);
        f32x4 o[4]; float sum = 0.f;
#pragma unroll
        for (int te = 0; te < 4; ++te) { f32x4 acc = (f32x4){0.f, 0.f, 0.f, 0.f}, t0 = acc, t1 = acc;
#pragma unroll
            for (int ks2 = 0; ks2 < 2; ++ks2) { const u32x2 lo = *(const LAS u32x2*)(Vt + (16 * te + c) * 72 + 32 * ks2 + 4 * q), hi = *(const LAS u32x2*)(Vt + (16 * te + c) * 72 + 32 * ks2 + 16 + 4 * q);
                acc = mfma16(__builtin_bit_cast(bf16x8, ((u32x4){lo.x, lo.y, hi.x, hi.y})), pb[ks2], acc); }
#pragma unroll
            for (int ks = 0; ks < 2; ++ks) { t0 = mfma16(*(const LAS bf16x8*)(St + (16 * te + c) * 72 + 32 * ks + 8 * q), qf[ks], t0);
                t1 = mfma16(*(const LAS bf16x8*)(St + 4608 + (16 * te + c) * 72 + 32 * ks + 8 * q), qf[ks], t1); }
            o[te] = acc + sc0 * t0 + sc1 * t1; sum += (o[te][0] + o[te][1]) + (o[te][2] + o[te][3]); }
        sum = quad_rows_sum(sum);
        const float mu = sum * (1.0f / 64.0f); float vs = 0.f;
#pragma unroll
        for (int te = 0; te < 4; ++te) { o[te] = o[te] - mu; vs += (o[te][0] * o[te][0] + o[te][1] * o[te][1]) + (o[te][2] * o[te][2] + o[te][3] * o[te][3]); }
        vs = quad_rows_sum(vs);
        const float rs = 1.0f / sqrtf(vs * (1.0f / 64.0f) + EPS);
#pragma unroll
        for (int te = 0; te < 4; ++te) { const int e0 = hh * 64 + 16 * te + 4 * q;
            const u32x2 g2 = *(const u32x2*)(P + (size_t)(m0 + i) * NP + PC_RG + e0); const f32x4 gn = *(const f32x4*)(in.ret_gn_g + layer * 256 + e0);
            const float g0 = __uint_as_float(g2.x << 16), g1 = __uint_as_float(g2.x & 0xffff0000u), g2f = __uint_as_float(g2.y << 16), g3 = __uint_as_float(g2.y & 0xffff0000u);
            u32x2 wv; wv.x = cvtpk(o[te][0] * rs * gn[0] * siluf(g0), o[te][1] * rs * gn[1] * siluf(g1)); wv.y = cvtpk(o[te][2] * rs * gn[2] * siluf(g2f), o[te][3] * rs * gn[3] * siluf(g3));
            *(u32x2*)(O + (size_t)(m0 + i) * D + e0) = wv; }
        pp = dyn_bcast(dq, pp_next);
    }
}

__device__ __forceinline__ void phase_finish(Frame& F, const Inputs& in, int layer) {
    const bf16* P = (const bf16*)(F.ws + WS_R1 + R1_P);
    const float* OG = (const float*)(F.ws + WS_R1 + R1_OG);
    bf16* O = (bf16*)(F.ws + WS_R1 + R1_O);
    const int lane = F.lane;
    for (int m = F.gw; m < M; m += F.NGW) {
#pragma unroll
        for (int hh = 0; hh < 4; ++hh) {
            const float o2 = OG[(size_t)m * 256 + hh * 64 + lane] + OG[(size_t)(M + m) * 256 + hh * 64 + lane];
            const float ms = wave_sum(o2 * o2) * (1.0f / 64.0f);
            const float z = bf2f(P[(size_t)m * NP + PC_GZ + hh * 64 + lane]);
            const float y2 = o2 * (1.0f / sqrtf(ms + EPS)) * in.gdn_norm_g[layer * 64 + lane] * siluf(z);
            O[(size_t)m * D + 256 + hh * 64 + lane] = (bf16)f2bf(y2);
        }
    }
}

__device__ __forceinline__ void phase_route(Frame& F, int m_lo) {
    if (F.bid != 0) return;
    const int* TKE = (const int*)(F.ws + WS_TKE);
    int* TOKROW = (int*)(F.ws + WS_TOKROW); int* ROWTOK = (int*)(F.ws + WS_ROWTOK); int* TILEE = (int*)(F.ws + WS_TILEE);
    LAS int* cnt = (LAS int*)F.lds;
    LAS int* tot = cnt + 512 * 8;
    const int ntok = M - m_lo, per = (ntok + NTHR - 1) / NTHR;
    const int a0 = m_lo + F.tid * per, a1 = (a0 + per < M) ? a0 + per : M;
    int c[8];
#pragma unroll
    for (int e = 0; e < 8; ++e) c[e] = 0;
    for (int m = a0; m < a1; ++m) { const int e0 = TKE[2 * m], e1 = TKE[2 * m + 1];
#pragma unroll
        for (int e = 0; e < 8; ++e) c[e] += (e0 == e) + (e1 == e); }
#pragma unroll
    for (int e = 0; e < 8; ++e) cnt[F.tid * 8 + e] = c[e];
    __syncthreads();
    if (F.tid < 8) { int run = 0; for (int i = 0; i < NTHR; ++i) { const int v = cnt[i * 8 + F.tid]; cnt[i * 8 + F.tid] = run; run += v; } tot[F.tid] = run; }
    __syncthreads();
    if (F.tid == 0) { int st = 0; for (int e = 0; e < 8; ++e) { tot[8 + e] = st; const int pad = (tot[e] + 255) / 256 * 256;
            for (int tl = st / 256; tl < (st + pad) / 256; ++tl) TILEE[tl] = e; st += pad; }
        TILEE[256] = st / 256; }
    __syncthreads();
    int pos[8];
#pragma unroll
    for (int e = 0; e < 8; ++e) pos[e] = tot[8 + e] + cnt[F.tid * 8 + e];
    for (int m = a0; m < a1; ++m) {
#pragma unroll
        for (int k = 0; k < 2; ++k) { const int ee = TKE[2 * m + k]; int row = 0;
#pragma unroll
            for (int e = 0; e < 8; ++e) if (ee == e) { row = pos[e]; pos[e] = row + 1; }
            ROWTOK[row] = m; TOKROW[2 * m + k] = row; } }
    for (int e = 0; e < 8; ++e) { const int st = tot[8 + e] + tot[e], en = tot[8 + e] + (tot[e] + 255) / 256 * 256; for (int r = st + F.tid; r < en; r += NTHR) ROWTOK[r] = -1; }
}
__device__ __forceinline__ void phase_permute(Frame& F) {
    const int* ROWTOK = (const int*)(F.ws + WS_ROWTOK); const int nrows = ((const int*)(F.ws + WS_TILEE))[256] * 256;
    const bf16* H = (const bf16*)(F.ws + WS_H); bf16* HP = (bf16*)(F.ws + WS_HP);
    for (int r = F.gw; r < nrows; r += F.NGW) { const int tok = ROWTOK[r];
#pragma unroll
        for (int j = 0; j < 2; ++j) { u32x4 v = (u32x4){0u, 0u, 0u, 0u}; if (tok >= 0) v = *(const u32x4*)(H + (size_t)tok * D + 8 * F.lane + 512 * j); *(u32x4*)(HP + (size_t)r * D + 8 * F.lane + 512 * j) = v; } }
}


__device__ __forceinline__ void phase_permute2(Frame& F, int route_lo) {
    const int* TKE = (const int*)(F.ws + WS_TKE); int* TOKROW = (int*)(F.ws + WS_TOKROW); int* TILEE = (int*)(F.ws + WS_TILEE);
    const int* WGCNT = (const int*)(F.ws + WS_TILEE + 4096);
    const bf16* H = (const bf16*)(F.ws + WS_H); bf16* HP = (bf16*)(F.ws + WS_HP);
    LAS int* base = (LAS int*)F.lds;
    LAS int* tot = base + 256 * 8;
    __syncthreads();
    {
        LAS int* scn = base + 256 * 8 + 64;
        int cnt8[8];
#pragma unroll
        for (int e = 0; e < 8; ++e) cnt8[e] = (F.tid < F.G) ? WGCNT[F.tid * 8 + e] : 0;
#pragma unroll
        for (int e = 0; e < 8; ++e) scn[F.tid * 8 + e] = cnt8[e];
        __syncthreads();
        int cur = 0;
        for (int off = 1; off < NTHR; off <<= 1) { int v[8];
#pragma unroll
            for (int e = 0; e < 8; ++e) v[e] = scn[cur * 4096 + F.tid * 8 + e] + (F.tid >= off ? scn[cur * 4096 + (F.tid - off) * 8 + e] : 0);
#pragma unroll
            for (int e = 0; e < 8; ++e) scn[(cur ^ 1) * 4096 + F.tid * 8 + e] = v[e];
            __syncthreads(); cur ^= 1; }
        if (F.tid < F.G) {
#pragma unroll
            for (int e = 0; e < 8; ++e) base[F.tid * 8 + e] = scn[cur * 4096 + F.tid * 8 + e] - cnt8[e]; }
        if (F.tid < 8) tot[F.tid] = scn[cur * 4096 + (F.G - 1) * 8 + F.tid];
    }
    __syncthreads();
    if (F.tid == 0) { int st = 0; for (int e = 0; e < 8; ++e) { tot[8 + e] = st; const int pad = (tot[e] + 255) / 256 * 256;
            if (F.bid == 0) for (int tl = st / 256; tl < (st + pad) / 256; ++tl) TILEE[tl] = e;
            st += pad; }
        if (F.bid == 0) TILEE[256] = st / 256; }
    __syncthreads();
    const int lane = F.lane;
    for (int m = route_lo + F.gw; m < M; m += F.NGW) {
        const int gwm = m < MC ? m : (int)((((long)(m - MC + 1)) * F.NGW - 1) / ML), wg = gwm >> 3;
        const int e0 = TKE[2 * m], e1 = TKE[2 * m + 1];
        const int r0 = tot[8 + e0] + base[wg * 8 + e0] + TOKROW[2 * m], r1 = tot[8 + e1] + base[wg * 8 + e1] + TOKROW[2 * m + 1];
        const u32x4 a = *(const u32x4*)(H + (size_t)m * D + 8 * lane), b = *(const u32x4*)(H + (size_t)m * D + 512 + 8 * lane);
        *(u32x4*)(HP + (size_t)r0 * D + 8 * lane) = a; *(u32x4*)(HP + (size_t)r0 * D + 512 + 8 * lane) = b;
        *(u32x4*)(HP + (size_t)r1 * D + 8 * lane) = a; *(u32x4*)(HP + (size_t)r1 * D + 512 + 8 * lane) = b;
        asm volatile("" ::: "memory");
        if (lane == 0) { TOKROW[2 * m] = r0; TOKROW[2 * m + 1] = r1; }
    }
    for (int e = 0; e < 8; ++e) { const int st = tot[8 + e] + tot[e], en = tot[8 + e] + (tot[e] + 255) / 256 * 256;
        for (int r = st + F.gw; r < en; r += F.NGW) { *(u32x4*)(HP + (size_t)r * D + 8 * lane) = (u32x4){0u, 0u, 0u, 0u}; *(u32x4*)(HP + (size_t)r * D + 512 + 8 * lane) = (u32x4){0u, 0u, 0u, 0u}; } }
}

constexpr int NPH = 12;
constexpr int PH_TOTAL = 1 + DEPTH * NPH + 1;
__host__ __device__ inline bool phase_exists(int ph) {
    if (ph == 0 || ph == PH_TOTAL - 1) return true;
    const int layer = (ph - 1) / NPH, j = (ph - 1) % NPH;
    if (!(layer & 1) && j >= 10) return false;
    if ((layer & 1) && j >= 11) return false;
    return true;
}
__global__ void __launch_bounds__(NTHR, 2) fwd_kernel(Args args) {
    extern __shared__ __attribute__((aligned(16))) unsigned char lds_raw[];
    Frame F;
    F.lds = (LAS unsigned char*)lds_raw;
    F.tid = threadIdx.x; F.lane = F.tid & 63; F.wave = __builtin_amdgcn_readfirstlane(F.tid >> 6);
    const int wave0 = F.wave;
    F.G = gridDim.x; F.bid = blockIdx.x; F.gw = blockIdx.x * NWAVES + F.wave; F.NGW = F.G * NWAVES; F.ws = args.ws;
    volatile LAS unsigned* MISC = (volatile LAS unsigned*)(F.lds + MISC_OFF);
    LAS unsigned long long* ptab = (LAS unsigned long long*)(F.lds + MISC_OFF + 128);
    if (F.tid < 32) MISC[F.tid] = 0u;
    if (PROBE_ON && F.tid == 65) { ((volatile LAS unsigned long long*)(F.lds + 132096))[0] = 0ull; ((volatile LAS unsigned long long*)(F.lds + 132096))[1] = 0ull; }
    if (F.tid == 64) { const Inputs& ai = args.in;
        ptab[0] = (unsigned long long)ai.x; ptab[1] = (unsigned long long)ai.c; ptab[2] = (unsigned long long)ai.ctx; ptab[3] = (unsigned long long)ai.c_ctx; ptab[4] = (unsigned long long)ai.ada_w; ptab[5] = (unsigned long long)ai.ada_b;
        ptab[6] = (unsigned long long)ai.norm1_g; ptab[7] = (unsigned long long)ai.w_in; ptab[8] = (unsigned long long)ai.ret_decay; ptab[9] = (unsigned long long)ai.ret_gn_g; ptab[10] = (unsigned long long)ai.gdn_conv_w; ptab[11] = (unsigned long long)ai.gdn_a_log;
        ptab[12] = (unsigned long long)ai.gdn_dt_bias; ptab[13] = (unsigned long long)ai.gdn_norm_g; ptab[14] = (unsigned long long)ai.swa_sink; ptab[15] = (unsigned long long)ai.w_out; ptab[16] = (unsigned long long)ai.norm2_g; ptab[17] = (unsigned long long)ai.ffn_w1;
        ptab[18] = (unsigned long long)ai.ffn_w3; ptab[19] = (unsigned long long)ai.ffn_w2; ptab[20] = (unsigned long long)ai.router_w; ptab[21] = (unsigned long long)ai.moe_w1; ptab[22] = (unsigned long long)ai.moe_w3; ptab[23] = (unsigned long long)ai.moe_w2; ptab[24] = (unsigned long long)ai.final_g; }
    __syncthreads();
    XcdBarrier bar; bar.bar = (unsigned*)(F.ws + WS_CTL) + CW_BAR; bar.x = 0; bar.st = nullptr; bar.w0 = F.wave;
    const int lo = args.ph_lo, hi = args.ph_hi;
    const bool multi = (hi - lo) > 1;
    if (multi) bar = xcd_barrier_post((unsigned*)(F.ws + WS_CTL) + CW_BAR, MISC + 8);
#define LAUNDER() GAS unsigned char* _w = (GAS unsigned char*)args.ws; asm volatile("" : "+s"(_w)); F.ws = (unsigned char*)_w; asm volatile("" ::: "memory"); { int _t = (wave0 << 6) | (int)__builtin_amdgcn_mbcnt_hi(~0u, __builtin_amdgcn_mbcnt_lo(~0u, 0u)); asm volatile("" : "+v"(_t)); int _b = blockIdx.x; asm volatile("" : "+s"(_b)); F.tid = _t; F.lane = _t & 63; F.wave = __builtin_amdgcn_readfirstlane(_t >> 6); F.bid = _b; F.gw = _b * NWAVES + F.wave; } const Inputs in = load_inputs(ptab)
#define RELAUNDER() do { GAS unsigned char* _w2 = (GAS unsigned char*)args.ws; asm volatile("" : "+s"(_w2)); F.ws = (unsigned char*)_w2; int _t = (wave0 << 6) | (int)__builtin_amdgcn_mbcnt_hi(~0u, __builtin_amdgcn_mbcnt_lo(~0u, 0u)); asm volatile("" : "+v"(_t)); int _b = blockIdx.x; asm volatile("" : "+s"(_b)); F.tid = _t; F.lane = _t & 63; F.wave = __builtin_amdgcn_readfirstlane(_t >> 6); F.bid = _b; F.gw = _b * NWAVES + F.wave; asm volatile("" ::: "memory"); } while (0)
#define IN(k) (lo <= (k) && (k) < hi)
#define STAMP(k) do { if (PROBE_ON && !(PROBE_CUSTOM) && blockIdx.x == 0 && xb_leader(F.wave)) { volatile LAS unsigned long long* _st = (volatile LAS unsigned long long*)(F.lds + 132096); const unsigned long long _now = __builtin_amdgcn_s_memrealtime(), _prev = _st[0]; _st[0] = _now; \
    const int _ph = (k) - 1; bool _sel = false; if (_ph == 0) _sel = (PROBE_PRO) != 0; else if (_ph > 0) { const int _l = (_ph - 1) / NPH, _j = (_ph - 1) % NPH; _sel = (((PROBE_LMASK) >> _l) & 1u) && (((PROBE_JMASK) >> _j) & 1u); } if (_sel) _st[1] = _st[1] + (_now - _prev); } } while (0)
#define SEAM(k) do { if (IN(k) && IN((k) + 1)) { xcd_barrier(bar); STAMP((k) + 1); } } while (0)
    LAS unsigned char* ring = F.lds;

    STAMP(0);
    if (IN(0)) { LAUNDER(); phase_prologue(F, in); } SEAM(0);

#define LAYER_BODY(layer) { \
        const int p0 = 1 + layer * NPH; \
        const bool moe = layer & 1; \
        if (IN(p0 + 0)) { LAUNDER(); phase_token2<0>(F, in, layer, layer == 0, layer > 0 && ((layer - 1) & 1), false, nullptr, 0, (layer > 0 && !((layer - 1) & 1)) ? 11 : 0); } \
        SEAM(p0 + 0); \
        if (IN(p0 + 1)) { LAUNDER(); pg8::StaticOrder S; S.init(F.ws + WS_H, (bf16*)(F.ws + WS_WIN) + (size_t)layer * NP * D, M, NP, D, F.G, F.bid); \
            pg8::EpiBf16 E{(bf16*)(F.ws + WS_R1 + R1_P), NP}; pg8::gemm_phase<D, D, pg8::EpiBf16, pg8::StaticOrder>(ring, S, E, F.tid); } \
        SEAM(p0 + 1); \
        if (IN(p0 + 2)) { LAUNDER(); phase_prep3(F, in, layer); } \
        SEAM(p0 + 2); \
        if (IN(p0 + 3)) { LAUNDER(); PB(4); phase_gdn_local3(F, layer); PE(4); RELAUNDER(); PB(5); phase_ret_kv(F, in, layer); PE(5); RELAUNDER(); PB(3); phase_swa2(F, in, layer, F.G); PE(3); } \
        SEAM(p0 + 3); \
        if (IN(p0 + 4)) { LAUNDER(); PB(1); phase_gdn_scan3(F, F.G - 32); PE(1); RELAUNDER(); PB(2); phase_ret_state(F, in, layer, F.G - 32); PE(2); RELAUNDER(); convert_moe_layer(F, in, (layer) >> 1, (layer) & 1, F.G - 32); } \
        SEAM(p0 + 4); \
        if (IN(p0 + 5)) { LAUNDER(); PB(6); phase_ret_out(F, in, layer); PE(6); RELAUNDER(); PB(7); phase_gdn_out2(F, in, layer); PE(7); } \
        SEAM(p0 + 5); \
        if (IN(p0 + 6)) { LAUNDER(); \
            { pg8::StaticOrder S; S.init(F.ws + WS_R1 + R1_O, (bf16*)(F.ws + WS_WOUT) + (size_t)layer * D * D, ML, D, D, F.G, F.bid, 4); \
              pg8::EpiResid E{(float*)(F.ws + WS_XS), (const float*)(F.ws + WS_MOD) + (size_t)layer * 5 * 6 * D, 2, (layer) == 0 ? in.x : nullptr}; pg8::gemm_phase<D, D, pg8::EpiResid, pg8::StaticOrder>(ring, S, E, F.tid); } \
            if (layer < DEPTH - 1) { RELAUNDER(); \
              pg8::SplitOrder S; S.init(F.ws + WS_R1 + R1_O, (bf16*)(F.ws + WS_WOUT) + (size_t)layer * D * D, D, 4, F.G, F.bid); \
              pg8::EpiSlab E{(float*)(F.ws + WS_R1 + 100 * MiB)}; pg8::gemm_phase<256, D, pg8::EpiSlab, pg8::SplitOrder>(ring, S, E, F.tid); } } \
        SEAM(p0 + 6); \
        if (IN(p0 + 7)) { LAUNDER(); phase_token2<1>(F, in, layer, false, false, moe, nullptr, layer == DEPTH - 1 ? MC : 0, layer < DEPTH - 1 ? 4 : 0); } \
        SEAM(p0 + 7); \
        if (!moe) { \
            if (IN(p0 + 8)) { LAUNDER(); pg8::StaticOrder S; S.init(F.ws + WS_H, (bf16*)(F.ws + WS_W13) + (size_t)(layer >> 1) * 2 * FF * D, M, 2 * FF, D, F.G, F.bid); \
                pg8::EpiSwiglu E{(bf16*)(F.ws + WS_R1 + R1_HID), FF}; pg8::gemm_phase<D, D, pg8::EpiSwiglu, pg8::StaticOrder>(ring, S, E, F.tid); } \
            SEAM(p0 + 8); \
            if (IN(p0 + 9)) { LAUNDER(); \
                { pg8::StaticOrder S; S.init(F.ws + WS_R1 + R1_HID, (bf16*)(F.ws + WS_W2) + (size_t)(layer >> 1) * D * FF, ML, D, FF, F.G, F.bid, 4); \
                  pg8::EpiResid E{(float*)(F.ws + WS_XS), (const float*)(F.ws + WS_MOD) + (size_t)layer * 5 * 6 * D, 5, nullptr}; pg8::gemm_phase<FF, FF, pg8::EpiResid, pg8::StaticOrder>(ring, S, E, F.tid); } \
                { RELAUNDER(); \
                  pg8::SplitOrder S; S.init(F.ws + WS_R1 + R1_HID, (bf16*)(F.ws + WS_W2) + (size_t)(layer >> 1) * D * FF, FF, 11, F.G, F.bid); \
                  pg8::EpiSlab E{(float*)(F.ws + WS_R1 + 100 * MiB)}; pg8::gemm_phase<256, FF, pg8::EpiSlab, pg8::SplitOrder>(ring, S, E, F.tid); } } \
            if (IN(p0 + 9) && IN(p0 + NPH)) { xcd_barrier(bar); STAMP(p0 + 10); } \
        } else { \
            if (IN(p0 + 8)) { LAUNDER(); phase_permute2(F, layer == DEPTH - 1 ? MC : 0); } \
            SEAM(p0 + 8); \
            if (IN(p0 + 9)) { LAUNDER(); const int* tile_e = (const int*)(F.ws + WS_TILEE); const int ntiles = __builtin_amdgcn_readfirstlane(tile_e[256]); \
                pg8::GroupedOrder S; S.init(F.ws + WS_HP, F.ws + WS_MW13, ntiles, 2 * EF, D, F.G, F.bid, tile_e); \
                pg8::EpiSwiglu E{(bf16*)(F.ws + WS_R1 + R1_HID), EF}; pg8::gemm_phase<D, D, pg8::EpiSwiglu, pg8::GroupedOrder>(ring, S, E, F.tid); } \
            SEAM(p0 + 9); \
            if (IN(p0 + 10)) { LAUNDER(); const int* tile_e = (const int*)(F.ws + WS_TILEE); const int ntiles = __builtin_amdgcn_readfirstlane(tile_e[256]); \
                const int tmain = (ntiles - (ntiles / 64) * 64 <= 16) ? (ntiles / 64) * 64 : ntiles; \
                { pg8::GroupedOrder S; S.init(F.ws + WS_R1 + R1_HID, F.ws + WS_MW2, tmain, D, EF, F.G, F.bid, tile_e); \
                  pg8::EpiBf16 E{(bf16*)(F.ws + WS_YM), D}; pg8::gemm_phase<EF, EF, pg8::EpiBf16, pg8::GroupedOrder>(ring, S, E, F.tid); } \
                if (ntiles > tmain) { RELAUNDER(); const int* tile_e2 = (const int*)(F.ws + WS_TILEE); \
                  pg8::SplitGroupedOrder S; S.init(F.ws + WS_R1 + R1_HID, F.ws + WS_MW2, tmain, ntiles - tmain, F.G, F.bid, tile_e2); \
                  pg8::EpiYMSlab E{(float*)(F.ws + WS_YM), (float*)(F.ws + WS_HP), tmain * 256}; pg8::gemm_phase<896, EF, pg8::EpiYMSlab, pg8::SplitGroupedOrder>(ring, S, E, F.tid); } } \
            if (IN(p0 + 10) && IN(p0 + NPH)) { xcd_barrier(bar); STAMP(p0 + 11); } \
        } \
    }
    LAYER_BODY(0) LAYER_BODY(1) LAYER_BODY(2) LAYER_BODY(3)
#undef LAYER_BODY
    if (IN(PH_TOTAL - 1)) { LAUNDER(); phase_token2<2>(F, in, DEPTH, false, true, false, args.out); }
    if (PROBE_ON && (int)blockIdx.x == ((PROBE_CUSTOM) ? (PROBE_BLOCK < 0 ? (int)gridDim.x + (PROBE_BLOCK) : (PROBE_BLOCK)) : 0) && xb_leader(F.wave)) {
        STAMP(PH_TOTAL);
        const unsigned long long T = ((volatile LAS unsigned long long*)(F.lds + 132096))[1];
        const unsigned long long t0 = __builtin_amdgcn_s_memrealtime();
        while (__builtin_amdgcn_s_memrealtime() - t0 < 8ull * T) __builtin_amdgcn_s_sleep(8);
    }
#undef IN
#undef SEAM
}

extern "C" void kernel_launch(void* const* d_in, const int* in_sizes, int n_in, void* d_out, int out_size, void* d_ws, size_t ws_size, hipStream_t stream) {
    static int grid = 0;
    if (grid == 0) {
        if (n_in != 25 || out_size != ML * D || ws_size < WS_END) { fprintf(stderr, "kernel_launch: unexpected problem: n_in %d out %d ws %zu (need %zu)\n", n_in, out_size, ws_size, (size_t)WS_END); grid = -1; return; }
        int dev = 0, cus = 0, per_cu = 0;
        if (hipGetDevice(&dev) != hipSuccess || hipDeviceGetAttribute(&cus, hipDeviceAttributeMultiprocessorCount, dev) != hipSuccess) { grid = -1; return; }
        if (hipFuncSetAttribute((const void*)fwd_kernel, hipFuncAttributeMaxDynamicSharedMemorySize, LDS_BYTES) != hipSuccess) { fprintf(stderr, "kernel_launch: hipFuncSetAttribute failed\n"); grid = -1; return; }
        if (hipOccupancyMaxActiveBlocksPerMultiprocessor(&per_cu, (const void*)fwd_kernel, NTHR, LDS_BYTES) != hipSuccess || per_cu < 1) fprintf(stderr, "kernel_launch: occupancy query reports %d\n", per_cu);
        (void)hipGetLastError();
        grid = cus;
    }
    if (grid < 0) return;
    (void)hipMemsetAsync((char*)d_ws + WS_CTL, 0, CTL_ZERO_BYTES, stream);
    Args a{};
    const float** ip = (const float**)&a.in;
    for (int i = 0; i < 25; ++i) ip[i] = (const float*)d_in[i];
    a.out = (float*)d_out; a.ws = (unsigned char*)d_ws;
#if MK_ONE_LAUNCH
    a.ph_lo = 0; a.ph_hi = PH_TOTAL;
    hipLaunchKernelGGL(fwd_kernel, dim3(grid), dim3(NTHR), LDS_BYTES, stream, a);
#else
    for (int ph = 0; ph < PH_TOTAL; ++ph) { if (!phase_exists(ph)) continue; a.ph_lo = ph; a.ph_hi = ph + 1;
        hipLaunchKernelGGL(fwd_kernel, dim3(grid), dim3(NTHR), LDS_BYTES, stream, a); }
#endif
}
```

```cpp
#include <hip/hip_runtime.h>
#include <cstdio>
#include <cstdint>

#ifndef PROBE_JMASK
#define PROBE_JMASK 0u
#endif
#ifndef PROBE_LMASK
#define PROBE_LMASK 15u
#endif
#ifndef PROBE_PRO
#define PROBE_PRO 0
#endif
#ifndef PROBE_CUSTOM
#define PROBE_CUSTOM 0
#endif
#ifndef PROBE_BLOCK
#define PROBE_BLOCK 0
#endif
#define PROBE_ON ((PROBE_JMASK) != 0u || (PROBE_PRO) != 0 || (PROBE_CUSTOM) != 0)
#define PB(id) do { if ((PROBE_CUSTOM) == (id) && (int)blockIdx.x == (PROBE_BLOCK < 0 ? (int)gridDim.x + (PROBE_BLOCK) : (PROBE_BLOCK)) && xb_leader(F.wave)) ((volatile LAS unsigned long long*)(F.lds + 132096))[2] = __builtin_amdgcn_s_memrealtime(); } while (0)
#define PE(id) do { if ((PROBE_CUSTOM) == (id) && (int)blockIdx.x == (PROBE_BLOCK < 0 ? (int)gridDim.x + (PROBE_BLOCK) : (PROBE_BLOCK)) && xb_leader(F.wave)) { volatile LAS unsigned long long* _s = (volatile LAS unsigned long long*)(F.lds + 132096); _s[1] = _s[1] + (__builtin_amdgcn_s_memrealtime() - _s[2]); } } while (0)
#define PG8_PB() do { if ((PROBE_CUSTOM) == 20 && (int)blockIdx.x == 0 && wid == 0 && lane == 0) ((volatile __attribute__((address_space(3))) unsigned long long*)(lds + 132096))[2] = __builtin_amdgcn_s_memrealtime(); } while (0)
#define PG8_PE() do { if ((PROBE_CUSTOM) == 20 && (int)blockIdx.x == 0 && wid == 0 && lane == 0) { volatile __attribute__((address_space(3))) unsigned long long* _s = (volatile __attribute__((address_space(3))) unsigned long long*)(lds + 132096); _s[1] = _s[1] + (__builtin_amdgcn_s_memrealtime() - _s[2]); } } while (0)
#ifndef MK_ONE_LAUNCH
#define MK_ONE_LAUNCH 1
#endif

#define GAS __attribute__((address_space(1)))
#define LAS __attribute__((address_space(3)))
typedef unsigned short bf16;
typedef short bf16x8 __attribute__((ext_vector_type(8)));
typedef float f32x4 __attribute__((ext_vector_type(4)));
typedef float f32x2 __attribute__((ext_vector_type(2)));
typedef unsigned u32x4 __attribute__((ext_vector_type(4)));
typedef unsigned u32x2 __attribute__((ext_vector_type(2)));

constexpr int D = 1024, NB = 4, TL = 4096, TC = 256, DEPTH = 4;
constexpr int MC = NB * TC, ML = NB * TL, M = MC + ML;
constexpr int INC = 2832, NP = 2816;
constexpr int FF = 2816, EF = 3584, NE = 8;
constexpr int MAXROWS = 36864;
constexpr float EPS = 1e-6f;
constexpr int PC_RQ = 0, PC_RK = 256, PC_RV = 512, PC_RG = 768, PC_GQKV = 1024, PC_GZ = 1792, PC_SQ = 2048, PC_SK = 2560, PC_SV = 2688;

constexpr size_t MiB = 1u << 20;
constexpr size_t WS_CTL = 0, CTL_ZERO_BYTES = 1 * MiB;
constexpr size_t WS_MOD = 1 * MiB;
constexpr size_t WS_ROPE = 2 * MiB;
constexpr size_t WS_TKE = 3 * MiB, WS_TKG = 3 * MiB + 256 * 1024, WS_TOKROW = 3 * MiB + 512 * 1024, WS_ROWTOK = 3 * MiB + 768 * 1024, WS_TILEE = 4 * MiB;
constexpr size_t WS_AB = 5 * MiB, WS_GB = 7 * MiB;
constexpr size_t WS_WIN = 16 * MiB, WS_WOUT = 38 * MiB, WS_W13 = 46 * MiB, WS_W2 = 68 * MiB, WS_MW13 = 80 * MiB, WS_MW2 = 192 * MiB;
constexpr size_t WS_XS = 248 * MiB, WS_H = 316 * MiB, WS_HP = 350 * MiB, WS_YM = 422 * MiB, WS_R1 = 566 * MiB;
constexpr size_t R1_P = 0, R1_PREP = 94 * MiB, R1_O = 158 * MiB, R1_OR = 192 * MiB, R1_OG = 226 * MiB, R1_HID = 0;
constexpr size_t WS_END = WS_R1 + 260 * MiB;
constexpr size_t WS_GCH = WS_YM, GCH_STEP = 40960, GCH_CHAIN = 68 * GCH_STEP, WS_GDEC = WS_HP;
constexpr size_t G2_STEP = 24576, G2_CHAIN = 68 * G2_STEP;
constexpr size_t WS_GST = WS_YM + 56 * MiB;
constexpr size_t WS_GCS = WS_HP + 64 * 1024;
static_assert(32 * G2_CHAIN <= 56 * MiB && 32 * 68 * 16384 <= 40 * MiB, "gdn v2 buffers");
constexpr size_t WS_RKV = WS_YM + 96 * MiB;
constexpr size_t WS_RST = WS_HP + 1 * MiB;
static_assert(32 * GCH_CHAIN <= 144 * MiB, "gdn chunk data");
constexpr size_t PREP_RQ = 0, PREP_RK = (size_t)M * 256 * 2, PREP_SQ = (size_t)M * 512 * 2, PREP_SK = (size_t)M * 1024 * 2, PREP_GD = (size_t)M * 1152 * 2;
static_assert(PREP_GD + (size_t)M * 768 * 2 <= 64 * MiB, "prep");
static_assert((size_t)M * NP * 2 <= 94 * MiB && (size_t)MAXROWS * EF * 2 <= 260 * MiB, "r1");

constexpr int CW_TMO = 0, CW_BAR = 4096;

__device__ __forceinline__ float bf2f(bf16 v) { return __uint_as_float(((unsigned)v) << 16); }
__device__ __forceinline__ unsigned f2bf(float f) { unsigned u = __float_as_uint(f); return (u + 0x7fffu + ((u >> 16) & 1u)) >> 16; }
__device__ __forceinline__ unsigned pk2(float lo, float hi) { return f2bf(lo) | (f2bf(hi) << 16); }
template <int CTRL> __device__ __forceinline__ float dppf(float v) { return __int_as_float(__builtin_amdgcn_update_dpp(0, __float_as_int(v), CTRL, 0xF, 0xF, true)); }
__device__ __forceinline__ float row_sum16(float v) {
    v += dppf<0xB1>(v); v += dppf<0x4E>(v); v += dppf<0x141>(v); v += dppf<0x140>(v); return v; }
__device__ __forceinline__ float wave_sum(float v) {
    v = row_sum16(v);
    return __int_as_float(__builtin_amdgcn_readlane(__float_as_int(v), 0)) + __int_as_float(__builtin_amdgcn_readlane(__float_as_int(v), 16))
         + __int_as_float(__builtin_amdgcn_readlane(__float_as_int(v), 32)) + __int_as_float(__builtin_amdgcn_readlane(__float_as_int(v), 48)); }
__device__ __forceinline__ float quad_rows_sum(float v) {
    u32x2 r = __builtin_amdgcn_permlane16_swap(__float_as_uint(v), __float_as_uint(v), false, false); v = __uint_as_float(r.x) + __uint_as_float(r.y);
    r = __builtin_amdgcn_permlane32_swap(__float_as_uint(v), __float_as_uint(v), false, false); return __uint_as_float(r.x) + __uint_as_float(r.y); }
__device__ __forceinline__ float quad_rows_max(float v) {
    u32x2 r = __builtin_amdgcn_permlane16_swap(__float_as_uint(v), __float_as_uint(v), false, false); v = fmaxf(__uint_as_float(r.x), __uint_as_float(r.y));
    r = __builtin_amdgcn_permlane32_swap(__float_as_uint(v), __float_as_uint(v), false, false); return fmaxf(__uint_as_float(r.x), __uint_as_float(r.y)); }
__device__ __forceinline__ float fexp2(float x) { return __builtin_amdgcn_exp2f(x); }
__device__ __forceinline__ float fexp(float x) { return __builtin_amdgcn_exp2f(x * 1.4426950408889634f); }
__device__ __forceinline__ float siluf(float x) { return x * __builtin_amdgcn_rcpf(1.0f + fexp(-x)); }
#define LDS_WAIT() asm volatile("s_waitcnt lgkmcnt(0)" ::: "memory")
__device__ __forceinline__ f32x4 mfma16(bf16x8 a, bf16x8 b, f32x4 c) { return __builtin_amdgcn_mfma_f32_16x16x32_bf16(a, b, c, 0, 0, 0); }
__device__ __forceinline__ unsigned cvtpk(float lo, float hi) { unsigned r; asm volatile("v_cvt_pk_bf16_f32 %0, %1, %2" : "=v"(r) : "v"(lo), "v"(hi)); return r; }


namespace pg8 {
#define PG8_LAS __attribute__((address_space(3)))
constexpr int BM = 256, BK = 64, HALF = 128, HTB = HALF * BK * 2, STAGE_BYTES = 8 * HTB;
__host__ __device__ __forceinline__ int lds_byte(int r, int c) { const int st = (r >> 4) * 2 + (c >> 5), rr = r & 15, cc = c & 31, ob = rr * 64 + cc * 2; return st * 1024 + (ob ^ (((ob >> 9) & 1) << 5)); }
__host__ __device__ __forceinline__ void stage_rc(int b, int& R, int& C) { const int st = b / 1024, sb = b % 1024, swz = sb ^ (((sb >> 9) & 1) << 5); R = (st >> 1) * 16 + swz / 64; C = (st & 1) * 32 + (swz % 64) / 2; }
__host__ __device__ __forceinline__ int perm32(int rho) { const int n = rho >> 4, i = rho & 15; return 8 * (i >> 2) + 4 * n + (i & 3); }
struct Unit { int pm, pn, aux; const char* A; const char* B; };
__device__ __forceinline__ unsigned cvt_pk_bf16(float lo, float hi) { unsigned r; asm volatile("v_cvt_pk_bf16_f32 %0, %1, %2" : "=v"(r) : "v"(lo), "v"(hi)); return r; }

template <int K, int LD, class Epi, class Sched, bool ALIGN_EPI = true, bool SP2 = true>
__device__ __forceinline__ void gemm_phase(PG8_LAS unsigned char* lds, const Sched& S, const Epi& E, const int tid) {
    const int wid = __builtin_amdgcn_readfirstlane(tid >> 6), lane = tid & 63, wr = wid >> 2, wc = wid & 3, fr = lane & 15, fq = lane >> 4;
    constexpr int nt = K / BK;
    unsigned voffA[2], voffB[2];
#pragma unroll
    for (int i = 0; i < 2; ++i) { int R, C; stage_rc(tid * 16 + i * 8192, R, C); const int Rb = Epi::PERM ? ((R & ~31) + perm32(R & 31)) : R;
        voffA[i] = (unsigned)(R * LD + C) * 2u; voffB[i] = (unsigned)(Rb * LD + C) * 2u; }
    constexpr size_t kstep = (size_t)(BK * 2);
    constexpr size_t hstep = (size_t)HALF * LD * 2;
    const unsigned ldsw = (unsigned)wid * 1024u;
    const int aoff = lds_byte(wr * 64 + fr, fq * 8), boff = lds_byte(wc * 32 + fr, fq * 8);
#define PG8_SA(b, h) (((b) * 2 + (h)) * HTB)
#define PG8_SB(b, h) ((4 + (b) * 2 + (h)) * HTB)
#define PG8_STAGE(bufoff, gbase, voff) do { _Pragma("unroll") for (int _i = 0; _i < 2; ++_i) \
        __builtin_amdgcn_global_load_lds((const unsigned*)((const char*)(gbase) + (voff)[_i]), (PG8_LAS unsigned*)(lds + (bufoff) + ldsw + _i * 8192), 16, 0, 0); } while (0)
#define PG8_LDA(dst, b, h) do { _Pragma("unroll") for (int m = 0; m < 4; ++m) _Pragma("unroll") for (int k = 0; k < 2; ++k) dst[m][k] = *(const PG8_LAS bf16x8*)(lds + PG8_SA(b, h) + aoff + m * 2048 + k * 1024); } while (0)
#define PG8_LDB(dst, b, h) do { _Pragma("unroll") for (int n = 0; n < 2; ++n) _Pragma("unroll") for (int k = 0; k < 2; ++k) dst[n][k] = *(const PG8_LAS bf16x8*)(lds + PG8_SB(b, h) + boff + n * 2048 + k * 1024); } while (0)
#define PG8_MMA(ai, bj, At, Bt) do { __builtin_amdgcn_s_setprio(1); _Pragma("unroll") for (int m = 0; m < 4; ++m) _Pragma("unroll") for (int n = 0; n < 2; ++n) _Pragma("unroll") for (int k = 0; k < 2; ++k) \
        acc[ai][bj][m][n] = __builtin_amdgcn_mfma_f32_16x16x32_bf16(Bt[n][k], At[m][k], acc[ai][bj][m][n], 0, 0, 0); __builtin_amdgcn_s_setprio(0); } while (0)
#define PG8_WAIT_V(n) asm volatile("s_waitcnt vmcnt(" #n ")" ::: "memory")
#define PG8_WAIT_L(n) asm volatile("s_waitcnt lgkmcnt(" #n ")" ::: "memory")
#define PG8_BAR __builtin_amdgcn_s_barrier()
#define PG8_SCHED __builtin_amdgcn_sched_barrier(0)
    Unit cur, nxt; int ui = 0;
    if (!S.next(0, cur)) return;
    f32x4 acc[2][2][4][2];
#pragma unroll
    for (int a = 0; a < 2; ++a)
#pragma unroll
        for (int b = 0; b < 2; ++b)
#pragma unroll
            for (int m = 0; m < 4; ++m)
#pragma unroll
                for (int n = 0; n < 2; ++n) acc[a][b][m][n] = (f32x4){0.f, 0.f, 0.f, 0.f};
    bf16x8 At[4][2], B0[2][2], B1[2][2];
    const char* cA = cur.A; const char* cB = cur.B;
    if constexpr (SP2) {
        PG8_STAGE(PG8_SB(0, 0), cB, voffB); PG8_STAGE(PG8_SB(0, 1), cB + hstep, voffB); PG8_STAGE(PG8_SA(0, 0), cA, voffA); PG8_STAGE(PG8_SA(0, 1), cA + hstep, voffA);
        if (wr == 1) PG8_BAR;
        PG8_WAIT_V(2); PG8_BAR;
        PG8_STAGE(PG8_SB(1, 0), cB + kstep, voffB); PG8_STAGE(PG8_SA(1, 0), cA + kstep, voffA); PG8_STAGE(PG8_SB(1, 1), cB + hstep + kstep, voffB);
        PG8_WAIT_V(6); PG8_BAR;
    } else {
        PG8_STAGE(PG8_SB(0, 0), cB, voffB); PG8_STAGE(PG8_SA(0, 0), cA, voffA); PG8_STAGE(PG8_SB(0, 1), cB + hstep, voffB); PG8_STAGE(PG8_SA(0, 1), cA + hstep, voffA);
        if (wr == 1) PG8_BAR;
        PG8_WAIT_V(4); PG8_BAR;
        PG8_STAGE(PG8_SB(1, 0), cB + kstep, voffB); PG8_STAGE(PG8_SA(1, 0), cA + kstep, voffA); PG8_STAGE(PG8_SB(1, 1), cB + hstep + kstep, voffB);
        PG8_WAIT_V(6); PG8_BAR;
    }
    for (;;) {
        const bool has_next = S.next(ui + 1, nxt);
        const char* nA = has_next ? nxt.A : cA; const char* nB = has_next ? nxt.B : cB;
        for (int t = 0; t < nt; t += 2) {
            const bool last = (t == nt - 2);
            const char* a1 = cA + (size_t)(t + 1) * kstep;
            const char* a2 = last ? nA : cA + (size_t)(t + 2) * kstep; const char* b2 = last ? nB : cB + (size_t)(t + 2) * kstep;
            const char* a3 = a2 + kstep; const char* b3 = b2 + kstep;
            if constexpr (SP2) {
            PG8_LDB(B0, 0, 0); PG8_LDB(B1, 0, 1); PG8_SCHED; PG8_LDA(At, 0, 0); PG8_STAGE(PG8_SA(1, 1), a1 + hstep, voffA);
            PG8_WAIT_V(8); PG8_WAIT_L(0); PG8_BAR; PG8_MMA(0, 0, At, B0); PG8_MMA(0, 1, At, B1); PG8_BAR; PG8_SCHED;
            PG8_LDA(At, 0, 1); PG8_STAGE(PG8_SB(0, 0), b2, voffB); PG8_STAGE(PG8_SB(0, 1), b2 + hstep, voffB); PG8_STAGE(PG8_SA(0, 0), a2, voffA);
            PG8_WAIT_V(8); PG8_WAIT_L(0); PG8_BAR; PG8_MMA(1, 0, At, B0); PG8_MMA(1, 1, At, B1); PG8_BAR; PG8_SCHED;
            PG8_LDB(B0, 1, 0); PG8_LDB(B1, 1, 1); PG8_SCHED; PG8_LDA(At, 1, 0); PG8_STAGE(PG8_SA(0, 1), a2 + hstep, voffA);
            PG8_WAIT_V(8); PG8_WAIT_L(0); PG8_BAR; PG8_MMA(0, 0, At, B0); PG8_MMA(0, 1, At, B1); PG8_BAR; PG8_SCHED;
            PG8_LDA(At, 1, 1); PG8_STAGE(PG8_SB(1, 0), b3, voffB); PG8_STAGE(PG8_SB(1, 1), b3 + hstep, voffB); PG8_STAGE(PG8_SA(1, 0), a3, voffA);
            PG8_WAIT_V(8); PG8_WAIT_L(0); PG8_BAR; PG8_MMA(1, 0, At, B0); PG8_MMA(1, 1, At, B1); PG8_BAR; PG8_SCHED;
            } else {
            PG8_LDB(B0, 0, 0); PG8_SCHED; PG8_LDA(At, 0, 0); PG8_STAGE(PG8_SA(1, 1), a1 + hstep, voffA);
            PG8_WAIT_L(8); PG8_BAR; PG8_WAIT_L(0); PG8_MMA(0, 0, At, B0); PG8_BAR; PG8_SCHED;
            PG8_LDB(B1, 0, 1); PG8_STAGE(PG8_SB(0, 0), b2, voffB);
            PG8_BAR; PG8_WAIT_L(0); PG8_MMA(0, 1, At, B1); PG8_BAR;
            PG8_LDA(At, 0, 1); PG8_STAGE(PG8_SA(0, 0), a2, voffA);
            PG8_BAR; PG8_WAIT_L(0); PG8_MMA(1, 0, At, B0); PG8_BAR; PG8_SCHED;
            PG8_STAGE(PG8_SB(0, 1), b2 + hstep, voffB);
            PG8_WAIT_V(6); PG8_BAR; PG8_MMA(1, 1, At, B1); PG8_BAR;
            PG8_LDB(B0, 1, 0); PG8_SCHED; PG8_LDA(At, 1, 0); PG8_STAGE(PG8_SA(0, 1), a2 + hstep, voffA);
            PG8_WAIT_L(8); PG8_BAR; PG8_WAIT_L(0); PG8_MMA(0, 0, At, B0); PG8_BAR; PG8_SCHED;
            PG8_LDB(B1, 1, 1); PG8_STAGE(PG8_SB(1, 0), b3, voffB);
            PG8_BAR; PG8_WAIT_L(0); PG8_MMA(0, 1, At, B1); PG8_BAR;
            PG8_LDA(At, 1, 1); PG8_STAGE(PG8_SA(1, 0), a3, voffA);
            PG8_BAR; PG8_WAIT_L(0); PG8_MMA(1, 0, At, B0); PG8_BAR; PG8_SCHED;
            PG8_STAGE(PG8_SB(1, 1), b3 + hstep, voffB);
            PG8_WAIT_V(6); PG8_BAR; PG8_MMA(1, 1, At, B1); PG8_BAR;
            }
        }
        if constexpr (ALIGN_EPI) { if (wr == 0) PG8_BAR; }
        PG8_PB();
        E(acc, cur, wr, wc, fr, fq);
        PG8_PE();
        if (!has_next) break;
#pragma unroll
        for (int a = 0; a < 2; ++a)
#pragma unroll
            for (int b = 0; b < 2; ++b)
#pragma unroll
                for (int m = 0; m < 4; ++m)
#pragma unroll
                    for (int n = 0; n < 2; ++n) acc[a][b][m][n] = (f32x4){0.f, 0.f, 0.f, 0.f};
        cur = nxt; cA = nA; cB = nB; ++ui;
        if constexpr (ALIGN_EPI) { if (wr == 1) PG8_BAR; }
    }
    PG8_WAIT_V(0);
    if constexpr (!ALIGN_EPI) { if (wr == 0) PG8_BAR; }
    PG8_BAR;
#undef PG8_SA
#undef PG8_SB
#undef PG8_STAGE
#undef PG8_LDA
#undef PG8_LDB
#undef PG8_MMA
#undef PG8_WAIT_V
#undef PG8_WAIT_L
#undef PG8_BAR
#undef PG8_SCHED
}

struct StaticOrder {
    int nM, nN, nwg, G, c, pm_off; const char* A; const char* Bt; size_t tstep;
    __device__ void init(const void* A_, const void* Bt_, int M_, int N_, int K_, int G_, int c_, int pm_off_ = 0) { A = (const char*)A_; Bt = (const char*)Bt_; nM = M_ / BM; nN = N_ / BM; nwg = nM * nN; G = G_; c = c_; pm_off = pm_off_; tstep = (size_t)BM * K_ * 2; }
    __device__ bool next(int i, Unit& u) const {
        const long L = (long)i * G + c; if (L >= nwg) return false;
        int wgid = (int)L; { const int q = nwg / 8, r = nwg % 8, xcd = wgid % 8, off = wgid / 8; wgid = (xcd < r ? xcd * (q + 1) : r * (q + 1) + (xcd - r) * q) + off; }
        const int nig = 8 * nN, gid = wgid / nig, fm = gid * 8, gsz = (nM - fm) < 8 ? (nM - fm) : 8;
        u.pm = fm + ((wgid % nig) % gsz) + pm_off; u.pn = (wgid % nig) / gsz; u.aux = 0;
        u.A = A + (size_t)u.pm * tstep; u.B = Bt + (size_t)u.pn * tstep; return true;
    }
};
struct SplitOrder {
    int nks, nsub, G, c; const char* A; const char* Bt; size_t tstep;
    __device__ void init(const void* A_, const void* Bt_, int LD_, int nks_, int G_, int c_) { A = (const char*)A_; Bt = (const char*)Bt_; nks = nks_; nsub = 16 * nks_; G = G_; c = c_; tstep = (size_t)BM * LD_ * 2; }
    __device__ bool next(int i, Unit& u) const {
        const int L = i * G + c; if (L >= nsub) return false;
        const int ksl = L % nks, t = L / nks; u.pm = t >> 2; u.pn = t & 3; u.aux = ksl;
        u.A = A + (size_t)u.pm * tstep + (size_t)ksl * 512; u.B = Bt + (size_t)u.pn * tstep + (size_t)ksl * 512; return true;
    }
};
struct GroupedOrder {
    int nM, nN, nwg, G, c; const char* A; const char* Bt; size_t tstep, estep; const int* tile_e;
    __device__ void init(const void* A_, const void* Bt_, int ntiles, int N_, int K_, int G_, int c_, const int* te) { A = (const char*)A_; Bt = (const char*)Bt_; nM = ntiles; nN = N_ / BM; nwg = nM * nN; G = G_; c = c_; tstep = (size_t)BM * K_ * 2; estep = (size_t)N_ * K_ * 2; tile_e = te; }
    __device__ bool next(int i, Unit& u) const {
        const long L = (long)i * G + c; if (L >= nwg) return false;
        int wgid = (int)L; { const int q = nwg / 8, r = nwg % 8, xcd = wgid % 8, off = wgid / 8; wgid = (xcd < r ? xcd * (q + 1) : r * (q + 1) + (xcd - r) * q) + off; }
        const int nig = 8 * nN, gid = wgid / nig, fm = gid * 8, gsz = (nM - fm) < 8 ? (nM - fm) : 8;
        u.pm = fm + ((wgid % nig) % gsz); u.pn = (wgid % nig) / gsz; u.aux = __builtin_amdgcn_readfirstlane(tile_e[u.pm]);
        u.A = A + (size_t)u.pm * tstep; u.B = Bt + (size_t)u.aux * estep + (size_t)u.pn * tstep; return true;
    }
};

struct SplitGroupedOrder {
    int t0, nsub, G, c; const char* A; const char* Bt; size_t tstep, estep; const int* tile_e;
    __device__ void init(const void* A_, const void* Bt_, int t0_, int nt_, int G_, int c_, const int* te) { A = (const char*)A_; Bt = (const char*)Bt_; t0 = t0_; nsub = nt_ * 16; G = G_; c = c_; tstep = (size_t)BM * EF * 2; estep = (size_t)D * EF * 2; tile_e = te; }
    __device__ bool next(int i, Unit& u) const {
        const int L = i * G + c; if (L >= nsub) return false;
        const int ksl = L & 3, t = L >> 2; u.pm = t0 + (t >> 2); u.pn = t & 3; u.aux = ksl;
        const int e = __builtin_amdgcn_readfirstlane(tile_e[u.pm]);
        u.A = A + (size_t)u.pm * tstep + (size_t)ksl * 896 * 2; u.B = Bt + (size_t)e * estep + (size_t)u.pn * tstep + (size_t)ksl * 896 * 2; return true;
    }
};
struct EpiBf16 {
    static constexpr bool PERM = true;
    bf16* O; int ldc;
    __device__ __forceinline__ void operator()(const f32x4 (&acc)[2][2][4][2], const Unit& u, int wr, int wc, int fr, int fq) const {
        const int row0 = u.pm * BM + wr * 64 + fr, col0 = u.pn * BM + wc * 32 + 8 * fq;
#pragma unroll
        for (int ai = 0; ai < 2; ++ai)
#pragma unroll
            for (int m = 0; m < 4; ++m) { bf16* rowp = O + (size_t)(row0 + ai * HALF + m * 16) * ldc + col0;
#pragma unroll
                for (int bj = 0; bj < 2; ++bj) { const f32x4 v0 = acc[ai][bj][m][0], v1 = acc[ai][bj][m][1];
                    u32x4 w; w.x = cvt_pk_bf16(v0[0], v0[1]); w.y = cvt_pk_bf16(v0[2], v0[3]); w.z = cvt_pk_bf16(v1[0], v1[1]); w.w = cvt_pk_bf16(v1[2], v1[3]);
                    *(u32x4*)(rowp + bj * HALF) = w; } }
    }
};
struct EpiResid {
    static constexpr bool PERM = false;
    float* X; const float* mod; int gsel; const float* Xsrc;
    __device__ __forceinline__ void operator()(const f32x4 (&acc)[2][2][4][2], const Unit& u, int wr, int wc, int fr, int fq) const {
        const int row0 = u.pm * BM + wr * 64 + fr, col0 = u.pn * BM + wc * 32 + 4 * fq;
        const int r = u.pm < 4 ? 4 : ((u.pm - 4) >> 4);
        const float* g = mod + (size_t)r * 6 * D + gsel * D;
        f32x4 gv[2][2];
#pragma unroll
        for (int bj = 0; bj < 2; ++bj)
#pragma unroll
            for (int n = 0; n < 2; ++n) gv[bj][n] = *(const f32x4*)(g + col0 + bj * HALF + n * 16);
#pragma unroll
        for (int ai = 0; ai < 2; ++ai)
#pragma unroll
            for (int m = 0; m < 4; ++m) { float* rowp = X + (size_t)(row0 + ai * HALF + m * 16) * D + col0; const float* srcp = Xsrc ? Xsrc + (size_t)(row0 + ai * HALF + m * 16 - MC) * D + col0 : rowp;
#pragma unroll
                for (int bj = 0; bj < 2; ++bj)
#pragma unroll
                    for (int n = 0; n < 2; ++n) { f32x4 x = *(const f32x4*)(srcp + bj * HALF + n * 16); x += gv[bj][n] * acc[ai][bj][m][n]; *(f32x4*)(rowp + bj * HALF + n * 16) = x; } }
    }
};
struct EpiSwiglu {
    static constexpr bool PERM = false;
    bf16* Hd; int ldh;
    __device__ __forceinline__ void operator()(const f32x4 (&acc)[2][2][4][2], const Unit& u, int wr, int wc, int fr, int fq) const {
        const int row0 = u.pm * BM + wr * 64 + fr, col0 = u.pn * 128 + wc * 16 + 4 * fq;
#pragma unroll
        for (int ai = 0; ai < 2; ++ai)
#pragma unroll
            for (int m = 0; m < 4; ++m) { bf16* rowp = Hd + (size_t)(row0 + ai * HALF + m * 16) * ldh + col0;
#pragma unroll
                for (int bj = 0; bj < 2; ++bj) { const f32x4 a = acc[ai][bj][m][0], b = acc[ai][bj][m][1];
                    float h[4];
#pragma unroll
                    for (int j = 0; j < 4; ++j) h[j] = a[j] * __builtin_amdgcn_rcpf(1.0f + __builtin_amdgcn_exp2f(-1.4426950408889634f * a[j])) * b[j];
                    u32x2 w; w.x = cvt_pk_bf16(h[0], h[1]); w.y = cvt_pk_bf16(h[2], h[3]);
                    *(u32x2*)(rowp + bj * 64) = w; } }
    }
};
struct EpiF32 {
    static constexpr bool PERM = false;
    float* C; int ldc;
    __device__ __forceinline__ void operator()(const f32x4 (&acc)[2][2][4][2], const Unit& u, int wr, int wc, int fr, int fq) const {
        const int row0 = u.pm * BM + wr * 64 + fr, col0 = u.pn * BM + wc * 32 + 4 * fq;
#pragma unroll
        for (int ai = 0; ai < 2; ++ai)
#pragma unroll
            for (int m = 0; m < 4; ++m) { float* rowp = C + (size_t)(row0 + ai * HALF + m * 16) * ldc + col0;
#pragma unroll
                for (int bj = 0; bj < 2; ++bj)
#pragma unroll
                    for (int n = 0; n < 2; ++n) *(f32x4*)(rowp + bj * HALF + n * 16) = acc[ai][bj][m][n]; }
    }
};
struct EpiSlab {
    static constexpr bool PERM = false;
    float* C;
    __device__ __forceinline__ void operator()(const f32x4 (&acc)[2][2][4][2], const Unit& u, int wr, int wc, int fr, int fq) const {
        const int row0 = u.pm * BM + wr * 64 + fr, col0 = u.pn * BM + wc * 32 + 4 * fq;
        float* base = C + (size_t)u.aux * MC * D;
#pragma unroll
        for (int ai = 0; ai < 2; ++ai)
#pragma unroll
            for (int m = 0; m < 4; ++m) { float* rowp = base + (size_t)(row0 + ai * HALF + m * 16) * D + col0;
#pragma unroll
                for (int bj = 0; bj < 2; ++bj)
#pragma unroll
                    for (int n = 0; n < 2; ++n) *(f32x4*)(rowp + bj * HALF + n * 16) = acc[ai][bj][m][n]; }
    }
};
struct EpiYMSlab {
    static constexpr bool PERM = false;
    float* YMp; float* slab; int row0s;
    __device__ __forceinline__ void operator()(const f32x4 (&acc)[2][2][4][2], const Unit& u, int wr, int wc, int fr, int fq) const {
        const int row0 = u.pm * BM + wr * 64 + fr, col0 = u.pn * BM + wc * 32 + 4 * fq;
        float* base = slab + ((size_t)u.aux * 4096 + (row0 - row0s)) * D;
#pragma unroll
        for (int ai = 0; ai < 2; ++ai)
#pragma unroll
            for (int m = 0; m < 4; ++m) { float* rowp = base + (size_t)(ai * HALF + m * 16) * D + col0;
#pragma unroll
                for (int bj = 0; bj < 2; ++bj)
#pragma unroll
                    for (int n = 0; n < 2; ++n) *(f32x4*)(rowp + bj * HALF + n * 16) = acc[ai][bj][m][n]; }
    }
};
}

#define XB_TMO      128
#define XB_XCNT(j)  (256  + 64 * (j))
#define XB_XSUB(j)  (1280 + 64 * (j))
#define XB_XGEN(j)  (2304 + 64 * (j))
#define XB_TOP      3328
#define XB_TOPGEN   3392
#define XCD_BAR_WORDS 3456
#define XB_SPIN_CAP (1u << 22)
__device__ __forceinline__ unsigned xb_ld(unsigned* p)              { return __hip_atomic_load(p, __ATOMIC_RELAXED, __HIP_MEMORY_SCOPE_AGENT); }
__device__ __forceinline__ unsigned xb_add(unsigned* p, unsigned v) { return __hip_atomic_fetch_add(p, v, __ATOMIC_RELAXED, __HIP_MEMORY_SCOPE_AGENT); }
__device__ __forceinline__ unsigned xb_xcc_id() { return (unsigned)__builtin_amdgcn_s_getreg((3 << 11) | 20) & 0xFu; }
#define XB_SPIN(cond, bar) do { unsigned _sp = 0; while (cond) { __builtin_amdgcn_s_sleep(1); \
    if ((++_sp & 255u) == 0u) { if (xb_ld(&(bar)[XB_TMO])) break; if (_sp > XB_SPIN_CAP) { atomicAdd(&(bar)[XB_TMO], 1u); break; } } } } while (0)
struct XcdBarrier { unsigned* bar; unsigned x; volatile LAS unsigned* st; int w0; };
__device__ __forceinline__ bool xb_leader(int w0) { return w0 == 0 && __builtin_amdgcn_mbcnt_hi(~0u, __builtin_amdgcn_mbcnt_lo(~0u, 0u)) == 0u; }
__device__ __forceinline__ XcdBarrier xcd_barrier_post(unsigned* bar, volatile LAS unsigned* st) {
    XcdBarrier b; b.bar = bar; b.x = xb_xcc_id(); b.st = st; b.w0 = __builtin_amdgcn_readfirstlane(threadIdx.x >> 6);
    if (xb_leader(b.w0)) (void)xb_add(&bar[XB_XCNT(b.x)], 1u);
    return b;
}
__device__ __forceinline__ void xcd_barrier_complete(unsigned* bar, unsigned x, unsigned& nloc, unsigned& nx) {
    const unsigned G = gridDim.x * gridDim.y * gridDim.z;
    unsigned sum, cnt, mine, sp = 0u;
    for (;;) {
        sum = 0u; cnt = 0u; mine = 0u;
#pragma unroll
        for (unsigned j = 0; j < 16; ++j) { const unsigned c = xb_ld(&bar[XB_XCNT(j)]); sum += c; cnt += (c > 0u) ? 1u : 0u; mine = (j == x) ? c : mine; }
        if (sum == G) break;
        __builtin_amdgcn_s_sleep(1);
        if ((++sp & 255u) == 0u) { if (xb_ld(&bar[XB_TMO])) break; if (sp > XB_SPIN_CAP) { atomicAdd(&bar[XB_TMO], 1u); break; } }
    }
    nloc = mine > 0u ? mine : 1u; nx = cnt > 0u ? cnt : 1u;
}
__device__ __forceinline__ void xcd_barrier(const XcdBarrier& b) {
    asm volatile("s_waitcnt vmcnt(0)" ::: "memory");
    __syncthreads();
    if (xb_leader(b.w0)) {
        unsigned* bar = b.bar; unsigned bx = b.x;
        asm volatile("" : "+s"(bar), "+s"(bx));
        __builtin_amdgcn_s_waitcnt(0);
        unsigned nloc = b.st[0], nx = b.st[1];
        if (nloc == 0u) { xcd_barrier_complete(bar, bx, nloc, nx); b.st[0] = nloc; b.st[1] = nx; }
        const unsigned old = xb_add(&bar[XB_XSUB(bx)], 1u);
        const unsigned gen = old / nloc;
        if (old + 1u == (gen + 1u) * nloc) {
            __builtin_amdgcn_fence(__ATOMIC_RELEASE, "agent");
            asm volatile("s_waitcnt vmcnt(0)" ::: "memory");
            const unsigned og = xb_add(&bar[XB_TOP], 1u);
            const unsigned tg = og / nx;
            if (og + 1u == (tg + 1u) * nx) xb_add(&bar[XB_TOPGEN], 1u);
            else XB_SPIN(xb_ld(&bar[XB_TOPGEN]) == tg, bar);
            __builtin_amdgcn_fence(__ATOMIC_ACQUIRE, "agent");
            xb_add(&bar[XB_XGEN(bx)], 1u);
            asm volatile("s_waitcnt vmcnt(0)" ::: "memory");
        } else {
            XB_SPIN(xb_ld(&bar[XB_XGEN(bx)]) == gen, bar);
            __builtin_amdgcn_fence(__ATOMIC_ACQUIRE, "agent");
            asm volatile("s_waitcnt vmcnt(0)" ::: "memory");
        }
    }
    __syncthreads();
}

constexpr int NWAVES = 8, NTHR = 512;
constexpr int RING_BYTES = 131072, MISC_OFF = RING_BYTES + 320, LDS_BYTES = 147456;

struct Inputs {
    const float *x, *c, *ctx, *c_ctx, *ada_w, *ada_b, *norm1_g, *w_in, *ret_decay, *ret_gn_g, *gdn_conv_w, *gdn_a_log, *gdn_dt_bias, *gdn_norm_g, *swa_sink, *w_out, *norm2_g,
        *ffn_w1, *ffn_w3, *ffn_w2, *router_w, *moe_w1, *moe_w3, *moe_w2, *final_g;
};
struct Args { Inputs in; float* out; unsigned char* ws; int ph_lo, ph_hi; };
static_assert(sizeof(Args) == 25 * 8 + 8 + 8 + 8, "no padding");


__device__ __forceinline__ const float* ld_ptr(const LAS unsigned long long* t, int i) { const unsigned long long v = t[i]; const unsigned lo = __builtin_amdgcn_readfirstlane((unsigned)v), hi = __builtin_amdgcn_readfirstlane((unsigned)(v >> 32)); return (const float*)(GAS const float*)(((unsigned long long)hi << 32) | lo); }
__device__ __forceinline__ Inputs load_inputs(const LAS unsigned long long* t) {
    Inputs in; const float** ip = (const float**)&in;
#pragma unroll
    for (int i = 0; i < 25; ++i) ip[i] = ld_ptr(t, i);
    return in;
}
struct Frame {
    LAS unsigned char* lds;
    int tid, lane, wave, G, gw, NGW, bid;
    unsigned char* ws;
};


constexpr int CW_DYN = 8192;
struct DynQ { unsigned* ctr; volatile LAS int* slot; bool lead; };
__device__ __forceinline__ DynQ dyn_make(Frame& F, int layer, int k) { DynQ q; q.ctr = (unsigned*)(F.ws + WS_CTL) + CW_DYN + (layer * 8 + k) * 64; q.slot = (volatile LAS int*)(F.lds + MISC_OFF + 64); q.lead = F.wave == 0 && F.lane == 0; return q; }
__device__ __forceinline__ int dyn_grab(const DynQ& q) { return q.lead ? (int)__hip_atomic_fetch_add(q.ctr, 1u, __ATOMIC_RELAXED, __HIP_MEMORY_SCOPE_AGENT) : 0; }
__device__ __forceinline__ int dyn_bcast(const DynQ& q, int v) { __syncthreads(); if (q.lead) q.slot[0] = v; __syncthreads(); return __builtin_amdgcn_readfirstlane(q.slot[0]); }


constexpr int CW_RSYNC = 12288;
__device__ __forceinline__ void rsync_publish(Frame& F, int layer) {
    asm volatile("s_waitcnt vmcnt(0)" ::: "memory");
    __syncthreads();
    if (F.wave == 0 && F.lane == 0) { __builtin_amdgcn_fence(__ATOMIC_RELEASE, "agent"); asm volatile("s_waitcnt vmcnt(0)" ::: "memory");
        (void)xb_add((unsigned*)(F.ws + WS_CTL) + CW_RSYNC + layer * 64, 1u); }
}
__device__ __forceinline__ void rsync_wait(Frame& F, int layer, unsigned want) {
    if (F.wave == 0 && F.lane == 0) { unsigned* w = (unsigned*)(F.ws + WS_CTL) + CW_RSYNC + layer * 64; unsigned* tmo = (unsigned*)(F.ws + WS_CTL) + CW_BAR + XB_TMO;
        unsigned sp = 0; while (xb_ld(w) < want) { __builtin_amdgcn_s_sleep(2); if ((++sp & 255u) == 0u) { if (xb_ld(tmo)) break; if (sp > XB_SPIN_CAP) { atomicAdd(tmo, 1u); break; } } }
        __builtin_amdgcn_fence(__ATOMIC_ACQUIRE, "agent"); asm volatile("s_waitcnt vmcnt(0)" ::: "memory"); }
    __syncthreads();
}

template <class SrcF>
__device__ __forceinline__ void transpose_item(const SrcF& src, int K, bf16* WT, LAS float* scr, int k0, int n0, int lane) {
#pragma unroll
    for (int i = 0; i < 8; ++i) { const int row = 4 * i + (lane >> 4), col = 4 * (lane & 15); *(LAS f32x4*)(scr + row * 68 + col) = src(k0 + row, n0 + col); }
    LDS_WAIT(); asm volatile("" ::: "memory");
#pragma unroll
    for (int j = 0; j < 4; ++j) { const int ch = j * 64 + lane, n = ch >> 2, c8 = ch & 3; const LAS float* sp = scr + (8 * c8) * 68 + n;
        u32x4 o; o.x = cvtpk(sp[0 * 68], sp[1 * 68]); o.y = cvtpk(sp[2 * 68], sp[3 * 68]); o.z = cvtpk(sp[4 * 68], sp[5 * 68]); o.w = cvtpk(sp[6 * 68], sp[7 * 68]);
        *(u32x4*)(WT + (size_t)(n0 + n) * K + k0 + 8 * c8) = o; }
    LDS_WAIT(); asm volatile("" ::: "memory");
}
struct SrcPlain { const float* W; int ld; __device__ __forceinline__ f32x4 operator()(int k, int n) const { return *(const f32x4*)(W + (size_t)k * ld + n); } };
struct SrcWin { const float* W; __device__ __forceinline__ f32x4 operator()(int k, int n) const { return *(const f32x4*)(W + (size_t)k * INC + (n < 2048 ? n : n + 16)); } };
struct SrcGU { const float* W1; const float* W3; int ld; __device__ __forceinline__ f32x4 operator()(int k, int n) const { const int g = n >> 5, i = n & 31; const ptrdiff_t d = (i < 16) ? (ptrdiff_t)0 : (W3 - W1); return *(const f32x4*)(W1 + d + (ptrdiff_t)k * ld + 16 * g + (i & 15)); } };

__device__ __forceinline__ void convert_moe_layer(Frame& F, const Inputs& in, int mi, int part, int nwg) {
    LAS float* scr = (LAS float*)(F.lds + F.wave * 16384);
    bf16* mw13 = (bf16*)(F.ws + WS_MW13); bf16* mw2 = (bf16*)(F.ws + WS_MW2);
    constexpr int I13 = (D / 32) * (2 * EF / 64), I2 = (EF / 32) * (D / 64);
    if (F.bid >= nwg) return;
    constexpr int NIT = NE * (I13 + I2);
    const int lane = F.lane, lr = lane >> 4, lc = 4 * (lane & 15);
    const int it_end = (part + 1) * (NIT / 2), step = nwg * NWAVES;
    int it = part * (NIT / 2) + F.gw;
    const float* sp = nullptr; int ld = 0; bf16* dp = nullptr; int dK = 0;
#define CV_DESC(itv, SP, LDv, DP, DK) do { const int e_ = (itv) / (I13 + I2); int r_ = (itv) % (I13 + I2); const size_t wo_ = ((size_t)mi * NE + e_) * (size_t)D * EF; \
        if (r_ < I13) { const int nb_ = 2 * EF / 64, k0_ = 32 * (r_ / nb_), n0_ = 64 * (r_ % nb_), n_ = n0_ + lc, g_ = n_ >> 5, i_ = n_ & 31; \
            SP = (i_ < 16 ? in.moe_w1 : in.moe_w3) + wo_ + (size_t)(k0_ + lr) * EF + 16 * g_ + (i_ & 15); LDv = EF; DP = mw13 + (size_t)e_ * 2 * EF * D + (size_t)n0_ * D + k0_; DK = D; } \
        else { r_ -= I13; const int nb_ = D / 64, k0_ = 32 * (r_ / nb_), n0_ = 64 * (r_ % nb_); \
            SP = in.moe_w2 + wo_ + (size_t)(k0_ + lr) * D + n0_ + lc; LDv = D; DP = mw2 + (size_t)e_ * D * EF + (size_t)n0_ * EF + k0_; DK = EF; } } while (0)
    f32x4 rc[8];
    if (it < it_end) { CV_DESC(it, sp, ld, dp, dK);
#pragma unroll
        for (int i = 0; i < 8; ++i) rc[i] = *(const f32x4*)(sp + (size_t)(4 * i) * ld); }
    while (it < it_end) {
        const int itn = it + step; const bool hasn = itn < it_end;
        const float* spn = sp; int ldn = ld; bf16* dpn = dp; int dKn = dK;
        if (hasn) CV_DESC(itn, spn, ldn, dpn, dKn);
#pragma unroll
        for (int i = 0; i < 8; ++i) *(LAS f32x4*)(scr + (4 * i + lr) * 68 + lc) = rc[i];
        f32x4 rn[8];
#pragma unroll
        for (int i = 0; i < 8; ++i) rn[i] = *(const f32x4*)(spn + (size_t)(4 * i) * ldn);
        LDS_WAIT(); asm volatile("" ::: "memory");
#pragma unroll
        for (int j = 0; j < 4; ++j) { const int ch = j * 64 + lane, n = ch >> 2, c8 = ch & 3; const LAS float* q = scr + (8 * c8) * 68 + n;
            u32x4 o; o.x = cvtpk(q[0 * 68], q[1 * 68]); o.y = cvtpk(q[2 * 68], q[3 * 68]); o.z = cvtpk(q[4 * 68], q[5 * 68]); o.w = cvtpk(q[6 * 68], q[7 * 68]);
            *(u32x4*)(dp + (size_t)n * dK + 8 * c8) = o; }
        LDS_WAIT(); asm volatile("" ::: "memory");
        it = itn; sp = spn; ld = ldn; dp = dpn; dK = dKn;
#pragma unroll
        for (int i = 0; i < 8; ++i) rc[i] = rn[i];
    }
#undef CV_DESC
}
__device__ __forceinline__ void phase_prologue(Frame& F, const Inputs& in) {
    LAS float* scr = (LAS float*)(F.lds + F.wave * 16384);
    {
        constexpr int I_IN = (D / 32) * (NP / 64), I_OUT = (D / 32) * (D / 64), I_13 = (D / 32) * (2 * FF / 64), I_2 = (FF / 32) * (D / 64);
        constexpr int PER_L = I_IN + I_OUT, PER_F = I_13 + I_2, TOT = DEPTH * PER_L + 2 * PER_F;
        for (int it = F.gw; it < TOT; it += F.NGW) {
            if (it < DEPTH * PER_L) { const int l = it / PER_L; int r = it % PER_L;
                if (r < I_IN) { const int nblk = NP / 64; SrcWin s{in.w_in + (size_t)l * D * INC}; transpose_item(s, D, (bf16*)(F.ws + WS_WIN) + (size_t)l * NP * D, scr, 32 * (r / nblk), 64 * (r % nblk), F.lane); }
                else { r -= I_IN; const int nblk = D / 64; SrcPlain s{in.w_out + (size_t)l * D * D, D}; transpose_item(s, D, (bf16*)(F.ws + WS_WOUT) + (size_t)l * D * D, scr, 32 * (r / nblk), 64 * (r % nblk), F.lane); }
            } else { const int q = it - DEPTH * PER_L; const int i = q / PER_F; int r = q % PER_F;
                if (r < I_13) { const int nblk = 2 * FF / 64; SrcGU s{in.ffn_w1 + (size_t)i * D * FF, in.ffn_w3 + (size_t)i * D * FF, FF}; transpose_item(s, D, (bf16*)(F.ws + WS_W13) + (size_t)i * 2 * FF * D, scr, 32 * (r / nblk), 64 * (r % nblk), F.lane); }
                else { r -= I_13; const int nblk = D / 64; SrcPlain s{in.ffn_w2 + (size_t)i * FF * D, D}; transpose_item(s, FF, (bf16*)(F.ws + WS_W2) + (size_t)i * D * FF, scr, 32 * (r / nblk), 64 * (r % nblk), F.lane); }
            }
        }
    }
    {
        __syncthreads();
        LAS float* sc = (LAS float*)F.lds;
        LAS float* red = (LAS float*)(F.lds + 32768);
        for (int i = F.tid; i < 5 * D; i += NTHR) { const int r = i / D, k = i % D; const float v = r < 4 ? in.c[r * D + k] : in.c_ctx[k]; sc[i] = siluf(v); }
        __syncthreads();
        float* mod = (float*)(F.ws + WS_MOD);
        for (int u = F.bid; u < DEPTH * 96; u += F.G) {
            const int l = u / 96, n = (u % 96) * 64 + F.lane;
            const float* w = in.ada_w + (size_t)l * D * 6 * D + n;
            float a[5] = {0.f, 0.f, 0.f, 0.f, 0.f};
            for (int k = F.wave * 128; k < F.wave * 128 + 128; ++k) { const float wv = w[(size_t)k * 6 * D];
#pragma unroll
                for (int r = 0; r < 5; ++r) a[r] += sc[r * D + k] * wv; }
#pragma unroll
            for (int r = 0; r < 5; ++r) red[(F.wave * 5 + r) * 64 + F.lane] = a[r];
            __syncthreads();
            if (F.tid < 320) { const int r = F.tid / 64, ln = F.tid % 64; float s = 0.f;
#pragma unroll
                for (int w8 = 0; w8 < 8; ++w8) s += red[(w8 * 5 + r) * 64 + ln];
                const int nn = (u % 96) * 64 + ln;
                mod[((size_t)l * 5 + r) * 6 * D + nn] = s + in.ada_b[(size_t)l * 6 * D + nn]; }
            __syncthreads();
        }
    }
    if (F.bid == 0) { float* rp = (float*)(F.ws + WS_ROPE);
        for (int i = F.tid; i < 64 * 16; i += NTHR) { const int pos = i / 16, fi = i % 16; const double inv = pow(10000.0, -(double)fi / 16.0), ang = (double)pos * inv; rp[2 * i] = (float)cos(ang); rp[2 * i + 1] = (float)sin(ang); } }
}

__device__ __forceinline__ int mod_row(int m) { return m < MC ? 4 : ((m - MC) >> 12); }


template <int MODE>
__device__ __forceinline__ void phase_token2(Frame& F, const Inputs& in, int layer, bool first_from_input, bool combine_moe, bool moe_router, float* out, int route_lo = 0, int nslab = 0) {
    float* XS = (float*)(F.ws + WS_XS);
    bf16* H = (bf16*)(F.ws + WS_H);
    const float* mod = (const float*)(F.ws + WS_MOD) + (size_t)(layer < DEPTH ? layer : DEPTH - 1) * 5 * 6 * D;
    const float* modprev = (const float*)(F.ws + WS_MOD) + (size_t)(layer > 0 ? layer - 1 : 0) * 5 * 6 * D;
    const float* TKG = (const float*)(F.ws + WS_TKG); const int* TOKROW = (const int*)(F.ws + WS_TOKROW);
    const bf16* YM = (const bf16*)(F.ws + WS_YM);
    LAS float* wl = (LAS float*)F.lds;
    const int lane = F.lane;
    if (MODE == 0) PB(8);
    if (MODE == 0) { __syncthreads(); const float* w = in.w_in + (size_t)layer * D * INC + 2048;
#pragma unroll
        for (int n = 0; n < 8; ++n) { const int k = (F.tid >> 2) + 128 * n, q4 = F.tid & 3, kp = ((k >> 8) * 4 + (k & 3)) * 64 + ((k >> 2) & 63);
            *(LAS f32x4*)(wl + (q4 * 1024 + kp) * 4) = *(const f32x4*)(w + (size_t)k * INC + 4 * q4); }
        __syncthreads(); }
    LAS int* lcnt = (LAS int*)(F.lds + 61440);
    if (MODE == 1 && moe_router) { __syncthreads(); if (F.tid < 8) lcnt[F.tid] = 0; const float* w = in.router_w + (size_t)(layer >> 1) * D * NE;
#pragma unroll
        for (int n = 0; n < 4; ++n) { const int k = (F.tid >> 1) + 256 * n, q4 = F.tid & 1, kp = ((k >> 8) * 4 + (k & 3)) * 64 + ((k >> 2) & 63);
            *(LAS f32x4*)(wl + (q4 * 1024 + kp) * 4) = *(const f32x4*)(w + (size_t)k * NE + 4 * q4); }
        __syncthreads(); }
    if (MODE == 0) PE(8);
    if (MODE == 0) PB(9);
    if (MODE == 1) PB(10);
    const float* gain = MODE == 0 ? in.norm1_g + (size_t)layer * D : (MODE == 1 ? in.norm2_g + (size_t)layer * D : in.final_g);
    const bool has_ctx = (MODE != 2) && F.gw < MC;
    const int r_beg = MC + (int)(((long)F.gw * ML) / F.NGW), r_end = MC + (int)(((long)(F.gw + 1) * ML) / F.NGW);
    if (nslab > 0 && has_ctx) {
        const float* sb = (const float*)(F.ws + WS_R1 + 100 * MiB); const float* gsrc = (MODE == 1 ? mod + (size_t)4 * 6 * D + 2 * D : modprev + (size_t)4 * 6 * D + 5 * D);
        { const int m = F.gw;
#pragma unroll
            for (int j = 0; j < 4; ++j) { f32x4 a0 = (f32x4){0.f, 0.f, 0.f, 0.f};
                for (int sidx = 0; sidx < nslab; ++sidx) a0 += *(const f32x4*)(sb + ((size_t)sidx * MC + m) * D + 4 * lane + 256 * j);
                float* xp = XS + (size_t)m * D + 4 * lane + 256 * j; *(f32x4*)xp = *(const f32x4*)xp + *(const f32x4*)(gsrc + 4 * lane + 256 * j) * a0; } }
        asm volatile("s_waitcnt vmcnt(0)" ::: "memory");
    }
    if (combine_moe) {
        const int ntl = ((const int*)(F.ws + WS_TILEE))[256]; const int srow = ((ntl - (ntl / 64) * 64 <= 16) ? (ntl / 64) * 64 : ntl) * 256; const float* sl = (const float*)(F.ws + WS_HP);
        bf16* YMw = (bf16*)(F.ws + WS_YM);
        for (int m0 = has_ctx ? r_beg - 1 : r_beg; m0 < r_end; ++m0) { const int m = m0 < r_beg ? F.gw : m0;
            if (MODE == 0 && layer == DEPTH && m < MC) continue;
#pragma unroll
            for (int k = 0; k < 2; ++k) { const int r = TOKROW[2 * m + k];
                if (r >= srow) { const size_t o = (size_t)(r - srow) * D;
#pragma unroll
                    for (int j = 0; j < 4; ++j) { const f32x4 y = ((*(const f32x4*)(sl + o + 4 * lane + 256 * j) + *(const f32x4*)(sl + (size_t)4096 * D + o + 4 * lane + 256 * j)) + *(const f32x4*)(sl + (size_t)8192 * D + o + 4 * lane + 256 * j)) + *(const f32x4*)(sl + (size_t)12288 * D + o + 4 * lane + 256 * j);
                        u32x2 wv; wv.x = cvtpk(y.x, y.y); wv.y = cvtpk(y.z, y.w); *(u32x2*)(YMw + (size_t)r * D + 4 * lane + 256 * j) = wv; } } } }
        asm volatile("s_waitcnt vmcnt(0)" ::: "memory");
    }
    f32x4 gv[4], av[4], bv[4], gt[4];
#pragma unroll
    for (int j = 0; j < 4; ++j) gv[j] = *(const f32x4*)(gain + 4 * lane + 256 * j);
    int rcur = -1;
    for (int m0 = has_ctx ? r_beg - 1 : r_beg; m0 < r_end; m0 += 2) {
        const bool isc = m0 < r_beg;
        const int ma = isc ? F.gw : m0; const bool two = !isc && ma + 1 < r_end; const int m1 = two ? ma + 1 : ma;
        if (isc) m0 -= 1;
        const int r = mod_row(ma);
        const bool same = mod_row(m1) == r;
        const int mm1 = same ? m1 : ma; const bool do1 = two && same;
        if (!same) m0 -= 1;
        if (r != rcur) { rcur = r;
            if (MODE != 2) { const float* sh = mod + (size_t)r * 6 * D + (MODE == 0 ? 0 : 3) * D;
#pragma unroll
                for (int j = 0; j < 4; ++j) { const f32x4 s1 = *(const f32x4*)(sh + D + 4 * lane + 256 * j); av[j] = gv[j] * (1.0f + s1); bv[j] = *(const f32x4*)(sh + 4 * lane + 256 * j); } }
            if (combine_moe) {
#pragma unroll
                for (int j = 0; j < 4; ++j) gt[j] = *(const f32x4*)(modprev + (size_t)r * 6 * D + 5 * D + 4 * lane + 256 * j); } }
        const int mr[2] = {ma, mm1};
        f32x4 v[2][4];
        int t0[2], t1[2]; float g0[2], g1[2];
        if (combine_moe) {
#pragma unroll
            for (int p = 0; p < 2; ++p) { t0[p] = TOKROW[2 * mr[p]]; t1[p] = TOKROW[2 * mr[p] + 1]; g0[p] = TKG[2 * mr[p]]; g1[p] = TKG[2 * mr[p] + 1]; } }
#pragma unroll
        for (int p = 0; p < 2; ++p) { const int m = mr[p];
            const float* xrow = first_from_input ? (m < MC ? in.ctx + (size_t)m * D : in.x + (size_t)(m - MC) * D) : XS + (size_t)m * D;
#pragma unroll
            for (int j = 0; j < 4; ++j) v[p][j] = *(const f32x4*)(xrow + 4 * lane + 256 * j); }
        if (combine_moe) {
#pragma unroll
            for (int p = 0; p < 2; ++p)
#pragma unroll
                for (int j = 0; j < 4; ++j) { const u32x2 a = *(const u32x2*)(YM + (size_t)t0[p] * D + 4 * lane + 256 * j), b = *(const u32x2*)(YM + (size_t)t1[p] * D + 4 * lane + 256 * j);
                    const f32x4 y0 = (f32x4){__uint_as_float(a.x << 16), __uint_as_float(a.x & 0xffff0000u), __uint_as_float(a.y << 16), __uint_as_float(a.y & 0xffff0000u)};
                    const f32x4 y1 = (f32x4){__uint_as_float(b.x << 16), __uint_as_float(b.x & 0xffff0000u), __uint_as_float(b.y << 16), __uint_as_float(b.y & 0xffff0000u)};
                    v[p][j] += gt[j] * (g0[p] * y0 + g1[p] * y1); } }
        if (((first_from_input && ma < MC) || combine_moe) && MODE != 2) {
#pragma unroll
            for (int p = 0; p < 2; ++p) if (p == 0 || do1) {
#pragma unroll
                for (int j = 0; j < 4; ++j) *(f32x4*)(XS + (size_t)mr[p] * D + 4 * lane + 256 * j) = v[p][j]; } }
        float rstd[2];
#pragma unroll
        for (int p = 0; p < 2; ++p) { float ss = 0.f;
#pragma unroll
            for (int j = 0; j < 4; ++j) ss += (v[p][j].x * v[p][j].x + v[p][j].y * v[p][j].y) + (v[p][j].z * v[p][j].z + v[p][j].w * v[p][j].w);
            rstd[p] = 1.0f / sqrtf(wave_sum(ss) * (1.0f / D) + EPS); }
        if (MODE == 2) {
#pragma unroll
            for (int p = 0; p < 2; ++p) if (p == 0 || do1) {
#pragma unroll
                for (int j = 0; j < 4; ++j) *(f32x4*)(out + (size_t)(mr[p] - MC) * D + 4 * lane + 256 * j) = v[p][j] * rstd[p] * gv[j]; }
            continue; }
        f32x4 h[2][4];
#pragma unroll
        for (int p = 0; p < 2; ++p)
#pragma unroll
            for (int j = 0; j < 4; ++j) { h[p][j] = v[p][j] * rstd[p] * av[j] + bv[j];
                if (p == 0 || do1) { u32x2 w; w.x = cvtpk(h[p][j].x, h[p][j].y); w.y = cvtpk(h[p][j].z, h[p][j].w); *(u32x2*)(H + (size_t)mr[p] * D + 4 * lane + 256 * j) = w; } }
        if (MODE == 0 || (MODE == 1 && moe_router)) {
            constexpr int NC = (MODE == 0) ? 16 : 8;
            float a[2][NC];
#pragma unroll
            for (int p = 0; p < 2; ++p)
#pragma unroll
                for (int c = 0; c < NC; ++c) a[p][c] = 0.f;
#pragma unroll
            for (int j = 0; j < 4; ++j)
#pragma unroll
                for (int e = 0; e < 4; ++e) { const int kp = (j * 4 + e) * 64 + lane;
#pragma unroll
                    for (int q = 0; q < NC / 4; ++q) { const f32x4 w = *(const LAS f32x4*)(wl + (q * 1024 + kp) * 4);
#pragma unroll
                        for (int p = 0; p < 2; ++p) { const float hv = h[p][j][e]; a[p][4 * q] += hv * w.x; a[p][4 * q + 1] += hv * w.y; a[p][4 * q + 2] += hv * w.z; a[p][4 * q + 3] += hv * w.w; } } }
#pragma unroll
            for (int p = 0; p < 2; ++p) {
#pragma unroll
                for (int c = 0; c < NC; ++c) a[p][c] = wave_sum(a[p][c]); }
#pragma unroll
            for (int p = 0; p < 2; ++p) if (p == 0 || do1) { const int m = mr[p];
                if (MODE == 0) { float mine = 0.f;
#pragma unroll
                    for (int c = 0; c < NC; ++c) mine = (lane == c) ? a[p][c] : mine;
                    if (lane < 16) ((float*)(F.ws + WS_AB))[(size_t)m * 16 + lane] = mine; }
                else { int i0 = 0; float l0 = a[p][0];
#pragma unroll
                    for (int c = 1; c < NC; ++c) if (a[p][c] > l0) { l0 = a[p][c]; i0 = c; }
                    int i1 = -1; float l1 = -3.0e38f;
#pragma unroll
                    for (int c = 0; c < NC; ++c) if (c != i0 && a[p][c] > l1) { l1 = a[p][c]; i1 = c; }
                    const float e1 = fexp(l1 - l0), gg0 = 1.0f / (1.0f + e1), gg1 = e1 / (1.0f + e1);
                    if (lane == 0 && m >= route_lo) { ((int*)(F.ws + WS_TKE))[2 * m] = i0; ((int*)(F.ws + WS_TKE))[2 * m + 1] = i1; ((float*)(F.ws + WS_TKG))[2 * m] = gg0; ((float*)(F.ws + WS_TKG))[2 * m + 1] = gg1;
                        ((int*)(F.ws + WS_TOKROW))[2 * m] = __hip_atomic_fetch_add(lcnt + i0, 1, __ATOMIC_RELAXED, __HIP_MEMORY_SCOPE_WORKGROUP); ((int*)(F.ws + WS_TOKROW))[2 * m + 1] = __hip_atomic_fetch_add(lcnt + i1, 1, __ATOMIC_RELAXED, __HIP_MEMORY_SCOPE_WORKGROUP); } } }
        }
    }
    if (MODE == 0) PE(9);
    if (MODE == 1) PE(10);
    if (MODE == 1 && moe_router) { __syncthreads(); if (F.tid < 8) ((int*)(F.ws + WS_TILEE + 4096))[F.bid * 8 + F.tid] = lcnt[F.tid]; }
}


__device__ __forceinline__ void unpack8(const u32x4 w, float (&v)[8]) {
#pragma unroll
    for (int e = 0; e < 4; ++e) { v[2 * e] = __uint_as_float(w[e] << 16); v[2 * e + 1] = __uint_as_float(w[e] & 0xffff0000u); } }
__device__ __forceinline__ u32x4 pack8(const float (&v)[8]) { u32x4 w; w.x = cvtpk(v[0], v[1]); w.y = cvtpk(v[2], v[3]); w.z = cvtpk(v[4], v[5]); w.w = cvtpk(v[6], v[7]); return w; }


__device__ __forceinline__ void phase_prep3(Frame& F, const Inputs& in, int layer) {
    const bf16* P = (const bf16*)(F.ws + WS_R1 + R1_P);
    unsigned char* prep = F.ws + WS_R1 + R1_PREP;
    bf16* RQ = (bf16*)(prep + PREP_RQ); bf16* RK = (bf16*)(prep + PREP_RK); bf16* SQ = (bf16*)(prep + PREP_SQ); bf16* SK = (bf16*)(prep + PREP_SK); bf16* GD = (bf16*)(prep + PREP_GD);
    const float* rope = (const float*)(F.ws + WS_ROPE);
    const float* AB = (const float*)(F.ws + WS_AB); float* GB = (float*)(F.ws + WS_GB);
    const float* cw = in.gdn_conv_w + (size_t)layer * 5 * 768;
    const int lane = F.lane, l3 = lane & 3, l31 = lane & 31;
    float wA[5][8], wB[5][8];
#pragma unroll
    for (int j = 0; j < 5; ++j) { const f32x4 a0 = *(const f32x4*)(cw + j * 768 + 8 * lane), a1 = *(const f32x4*)(cw + j * 768 + 8 * lane + 4), b0 = *(const f32x4*)(cw + j * 768 + 512 + 8 * l31), b1 = *(const f32x4*)(cw + j * 768 + 512 + 8 * l31 + 4);
#pragma unroll
        for (int x = 0; x < 4; ++x) { wA[j][x] = a0[x]; wA[j][4 + x] = a1[x]; wB[j][x] = b0[x]; wB[j][4 + x] = b1[x]; } }
    const float sgn = ((lane & 7) < 4) ? -1.0f : 1.0f;
    const bool isk = lane >= 32;
    const float dtb = in.gdn_dt_bias[layer * 8 + (lane & 7)], alg = -fexp(in.gdn_a_log[layer * 8 + (lane & 7)]);
    for (int mbase = F.gw; mbase < M; mbase += 2 * F.NGW) {
        const bool ok1 = mbase + F.NGW < M;
        const int mm[2] = {mbase, ok1 ? mbase + F.NGW : mbase};
        bool lat[2]; int tt0[2], Tn[2]; const bf16* prow[2];
#pragma unroll
        for (int p = 0; p < 2; ++p) { const int m = mm[p]; lat[p] = m >= MC; tt0[p] = lat[p] ? ((m - MC) & (TL - 1)) : (m & (TC - 1)); Tn[p] = lat[p] ? TL : TC; prow[p] = P + (size_t)m * NP; }
        f32x4 rt[2][4]; u32x4 u1[2], u2[2], u3[2];
#pragma unroll
        for (int p = 0; p < 2; ++p) { const int t = tt0[p]; const int pos = (l3 < 2) ? (t >> 6) : (t & 63); const float* rp = rope + (pos * 16 + 8 * (l3 & 1)) * 2;
            rt[p][0] = *(const f32x4*)(rp); rt[p][1] = *(const f32x4*)(rp + 4); rt[p][2] = *(const f32x4*)(rp + 8); rt[p][3] = *(const f32x4*)(rp + 12);
            u1[p] = *(const u32x4*)(prow[p] + (isk ? PC_RK : PC_RQ) + 8 * l31); u2[p] = *(const u32x4*)(prow[p] + PC_SQ + 8 * lane); u3[p] = *(const u32x4*)(prow[p] + PC_SK + 8 * (lane & 15)); }
        __builtin_amdgcn_sched_barrier(0);
#pragma unroll
        for (int p = 0; p < 2; ++p) { const int m = mm[p]; const bool st = (p == 0) || ok1;
            float cs[8], sn[8];
#pragma unroll
            for (int x = 0; x < 8; ++x) { cs[x] = rt[p][x >> 1][(x & 1) * 2]; sn[x] = rt[p][x >> 1][(x & 1) * 2 + 1]; if (!lat[p]) { cs[x] = 1.0f; sn[x] = 0.0f; } sn[x] *= sgn; }
            { float v[8], o[8]; unpack8(u1[p], v);
#pragma unroll
              for (int x = 0; x < 8; ++x) { if (isk) v[x] *= 0.125f; const float pv = __shfl_xor(v[x], 4); o[x] = v[x] * cs[x] + pv * sn[x]; }
              if (st) *(u32x4*)((isk ? RK : RQ) + (size_t)m * 256 + 8 * l31) = pack8(o); }
            { float v[8], o[8]; unpack8(u2[p], v);
#pragma unroll
              for (int x = 0; x < 8; ++x) { const float pv = __shfl_xor(v[x], 4); o[x] = v[x] * cs[x] + pv * sn[x]; }
              if (st) *(u32x4*)(SQ + (size_t)m * 512 + 8 * lane) = pack8(o); }
            { float v[8], o[8]; unpack8(u3[p], v);
#pragma unroll
              for (int x = 0; x < 8; ++x) { const float pv = __shfl_xor(v[x], 4); o[x] = v[x] * cs[x] + pv * sn[x]; }
              if (st && lane < 16) *(u32x4*)(SK + (size_t)m * 128 + 8 * lane) = pack8(o); } }
        { u32x4 ca[2][5];
#pragma unroll
          for (int p = 0; p < 2; ++p)
#pragma unroll
              for (int j = 0; j < 5; ++j) { const int tt = tt0[p] + j - 2; const bool ok = tt >= 0 && tt < Tn[p]; ca[p][j] = *(const u32x4*)(prow[p] + (ok ? (ptrdiff_t)(j - 2) * NP : (ptrdiff_t)0) + PC_GQKV + 8 * lane); }
          __builtin_amdgcn_sched_barrier(0);
#pragma unroll
          for (int p = 0; p < 2; ++p) { float a[8];
#pragma unroll
              for (int x = 0; x < 8; ++x) a[x] = 0.f;
#pragma unroll
              for (int j = 0; j < 5; ++j) { const int tt = tt0[p] + j - 2; const float z = (tt >= 0 && tt < Tn[p]) ? 1.0f : 0.0f; float va[8]; unpack8(ca[p][j], va);
#pragma unroll
                  for (int x = 0; x < 8; ++x) a[x] += z * wA[j][x] * va[x]; }
              float n2 = 0.f;
#pragma unroll
              for (int x = 0; x < 8; ++x) { a[x] = siluf(a[x]); n2 += a[x] * a[x]; }
              n2 += dppf<0xB1>(n2); n2 += dppf<0x4E>(n2); n2 += dppf<0x141>(n2);
              const float sc = __builtin_amdgcn_rsqf(n2 + EPS) * (lane < 32 ? 0.125f : 1.0f);
#pragma unroll
              for (int x = 0; x < 8; ++x) a[x] *= sc;
              if (p == 0 || ok1) *(u32x4*)(GD + (size_t)mm[p] * 768 + 8 * lane) = pack8(a); } }
        { u32x4 cb[2][5]; float abv[2];
#pragma unroll
          for (int p = 0; p < 2; ++p) {
#pragma unroll
              for (int j = 0; j < 5; ++j) { const int tt = tt0[p] + j - 2; const bool ok = tt >= 0 && tt < Tn[p]; cb[p][j] = *(const u32x4*)(prow[p] + (ok ? (ptrdiff_t)(j - 2) * NP : (ptrdiff_t)0) + PC_GQKV + 512 + 8 * l31); }
              abv[p] = AB[(size_t)mm[p] * 16 + (lane & 15)]; }
          __builtin_amdgcn_sched_barrier(0);
#pragma unroll
          for (int p = 0; p < 2; ++p) { const int m = mm[p]; float bq[8];
#pragma unroll
              for (int x = 0; x < 8; ++x) bq[x] = 0.f;
#pragma unroll
              for (int j = 0; j < 5; ++j) { const int tt = tt0[p] + j - 2; const float z = (tt >= 0 && tt < Tn[p]) ? 1.0f : 0.0f; float vb[8]; unpack8(cb[p][j], vb);
#pragma unroll
                  for (int x = 0; x < 8; ++x) bq[x] += z * wB[j][x] * vb[x]; }
#pragma unroll
              for (int x = 0; x < 8; ++x) bq[x] = siluf(bq[x]);
              if (p == 0 || ok1) { if (lane < 32) *(u32x4*)(GD + (size_t)m * 768 + 512 + 8 * lane) = pack8(bq);
                  if (lane < 16) { const float av = abv[p]; float o;
                      if (lane < 8) { const float xx = av + dtb; const float sp = fmaxf(xx, 0.f) + log1pf(fexp(-fabsf(xx))); o = alg * sp; }
                      else o = __builtin_amdgcn_rcpf(1.0f + fexp(-av));
                      GB[(size_t)m * 16 + lane] = o; } } } }
    }
}


__device__ __forceinline__ void phase_swa2(Frame& F, const Inputs& in, int layer, int nwg) {
    if (F.bid >= nwg) return;
    const bf16* P = (const bf16*)(F.ws + WS_R1 + R1_P);
    unsigned char* prep = F.ws + WS_R1 + R1_PREP;
    const bf16* SQ = (const bf16*)(prep + PREP_SQ); const bf16* SK = (const bf16*)(prep + PREP_SK);
    bf16* O = (bf16*)(F.ws + WS_R1 + R1_O);
    LAS bf16* Kl = (LAS bf16*)F.lds; LAS bf16* Vt = Kl + 64 * 72;
    const int lane = F.lane, c = lane & 15, q = lane >> 4, w = F.wave;
    const float LOG2E = 1.4426950408889634f;
    const int srow = F.tid >> 3, scol = (F.tid & 7) * 8;
    DynQ dq = dyn_make(F, layer, 1);
    for (int u = dyn_bcast(dq, dyn_grab(dq)); u < 544; ) {
        const int u_next = dyn_grab(dq);
        const bool lat = u < 512; int b, g, qb;
        if (lat) { b = u >> 7; g = (u >> 6) & 1; qb = u & 63; } else { const int uu = u - 512; b = uu >> 3; g = (uu >> 2) & 1; qb = uu & 3; }
        const int hq = 4 * g + (w >> 1), i0 = 32 * (w & 1);
        const int mrow0 = lat ? MC + b * TL + 64 * qb : b * TC + 64 * qb;
        const int kt0 = lat ? (2 - qb > 0 ? 2 - qb : 0) : 0, kt1 = lat ? (65 - qb < 4 ? 65 - qb : 4) : -1, nb = lat ? kt1 - kt0 + 1 : 0, nt = nb + 4;
        const int band0 = MC + b * TL + 64 * qb - 128 + 64 * kt0, ctx0 = b * TC;
        bf16x8 qf[2][2];
#pragma unroll
        for (int ti = 0; ti < 2; ++ti)
#pragma unroll
            for (int ks = 0; ks < 2; ++ks) qf[ti][ks] = *(const bf16x8*)(SQ + (size_t)(mrow0 + i0 + 16 * ti + c) * 512 + hq * 64 + 32 * ks + 8 * q);
        float mrun[2], lrun[2]; f32x4 oacc[4][2];
        const float sk = in.swa_sink[layer * 8 + hq] * LOG2E;
#pragma unroll
        for (int ti = 0; ti < 2; ++ti) { mrun[ti] = sk; lrun[ti] = 1.0f;
#pragma unroll
            for (int te = 0; te < 4; ++te) oacc[te][ti] = (f32x4){0.f, 0.f, 0.f, 0.f}; }
        u32x4 kreg, vreg;
        { const int r0 = (0 < nb) ? band0 : ctx0; kreg = *(const u32x4*)(SK + (size_t)(r0 + srow) * 128 + g * 64 + scol); vreg = *(const u32x4*)(P + (size_t)(r0 + srow) * NP + PC_SV + g * 64 + scol); }
        for (int tt = 0; tt < nt; ++tt) {
            __syncthreads();
            *(LAS u32x4*)(Kl + srow * 72 + scol) = kreg;
#pragma unroll
            for (int x = 0; x < 8; ++x) Vt[(scol + x) * 72 + srow] = (bf16)(vreg[x >> 1] >> (16 * (x & 1)));
            __syncthreads();
            if (tt + 1 < nt) { const int r0 = (tt + 1 < nb) ? band0 + 64 * (tt + 1) : ctx0 + 64 * (tt + 1 - nb);
                kreg = *(const u32x4*)(SK + (size_t)(r0 + srow) * 128 + g * 64 + scol); vreg = *(const u32x4*)(P + (size_t)(r0 + srow) * NP + PC_SV + g * 64 + scol); }
            bf16x8 kfr[2][4]; u32x2 vlo[2][4], vhi[2][4];
#pragma unroll
            for (int ks = 0; ks < 2; ++ks)
#pragma unroll
                for (int tj = 0; tj < 4; ++tj) kfr[ks][tj] = *(const LAS bf16x8*)(Kl + (16 * tj + c) * 72 + 32 * ks + 8 * q);
#pragma unroll
            for (int ks2 = 0; ks2 < 2; ++ks2)
#pragma unroll
                for (int te = 0; te < 4; ++te) { vlo[ks2][te] = *(const LAS u32x2*)(Vt + (16 * te + c) * 72 + 32 * ks2 + 4 * q); vhi[ks2][te] = *(const LAS u32x2*)(Vt + (16 * te + c) * 72 + 32 * ks2 + 16 + 4 * q); }
            __builtin_amdgcn_sched_barrier(0);
            f32x4 sacc[4][2];
#pragma unroll
            for (int tj = 0; tj < 4; ++tj)
#pragma unroll
                for (int ti = 0; ti < 2; ++ti) sacc[tj][ti] = (f32x4){0.f, 0.f, 0.f, 0.f};
#pragma unroll
            for (int ks = 0; ks < 2; ++ks)
#pragma unroll
                for (int tj = 0; tj < 4; ++tj)
#pragma unroll
                    for (int ti = 0; ti < 2; ++ti) sacc[tj][ti] = mfma16(kfr[ks][tj], qf[ti][ks], sacc[tj][ti]);
            const bool band = tt < nb;
            const int kp0 = 64 * qb - 128 + 64 * (kt0 + tt) + 4 * q;
#pragma unroll
            for (int ti = 0; ti < 2; ++ti) {
                const int qp = 64 * qb + i0 + 16 * ti + c;
                float mx = -30000.0f;
                if (band) {
#pragma unroll
                    for (int tj = 0; tj < 4; ++tj)
#pragma unroll
                        for (int r = 0; r < 4; ++r) { float sv = sacc[tj][ti][r] * (0.125f * LOG2E); const int dlt = kp0 + 16 * tj + r - qp; if (dlt > 128 || dlt < -128) sv = -30000.0f; sacc[tj][ti][r] = sv; mx = fmaxf(mx, sv); }
                } else {
#pragma unroll
                    for (int tj = 0; tj < 4; ++tj)
#pragma unroll
                        for (int r = 0; r < 4; ++r) { const float sv = sacc[tj][ti][r] * (0.125f * LOG2E); sacc[tj][ti][r] = sv; mx = fmaxf(mx, sv); }
                }
                mx = quad_rows_max(mx);
                const float mn = fmaxf(mrun[ti], mx), corr = __builtin_amdgcn_exp2f(mrun[ti] - mn);
                float ls = 0.f;
#pragma unroll
                for (int tj = 0; tj < 4; ++tj)
#pragma unroll
                    for (int r = 0; r < 4; ++r) { const float p = __builtin_amdgcn_exp2f(sacc[tj][ti][r] - mn); sacc[tj][ti][r] = p; ls += p; }
                ls = quad_rows_sum(ls);
                lrun[ti] = lrun[ti] * corr + ls; mrun[ti] = mn;
#pragma unroll
                for (int te = 0; te < 4; ++te) oacc[te][ti] *= corr;
            }
#pragma unroll
            for (int ks2 = 0; ks2 < 2; ++ks2) {
                bf16x8 pb[2];
#pragma unroll
                for (int ti = 0; ti < 2; ++ti) { u32x4 t; t.x = cvtpk(sacc[2 * ks2][ti][0], sacc[2 * ks2][ti][1]); t.y = cvtpk(sacc[2 * ks2][ti][2], sacc[2 * ks2][ti][3]);
                    t.z = cvtpk(sacc[2 * ks2 + 1][ti][0], sacc[2 * ks2 + 1][ti][1]); t.w = cvtpk(sacc[2 * ks2 + 1][ti][2], sacc[2 * ks2 + 1][ti][3]); pb[ti] = __builtin_bit_cast(bf16x8, t); }
#pragma unroll
                for (int te = 0; te < 4; ++te) { const bf16x8 va = __builtin_bit_cast(bf16x8, ((u32x4){vlo[ks2][te].x, vlo[ks2][te].y, vhi[ks2][te].x, vhi[ks2][te].y}));
#pragma unroll
                    for (int ti = 0; ti < 2; ++ti) oacc[te][ti] = mfma16(va, pb[ti], oacc[te][ti]); }
            }
        }
#pragma unroll
        for (int ti = 0; ti < 2; ++ti) { const float il = 1.0f / lrun[ti]; bf16* orow = O + (size_t)(mrow0 + i0 + 16 * ti + c) * D + 512 + hq * 64 + 4 * q;
#pragma unroll
            for (int te = 0; te < 4; ++te) { u32x2 wv; wv.x = cvtpk(oacc[te][ti][0] * il, oacc[te][ti][1] * il); wv.y = cvtpk(oacc[te][ti][2] * il, oacc[te][ti][3] * il); *(u32x2*)(orow + 16 * te) = wv; } }
        u = dyn_bcast(dq, u_next);
    }
}


__device__ __forceinline__ void phase_gdn_local3(Frame& F, int layer) {
    unsigned char* prep = F.ws + WS_R1 + R1_PREP;
    const bf16* GD = (const bf16*)(prep + PREP_GD); const float* GB = (const float*)(F.ws + WS_GB);
    const int lane = F.lane, c = lane & 15, q = lane >> 4, w = F.wave, half = w >> 2, wq = w & 3, t2 = F.tid & 255;
    LAS unsigned char* L0 = F.lds + half * 54272;
    LAS bf16* Ks = (LAS bf16*)L0; LAS bf16* Vs = Ks + 64 * 72;
    LAS float* At = (LAS float*)(L0 + 18432);
    LAS bf16* XS_ = (LAS bf16*)(L0 + 18432);
    LAS float* sm = (LAS float*)(L0 + 51200);
    LAS float* gl = sm; LAS float* bl = sm + 128; LAS float* gcs = sm + 256; LAS float* eg = sm + 384; LAS float* ekd = sm + 512;
    DynQ dq = dyn_make(F, layer, 0);
    for (int pp = dyn_bcast(dq, dyn_grab(dq)); pp < 8 * 68; ) {
        const int pp_next = dyn_grab(dq);
        const int uu = 2 * pp + half, bh = uu / 68, ch = uu % 68, b = bh >> 2, hh = bh & 3;
        const int m0 = ch < 4 ? b * TC + 64 * ch : MC + b * TL + 64 * (ch - 4);
        __syncthreads();
#pragma unroll
        for (int rep = 0; rep < 2; ++rep) { const int idx = t2 + 256 * rep, row = idx >> 3, col8 = (idx & 7) * 8; const bf16* src = GD + (size_t)(m0 + row) * 768 + hh * 64 + col8;
            *(LAS u32x4*)(Ks + row * 72 + col8) = *(const u32x4*)(src + 256); *(LAS u32x4*)(Vs + row * 72 + col8) = *(const u32x4*)(src + 512); }
        { const int tok = t2 & 63, which = t2 >> 6; sm[which * 64 + tok] = GB[(size_t)(m0 + tok) * 16 + (which >> 1) * 8 + (which & 1) * 4 + hh]; }
        __syncthreads();
        if (wq < 2) { const int d = wq; const int tok = d ? 63 - lane : lane; float v = gl[d * 64 + tok];
#pragma unroll
            for (int o = 1; o < 64; o <<= 1) { const float t = __shfl_up(v, o); if (lane >= o) v += t; }
            const float last = __shfl(v, 63);
            gcs[d * 64 + lane] = v; eg[d * 64 + lane] = fexp(v); ekd[d * 64 + lane] = fexp(last - v);
            ((float*)(F.ws + WS_GCS))[((size_t)uu * 2 + d) * 64 + tok] = v; }
        __syncthreads();
        {
            const int ti = wq;
            bf16x8 a[2];
#pragma unroll
            for (int ks = 0; ks < 2; ++ks) a[ks] = *(const LAS bf16x8*)(Ks + (16 * ti + c) * 72 + 32 * ks + 8 * q);
#pragma unroll
            for (int tj = 0; tj < 4; ++tj) { f32x4 acc = (f32x4){0.f, 0.f, 0.f, 0.f};
#pragma unroll
                for (int ks = 0; ks < 2; ++ks) acc = mfma16(a[ks], *(const LAS bf16x8*)(Ks + (16 * tj + c) * 72 + 32 * ks + 8 * q), acc);
#pragma unroll
                for (int r = 0; r < 4; ++r) { const int it = 16 * ti + 4 * q + r, jt = 16 * tj + c;
#pragma unroll
                    for (int d = 0; d < 2; ++d) { const int i = d ? 63 - it : it, j = d ? 63 - jt : jt;
                        const float e = fexp(fminf(gcs[d * 64 + i] - gcs[d * 64 + j], 0.f));
                        At[d * 4096 + j * 64 + i] = (j < i) ? bl[d * 64 + it] * acc[r] * e : 0.f; } } }
        }
        __syncthreads();
        float x[64];
        const int sd = wq >> 1, kind = wq & 1;
        {
            const LAS bf16* R = kind ? Ks : Vs; const LAS float* A = At + sd * 4096;
#pragma unroll
            for (int i = 0; i < 64; ++i) { const int tok = sd ? 63 - i : i; float v = bl[sd * 64 + tok] * bf2f(R[tok * 72 + lane]); if (kind) v *= eg[sd * 64 + i]; x[i] = v; }
#pragma unroll
            for (int j = 0; j < 63; ++j) { const float xj = x[j];
                f32x4 ca[16];
#pragma unroll
                for (int g = ((j + 1) >> 2); g < 16; ++g) ca[g] = *(const LAS f32x4*)(A + j * 64 + 4 * g);
                __builtin_amdgcn_sched_barrier(0);
#pragma unroll
                for (int g = ((j + 1) >> 2); g < 16; ++g) { x[4 * g] -= ca[g].x * xj; x[4 * g + 1] -= ca[g].y * xj; x[4 * g + 2] -= ca[g].z * xj; x[4 * g + 3] -= ca[g].w * xj; }
                __builtin_amdgcn_sched_barrier(0); }
        }
        __syncthreads();
        { LAS bf16* XO = XS_ + (sd * 2 + kind) * 4096;
#pragma unroll
          for (int i = 0; i < 64; ++i) XO[(sd ? 63 - i : i) * 64 + lane] = (bf16)f2bf(x[i]); }
        __syncthreads();
        {
            for (int it = t2; it < 2 * 512; it += 256) { const int d = it >> 9, chk = it & 511;
                const int rt = chk >> 7, ks = (chk >> 6) & 1, ln = chk & 63, r = ln & 15, qq = ln >> 4, row = 16 * rt + r, c0 = 32 * ks + 4 * qq;
                const int chain = bh * 2 + d, sg = ch < 4 ? (d ? 3 - ch : ch) : 4 + (d ? 63 - (ch - 4) : ch - 4);
                unsigned char* dst = F.ws + WS_GCH + (size_t)chain * G2_CHAIN + (size_t)sg * G2_STEP;
                const LAS bf16* XW = XS_ + (d * 2 + 1) * 4096;
                const u32x2 lo = *(const LAS u32x2*)(XW + row * 64 + c0), hi = *(const LAS u32x2*)(XW + row * 64 + c0 + 16);
                *(u32x4*)(dst + chk * 16) = (u32x4){lo.x, lo.y, hi.x, hi.y};
                float v[8];
#pragma unroll
                for (int x8 = 0; x8 < 8; ++x8) { const int tok = c0 + (x8 & 3) + 16 * (x8 >> 2); const int i = d ? 63 - tok : tok; v[x8] = bf2f(Ks[tok * 72 + row]) * ekd[d * 64 + i]; }
                u32x4 o; o.x = cvtpk(v[0], v[1]); o.y = cvtpk(v[2], v[3]); o.z = cvtpk(v[4], v[5]); o.w = cvtpk(v[6], v[7]);
                *(u32x4*)(dst + 8192 + chk * 16) = o; }
            for (int it = t2; it < 2 * 1024; it += 256) { const int d = it >> 10, cu = it & 1023;
                const int sl = cu >> 8, rt = (cu >> 6) & 3, ln = cu & 63, qq = ln >> 4, cc = ln & 15;
                const LAS bf16* XU = XS_ + (d * 2) * 4096; const int tr = 16 * rt + 4 * qq;
                const bf16 e0 = XU[(tr) * 64 + 16 * sl + cc], e1 = XU[(tr + 1) * 64 + 16 * sl + cc], e2 = XU[(tr + 2) * 64 + 16 * sl + cc], e3 = XU[(tr + 3) * 64 + 16 * sl + cc];
                const int chain = bh * 2 + d, sg = ch < 4 ? (d ? 3 - ch : ch) : 4 + (d ? 63 - (ch - 4) : ch - 4);
                unsigned char* dst = F.ws + WS_GCH + (size_t)chain * G2_CHAIN + (size_t)sg * G2_STEP + 16384;
                *(u32x2*)(dst + cu * 8) = (u32x2){(unsigned)e0 | ((unsigned)e1 << 16), (unsigned)e2 | ((unsigned)e3 << 16)}; }
            if (t2 < 2) { const int d = t2; const int chain = bh * 2 + d, sg = ch < 4 ? (d ? 3 - ch : ch) : 4 + (d ? 63 - (ch - 4) : ch - 4);
                ((float*)(F.ws + WS_GDEC))[chain * 68 + sg] = eg[d * 64 + 63]; }
        }
        pp = dyn_bcast(dq, pp_next);
    }
}


__device__ __forceinline__ void phase_gdn_scan3(Frame& F, int first_wg) {
    const int chain = F.bid - first_wg; if (chain < 0 || chain >= 32) return;
    const unsigned char* src = F.ws + WS_GCH + (size_t)chain * G2_CHAIN;
    const float* decs = (const float*)(F.ws + WS_GDEC) + chain * 68;
    unsigned char* GSTb = F.ws + WS_GST + (size_t)chain * 68 * 16384;
    LAS unsigned char* ring = F.lds;
    const int lane = F.lane, w = F.wave;
    if (w >= 4) {
        const int dw = w - 4;
#define GS3_ISSUE(step) do { _Pragma("unroll") for (int k = 0; k < 6; ++k) { const int p = dw * 6 + k; \
            __builtin_amdgcn_global_load_lds((const unsigned*)(src + (size_t)(step) * G2_STEP + p * 1024 + lane * 16), (LAS unsigned*)(ring + ((step) & 3) * 24576 + p * 1024), 16, 0, 0); } } while (0)
        GS3_ISSUE(0); GS3_ISSUE(1); GS3_ISSUE(2);
        asm volatile("s_waitcnt vmcnt(12)" ::: "memory"); __builtin_amdgcn_s_barrier();
        for (int n = 0; n < 68; ++n) {
            if (n + 3 < 68) { GS3_ISSUE(n + 3); asm volatile("s_waitcnt vmcnt(12)" ::: "memory"); }
            else if (n + 2 < 68) asm volatile("s_waitcnt vmcnt(6)" ::: "memory");
            else asm volatile("s_waitcnt vmcnt(0)" ::: "memory");
            __builtin_amdgcn_s_barrier();
        }
#undef GS3_ISSUE
    } else {
        const int sl = w;
        f32x4 S[4];
#pragma unroll
        for (int rt = 0; rt < 4; ++rt) S[rt] = (f32x4){0.f, 0.f, 0.f, 0.f};
        const float dv0 = decs[lane], dv1 = decs[64 + (lane & 3)];
        asm volatile("s_waitcnt vmcnt(0)" ::: "memory"); __builtin_amdgcn_s_barrier(); asm volatile("" ::: "memory");
        for (int n = 0; n < 68; ++n) {
            const LAS unsigned char* base = ring + (n & 3) * 24576;
            const float dec = n < 64 ? __shfl(dv0, n) : __shfl(dv1, n - 64);
            unsigned char* go = GSTb + (size_t)n * 16384 + (size_t)(sl * 2 * 64 + lane) * 16;
#define GS3_FRAG(mat, rt, ks) (*(const LAS bf16x8*)(base + (mat) * 8192 + (((rt) * 2 + (ks)) * 64 + lane) * 16))
            bf16x8 wf[4][2], kf[4][2]; u32x2 uf[4];
#pragma unroll
            for (int rt = 0; rt < 4; ++rt) { wf[rt][0] = GS3_FRAG(0, rt, 0); wf[rt][1] = GS3_FRAG(0, rt, 1); }
#pragma unroll
            for (int rt = 0; rt < 4; ++rt) uf[rt] = *(const LAS u32x2*)(base + 16384 + ((sl * 4 + rt) * 64 + lane) * 8);
#pragma unroll
            for (int rt = 0; rt < 4; ++rt) { kf[rt][0] = GS3_FRAG(1, rt, 0); kf[rt][1] = GS3_FRAG(1, rt, 1); }
#undef GS3_FRAG
            __builtin_amdgcn_sched_barrier(0);
            bf16x8 BS[2], BV[2];
#pragma unroll
            for (int ks = 0; ks < 2; ++ks) { u32x4 t; t.x = cvtpk(S[2 * ks][0], S[2 * ks][1]); t.y = cvtpk(S[2 * ks][2], S[2 * ks][3]); t.z = cvtpk(S[2 * ks + 1][0], S[2 * ks + 1][1]); t.w = cvtpk(S[2 * ks + 1][2], S[2 * ks + 1][3]);
                BS[ks] = __builtin_bit_cast(bf16x8, t); *(u32x4*)(go + ks * 1024) = t; }
            f32x4 vn[4];
#pragma unroll
            for (int ks = 0; ks < 2; ++ks)
#pragma unroll
                for (int rt = 0; rt < 4; ++rt) vn[rt] = mfma16(wf[rt][ks], BS[ks], ks ? vn[rt] : (f32x4){0.f, 0.f, 0.f, 0.f});
#pragma unroll
            for (int rt = 0; rt < 4; ++rt) { const u32x2 uu = uf[rt];
                vn[rt] = (f32x4){__uint_as_float(uu.x << 16), __uint_as_float(uu.x & 0xffff0000u), __uint_as_float(uu.y << 16), __uint_as_float(uu.y & 0xffff0000u)} - vn[rt]; }
#pragma unroll
            for (int ks = 0; ks < 2; ++ks) { u32x4 t; t.x = cvtpk(vn[2 * ks][0], vn[2 * ks][1]); t.y = cvtpk(vn[2 * ks][2], vn[2 * ks][3]); t.z = cvtpk(vn[2 * ks + 1][0], vn[2 * ks + 1][1]); t.w = cvtpk(vn[2 * ks + 1][2], vn[2 * ks + 1][3]);
                BV[ks] = __builtin_bit_cast(bf16x8, t); *(u32x4*)(go + 8192 + ks * 1024) = t; }
#pragma unroll
            for (int rt = 0; rt < 4; ++rt) S[rt] = S[rt] * dec;
#pragma unroll
            for (int ks = 0; ks < 2; ++ks)
#pragma unroll
                for (int rt = 0; rt < 4; ++rt) S[rt] = mfma16(kf[rt][ks], BV[ks], S[rt]);
            asm volatile("s_waitcnt lgkmcnt(0)" ::: "memory"); __builtin_amdgcn_s_barrier(); asm volatile("" ::: "memory");
        }
    }
}

__device__ __forceinline__ void phase_gdn_out2(Frame& F, const Inputs& in, int layer) {
    const bf16* P = (const bf16*)(F.ws + WS_R1 + R1_P);
    const bf16* GD = (const bf16*)(F.ws + WS_R1 + R1_PREP + PREP_GD);
    const unsigned char* GSTb = F.ws + WS_GST; const float* GCS = (const float*)(F.ws + WS_GCS);
    bf16* O = (bf16*)(F.ws + WS_R1 + R1_O);
    const int lane = F.lane, c = lane & 15, q = lane >> 4, w = F.wave, half = w >> 2, ti = w & 3, t2 = F.tid & 255;
    LAS bf16* Qs = (LAS bf16*)(F.lds + half * 56320); LAS bf16* Ks = Qs + 4608;
    LAS unsigned char* Fr = F.lds + half * 56320 + 18432;
    LAS float* gT = (LAS float*)(F.lds + half * 56320 + 55296);
    DynQ dq = dyn_make(F, layer, 4);
    for (int pp = dyn_bcast(dq, dyn_grab(dq)); pp < 8 * 68; ) {
        const int pp_next = dyn_grab(dq);
        const int uu = 2 * pp + half, bh = uu / 68, ch = uu % 68, b = bh >> 2, hh = bh & 3;
        const int m0 = ch < 4 ? b * TC + 64 * ch : MC + b * TL + 64 * (ch - 4);
        __syncthreads();
#pragma unroll
        for (int rep = 0; rep < 2; ++rep) { const int idx = t2 + 256 * rep, row = idx >> 3, col8 = (idx & 7) * 8;
            const bf16* src = GD + (size_t)(m0 + row) * 768 + hh * 64 + col8;
            *(LAS u32x4*)(Qs + row * 72 + col8) = *(const u32x4*)(src); *(LAS u32x4*)(Ks + row * 72 + col8) = *(const u32x4*)(src + 256); }
#pragma unroll
        for (int d = 0; d < 2; ++d) { const int sg = ch < 4 ? (d ? 3 - ch : ch) : 4 + (d ? 63 - (ch - 4) : ch - 4);
            const unsigned char* g = GSTb + ((size_t)(bh * 2 + d) * 68 + sg) * 16384;
#pragma unroll
            for (int rep = 0; rep < 4; ++rep) { const int idx = t2 + 256 * rep; *(LAS u32x4*)(Fr + d * 16384 + idx * 16) = *(const u32x4*)(g + (size_t)idx * 16); } }
        if (t2 < 128) gT[t2] = GCS[(size_t)uu * 128 + t2];
        __syncthreads();
        bf16x8 qf[2], qr[2];
#pragma unroll
        for (int ks = 0; ks < 2; ++ks) { qf[ks] = *(const LAS bf16x8*)(Qs + (16 * ti + c) * 72 + 32 * ks + 8 * q);
            const u32x2 lo = *(const LAS u32x2*)(Qs + (16 * ti + c) * 72 + 32 * ks + 4 * q), hi = *(const LAS u32x2*)(Qs + (16 * ti + c) * 72 + 32 * ks + 16 + 4 * q);
            qr[ks] = __builtin_bit_cast(bf16x8, ((u32x4){lo.x, lo.y, hi.x, hi.y})); }
        const int i = 16 * ti + c;
        const float gi0 = gT[i], gi1 = gT[64 + i];
        f32x4 sacc[4];
#pragma unroll
        for (int tj = 0; tj < 4; ++tj) { f32x4 acc = (f32x4){0.f, 0.f, 0.f, 0.f};
#pragma unroll
            for (int ks = 0; ks < 2; ++ks) acc = mfma16(*(const LAS bf16x8*)(Ks + (16 * tj + c) * 72 + 32 * ks + 8 * q), qf[ks], acc);
            sacc[tj] = acc; }
        bf16x8 pb[2][2];
#pragma unroll
        for (int d = 0; d < 2; ++d) { f32x4 p[4];
#pragma unroll
            for (int tj = 0; tj < 4; ++tj) { const f32x4 gj = *(const LAS f32x4*)(gT + d * 64 + 16 * tj + 4 * q);
#pragma unroll
                for (int r = 0; r < 4; ++r) { const int j = 16 * tj + 4 * q + r; const bool ok = d ? (j >= i) : (j <= i);
                    p[tj][r] = ok ? sacc[tj][r] * fexp(fminf((d ? gi1 : gi0) - gj[r], 0.f)) : 0.f; } }
#pragma unroll
            for (int ks2 = 0; ks2 < 2; ++ks2) { u32x4 t; t.x = cvtpk(p[2 * ks2][0], p[2 * ks2][1]); t.y = cvtpk(p[2 * ks2][2], p[2 * ks2][3]); t.z = cvtpk(p[2 * ks2 + 1][0], p[2 * ks2 + 1][1]); t.w = cvtpk(p[2 * ks2 + 1][2], p[2 * ks2 + 1][3]); pb[d][ks2] = __builtin_bit_cast(bf16x8, t); } }
        const float sc0 = fexp(gi0), sc1 = fexp(gi1);
        f32x4 o[4]; float ssq = 0.f;
#pragma unroll
        for (int te = 0; te < 4; ++te) { f32x4 acc = (f32x4){0.f, 0.f, 0.f, 0.f}, t0 = acc, t1 = acc;
#pragma unroll
            for (int ks = 0; ks < 2; ++ks) {
                acc = mfma16(*(const LAS bf16x8*)(Fr + 8192 + ((te * 2 + ks) * 64 + lane) * 16), pb[0][ks], acc);
                acc = mfma16(*(const LAS bf16x8*)(Fr + 16384 + 8192 + ((te * 2 + ks) * 64 + lane) * 16), pb[1][ks], acc);
                t0 = mfma16(*(const LAS bf16x8*)(Fr + ((te * 2 + ks) * 64 + lane) * 16), qr[ks], t0);
                t1 = mfma16(*(const LAS bf16x8*)(Fr + 16384 + ((te * 2 + ks) * 64 + lane) * 16), qr[ks], t1); }
            o[te] = acc + sc0 * t0 + sc1 * t1; ssq += (o[te][0] * o[te][0] + o[te][1] * o[te][1]) + (o[te][2] * o[te][2] + o[te][3] * o[te][3]); }
        ssq = quad_rows_sum(ssq);
        const float rs = 1.0f / sqrtf(ssq * (1.0f / 64.0f) + EPS);
#pragma unroll
        for (int te = 0; te < 4; ++te) { const int e0 = 16 * te + 4 * q;
            const u32x2 z2 = *(const u32x2*)(P + (size_t)(m0 + i) * NP + PC_GZ + hh * 64 + e0); const f32x4 gn = *(const f32x4*)(in.gdn_norm_g + layer * 64 + e0);
            const float z0 = __uint_as_float(z2.x << 16), z1 = __uint_as_float(z2.x & 0xffff0000u), z2f = __uint_as_float(z2.y << 16), z3 = __uint_as_float(z2.y & 0xffff0000u);
            u32x2 wv; wv.x = cvtpk(o[te][0] * rs * gn[0] * siluf(z0), o[te][1] * rs * gn[1] * siluf(z1)); wv.y = cvtpk(o[te][2] * rs * gn[2] * siluf(z2f), o[te][3] * rs * gn[3] * siluf(z3));
            *(u32x2*)(O + (size_t)(m0 + i) * D + 256 + hh * 64 + e0) = wv; }
        pp = dyn_bcast(dq, pp_next);
    }
}

__device__ __forceinline__ void phase_ret_kv(Frame& F, const Inputs& in, int layer) {
    const bf16* P = (const bf16*)(F.ws + WS_R1 + R1_P);
    const bf16* RK = (const bf16*)(F.ws + WS_R1 + R1_PREP + PREP_RK);
    LAS bf16* Kt = (LAS bf16*)F.lds; LAS bf16* Vw = Kt + 64 * 72;
    const int lane = F.lane, c = lane & 15, q = lane >> 4, w = F.wave, tid = F.tid;
    const float LOG2E = 1.4426950408889634f;
    DynQ dq = dyn_make(F, layer, 2);
    for (int uu = dyn_bcast(dq, dyn_grab(dq)); uu < 16 * 68; ) {
        const int uu_next = dyn_grab(dq);
        const int bh = uu / 68, ch = uu % 68, b = bh >> 2, hh = bh & 3;
        const int m0 = ch < 4 ? b * TC + 64 * ch : MC + b * TL + 64 * (ch - 4);
        const float l0 = -fexp(in.ret_decay[layer * 8 + hh]) * LOG2E, l1 = -fexp(in.ret_decay[layer * 8 + 4 + hh]) * LOG2E;
        __syncthreads();
        { const int j = tid >> 3, col8 = (tid & 7) * 8;
          const u32x4 k8 = *(const u32x4*)(RK + (size_t)(m0 + j) * 256 + hh * 64 + col8), v8 = *(const u32x4*)(P + (size_t)(m0 + j) * NP + PC_RV + hh * 64 + col8);
          const float w0 = fexp2((float)(63 - j) * l0), w1 = fexp2((float)j * l1);
#pragma unroll
          for (int x = 0; x < 8; ++x) { const unsigned kk = (k8[x >> 1] >> (16 * (x & 1))) & 0xffffu; const float vv = __uint_as_float(((v8[x >> 1] >> (16 * (x & 1))) & 0xffffu) << 16);
              Kt[(col8 + x) * 72 + j] = (bf16)kk; Vw[(col8 + x) * 72 + j] = (bf16)f2bf(vv * w0); Vw[4608 + (col8 + x) * 72 + j] = (bf16)f2bf(vv * w1); } }
        __syncthreads();
        { const int d = w >> 2, td = w & 3;
          bf16x8 a[2];
#pragma unroll
          for (int ks = 0; ks < 2; ++ks) a[ks] = *(const LAS bf16x8*)(Kt + (16 * td + c) * 72 + 32 * ks + 8 * q);
          const int chain = bh * 2 + d, sg = d ? (ch < 4 ? 3 - ch : 71 - ch) : ch;
          float* dst = (float*)(F.ws + WS_RKV) + ((size_t)chain * 68 + sg) * 4096;
#pragma unroll
          for (int te = 0; te < 4; ++te) { f32x4 acc = (f32x4){0.f, 0.f, 0.f, 0.f};
#pragma unroll
              for (int ks = 0; ks < 2; ++ks) acc = mfma16(a[ks], *(const LAS bf16x8*)(Vw + d * 4608 + (16 * te + c) * 72 + 32 * ks + 8 * q), acc);
              *(f32x4*)(dst + (16 * te + c) * 64 + 16 * td + 4 * q) = acc; } }
        uu = dyn_bcast(dq, uu_next);
    }
}
__device__ __forceinline__ void phase_ret_state(Frame& F, const Inputs& in, int layer, int nwg) {
    if (F.bid >= nwg) return;
    const float* RKV = (const float*)(F.ws + WS_RKV); bf16* RST = (bf16*)(F.ws + WS_RST);
    for (int el = F.bid * NTHR + F.tid; el < 32 * 4096; el += nwg * NTHR) {
        const int chain = el >> 12, idx = el & 4095, hh = (chain >> 1) & 3, d = chain & 1;
        const float G64 = fexp(-64.0f * fexp(in.ret_decay[layer * 8 + d * 4 + hh]));
        const float* kv = RKV + (size_t)chain * 68 * 4096 + idx; bf16* st = RST + (size_t)chain * 68 * 4096 + idx;
        float S = 0.f;
#pragma unroll
        for (int h2 = 0; h2 < 2; ++h2) { float kvv[34];
#pragma unroll
            for (int sg = 0; sg < 34; ++sg) kvv[sg] = kv[(size_t)(34 * h2 + sg) * 4096];
#pragma unroll
            for (int sg = 0; sg < 34; ++sg) { st[(size_t)(34 * h2 + sg) * 4096] = (bf16)f2bf(S); S = G64 * S + kvv[sg]; } }
    }
}
__device__ __forceinline__ void phase_ret_out(Frame& F, const Inputs& in, int layer) {
    const bf16* P = (const bf16*)(F.ws + WS_R1 + R1_P);
    const bf16* RQ = (const bf16*)(F.ws + WS_R1 + R1_PREP + PREP_RQ); const bf16* RK = (const bf16*)(F.ws + WS_R1 + R1_PREP + PREP_RK);
    const bf16* RST = (const bf16*)(F.ws + WS_RST);
    bf16* O = (bf16*)(F.ws + WS_R1 + R1_O);
    const int lane = F.lane, c = lane & 15, q = lane >> 4, w = F.wave, half = w >> 2, ti = w & 3, t2 = F.tid & 255;
    LAS bf16* Qs = (LAS bf16*)(F.lds + half * 46080); LAS bf16* Ks = Qs + 4608; LAS bf16* Vt = Ks + 4608; LAS bf16* St = Vt + 4608;
    const float LOG2E = 1.4426950408889634f;
    DynQ dq = dyn_make(F, layer, 3);
    for (int pp = dyn_bcast(dq, dyn_grab(dq)); pp < 8 * 68; ) {
        const int pp_next = dyn_grab(dq);
        const int uu = 2 * pp + half, bh = uu / 68, ch = uu % 68, b = bh >> 2, hh = bh & 3;
        const int m0 = ch < 4 ? b * TC + 64 * ch : MC + b * TL + 64 * (ch - 4);
        const float l0 = -fexp(in.ret_decay[layer * 8 + hh]) * LOG2E, l1 = -fexp(in.ret_decay[layer * 8 + 4 + hh]) * LOG2E;
        __syncthreads();
#pragma unroll
        for (int rep = 0; rep < 2; ++rep) { const int idx = t2 + 256 * rep, row = idx >> 3, col8 = (idx & 7) * 8;
            *(LAS u32x4*)(Qs + row * 72 + col8) = *(const u32x4*)(RQ + (size_t)(m0 + row) * 256 + hh * 64 + col8);
            *(LAS u32x4*)(Ks + row * 72 + col8) = *(const u32x4*)(RK + (size_t)(m0 + row) * 256 + hh * 64 + col8);
            const u32x4 v8 = *(const u32x4*)(P + (size_t)(m0 + row) * NP + PC_RV + hh * 64 + col8);
#pragma unroll
            for (int x = 0; x < 8; ++x) Vt[(col8 + x) * 72 + row] = (bf16)(v8[x >> 1] >> (16 * (x & 1)));
#pragma unroll
            for (int d = 0; d < 2; ++d) { const int sg = d ? (ch < 4 ? 3 - ch : 71 - ch) : ch;
                *(LAS u32x4*)(St + d * 4608 + row * 72 + col8) = *(const u32x4*)(RST + ((size_t)(bh * 2 + d) * 68 + sg) * 4096 + row * 64 + col8); } }
        __syncthreads();
        bf16x8 qf[2];
#pragma unroll
        for (int ks = 0; ks < 2; ++ks) qf[ks] = *(const LAS bf16x8*)(Qs + (16 * ti + c) * 72 + 32 * ks + 8 * q);
        const int i = 16 * ti + c;
        f32x4 p[4];
#pragma unroll
        for (int tj = 0; tj < 4; ++tj) { f32x4 acc = (f32x4){0.f, 0.f, 0.f, 0.f};
#pragma unroll
            for (int ks = 0; ks < 2; ++ks) acc = mfma16(*(const LAS bf16x8*)(Ks + (16 * tj + c) * 72 + 32 * ks + 8 * q), qf[ks], acc);
#pragma unroll
            for (int r = 0; r < 4; ++r) { const int dlt = i - (16 * tj + 4 * q + r);
                const float wgt = (dlt >= 0 ? fexp2((float)dlt * l0) : 0.f) + (dlt <= 0 ? fexp2((float)(-dlt) * l1) : 0.f);
                acc[r] *= wgt; }
            p[tj] = acc; }
        bf16x8 pb[2];
#pragma unroll
        for (int ks2 = 0; ks2 < 2; ++ks2) { u32x4 t; t.x = cvtpk(p[2 * ks2][0], p[2 * ks2][1]); t.y = cvtpk(p[2 * ks2][2], p[2 * ks2][3]); t.z = cvtpk(p[2 * ks2 + 1][0], p[2 * ks2 + 1][1]); t.w = cvtpk(p[2 * ks2 + 1][2], p[2 * ks2 + 1][3]); pb[ks2] = __builtin_bit_cast(bf16x8, t); }
        const float sc0 = fexp2((float)(i + 1) * l0), sc1 = fexp2((float)(64 - i) * l1);
        f32x4 o[4]; float sum = 0.f;
#pragma unroll
        for (int te = 0; te < 4; ++te) { f32x4 acc = (f32x4){0.f, 0.f, 0.f, 0.f}, t0 = acc, t1 = acc;
#pragma unroll
            for (int ks2 = 0; ks2 < 2; ++ks2) { const u32x2 lo = *(const LAS u32x2*)(Vt + (16 * te + c) * 72 + 32 * ks2 + 4 * q), hi = *(const LAS u32x2*)(Vt + (16 * te + c) * 72 + 32 * ks2 + 16 + 4 * q);
                acc = mfma16(__builtin_bit_cast(bf16x8, ((u32x4){lo.x, lo.y, hi.x, hi.y})), pb[ks2], acc); }
#pragma unroll
            for (int ks = 0; ks < 2; ++ks) { t0 = mfma16(*(const LAS bf16x8*)(St + (16 * te + c) * 72 + 32 * ks + 8 * q), qf[ks], t0);
                t1 = mfma16(*(const LAS bf16x8*)(St + 4608 + (16 * te + c) * 72 + 32 * ks + 8 * q), qf[ks], t1); }
            o[te] = acc + sc0 * t0 + sc1 * t1; sum += (o[te][0] + o[te][1]) + (o[te][2] + o[te][3]); }
        sum = quad_rows_sum(sum);
        const float mu = sum * (1.0f / 64.0f); float vs = 0.f;
#pragma unroll
        for (int te = 0; te < 4; ++te) { o[te] = o[te] - mu; vs += (o[te][0] * o[te][0] + o[te][1] * o[te][1]) + (o[te][2] * o[te][2] + o[te][3] * o[te][3]); }
        vs = quad_rows_sum(vs);
        const float rs = 1.0f / sqrtf(vs * (1.0f / 64.0f) + EPS);
#pragma unroll
        for (int te = 0; te < 4; ++te) { const int e0 = hh * 64 + 16 * te + 4 * q;
            const u32x2 g2 = *(const u32x2*)(P + (size_t)(m0 + i) * NP + PC_RG + e0); const f32x4 gn = *(const f32x4*)(in.ret_gn_g + layer * 256 + e0);
            const float g0 = __uint_as_float(g2.x << 16), g1 = __uint_as_float(g2.x & 0xffff0000u), g2f = __uint_as_float(g2.y << 16), g3 = __uint_as_float(g2.y & 0xffff0000u);
            u32x2 wv; wv.x = cvtpk(o[te][0] * rs * gn[0] * siluf(g0), o[te][1] * rs * gn[1] * siluf(g1)); wv.y = cvtpk(o[te][2] * rs * gn[2] * siluf(g2f), o[te][3] * rs * gn[3] * siluf(g3));
            *(u32x2*)(O + (size_t)(m0 + i) * D + e0) = wv; }
        pp = dyn_bcast(dq, pp_next);
    }
}


__device__ __forceinline__ void phase_permute2(Frame& F, int route_lo) {
    const int* TKE = (const int*)(F.ws + WS_TKE); int* TOKROW = (int*)(F.ws + WS_TOKROW); int* TILEE = (int*)(F.ws + WS_TILEE);
    const int* WGCNT = (const int*)(F.ws + WS_TILEE + 4096);
    const bf16* H = (const bf16*)(F.ws + WS_H); bf16* HP = (bf16*)(F.ws + WS_HP);
    LAS int* base = (LAS int*)F.lds;
    LAS int* tot = base + 256 * 8;
    __syncthreads();
    {
        LAS int* scn = base + 256 * 8 + 64;
        int cnt8[8];
#pragma unroll
        for (int e = 0; e < 8; ++e) cnt8[e] = (F.tid < F.G) ? WGCNT[F.tid * 8 + e] : 0;
#pragma unroll
        for (int e = 0; e < 8; ++e) scn[F.tid * 8 + e] = cnt8[e];
        __syncthreads();
        int cur = 0;
        for (int off = 1; off < NTHR; off <<= 1) { int v[8];
#pragma unroll
            for (int e = 0; e < 8; ++e) v[e] = scn[cur * 4096 + F.tid * 8 + e] + (F.tid >= off ? scn[cur * 4096 + (F.tid - off) * 8 + e] : 0);
#pragma unroll
            for (int e = 0; e < 8; ++e) scn[(cur ^ 1) * 4096 + F.tid * 8 + e] = v[e];
            __syncthreads(); cur ^= 1; }
        if (F.tid < F.G) {
#pragma unroll
            for (int e = 0; e < 8; ++e) base[F.tid * 8 + e] = scn[cur * 4096 + F.tid * 8 + e] - cnt8[e]; }
        if (F.tid < 8) tot[F.tid] = scn[cur * 4096 + (F.G - 1) * 8 + F.tid];
    }
    __syncthreads();
    if (F.tid == 0) { int st = 0; for (int e = 0; e < 8; ++e) { tot[8 + e] = st; const int pad = (tot[e] + 255) / 256 * 256;
            if (F.bid == 0) for (int tl = st / 256; tl < (st + pad) / 256; ++tl) TILEE[tl] = e;
            st += pad; }
        if (F.bid == 0) TILEE[256] = st / 256; }
    __syncthreads();
    const int lane = F.lane;
    for (int m = route_lo + F.gw; m < M; m += F.NGW) {
        const int gwm = m < MC ? m : (int)((((long)(m - MC + 1)) * F.NGW - 1) / ML), wg = gwm >> 3;
        const int e0 = TKE[2 * m], e1 = TKE[2 * m + 1];
        const int r0 = tot[8 + e0] + base[wg * 8 + e0] + TOKROW[2 * m], r1 = tot[8 + e1] + base[wg * 8 + e1] + TOKROW[2 * m + 1];
        const u32x4 a = *(const u32x4*)(H + (size_t)m * D + 8 * lane), b = *(const u32x4*)(H + (size_t)m * D + 512 + 8 * lane);
        *(u32x4*)(HP + (size_t)r0 * D + 8 * lane) = a; *(u32x4*)(HP + (size_t)r0 * D + 512 + 8 * lane) = b;
        *(u32x4*)(HP + (size_t)r1 * D + 8 * lane) = a; *(u32x4*)(HP + (size_t)r1 * D + 512 + 8 * lane) = b;
        asm volatile("" ::: "memory");
        if (lane == 0) { TOKROW[2 * m] = r0; TOKROW[2 * m + 1] = r1; }
    }
    for (int e = 0; e < 8; ++e) { const int st = tot[8 + e] + tot[e], en = tot[8 + e] + (tot[e] + 255) / 256 * 256;
        for (int r = st + F.gw; r < en; r += F.NGW) { *(u32x4*)(HP + (size_t)r * D + 8 * lane) = (u32x4){0u, 0u, 0u, 0u}; *(u32x4*)(HP + (size_t)r * D + 512 + 8 * lane) = (u32x4){0u, 0u, 0u, 0u}; } }
}

constexpr int NPH = 12;
constexpr int PH_TOTAL = 1 + DEPTH * NPH + 1;
__host__ __device__ inline bool phase_exists(int ph) {
    if (ph == 0 || ph == PH_TOTAL - 1) return true;
    const int layer = (ph - 1) / NPH, j = (ph - 1) % NPH;
    if (!(layer & 1) && j >= 10) return false;
    if ((layer & 1) && j >= 11) return false;
    return true;
}
__global__ void __launch_bounds__(NTHR, 2) fwd_kernel(Args args) {
    extern __shared__ __attribute__((aligned(16))) unsigned char lds_raw[];
    Frame F;
    F.lds = (LAS unsigned char*)lds_raw;
    F.tid = threadIdx.x; F.lane = F.tid & 63; F.wave = __builtin_amdgcn_readfirstlane(F.tid >> 6);
    const int wave0 = F.wave;
    F.G = gridDim.x; F.bid = blockIdx.x; F.gw = blockIdx.x * NWAVES + F.wave; F.NGW = F.G * NWAVES; F.ws = args.ws;
    volatile LAS unsigned* MISC = (volatile LAS unsigned*)(F.lds + MISC_OFF);
    LAS unsigned long long* ptab = (LAS unsigned long long*)(F.lds + MISC_OFF + 128);
    if (F.tid < 32) MISC[F.tid] = 0u;
    if (PROBE_ON && F.tid == 65) { ((volatile LAS unsigned long long*)(F.lds + 132096))[0] = 0ull; ((volatile LAS unsigned long long*)(F.lds + 132096))[1] = 0ull; }
    if (F.tid == 64) { const Inputs& ai = args.in;
        ptab[0] = (unsigned long long)ai.x; ptab[1] = (unsigned long long)ai.c; ptab[2] = (unsigned long long)ai.ctx; ptab[3] = (unsigned long long)ai.c_ctx; ptab[4] = (unsigned long long)ai.ada_w; ptab[5] = (unsigned long long)ai.ada_b;
        ptab[6] = (unsigned long long)ai.norm1_g; ptab[7] = (unsigned long long)ai.w_in; ptab[8] = (unsigned long long)ai.ret_decay; ptab[9] = (unsigned long long)ai.ret_gn_g; ptab[10] = (unsigned long long)ai.gdn_conv_w; ptab[11] = (unsigned long long)ai.gdn_a_log;
        ptab[12] = (unsigned long long)ai.gdn_dt_bias; ptab[13] = (unsigned long long)ai.gdn_norm_g; ptab[14] = (unsigned long long)ai.swa_sink; ptab[15] = (unsigned long long)ai.w_out; ptab[16] = (unsigned long long)ai.norm2_g; ptab[17] = (unsigned long long)ai.ffn_w1;
        ptab[18] = (unsigned long long)ai.ffn_w3; ptab[19] = (unsigned long long)ai.ffn_w2; ptab[20] = (unsigned long long)ai.router_w; ptab[21] = (unsigned long long)ai.moe_w1; ptab[22] = (unsigned long long)ai.moe_w3; ptab[23] = (unsigned long long)ai.moe_w2; ptab[24] = (unsigned long long)ai.final_g; }
    __syncthreads();
    XcdBarrier bar; bar.bar = (unsigned*)(F.ws + WS_CTL) + CW_BAR; bar.x = 0; bar.st = nullptr; bar.w0 = F.wave;
    const int lo = args.ph_lo, hi = args.ph_hi;
    const bool multi = (hi - lo) > 1;
    if (multi) bar = xcd_barrier_post((unsigned*)(F.ws + WS_CTL) + CW_BAR, MISC + 8);
#define LAUNDER() GAS unsigned char* _w = (GAS unsigned char*)args.ws; asm volatile("" : "+s"(_w)); F.ws = (unsigned char*)_w; asm volatile("" ::: "memory"); { int _t = (wave0 << 6) | (int)__builtin_amdgcn_mbcnt_hi(~0u, __builtin_amdgcn_mbcnt_lo(~0u, 0u)); asm volatile("" : "+v"(_t)); int _b = blockIdx.x; asm volatile("" : "+s"(_b)); F.tid = _t; F.lane = _t & 63; F.wave = __builtin_amdgcn_readfirstlane(_t >> 6); F.bid = _b; F.gw = _b * NWAVES + F.wave; } const Inputs in = load_inputs(ptab)
#define RELAUNDER() do { GAS unsigned char* _w2 = (GAS unsigned char*)args.ws; asm volatile("" : "+s"(_w2)); F.ws = (unsigned char*)_w2; int _t = (wave0 << 6) | (int)__builtin_amdgcn_mbcnt_hi(~0u, __builtin_amdgcn_mbcnt_lo(~0u, 0u)); asm volatile("" : "+v"(_t)); int _b = blockIdx.x; asm volatile("" : "+s"(_b)); F.tid = _t; F.lane = _t & 63; F.wave = __builtin_amdgcn_readfirstlane(_t >> 6); F.bid = _b; F.gw = _b * NWAVES + F.wave; asm volatile("" ::: "memory"); } while (0)
#define IN(k) (lo <= (k) && (k) < hi)
#define STAMP(k) do { if (PROBE_ON && !(PROBE_CUSTOM) && blockIdx.x == 0 && xb_leader(F.wave)) { volatile LAS unsigned long long* _st = (volatile LAS unsigned long long*)(F.lds + 132096); const unsigned long long _now = __builtin_amdgcn_s_memrealtime(), _prev = _st[0]; _st[0] = _now; \
    const int _ph = (k) - 1; bool _sel = false; if (_ph == 0) _sel = (PROBE_PRO) != 0; else if (_ph > 0) { const int _l = (_ph - 1) / NPH, _j = (_ph - 1) % NPH; _sel = (((PROBE_LMASK) >> _l) & 1u) && (((PROBE_JMASK) >> _j) & 1u); } if (_sel) _st[1] = _st[1] + (_now - _prev); } } while (0)
#define SEAM(k) do { if (IN(k) && IN((k) + 1)) { xcd_barrier(bar); STAMP((k) + 1); } } while (0)
    LAS unsigned char* ring = F.lds;

    STAMP(0);
    if (IN(0)) { LAUNDER(); phase_prologue(F, in); } SEAM(0);

#define LAYER_BODY(layer) { \
        const int p0 = 1 + layer * NPH; \
        const bool moe = layer & 1; \
        if (IN(p0 + 0)) { LAUNDER(); phase_token2<0>(F, in, layer, layer == 0, layer > 0 && ((layer - 1) & 1), false, nullptr, 0, (layer > 0 && !((layer - 1) & 1)) ? 11 : 0); } \
        SEAM(p0 + 0); \
        if (IN(p0 + 1)) { LAUNDER(); pg8::StaticOrder S; S.init(F.ws + WS_H, (bf16*)(F.ws + WS_WIN) + (size_t)layer * NP * D, M, NP, D, F.G, F.bid); \
            pg8::EpiBf16 E{(bf16*)(F.ws + WS_R1 + R1_P), NP}; pg8::gemm_phase<D, D, pg8::EpiBf16, pg8::StaticOrder>(ring, S, E, F.tid); } \
        SEAM(p0 + 1); \
        if (IN(p0 + 2)) { LAUNDER(); phase_prep3(F, in, layer); } \
        SEAM(p0 + 2); \
        if (IN(p0 + 3)) { LAUNDER(); convert_moe_layer(F, in, (layer) >> 1, (layer) & 1, F.G); RELAUNDER(); PB(4); phase_gdn_local3(F, layer); PE(4); RELAUNDER(); PB(5); phase_ret_kv(F, in, layer); PE(5); } \
        SEAM(p0 + 3); \
        if (IN(p0 + 4)) { LAUNDER(); PB(1); phase_gdn_scan3(F, F.G - 32); PE(1); RELAUNDER(); PB(2); phase_ret_state(F, in, layer, F.G - 32); PE(2); if (F.bid < F.G - 32) rsync_publish(F, layer); RELAUNDER(); PB(3); phase_swa2(F, in, layer, F.G); PE(3); RELAUNDER(); rsync_wait(F, layer, (unsigned)(F.G - 32)); PB(6); phase_ret_out(F, in, layer); PE(6); } \
        SEAM(p0 + 4); \
        if (IN(p0 + 5)) { LAUNDER(); PB(7); phase_gdn_out2(F, in, layer); PE(7); } \
        SEAM(p0 + 5); \
        if (IN(p0 + 6)) { LAUNDER(); \
            { pg8::StaticOrder S; S.init(F.ws + WS_R1 + R1_O, (bf16*)(F.ws + WS_WOUT) + (size_t)layer * D * D, ML, D, D, F.G, F.bid, 4); \
              pg8::EpiResid E{(float*)(F.ws + WS_XS), (const float*)(F.ws + WS_MOD) + (size_t)layer * 5 * 6 * D, 2, (layer) == 0 ? in.x : nullptr}; pg8::gemm_phase<D, D, pg8::EpiResid, pg8::StaticOrder>(ring, S, E, F.tid); } \
            if (layer < DEPTH - 1) { RELAUNDER(); \
              pg8::SplitOrder S; S.init(F.ws + WS_R1 + R1_O, (bf16*)(F.ws + WS_WOUT) + (size_t)layer * D * D, D, 4, F.G, F.bid); \
              pg8::EpiSlab E{(float*)(F.ws + WS_R1 + 100 * MiB)}; pg8::gemm_phase<256, D, pg8::EpiSlab, pg8::SplitOrder>(ring, S, E, F.tid); } } \
        SEAM(p0 + 6); \
        if (IN(p0 + 7)) { LAUNDER(); phase_token2<1>(F, in, layer, false, false, moe, nullptr, layer == DEPTH - 1 ? MC : 0, layer < DEPTH - 1 ? 4 : 0); } \
        SEAM(p0 + 7); \
        if (!moe) { \
            if (IN(p0 + 8)) { LAUNDER(); pg8::StaticOrder S; S.init(F.ws + WS_H, (bf16*)(F.ws + WS_W13) + (size_t)(layer >> 1) * 2 * FF * D, M, 2 * FF, D, F.G, F.bid); \
                pg8::EpiSwiglu E{(bf16*)(F.ws + WS_R1 + R1_HID), FF}; pg8::gemm_phase<D, D, pg8::EpiSwiglu, pg8::StaticOrder>(ring, S, E, F.tid); } \
            SEAM(p0 + 8); \
            if (IN(p0 + 9)) { LAUNDER(); \
                { pg8::StaticOrder S; S.init(F.ws + WS_R1 + R1_HID, (bf16*)(F.ws + WS_W2) + (size_t)(layer >> 1) * D * FF, ML, D, FF, F.G, F.bid, 4); \
                  pg8::EpiResid E{(float*)(F.ws + WS_XS), (const float*)(F.ws + WS_MOD) + (size_t)layer * 5 * 6 * D, 5, nullptr}; pg8::gemm_phase<FF, FF, pg8::EpiResid, pg8::StaticOrder>(ring, S, E, F.tid); } \
                { RELAUNDER(); \
                  pg8::SplitOrder S; S.init(F.ws + WS_R1 + R1_HID, (bf16*)(F.ws + WS_W2) + (size_t)(layer >> 1) * D * FF, FF, 11, F.G, F.bid); \
                  pg8::EpiSlab E{(float*)(F.ws + WS_R1 + 100 * MiB)}; pg8::gemm_phase<256, FF, pg8::EpiSlab, pg8::SplitOrder>(ring, S, E, F.tid); } } \
            if (IN(p0 + 9) && IN(p0 + NPH)) { xcd_barrier(bar); STAMP(p0 + 10); } \
        } else { \
            if (IN(p0 + 8)) { LAUNDER(); phase_permute2(F, layer == DEPTH - 1 ? MC : 0); } \
            SEAM(p0 + 8); \
            if (IN(p0 + 9)) { LAUNDER(); const int* tile_e = (const int*)(F.ws + WS_TILEE); const int ntiles = __builtin_amdgcn_readfirstlane(tile_e[256]); \
                pg8::GroupedOrder S; S.init(F.ws + WS_HP, F.ws + WS_MW13, ntiles, 2 * EF, D, F.G, F.bid, tile_e); \
                pg8::EpiSwiglu E{(bf16*)(F.ws + WS_R1 + R1_HID), EF}; pg8::gemm_phase<D, D, pg8::EpiSwiglu, pg8::GroupedOrder>(ring, S, E, F.tid); } \
            SEAM(p0 + 9); \
            if (IN(p0 + 10)) { LAUNDER(); const int* tile_e = (const int*)(F.ws + WS_TILEE); const int ntiles = __builtin_amdgcn_readfirstlane(tile_e[256]); \
                const int tmain = (ntiles - (ntiles / 64) * 64 <= 16) ? (ntiles / 64) * 64 : ntiles; \
                { pg8::GroupedOrder S; S.init(F.ws + WS_R1 + R1_HID, F.ws + WS_MW2, tmain, D, EF, F.G, F.bid, tile_e); \
                  pg8::EpiBf16 E{(bf16*)(F.ws + WS_YM), D}; pg8::gemm_phase<EF, EF, pg8::EpiBf16, pg8::GroupedOrder>(ring, S, E, F.tid); } \
                if (ntiles > tmain) { RELAUNDER(); const int* tile_e2 = (const int*)(F.ws + WS_TILEE); \
                  pg8::SplitGroupedOrder S; S.init(F.ws + WS_R1 + R1_HID, F.ws + WS_MW2, tmain, ntiles - tmain, F.G, F.bid, tile_e2); \
                  pg8::EpiYMSlab E{(float*)(F.ws + WS_YM), (float*)(F.ws + WS_HP), tmain * 256}; pg8::gemm_phase<896, EF, pg8::EpiYMSlab, pg8::SplitGroupedOrder>(ring, S, E, F.tid); } } \
            if (IN(p0 + 10) && IN(p0 + NPH)) { xcd_barrier(bar); STAMP(p0 + 11); } \
        } \
    }
    LAYER_BODY(0) LAYER_BODY(1) LAYER_BODY(2) LAYER_BODY(3)
#undef LAYER_BODY
    if (IN(PH_TOTAL - 1)) { LAUNDER(); phase_token2<2>(F, in, DEPTH, false, true, false, args.out); }
    if (PROBE_ON && (int)blockIdx.x == ((PROBE_CUSTOM) ? (PROBE_BLOCK < 0 ? (int)gridDim.x + (PROBE_BLOCK) : (PROBE_BLOCK)) : 0) && xb_leader(F.wave)) {
        STAMP(PH_TOTAL);
        const unsigned long long T = ((volatile LAS unsigned long long*)(F.lds + 132096))[1];
        const unsigned long long t0 = __builtin_amdgcn_s_memrealtime();
        while (__builtin_amdgcn_s_memrealtime() - t0 < 8ull * T) __builtin_amdgcn_s_sleep(8);
    }
#undef IN
#undef SEAM
}

extern "C" void kernel_launch(void* const* d_in, const int* in_sizes, int n_in, void* d_out, int out_size, void* d_ws, size_t ws_size, hipStream_t stream) {
    static int grid = 0;
    if (grid == 0) {
        if (n_in != 25 || out_size != ML * D || ws_size < WS_END) { fprintf(stderr, "kernel_launch: unexpected problem: n_in %d out %d ws %zu (need %zu)\n", n_in, out_size, ws_size, (size_t)WS_END); grid = -1; return; }
        int dev = 0, cus = 0, per_cu = 0;
        if (hipGetDevice(&dev) != hipSuccess || hipDeviceGetAttribute(&cus, hipDeviceAttributeMultiprocessorCount, dev) != hipSuccess) { grid = -1; return; }
        if (hipFuncSetAttribute((const void*)fwd_kernel, hipFuncAttributeMaxDynamicSharedMemorySize, LDS_BYTES) != hipSuccess) { fprintf(stderr, "kernel_launch: hipFuncSetAttribute failed\n"); grid = -1; return; }
        if (hipOccupancyMaxActiveBlocksPerMultiprocessor(&per_cu, (const void*)fwd_kernel, NTHR, LDS_BYTES) != hipSuccess || per_cu < 1) fprintf(stderr, "kernel_launch: occupancy query reports %d\n", per_cu);
        (void)hipGetLastError();
        grid = cus;
    }
    if (grid < 0) return;
    (void)hipMemsetAsync((char*)d_ws + WS_CTL, 0, CTL_ZERO_BYTES, stream);
    Args a{};
    const float** ip = (const float**)&a.in;
    for (int i = 0; i < 25; ++i) ip[i] = (const float*)d_in[i];
    a.out = (float*)d_out; a.ws = (unsigned char*)d_ws;
#if MK_ONE_LAUNCH
    a.ph_lo = 0; a.ph_hi = PH_TOTAL;
    hipLaunchKernelGGL(fwd_kernel, dim3(grid), dim3(NTHR), LDS_BYTES, stream, a);
#else
    for (int ph = 0; ph < PH_TOTAL; ++ph) { if (!phase_exists(ph)) continue; a.ph_lo = ph; a.ph_hi = ph + 1;
        hipLaunchKernelGGL(fwd_kernel, dim3(grid), dim3(NTHR), LDS_BYTES, stream, a); }
#endif
}
```

```cpp
#include <hip/hip_runtime.h>
#include <cstdio>
#include <cstdint>

#ifndef PROBE_JMASK
#define PROBE_JMASK 0u
#endif
#ifndef PROBE_LMASK
#define PROBE_LMASK 15u
#endif
#ifndef PROBE_PRO
#define PROBE_PRO 0
#endif
#ifndef PROBE_CUSTOM
#define PROBE_CUSTOM 0
#endif
#ifndef PROBE_BLOCK
#define PROBE_BLOCK 0
#endif
#define PROBE_ON ((PROBE_JMASK) != 0u || (PROBE_PRO) != 0 || (PROBE_CUSTOM) != 0)
#define PB(id) do { if ((PROBE_CUSTOM) == (id) && (int)blockIdx.x == (PROBE_BLOCK < 0 ? (int)gridDim.x + (PROBE_BLOCK) : (PROBE_BLOCK)) && xb_leader(F.wave)) ((volatile LAS unsigned long long*)(F.lds + 132096))[2] = __builtin_amdgcn_s_memrealtime(); } while (0)
#define PE(id) do { if ((PROBE_CUSTOM) == (id) && (int)blockIdx.x == (PROBE_BLOCK < 0 ? (int)gridDim.x + (PROBE_BLOCK) : (PROBE_BLOCK)) && xb_leader(F.wave)) { volatile LAS unsigned long long* _s = (volatile LAS unsigned long long*)(F.lds + 132096); _s[1] = _s[1] + (__builtin_amdgcn_s_memrealtime() - _s[2]); } } while (0)
#define PG8_PB() do { if ((PROBE_CUSTOM) == 20 && (int)blockIdx.x == 0 && wid == 0 && lane == 0) ((volatile __attribute__((address_space(3))) unsigned long long*)(lds + 132096))[2] = __builtin_amdgcn_s_memrealtime(); } while (0)
#define PG8_PE() do { if ((PROBE_CUSTOM) == 20 && (int)blockIdx.x == 0 && wid == 0 && lane == 0) { volatile __attribute__((address_space(3))) unsigned long long* _s = (volatile __attribute__((address_space(3))) unsigned long long*)(lds + 132096); _s[1] = _s[1] + (__builtin_amdgcn_s_memrealtime() - _s[2]); } } while (0)
#ifndef MK_ONE_LAUNCH
#define MK_ONE_LAUNCH 1
#endif

#define GAS __attribute__((address_space(1)))
#define LAS __attribute__((address_space(3)))
typedef unsigned short bf16;
typedef short bf16x8 __attribute__((ext_vector_type(8)));
typedef float f32x4 __attribute__((ext_vector_type(4)));
typedef float f32x2 __attribute__((ext_vector_type(2)));
typedef unsigned u32x4 __attribute__((ext_vector_type(4)));
typedef unsigned u32x2 __attribute__((ext_vector_type(2)));

constexpr int D = 1024, NB = 4, TL = 4096, TC = 256, DEPTH = 4;
constexpr int MC = NB * TC, ML = NB * TL, M = MC + ML;
constexpr int INC = 2832, NP = 2816;
constexpr int FF = 2816, EF = 3584, NE = 8;
constexpr int MAXROWS = 36864;
constexpr float EPS = 1e-6f;
constexpr int PC_RQ = 0, PC_RK = 256, PC_RV = 512, PC_RG = 768, PC_GQKV = 1024, PC_GZ = 1792, PC_SQ = 2048, PC_SK = 2560, PC_SV = 2688;

constexpr size_t MiB = 1u << 20;
constexpr size_t WS_CTL = 0, CTL_ZERO_BYTES = 1 * MiB;
constexpr size_t WS_MOD = 1 * MiB;
constexpr size_t WS_ROPE = 2 * MiB;
constexpr size_t WS_TKE = 3 * MiB, WS_TKG = 3 * MiB + 256 * 1024, WS_TOKROW = 3 * MiB + 512 * 1024, WS_ROWTOK = 3 * MiB + 768 * 1024, WS_TILEE = 4 * MiB;
constexpr size_t WS_AB = 5 * MiB, WS_GB = 7 * MiB;
constexpr size_t WS_WIN = 16 * MiB, WS_WOUT = 38 * MiB, WS_W13 = 46 * MiB, WS_W2 = 68 * MiB, WS_MW13 = 80 * MiB, WS_MW2 = 192 * MiB;
constexpr size_t WS_XS = 248 * MiB, WS_H = 316 * MiB, WS_HP = 350 * MiB, WS_YM = 422 * MiB, WS_R1 = 566 * MiB;
constexpr size_t R1_P = 0, R1_PREP = 94 * MiB, R1_O = 158 * MiB, R1_OR = 192 * MiB, R1_OG = 226 * MiB, R1_HID = 0;
constexpr size_t WS_END = WS_R1 + 260 * MiB;
constexpr size_t WS_GCH = WS_YM, GCH_STEP = 40960, GCH_CHAIN = 68 * GCH_STEP, WS_GDEC = WS_HP;
constexpr size_t G2_STEP = 24576, G2_CHAIN = 68 * G2_STEP;
constexpr size_t WS_GST = WS_YM + 56 * MiB;
constexpr size_t WS_GCS = WS_HP + 64 * 1024;
static_assert(32 * G2_CHAIN <= 56 * MiB && 32 * 68 * 16384 <= 40 * MiB, "gdn v2 buffers");
constexpr size_t WS_RKV = WS_YM + 96 * MiB;
constexpr size_t WS_RST = WS_HP + 1 * MiB;
static_assert(32 * GCH_CHAIN <= 144 * MiB, "gdn chunk data");
constexpr size_t PREP_RQ = 0, PREP_RK = (size_t)M * 256 * 2, PREP_SQ = (size_t)M * 512 * 2, PREP_SK = (size_t)M * 1024 * 2, PREP_GD = (size_t)M * 1152 * 2;
static_assert(PREP_GD + (size_t)M * 768 * 2 <= 64 * MiB, "prep");
static_assert((size_t)M * NP * 2 <= 94 * MiB && (size_t)MAXROWS * EF * 2 <= 260 * MiB, "r1");

constexpr int CW_TMO = 0, CW_BAR = 4096;

__device__ __forceinline__ float bf2f(bf16 v) { return __uint_as_float(((unsigned)v) << 16); }
__device__ __forceinline__ unsigned f2bf(float f) { unsigned u = __float_as_uint(f); return (u + 0x7fffu + ((u >> 16) & 1u)) >> 16; }
__device__ __forceinline__ unsigned pk2(float lo, float hi) { return f2bf(lo) | (f2bf(hi) << 16); }
template <int CTRL> __device__ __forceinline__ float dppf(float v) { return __int_as_float(__builtin_amdgcn_update_dpp(0, __float_as_int(v), CTRL, 0xF, 0xF, true)); }
__device__ __forceinline__ float row_sum16(float v) {
    v += dppf<0xB1>(v); v += dppf<0x4E>(v); v += dppf<0x141>(v); v += dppf<0x140>(v); return v; }
__device__ __forceinline__ float wave_sum(float v) {
    v = row_sum16(v);
    return __int_as_float(__builtin_amdgcn_readlane(__float_as_int(v), 0)) + __int_as_float(__builtin_amdgcn_readlane(__float_as_int(v), 16))
         + __int_as_float(__builtin_amdgcn_readlane(__float_as_int(v), 32)) + __int_as_float(__builtin_amdgcn_readlane(__float_as_int(v), 48)); }
__device__ __forceinline__ float quad_rows_sum(float v) {
    u32x2 r = __builtin_amdgcn_permlane16_swap(__float_as_uint(v), __float_as_uint(v), false, false); v = __uint_as_float(r.x) + __uint_as_float(r.y);
    r = __builtin_amdgcn_permlane32_swap(__float_as_uint(v), __float_as_uint(v), false, false); return __uint_as_float(r.x) + __uint_as_float(r.y); }
__device__ __forceinline__ float quad_rows_max(float v) {
    u32x2 r = __builtin_amdgcn_permlane16_swap(__float_as_uint(v), __float_as_uint(v), false, false); v = fmaxf(__uint_as_float(r.x), __uint_as_float(r.y));
    r = __builtin_amdgcn_permlane32_swap(__float_as_uint(v), __float_as_uint(v), false, false); return fmaxf(__uint_as_float(r.x), __uint_as_float(r.y)); }
__device__ __forceinline__ float fexp2(float x) { return __builtin_amdgcn_exp2f(x); }
__device__ __forceinline__ float fexp(float x) { return __builtin_amdgcn_exp2f(x * 1.4426950408889634f); }
__device__ __forceinline__ float siluf(float x) { return x * __builtin_amdgcn_rcpf(1.0f + fexp(-x)); }
#define LDS_WAIT() asm volatile("s_waitcnt lgkmcnt(0)" ::: "memory")
__device__ __forceinline__ f32x4 mfma16(bf16x8 a, bf16x8 b, f32x4 c) { return __builtin_amdgcn_mfma_f32_16x16x32_bf16(a, b, c, 0, 0, 0); }
__device__ __forceinline__ unsigned cvtpk(float lo, float hi) { unsigned r; asm volatile("v_cvt_pk_bf16_f32 %0, %1, %2" : "=v"(r) : "v"(lo), "v"(hi)); return r; }


namespace pg8 {
#define PG8_LAS __attribute__((address_space(3)))
constexpr int BM = 256, BK = 64, HALF = 128, HTB = HALF * BK * 2, STAGE_BYTES = 8 * HTB;
__host__ __device__ __forceinline__ int lds_byte(int r, int c) { const int st = (r >> 4) * 2 + (c >> 5), rr = r & 15, cc = c & 31, ob = rr * 64 + cc * 2; return st * 1024 + (ob ^ (((ob >> 9) & 1) << 5)); }
__host__ __device__ __forceinline__ void stage_rc(int b, int& R, int& C) { const int st = b / 1024, sb = b % 1024, swz = sb ^ (((sb >> 9) & 1) << 5); R = (st >> 1) * 16 + swz / 64; C = (st & 1) * 32 + (swz % 64) / 2; }
__host__ __device__ __forceinline__ int perm32(int rho) { const int n = rho >> 4, i = rho & 15; return 8 * (i >> 2) + 4 * n + (i & 3); }
struct Unit { int pm, pn, aux; const char* A; const char* B; };
__device__ __forceinline__ unsigned cvt_pk_bf16(float lo, float hi) { unsigned r; asm volatile("v_cvt_pk_bf16_f32 %0, %1, %2" : "=v"(r) : "v"(lo), "v"(hi)); return r; }

template <int K, int LD, class Epi, class Sched, bool ALIGN_EPI = true, bool SP2 = true>
__device__ __forceinline__ void gemm_phase(PG8_LAS unsigned char* lds, const Sched& S, const Epi& E, const int tid) {
    const int wid = __builtin_amdgcn_readfirstlane(tid >> 6), lane = tid & 63, wr = wid >> 2, wc = wid & 3, fr = lane & 15, fq = lane >> 4;
    constexpr int nt = K / BK;
    unsigned voffA[2], voffB[2];
#pragma unroll
    for (int i = 0; i < 2; ++i) { int R, C; stage_rc(tid * 16 + i * 8192, R, C); const int Rb = Epi::PERM ? ((R & ~31) + perm32(R & 31)) : R;
        voffA[i] = (unsigned)(R * LD + C) * 2u; voffB[i] = (unsigned)(Rb * LD + C) * 2u; }
    constexpr size_t kstep = (size_t)(BK * 2);
    constexpr size_t hstep = (size_t)HALF * LD * 2;
    const unsigned ldsw = (unsigned)wid * 1024u;
    const int aoff = lds_byte(wr * 64 + fr, fq * 8), boff = lds_byte(wc * 32 + fr, fq * 8);
#define PG8_SA(b, h) (((b) * 2 + (h)) * HTB)
#define PG8_SB(b, h) ((4 + (b) * 2 + (h)) * HTB)
#define PG8_STAGE(bufoff, gbase, voff) do { _Pragma("unroll") for (int _i = 0; _i < 2; ++_i) \
        __builtin_amdgcn_global_load_lds((const unsigned*)((const char*)(gbase) + (voff)[_i]), (PG8_LAS unsigned*)(lds + (bufoff) + ldsw + _i * 8192), 16, 0, 0); } while (0)
#define PG8_LDA(dst, b, h) do { _Pragma("unroll") for (int m = 0; m < 4; ++m) _Pragma("unroll") for (int k = 0; k < 2; ++k) dst[m][k] = *(const PG8_LAS bf16x8*)(lds + PG8_SA(b, h) + aoff + m * 2048 + k * 1024); } while (0)
#define PG8_LDB(dst, b, h) do { _Pragma("unroll") for (int n = 0; n < 2; ++n) _Pragma("unroll") for (int k = 0; k < 2; ++k) dst[n][k] = *(const PG8_LAS bf16x8*)(lds + PG8_SB(b, h) + boff + n * 2048 + k * 1024); } while (0)
#define PG8_MMA(ai, bj, At, Bt) do { __builtin_amdgcn_s_setprio(1); _Pragma("unroll") for (int m = 0; m < 4; ++m) _Pragma("unroll") for (int n = 0; n < 2; ++n) _Pragma("unroll") for (int k = 0; k < 2; ++k) \
        acc[ai][bj][m][n] = __builtin_amdgcn_mfma_f32_16x16x32_bf16(Bt[n][k], At[m][k], acc[ai][bj][m][n], 0, 0, 0); __builtin_amdgcn_s_setprio(0); } while (0)
#define PG8_WAIT_V(n) asm volatile("s_waitcnt vmcnt(" #n ")" ::: "memory")
#define PG8_WAIT_L(n) asm volatile("s_waitcnt lgkmcnt(" #n ")" ::: "memory")
#define PG8_BAR __builtin_amdgcn_s_barrier()
#define PG8_SCHED __builtin_amdgcn_sched_barrier(0)
    Unit cur, nxt; int ui = 0;
    if (!S.next(0, cur)) return;
    f32x4 acc[2][2][4][2];
#pragma unroll
    for (int a = 0; a < 2; ++a)
#pragma unroll
        for (int b = 0; b < 2; ++b)
#pragma unroll
            for (int m = 0; m < 4; ++m)
#pragma unroll
                for (int n = 0; n < 2; ++n) acc[a][b][m][n] = (f32x4){0.f, 0.f, 0.f, 0.f};
    bf16x8 At[4][2], B0[2][2], B1[2][2];
    const char* cA = cur.A; const char* cB = cur.B;
    if constexpr (SP2) {
        PG8_STAGE(PG8_SB(0, 0), cB, voffB); PG8_STAGE(PG8_SB(0, 1), cB + hstep, voffB); PG8_STAGE(PG8_SA(0, 0), cA, voffA); PG8_STAGE(PG8_SA(0, 1), cA + hstep, voffA);
        if (wr == 1) PG8_BAR;
        PG8_WAIT_V(2); PG8_BAR;
        PG8_STAGE(PG8_SB(1, 0), cB + kstep, voffB); PG8_STAGE(PG8_SA(1, 0), cA + kstep, voffA); PG8_STAGE(PG8_SB(1, 1), cB + hstep + kstep, voffB);
        PG8_WAIT_V(6); PG8_BAR;
    } else {
        PG8_STAGE(PG8_SB(0, 0), cB, voffB); PG8_STAGE(PG8_SA(0, 0), cA, voffA); PG8_STAGE(PG8_SB(0, 1), cB + hstep, voffB); PG8_STAGE(PG8_SA(0, 1), cA + hstep, voffA);
        if (wr == 1) PG8_BAR;
        PG8_WAIT_V(4); PG8_BAR;
        PG8_STAGE(PG8_SB(1, 0), cB + kstep, voffB); PG8_STAGE(PG8_SA(1, 0), cA + kstep, voffA); PG8_STAGE(PG8_SB(1, 1), cB + hstep + kstep, voffB);
        PG8_WAIT_V(6); PG8_BAR;
    }
    for (;;) {
        const bool has_next = S.next(ui + 1, nxt);
        const char* nA = has_next ? nxt.A : cA; const char* nB = has_next ? nxt.B : cB;
        for (int t = 0; t < nt; t += 2) {
            const bool last = (t == nt - 2);
            const char* a1 = cA + (size_t)(t + 1) * kstep;
            const char* a2 = last ? nA : cA + (size_t)(t + 2) * kstep; const char* b2 = last ? nB : cB + (size_t)(t + 2) * kstep;
            const char* a3 = a2 + kstep; const char* b3 = b2 + kstep;
            if constexpr (SP2) {
            PG8_LDB(B0, 0, 0); PG8_LDB(B1, 0, 1); PG8_SCHED; PG8_LDA(At, 0, 0); PG8_STAGE(PG8_SA(1, 1), a1 + hstep, voffA);
            PG8_WAIT_V(8); PG8_WAIT_L(0); PG8_BAR; PG8_MMA(0, 0, At, B0); PG8_MMA(0, 1, At, B1); PG8_BAR; PG8_SCHED;
            PG8_LDA(At, 0, 1); PG8_STAGE(PG8_SB(0, 0), b2, voffB); PG8_STAGE(PG8_SB(0, 1), b2 + hstep, voffB); PG8_STAGE(PG8_SA(0, 0), a2, voffA);
            PG8_WAIT_V(8); PG8_WAIT_L(0); PG8_BAR; PG8_MMA(1, 0, At, B0); PG8_MMA(1, 1, At, B1); PG8_BAR; PG8_SCHED;
            PG8_LDB(B0, 1, 0); PG8_LDB(B1, 1, 1); PG8_SCHED; PG8_LDA(At, 1, 0); PG8_STAGE(PG8_SA(0, 1), a2 + hstep, voffA);
            PG8_WAIT_V(8); PG8_WAIT_L(0); PG8_BAR; PG8_MMA(0, 0, At, B0); PG8_MMA(0, 1, At, B1); PG8_BAR; PG8_SCHED;
            PG8_LDA(At, 1, 1); PG8_STAGE(PG8_SB(1, 0), b3, voffB); PG8_STAGE(PG8_SB(1, 1), b3 + hstep, voffB); PG8_STAGE(PG8_SA(1, 0), a3, voffA);
            PG8_WAIT_V(8); PG8_WAIT_L(0); PG8_BAR; PG8_MMA(1, 0, At, B0); PG8_MMA(1, 1, At, B1); PG8_BAR; PG8_SCHED;
            } else {
            PG8_LDB(B0, 0, 0); PG8_SCHED; PG8_LDA(At, 0, 0); PG8_STAGE(PG8_SA(1, 1), a1 + hstep, voffA);
            PG8_WAIT_L(8); PG8_BAR; PG8_WAIT_L(0); PG8_MMA(0, 0, At, B0); PG8_BAR; PG8_SCHED;
            PG8_LDB(B1, 0, 1); PG8_STAGE(PG8_SB(0, 0), b2, voffB);
            PG8_BAR; PG8_WAIT_L(0); PG8_MMA(0, 1, At, B1); PG8_BAR;
            PG8_LDA(At, 0, 1); PG8_STAGE(PG8_SA(0, 0), a2, voffA);
            PG8_BAR; PG8_WAIT_L(0); PG8_MMA(1, 0, At, B0); PG8_BAR; PG8_SCHED;
            PG8_STAGE(PG8_SB(0, 1), b2 + hstep, voffB);
            PG8_WAIT_V(6); PG8_BAR; PG8_MMA(1, 1, At, B1); PG8_BAR;
            PG8_LDB(B0, 1, 0); PG8_SCHED; PG8_LDA(At, 1, 0); PG8_STAGE(PG8_SA(0, 1), a2 + hstep, voffA);
            PG8_WAIT_L(8); PG8_BAR; PG8_WAIT_L(0); PG8_MMA(0, 0, At, B0); PG8_BAR; PG8_SCHED;
            PG8_LDB(B1, 1, 1); PG8_STAGE(PG8_SB(1, 0), b3, voffB);
            PG8_BAR; PG8_WAIT_L(0); PG8_MMA(0, 1, At, B1); PG8_BAR;
            PG8_LDA(At, 1, 1); PG8_STAGE(PG8_SA(1, 0), a3, voffA);
            PG8_BAR; PG8_WAIT_L(0); PG8_MMA(1, 0, At, B0); PG8_BAR; PG8_SCHED;
            PG8_STAGE(PG8_SB(1, 1), b3 + hstep, voffB);
            PG8_WAIT_V(6); PG8_BAR; PG8_MMA(1, 1, At, B1); PG8_BAR;
            }
        }
        if constexpr (ALIGN_EPI) { if (wr == 0) PG8_BAR; }
        PG8_PB();
        E(acc, cur, wr, wc, fr, fq);
        PG8_PE();
        if (!has_next) break;
#pragma unroll
        for (int a = 0; a < 2; ++a)
#pragma unroll
            for (int b = 0; b < 2; ++b)
#pragma unroll
                for (int m = 0; m < 4; ++m)
#pragma unroll
                    for (int n = 0; n < 2; ++n) acc[a][b][m][n] = (f32x4){0.f, 0.f, 0.f, 0.f};
        cur = nxt; cA = nA; cB = nB; ++ui;
        if constexpr (ALIGN_EPI) { if (wr == 1) PG8_BAR; }
    }
    PG8_WAIT_V(0);
    if constexpr (!ALIGN_EPI) { if (wr == 0) PG8_BAR; }
    PG8_BAR;
#undef PG8_SA
#undef PG8_SB
#undef PG8_STAGE
#undef PG8_LDA
#undef PG8_LDB
#undef PG8_MMA
#undef PG8_WAIT_V
#undef PG8_WAIT_L
#undef PG8_BAR
#undef PG8_SCHED
}

struct StaticOrder {
    int nM, nN, nwg, G, c, pm_off; const char* A; const char* Bt; size_t tstep;
    __device__ void init(const void* A_, const void* Bt_, int M_, int N_, int K_, int G_, int c_, int pm_off_ = 0) { A = (const char*)A_; Bt = (const char*)Bt_; nM = M_ / BM; nN = N_ / BM; nwg = nM * nN; G = G_; c = c_; pm_off = pm_off_; tstep = (size_t)BM * K_ * 2; }
    __device__ bool next(int i, Unit& u) const {
        const long L = (long)i * G + c; if (L >= nwg) return false;
        int wgid = (int)L; { const int q = nwg / 8, r = nwg % 8, xcd = wgid % 8, off = wgid / 8; wgid = (xcd < r ? xcd * (q + 1) : r * (q + 1) + (xcd - r) * q) + off; }
        const int nig = 8 * nN, gid = wgid / nig, fm = gid * 8, gsz = (nM - fm) < 8 ? (nM - fm) : 8;
        u.pm = fm + ((wgid % nig) % gsz) + pm_off; u.pn = (wgid % nig) / gsz; u.aux = 0;
        u.A = A + (size_t)u.pm * tstep; u.B = Bt + (size_t)u.pn * tstep; return true;
    }
};
struct SplitOrder {
    int nks, nsub, G, c; const char* A; const char* Bt; size_t tstep;
    __device__ void init(const void* A_, const void* Bt_, int LD_, int nks_, int G_, int c_) { A = (const char*)A_; Bt = (const char*)Bt_; nks = nks_; nsub = 16 * nks_; G = G_; c = c_; tstep = (size_t)BM * LD_ * 2; }
    __device__ bool next(int i, Unit& u) const {
        const int L = i * G + c; if (L >= nsub) return false;
        const int ksl = L % nks, t = L / nks; u.pm = t >> 2; u.pn = t & 3; u.aux = ksl;
        u.A = A + (size_t)u.pm * tstep + (size_t)ksl * 512; u.B = Bt + (size_t)u.pn * tstep + (size_t)ksl * 512; return true;
    }
};
struct GroupedOrder {
    int nM, nN, nwg, G, c; const char* A; const char* Bt; size_t tstep, estep; const int* tile_e;
    __device__ void init(const void* A_, const void* Bt_, int ntiles, int N_, int K_, int G_, int c_, const int* te) { A = (const char*)A_; Bt = (const char*)Bt_; nM = ntiles; nN = N_ / BM; nwg = nM * nN; G = G_; c = c_; tstep = (size_t)BM * K_ * 2; estep = (size_t)N_ * K_ * 2; tile_e = te; }
    __device__ bool next(int i, Unit& u) const {
        const long L = (long)i * G + c; if (L >= nwg) return false;
        int wgid = (int)L; { const int q = nwg / 8, r = nwg % 8, xcd = wgid % 8, off = wgid / 8; wgid = (xcd < r ? xcd * (q + 1) : r * (q + 1) + (xcd - r) * q) + off; }
        const int nig = 8 * nN, gid = wgid / nig, fm = gid * 8, gsz = (nM - fm) < 8 ? (nM - fm) : 8;
        u.pm = fm + ((wgid % nig) % gsz); u.pn = (wgid % nig) / gsz; u.aux = __builtin_amdgcn_readfirstlane(tile_e[u.pm]);
        u.A = A + (size_t)u.pm * tstep; u.B = Bt + (size_t)u.aux * estep + (size_t)u.pn * tstep; return true;
    }
};

struct SplitGroupedOrder {
    int t0, nsub, G, c; const char* A; const char* Bt; size_t tstep, estep; const int* tile_e;
    __device__ void init(const void* A_, const void* Bt_, int t0_, int nt_, int G_, int c_, const int* te) { A = (const char*)A_; Bt = (const char*)Bt_; t0 = t0_; nsub = nt_ * 16; G = G_; c = c_; tstep = (size_t)BM * EF * 2; estep = (size_t)D * EF * 2; tile_e = te; }
    __device__ bool next(int i, Unit& u) const {
        const int L = i * G + c; if (L >= nsub) return false;
        const int ksl = L & 3, t = L >> 2; u.pm = t0 + (t >> 2); u.pn = t & 3; u.aux = ksl;
        const int e = __builtin_amdgcn_readfirstlane(tile_e[u.pm]);
        u.A = A + (size_t)u.pm * tstep + (size_t)ksl * 896 * 2; u.B = Bt + (size_t)e * estep + (size_t)u.pn * tstep + (size_t)ksl * 896 * 2; return true;
    }
};
struct EpiBf16 {
    static constexpr bool PERM = true;
    bf16* O; int ldc;
    __device__ __forceinline__ void operator()(const f32x4 (&acc)[2][2][4][2], const Unit& u, int wr, int wc, int fr, int fq) const {
        const int row0 = u.pm * BM + wr * 64 + fr, col0 = u.pn * BM + wc * 32 + 8 * fq;
#pragma unroll
        for (int ai = 0; ai < 2; ++ai)
#pragma unroll
            for (int m = 0; m < 4; ++m) { bf16* rowp = O + (size_t)(row0 + ai * HALF + m * 16) * ldc + col0;
#pragma unroll
                for (int bj = 0; bj < 2; ++bj) { const f32x4 v0 = acc[ai][bj][m][0], v1 = acc[ai][bj][m][1];
                    u32x4 w; w.x = cvt_pk_bf16(v0[0], v0[1]); w.y = cvt_pk_bf16(v0[2], v0[3]); w.z = cvt_pk_bf16(v1[0], v1[1]); w.w = cvt_pk_bf16(v1[2], v1[3]);
                    *(u32x4*)(rowp + bj * HALF) = w; } }
    }
};
struct EpiResid {
    static constexpr bool PERM = false;
    float* X; const float* mod; int gsel; const float* Xsrc;
    __device__ __forceinline__ void operator()(const f32x4 (&acc)[2][2][4][2], const Unit& u, int wr, int wc, int fr, int fq) const {
        const int row0 = u.pm * BM + wr * 64 + fr, col0 = u.pn * BM + wc * 32 + 4 * fq;
        const int r = u.pm < 4 ? 4 : ((u.pm - 4) >> 4);
        const float* g = mod + (size_t)r * 6 * D + gsel * D;
        f32x4 gv[2][2];
#pragma unroll
        for (int bj = 0; bj < 2; ++bj)
#pragma unroll
            for (int n = 0; n < 2; ++n) gv[bj][n] = *(const f32x4*)(g + col0 + bj * HALF + n * 16);
#pragma unroll
        for (int ai = 0; ai < 2; ++ai)
#pragma unroll
            for (int m = 0; m < 4; ++m) { float* rowp = X + (size_t)(row0 + ai * HALF + m * 16) * D + col0; const float* srcp = Xsrc ? Xsrc + (size_t)(row0 + ai * HALF + m * 16 - MC) * D + col0 : rowp;
#pragma unroll
                for (int bj = 0; bj < 2; ++bj)
#pragma unroll
                    for (int n = 0; n < 2; ++n) { f32x4 x = *(const f32x4*)(srcp + bj * HALF + n * 16); x += gv[bj][n] * acc[ai][bj][m][n]; *(f32x4*)(rowp + bj * HALF + n * 16) = x; } }
    }
};
struct EpiSwiglu {
    static constexpr bool PERM = false;
    bf16* Hd; int ldh;
    __device__ __forceinline__ void operator()(const f32x4 (&acc)[2][2][4][2], const Unit& u, int wr, int wc, int fr, int fq) const {
        const int row0 = u.pm * BM + wr * 64 + fr, col0 = u.pn * 128 + wc * 16 + 4 * fq;
#pragma unroll
        for (int ai = 0; ai < 2; ++ai)
#pragma unroll
            for (int m = 0; m < 4; ++m) { bf16* rowp = Hd + (size_t)(row0 + ai * HALF + m * 16) * ldh + col0;
#pragma unroll
                for (int bj = 0; bj < 2; ++bj) { const f32x4 a = acc[ai][bj][m][0], b = acc[ai][bj][m][1];
                    float h[4];
#pragma unroll
                    for (int j = 0; j < 4; ++j) h[j] = a[j] * __builtin_amdgcn_rcpf(1.0f + __builtin_amdgcn_exp2f(-1.4426950408889634f * a[j])) * b[j];
                    u32x2 w; w.x = cvt_pk_bf16(h[0], h[1]); w.y = cvt_pk_bf16(h[2], h[3]);
                    *(u32x2*)(rowp + bj * 64) = w; } }
    }
};
struct EpiF32 {
    static constexpr bool PERM = false;
    float* C; int ldc;
    __device__ __forceinline__ void operator()(const f32x4 (&acc)[2][2][4][2], const Unit& u, int wr, int wc, int fr, int fq) const {
        const int row0 = u.pm * BM + wr * 64 + fr, col0 = u.pn * BM + wc * 32 + 4 * fq;
#pragma unroll
        for (int ai = 0; ai < 2; ++ai)
#pragma unroll
            for (int m = 0; m < 4; ++m) { float* rowp = C + (size_t)(row0 + ai * HALF + m * 16) * ldc + col0;
#pragma unroll
                for (int bj = 0; bj < 2; ++bj)
#pragma unroll
                    for (int n = 0; n < 2; ++n) *(f32x4*)(rowp + bj * HALF + n * 16) = acc[ai][bj][m][n]; }
    }
};
struct EpiSlab {
    static constexpr bool PERM = false;
    float* C;
    __device__ __forceinline__ void operator()(const f32x4 (&acc)[2][2][4][2], const Unit& u, int wr, int wc, int fr, int fq) const {
        const int row0 = u.pm * BM + wr * 64 + fr, col0 = u.pn * BM + wc * 32 + 4 * fq;
        float* base = C + (size_t)u.aux * MC * D;
#pragma unroll
        for (int ai = 0; ai < 2; ++ai)
#pragma unroll
            for (int m = 0; m < 4; ++m) { float* rowp = base + (size_t)(row0 + ai * HALF + m * 16) * D + col0;
#pragma unroll
                for (int bj = 0; bj < 2; ++bj)
#pragma unroll
                    for (int n = 0; n < 2; ++n) *(f32x4*)(rowp + bj * HALF + n * 16) = acc[ai][bj][m][n]; }
    }
};
struct EpiYMSlab {
    static constexpr bool PERM = false;
    float* YMp; float* slab; int row0s;
    __device__ __forceinline__ void operator()(const f32x4 (&acc)[2][2][4][2], const Unit& u, int wr, int wc, int fr, int fq) const {
        const int row0 = u.pm * BM + wr * 64 + fr, col0 = u.pn * BM + wc * 32 + 4 * fq;
        float* base = slab + ((size_t)u.aux * 4096 + (row0 - row0s)) * D;
#pragma unroll
        for (int ai = 0; ai < 2; ++ai)
#pragma unroll
            for (int m = 0; m < 4; ++m) { float* rowp = base + (size_t)(ai * HALF + m * 16) * D + col0;
#pragma unroll
                for (int bj = 0; bj < 2; ++bj)
#pragma unroll
                    for (int n = 0; n < 2; ++n) *(f32x4*)(rowp + bj * HALF + n * 16) = acc[ai][bj][m][n]; }
    }
};
}

#define XB_TMO      128
#define XB_XCNT(j)  (256  + 64 * (j))
#define XB_XSUB(j)  (1280 + 64 * (j))
#define XB_XGEN(j)  (2304 + 64 * (j))
#define XB_TOP      3328
#define XB_TOPGEN   3392
#define XCD_BAR_WORDS 3456
#define XB_SPIN_CAP (1u << 22)
__device__ __forceinline__ unsigned xb_ld(unsigned* p)              { return __hip_atomic_load(p, __ATOMIC_RELAXED, __HIP_MEMORY_SCOPE_AGENT); }
__device__ __forceinline__ unsigned xb_add(unsigned* p, unsigned v) { return __hip_atomic_fetch_add(p, v, __ATOMIC_RELAXED, __HIP_MEMORY_SCOPE_AGENT); }
__device__ __forceinline__ unsigned xb_xcc_id() { return (unsigned)__builtin_amdgcn_s_getreg((3 << 11) | 20) & 0xFu; }
#define XB_SPIN(cond, bar) do { unsigned _sp = 0; while (cond) { __builtin_amdgcn_s_sleep(1); \
    if ((++_sp & 255u) == 0u) { if (xb_ld(&(bar)[XB_TMO])) break; if (_sp > XB_SPIN_CAP) { atomicAdd(&(bar)[XB_TMO], 1u); break; } } } } while (0)
struct XcdBarrier { unsigned* bar; unsigned x; volatile LAS unsigned* st; int w0; };
__device__ __forceinline__ bool xb_leader(int w0) { return w0 == 0 && __builtin_amdgcn_mbcnt_hi(~0u, __builtin_amdgcn_mbcnt_lo(~0u, 0u)) == 0u; }
__device__ __forceinline__ XcdBarrier xcd_barrier_post(unsigned* bar, volatile LAS unsigned* st) {
    XcdBarrier b; b.bar = bar; b.x = xb_xcc_id(); b.st = st; b.w0 = __builtin_amdgcn_readfirstlane(threadIdx.x >> 6);
    if (xb_leader(b.w0)) (void)xb_add(&bar[XB_XCNT(b.x)], 1u);
    return b;
}
__device__ __forceinline__ void xcd_barrier_complete(unsigned* bar, unsigned x, unsigned& nloc, unsigned& nx) {
    const unsigned G = gridDim.x * gridDim.y * gridDim.z;
    unsigned sum, cnt, mine, sp = 0u;
    for (;;) {
        sum = 0u; cnt = 0u; mine = 0u;
#pragma unroll
        for (unsigned j = 0; j < 16; ++j) { const unsigned c = xb_ld(&bar[XB_XCNT(j)]); sum += c; cnt += (c > 0u) ? 1u : 0u; mine = (j == x) ? c : mine; }
        if (sum == G) break;
        __builtin_amdgcn_s_sleep(1);
        if ((++sp & 255u) == 0u) { if (xb_ld(&bar[XB_TMO])) break; if (sp > XB_SPIN_CAP) { atomicAdd(&bar[XB_TMO], 1u); break; } }
    }
    nloc = mine > 0u ? mine : 1u; nx = cnt > 0u ? cnt : 1u;
}
__device__ __forceinline__ void xcd_barrier(const XcdBarrier& b) {
    asm volatile("s_waitcnt vmcnt(0)" ::: "memory");
    __syncthreads();
    if (xb_leader(b.w0)) {
        unsigned* bar = b.bar; unsigned bx = b.x;
        asm volatile("" : "+s"(bar), "+s"(bx));
        __builtin_amdgcn_s_waitcnt(0);
        unsigned nloc = b.st[0], nx = b.st[1];
        if (nloc == 0u) { xcd_barrier_complete(bar, bx, nloc, nx); b.st[0] = nloc; b.st[1] = nx; }
        const unsigned old = xb_add(&bar[XB_XSUB(bx)], 1u);
        const unsigned gen = old / nloc;
        if (old + 1u == (gen + 1u) * nloc) {
            __builtin_amdgcn_fence(__ATOMIC_RELEASE, "agent");
            asm volatile("s_waitcnt vmcnt(0)" ::: "memory");
            const unsigned og = xb_add(&bar[XB_TOP], 1u);
            const unsigned tg = og / nx;
            if (og + 1u == (tg + 1u) * nx) xb_add(&bar[XB_TOPGEN], 1u);
            else XB_SPIN(xb_ld(&bar[XB_TOPGEN]) == tg, bar);
            __builtin_amdgcn_fence(__ATOMIC_ACQUIRE, "agent");
            xb_add(&bar[XB_XGEN(bx)], 1u);
            asm volatile("s_waitcnt vmcnt(0)" ::: "memory");
        } else {
            XB_SPIN(xb_ld(&bar[XB_XGEN(bx)]) == gen, bar);
            __builtin_amdgcn_fence(__ATOMIC_ACQUIRE, "agent");
            asm volatile("s_waitcnt vmcnt(0)" ::: "memory");
        }
    }
    __syncthreads();
}

constexpr int NWAVES = 8, NTHR = 512;
constexpr int RING_BYTES = 131072, MISC_OFF = RING_BYTES + 320, LDS_BYTES = 147456;

struct Inputs {
    const float *x, *c, *ctx, *c_ctx, *ada_w, *ada_b, *norm1_g, *w_in, *ret_decay, *ret_gn_g, *gdn_conv_w, *gdn_a_log, *gdn_dt_bias, *gdn_norm_g, *swa_sink, *w_out, *norm2_g,
        *ffn_w1, *ffn_w3, *ffn_w2, *router_w, *moe_w1, *moe_w3, *moe_w2, *final_g;
};
struct Args { Inputs in; float* out; unsigned char* ws; int ph_lo, ph_hi; };
static_assert(sizeof(Args) == 25 * 8 + 8 + 8 + 8, "no padding");


__device__ __forceinline__ const float* ld_ptr(const LAS unsigned long long* t, int i) { const unsigned long long v = t[i]; const unsigned lo = __builtin_amdgcn_readfirstlane((unsigned)v), hi = __builtin_amdgcn_readfirstlane((unsigned)(v >> 32)); return (const float*)(GAS const float*)(((unsigned long long)hi << 32) | lo); }
__device__ __forceinline__ Inputs load_inputs(const LAS unsigned long long* t) {
    Inputs in; const float** ip = (const float**)&in;
#pragma unroll
    for (int i = 0; i < 25; ++i) ip[i] = ld_ptr(t, i);
    return in;
}
struct Frame {
    LAS unsigned char* lds;
    int tid, lane, wave, G, gw, NGW, bid;
    unsigned char* ws;
};


constexpr int CW_DYN = 8192;
struct DynQ { unsigned* ctr; volatile LAS int* slot; bool lead; };
__device__ __forceinline__ DynQ dyn_make(Frame& F, int layer, int k) { DynQ q; q.ctr = (unsigned*)(F.ws + WS_CTL) + CW_DYN + (layer * 8 + k) * 64; q.slot = (volatile LAS int*)(F.lds + MISC_OFF + 64); q.lead = F.wave == 0 && F.lane == 0; return q; }
__device__ __forceinline__ int dyn_grab(const DynQ& q) { return q.lead ? (int)__hip_atomic_fetch_add(q.ctr, 1u, __ATOMIC_RELAXED, __HIP_MEMORY_SCOPE_AGENT) : 0; }
__device__ __forceinline__ int dyn_bcast(const DynQ& q, int v) { __syncthreads(); if (q.lead) q.slot[0] = v; __syncthreads(); return __builtin_amdgcn_readfirstlane(q.slot[0]); }


constexpr int CW_RSYNC = 12288;
__device__ __forceinline__ void rsync_publish(Frame& F, int layer) {
    asm volatile("s_waitcnt vmcnt(0)" ::: "memory");
    __syncthreads();
    if (F.wave == 0 && F.lane == 0) { __builtin_amdgcn_fence(__ATOMIC_RELEASE, "agent"); asm volatile("s_waitcnt vmcnt(0)" ::: "memory");
        (void)xb_add((unsigned*)(F.ws + WS_CTL) + CW_RSYNC + layer * 64, 1u); }
}
__device__ __forceinline__ void rsync_wait(Frame& F, int layer, unsigned want) {
    if (F.wave == 0 && F.lane == 0) { unsigned* w = (unsigned*)(F.ws + WS_CTL) + CW_RSYNC + layer * 64; unsigned* tmo = (unsigned*)(F.ws + WS_CTL) + CW_BAR + XB_TMO;
        unsigned sp = 0; while (xb_ld(w) < want) { __builtin_amdgcn_s_sleep(2); if ((++sp & 255u) == 0u) { if (xb_ld(tmo)) break; if (sp > XB_SPIN_CAP) { atomicAdd(tmo, 1u); break; } } }
        __builtin_amdgcn_fence(__ATOMIC_ACQUIRE, "agent"); asm volatile("s_waitcnt vmcnt(0)" ::: "memory"); }
    __syncthreads();
}

template <class SrcF>
__device__ __forceinline__ void transpose_item(const SrcF& src, int K, bf16* WT, LAS float* scr, int k0, int n0, int lane) {
#pragma unroll
    for (int i = 0; i < 8; ++i) { const int row = 4 * i + (lane >> 4), col = 4 * (lane & 15); *(LAS f32x4*)(scr + row * 68 + col) = src(k0 + row, n0 + col); }
    LDS_WAIT(); asm volatile("" ::: "memory");
#pragma unroll
    for (int j = 0; j < 4; ++j) { const int ch = j * 64 + lane, n = ch >> 2, c8 = ch & 3; const LAS float* sp = scr + (8 * c8) * 68 + n;
        u32x4 o; o.x = cvtpk(sp[0 * 68], sp[1 * 68]); o.y = cvtpk(sp[2 * 68], sp[3 * 68]); o.z = cvtpk(sp[4 * 68], sp[5 * 68]); o.w = cvtpk(sp[6 * 68], sp[7 * 68]);
        *(u32x4*)(WT + (size_t)(n0 + n) * K + k0 + 8 * c8) = o; }
    LDS_WAIT(); asm volatile("" ::: "memory");
}
struct SrcPlain { const float* W; int ld; __device__ __forceinline__ f32x4 operator()(int k, int n) const { return *(const f32x4*)(W + (size_t)k * ld + n); } };
struct SrcWin { const float* W; __device__ __forceinline__ f32x4 operator()(int k, int n) const { return *(const f32x4*)(W + (size_t)k * INC + (n < 2048 ? n : n + 16)); } };
struct SrcGU { const float* W1; const float* W3; int ld; __device__ __forceinline__ f32x4 operator()(int k, int n) const { const int g = n >> 5, i = n & 31; const ptrdiff_t d = (i < 16) ? (ptrdiff_t)0 : (W3 - W1); return *(const f32x4*)(W1 + d + (ptrdiff_t)k * ld + 16 * g + (i & 15)); } };

__device__ __forceinline__ void convert_moe_layer(Frame& F, const Inputs& in, int mi, int part, int nwg) {
    LAS float* scr = (LAS float*)(F.lds + F.wave * 16384);
    bf16* mw13 = (bf16*)(F.ws + WS_MW13); bf16* mw2 = (bf16*)(F.ws + WS_MW2);
    constexpr int I13 = (D / 32) * (2 * EF / 64), I2 = (EF / 32) * (D / 64);
    if (F.bid >= nwg) return;
    constexpr int NIT = NE * (I13 + I2);
    const int lane = F.lane, lr = lane >> 4, lc = 4 * (lane & 15);
    const int it_end = (part + 1) * (NIT / 2), step = nwg * NWAVES;
    int it = part * (NIT / 2) + F.gw;
    const float* sp = nullptr; int ld = 0; bf16* dp = nullptr; int dK = 0;
#define CV_DESC(itv, SP, LDv, DP, DK) do { const int e_ = (itv) / (I13 + I2); int r_ = (itv) % (I13 + I2); const size_t wo_ = ((size_t)mi * NE + e_) * (size_t)D * EF; \
        if (r_ < I13) { const int nb_ = 2 * EF / 64, k0_ = 32 * (r_ / nb_), n0_ = 64 * (r_ % nb_), n_ = n0_ + lc, g_ = n_ >> 5, i_ = n_ & 31; \
            SP = (i_ < 16 ? in.moe_w1 : in.moe_w3) + wo_ + (size_t)(k0_ + lr) * EF + 16 * g_ + (i_ & 15); LDv = EF; DP = mw13 + (size_t)e_ * 2 * EF * D + (size_t)n0_ * D + k0_; DK = D; } \
        else { r_ -= I13; const int nb_ = D / 64, k0_ = 32 * (r_ / nb_), n0_ = 64 * (r_ % nb_); \
            SP = in.moe_w2 + wo_ + (size_t)(k0_ + lr) * D + n0_ + lc; LDv = D; DP = mw2 + (size_t)e_ * D * EF + (size_t)n0_ * EF + k0_; DK = EF; } } while (0)
    f32x4 rc[8];
    if (it < it_end) { CV_DESC(it, sp, ld, dp, dK);
#pragma unroll
        for (int i = 0; i < 8; ++i) rc[i] = *(const f32x4*)(sp + (size_t)(4 * i) * ld); }
    while (it < it_end) {
        const int itn = it + step; const bool hasn = itn < it_end;
        const float* spn = sp; int ldn = ld; bf16* dpn = dp; int dKn = dK;
        if (hasn) CV_DESC(itn, spn, ldn, dpn, dKn);
#pragma unroll
        for (int i = 0; i < 8; ++i) *(LAS f32x4*)(scr + (4 * i + lr) * 68 + lc) = rc[i];
        f32x4 rn[8];
#pragma unroll
        for (int i = 0; i < 8; ++i) rn[i] = *(const f32x4*)(spn + (size_t)(4 * i) * ldn);
        LDS_WAIT(); asm volatile("" ::: "memory");
#pragma unroll
        for (int j = 0; j < 4; ++j) { const int ch = j * 64 + lane, n = ch >> 2, c8 = ch & 3; const LAS float* q = scr + (8 * c8) * 68 + n;
            u32x4 o; o.x = cvtpk(q[0 * 68], q[1 * 68]); o.y = cvtpk(q[2 * 68], q[3 * 68]); o.z = cvtpk(q[4 * 68], q[5 * 68]); o.w = cvtpk(q[6 * 68], q[7 * 68]);
            *(u32x4*)(dp + (size_t)n * dK + 8 * c8) = o; }
        LDS_WAIT(); asm volatile("" ::: "memory");
        it = itn; sp = spn; ld = ldn; dp = dpn; dK = dKn;
#pragma unroll
        for (int i = 0; i < 8; ++i) rc[i] = rn[i];
    }
#undef CV_DESC
}
__device__ __forceinline__ void phase_prologue(Frame& F, const Inputs& in) {
    LAS float* scr = (LAS float*)(F.lds + F.wave * 16384);
    {
        constexpr int I_IN = (D / 32) * (NP / 64), I_OUT = (D / 32) * (D / 64), I_13 = (D / 32) * (2 * FF / 64), I_2 = (FF / 32) * (D / 64);
        constexpr int PER_L = I_IN + I_OUT, PER_F = I_13 + I_2, TOT = DEPTH * PER_L + 2 * PER_F;
        for (int it = F.gw; it < TOT; it += F.NGW) {
            if (it < DEPTH * PER_L) { const int l = it / PER_L; int r = it % PER_L;
                if (r < I_IN) { const int nblk = NP / 64; SrcWin s{in.w_in + (size_t)l * D * INC}; transpose_item(s, D, (bf16*)(F.ws + WS_WIN) + (size_t)l * NP * D, scr, 32 * (r / nblk), 64 * (r % nblk), F.lane); }
                else { r -= I_IN; const int nblk = D / 64; SrcPlain s{in.w_out + (size_t)l * D * D, D}; transpose_item(s, D, (bf16*)(F.ws + WS_WOUT) + (size_t)l * D * D, scr, 32 * (r / nblk), 64 * (r % nblk), F.lane); }
            } else { const int q = it - DEPTH * PER_L; const int i = q / PER_F; int r = q % PER_F;
                if (r < I_13) { const int nblk = 2 * FF / 64; SrcGU s{in.ffn_w1 + (size_t)i * D * FF, in.ffn_w3 + (size_t)i * D * FF, FF}; transpose_item(s, D, (bf16*)(F.ws + WS_W13) + (size_t)i * 2 * FF * D, scr, 32 * (r / nblk), 64 * (r % nblk), F.lane); }
                else { r -= I_13; const int nblk = D / 64; SrcPlain s{in.ffn_w2 + (size_t)i * FF * D, D}; transpose_item(s, FF, (bf16*)(F.ws + WS_W2) + (size_t)i * D * FF, scr, 32 * (r / nblk), 64 * (r % nblk), F.lane); }
            }
        }
    }
    {
        __syncthreads();
        LAS float* sc = (LAS float*)F.lds;
        LAS float* red = (LAS float*)(F.lds + 32768);
        for (int i = F.tid; i < 5 * D; i += NTHR) { const int r = i / D, k = i % D; const float v = r < 4 ? in.c[r * D + k] : in.c_ctx[k]; sc[i] = siluf(v); }
        __syncthreads();
        float* mod = (float*)(F.ws + WS_MOD);
        for (int u = F.bid; u < DEPTH * 96; u += F.G) {
            const int l = u / 96, n = (u % 96) * 64 + F.lane;
            const float* w = in.ada_w + (size_t)l * D * 6 * D + n;
            float a[5] = {0.f, 0.f, 0.f, 0.f, 0.f};
            for (int k = F.wave * 128; k < F.wave * 128 + 128; ++k) { const float wv = w[(size_t)k * 6 * D];
#pragma unroll
                for (int r = 0; r < 5; ++r) a[r] += sc[r * D + k] * wv; }
#pragma unroll
            for (int r = 0; r < 5; ++r) red[(F.wave * 5 + r) * 64 + F.lane] = a[r];
            __syncthreads();
            if (F.tid < 320) { const int r = F.tid / 64, ln = F.tid % 64; float s = 0.f;
#pragma unroll
                for (int w8 = 0; w8 < 8; ++w8) s += red[(w8 * 5 + r) * 64 + ln];
                const int nn = (u % 96) * 64 + ln;
                mod[((size_t)l * 5 + r) * 6 * D + nn] = s + in.ada_b[(size_t)l * 6 * D + nn]; }
            __syncthreads();
        }
    }
    if (F.bid == 0) { float* rp = (float*)(F.ws + WS_ROPE);
        for (int i = F.tid; i < 64 * 16; i += NTHR) { const int pos = i / 16, fi = i % 16; const double inv = pow(10000.0, -(double)fi / 16.0), ang = (double)pos * inv; rp[2 * i] = (float)cos(ang); rp[2 * i + 1] = (float)sin(ang); } }
}

__device__ __forceinline__ int mod_row(int m) { return m < MC ? 4 : ((m - MC) >> 12); }


template <int MODE>
__device__ __forceinline__ void phase_token2(Frame& F, const Inputs& in, int layer, bool first_from_input, bool combine_moe, bool moe_router, float* out, int route_lo = 0, int nslab = 0) {
    float* XS = (float*)(F.ws + WS_XS);
    bf16* H = (bf16*)(F.ws + WS_H);
    const float* mod = (const float*)(F.ws + WS_MOD) + (size_t)(layer < DEPTH ? layer : DEPTH - 1) * 5 * 6 * D;
    const float* modprev = (const float*)(F.ws + WS_MOD) + (size_t)(layer > 0 ? layer - 1 : 0) * 5 * 6 * D;
    const float* TKG = (const float*)(F.ws + WS_TKG); const int* TOKROW = (const int*)(F.ws + WS_TOKROW);
    const bf16* YM = (const bf16*)(F.ws + WS_YM);
    LAS float* wl = (LAS float*)F.lds;
    const int lane = F.lane;
    if (MODE == 0) PB(8);
    if (MODE == 0) { __syncthreads(); const float* w = in.w_in + (size_t)layer * D * INC + 2048;
#pragma unroll
        for (int n = 0; n < 8; ++n) { const int k = (F.tid >> 2) + 128 * n, q4 = F.tid & 3, kp = ((k >> 8) * 4 + (k & 3)) * 64 + ((k >> 2) & 63);
            *(LAS f32x4*)(wl + (q4 * 1024 + kp) * 4) = *(const f32x4*)(w + (size_t)k * INC + 4 * q4); }
        __syncthreads(); }
    LAS int* lcnt = (LAS int*)(F.lds + 61440);
    if (MODE == 1 && moe_router) { __syncthreads(); if (F.tid < 8) lcnt[F.tid] = 0; const float* w = in.router_w + (size_t)(layer >> 1) * D * NE;
#pragma unroll
        for (int n = 0; n < 4; ++n) { const int k = (F.tid >> 1) + 256 * n, q4 = F.tid & 1, kp = ((k >> 8) * 4 + (k & 3)) * 64 + ((k >> 2) & 63);
            *(LAS f32x4*)(wl + (q4 * 1024 + kp) * 4) = *(const f32x4*)(w + (size_t)k * NE + 4 * q4); }
        __syncthreads(); }
    if (MODE == 0) PE(8);
    if (MODE == 0) PB(9);
    if (MODE == 1) PB(10);
    const float* gain = MODE == 0 ? in.norm1_g + (size_t)layer * D : (MODE == 1 ? in.norm2_g + (size_t)layer * D : in.final_g);
    const bool has_ctx = (MODE != 2) && F.gw < MC;
    const int r_beg = MC + (int)(((long)F.gw * ML) / F.NGW), r_end = MC + (int)(((long)(F.gw + 1) * ML) / F.NGW);
    if (nslab > 0 && has_ctx) {
        const float* sb = (const float*)(F.ws + WS_R1 + 100 * MiB); const float* gsrc = (MODE == 1 ? mod + (size_t)4 * 6 * D + 2 * D : modprev + (size_t)4 * 6 * D + 5 * D);
        { const int m = F.gw;
#pragma unroll
            for (int j = 0; j < 4; ++j) { f32x4 a0 = (f32x4){0.f, 0.f, 0.f, 0.f};
                for (int sidx = 0; sidx < nslab; ++sidx) a0 += *(const f32x4*)(sb + ((size_t)sidx * MC + m) * D + 4 * lane + 256 * j);
                float* xp = XS + (size_t)m * D + 4 * lane + 256 * j; *(f32x4*)xp = *(const f32x4*)xp + *(const f32x4*)(gsrc + 4 * lane + 256 * j) * a0; } }
        asm volatile("s_waitcnt vmcnt(0)" ::: "memory");
    }
    if (combine_moe) {
        const int ntl = ((const int*)(F.ws + WS_TILEE))[256]; const int srow = ((ntl - (ntl / 64) * 64 <= 16) ? (ntl / 64) * 64 : ntl) * 256; const float* sl = (const float*)(F.ws + WS_HP);
        bf16* YMw = (bf16*)(F.ws + WS_YM);
        for (int m0 = has_ctx ? r_beg - 1 : r_beg; m0 < r_end; ++m0) { const int m = m0 < r_beg ? F.gw : m0;
            if (MODE == 0 && layer == DEPTH && m < MC) continue;
#pragma unroll
            for (int k = 0; k < 2; ++k) { const int r = TOKROW[2 * m + k];
                if (r >= srow) { const size_t o = (size_t)(r - srow) * D;
#pragma unroll
                    for (int j = 0; j < 4; ++j) { const f32x4 y = ((*(const f32x4*)(sl + o + 4 * lane + 256 * j) + *(const f32x4*)(sl + (size_t)4096 * D + o + 4 * lane + 256 * j)) + *(const f32x4*)(sl + (size_t)8192 * D + o + 4 * lane + 256 * j)) + *(const f32x4*)(sl + (size_t)12288 * D + o + 4 * lane + 256 * j);
                        u32x2 wv; wv.x = cvtpk(y.x, y.y); wv.y = cvtpk(y.z, y.w); *(u32x2*)(YMw + (size_t)r * D + 4 * lane + 256 * j) = wv; } } } }
        asm volatile("s_waitcnt vmcnt(0)" ::: "memory");
    }
    f32x4 gv[4], av[4], bv[4], gt[4];
#pragma unroll
    for (int j = 0; j < 4; ++j) gv[j] = *(const f32x4*)(gain + 4 * lane + 256 * j);
    int rcur = -1;
    for (int m0 = has_ctx ? r_beg - 1 : r_beg; m0 < r_end; m0 += 2) {
        const bool isc = m0 < r_beg;
        const int ma = isc ? F.gw : m0; const bool two = !isc && ma + 1 < r_end; const int m1 = two ? ma + 1 : ma;
        if (isc) m0 -= 1;
        const int r = mod_row(ma);
        const bool same = mod_row(m1) == r;
        const int mm1 = same ? m1 : ma; const bool do1 = two && same;
        if (!same) m0 -= 1;
        if (r != rcur) { rcur = r;
            if (MODE != 2) { const float* sh = mod + (size_t)r * 6 * D + (MODE == 0 ? 0 : 3) * D;
#pragma unroll
                for (int j = 0; j < 4; ++j) { const f32x4 s1 = *(const f32x4*)(sh + D + 4 * lane + 256 * j); av[j] = gv[j] * (1.0f + s1); bv[j] = *(const f32x4*)(sh + 4 * lane + 256 * j); } }
            if (combine_moe) {
#pragma unroll
                for (int j = 0; j < 4; ++j) gt[j] = *(const f32x4*)(modprev + (size_t)r * 6 * D + 5 * D + 4 * lane + 256 * j); } }
        const int mr[2] = {ma, mm1};
        f32x4 v[2][4];
        int t0[2], t1[2]; float g0[2], g1[2];
        if (combine_moe) {
#pragma unroll
            for (int p = 0; p < 2; ++p) { t0[p] = TOKROW[2 * mr[p]]; t1[p] = TOKROW[2 * mr[p] + 1]; g0[p] = TKG[2 * mr[p]]; g1[p] = TKG[2 * mr[p] + 1]; } }
#pragma unroll
        for (int p = 0; p < 2; ++p) { const int m = mr[p];
            const float* xrow = first_from_input ? (m < MC ? in.ctx + (size_t)m * D : in.x + (size_t)(m - MC) * D) : XS + (size_t)m * D;
#pragma unroll
            for (int j = 0; j < 4; ++j) v[p][j] = *(const f32x4*)(xrow + 4 * lane + 256 * j); }
        if (combine_moe) {
#pragma unroll
            for (int p = 0; p < 2; ++p)
#pragma unroll
                for (int j = 0; j < 4; ++j) { const u32x2 a = *(const u32x2*)(YM + (size_t)t0[p] * D + 4 * lane + 256 * j), b = *(const u32x2*)(YM + (size_t)t1[p] * D + 4 * lane + 256 * j);
                    const f32x4 y0 = (f32x4){__uint_as_float(a.x << 16), __uint_as_float(a.x & 0xffff0000u), __uint_as_float(a.y << 16), __uint_as_float(a.y & 0xffff0000u)};
                    const f32x4 y1 = (f32x4){__uint_as_float(b.x << 16), __uint_as_float(b.x & 0xffff0000u), __uint_as_float(b.y << 16), __uint_as_float(b.y & 0xffff0000u)};
                    v[p][j] += gt[j] * (g0[p] * y0 + g1[p] * y1); } }
        if (((first_from_input && ma < MC) || combine_moe) && MODE != 2) {
#pragma unroll
            for (int p = 0; p < 2; ++p) if (p == 0 || do1) {
#pragma unroll
                for (int j = 0; j < 4; ++j) *(f32x4*)(XS + (size_t)mr[p] * D + 4 * lane + 256 * j) = v[p][j]; } }
        float rstd[2];
#pragma unroll
        for (int p = 0; p < 2; ++p) { float ss = 0.f;
#pragma unroll
            for (int j = 0; j < 4; ++j) ss += (v[p][j].x * v[p][j].x + v[p][j].y * v[p][j].y) + (v[p][j].z * v[p][j].z + v[p][j].w * v[p][j].w);
            rstd[p] = 1.0f / sqrtf(wave_sum(ss) * (1.0f / D) + EPS); }
        if (MODE == 2) {
#pragma unroll
            for (int p = 0; p < 2; ++p) if (p == 0 || do1) {
#pragma unroll
                for (int j = 0; j < 4; ++j) *(f32x4*)(out + (size_t)(mr[p] - MC) * D + 4 * lane + 256 * j) = v[p][j] * rstd[p] * gv[j]; }
            continue; }
        f32x4 h[2][4];
#pragma unroll
        for (int p = 0; p < 2; ++p)
#pragma unroll
            for (int j = 0; j < 4; ++j) { h[p][j] = v[p][j] * rstd[p] * av[j] + bv[j];
                if (p == 0 || do1) { u32x2 w; w.x = cvtpk(h[p][j].x, h[p][j].y); w.y = cvtpk(h[p][j].z, h[p][j].w); *(u32x2*)(H + (size_t)mr[p] * D + 4 * lane + 256 * j) = w; } }
        if (MODE == 0 || (MODE == 1 && moe_router)) {
            constexpr int NC = (MODE == 0) ? 16 : 8;
            float a[2][NC];
#pragma unroll
            for (int p = 0; p < 2; ++p)
#pragma unroll
                for (int c = 0; c < NC; ++c) a[p][c] = 0.f;
#pragma unroll
            for (int j = 0; j < 4; ++j)
#pragma unroll
                for (int e = 0; e < 4; ++e) { const int kp = (j * 4 + e) * 64 + lane;
#pragma unroll
                    for (int q = 0; q < NC / 4; ++q) { const f32x4 w = *(const LAS f32x4*)(wl + (q * 1024 + kp) * 4);
#pragma unroll
                        for (int p = 0; p < 2; ++p) { const float hv = h[p][j][e]; a[p][4 * q] += hv * w.x; a[p][4 * q + 1] += hv * w.y; a[p][4 * q + 2] += hv * w.z; a[p][4 * q + 3] += hv * w.w; } } }
#pragma unroll
            for (int p = 0; p < 2; ++p) {
#pragma unroll
                for (int c = 0; c < NC; ++c) a[p][c] = wave_sum(a[p][c]); }
#pragma unroll
            for (int p = 0; p < 2; ++p) if (p == 0 || do1) { const int m = mr[p];
                if (MODE == 0) { float mine = 0.f;
#pragma unroll
                    for (int c = 0; c < NC; ++c) mine = (lane == c) ? a[p][c] : mine;
                    if (lane < 16) ((float*)(F.ws + WS_AB))[(size_t)m * 16 + lane] = mine; }
                else { int i0 = 0; float l0 = a[p][0];
#pragma unroll
                    for (int c = 1; c < NC; ++c) if (a[p][c] > l0) { l0 = a[p][c]; i0 = c; }
                    int i1 = -1; float l1 = -3.0e38f;
#pragma unroll
                    for (int c = 0; c < NC; ++c) if (c != i0 && a[p][c] > l1) { l1 = a[p][c]; i1 = c; }
                    const float e1 = fexp(l1 - l0), gg0 = 1.0f / (1.0f + e1), gg1 = e1 / (1.0f + e1);
                    if (lane == 0 && m >= route_lo) { ((int*)(F.ws + WS_TKE))[2 * m] = i0; ((int*)(F.ws + WS_TKE))[2 * m + 1] = i1; ((float*)(F.ws + WS_TKG))[2 * m] = gg0; ((float*)(F.ws + WS_TKG))[2 * m + 1] = gg1;
                        ((int*)(F.ws + WS_TOKROW))[2 * m] = __hip_atomic_fetch_add(lcnt + i0, 1, __ATOMIC_RELAXED, __HIP_MEMORY_SCOPE_WORKGROUP); ((int*)(F.ws + WS_TOKROW))[2 * m + 1] = __hip_atomic_fetch_add(lcnt + i1, 1, __ATOMIC_RELAXED, __HIP_MEMORY_SCOPE_WORKGROUP); } } }
        }
    }
    if (MODE == 0) PE(9);
    if (MODE == 1) PE(10);
    if (MODE == 1 && moe_router) { __syncthreads(); if (F.tid < 8) ((int*)(F.ws + WS_TILEE + 4096))[F.bid * 8 + F.tid] = lcnt[F.tid]; }
}


__device__ __forceinline__ void unpack8(const u32x4 w, float (&v)[8]) {
#pragma unroll
    for (int e = 0; e < 4; ++e) { v[2 * e] = __uint_as_float(w[e] << 16); v[2 * e + 1] = __uint_as_float(w[e] & 0xffff0000u); } }
__device__ __forceinline__ u32x4 pack8(const float (&v)[8]) { u32x4 w; w.x = cvtpk(v[0], v[1]); w.y = cvtpk(v[2], v[3]); w.z = cvtpk(v[4], v[5]); w.w = cvtpk(v[6], v[7]); return w; }


__device__ __forceinline__ void phase_prep3(Frame& F, const Inputs& in, int layer) {
    const bf16* P = (const bf16*)(F.ws + WS_R1 + R1_P);
    unsigned char* prep = F.ws + WS_R1 + R1_PREP;
    bf16* RQ = (bf16*)(prep + PREP_RQ); bf16* RK = (bf16*)(prep + PREP_RK); bf16* SQ = (bf16*)(prep + PREP_SQ); bf16* SK = (bf16*)(prep + PREP_SK); bf16* GD = (bf16*)(prep + PREP_GD);
    const float* rope = (const float*)(F.ws + WS_ROPE);
    const float* AB = (const float*)(F.ws + WS_AB); float* GB = (float*)(F.ws + WS_GB);
    const float* cw = in.gdn_conv_w + (size_t)layer * 5 * 768;
    const int lane = F.lane, l3 = lane & 3, l31 = lane & 31;
    float wA[5][8], wB[5][8];
#pragma unroll
    for (int j = 0; j < 5; ++j) { const f32x4 a0 = *(const f32x4*)(cw + j * 768 + 8 * lane), a1 = *(const f32x4*)(cw + j * 768 + 8 * lane + 4), b0 = *(const f32x4*)(cw + j * 768 + 512 + 8 * l31), b1 = *(const f32x4*)(cw + j * 768 + 512 + 8 * l31 + 4);
#pragma unroll
        for (int x = 0; x < 4; ++x) { wA[j][x] = a0[x]; wA[j][4 + x] = a1[x]; wB[j][x] = b0[x]; wB[j][4 + x] = b1[x]; } }
    const float sgn = ((lane & 7) < 4) ? -1.0f : 1.0f;
    const bool isk = lane >= 32;
    const float dtb = in.gdn_dt_bias[layer * 8 + (lane & 7)], alg = -fexp(in.gdn_a_log[layer * 8 + (lane & 7)]);
    for (int mbase = F.gw; mbase < M; mbase += 2 * F.NGW) {
        const bool ok1 = mbase + F.NGW < M;
        const int mm[2] = {mbase, ok1 ? mbase + F.NGW : mbase};
        bool lat[2]; int tt0[2], Tn[2]; const bf16* prow[2];
#pragma unroll
        for (int p = 0; p < 2; ++p) { const int m = mm[p]; lat[p] = m >= MC; tt0[p] = lat[p] ? ((m - MC) & (TL - 1)) : (m & (TC - 1)); Tn[p] = lat[p] ? TL : TC; prow[p] = P + (size_t)m * NP; }
        f32x4 rt[2][4]; u32x4 u1[2], u2[2], u3[2];
#pragma unroll
        for (int p = 0; p < 2; ++p) { const int t = tt0[p]; const int pos = (l3 < 2) ? (t >> 6) : (t & 63); const float* rp = rope + (pos * 16 + 8 * (l3 & 1)) * 2;
            rt[p][0] = *(const f32x4*)(rp); rt[p][1] = *(const f32x4*)(rp + 4); rt[p][2] = *(const f32x4*)(rp + 8); rt[p][3] = *(const f32x4*)(rp + 12);
            u1[p] = *(const u32x4*)(prow[p] + (isk ? PC_RK : PC_RQ) + 8 * l31); u2[p] = *(const u32x4*)(prow[p] + PC_SQ + 8 * lane); u3[p] = *(const u32x4*)(prow[p] + PC_SK + 8 * (lane & 15)); }
        __builtin_amdgcn_sched_barrier(0);
#pragma unroll
        for (int p = 0; p < 2; ++p) { const int m = mm[p]; const bool st = (p == 0) || ok1;
            float cs[8], sn[8];
#pragma unroll
            for (int x = 0; x < 8; ++x) { cs[x] = rt[p][x >> 1][(x & 1) * 2]; sn[x] = rt[p][x >> 1][(x & 1) * 2 + 1]; if (!lat[p]) { cs[x] = 1.0f; sn[x] = 0.0f; } sn[x] *= sgn; }
            { float v[8], o[8]; unpack8(u1[p], v);
#pragma unroll
              for (int x = 0; x < 8; ++x) { if (isk) v[x] *= 0.125f; const float pv = __shfl_xor(v[x], 4); o[x] = v[x] * cs[x] + pv * sn[x]; }
              if (st) *(u32x4*)((isk ? RK : RQ) + (size_t)m * 256 + 8 * l31) = pack8(o); }
            { float v[8], o[8]; unpack8(u2[p], v);
#pragma unroll
              for (int x = 0; x < 8; ++x) { const float pv = __shfl_xor(v[x], 4); o[x] = v[x] * cs[x] + pv * sn[x]; }
              if (st) *(u32x4*)(SQ + (size_t)m * 512 + 8 * lane) = pack8(o); }
            { float v[8], o[8]; unpack8(u3[p], v);
#pragma unroll
              for (int x = 0; x < 8; ++x) { const float pv = __shfl_xor(v[x], 4); o[x] = v[x] * cs[x] + pv * sn[x]; }
              if (st && lane < 16) *(u32x4*)(SK + (size_t)m * 128 + 8 * lane) = pack8(o); } }
        { u32x4 ca[2][5];
#pragma unroll
          for (int p = 0; p < 2; ++p)
#pragma unroll
              for (int j = 0; j < 5; ++j) { const int tt = tt0[p] + j - 2; const bool ok = tt >= 0 && tt < Tn[p]; ca[p][j] = *(const u32x4*)(prow[p] + (ok ? (ptrdiff_t)(j - 2) * NP : (ptrdiff_t)0) + PC_GQKV + 8 * lane); }
          __builtin_amdgcn_sched_barrier(0);
#pragma unroll
          for (int p = 0; p < 2; ++p) { float a[8];
#pragma unroll
              for (int x = 0; x < 8; ++x) a[x] = 0.f;
#pragma unroll
              for (int j = 0; j < 5; ++j) { const int tt = tt0[p] + j - 2; const float z = (tt >= 0 && tt < Tn[p]) ? 1.0f : 0.0f; float va[8]; unpack8(ca[p][j], va);
#pragma unroll
                  for (int x = 0; x < 8; ++x) a[x] += z * wA[j][x] * va[x]; }
              float n2 = 0.f;
#pragma unroll
              for (int x = 0; x < 8; ++x) { a[x] = siluf(a[x]); n2 += a[x] * a[x]; }
              n2 += dppf<0xB1>(n2); n2 += dppf<0x4E>(n2); n2 += dppf<0x141>(n2);
              const float sc = __builtin_amdgcn_rsqf(n2 + EPS) * (lane < 32 ? 0.125f : 1.0f);
#pragma unroll
              for (int x = 0; x < 8; ++x) a[x] *= sc;
              if (p == 0 || ok1) *(u32x4*)(GD + (size_t)mm[p] * 768 + 8 * lane) = pack8(a); } }
        { u32x4 cb[2][5]; float abv[2];
#pragma unroll
          for (int p = 0; p < 2; ++p) {
#pragma unroll
              for (int j = 0; j < 5; ++j) { const int tt = tt0[p] + j - 2; const bool ok = tt >= 0 && tt < Tn[p]; cb[p][j] = *(const u32x4*)(prow[p] + (ok ? (ptrdiff_t)(j - 2) * NP : (ptrdiff_t)0) + PC_GQKV + 512 + 8 * l31); }
              abv[p] = AB[(size_t)mm[p] * 16 + (lane & 15)]; }
          __builtin_amdgcn_sched_barrier(0);
#pragma unroll
          for (int p = 0; p < 2; ++p) { const int m = mm[p]; float bq[8];
#pragma unroll
              for (int x = 0; x < 8; ++x) bq[x] = 0.f;
#pragma unroll
              for (int j = 0; j < 5; ++j) { const int tt = tt0[p] + j - 2; const float z = (tt >= 0 && tt < Tn[p]) ? 1.0f : 0.0f; float vb[8]; unpack8(cb[p][j], vb);
#pragma unroll
                  for (int x = 0; x < 8; ++x) bq[x] += z * wB[j][x] * vb[x]; }
#pragma unroll
              for (int x = 0; x < 8; ++x) bq[x] = siluf(bq[x]);
              if (p == 0 || ok1) { if (lane < 32) *(u32x4*)(GD + (size_t)m * 768 + 512 + 8 * lane) = pack8(bq);
                  if (lane < 16) { const float av = abv[p]; float o;
                      if (lane < 8) { const float xx = av + dtb; const float sp = fmaxf(xx, 0.f) + log1pf(fexp(-fabsf(xx))); o = alg * sp; }
                      else o = __builtin_amdgcn_rcpf(1.0f + fexp(-av));
                      GB[(size_t)m * 16 + lane] = o; } } } }
    }
}


__device__ __forceinline__ void phase_swa2(Frame& F, const Inputs& in, int layer, int nwg) {
    if (F.bid >= nwg) return;
    const bf16* P = (const bf16*)(F.ws + WS_R1 + R1_P);
    unsigned char* prep = F.ws + WS_R1 + R1_PREP;
    const bf16* SQ = (const bf16*)(prep + PREP_SQ); const bf16* SK = (const bf16*)(prep + PREP_SK);
    bf16* O = (bf16*)(F.ws + WS_R1 + R1_O);
    LAS bf16* Kbuf = (LAS bf16*)F.lds;
    const int lane = F.lane, c = lane & 15, q = lane >> 4, w = F.wave;
    const float LOG2E = 1.4426950408889634f;
    const int srow = F.tid >> 3, scol = (F.tid & 7) * 8;
    DynQ dq = dyn_make(F, layer, 1);
    for (int u = dyn_bcast(dq, dyn_grab(dq)); u < 544; ) {
        const int u_next = dyn_grab(dq);
        const bool lat = u < 512; int b, g, qb;
        if (lat) { b = u >> 7; g = (u >> 6) & 1; qb = u & 63; } else { const int uu = u - 512; b = uu >> 3; g = (uu >> 2) & 1; qb = uu & 3; }
        const int hq = 4 * g + (w >> 1), i0 = 32 * (w & 1);
        const int mrow0 = lat ? MC + b * TL + 64 * qb : b * TC + 64 * qb;
        const int kt0 = lat ? (2 - qb > 0 ? 2 - qb : 0) : 0, kt1 = lat ? (65 - qb < 4 ? 65 - qb : 4) : -1, nb = lat ? kt1 - kt0 + 1 : 0, nt = nb + 4;
        const int band0 = MC + b * TL + 64 * qb - 128 + 64 * kt0, ctx0 = b * TC;
        bf16x8 qf[2][2];
#pragma unroll
        for (int ti = 0; ti < 2; ++ti)
#pragma unroll
            for (int ks = 0; ks < 2; ++ks) qf[ti][ks] = *(const bf16x8*)(SQ + (size_t)(mrow0 + i0 + 16 * ti + c) * 512 + hq * 64 + 32 * ks + 8 * q);
        float mrun[2], lrun[2]; f32x4 oacc[4][2];
        const float sk = in.swa_sink[layer * 8 + hq] * LOG2E;
#pragma unroll
        for (int ti = 0; ti < 2; ++ti) { mrun[ti] = sk; lrun[ti] = 1.0f;
#pragma unroll
            for (int te = 0; te < 4; ++te) oacc[te][ti] = (f32x4){0.f, 0.f, 0.f, 0.f}; }
        u32x4 kreg, vreg;
#define SWA_LOAD(tix) do { const int r0_ = ((tix) < nb) ? band0 + 64 * (tix) : ctx0 + 64 * ((tix) - nb); \
            kreg = *(const u32x4*)(SK + (size_t)(r0_ + srow) * 128 + g * 64 + scol); vreg = *(const u32x4*)(P + (size_t)(r0_ + srow) * NP + PC_SV + g * 64 + scol); } while (0)
#define SWA_WRITE(buf) do { LAS bf16* Kw_ = Kbuf + (buf) * 9216; LAS bf16* Vw_ = Kw_ + 4608; *(LAS u32x4*)(Kw_ + srow * 72 + scol) = kreg; \
            _Pragma("unroll") for (int x = 0; x < 8; ++x) Vw_[(scol + x) * 72 + srow] = (bf16)(vreg[x >> 1] >> (16 * (x & 1))); } while (0)
        __syncthreads();
        SWA_LOAD(0); SWA_WRITE(0);
        if (nt > 1) SWA_LOAD(1);
        for (int tt = 0; tt < nt; ++tt) {
            __syncthreads();
            const LAS bf16* Kl = Kbuf + (tt & 1) * 9216; const LAS bf16* Vt = Kl + 4608;
            bf16x8 kfr[2][4]; u32x2 vlo[2][4], vhi[2][4];
#pragma unroll
            for (int ks = 0; ks < 2; ++ks)
#pragma unroll
                for (int tj = 0; tj < 4; ++tj) kfr[ks][tj] = *(const LAS bf16x8*)(Kl + (16 * tj + c) * 72 + 32 * ks + 8 * q);
#pragma unroll
            for (int ks2 = 0; ks2 < 2; ++ks2)
#pragma unroll
                for (int te = 0; te < 4; ++te) { vlo[ks2][te] = *(const LAS u32x2*)(Vt + (16 * te + c) * 72 + 32 * ks2 + 4 * q); vhi[ks2][te] = *(const LAS u32x2*)(Vt + (16 * te + c) * 72 + 32 * ks2 + 16 + 4 * q); }
            __builtin_amdgcn_sched_barrier(0);
            if (tt + 1 < nt) { SWA_WRITE((tt + 1) & 1); if (tt + 2 < nt) SWA_LOAD(tt + 2); }
            f32x4 sacc[4][2];
#pragma unroll
            for (int tj = 0; tj < 4; ++tj)
#pragma unroll
                for (int ti = 0; ti < 2; ++ti) sacc[tj][ti] = (f32x4){0.f, 0.f, 0.f, 0.f};
#pragma unroll
            for (int ks = 0; ks < 2; ++ks)
#pragma unroll
                for (int tj = 0; tj < 4; ++tj)
#pragma unroll
                    for (int ti = 0; ti < 2; ++ti) sacc[tj][ti] = mfma16(kfr[ks][tj], qf[ti][ks], sacc[tj][ti]);
            const bool band = tt < nb;
            const int kp0 = 64 * qb - 128 + 64 * (kt0 + tt) + 4 * q;
#pragma unroll
            for (int ti = 0; ti < 2; ++ti) {
                const int qp = 64 * qb + i0 + 16 * ti + c;
                float mx = -30000.0f;
                if (band) {
#pragma unroll
                    for (int tj = 0; tj < 4; ++tj)
#pragma unroll
                        for (int r = 0; r < 4; ++r) { float sv = sacc[tj][ti][r] * (0.125f * LOG2E); const int dlt = kp0 + 16 * tj + r - qp; if (dlt > 128 || dlt < -128) sv = -30000.0f; sacc[tj][ti][r] = sv; mx = fmaxf(mx, sv); }
                } else {
#pragma unroll
                    for (int tj = 0; tj < 4; ++tj)
#pragma unroll
                        for (int r = 0; r < 4; ++r) { const float sv = sacc[tj][ti][r] * (0.125f * LOG2E); sacc[tj][ti][r] = sv; mx = fmaxf(mx, sv); }
                }
                mx = quad_rows_max(mx);
                const float mn = fmaxf(mrun[ti], mx), corr = __builtin_amdgcn_exp2f(mrun[ti] - mn);
                float ls = 0.f;
#pragma unroll
                for (int tj = 0; tj < 4; ++tj)
#pragma unroll
                    for (int r = 0; r < 4; ++r) { const float p = __builtin_amdgcn_exp2f(sacc[tj][ti][r] - mn); sacc[tj][ti][r] = p; ls += p; }
                ls = quad_rows_sum(ls);
                lrun[ti] = lrun[ti] * corr + ls; mrun[ti] = mn;
#pragma unroll
                for (int te = 0; te < 4; ++te) oacc[te][ti] *= corr;
            }
#pragma unroll
            for (int ks2 = 0; ks2 < 2; ++ks2) {
                bf16x8 pb[2];
#pragma unroll
                for (int ti = 0; ti < 2; ++ti) { u32x4 t; t.x = cvtpk(sacc[2 * ks2][ti][0], sacc[2 * ks2][ti][1]); t.y = cvtpk(sacc[2 * ks2][ti][2], sacc[2 * ks2][ti][3]);
                    t.z = cvtpk(sacc[2 * ks2 + 1][ti][0], sacc[2 * ks2 + 1][ti][1]); t.w = cvtpk(sacc[2 * ks2 + 1][ti][2], sacc[2 * ks2 + 1][ti][3]); pb[ti] = __builtin_bit_cast(bf16x8, t); }
#pragma unroll
                for (int te = 0; te < 4; ++te) { const bf16x8 va = __builtin_bit_cast(bf16x8, ((u32x4){vlo[ks2][te].x, vlo[ks2][te].y, vhi[ks2][te].x, vhi[ks2][te].y}));
#pragma unroll
                    for (int ti = 0; ti < 2; ++ti) oacc[te][ti] = mfma16(va, pb[ti], oacc[te][ti]); }
            }
        }
#pragma unroll
        for (int ti = 0; ti < 2; ++ti) { const float il = 1.0f / lrun[ti]; bf16* orow = O + (size_t)(mrow0 + i0 + 16 * ti + c) * D + 512 + hq * 64 + 4 * q;
#pragma unroll
            for (int te = 0; te < 4; ++te) { u32x2 wv; wv.x = cvtpk(oacc[te][ti][0] * il, oacc[te][ti][1] * il); wv.y = cvtpk(oacc[te][ti][2] * il, oacc[te][ti][3] * il); *(u32x2*)(orow + 16 * te) = wv; } }
        u = dyn_bcast(dq, u_next);
    }
#undef SWA_LOAD
#undef SWA_WRITE
}


__device__ __forceinline__ void phase_gdn_local3(Frame& F, int layer) {
    unsigned char* prep = F.ws + WS_R1 + R1_PREP;
    const bf16* GD = (const bf16*)(prep + PREP_GD); const float* GB = (const float*)(F.ws + WS_GB);
    const int lane = F.lane, c = lane & 15, q = lane >> 4, w = F.wave, half = w >> 2, wq = w & 3, t2 = F.tid & 255;
    LAS unsigned char* L0 = F.lds + half * 54272;
    LAS bf16* Ks = (LAS bf16*)L0; LAS bf16* Vs = Ks + 64 * 72;
    LAS float* At = (LAS float*)(L0 + 18432);
    LAS bf16* XS_ = (LAS bf16*)(L0 + 18432);
    LAS float* sm = (LAS float*)(L0 + 51200);
    LAS float* gl = sm; LAS float* bl = sm + 128; LAS float* gcs = sm + 256; LAS float* eg = sm + 384; LAS float* ekd = sm + 512;
    DynQ dq = dyn_make(F, layer, 0);
    for (int pp = dyn_bcast(dq, dyn_grab(dq)); pp < 8 * 68; ) {
        const int pp_next = dyn_grab(dq);
        const int uu = 2 * pp + half, bh = uu / 68, ch = uu % 68, b = bh >> 2, hh = bh & 3;
        const int m0 = ch < 4 ? b * TC + 64 * ch : MC + b * TL + 64 * (ch - 4);
        __syncthreads();
#pragma unroll
        for (int rep = 0; rep < 2; ++rep) { const int idx = t2 + 256 * rep, row = idx >> 3, col8 = (idx & 7) * 8; const bf16* src = GD + (size_t)(m0 + row) * 768 + hh * 64 + col8;
            *(LAS u32x4*)(Ks + row * 72 + col8) = *(const u32x4*)(src + 256); *(LAS u32x4*)(Vs + row * 72 + col8) = *(const u32x4*)(src + 512); }
        { const int tok = t2 & 63, which = t2 >> 6; sm[which * 64 + tok] = GB[(size_t)(m0 + tok) * 16 + (which >> 1) * 8 + (which & 1) * 4 + hh]; }
        __syncthreads();
        if (wq < 2) { const int d = wq; const int tok = d ? 63 - lane : lane; float v = gl[d * 64 + tok];
#pragma unroll
            for (int o = 1; o < 64; o <<= 1) { const float t = __shfl_up(v, o); if (lane >= o) v += t; }
            const float last = __shfl(v, 63);
            gcs[d * 64 + lane] = v; eg[d * 64 + lane] = fexp(v); ekd[d * 64 + lane] = fexp(last - v);
            ((float*)(F.ws + WS_GCS))[((size_t)uu * 2 + d) * 64 + tok] = v; }
        __syncthreads();
        {
            const int ti = wq;
            bf16x8 a[2];
#pragma unroll
            for (int ks = 0; ks < 2; ++ks) a[ks] = *(const LAS bf16x8*)(Ks + (16 * ti + c) * 72 + 32 * ks + 8 * q);
#pragma unroll
            for (int tj = 0; tj < 4; ++tj) { f32x4 acc = (f32x4){0.f, 0.f, 0.f, 0.f};
#pragma unroll
                for (int ks = 0; ks < 2; ++ks) acc = mfma16(a[ks], *(const LAS bf16x8*)(Ks + (16 * tj + c) * 72 + 32 * ks + 8 * q), acc);
#pragma unroll
                for (int r = 0; r < 4; ++r) { const int it = 16 * ti + 4 * q + r, jt = 16 * tj + c;
#pragma unroll
                    for (int d = 0; d < 2; ++d) { const int i = d ? 63 - it : it, j = d ? 63 - jt : jt;
                        const float e = fexp(fminf(gcs[d * 64 + i] - gcs[d * 64 + j], 0.f));
                        At[d * 4096 + j * 64 + i] = (j < i) ? bl[d * 64 + it] * acc[r] * e : 0.f; } } }
        }
        __syncthreads();
        float x[64];
        const int sd = wq >> 1, kind = wq & 1;
        {
            const LAS bf16* R = kind ? Ks : Vs; const LAS float* A = At + sd * 4096;
#pragma unroll
            for (int i = 0; i < 64; ++i) { const int tok = sd ? 63 - i : i; float v = bl[sd * 64 + tok] * bf2f(R[tok * 72 + lane]); if (kind) v *= eg[sd * 64 + i]; x[i] = v; }
#pragma unroll
            for (int j = 0; j < 63; ++j) { const float xj = x[j];
                f32x4 ca[16];
#pragma unroll
                for (int g = ((j + 1) >> 2); g < 16; ++g) ca[g] = *(const LAS f32x4*)(A + j * 64 + 4 * g);
                __builtin_amdgcn_sched_barrier(0);
#pragma unroll
                for (int g = ((j + 1) >> 2); g < 16; ++g) { x[4 * g] -= ca[g].x * xj; x[4 * g + 1] -= ca[g].y * xj; x[4 * g + 2] -= ca[g].z * xj; x[4 * g + 3] -= ca[g].w * xj; }
                __builtin_amdgcn_sched_barrier(0); }
        }
        __syncthreads();
        { LAS bf16* XO = XS_ + (sd * 2 + kind) * 4096;
#pragma unroll
          for (int i = 0; i < 64; ++i) XO[(sd ? 63 - i : i) * 64 + lane] = (bf16)f2bf(x[i]); }
        __syncthreads();
        {
            for (int it = t2; it < 2 * 512; it += 256) { const int d = it >> 9, chk = it & 511;
                const int rt = chk >> 7, ks = (chk >> 6) & 1, ln = chk & 63, r = ln & 15, qq = ln >> 4, row = 16 * rt + r, c0 = 32 * ks + 4 * qq;
                const int chain = bh * 2 + d, sg = ch < 4 ? (d ? 3 - ch : ch) : 4 + (d ? 63 - (ch - 4) : ch - 4);
                unsigned char* dst = F.ws + WS_GCH + (size_t)chain * G2_CHAIN + (size_t)sg * G2_STEP;
                const LAS bf16* XW = XS_ + (d * 2 + 1) * 4096;
                const u32x2 lo = *(const LAS u32x2*)(XW + row * 64 + c0), hi = *(const LAS u32x2*)(XW + row * 64 + c0 + 16);
                *(u32x4*)(dst + chk * 16) = (u32x4){lo.x, lo.y, hi.x, hi.y};
                float v[8];
#pragma unroll
                for (int x8 = 0; x8 < 8; ++x8) { const int tok = c0 + (x8 & 3) + 16 * (x8 >> 2); const int i = d ? 63 - tok : tok; v[x8] = bf2f(Ks[tok * 72 + row]) * ekd[d * 64 + i]; }
                u32x4 o; o.x = cvtpk(v[0], v[1]); o.y = cvtpk(v[2], v[3]); o.z = cvtpk(v[4], v[5]); o.w = cvtpk(v[6], v[7]);
                *(u32x4*)(dst + 8192 + chk * 16) = o; }
            for (int it = t2; it < 2 * 1024; it += 256) { const int d = it >> 10, cu = it & 1023;
                const int sl = cu >> 8, rt = (cu >> 6) & 3, ln = cu & 63, qq = ln >> 4, cc = ln & 15;
                const LAS bf16* XU = XS_ + (d * 2) * 4096; const int tr = 16 * rt + 4 * qq;
                const bf16 e0 = XU[(tr) * 64 + 16 * sl + cc], e1 = XU[(tr + 1) * 64 + 16 * sl + cc], e2 = XU[(tr + 2) * 64 + 16 * sl + cc], e3 = XU[(tr + 3) * 64 + 16 * sl + cc];
                const int chain = bh * 2 + d, sg = ch < 4 ? (d ? 3 - ch : ch) : 4 + (d ? 63 - (ch - 4) : ch - 4);
                unsigned char* dst = F.ws + WS_GCH + (size_t)chain * G2_CHAIN + (size_t)sg * G2_STEP + 16384;
                *(u32x2*)(dst + cu * 8) = (u32x2){(unsigned)e0 | ((unsigned)e1 << 16), (unsigned)e2 | ((unsigned)e3 << 16)}; }
            if (t2 < 2) { const int d = t2; const int chain = bh * 2 + d, sg = ch < 4 ? (d ? 3 - ch : ch) : 4 + (d ? 63 - (ch - 4) : ch - 4);
                ((float*)(F.ws + WS_GDEC))[chain * 68 + sg] = eg[d * 64 + 63]; }
        }
        pp = dyn_bcast(dq, pp_next);
    }
}


__device__ __forceinline__ void phase_gdn_scan3(Frame& F, int first_wg) {
    const int chain = F.bid - first_wg; if (chain < 0 || chain >= 32) return;
    const unsigned char* src = F.ws + WS_GCH + (size_t)chain * G2_CHAIN;
    const float* decs = (const float*)(F.ws + WS_GDEC) + chain * 68;
    unsigned char* GSTb = F.ws + WS_GST + (size_t)chain * 68 * 16384;
    LAS unsigned char* ring = F.lds;
    const int lane = F.lane, w = F.wave;
    if (w >= 4) {
        const int dw = w - 4;
#define GS3_ISSUE(step) do { _Pragma("unroll") for (int k = 0; k < 6; ++k) { const int p = dw * 6 + k; \
            __builtin_amdgcn_global_load_lds((const unsigned*)(src + (size_t)(step) * G2_STEP + p * 1024 + lane * 16), (LAS unsigned*)(ring + ((step) & 3) * 24576 + p * 1024), 16, 0, 0); } } while (0)
        GS3_ISSUE(0); GS3_ISSUE(1); GS3_ISSUE(2);
        asm volatile("s_waitcnt vmcnt(12)" ::: "memory"); __builtin_amdgcn_s_barrier();
        for (int n = 0; n < 68; ++n) {
            if (n + 3 < 68) { GS3_ISSUE(n + 3); asm volatile("s_waitcnt vmcnt(12)" ::: "memory"); }
            else if (n + 2 < 68) asm volatile("s_waitcnt vmcnt(6)" ::: "memory");
            else asm volatile("s_waitcnt vmcnt(0)" ::: "memory");
            __builtin_amdgcn_s_barrier();
        }
#undef GS3_ISSUE
    } else {
        const int sl = w;
        f32x4 S[4];
#pragma unroll
        for (int rt = 0; rt < 4; ++rt) S[rt] = (f32x4){0.f, 0.f, 0.f, 0.f};
        const float dv0 = decs[lane], dv1 = decs[64 + (lane & 3)];
        asm volatile("s_waitcnt vmcnt(0)" ::: "memory"); __builtin_amdgcn_s_barrier(); asm volatile("" ::: "memory");
        for (int n = 0; n < 68; ++n) {
            const LAS unsigned char* base = ring + (n & 3) * 24576;
            const float dec = n < 64 ? __shfl(dv0, n) : __shfl(dv1, n - 64);
            unsigned char* go = GSTb + (size_t)n * 16384 + (size_t)(sl * 2 * 64 + lane) * 16;
#define GS3_FRAG(mat, rt, ks) (*(const LAS bf16x8*)(base + (mat) * 8192 + (((rt) * 2 + (ks)) * 64 + lane) * 16))
            bf16x8 wf[4][2], kf[4][2]; u32x2 uf[4];
#pragma unroll
            for (int rt = 0; rt < 4; ++rt) { wf[rt][0] = GS3_FRAG(0, rt, 0); wf[rt][1] = GS3_FRAG(0, rt, 1); }
#pragma unroll
            for (int rt = 0; rt < 4; ++rt) uf[rt] = *(const LAS u32x2*)(base + 16384 + ((sl * 4 + rt) * 64 + lane) * 8);
#pragma unroll
            for (int rt = 0; rt < 4; ++rt) { kf[rt][0] = GS3_FRAG(1, rt, 0); kf[rt][1] = GS3_FRAG(1, rt, 1); }
#undef GS3_FRAG
            __builtin_amdgcn_sched_barrier(0);
            bf16x8 BS[2], BV[2];
#pragma unroll
            for (int ks = 0; ks < 2; ++ks) { u32x4 t; t.x = cvtpk(S[2 * ks][0], S[2 * ks][1]); t.y = cvtpk(S[2 * ks][2], S[2 * ks][3]); t.z = cvtpk(S[2 * ks + 1][0], S[2 * ks + 1][1]); t.w = cvtpk(S[2 * ks + 1][2], S[2 * ks + 1][3]);
                BS[ks] = __builtin_bit_cast(bf16x8, t); *(u32x4*)(go + ks * 1024) = t; }
            f32x4 vn[4];
#pragma unroll
            for (int ks = 0; ks < 2; ++ks)
#pragma unroll
                for (int rt = 0; rt < 4; ++rt) vn[rt] = mfma16(wf[rt][ks], BS[ks], ks ? vn[rt] : (f32x4){0.f, 0.f, 0.f, 0.f});
#pragma unroll
            for (int rt = 0; rt < 4; ++rt) { const u32x2 uu = uf[rt];
                vn[rt] = (f32x4){__uint_as_float(uu.x << 16), __uint_as_float(uu.x & 0xffff0000u), __uint_as_float(uu.y << 16), __uint_as_float(uu.y & 0xffff0000u)} - vn[rt]; }
#pragma unroll
            for (int ks = 0; ks < 2; ++ks) { u32x4 t; t.x = cvtpk(vn[2 * ks][0], vn[2 * ks][1]); t.y = cvtpk(vn[2 * ks][2], vn[2 * ks][3]); t.z = cvtpk(vn[2 * ks + 1][0], vn[2 * ks + 1][1]); t.w = cvtpk(vn[2 * ks + 1][2], vn[2 * ks + 1][3]);
                BV[ks] = __builtin_bit_cast(bf16x8, t); *(u32x4*)(go + 8192 + ks * 1024) = t; }
#pragma unroll
            for (int rt = 0; rt < 4; ++rt) S[rt] = S[rt] * dec;
#pragma unroll
            for (int ks = 0; ks < 2; ++ks)
#pragma unroll
                for (int rt = 0; rt < 4; ++rt) S[rt] = mfma16(kf[rt][ks], BV[ks], S[rt]);
            asm volatile("s_waitcnt lgkmcnt(0)" ::: "memory"); __builtin_amdgcn_s_barrier(); asm volatile("" ::: "memory");
        }
    }
}

__device__ __forceinline__ void phase_gdn_out2(Frame& F, const Inputs& in, int layer) {
    const bf16* P = (const bf16*)(F.ws + WS_R1 + R1_P);
    const bf16* GD = (const bf16*)(F.ws + WS_R1 + R1_PREP + PREP_GD);
    const unsigned char* GSTb = F.ws + WS_GST; const float* GCS = (const float*)(F.ws + WS_GCS);
    bf16* O = (bf16*)(F.ws + WS_R1 + R1_O);
    const int lane = F.lane, c = lane & 15, q = lane >> 4, w = F.wave, half = w >> 2, ti = w & 3, t2 = F.tid & 255;
    LAS bf16* Qs = (LAS bf16*)(F.lds + half * 56320); LAS bf16* Ks = Qs + 4608;
    LAS unsigned char* Fr = F.lds + half * 56320 + 18432;
    LAS float* gT = (LAS float*)(F.lds + half * 56320 + 55296);
    DynQ dq = dyn_make(F, layer, 4);
    for (int pp = dyn_bcast(dq, dyn_grab(dq)); pp < 8 * 68; ) {
        const int pp_next = dyn_grab(dq);
        const int uu = 2 * pp + half, bh = uu / 68, ch = uu % 68, b = bh >> 2, hh = bh & 3;
        const int m0 = ch < 4 ? b * TC + 64 * ch : MC + b * TL + 64 * (ch - 4);
        __syncthreads();
#pragma unroll
        for (int rep = 0; rep < 2; ++rep) { const int idx = t2 + 256 * rep, row = idx >> 3, col8 = (idx & 7) * 8;
            const bf16* src = GD + (size_t)(m0 + row) * 768 + hh * 64 + col8;
            *(LAS u32x4*)(Qs + row * 72 + col8) = *(const u32x4*)(src); *(LAS u32x4*)(Ks + row * 72 + col8) = *(const u32x4*)(src + 256); }
#pragma unroll
        for (int d = 0; d < 2; ++d) { const int sg = ch < 4 ? (d ? 3 - ch : ch) : 4 + (d ? 63 - (ch - 4) : ch - 4);
            const unsigned char* g = GSTb + ((size_t)(bh * 2 + d) * 68 + sg) * 16384;
#pragma unroll
            for (int rep = 0; rep < 4; ++rep) { const int idx = t2 + 256 * rep; *(LAS u32x4*)(Fr + d * 16384 + idx * 16) = *(const u32x4*)(g + (size_t)idx * 16); } }
        if (t2 < 128) gT[t2] = GCS[(size_t)uu * 128 + t2];
        __syncthreads();
        bf16x8 qf[2], qr[2];
#pragma unroll
        for (int ks = 0; ks < 2; ++ks) { qf[ks] = *(const LAS bf16x8*)(Qs + (16 * ti + c) * 72 + 32 * ks + 8 * q);
            const u32x2 lo = *(const LAS u32x2*)(Qs + (16 * ti + c) * 72 + 32 * ks + 4 * q), hi = *(const LAS u32x2*)(Qs + (16 * ti + c) * 72 + 32 * ks + 16 + 4 * q);
            qr[ks] = __builtin_bit_cast(bf16x8, ((u32x4){lo.x, lo.y, hi.x, hi.y})); }
        const int i = 16 * ti + c;
        const float gi0 = gT[i], gi1 = gT[64 + i];
        f32x4 sacc[4];
#pragma unroll
        for (int tj = 0; tj < 4; ++tj) { f32x4 acc = (f32x4){0.f, 0.f, 0.f, 0.f};
#pragma unroll
            for (int ks = 0; ks < 2; ++ks) acc = mfma16(*(const LAS bf16x8*)(Ks + (16 * tj + c) * 72 + 32 * ks + 8 * q), qf[ks], acc);
            sacc[tj] = acc; }
        bf16x8 pb[2][2];
#pragma unroll
        for (int d = 0; d < 2; ++d) { f32x4 p[4];
#pragma unroll
            for (int tj = 0; tj < 4; ++tj) { const f32x4 gj = *(const LAS f32x4*)(gT + d * 64 + 16 * tj + 4 * q);
#pragma unroll
                for (int r = 0; r < 4; ++r) { const int j = 16 * tj + 4 * q + r; const bool ok = d ? (j >= i) : (j <= i);
                    p[tj][r] = ok ? sacc[tj][r] * fexp(fminf((d ? gi1 : gi0) - gj[r], 0.f)) : 0.f; } }
#pragma unroll
            for (int ks2 = 0; ks2 < 2; ++ks2) { u32x4 t; t.x = cvtpk(p[2 * ks2][0], p[2 * ks2][1]); t.y = cvtpk(p[2 * ks2][2], p[2 * ks2][3]); t.z = cvtpk(p[2 * ks2 + 1][0], p[2 * ks2 + 1][1]); t.w = cvtpk(p[2 * ks2 + 1][2], p[2 * ks2 + 1][3]); pb[d][ks2] = __builtin_bit_cast(bf16x8, t); } }
        const float sc0 = fexp(gi0), sc1 = fexp(gi1);
        f32x4 o[4]; float ssq = 0.f;
#pragma unroll
        for (int te = 0; te < 4; ++te) { f32x4 acc = (f32x4){0.f, 0.f, 0.f, 0.f}, t0 = acc, t1 = acc;
#pragma unroll
            for (int ks = 0; ks < 2; ++ks) {
                acc = mfma16(*(const LAS bf16x8*)(Fr + 8192 + ((te * 2 + ks) * 64 + lane) * 16), pb[0][ks], acc);
                acc = mfma16(*(const LAS bf16x8*)(Fr + 16384 + 8192 + ((te * 2 + ks) * 64 + lane) * 16), pb[1][ks], acc);
                t0 = mfma16(*(const LAS bf16x8*)(Fr + ((te * 2 + ks) * 64 + lane) * 16), qr[ks], t0);
                t1 = mfma16(*(const LAS bf16x8*)(Fr + 16384 + ((te * 2 + ks) * 64 + lane) * 16), qr[ks], t1); }
            o[te] = acc + sc0 * t0 + sc1 * t1; ssq += (o[te][0] * o[te][0] + o[te][1] * o[te][1]) + (o[te][2] * o[te][2] + o[te][3] * o[te][3]); }
        ssq = quad_rows_sum(ssq);
        const float rs = 1.0f / sqrtf(ssq * (1.0f / 64.0f) + EPS);
#pragma unroll
        for (int te = 0; te < 4; ++te) { const int e0 = 16 * te + 4 * q;
            const u32x2 z2 = *(const u32x2*)(P + (size_t)(m0 + i) * NP + PC_GZ + hh * 64 + e0); const f32x4 gn = *(const f32x4*)(in.gdn_norm_g + layer * 64 + e0);
            const float z0 = __uint_as_float(z2.x << 16), z1 = __uint_as_float(z2.x & 0xffff0000u), z2f = __uint_as_float(z2.y << 16), z3 = __uint_as_float(z2.y & 0xffff0000u);
            u32x2 wv; wv.x = cvtpk(o[te][0] * rs * gn[0] * siluf(z0), o[te][1] * rs * gn[1] * siluf(z1)); wv.y = cvtpk(o[te][2] * rs * gn[2] * siluf(z2f), o[te][3] * rs * gn[3] * siluf(z3));
            *(u32x2*)(O + (size_t)(m0 + i) * D + 256 + hh * 64 + e0) = wv; }
        pp = dyn_bcast(dq, pp_next);
    }
}

__device__ __forceinline__ void phase_ret_kv(Frame& F, const Inputs& in, int layer) {
    const bf16* P = (const bf16*)(F.ws + WS_R1 + R1_P);
    const bf16* RK = (const bf16*)(F.ws + WS_R1 + R1_PREP + PREP_RK);
    LAS bf16* Kt = (LAS bf16*)F.lds; LAS bf16* Vw = Kt + 64 * 72;
    const int lane = F.lane, c = lane & 15, q = lane >> 4, w = F.wave, tid = F.tid;
    const float LOG2E = 1.4426950408889634f;
    DynQ dq = dyn_make(F, layer, 2);
    for (int uu = dyn_bcast(dq, dyn_grab(dq)); uu < 16 * 68; ) {
        const int uu_next = dyn_grab(dq);
        const int bh = uu / 68, ch = uu % 68, b = bh >> 2, hh = bh & 3;
        const int m0 = ch < 4 ? b * TC + 64 * ch : MC + b * TL + 64 * (ch - 4);
        const float l0 = -fexp(in.ret_decay[layer * 8 + hh]) * LOG2E, l1 = -fexp(in.ret_decay[layer * 8 + 4 + hh]) * LOG2E;
        __syncthreads();
        { const int j = tid >> 3, col8 = (tid & 7) * 8;
          const u32x4 k8 = *(const u32x4*)(RK + (size_t)(m0 + j) * 256 + hh * 64 + col8), v8 = *(const u32x4*)(P + (size_t)(m0 + j) * NP + PC_RV + hh * 64 + col8);
          const float w0 = fexp2((float)(63 - j) * l0), w1 = fexp2((float)j * l1);
#pragma unroll
          for (int x = 0; x < 8; ++x) { const unsigned kk = (k8[x >> 1] >> (16 * (x & 1))) & 0xffffu; const float vv = __uint_as_float(((v8[x >> 1] >> (16 * (x & 1))) & 0xffffu) << 16);
              Kt[(col8 + x) * 72 + j] = (bf16)kk; Vw[(col8 + x) * 72 + j] = (bf16)f2bf(vv * w0); Vw[4608 + (col8 + x) * 72 + j] = (bf16)f2bf(vv * w1); } }
        __syncthreads();
        { const int d = w >> 2, td = w & 3;
          bf16x8 a[2];
#pragma unroll
          for (int ks = 0; ks < 2; ++ks) a[ks] = *(const LAS bf16x8*)(Kt + (16 * td + c) * 72 + 32 * ks + 8 * q);
          const int chain = bh * 2 + d, sg = d ? (ch < 4 ? 3 - ch : 71 - ch) : ch;
          float* dst = (float*)(F.ws + WS_RKV) + ((size_t)chain * 68 + sg) * 4096;
#pragma unroll
          for (int te = 0; te < 4; ++te) { f32x4 acc = (f32x4){0.f, 0.f, 0.f, 0.f};
#pragma unroll
              for (int ks = 0; ks < 2; ++ks) acc = mfma16(a[ks], *(const LAS bf16x8*)(Vw + d * 4608 + (16 * te + c) * 72 + 32 * ks + 8 * q), acc);
              *(f32x4*)(dst + (16 * te + c) * 64 + 16 * td + 4 * q) = acc; } }
        uu = dyn_bcast(dq, uu_next);
    }
}
__device__ __forceinline__ void phase_ret_state(Frame& F, const Inputs& in, int layer, int nwg) {
    if (F.bid >= nwg) return;
    const float* RKV = (const float*)(F.ws + WS_RKV); bf16* RST = (bf16*)(F.ws + WS_RST);
    for (int el = F.bid * NTHR + F.tid; el < 32 * 4096; el += nwg * NTHR) {
        const int chain = el >> 12, idx = el & 4095, hh = (chain >> 1) & 3, d = chain & 1;
        const float G64 = fexp(-64.0f * fexp(in.ret_decay[layer * 8 + d * 4 + hh]));
        const float* kv = RKV + (size_t)chain * 68 * 4096 + idx; bf16* st = RST + (size_t)chain * 68 * 4096 + idx;
        float S = 0.f;
#pragma unroll
        for (int h2 = 0; h2 < 2; ++h2) { float kvv[34];
#pragma unroll
            for (int sg = 0; sg < 34; ++sg) kvv[sg] = kv[(size_t)(34 * h2 + sg) * 4096];
#pragma unroll
            for (int sg = 0; sg < 34; ++sg) { st[(size_t)(34 * h2 + sg) * 4096] = (bf16)f2bf(S); S = G64 * S + kvv[sg]; } }
    }
}
__device__ __forceinline__ void phase_ret_out(Frame& F, const Inputs& in, int layer) {
    const bf16* P = (const bf16*)(F.ws + WS_R1 + R1_P);
    const bf16* RQ = (const bf16*)(F.ws + WS_R1 + R1_PREP + PREP_RQ); const bf16* RK = (const bf16*)(F.ws + WS_R1 + R1_PREP + PREP_RK);
    const bf16* RST = (const bf16*)(F.ws + WS_RST);
    bf16* O = (bf16*)(F.ws + WS_R1 + R1_O);
    const int lane = F.lane, c = lane & 15, q = lane >> 4, w = F.wave, half = w >> 2, ti = w & 3, t2 = F.tid & 255;
    LAS bf16* Qs = (LAS bf16*)(F.lds + half * 46080); LAS bf16* Ks = Qs + 4608; LAS bf16* Vt = Ks + 4608; LAS bf16* St = Vt + 4608;
    const float LOG2E = 1.4426950408889634f;
    DynQ dq = dyn_make(F, layer, 3);
    for (int pp = dyn_bcast(dq, dyn_grab(dq)); pp < 8 * 68; ) {
        const int pp_next = dyn_grab(dq);
        const int uu = 2 * pp + half, bh = uu / 68, ch = uu % 68, b = bh >> 2, hh = bh & 3;
        const int m0 = ch < 4 ? b * TC + 64 * ch : MC + b * TL + 64 * (ch - 4);
        const float l0 = -fexp(in.ret_decay[layer * 8 + hh]) * LOG2E, l1 = -fexp(in.ret_decay[layer * 8 + 4 + hh]) * LOG2E;
        __syncthreads();
#pragma unroll
        for (int rep = 0; rep < 2; ++rep) { const int idx = t2 + 256 * rep, row = idx >> 3, col8 = (idx & 7) * 8;
            *(LAS u32x4*)(Qs + row * 72 + col8) = *(const u32x4*)(RQ + (size_t)(m0 + row) * 256 + hh * 64 + col8);
            *(LAS u32x4*)(Ks + row * 72 + col8) = *(const u32x4*)(RK + (size_t)(m0 + row) * 256 + hh * 64 + col8);
            const u32x4 v8 = *(const u32x4*)(P + (size_t)(m0 + row) * NP + PC_RV + hh * 64 + col8);
#pragma unroll
            for (int x = 0; x < 8; ++x) Vt[(col8 + x) * 72 + row] = (bf16)(v8[x >> 1] >> (16 * (x & 1)));
#pragma unroll
            for (int d = 0; d < 2; ++d) { const int sg = d ? (ch < 4 ? 3 - ch : 71 - ch) : ch;
                *(LAS u32x4*)(St + d * 4608 + row * 72 + col8) = *(const u32x4*)(RST + ((size_t)(bh * 2 + d) * 68 + sg) * 4096 + row * 64 + col8); } }
        __syncthreads();
        bf16x8 qf[2];
#pragma unroll
        for (int ks = 0; ks < 2; ++ks) qf[ks] = *(const LAS bf16x8*)(Qs + (16 * ti + c) * 72 + 32 * ks + 8 * q);
        const int i = 16 * ti + c;
        f32x4 p[4];
#pragma unroll
        for (int tj = 0; tj < 4; ++tj) { f32x4 acc = (f32x4){0.f, 0.f, 0.f, 0.f};
#pragma unroll
            for (int ks = 0; ks < 2; ++ks) acc = mfma16(*(const LAS bf16x8*)(Ks + (16 * tj + c) * 72 + 32 * ks + 8 * q), qf[ks], acc);
#pragma unroll
            for (int r = 0; r < 4; ++r) { const int dlt = i - (16 * tj + 4 * q + r);
                const float wgt = (dlt >= 0 ? fexp2((float)dlt * l0) : 0.f) + (dlt <= 0 ? fexp2((float)(-dlt) * l1) : 0.f);
                acc[r] *= wgt; }
            p[tj] = acc; }
        bf16x8 pb[2];
#pragma unroll
        for (int ks2 = 0; ks2 < 2; ++ks2) { u32x4 t; t.x = cvtpk(p[2 * ks2][0], p[2 * ks2][1]); t.y = cvtpk(p[2 * ks2][2], p[2 * ks2][3]); t.z = cvtpk(p[2 * ks2 + 1][0], p[2 * ks2 + 1][1]); t.w = cvtpk(p[2 * ks2 + 1][2], p[2 * ks2 + 1][3]); pb[ks2] = __builtin_bit_cast(bf16x8, t); }
        const float sc0 = fexp2((float)(i + 1) * l0), sc1 = fexp2((float)(64 - i) * l1);
        f32x4 o[4]; float sum = 0.f;
#pragma unroll
        for (int te = 0; te < 4; ++te) { f32x4 acc = (f32x4){0.f, 0.f, 0.f, 0.f}, t0 = acc, t1 = acc;
#pragma unroll
            for (int ks2 = 0; ks2 < 2; ++ks2) { const u32x2 lo = *(const LAS u32x2*)(Vt + (16 * te + c) * 72 + 32 * ks2 + 4 * q), hi = *(const LAS u32x2*)(Vt + (16 * te + c) * 72 + 32 * ks2 + 16 + 4 * q);
                acc = mfma16(__builtin_bit_cast(bf16x8, ((u32x4){lo.x, lo.y, hi.x, hi.y})), pb[ks2], acc); }
#pragma unroll
            for (int ks = 0; ks < 2; ++ks) { t0 = mfma16(*(const LAS bf16x8*)(St + (16 * te + c) * 72 + 32 * ks + 8 * q), qf[ks], t0);
                t1 = mfma16(*(const LAS bf16x8*)(St + 4608 + (16 * te + c) * 72 + 32 * ks + 8 * q), qf[ks], t1); }
            o[te] = acc + sc0 * t0 + sc1 * t1; sum += (o[te][0] + o[te][1]) + (o[te][2] + o[te][3]); }
        sum = quad_rows_sum(sum);
        const float mu = sum * (1.0f / 64.0f); float vs = 0.f;
#pragma unroll
        for (int te = 0; te < 4; ++te) { o[te] = o[te] - mu; vs += (o[te][0] * o[te][0] + o[te][1] * o[te][1]) + (o[te][2] * o[te][2] + o[te][3] * o[te][3]); }
        vs = quad_rows_sum(vs);
        const float rs = 1.0f / sqrtf(vs * (1.0f / 64.0f) + EPS);
#pragma unroll
        for (int te = 0; te < 4; ++te) { const int e0 = hh * 64 + 16 * te + 4 * q;
            const u32x2 g2 = *(const u32x2*)(P + (size_t)(m0 + i) * NP + PC_RG + e0); const f32x4 gn = *(const f32x4*)(in.ret_gn_g + layer * 256 + e0);
            const float g0 = __uint_as_float(g2.x << 16), g1 = __uint_as_float(g2.x & 0xffff0000u), g2f = __uint_as_float(g2.y << 16), g3 = __uint_as_float(g2.y & 0xffff0000u);
            u32x2 wv; wv.x = cvtpk(o[te][0] * rs * gn[0] * siluf(g0), o[te][1] * rs * gn[1] * siluf(g1)); wv.y = cvtpk(o[te][2] * rs * gn[2] * siluf(g2f), o[te][3] * rs * gn[3] * siluf(g3));
            *(u32x2*)(O + (size_t)(m0 + i) * D + e0) = wv; }
        pp = dyn_bcast(dq, pp_next);
    }
}


__device__ __forceinline__ void phase_permute2(Frame& F, int route_lo) {
    const int* TKE = (const int*)(F.ws + WS_TKE); int* TOKROW = (int*)(F.ws + WS_TOKROW); int* TILEE = (int*)(F.ws + WS_TILEE);
    const int* WGCNT = (const int*)(F.ws + WS_TILEE + 4096);
    const bf16* H = (const bf16*)(F.ws + WS_H); bf16* HP = (bf16*)(F.ws + WS_HP);
    LAS int* base = (LAS int*)F.lds;
    LAS int* tot = base + 256 * 8;
    __syncthreads();
    {
        LAS int* scn = base + 256 * 8 + 64;
        int cnt8[8];
#pragma unroll
        for (int e = 0; e < 8; ++e) cnt8[e] = (F.tid < F.G) ? WGCNT[F.tid * 8 + e] : 0;
#pragma unroll
        for (int e = 0; e < 8; ++e) scn[F.tid * 8 + e] = cnt8[e];
        __syncthreads();
        int cur = 0;
        for (int off = 1; off < NTHR; off <<= 1) { int v[8];
#pragma unroll
            for (int e = 0; e < 8; ++e) v[e] = scn[cur * 4096 + F.tid * 8 + e] + (F.tid >= off ? scn[cur * 4096 + (F.tid - off) * 8 + e] : 0);
#pragma unroll
            for (int e = 0; e < 8; ++e) scn[(cur ^ 1) * 4096 + F.tid * 8 + e] = v[e];
            __syncthreads(); cur ^= 1; }
        if (F.tid < F.G) {
#pragma unroll
            for (int e = 0; e < 8; ++e) base[F.tid * 8 + e] = scn[cur * 4096 + F.tid * 8 + e] - cnt8[e]; }
        if (F.tid < 8) tot[F.tid] = scn[cur * 4096 + (F.G - 1) * 8 + F.tid];
    }
    __syncthreads();
    if (F.tid == 0) { int st = 0; for (int e = 0; e < 8; ++e) { tot[8 + e] = st; const int pad = (tot[e] + 255) / 256 * 256;
            if (F.bid == 0) for (int tl = st / 256; tl < (st + pad) / 256; ++tl) TILEE[tl] = e;
            st += pad; }
        if (F.bid == 0) TILEE[256] = st / 256; }
    __syncthreads();
    const int lane = F.lane;
    for (int m = route_lo + F.gw; m < M; m += F.NGW) {
        const int gwm = m < MC ? m : (int)((((long)(m - MC + 1)) * F.NGW - 1) / ML), wg = gwm >> 3;
        const int e0 = TKE[2 * m], e1 = TKE[2 * m + 1];
        const int r0 = tot[8 + e0] + base[wg * 8 + e0] + TOKROW[2 * m], r1 = tot[8 + e1] + base[wg * 8 + e1] + TOKROW[2 * m + 1];
        const u32x4 a = *(const u32x4*)(H + (size_t)m * D + 8 * lane), b = *(const u32x4*)(H + (size_t)m * D + 512 + 8 * lane);
        *(u32x4*)(HP + (size_t)r0 * D + 8 * lane) = a; *(u32x4*)(HP + (size_t)r0 * D + 512 + 8 * lane) = b;
        *(u32x4*)(HP + (size_t)r1 * D + 8 * lane) = a; *(u32x4*)(HP + (size_t)r1 * D + 512 + 8 * lane) = b;
        asm volatile("" ::: "memory");
        if (lane == 0) { TOKROW[2 * m] = r0; TOKROW[2 * m + 1] = r1; }
    }
    for (int e = 0; e < 8; ++e) { const int st = tot[8 + e] + tot[e], en = tot[8 + e] + (tot[e] + 255) / 256 * 256;
        for (int r = st + F.gw; r < en; r += F.NGW) { *(u32x4*)(HP + (size_t)r * D + 8 * lane) = (u32x4){0u, 0u, 0u, 0u}; *(u32x4*)(HP + (size_t)r * D + 512 + 8 * lane) = (u32x4){0u, 0u, 0u, 0u}; } }
}

constexpr int NPH = 12;
constexpr int PH_TOTAL = 1 + DEPTH * NPH + 1;
__host__ __device__ inline bool phase_exists(int ph) {
    if (ph == 0 || ph == PH_TOTAL - 1) return true;
    const int layer = (ph - 1) / NPH, j = (ph - 1) % NPH;
    if (!(layer & 1) && j >= 10) return false;
    if ((layer & 1) && j >= 11) return false;
    return true;
}
__global__ void __launch_bounds__(NTHR, 2) fwd_kernel(Args args) {
    extern __shared__ __attribute__((aligned(16))) unsigned char lds_raw[];
    Frame F;
    F.lds = (LAS unsigned char*)lds_raw;
    F.tid = threadIdx.x; F.lane = F.tid & 63; F.wave = __builtin_amdgcn_readfirstlane(F.tid >> 6);
    const int wave0 = F.wave;
    F.G = gridDim.x; F.bid = blockIdx.x; F.gw = blockIdx.x * NWAVES + F.wave; F.NGW = F.G * NWAVES; F.ws = args.ws;
    volatile LAS unsigned* MISC = (volatile LAS unsigned*)(F.lds + MISC_OFF);
    LAS unsigned long long* ptab = (LAS unsigned long long*)(F.lds + MISC_OFF + 128);
    if (F.tid < 32) MISC[F.tid] = 0u;
    if (PROBE_ON && F.tid == 65) { ((volatile LAS unsigned long long*)(F.lds + 132096))[0] = 0ull; ((volatile LAS unsigned long long*)(F.lds + 132096))[1] = 0ull; }
    if (F.tid == 64) { const Inputs& ai = args.in;
        ptab[0] = (unsigned long long)ai.x; ptab[1] = (unsigned long long)ai.c; ptab[2] = (unsigned long long)ai.ctx; ptab[3] = (unsigned long long)ai.c_ctx; ptab[4] = (unsigned long long)ai.ada_w; ptab[5] = (unsigned long long)ai.ada_b;
        ptab[6] = (unsigned long long)ai.norm1_g; ptab[7] = (unsigned long long)ai.w_in; ptab[8] = (unsigned long long)ai.ret_decay; ptab[9] = (unsigned long long)ai.ret_gn_g; ptab[10] = (unsigned long long)ai.gdn_conv_w; ptab[11] = (unsigned long long)ai.gdn_a_log;
        ptab[12] = (unsigned long long)ai.gdn_dt_bias; ptab[13] = (unsigned long long)ai.gdn_norm_g; ptab[14] = (unsigned long long)ai.swa_sink; ptab[15] = (unsigned long long)ai.w_out; ptab[16] = (unsigned long long)ai.norm2_g; ptab[17] = (unsigned long long)ai.ffn_w1;
        ptab[18] = (unsigned long long)ai.ffn_w3; ptab[19] = (unsigned long long)ai.ffn_w2; ptab[20] = (unsigned long long)ai.router_w; ptab[21] = (unsigned long long)ai.moe_w1; ptab[22] = (unsigned long long)ai.moe_w3; ptab[23] = (unsigned long long)ai.moe_w2; ptab[24] = (unsigned long long)ai.final_g; }
    __syncthreads();
    XcdBarrier bar; bar.bar = (unsigned*)(F.ws + WS_CTL) + CW_BAR; bar.x = 0; bar.st = nullptr; bar.w0 = F.wave;
    const int lo = args.ph_lo, hi = args.ph_hi;
    const bool multi = (hi - lo) > 1;
    if (multi) bar = xcd_barrier_post((unsigned*)(F.ws + WS_CTL) + CW_BAR, MISC + 8);
#define LAUNDER() GAS unsigned char* _w = (GAS unsigned char*)args.ws; asm volatile("" : "+s"(_w)); F.ws = (unsigned char*)_w; asm volatile("" ::: "memory"); { int _t = (wave0 << 6) | (int)__builtin_amdgcn_mbcnt_hi(~0u, __builtin_amdgcn_mbcnt_lo(~0u, 0u)); asm volatile("" : "+v"(_t)); int _b = blockIdx.x; asm volatile("" : "+s"(_b)); F.tid = _t; F.lane = _t & 63; F.wave = __builtin_amdgcn_readfirstlane(_t >> 6); F.bid = _b; F.gw = _b * NWAVES + F.wave; } const Inputs in = load_inputs(ptab)
#define RELAUNDER() do { GAS unsigned char* _w2 = (GAS unsigned char*)args.ws; asm volatile("" : "+s"(_w2)); F.ws = (unsigned char*)_w2; int _t = (wave0 << 6) | (int)__builtin_amdgcn_mbcnt_hi(~0u, __builtin_amdgcn_mbcnt_lo(~0u, 0u)); asm volatile("" : "+v"(_t)); int _b = blockIdx.x; asm volatile("" : "+s"(_b)); F.tid = _t; F.lane = _t & 63; F.wave = __builtin_amdgcn_readfirstlane(_t >> 6); F.bid = _b; F.gw = _b * NWAVES + F.wave; asm volatile("" ::: "memory"); } while (0)
#define IN(k) (lo <= (k) && (k) < hi)
#define STAMP(k) do { if (PROBE_ON && !(PROBE_CUSTOM) && blockIdx.x == 0 && xb_leader(F.wave)) { volatile LAS unsigned long long* _st = (volatile LAS unsigned long long*)(F.lds + 132096); const unsigned long long _now = __builtin_amdgcn_s_memrealtime(), _prev = _st[0]; _st[0] = _now; \
    const int _ph = (k) - 1; bool _sel = false; if (_ph == 0) _sel = (PROBE_PRO) != 0; else if (_ph > 0) { const int _l = (_ph - 1) / NPH, _j = (_ph - 1) % NPH; _sel = (((PROBE_LMASK) >> _l) & 1u) && (((PROBE_JMASK) >> _j) & 1u); } if (_sel) _st[1] = _st[1] + (_now - _prev); } } while (0)
#define SEAM(k) do { if (IN(k) && IN((k) + 1)) { xcd_barrier(bar); STAMP((k) + 1); } } while (0)
    LAS unsigned char* ring = F.lds;

    STAMP(0);
    if (IN(0)) { LAUNDER(); phase_prologue(F, in); } SEAM(0);

#define LAYER_BODY(layer) { \
        const int p0 = 1 + layer * NPH; \
        const bool moe = layer & 1; \
        if (IN(p0 + 0)) { LAUNDER(); phase_token2<0>(F, in, layer, layer == 0, layer > 0 && ((layer - 1) & 1), false, nullptr, 0, (layer > 0 && !((layer - 1) & 1)) ? 11 : 0); } \
        SEAM(p0 + 0); \
        if (IN(p0 + 1)) { LAUNDER(); pg8::StaticOrder S; S.init(F.ws + WS_H, (bf16*)(F.ws + WS_WIN) + (size_t)layer * NP * D, M, NP, D, F.G, F.bid); \
            pg8::EpiBf16 E{(bf16*)(F.ws + WS_R1 + R1_P), NP}; pg8::gemm_phase<D, D, pg8::EpiBf16, pg8::StaticOrder>(ring, S, E, F.tid); } \
        SEAM(p0 + 1); \
        if (IN(p0 + 2)) { LAUNDER(); phase_prep3(F, in, layer); } \
        SEAM(p0 + 2); \
        if (IN(p0 + 3)) { LAUNDER(); convert_moe_layer(F, in, (layer) >> 1, (layer) & 1, F.G); RELAUNDER(); PB(4); phase_gdn_local3(F, layer); PE(4); RELAUNDER(); PB(5); phase_ret_kv(F, in, layer); PE(5); } \
        SEAM(p0 + 3); \
        if (IN(p0 + 4)) { LAUNDER(); PB(1); phase_gdn_scan3(F, F.G - 32); PE(1); RELAUNDER(); PB(2); phase_ret_state(F, in, layer, F.G - 32); PE(2); if (F.bid < F.G - 32) rsync_publish(F, layer); RELAUNDER(); PB(3); phase_swa2(F, in, layer, F.G); PE(3); RELAUNDER(); rsync_wait(F, layer, (unsigned)(F.G - 32)); PB(6); phase_ret_out(F, in, layer); PE(6); } \
        SEAM(p0 + 4); \
        if (IN(p0 + 5)) { LAUNDER(); PB(7); phase_gdn_out2(F, in, layer); PE(7); } \
        SEAM(p0 + 5); \
        if (IN(p0 + 6)) { LAUNDER(); \
            { pg8::StaticOrder S; S.init(F.ws + WS_R1 + R1_O, (bf16*)(F.ws + WS_WOUT) + (size_t)layer * D * D, ML, D, D, F.G, F.bid, 4); \
              pg8::EpiResid E{(float*)(F.ws + WS_XS), (const float*)(F.ws + WS_MOD) + (size_t)layer * 5 * 6 * D, 2, (layer) == 0 ? in.x : nullptr}; pg8::gemm_phase<D, D, pg8::EpiResid, pg8::StaticOrder>(ring, S, E, F.tid); } \
            if (layer < DEPTH - 1) { RELAUNDER(); \
              pg8::SplitOrder S; S.init(F.ws + WS_R1 + R1_O, (bf16*)(F.ws + WS_WOUT) + (size_t)layer * D * D, D, 4, F.G, F.bid); \
              pg8::EpiSlab E{(float*)(F.ws + WS_R1 + 100 * MiB)}; pg8::gemm_phase<256, D, pg8::EpiSlab, pg8::SplitOrder>(ring, S, E, F.tid); } } \
        SEAM(p0 + 6); \
        if (IN(p0 + 7)) { LAUNDER(); phase_token2<1>(F, in, layer, false, false, moe, nullptr, layer == DEPTH - 1 ? MC : 0, layer < DEPTH - 1 ? 4 : 0); } \
        SEAM(p0 + 7); \
        if (!moe) { \
            if (IN(p0 + 8)) { LAUNDER(); pg8::StaticOrder S; S.init(F.ws + WS_H, (bf16*)(F.ws + WS_W13) + (size_t)(layer >> 1) * 2 * FF * D, M, 2 * FF, D, F.G, F.bid); \
                pg8::EpiSwiglu E{(bf16*)(F.ws + WS_R1 + R1_HID), FF}; pg8::gemm_phase<D, D, pg8::EpiSwiglu, pg8::StaticOrder>(ring, S, E, F.tid); } \
            SEAM(p0 + 8); \
            if (IN(p0 + 9)) { LAUNDER(); \
                { pg8::StaticOrder S; S.init(F.ws + WS_R1 + R1_HID, (bf16*)(F.ws + WS_W2) + (size_t)(layer >> 1) * D * FF, ML, D, FF, F.G, F.bid, 4); \
                  pg8::EpiResid E{(float*)(F.ws + WS_XS), (const float*)(F.ws + WS_MOD) + (size_t)layer * 5 * 6 * D, 5, nullptr}; pg8::gemm_phase<FF, FF, pg8::EpiResid, pg8::StaticOrder>(ring, S, E, F.tid); } \
                { RELAUNDER(); \
                  pg8::SplitOrder S; S.init(F.ws + WS_R1 + R1_HID, (bf16*)(F.ws + WS_W2) + (size_t)(layer >> 1) * D * FF, FF, 11, F.G, F.bid); \
                  pg8::EpiSlab E{(float*)(F.ws + WS_R1 + 100 * MiB)}; pg8::gemm_phase<256, FF, pg8::EpiSlab, pg8::SplitOrder>(ring, S, E, F.tid); } } \
            if (IN(p0 + 9) && IN(p0 + NPH)) { xcd_barrier(bar); STAMP(p0 + 10); } \
        } else { \
            if (IN(p0 + 8)) { LAUNDER(); phase_permute2(F, layer == DEPTH - 1 ? MC : 0); } \
            SEAM(p0 + 8); \
            if (IN(p0 + 9)) { LAUNDER(); const int* tile_e = (const int*)(F.ws + WS_TILEE); const int ntiles = __builtin_amdgcn_readfirstlane(tile_e[256]); \
                pg8::GroupedOrder S; S.init(F.ws + WS_HP, F.ws + WS_MW13, ntiles, 2 * EF, D, F.G, F.bid, tile_e); \
                pg8::EpiSwiglu E{(bf16*)(F.ws + WS_R1 + R1_HID), EF}; pg8::gemm_phase<D, D, pg8::EpiSwiglu, pg8::GroupedOrder>(ring, S, E, F.tid); } \
            SEAM(p0 + 9); \
            if (IN(p0 + 10)) { LAUNDER(); const int* tile_e = (const int*)(F.ws + WS_TILEE); const int ntiles = __builtin_amdgcn_readfirstlane(tile_e[256]); \
                const int tmain = (ntiles - (ntiles / 64) * 64 <= 16) ? (ntiles / 64) * 64 : ntiles; \
                { pg8::GroupedOrder S; S.init(F.ws + WS_R1 + R1_HID, F.ws + WS_MW2, tmain, D, EF, F.G, F.bid, tile_e); \
                  pg8::EpiBf16 E{(bf16*)(F.ws + WS_YM), D}; pg8::gemm_phase<EF, EF, pg8::EpiBf16, pg8::GroupedOrder>(ring, S, E, F.tid); } \
                if (ntiles > tmain) { RELAUNDER(); const int* tile_e2 = (const int*)(F.ws + WS_TILEE); \
                  pg8::SplitGroupedOrder S; S.init(F.ws + WS_R1 + R1_HID, F.ws + WS_MW2, tmain, ntiles - tmain, F.G, F.bid, tile_e2); \
                  pg8::EpiYMSlab E{(float*)(F.ws + WS_YM), (float*)(F.ws + WS_HP), tmain * 256}; pg8::gemm_phase<896, EF, pg8::EpiYMSlab, pg8::SplitGroupedOrder>(ring, S, E, F.tid); } } \
            if (IN(p0 + 10) && IN(p0 + NPH)) { xcd_barrier(bar); STAMP(p0 + 11); } \
        } \
    }
    LAYER_BODY(0) LAYER_BODY(1) LAYER_BODY(2) LAYER_BODY(3)
#undef LAYER_BODY
    if (IN(PH_TOTAL - 1)) { LAUNDER(); phase_token2<2>(F, in, DEPTH, false, true, false, args.out); }
    if (PROBE_ON && (int)blockIdx.x == ((PROBE_CUSTOM) ? (PROBE_BLOCK < 0 ? (int)gridDim.x + (PROBE_BLOCK) : (PROBE_BLOCK)) : 0) && xb_leader(F.wave)) {
        STAMP(PH_TOTAL);
        const unsigned long long T = ((volatile LAS unsigned long long*)(F.lds + 132096))[1];
        const unsigned long long t0 = __builtin_amdgcn_s_memrealtime();
        while (__builtin_amdgcn_s_memrealtime() - t0 < 8ull * T) __builtin_amdgcn_s_sleep(8);
    }
#undef IN
#undef SEAM
}

extern "C" void kernel_launch(void* const* d_in, const int* in_sizes, int n_in, void* d_out, int out_size, void* d_ws, size_t ws_size, hipStream_t stream) {
    static int grid = 0;
    if (grid == 0) {
        if (n_in != 25 || out_size != ML * D || ws_size < WS_END) { fprintf(stderr, "kernel_launch: unexpected problem: n_in %d out %d ws %zu (need %zu)\n", n_in, out_size, ws_size, (size_t)WS_END); grid = -1; return; }
        int dev = 0, cus = 0, per_cu = 0;
        if (hipGetDevice(&dev) != hipSuccess || hipDeviceGetAttribute(&cus, hipDeviceAttributeMultiprocessorCount, dev) != hipSuccess) { grid = -1; return; }
        if (hipFuncSetAttribute((const void*)fwd_kernel, hipFuncAttributeMaxDynamicSharedMemorySize, LDS_BYTES) != hipSuccess) { fprintf(stderr, "kernel_launch: hipFuncSetAttribute failed\n"); grid = -1; return; }
        if (hipOccupancyMaxActiveBlocksPerMultiprocessor(&per_cu, (const void*)fwd_kernel, NTHR, LDS_BYTES) != hipSuccess || per_cu < 1) fprintf(stderr, "kernel_launch: occupancy query reports %d\n", per_cu);
        (void)hipGetLastError();
        grid = cus;
    }
    if (grid < 0) return;
    (void)hipMemsetAsync((char*)d_ws + WS_CTL, 0, CTL_ZERO_BYTES, stream);
    Args a{};
    const float** ip = (const float**)&a.in;
    for (int i = 0; i < 25; ++i) ip[i] = (const float*)d_in[i];
    a.out = (float*)d_out; a.ws = (unsigned char*)d_ws;
#if MK_ONE_LAUNCH
    a.ph_lo = 0; a.ph_hi = PH_TOTAL;
    hipLaunchKernelGGL(fwd_kernel, dim3(grid), dim3(NTHR), LDS_BYTES, stream, a);
#else
    for (int ph = 0; ph < PH_TOTAL; ++ph) { if (!phase_exists(ph)) continue; a.ph_lo = ph; a.ph_hi = ph + 1;
        hipLaunchKernelGGL(fwd_kernel, dim3(grid), dim3(NTHR), LDS_BYTES, stream, a); }
#endif
}
```

```cpp
#include <hip/hip_runtime.h>
#include <cstdio>
#include <cstdint>

#ifndef PROBE_JMASK
#define PROBE_JMASK 0u
#endif
#ifndef PROBE_LMASK
#define PROBE_LMASK 15u
#endif
#ifndef PROBE_PRO
#define PROBE_PRO 0
#endif
#ifndef PROBE_CUSTOM
#define PROBE_CUSTOM 0
#endif
#ifndef PROBE_BLOCK
#define PROBE_BLOCK 0
#endif
#define PROBE_ON ((PROBE_JMASK) != 0u || (PROBE_PRO) != 0 || (PROBE_CUSTOM) != 0)
#define PB(id) do { if ((PROBE_CUSTOM) == (id) && (int)blockIdx.x == (PROBE_BLOCK < 0 ? (int)gridDim.x + (PROBE_BLOCK) : (PROBE_BLOCK)) && xb_leader(F.wave)) ((volatile LAS unsigned long long*)(F.lds + 132096))[2] = __builtin_amdgcn_s_memrealtime(); } while (0)
#define PE(id) do { if ((PROBE_CUSTOM) == (id) && (int)blockIdx.x == (PROBE_BLOCK < 0 ? (int)gridDim.x + (PROBE_BLOCK) : (PROBE_BLOCK)) && xb_leader(F.wave)) { volatile LAS unsigned long long* _s = (volatile LAS unsigned long long*)(F.lds + 132096); _s[1] = _s[1] + (__builtin_amdgcn_s_memrealtime() - _s[2]); } } while (0)
#define PG8_PB() do { if ((PROBE_CUSTOM) == 20 && (int)blockIdx.x == 0 && wid == 0 && lane == 0) ((volatile __attribute__((address_space(3))) unsigned long long*)(lds + 132096))[2] = __builtin_amdgcn_s_memrealtime(); } while (0)
#define PG8_PE() do { if ((PROBE_CUSTOM) == 20 && (int)blockIdx.x == 0 && wid == 0 && lane == 0) { volatile __attribute__((address_space(3))) unsigned long long* _s = (volatile __attribute__((address_space(3))) unsigned long long*)(lds + 132096); _s[1] = _s[1] + (__builtin_amdgcn_s_memrealtime() - _s[2]); } } while (0)
#ifndef MK_ONE_LAUNCH
#define MK_ONE_LAUNCH 1
#endif

#define GAS __attribute__((address_space(1)))
#define LAS __attribute__((address_space(3)))
typedef unsigned short bf16;
typedef short bf16x8 __attribute__((ext_vector_type(8)));
typedef float f32x4 __attribute__((ext_vector_type(4)));
typedef float f32x2 __attribute__((ext_vector_type(2)));
typedef unsigned u32x4 __attribute__((ext_vector_type(4)));
typedef unsigned u32x2 __attribute__((ext_vector_type(2)));

constexpr int D = 1024, NB = 4, TL = 4096, TC = 256, DEPTH = 4;
constexpr int MC = NB * TC, ML = NB * TL, M = MC + ML;
constexpr int INC = 2832, NP = 2816;
constexpr int FF = 2816, EF = 3584, NE = 8;
constexpr int MAXROWS = 36864;
constexpr float EPS = 1e-6f;
constexpr int PC_RQ = 0, PC_RK = 256, PC_RV = 512, PC_RG = 768, PC_GQKV = 1024, PC_GZ = 1792, PC_SQ = 2048, PC_SK = 2560, PC_SV = 2688;

constexpr size_t MiB = 1u << 20;
constexpr size_t WS_CTL = 0, CTL_ZERO_BYTES = 1 * MiB;
constexpr size_t WS_MOD = 1 * MiB;
constexpr size_t WS_ROPE = 2 * MiB;
constexpr size_t WS_TKE = 3 * MiB, WS_TKG = 3 * MiB + 256 * 1024, WS_TOKROW = 3 * MiB + 512 * 1024, WS_ROWTOK = 3 * MiB + 768 * 1024, WS_TILEE = 4 * MiB;
constexpr size_t WS_AB = 5 * MiB, WS_GB = 7 * MiB;
constexpr size_t WS_WIN = 16 * MiB, WS_WOUT = 38 * MiB, WS_W13 = 46 * MiB, WS_W2 = 68 * MiB, WS_MW13 = 80 * MiB, WS_MW2 = 192 * MiB;
constexpr size_t WS_XS = 248 * MiB, WS_H = 316 * MiB, WS_HP = 350 * MiB, WS_YM = 422 * MiB, WS_R1 = 566 * MiB;
constexpr size_t R1_P = 0, R1_PREP = 94 * MiB, R1_O = 158 * MiB, R1_OR = 192 * MiB, R1_OG = 226 * MiB, R1_HID = 0;
constexpr size_t WS_END = WS_R1 + 260 * MiB;
constexpr size_t WS_GCH = WS_YM, GCH_STEP = 40960, GCH_CHAIN = 68 * GCH_STEP, WS_GDEC = WS_HP;
constexpr size_t G2_STEP = 24576, G2_CHAIN = 68 * G2_STEP;
constexpr size_t WS_GST = WS_YM + 56 * MiB;
constexpr size_t WS_GCS = WS_HP + 64 * 1024;
static_assert(32 * G2_CHAIN <= 56 * MiB && 32 * 68 * 16384 <= 40 * MiB, "gdn v2 buffers");
constexpr size_t WS_RKV = WS_YM + 96 * MiB;
constexpr size_t WS_RST = WS_HP + 1 * MiB;
static_assert(32 * GCH_CHAIN <= 144 * MiB, "gdn chunk data");
constexpr size_t PREP_RQ = 0, PREP_RK = (size_t)M * 256 * 2, PREP_SQ = (size_t)M * 512 * 2, PREP_SK = (size_t)M * 1024 * 2, PREP_GD = (size_t)M * 1152 * 2;
static_assert(PREP_GD + (size_t)M * 768 * 2 <= 64 * MiB, "prep");
static_assert((size_t)M * NP * 2 <= 94 * MiB && (size_t)MAXROWS * EF * 2 <= 260 * MiB, "r1");

constexpr int CW_TMO = 0, CW_BAR = 4096;

__device__ __forceinline__ float bf2f(bf16 v) { return __uint_as_float(((unsigned)v) << 16); }
__device__ __forceinline__ unsigned f2bf(float f) { unsigned u = __float_as_uint(f); return (u + 0x7fffu + ((u >> 16) & 1u)) >> 16; }
__device__ __forceinline__ unsigned pk2(float lo, float hi) { return f2bf(lo) | (f2bf(hi) << 16); }
template <int CTRL> __device__ __forceinline__ float dppf(float v) { return __int_as_float(__builtin_amdgcn_update_dpp(0, __float_as_int(v), CTRL, 0xF, 0xF, true)); }
__device__ __forceinline__ float row_sum16(float v) {
    v += dppf<0xB1>(v); v += dppf<0x4E>(v); v += dppf<0x141>(v); v += dppf<0x140>(v); return v; }
__device__ __forceinline__ float wave_sum(float v) {
    v = row_sum16(v);
    return __int_as_float(__builtin_amdgcn_readlane(__float_as_int(v), 0)) + __int_as_float(__builtin_amdgcn_readlane(__float_as_int(v), 16))
         + __int_as_float(__builtin_amdgcn_readlane(__float_as_int(v), 32)) + __int_as_float(__builtin_amdgcn_readlane(__float_as_int(v), 48)); }
__device__ __forceinline__ float quad_rows_sum(float v) {
    u32x2 r = __builtin_amdgcn_permlane16_swap(__float_as_uint(v), __float_as_uint(v), false, false); v = __uint_as_float(r.x) + __uint_as_float(r.y);
    r = __builtin_amdgcn_permlane32_swap(__float_as_uint(v), __float_as_uint(v), false, false); return __uint_as_float(r.x) + __uint_as_float(r.y); }
__device__ __forceinline__ float quad_rows_max(float v) {
    u32x2 r = __builtin_amdgcn_permlane16_swap(__float_as_uint(v), __float_as_uint(v), false, false); v = fmaxf(__uint_as_float(r.x), __uint_as_float(r.y));
    r = __builtin_amdgcn_permlane32_swap(__float_as_uint(v), __float_as_uint(v), false, false); return fmaxf(__uint_as_float(r.x), __uint_as_float(r.y)); }
__device__ __forceinline__ float fexp2(float x) { return __builtin_amdgcn_exp2f(x); }
__device__ __forceinline__ float fexp(float x) { return __builtin_amdgcn_exp2f(x * 1.4426950408889634f); }
__device__ __forceinline__ float siluf(float x) { return x * __builtin_amdgcn_rcpf(1.0f + fexp(-x)); }
#define LDS_WAIT() asm volatile("s_waitcnt lgkmcnt(0)" ::: "memory")
__device__ __forceinline__ f32x4 mfma16(bf16x8 a, bf16x8 b, f32x4 c) { return __builtin_amdgcn_mfma_f32_16x16x32_bf16(a, b, c, 0, 0, 0); }
__device__ __forceinline__ unsigned cvtpk(float lo, float hi) { unsigned r; asm volatile("v_cvt_pk_bf16_f32 %0, %1, %2" : "=v"(r) : "v"(lo), "v"(hi)); return r; }


namespace pg8 {
#define PG8_LAS __attribute__((address_space(3)))
constexpr int BM = 256, BK = 64, HALF = 128, HTB = HALF * BK * 2, STAGE_BYTES = 8 * HTB;
__host__ __device__ __forceinline__ int lds_byte(int r, int c) { const int st = (r >> 4) * 2 + (c >> 5), rr = r & 15, cc = c & 31, ob = rr * 64 + cc * 2; return st * 1024 + (ob ^ (((ob >> 9) & 1) << 5)); }
__host__ __device__ __forceinline__ void stage_rc(int b, int& R, int& C) { const int st = b / 1024, sb = b % 1024, swz = sb ^ (((sb >> 9) & 1) << 5); R = (st >> 1) * 16 + swz / 64; C = (st & 1) * 32 + (swz % 64) / 2; }
__host__ __device__ __forceinline__ int perm32(int rho) { const int n = rho >> 4, i = rho & 15; return 8 * (i >> 2) + 4 * n + (i & 3); }
struct Unit { int pm, pn, aux; const char* A; const char* B; };
__device__ __forceinline__ unsigned cvt_pk_bf16(float lo, float hi) { unsigned r; asm volatile("v_cvt_pk_bf16_f32 %0, %1, %2" : "=v"(r) : "v"(lo), "v"(hi)); return r; }

template <int K, int LD, class Epi, class Sched, bool ALIGN_EPI = true, bool SP2 = true>
__device__ __forceinline__ void gemm_phase(PG8_LAS unsigned char* lds, const Sched& S, const Epi& E, const int tid) {
    const int wid = __builtin_amdgcn_readfirstlane(tid >> 6), lane = tid & 63, wr = wid >> 2, wc = wid & 3, fr = lane & 15, fq = lane >> 4;
    constexpr int nt = K / BK;
    unsigned voffA[2], voffB[2];
#pragma unroll
    for (int i = 0; i < 2; ++i) { int R, C; stage_rc(tid * 16 + i * 8192, R, C); const int Rb = Epi::PERM ? ((R & ~31) + perm32(R & 31)) : R;
        voffA[i] = (unsigned)(R * LD + C) * 2u; voffB[i] = (unsigned)(Rb * LD + C) * 2u; }
    constexpr size_t kstep = (size_t)(BK * 2);
    constexpr size_t hstep = (size_t)HALF * LD * 2;
    const unsigned ldsw = (unsigned)wid * 1024u;
    const int aoff = lds_byte(wr * 64 + fr, fq * 8), boff = lds_byte(wc * 32 + fr, fq * 8);
#define PG8_SA(b, h) (((b) * 2 + (h)) * HTB)
#define PG8_SB(b, h) ((4 + (b) * 2 + (h)) * HTB)
#define PG8_STAGE(bufoff, gbase, voff) do { _Pragma("unroll") for (int _i = 0; _i < 2; ++_i) \
        __builtin_amdgcn_global_load_lds((const unsigned*)((const char*)(gbase) + (voff)[_i]), (PG8_LAS unsigned*)(lds + (bufoff) + ldsw + _i * 8192), 16, 0, 0); } while (0)
#define PG8_LDA(dst, b, h) do { _Pragma("unroll") for (int m = 0; m < 4; ++m) _Pragma("unroll") for (int k = 0; k < 2; ++k) dst[m][k] = *(const PG8_LAS bf16x8*)(lds + PG8_SA(b, h) + aoff + m * 2048 + k * 1024); } while (0)
#define PG8_LDB(dst, b, h) do { _Pragma("unroll") for (int n = 0; n < 2; ++n) _Pragma("unroll") for (int k = 0; k < 2; ++k) dst[n][k] = *(const PG8_LAS bf16x8*)(lds + PG8_SB(b, h) + boff + n * 2048 + k * 1024); } while (0)
#define PG8_MMA(ai, bj, At, Bt) do { __builtin_amdgcn_s_setprio(1); _Pragma("unroll") for (int m = 0; m < 4; ++m) _Pragma("unroll") for (int n = 0; n < 2; ++n) _Pragma("unroll") for (int k = 0; k < 2; ++k) \
        acc[ai][bj][m][n] = __builtin_amdgcn_mfma_f32_16x16x32_bf16(Bt[n][k], At[m][k], acc[ai][bj][m][n], 0, 0, 0); __builtin_amdgcn_s_setprio(0); } while (0)
#define PG8_WAIT_V(n) asm volatile("s_waitcnt vmcnt(" #n ")" ::: "memory")
#define PG8_WAIT_L(n) asm volatile("s_waitcnt lgkmcnt(" #n ")" ::: "memory")
#define PG8_BAR __builtin_amdgcn_s_barrier()
#define PG8_SCHED __builtin_amdgcn_sched_barrier(0)
    Unit cur, nxt; int ui = 0;
    if (!S.next(0, cur)) return;
    f32x4 acc[2][2][4][2];
#pragma unroll
    for (int a = 0; a < 2; ++a)
#pragma unroll
        for (int b = 0; b < 2; ++b)
#pragma unroll
            for (int m = 0; m < 4; ++m)
#pragma unroll
                for (int n = 0; n < 2; ++n) acc[a][b][m][n] = (f32x4){0.f, 0.f, 0.f, 0.f};
    bf16x8 At[4][2], B0[2][2], B1[2][2];
    const char* cA = cur.A; const char* cB = cur.B;
    if constexpr (SP2) {
        PG8_STAGE(PG8_SB(0, 0), cB, voffB); PG8_STAGE(PG8_SB(0, 1), cB + hstep, voffB); PG8_STAGE(PG8_SA(0, 0), cA, voffA); PG8_STAGE(PG8_SA(0, 1), cA + hstep, voffA);
        if (wr == 1) PG8_BAR;
        PG8_WAIT_V(2); PG8_BAR;
        PG8_STAGE(PG8_SB(1, 0), cB + kstep, voffB); PG8_STAGE(PG8_SA(1, 0), cA + kstep, voffA); PG8_STAGE(PG8_SB(1, 1), cB + hstep + kstep, voffB);
        PG8_WAIT_V(6); PG8_BAR;
    } else {
        PG8_STAGE(PG8_SB(0, 0), cB, voffB); PG8_STAGE(PG8_SA(0, 0), cA, voffA); PG8_STAGE(PG8_SB(0, 1), cB + hstep, voffB); PG8_STAGE(PG8_SA(0, 1), cA + hstep, voffA);
        if (wr == 1) PG8_BAR;
        PG8_WAIT_V(4); PG8_BAR;
        PG8_STAGE(PG8_SB(1, 0), cB + kstep, voffB); PG8_STAGE(PG8_SA(1, 0), cA + kstep, voffA); PG8_STAGE(PG8_SB(1, 1), cB + hstep + kstep, voffB);
        PG8_WAIT_V(6); PG8_BAR;
    }
    for (;;) {
        const bool has_next = S.next(ui + 1, nxt);
        const char* nA = has_next ? nxt.A : cA; const char* nB = has_next ? nxt.B : cB;
        for (int t = 0; t < nt; t += 2) {
            const bool last = (t == nt - 2);
            const char* a1 = cA + (size_t)(t + 1) * kstep;
            const char* a2 = last ? nA : cA + (size_t)(t + 2) * kstep; const char* b2 = last ? nB : cB + (size_t)(t + 2) * kstep;
            const char* a3 = a2 + kstep; const char* b3 = b2 + kstep;
            if constexpr (SP2) {
            PG8_LDB(B0, 0, 0); PG8_LDB(B1, 0, 1); PG8_SCHED; PG8_LDA(At, 0, 0); PG8_STAGE(PG8_SA(1, 1), a1 + hstep, voffA);
            PG8_WAIT_V(8); PG8_WAIT_L(0); PG8_BAR; PG8_MMA(0, 0, At, B0); PG8_MMA(0, 1, At, B1); PG8_BAR; PG8_SCHED;
            PG8_LDA(At, 0, 1); PG8_STAGE(PG8_SB(0, 0), b2, voffB); PG8_STAGE(PG8_SB(0, 1), b2 + hstep, voffB); PG8_STAGE(PG8_SA(0, 0), a2, voffA);
            PG8_WAIT_V(8); PG8_WAIT_L(0); PG8_BAR; PG8_MMA(1, 0, At, B0); PG8_MMA(1, 1, At, B1); PG8_BAR; PG8_SCHED;
            PG8_LDB(B0, 1, 0); PG8_LDB(B1, 1, 1); PG8_SCHED; PG8_LDA(At, 1, 0); PG8_STAGE(PG8_SA(0, 1), a2 + hstep, voffA);
            PG8_WAIT_V(8); PG8_WAIT_L(0); PG8_BAR; PG8_MMA(0, 0, At, B0); PG8_MMA(0, 1, At, B1); PG8_BAR; PG8_SCHED;
            PG8_LDA(At, 1, 1); PG8_STAGE(PG8_SB(1, 0), b3, voffB); PG8_STAGE(PG8_SB(1, 1), b3 + hstep, voffB); PG8_STAGE(PG8_SA(1, 0), a3, voffA);
            PG8_WAIT_V(8); PG8_WAIT_L(0); PG8_BAR; PG8_MMA(1, 0, At, B0); PG8_MMA(1, 1, At, B1); PG8_BAR; PG8_SCHED;
            } else {
            PG8_LDB(B0, 0, 0); PG8_SCHED; PG8_LDA(At, 0, 0); PG8_STAGE(PG8_SA(1, 1), a1 + hstep, voffA);
            PG8_WAIT_L(8); PG8_BAR; PG8_WAIT_L(0); PG8_MMA(0, 0, At, B0); PG8_BAR; PG8_SCHED;
            PG8_LDB(B1, 0, 1); PG8_STAGE(PG8_SB(0, 0), b2, voffB);
            PG8_BAR; PG8_WAIT_L(0); PG8_MMA(0, 1, At, B1); PG8_BAR;
            PG8_LDA(At, 0, 1); PG8_STAGE(PG8_SA(0, 0), a2, voffA);
            PG8_BAR; PG8_WAIT_L(0); PG8_MMA(1, 0, At, B0); PG8_BAR; PG8_SCHED;
            PG8_STAGE(PG8_SB(0, 1), b2 + hstep, voffB);
            PG8_WAIT_V(6); PG8_BAR; PG8_MMA(1, 1, At, B1); PG8_BAR;
            PG8_LDB(B0, 1, 0); PG8_SCHED; PG8_LDA(At, 1, 0); PG8_STAGE(PG8_SA(0, 1), a2 + hstep, voffA);
            PG8_WAIT_L(8); PG8_BAR; PG8_WAIT_L(0); PG8_MMA(0, 0, At, B0); PG8_BAR; PG8_SCHED;
            PG8_LDB(B1, 1, 1); PG8_STAGE(PG8_SB(1, 0), b3, voffB);
            PG8_BAR; PG8_WAIT_L(0); PG8_MMA(0, 1, At, B1); PG8_BAR;
            PG8_LDA(At, 1, 1); PG8_STAGE(PG8_SA(1, 0), a3, voffA);
            PG8_BAR; PG8_WAIT_L(0); PG8_MMA(1, 0, At, B0); PG8_BAR; PG8_SCHED;
            PG8_STAGE(PG8_SB(1, 1), b3 + hstep, voffB);
            PG8_WAIT_V(6); PG8_BAR; PG8_MMA(1, 1, At, B1); PG8_BAR;
            }
        }
        if constexpr (ALIGN_EPI) { if (wr == 0) PG8_BAR; }
        PG8_PB();
        E(acc, cur, wr, wc, fr, fq);
        PG8_PE();
        if (!has_next) break;
#pragma unroll
        for (int a = 0; a < 2; ++a)
#pragma unroll
            for (int b = 0; b < 2; ++b)
#pragma unroll
                for (int m = 0; m < 4; ++m)
#pragma unroll
                    for (int n = 0; n < 2; ++n) acc[a][b][m][n] = (f32x4){0.f, 0.f, 0.f, 0.f};
        cur = nxt; cA = nA; cB = nB; ++ui;
        if constexpr (ALIGN_EPI) { if (wr == 1) PG8_BAR; }
    }
    PG8_WAIT_V(0);
    if constexpr (!ALIGN_EPI) { if (wr == 0) PG8_BAR; }
    PG8_BAR;
#undef PG8_SA
#undef PG8_SB
#undef PG8_STAGE
#undef PG8_LDA
#undef PG8_LDB
#undef PG8_MMA
#undef PG8_WAIT_V
#undef PG8_WAIT_L
#undef PG8_BAR
#undef PG8_SCHED
}

struct StaticOrder {
    int nM, nN, nwg, G, c, pm_off; const char* A; const char* Bt; size_t tstep;
    __device__ void init(const void* A_, const void* Bt_, int M_, int N_, int K_, int G_, int c_, int pm_off_ = 0) { A = (const char*)A_; Bt = (const char*)Bt_; nM = M_ / BM; nN = N_ / BM; nwg = nM * nN; G = G_; c = c_; pm_off = pm_off_; tstep = (size_t)BM * K_ * 2; }
    __device__ bool next(int i, Unit& u) const {
        const long L = (long)i * G + c; if (L >= nwg) return false;
        int wgid = (int)L; { const int q = nwg / 8, r = nwg % 8, xcd = wgid % 8, off = wgid / 8; wgid = (xcd < r ? xcd * (q + 1) : r * (q + 1) + (xcd - r) * q) + off; }
        const int nig = 8 * nN, gid = wgid / nig, fm = gid * 8, gsz = (nM - fm) < 8 ? (nM - fm) : 8;
        u.pm = fm + ((wgid % nig) % gsz) + pm_off; u.pn = (wgid % nig) / gsz; u.aux = 0;
        u.A = A + (size_t)u.pm * tstep; u.B = Bt + (size_t)u.pn * tstep; return true;
    }
};
struct SplitOrder {
    int nks, nsub, G, c; const char* A; const char* Bt; size_t tstep;
    __device__ void init(const void* A_, const void* Bt_, int LD_, int nks_, int G_, int c_) { A = (const char*)A_; Bt = (const char*)Bt_; nks = nks_; nsub = 16 * nks_; G = G_; c = c_; tstep = (size_t)BM * LD_ * 2; }
    __device__ bool next(int i, Unit& u) const {
        const int L = i * G + c; if (L >= nsub) return false;
        const int ksl = L % nks, t = L / nks; u.pm = t >> 2; u.pn = t & 3; u.aux = ksl;
        u.A = A + (size_t)u.pm * tstep + (size_t)ksl * 512; u.B = Bt + (size_t)u.pn * tstep + (size_t)ksl * 512; return true;
    }
};
struct GroupedOrder {
    int nM, nN, nwg, G, c; const char* A; const char* Bt; size_t tstep, estep; const int* tile_e;
    __device__ void init(const void* A_, const void* Bt_, int ntiles, int N_, int K_, int G_, int c_, const int* te) { A = (const char*)A_; Bt = (const char*)Bt_; nM = ntiles; nN = N_ / BM; nwg = nM * nN; G = G_; c = c_; tstep = (size_t)BM * K_ * 2; estep = (size_t)N_ * K_ * 2; tile_e = te; }
    __device__ bool next(int i, Unit& u) const {
        const long L = (long)i * G + c; if (L >= nwg) return false;
        int wgid = (int)L; { const int q = nwg / 8, r = nwg % 8, xcd = wgid % 8, off = wgid / 8; wgid = (xcd < r ? xcd * (q + 1) : r * (q + 1) + (xcd - r) * q) + off; }
        const int nig = 8 * nN, gid = wgid / nig, fm = gid * 8, gsz = (nM - fm) < 8 ? (nM - fm) : 8;
        u.pm = fm + ((wgid % nig) % gsz); u.pn = (wgid % nig) / gsz; u.aux = __builtin_amdgcn_readfirstlane(tile_e[u.pm]);
        u.A = A + (size_t)u.pm * tstep; u.B = Bt + (size_t)u.aux * estep + (size_t)u.pn * tstep; return true;
    }
};

struct SplitGroupedOrder {
    int t0, nsub, G, c; const char* A; const char* Bt; size_t tstep, estep; const int* tile_e;
    __device__ void init(const void* A_, const void* Bt_, int t0_, int nt_, int G_, int c_, const int* te) { A = (const char*)A_; Bt = (const char*)Bt_; t0 = t0_; nsub = nt_ * 16; G = G_; c = c_; tstep = (size_t)BM * EF * 2; estep = (size_t)D * EF * 2; tile_e = te; }
    __device__ bool next(int i, Unit& u) const {
        const int L = i * G + c; if (L >= nsub) return false;
        const int ksl = L & 3, t = L >> 2; u.pm = t0 + (t >> 2); u.pn = t & 3; u.aux = ksl;
        const int e = __builtin_amdgcn_readfirstlane(tile_e[u.pm]);
        u.A = A + (size_t)u.pm * tstep + (size_t)ksl * 896 * 2; u.B = Bt + (size_t)e * estep + (size_t)u.pn * tstep + (size_t)ksl * 896 * 2; return true;
    }
};
struct EpiBf16 {
    static constexpr bool PERM = true;
    bf16* O; int ldc;
    __device__ __forceinline__ void operator()(const f32x4 (&acc)[2][2][4][2], const Unit& u, int wr, int wc, int fr, int fq) const {
        const int row0 = u.pm * BM + wr * 64 + fr, col0 = u.pn * BM + wc * 32 + 8 * fq;
#pragma unroll
        for (int ai = 0; ai < 2; ++ai)
#pragma unroll
            for (int m = 0; m < 4; ++m) { bf16* rowp = O + (size_t)(row0 + ai * HALF + m * 16) * ldc + col0;
#pragma unroll
                for (int bj = 0; bj < 2; ++bj) { const f32x4 v0 = acc[ai][bj][m][0], v1 = acc[ai][bj][m][1];
                    u32x4 w; w.x = cvt_pk_bf16(v0[0], v0[1]); w.y = cvt_pk_bf16(v0[2], v0[3]); w.z = cvt_pk_bf16(v1[0], v1[1]); w.w = cvt_pk_bf16(v1[2], v1[3]);
                    *(u32x4*)(rowp + bj * HALF) = w; } }
    }
};
struct EpiResid {
    static constexpr bool PERM = false;
    float* X; const float* mod; int gsel; const float* Xsrc;
    __device__ __forceinline__ void operator()(const f32x4 (&acc)[2][2][4][2], const Unit& u, int wr, int wc, int fr, int fq) const {
        const int row0 = u.pm * BM + wr * 64 + fr, col0 = u.pn * BM + wc * 32 + 4 * fq;
        const int r = u.pm < 4 ? 4 : ((u.pm - 4) >> 4);
        const float* g = mod + (size_t)r * 6 * D + gsel * D;
        f32x4 gv[2][2];
#pragma unroll
        for (int bj = 0; bj < 2; ++bj)
#pragma unroll
            for (int n = 0; n < 2; ++n) gv[bj][n] = *(const f32x4*)(g + col0 + bj * HALF + n * 16);
#pragma unroll
        for (int ai = 0; ai < 2; ++ai)
#pragma unroll
            for (int m = 0; m < 4; ++m) { float* rowp = X + (size_t)(row0 + ai * HALF + m * 16) * D + col0; const float* srcp = Xsrc ? Xsrc + (size_t)(row0 + ai * HALF + m * 16 - MC) * D + col0 : rowp;
#pragma unroll
                for (int bj = 0; bj < 2; ++bj)
#pragma unroll
                    for (int n = 0; n < 2; ++n) { f32x4 x = *(const f32x4*)(srcp + bj * HALF + n * 16); x += gv[bj][n] * acc[ai][bj][m][n]; *(f32x4*)(rowp + bj * HALF + n * 16) = x; } }
    }
};
struct EpiSwiglu {
    static constexpr bool PERM = false;
    bf16* Hd; int ldh;
    __device__ __forceinline__ void operator()(const f32x4 (&acc)[2][2][4][2], const Unit& u, int wr, int wc, int fr, int fq) const {
        const int row0 = u.pm * BM + wr * 64 + fr, col0 = u.pn * 128 + wc * 16 + 4 * fq;
#pragma unroll
        for (int ai = 0; ai < 2; ++ai)
#pragma unroll
            for (int m = 0; m < 4; ++m) { bf16* rowp = Hd + (size_t)(row0 + ai * HALF + m * 16) * ldh + col0;
#pragma unroll
                for (int bj = 0; bj < 2; ++bj) { const f32x4 a = acc[ai][bj][m][0], b = acc[ai][bj][m][1];
                    float h[4];
#pragma unroll
                    for (int j = 0; j < 4; ++j) h[j] = a[j] * __builtin_amdgcn_rcpf(1.0f + __builtin_amdgcn_exp2f(-1.4426950408889634f * a[j])) * b[j];
                    u32x2 w; w.x = cvt_pk_bf16(h[0], h[1]); w.y = cvt_pk_bf16(h[2], h[3]);
                    *(u32x2*)(rowp + bj * 64) = w; } }
    }
};
struct EpiF32 {
    static constexpr bool PERM = false;
    float* C; int ldc;
    __device__ __forceinline__ void operator()(const f32x4 (&acc)[2][2][4][2], const Unit& u, int wr, int wc, int fr, int fq) const {
        const int row0 = u.pm * BM + wr * 64 + fr, col0 = u.pn * BM + wc * 32 + 4 * fq;
#pragma unroll
        for (int ai = 0; ai < 2; ++ai)
#pragma unroll
            for (int m = 0; m < 4; ++m) { float* rowp = C + (size_t)(row0 + ai * HALF + m * 16) * ldc + col0;
#pragma unroll
                for (int bj = 0; bj < 2; ++bj)
#pragma unroll
                    for (int n = 0; n < 2; ++n) *(f32x4*)(rowp + bj * HALF + n * 16) = acc[ai][bj][m][n]; }
    }
};
struct EpiSlab {
    static constexpr bool PERM = false;
    float* C;
    __device__ __forceinline__ void operator()(const f32x4 (&acc)[2][2][4][2], const Unit& u, int wr, int wc, int fr, int fq) const {
        const int row0 = u.pm * BM + wr * 64 + fr, col0 = u.pn * BM + wc * 32 + 4 * fq;
        float* base = C + (size_t)u.aux * MC * D;
#pragma unroll
        for (int ai = 0; ai < 2; ++ai)
#pragma unroll
            for (int m = 0; m < 4; ++m) { float* rowp = base + (size_t)(row0 + ai * HALF + m * 16) * D + col0;
#pragma unroll
                for (int bj = 0; bj < 2; ++bj)
#pragma unroll
                    for (int n = 0; n < 2; ++n) *(f32x4*)(rowp + bj * HALF + n * 16) = acc[ai][bj][m][n]; }
    }
};
struct EpiYMSlab {
    static constexpr bool PERM = false;
    float* YMp; float* slab; int row0s;
    __device__ __forceinline__ void operator()(const f32x4 (&acc)[2][2][4][2], const Unit& u, int wr, int wc, int fr, int fq) const {
        const int row0 = u.pm * BM + wr * 64 + fr, col0 = u.pn * BM + wc * 32 + 4 * fq;
        float* base = slab + ((size_t)u.aux * 4096 + (row0 - row0s)) * D;
#pragma unroll
        for (int ai = 0; ai < 2; ++ai)
#pragma unroll
            for (int m = 0; m < 4; ++m) { float* rowp = base + (size_t)(ai * HALF + m * 16) * D + col0;
#pragma unroll
                for (int bj = 0; bj < 2; ++bj)
#pragma unroll
                    for (int n = 0; n < 2; ++n) *(f32x4*)(rowp + bj * HALF + n * 16) = acc[ai][bj][m][n]; }
    }
};
}

#define XB_TMO      128
#define XB_XCNT(j)  (256  + 64 * (j))
#define XB_XSUB(j)  (1280 + 64 * (j))
#define XB_XGEN(j)  (2304 + 64 * (j))
#define XB_TOP      3328
#define XB_TOPGEN   3392
#define XCD_BAR_WORDS 3456
#define XB_SPIN_CAP (1u << 22)
__device__ __forceinline__ unsigned xb_ld(unsigned* p)              { return __hip_atomic_load(p, __ATOMIC_RELAXED, __HIP_MEMORY_SCOPE_AGENT); }
__device__ __forceinline__ unsigned xb_add(unsigned* p, unsigned v) { return __hip_atomic_fetch_add(p, v, __ATOMIC_RELAXED, __HIP_MEMORY_SCOPE_AGENT); }
__device__ __forceinline__ unsigned xb_xcc_id() { return (unsigned)__builtin_amdgcn_s_getreg((3 << 11) | 20) & 0xFu; }
#define XB_SPIN(cond, bar) do { unsigned _sp = 0; while (cond) { __builtin_amdgcn_s_sleep(1); \
    if ((++_sp & 255u) == 0u) { if (xb_ld(&(bar)[XB_TMO])) break; if (_sp > XB_SPIN_CAP) { atomicAdd(&(bar)[XB_TMO], 1u); break; } } } } while (0)
struct XcdBarrier { unsigned* bar; unsigned x; volatile LAS unsigned* st; int w0; };
__device__ __forceinline__ bool xb_leader(int w0) { return w0 == 0 && __builtin_amdgcn_mbcnt_hi(~0u, __builtin_amdgcn_mbcnt_lo(~0u, 0u)) == 0u; }
__device__ __forceinline__ XcdBarrier xcd_barrier_post(unsigned* bar, volatile LAS unsigned* st) {
    XcdBarrier b; b.bar = bar; b.x = xb_xcc_id(); b.st = st; b.w0 = __builtin_amdgcn_readfirstlane(threadIdx.x >> 6);
    if (xb_leader(b.w0)) (void)xb_add(&bar[XB_XCNT(b.x)], 1u);
    return b;
}
__device__ __forceinline__ void xcd_barrier_complete(unsigned* bar, unsigned x, unsigned& nloc, unsigned& nx) {
    const unsigned G = gridDim.x * gridDim.y * gridDim.z;
    unsigned sum, cnt, mine, sp = 0u;
    for (;;) {
        sum = 0u; cnt = 0u; mine = 0u;
#pragma unroll
        for (unsigned j = 0; j < 16; ++j) { const unsigned c = xb_ld(&bar[XB_XCNT(j)]); sum += c; cnt += (c > 0u) ? 1u : 0u; mine = (j == x) ? c : mine; }
        if (sum == G) break;
        __builtin_amdgcn_s_sleep(1);
        if ((++sp & 255u) == 0u) { if (xb_ld(&bar[XB_TMO])) break; if (sp > XB_SPIN_CAP) { atomicAdd(&bar[XB_TMO], 1u); break; } }
    }
    nloc = mine > 0u ? mine : 1u; nx = cnt > 0u ? cnt : 1u;
}
__device__ __forceinline__ void xcd_barrier(const XcdBarrier& b) {
    asm volatile("s_waitcnt vmcnt(0)" ::: "memory");
    __syncthreads();
    if (xb_leader(b.w0)) {
        unsigned* bar = b.bar; unsigned bx = b.x;
        asm volatile("" : "+s"(bar), "+s"(bx));
        __builtin_amdgcn_s_waitcnt(0);
        unsigned nloc = b.st[0], nx = b.st[1];
        if (nloc == 0u) { xcd_barrier_complete(bar, bx, nloc, nx); b.st[0] = nloc; b.st[1] = nx; }
        const unsigned old = xb_add(&bar[XB_XSUB(bx)], 1u);
        const unsigned gen = old / nloc;
        if (old + 1u == (gen + 1u) * nloc) {
            __builtin_amdgcn_fence(__ATOMIC_RELEASE, "agent");
            asm volatile("s_waitcnt vmcnt(0)" ::: "memory");
            const unsigned og = xb_add(&bar[XB_TOP], 1u);
            const unsigned tg = og / nx;
            if (og + 1u == (tg + 1u) * nx) xb_add(&bar[XB_TOPGEN], 1u);
            else XB_SPIN(xb_ld(&bar[XB_TOPGEN]) == tg, bar);
            __builtin_amdgcn_fence(__ATOMIC_ACQUIRE, "agent");
            xb_add(&bar[XB_XGEN(bx)], 1u);
            asm volatile("s_waitcnt vmcnt(0)" ::: "memory");
        } else {
            XB_SPIN(xb_ld(&bar[XB_XGEN(bx)]) == gen, bar);
            __builtin_amdgcn_fence(__ATOMIC_ACQUIRE, "agent");
            asm volatile("s_waitcnt vmcnt(0)" ::: "memory");
        }
    }
    __syncthreads();
}

constexpr int NWAVES = 8, NTHR = 512;
constexpr int RING_BYTES = 131072, MISC_OFF = RING_BYTES + 320, LDS_BYTES = 147456;

struct Inputs {
    const float *x, *c, *ctx, *c_ctx, *ada_w, *ada_b, *norm1_g, *w_in, *ret_decay, *ret_gn_g, *gdn_conv_w, *gdn_a_log, *gdn_dt_bias, *gdn_norm_g, *swa_sink, *w_out, *norm2_g,
        *ffn_w1, *ffn_w3, *ffn_w2, *router_w, *moe_w1, *moe_w3, *moe_w2, *final_g;
};
struct Args { Inputs in; float* out; unsigned char* ws; int ph_lo, ph_hi; };
static_assert(sizeof(Args) == 25 * 8 + 8 + 8 + 8, "no padding");


__device__ __forceinline__ const float* ld_ptr(const LAS unsigned long long* t, int i) { const unsigned long long v = t[i]; const unsigned lo = __builtin_amdgcn_readfirstlane((unsigned)v), hi = __builtin_amdgcn_readfirstlane((unsigned)(v >> 32)); return (const float*)(GAS const float*)(((unsigned long long)hi << 32) | lo); }
__device__ __forceinline__ Inputs load_inputs(const LAS unsigned long long* t) {
    Inputs in; const float** ip = (const float**)&in;
#pragma unroll
    for (int i = 0; i < 25; ++i) ip[i] = ld_ptr(t, i);
    return in;
}
struct Frame {
    LAS unsigned char* lds;
    int tid, lane, wave, G, gw, NGW, bid;
    unsigned char* ws;
};


constexpr int CW_DYN = 8192;
struct DynQ { unsigned* ctr; volatile LAS int* slot; bool lead; };
__device__ __forceinline__ DynQ dyn_make(Frame& F, int layer, int k) { DynQ q; q.ctr = (unsigned*)(F.ws + WS_CTL) + CW_DYN + (layer * 8 + k) * 64; q.slot = (volatile LAS int*)(F.lds + MISC_OFF + 64); q.lead = F.wave == 0 && F.lane == 0; return q; }
__device__ __forceinline__ int dyn_grab(const DynQ& q) { return q.lead ? (int)__hip_atomic_fetch_add(q.ctr, 1u, __ATOMIC_RELAXED, __HIP_MEMORY_SCOPE_AGENT) : 0; }
__device__ __forceinline__ int dyn_bcast(const DynQ& q, int v) { __syncthreads(); if (q.lead) q.slot[0] = v; __syncthreads(); return __builtin_amdgcn_readfirstlane(q.slot[0]); }


constexpr int CW_RSYNC = 12288;
__device__ __forceinline__ void rsync_publish(Frame& F, int layer) {
    asm volatile("s_waitcnt vmcnt(0)" ::: "memory");
    __syncthreads();
    if (F.wave == 0 && F.lane == 0) { __builtin_amdgcn_fence(__ATOMIC_RELEASE, "agent"); asm volatile("s_waitcnt vmcnt(0)" ::: "memory");
        (void)xb_add((unsigned*)(F.ws + WS_CTL) + CW_RSYNC + layer * 64, 1u); }
}
__device__ __forceinline__ void rsync_wait(Frame& F, int layer, unsigned want) {
    if (F.wave == 0 && F.lane == 0) { unsigned* w = (unsigned*)(F.ws + WS_CTL) + CW_RSYNC + layer * 64; unsigned* tmo = (unsigned*)(F.ws + WS_CTL) + CW_BAR + XB_TMO;
        unsigned sp = 0; while (xb_ld(w) < want) { __builtin_amdgcn_s_sleep(2); if ((++sp & 255u) == 0u) { if (xb_ld(tmo)) break; if (sp > XB_SPIN_CAP) { atomicAdd(tmo, 1u); break; } } }
        __builtin_amdgcn_fence(__ATOMIC_ACQUIRE, "agent"); asm volatile("s_waitcnt vmcnt(0)" ::: "memory"); }
    __syncthreads();
}

template <class SrcF>
__device__ __forceinline__ void transpose_item(const SrcF& src, int K, bf16* WT, LAS float* scr, int k0, int n0, int lane) {
#pragma unroll
    for (int i = 0; i < 8; ++i) { const int row = 4 * i + (lane >> 4), col = 4 * (lane & 15); *(LAS f32x4*)(scr + row * 68 + col) = src(k0 + row, n0 + col); }
    LDS_WAIT(); asm volatile("" ::: "memory");
#pragma unroll
    for (int j = 0; j < 4; ++j) { const int ch = j * 64 + lane, n = ch >> 2, c8 = ch & 3; const LAS float* sp = scr + (8 * c8) * 68 + n;
        u32x4 o; o.x = cvtpk(sp[0 * 68], sp[1 * 68]); o.y = cvtpk(sp[2 * 68], sp[3 * 68]); o.z = cvtpk(sp[4 * 68], sp[5 * 68]); o.w = cvtpk(sp[6 * 68], sp[7 * 68]);
        *(u32x4*)(WT + (size_t)(n0 + n) * K + k0 + 8 * c8) = o; }
    LDS_WAIT(); asm volatile("" ::: "memory");
}
struct SrcPlain { const float* W; int ld; __device__ __forceinline__ f32x4 operator()(int k, int n) const { return *(const f32x4*)(W + (size_t)k * ld + n); } };
struct SrcWin { const float* W; __device__ __forceinline__ f32x4 operator()(int k, int n) const { return *(const f32x4*)(W + (size_t)k * INC + (n < 2048 ? n : n + 16)); } };
struct SrcGU { const float* W1; const float* W3; int ld; __device__ __forceinline__ f32x4 operator()(int k, int n) const { const int g = n >> 5, i = n & 31; const ptrdiff_t d = (i < 16) ? (ptrdiff_t)0 : (W3 - W1); return *(const f32x4*)(W1 + d + (ptrdiff_t)k * ld + 16 * g + (i & 15)); } };

__device__ __forceinline__ void convert_moe_layer(Frame& F, const Inputs& in, int mi, int part, int nwg) {
    LAS float* scr = (LAS float*)(F.lds + F.wave * 16384);
    bf16* mw13 = (bf16*)(F.ws + WS_MW13); bf16* mw2 = (bf16*)(F.ws + WS_MW2);
    constexpr int I13 = (D / 32) * (2 * EF / 64), I2 = (EF / 32) * (D / 64);
    if (F.bid >= nwg) return;
    constexpr int NIT = NE * (I13 + I2);
    const int lane = F.lane, lr = lane >> 4, lc = 4 * (lane & 15);
    const int it_end = (part + 1) * (NIT / 2), step = nwg * NWAVES;
    int it = part * (NIT / 2) + F.gw;
    const float* sp = nullptr; int ld = 0; bf16* dp = nullptr; int dK = 0;
#define CV_DESC(itv, SP, LDv, DP, DK) do { const int e_ = (itv) / (I13 + I2); int r_ = (itv) % (I13 + I2); const size_t wo_ = ((size_t)mi * NE + e_) * (size_t)D * EF; \
        if (r_ < I13) { const int nb_ = 2 * EF / 64, k0_ = 32 * (r_ / nb_), n0_ = 64 * (r_ % nb_), n_ = n0_ + lc, g_ = n_ >> 5, i_ = n_ & 31; \
            SP = (i_ < 16 ? in.moe_w1 : in.moe_w3) + wo_ + (size_t)(k0_ + lr) * EF + 16 * g_ + (i_ & 15); LDv = EF; DP = mw13 + (size_t)e_ * 2 * EF * D + (size_t)n0_ * D + k0_; DK = D; } \
        else { r_ -= I13; const int nb_ = D / 64, k0_ = 32 * (r_ / nb_), n0_ = 64 * (r_ % nb_); \
            SP = in.moe_w2 + wo_ + (size_t)(k0_ + lr) * D + n0_ + lc; LDv = D; DP = mw2 + (size_t)e_ * D * EF + (size_t)n0_ * EF + k0_; DK = EF; } } while (0)
    f32x4 rc[8];
    if (it < it_end) { CV_DESC(it, sp, ld, dp, dK);
#pragma unroll
        for (int i = 0; i < 8; ++i) rc[i] = *(const f32x4*)(sp + (size_t)(4 * i) * ld); }
    while (it < it_end) {
        const int itn = it + step; const bool hasn = itn < it_end;
        const float* spn = sp; int ldn = ld; bf16* dpn = dp; int dKn = dK;
        if (hasn) CV_DESC(itn, spn, ldn, dpn, dKn);
#pragma unroll
        for (int i = 0; i < 8; ++i) *(LAS f32x4*)(scr + (4 * i + lr) * 68 + lc) = rc[i];
        f32x4 rn[8];
#pragma unroll
        for (int i = 0; i < 8; ++i) rn[i] = *(const f32x4*)(spn + (size_t)(4 * i) * ldn);
        LDS_WAIT(); asm volatile("" ::: "memory");
#pragma unroll
        for (int j = 0; j < 4; ++j) { const int ch = j * 64 + lane, n = ch >> 2, c8 = ch & 3; const LAS float* q = scr + (8 * c8) * 68 + n;
            u32x4 o; o.x = cvtpk(q[0 * 68], q[1 * 68]); o.y = cvtpk(q[2 * 68], q[3 * 68]); o.z = cvtpk(q[4 * 68], q[5 * 68]); o.w = cvtpk(q[6 * 68], q[7 * 68]);
            *(u32x4*)(dp + (size_t)n * dK + 8 * c8) = o; }
        LDS_WAIT(); asm volatile("" ::: "memory");
        it = itn; sp = spn; ld = ldn; dp = dpn; dK = dKn;
#pragma unroll
        for (int i = 0; i < 8; ++i) rc[i] = rn[i];
    }
#undef CV_DESC
}
__device__ __forceinline__ void phase_prologue(Frame& F, const Inputs& in) {
    LAS float* scr = (LAS float*)(F.lds + F.wave * 16384);
    {
        constexpr int I_IN = (D / 32) * (NP / 64), I_OUT = (D / 32) * (D / 64), I_13 = (D / 32) * (2 * FF / 64), I_2 = (FF / 32) * (D / 64);
        constexpr int PER_L = I_IN + I_OUT, PER_F = I_13 + I_2, TOT = DEPTH * PER_L + 2 * PER_F;
        const int lane = F.lane, lr = lane >> 4, lc = 4 * (lane & 15);
        const float* sp = nullptr; int ld = 0; bf16* dp = nullptr; int dK = 0;
#define PD_DESC(itv, SP, LDv, DP, DK) do { if ((itv) < DEPTH * PER_L) { const int l_ = (itv) / PER_L; int r_ = (itv) % PER_L; \
            if (r_ < I_IN) { const int nb_ = NP / 64, k0_ = 32 * (r_ / nb_), n0_ = 64 * (r_ % nb_), n_ = n0_ + lc; \
                SP = in.w_in + (size_t)l_ * D * INC + (size_t)(k0_ + lr) * INC + (n_ < 2048 ? n_ : n_ + 16); LDv = INC; DP = (bf16*)(F.ws + WS_WIN) + (size_t)l_ * NP * D + (size_t)n0_ * D + k0_; DK = D; } \
            else { r_ -= I_IN; const int nb_ = D / 64, k0_ = 32 * (r_ / nb_), n0_ = 64 * (r_ % nb_); \
                SP = in.w_out + (size_t)l_ * D * D + (size_t)(k0_ + lr) * D + n0_ + lc; LDv = D; DP = (bf16*)(F.ws + WS_WOUT) + (size_t)l_ * D * D + (size_t)n0_ * D + k0_; DK = D; } } \
        else { const int q_ = (itv) - DEPTH * PER_L, i_ = q_ / PER_F; int r_ = q_ % PER_F; \
            if (r_ < I_13) { const int nb_ = 2 * FF / 64, k0_ = 32 * (r_ / nb_), n0_ = 64 * (r_ % nb_), n_ = n0_ + lc, g_ = n_ >> 5, j_ = n_ & 31; \
                SP = (j_ < 16 ? in.ffn_w1 : in.ffn_w3) + (size_t)i_ * D * FF + (size_t)(k0_ + lr) * FF + 16 * g_ + (j_ & 15); LDv = FF; DP = (bf16*)(F.ws + WS_W13) + (size_t)i_ * 2 * FF * D + (size_t)n0_ * D + k0_; DK = D; } \
            else { r_ -= I_13; const int nb_ = D / 64, k0_ = 32 * (r_ / nb_), n0_ = 64 * (r_ % nb_); \
                SP = in.ffn_w2 + (size_t)i_ * FF * D + (size_t)(k0_ + lr) * D + n0_ + lc; LDv = D; DP = (bf16*)(F.ws + WS_W2) + (size_t)i_ * D * FF + (size_t)n0_ * FF + k0_; DK = FF; } } } while (0)
        int it = F.gw; f32x4 rc[8];
        if (it < TOT) { PD_DESC(it, sp, ld, dp, dK);
#pragma unroll
            for (int i = 0; i < 8; ++i) rc[i] = *(const f32x4*)(sp + (size_t)(4 * i) * ld); }
        while (it < TOT) {
            const int itn = it + F.NGW; const bool hasn = itn < TOT;
            const float* spn = sp; int ldn = ld; bf16* dpn = dp; int dKn = dK;
            if (hasn) PD_DESC(itn, spn, ldn, dpn, dKn);
#pragma unroll
            for (int i = 0; i < 8; ++i) *(LAS f32x4*)(scr + (4 * i + lr) * 68 + lc) = rc[i];
            f32x4 rn[8];
#pragma unroll
            for (int i = 0; i < 8; ++i) rn[i] = *(const f32x4*)(spn + (size_t)(4 * i) * ldn);
            LDS_WAIT(); asm volatile("" ::: "memory");
#pragma unroll
            for (int j = 0; j < 4; ++j) { const int ch = j * 64 + lane, n = ch >> 2, c8 = ch & 3; const LAS float* q = scr + (8 * c8) * 68 + n;
                u32x4 o; o.x = cvtpk(q[0 * 68], q[1 * 68]); o.y = cvtpk(q[2 * 68], q[3 * 68]); o.z = cvtpk(q[4 * 68], q[5 * 68]); o.w = cvtpk(q[6 * 68], q[7 * 68]);
                *(u32x4*)(dp + (size_t)n * dK + 8 * c8) = o; }
            LDS_WAIT(); asm volatile("" ::: "memory");
            it = itn; sp = spn; ld = ldn; dp = dpn; dK = dKn;
#pragma unroll
            for (int i = 0; i < 8; ++i) rc[i] = rn[i];
        }
#undef PD_DESC
    }
    {
        __syncthreads();
        LAS float* sc = (LAS float*)F.lds;
        LAS float* red = (LAS float*)(F.lds + 32768);
        for (int i = F.tid; i < 5 * D; i += NTHR) { const int r = i / D, k = i % D; const float v = r < 4 ? in.c[r * D + k] : in.c_ctx[k]; sc[i] = siluf(v); }
        __syncthreads();
        float* mod = (float*)(F.ws + WS_MOD);
        for (int u = F.bid; u < DEPTH * 96; u += F.G) {
            const int l = u / 96, n = (u % 96) * 64 + F.lane;
            const float* w = in.ada_w + (size_t)l * D * 6 * D + n;
            float a[5] = {0.f, 0.f, 0.f, 0.f, 0.f};
            for (int k = F.wave * 128; k < F.wave * 128 + 128; ++k) { const float wv = w[(size_t)k * 6 * D];
#pragma unroll
                for (int r = 0; r < 5; ++r) a[r] += sc[r * D + k] * wv; }
#pragma unroll
            for (int r = 0; r < 5; ++r) red[(F.wave * 5 + r) * 64 + F.lane] = a[r];
            __syncthreads();
            if (F.tid < 320) { const int r = F.tid / 64, ln = F.tid % 64; float s = 0.f;
#pragma unroll
                for (int w8 = 0; w8 < 8; ++w8) s += red[(w8 * 5 + r) * 64 + ln];
                const int nn = (u % 96) * 64 + ln;
                mod[((size_t)l * 5 + r) * 6 * D + nn] = s + in.ada_b[(size_t)l * 6 * D + nn]; }
            __syncthreads();
        }
    }
    if (F.bid == 0) { float* rp = (float*)(F.ws + WS_ROPE);
        for (int i = F.tid; i < 64 * 16; i += NTHR) { const int pos = i / 16, fi = i % 16; const double inv = pow(10000.0, -(double)fi / 16.0), ang = (double)pos * inv; rp[2 * i] = (float)cos(ang); rp[2 * i + 1] = (float)sin(ang); } }
}

__device__ __forceinline__ int mod_row(int m) { return m < MC ? 4 : ((m - MC) >> 12); }


template <int MODE>
__device__ __forceinline__ void phase_token2(Frame& F, const Inputs& in, int layer, bool first_from_input, bool combine_moe, bool moe_router, float* out, int route_lo = 0, int nslab = 0) {
    float* XS = (float*)(F.ws + WS_XS);
    bf16* H = (bf16*)(F.ws + WS_H);
    const float* mod = (const float*)(F.ws + WS_MOD) + (size_t)(layer < DEPTH ? layer : DEPTH - 1) * 5 * 6 * D;
    const float* modprev = (const float*)(F.ws + WS_MOD) + (size_t)(layer > 0 ? layer - 1 : 0) * 5 * 6 * D;
    const float* TKG = (const float*)(F.ws + WS_TKG); const int* TOKROW = (const int*)(F.ws + WS_TOKROW);
    const bf16* YM = (const bf16*)(F.ws + WS_YM);
    LAS float* wl = (LAS float*)F.lds;
    const int lane = F.lane;
    if (MODE == 0) PB(8);
    if (MODE == 0) { __syncthreads(); const float* w = in.w_in + (size_t)layer * D * INC + 2048;
#pragma unroll
        for (int n = 0; n < 8; ++n) { const int k = (F.tid >> 2) + 128 * n, q4 = F.tid & 3, kp = ((k >> 8) * 4 + (k & 3)) * 64 + ((k >> 2) & 63);
            *(LAS f32x4*)(wl + (q4 * 1024 + kp) * 4) = *(const f32x4*)(w + (size_t)k * INC + 4 * q4); }
        __syncthreads(); }
    LAS int* lcnt = (LAS int*)(F.lds + 61440);
    if (MODE == 1 && moe_router) { __syncthreads(); if (F.tid < 8) lcnt[F.tid] = 0; const float* w = in.router_w + (size_t)(layer >> 1) * D * NE;
#pragma unroll
        for (int n = 0; n < 4; ++n) { const int k = (F.tid >> 1) + 256 * n, q4 = F.tid & 1, kp = ((k >> 8) * 4 + (k & 3)) * 64 + ((k >> 2) & 63);
            *(LAS f32x4*)(wl + (q4 * 1024 + kp) * 4) = *(const f32x4*)(w + (size_t)k * NE + 4 * q4); }
        __syncthreads(); }
    if (MODE == 0) PE(8);
    if (MODE == 0) PB(9);
    if (MODE == 1) PB(10);
    const float* gain = MODE == 0 ? in.norm1_g + (size_t)layer * D : (MODE == 1 ? in.norm2_g + (size_t)layer * D : in.final_g);
    const bool has_ctx = (MODE != 2) && F.gw < MC;
    const int r_beg = MC + (int)(((long)F.gw * ML) / F.NGW), r_end = MC + (int)(((long)(F.gw + 1) * ML) / F.NGW);
    if (nslab > 0 && has_ctx) {
        const float* sb = (const float*)(F.ws + WS_R1 + 100 * MiB); const float* gsrc = (MODE == 1 ? mod + (size_t)4 * 6 * D + 2 * D : modprev + (size_t)4 * 6 * D + 5 * D);
        { const int m = F.gw;
#pragma unroll
            for (int j = 0; j < 4; ++j) { f32x4 a0 = (f32x4){0.f, 0.f, 0.f, 0.f};
                for (int sidx = 0; sidx < nslab; ++sidx) a0 += *(const f32x4*)(sb + ((size_t)sidx * MC + m) * D + 4 * lane + 256 * j);
                float* xp = XS + (size_t)m * D + 4 * lane + 256 * j; *(f32x4*)xp = *(const f32x4*)xp + *(const f32x4*)(gsrc + 4 * lane + 256 * j) * a0; } }
        asm volatile("s_waitcnt vmcnt(0)" ::: "memory");
    }
    if (combine_moe) {
        const int ntl = ((const int*)(F.ws + WS_TILEE))[256]; const int srow = ((ntl - (ntl / 64) * 64 <= 16) ? (ntl / 64) * 64 : ntl) * 256; const float* sl = (const float*)(F.ws + WS_HP);
        bf16* YMw = (bf16*)(F.ws + WS_YM);
        for (int m0 = has_ctx ? r_beg - 1 : r_beg; m0 < r_end; ++m0) { const int m = m0 < r_beg ? F.gw : m0;
            if (MODE == 0 && layer == DEPTH && m < MC) continue;
#pragma unroll
            for (int k = 0; k < 2; ++k) { const int r = TOKROW[2 * m + k];
                if (r >= srow) { const size_t o = (size_t)(r - srow) * D;
#pragma unroll
                    for (int j = 0; j < 4; ++j) { const f32x4 y = ((*(const f32x4*)(sl + o + 4 * lane + 256 * j) + *(const f32x4*)(sl + (size_t)4096 * D + o + 4 * lane + 256 * j)) + *(const f32x4*)(sl + (size_t)8192 * D + o + 4 * lane + 256 * j)) + *(const f32x4*)(sl + (size_t)12288 * D + o + 4 * lane + 256 * j);
                        u32x2 wv; wv.x = cvtpk(y.x, y.y); wv.y = cvtpk(y.z, y.w); *(u32x2*)(YMw + (size_t)r * D + 4 * lane + 256 * j) = wv; } } } }
        asm volatile("s_waitcnt vmcnt(0)" ::: "memory");
    }
    f32x4 gv[4], av[4], bv[4], gt[4];
#pragma unroll
    for (int j = 0; j < 4; ++j) gv[j] = *(const f32x4*)(gain + 4 * lane + 256 * j);
    int rcur = -1;
    for (int m0 = has_ctx ? r_beg - 1 : r_beg; m0 < r_end; m0 += 2) {
        const bool isc = m0 < r_beg;
        const int ma = isc ? F.gw : m0; const bool two = !isc && ma + 1 < r_end; const int m1 = two ? ma + 1 : ma;
        if (isc) m0 -= 1;
        const int r = mod_row(ma);
        const bool same = mod_row(m1) == r;
        const int mm1 = same ? m1 : ma; const bool do1 = two && same;
        if (!same) m0 -= 1;
        if (r != rcur) { rcur = r;
            if (MODE != 2) { const float* sh = mod + (size_t)r * 6 * D + (MODE == 0 ? 0 : 3) * D;
#pragma unroll
                for (int j = 0; j < 4; ++j) { const f32x4 s1 = *(const f32x4*)(sh + D + 4 * lane + 256 * j); av[j] = gv[j] * (1.0f + s1); bv[j] = *(const f32x4*)(sh + 4 * lane + 256 * j); } }
            if (combine_moe) {
#pragma unroll
                for (int j = 0; j < 4; ++j) gt[j] = *(const f32x4*)(modprev + (size_t)r * 6 * D + 5 * D + 4 * lane + 256 * j); } }
        const int mr[2] = {ma, mm1};
        f32x4 v[2][4];
        int t0[2], t1[2]; float g0[2], g1[2];
        if (combine_moe) {
#pragma unroll
            for (int p = 0; p < 2; ++p) { t0[p] = TOKROW[2 * mr[p]]; t1[p] = TOKROW[2 * mr[p] + 1]; g0[p] = TKG[2 * mr[p]]; g1[p] = TKG[2 * mr[p] + 1]; } }
#pragma unroll
        for (int p = 0; p < 2; ++p) { const int m = mr[p];
            const float* xrow = first_from_input ? (m < MC ? in.ctx + (size_t)m * D : in.x + (size_t)(m - MC) * D) : XS + (size_t)m * D;
#pragma unroll
            for (int j = 0; j < 4; ++j) v[p][j] = *(const f32x4*)(xrow + 4 * lane + 256 * j); }
        if (combine_moe) {
#pragma unroll
            for (int p = 0; p < 2; ++p)
#pragma unroll
                for (int j = 0; j < 4; ++j) { const u32x2 a = *(const u32x2*)(YM + (size_t)t0[p] * D + 4 * lane + 256 * j), b = *(const u32x2*)(YM + (size_t)t1[p] * D + 4 * lane + 256 * j);
                    const f32x4 y0 = (f32x4){__uint_as_float(a.x << 16), __uint_as_float(a.x & 0xffff0000u), __uint_as_float(a.y << 16), __uint_as_float(a.y & 0xffff0000u)};
                    const f32x4 y1 = (f32x4){__uint_as_float(b.x << 16), __uint_as_float(b.x & 0xffff0000u), __uint_as_float(b.y << 16), __uint_as_float(b.y & 0xffff0000u)};
                    v[p][j] += gt[j] * (g0[p] * y0 + g1[p] * y1); } }
        if (((first_from_input && ma < MC) || combine_moe) && MODE != 2) {
#pragma unroll
            for (int p = 0; p < 2; ++p) if (p == 0 || do1) {
#pragma unroll
                for (int j = 0; j < 4; ++j) *(f32x4*)(XS + (size_t)mr[p] * D + 4 * lane + 256 * j) = v[p][j]; } }
        float rstd[2];
#pragma unroll
        for (int p = 0; p < 2; ++p) { float ss = 0.f;
#pragma unroll
            for (int j = 0; j < 4; ++j) ss += (v[p][j].x * v[p][j].x + v[p][j].y * v[p][j].y) + (v[p][j].z * v[p][j].z + v[p][j].w * v[p][j].w);
            rstd[p] = 1.0f / sqrtf(wave_sum(ss) * (1.0f / D) + EPS); }
        if (MODE == 2) {
#pragma unroll
            for (int p = 0; p < 2; ++p) if (p == 0 || do1) {
#pragma unroll
                for (int j = 0; j < 4; ++j) *(f32x4*)(out + (size_t)(mr[p] - MC) * D + 4 * lane + 256 * j) = v[p][j] * rstd[p] * gv[j]; }
            continue; }
        f32x4 h[2][4];
#pragma unroll
        for (int p = 0; p < 2; ++p)
#pragma unroll
            for (int j = 0; j < 4; ++j) { h[p][j] = v[p][j] * rstd[p] * av[j] + bv[j];
                if (p == 0 || do1) { u32x2 w; w.x = cvtpk(h[p][j].x, h[p][j].y); w.y = cvtpk(h[p][j].z, h[p][j].w); *(u32x2*)(H + (size_t)mr[p] * D + 4 * lane + 256 * j) = w; } }
        if (MODE == 0 || (MODE == 1 && moe_router)) {
            constexpr int NC = (MODE == 0) ? 16 : 8;
            float a[2][NC];
#pragma unroll
            for (int p = 0; p < 2; ++p)
#pragma unroll
                for (int c = 0; c < NC; ++c) a[p][c] = 0.f;
#pragma unroll
            for (int j = 0; j < 4; ++j)
#pragma unroll
                for (int e = 0; e < 4; ++e) { const int kp = (j * 4 + e) * 64 + lane;
#pragma unroll
                    for (int q = 0; q < NC / 4; ++q) { const f32x4 w = *(const LAS f32x4*)(wl + (q * 1024 + kp) * 4);
#pragma unroll
                        for (int p = 0; p < 2; ++p) { const float hv = h[p][j][e]; a[p][4 * q] += hv * w.x; a[p][4 * q + 1] += hv * w.y; a[p][4 * q + 2] += hv * w.z; a[p][4 * q + 3] += hv * w.w; } } }
#pragma unroll
            for (int p = 0; p < 2; ++p) {
#pragma unroll
                for (int c = 0; c < NC; ++c) a[p][c] = wave_sum(a[p][c]); }
#pragma unroll
            for (int p = 0; p < 2; ++p) if (p == 0 || do1) { const int m = mr[p];
                if (MODE == 0) { float mine = 0.f;
#pragma unroll
                    for (int c = 0; c < NC; ++c) mine = (lane == c) ? a[p][c] : mine;
                    if (lane < 16) ((float*)(F.ws + WS_AB))[(size_t)m * 16 + lane] = mine; }
                else { int i0 = 0; float l0 = a[p][0];
#pragma unroll
                    for (int c = 1; c < NC; ++c) if (a[p][c] > l0) { l0 = a[p][c]; i0 = c; }
                    int i1 = -1; float l1 = -3.0e38f;
#pragma unroll
                    for (int c = 0; c < NC; ++c) if (c != i0 && a[p][c] > l1) { l1 = a[p][c]; i1 = c; }
                    const float e1 = fexp(l1 - l0), gg0 = 1.0f / (1.0f + e1), gg1 = e1 / (1.0f + e1);
                    if (lane == 0 && m >= route_lo) { ((int*)(F.ws + WS_TKE))[2 * m] = i0; ((int*)(F.ws + WS_TKE))[2 * m + 1] = i1; ((float*)(F.ws + WS_TKG))[2 * m] = gg0; ((float*)(F.ws + WS_TKG))[2 * m + 1] = gg1;
                        ((int*)(F.ws + WS_TOKROW))[2 * m] = __hip_atomic_fetch_add(lcnt + i0, 1, __ATOMIC_RELAXED, __HIP_MEMORY_SCOPE_WORKGROUP); ((int*)(F.ws + WS_TOKROW))[2 * m + 1] = __hip_atomic_fetch_add(lcnt + i1, 1, __ATOMIC_RELAXED, __HIP_MEMORY_SCOPE_WORKGROUP); } } }
        }
    }
    if (MODE == 0) PE(9);
    if (MODE == 1) PE(10);
    if (MODE == 1 && moe_router) { __syncthreads(); if (F.tid < 8) ((int*)(F.ws + WS_TILEE + 4096))[F.bid * 8 + F.tid] = lcnt[F.tid]; }
}


__device__ __forceinline__ void unpack8(const u32x4 w, float (&v)[8]) {
#pragma unroll
    for (int e = 0; e < 4; ++e) { v[2 * e] = __uint_as_float(w[e] << 16); v[2 * e + 1] = __uint_as_float(w[e] & 0xffff0000u); } }
__device__ __forceinline__ u32x4 pack8(const float (&v)[8]) { u32x4 w; w.x = cvtpk(v[0], v[1]); w.y = cvtpk(v[2], v[3]); w.z = cvtpk(v[4], v[5]); w.w = cvtpk(v[6], v[7]); return w; }


__device__ __forceinline__ void phase_prep3(Frame& F, const Inputs& in, int layer) {
    const bf16* P = (const bf16*)(F.ws + WS_R1 + R1_P);
    unsigned char* prep = F.ws + WS_R1 + R1_PREP;
    bf16* RQ = (bf16*)(prep + PREP_RQ); bf16* RK = (bf16*)(prep + PREP_RK); bf16* SQ = (bf16*)(prep + PREP_SQ); bf16* SK = (bf16*)(prep + PREP_SK); bf16* GD = (bf16*)(prep + PREP_GD);
    const float* rope = (const float*)(F.ws + WS_ROPE);
    const float* AB = (const float*)(F.ws + WS_AB); float* GB = (float*)(F.ws + WS_GB);
    const float* cw = in.gdn_conv_w + (size_t)layer * 5 * 768;
    const int lane = F.lane, l3 = lane & 3, l31 = lane & 31;
    float wA[5][8], wB[5][8];
#pragma unroll
    for (int j = 0; j < 5; ++j) { const f32x4 a0 = *(const f32x4*)(cw + j * 768 + 8 * lane), a1 = *(const f32x4*)(cw + j * 768 + 8 * lane + 4), b0 = *(const f32x4*)(cw + j * 768 + 512 + 8 * l31), b1 = *(const f32x4*)(cw + j * 768 + 512 + 8 * l31 + 4);
#pragma unroll
        for (int x = 0; x < 4; ++x) { wA[j][x] = a0[x]; wA[j][4 + x] = a1[x]; wB[j][x] = b0[x]; wB[j][4 + x] = b1[x]; } }
    const float sgn = ((lane & 7) < 4) ? -1.0f : 1.0f;
    const bool isk = lane >= 32;
    const float dtb = in.gdn_dt_bias[layer * 8 + (lane & 7)], alg = -fexp(in.gdn_a_log[layer * 8 + (lane & 7)]);
    for (int mbase = F.gw; mbase < M; mbase += 2 * F.NGW) {
        const bool ok1 = mbase + F.NGW < M;
        const int mm[2] = {mbase, ok1 ? mbase + F.NGW : mbase};
        bool lat[2]; int tt0[2], Tn[2]; const bf16* prow[2];
#pragma unroll
        for (int p = 0; p < 2; ++p) { const int m = mm[p]; lat[p] = m >= MC; tt0[p] = lat[p] ? ((m - MC) & (TL - 1)) : (m & (TC - 1)); Tn[p] = lat[p] ? TL : TC; prow[p] = P + (size_t)m * NP; }
        f32x4 rt[2][4]; u32x4 u1[2], u2[2], u3[2];
#pragma unroll
        for (int p = 0; p < 2; ++p) { const int t = tt0[p]; const int pos = (l3 < 2) ? (t >> 6) : (t & 63); const float* rp = rope + (pos * 16 + 8 * (l3 & 1)) * 2;
            rt[p][0] = *(const f32x4*)(rp); rt[p][1] = *(const f32x4*)(rp + 4); rt[p][2] = *(const f32x4*)(rp + 8); rt[p][3] = *(const f32x4*)(rp + 12);
            u1[p] = *(const u32x4*)(prow[p] + (isk ? PC_RK : PC_RQ) + 8 * l31); u2[p] = *(const u32x4*)(prow[p] + PC_SQ + 8 * lane); u3[p] = *(const u32x4*)(prow[p] + PC_SK + 8 * (lane & 15)); }
        __builtin_amdgcn_sched_barrier(0);
#pragma unroll
        for (int p = 0; p < 2; ++p) { const int m = mm[p]; const bool st = (p == 0) || ok1;
            float cs[8], sn[8];
#pragma unroll
            for (int x = 0; x < 8; ++x) { cs[x] = rt[p][x >> 1][(x & 1) * 2]; sn[x] = rt[p][x >> 1][(x & 1) * 2 + 1]; if (!lat[p]) { cs[x] = 1.0f; sn[x] = 0.0f; } sn[x] *= sgn; }
            { float v[8], o[8]; unpack8(u1[p], v);
#pragma unroll
              for (int x = 0; x < 8; ++x) { if (isk) v[x] *= 0.125f; const float pv = __shfl_xor(v[x], 4); o[x] = v[x] * cs[x] + pv * sn[x]; }
              if (st) *(u32x4*)((isk ? RK : RQ) + (size_t)m * 256 + 8 * l31) = pack8(o); }
            { float v[8], o[8]; unpack8(u2[p], v);
#pragma unroll
              for (int x = 0; x < 8; ++x) { const float pv = __shfl_xor(v[x], 4); o[x] = v[x] * cs[x] + pv * sn[x]; }
              if (st) *(u32x4*)(SQ + (size_t)m * 512 + 8 * lane) = pack8(o); }
            { float v[8], o[8]; unpack8(u3[p], v);
#pragma unroll
              for (int x = 0; x < 8; ++x) { const float pv = __shfl_xor(v[x], 4); o[x] = v[x] * cs[x] + pv * sn[x]; }
              if (st && lane < 16) *(u32x4*)(SK + (size_t)m * 128 + 8 * lane) = pack8(o); } }
        { u32x4 ca[2][5];
#pragma unroll
          for (int p = 0; p < 2; ++p)
#pragma unroll
              for (int j = 0; j < 5; ++j) { const int tt = tt0[p] + j - 2; const bool ok = tt >= 0 && tt < Tn[p]; ca[p][j] = *(const u32x4*)(prow[p] + (ok ? (ptrdiff_t)(j - 2) * NP : (ptrdiff_t)0) + PC_GQKV + 8 * lane); }
          __builtin_amdgcn_sched_barrier(0);
#pragma unroll
          for (int p = 0; p < 2; ++p) { float a[8];
#pragma unroll
              for (int x = 0; x < 8; ++x) a[x] = 0.f;
#pragma unroll
              for (int j = 0; j < 5; ++j) { const int tt = tt0[p] + j - 2; const float z = (tt >= 0 && tt < Tn[p]) ? 1.0f : 0.0f; float va[8]; unpack8(ca[p][j], va);
#pragma unroll
                  for (int x = 0; x < 8; ++x) a[x] += z * wA[j][x] * va[x]; }
              float n2 = 0.f;
#pragma unroll
              for (int x = 0; x < 8; ++x) { a[x] = siluf(a[x]); n2 += a[x] * a[x]; }
              n2 += dppf<0xB1>(n2); n2 += dppf<0x4E>(n2); n2 += dppf<0x141>(n2);
              const float sc = __builtin_amdgcn_rsqf(n2 + EPS) * (lane < 32 ? 0.125f : 1.0f);
#pragma unroll
              for (int x = 0; x < 8; ++x) a[x] *= sc;
              if (p == 0 || ok1) *(u32x4*)(GD + (size_t)mm[p] * 768 + 8 * lane) = pack8(a); } }
        { u32x4 cb[2][5]; float abv[2];
#pragma unroll
          for (int p = 0; p < 2; ++p) {
#pragma unroll
              for (int j = 0; j < 5; ++j) { const int tt = tt0[p] + j - 2; const bool ok = tt >= 0 && tt < Tn[p]; cb[p][j] = *(const u32x4*)(prow[p] + (ok ? (ptrdiff_t)(j - 2) * NP : (ptrdiff_t)0) + PC_GQKV + 512 + 8 * l31); }
              abv[p] = AB[(size_t)mm[p] * 16 + (lane & 15)]; }
          __builtin_amdgcn_sched_barrier(0);
#pragma unroll
          for (int p = 0; p < 2; ++p) { const int m = mm[p]; float bq[8];
#pragma unroll
              for (int x = 0; x < 8; ++x) bq[x] = 0.f;
#pragma unroll
              for (int j = 0; j < 5; ++j) { const int tt = tt0[p] + j - 2; const float z = (tt >= 0 && tt < Tn[p]) ? 1.0f : 0.0f; float vb[8]; unpack8(cb[p][j], vb);
#pragma unroll
                  for (int x = 0; x < 8; ++x) bq[x] += z * wB[j][x] * vb[x]; }
#pragma unroll
              for (int x = 0; x < 8; ++x) bq[x] = siluf(bq[x]);
              if (p == 0 || ok1) { if (lane < 32) *(u32x4*)(GD + (size_t)m * 768 + 512 + 8 * lane) = pack8(bq);
                  if (lane < 16) { const float av = abv[p]; float o;
                      if (lane < 8) { const float xx = av + dtb; const float sp = fmaxf(xx, 0.f) + log1pf(fexp(-fabsf(xx))); o = alg * sp; }
                      else o = __builtin_amdgcn_rcpf(1.0f + fexp(-av));
                      GB[(size_t)m * 16 + lane] = o; } } } }
    }
}


__device__ __forceinline__ void phase_swa2(Frame& F, const Inputs& in, int layer, int nwg) {
    if (F.bid >= nwg) return;
    const bf16* P = (const bf16*)(F.ws + WS_R1 + R1_P);
    unsigned char* prep = F.ws + WS_R1 + R1_PREP;
    const bf16* SQ = (const bf16*)(prep + PREP_SQ); const bf16* SK = (const bf16*)(prep + PREP_SK);
    bf16* O = (bf16*)(F.ws + WS_R1 + R1_O);
    LAS bf16* Kbuf = (LAS bf16*)F.lds;
    const int lane = F.lane, c = lane & 15, q = lane >> 4, w = F.wave;
    const float LOG2E = 1.4426950408889634f;
    const int srow = F.tid >> 3, scol = (F.tid & 7) * 8;
    DynQ dq = dyn_make(F, layer, 1);
    for (int u = dyn_bcast(dq, dyn_grab(dq)); u < 544; ) {
        const int u_next = dyn_grab(dq);
        const bool lat = u < 512; int b, g, qb;
        if (lat) { b = u >> 7; g = (u >> 6) & 1; qb = u & 63; } else { const int uu = u - 512; b = uu >> 3; g = (uu >> 2) & 1; qb = uu & 3; }
        const int hq = 4 * g + (w >> 1), i0 = 32 * (w & 1);
        const int mrow0 = lat ? MC + b * TL + 64 * qb : b * TC + 64 * qb;
        const int kt0 = lat ? (2 - qb > 0 ? 2 - qb : 0) : 0, kt1 = lat ? (65 - qb < 4 ? 65 - qb : 4) : -1, nb = lat ? kt1 - kt0 + 1 : 0, nt = nb + 4;
        const int band0 = MC + b * TL + 64 * qb - 128 + 64 * kt0, ctx0 = b * TC;
        bf16x8 qf[2][2];
#pragma unroll
        for (int ti = 0; ti < 2; ++ti)
#pragma unroll
            for (int ks = 0; ks < 2; ++ks) qf[ti][ks] = *(const bf16x8*)(SQ + (size_t)(mrow0 + i0 + 16 * ti + c) * 512 + hq * 64 + 32 * ks + 8 * q);
        float mrun[2], lrun[2]; f32x4 oacc[4][2];
        const float sk = in.swa_sink[layer * 8 + hq] * LOG2E;
#pragma unroll
        for (int ti = 0; ti < 2; ++ti) { mrun[ti] = sk; lrun[ti] = 1.0f;
#pragma unroll
            for (int te = 0; te < 4; ++te) oacc[te][ti] = (f32x4){0.f, 0.f, 0.f, 0.f}; }
        u32x4 kreg, vreg;
#define SWA_LOAD(tix) do { const int r0_ = ((tix) < nb) ? band0 + 64 * (tix) : ctx0 + 64 * ((tix) - nb); \
            kreg = *(const u32x4*)(SK + (size_t)(r0_ + srow) * 128 + g * 64 + scol); vreg = *(const u32x4*)(P + (size_t)(r0_ + srow) * NP + PC_SV + g * 64 + scol); } while (0)
#define SWA_WRITE(buf) do { LAS bf16* Kw_ = Kbuf + (buf) * 9216; LAS bf16* Vw_ = Kw_ + 4608; *(LAS u32x4*)(Kw_ + srow * 72 + scol) = kreg; \
            _Pragma("unroll") for (int x = 0; x < 8; ++x) Vw_[(scol + x) * 72 + srow] = (bf16)(vreg[x >> 1] >> (16 * (x & 1))); } while (0)
        __syncthreads();
        SWA_LOAD(0); SWA_WRITE(0);
        if (nt > 1) SWA_LOAD(1);
        for (int tt = 0; tt < nt; ++tt) {
            __syncthreads();
            const LAS bf16* Kl = Kbuf + (tt & 1) * 9216; const LAS bf16* Vt = Kl + 4608;
            bf16x8 kfr[2][4]; u32x2 vlo[2][4], vhi[2][4];
#pragma unroll
            for (int ks = 0; ks < 2; ++ks)
#pragma unroll
                for (int tj = 0; tj < 4; ++tj) kfr[ks][tj] = *(const LAS bf16x8*)(Kl + (16 * tj + c) * 72 + 32 * ks + 8 * q);
#pragma unroll
            for (int ks2 = 0; ks2 < 2; ++ks2)
#pragma unroll
                for (int te = 0; te < 4; ++te) { vlo[ks2][te] = *(const LAS u32x2*)(Vt + (16 * te + c) * 72 + 32 * ks2 + 4 * q); vhi[ks2][te] = *(const LAS u32x2*)(Vt + (16 * te + c) * 72 + 32 * ks2 + 16 + 4 * q); }
            __builtin_amdgcn_sched_barrier(0);
            if (tt + 1 < nt) { SWA_WRITE((tt + 1) & 1); if (tt + 2 < nt) SWA_LOAD(tt + 2); }
            f32x4 sacc[4][2];
#pragma unroll
            for (int tj = 0; tj < 4; ++tj)
#pragma unroll
                for (int ti = 0; ti < 2; ++ti) sacc[tj][ti] = (f32x4){0.f, 0.f, 0.f, 0.f};
#pragma unroll
            for (int ks = 0; ks < 2; ++ks)
#pragma unroll
                for (int tj = 0; tj < 4; ++tj)
#pragma unroll
                    for (int ti = 0; ti < 2; ++ti) sacc[tj][ti] = mfma16(kfr[ks][tj], qf[ti][ks], sacc[tj][ti]);
            const bool band = tt < nb;
            const int kp0 = 64 * qb - 128 + 64 * (kt0 + tt) + 4 * q;
#pragma unroll
            for (int ti = 0; ti < 2; ++ti) {
                const int qp = 64 * qb + i0 + 16 * ti + c;
                float mx = -30000.0f;
                if (band) {
#pragma unroll
                    for (int tj = 0; tj < 4; ++tj)
#pragma unroll
                        for (int r = 0; r < 4; ++r) { float sv = sacc[tj][ti][r] * (0.125f * LOG2E); const int dlt = kp0 + 16 * tj + r - qp; if (dlt > 128 || dlt < -128) sv = -30000.0f; sacc[tj][ti][r] = sv; mx = fmaxf(mx, sv); }
                } else {
#pragma unroll
                    for (int tj = 0; tj < 4; ++tj)
#pragma unroll
                        for (int r = 0; r < 4; ++r) { const float sv = sacc[tj][ti][r] * (0.125f * LOG2E); sacc[tj][ti][r] = sv; mx = fmaxf(mx, sv); }
                }
                mx = quad_rows_max(mx);
                const float mn = fmaxf(mrun[ti], mx), corr = __builtin_amdgcn_exp2f(mrun[ti] - mn);
                float ls = 0.f;
#pragma unroll
                for (int tj = 0; tj < 4; ++tj)
#pragma unroll
                    for (int r = 0; r < 4; ++r) { const float p = __builtin_amdgcn_exp2f(sacc[tj][ti][r] - mn); sacc[tj][ti][r] = p; ls += p; }
                ls = quad_rows_sum(ls);
                lrun[ti] = lrun[ti] * corr + ls; mrun[ti] = mn;
#pragma unroll
                for (int te = 0; te < 4; ++te) oacc[te][ti] *= corr;
            }
#pragma unroll
            for (int ks2 = 0; ks2 < 2; ++ks2) {
                bf16x8 pb[2];
#pragma unroll
                for (int ti = 0; ti < 2; ++ti) { u32x4 t; t.x = cvtpk(sacc[2 * ks2][ti][0], sacc[2 * ks2][ti][1]); t.y = cvtpk(sacc[2 * ks2][ti][2], sacc[2 * ks2][ti][3]);
                    t.z = cvtpk(sacc[2 * ks2 + 1][ti][0], sacc[2 * ks2 + 1][ti][1]); t.w = cvtpk(sacc[2 * ks2 + 1][ti][2], sacc[2 * ks2 + 1][ti][3]); pb[ti] = __builtin_bit_cast(bf16x8, t); }
#pragma unroll
                for (int te = 0; te < 4; ++te) { const bf16x8 va = __builtin_bit_cast(bf16x8, ((u32x4){vlo[ks2][te].x, vlo[ks2][te].y, vhi[ks2][te].x, vhi[ks2][te].y}));
#pragma unroll
                    for (int ti = 0; ti < 2; ++ti) oacc[te][ti] = mfma16(va, pb[ti], oacc[te][ti]); }
            }
        }
#pragma unroll
        for (int ti = 0; ti < 2; ++ti) { const float il = 1.0f / lrun[ti]; bf16* orow = O + (size_t)(mrow0 + i0 + 16 * ti + c) * D + 512 + hq * 64 + 4 * q;
#pragma unroll
            for (int te = 0; te < 4; ++te) { u32x2 wv; wv.x = cvtpk(oacc[te][ti][0] * il, oacc[te][ti][1] * il); wv.y = cvtpk(oacc[te][ti][2] * il, oacc[te][ti][3] * il); *(u32x2*)(orow + 16 * te) = wv; } }
        u = dyn_bcast(dq, u_next);
    }
#undef SWA_LOAD
#undef SWA_WRITE
}


__device__ __forceinline__ void phase_gdn_local3(Frame& F, int layer) {
    unsigned char* prep = F.ws + WS_R1 + R1_PREP;
    const bf16* GD = (const bf16*)(prep + PREP_GD); const float* GB = (const float*)(F.ws + WS_GB);
    const int lane = F.lane, c = lane & 15, q = lane >> 4, w = F.wave, half = w >> 2, wq = w & 3, t2 = F.tid & 255;
    LAS unsigned char* L0 = F.lds + half * 54272;
    LAS bf16* Ks = (LAS bf16*)L0; LAS bf16* Vs = Ks + 64 * 72;
    LAS float* At = (LAS float*)(L0 + 18432);
    LAS bf16* XS_ = (LAS bf16*)(L0 + 18432);
    LAS float* sm = (LAS float*)(L0 + 51200);
    LAS float* gl = sm; LAS float* bl = sm + 128; LAS float* gcs = sm + 256; LAS float* eg = sm + 384; LAS float* ekd = sm + 512;
    DynQ dq = dyn_make(F, layer, 0);
    for (int pp = dyn_bcast(dq, dyn_grab(dq)); pp < 8 * 68; ) {
        const int pp_next = dyn_grab(dq);
        const int uu = 2 * pp + half, bh = uu / 68, ch = uu % 68, b = bh >> 2, hh = bh & 3;
        const int m0 = ch < 4 ? b * TC + 64 * ch : MC + b * TL + 64 * (ch - 4);
        __syncthreads();
#pragma unroll
        for (int rep = 0; rep < 2; ++rep) { const int idx = t2 + 256 * rep, row = idx >> 3, col8 = (idx & 7) * 8; const bf16* src = GD + (size_t)(m0 + row) * 768 + hh * 64 + col8;
            *(LAS u32x4*)(Ks + row * 72 + col8) = *(const u32x4*)(src + 256); *(LAS u32x4*)(Vs + row * 72 + col8) = *(const u32x4*)(src + 512); }
        { const int tok = t2 & 63, which = t2 >> 6; sm[which * 64 + tok] = GB[(size_t)(m0 + tok) * 16 + (which >> 1) * 8 + (which & 1) * 4 + hh]; }
        __syncthreads();
        if (wq < 2) { const int d = wq; const int tok = d ? 63 - lane : lane; float v = gl[d * 64 + tok];
#pragma unroll
            for (int o = 1; o < 64; o <<= 1) { const float t = __shfl_up(v, o); if (lane >= o) v += t; }
            const float last = __shfl(v, 63);
            gcs[d * 64 + lane] = v; eg[d * 64 + lane] = fexp(v); ekd[d * 64 + lane] = fexp(last - v);
            ((float*)(F.ws + WS_GCS))[((size_t)uu * 2 + d) * 64 + tok] = v; }
        __syncthreads();
        {
            const int ti = wq;
            bf16x8 a[2];
#pragma unroll
            for (int ks = 0; ks < 2; ++ks) a[ks] = *(const LAS bf16x8*)(Ks + (16 * ti + c) * 72 + 32 * ks + 8 * q);
#pragma unroll
            for (int tj = 0; tj < 4; ++tj) { f32x4 acc = (f32x4){0.f, 0.f, 0.f, 0.f};
#pragma unroll
                for (int ks = 0; ks < 2; ++ks) acc = mfma16(a[ks], *(const LAS bf16x8*)(Ks + (16 * tj + c) * 72 + 32 * ks + 8 * q), acc);
#pragma unroll
                for (int r = 0; r < 4; ++r) { const int it = 16 * ti + 4 * q + r, jt = 16 * tj + c;
#pragma unroll
                    for (int d = 0; d < 2; ++d) { const int i = d ? 63 - it : it, j = d ? 63 - jt : jt;
                        const float e = fexp(fminf(gcs[d * 64 + i] - gcs[d * 64 + j], 0.f));
                        At[d * 4096 + j * 64 + i] = (j < i) ? bl[d * 64 + it] * acc[r] * e : 0.f; } } }
        }
        __syncthreads();
        float x[64];
        const int sd = wq >> 1, kind = wq & 1;
        {
            const LAS bf16* R = kind ? Ks : Vs; const LAS float* A = At + sd * 4096;
#pragma unroll
            for (int i = 0; i < 64; ++i) { const int tok = sd ? 63 - i : i; float v = bl[sd * 64 + tok] * bf2f(R[tok * 72 + lane]); if (kind) v *= eg[sd * 64 + i]; x[i] = v; }
#pragma unroll
            for (int j = 0; j < 63; ++j) { const float xj = x[j];
                f32x4 ca[16];
#pragma unroll
                for (int g = ((j + 1) >> 2); g < 16; ++g) ca[g] = *(const LAS f32x4*)(A + j * 64 + 4 * g);
                __builtin_amdgcn_sched_barrier(0);
#pragma unroll
                for (int g = ((j + 1) >> 2); g < 16; ++g) { x[4 * g] -= ca[g].x * xj; x[4 * g + 1] -= ca[g].y * xj; x[4 * g + 2] -= ca[g].z * xj; x[4 * g + 3] -= ca[g].w * xj; }
                __builtin_amdgcn_sched_barrier(0); }
        }
        __syncthreads();
        { LAS bf16* XO = XS_ + (sd * 2 + kind) * 4096;
#pragma unroll
          for (int i = 0; i < 64; ++i) XO[(sd ? 63 - i : i) * 64 + lane] = (bf16)f2bf(x[i]); }
        __syncthreads();
        {
            for (int it = t2; it < 2 * 512; it += 256) { const int d = it >> 9, chk = it & 511;
                const int rt = chk >> 7, ks = (chk >> 6) & 1, ln = chk & 63, r = ln & 15, qq = ln >> 4, row = 16 * rt + r, c0 = 32 * ks + 4 * qq;
                const int chain = bh * 2 + d, sg = ch < 4 ? (d ? 3 - ch : ch) : 4 + (d ? 63 - (ch - 4) : ch - 4);
                unsigned char* dst = F.ws + WS_GCH + (size_t)chain * G2_CHAIN + (size_t)sg * G2_STEP;
                const LAS bf16* XW = XS_ + (d * 2 + 1) * 4096;
                const u32x2 lo = *(const LAS u32x2*)(XW + row * 64 + c0), hi = *(const LAS u32x2*)(XW + row * 64 + c0 + 16);
                *(u32x4*)(dst + chk * 16) = (u32x4){lo.x, lo.y, hi.x, hi.y};
                float v[8];
#pragma unroll
                for (int x8 = 0; x8 < 8; ++x8) { const int tok = c0 + (x8 & 3) + 16 * (x8 >> 2); const int i = d ? 63 - tok : tok; v[x8] = bf2f(Ks[tok * 72 + row]) * ekd[d * 64 + i]; }
                u32x4 o; o.x = cvtpk(v[0], v[1]); o.y = cvtpk(v[2], v[3]); o.z = cvtpk(v[4], v[5]); o.w = cvtpk(v[6], v[7]);
                *(u32x4*)(dst + 8192 + chk * 16) = o; }
            for (int it = t2; it < 2 * 1024; it += 256) { const int d = it >> 10, cu = it & 1023;
                const int sl = cu >> 8, rt = (cu >> 6) & 3, ln = cu & 63, qq = ln >> 4, cc = ln & 15;
                const LAS bf16* XU = XS_ + (d * 2) * 4096; const int tr = 16 * rt + 4 * qq;
                const bf16 e0 = XU[(tr) * 64 + 16 * sl + cc], e1 = XU[(tr + 1) * 64 + 16 * sl + cc], e2 = XU[(tr + 2) * 64 + 16 * sl + cc], e3 = XU[(tr + 3) * 64 + 16 * sl + cc];
                const int chain = bh * 2 + d, sg = ch < 4 ? (d ? 3 - ch : ch) : 4 + (d ? 63 - (ch - 4) : ch - 4);
                unsigned char* dst = F.ws + WS_GCH + (size_t)chain * G2_CHAIN + (size_t)sg * G2_STEP + 16384;
                *(u32x2*)(dst + cu * 8) = (u32x2){(unsigned)e0 | ((unsigned)e1 << 16), (unsigned)e2 | ((unsigned)e3 << 16)}; }
            if (t2 < 2) { const int d = t2; const int chain = bh * 2 + d, sg = ch < 4 ? (d ? 3 - ch : ch) : 4 + (d ? 63 - (ch - 4) : ch - 4);
                ((float*)(F.ws + WS_GDEC))[chain * 68 + sg] = eg[d * 64 + 63]; }
        }
        pp = dyn_bcast(dq, pp_next);
    }
}


__device__ __forceinline__ void phase_gdn_scan3(Frame& F, int first_wg) {
    const int chain = F.bid - first_wg; if (chain < 0 || chain >= 32) return;
    const unsigned char* src = F.ws + WS_GCH + (size_t)chain * G2_CHAIN;
    const float* decs = (const float*)(F.ws + WS_GDEC) + chain * 68;
    unsigned char* GSTb = F.ws + WS_GST + (size_t)chain * 68 * 16384;
    LAS unsigned char* ring = F.lds;
    const int lane = F.lane, w = F.wave;
    if (w >= 4) {
        const int dw = w - 4;
#define GS3_ISSUE(step) do { _Pragma("unroll") for (int k = 0; k < 6; ++k) { const int p = dw * 6 + k; \
            __builtin_amdgcn_global_load_lds((const unsigned*)(src + (size_t)(step) * G2_STEP + p * 1024 + lane * 16), (LAS unsigned*)(ring + ((step) & 3) * 24576 + p * 1024), 16, 0, 0); } } while (0)
        GS3_ISSUE(0); GS3_ISSUE(1); GS3_ISSUE(2);
        asm volatile("s_waitcnt vmcnt(12)" ::: "memory"); __builtin_amdgcn_s_barrier();
        for (int n = 0; n < 68; ++n) {
            if (n + 3 < 68) { GS3_ISSUE(n + 3); asm volatile("s_waitcnt vmcnt(12)" ::: "memory"); }
            else if (n + 2 < 68) asm volatile("s_waitcnt vmcnt(6)" ::: "memory");
            else asm volatile("s_waitcnt vmcnt(0)" ::: "memory");
            __builtin_amdgcn_s_barrier();
        }
#undef GS3_ISSUE
    } else {
        const int sl = w;
        f32x4 S[4];
#pragma unroll
        for (int rt = 0; rt < 4; ++rt) S[rt] = (f32x4){0.f, 0.f, 0.f, 0.f};
        const float dv0 = decs[lane], dv1 = decs[64 + (lane & 3)];
        asm volatile("s_waitcnt vmcnt(0)" ::: "memory"); __builtin_amdgcn_s_barrier(); asm volatile("" ::: "memory");
        for (int n = 0; n < 68; ++n) {
            const LAS unsigned char* base = ring + (n & 3) * 24576;
            const float dec = n < 64 ? __shfl(dv0, n) : __shfl(dv1, n - 64);
            unsigned char* go = GSTb + (size_t)n * 16384 + (size_t)(sl * 2 * 64 + lane) * 16;
#define GS3_FRAG(mat, rt, ks) (*(const LAS bf16x8*)(base + (mat) * 8192 + (((rt) * 2 + (ks)) * 64 + lane) * 16))
            bf16x8 wf[4][2], kf[4][2]; u32x2 uf[4];
#pragma unroll
            for (int rt = 0; rt < 4; ++rt) { wf[rt][0] = GS3_FRAG(0, rt, 0); wf[rt][1] = GS3_FRAG(0, rt, 1); }
#pragma unroll
            for (int rt = 0; rt < 4; ++rt) uf[rt] = *(const LAS u32x2*)(base + 16384 + ((sl * 4 + rt) * 64 + lane) * 8);
#pragma unroll
            for (int rt = 0; rt < 4; ++rt) { kf[rt][0] = GS3_FRAG(1, rt, 0); kf[rt][1] = GS3_FRAG(1, rt, 1); }
#undef GS3_FRAG
            __builtin_amdgcn_sched_barrier(0);
            bf16x8 BS[2], BV[2];
#pragma unroll
            for (int ks = 0; ks < 2; ++ks) { u32x4 t; t.x = cvtpk(S[2 * ks][0], S[2 * ks][1]); t.y = cvtpk(S[2 * ks][2], S[2 * ks][3]); t.z = cvtpk(S[2 * ks + 1][0], S[2 * ks + 1][1]); t.w = cvtpk(S[2 * ks + 1][2], S[2 * ks + 1][3]);
                BS[ks] = __builtin_bit_cast(bf16x8, t); *(u32x4*)(go + ks * 1024) = t; }
            f32x4 vn[4];
#pragma unroll
            for (int ks = 0; ks < 2; ++ks)
#pragma unroll
                for (int rt = 0; rt < 4; ++rt) vn[rt] = mfma16(wf[rt][ks], BS[ks], ks ? vn[rt] : (f32x4){0.f, 0.f, 0.f, 0.f});
#pragma unroll
            for (int rt = 0; rt < 4; ++rt) { const u32x2 uu = uf[rt];
                vn[rt] = (f32x4){__uint_as_float(uu.x << 16), __uint_as_float(uu.x & 0xffff0000u), __uint_as_float(uu.y << 16), __uint_as_float(uu.y & 0xffff0000u)} - vn[rt]; }
#pragma unroll
            for (int ks = 0; ks < 2; ++ks) { u32x4 t; t.x = cvtpk(vn[2 * ks][0], vn[2 * ks][1]); t.y = cvtpk(vn[2 * ks][2], vn[2 * ks][3]); t.z = cvtpk(vn[2 * ks + 1][0], vn[2 * ks + 1][1]); t.w = cvtpk(vn[2 * ks + 1][2], vn[2 * ks + 1][3]);
                BV[ks] = __builtin_bit_cast(bf16x8, t); *(u32x4*)(go + 8192 + ks * 1024) = t; }
#pragma unroll
            for (int rt = 0; rt < 4; ++rt) S[rt] = S[rt] * dec;
#pragma unroll
            for (int ks = 0; ks < 2; ++ks)
#pragma unroll
                for (int rt = 0; rt < 4; ++rt) S[rt] = mfma16(kf[rt][ks], BV[ks], S[rt]);
            asm volatile("s_waitcnt lgkmcnt(0)" ::: "memory"); __builtin_amdgcn_s_barrier(); asm volatile("" ::: "memory");
        }
    }
}

__device__ __forceinline__ void phase_gdn_out2(Frame& F, const Inputs& in, int layer) {
    const bf16* P = (const bf16*)(F.ws + WS_R1 + R1_P);
    const bf16* GD = (const bf16*)(F.ws + WS_R1 + R1_PREP + PREP_GD);
    const unsigned char* GSTb = F.ws + WS_GST; const float* GCS = (const float*)(F.ws + WS_GCS);
    bf16* O = (bf16*)(F.ws + WS_R1 + R1_O);
    const int lane = F.lane, c = lane & 15, q = lane >> 4, w = F.wave, half = w >> 2, ti = w & 3, t2 = F.tid & 255;
    LAS bf16* Qs = (LAS bf16*)(F.lds + half * 56320); LAS bf16* Ks = Qs + 4608;
    LAS unsigned char* Fr = F.lds + half * 56320 + 18432;
    LAS float* gT = (LAS float*)(F.lds + half * 56320 + 55296);
    DynQ dq = dyn_make(F, layer, 4);
    for (int pp = dyn_bcast(dq, dyn_grab(dq)); pp < 8 * 68; ) {
        const int pp_next = dyn_grab(dq);
        const int uu = 2 * pp + half, bh = uu / 68, ch = uu % 68, b = bh >> 2, hh = bh & 3;
        const int m0 = ch < 4 ? b * TC + 64 * ch : MC + b * TL + 64 * (ch - 4);
        __syncthreads();
#pragma unroll
        for (int rep = 0; rep < 2; ++rep) { const int idx = t2 + 256 * rep, row = idx >> 3, col8 = (idx & 7) * 8;
            const bf16* src = GD + (size_t)(m0 + row) * 768 + hh * 64 + col8;
            *(LAS u32x4*)(Qs + row * 72 + col8) = *(const u32x4*)(src); *(LAS u32x4*)(Ks + row * 72 + col8) = *(const u32x4*)(src + 256); }
#pragma unroll
        for (int d = 0; d < 2; ++d) { const int sg = ch < 4 ? (d ? 3 - ch : ch) : 4 + (d ? 63 - (ch - 4) : ch - 4);
            const unsigned char* g = GSTb + ((size_t)(bh * 2 + d) * 68 + sg) * 16384;
#pragma unroll
            for (int rep = 0; rep < 4; ++rep) { const int idx = t2 + 256 * rep; *(LAS u32x4*)(Fr + d * 16384 + idx * 16) = *(const u32x4*)(g + (size_t)idx * 16); } }
        if (t2 < 128) gT[t2] = GCS[(size_t)uu * 128 + t2];
        __syncthreads();
        bf16x8 qf[2], qr[2];
#pragma unroll
        for (int ks = 0; ks < 2; ++ks) { qf[ks] = *(const LAS bf16x8*)(Qs + (16 * ti + c) * 72 + 32 * ks + 8 * q);
            const u32x2 lo = *(const LAS u32x2*)(Qs + (16 * ti + c) * 72 + 32 * ks + 4 * q), hi = *(const LAS u32x2*)(Qs + (16 * ti + c) * 72 + 32 * ks + 16 + 4 * q);
            qr[ks] = __builtin_bit_cast(bf16x8, ((u32x4){lo.x, lo.y, hi.x, hi.y})); }
        const int i = 16 * ti + c;
        const float gi0 = gT[i], gi1 = gT[64 + i];
        f32x4 sacc[4];
#pragma unroll
        for (int tj = 0; tj < 4; ++tj) { f32x4 acc = (f32x4){0.f, 0.f, 0.f, 0.f};
#pragma unroll
            for (int ks = 0; ks < 2; ++ks) acc = mfma16(*(const LAS bf16x8*)(Ks + (16 * tj + c) * 72 + 32 * ks + 8 * q), qf[ks], acc);
            sacc[tj] = acc; }
        bf16x8 pb[2][2];
#pragma unroll
        for (int d = 0; d < 2; ++d) { f32x4 p[4];
#pragma unroll
            for (int tj = 0; tj < 4; ++tj) { const f32x4 gj = *(const LAS f32x4*)(gT + d * 64 + 16 * tj + 4 * q);
#pragma unroll
                for (int r = 0; r < 4; ++r) { const int j = 16 * tj + 4 * q + r; const bool ok = d ? (j >= i) : (j <= i);
                    p[tj][r] = ok ? sacc[tj][r] * fexp(fminf((d ? gi1 : gi0) - gj[r], 0.f)) : 0.f; } }
#pragma unroll
            for (int ks2 = 0; ks2 < 2; ++ks2) { u32x4 t; t.x = cvtpk(p[2 * ks2][0], p[2 * ks2][1]); t.y = cvtpk(p[2 * ks2][2], p[2 * ks2][3]); t.z = cvtpk(p[2 * ks2 + 1][0], p[2 * ks2 + 1][1]); t.w = cvtpk(p[2 * ks2 + 1][2], p[2 * ks2 + 1][3]); pb[d][ks2] = __builtin_bit_cast(bf16x8, t); } }
        const float sc0 = fexp(gi0), sc1 = fexp(gi1);
        f32x4 o[4]; float ssq = 0.f;
#pragma unroll
        for (int te = 0; te < 4; ++te) { f32x4 acc = (f32x4){0.f, 0.f, 0.f, 0.f}, t0 = acc, t1 = acc;
#pragma unroll
            for (int ks = 0; ks < 2; ++ks) {
                acc = mfma16(*(const LAS bf16x8*)(Fr + 8192 + ((te * 2 + ks) * 64 + lane) * 16), pb[0][ks], acc);
                acc = mfma16(*(const LAS bf16x8*)(Fr + 16384 + 8192 + ((te * 2 + ks) * 64 + lane) * 16), pb[1][ks], acc);
                t0 = mfma16(*(const LAS bf16x8*)(Fr + ((te * 2 + ks) * 64 + lane) * 16), qr[ks], t0);
                t1 = mfma16(*(const LAS bf16x8*)(Fr + 16384 + ((te * 2 + ks) * 64 + lane) * 16), qr[ks], t1); }
            o[te] = acc + sc0 * t0 + sc1 * t1; ssq += (o[te][0] * o[te][0] + o[te][1] * o[te][1]) + (o[te][2] * o[te][2] + o[te][3] * o[te][3]); }
        ssq = quad_rows_sum(ssq);
        const float rs = 1.0f / sqrtf(ssq * (1.0f / 64.0f) + EPS);
#pragma unroll
        for (int te = 0; te < 4; ++te) { const int e0 = 16 * te + 4 * q;
            const u32x2 z2 = *(const u32x2*)(P + (size_t)(m0 + i) * NP + PC_GZ + hh * 64 + e0); const f32x4 gn = *(const f32x4*)(in.gdn_norm_g + layer * 64 + e0);
            const float z0 = __uint_as_float(z2.x << 16), z1 = __uint_as_float(z2.x & 0xffff0000u), z2f = __uint_as_float(z2.y << 16), z3 = __uint_as_float(z2.y & 0xffff0000u);
            u32x2 wv; wv.x = cvtpk(o[te][0] * rs * gn[0] * siluf(z0), o[te][1] * rs * gn[1] * siluf(z1)); wv.y = cvtpk(o[te][2] * rs * gn[2] * siluf(z2f), o[te][3] * rs * gn[3] * siluf(z3));
            *(u32x2*)(O + (size_t)(m0 + i) * D + 256 + hh * 64 + e0) = wv; }
        pp = dyn_bcast(dq, pp_next);
    }
}

__device__ __forceinline__ void phase_ret_kv(Frame& F, const Inputs& in, int layer) {
    const bf16* P = (const bf16*)(F.ws + WS_R1 + R1_P);
    const bf16* RK = (const bf16*)(F.ws + WS_R1 + R1_PREP + PREP_RK);
    LAS bf16* Kt = (LAS bf16*)F.lds; LAS bf16* Vw = Kt + 64 * 72;
    const int lane = F.lane, c = lane & 15, q = lane >> 4, w = F.wave, tid = F.tid;
    const float LOG2E = 1.4426950408889634f;
    DynQ dq = dyn_make(F, layer, 2);
    for (int uu = dyn_bcast(dq, dyn_grab(dq)); uu < 16 * 68; ) {
        const int uu_next = dyn_grab(dq);
        const int bh = uu / 68, ch = uu % 68, b = bh >> 2, hh = bh & 3;
        const int m0 = ch < 4 ? b * TC + 64 * ch : MC + b * TL + 64 * (ch - 4);
        const float l0 = -fexp(in.ret_decay[layer * 8 + hh]) * LOG2E, l1 = -fexp(in.ret_decay[layer * 8 + 4 + hh]) * LOG2E;
        __syncthreads();
        { const int j = tid >> 3, col8 = (tid & 7) * 8;
          const u32x4 k8 = *(const u32x4*)(RK + (size_t)(m0 + j) * 256 + hh * 64 + col8), v8 = *(const u32x4*)(P + (size_t)(m0 + j) * NP + PC_RV + hh * 64 + col8);
          const float w0 = fexp2((float)(63 - j) * l0), w1 = fexp2((float)j * l1);
#pragma unroll
          for (int x = 0; x < 8; ++x) { const unsigned kk = (k8[x >> 1] >> (16 * (x & 1))) & 0xffffu; const float vv = __uint_as_float(((v8[x >> 1] >> (16 * (x & 1))) & 0xffffu) << 16);
              Kt[(col8 + x) * 72 + j] = (bf16)kk; Vw[(col8 + x) * 72 + j] = (bf16)f2bf(vv * w0); Vw[4608 + (col8 + x) * 72 + j] = (bf16)f2bf(vv * w1); } }
        __syncthreads();
        { const int d = w >> 2, td = w & 3;
          bf16x8 a[2];
#pragma unroll
          for (int ks = 0; ks < 2; ++ks) a[ks] = *(const LAS bf16x8*)(Kt + (16 * td + c) * 72 + 32 * ks + 8 * q);
          const int chain = bh * 2 + d, sg = d ? (ch < 4 ? 3 - ch : 71 - ch) : ch;
          float* dst = (float*)(F.ws + WS_RKV) + ((size_t)chain * 68 + sg) * 4096;
#pragma unroll
          for (int te = 0; te < 4; ++te) { f32x4 acc = (f32x4){0.f, 0.f, 0.f, 0.f};
#pragma unroll
              for (int ks = 0; ks < 2; ++ks) acc = mfma16(a[ks], *(const LAS bf16x8*)(Vw + d * 4608 + (16 * te + c) * 72 + 32 * ks + 8 * q), acc);
              *(f32x4*)(dst + (16 * te + c) * 64 + 16 * td + 4 * q) = acc; } }
        uu = dyn_bcast(dq, uu_next);
    }
}
__device__ __forceinline__ void phase_ret_state(Frame& F, const Inputs& in, int layer, int nwg) {
    if (F.bid >= nwg) return;
    const float* RKV = (const float*)(F.ws + WS_RKV); bf16* RST = (bf16*)(F.ws + WS_RST);
    for (int el = F.bid * NTHR + F.tid; el < 32 * 4096; el += nwg * NTHR) {
        const int chain = el >> 12, idx = el & 4095, hh = (chain >> 1) & 3, d = chain & 1;
        const float G64 = fexp(-64.0f * fexp(in.ret_decay[layer * 8 + d * 4 + hh]));
        const float* kv = RKV + (size_t)chain * 68 * 4096 + idx; bf16* st = RST + (size_t)chain * 68 * 4096 + idx;
        float S = 0.f;
#pragma unroll
        for (int h2 = 0; h2 < 2; ++h2) { float kvv[34];
#pragma unroll
            for (int sg = 0; sg < 34; ++sg) kvv[sg] = kv[(size_t)(34 * h2 + sg) * 4096];
#pragma unroll
            for (int sg = 0; sg < 34; ++sg) { st[(size_t)(34 * h2 + sg) * 4096] = (bf16)f2bf(S); S = G64 * S + kvv[sg]; } }
    }
}
__device__ __forceinline__ void phase_ret_out(Frame& F, const Inputs& in, int layer) {
    const bf16* P = (const bf16*)(F.ws + WS_R1 + R1_P);
    const bf16* RQ = (const bf16*)(F.ws + WS_R1 + R1_PREP + PREP_RQ); const bf16* RK = (const bf16*)(F.ws + WS_R1 + R1_PREP + PREP_RK);
    const bf16* RST = (const bf16*)(F.ws + WS_RST);
    bf16* O = (bf16*)(F.ws + WS_R1 + R1_O);
    const int lane = F.lane, c = lane & 15, q = lane >> 4, w = F.wave, half = w >> 2, ti = w & 3, t2 = F.tid & 255;
    LAS bf16* Qs = (LAS bf16*)(F.lds + half * 46080); LAS bf16* Ks = Qs + 4608; LAS bf16* Vt = Ks + 4608; LAS bf16* St = Vt + 4608;
    const float LOG2E = 1.4426950408889634f;
    DynQ dq = dyn_make(F, layer, 3);
    for (int pp = dyn_bcast(dq, dyn_grab(dq)); pp < 8 * 68; ) {
        const int pp_next = dyn_grab(dq);
        const int uu = 2 * pp + half, bh = uu / 68, ch = uu % 68, b = bh >> 2, hh = bh & 3;
        const int m0 = ch < 4 ? b * TC + 64 * ch : MC + b * TL + 64 * (ch - 4);
        const float l0 = -fexp(in.ret_decay[layer * 8 + hh]) * LOG2E, l1 = -fexp(in.ret_decay[layer * 8 + 4 + hh]) * LOG2E;
        __syncthreads();
#pragma unroll
        for (int rep = 0; rep < 2; ++rep) { const int idx = t2 + 256 * rep, row = idx >> 3, col8 = (idx & 7) * 8;
            *(LAS u32x4*)(Qs + row * 72 + col8) = *(const u32x4*)(RQ + (size_t)(m0 + row) * 256 + hh * 64 + col8);
            *(LAS u32x4*)(Ks + row * 72 + col8) = *(const u32x4*)(RK + (size_t)(m0 + row) * 256 + hh * 64 + col8);
            const u32x4 v8 = *(const u32x4*)(P + (size_t)(m0 + row) * NP + PC_RV + hh * 64 + col8);
#pragma unroll
            for (int x = 0; x < 8; ++x) Vt[(col8 + x) * 72 + row] = (bf16)(v8[x >> 1] >> (16 * (x & 1)));
#pragma unroll
            for (int d = 0; d < 2; ++d) { const int sg = d ? (ch < 4 ? 3 - ch : 71 - ch) : ch;
                *(LAS u32x4*)(St + d * 4608 + row * 72 + col8) = *(const u32x4*)(RST + ((size_t)(bh * 2 + d) * 68 + sg) * 4096 + row * 64 + col8); } }
        __syncthreads();
        bf16x8 qf[2];
#pragma unroll
        for (int ks = 0; ks < 2; ++ks) qf[ks] = *(const LAS bf16x8*)(Qs + (16 * ti + c) * 72 + 32 * ks + 8 * q);
        const int i = 16 * ti + c;
        f32x4 p[4];
#pragma unroll
        for (int tj = 0; tj < 4; ++tj) { f32x4 acc = (f32x4){0.f, 0.f, 0.f, 0.f};
#pragma unroll
            for (int ks = 0; ks < 2; ++ks) acc = mfma16(*(const LAS bf16x8*)(Ks + (16 * tj + c) * 72 + 32 * ks + 8 * q), qf[ks], acc);
#pragma unroll
            for (int r = 0; r < 4; ++r) { const int dlt = i - (16 * tj + 4 * q + r);
                const float wgt = (dlt >= 0 ? fexp2((float)dlt * l0) : 0.f) + (dlt <= 0 ? fexp2((float)(-dlt) * l1) : 0.f);
                acc[r] *= wgt; }
            p[tj] = acc; }
        bf16x8 pb[2];
#pragma unroll
        for (int ks2 = 0; ks2 < 2; ++ks2) { u32x4 t; t.x = cvtpk(p[2 * ks2][0], p[2 * ks2][1]); t.y = cvtpk(p[2 * ks2][2], p[2 * ks2][3]); t.z = cvtpk(p[2 * ks2 + 1][0], p[2 * ks2 + 1][1]); t.w = cvtpk(p[2 * ks2 + 1][2], p[2 * ks2 + 1][3]); pb[ks2] = __builtin_bit_cast(bf16x8, t); }
        const float sc0 = fexp2((float)(i + 1) * l0), sc1 = fexp2((float)(64 - i) * l1);
        f32x4 o[4]; float sum = 0.f;
#pragma unroll
        for (int te = 0; te < 4; ++te) { f32x4 acc = (f32x4){0.f, 0.f, 0.f, 0.f}, t0 = acc, t1 = acc;
#pragma unroll
            for (int ks2 = 0; ks2 < 2; ++ks2) { const u32x2 lo = *(const LAS u32x2*)(Vt + (16 * te + c) * 72 + 32 * ks2 + 4 * q), hi = *(const LAS u32x2*)(Vt + (16 * te + c) * 72 + 32 * ks2 + 16 + 4 * q);
                acc = mfma16(__builtin_bit_cast(bf16x8, ((u32x4){lo.x, lo.y, hi.x, hi.y})), pb[ks2], acc); }
#pragma unroll
            for (int ks = 0; ks < 2; ++ks) { t0 = mfma16(*(const LAS bf16x8*)(St + (16 * te + c) * 72 + 32 * ks + 8 * q), qf[ks], t0);
                t1 = mfma16(*(const LAS bf16x8*)(St + 4608 + (16 * te + c) * 72 + 32 * ks + 8 * q), qf[ks], t1); }
            o[te] = acc + sc0 * t0 + sc1 * t1; sum += (o[te][0] + o[te][1]) + (o[te][2] + o[te][3]); }
        sum = quad_rows_sum(sum);
        const float mu = sum * (1.0f / 64.0f); float vs = 0.f;
#pragma unroll
        for (int te = 0; te < 4; ++te) { o[te] = o[te] - mu; vs += (o[te][0] * o[te][0] + o[te][1] * o[te][1]) + (o[te][2] * o[te][2] + o[te][3] * o[te][3]); }
        vs = quad_rows_sum(vs);
        const float rs = 1.0f / sqrtf(vs * (1.0f / 64.0f) + EPS);
#pragma unroll
        for (int te = 0; te < 4; ++te) { const int e0 = hh * 64 + 16 * te + 4 * q;
            const u32x2 g2 = *(const u32x2*)(P + (size_t)(m0 + i) * NP + PC_RG + e0); const f32x4 gn = *(const f32x4*)(in.ret_gn_g + layer * 256 + e0);
            const float g0 = __uint_as_float(g2.x << 16), g1 = __uint_as_float(g2.x & 0xffff0000u), g2f = __uint_as_float(g2.y << 16), g3 = __uint_as_float(g2.y & 0xffff0000u);
            u32x2 wv; wv.x = cvtpk(o[te][0] * rs * gn[0] * siluf(g0), o[te][1] * rs * gn[1] * siluf(g1)); wv.y = cvtpk(o[te][2] * rs * gn[2] * siluf(g2f), o[te][3] * rs * gn[3] * siluf(g3));
            *(u32x2*)(O + (size_t)(m0 + i) * D + e0) = wv; }
        pp = dyn_bcast(dq, pp_next);
    }
}


__device__ __forceinline__ void phase_permute2(Frame& F, int route_lo) {
    const int* TKE = (const int*)(F.ws + WS_TKE); int* TOKROW = (int*)(F.ws + WS_TOKROW); int* TILEE = (int*)(F.ws + WS_TILEE);
    const int* WGCNT = (const int*)(F.ws + WS_TILEE + 4096);
    const bf16* H = (const bf16*)(F.ws + WS_H); bf16* HP = (bf16*)(F.ws + WS_HP);
    LAS int* base = (LAS int*)F.lds;
    LAS int* tot = base + 256 * 8;
    __syncthreads();
    {
        LAS int* scn = base + 256 * 8 + 64;
        int cnt8[8];
#pragma unroll
        for (int e = 0; e < 8; ++e) cnt8[e] = (F.tid < F.G) ? WGCNT[F.tid * 8 + e] : 0;
#pragma unroll
        for (int e = 0; e < 8; ++e) scn[F.tid * 8 + e] = cnt8[e];
        __syncthreads();
        int cur = 0;
        for (int off = 1; off < NTHR; off <<= 1) { int v[8];
#pragma unroll
            for (int e = 0; e < 8; ++e) v[e] = scn[cur * 4096 + F.tid * 8 + e] + (F.tid >= off ? scn[cur * 4096 + (F.tid - off) * 8 + e] : 0);
#pragma unroll
            for (int e = 0; e < 8; ++e) scn[(cur ^ 1) * 4096 + F.tid * 8 + e] = v[e];
            __syncthreads(); cur ^= 1; }
        if (F.tid < F.G) {
#pragma unroll
            for (int e = 0; e < 8; ++e) base[F.tid * 8 + e] = scn[cur * 4096 + F.tid * 8 + e] - cnt8[e]; }
        if (F.tid < 8) tot[F.tid] = scn[cur * 4096 + (F.G - 1) * 8 + F.tid];
    }
    __syncthreads();
    if (F.tid == 0) { int st = 0; for (int e = 0; e < 8; ++e) { tot[8 + e] = st; const int pad = (tot[e] + 255) / 256 * 256;
            if (F.bid == 0) for (int tl = st / 256; tl < (st + pad) / 256; ++tl) TILEE[tl] = e;
            st += pad; }
        if (F.bid == 0) TILEE[256] = st / 256; }
    __syncthreads();
    const int lane = F.lane;
    for (int m = route_lo + F.gw; m < M; m += F.NGW) {
        const int gwm = m < MC ? m : (int)((((long)(m - MC + 1)) * F.NGW - 1) / ML), wg = gwm >> 3;
        const int e0 = TKE[2 * m], e1 = TKE[2 * m + 1];
        const int r0 = tot[8 + e0] + base[wg * 8 + e0] + TOKROW[2 * m], r1 = tot[8 + e1] + base[wg * 8 + e1] + TOKROW[2 * m + 1];
        const u32x4 a = *(const u32x4*)(H + (size_t)m * D + 8 * lane), b = *(const u32x4*)(H + (size_t)m * D + 512 + 8 * lane);
        *(u32x4*)(HP + (size_t)r0 * D + 8 * lane) = a; *(u32x4*)(HP + (size_t)r0 * D + 512 + 8 * lane) = b;
        *(u32x4*)(HP + (size_t)r1 * D + 8 * lane) = a; *(u32x4*)(HP + (size_t)r1 * D + 512 + 8 * lane) = b;
        asm volatile("" ::: "memory");
        if (lane == 0) { TOKROW[2 * m] = r0; TOKROW[2 * m + 1] = r1; }
    }
    for (int e = 0; e < 8; ++e) { const int st = tot[8 + e] + tot[e], en = tot[8 + e] + (tot[e] + 255) / 256 * 256;
        for (int r = st + F.gw; r < en; r += F.NGW) { *(u32x4*)(HP + (size_t)r * D + 8 * lane) = (u32x4){0u, 0u, 0u, 0u}; *(u32x4*)(HP + (size_t)r * D + 512 + 8 * lane) = (u32x4){0u, 0u, 0u, 0u}; } }
}

constexpr int NPH = 12;
constexpr int PH_TOTAL = 1 + DEPTH * NPH + 1;
__host__ __device__ inline bool phase_exists(int ph) {
    if (ph == 0 || ph == PH_TOTAL - 1) return true;
    const int layer = (ph - 1) / NPH, j = (ph - 1) % NPH;
    if (!(layer & 1) && j >= 10) return false;
    if ((layer & 1) && j >= 11) return false;
    return true;
}
__global__ void __launch_bounds__(NTHR, 2) fwd_kernel(Args args) {
    extern __shared__ __attribute__((aligned(16))) unsigned char lds_raw[];
    Frame F;
    F.lds = (LAS unsigned char*)lds_raw;
    F.tid = threadIdx.x; F.lane = F.tid & 63; F.wave = __builtin_amdgcn_readfirstlane(F.tid >> 6);
    const int wave0 = F.wave;
    F.G = gridDim.x; F.bid = blockIdx.x; F.gw = blockIdx.x * NWAVES + F.wave; F.NGW = F.G * NWAVES; F.ws = args.ws;
    volatile LAS unsigned* MISC = (volatile LAS unsigned*)(F.lds + MISC_OFF);
    LAS unsigned long long* ptab = (LAS unsigned long long*)(F.lds + MISC_OFF + 128);
    if (F.tid < 32) MISC[F.tid] = 0u;
    if (PROBE_ON && F.tid == 65) { ((volatile LAS unsigned long long*)(F.lds + 132096))[0] = 0ull; ((volatile LAS unsigned long long*)(F.lds + 132096))[1] = 0ull; }
    if (F.tid == 64) { const Inputs& ai = args.in;
        ptab[0] = (unsigned long long)ai.x; ptab[1] = (unsigned long long)ai.c; ptab[2] = (unsigned long long)ai.ctx; ptab[3] = (unsigned long long)ai.c_ctx; ptab[4] = (unsigned long long)ai.ada_w; ptab[5] = (unsigned long long)ai.ada_b;
        ptab[6] = (unsigned long long)ai.norm1_g; ptab[7] = (unsigned long long)ai.w_in; ptab[8] = (unsigned long long)ai.ret_decay; ptab[9] = (unsigned long long)ai.ret_gn_g; ptab[10] = (unsigned long long)ai.gdn_conv_w; ptab[11] = (unsigned long long)ai.gdn_a_log;
        ptab[12] = (unsigned long long)ai.gdn_dt_bias; ptab[13] = (unsigned long long)ai.gdn_norm_g; ptab[14] = (unsigned long long)ai.swa_sink; ptab[15] = (unsigned long long)ai.w_out; ptab[16] = (unsigned long long)ai.norm2_g; ptab[17] = (unsigned long long)ai.ffn_w1;
        ptab[18] = (unsigned long long)ai.ffn_w3; ptab[19] = (unsigned long long)ai.ffn_w2; ptab[20] = (unsigned long long)ai.router_w; ptab[21] = (unsigned long long)ai.moe_w1; ptab[22] = (unsigned long long)ai.moe_w3; ptab[23] = (unsigned long long)ai.moe_w2; ptab[24] = (unsigned long long)ai.final_g; }
    __syncthreads();
    XcdBarrier bar; bar.bar = (unsigned*)(F.ws + WS_CTL) + CW_BAR; bar.x = 0; bar.st = nullptr; bar.w0 = F.wave;
    const int lo = args.ph_lo, hi = args.ph_hi;
    const bool multi = (hi - lo) > 1;
    if (multi) bar = xcd_barrier_post((unsigned*)(F.ws + WS_CTL) + CW_BAR, MISC + 8);
#define LAUNDER() GAS unsigned char* _w = (GAS unsigned char*)args.ws; asm volatile("" : "+s"(_w)); F.ws = (unsigned char*)_w; asm volatile("" ::: "memory"); { int _t = (wave0 << 6) | (int)__builtin_amdgcn_mbcnt_hi(~0u, __builtin_amdgcn_mbcnt_lo(~0u, 0u)); asm volatile("" : "+v"(_t)); int _b = blockIdx.x; asm volatile("" : "+s"(_b)); F.tid = _t; F.lane = _t & 63; F.wave = __builtin_amdgcn_readfirstlane(_t >> 6); F.bid = _b; F.gw = _b * NWAVES + F.wave; } const Inputs in = load_inputs(ptab)
#define RELAUNDER() do { GAS unsigned char* _w2 = (GAS unsigned char*)args.ws; asm volatile("" : "+s"(_w2)); F.ws = (unsigned char*)_w2; int _t = (wave0 << 6) | (int)__builtin_amdgcn_mbcnt_hi(~0u, __builtin_amdgcn_mbcnt_lo(~0u, 0u)); asm volatile("" : "+v"(_t)); int _b = blockIdx.x; asm volatile("" : "+s"(_b)); F.tid = _t; F.lane = _t & 63; F.wave = __builtin_amdgcn_readfirstlane(_t >> 6); F.bid = _b; F.gw = _b * NWAVES + F.wave; asm volatile("" ::: "memory"); } while (0)
#define IN(k) (lo <= (k) && (k) < hi)
#define STAMP(k) do { if (PROBE_ON && !(PROBE_CUSTOM) && blockIdx.x == 0 && xb_leader(F.wave)) { volatile LAS unsigned long long* _st = (volatile LAS unsigned long long*)(F.lds + 132096); const unsigned long long _now = __builtin_amdgcn_s_memrealtime(), _prev = _st[0]; _st[0] = _now; \
    const int _ph = (k) - 1; bool _sel = false; if (_ph == 0) _sel = (PROBE_PRO) != 0; else if (_ph > 0) { const int _l = (_ph - 1) / NPH, _j = (_ph - 1) % NPH; _sel = (((PROBE_LMASK) >> _l) & 1u) && (((PROBE_JMASK) >> _j) & 1u); } if (_sel) _st[1] = _st[1] + (_now - _prev); } } while (0)
#define SEAM(k) do { if (IN(k) && IN((k) + 1)) { xcd_barrier(bar); STAMP((k) + 1); } } while (0)
    LAS unsigned char* ring = F.lds;

    STAMP(0);
    if (IN(0)) { LAUNDER(); phase_prologue(F, in); } SEAM(0);

#define LAYER_BODY(layer) { \
        const int p0 = 1 + layer * NPH; \
        const bool moe = layer & 1; \
        if (IN(p0 + 0)) { LAUNDER(); phase_token2<0>(F, in, layer, layer == 0, layer > 0 && ((layer - 1) & 1), false, nullptr, 0, (layer > 0 && !((layer - 1) & 1)) ? 11 : 0); } \
        SEAM(p0 + 0); \
        if (IN(p0 + 1)) { LAUNDER(); pg8::StaticOrder S; S.init(F.ws + WS_H, (bf16*)(F.ws + WS_WIN) + (size_t)layer * NP * D, M, NP, D, F.G, F.bid); \
            pg8::EpiBf16 E{(bf16*)(F.ws + WS_R1 + R1_P), NP}; pg8::gemm_phase<D, D, pg8::EpiBf16, pg8::StaticOrder>(ring, S, E, F.tid); } \
        SEAM(p0 + 1); \
        if (IN(p0 + 2)) { LAUNDER(); phase_prep3(F, in, layer); } \
        SEAM(p0 + 2); \
        if (IN(p0 + 3)) { LAUNDER(); convert_moe_layer(F, in, (layer) >> 1, (layer) & 1, F.G); RELAUNDER(); PB(4); phase_gdn_local3(F, layer); PE(4); RELAUNDER(); PB(5); phase_ret_kv(F, in, layer); PE(5); } \
        SEAM(p0 + 3); \
        if (IN(p0 + 4)) { LAUNDER(); PB(1); phase_gdn_scan3(F, F.G - 32); PE(1); RELAUNDER(); PB(2); phase_ret_state(F, in, layer, F.G - 32); PE(2); if (F.bid < F.G - 32) rsync_publish(F, layer); RELAUNDER(); PB(3); phase_swa2(F, in, layer, F.G); PE(3); RELAUNDER(); rsync_wait(F, layer, (unsigned)(F.G - 32)); PB(6); phase_ret_out(F, in, layer); PE(6); } \
        SEAM(p0 + 4); \
        if (IN(p0 + 5)) { LAUNDER(); PB(7); phase_gdn_out2(F, in, layer); PE(7); } \
        SEAM(p0 + 5); \
        if (IN(p0 + 6)) { LAUNDER(); \
            { pg8::StaticOrder S; S.init(F.ws + WS_R1 + R1_O, (bf16*)(F.ws + WS_WOUT) + (size_t)layer * D * D, ML, D, D, F.G, F.bid, 4); \
              pg8::EpiResid E{(float*)(F.ws + WS_XS), (const float*)(F.ws + WS_MOD) + (size_t)layer * 5 * 6 * D, 2, (layer) == 0 ? in.x : nullptr}; pg8::gemm_phase<D, D, pg8::EpiResid, pg8::StaticOrder>(ring, S, E, F.tid); } \
            if (layer < DEPTH - 1) { RELAUNDER(); \
              pg8::SplitOrder S; S.init(F.ws + WS_R1 + R1_O, (bf16*)(F.ws + WS_WOUT) + (size_t)layer * D * D, D, 4, F.G, F.bid); \
              pg8::EpiSlab E{(float*)(F.ws + WS_R1 + 100 * MiB)}; pg8::gemm_phase<256, D, pg8::EpiSlab, pg8::SplitOrder>(ring, S, E, F.tid); } } \
        SEAM(p0 + 6); \
        if (IN(p0 + 7)) { LAUNDER(); phase_token2<1>(F, in, layer, false, false, moe, nullptr, layer == DEPTH - 1 ? MC : 0, layer < DEPTH - 1 ? 4 : 0); } \
        SEAM(p0 + 7); \
        if (!moe) { \
            if (IN(p0 + 8)) { LAUNDER(); pg8::StaticOrder S; S.init(F.ws + WS_H, (bf16*)(F.ws + WS_W13) + (size_t)(layer >> 1) * 2 * FF * D, M, 2 * FF, D, F.G, F.bid); \
                pg8::EpiSwiglu E{(bf16*)(F.ws + WS_R1 + R1_HID), FF}; pg8::gemm_phase<D, D, pg8::EpiSwiglu, pg8::StaticOrder>(ring, S, E, F.tid); } \
            SEAM(p0 + 8); \
            if (IN(p0 + 9)) { LAUNDER(); \
                { pg8::StaticOrder S; S.init(F.ws + WS_R1 + R1_HID, (bf16*)(F.ws + WS_W2) + (size_t)(layer >> 1) * D * FF, ML, D, FF, F.G, F.bid, 4); \
                  pg8::EpiResid E{(float*)(F.ws + WS_XS), (const float*)(F.ws + WS_MOD) + (size_t)layer * 5 * 6 * D, 5, nullptr}; pg8::gemm_phase<FF, FF, pg8::EpiResid, pg8::StaticOrder>(ring, S, E, F.tid); } \
                { RELAUNDER(); \
                  pg8::SplitOrder S; S.init(F.ws + WS_R1 + R1_HID, (bf16*)(F.ws + WS_W2) + (size_t)(layer >> 1) * D * FF, FF, 11, F.G, F.bid); \
                  pg8::EpiSlab E{(float*)(F.ws + WS_R1 + 100 * MiB)}; pg8::gemm_phase<256, FF, pg8::EpiSlab, pg8::SplitOrder>(ring, S, E, F.tid); } } \
            if (IN(p0 + 9) && IN(p0 + NPH)) { xcd_barrier(bar); STAMP(p0 + 10); } \
        } else { \
            if (IN(p0 + 8)) { LAUNDER(); phase_permute2(F, layer == DEPTH - 1 ? MC : 0); } \
            SEAM(p0 + 8); \
            if (IN(p0 + 9)) { LAUNDER(); const int* tile_e = (const int*)(F.ws + WS_TILEE); const int ntiles = __builtin_amdgcn_readfirstlane(tile_e[256]); \
                pg8::GroupedOrder S; S.init(F.ws + WS_HP, F.ws + WS_MW13, ntiles, 2 * EF, D, F.G, F.bid, tile_e); \
                pg8::EpiSwiglu E{(bf16*)(F.ws + WS_R1 + R1_HID), EF}; pg8::gemm_phase<D, D, pg8::EpiSwiglu, pg8::GroupedOrder>(ring, S, E, F.tid); } \
            SEAM(p0 + 9); \
            if (IN(p0 + 10)) { LAUNDER(); const int* tile_e = (const int*)(F.ws + WS_TILEE); const int ntiles = __builtin_amdgcn_readfirstlane(tile_e[256]); \
                const int tmain = (ntiles - (ntiles / 64) * 64 <= 16) ? (ntiles / 64) * 64 : ntiles; \
                { pg8::GroupedOrder S; S.init(F.ws + WS_R1 + R1_HID, F.ws + WS_MW2, tmain, D, EF, F.G, F.bid, tile_e); \
                  pg8::EpiBf16 E{(bf16*)(F.ws + WS_YM), D}; pg8::gemm_phase<EF, EF, pg8::EpiBf16, pg8::GroupedOrder>(ring, S, E, F.tid); } \
                if (ntiles > tmain) { RELAUNDER(); const int* tile_e2 = (const int*)(F.ws + WS_TILEE); \
                  pg8::SplitGroupedOrder S; S.init(F.ws + WS_R1 + R1_HID, F.ws + WS_MW2, tmain, ntiles - tmain, F.G, F.bid, tile_e2); \
                  pg8::EpiYMSlab E{(float*)(F.ws + WS_YM), (float*)(F.ws + WS_HP), tmain * 256}; pg8::gemm_phase<896, EF, pg8::EpiYMSlab, pg8::SplitGroupedOrder>(ring, S, E, F.tid); } } \
            if (IN(p0 + 10) && IN(p0 + NPH)) { xcd_barrier(bar); STAMP(p0 + 11); } \
        } \
    }
    LAYER_BODY(0) LAYER_BODY(1) LAYER_BODY(2) LAYER_BODY(3)
#undef LAYER_BODY
    if (IN(PH_TOTAL - 1)) { LAUNDER(); phase_token2<2>(F, in, DEPTH, false, true, false, args.out); }
    if (PROBE_ON && (int)blockIdx.x == ((PROBE_CUSTOM) ? (PROBE_BLOCK < 0 ? (int)gridDim.x + (PROBE_BLOCK) : (PROBE_BLOCK)) : 0) && xb_leader(F.wave)) {
        STAMP(PH_TOTAL);
        const unsigned long long T = ((volatile LAS unsigned long long*)(F.lds + 132096))[1];
        const unsigned long long t0 = __builtin_amdgcn_s_memrealtime();
        while (__builtin_amdgcn_s_memrealtime() - t0 < 8ull * T) __builtin_amdgcn_s_sleep(8);
    }
#undef IN
#undef SEAM
}

extern "C" void kernel_launch(void* const* d_in, const int* in_sizes, int n_in, void* d_out, int out_size, void* d_ws, size_t ws_size, hipStream_t stream) {
    static int grid = 0;
    if (grid == 0) {
        if (n_in != 25 || out_size != ML * D || ws_size < WS_END) { fprintf(stderr, "kernel_launch: unexpected problem: n_in %d out %d ws %zu (need %zu)\n", n_in, out_size, ws_size, (size_t)WS_END); grid = -1; return; }
        int dev = 0, cus = 0, per_cu = 0;
        if (hipGetDevice(&dev) != hipSuccess || hipDeviceGetAttribute(&cus, hipDeviceAttributeMultiprocessorCount, dev) != hipSuccess) { grid = -1; return; }
        if (hipFuncSetAttribute((const void*)fwd_kernel, hipFuncAttributeMaxDynamicSharedMemorySize, LDS_BYTES) != hipSuccess) { fprintf(stderr, "kernel_launch: hipFuncSetAttribute failed\n"); grid = -1; return; }
        if (hipOccupancyMaxActiveBlocksPerMultiprocessor(&per_cu, (const void*)fwd_kernel, NTHR, LDS_BYTES) != hipSuccess || per_cu < 1) fprintf(stderr, "kernel_launch: occupancy query reports %d\n", per_cu);
        (void)hipGetLastError();
        grid = cus;
    }
    if (grid < 0) return;
    (void)hipMemsetAsync((char*)d_ws + WS_CTL, 0, CTL_ZERO_BYTES, stream);
    Args a{};
    const float** ip = (const float**)&a.in;
    for (int i = 0; i < 25; ++i) ip[i] = (const float*)d_in[i];
    a.out = (float*)d_out; a.ws = (unsigned char*)d_ws;
#if MK_ONE_LAUNCH
    a.ph_lo = 0; a.ph_hi = PH_TOTAL;
    hipLaunchKernelGGL(fwd_kernel, dim3(grid), dim3(NTHR), LDS_BYTES, stream, a);
#else
    for (int ph = 0; ph < PH_TOTAL; ++ph) { if (!phase_exists(ph)) continue; a.ph_lo = ph; a.ph_hi = ph + 1;
        hipLaunchKernelGGL(fwd_kernel, dim3(grid), dim3(NTHR), LDS_BYTES, stream, a); }
#endif
}
```

```cpp
#include <hip/hip_runtime.h>
#include <cstdio>
#include <cstdint>

#ifndef PROBE_JMASK
#define PROBE_JMASK 0u
#endif
#ifndef PROBE_LMASK
#define PROBE_LMASK 15u
#endif
#ifndef PROBE_PRO
#define PROBE_PRO 0
#endif
#ifndef PROBE_CUSTOM
#define PROBE_CUSTOM 0
#endif
#ifndef PROBE_BLOCK
#define PROBE_BLOCK 0
#endif
#define PROBE_ON ((PROBE_JMASK) != 0u || (PROBE_PRO) != 0 || (PROBE_CUSTOM) != 0)
#define PB(id) do { if ((PROBE_CUSTOM) == (id) && (int)blockIdx.x == (PROBE_BLOCK < 0 ? (int)gridDim.x + (PROBE_BLOCK) : (PROBE_BLOCK)) && xb_leader(F.wave)) ((volatile LAS unsigned long long*)(F.lds + 132096))[2] = __builtin_amdgcn_s_memrealtime(); } while (0)
#define PE(id) do { if ((PROBE_CUSTOM) == (id) && (int)blockIdx.x == (PROBE_BLOCK < 0 ? (int)gridDim.x + (PROBE_BLOCK) : (PROBE_BLOCK)) && xb_leader(F.wave)) { volatile LAS unsigned long long* _s = (volatile LAS unsigned long long*)(F.lds + 132096); _s[1] = _s[1] + (__builtin_amdgcn_s_memrealtime() - _s[2]); } } while (0)
#define PG8_PB() do { if ((PROBE_CUSTOM) == 20 && (int)blockIdx.x == 0 && wid == 0 && lane == 0) ((volatile __attribute__((address_space(3))) unsigned long long*)(lds + 132096))[2] = __builtin_amdgcn_s_memrealtime(); } while (0)
#define PG8_PE() do { if ((PROBE_CUSTOM) == 20 && (int)blockIdx.x == 0 && wid == 0 && lane == 0) { volatile __attribute__((address_space(3))) unsigned long long* _s = (volatile __attribute__((address_space(3))) unsigned long long*)(lds + 132096); _s[1] = _s[1] + (__builtin_amdgcn_s_memrealtime() - _s[2]); } } while (0)
#ifndef MK_ONE_LAUNCH
#define MK_ONE_LAUNCH 1
#endif

#define GAS __attribute__((address_space(1)))
#define LAS __attribute__((address_space(3)))
typedef unsigned short bf16;
typedef short bf16x8 __attribute__((ext_vector_type(8)));
typedef float f32x4 __attribute__((ext_vector_type(4)));
typedef float f32x2 __attribute__((ext_vector_type(2)));
typedef unsigned u32x4 __attribute__((ext_vector_type(4)));
typedef unsigned u32x2 __attribute__((ext_vector_type(2)));

constexpr int D = 1024, NB = 4, TL = 4096, TC = 256, DEPTH = 4;
constexpr int MC = NB * TC, ML = NB * TL, M = MC + ML;
constexpr int INC = 2832, NP = 2816;
constexpr int FF = 2816, EF = 3584, NE = 8;
constexpr int MAXROWS = 36864;
constexpr float EPS = 1e-6f;
constexpr int PC_RQ = 0, PC_RK = 256, PC_RV = 512, PC_RG = 768, PC_GQKV = 1024, PC_GZ = 1792, PC_SQ = 2048, PC_SK = 2560, PC_SV = 2688;

constexpr size_t MiB = 1u << 20;
constexpr size_t WS_CTL = 0, CTL_ZERO_BYTES = 1 * MiB;
constexpr size_t WS_MOD = 1 * MiB;
constexpr size_t WS_ROPE = 2 * MiB;
constexpr size_t WS_TKE = 3 * MiB, WS_TKG = 3 * MiB + 256 * 1024, WS_TOKROW = 3 * MiB + 512 * 1024, WS_ROWTOK = 3 * MiB + 768 * 1024, WS_TILEE = 4 * MiB;
constexpr size_t WS_AB = 5 * MiB, WS_GB = 7 * MiB;
constexpr size_t WS_WIN = 16 * MiB, WS_WOUT = 38 * MiB, WS_W13 = 46 * MiB, WS_W2 = 68 * MiB, WS_MW13 = 80 * MiB, WS_MW2 = 192 * MiB;
constexpr size_t WS_XS = 248 * MiB, WS_H = 316 * MiB, WS_HP = 350 * MiB, WS_YM = 422 * MiB, WS_R1 = 566 * MiB;
constexpr size_t R1_P = 0, R1_PREP = 94 * MiB, R1_O = 158 * MiB, R1_OR = 192 * MiB, R1_OG = 226 * MiB, R1_HID = 0;
constexpr size_t WS_END = WS_R1 + 260 * MiB;
constexpr size_t WS_GCH = WS_YM, GCH_STEP = 40960, GCH_CHAIN = 68 * GCH_STEP, WS_GDEC = WS_HP;
constexpr size_t G2_STEP = 24576, G2_CHAIN = 68 * G2_STEP;
constexpr size_t WS_GST = WS_YM + 56 * MiB;
constexpr size_t WS_GCS = WS_HP + 64 * 1024;
static_assert(32 * G2_CHAIN <= 56 * MiB && 32 * 68 * 16384 <= 40 * MiB, "gdn v2 buffers");
constexpr size_t WS_RKV = WS_YM + 96 * MiB;
constexpr size_t WS_RST = WS_HP + 1 * MiB;
static_assert(32 * GCH_CHAIN <= 144 * MiB, "gdn chunk data");
constexpr size_t PREP_RQ = 0, PREP_RK = (size_t)M * 256 * 2, PREP_SQ = (size_t)M * 512 * 2, PREP_SK = (size_t)M * 1024 * 2, PREP_GD = (size_t)M * 1152 * 2;
static_assert(PREP_GD + (size_t)M * 768 * 2 <= 64 * MiB, "prep");
static_assert((size_t)M * NP * 2 <= 94 * MiB && (size_t)MAXROWS * EF * 2 <= 260 * MiB, "r1");

constexpr int CW_TMO = 0, CW_BAR = 4096;

__device__ __forceinline__ float bf2f(bf16 v) { return __uint_as_float(((unsigned)v) << 16); }
__device__ __forceinline__ unsigned f2bf(float f) { unsigned u = __float_as_uint(f); return (u + 0x7fffu + ((u >> 16) & 1u)) >> 16; }
__device__ __forceinline__ unsigned pk2(float lo, float hi) { return f2bf(lo) | (f2bf(hi) << 16); }
template <int CTRL> __device__ __forceinline__ float dppf(float v) { return __int_as_float(__builtin_amdgcn_update_dpp(0, __float_as_int(v), CTRL, 0xF, 0xF, true)); }
__device__ __forceinline__ float row_sum16(float v) {
    v += dppf<0xB1>(v); v += dppf<0x4E>(v); v += dppf<0x141>(v); v += dppf<0x140>(v); return v; }
__device__ __forceinline__ float wave_sum(float v) {
    v = row_sum16(v);
    return __int_as_float(__builtin_amdgcn_readlane(__float_as_int(v), 0)) + __int_as_float(__builtin_amdgcn_readlane(__float_as_int(v), 16))
         + __int_as_float(__builtin_amdgcn_readlane(__float_as_int(v), 32)) + __int_as_float(__builtin_amdgcn_readlane(__float_as_int(v), 48)); }
__device__ __forceinline__ float quad_rows_sum(float v) {
    u32x2 r = __builtin_amdgcn_permlane16_swap(__float_as_uint(v), __float_as_uint(v), false, false); v = __uint_as_float(r.x) + __uint_as_float(r.y);
    r = __builtin_amdgcn_permlane32_swap(__float_as_uint(v), __float_as_uint(v), false, false); return __uint_as_float(r.x) + __uint_as_float(r.y); }
__device__ __forceinline__ float quad_rows_max(float v) {
    u32x2 r = __builtin_amdgcn_permlane16_swap(__float_as_uint(v), __float_as_uint(v), false, false); v = fmaxf(__uint_as_float(r.x), __uint_as_float(r.y));
    r = __builtin_amdgcn_permlane32_swap(__float_as_uint(v), __float_as_uint(v), false, false); return fmaxf(__uint_as_float(r.x), __uint_as_float(r.y)); }
__device__ __forceinline__ float fexp2(float x) { return __builtin_amdgcn_exp2f(x); }
__device__ __forceinline__ float fexp(float x) { return __builtin_amdgcn_exp2f(x * 1.4426950408889634f); }
__device__ __forceinline__ float siluf(float x) { return x * __builtin_amdgcn_rcpf(1.0f + fexp(-x)); }
#define LDS_WAIT() asm volatile("s_waitcnt lgkmcnt(0)" ::: "memory")
__device__ __forceinline__ f32x4 mfma16(bf16x8 a, bf16x8 b, f32x4 c) { return __builtin_amdgcn_mfma_f32_16x16x32_bf16(a, b, c, 0, 0, 0); }
__device__ __forceinline__ unsigned cvtpk(float lo, float hi) { unsigned r; asm volatile("v_cvt_pk_bf16_f32 %0, %1, %2" : "=v"(r) : "v"(lo), "v"(hi)); return r; }


namespace pg8 {
#define PG8_LAS __attribute__((address_space(3)))
constexpr int BM = 256, BK = 64, HALF = 128, HTB = HALF * BK * 2, STAGE_BYTES = 8 * HTB;
__host__ __device__ __forceinline__ int lds_byte(int r, int c) { const int st = (r >> 4) * 2 + (c >> 5), rr = r & 15, cc = c & 31, ob = rr * 64 + cc * 2; return st * 1024 + (ob ^ (((ob >> 9) & 1) << 5)); }
__host__ __device__ __forceinline__ void stage_rc(int b, int& R, int& C) { const int st = b / 1024, sb = b % 1024, swz = sb ^ (((sb >> 9) & 1) << 5); R = (st >> 1) * 16 + swz / 64; C = (st & 1) * 32 + (swz % 64) / 2; }
__host__ __device__ __forceinline__ int perm32(int rho) { const int n = rho >> 4, i = rho & 15; return 8 * (i >> 2) + 4 * n + (i & 3); }
struct Unit { int pm, pn, aux; const char* A; const char* B; };
__device__ __forceinline__ unsigned cvt_pk_bf16(float lo, float hi) { unsigned r; asm volatile("v_cvt_pk_bf16_f32 %0, %1, %2" : "=v"(r) : "v"(lo), "v"(hi)); return r; }

template <int K, int LD, class Epi, class Sched, bool ALIGN_EPI = true, bool SP2 = true>
__device__ __forceinline__ void gemm_phase(PG8_LAS unsigned char* lds, const Sched& S, const Epi& E, const int tid) {
    const int wid = __builtin_amdgcn_readfirstlane(tid >> 6), lane = tid & 63, wr = wid >> 2, wc = wid & 3, fr = lane & 15, fq = lane >> 4;
    constexpr int nt = K / BK;
    unsigned voffA[2], voffB[2];
#pragma unroll
    for (int i = 0; i < 2; ++i) { int R, C; stage_rc(tid * 16 + i * 8192, R, C); const int Rb = Epi::PERM ? ((R & ~31) + perm32(R & 31)) : R;
        voffA[i] = (unsigned)(R * LD + C) * 2u; voffB[i] = (unsigned)(Rb * LD + C) * 2u; }
    constexpr size_t kstep = (size_t)(BK * 2);
    constexpr size_t hstep = (size_t)HALF * LD * 2;
    const unsigned ldsw = (unsigned)wid * 1024u;
    PG8_LAS unsigned short* gtab = (PG8_LAS unsigned short*)(lds + 133120);
    unsigned vG[2][2] = {{0u, 0u}, {0u, 0u}}; int gR[2] = {0, 0}; unsigned gC[2] = {0u, 0u};
    if constexpr (Sched::GATHER) {
        int tk[8];
#pragma unroll
        for (int j = 0; j < 8; ++j) { Unit tu; const bool ok = S.next(2 * j + (wid >> 2), tu); tk[j] = ok ? S.rowtok[tu.pm * 256 + (tid & 255)] : 0; }
#pragma unroll
        for (int j = 0; j < 8; ++j) gtab[(2 * j + (wid >> 2)) * 256 + (tid & 255)] = (unsigned short)tk[j];
        __syncthreads();
#pragma unroll
        for (int i = 0; i < 2; ++i) { int R, C; stage_rc(tid * 16 + i * 8192, R, C); gR[i] = R; gC[i] = (unsigned)C * 2u; }
#pragma unroll
        for (int h = 0; h < 2; ++h)
#pragma unroll
            for (int i = 0; i < 2; ++i) vG[h][i] = (unsigned)gtab[h * 128 + gR[i]] * (unsigned)(LD * 2) + gC[i];
    }
#define PG8_STGA(b, h, ptr) do { if constexpr (Sched::GATHER) PG8_STAGE(PG8_SA(b, h), (ptr), vG[h]); else PG8_STAGE(PG8_SA(b, h), (ptr) + (h) * hstep, voffA); } while (0)
    const int aoff = lds_byte(wr * 64 + fr, fq * 8), boff = lds_byte(wc * 32 + fr, fq * 8);
#define PG8_SA(b, h) (((b) * 2 + (h)) * HTB)
#define PG8_SB(b, h) ((4 + (b) * 2 + (h)) * HTB)
#define PG8_STAGE(bufoff, gbase, voff) do { _Pragma("unroll") for (int _i = 0; _i < 2; ++_i) \
        __builtin_amdgcn_global_load_lds((const unsigned*)((const char*)(gbase) + (voff)[_i]), (PG8_LAS unsigned*)(lds + (bufoff) + ldsw + _i * 8192), 16, 0, 0); } while (0)
#define PG8_LDA(dst, b, h) do { _Pragma("unroll") for (int m = 0; m < 4; ++m) _Pragma("unroll") for (int k = 0; k < 2; ++k) dst[m][k] = *(const PG8_LAS bf16x8*)(lds + PG8_SA(b, h) + aoff + m * 2048 + k * 1024); } while (0)
#define PG8_LDB(dst, b, h) do { _Pragma("unroll") for (int n = 0; n < 2; ++n) _Pragma("unroll") for (int k = 0; k < 2; ++k) dst[n][k] = *(const PG8_LAS bf16x8*)(lds + PG8_SB(b, h) + boff + n * 2048 + k * 1024); } while (0)
#define PG8_MMA(ai, bj, At, Bt) do { __builtin_amdgcn_s_setprio(1); _Pragma("unroll") for (int m = 0; m < 4; ++m) _Pragma("unroll") for (int n = 0; n < 2; ++n) _Pragma("unroll") for (int k = 0; k < 2; ++k) \
        acc[ai][bj][m][n] = __builtin_amdgcn_mfma_f32_16x16x32_bf16(Bt[n][k], At[m][k], acc[ai][bj][m][n], 0, 0, 0); __builtin_amdgcn_s_setprio(0); } while (0)
#define PG8_WAIT_V(n) asm volatile("s_waitcnt vmcnt(" #n ")" ::: "memory")
#define PG8_WAIT_L(n) asm volatile("s_waitcnt lgkmcnt(" #n ")" ::: "memory")
#define PG8_BAR __builtin_amdgcn_s_barrier()
#define PG8_SCHED __builtin_amdgcn_sched_barrier(0)
    Unit cur, nxt; int ui = 0;
    if (!S.next(0, cur)) return;
    f32x4 acc[2][2][4][2];
#pragma unroll
    for (int a = 0; a < 2; ++a)
#pragma unroll
        for (int b = 0; b < 2; ++b)
#pragma unroll
            for (int m = 0; m < 4; ++m)
#pragma unroll
                for (int n = 0; n < 2; ++n) acc[a][b][m][n] = (f32x4){0.f, 0.f, 0.f, 0.f};
    bf16x8 At[4][2], B0[2][2], B1[2][2];
    const char* cA = cur.A; const char* cB = cur.B;
    if constexpr (SP2) {
        PG8_STAGE(PG8_SB(0, 0), cB, voffB); PG8_STAGE(PG8_SB(0, 1), cB + hstep, voffB); PG8_STGA(0, 0, cA); PG8_STGA(0, 1, cA);
        if (wr == 1) PG8_BAR;
        PG8_WAIT_V(2); PG8_BAR;
        PG8_STAGE(PG8_SB(1, 0), cB + kstep, voffB); PG8_STGA(1, 0, cA + kstep); PG8_STAGE(PG8_SB(1, 1), cB + hstep + kstep, voffB);
        PG8_WAIT_V(6); PG8_BAR;
    } else {
        PG8_STAGE(PG8_SB(0, 0), cB, voffB); PG8_STAGE(PG8_SA(0, 0), cA, voffA); PG8_STAGE(PG8_SB(0, 1), cB + hstep, voffB); PG8_STAGE(PG8_SA(0, 1), cA + hstep, voffA);
        if (wr == 1) PG8_BAR;
        PG8_WAIT_V(4); PG8_BAR;
        PG8_STAGE(PG8_SB(1, 0), cB + kstep, voffB); PG8_STAGE(PG8_SA(1, 0), cA + kstep, voffA); PG8_STAGE(PG8_SB(1, 1), cB + hstep + kstep, voffB);
        PG8_WAIT_V(6); PG8_BAR;
    }
    for (;;) {
        const bool has_next = S.next(ui + 1, nxt);
        const char* nA = has_next ? nxt.A : cA; const char* nB = has_next ? nxt.B : cB;
        for (int t = 0; t < nt; t += 2) {
            const bool last = (t == nt - 2);
            const char* a1 = cA + (size_t)(t + 1) * kstep;
            const char* a2 = last ? nA : cA + (size_t)(t + 2) * kstep; const char* b2 = last ? nB : cB + (size_t)(t + 2) * kstep;
            const char* a3 = a2 + kstep; const char* b3 = b2 + kstep;
            if constexpr (SP2) {
            PG8_LDB(B0, 0, 0); PG8_LDB(B1, 0, 1); PG8_SCHED; PG8_LDA(At, 0, 0); PG8_STGA(1, 1, a1);
            if constexpr (Sched::GATHER) { if (last && has_next) { _Pragma("unroll") for (int h = 0; h < 2; ++h) _Pragma("unroll") for (int i = 0; i < 2; ++i) vG[h][i] = (unsigned)gtab[(ui + 1) * 256 + h * 128 + gR[i]] * (unsigned)(LD * 2) + gC[i]; } }
            PG8_WAIT_V(8); PG8_WAIT_L(0); PG8_BAR; PG8_MMA(0, 0, At, B0); PG8_MMA(0, 1, At, B1); PG8_BAR; PG8_SCHED;
            PG8_LDA(At, 0, 1); PG8_STAGE(PG8_SB(0, 0), b2, voffB); PG8_STAGE(PG8_SB(0, 1), b2 + hstep, voffB); PG8_STGA(0, 0, a2);
            PG8_WAIT_V(8); PG8_WAIT_L(0); PG8_BAR; PG8_MMA(1, 0, At, B0); PG8_MMA(1, 1, At, B1); PG8_BAR; PG8_SCHED;
            PG8_LDB(B0, 1, 0); PG8_LDB(B1, 1, 1); PG8_SCHED; PG8_LDA(At, 1, 0); PG8_STGA(0, 1, a2);
            PG8_WAIT_V(8); PG8_WAIT_L(0); PG8_BAR; PG8_MMA(0, 0, At, B0); PG8_MMA(0, 1, At, B1); PG8_BAR; PG8_SCHED;
            PG8_LDA(At, 1, 1); PG8_STAGE(PG8_SB(1, 0), b3, voffB); PG8_STAGE(PG8_SB(1, 1), b3 + hstep, voffB); PG8_STGA(1, 0, a3);
            PG8_WAIT_V(8); PG8_WAIT_L(0); PG8_BAR; PG8_MMA(1, 0, At, B0); PG8_MMA(1, 1, At, B1); PG8_BAR; PG8_SCHED;
            } else {
            PG8_LDB(B0, 0, 0); PG8_SCHED; PG8_LDA(At, 0, 0); PG8_STAGE(PG8_SA(1, 1), a1 + hstep, voffA);
            PG8_WAIT_L(8); PG8_BAR; PG8_WAIT_L(0); PG8_MMA(0, 0, At, B0); PG8_BAR; PG8_SCHED;
            PG8_LDB(B1, 0, 1); PG8_STAGE(PG8_SB(0, 0), b2, voffB);
            PG8_BAR; PG8_WAIT_L(0); PG8_MMA(0, 1, At, B1); PG8_BAR;
            PG8_LDA(At, 0, 1); PG8_STAGE(PG8_SA(0, 0), a2, voffA);
            PG8_BAR; PG8_WAIT_L(0); PG8_MMA(1, 0, At, B0); PG8_BAR; PG8_SCHED;
            PG8_STAGE(PG8_SB(0, 1), b2 + hstep, voffB);
            PG8_WAIT_V(6); PG8_BAR; PG8_MMA(1, 1, At, B1); PG8_BAR;
            PG8_LDB(B0, 1, 0); PG8_SCHED; PG8_LDA(At, 1, 0); PG8_STAGE(PG8_SA(0, 1), a2 + hstep, voffA);
            PG8_WAIT_L(8); PG8_BAR; PG8_WAIT_L(0); PG8_MMA(0, 0, At, B0); PG8_BAR; PG8_SCHED;
            PG8_LDB(B1, 1, 1); PG8_STAGE(PG8_SB(1, 0), b3, voffB);
            PG8_BAR; PG8_WAIT_L(0); PG8_MMA(0, 1, At, B1); PG8_BAR;
            PG8_LDA(At, 1, 1); PG8_STAGE(PG8_SA(1, 0), a3, voffA);
            PG8_BAR; PG8_WAIT_L(0); PG8_MMA(1, 0, At, B0); PG8_BAR; PG8_SCHED;
            PG8_STAGE(PG8_SB(1, 1), b3 + hstep, voffB);
            PG8_WAIT_V(6); PG8_BAR; PG8_MMA(1, 1, At, B1); PG8_BAR;
            }
        }
        if constexpr (ALIGN_EPI) { if (wr == 0) PG8_BAR; }
        PG8_PB();
        E(acc, cur, wr, wc, fr, fq);
        PG8_PE();
        if (!has_next) break;
#pragma unroll
        for (int a = 0; a < 2; ++a)
#pragma unroll
            for (int b = 0; b < 2; ++b)
#pragma unroll
                for (int m = 0; m < 4; ++m)
#pragma unroll
                    for (int n = 0; n < 2; ++n) acc[a][b][m][n] = (f32x4){0.f, 0.f, 0.f, 0.f};
        cur = nxt; cA = nA; cB = nB; ++ui;
        if constexpr (ALIGN_EPI) { if (wr == 1) PG8_BAR; }
    }
    PG8_WAIT_V(0);
    if constexpr (!ALIGN_EPI) { if (wr == 0) PG8_BAR; }
    PG8_BAR;
#undef PG8_SA
#undef PG8_SB
#undef PG8_STAGE
#undef PG8_STGA
#undef PG8_LDA
#undef PG8_LDB
#undef PG8_MMA
#undef PG8_WAIT_V
#undef PG8_WAIT_L
#undef PG8_BAR
#undef PG8_SCHED
}

struct StaticOrder {
    static constexpr bool GATHER = false;
    int nM, nN, nwg, G, c, pm_off; const char* A; const char* Bt; size_t tstep;
    __device__ void init(const void* A_, const void* Bt_, int M_, int N_, int K_, int G_, int c_, int pm_off_ = 0) { A = (const char*)A_; Bt = (const char*)Bt_; nM = M_ / BM; nN = N_ / BM; nwg = nM * nN; G = G_; c = c_; pm_off = pm_off_; tstep = (size_t)BM * K_ * 2; }
    __device__ bool next(int i, Unit& u) const {
        const long L = (long)i * G + c; if (L >= nwg) return false;
        int wgid = (int)L; { const int q = nwg / 8, r = nwg % 8, xcd = wgid % 8, off = wgid / 8; wgid = (xcd < r ? xcd * (q + 1) : r * (q + 1) + (xcd - r) * q) + off; }
        const int nig = 8 * nN, gid = wgid / nig, fm = gid * 8, gsz = (nM - fm) < 8 ? (nM - fm) : 8;
        u.pm = fm + ((wgid % nig) % gsz) + pm_off; u.pn = (wgid % nig) / gsz; u.aux = 0;
        u.A = A + (size_t)u.pm * tstep; u.B = Bt + (size_t)u.pn * tstep; return true;
    }
};
struct SplitOrder {
    static constexpr bool GATHER = false;
    int nks, nsub, G, c; const char* A; const char* Bt; size_t tstep;
    __device__ void init(const void* A_, const void* Bt_, int LD_, int nks_, int G_, int c_) { A = (const char*)A_; Bt = (const char*)Bt_; nks = nks_; nsub = 16 * nks_; G = G_; c = c_; tstep = (size_t)BM * LD_ * 2; }
    __device__ bool next(int i, Unit& u) const {
        const int L = i * G + c; if (L >= nsub) return false;
        const int ksl = L % nks, t = L / nks; u.pm = t >> 2; u.pn = t & 3; u.aux = ksl;
        u.A = A + (size_t)u.pm * tstep + (size_t)ksl * 512; u.B = Bt + (size_t)u.pn * tstep + (size_t)ksl * 512; return true;
    }
};
struct GroupedOrder {
    static constexpr bool GATHER = false;
    int nM, nN, nwg, G, c; const char* A; const char* Bt; size_t tstep, estep; const int* tile_e;
    __device__ void init(const void* A_, const void* Bt_, int ntiles, int N_, int K_, int G_, int c_, const int* te) { A = (const char*)A_; Bt = (const char*)Bt_; nM = ntiles; nN = N_ / BM; nwg = nM * nN; G = G_; c = c_; tstep = (size_t)BM * K_ * 2; estep = (size_t)N_ * K_ * 2; tile_e = te; }
    __device__ bool next(int i, Unit& u) const {
        const long L = (long)i * G + c; if (L >= nwg) return false;
        int wgid = (int)L; { const int q = nwg / 8, r = nwg % 8, xcd = wgid % 8, off = wgid / 8; wgid = (xcd < r ? xcd * (q + 1) : r * (q + 1) + (xcd - r) * q) + off; }
        const int nig = 8 * nN, gid = wgid / nig, fm = gid * 8, gsz = (nM - fm) < 8 ? (nM - fm) : 8;
        u.pm = fm + ((wgid % nig) % gsz); u.pn = (wgid % nig) / gsz; u.aux = __builtin_amdgcn_readfirstlane(tile_e[u.pm]);
        u.A = A + (size_t)u.pm * tstep; u.B = Bt + (size_t)u.aux * estep + (size_t)u.pn * tstep; return true;
    }
};

struct GatherOrder {
    static constexpr bool GATHER = true;
    int nM, nN, nwg, G, c; const char* A; const char* Bt; size_t tstep, estep; const int* tile_e; const int* rowtok;
    __device__ void init(const void* A_, const void* Bt_, int ntiles, int N_, int K_, int G_, int c_, const int* te, const int* rt) { A = (const char*)A_; Bt = (const char*)Bt_; nM = ntiles; nN = N_ / BM; nwg = nM * nN; G = G_; c = c_; tstep = (size_t)BM * K_ * 2; estep = (size_t)N_ * K_ * 2; tile_e = te; rowtok = rt; }
    __device__ bool next(int i, Unit& u) const {
        const long L = (long)i * G + c; if (L >= nwg) return false;
        int wgid = (int)L; { const int q = nwg / 8, r = nwg % 8, xcd = wgid % 8, off = wgid / 8; wgid = (xcd < r ? xcd * (q + 1) : r * (q + 1) + (xcd - r) * q) + off; }
        const int nig = 8 * nN, gid = wgid / nig, fm = gid * 8, gsz = (nM - fm) < 8 ? (nM - fm) : 8;
        u.pm = fm + ((wgid % nig) % gsz); u.pn = (wgid % nig) / gsz; u.aux = __builtin_amdgcn_readfirstlane(tile_e[u.pm]);
        u.A = A; u.B = Bt + (size_t)u.aux * estep + (size_t)u.pn * tstep; return true;
    }
};

struct SplitGroupedOrder {
    static constexpr bool GATHER = false;
    int t0, nsub, G, c; const char* A; const char* Bt; size_t tstep, estep; const int* tile_e;
    __device__ void init(const void* A_, const void* Bt_, int t0_, int nt_, int G_, int c_, const int* te) { A = (const char*)A_; Bt = (const char*)Bt_; t0 = t0_; nsub = nt_ * 16; G = G_; c = c_; tstep = (size_t)BM * EF * 2; estep = (size_t)D * EF * 2; tile_e = te; }
    __device__ bool next(int i, Unit& u) const {
        const int L = i * G + c; if (L >= nsub) return false;
        const int ksl = L & 3, t = L >> 2; u.pm = t0 + (t >> 2); u.pn = t & 3; u.aux = ksl;
        const int e = __builtin_amdgcn_readfirstlane(tile_e[u.pm]);
        u.A = A + (size_t)u.pm * tstep + (size_t)ksl * 896 * 2; u.B = Bt + (size_t)e * estep + (size_t)u.pn * tstep + (size_t)ksl * 896 * 2; return true;
    }
};
struct EpiBf16 {
    static constexpr bool PERM = true;
    bf16* O; int ldc;
    __device__ __forceinline__ void operator()(const f32x4 (&acc)[2][2][4][2], const Unit& u, int wr, int wc, int fr, int fq) const {
        const int row0 = u.pm * BM + wr * 64 + fr, col0 = u.pn * BM + wc * 32 + 8 * fq;
#pragma unroll
        for (int ai = 0; ai < 2; ++ai)
#pragma unroll
            for (int m = 0; m < 4; ++m) { bf16* rowp = O + (size_t)(row0 + ai * HALF + m * 16) * ldc + col0;
#pragma unroll
                for (int bj = 0; bj < 2; ++bj) { const f32x4 v0 = acc[ai][bj][m][0], v1 = acc[ai][bj][m][1];
                    u32x4 w; w.x = cvt_pk_bf16(v0[0], v0[1]); w.y = cvt_pk_bf16(v0[2], v0[3]); w.z = cvt_pk_bf16(v1[0], v1[1]); w.w = cvt_pk_bf16(v1[2], v1[3]);
                    *(u32x4*)(rowp + bj * HALF) = w; } }
    }
};
struct EpiResid {
    static constexpr bool PERM = false;
    float* X; const float* mod; int gsel; const float* Xsrc;
    __device__ __forceinline__ void operator()(const f32x4 (&acc)[2][2][4][2], const Unit& u, int wr, int wc, int fr, int fq) const {
        const int row0 = u.pm * BM + wr * 64 + fr, col0 = u.pn * BM + wc * 32 + 4 * fq;
        const int r = u.pm < 4 ? 4 : ((u.pm - 4) >> 4);
        const float* g = mod + (size_t)r * 6 * D + gsel * D;
        f32x4 gv[2][2];
#pragma unroll
        for (int bj = 0; bj < 2; ++bj)
#pragma unroll
            for (int n = 0; n < 2; ++n) gv[bj][n] = *(const f32x4*)(g + col0 + bj * HALF + n * 16);
#pragma unroll
        for (int ai = 0; ai < 2; ++ai)
#pragma unroll
            for (int m = 0; m < 4; ++m) { float* rowp = X + (size_t)(row0 + ai * HALF + m * 16) * D + col0; const float* srcp = Xsrc ? Xsrc + (size_t)(row0 + ai * HALF + m * 16 - MC) * D + col0 : rowp;
#pragma unroll
                for (int bj = 0; bj < 2; ++bj)
#pragma unroll
                    for (int n = 0; n < 2; ++n) { f32x4 x = *(const f32x4*)(srcp + bj * HALF + n * 16); x += gv[bj][n] * acc[ai][bj][m][n]; *(f32x4*)(rowp + bj * HALF + n * 16) = x; } }
    }
};
struct EpiSwiglu {
    static constexpr bool PERM = false;
    bf16* Hd; int ldh;
    __device__ __forceinline__ void operator()(const f32x4 (&acc)[2][2][4][2], const Unit& u, int wr, int wc, int fr, int fq) const {
        const int row0 = u.pm * BM + wr * 64 + fr, col0 = u.pn * 128 + wc * 16 + 4 * fq;
#pragma unroll
        for (int ai = 0; ai < 2; ++ai)
#pragma unroll
            for (int m = 0; m < 4; ++m) { bf16* rowp = Hd + (size_t)(row0 + ai * HALF + m * 16) * ldh + col0;
#pragma unroll
                for (int bj = 0; bj < 2; ++bj) { const f32x4 a = acc[ai][bj][m][0], b = acc[ai][bj][m][1];
                    float h[4];
#pragma unroll
                    for (int j = 0; j < 4; ++j) h[j] = a[j] * __builtin_amdgcn_rcpf(1.0f + __builtin_amdgcn_exp2f(-1.4426950408889634f * a[j])) * b[j];
                    u32x2 w; w.x = cvt_pk_bf16(h[0], h[1]); w.y = cvt_pk_bf16(h[2], h[3]);
                    *(u32x2*)(rowp + bj * 64) = w; } }
    }
};
struct EpiF32 {
    static constexpr bool PERM = false;
    float* C; int ldc;
    __device__ __forceinline__ void operator()(const f32x4 (&acc)[2][2][4][2], const Unit& u, int wr, int wc, int fr, int fq) const {
        const int row0 = u.pm * BM + wr * 64 + fr, col0 = u.pn * BM + wc * 32 + 4 * fq;
#pragma unroll
        for (int ai = 0; ai < 2; ++ai)
#pragma unroll
            for (int m = 0; m < 4; ++m) { float* rowp = C + (size_t)(row0 + ai * HALF + m * 16) * ldc + col0;
#pragma unroll
                for (int bj = 0; bj < 2; ++bj)
#pragma unroll
                    for (int n = 0; n < 2; ++n) *(f32x4*)(rowp + bj * HALF + n * 16) = acc[ai][bj][m][n]; }
    }
};
struct EpiSlab {
    static constexpr bool PERM = false;
    float* C;
    __device__ __forceinline__ void operator()(const f32x4 (&acc)[2][2][4][2], const Unit& u, int wr, int wc, int fr, int fq) const {
        const int row0 = u.pm * BM + wr * 64 + fr, col0 = u.pn * BM + wc * 32 + 4 * fq;
        float* base = C + (size_t)u.aux * MC * D;
#pragma unroll
        for (int ai = 0; ai < 2; ++ai)
#pragma unroll
            for (int m = 0; m < 4; ++m) { float* rowp = base + (size_t)(row0 + ai * HALF + m * 16) * D + col0;
#pragma unroll
                for (int bj = 0; bj < 2; ++bj)
#pragma unroll
                    for (int n = 0; n < 2; ++n) *(f32x4*)(rowp + bj * HALF + n * 16) = acc[ai][bj][m][n]; }
    }
};
struct EpiYMSlab {
    static constexpr bool PERM = false;
    float* YMp; float* slab; int row0s;
    __device__ __forceinline__ void operator()(const f32x4 (&acc)[2][2][4][2], const Unit& u, int wr, int wc, int fr, int fq) const {
        const int row0 = u.pm * BM + wr * 64 + fr, col0 = u.pn * BM + wc * 32 + 4 * fq;
        float* base = slab + ((size_t)u.aux * 4096 + (row0 - row0s)) * D;
#pragma unroll
        for (int ai = 0; ai < 2; ++ai)
#pragma unroll
            for (int m = 0; m < 4; ++m) { float* rowp = base + (size_t)(ai * HALF + m * 16) * D + col0;
#pragma unroll
                for (int bj = 0; bj < 2; ++bj)
#pragma unroll
                    for (int n = 0; n < 2; ++n) *(f32x4*)(rowp + bj * HALF + n * 16) = acc[ai][bj][m][n]; }
    }
};
}

__device__ __forceinline__ int lane_id_opaque() { int l; asm volatile("v_mbcnt_lo_u32_b32 %0, -1, 0\n\tv_mbcnt_hi_u32_b32 %0, -1, %0" : "=v"(l)); return l; }
#define XB_TMO      128
#define XB_XCNT(j)  (256  + 64 * (j))
#define XB_XSUB(j)  (1280 + 64 * (j))
#define XB_XGEN(j)  (2304 + 64 * (j))
#define XB_TOP      3328
#define XB_TOPGEN   3392
#define XCD_BAR_WORDS 3456
#define XB_SPIN_CAP (1u << 22)
__device__ __forceinline__ unsigned xb_ld(unsigned* p)              { return __hip_atomic_load(p, __ATOMIC_RELAXED, __HIP_MEMORY_SCOPE_AGENT); }
__device__ __forceinline__ unsigned xb_add(unsigned* p, unsigned v) { return __hip_atomic_fetch_add(p, v, __ATOMIC_RELAXED, __HIP_MEMORY_SCOPE_AGENT); }
__device__ __forceinline__ unsigned xb_xcc_id() { return (unsigned)__builtin_amdgcn_s_getreg((3 << 11) | 20) & 0xFu; }
#define XB_SPIN(cond, bar) do { unsigned _sp = 0; while (cond) { __builtin_amdgcn_s_sleep(1); \
    if ((++_sp & 255u) == 0u) { if (xb_ld(&(bar)[XB_TMO])) break; if (_sp > XB_SPIN_CAP) { atomicAdd(&(bar)[XB_TMO], 1u); break; } } } } while (0)
struct XcdBarrier { unsigned* bar; unsigned x; volatile LAS unsigned* st; int w0; };
__device__ __forceinline__ bool xb_leader(int w0) { return w0 == 0 && lane_id_opaque() == 0; }
__device__ __forceinline__ XcdBarrier xcd_barrier_post(unsigned* bar, volatile LAS unsigned* st) {
    XcdBarrier b; b.bar = bar; b.x = xb_xcc_id(); b.st = st; b.w0 = __builtin_amdgcn_readfirstlane(threadIdx.x >> 6);
    if (xb_leader(b.w0)) (void)xb_add(&bar[XB_XCNT(b.x)], 1u);
    return b;
}
__device__ __forceinline__ void xcd_barrier_complete(unsigned* bar, unsigned x, unsigned& nloc, unsigned& nx) {
    const unsigned G = gridDim.x * gridDim.y * gridDim.z;
    unsigned sum, cnt, mine, sp = 0u;
    for (;;) {
        sum = 0u; cnt = 0u; mine = 0u;
#pragma unroll
        for (unsigned j = 0; j < 16; ++j) { const unsigned c = xb_ld(&bar[XB_XCNT(j)]); sum += c; cnt += (c > 0u) ? 1u : 0u; mine = (j == x) ? c : mine; }
        if (sum == G) break;
        __builtin_amdgcn_s_sleep(1);
        if ((++sp & 255u) == 0u) { if (xb_ld(&bar[XB_TMO])) break; if (sp > XB_SPIN_CAP) { atomicAdd(&bar[XB_TMO], 1u); break; } }
    }
    nloc = mine > 0u ? mine : 1u; nx = cnt > 0u ? cnt : 1u;
}
__device__ __forceinline__ void xcd_barrier(const XcdBarrier& b) {
    asm volatile("s_waitcnt vmcnt(0)" ::: "memory");
    __syncthreads();
    if (xb_leader(b.w0)) {
        unsigned* bar = b.bar; unsigned bx = b.x;
        asm volatile("" : "+s"(bar), "+s"(bx));
        __builtin_amdgcn_s_waitcnt(0);
        unsigned nloc = b.st[0], nx = b.st[1];
        if (nloc == 0u) { xcd_barrier_complete(bar, bx, nloc, nx); b.st[0] = nloc; b.st[1] = nx; }
        const unsigned old = xb_add(&bar[XB_XSUB(bx)], 1u);
        const unsigned gen = old / nloc;
        if (old + 1u == (gen + 1u) * nloc) {
            __builtin_amdgcn_fence(__ATOMIC_RELEASE, "agent");
            asm volatile("s_waitcnt vmcnt(0)" ::: "memory");
            const unsigned og = xb_add(&bar[XB_TOP], 1u);
            const unsigned tg = og / nx;
            if (og + 1u == (tg + 1u) * nx) xb_add(&bar[XB_TOPGEN], 1u);
            else XB_SPIN(xb_ld(&bar[XB_TOPGEN]) == tg, bar);
            __builtin_amdgcn_fence(__ATOMIC_ACQUIRE, "agent");
            xb_add(&bar[XB_XGEN(bx)], 1u);
            asm volatile("s_waitcnt vmcnt(0)" ::: "memory");
        } else {
            XB_SPIN(xb_ld(&bar[XB_XGEN(bx)]) == gen, bar);
            __builtin_amdgcn_fence(__ATOMIC_ACQUIRE, "agent");
            asm volatile("s_waitcnt vmcnt(0)" ::: "memory");
        }
    }
    __syncthreads();
}

constexpr int NWAVES = 8, NTHR = 512;
constexpr int RING_BYTES = 131072, MISC_OFF = RING_BYTES + 320, LDS_BYTES = 147456;

struct Inputs {
    const float *x, *c, *ctx, *c_ctx, *ada_w, *ada_b, *norm1_g, *w_in, *ret_decay, *ret_gn_g, *gdn_conv_w, *gdn_a_log, *gdn_dt_bias, *gdn_norm_g, *swa_sink, *w_out, *norm2_g,
        *ffn_w1, *ffn_w3, *ffn_w2, *router_w, *moe_w1, *moe_w3, *moe_w2, *final_g;
};
struct Args { Inputs in; float* out; unsigned char* ws; int ph_lo, ph_hi; };
static_assert(sizeof(Args) == 25 * 8 + 8 + 8 + 8, "no padding");


__device__ __forceinline__ const float* ld_ptr(const LAS unsigned long long* t, int i) { const unsigned long long v = t[i]; const unsigned lo = __builtin_amdgcn_readfirstlane((unsigned)v), hi = __builtin_amdgcn_readfirstlane((unsigned)(v >> 32)); return (const float*)(GAS const float*)(((unsigned long long)hi << 32) | lo); }
__device__ __forceinline__ Inputs load_inputs(const LAS unsigned long long* t) {
    Inputs in; const float** ip = (const float**)&in;
#pragma unroll
    for (int i = 0; i < 25; ++i) ip[i] = ld_ptr(t, i);
    return in;
}
struct Frame {
    LAS unsigned char* lds;
    int tid, lane, wave, G, gw, NGW, bid;
    unsigned char* ws;
};


constexpr int CW_DYN = 8192;
struct DynQ { unsigned* ctr; volatile LAS int* slot; bool lead; };
__device__ __forceinline__ DynQ dyn_make(Frame& F, int layer, int k) { DynQ q; q.ctr = (unsigned*)(F.ws + WS_CTL) + CW_DYN + (layer * 8 + k) * 64; q.slot = (volatile LAS int*)(F.lds + MISC_OFF + 64); q.lead = F.wave == 0 && F.lane == 0; return q; }
__device__ __forceinline__ int dyn_grab(const DynQ& q) { return q.lead ? (int)__hip_atomic_fetch_add(q.ctr, 1u, __ATOMIC_RELAXED, __HIP_MEMORY_SCOPE_AGENT) : 0; }
__device__ __forceinline__ int dyn_bcast(const DynQ& q, int v) { __syncthreads(); if (q.lead) q.slot[0] = v; __syncthreads(); return __builtin_amdgcn_readfirstlane(q.slot[0]); }


#define XB2_XSUB(j)  (16384 + 64 * (j))
#define XB2_TOP      (16384 + 64 * 16)
#define XB2_GEN(j)   (16384 + 64 * (17 + (j)))
__device__ __forceinline__ void xb2_arrive(const XcdBarrier& b, unsigned* ctl) {
    asm volatile("s_waitcnt vmcnt(0)" ::: "memory");
    __syncthreads();
    if (xb_leader(b.w0)) {
        unsigned* c = ctl; unsigned bx = b.x;
        asm volatile("" : "+s"(c), "+s"(bx));
        __builtin_amdgcn_s_waitcnt(0);
        const unsigned nloc = b.st[0], nx = b.st[1];
        const unsigned old = xb_add(&c[XB2_XSUB(bx)], 1u);
        if ((old + 1u) % nloc == 0u) {
            __builtin_amdgcn_fence(__ATOMIC_RELEASE, "agent");
            asm volatile("s_waitcnt vmcnt(0)" ::: "memory");
            const unsigned og = xb_add(&c[XB2_TOP], 1u);
            if ((og + 1u) % nx == 0u) {
#pragma unroll
                for (unsigned j = 0; j < 16; ++j) xb_add(&c[XB2_GEN(j)], 1u); }
        }
    }
}
__device__ __forceinline__ void xb2_wait(const XcdBarrier& b, unsigned* ctl, unsigned round) {
    if (xb_leader(b.w0)) {
        unsigned* c = ctl; asm volatile("" : "+s"(c));
        unsigned sp = 0;
        while (xb_ld(&c[XB2_GEN(b.x)]) < round) { __builtin_amdgcn_s_sleep(1); if ((++sp & 255u) == 0u) { if (xb_ld(&c[CW_BAR + XB_TMO])) break; if (sp > XB_SPIN_CAP) { atomicAdd(&c[CW_BAR + XB_TMO], 1u); break; } } }
        __builtin_amdgcn_fence(__ATOMIC_ACQUIRE, "agent");
        asm volatile("s_waitcnt vmcnt(0)" ::: "memory");
    }
    __syncthreads();
}

constexpr int CW_RSYNC = 12288;
__device__ __forceinline__ void rsync_publish(Frame& F, int layer, int k = 0) {
    asm volatile("s_waitcnt vmcnt(0)" ::: "memory");
    __syncthreads();
    if (F.wave == 0 && F.lane == 0) { __builtin_amdgcn_fence(__ATOMIC_RELEASE, "agent"); asm volatile("s_waitcnt vmcnt(0)" ::: "memory");
        (void)xb_add((unsigned*)(F.ws + WS_CTL) + CW_RSYNC + (layer * 4 + k) * 64, 1u); }
}
__device__ __forceinline__ void rsync_wait(Frame& F, int layer, unsigned want, int k = 0) {
    if (F.wave == 0 && F.lane == 0) { unsigned* w = (unsigned*)(F.ws + WS_CTL) + CW_RSYNC + (layer * 4 + k) * 64; unsigned* tmo = (unsigned*)(F.ws + WS_CTL) + CW_BAR + XB_TMO;
        unsigned sp = 0; while (xb_ld(w) < want) { __builtin_amdgcn_s_sleep(2); if ((++sp & 255u) == 0u) { if (xb_ld(tmo)) break; if (sp > XB_SPIN_CAP) { atomicAdd(tmo, 1u); break; } } }
        __builtin_amdgcn_fence(__ATOMIC_ACQUIRE, "agent"); asm volatile("s_waitcnt vmcnt(0)" ::: "memory"); }
    __syncthreads();
}

template <class SrcF>
__device__ __forceinline__ void transpose_item(const SrcF& src, int K, bf16* WT, LAS float* scr, int k0, int n0, int lane) {
#pragma unroll
    for (int i = 0; i < 8; ++i) { const int row = 4 * i + (lane >> 4), col = 4 * (lane & 15); *(LAS f32x4*)(scr + row * 68 + col) = src(k0 + row, n0 + col); }
    LDS_WAIT(); asm volatile("" ::: "memory");
#pragma unroll
    for (int j = 0; j < 4; ++j) { const int ch = j * 64 + lane, n = ch >> 2, c8 = ch & 3; const LAS float* sp = scr + (8 * c8) * 68 + n;
        u32x4 o; o.x = cvtpk(sp[0 * 68], sp[1 * 68]); o.y = cvtpk(sp[2 * 68], sp[3 * 68]); o.z = cvtpk(sp[4 * 68], sp[5 * 68]); o.w = cvtpk(sp[6 * 68], sp[7 * 68]);
        *(u32x4*)(WT + (size_t)(n0 + n) * K + k0 + 8 * c8) = o; }
    LDS_WAIT(); asm volatile("" ::: "memory");
}
struct SrcPlain { const float* W; int ld; __device__ __forceinline__ f32x4 operator()(int k, int n) const { return *(const f32x4*)(W + (size_t)k * ld + n); } };
struct SrcWin { const float* W; __device__ __forceinline__ f32x4 operator()(int k, int n) const { return *(const f32x4*)(W + (size_t)k * INC + (n < 2048 ? n : n + 16)); } };
struct SrcGU { const float* W1; const float* W3; int ld; __device__ __forceinline__ f32x4 operator()(int k, int n) const { const int g = n >> 5, i = n & 31; const ptrdiff_t d = (i < 16) ? (ptrdiff_t)0 : (W3 - W1); return *(const f32x4*)(W1 + d + (ptrdiff_t)k * ld + 16 * g + (i & 15)); } };

__device__ __forceinline__ void convert_moe_layer(Frame& F, const Inputs& in, int mi, int part, int nwg, int nparts = 2) {
    LAS float* scr = (LAS float*)(F.lds + F.wave * 16384);
    bf16* mw13 = (bf16*)(F.ws + WS_MW13); bf16* mw2 = (bf16*)(F.ws + WS_MW2);
    constexpr int I13 = (D / 32) * (2 * EF / 64), I2 = (EF / 32) * (D / 64);
    if (F.bid >= nwg) return;
    constexpr int NIT = NE * (I13 + I2);
    const int lane = F.lane, lr = lane >> 4, lc = 4 * (lane & 15);
    const int it_end = (part + 1) * (NIT / nparts), step = nwg * NWAVES;
    int it = part * (NIT / nparts) + F.gw;
    const float* sp = nullptr; int ld = 0; bf16* dp = nullptr; int dK = 0;
#define CV_DESC(itv, SP, LDv, DP, DK) do { const int e_ = (itv) / (I13 + I2); int r_ = (itv) % (I13 + I2); const size_t wo_ = ((size_t)mi * NE + e_) * (size_t)D * EF; \
        if (r_ < I13) { const int nb_ = 2 * EF / 64, k0_ = 32 * (r_ / nb_), n0_ = 64 * (r_ % nb_), n_ = n0_ + lc, g_ = n_ >> 5, i_ = n_ & 31; \
            SP = (i_ < 16 ? in.moe_w1 : in.moe_w3) + wo_ + (size_t)(k0_ + lr) * EF + 16 * g_ + (i_ & 15); LDv = EF; DP = mw13 + (size_t)e_ * 2 * EF * D + (size_t)n0_ * D + k0_; DK = D; } \
        else { r_ -= I13; const int nb_ = D / 64, k0_ = 32 * (r_ / nb_), n0_ = 64 * (r_ % nb_); \
            SP = in.moe_w2 + wo_ + (size_t)(k0_ + lr) * D + n0_ + lc; LDv = D; DP = mw2 + (size_t)e_ * D * EF + (size_t)n0_ * EF + k0_; DK = EF; } } while (0)
    f32x4 rc[8];
    if (it < it_end) { CV_DESC(it, sp, ld, dp, dK);
#pragma unroll
        for (int i = 0; i < 8; ++i) rc[i] = *(const f32x4*)(sp + (size_t)(4 * i) * ld); }
    while (it < it_end) {
        const int itn = it + step; const bool hasn = itn < it_end;
        const float* spn = sp; int ldn = ld; bf16* dpn = dp; int dKn = dK;
        if (hasn) CV_DESC(itn, spn, ldn, dpn, dKn);
#pragma unroll
        for (int i = 0; i < 8; ++i) *(LAS f32x4*)(scr + (4 * i + lr) * 68 + lc) = rc[i];
        f32x4 rn[8];
#pragma unroll
        for (int i = 0; i < 8; ++i) rn[i] = *(const f32x4*)(spn + (size_t)(4 * i) * ldn);
        LDS_WAIT(); asm volatile("" ::: "memory");
#pragma unroll
        for (int j = 0; j < 4; ++j) { const int ch = j * 64 + lane, n = ch >> 2, c8 = ch & 3; const LAS float* q = scr + (8 * c8) * 68 + n;
            u32x4 o; o.x = cvtpk(q[0 * 68], q[1 * 68]); o.y = cvtpk(q[2 * 68], q[3 * 68]); o.z = cvtpk(q[4 * 68], q[5 * 68]); o.w = cvtpk(q[6 * 68], q[7 * 68]);
            *(u32x4*)(dp + (size_t)n * dK + 8 * c8) = o; }
        LDS_WAIT(); asm volatile("" ::: "memory");
        it = itn; sp = spn; ld = ldn; dp = dpn; dK = dKn;
#pragma unroll
        for (int i = 0; i < 8; ++i) rc[i] = rn[i];
    }
#undef CV_DESC
}
__device__ __forceinline__ void phase_prologue(Frame& F, const Inputs& in) {
    LAS float* scr = (LAS float*)(F.lds + F.wave * 16384);
    {
        constexpr int I_IN = (D / 32) * (NP / 64), I_OUT = (D / 32) * (D / 64), I_13 = (D / 32) * (2 * FF / 64), I_2 = (FF / 32) * (D / 64);
        constexpr int PER_L = I_IN + I_OUT, PER_F = I_13 + I_2, TOT = DEPTH * PER_L + 2 * PER_F;
        const int lane = F.lane, lr = lane >> 4, lc = 4 * (lane & 15);
        const float* sp = nullptr; int ld = 0; bf16* dp = nullptr; int dK = 0;
#define PD_DESC(itv, SP, LDv, DP, DK) do { if ((itv) < DEPTH * PER_L) { const int l_ = (itv) / PER_L; int r_ = (itv) % PER_L; \
            if (r_ < I_IN) { const int nb_ = NP / 64, k0_ = 32 * (r_ / nb_), n0_ = 64 * (r_ % nb_), n_ = n0_ + lc; \
                SP = in.w_in + (size_t)l_ * D * INC + (size_t)(k0_ + lr) * INC + (n_ < 2048 ? n_ : n_ + 16); LDv = INC; DP = (bf16*)(F.ws + WS_WIN) + (size_t)l_ * NP * D + (size_t)n0_ * D + k0_; DK = D; } \
            else { r_ -= I_IN; const int nb_ = D / 64, k0_ = 32 * (r_ / nb_), n0_ = 64 * (r_ % nb_); \
                SP = in.w_out + (size_t)l_ * D * D + (size_t)(k0_ + lr) * D + n0_ + lc; LDv = D; DP = (bf16*)(F.ws + WS_WOUT) + (size_t)l_ * D * D + (size_t)n0_ * D + k0_; DK = D; } } \
        else { const int q_ = (itv) - DEPTH * PER_L, i_ = q_ / PER_F; int r_ = q_ % PER_F; \
            if (r_ < I_13) { const int nb_ = 2 * FF / 64, k0_ = 32 * (r_ / nb_), n0_ = 64 * (r_ % nb_), n_ = n0_ + lc, g_ = n_ >> 5, j_ = n_ & 31; \
                SP = (j_ < 16 ? in.ffn_w1 : in.ffn_w3) + (size_t)i_ * D * FF + (size_t)(k0_ + lr) * FF + 16 * g_ + (j_ & 15); LDv = FF; DP = (bf16*)(F.ws + WS_W13) + (size_t)i_ * 2 * FF * D + (size_t)n0_ * D + k0_; DK = D; } \
            else { r_ -= I_13; const int nb_ = D / 64, k0_ = 32 * (r_ / nb_), n0_ = 64 * (r_ % nb_); \
                SP = in.ffn_w2 + (size_t)i_ * FF * D + (size_t)(k0_ + lr) * D + n0_ + lc; LDv = D; DP = (bf16*)(F.ws + WS_W2) + (size_t)i_ * D * FF + (size_t)n0_ * FF + k0_; DK = FF; } } } while (0)
        int it = F.gw; f32x4 rc[8];
        if (it < TOT) { PD_DESC(it, sp, ld, dp, dK);
#pragma unroll
            for (int i = 0; i < 8; ++i) rc[i] = *(const f32x4*)(sp + (size_t)(4 * i) * ld); }
        while (it < TOT) {
            const int itn = it + F.NGW; const bool hasn = itn < TOT;
            const float* spn = sp; int ldn = ld; bf16* dpn = dp; int dKn = dK;
            if (hasn) PD_DESC(itn, spn, ldn, dpn, dKn);
#pragma unroll
            for (int i = 0; i < 8; ++i) *(LAS f32x4*)(scr + (4 * i + lr) * 68 + lc) = rc[i];
            f32x4 rn[8];
#pragma unroll
            for (int i = 0; i < 8; ++i) rn[i] = *(const f32x4*)(spn + (size_t)(4 * i) * ldn);
            LDS_WAIT(); asm volatile("" ::: "memory");
#pragma unroll
            for (int j = 0; j < 4; ++j) { const int ch = j * 64 + lane, n = ch >> 2, c8 = ch & 3; const LAS float* q = scr + (8 * c8) * 68 + n;
                u32x4 o; o.x = cvtpk(q[0 * 68], q[1 * 68]); o.y = cvtpk(q[2 * 68], q[3 * 68]); o.z = cvtpk(q[4 * 68], q[5 * 68]); o.w = cvtpk(q[6 * 68], q[7 * 68]);
                *(u32x4*)(dp + (size_t)n * dK + 8 * c8) = o; }
            LDS_WAIT(); asm volatile("" ::: "memory");
            it = itn; sp = spn; ld = ldn; dp = dpn; dK = dKn;
#pragma unroll
            for (int i = 0; i < 8; ++i) rc[i] = rn[i];
        }
#undef PD_DESC
    }
    {
        __syncthreads();
        LAS float* sc = (LAS float*)F.lds;
        LAS float* red = (LAS float*)(F.lds + 32768);
        for (int i = F.tid; i < 5 * D; i += NTHR) { const int r = i / D, k = i % D; const float v = r < 4 ? in.c[r * D + k] : in.c_ctx[k]; sc[i] = siluf(v); }
        __syncthreads();
        float* mod = (float*)(F.ws + WS_MOD);
        for (int u = F.bid; u < DEPTH * 96; u += F.G) {
            const int l = u / 96, n = (u % 96) * 64 + F.lane;
            const float* w = in.ada_w + (size_t)l * D * 6 * D + n + (size_t)(F.wave * 128) * 6 * D;
            float a[5] = {0.f, 0.f, 0.f, 0.f, 0.f};
            float wv[128];
#pragma unroll
            for (int kk = 0; kk < 128; ++kk) wv[kk] = w[(size_t)kk * 6 * D];
#pragma unroll
            for (int kk = 0; kk < 128; ++kk) {
#pragma unroll
                for (int r = 0; r < 5; ++r) a[r] += sc[r * D + F.wave * 128 + kk] * wv[kk]; }
#pragma unroll
            for (int r = 0; r < 5; ++r) red[(F.wave * 5 + r) * 64 + F.lane] = a[r];
            __syncthreads();
            if (F.tid < 320) { const int r = F.tid / 64, ln = F.tid % 64; float s = 0.f;
#pragma unroll
                for (int w8 = 0; w8 < 8; ++w8) s += red[(w8 * 5 + r) * 64 + ln];
                const int nn = (u % 96) * 64 + ln;
                mod[((size_t)l * 5 + r) * 6 * D + nn] = s + in.ada_b[(size_t)l * 6 * D + nn]; }
            __syncthreads();
        }
    }
    if (F.bid == F.G - 1) { float* rp = (float*)(F.ws + WS_ROPE);
        for (int i = F.tid; i < 64 * 16; i += NTHR) { const int pos = i / 16, fi = i % 16; const double inv = pow(10000.0, -(double)fi / 16.0), ang = (double)pos * inv; rp[2 * i] = (float)cos(ang); rp[2 * i + 1] = (float)sin(ang); } }
}

__device__ __forceinline__ int mod_row(int m) { return m < MC ? 4 : ((m - MC) >> 12); }


template <int MODE>
__device__ __forceinline__ void phase_token2(Frame& F, const Inputs& in, int layer, bool first_from_input, bool combine_moe, bool moe_router, float* out, int route_lo = 0, int nslab = 0) {
    float* XS = (float*)(F.ws + WS_XS);
    bf16* H = (bf16*)(F.ws + WS_H);
    const float* mod = (const float*)(F.ws + WS_MOD) + (size_t)(layer < DEPTH ? layer : DEPTH - 1) * 5 * 6 * D;
    const float* modprev = (const float*)(F.ws + WS_MOD) + (size_t)(layer > 0 ? layer - 1 : 0) * 5 * 6 * D;
    const float* TKG = (const float*)(F.ws + WS_TKG); const int* TOKROW = (const int*)(F.ws + WS_TOKROW);
    const bf16* YM = (const bf16*)(F.ws + WS_YM);
    LAS float* wl = (LAS float*)F.lds;
    const int lane = F.lane;
    if (MODE == 0) PB(8);
    if (MODE == 0) { __syncthreads(); const float* w = in.w_in + (size_t)layer * D * INC + 2048;
#pragma unroll
        for (int n = 0; n < 8; ++n) { const int k = (F.tid >> 2) + 128 * n, q4 = F.tid & 3, kp = ((k >> 8) * 4 + (k & 3)) * 64 + ((k >> 2) & 63);
            *(LAS f32x4*)(wl + (q4 * 1024 + kp) * 4) = *(const f32x4*)(w + (size_t)k * INC + 4 * q4); }
        __syncthreads(); }
    LAS int* lcnt = (LAS int*)(F.lds + 61440);
    if (MODE == 1 && moe_router) { __syncthreads(); if (F.tid < 8) lcnt[F.tid] = 0; const float* w = in.router_w + (size_t)(layer >> 1) * D * NE;
#pragma unroll
        for (int n = 0; n < 4; ++n) { const int k = (F.tid >> 1) + 256 * n, q4 = F.tid & 1, kp = ((k >> 8) * 4 + (k & 3)) * 64 + ((k >> 2) & 63);
            *(LAS f32x4*)(wl + (q4 * 1024 + kp) * 4) = *(const f32x4*)(w + (size_t)k * NE + 4 * q4); }
        __syncthreads(); }
    if (MODE == 0) PE(8);
    if (MODE == 0) PB(9);
    if (MODE == 1) PB(10);
    const float* gain = MODE == 0 ? in.norm1_g + (size_t)layer * D : (MODE == 1 ? in.norm2_g + (size_t)layer * D : in.final_g);
    const bool has_ctx = (MODE != 2) && F.gw < MC;
    const int r_beg = MC + (int)(((long)F.gw * ML) / F.NGW), r_end = MC + (int)(((long)(F.gw + 1) * ML) / F.NGW);
    if (nslab > 0 && has_ctx) {
        const float* sb = (const float*)(F.ws + WS_R1 + 100 * MiB); const float* gsrc = (MODE == 1 ? mod + (size_t)4 * 6 * D + 2 * D : modprev + (size_t)4 * 6 * D + 5 * D);
        { const int m = F.gw;
#pragma unroll
            for (int j = 0; j < 4; ++j) { f32x4 a0 = (f32x4){0.f, 0.f, 0.f, 0.f};
                for (int sidx = 0; sidx < nslab; ++sidx) a0 += *(const f32x4*)(sb + ((size_t)sidx * MC + m) * D + 4 * lane + 256 * j);
                float* xp = XS + (size_t)m * D + 4 * lane + 256 * j; *(f32x4*)xp = *(const f32x4*)xp + *(const f32x4*)(gsrc + 4 * lane + 256 * j) * a0; } }
        asm volatile("s_waitcnt vmcnt(0)" ::: "memory");
    }
    if (combine_moe) {
        const int ntl = ((const int*)(F.ws + WS_TILEE))[256]; const int srow = ((ntl - (ntl / 64) * 64 <= 16) ? (ntl / 64) * 64 : ntl) * 256; const float* sl = (const float*)(F.ws + WS_HP);
        bf16* YMw = (bf16*)(F.ws + WS_YM);
        for (int m0 = has_ctx ? r_beg - 1 : r_beg; m0 < r_end; ++m0) { const int m = m0 < r_beg ? F.gw : m0;
            if (MODE == 0 && layer == DEPTH && m < MC) continue;
#pragma unroll
            for (int k = 0; k < 2; ++k) { const int r = TOKROW[2 * m + k];
                if (r >= srow) { const size_t o = (size_t)(r - srow) * D;
#pragma unroll
                    for (int j = 0; j < 4; ++j) { const f32x4 y = ((*(const f32x4*)(sl + o + 4 * lane + 256 * j) + *(const f32x4*)(sl + (size_t)4096 * D + o + 4 * lane + 256 * j)) + *(const f32x4*)(sl + (size_t)8192 * D + o + 4 * lane + 256 * j)) + *(const f32x4*)(sl + (size_t)12288 * D + o + 4 * lane + 256 * j);
                        u32x2 wv; wv.x = cvtpk(y.x, y.y); wv.y = cvtpk(y.z, y.w); *(u32x2*)(YMw + (size_t)r * D + 4 * lane + 256 * j) = wv; } } } }
        asm volatile("s_waitcnt vmcnt(0)" ::: "memory");
    }
    f32x4 gv[4], av[4], bv[4], gt[4];
#pragma unroll
    for (int j = 0; j < 4; ++j) gv[j] = *(const f32x4*)(gain + 4 * lane + 256 * j);
    int rcur = -1;
    for (int m0 = has_ctx ? r_beg - 1 : r_beg; m0 < r_end; m0 += 2) {
        const bool isc = m0 < r_beg;
        const int ma = isc ? F.gw : m0; const bool two = !isc && ma + 1 < r_end; const int m1 = two ? ma + 1 : ma;
        if (isc) m0 -= 1;
        const int r = mod_row(ma);
        const bool same = mod_row(m1) == r;
        const int mm1 = same ? m1 : ma; const bool do1 = two && same;
        if (!same) m0 -= 1;
        if (r != rcur) { rcur = r;
            if (MODE != 2) { const float* sh = mod + (size_t)r * 6 * D + (MODE == 0 ? 0 : 3) * D;
#pragma unroll
                for (int j = 0; j < 4; ++j) { const f32x4 s1 = *(const f32x4*)(sh + D + 4 * lane + 256 * j); av[j] = gv[j] * (1.0f + s1); bv[j] = *(const f32x4*)(sh + 4 * lane + 256 * j); } }
            if (combine_moe) {
#pragma unroll
                for (int j = 0; j < 4; ++j) gt[j] = *(const f32x4*)(modprev + (size_t)r * 6 * D + 5 * D + 4 * lane + 256 * j); } }
        const int mr[2] = {ma, mm1};
        f32x4 v[2][4];
        int t0[2], t1[2]; float g0[2], g1[2];
        if (combine_moe) {
#pragma unroll
            for (int p = 0; p < 2; ++p) { t0[p] = TOKROW[2 * mr[p]]; t1[p] = TOKROW[2 * mr[p] + 1]; g0[p] = TKG[2 * mr[p]]; g1[p] = TKG[2 * mr[p] + 1]; } }
#pragma unroll
        for (int p = 0; p < 2; ++p) { const int m = mr[p];
            const float* xrow = first_from_input ? (m < MC ? in.ctx + (size_t)m * D : in.x + (size_t)(m - MC) * D) : XS + (size_t)m * D;
#pragma unroll
            for (int j = 0; j < 4; ++j) v[p][j] = *(const f32x4*)(xrow + 4 * lane + 256 * j); }
        if (combine_moe) {
#pragma unroll
            for (int p = 0; p < 2; ++p)
#pragma unroll
                for (int j = 0; j < 4; ++j) { const u32x2 a = *(const u32x2*)(YM + (size_t)t0[p] * D + 4 * lane + 256 * j), b = *(const u32x2*)(YM + (size_t)t1[p] * D + 4 * lane + 256 * j);
                    const f32x4 y0 = (f32x4){__uint_as_float(a.x << 16), __uint_as_float(a.x & 0xffff0000u), __uint_as_float(a.y << 16), __uint_as_float(a.y & 0xffff0000u)};
                    const f32x4 y1 = (f32x4){__uint_as_float(b.x << 16), __uint_as_float(b.x & 0xffff0000u), __uint_as_float(b.y << 16), __uint_as_float(b.y & 0xffff0000u)};
                    v[p][j] += gt[j] * (g0[p] * y0 + g1[p] * y1); } }
        if (((first_from_input && ma < MC) || combine_moe) && MODE != 2) {
#pragma unroll
            for (int p = 0; p < 2; ++p) if (p == 0 || do1) {
#pragma unroll
                for (int j = 0; j < 4; ++j) *(f32x4*)(XS + (size_t)mr[p] * D + 4 * lane + 256 * j) = v[p][j]; } }
        float rstd[2];
#pragma unroll
        for (int p = 0; p < 2; ++p) { float ss = 0.f;
#pragma unroll
            for (int j = 0; j < 4; ++j) ss += (v[p][j].x * v[p][j].x + v[p][j].y * v[p][j].y) + (v[p][j].z * v[p][j].z + v[p][j].w * v[p][j].w);
            rstd[p] = 1.0f / sqrtf(wave_sum(ss) * (1.0f / D) + EPS); }
        if (MODE == 2) {
#pragma unroll
            for (int p = 0; p < 2; ++p) if (p == 0 || do1) {
#pragma unroll
                for (int j = 0; j < 4; ++j) *(f32x4*)(out + (size_t)(mr[p] - MC) * D + 4 * lane + 256 * j) = v[p][j] * rstd[p] * gv[j]; }
            continue; }
        f32x4 h[2][4];
#pragma unroll
        for (int p = 0; p < 2; ++p)
#pragma unroll
            for (int j = 0; j < 4; ++j) { h[p][j] = v[p][j] * rstd[p] * av[j] + bv[j];
                if (p == 0 || do1) { u32x2 w; w.x = cvtpk(h[p][j].x, h[p][j].y); w.y = cvtpk(h[p][j].z, h[p][j].w); *(u32x2*)(H + (size_t)mr[p] * D + 4 * lane + 256 * j) = w; } }
        if (MODE == 0 || (MODE == 1 && moe_router)) {
            constexpr int NC = (MODE == 0) ? 16 : 8;
            float a[2][NC];
#pragma unroll
            for (int p = 0; p < 2; ++p)
#pragma unroll
                for (int c = 0; c < NC; ++c) a[p][c] = 0.f;
#pragma unroll
            for (int j = 0; j < 4; ++j)
#pragma unroll
                for (int e = 0; e < 4; ++e) { const int kp = (j * 4 + e) * 64 + lane;
#pragma unroll
                    for (int q = 0; q < NC / 4; ++q) { const f32x4 w = *(const LAS f32x4*)(wl + (q * 1024 + kp) * 4);
#pragma unroll
                        for (int p = 0; p < 2; ++p) { const float hv = h[p][j][e]; a[p][4 * q] += hv * w.x; a[p][4 * q + 1] += hv * w.y; a[p][4 * q + 2] += hv * w.z; a[p][4 * q + 3] += hv * w.w; } } }
#pragma unroll
            for (int p = 0; p < 2; ++p) {
#pragma unroll
                for (int c = 0; c < NC; ++c) a[p][c] = wave_sum(a[p][c]); }
#pragma unroll
            for (int p = 0; p < 2; ++p) if (p == 0 || do1) { const int m = mr[p];
                if (MODE == 0) { float mine = 0.f;
#pragma unroll
                    for (int c = 0; c < NC; ++c) mine = (lane == c) ? a[p][c] : mine;
                    if (lane < 16) ((float*)(F.ws + WS_AB))[(size_t)m * 16 + lane] = mine; }
                else { int i0 = 0; float l0 = a[p][0];
#pragma unroll
                    for (int c = 1; c < NC; ++c) if (a[p][c] > l0) { l0 = a[p][c]; i0 = c; }
                    int i1 = -1; float l1 = -3.0e38f;
#pragma unroll
                    for (int c = 0; c < NC; ++c) if (c != i0 && a[p][c] > l1) { l1 = a[p][c]; i1 = c; }
                    const float e1 = fexp(l1 - l0), gg0 = 1.0f / (1.0f + e1), gg1 = e1 / (1.0f + e1);
                    if (lane == 0 && m >= route_lo) { ((int*)(F.ws + WS_TKE))[2 * m] = i0; ((int*)(F.ws + WS_TKE))[2 * m + 1] = i1; ((float*)(F.ws + WS_TKG))[2 * m] = gg0; ((float*)(F.ws + WS_TKG))[2 * m + 1] = gg1;
                        ((int*)(F.ws + WS_TOKROW))[2 * m] = __hip_atomic_fetch_add(lcnt + i0, 1, __ATOMIC_RELAXED, __HIP_MEMORY_SCOPE_WORKGROUP); ((int*)(F.ws + WS_TOKROW))[2 * m + 1] = __hip_atomic_fetch_add(lcnt + i1, 1, __ATOMIC_RELAXED, __HIP_MEMORY_SCOPE_WORKGROUP); } } }
        }
    }
    if (MODE == 0) PE(9);
    if (MODE == 1) PE(10);
    if (MODE == 1 && moe_router) { __syncthreads(); if (F.tid < 8) ((int*)(F.ws + WS_TILEE + 4096))[F.bid * 8 + F.tid] = lcnt[F.tid]; }
}


__device__ __forceinline__ void unpack8(const u32x4 w, float (&v)[8]) {
#pragma unroll
    for (int e = 0; e < 4; ++e) { v[2 * e] = __uint_as_float(w[e] << 16); v[2 * e + 1] = __uint_as_float(w[e] & 0xffff0000u); } }
__device__ __forceinline__ u32x4 pack8(const float (&v)[8]) { u32x4 w; w.x = cvtpk(v[0], v[1]); w.y = cvtpk(v[2], v[3]); w.z = cvtpk(v[4], v[5]); w.w = cvtpk(v[6], v[7]); return w; }


__device__ __forceinline__ void phase_prep3(Frame& F, const Inputs& in, int layer) {
    const bf16* P = (const bf16*)(F.ws + WS_R1 + R1_P);
    unsigned char* prep = F.ws + WS_R1 + R1_PREP;
    bf16* RQ = (bf16*)(prep + PREP_RQ); bf16* RK = (bf16*)(prep + PREP_RK); bf16* SQ = (bf16*)(prep + PREP_SQ); bf16* SK = (bf16*)(prep + PREP_SK); bf16* GD = (bf16*)(prep + PREP_GD);
    const float* rope = (const float*)(F.ws + WS_ROPE);
    const float* AB = (const float*)(F.ws + WS_AB); float* GB = (float*)(F.ws + WS_GB);
    const float* cw = in.gdn_conv_w + (size_t)layer * 5 * 768;
    const int lane = F.lane, l3 = lane & 3, l31 = lane & 31;
    float wA[5][8], wB[5][8];
#pragma unroll
    for (int j = 0; j < 5; ++j) { const f32x4 a0 = *(const f32x4*)(cw + j * 768 + 8 * lane), a1 = *(const f32x4*)(cw + j * 768 + 8 * lane + 4), b0 = *(const f32x4*)(cw + j * 768 + 512 + 8 * l31), b1 = *(const f32x4*)(cw + j * 768 + 512 + 8 * l31 + 4);
#pragma unroll
        for (int x = 0; x < 4; ++x) { wA[j][x] = a0[x]; wA[j][4 + x] = a1[x]; wB[j][x] = b0[x]; wB[j][4 + x] = b1[x]; } }
    const float sgn = ((lane & 7) < 4) ? -1.0f : 1.0f;
    const bool isk = lane >= 32;
    const float dtb = in.gdn_dt_bias[layer * 8 + (lane & 7)], alg = -fexp(in.gdn_a_log[layer * 8 + (lane & 7)]);
    for (int mbase = F.gw; mbase < M; mbase += 2 * F.NGW) {
        const bool ok1 = mbase + F.NGW < M;
        const int mm[2] = {mbase, ok1 ? mbase + F.NGW : mbase};
        bool lat[2]; int tt0[2], Tn[2]; const bf16* prow[2];
#pragma unroll
        for (int p = 0; p < 2; ++p) { const int m = mm[p]; lat[p] = m >= MC; tt0[p] = lat[p] ? ((m - MC) & (TL - 1)) : (m & (TC - 1)); Tn[p] = lat[p] ? TL : TC; prow[p] = P + (size_t)m * NP; }
        f32x4 rt[2][4]; u32x4 u1[2], u2[2], u3[2];
#pragma unroll
        for (int p = 0; p < 2; ++p) { const int t = tt0[p]; const int pos = (l3 < 2) ? (t >> 6) : (t & 63); const float* rp = rope + (pos * 16 + 8 * (l3 & 1)) * 2;
            rt[p][0] = *(const f32x4*)(rp); rt[p][1] = *(const f32x4*)(rp + 4); rt[p][2] = *(const f32x4*)(rp + 8); rt[p][3] = *(const f32x4*)(rp + 12);
            u1[p] = *(const u32x4*)(prow[p] + (isk ? PC_RK : PC_RQ) + 8 * l31); u2[p] = *(const u32x4*)(prow[p] + PC_SQ + 8 * lane); u3[p] = *(const u32x4*)(prow[p] + PC_SK + 8 * (lane & 15)); }
        __builtin_amdgcn_sched_barrier(0);
#pragma unroll
        for (int p = 0; p < 2; ++p) { const int m = mm[p]; const bool st = (p == 0) || ok1;
            float cs[8], sn[8];
#pragma unroll
            for (int x = 0; x < 8; ++x) { cs[x] = rt[p][x >> 1][(x & 1) * 2]; sn[x] = rt[p][x >> 1][(x & 1) * 2 + 1]; if (!lat[p]) { cs[x] = 1.0f; sn[x] = 0.0f; } sn[x] *= sgn; }
            { float v[8], o[8]; unpack8(u1[p], v);
#pragma unroll
              for (int x = 0; x < 8; ++x) { if (isk) v[x] *= 0.125f; const float pv = __shfl_xor(v[x], 4); o[x] = v[x] * cs[x] + pv * sn[x]; }
              if (st) *(u32x4*)((isk ? RK : RQ) + (size_t)m * 256 + 8 * l31) = pack8(o); }
            { float v[8], o[8]; unpack8(u2[p], v);
#pragma unroll
              for (int x = 0; x < 8; ++x) { const float pv = __shfl_xor(v[x], 4); o[x] = v[x] * cs[x] + pv * sn[x]; }
              if (st) *(u32x4*)(SQ + (size_t)m * 512 + 8 * lane) = pack8(o); }
            { float v[8], o[8]; unpack8(u3[p], v);
#pragma unroll
              for (int x = 0; x < 8; ++x) { const float pv = __shfl_xor(v[x], 4); o[x] = v[x] * cs[x] + pv * sn[x]; }
              if (st && lane < 16) *(u32x4*)(SK + (size_t)m * 128 + 8 * lane) = pack8(o); } }
        { u32x4 ca[2][5];
#pragma unroll
          for (int p = 0; p < 2; ++p)
#pragma unroll
              for (int j = 0; j < 5; ++j) { const int tt = tt0[p] + j - 2; const bool ok = tt >= 0 && tt < Tn[p]; ca[p][j] = *(const u32x4*)(prow[p] + (ok ? (ptrdiff_t)(j - 2) * NP : (ptrdiff_t)0) + PC_GQKV + 8 * lane); }
          __builtin_amdgcn_sched_barrier(0);
#pragma unroll
          for (int p = 0; p < 2; ++p) { float a[8];
#pragma unroll
              for (int x = 0; x < 8; ++x) a[x] = 0.f;
#pragma unroll
              for (int j = 0; j < 5; ++j) { const int tt = tt0[p] + j - 2; const float z = (tt >= 0 && tt < Tn[p]) ? 1.0f : 0.0f; float va[8]; unpack8(ca[p][j], va);
#pragma unroll
                  for (int x = 0; x < 8; ++x) a[x] += z * wA[j][x] * va[x]; }
              float n2 = 0.f;
#pragma unroll
              for (int x = 0; x < 8; ++x) { a[x] = siluf(a[x]); n2 += a[x] * a[x]; }
              n2 += dppf<0xB1>(n2); n2 += dppf<0x4E>(n2); n2 += dppf<0x141>(n2);
              const float sc = __builtin_amdgcn_rsqf(n2 + EPS) * (lane < 32 ? 0.125f : 1.0f);
#pragma unroll
              for (int x = 0; x < 8; ++x) a[x] *= sc;
              if (p == 0 || ok1) *(u32x4*)(GD + (size_t)mm[p] * 768 + 8 * lane) = pack8(a); } }
        { u32x4 cb[2][5]; float abv[2];
#pragma unroll
          for (int p = 0; p < 2; ++p) {
#pragma unroll
              for (int j = 0; j < 5; ++j) { const int tt = tt0[p] + j - 2; const bool ok = tt >= 0 && tt < Tn[p]; cb[p][j] = *(const u32x4*)(prow[p] + (ok ? (ptrdiff_t)(j - 2) * NP : (ptrdiff_t)0) + PC_GQKV + 512 + 8 * l31); }
              abv[p] = AB[(size_t)mm[p] * 16 + (lane & 15)]; }
          __builtin_amdgcn_sched_barrier(0);
#pragma unroll
          for (int p = 0; p < 2; ++p) { const int m = mm[p]; float bq[8];
#pragma unroll
              for (int x = 0; x < 8; ++x) bq[x] = 0.f;
#pragma unroll
              for (int j = 0; j < 5; ++j) { const int tt = tt0[p] + j - 2; const float z = (tt >= 0 && tt < Tn[p]) ? 1.0f : 0.0f; float vb[8]; unpack8(cb[p][j], vb);
#pragma unroll
                  for (int x = 0; x < 8; ++x) bq[x] += z * wB[j][x] * vb[x]; }
#pragma unroll
              for (int x = 0; x < 8; ++x) bq[x] = siluf(bq[x]);
              if (p == 0 || ok1) { if (lane < 32) *(u32x4*)(GD + (size_t)m * 768 + 512 + 8 * lane) = pack8(bq);
                  if (lane < 16) { const float av = abv[p]; float o;
                      if (lane < 8) { const float xx = av + dtb; const float sp = fmaxf(xx, 0.f) + log1pf(fexp(-fabsf(xx))); o = alg * sp; }
                      else o = __builtin_amdgcn_rcpf(1.0f + fexp(-av));
                      GB[(size_t)m * 16 + lane] = o; } } } }
    }
}


__device__ __forceinline__ void phase_swa2(Frame& F, const Inputs& in, int layer, int nwg) {
    if (F.bid >= nwg) return;
    const bf16* P = (const bf16*)(F.ws + WS_R1 + R1_P);
    unsigned char* prep = F.ws + WS_R1 + R1_PREP;
    const bf16* SQ = (const bf16*)(prep + PREP_SQ); const bf16* SK = (const bf16*)(prep + PREP_SK);
    bf16* O = (bf16*)(F.ws + WS_R1 + R1_O);
    LAS bf16* Kbuf = (LAS bf16*)F.lds;
    const int lane = F.lane, c = lane & 15, q = lane >> 4, w = F.wave;
    const float LOG2E = 1.4426950408889634f;
    const int srow = F.tid >> 3, scol = (F.tid & 7) * 8;
    DynQ dq = dyn_make(F, layer, 1);
    const int i0 = 32 * (w & 1);
    bf16x8 qn[2][2]; u32x4 kreg, vreg, kreg2, vreg2;
#define SWA_PREFETCH(uu) do { const bool lat_ = (uu) < 512; int b_, g_, qb_; if (lat_) { b_ = (uu) >> 7; g_ = ((uu) >> 6) & 1; qb_ = (uu) & 63; } else { const int u2_ = (uu) - 512; b_ = u2_ >> 3; g_ = (u2_ >> 2) & 1; qb_ = u2_ & 3; } \
        const int hq_ = 4 * g_ + (w >> 1), mrow0_ = lat_ ? MC + b_ * TL + 64 * qb_ : b_ * TC + 64 * qb_; const int kt0_ = lat_ ? (2 - qb_ > 0 ? 2 - qb_ : 0) : 0; \
        const int r0_ = lat_ ? MC + b_ * TL + 64 * qb_ - 128 + 64 * kt0_ : b_ * TC;        \
        _Pragma("unroll") for (int ti = 0; ti < 2; ++ti) _Pragma("unroll") for (int ks = 0; ks < 2; ++ks) qn[ti][ks] = *(const bf16x8*)(SQ + (size_t)(mrow0_ + i0 + 16 * ti + c) * 512 + hq_ * 64 + 32 * ks + 8 * q); \
        kreg = *(const u32x4*)(SK + (size_t)(r0_ + srow) * 128 + g_ * 64 + scol); vreg = *(const u32x4*)(P + (size_t)(r0_ + srow) * NP + PC_SV + g_ * 64 + scol); \
        kreg2 = *(const u32x4*)(SK + (size_t)(r0_ + 64 + srow) * 128 + g_ * 64 + scol); vreg2 = *(const u32x4*)(P + (size_t)(r0_ + 64 + srow) * NP + PC_SV + g_ * 64 + scol); } while (0)
    int u = dyn_bcast(dq, dyn_grab(dq));
    if (u < 544) SWA_PREFETCH(u);
    while (u < 544) {
        const int u_next = dyn_grab(dq);
        const bool lat = u < 512; int b, g, qb;
        if (lat) { b = u >> 7; g = (u >> 6) & 1; qb = u & 63; } else { const int uu = u - 512; b = uu >> 3; g = (uu >> 2) & 1; qb = uu & 3; }
        const int hq = 4 * g + (w >> 1);
        const int mrow0 = lat ? MC + b * TL + 64 * qb : b * TC + 64 * qb;
        const int kt0 = lat ? (2 - qb > 0 ? 2 - qb : 0) : 0, kt1 = lat ? (65 - qb < 4 ? 65 - qb : 4) : -1, nb = lat ? kt1 - kt0 + 1 : 0, nt = nb + 4;
        const int band0 = MC + b * TL + 64 * qb - 128 + 64 * kt0, ctx0 = b * TC;
        bf16x8 qf[2][2];
#pragma unroll
        for (int ti = 0; ti < 2; ++ti)
#pragma unroll
            for (int ks = 0; ks < 2; ++ks) qf[ti][ks] = qn[ti][ks];
        float mrun[2], lrun[2]; f32x4 oacc[4][2];
        const float sk = in.swa_sink[layer * 8 + hq] * LOG2E;
#pragma unroll
        for (int ti = 0; ti < 2; ++ti) { mrun[ti] = sk; lrun[ti] = 1.0f;
#pragma unroll
            for (int te = 0; te < 4; ++te) oacc[te][ti] = (f32x4){0.f, 0.f, 0.f, 0.f}; }
#define SWA_LOAD(tix, KR, VR) do { const int r0_ = ((tix) < nb) ? band0 + 64 * (tix) : ctx0 + 64 * ((tix) - nb); \
            KR = *(const u32x4*)(SK + (size_t)(r0_ + srow) * 128 + g * 64 + scol); VR = *(const u32x4*)(P + (size_t)(r0_ + srow) * NP + PC_SV + g * 64 + scol); } while (0)
#define SWA_WRITE(buf, KR, VR) do { LAS bf16* Kw_ = Kbuf + (buf) * 9216; LAS bf16* Vw_ = Kw_ + 4608; *(LAS u32x4*)(Kw_ + srow * 72 + scol) = KR; \
            _Pragma("unroll") for (int x = 0; x < 8; ++x) Vw_[(scol + x) * 72 + srow] = (bf16)(VR[x >> 1] >> (16 * (x & 1))); } while (0)
        __syncthreads();
        SWA_WRITE(0, kreg, vreg); SWA_WRITE(1, kreg2, vreg2);
        SWA_LOAD(2, kreg, vreg); SWA_LOAD(3, kreg2, vreg2);
        int un = 0;
        for (int tt = 0; tt < nt; ++tt) {
            if (!(tt & 1)) { __syncthreads();
                if (tt == 2) un = __builtin_amdgcn_readfirstlane(dq.slot[0]); }
            const LAS bf16* Kl = Kbuf + (tt & 3) * 9216; const LAS bf16* Vt = Kl + 4608;
            bf16x8 kfr[2][4]; u32x2 vlo[2][4], vhi[2][4];
#pragma unroll
            for (int ks = 0; ks < 2; ++ks)
#pragma unroll
                for (int tj = 0; tj < 4; ++tj) kfr[ks][tj] = *(const LAS bf16x8*)(Kl + (16 * tj + c) * 72 + 32 * ks + 8 * q);
#pragma unroll
            for (int ks2 = 0; ks2 < 2; ++ks2)
#pragma unroll
                for (int te = 0; te < 4; ++te) { vlo[ks2][te] = *(const LAS u32x2*)(Vt + (16 * te + c) * 72 + 32 * ks2 + 4 * q); vhi[ks2][te] = *(const LAS u32x2*)(Vt + (16 * te + c) * 72 + 32 * ks2 + 16 + 4 * q); }
            __builtin_amdgcn_sched_barrier(0);
            if (!(tt & 1)) {
                if (tt + 2 < nt) { SWA_WRITE((tt + 2) & 3, kreg, vreg); if (tt + 3 < nt) SWA_WRITE((tt + 3) & 3, kreg2, vreg2);
                    if (tt + 4 < nt) SWA_LOAD(tt + 4, kreg, vreg); if (tt + 5 < nt) SWA_LOAD(tt + 5, kreg2, vreg2); }
                else if (un < 544) SWA_PREFETCH(un); }
            f32x4 sacc[4][2];
#pragma unroll
            for (int tj = 0; tj < 4; ++tj)
#pragma unroll
                for (int ti = 0; ti < 2; ++ti) sacc[tj][ti] = (f32x4){0.f, 0.f, 0.f, 0.f};
#pragma unroll
            for (int ks = 0; ks < 2; ++ks)
#pragma unroll
                for (int tj = 0; tj < 4; ++tj)
#pragma unroll
                    for (int ti = 0; ti < 2; ++ti) sacc[tj][ti] = mfma16(kfr[ks][tj], qf[ti][ks], sacc[tj][ti]);
            const bool edge = tt < nb && ((kt0 + tt) == 0 || (kt0 + tt) == 4);
            const int kp0 = 64 * qb - 128 + 64 * (kt0 + tt) + 4 * q;
            const float CS = 0.125f * LOG2E;
#pragma unroll
            for (int ti = 0; ti < 2; ++ti) {
                const int qp = 64 * qb + i0 + 16 * ti + c;
                if (edge) {
#pragma unroll
                    for (int tj = 0; tj < 4; ++tj)
#pragma unroll
                        for (int r = 0; r < 4; ++r) { const int dlt = kp0 + 16 * tj + r - qp; if (dlt > 128 || dlt < -128) sacc[tj][ti][r] = -30000.0f; }
                }
                float mx = -30000.0f;
#pragma unroll
                for (int tj = 0; tj < 4; ++tj) mx = fmaxf(mx, fmaxf(fmaxf(sacc[tj][ti][0], sacc[tj][ti][1]), fmaxf(sacc[tj][ti][2], sacc[tj][ti][3])));
                mx = quad_rows_max(mx) * CS;
                if (__builtin_amdgcn_ballot_w64(mx > mrun[ti] + 8.0f) != 0ull) {
                    const float mn = fmaxf(mrun[ti], mx), corr = __builtin_amdgcn_exp2f(mrun[ti] - mn);
                    lrun[ti] *= corr; mrun[ti] = mn;
#pragma unroll
                    for (int te = 0; te < 4; ++te) oacc[te][ti] *= corr;
                }
                const float nm = -mrun[ti];
                float ls = 0.f;
#pragma unroll
                for (int tj = 0; tj < 4; ++tj)
#pragma unroll
                    for (int r = 0; r < 4; ++r) { const float p = __builtin_amdgcn_exp2f(__builtin_fmaf(sacc[tj][ti][r], CS, nm)); sacc[tj][ti][r] = p; ls += p; }
                lrun[ti] += quad_rows_sum(ls);
            }
#pragma unroll
            for (int ks2 = 0; ks2 < 2; ++ks2) {
                bf16x8 pb[2];
#pragma unroll
                for (int ti = 0; ti < 2; ++ti) { u32x4 t; t.x = cvtpk(sacc[2 * ks2][ti][0], sacc[2 * ks2][ti][1]); t.y = cvtpk(sacc[2 * ks2][ti][2], sacc[2 * ks2][ti][3]);
                    t.z = cvtpk(sacc[2 * ks2 + 1][ti][0], sacc[2 * ks2 + 1][ti][1]); t.w = cvtpk(sacc[2 * ks2 + 1][ti][2], sacc[2 * ks2 + 1][ti][3]); pb[ti] = __builtin_bit_cast(bf16x8, t); }
#pragma unroll
                for (int te = 0; te < 4; ++te) { const bf16x8 va = __builtin_bit_cast(bf16x8, ((u32x4){vlo[ks2][te].x, vlo[ks2][te].y, vhi[ks2][te].x, vhi[ks2][te].y}));
#pragma unroll
                    for (int ti = 0; ti < 2; ++ti) oacc[te][ti] = mfma16(va, pb[ti], oacc[te][ti]); }
            }
            if (tt == 0 && dq.lead) dq.slot[0] = u_next;
        }
#pragma unroll
        for (int ti = 0; ti < 2; ++ti) { const float il = 1.0f / lrun[ti]; bf16* orow = O + (size_t)(mrow0 + i0 + 16 * ti + c) * D + 512 + hq * 64 + 4 * q;
#pragma unroll
            for (int te = 0; te < 4; ++te) { u32x2 wv; wv.x = cvtpk(oacc[te][ti][0] * il, oacc[te][ti][1] * il); wv.y = cvtpk(oacc[te][ti][2] * il, oacc[te][ti][3] * il); *(u32x2*)(orow + 16 * te) = wv; } }
        u = un;
    }
#undef SWA_LOAD
#undef SWA_WRITE
#undef SWA_PREFETCH
}


__device__ __forceinline__ void phase_gdn_local3(Frame& F, int layer) {
    unsigned char* prep = F.ws + WS_R1 + R1_PREP;
    const bf16* GD = (const bf16*)(prep + PREP_GD); const float* GB = (const float*)(F.ws + WS_GB);
    const int lane = F.lane, c = lane & 15, q = lane >> 4, w = F.wave, half = w >> 2, wq = w & 3, t2 = F.tid & 255;
    LAS unsigned char* L0 = F.lds + half * 54272;
    LAS bf16* Ks = (LAS bf16*)L0; LAS bf16* Vs = Ks + 64 * 72;
    LAS float* At = (LAS float*)(L0 + 18432);
    LAS bf16* XS_ = (LAS bf16*)(L0 + 18432);
    LAS float* sm = (LAS float*)(L0 + 51200);
    LAS float* gl = sm; LAS float* bl = sm + 128; LAS float* gcs = sm + 256; LAS float* eg = sm + 384; LAS float* ekd = sm + 512;
    DynQ dq = dyn_make(F, layer, 0);
    u32x4 pk[2], pv[2]; float pg;
#define GL3_FETCH(ppx) do { const int _uu = 2 * (ppx) + half, _bh = _uu / 68, _ch = _uu % 68, _b = _bh >> 2, _hh = _bh & 3; const int _m0 = _ch < 4 ? _b * TC + 64 * _ch : MC + _b * TL + 64 * (_ch - 4); \
        _Pragma("unroll") for (int rep = 0; rep < 2; ++rep) { const int idx = t2 + 256 * rep, row = idx >> 3, col8 = (idx & 7) * 8; const bf16* src = GD + (size_t)(_m0 + row) * 768 + _hh * 64 + col8; pk[rep] = *(const u32x4*)(src + 256); pv[rep] = *(const u32x4*)(src + 512); } \
        { const int tok = t2 & 63, which = t2 >> 6; pg = GB[(size_t)(_m0 + tok) * 16 + (which >> 1) * 8 + (which & 1) * 4 + _hh]; } } while (0)
    int pp = dyn_bcast(dq, dyn_grab(dq));
    if (pp < 8 * 68) GL3_FETCH(pp);
    while (pp < 8 * 68) {
        const int pp_next = dyn_grab(dq);
        const int uu = 2 * pp + half, bh = uu / 68, ch = uu % 68, b = bh >> 2, hh = bh & 3;
        __syncthreads();
#pragma unroll
        for (int rep = 0; rep < 2; ++rep) { const int idx = t2 + 256 * rep, row = idx >> 3, col8 = (idx & 7) * 8;
            *(LAS u32x4*)(Ks + row * 72 + col8) = pk[rep]; *(LAS u32x4*)(Vs + row * 72 + col8) = pv[rep]; }
        { const int tok = t2 & 63, which = t2 >> 6; sm[which * 64 + tok] = pg; }
        __syncthreads();
        if (wq < 2) { const int d = wq; const int tok = d ? 63 - lane : lane; float v = gl[d * 64 + tok];
#pragma unroll
            for (int o = 1; o < 64; o <<= 1) { const float t = __shfl_up(v, o); if (lane >= o) v += t; }
            const float last = __shfl(v, 63);
            gcs[d * 64 + lane] = v; eg[d * 64 + lane] = fexp(v); ekd[d * 64 + lane] = fexp(last - v);
            ((float*)(F.ws + WS_GCS))[((size_t)uu * 2 + d) * 64 + tok] = v; }
        __syncthreads();
        {
            const int ti = wq;
            bf16x8 a[2];
#pragma unroll
            for (int ks = 0; ks < 2; ++ks) a[ks] = *(const LAS bf16x8*)(Ks + (16 * ti + c) * 72 + 32 * ks + 8 * q);
#pragma unroll
            for (int tj = 0; tj < 4; ++tj) { f32x4 acc = (f32x4){0.f, 0.f, 0.f, 0.f};
#pragma unroll
                for (int ks = 0; ks < 2; ++ks) acc = mfma16(a[ks], *(const LAS bf16x8*)(Ks + (16 * tj + c) * 72 + 32 * ks + 8 * q), acc);
#pragma unroll
                for (int r = 0; r < 4; ++r) { const int jt = 16 * ti + 4 * q + r, it = 16 * tj + c;
#pragma unroll
                    for (int d = 0; d < 2; ++d) { const int i = d ? 63 - it : it, j = d ? 63 - jt : jt;
                        const float e = fexp(fminf(gcs[d * 64 + i] - gcs[d * 64 + j], 0.f));
                        At[d * 4096 + j * 64 + i] = (j < i) ? -(bl[d * 64 + it] * acc[r] * e) : 0.f; } } }
        }
        if (dq.lead) dq.slot[0] = pp_next;
        __syncthreads();
        const int pp_n = __builtin_amdgcn_readfirstlane(dq.slot[0]);
        if (pp_n < 8 * 68) GL3_FETCH(pp_n);
        const int sd = wq >> 1, kind = wq & 1;
        if ((wq >> 1) == half) {
            const int d1 = wq & 1; const LAS float* A = At + d1 * 4096;
            int lnL = lane; asm volatile("" : "+v"(lnL));
            const int blk = lnL >> 5, cc = lnL & 31, c2 = lnL & 15, q2 = lnL >> 4;
            const LAS float* Ab = A + blk * (32 * 64 + 32);
            f32x2 x[16];
#pragma unroll
            for (int i = 0; i < 32; ++i) x[i >> 1][i & 1] = (i == cc) ? 1.0f : 0.0f;
#pragma unroll
            for (int j = 0; j < 31; ++j) { const float xj = x[j >> 1][j & 1]; const f32x2 xjj = (f32x2){xj, xj};
                f32x4 ca[8];
#pragma unroll
                for (int g = ((j + 1) >> 2); g < 8; ++g) ca[g] = *(const LAS f32x4*)(Ab + j * 64 + 4 * g);
                __builtin_amdgcn_sched_barrier(0);
#pragma unroll
                for (int g = ((j + 1) >> 2); g < 8; ++g) { x[2 * g] = __builtin_elementwise_fma((f32x2){ca[g].x, ca[g].y}, xjj, x[2 * g]); x[2 * g + 1] = __builtin_elementwise_fma((f32x2){ca[g].z, ca[g].w}, xjj, x[2 * g + 1]); }
                __builtin_amdgcn_sched_barrier(0); }
            bf16x8 mf[2];
#pragma unroll
            for (int mt = 0; mt < 2; ++mt) { float v[8];
#pragma unroll
                for (int jj = 0; jj < 8; ++jj) v[jj] = A[(8 * q2 + jj) * 64 + 32 + 16 * mt + c2];
                u32x4 t; t.x = cvtpk(v[0], v[1]); t.y = cvtpk(v[2], v[3]); t.z = cvtpk(v[4], v[5]); t.w = cvtpk(v[6], v[7]); mf[mt] = __builtin_bit_cast(bf16x8, t); }
            asm volatile("s_waitcnt lgkmcnt(0)" ::: "memory"); __builtin_amdgcn_sched_barrier(0);
            LAS bf16* Tt = (LAS bf16*)(At + d1 * 4096);
#pragma unroll
            for (int r = 0; r < 32; ++r) Tt[(32 * blk + r) * 72 + 32 * blk + cc] = (bf16)f2bf(x[r >> 1][r & 1]);
            asm volatile("s_waitcnt lgkmcnt(0)" ::: "memory"); __builtin_amdgcn_sched_barrier(0);
            f32x4 Pm[2][2];
#pragma unroll
            for (int nt = 0; nt < 2; ++nt) { float v[8];
#pragma unroll
                for (int jj = 0; jj < 8; ++jj) v[jj] = bf2f(Tt[(8 * q2 + jj) * 72 + 16 * nt + c2]);
                u32x4 t; t.x = cvtpk(v[0], v[1]); t.y = cvtpk(v[2], v[3]); t.z = cvtpk(v[4], v[5]); t.w = cvtpk(v[6], v[7]); const bf16x8 bt = __builtin_bit_cast(bf16x8, t);
#pragma unroll
                for (int mt = 0; mt < 2; ++mt) Pm[mt][nt] = mfma16(mf[mt], bt, (f32x4){0.f, 0.f, 0.f, 0.f}); }
#pragma unroll
            for (int mt2 = 0; mt2 < 2; ++mt2) {
                const u32x2 lo = *(const LAS u32x2*)(Tt + (32 + 16 * mt2 + c2) * 72 + 32 + 4 * q2), hi = *(const LAS u32x2*)(Tt + (32 + 16 * mt2 + c2) * 72 + 48 + 4 * q2);
                const bf16x8 af = __builtin_bit_cast(bf16x8, ((u32x4){lo.x, lo.y, hi.x, hi.y}));
#pragma unroll
                for (int nt = 0; nt < 2; ++nt) { u32x4 t; t.x = cvtpk(Pm[0][nt][0], Pm[0][nt][1]); t.y = cvtpk(Pm[0][nt][2], Pm[0][nt][3]); t.z = cvtpk(Pm[1][nt][0], Pm[1][nt][1]); t.w = cvtpk(Pm[1][nt][2], Pm[1][nt][3]);
                    const f32x4 acc = mfma16(af, __builtin_bit_cast(bf16x8, t), (f32x4){0.f, 0.f, 0.f, 0.f});
#pragma unroll
                    for (int r = 0; r < 4; ++r) Tt[(32 + 16 * mt2 + 4 * q2 + r) * 72 + 16 * nt + c2] = (bf16)f2bf(acc[r]); } }
        }
        __syncthreads();
        int cL = c, qL = q; asm volatile("" : "+v"(cL), "+v"(qL));
        f32x4 xa[4][4];
#define GL3_APPLY(SD, KIND) do { bf16x8 bfr[4][2]; const LAS bf16* R_ = ((KIND) ? Ks : Vs) + cL; \
            _Pragma("unroll") for (int ks = 0; ks < 2; ++ks) { float scl[8]; \
                _Pragma("unroll") for (int jj = 0; jj < 8; ++jj) { scl[jj] = (SD) ? bl[64 + 63 - 32 * ks - jj - 8 * qL] : bl[32 * ks + jj + 8 * qL]; if (KIND) scl[jj] *= eg[(SD) * 64 + 32 * ks + jj + 8 * qL]; } \
                _Pragma("unroll") for (int nt = 0; nt < 4; ++nt) { float v[8]; \
                    _Pragma("unroll") for (int jj = 0; jj < 8; ++jj) v[jj] = scl[jj] * bf2f((SD) ? R_[(63 - 32 * ks - jj) * 72 + 16 * nt - 8 * 72 * qL] : R_[(32 * ks + jj) * 72 + 16 * nt + 8 * 72 * qL]); \
                    u32x4 t_; t_.x = cvtpk(v[0], v[1]); t_.y = cvtpk(v[2], v[3]); t_.z = cvtpk(v[4], v[5]); t_.w = cvtpk(v[6], v[7]); bfr[nt][ks] = __builtin_bit_cast(bf16x8, t_); } } \
            const LAS bf16* Tr_ = (const LAS bf16*)(At + (SD) * 4096) + cL * 72 + 8 * qL; \
            _Pragma("unroll") for (int mt = 0; mt < 4; ++mt) { \
                _Pragma("unroll") for (int nt = 0; nt < 4; ++nt) xa[mt][nt] = (f32x4){0.f, 0.f, 0.f, 0.f}; \
                _Pragma("unroll") for (int ks = 0; ks < 2; ++ks) { if (32 * ks <= 16 * mt + 15) { const bf16x8 af = *(const LAS bf16x8*)(Tr_ + 16 * mt * 72 + 32 * ks); \
                    _Pragma("unroll") for (int nt = 0; nt < 4; ++nt) xa[mt][nt] = mfma16(af, bfr[nt][ks], xa[mt][nt]); } } } } while (0)
        if (wq == 0) GL3_APPLY(0, 0); else if (wq == 1) GL3_APPLY(0, 1); else if (wq == 2) GL3_APPLY(1, 0); else GL3_APPLY(1, 1);
#undef GL3_APPLY
        __syncthreads();
#define GL3_XO(SD, KIND) do { LAS bf16* XO = XS_ + ((SD) * 2 + (KIND)) * 4096 + cL + ((SD) ? -4 * 64 * qL : 4 * 64 * qL);        \
          _Pragma("unroll") for (int mt = 0; mt < 4; ++mt) _Pragma("unroll") for (int nt = 0; nt < 4; ++nt) _Pragma("unroll") for (int r = 0; r < 4; ++r) \
              XO[((SD) ? 63 - 16 * mt - r : 16 * mt + r) * 64 + 16 * nt] = (bf16)f2bf(xa[mt][nt][r]); } while (0)
        if (wq == 0) GL3_XO(0, 0); else if (wq == 1) GL3_XO(0, 1); else if (wq == 2) GL3_XO(1, 0); else GL3_XO(1, 1);
#undef GL3_XO
        __syncthreads();
        {
            for (int it = t2; it < 2 * 512; it += 256) { const int d = it >> 9, chk = it & 511;
                const int rt = chk >> 7, ks = (chk >> 6) & 1, ln = chk & 63, r = ln & 15, qq = ln >> 4, row = 16 * rt + r, c0 = 32 * ks + 4 * qq;
                const int chain = bh * 2 + d, sg = ch < 4 ? (d ? 3 - ch : ch) : 4 + (d ? 63 - (ch - 4) : ch - 4);
                unsigned char* dst = F.ws + WS_GCH + (size_t)chain * G2_CHAIN + (size_t)sg * G2_STEP;
                const LAS bf16* XW = XS_ + (d * 2 + 1) * 4096;
                const u32x2 lo = *(const LAS u32x2*)(XW + row * 64 + c0), hi = *(const LAS u32x2*)(XW + row * 64 + c0 + 16);
                *(u32x4*)(dst + chk * 16) = (u32x4){lo.x, lo.y, hi.x, hi.y};
                float v[8];
#pragma unroll
                for (int x8 = 0; x8 < 8; ++x8) { const int tok = c0 + (x8 & 3) + 16 * (x8 >> 2); const int i = d ? 63 - tok : tok; v[x8] = bf2f(Ks[tok * 72 + row]) * ekd[d * 64 + i]; }
                u32x4 o; o.x = cvtpk(v[0], v[1]); o.y = cvtpk(v[2], v[3]); o.z = cvtpk(v[4], v[5]); o.w = cvtpk(v[6], v[7]);
                *(u32x4*)(dst + 8192 + chk * 16) = o; }
            for (int it = t2; it < 2 * 1024; it += 256) { const int d = it >> 10, cu = it & 1023;
                const int sl = cu >> 8, rt = (cu >> 6) & 3, ln = cu & 63, qq = ln >> 4, cc = ln & 15;
                const LAS bf16* XU = XS_ + (d * 2) * 4096; const int tr = 16 * rt + 4 * qq;
                const bf16 e0 = XU[(tr) * 64 + 16 * sl + cc], e1 = XU[(tr + 1) * 64 + 16 * sl + cc], e2 = XU[(tr + 2) * 64 + 16 * sl + cc], e3 = XU[(tr + 3) * 64 + 16 * sl + cc];
                const int chain = bh * 2 + d, sg = ch < 4 ? (d ? 3 - ch : ch) : 4 + (d ? 63 - (ch - 4) : ch - 4);
                unsigned char* dst = F.ws + WS_GCH + (size_t)chain * G2_CHAIN + (size_t)sg * G2_STEP + 16384;
                *(u32x2*)(dst + cu * 8) = (u32x2){(unsigned)e0 | ((unsigned)e1 << 16), (unsigned)e2 | ((unsigned)e3 << 16)}; }
            if (t2 < 2) { const int d = t2; const int chain = bh * 2 + d, sg = ch < 4 ? (d ? 3 - ch : ch) : 4 + (d ? 63 - (ch - 4) : ch - 4);
                ((float*)(F.ws + WS_GDEC))[chain * 68 + sg] = eg[d * 64 + 63]; }
        }
        pp = pp_n;
    }
#undef GL3_FETCH
}


__device__ __forceinline__ void phase_gdn_scan3(Frame& F, int first_wg) {
    const int chain = F.bid - first_wg; if (chain < 0 || chain >= 32) return;
    const unsigned char* src = F.ws + WS_GCH + (size_t)chain * G2_CHAIN;
    const float* decs = (const float*)(F.ws + WS_GDEC) + chain * 68;
    unsigned char* GSTb = F.ws + WS_GST + (size_t)chain * 68 * 16384;
    LAS unsigned char* ring = F.lds;
    const int lane = F.lane, w = F.wave;
    if (w >= 4) {
        const int dw = w - 4;
#define GS3_ISSUE(step) do { _Pragma("unroll") for (int k = 0; k < 6; ++k) { const int p = dw * 6 + k; \
            __builtin_amdgcn_global_load_lds((const unsigned*)(src + (size_t)(step) * G2_STEP + p * 1024 + lane * 16), (LAS unsigned*)(ring + ((step) & 3) * 24576 + p * 1024), 16, 0, 0); } } while (0)
        GS3_ISSUE(0); GS3_ISSUE(1); GS3_ISSUE(2);
        asm volatile("s_waitcnt vmcnt(12)" ::: "memory"); __builtin_amdgcn_s_barrier();
        for (int n = 0; n < 68; ++n) {
            if (n + 3 < 68) { GS3_ISSUE(n + 3); asm volatile("s_waitcnt vmcnt(12)" ::: "memory"); }
            else if (n + 2 < 68) asm volatile("s_waitcnt vmcnt(6)" ::: "memory");
            else asm volatile("s_waitcnt vmcnt(0)" ::: "memory");
            __builtin_amdgcn_s_barrier();
        }
#undef GS3_ISSUE
    } else {
        const int sl = w;
        f32x4 S[4];
#pragma unroll
        for (int rt = 0; rt < 4; ++rt) S[rt] = (f32x4){0.f, 0.f, 0.f, 0.f};
        const float dv0 = decs[lane], dv1 = decs[64 + (lane & 3)];
        asm volatile("s_waitcnt vmcnt(0)" ::: "memory"); __builtin_amdgcn_s_barrier(); asm volatile("" ::: "memory");
        for (int n = 0; n < 68; ++n) {
            const LAS unsigned char* base = ring + (n & 3) * 24576;
            const float dec = n < 64 ? __shfl(dv0, n) : __shfl(dv1, n - 64);
            unsigned char* go = GSTb + (size_t)n * 16384 + (size_t)(sl * 2 * 64 + lane) * 16;
#define GS3_FRAG(mat, rt, ks) (*(const LAS bf16x8*)(base + (mat) * 8192 + (((rt) * 2 + (ks)) * 64 + lane) * 16))
            bf16x8 wf[4][2], kf[4][2]; u32x2 uf[4];
#pragma unroll
            for (int rt = 0; rt < 4; ++rt) { wf[rt][0] = GS3_FRAG(0, rt, 0); wf[rt][1] = GS3_FRAG(0, rt, 1); }
#pragma unroll
            for (int rt = 0; rt < 4; ++rt) uf[rt] = *(const LAS u32x2*)(base + 16384 + ((sl * 4 + rt) * 64 + lane) * 8);
#pragma unroll
            for (int rt = 0; rt < 4; ++rt) { kf[rt][0] = GS3_FRAG(1, rt, 0); kf[rt][1] = GS3_FRAG(1, rt, 1); }
#undef GS3_FRAG
            __builtin_amdgcn_sched_barrier(0);
            bf16x8 BS[2], BV[2];
#pragma unroll
            for (int ks = 0; ks < 2; ++ks) { u32x4 t; t.x = cvtpk(S[2 * ks][0], S[2 * ks][1]); t.y = cvtpk(S[2 * ks][2], S[2 * ks][3]); t.z = cvtpk(S[2 * ks + 1][0], S[2 * ks + 1][1]); t.w = cvtpk(S[2 * ks + 1][2], S[2 * ks + 1][3]);
                BS[ks] = __builtin_bit_cast(bf16x8, t); *(u32x4*)(go + ks * 1024) = t; }
            f32x4 vn[4];
#pragma unroll
            for (int ks = 0; ks < 2; ++ks)
#pragma unroll
                for (int rt = 0; rt < 4; ++rt) vn[rt] = mfma16(wf[rt][ks], BS[ks], ks ? vn[rt] : (f32x4){0.f, 0.f, 0.f, 0.f});
#pragma unroll
            for (int rt = 0; rt < 4; ++rt) { const u32x2 uu = uf[rt];
                vn[rt] = (f32x4){__uint_as_float(uu.x << 16), __uint_as_float(uu.x & 0xffff0000u), __uint_as_float(uu.y << 16), __uint_as_float(uu.y & 0xffff0000u)} - vn[rt]; }
#pragma unroll
            for (int ks = 0; ks < 2; ++ks) { u32x4 t; t.x = cvtpk(vn[2 * ks][0], vn[2 * ks][1]); t.y = cvtpk(vn[2 * ks][2], vn[2 * ks][3]); t.z = cvtpk(vn[2 * ks + 1][0], vn[2 * ks + 1][1]); t.w = cvtpk(vn[2 * ks + 1][2], vn[2 * ks + 1][3]);
                BV[ks] = __builtin_bit_cast(bf16x8, t); *(u32x4*)(go + 8192 + ks * 1024) = t; }
#pragma unroll
            for (int rt = 0; rt < 4; ++rt) S[rt] = S[rt] * dec;
#pragma unroll
            for (int ks = 0; ks < 2; ++ks)
#pragma unroll
                for (int rt = 0; rt < 4; ++rt) S[rt] = mfma16(kf[rt][ks], BV[ks], S[rt]);
            asm volatile("s_waitcnt lgkmcnt(0)" ::: "memory"); __builtin_amdgcn_s_barrier(); asm volatile("" ::: "memory");
        }
    }
}

__device__ __forceinline__ void phase_gdn_out2(Frame& F, const Inputs& in, int layer) {
    const bf16* P = (const bf16*)(F.ws + WS_R1 + R1_P);
    const bf16* GD = (const bf16*)(F.ws + WS_R1 + R1_PREP + PREP_GD);
    const unsigned char* GSTb = F.ws + WS_GST; const float* GCS = (const float*)(F.ws + WS_GCS);
    bf16* O = (bf16*)(F.ws + WS_R1 + R1_O);
    const int lane = F.lane, c = lane & 15, q = lane >> 4, w = F.wave, half = w >> 2, ti = w & 3, t2 = F.tid & 255;
    LAS bf16* Qs = (LAS bf16*)(F.lds + half * 56320); LAS bf16* Ks = Qs + 4608;
    LAS unsigned char* Fr = F.lds + half * 56320 + 18432;
    LAS float* gT = (LAS float*)(F.lds + half * 56320 + 55296);
    DynQ dq = dyn_make(F, layer, 4);
    for (int pp = dyn_bcast(dq, dyn_grab(dq)); pp < 8 * 68; ) {
        const int pp_next = dyn_grab(dq);
        const int uu = 2 * pp + half, bh = uu / 68, ch = uu % 68, b = bh >> 2, hh = bh & 3;
        const int m0 = ch < 4 ? b * TC + 64 * ch : MC + b * TL + 64 * (ch - 4);
        __syncthreads();
#pragma unroll
        for (int rep = 0; rep < 2; ++rep) { const int idx = t2 + 256 * rep, row = idx >> 3, col8 = (idx & 7) * 8;
            const bf16* src = GD + (size_t)(m0 + row) * 768 + hh * 64 + col8;
            *(LAS u32x4*)(Qs + row * 72 + col8) = *(const u32x4*)(src); *(LAS u32x4*)(Ks + row * 72 + col8) = *(const u32x4*)(src + 256); }
#pragma unroll
        for (int d = 0; d < 2; ++d) { const int sg = ch < 4 ? (d ? 3 - ch : ch) : 4 + (d ? 63 - (ch - 4) : ch - 4);
            const unsigned char* g = GSTb + ((size_t)(bh * 2 + d) * 68 + sg) * 16384;
#pragma unroll
            for (int rep = 0; rep < 4; ++rep) { const int idx = t2 + 256 * rep; *(LAS u32x4*)(Fr + d * 16384 + idx * 16) = *(const u32x4*)(g + (size_t)idx * 16); } }
        if (t2 < 128) gT[t2] = GCS[(size_t)uu * 128 + t2];
        if (dq.lead) dq.slot[0] = pp_next;
        __syncthreads();
        const int pp_nx = __builtin_amdgcn_readfirstlane(dq.slot[0]);
        bf16x8 qf[2], qr[2];
#pragma unroll
        for (int ks = 0; ks < 2; ++ks) { qf[ks] = *(const LAS bf16x8*)(Qs + (16 * ti + c) * 72 + 32 * ks + 8 * q);
            const u32x2 lo = *(const LAS u32x2*)(Qs + (16 * ti + c) * 72 + 32 * ks + 4 * q), hi = *(const LAS u32x2*)(Qs + (16 * ti + c) * 72 + 32 * ks + 16 + 4 * q);
            qr[ks] = __builtin_bit_cast(bf16x8, ((u32x4){lo.x, lo.y, hi.x, hi.y})); }
        const int i = 16 * ti + c;
        const float gi0 = gT[i], gi1 = gT[64 + i];
        f32x4 sacc[4];
#pragma unroll
        for (int tj = 0; tj < 4; ++tj) { f32x4 acc = (f32x4){0.f, 0.f, 0.f, 0.f};
#pragma unroll
            for (int ks = 0; ks < 2; ++ks) acc = mfma16(*(const LAS bf16x8*)(Ks + (16 * tj + c) * 72 + 32 * ks + 8 * q), qf[ks], acc);
            sacc[tj] = acc; }
        bf16x8 pb[2][2];
#pragma unroll
        for (int d = 0; d < 2; ++d) { f32x4 p[4];
#pragma unroll
            for (int tj = 0; tj < 4; ++tj) { const f32x4 gj = *(const LAS f32x4*)(gT + d * 64 + 16 * tj + 4 * q);
#pragma unroll
                for (int r = 0; r < 4; ++r) { const int j = 16 * tj + 4 * q + r; const bool ok = d ? (j >= i) : (j <= i);
                    p[tj][r] = ok ? sacc[tj][r] * fexp(fminf((d ? gi1 : gi0) - gj[r], 0.f)) : 0.f; } }
#pragma unroll
            for (int ks2 = 0; ks2 < 2; ++ks2) { u32x4 t; t.x = cvtpk(p[2 * ks2][0], p[2 * ks2][1]); t.y = cvtpk(p[2 * ks2][2], p[2 * ks2][3]); t.z = cvtpk(p[2 * ks2 + 1][0], p[2 * ks2 + 1][1]); t.w = cvtpk(p[2 * ks2 + 1][2], p[2 * ks2 + 1][3]); pb[d][ks2] = __builtin_bit_cast(bf16x8, t); } }
        const float sc0 = fexp(gi0), sc1 = fexp(gi1);
        f32x4 o[4]; float ssq = 0.f;
#pragma unroll
        for (int te = 0; te < 4; ++te) { f32x4 acc = (f32x4){0.f, 0.f, 0.f, 0.f}, t0 = acc, t1 = acc;
#pragma unroll
            for (int ks = 0; ks < 2; ++ks) {
                acc = mfma16(*(const LAS bf16x8*)(Fr + 8192 + ((te * 2 + ks) * 64 + lane) * 16), pb[0][ks], acc);
                acc = mfma16(*(const LAS bf16x8*)(Fr + 16384 + 8192 + ((te * 2 + ks) * 64 + lane) * 16), pb[1][ks], acc);
                t0 = mfma16(*(const LAS bf16x8*)(Fr + ((te * 2 + ks) * 64 + lane) * 16), qr[ks], t0);
                t1 = mfma16(*(const LAS bf16x8*)(Fr + 16384 + ((te * 2 + ks) * 64 + lane) * 16), qr[ks], t1); }
            o[te] = acc + sc0 * t0 + sc1 * t1; ssq += (o[te][0] * o[te][0] + o[te][1] * o[te][1]) + (o[te][2] * o[te][2] + o[te][3] * o[te][3]); }
        ssq = quad_rows_sum(ssq);
        const float rs = 1.0f / sqrtf(ssq * (1.0f / 64.0f) + EPS);
#pragma unroll
        for (int te = 0; te < 4; ++te) { const int e0 = 16 * te + 4 * q;
            const u32x2 z2 = *(const u32x2*)(P + (size_t)(m0 + i) * NP + PC_GZ + hh * 64 + e0); const f32x4 gn = *(const f32x4*)(in.gdn_norm_g + layer * 64 + e0);
            const float z0 = __uint_as_float(z2.x << 16), z1 = __uint_as_float(z2.x & 0xffff0000u), z2f = __uint_as_float(z2.y << 16), z3 = __uint_as_float(z2.y & 0xffff0000u);
            u32x2 wv; wv.x = cvtpk(o[te][0] * rs * gn[0] * siluf(z0), o[te][1] * rs * gn[1] * siluf(z1)); wv.y = cvtpk(o[te][2] * rs * gn[2] * siluf(z2f), o[te][3] * rs * gn[3] * siluf(z3));
            *(u32x2*)(O + (size_t)(m0 + i) * D + 256 + hh * 64 + e0) = wv; }
        pp = pp_nx;
    }
}

__device__ __forceinline__ void phase_ret_kv(Frame& F, const Inputs& in, int layer) {
    const bf16* P = (const bf16*)(F.ws + WS_R1 + R1_P);
    const bf16* RK = (const bf16*)(F.ws + WS_R1 + R1_PREP + PREP_RK);
    LAS bf16* Kt = (LAS bf16*)F.lds; LAS bf16* Vw = Kt + 64 * 72;
    const int lane = F.lane, c = lane & 15, q = lane >> 4, w = F.wave, tid = F.tid;
    const float LOG2E = 1.4426950408889634f;
    DynQ dq = dyn_make(F, layer, 2);
    for (int uu = dyn_bcast(dq, dyn_grab(dq)); uu < 16 * 68; ) {
        const int uu_next = dyn_grab(dq);
        const int bh = uu / 68, ch = uu % 68, b = bh >> 2, hh = bh & 3;
        const int m0 = ch < 4 ? b * TC + 64 * ch : MC + b * TL + 64 * (ch - 4);
        const float l0 = -fexp(in.ret_decay[layer * 8 + hh]) * LOG2E, l1 = -fexp(in.ret_decay[layer * 8 + 4 + hh]) * LOG2E;
        __syncthreads();
        { const int j = tid >> 3, col8 = (tid & 7) * 8;
          const u32x4 k8 = *(const u32x4*)(RK + (size_t)(m0 + j) * 256 + hh * 64 + col8), v8 = *(const u32x4*)(P + (size_t)(m0 + j) * NP + PC_RV + hh * 64 + col8);
          const float w0 = fexp2((float)(63 - j) * l0), w1 = fexp2((float)j * l1);
#pragma unroll
          for (int x = 0; x < 8; ++x) { const unsigned kk = (k8[x >> 1] >> (16 * (x & 1))) & 0xffffu; const float vv = __uint_as_float(((v8[x >> 1] >> (16 * (x & 1))) & 0xffffu) << 16);
              Kt[(col8 + x) * 72 + j] = (bf16)kk; Vw[(col8 + x) * 72 + j] = (bf16)f2bf(vv * w0); Vw[4608 + (col8 + x) * 72 + j] = (bf16)f2bf(vv * w1); } }
        if (dq.lead) dq.slot[0] = uu_next;
        __syncthreads();
        const int uu_nx = __builtin_amdgcn_readfirstlane(dq.slot[0]);
        { const int d = w >> 2, td = w & 3;
          bf16x8 a[2];
#pragma unroll
          for (int ks = 0; ks < 2; ++ks) a[ks] = *(const LAS bf16x8*)(Kt + (16 * td + c) * 72 + 32 * ks + 8 * q);
          const int chain = bh * 2 + d, sg = d ? (ch < 4 ? 3 - ch : 71 - ch) : ch;
          float* dst = (float*)(F.ws + WS_RKV) + ((size_t)chain * 68 + sg) * 4096;
#pragma unroll
          for (int te = 0; te < 4; ++te) { f32x4 acc = (f32x4){0.f, 0.f, 0.f, 0.f};
#pragma unroll
              for (int ks = 0; ks < 2; ++ks) acc = mfma16(a[ks], *(const LAS bf16x8*)(Vw + d * 4608 + (16 * te + c) * 72 + 32 * ks + 8 * q), acc);
              *(f32x4*)(dst + (16 * te + c) * 64 + 16 * td + 4 * q) = acc; } }
        uu = uu_nx;
    }
}
__device__ __forceinline__ void phase_ret_state(Frame& F, const Inputs& in, int layer, int nwg) {
    if (F.bid >= nwg) return;
    const float* RKV = (const float*)(F.ws + WS_RKV); bf16* RST = (bf16*)(F.ws + WS_RST);
    for (int el = F.bid * NTHR + F.tid; el < 32 * 4096; el += nwg * NTHR) {
        const int chain = el >> 12, idx = el & 4095, hh = (chain >> 1) & 3, d = chain & 1;
        const float G64 = fexp(-64.0f * fexp(in.ret_decay[layer * 8 + d * 4 + hh]));
        const float* kv = RKV + (size_t)chain * 68 * 4096 + idx; bf16* st = RST + (size_t)chain * 68 * 4096 + idx;
        float S = 0.f;
#pragma unroll
        for (int h2 = 0; h2 < 2; ++h2) { float kvv[34];
#pragma unroll
            for (int sg = 0; sg < 34; ++sg) kvv[sg] = kv[(size_t)(34 * h2 + sg) * 4096];
#pragma unroll
            for (int sg = 0; sg < 34; ++sg) { st[(size_t)(34 * h2 + sg) * 4096] = (bf16)f2bf(S); S = G64 * S + kvv[sg]; } }
    }
}
__device__ __forceinline__ void phase_ret_out(Frame& F, const Inputs& in, int layer) {
    const bf16* P = (const bf16*)(F.ws + WS_R1 + R1_P);
    const bf16* RQ = (const bf16*)(F.ws + WS_R1 + R1_PREP + PREP_RQ); const bf16* RK = (const bf16*)(F.ws + WS_R1 + R1_PREP + PREP_RK);
    const bf16* RST = (const bf16*)(F.ws + WS_RST);
    bf16* O = (bf16*)(F.ws + WS_R1 + R1_O);
    const int lane = F.lane, c = lane & 15, q = lane >> 4, w = F.wave, half = w >> 2, ti = w & 3, t2 = F.tid & 255;
    LAS bf16* Qs = (LAS bf16*)(F.lds + half * 46080); LAS bf16* Ks = Qs + 4608; LAS bf16* Vt = Ks + 4608; LAS bf16* St = Vt + 4608;
    const float LOG2E = 1.4426950408889634f;
    DynQ dq = dyn_make(F, layer, 3);
    for (int pp = dyn_bcast(dq, dyn_grab(dq)); pp < 8 * 68; ) {
        const int pp_next = dyn_grab(dq);
        const int uu = 2 * pp + half, bh = uu / 68, ch = uu % 68, b = bh >> 2, hh = bh & 3;
        const int m0 = ch < 4 ? b * TC + 64 * ch : MC + b * TL + 64 * (ch - 4);
        const float l0 = -fexp(in.ret_decay[layer * 8 + hh]) * LOG2E, l1 = -fexp(in.ret_decay[layer * 8 + 4 + hh]) * LOG2E;
        __syncthreads();
#pragma unroll
        for (int rep = 0; rep < 2; ++rep) { const int idx = t2 + 256 * rep, row = idx >> 3, col8 = (idx & 7) * 8;
            *(LAS u32x4*)(Qs + row * 72 + col8) = *(const u32x4*)(RQ + (size_t)(m0 + row) * 256 + hh * 64 + col8);
            *(LAS u32x4*)(Ks + row * 72 + col8) = *(const u32x4*)(RK + (size_t)(m0 + row) * 256 + hh * 64 + col8);
            const u32x4 v8 = *(const u32x4*)(P + (size_t)(m0 + row) * NP + PC_RV + hh * 64 + col8);
#pragma unroll
            for (int x = 0; x < 8; ++x) Vt[(col8 + x) * 72 + row] = (bf16)(v8[x >> 1] >> (16 * (x & 1)));
#pragma unroll
            for (int d = 0; d < 2; ++d) { const int sg = d ? (ch < 4 ? 3 - ch : 71 - ch) : ch;
                *(LAS u32x4*)(St + d * 4608 + row * 72 + col8) = *(const u32x4*)(RST + ((size_t)(bh * 2 + d) * 68 + sg) * 4096 + row * 64 + col8); } }
        if (dq.lead) dq.slot[0] = pp_next;
        __syncthreads();
        const int pp_nx = __builtin_amdgcn_readfirstlane(dq.slot[0]);
        bf16x8 qf[2];
#pragma unroll
        for (int ks = 0; ks < 2; ++ks) qf[ks] = *(const LAS bf16x8*)(Qs + (16 * ti + c) * 72 + 32 * ks + 8 * q);
        const int i = 16 * ti + c;
        f32x4 p[4];
#pragma unroll
        for (int tj = 0; tj < 4; ++tj) { f32x4 acc = (f32x4){0.f, 0.f, 0.f, 0.f};
#pragma unroll
            for (int ks = 0; ks < 2; ++ks) acc = mfma16(*(const LAS bf16x8*)(Ks + (16 * tj + c) * 72 + 32 * ks + 8 * q), qf[ks], acc);
#pragma unroll
            for (int r = 0; r < 4; ++r) { const int dlt = i - (16 * tj + 4 * q + r);
                const float wgt = (dlt >= 0 ? fexp2((float)dlt * l0) : 0.f) + (dlt <= 0 ? fexp2((float)(-dlt) * l1) : 0.f);
                acc[r] *= wgt; }
            p[tj] = acc; }
        bf16x8 pb[2];
#pragma unroll
        for (int ks2 = 0; ks2 < 2; ++ks2) { u32x4 t; t.x = cvtpk(p[2 * ks2][0], p[2 * ks2][1]); t.y = cvtpk(p[2 * ks2][2], p[2 * ks2][3]); t.z = cvtpk(p[2 * ks2 + 1][0], p[2 * ks2 + 1][1]); t.w = cvtpk(p[2 * ks2 + 1][2], p[2 * ks2 + 1][3]); pb[ks2] = __builtin_bit_cast(bf16x8, t); }
        const float sc0 = fexp2((float)(i + 1) * l0), sc1 = fexp2((float)(64 - i) * l1);
        f32x4 o[4]; float sum = 0.f;
#pragma unroll
        for (int te = 0; te < 4; ++te) { f32x4 acc = (f32x4){0.f, 0.f, 0.f, 0.f}, t0 = acc, t1 = acc;
#pragma unroll
            for (int ks2 = 0; ks2 < 2; ++ks2) { const u32x2 lo = *(const LAS u32x2*)(Vt + (16 * te + c) * 72 + 32 * ks2 + 4 * q), hi = *(const LAS u32x2*)(Vt + (16 * te + c) * 72 + 32 * ks2 + 16 + 4 * q);
                acc = mfma16(__builtin_bit_cast(bf16x8, ((u32x4){lo.x, lo.y, hi.x, hi.y})), pb[ks2], acc); }
#pragma unroll
            for (int ks = 0; ks < 2; ++ks) { t0 = mfma16(*(const LAS bf16x8*)(St + (16 * te + c) * 72 + 32 * ks + 8 * q), qf[ks], t0);
                t1 = mfma16(*(const LAS bf16x8*)(St + 4608 + (16 * te + c) * 72 + 32 * ks + 8 * q), qf[ks], t1); }
            o[te] = acc + sc0 * t0 + sc1 * t1; sum += (o[te][0] + o[te][1]) + (o[te][2] + o[te][3]); }
        sum = quad_rows_sum(sum);
        const float mu = sum * (1.0f / 64.0f); float vs = 0.f;
#pragma unroll
        for (int te = 0; te < 4; ++te) { o[te] = o[te] - mu; vs += (o[te][0] * o[te][0] + o[te][1] * o[te][1]) + (o[te][2] * o[te][2] + o[te][3] * o[te][3]); }
        vs = quad_rows_sum(vs);
        const float rs = 1.0f / sqrtf(vs * (1.0f / 64.0f) + EPS);
#pragma unroll
        for (int te = 0; te < 4; ++te) { const int e0 = hh * 64 + 16 * te + 4 * q;
            const u32x2 g2 = *(const u32x2*)(P + (size_t)(m0 + i) * NP + PC_RG + e0); const f32x4 gn = *(const f32x4*)(in.ret_gn_g + layer * 256 + e0);
            const float g0 = __uint_as_float(g2.x << 16), g1 = __uint_as_float(g2.x & 0xffff0000u), g2f = __uint_as_float(g2.y << 16), g3 = __uint_as_float(g2.y & 0xffff0000u);
            u32x2 wv; wv.x = cvtpk(o[te][0] * rs * gn[0] * siluf(g0), o[te][1] * rs * gn[1] * siluf(g1)); wv.y = cvtpk(o[te][2] * rs * gn[2] * siluf(g2f), o[te][3] * rs * gn[3] * siluf(g3));
            *(u32x2*)(O + (size_t)(m0 + i) * D + e0) = wv; }
        pp = pp_nx;
    }
}


__device__ __forceinline__ void phase_permute2(Frame& F, int route_lo) {
    const int* TKE = (const int*)(F.ws + WS_TKE); int* TOKROW = (int*)(F.ws + WS_TOKROW); int* TILEE = (int*)(F.ws + WS_TILEE);
    const int* WGCNT = (const int*)(F.ws + WS_TILEE + 4096);
    int* ROWTOK = (int*)(F.ws + WS_ROWTOK);
    LAS int* base = (LAS int*)F.lds;
    LAS int* tot = base + 256 * 8;
    __syncthreads();
    {
        LAS int* scn = base + 256 * 8 + 64;
        int cnt8[8];
#pragma unroll
        for (int e = 0; e < 8; ++e) cnt8[e] = (F.tid < F.G) ? WGCNT[F.tid * 8 + e] : 0;
#pragma unroll
        for (int e = 0; e < 8; ++e) scn[F.tid * 8 + e] = cnt8[e];
        __syncthreads();
        int cur = 0;
        for (int off = 1; off < NTHR; off <<= 1) { int v[8];
#pragma unroll
            for (int e = 0; e < 8; ++e) v[e] = scn[cur * 4096 + F.tid * 8 + e] + (F.tid >= off ? scn[cur * 4096 + (F.tid - off) * 8 + e] : 0);
#pragma unroll
            for (int e = 0; e < 8; ++e) scn[(cur ^ 1) * 4096 + F.tid * 8 + e] = v[e];
            __syncthreads(); cur ^= 1; }
        if (F.tid < F.G) {
#pragma unroll
            for (int e = 0; e < 8; ++e) base[F.tid * 8 + e] = scn[cur * 4096 + F.tid * 8 + e] - cnt8[e]; }
        if (F.tid < 8) tot[F.tid] = scn[cur * 4096 + (F.G - 1) * 8 + F.tid];
    }
    __syncthreads();
    if (F.tid == 0) { int st = 0; for (int e = 0; e < 8; ++e) { tot[8 + e] = st; const int pad = (tot[e] + 255) / 256 * 256;
            if (F.bid == 0) for (int tl = st / 256; tl < (st + pad) / 256; ++tl) TILEE[tl] = e;
            st += pad; }
        if (F.bid == 0) TILEE[256] = st / 256; }
    __syncthreads();
    const int lane = F.lane;
    for (int t = F.gw + lane * F.NGW; t < M - route_lo; t += 64 * F.NGW) {
        const int m = route_lo + t;
        const int gwm = m < MC ? m : (int)((((long)(m - MC + 1)) * F.NGW - 1) / ML), wg = gwm >> 3;
        const int2 ee = *(const int2*)(TKE + 2 * m), lr = *(const int2*)(TOKROW + 2 * m);
        const int r0 = tot[8 + ee.x] + base[wg * 8 + ee.x] + lr.x, r1 = tot[8 + ee.y] + base[wg * 8 + ee.y] + lr.y;
        *(int2*)(TOKROW + 2 * m) = make_int2(r0, r1); ROWTOK[r0] = m; ROWTOK[r1] = m;
    }
    for (int e = 0; e < 8; ++e) { const int st = tot[8 + e] + tot[e], en = tot[8 + e] + (tot[e] + 255) / 256 * 256;
        for (int r = st + F.gw * 64 + lane; r < en; r += F.NGW * 64) ROWTOK[r] = MC; }
}

constexpr int NPH = 12;
constexpr int PH_TOTAL = 1 + DEPTH * NPH + 1;
__host__ __device__ inline bool phase_exists(int ph) {
    if (ph == 0 || ph == PH_TOTAL - 1) return true;
    const int layer = (ph - 1) / NPH, j = (ph - 1) % NPH;
    if (!(layer & 1) && j >= 10) return false;
    if ((layer & 1) && j >= 11) return false;
    if (j == 5) return false;
    return true;
}
__global__ void __launch_bounds__(NTHR, 2) fwd_kernel(Args args) {
    extern __shared__ __attribute__((aligned(16))) unsigned char lds_raw[];
    Frame F;
    F.lds = (LAS unsigned char*)lds_raw;
    F.tid = threadIdx.x; F.lane = F.tid & 63; F.wave = __builtin_amdgcn_readfirstlane(F.tid >> 6);
    const int wave0 = F.wave;
    F.G = gridDim.x; F.bid = blockIdx.x; F.gw = blockIdx.x * NWAVES + F.wave; F.NGW = F.G * NWAVES; F.ws = args.ws;
    volatile LAS unsigned* MISC = (volatile LAS unsigned*)(F.lds + MISC_OFF);
    LAS unsigned long long* ptab = (LAS unsigned long long*)(F.lds + MISC_OFF + 128);
    if (F.tid < 32) MISC[F.tid] = 0u;
    if (PROBE_ON && F.tid == 65) { ((volatile LAS unsigned long long*)(F.lds + 132096))[0] = 0ull; ((volatile LAS unsigned long long*)(F.lds + 132096))[1] = 0ull; }
    if (F.tid == 64) { const Inputs& ai = args.in;
        ptab[0] = (unsigned long long)ai.x; ptab[1] = (unsigned long long)ai.c; ptab[2] = (unsigned long long)ai.ctx; ptab[3] = (unsigned long long)ai.c_ctx; ptab[4] = (unsigned long long)ai.ada_w; ptab[5] = (unsigned long long)ai.ada_b;
        ptab[6] = (unsigned long long)ai.norm1_g; ptab[7] = (unsigned long long)ai.w_in; ptab[8] = (unsigned long long)ai.ret_decay; ptab[9] = (unsigned long long)ai.ret_gn_g; ptab[10] = (unsigned long long)ai.gdn_conv_w; ptab[11] = (unsigned long long)ai.gdn_a_log;
        ptab[12] = (unsigned long long)ai.gdn_dt_bias; ptab[13] = (unsigned long long)ai.gdn_norm_g; ptab[14] = (unsigned long long)ai.swa_sink; ptab[15] = (unsigned long long)ai.w_out; ptab[16] = (unsigned long long)ai.norm2_g; ptab[17] = (unsigned long long)ai.ffn_w1;
        ptab[18] = (unsigned long long)ai.ffn_w3; ptab[19] = (unsigned long long)ai.ffn_w2; ptab[20] = (unsigned long long)ai.router_w; ptab[21] = (unsigned long long)ai.moe_w1; ptab[22] = (unsigned long long)ai.moe_w3; ptab[23] = (unsigned long long)ai.moe_w2; ptab[24] = (unsigned long long)ai.final_g; }
    __syncthreads();
    XcdBarrier bar; bar.bar = (unsigned*)(F.ws + WS_CTL) + CW_BAR; bar.x = 0; bar.st = nullptr; bar.w0 = F.wave;
    const int lo = args.ph_lo, hi = args.ph_hi;
    const bool multi = (hi - lo) > 1;
    if (multi) bar = xcd_barrier_post((unsigned*)(F.ws + WS_CTL) + CW_BAR, MISC + 8);
#define LAUNDER() GAS unsigned char* _w = (GAS unsigned char*)args.ws; asm volatile("" : "+s"(_w)); F.ws = (unsigned char*)_w; asm volatile("" ::: "memory"); { int _t = (wave0 << 6) | lane_id_opaque(); asm volatile("" : "+v"(_t)); int _b = blockIdx.x; asm volatile("" : "+s"(_b)); F.tid = _t; F.lane = _t & 63; F.wave = __builtin_amdgcn_readfirstlane(_t >> 6); F.bid = _b; F.gw = _b * NWAVES + F.wave; } const Inputs in = load_inputs(ptab)
#define RELAUNDER() do { GAS unsigned char* _w2 = (GAS unsigned char*)args.ws; asm volatile("" : "+s"(_w2)); F.ws = (unsigned char*)_w2; int _t = (wave0 << 6) | lane_id_opaque(); asm volatile("" : "+v"(_t)); int _b = blockIdx.x; asm volatile("" : "+s"(_b)); F.tid = _t; F.lane = _t & 63; F.wave = __builtin_amdgcn_readfirstlane(_t >> 6); F.bid = _b; F.gw = _b * NWAVES + F.wave; asm volatile("" ::: "memory"); } while (0)
#define IN(k) (lo <= (k) && (k) < hi)
#define STAMP(k) do { if (PROBE_ON && !(PROBE_CUSTOM) && blockIdx.x == 0 && xb_leader(F.wave)) { volatile LAS unsigned long long* _st = (volatile LAS unsigned long long*)(F.lds + 132096); const unsigned long long _now = __builtin_amdgcn_s_memrealtime(), _prev = _st[0]; _st[0] = _now; \
    const int _ph = (k) - 1; bool _sel = false; if (_ph == 0) _sel = (PROBE_PRO) != 0; else if (_ph > 0) { const int _l = (_ph - 1) / NPH, _j = (_ph - 1) % NPH; _sel = (((PROBE_LMASK) >> _l) & 1u) && (((PROBE_JMASK) >> _j) & 1u); } if (_sel) _st[1] = _st[1] + (_now - _prev); } } while (0)
#define SEAM(k) do { if (IN(k) && IN((k) + 1)) { xcd_barrier(bar); STAMP((k) + 1); } } while (0)
#define XB2_BASE(L) ((unsigned)(((L) >> 1) * 18 + ((L) & 1) * 10))
#define SEAMC(k, L, idx, piece) do { if (IN(k)) { LAUNDER(); xb2_arrive(bar, (unsigned*)(F.ws + WS_CTL)); convert_moe_layer(F, in, (L) >> 1, ((L) & 1) * 8 + (piece), F.G, 14); xb2_wait(bar, (unsigned*)(F.ws + WS_CTL), XB2_BASE(L) + (idx)); STAMP((k) + 1); } } while (0)
    LAS unsigned char* ring = F.lds;

    STAMP(0);
    if (IN(0)) { LAUNDER(); phase_prologue(F, in); } SEAM(0);

#define LAYER_BODY(layer) { \
        const int p0 = 1 + layer * NPH; \
        const bool moe = layer & 1; \
        if (IN(p0 + 0)) { LAUNDER(); phase_token2<0>(F, in, layer, layer == 0, layer > 0 && ((layer - 1) & 1), false, nullptr, 0, (layer > 0 && !((layer - 1) & 1)) ? 11 : 0); } \
        SEAMC(p0 + 0, layer, 1u, 0); \
        if (IN(p0 + 1)) { LAUNDER(); pg8::StaticOrder S; S.init(F.ws + WS_H, (bf16*)(F.ws + WS_WIN) + (size_t)layer * NP * D, M, NP, D, F.G, F.bid); \
            pg8::EpiBf16 E{(bf16*)(F.ws + WS_R1 + R1_P), NP}; pg8::gemm_phase<D, D, pg8::EpiBf16, pg8::StaticOrder>(ring, S, E, F.tid); } \
        SEAMC(p0 + 1, layer, 2u, 1); \
        if (IN(p0 + 2)) { LAUNDER(); phase_prep3(F, in, layer); } \
        SEAMC(p0 + 2, layer, 3u, 2); \
        if (IN(p0 + 3)) { LAUNDER(); PB(4); phase_gdn_local3(F, layer); PE(4); RELAUNDER(); PB(5); phase_ret_kv(F, in, layer); PE(5); } \
        if (IN(p0 + 3)) { LAUNDER(); xb2_arrive(bar, (unsigned*)(F.ws + WS_CTL)); STAMP(p0 + 4); } \
        if (IN(p0 + 4)) { LAUNDER(); \
            if (F.bid >= F.G - 32) { xb2_wait(bar, (unsigned*)(F.ws + WS_CTL), XB2_BASE(layer) + 4u); xb2_arrive(bar, (unsigned*)(F.ws + WS_CTL)); PB(1); phase_gdn_scan3(F, F.G - 32); PE(1); rsync_publish(F, layer, 1); } \
            RELAUNDER(); PB(3); phase_swa2(F, in, layer, F.G); PE(3); \
            RELAUNDER(); if (F.bid < F.G - 32) { xb2_wait(bar, (unsigned*)(F.ws + WS_CTL), XB2_BASE(layer) + 4u); PB(2); phase_ret_state(F, in, layer, F.G - 32); PE(2); xb2_arrive(bar, (unsigned*)(F.ws + WS_CTL)); } \
            RELAUNDER(); rsync_wait(F, layer, 32u, 1); PB(7); phase_gdn_out2(F, in, layer); PE(7); \
            RELAUNDER(); xb2_wait(bar, (unsigned*)(F.ws + WS_CTL), XB2_BASE(layer) + 5u); PB(6); phase_ret_out(F, in, layer); PE(6); } \
        if (IN(p0 + 4)) { LAUNDER(); xb2_arrive(bar, (unsigned*)(F.ws + WS_CTL)); convert_moe_layer(F, in, (layer) >> 1, ((layer) & 1) * 8 + 3, F.G, 14); xb2_wait(bar, (unsigned*)(F.ws + WS_CTL), XB2_BASE(layer) + 6u); STAMP(p0 + 5); STAMP(p0 + 6); } \
        if (IN(p0 + 6)) { LAUNDER(); \
            { pg8::StaticOrder S; S.init(F.ws + WS_R1 + R1_O, (bf16*)(F.ws + WS_WOUT) + (size_t)layer * D * D, ML, D, D, F.G, F.bid, 4); \
              pg8::EpiResid E{(float*)(F.ws + WS_XS), (const float*)(F.ws + WS_MOD) + (size_t)layer * 5 * 6 * D, 2, (layer) == 0 ? in.x : nullptr}; pg8::gemm_phase<D, D, pg8::EpiResid, pg8::StaticOrder>(ring, S, E, F.tid); } \
            if (layer < DEPTH - 1) { RELAUNDER(); \
              pg8::SplitOrder S; S.init(F.ws + WS_R1 + R1_O, (bf16*)(F.ws + WS_WOUT) + (size_t)layer * D * D, D, 4, F.G, F.bid); \
              pg8::EpiSlab E{(float*)(F.ws + WS_R1 + 100 * MiB)}; pg8::gemm_phase<256, D, pg8::EpiSlab, pg8::SplitOrder>(ring, S, E, F.tid); } } \
        SEAMC(p0 + 6, layer, 7u, 4); \
        if (IN(p0 + 7)) { LAUNDER(); phase_token2<1>(F, in, layer, false, false, moe, nullptr, layer == DEPTH - 1 ? MC : 0, layer < DEPTH - 1 ? 4 : 0); } \
        SEAMC(p0 + 7, layer, 8u, 5); \
        if (!moe) { \
            if (IN(p0 + 8)) { LAUNDER(); pg8::StaticOrder S; S.init(F.ws + WS_H, (bf16*)(F.ws + WS_W13) + (size_t)(layer >> 1) * 2 * FF * D, M, 2 * FF, D, F.G, F.bid); \
                pg8::EpiSwiglu E{(bf16*)(F.ws + WS_R1 + R1_HID), FF}; pg8::gemm_phase<D, D, pg8::EpiSwiglu, pg8::StaticOrder>(ring, S, E, F.tid); } \
            SEAMC(p0 + 8, layer, 9u, 6); \
            if (IN(p0 + 9)) { LAUNDER(); \
                { pg8::StaticOrder S; S.init(F.ws + WS_R1 + R1_HID, (bf16*)(F.ws + WS_W2) + (size_t)(layer >> 1) * D * FF, ML, D, FF, F.G, F.bid, 4); \
                  pg8::EpiResid E{(float*)(F.ws + WS_XS), (const float*)(F.ws + WS_MOD) + (size_t)layer * 5 * 6 * D, 5, nullptr}; pg8::gemm_phase<FF, FF, pg8::EpiResid, pg8::StaticOrder>(ring, S, E, F.tid); } \
                { RELAUNDER(); \
                  pg8::SplitOrder S; S.init(F.ws + WS_R1 + R1_HID, (bf16*)(F.ws + WS_W2) + (size_t)(layer >> 1) * D * FF, FF, 11, F.G, F.bid); \
                  pg8::EpiSlab E{(float*)(F.ws + WS_R1 + 100 * MiB)}; pg8::gemm_phase<256, FF, pg8::EpiSlab, pg8::SplitOrder>(ring, S, E, F.tid); } } \
            SEAMC(p0 + 9, layer, 10u, 7); \
        } else { \
            if (IN(p0 + 8)) { LAUNDER(); phase_permute2(F, layer == DEPTH - 1 ? MC : 0); } \
            SEAM(p0 + 8); \
            if (IN(p0 + 9)) { LAUNDER(); const int* tile_e = (const int*)(F.ws + WS_TILEE); const int ntiles = __builtin_amdgcn_readfirstlane(tile_e[256]); \
                pg8::GatherOrder S; S.init(F.ws + WS_H, F.ws + WS_MW13, ntiles, 2 * EF, D, F.G, F.bid, tile_e, (const int*)(F.ws + WS_ROWTOK)); \
                pg8::EpiSwiglu E{(bf16*)(F.ws + WS_R1 + R1_HID), EF}; pg8::gemm_phase<D, D, pg8::EpiSwiglu, pg8::GatherOrder>(ring, S, E, F.tid); } \
            SEAM(p0 + 9); \
            if (IN(p0 + 10)) { LAUNDER(); const int* tile_e = (const int*)(F.ws + WS_TILEE); const int ntiles = __builtin_amdgcn_readfirstlane(tile_e[256]); \
                const int tmain = (ntiles - (ntiles / 64) * 64 <= 16) ? (ntiles / 64) * 64 : ntiles; \
                { pg8::GroupedOrder S; S.init(F.ws + WS_R1 + R1_HID, F.ws + WS_MW2, tmain, D, EF, F.G, F.bid, tile_e); \
                  pg8::EpiBf16 E{(bf16*)(F.ws + WS_YM), D}; pg8::gemm_phase<EF, EF, pg8::EpiBf16, pg8::GroupedOrder>(ring, S, E, F.tid); } \
                if (ntiles > tmain) { RELAUNDER(); const int* tile_e2 = (const int*)(F.ws + WS_TILEE); \
                  pg8::SplitGroupedOrder S; S.init(F.ws + WS_R1 + R1_HID, F.ws + WS_MW2, tmain, ntiles - tmain, F.G, F.bid, tile_e2); \
                  pg8::EpiYMSlab E{(float*)(F.ws + WS_YM), (float*)(F.ws + WS_HP), tmain * 256}; pg8::gemm_phase<896, EF, pg8::EpiYMSlab, pg8::SplitGroupedOrder>(ring, S, E, F.tid); } } \
            if (IN(p0 + 10) && IN(p0 + NPH)) { xcd_barrier(bar); STAMP(p0 + 11); } \
        } \
    }
    LAYER_BODY(0) LAYER_BODY(1) LAYER_BODY(2) LAYER_BODY(3)
#undef LAYER_BODY
    if (IN(PH_TOTAL - 1)) { LAUNDER(); phase_token2<2>(F, in, DEPTH, false, true, false, args.out); }
    if (PROBE_ON && (int)blockIdx.x == ((PROBE_CUSTOM) ? (PROBE_BLOCK < 0 ? (int)gridDim.x + (PROBE_BLOCK) : (PROBE_BLOCK)) : 0) && xb_leader(F.wave)) {
        STAMP(PH_TOTAL);
        const unsigned long long T = ((volatile LAS unsigned long long*)(F.lds + 132096))[1];
        const unsigned long long t0 = __builtin_amdgcn_s_memrealtime();
        while (__builtin_amdgcn_s_memrealtime() - t0 < 8ull * T) __builtin_amdgcn_s_sleep(8);
    }
#undef IN
#undef SEAM
}

extern "C" void kernel_launch(void* const* d_in, const int* in_sizes, int n_in, void* d_out, int out_size, void* d_ws, size_t ws_size, hipStream_t stream) {
    static int grid = 0;
    if (grid == 0) {
        if (n_in != 25 || out_size != ML * D || ws_size < WS_END) { fprintf(stderr, "kernel_launch: unexpected problem: n_in %d out %d ws %zu (need %zu)\n", n_in, out_size, ws_size, (size_t)WS_END); grid = -1; return; }
        int dev = 0, cus = 0, per_cu = 0;
        if (hipGetDevice(&dev) != hipSuccess || hipDeviceGetAttribute(&cus, hipDeviceAttributeMultiprocessorCount, dev) != hipSuccess) { grid = -1; return; }
        if (hipFuncSetAttribute((const void*)fwd_kernel, hipFuncAttributeMaxDynamicSharedMemorySize, LDS_BYTES) != hipSuccess) { fprintf(stderr, "kernel_launch: hipFuncSetAttribute failed\n"); grid = -1; return; }
        if (hipOccupancyMaxActiveBlocksPerMultiprocessor(&per_cu, (const void*)fwd_kernel, NTHR, LDS_BYTES) != hipSuccess || per_cu < 1) fprintf(stderr, "kernel_launch: occupancy query reports %d\n", per_cu);
        (void)hipGetLastError();
        grid = cus;
    }
    if (grid < 0) return;
    (void)hipMemsetAsync((char*)d_ws + WS_CTL, 0, CTL_ZERO_BYTES, stream);
    Args a{};
    const float** ip = (const float**)&a.in;
    for (int i = 0; i < 25; ++i) ip[i] = (const float*)d_in[i];
    a.out = (float*)d_out; a.ws = (unsigned char*)d_ws;
#if MK_ONE_LAUNCH
    a.ph_lo = 0; a.ph_hi = PH_TOTAL;
    hipLaunchKernelGGL(fwd_kernel, dim3(grid), dim3(NTHR), LDS_BYTES, stream, a);
#else
    for (int ph = 0; ph < PH_TOTAL; ++ph) { if (!phase_exists(ph)) continue; a.ph_lo = ph; a.ph_hi = ph + 1;
        hipLaunchKernelGGL(fwd_kernel, dim3(grid), dim3(NTHR), LDS_BYTES, stream, a); }
#endif
}
```
